# Optimizing an MI355X kernel written in HIP

```python
import math
import jax
import jax.numpy as jnp
from jax import lax
import numpy as np

D_MODEL = 1024
BATCH = 8
SEQ = 2048
DEPTH = 2

F32 = jnp.float32

GDN_HEADS = 6
GDN_DK = 64
GDN_DV = 64
GDN_CONV = 5
GDN_CHUNK = 64
GDN_QK_W = GDN_HEADS * GDN_DK
GDN_W = GDN_HEADS * GDN_DV
GDN_QKV_W = 2 * GDN_QK_W + GDN_W

MLA_HEADS = 6
MLA_NOPE = 64
MLA_ROPE = 32
MLA_V = 64
MLA_Q_RANK = 192
MLA_KV_RANK = 128
MLA_QBLOCK = 128
ROPE_THETA = 10000.0
MLA_W = MLA_HEADS * MLA_V

RWKV_HEADS = 4
RWKV_HD = 64
RWKV_DECAY_LORA = 64
RWKV_ICLR_LORA = 64
RWKV_W = RWKV_HEADS * RWKV_HD
RWKV_SHIFT_W = 3 * RWKV_W + RWKV_DECAY_LORA + RWKV_ICLR_LORA
RWKV_LN_EPS = 64e-5

D_MIX = GDN_W + MLA_W + RWKV_W
NORM_EPS = 1e-6

IN_LAYOUT = (
    ('gate', D_MIX),
    ('gdn_q', GDN_QK_W), ('gdn_k', GDN_QK_W), ('gdn_v', GDN_W),
    ('gdn_a', 2 * GDN_HEADS), ('gdn_b', 2 * GDN_HEADS),
    ('mla_cq', MLA_Q_RANK), ('mla_ckv', MLA_KV_RANK), ('mla_kr', MLA_ROPE),
    ('rw_r', RWKV_W), ('rw_k', RWKV_W), ('rw_v', RWKV_W),
    ('rw_wd', RWKV_DECAY_LORA), ('rw_ad', RWKV_ICLR_LORA),
)
N_IN = sum(width for _, width in IN_LAYOUT)

kernel_name = 'bidir_hybrid_gdn_mla_rwkv7_block'


def split_columns(p):
    cols = {}
    off = 0
    for name, width in IN_LAYOUT:
        cols[name] = p[..., off:off + width]
        off += width
    return cols


def rms_norm(x, g, eps=NORM_EPS):
    xf = x.astype(F32)
    y = xf * lax.rsqrt(jnp.mean(xf * xf, axis=-1, keepdims=True) + eps)
    return (y * g.astype(F32)).astype(x.dtype)


def l2_normalize(x, eps=1e-6):
    xf = x.astype(F32)
    return xf * lax.rsqrt(jnp.sum(xf * xf, axis=-1, keepdims=True) + eps)


def centred_depthwise_conv(x, w):
    pad = w.shape[0] // 2
    return lax.conv_general_dilated(
        x, w[:, None, :].astype(x.dtype), window_strides=(1,), padding=[(pad, pad)],
        dimension_numbers=('NWC', 'WIO', 'NWC'), feature_group_count=x.shape[-1])


def centred_token_shift(x, mu):
    zeros = jnp.zeros_like(x[:, :1])
    x_prev = jnp.concatenate([zeros, x[:, :-1]], axis=1)
    x_next = jnp.concatenate([x[:, 1:], zeros], axis=1)
    return x + mu[0] * (x_prev - x) + mu[1] * (x_next - x)


def bidir_stack(t_fwd, t_bwd):
    return jnp.concatenate([t_fwd, jnp.flip(t_bwd, axis=1)], axis=0)


def bidir_merge(y):
    b = y.shape[0] // 2
    return y[:b] + jnp.flip(y[b:], axis=1)


def gated_delta_chunked(q, k, v, g, beta):
    n, l, h, dk = q.shape
    dv = v.shape[-1]
    c = GDN_CHUNK
    nc = l // c

    def chunks(t):
        return jnp.moveaxis(t.reshape((n, nc, c, h) + t.shape[3:]), 3, 1)

    q, k, v, g, beta = chunks(q), chunks(k), chunks(v), chunks(g), chunks(beta)
    cum = jnp.cumsum(g, axis=-1)
    diff = cum[..., :, None] - cum[..., None, :]
    idx = jnp.arange(c)
    incl = idx[:, None] >= idx[None, :]
    strict = idx[:, None] > idx[None, :]
    d_incl = jnp.exp(jnp.where(incl, diff, -jnp.inf))
    d_strict = jnp.where(strict, d_incl, 0.0)
    a_mat = beta[..., :, None] * jnp.einsum('nhcid,nhcjd->nhcij', k, k) * d_strict
    gam = jnp.exp(cum)
    rhs = jnp.concatenate([beta[..., None] * v, (beta * gam)[..., None] * k], axis=-1)
    sol = lax.linalg.triangular_solve(a_mat, rhs, left_side=True, lower=True, unit_diagonal=True)
    u0, w = sol[..., :dv], sol[..., dv:]
    p_intra = jnp.einsum('nhcid,nhcjd->nhcij', q, k) * d_incl
    q_g = q * gam[..., None]
    k_d = k * jnp.exp(cum[..., -1:] - cum)[..., None]
    g_end = jnp.exp(cum[..., -1])
    xs = tuple(jnp.moveaxis(t, 2, 0) for t in (w, u0, p_intra, q_g, k_d, g_end))

    def step(s, inp):
        w_c, u0_c, p_c, qg_c, kd_c, ge_c = inp
        u = u0_c - jnp.einsum('nhcd,nhde->nhce', w_c, s)
        o = jnp.einsum('nhcd,nhde->nhce', qg_c, s) + jnp.einsum('nhij,nhje->nhie', p_c, u)
        s = ge_c[..., None, None] * s + jnp.einsum('nhcd,nhce->nhde', kd_c, u)
        return s, o

    s0 = jnp.zeros((n, h, dk, dv), F32)
    _, o = lax.scan(step, s0, xs)
    return jnp.transpose(o, (1, 0, 3, 2, 4)).reshape(n, l, h, dv)


def gdn_branch(cols, conv_w, a_log, dt_bias, norm_g):
    b, l = cols['gdn_q'].shape[:2]
    qkv = jnp.concatenate([cols['gdn_q'], cols['gdn_k'], cols['gdn_v']], axis=-1)
    qkv = jax.nn.silu(centred_depthwise_conv(qkv, conv_w))
    q, k, v = jnp.split(qkv, [GDN_QK_W, 2 * GDN_QK_W], axis=-1)
    q = l2_normalize(q.reshape(b, l, GDN_HEADS, GDN_DK)) * (GDN_DK ** -0.5)
    k = l2_normalize(k.reshape(b, l, GDN_HEADS, GDN_DK))
    v = v.reshape(b, l, GDN_HEADS, GDN_DV).astype(F32)
    a = cols['gdn_a'].astype(F32).reshape(b, l, 2, GDN_HEADS)
    bt = cols['gdn_b'].astype(F32).reshape(b, l, 2, GDN_HEADS)
    g = -jnp.exp(a_log.astype(F32)) * jax.nn.softplus(a + dt_bias.astype(F32))
    beta = jax.nn.sigmoid(bt)
    o = gated_delta_chunked(
        bidir_stack(q, q), bidir_stack(k, k), bidir_stack(v, v),
        bidir_stack(g[:, :, 0], g[:, :, 1]), bidir_stack(beta[:, :, 0], beta[:, :, 1]))
    o = rms_norm(bidir_merge(o), norm_g)
    return o.reshape(b, l, GDN_W)


def apply_rope(x, cos, sin):
    xf = x.astype(F32)
    x1, x2 = jnp.split(xf, 2, axis=-1)
    return jnp.concatenate([x1 * cos - x2 * sin, x2 * cos + x1 * sin], axis=-1)


def mla_branch(cols, positions, q_norm_g, w_uq, kv_norm_g, w_ukv):
    b, l = cols['mla_cq'].shape[:2]
    q = (rms_norm(cols['mla_cq'], q_norm_g) @ w_uq).reshape(b, l, MLA_HEADS, MLA_NOPE + MLA_ROPE)
    kv = (rms_norm(cols['mla_ckv'], kv_norm_g) @ w_ukv).reshape(b, l, MLA_HEADS, MLA_NOPE + MLA_V)
    q_nope, q_rot = q[..., :MLA_NOPE], q[..., MLA_NOPE:]
    k_nope, v = kv[..., :MLA_NOPE], kv[..., MLA_NOPE:]
    half = MLA_ROPE // 2
    inv_freq = ROPE_THETA ** (-jnp.arange(half, dtype=F32) / half)
    ang = positions.astype(F32)[..., None] * inv_freq
    cos, sin = jnp.cos(ang), jnp.sin(ang)
    q_rot = apply_rope(q_rot, cos[:, :, None], sin[:, :, None])
    k_rot = apply_rope(cols['mla_kr'], cos, sin)
    scale = (MLA_NOPE + MLA_ROPE) ** -0.5
    q = jnp.concatenate([q_nope.astype(F32), q_rot], axis=-1) * scale
    k = jnp.concatenate([k_nope.astype(F32),
                         jnp.broadcast_to(k_rot[:, :, None], (b, l, MLA_HEADS, MLA_ROPE))], axis=-1)
    v = v.astype(F32)
    nb = l // MLA_QBLOCK
    q_blocks = jnp.moveaxis(q.reshape(b, nb, MLA_QBLOCK, MLA_HEADS, MLA_NOPE + MLA_ROPE), 1, 0)

    def attend(q_blk):
        s = jnp.einsum('bqhd,bkhd->bhqk', q_blk, k)
        p = jax.nn.softmax(s, axis=-1)
        return jnp.einsum('bhqk,bkhd->bqhd', p, v)

    o = lax.map(attend, q_blocks)
    return jnp.moveaxis(o, 0, 1).reshape(b, l, MLA_W)


def to_heads(t):
    return t.reshape(t.shape[:-1] + (RWKV_HEADS, RWKV_HD))


def rwkv7_branch(cols, mu, w0, w2, a0, a2, k_k, k_a, r_k, ln_g, ln_b):
    b, l = cols['rw_r'].shape[:2]
    feats = jnp.concatenate([cols['rw_r'], cols['rw_k'], cols['rw_v'], cols['rw_wd'], cols['rw_ad']],
                            axis=-1).astype(F32)
    feats = centred_token_shift(feats, mu.astype(F32))
    r, k, v, wd, ad = jnp.split(feats, [RWKV_W, 2 * RWKV_W, 3 * RWKV_W, 3 * RWKV_W + RWKV_DECAY_LORA], axis=-1)
    w_log = -jax.nn.softplus(-(w0.astype(F32)[:, None, None]
                               + jnp.einsum('bld,edc->eblc', jnp.tanh(wd), w2.astype(F32)))) - 0.5
    decay = jnp.exp(-jnp.exp(w_log))
    a = jax.nn.sigmoid(a0.astype(F32)[:, None, None] + jnp.einsum('bld,edc->eblc', ad, a2.astype(F32)))
    kk = l2_normalize(to_heads(k * k_k.astype(F32)))
    k_mod = k[None] * (1.0 + (a - 1.0) * k_a.astype(F32))
    r_h, v_h = to_heads(r), to_heads(v)
    a_h = to_heads(a)
    xs = (
        bidir_stack(r_h, r_h),
        bidir_stack(to_heads(decay[0]), to_heads(decay[1])),
        bidir_stack(to_heads(k_mod[0]), to_heads(k_mod[1])),
        bidir_stack(v_h, v_h),
        bidir_stack(kk, kk),
        bidir_stack(a_h[0] * kk, a_h[1] * kk),
    )
    xs = tuple(jnp.moveaxis(t, 1, 0) for t in xs)

    def step(s, inp):
        r_t, w_t, k_t, v_t, kk_t, b_t = inp
        sa = jnp.einsum('nhij,nhj->nhi', s, -kk_t)
        s = s * w_t[:, :, None, :] + sa[..., None] * b_t[:, :, None, :] + v_t[..., None] * k_t[:, :, None, :]
        y = jnp.einsum('nhij,nhj->nhi', s, r_t)
        return s, y

    s0 = jnp.zeros((2 * b, RWKV_HEADS, RWKV_HD, RWKV_HD), F32)
    _, y = lax.scan(step, s0, xs)
    y = bidir_merge(jnp.moveaxis(y, 0, 1))
    mean = jnp.mean(y, axis=-1, keepdims=True)
    var = jnp.mean(jnp.square(y - mean), axis=-1, keepdims=True)
    y = ((y - mean) * lax.rsqrt(var + RWKV_LN_EPS)).reshape(b, l, RWKV_W) * ln_g.astype(F32) + ln_b.astype(F32)
    k_bonus = to_heads(0.5 * (k_mod[0] + k_mod[1]))
    bonus = jnp.sum(r_h * k_bonus * r_k.astype(F32), axis=-1, keepdims=True) * v_h
    return y + bonus.reshape(b, l, RWKV_W)


def setup_inputs(seed: int = 0) -> dict:
    key = jax.random.key(seed)
    ks = jax.random.split(key, 24)

    def nrm(k, shape, scale):
        return jax.random.normal(k, shape, F32) * scale

    x = nrm(ks[0], (BATCH, SEQ, D_MODEL), 1.0)
    positions = (jnp.arange(SEQ, dtype=jnp.int32)[None, :]
                 + jax.random.randint(ks[1], (BATCH, 1), 0, 512, dtype=jnp.int32))
    norm_g = 1.0 + nrm(ks[2], (DEPTH, D_MODEL), 0.02)
    w_in = nrm(ks[3], (DEPTH, D_MODEL, N_IN), D_MODEL ** -0.5)
    gdn_conv = nrm(ks[4], (DEPTH, GDN_CONV, GDN_QKV_W), GDN_CONV ** -0.5)
    gdn_a_log = jnp.log(jax.random.uniform(ks[5], (DEPTH, 2, GDN_HEADS), F32, 1.0, 16.0))
    dt = jnp.exp(jax.random.uniform(ks[6], (DEPTH, 2, GDN_HEADS), F32, math.log(1e-3), math.log(1e-1)))
    gdn_dt_bias = dt + jnp.log(-jnp.expm1(-dt))
    gdn_norm_g = 1.0 + nrm(ks[7], (DEPTH, GDN_DV), 0.02)
    mla_q_norm_g = 1.0 + nrm(ks[8], (DEPTH, MLA_Q_RANK), 0.02)
    mla_w_uq = nrm(ks[9], (DEPTH, MLA_Q_RANK, MLA_HEADS * (MLA_NOPE + MLA_ROPE)), MLA_Q_RANK ** -0.5)
    mla_kv_norm_g = 1.0 + nrm(ks[10], (DEPTH, MLA_KV_RANK), 0.02)
    mla_w_ukv = nrm(ks[11], (DEPTH, MLA_KV_RANK, MLA_HEADS * (MLA_NOPE + MLA_V)), MLA_KV_RANK ** -0.5)
    rwkv_mu = jax.random.uniform(ks[12], (DEPTH, 2, RWKV_SHIFT_W), F32, 0.0, 0.5)
    rwkv_w0 = jax.random.uniform(ks[13], (DEPTH, 2, RWKV_W), F32, -6.0, -1.0)
    rwkv_w2 = nrm(ks[14], (DEPTH, 2, RWKV_DECAY_LORA, RWKV_W), 0.1)
    rwkv_a0 = nrm(ks[15], (DEPTH, 2, RWKV_W), 0.1)
    rwkv_a2 = nrm(ks[16], (DEPTH, 2, RWKV_ICLR_LORA, RWKV_W), 0.1)
    rwkv_k_k = 0.85 + nrm(ks[17], (DEPTH, RWKV_W), 0.02)
    rwkv_k_a = 1.0 + nrm(ks[18], (DEPTH, RWKV_W), 0.02)
    rwkv_r_k = nrm(ks[19], (DEPTH, RWKV_HEADS, RWKV_HD), 0.1)
    rwkv_ln_g = 1.0 + nrm(ks[20], (DEPTH, RWKV_W), 0.02)
    rwkv_ln_b = nrm(ks[21], (DEPTH, RWKV_W), 0.02)
    w_out = nrm(ks[22], (DEPTH, D_MIX, D_MODEL), D_MIX ** -0.5)
    final_norm_g = 1.0 + nrm(ks[23], (D_MODEL,), 0.02)
    return {
        'x': x, 'positions': positions, 'norm_g': norm_g, 'w_in': w_in,
        'gdn_conv': gdn_conv, 'gdn_a_log': gdn_a_log, 'gdn_dt_bias': gdn_dt_bias, 'gdn_norm_g': gdn_norm_g,
        'mla_q_norm_g': mla_q_norm_g, 'mla_w_uq': mla_w_uq, 'mla_kv_norm_g': mla_kv_norm_g, 'mla_w_ukv': mla_w_ukv,
        'rwkv_mu': rwkv_mu, 'rwkv_w0': rwkv_w0, 'rwkv_w2': rwkv_w2, 'rwkv_a0': rwkv_a0, 'rwkv_a2': rwkv_a2,
        'rwkv_k_k': rwkv_k_k, 'rwkv_k_a': rwkv_k_a, 'rwkv_r_k': rwkv_r_k,
        'rwkv_ln_g': rwkv_ln_g, 'rwkv_ln_b': rwkv_ln_b,
        'w_out': w_out, 'final_norm_g': final_norm_g,
    }


def reference(x, positions, norm_g, w_in, gdn_conv, gdn_a_log, gdn_dt_bias, gdn_norm_g,
              mla_q_norm_g, mla_w_uq, mla_kv_norm_g, mla_w_ukv,
              rwkv_mu, rwkv_w0, rwkv_w2, rwkv_a0, rwkv_a2, rwkv_k_k, rwkv_k_a, rwkv_r_k,
              rwkv_ln_g, rwkv_ln_b, w_out, final_norm_g):
    for layer in range(DEPTH):
        h = rms_norm(x, norm_g[layer])
        cols = split_columns(h @ w_in[layer])
        y_gdn = gdn_branch(cols, gdn_conv[layer], gdn_a_log[layer], gdn_dt_bias[layer], gdn_norm_g[layer])
        y_mla = mla_branch(cols, positions, mla_q_norm_g[layer], mla_w_uq[layer],
                           mla_kv_norm_g[layer], mla_w_ukv[layer])
        y_rwkv = rwkv7_branch(cols, rwkv_mu[layer], rwkv_w0[layer], rwkv_w2[layer], rwkv_a0[layer],
                              rwkv_a2[layer], rwkv_k_k[layer], rwkv_k_a[layer], rwkv_r_k[layer],
                              rwkv_ln_g[layer], rwkv_ln_b[layer])
        mix = jnp.concatenate([y_gdn.astype(F32), y_mla.astype(F32), y_rwkv.astype(F32)], axis=-1)
        mix = mix * jax.nn.silu(cols['gate'].astype(F32))
        x = x + mix.astype(x.dtype) @ w_out[layer]
    return rms_norm(x, final_norm_g)
```

```cpp
#include <hip/hip_runtime.h>
#include <hip/hip_fp16.h>
#include <cstdint>
#include <cstdio>

typedef unsigned short bf16;
typedef unsigned u32x4 __attribute__((ext_vector_type(4)));

constexpr int BATCH = 8, SEQ = 2048, M = BATCH * SEQ, D = 1024, NIN = 3448, NP = 3584;
constexpr float NORM_EPS = 1e-6f;
constexpr float LOG2E = 1.4426950408889634f;
constexpr size_t MiB = 1u << 20;
constexpr size_t WS_CTL = 0;
constexpr size_t WS_ROWSS = 1 * MiB;
constexpr size_t WS_WIN = 2 * MiB;
constexpr size_t WS_WOUT = 16 * MiB;
constexpr size_t WS_WSMALL = 20 * MiB;
constexpr size_t OFF_WUQ = 0, OFF_WUKV = 2 * 576 * 192 * 2, OFF_W2T = OFF_WUKV + 2 * 768 * 128 * 2, OFF_A2T = OFF_W2T + 2 * 2 * 256 * 64 * 2;
constexpr size_t WS_PSM = 22 * MiB;
constexpr size_t WS_CB = 24 * MiB;
constexpr size_t WS_PGATE = 25 * MiB;
constexpr size_t WS_PGDN = 57 * MiB;
constexpr size_t WS_PMLA = 93 * MiB;
constexpr size_t WS_PRW = 104 * MiB;
constexpr size_t WS_OGDN = 93 * MiB;
constexpr size_t WS_OMLA = 105 * MiB;
constexpr size_t WS_Y = 117 * MiB;
constexpr size_t WS_RS = 133 * MiB;
constexpr size_t WS_RD = 157 * MiB;
constexpr size_t WS_XB = 133 * MiB;
constexpr size_t WS_Q = 207 * MiB;
constexpr size_t WS_K = 225 * MiB;
constexpr size_t WS_VT = 243 * MiB;
constexpr size_t WS_MIX = 207 * MiB;
constexpr size_t WS_END = 255 * MiB;
constexpr int RS_REC = 384, RD_REC = 400;
constexpr size_t RD_DIR = (size_t)BATCH * 4 * SEQ * RD_REC;

__device__ __forceinline__ float bf2f(bf16 v) { return __uint_as_float(((unsigned)v) << 16); }
__device__ __forceinline__ bf16 f2bf(float f) { unsigned u = __float_as_uint(f); return (bf16)((u + 0x7fffu + ((u >> 16) & 1u)) >> 16); }
__device__ __forceinline__ float wave_sum(float v) {
#pragma unroll
    for (int o = 1; o < 64; o <<= 1) v += __shfl_xor(v, o);
    return v;
}
__device__ __forceinline__ float siluf(float x) { return x / (1.f + __expf(-x)); }
__device__ __forceinline__ float sigmoidf_(float x) { return 1.f / (1.f + __expf(-x)); }
__device__ __forceinline__ float softplusf_(float x) { return x > 20.f ? x : log1pf(__expf(x)); }

__global__ void nk_transpose(const float* W, int K, int ldsrc, int src_col0, int nvalid, int nrows, bf16* WT, const float* gs) {
    const size_t idx = (size_t)blockIdx.x * blockDim.x + threadIdx.x;
    if (idx >= (size_t)nrows * K) return;
    const int n = (int)(idx / K), k = (int)(idx % K);
    float v = 0.f;
    if (n < nvalid) v = W[(size_t)k * ldsrc + src_col0 + n] * (gs ? gs[k] : 1.f);
    WT[idx] = f2bf(v);
}
__global__ void nk_xprep(const float* x, bf16* xb, float* rowss) {
    const int row = blockIdx.x * 4 + (threadIdx.x >> 6), lane = threadIdx.x & 63;
    const float* xr = x + (size_t)row * D;
    float s = 0.f;
    for (int c = lane; c < D; c += 64) { const float v = xr[c]; s += v * v; xb[(size_t)row * D + c] = f2bf(v); }
    s = wave_sum(s);
    if (lane < 16) rowss[(size_t)row * 16 + lane] = lane == 0 ? s : 0.f;
}
__device__ __forceinline__ float dot_bf16(const bf16* a, const bf16* b, int K) {
    float acc = 0.f;
    for (int k = 0; k < K; k += 8) {
        const u32x4 av = *(const u32x4*)(a + k), bv = *(const u32x4*)(b + k);
#pragma unroll
        for (int i = 0; i < 4; ++i) {
            acc += __uint_as_float(av[i] << 16) * __uint_as_float(bv[i] << 16);
            acc += __uint_as_float(av[i] & 0xffff0000u) * __uint_as_float(bv[i] & 0xffff0000u);
        }
    }
    return acc;
}
__global__ void nk_inproj(const bf16* xb, const bf16* WinT, const float* rowss, bf16* Pgate, bf16* Pgdn, bf16* Pmla, bf16* Prw, float* Psm) {
    const int n = blockIdx.x * 16 + (threadIdx.x & 15), m = blockIdx.y * 16 + (threadIdx.x >> 4);
    if (n >= NIN) return;
    float ss = 0.f;
    for (int i = 0; i < 16; ++i) ss += rowss[(size_t)m * 16 + i];
    const float rstd = rsqrtf(ss * (1.f / D) + NORM_EPS);
    const float v = dot_bf16(xb + (size_t)m * D, WinT + (size_t)n * D, D) * rstd;
    if (n < 1024) Pgate[(size_t)m * 1024 + n] = f2bf(v);
    else if (n < 2176) Pgdn[(size_t)m * 1152 + (n - 1024)] = f2bf(v);
    else if (n < 2528) Pmla[(size_t)m * 352 + (n - 2176)] = f2bf(v);
    else if (n < 3424) Prw[(size_t)m * 896 + (n - 2528)] = f2bf(v);
    else Psm[(size_t)m * 32 + (n - 3424)] = v;
}
__global__ void __launch_bounds__(64) nk_mla_prep(const bf16* Pmla, const bf16* WuqT, const bf16* WukvT, const int* positions, bf16* Q, bf16* Kb, bf16* Vt) {
    __shared__ float raw[576 + 768];
    __shared__ float rs[2];
    const int m = blockIdx.x, lane = threadIdx.x, b = m / SEQ, t = m % SEQ;
    const bf16* p = Pmla + (size_t)m * 352;
    float s1 = 0.f, s2 = 0.f;
    for (int c = lane; c < 192; c += 64) { const float v = bf2f(p[c]); s1 += v * v; }
    for (int c = lane; c < 128; c += 64) { const float v = bf2f(p[192 + c]); s2 += v * v; }
    s1 = wave_sum(s1); s2 = wave_sum(s2);
    const float rq = rsqrtf(s1 * (1.f / 192.f) + NORM_EPS), rkv = rsqrtf(s2 * (1.f / 128.f) + NORM_EPS);
    for (int c = lane; c < 576; c += 64) raw[c] = dot_bf16(p, WuqT + (size_t)c * 192, 192) * rq;
    for (int c = lane; c < 768; c += 64) raw[576 + c] = dot_bf16(p + 192, WukvT + (size_t)c * 128, 128) * rkv;
    __syncthreads();
    const float pos = (float)positions[m];
    const float qs = 0.10206207261596575f * LOG2E;
    for (int i = lane; i < 6 * 80; i += 64) {
        const int h = i / 80, j = i % 80;
        bf16* qo = Q + (((size_t)b * 6 + h) * SEQ + t) * 96;
        if (j < 64) qo[j] = f2bf(raw[h * 96 + j] * qs);
        else { const int r = j - 64; const float inv = exp2f(-(float)r * (13.287712379549449f / 16.f)); float sn, cs; sincosf(pos * inv, &sn, &cs);
            const float x1 = raw[h * 96 + 64 + r], x2 = raw[h * 96 + 80 + r];
            qo[64 + r] = f2bf((x1 * cs - x2 * sn) * qs); qo[80 + r] = f2bf((x2 * cs + x1 * sn) * qs); }
    }
    for (int i = lane; i < 6 * 64; i += 64) {
        const int h = i / 64, j = i % 64;
        Kb[(((size_t)b * 6 + h) * SEQ + t) * 96 + j] = f2bf(raw[576 + h * 128 + j]);
        Vt[(((size_t)b * 6 + h) * 64 + j) * SEQ + t] = f2bf(raw[576 + h * 128 + 64 + j]);
    }
    if (lane < 16) {
        const int r = lane; const float inv = exp2f(-(float)r * (13.287712379549449f / 16.f)); float sn, cs; sincosf(pos * inv, &sn, &cs);
        const float x1 = bf2f(p[320 + r]), x2 = bf2f(p[336 + r]);
        const bf16 o1 = f2bf(x1 * cs - x2 * sn), o2 = f2bf(x2 * cs + x1 * sn);
        for (int h = 0; h < 6; ++h) { bf16* ko = Kb + (((size_t)b * 6 + h) * SEQ + t) * 96; ko[64 + r] = o1; ko[80 + r] = o2; }
    }
}
__global__ void __launch_bounds__(256) nk_rwkv_prep(const bf16* Prw, const float* mu, const float* w0, const float* w2, const float* a0, const float* a2,
                             const float* k_k, const float* k_a, const float* r_k, unsigned char* Rs, unsigned char* Rd, float* cb) {
    __shared__ float f[896];
    const int m = blockIdx.x, c = threadIdx.x, b = m / SEQ, t = m % SEQ, h = c >> 6, j = c & 63;
    for (int i = c; i < 896; i += 256) {
        const float x = bf2f(Prw[(size_t)m * 896 + i]);
        const float xp = t > 0 ? bf2f(Prw[(size_t)(m - 1) * 896 + i]) : 0.f;
        const float xn = t < SEQ - 1 ? bf2f(Prw[(size_t)(m + 1) * 896 + i]) : 0.f;
        float v = x + mu[i] * (xp - x) + mu[896 + i] * (xn - x);
        if (i >= 768 && i < 832) v = tanhf(v);
        f[i] = v;
    }
    __syncthreads();
    const float r = f[c], k = f[256 + c], v = f[512 + c];
    const float kkr = k * k_k[c];
    const float kn = wave_sum(kkr * kkr);
    const float kk = kkr * rsqrtf(kn + 1e-6f);
    float kmod[2], bb[2], lam[2];
#pragma unroll
    for (int e = 0; e < 2; ++e) {
        float lw = 0.f, la = 0.f;
        for (int d = 0; d < 64; ++d) { lw += f[768 + d] * w2[((size_t)e * 64 + d) * 256 + c]; la += f[832 + d] * a2[((size_t)e * 64 + d) * 256 + c]; }
        const float wl = -softplusf_(-(w0[e * 256 + c] + lw)) - 0.5f;
        lam[e] = __expf(wl);
        const float a = sigmoidf_(a0[e * 256 + c] + la);
        kmod[e] = k * (1.f + (a - 1.f) * k_a[c]);
        bb[e] = a * kk;
    }
    unsigned char* rs = Rs + (((size_t)b * 4 + h) * SEQ + t) * RS_REC;
    ((bf16*)rs)[j] = f2bf(kk); ((bf16*)(rs + 128))[j] = f2bf(v); ((bf16*)(rs + 256))[j] = f2bf(r);
#pragma unroll
    for (int e = 0; e < 2; ++e) {
        unsigned char* rd = Rd + e * RD_DIR + (((size_t)b * 4 + h) * SEQ + t) * RD_REC;
        ((__half*)rd)[j] = __float2half(lam[e]); ((bf16*)(rd + 128))[j] = f2bf(bb[e]); ((bf16*)(rd + 256))[j] = f2bf(kmod[e]);
        const float br = wave_sum(bb[e] * r), kr = wave_sum(kmod[e] * r);
        if (j == 0) { ((float*)(rd + 384))[0] = br; ((float*)(rd + 384))[1] = kr; }
    }
    const float cbv = wave_sum(r * 0.5f * (kmod[0] + kmod[1]) * r_k[c]);
    if (j == 0) cb[(size_t)m * 4 + h] = cbv;
}
__global__ void __launch_bounds__(128) nk_attn(const bf16* Q, const bf16* Kb, const bf16* Vt, bf16* Omla) {
    const int bh = blockIdx.y, q = blockIdx.x * 128 + threadIdx.x, b = bh / 6, h = bh % 6;
    const bf16* qp = Q + ((size_t)bh * SEQ + q) * 96;
    float qr[96];
#pragma unroll
    for (int i = 0; i < 96; ++i) qr[i] = bf2f(qp[i]);
    float acc[64];
#pragma unroll
    for (int i = 0; i < 64; ++i) acc[i] = 0.f;
    float mx = -1e30f, l = 0.f;
    const bf16* kb = Kb + (size_t)bh * SEQ * 96; const bf16* vt = Vt + (size_t)bh * 64 * SEQ;
    for (int k0 = 0; k0 < SEQ; k0 += 8) {
        float s[8];
#pragma unroll
        for (int kk = 0; kk < 8; ++kk) {
            const bf16* kr = kb + (size_t)(k0 + kk) * 96; float a = 0.f;
#pragma unroll
            for (int d = 0; d < 96; d += 8) { const u32x4 kv = *(const u32x4*)(kr + d);
#pragma unroll
                for (int i = 0; i < 4; ++i) { a += qr[d + 2 * i] * __uint_as_float(kv[i] << 16); a += qr[d + 2 * i + 1] * __uint_as_float(kv[i] & 0xffff0000u); } }
            s[kk] = a;
        }
        float cm = s[0];
#pragma unroll
        for (int kk = 1; kk < 8; ++kk) cm = fmaxf(cm, s[kk]);
        const float mn = fmaxf(mx, cm), sc = exp2f(mx - mn);
        l *= sc;
#pragma unroll
        for (int i = 0; i < 64; ++i) acc[i] *= sc;
        mx = mn;
#pragma unroll
        for (int kk = 0; kk < 8; ++kk) { s[kk] = exp2f(s[kk] - mn); l += s[kk]; }
#pragma unroll
        for (int d = 0; d < 64; ++d) { const u32x4 vv = *(const u32x4*)(vt + (size_t)d * SEQ + k0);
#pragma unroll
            for (int i = 0; i < 4; ++i) { acc[d] += s[2 * i] * __uint_as_float(vv[i] << 16); acc[d] += s[2 * i + 1] * __uint_as_float(vv[i] & 0xffff0000u); } }
    }
    const float il = 1.f / l;
    bf16* o = Omla + ((size_t)b * SEQ + q) * 384 + h * 64;
#pragma unroll
    for (int i = 0; i < 64; ++i) o[i] = f2bf(acc[i] * il);
}
__global__ void __launch_bounds__(64) nk_gdn(const bf16* Pgdn, const float* Psm, const float* conv_w, const float* a_log, const float* dt_bias, bf16* Ogdn, int dir) {
    __shared__ float qs[64], ks[64];
    const int bh = blockIdx.x, b = bh / 6, h = bh % 6, e = threadIdx.x;
    float S[64];
#pragma unroll
    for (int i = 0; i < 64; ++i) S[i] = 0.f;
    float cw[3][5];
#pragma unroll
    for (int i = 0; i < 5; ++i) { cw[0][i] = conv_w[i * 1152 + h * 64 + e]; cw[1][i] = conv_w[i * 1152 + 384 + h * 64 + e]; cw[2][i] = conv_w[i * 1152 + 768 + h * 64 + e]; }
    const float al = -__expf(a_log[dir * 6 + h]), dtb = dt_bias[dir * 6 + h];
    for (int n = 0; n < SEQ; ++n) {
        const int t = dir ? SEQ - 1 - n : n; const size_t m = (size_t)b * SEQ + t;
        float cq = 0.f, ck = 0.f, cv = 0.f;
#pragma unroll
        for (int i = 0; i < 5; ++i) { const int tt = t + i - 2; if (tt >= 0 && tt < SEQ) { const bf16* pr = Pgdn + ((size_t)b * SEQ + tt) * 1152 + h * 64 + e;
                cq += cw[0][i] * bf2f(pr[0]); ck += cw[1][i] * bf2f(pr[384]); cv += cw[2][i] * bf2f(pr[768]); } }
        cq = siluf(cq); ck = siluf(ck); cv = siluf(cv);
        const float qn = cq * rsqrtf(wave_sum(cq * cq) + 1e-6f) * 0.125f, kn = ck * rsqrtf(wave_sum(ck * ck) + 1e-6f);
        __syncthreads();
        qs[e] = qn; ks[e] = kn;
        __syncthreads();
        const float g = al * softplusf_(Psm[m * 32 + dir * 6 + h] + dtb), beta = sigmoidf_(Psm[m * 32 + 12 + dir * 6 + h]), alpha = __expf(g);
        float kS = 0.f;
#pragma unroll
        for (int d = 0; d < 64; ++d) kS += ks[d] * S[d];
        const float coef = beta * (cv - alpha * kS);
        float o = 0.f;
#pragma unroll
        for (int d = 0; d < 64; ++d) { S[d] = alpha * S[d] + coef * ks[d]; o += qs[d] * S[d]; }
        bf16* op = Ogdn + m * 384 + h * 64 + e;
        if (dir) o += bf2f(*op);
        *op = f2bf(o);
    }
}
__global__ void __launch_bounds__(64) nk_rwkv(const unsigned char* Rs, const unsigned char* Rd, bf16* Y, int dir) {
    const int bh = blockIdx.x, b = bh / 4, h = bh % 4, i = threadIdx.x;
    float S[64];
#pragma unroll
    for (int j = 0; j < 64; ++j) S[j] = 0.f;
    for (int n = 0; n < SEQ; ++n) {
        const int t = dir ? SEQ - 1 - n : n;
        const unsigned char* rs = Rs + ((size_t)bh * SEQ + t) * RS_REC;
        const unsigned char* rd = Rd + dir * RD_DIR + ((size_t)bh * SEQ + t) * RD_REC;
        const float v = bf2f(((const bf16*)(rs + 128))[i]);
        float sa = 0.f;
#pragma unroll
        for (int j = 0; j < 64; ++j) sa -= S[j] * bf2f(((const bf16*)rs)[j]);
        float y = 0.f;
#pragma unroll
        for (int j = 0; j < 64; ++j) {
            const float w = __expf(-__half2float(((const __half*)rd)[j]));
            S[j] = S[j] * w + sa * bf2f(((const bf16*)(rd + 128))[j]) + v * bf2f(((const bf16*)(rd + 256))[j]);
            y += S[j] * bf2f(((const bf16*)(rs + 256))[j]);
        }
        bf16* op = Y + ((size_t)b * SEQ + t) * 256 + h * 64 + i;
        if (dir) y += bf2f(*op);
        *op = f2bf(y);
    }
}
__global__ void __launch_bounds__(1024) nk_mix(const bf16* Ogdn, const bf16* Omla, const bf16* Y, const bf16* Pgate, const unsigned char* Rs, const float* cb,
                       const float* gdn_g, const float* ln_g, const float* ln_b, bf16* mix) {
    const int m = blockIdx.x, c = threadIdx.x, b = m / SEQ, t = m % SEQ;
    float val;
    if (c < 384) { const float o = bf2f(Ogdn[(size_t)m * 384 + c]); const float ss = wave_sum(o * o); val = o * rsqrtf(ss * (1.f / 64.f) + NORM_EPS) * gdn_g[c & 63]; }
    else if (c < 768) val = bf2f(Omla[(size_t)m * 384 + (c - 384)]);
    else { const int cc = c - 768, h = cc >> 6, j = cc & 63; const float y = bf2f(Y[(size_t)m * 256 + cc]);
        const float mean = wave_sum(y) * (1.f / 64.f); const float dv = y - mean; const float var = wave_sum(dv * dv) * (1.f / 64.f);
        const float v = bf2f(((const bf16*)(Rs + (((size_t)b * 4 + h) * SEQ + t) * RS_REC + 128))[j]);
        val = dv * rsqrtf(var + 64e-5f) * ln_g[cc] + ln_b[cc] + cb[(size_t)m * 4 + h] * v; }
    mix[(size_t)m * 1024 + c] = f2bf(val * siluf(bf2f(Pgate[(size_t)m * 1024 + c])));
}
__global__ void nk_outproj(const bf16* mix, const bf16* WoutT, const float* xin, float* xout) {
    const int n = blockIdx.x * 16 + (threadIdx.x & 15), m = blockIdx.y * 16 + (threadIdx.x >> 4);
    xout[(size_t)m * D + n] = xin[(size_t)m * D + n] + dot_bf16(mix + (size_t)m * D, WoutT + (size_t)n * D, D);
}
__global__ void nk_final(float* x, const float* g) {
    const int row = blockIdx.x * 4 + (threadIdx.x >> 6), lane = threadIdx.x & 63;
    float* xr = x + (size_t)row * D; float s = 0.f;
    for (int c = lane; c < D; c += 64) { const float v = xr[c]; s += v * v; }
    const float rstd = rsqrtf(wave_sum(s) * (1.f / D) + NORM_EPS);
    for (int c = lane; c < D; c += 64) xr[c] = xr[c] * rstd * g[c];
}

static void transpose(hipStream_t st, const float* W, int K, int ld, int c0, int nvalid, int nrows, bf16* WT, const float* gs) {
    const size_t n = (size_t)nrows * K;
    hipLaunchKernelGGL(nk_transpose, dim3((unsigned)((n + 255) / 256)), dim3(256), 0, st, W, K, ld, c0, nvalid, nrows, WT, gs);
}

extern "C" void kernel_launch(void* const* d_in, const int* in_sizes, int n_in, void* d_out, int out_size, void* d_ws, size_t ws_size, hipStream_t stream) {
    if (n_in != 24 || ws_size < WS_END) { fprintf(stderr, "kernel_launch: unexpected inputs (%d) or workspace (%zu)\n", n_in, ws_size); return; }
    unsigned char* ws = (unsigned char*)d_ws;
    const float* x = (const float*)d_in[0]; const int* positions = (const int*)d_in[1];
    const float* norm_g = (const float*)d_in[2]; const float* w_in = (const float*)d_in[3]; const float* gdn_conv = (const float*)d_in[4];
    const float* gdn_a_log = (const float*)d_in[5]; const float* gdn_dt_bias = (const float*)d_in[6]; const float* gdn_norm_g = (const float*)d_in[7];
    const float* q_norm_g = (const float*)d_in[8]; const float* w_uq = (const float*)d_in[9]; const float* kv_norm_g = (const float*)d_in[10]; const float* w_ukv = (const float*)d_in[11];
    const float* mu = (const float*)d_in[12]; const float* w0 = (const float*)d_in[13]; const float* w2 = (const float*)d_in[14]; const float* a0 = (const float*)d_in[15];
    const float* a2 = (const float*)d_in[16]; const float* k_k = (const float*)d_in[17]; const float* k_a = (const float*)d_in[18]; const float* r_k = (const float*)d_in[19];
    const float* ln_g = (const float*)d_in[20]; const float* ln_b = (const float*)d_in[21]; const float* w_out = (const float*)d_in[22]; const float* final_g = (const float*)d_in[23];
    float* out = (float*)d_out;
    bf16* WinT = (bf16*)(ws + WS_WIN); bf16* WoutT = (bf16*)(ws + WS_WOUT);
    bf16* WuqT = (bf16*)(ws + WS_WSMALL + OFF_WUQ); bf16* WukvT = (bf16*)(ws + WS_WSMALL + OFF_WUKV);
    float* rowss = (float*)(ws + WS_ROWSS); float* Psm = (float*)(ws + WS_PSM); float* cb = (float*)(ws + WS_CB);
    bf16* Pgate = (bf16*)(ws + WS_PGATE); bf16* Pgdn = (bf16*)(ws + WS_PGDN); bf16* Pmla = (bf16*)(ws + WS_PMLA); bf16* Prw = (bf16*)(ws + WS_PRW);
    bf16* Ogdn = (bf16*)(ws + WS_OGDN); bf16* Omla = (bf16*)(ws + WS_OMLA); bf16* Y = (bf16*)(ws + WS_Y);
    unsigned char* Rs = ws + WS_RS; unsigned char* Rd = ws + WS_RD; bf16* xb = (bf16*)(ws + WS_XB);
    bf16* Q = (bf16*)(ws + WS_Q); bf16* Kb = (bf16*)(ws + WS_K); bf16* Vt = (bf16*)(ws + WS_VT); bf16* mix = (bf16*)(ws + WS_MIX);

    for (int l = 0; l < 2; ++l) {
        const float* W = w_in + (size_t)l * D * NIN; bf16* WT = WinT + (size_t)l * NP * D; const float* g = norm_g + l * D;
        transpose(stream, W, D, NIN, 0, 2176, 2176, WT, g);
        transpose(stream, W, D, NIN, 2200, 1248, 1248, WT + (size_t)2176 * D, g);
        transpose(stream, W, D, NIN, 2176, 24, NP - 3424, WT + (size_t)3424 * D, g);
        transpose(stream, w_out + (size_t)l * D * D, D, D, 0, D, D, WoutT + (size_t)l * D * D, nullptr);
        transpose(stream, w_uq + (size_t)l * 192 * 576, 192, 576, 0, 576, 576, WuqT + (size_t)l * 576 * 192, q_norm_g + l * 192);
        transpose(stream, w_ukv + (size_t)l * 128 * 768, 128, 768, 0, 768, 768, WukvT + (size_t)l * 768 * 128, kv_norm_g + l * 128);
    }
    for (int l = 0; l < 2; ++l) {
        const float* xin = l == 0 ? x : out;
        hipLaunchKernelGGL(nk_xprep, dim3(M / 4), dim3(256), 0, stream, xin, xb, rowss);
        hipLaunchKernelGGL(nk_inproj, dim3((NIN + 15) / 16, M / 16), dim3(256), 0, stream, xb, WinT + (size_t)l * NP * D, rowss, Pgate, Pgdn, Pmla, Prw, Psm);
        hipLaunchKernelGGL(nk_mla_prep, dim3(M), dim3(64), 0, stream, Pmla, WuqT + (size_t)l * 576 * 192, WukvT + (size_t)l * 768 * 128, positions, Q, Kb, Vt);
        hipLaunchKernelGGL(nk_rwkv_prep, dim3(M), dim3(256), 0, stream, Prw, mu + l * 2 * 896, w0 + l * 512, w2 + (size_t)l * 2 * 64 * 256, a0 + l * 512, a2 + (size_t)l * 2 * 64 * 256,
                           k_k + l * 256, k_a + l * 256, r_k + l * 256, Rs, Rd, cb);
        hipLaunchKernelGGL(nk_attn, dim3(SEQ / 128, BATCH * 6), dim3(128), 0, stream, Q, Kb, Vt, Omla);
        for (int dir = 0; dir < 2; ++dir) {
            hipLaunchKernelGGL(nk_gdn, dim3(BATCH * 6), dim3(64), 0, stream, Pgdn, Psm, gdn_conv + (size_t)l * 5 * 1152, gdn_a_log + l * 12, gdn_dt_bias + l * 12, Ogdn, dir);
            hipLaunchKernelGGL(nk_rwkv, dim3(BATCH * 4), dim3(64), 0, stream, Rs, Rd, Y, dir);
        }
        hipLaunchKernelGGL(nk_mix, dim3(M), dim3(1024), 0, stream, Ogdn, Omla, Y, Pgate, Rs, cb, gdn_norm_g + l * 64, ln_g + l * 256, ln_b + l * 256, mix);
        hipLaunchKernelGGL(nk_outproj, dim3(D / 16, M / 16), dim3(256), 0, stream, mix, WoutT + (size_t)l * D * D, xin, out);
    }
    hipLaunchKernelGGL(nk_final, dim3(M / 4), dim3(256), 0, stream, out, final_g);
}
```

```cpp
#include <hip/hip_runtime.h>
#include <cstdio>
#include <cstdint>
#include <hip/hip_fp16.h>
namespace pg8 {
#define PG8_LAS __attribute__((address_space(3)))
typedef unsigned short bf16_t;
typedef short bf16x8 __attribute__((ext_vector_type(8)));
typedef float f32x4 __attribute__((ext_vector_type(4)));
typedef unsigned u32x4 __attribute__((ext_vector_type(4)));
constexpr int BM = 256, BK = 64, HALF = 128, HTB = HALF * BK * 2  , STAGE_BYTES = 8 * HTB, NXCD = 8, WGM = 8;

__host__ __device__ __forceinline__ int lds_byte(int r, int c) { const int st = (r >> 4) * 2 + (c >> 5), rr = r & 15, cc = c & 31, ob = rr * 64 + cc * 2; return st * 1024 + (ob ^ (((ob >> 9) & 1) << 5)); }
__host__ __device__ __forceinline__ void stage_rc(int b, int& R, int& C) { const int st = b / 1024, sb = b % 1024, swz = sb ^ (((sb >> 9) & 1) << 5); R = (st >> 1) * 16 + swz / 64; C = (st & 1) * 32 + (swz % 64) / 2; }
__host__ __device__ __forceinline__ int perm32(int rho) { const int n = rho >> 4, i = rho & 15; return 8 * (i >> 2) + 4 * n + (i & 3); }

struct Unit { int pm, pn; };
struct Gemm { const bf16_t* A; const bf16_t* Bt; int M, N, K; };

struct StaticOrder {
    int nM, nN, nwg, G, c;
    __host__ __device__ void init(int M, int N, int G_, int c_) { nM = M / BM; nN = N / BM; nwg = nM * nN; G = G_; c = c_; }
    __host__ __device__ bool next(int i, Unit& u) const {
        const long L = (long)i * G + c; if (L >= nwg) return false;
        int wgid = (int)L; { const int q = nwg / NXCD, r = nwg % NXCD, xcd = wgid % NXCD, off = wgid / NXCD; wgid = (xcd < r ? xcd * (q + 1) : r * (q + 1) + (xcd - r) * q) + off; }
        const int nig = WGM * nN, gid = wgid / nig, fm = gid * WGM, gsz = (nM - fm) < WGM ? (nM - fm) : WGM;
        u.pm = fm + ((wgid % nig) % gsz); u.pn = (wgid % nig) / gsz; return true;
    }
    __device__ __forceinline__ void a_ready(const Unit&) const {}
    __device__ __forceinline__ void done(const Unit&) const {}
};

__device__ __forceinline__ unsigned cvt_pk_bf16(float lo, float hi) { unsigned r; asm volatile("v_cvt_pk_bf16_f32 %0, %1, %2" : "=v"(r) : "v"(lo), "v"(hi)); return r; }
typedef float f32x2 __attribute__((ext_vector_type(2)));
constexpr int TIDTAB_OFF = 131072 + 320 + 512;
__device__ __forceinline__ unsigned hw_slot() { return (unsigned)__builtin_amdgcn_s_getreg((5 << 11) | 4) & 63u; }
__device__ __forceinline__ int mk_tid(PG8_LAS unsigned char* lds_base) {
    const unsigned lane = __builtin_amdgcn_mbcnt_hi(~0u, __builtin_amdgcn_mbcnt_lo(~0u, 0u));
    const unsigned w = __builtin_amdgcn_readfirstlane(((volatile PG8_LAS unsigned*)(lds_base + TIDTAB_OFF))[hw_slot()]);
    return (int)(w * 64u + lane);
}
struct EpiRoute {
    static constexpr bool PERM = true, AFTER_DRAIN = false;
    unsigned char* ws;
    __device__ __forceinline__ void operator()(const f32x4 (&acc)[2][2][4][2], const Unit& u, int wr, int wc, int fr, int fq) const {
        const int row0 = u.pm * BM + wr * 64 + fr;
        const float* rowss = (const float*)(ws + (1u << 20)); float* Psm = (float*)(ws + (22u << 20));
        unsigned base[2]; int ld[2], cc[2], kind[2];
#pragma unroll
        for (int bj = 0; bj < 2; ++bj) {
            const int cg = u.pn * BM + bj * HALF + wc * 32, col = cg + 8 * fq;
            if (cg < 1024) { base[bj] = 25u << 20; ld[bj] = 1024; cc[bj] = col; kind[bj] = 0; }
            else if (cg < 2176) { base[bj] = 57u << 20; ld[bj] = 1152; cc[bj] = col - 1024; kind[bj] = 0; }
            else if (cg < 2528) { base[bj] = 93u << 20; ld[bj] = 352; cc[bj] = col - 2176; kind[bj] = 0; }
            else if (cg < 3424) { base[bj] = 104u << 20; ld[bj] = 896; cc[bj] = col - 2528; kind[bj] = 0; }
            else if (cg < 3456) { base[bj] = 0u; ld[bj] = 32; cc[bj] = col - 3424; kind[bj] = 1; }
            else { base[bj] = 0u; ld[bj] = 0; cc[bj] = 0; kind[bj] = 2; }
        }
#pragma unroll
        for (int ai = 0; ai < 2; ++ai)
#pragma unroll
            for (int m = 0; m < 4; ++m) {
                const int row = row0 + ai * HALF + m * 16;
                const f32x4* rp = (const f32x4*)(rowss + (size_t)row * 16);
                const f32x4 s0 = rp[0], s1 = rp[1], s2 = rp[2], s3 = rp[3];
                const float ss = ((s0[0] + s0[1]) + (s0[2] + s0[3])) + ((s1[0] + s1[1]) + (s1[2] + s1[3])) + ((s2[0] + s2[1]) + (s2[2] + s2[3])) + ((s3[0] + s3[1]) + (s3[2] + s3[3]));
                const float rstd = __builtin_amdgcn_rsqf(ss * (1.0f / 1024.0f) + 1e-6f);
#pragma unroll
                for (int bj = 0; bj < 2; ++bj) {
                    const f32x4 v0 = acc[ai][bj][m][0] * rstd, v1 = acc[ai][bj][m][1] * rstd;
                    if (kind[bj] == 0) { u32x4 w; w.x = cvt_pk_bf16(v0[0], v0[1]); w.y = cvt_pk_bf16(v0[2], v0[3]); w.z = cvt_pk_bf16(v1[0], v1[1]); w.w = cvt_pk_bf16(v1[2], v1[3]);
                        *(u32x4*)((bf16_t*)(ws + base[bj]) + (size_t)row * ld[bj] + cc[bj]) = w; }
                    else if (kind[bj] == 1) { float* p = Psm + (size_t)row * 32 + cc[bj]; *(f32x4*)p = v0; *(f32x4*)(p + 4) = v1; }
                }
                asm volatile("" ::: "memory");
            }
    }
};
struct EpiOut {
    static constexpr bool PERM = false, AFTER_DRAIN = false;
    const float* xin; float* xout; unsigned char* ws;
    __device__ __forceinline__ void operator()(const f32x4 (&acc)[2][2][4][2], const Unit& u, int wr, int wc, int fr, int fq) const {
        typedef unsigned u32x2v __attribute__((ext_vector_type(2)));
        const int row0 = u.pm * BM + wr * 64 + fr, col0 = u.pn * BM + wc * 32 + 4 * fq;
        float* rowss = (float*)(ws + (1u << 20)); bf16_t* xb = (bf16_t*)(ws + (133u << 20));
#pragma unroll
        for (int ai = 0; ai < 2; ++ai)
#pragma unroll
            for (int m = 0; m < 4; ++m) {
                const int row = row0 + ai * HALF + m * 16; float ss = 0.f;
#pragma unroll
                for (int bj = 0; bj < 2; ++bj)
#pragma unroll
                    for (int n = 0; n < 2; ++n) {
                        const size_t off = (size_t)row * 1024 + col0 + bj * HALF + n * 16;
                        const f32x4 o = *(const f32x4*)(xin + off) + acc[ai][bj][m][n];
                        *(f32x4*)(xout + off) = o;
                        u32x2v w; w.x = cvt_pk_bf16(o[0], o[1]); w.y = cvt_pk_bf16(o[2], o[3]); *(u32x2v*)(xb + off) = w;
                        ss += (o[0] * o[0] + o[1] * o[1]) + (o[2] * o[2] + o[3] * o[3]);
                    }
                ss += __shfl_xor(ss, 16); ss += __shfl_xor(ss, 32);
                if (fq == 0) rowss[(size_t)row * 16 + u.pn * 4 + wc] = ss;
                asm volatile("" ::: "memory");
            }
    }
};
template <class Epi, class Sched, bool ALIGN_EPI = false, bool SP2 = false>
__device__ __forceinline__ void gemm_phase(PG8_LAS unsigned char* lds, const Gemm g, const Sched& S, const Epi& E) {
    const int tid_ = mk_tid(lds);
    const int tid = tid_, wid = __builtin_amdgcn_readfirstlane(tid >> 6), lane = tid & 63, wr = wid >> 2, wc = wid & 3, fr = lane & 15, fq = lane >> 4;
    const int K = g.K, nt = K / BK;
    unsigned voffA[2], voffB[2];
#pragma unroll
    for (int i = 0; i < 2; ++i) { int R, C; stage_rc(tid * 16 + i * 8192, R, C); const int Rb = Epi::PERM ? ((R & ~31) + perm32(R & 31)) : R;
        voffA[i] = (unsigned)(R * K + C) * 2u; voffB[i] = (unsigned)(Rb * K + C) * 2u; }
    const size_t kstep = (size_t)(BK * 2);
    const size_t hstep = (size_t)HALF * K * 2;
    const size_t tstep = 2 * hstep;
    const unsigned ldsw = (unsigned)wid * 1024u;
    const int aoff = lds_byte(wr * 64 + fr, fq * 8), boff = lds_byte(wc * 32 + fr, fq * 8);
#define PG8_SA(b, h) (((b) * 2 + (h)) * HTB)
#define PG8_SB(b, h) ((4 + (b) * 2 + (h)) * HTB)
#define PG8_STAGE(bufoff, gbase, voff) do { _Pragma("unroll") for (int _i = 0; _i < 2; ++_i) \
        __builtin_amdgcn_global_load_lds((const unsigned*)((const char*)(gbase) + (voff)[_i]), (PG8_LAS unsigned*)(lds + (bufoff) + ldsw + _i * 8192), 16, 0, 0); } while (0)
#define PG8_LDA(dst, b, h) do { _Pragma("unroll") for (int m = 0; m < 4; ++m) _Pragma("unroll") for (int k = 0; k < 2; ++k) dst[m][k] = *(const PG8_LAS bf16x8*)(lds + PG8_SA(b, h) + aoff + m * 2048 + k * 1024); } while (0)
#define PG8_LDB(dst, b, h) do { _Pragma("unroll") for (int n = 0; n < 2; ++n) _Pragma("unroll") for (int k = 0; k < 2; ++k) dst[n][k] = *(const PG8_LAS bf16x8*)(lds + PG8_SB(b, h) + boff + n * 2048 + k * 1024); } while (0)
#define PG8_MMA(ai, bj, At, Bt) do { __builtin_amdgcn_s_setprio(1); _Pragma("unroll") for (int m = 0; m < 4; ++m) _Pragma("unroll") for (int n = 0; n < 2; ++n) _Pragma("unroll") for (int k = 0; k < 2; ++k) \
        acc[ai][bj][m][n] = __builtin_amdgcn_mfma_f32_16x16x32_bf16(Bt[n][k], At[m][k], acc[ai][bj][m][n], 0, 0, 0); __builtin_amdgcn_s_setprio(0); } while (0)
#define PG8_WAIT_V(n) asm volatile("s_waitcnt vmcnt(" #n ")" ::: "memory")
#define PG8_WAIT_L(n) asm volatile("s_waitcnt lgkmcnt(" #n ")" ::: "memory")
#define PG8_BAR __builtin_amdgcn_s_barrier()
#define PG8_SCHED __builtin_amdgcn_sched_barrier(0)
    Unit cur, nxt; int ui = 0;
    if (!S.next(0, cur)) return;
    f32x4 acc[2][2][4][2];
#pragma unroll
    for (int a = 0; a < 2; ++a)
#pragma unroll
        for (int b = 0; b < 2; ++b)
#pragma unroll
            for (int m = 0; m < 4; ++m)
#pragma unroll
                for (int n = 0; n < 2; ++n) acc[a][b][m][n] = (f32x4){0.f, 0.f, 0.f, 0.f};
    bf16x8 At[4][2], B0[2][2], B1[2][2];
    const char* cA = (const char*)g.A + (size_t)cur.pm * tstep; const char* cB = (const char*)g.Bt + (size_t)cur.pn * tstep;
    S.a_ready(cur);
    if constexpr (SP2) {
        PG8_STAGE(PG8_SB(0, 0), cB, voffB); PG8_STAGE(PG8_SB(0, 1), cB + hstep, voffB); PG8_STAGE(PG8_SA(0, 0), cA, voffA); PG8_STAGE(PG8_SA(0, 1), cA + hstep, voffA);
        if (wr == 1) PG8_BAR;
        PG8_WAIT_V(2); PG8_BAR;
        PG8_STAGE(PG8_SB(1, 0), cB + kstep, voffB); PG8_STAGE(PG8_SA(1, 0), cA + kstep, voffA); PG8_STAGE(PG8_SB(1, 1), cB + hstep + kstep, voffB);
        PG8_WAIT_V(6); PG8_BAR;
    } else {
        PG8_STAGE(PG8_SB(0, 0), cB, voffB); PG8_STAGE(PG8_SA(0, 0), cA, voffA); PG8_STAGE(PG8_SB(0, 1), cB + hstep, voffB); PG8_STAGE(PG8_SA(0, 1), cA + hstep, voffA);
        if (wr == 1) PG8_BAR;
        PG8_WAIT_V(4); PG8_BAR;
        PG8_STAGE(PG8_SB(1, 0), cB + kstep, voffB); PG8_STAGE(PG8_SA(1, 0), cA + kstep, voffA); PG8_STAGE(PG8_SB(1, 1), cB + hstep + kstep, voffB);
        PG8_WAIT_V(6); PG8_BAR;
    }
    for (;;) {
        const bool has_next = S.next(ui + 1, nxt);
        const char* nA = has_next ? (const char*)g.A + (size_t)nxt.pm * tstep : cA; const char* nB = has_next ? (const char*)g.Bt + (size_t)nxt.pn * tstep : cB;
        for (int t = 0; t < nt; t += 2) {
            const bool last = (t == nt - 2);
            const char* a1 = cA + (size_t)(t + 1) * kstep;
            const char* a2 = last ? nA : cA + (size_t)(t + 2) * kstep; const char* b2 = last ? nB : cB + (size_t)(t + 2) * kstep;
            const char* a3 = a2 + kstep; const char* b3 = b2 + kstep;
            if (last && has_next) S.a_ready(nxt);
            if constexpr (SP2) {
            PG8_LDB(B0, 0, 0); PG8_LDB(B1, 0, 1); PG8_SCHED; PG8_LDA(At, 0, 0); PG8_STAGE(PG8_SA(1, 1), a1 + hstep, voffA);
            PG8_WAIT_V(8); PG8_WAIT_L(0); PG8_BAR; PG8_MMA(0, 0, At, B0); PG8_MMA(0, 1, At, B1); PG8_BAR; PG8_SCHED;
            PG8_LDA(At, 0, 1); PG8_STAGE(PG8_SB(0, 0), b2, voffB); PG8_STAGE(PG8_SB(0, 1), b2 + hstep, voffB); PG8_STAGE(PG8_SA(0, 0), a2, voffA);
            PG8_WAIT_V(8); PG8_WAIT_L(0); PG8_BAR; PG8_MMA(1, 0, At, B0); PG8_MMA(1, 1, At, B1); PG8_BAR; PG8_SCHED;
            PG8_LDB(B0, 1, 0); PG8_LDB(B1, 1, 1); PG8_SCHED; PG8_LDA(At, 1, 0); PG8_STAGE(PG8_SA(0, 1), a2 + hstep, voffA);
            PG8_WAIT_V(8); PG8_WAIT_L(0); PG8_BAR; PG8_MMA(0, 0, At, B0); PG8_MMA(0, 1, At, B1); PG8_BAR; PG8_SCHED;
            PG8_LDA(At, 1, 1); PG8_STAGE(PG8_SB(1, 0), b3, voffB); PG8_STAGE(PG8_SB(1, 1), b3 + hstep, voffB); PG8_STAGE(PG8_SA(1, 0), a3, voffA);
            PG8_WAIT_V(8); PG8_WAIT_L(0); PG8_BAR; PG8_MMA(1, 0, At, B0); PG8_MMA(1, 1, At, B1); PG8_BAR; PG8_SCHED;
            } else {
            PG8_LDB(B0, 0, 0); PG8_SCHED; PG8_LDA(At, 0, 0); PG8_STAGE(PG8_SA(1, 1), a1 + hstep, voffA);
            PG8_WAIT_L(8); PG8_BAR; PG8_WAIT_L(0); PG8_MMA(0, 0, At, B0); PG8_BAR; PG8_SCHED;
            PG8_LDB(B1, 0, 1); PG8_STAGE(PG8_SB(0, 0), b2, voffB);
            PG8_BAR; PG8_WAIT_L(0); PG8_MMA(0, 1, At, B1); PG8_BAR;
            PG8_LDA(At, 0, 1); PG8_STAGE(PG8_SA(0, 0), a2, voffA);
            PG8_BAR; PG8_WAIT_L(0); PG8_MMA(1, 0, At, B0); PG8_BAR; PG8_SCHED;
            PG8_STAGE(PG8_SB(0, 1), b2 + hstep, voffB);
            PG8_WAIT_V(6); PG8_BAR; PG8_MMA(1, 1, At, B1); PG8_BAR;
            PG8_LDB(B0, 1, 0); PG8_SCHED; PG8_LDA(At, 1, 0); PG8_STAGE(PG8_SA(0, 1), a2 + hstep, voffA);
            PG8_WAIT_L(8); PG8_BAR; PG8_WAIT_L(0); PG8_MMA(0, 0, At, B0); PG8_BAR; PG8_SCHED;
            PG8_LDB(B1, 1, 1); PG8_STAGE(PG8_SB(1, 0), b3, voffB);
            PG8_BAR; PG8_WAIT_L(0); PG8_MMA(0, 1, At, B1); PG8_BAR;
            PG8_LDA(At, 1, 1); PG8_STAGE(PG8_SA(1, 0), a3, voffA);
            PG8_BAR; PG8_WAIT_L(0); PG8_MMA(1, 0, At, B0); PG8_BAR; PG8_SCHED;
            PG8_STAGE(PG8_SB(1, 1), b3 + hstep, voffB);
            PG8_WAIT_V(6); PG8_BAR; PG8_MMA(1, 1, At, B1); PG8_BAR;
            }
        }
        if constexpr (ALIGN_EPI) { if (wr == 0) PG8_BAR; }
        if constexpr (!Epi::AFTER_DRAIN) { E(acc, cur, wr, wc, fr, fq); S.done(cur); }
        if (!has_next) break;
#pragma unroll
        for (int a = 0; a < 2; ++a)
#pragma unroll
            for (int b = 0; b < 2; ++b)
#pragma unroll
                for (int m = 0; m < 4; ++m)
#pragma unroll
                    for (int n = 0; n < 2; ++n) acc[a][b][m][n] = (f32x4){0.f, 0.f, 0.f, 0.f};
        cur = nxt; cA = nA; cB = nB; ++ui;
        if constexpr (ALIGN_EPI) { if (wr == 1) PG8_BAR; }
    }
    PG8_WAIT_V(0);
    if constexpr (!ALIGN_EPI) { if (wr == 0) PG8_BAR; }
    PG8_BAR;
    if constexpr (Epi::AFTER_DRAIN) { E.fused(acc, cur, wr, wc, fr, fq, lds, wid, lane); S.done(cur); }
#undef PG8_SA
#undef PG8_SB
#undef PG8_STAGE
#undef PG8_LDA
#undef PG8_LDB
#undef PG8_MMA
#undef PG8_WAIT_V
#undef PG8_WAIT_L
#undef PG8_BAR
#undef PG8_SCHED
}
}
#define GAS __attribute__((address_space(1)))
#define LAS __attribute__((address_space(3)))
typedef unsigned short bf16;
typedef unsigned v4u __attribute__((ext_vector_type(4)));
typedef float f32x4 __attribute__((ext_vector_type(4)));
typedef short bf16x8 __attribute__((ext_vector_type(8)));
typedef GAS unsigned gu32;
typedef GAS unsigned long long gu64;
#define RLX_AGENT __ATOMIC_RELAXED, __HIP_MEMORY_SCOPE_AGENT
#define LDS_WAIT() asm volatile("s_waitcnt lgkmcnt(0)" ::: "memory")
#define VM_WAIT() asm volatile("s_waitcnt vmcnt(0)" ::: "memory")
__device__ __forceinline__ unsigned long long rt() { return __builtin_amdgcn_s_memrealtime(); }
__device__ __forceinline__ unsigned f2bf(float f) { unsigned u = __builtin_bit_cast(unsigned, f); return (u + 0x7fffu + ((u >> 16) & 1u)) >> 16; }
__device__ __forceinline__ unsigned pk2(float lo, float hi) { return f2bf(lo) | (f2bf(hi) << 16); }

#define XB_TMO      128
#define XB_XCNT(j)  (256  + 64 * (j))
#define XB_XSUB(j)  (1280 + 64 * (j))
#define XB_XGEN(j)  (2304 + 64 * (j))
#define XB_TOP      3328
#define XB_TOPGEN   3392
#define XCD_BAR_WORDS 3456
#define XB_SPIN_CAP (1u << 18)

__device__ __forceinline__ unsigned xb_ld(unsigned* p)              { return __hip_atomic_load(p, __ATOMIC_RELAXED, __HIP_MEMORY_SCOPE_AGENT); }
__device__ __forceinline__ unsigned xb_add(unsigned* p, unsigned v) { return __hip_atomic_fetch_add(p, v, __ATOMIC_RELAXED, __HIP_MEMORY_SCOPE_AGENT); }
__device__ __forceinline__ unsigned xb_xcc_id() { return (unsigned)__builtin_amdgcn_s_getreg((3 << 11) | 20) & 0xFu; }
#define XB_SPIN(cond, bar) do { unsigned _sp = 0; while (cond) { __builtin_amdgcn_s_sleep(1); \
    if ((++_sp & 255u) == 0u) { if (xb_ld(&(bar)[XB_TMO])) break; if (_sp > XB_SPIN_CAP) { atomicAdd(&(bar)[XB_TMO], 1u); break; } } } } while (0)

struct XcdBarrier {
    unsigned* bar; unsigned x;
    volatile LAS unsigned* st;
};

__device__ __forceinline__ XcdBarrier xcd_barrier_post(unsigned* bar, volatile LAS unsigned* st) {
    XcdBarrier b; b.bar = bar; b.x = xb_xcc_id(); b.st = st;
    if (threadIdx.x == 0) (void)xb_add(&bar[XB_XCNT(b.x)], 1u);
    return b;
}
__device__ __forceinline__ void xcd_barrier_complete(unsigned* bar, unsigned x, unsigned& nloc, unsigned& nx) {
    const unsigned G = gridDim.x * gridDim.y * gridDim.z;
    unsigned sum, cnt, mine, sp = 0u;
    for (;;) {
        sum = 0u; cnt = 0u; mine = 0u;
#pragma unroll
        for (unsigned j = 0; j < 16; ++j) { const unsigned c = xb_ld(&bar[XB_XCNT(j)]); sum += c; cnt += (c > 0u) ? 1u : 0u; mine = (j == x) ? c : mine; }
        if (sum == G) break;
        __builtin_amdgcn_s_sleep(1);
        if ((++sp & 255u) == 0u) { if (xb_ld(&bar[XB_TMO])) break; if (sp > XB_SPIN_CAP) { atomicAdd(&bar[XB_TMO], 1u); break; } }
    }
    nloc = mine > 0u ? mine : 1u; nx = cnt > 0u ? cnt : 1u;
}

__device__ __forceinline__ void xcd_barrier(const XcdBarrier& b) {
    asm volatile("s_waitcnt vmcnt(0)" ::: "memory");
    __syncthreads();
    if (pg8::mk_tid((LAS unsigned char*)b.st - (131072 + 320 + 32)) == 0) {
        unsigned* bar = b.bar;
        __builtin_amdgcn_s_waitcnt(0);
        unsigned nloc = b.st[0], nx = b.st[1];
        if (nloc == 0u) { xcd_barrier_complete(bar, b.x, nloc, nx); b.st[0] = nloc; b.st[1] = nx; }
        const unsigned old = xb_add(&bar[XB_XSUB(b.x)], 1u);
        const unsigned gen = old / nloc;
        if (old + 1u == (gen + 1u) * nloc) {
            __builtin_amdgcn_fence(__ATOMIC_RELEASE, "agent");
            asm volatile("s_waitcnt vmcnt(0)" ::: "memory");
            const unsigned og = xb_add(&bar[XB_TOP], 1u);
            const unsigned tg = og / nx;
            if (og + 1u == (tg + 1u) * nx) xb_add(&bar[XB_TOPGEN], 1u);
            else XB_SPIN(xb_ld(&bar[XB_TOPGEN]) == tg, bar);
            __builtin_amdgcn_fence(__ATOMIC_ACQUIRE, "agent");
            xb_add(&bar[XB_XGEN(b.x)], 1u);
            asm volatile("s_waitcnt vmcnt(0)" ::: "memory");
        } else {
            XB_SPIN(xb_ld(&bar[XB_XGEN(b.x)]) == gen, bar);
            __builtin_amdgcn_fence(__ATOMIC_ACQUIRE, "agent");
            asm volatile("s_waitcnt vmcnt(0)" ::: "memory");
        }
    }
    __syncthreads();
}
constexpr int BATCH = 8, SEQ = 2048, M = BATCH * SEQ, D = 1024, NIN = 3448, NP = 3584;
constexpr float NORM_EPS = 1e-6f;
constexpr float LOG2E = 1.4426950408889634f;
constexpr size_t MiB = 1u << 20;
constexpr size_t WS_CTL = 0, CTL_ZERO_BYTES = 1 * MiB;
constexpr size_t WS_ROWSS = 1 * MiB;
constexpr size_t WS_WIN = 2 * MiB;
constexpr size_t WS_WOUT = 16 * MiB;
constexpr size_t WS_WSMALL = 20 * MiB;
constexpr size_t OFF_WUQ = 0, OFF_WUKV = 2 * 576 * 192 * 2, OFF_W2T = OFF_WUKV + 2 * 768 * 128 * 2, OFF_A2T = OFF_W2T + 2 * 2 * 256 * 64 * 2;
constexpr size_t WS_PSM = 22 * MiB;
constexpr size_t WS_CB = 24 * MiB;
constexpr size_t WS_PGATE = 25 * MiB;
constexpr size_t WS_PGDN = 57 * MiB;
constexpr size_t WS_PMLA = 93 * MiB;
constexpr size_t WS_PRW = 104 * MiB;
constexpr size_t WS_OGDN = 93 * MiB;
constexpr size_t WS_OMLA = 105 * MiB;
constexpr size_t WS_Y = 117 * MiB;
constexpr size_t WS_RS = 133 * MiB;
constexpr size_t WS_RD = 157 * MiB;
constexpr size_t WS_XB = 133 * MiB;
constexpr size_t WS_Q = 207 * MiB;
constexpr size_t WS_K = 225 * MiB;
constexpr size_t WS_VT = 243 * MiB;
constexpr size_t WS_MIX = 207 * MiB;
constexpr size_t WS_END = 255 * MiB;
constexpr int RS_REC = 384, RD_REC = 400;
constexpr size_t RD_DIR = (size_t)BATCH * 4 * SEQ * RD_REC;
constexpr int CW_BAR = 4096;
constexpr int CW_QUEUE = 16384;

constexpr int NWAVES = 8;
constexpr int RING_OFF = 0, RING_BYTES = 131072, LDSCTL_OFF = RING_BYTES, MISC_OFF = LDSCTL_OFF + 320, LDS_BYTES = 147456;
static_assert(pg8::TIDTAB_OFF == MISC_OFF + 512 && RING_OFF == 0, "LDS map");
constexpr int NPHASE = 12;

__device__ __forceinline__ float bf2f(bf16 v) { return __uint_as_float(((unsigned)v) << 16); }
__device__ __forceinline__ float wave_sum(float v) {
#pragma unroll
    for (int o = 1; o < 64; o <<= 1) v += __shfl_xor(v, o);
    return v;
}
__device__ __forceinline__ float siluf(float x) { return x / (1.f + __expf(-x)); }
__device__ __forceinline__ float sigmoidf_(float x) { return 1.f / (1.f + __expf(-x)); }
__device__ __forceinline__ float softplusf_(float x) { return x > 20.f ? x : log1pf(__expf(x)); }

struct Args { const void* in[24]; float* out; unsigned char* ws; int ph_lo, ph_hi; };

struct Frame {
    LAS unsigned char* lds;
    volatile LAS unsigned* MISC;
    gu32* ctl;
    int tid, lane, wave, vcu, G;
    unsigned char* ws;
    float* out;
    LAS const unsigned long long* ptab;
};
__device__ __forceinline__ const void* inptr(const Frame& F, int k) {
    const unsigned long long v = F.ptab[k];
    const unsigned lo = __builtin_amdgcn_readfirstlane((unsigned)v), hi = __builtin_amdgcn_readfirstlane((unsigned)(v >> 32));
    return (const void*)(((unsigned long long)hi << 32) | lo);
}

__device__ __forceinline__ void tr_item(const float* W, int K, int ldsrc, int scol, int nvalid, bf16* WT, const float* gs, LAS float* scr, int kb, int lane) {
    const int k0 = 64 * kb;
#pragma unroll 8
    for (int i = 0; i < 32; ++i) { const int kk = 2 * i + (lane >> 5), n = lane & 31; float v = 0.f;
        if (n < nvalid) { v = W[(size_t)(k0 + kk) * ldsrc + scol + n]; if (gs) v *= gs[k0 + kk]; }
        scr[kk * 33 + n] = v; }
    LDS_WAIT(); asm volatile("" ::: "memory");
    const int c = lane & 7;
#pragma unroll
    for (int j = 0; j < 4; ++j) { const int n = (lane >> 3) + 8 * j; const LAS float* s = scr + (8 * c) * 33 + n;
        v4u o; o.x = pk2(s[0 * 33], s[1 * 33]); o.y = pk2(s[2 * 33], s[3 * 33]); o.z = pk2(s[4 * 33], s[5 * 33]); o.w = pk2(s[6 * 33], s[7 * 33]);
        *(GAS v4u*)(WT + (size_t)n * K + k0 + 8 * c) = o; }
    LDS_WAIT(); asm volatile("" ::: "memory");
}
__device__ __forceinline__ void p0_prologue(Frame& F) {
    LAS float* scr = (LAS float*)(F.lds + RING_OFF + F.wave * 16384);
    const int gw = F.vcu * NWAVES + F.wave, NGW = F.G * NWAVES;
    constexpr int I_IN = 112 * 16, I_OUT = 32 * 16, I_UQ = 18 * 3, I_UKV = 24 * 2, I_W2 = 16, I_A2 = 16, I_L = I_IN + I_OUT + I_UQ + I_UKV + I_W2 + I_A2;
    for (int it = gw; it < 2 * I_L; it += NGW) {
        const int l = it / I_L; int r = it % I_L;
        if (r < I_IN) { const int nb = r >> 4, kb = r & 15, n0 = 32 * nb; int scol, nv;
            if (n0 < 2176) { scol = n0; nv = 32; } else if (n0 < 3424) { scol = n0 + 24; nv = 32; } else if (n0 == 3424) { scol = 2176; nv = 24; } else { scol = 0; nv = 0; }
            tr_item((const float*)inptr(F, 3) + (size_t)l * D * NIN, D, NIN, scol, nv, (bf16*)(F.ws + WS_WIN) + ((size_t)l * NP + n0) * D, (const float*)inptr(F, 2) + l * D, scr, kb, F.lane); continue; }
        r -= I_IN;
        if (r < I_OUT) { const int nb = r >> 4, kb = r & 15;
            tr_item((const float*)inptr(F, 22) + (size_t)l * D * D, D, D, 32 * nb, 32, (bf16*)(F.ws + WS_WOUT) + ((size_t)l * D + 32 * nb) * D, nullptr, scr, kb, F.lane); continue; }
        r -= I_OUT;
        if (r < I_UQ) { const int nb = r / 3, kb = r % 3;
            tr_item((const float*)inptr(F, 9) + (size_t)l * 192 * 576, 192, 576, 32 * nb, 32, (bf16*)(F.ws + WS_WSMALL + OFF_WUQ) + ((size_t)l * 576 + 32 * nb) * 192, (const float*)inptr(F, 8) + l * 192, scr, kb, F.lane); continue; }
        r -= I_UQ;
        if (r < I_UKV) { const int nb = r >> 1, kb = r & 1;
            tr_item((const float*)inptr(F, 11) + (size_t)l * 128 * 768, 128, 768, 32 * nb, 32, (bf16*)(F.ws + WS_WSMALL + OFF_WUKV) + ((size_t)l * 768 + 32 * nb) * 128, (const float*)inptr(F, 10) + l * 128, scr, kb, F.lane); continue; }
        r -= I_UKV;
        if (r < I_W2) { const int e = r >> 3, nb = r & 7;
            tr_item((const float*)inptr(F, 14) + ((size_t)l * 2 + e) * 64 * 256, 64, 256, 32 * nb, 32, (bf16*)(F.ws + WS_WSMALL + OFF_W2T) + (((size_t)l * 2 + e) * 256 + 32 * nb) * 64, nullptr, scr, 0, F.lane); continue; }
        r -= I_W2;
        { const int e = r >> 3, nb = r & 7;
            tr_item((const float*)inptr(F, 16) + ((size_t)l * 2 + e) * 64 * 256, 64, 256, 32 * nb, 32, (bf16*)(F.ws + WS_WSMALL + OFF_A2T) + (((size_t)l * 2 + e) * 256 + 32 * nb) * 64, nullptr, scr, 0, F.lane); }
    }
    const float* x = (const float*)inptr(F, 0); bf16* xb = (bf16*)(F.ws + WS_XB); float* rowss = (float*)(F.ws + WS_ROWSS);
    for (int m = gw; m < M; m += NGW) {
        const GAS f32x4* xr = (const GAS f32x4*)(x + (size_t)m * D) + F.lane;
        GAS unsigned long long* o8 = (GAS unsigned long long*)(xb + (size_t)m * D) + F.lane; float s = 0.f;
#pragma unroll
        for (int j = 0; j < 4; ++j) { const f32x4 v = xr[64 * j]; s += (v.x * v.x + v.y * v.y) + (v.z * v.z + v.w * v.w);
            o8[64 * j] = (unsigned long long)pk2(v.x, v.y) | ((unsigned long long)pk2(v.z, v.w) << 32); }
        s = wave_sum(s);
        if (F.lane < 16) rowss[(size_t)m * 16 + F.lane] = F.lane == 0 ? s : 0.f;
    }
}
__device__ __forceinline__ void p5_final(Frame& F) {
    const int gw = F.vcu * NWAVES + F.wave, NGW = F.G * NWAVES;
    const float* rowss = (const float*)(F.ws + WS_ROWSS); const float* g = (const float*)inptr(F, 23);
    f32x4 gv[4];
#pragma unroll
    for (int j = 0; j < 4; ++j) gv[j] = ((const f32x4*)g)[F.lane + 64 * j];
    for (int m = gw; m < M; m += NGW) {
        float ss = F.lane < 16 ? rowss[(size_t)m * 16 + F.lane] : 0.f;
        ss = wave_sum(ss);
        const float rstd = rsqrtf(ss * (1.f / D) + NORM_EPS);
        GAS f32x4* xr = (GAS f32x4*)(F.out + (size_t)m * D) + F.lane;
#pragma unroll
        for (int j = 0; j < 4; ++j) { f32x4 v = xr[64 * j]; v = v * rstd * gv[j]; xr[64 * j] = v; }
    }
}
__device__ __forceinline__ float dotbf(const bf16* a, const bf16* b, int K) {
    float acc = 0.f;
#pragma unroll 2
    for (int k = 0; k < K; k += 8) {
        const v4u av = *(const v4u*)(a + k), bv = *(const v4u*)(b + k);
#pragma unroll
        for (int i = 0; i < 4; ++i) {
            acc += __uint_as_float(av[i] << 16) * __uint_as_float(bv[i] << 16);
            acc += __uint_as_float(av[i] & 0xffff0000u) * __uint_as_float(bv[i] & 0xffff0000u);
        }
    }
    return acc;
}
__device__ __forceinline__ void p2_mla_token(Frame& F, int l, int m, LAS float* raw) {
    const bf16* Pmla = (const bf16*)(F.ws + WS_PMLA);
    const bf16* WuqT = (const bf16*)(F.ws + WS_WSMALL + OFF_WUQ) + (size_t)l * 576 * 192;
    const bf16* WukvT = (const bf16*)(F.ws + WS_WSMALL + OFF_WUKV) + (size_t)l * 768 * 128;
    bf16* Q = (bf16*)(F.ws + WS_Q); bf16* Kb = (bf16*)(F.ws + WS_K); bf16* Vt = (bf16*)(F.ws + WS_VT);
    const int lane = F.lane, b = m / SEQ, t = m % SEQ;
    const bf16* p = Pmla + (size_t)m * 352;
    float s1 = 0.f, s2 = 0.f;
    for (int c = lane; c < 192; c += 64) { const float v = bf2f(p[c]); s1 += v * v; }
    for (int c = lane; c < 128; c += 64) { const float v = bf2f(p[192 + c]); s2 += v * v; }
    s1 = wave_sum(s1); s2 = wave_sum(s2);
    const float rq = rsqrtf(s1 * (1.f / 192.f) + NORM_EPS), rkv = rsqrtf(s2 * (1.f / 128.f) + NORM_EPS);
#pragma unroll 1
    for (int c = lane; c < 576; c += 64) raw[c] = dotbf(p, WuqT + (size_t)c * 192, 192) * rq;
#pragma unroll 1
    for (int c = lane; c < 768; c += 64) raw[576 + c] = dotbf(p + 192, WukvT + (size_t)c * 128, 128) * rkv;
    LDS_WAIT(); asm volatile("" ::: "memory");
    const float pos = (float)((const int*)inptr(F, 1))[m];
    const float qs = 0.10206207261596575f * LOG2E;
#pragma unroll 1
    for (int i = lane; i < 6 * 80; i += 64) {
        const int h = i / 80, j = i % 80;
        bf16* qo = Q + (((size_t)b * 6 + h) * SEQ + t) * 96;
        if (j < 64) qo[j] = f2bf(raw[h * 96 + j] * qs);
        else { const int r = j - 64; const float inv = exp2f(-(float)r * (13.287712379549449f / 16.f)); float sn, cs; sincosf(pos * inv, &sn, &cs);
            const float x1 = raw[h * 96 + 64 + r], x2 = raw[h * 96 + 80 + r];
            qo[64 + r] = f2bf((x1 * cs - x2 * sn) * qs); qo[80 + r] = f2bf((x2 * cs + x1 * sn) * qs); }
    }
#pragma unroll 1
    for (int i = lane; i < 6 * 64; i += 64) {
        const int h = i / 64, j = i % 64;
        Kb[(((size_t)b * 6 + h) * SEQ + t) * 96 + j] = f2bf(raw[576 + h * 128 + j]);
        Vt[(((size_t)b * 6 + h) * 64 + j) * SEQ + t] = f2bf(raw[576 + h * 128 + 64 + j]);
    }
    if (lane < 16) {
        const int r = lane; const float inv = exp2f(-(float)r * (13.287712379549449f / 16.f)); float sn, cs; sincosf(pos * inv, &sn, &cs);
        const float x1 = bf2f(p[320 + r]), x2 = bf2f(p[336 + r]);
        const bf16 o1 = f2bf(x1 * cs - x2 * sn), o2 = f2bf(x2 * cs + x1 * sn);
        for (int h = 0; h < 6; ++h) { bf16* ko = Kb + (((size_t)b * 6 + h) * SEQ + t) * 96; ko[64 + r] = o1; ko[80 + r] = o2; }
    }
    LDS_WAIT(); asm volatile("" ::: "memory");
}
__device__ __forceinline__ void p2_rwkv_token(Frame& F, int l, int m, LAS float* f, int c) {
    const bf16* Prw = (const bf16*)(F.ws + WS_PRW);
    const float* mu = (const float*)inptr(F, 12) + l * 2 * 896; const float* w0 = (const float*)inptr(F, 13) + l * 512; const float* w2 = (const float*)inptr(F, 14) + (size_t)l * 2 * 64 * 256;
    const float* a0 = (const float*)inptr(F, 15) + l * 512; const float* a2 = (const float*)inptr(F, 16) + (size_t)l * 2 * 64 * 256;
    const float* k_k = (const float*)inptr(F, 17) + l * 256; const float* k_a = (const float*)inptr(F, 18) + l * 256; const float* r_k = (const float*)inptr(F, 19) + l * 256;
    unsigned char* Rs = F.ws + WS_RS; unsigned char* Rd = F.ws + WS_RD; float* cb = (float*)(F.ws + WS_CB);
    const int b = m / SEQ, t = m % SEQ, h = c >> 6, j = c & 63;
#pragma unroll 1
    for (int i = c; i < 896; i += 256) {
        const float x = bf2f(Prw[(size_t)m * 896 + i]);
        const float xp = t > 0 ? bf2f(Prw[(size_t)(m - 1) * 896 + i]) : 0.f;
        const float xn = t < SEQ - 1 ? bf2f(Prw[(size_t)(m + 1) * 896 + i]) : 0.f;
        float v = x + mu[i] * (xp - x) + mu[896 + i] * (xn - x);
        if (i >= 768 && i < 832) v = tanhf(v);
        f[i] = v;
    }
    __syncthreads();
    const float r = f[c], k = f[256 + c], v = f[512 + c];
    const float kkr = k * k_k[c];
    const float kn = wave_sum(kkr * kkr);
    const float kk = kkr * rsqrtf(kn + 1e-6f);
    float kmod[2], bb[2], lam[2];
#pragma unroll
    for (int e = 0; e < 2; ++e) {
        float lw = 0.f, la = 0.f;
#pragma unroll 8
        for (int d = 0; d < 64; ++d) { lw += f[768 + d] * w2[((size_t)e * 64 + d) * 256 + c]; la += f[832 + d] * a2[((size_t)e * 64 + d) * 256 + c]; }
        const float wl = -softplusf_(-(w0[e * 256 + c] + lw)) - 0.5f;
        lam[e] = __expf(wl);
        const float a = sigmoidf_(a0[e * 256 + c] + la);
        kmod[e] = k * (1.f + (a - 1.f) * k_a[c]);
        bb[e] = a * kk;
    }
    unsigned char* rs = Rs + (((size_t)b * 4 + h) * SEQ + t) * RS_REC;
    ((bf16*)rs)[j] = f2bf(kk); ((bf16*)(rs + 128))[j] = f2bf(v); ((bf16*)(rs + 256))[j] = f2bf(r);
#pragma unroll
    for (int e = 0; e < 2; ++e) {
        unsigned char* rd = Rd + e * RD_DIR + (((size_t)b * 4 + h) * SEQ + t) * RD_REC;
        ((__half*)rd)[j] = __float2half(lam[e]); ((bf16*)(rd + 128))[j] = f2bf(bb[e]); ((bf16*)(rd + 256))[j] = f2bf(kmod[e]);
        const float br = wave_sum(bb[e] * r), kr = wave_sum(kmod[e] * r);
        if (j == 0) { ((float*)(rd + 384))[0] = br; ((float*)(rd + 384))[1] = kr; }
    }
    const float cbv = wave_sum(r * 0.5f * (kmod[0] + kmod[1]) * r_k[c]);
    if (j == 0) cb[(size_t)m * 4 + h] = cbv;
    __syncthreads();
}
__device__ __forceinline__ void p2_prep(Frame& F, int l) {
    { LAS float* f = (LAS float*)(F.lds + RING_OFF) + (F.tid >> 8) * 896; const int c = F.tid & 255;
      for (int m = 2 * (int)blockIdx.x + (F.tid >> 8); m < M; m += 2 * F.G) p2_rwkv_token(F, l, m, f, c); }
    { LAS float* raw = (LAS float*)(F.lds + RING_OFF + 8192) + F.wave * 1344;
      const int gw = F.vcu * NWAVES + F.wave, NGW = F.G * NWAVES;
      for (int m = gw; m < M; m += NGW) p2_mla_token(F, l, m, raw); }
}
__device__ __forceinline__ void p4a_mix(Frame& F, int l) {
    const bf16* Ogdn = (const bf16*)(F.ws + WS_OGDN); const bf16* Omla = (const bf16*)(F.ws + WS_OMLA); const bf16* Y = (const bf16*)(F.ws + WS_Y);
    const bf16* Pgate = (const bf16*)(F.ws + WS_PGATE); const unsigned char* Rs = F.ws + WS_RS; const float* cb = (const float*)(F.ws + WS_CB); bf16* mix = (bf16*)(F.ws + WS_MIX);
    const float* gdn_g = (const float*)inptr(F, 7) + l * 64; const float* ln_g = (const float*)inptr(F, 20) + l * 256; const float* ln_b = (const float*)inptr(F, 21) + l * 256;
    const int gw = F.vcu * NWAVES + F.wave, NGW = F.G * NWAVES, j = F.lane;
    const float gg = gdn_g[j];
    for (int m = gw; m < M; m += NGW) {
        const int b = m / SEQ, t = m % SEQ;
#pragma unroll 2
        for (int g = 0; g < 16; ++g) {
            const int c = g * 64 + j; float val;
            if (g < 6) { const float o = bf2f(Ogdn[(size_t)m * 384 + c]); const float ss = wave_sum(o * o); val = o * rsqrtf(ss * (1.f / 64.f) + NORM_EPS) * gg; }
            else if (g < 12) val = bf2f(Omla[(size_t)m * 384 + (c - 384)]);
            else { const int cc = c - 768, h = g - 12; const float y = bf2f(Y[(size_t)m * 256 + cc]);
                const float mean = wave_sum(y) * (1.f / 64.f); const float dv = y - mean; const float var = wave_sum(dv * dv) * (1.f / 64.f);
                const float v = bf2f(((const bf16*)(Rs + (((size_t)b * 4 + h) * SEQ + t) * RS_REC + 128))[j]);
                val = dv * rsqrtf(var + 64e-5f) * ln_g[cc] + ln_b[cc] + cb[(size_t)m * 4 + h] * v; }
            mix[(size_t)m * 1024 + c] = f2bf(val * siluf(bf2f(Pgate[(size_t)m * 1024 + c])));
        }
    }
}
typedef float f32x16 __attribute__((ext_vector_type(16)));
typedef unsigned long long u64_t;
__device__ __forceinline__ bf16x8 mk_bf16x8(u64_t lo, u64_t hi) { typedef u64_t u64x2 __attribute__((ext_vector_type(2))); u64x2 v = {lo, hi}; return __builtin_bit_cast(bf16x8, v); }

constexpr int AT_KP = 208, AT_VP = 136, AT_KBYTES = 64 * AT_KP, AT_VBYTES = 64 * AT_VP, AT_BUF = AT_KBYTES + AT_VBYTES;
__device__ __forceinline__ void attn_unit(Frame& F, int unit) {
    const int bh = unit >> 3, qb = unit & 7, b = bh / 6, h = bh % 6;
    const int tid = F.tid, lane = F.lane, wave = F.wave, r32 = lane & 31, hi = lane >> 5;
    const bf16* Qg = (const bf16*)(F.ws + WS_Q) + ((size_t)bh * SEQ + qb * 256 + wave * 32 + r32) * 96;
    const bf16* Kg = (const bf16*)(F.ws + WS_K) + (size_t)bh * SEQ * 96;
    const bf16* Vg = (const bf16*)(F.ws + WS_VT) + (size_t)bh * 64 * SEQ;
    LAS unsigned char* lds = F.lds + RING_OFF;
    bf16x8 qf[6];
#pragma unroll
    for (int s = 0; s < 6; ++s) qf[s] = *(const bf16x8*)(Qg + 16 * s + 8 * hi);
    const int kr0 = tid / 12, kc0 = tid % 12, kr1 = (512 + tid) / 12, kc1 = (512 + tid) % 12, vd = tid >> 3, vc = tid & 7;
    const bool has1 = tid < 256;
    v4u kreg0, kreg1 = {0u, 0u, 0u, 0u}, vreg;
#define AT_LOAD(t0) do { kreg0 = *(const v4u*)(Kg + (size_t)((t0) + kr0) * 96 + kc0 * 8); if (has1) kreg1 = *(const v4u*)(Kg + (size_t)((t0) + kr1) * 96 + kc1 * 8); \
        vreg = *(const v4u*)(Vg + (size_t)vd * SEQ + (t0) + vc * 8); } while (0)
#define AT_STORE(buf) do { LAS unsigned char* bb_ = lds + (buf) * AT_BUF; *(LAS v4u*)(bb_ + kr0 * AT_KP + kc0 * 16) = kreg0; if (has1) *(LAS v4u*)(bb_ + kr1 * AT_KP + kc1 * 16) = kreg1; \
        LAS u64_t* vp_ = (LAS u64_t*)(bb_ + AT_KBYTES + vd * AT_VP + vc * 16); vp_[0] = (u64_t)vreg.x | ((u64_t)vreg.y << 32); vp_[1] = (u64_t)vreg.z | ((u64_t)vreg.w << 32); } while (0)
    AT_LOAD(0); AT_STORE(0);
    __syncthreads();
    f32x16 o0 = {}, o1 = {};
    float mrun = -1e30f, lsum = 0.f;
    for (int t = 0; t < SEQ / 64; ++t) {
        if (t + 1 < SEQ / 64) AT_LOAD((t + 1) * 64);
        LAS unsigned char* bb = lds + (t & 1) * AT_BUF;
        f32x16 p0 = {}, p1 = {};
        { const LAS unsigned char* kb = bb + r32 * AT_KP + hi * 16;
#pragma unroll
          for (int s = 0; s < 6; ++s) {
              const bf16x8 a0 = *(const LAS bf16x8*)(kb + 32 * s), a1 = *(const LAS bf16x8*)(kb + 32 * AT_KP + 32 * s);
              p0 = __builtin_amdgcn_mfma_f32_32x32x16_bf16(a0, qf[s], p0, 0, 0, 0);
              p1 = __builtin_amdgcn_mfma_f32_32x32x16_bf16(a1, qf[s], p1, 0, 0, 0); } }
        float mloc = fmaxf(p0[0], p1[0]);
#pragma unroll
        for (int r = 1; r < 16; ++r) mloc = fmaxf(mloc, fmaxf(p0[r], p1[r]));
        mloc = fmaxf(mloc, __shfl_xor(mloc, 32));
        const float mnew = fmaxf(mrun, mloc), alpha = __builtin_amdgcn_exp2f(mrun - mnew);
        mrun = mnew; lsum *= alpha;
#pragma unroll
        for (int r = 0; r < 16; ++r) { o0[r] *= alpha; o1[r] *= alpha; }
        float ps = 0.f;
#pragma unroll
        for (int r = 0; r < 16; ++r) { p0[r] = __builtin_amdgcn_exp2f(p0[r] - mnew); p1[r] = __builtin_amdgcn_exp2f(p1[r] - mnew); ps += p0[r] + p1[r]; }
        lsum += ps;
        v4u pk[4];
#pragma unroll
        for (int s2 = 0; s2 < 2; ++s2) {
            pk[s2] = (v4u){pg8::cvt_pk_bf16(p0[8 * s2], p0[8 * s2 + 1]), pg8::cvt_pk_bf16(p0[8 * s2 + 2], p0[8 * s2 + 3]), pg8::cvt_pk_bf16(p0[8 * s2 + 4], p0[8 * s2 + 5]), pg8::cvt_pk_bf16(p0[8 * s2 + 6], p0[8 * s2 + 7])};
            pk[2 + s2] = (v4u){pg8::cvt_pk_bf16(p1[8 * s2], p1[8 * s2 + 1]), pg8::cvt_pk_bf16(p1[8 * s2 + 2], p1[8 * s2 + 3]), pg8::cvt_pk_bf16(p1[8 * s2 + 4], p1[8 * s2 + 5]), pg8::cvt_pk_bf16(p1[8 * s2 + 6], p1[8 * s2 + 7])};
        }
        { const LAS unsigned char* vb = bb + AT_KBYTES + r32 * AT_VP + hi * 8;
#pragma unroll
          for (int ks = 0; ks < 4; ++ks) {
              const bf16x8 pb = __builtin_bit_cast(bf16x8, pk[ks]);
              const bf16x8 v0 = mk_bf16x8(*(const LAS u64_t*)(vb + ks * 32), *(const LAS u64_t*)(vb + ks * 32 + 16));
              const bf16x8 v1 = mk_bf16x8(*(const LAS u64_t*)(vb + 32 * AT_VP + ks * 32), *(const LAS u64_t*)(vb + 32 * AT_VP + ks * 32 + 16));
              o0 = __builtin_amdgcn_mfma_f32_32x32x16_bf16(v0, pb, o0, 0, 0, 0);
              o1 = __builtin_amdgcn_mfma_f32_32x32x16_bf16(v1, pb, o1, 0, 0, 0); } }
        if (t + 1 < SEQ / 64) AT_STORE((t + 1) & 1);
        __syncthreads();
    }
#undef AT_LOAD
#undef AT_STORE
    lsum += __shfl_xor(lsum, 32);
    const float inv = 1.f / lsum;
    bf16* Og = (bf16*)(F.ws + WS_OMLA) + ((size_t)b * SEQ + qb * 256 + wave * 32 + r32) * 384 + h * 64 + 4 * hi;
#pragma unroll
    for (int rg = 0; rg < 4; ++rg) {
        *(u64_t*)(Og + 8 * rg) = (u64_t)pg8::cvt_pk_bf16(o0[4 * rg] * inv, o0[4 * rg + 1] * inv) | ((u64_t)pg8::cvt_pk_bf16(o0[4 * rg + 2] * inv, o0[4 * rg + 3] * inv) << 32);
        *(u64_t*)(Og + 32 + 8 * rg) = (u64_t)pg8::cvt_pk_bf16(o1[4 * rg] * inv, o1[4 * rg + 1] * inv) | ((u64_t)pg8::cvt_pk_bf16(o1[4 * rg + 2] * inv, o1[4 * rg + 3] * inv) << 32);
    }
}

__device__ __forceinline__ void rwkv_unit(Frame& F, int unit) {
    const int bh = unit >> 1, rowhalf = unit & 1, b = bh >> 2, h = bh & 3;
    const int lane = F.lane, dir = F.wave >> 2, w4 = F.wave & 3, ri = lane >> 3, cs = lane & 7, i = 32 * rowhalf + 8 * w4 + ri;
    const unsigned char* Rs = F.ws + WS_RS + (size_t)bh * SEQ * RS_REC;
    const unsigned char* Rd = F.ws + WS_RD + dir * RD_DIR + (size_t)bh * SEQ * RD_REC;
    bf16* Yg = (bf16*)(F.ws + WS_Y) + (size_t)b * SEQ * 256 + h * 64 + i;
    float S[8];
#pragma unroll
    for (int j = 0; j < 8; ++j) S[j] = 0.f;
    struct Rec { v4u kk, r, lam, b, k; unsigned short v; float br, kr; };
    Rec cur, nxt;
#define RW_LOAD(R, n_) do { const int t_ = dir ? SEQ - 1 - (n_) : (n_); const unsigned char* rs_ = Rs + (size_t)t_ * RS_REC; const unsigned char* rd_ = Rd + (size_t)t_ * RD_REC; \
        R.kk = *(const v4u*)(rs_ + 16 * cs); R.r = *(const v4u*)(rs_ + 256 + 16 * cs); R.v = *(const unsigned short*)(rs_ + 128 + 2 * i); \
        R.lam = *(const v4u*)(rd_ + 16 * cs); R.b = *(const v4u*)(rd_ + 128 + 16 * cs); R.k = *(const v4u*)(rd_ + 256 + 16 * cs); R.br = *(const float*)(rd_ + 384); R.kr = *(const float*)(rd_ + 388); } while (0)
    RW_LOAD(cur, 0);
    for (int n = 0; n < SEQ; ++n) {
        if (n + 1 < SEQ) RW_LOAD(nxt, n + 1); else nxt = cur;
        if (n == SEQ / 2) { asm volatile("s_waitcnt vmcnt(0)" ::: "memory"); __syncthreads(); }
        float kk[8], r[8], w[8], bb[8], kv[8];
#pragma unroll
        for (int q = 0; q < 4; ++q) {
            kk[2 * q] = __uint_as_float(cur.kk[q] << 16); kk[2 * q + 1] = __uint_as_float(cur.kk[q] & 0xffff0000u);
            r[2 * q] = __uint_as_float(cur.r[q] << 16); r[2 * q + 1] = __uint_as_float(cur.r[q] & 0xffff0000u);
            bb[2 * q] = __uint_as_float(cur.b[q] << 16); bb[2 * q + 1] = __uint_as_float(cur.b[q] & 0xffff0000u);
            kv[2 * q] = __uint_as_float(cur.k[q] << 16); kv[2 * q + 1] = __uint_as_float(cur.k[q] & 0xffff0000u);
            w[2 * q] = __builtin_amdgcn_exp2f(-LOG2E * __half2float(__ushort_as_half((unsigned short)(cur.lam[q] & 0xffffu))));
            w[2 * q + 1] = __builtin_amdgcn_exp2f(-LOG2E * __half2float(__ushort_as_half((unsigned short)(cur.lam[q] >> 16))));
        }
        const float v = __uint_as_float(((unsigned)cur.v) << 16);
        float sa = 0.f, ym = 0.f;
#pragma unroll
        for (int j = 0; j < 8; ++j) { sa += S[j] * kk[j]; ym += S[j] * (w[j] * r[j]); }
        sa += __shfl_xor(sa, 1); ym += __shfl_xor(ym, 1);
        sa += __shfl_xor(sa, 2); ym += __shfl_xor(ym, 2);
        sa += __shfl_xor(sa, 4); ym += __shfl_xor(ym, 4);
        sa = -sa;
#pragma unroll
        for (int j = 0; j < 8; ++j) S[j] = S[j] * w[j] + (sa * bb[j] + v * kv[j]);
        float y = ym + sa * cur.br + v * cur.kr;
        if (cs == 0) {
            const int t = dir ? SEQ - 1 - n : n; bf16* yp = Yg + (size_t)t * 256;
            if (n >= SEQ / 2) y += bf2f(*yp);
            *yp = (bf16)f2bf(y);
        }
        cur = nxt;
    }
#undef RW_LOAD
}

__device__ __forceinline__ void gdn_unit(Frame& F, int l, int unit) {
    const int bh = unit, b = bh / 6, h = bh % 6, e = F.lane, dir = F.wave;
    const bf16* Pgdn = (const bf16*)(F.ws + WS_PGDN); const float* Psm = (const float*)(F.ws + WS_PSM); bf16* Ogdn = (bf16*)(F.ws + WS_OGDN);
    const float* conv_w = (const float*)inptr(F, 4) + (size_t)l * 5 * 1152; const float* a_log = (const float*)inptr(F, 5) + l * 12; const float* dt_bias = (const float*)inptr(F, 6) + l * 12;
    LAS float* qs = (LAS float*)(F.lds + RING_OFF) + F.wave * 128; LAS float* ks = qs + 64;
    if (F.wave < 2) {
        float S[64];
#pragma unroll
        for (int i = 0; i < 64; ++i) S[i] = 0.f;
        float cw[3][5];
#pragma unroll
        for (int i = 0; i < 5; ++i) { cw[0][i] = conv_w[i * 1152 + h * 64 + e]; cw[1][i] = conv_w[i * 1152 + 384 + h * 64 + e]; cw[2][i] = conv_w[i * 1152 + 768 + h * 64 + e]; }
        const float al = -__expf(a_log[dir * 6 + h]), dtb = dt_bias[dir * 6 + h];
        for (int n = 0; n < SEQ; ++n) {
            if (n == SEQ / 2) { asm volatile("s_waitcnt vmcnt(0)" ::: "memory"); __syncthreads(); }
            const int t = dir ? SEQ - 1 - n : n; const size_t m = (size_t)b * SEQ + t;
            float cq = 0.f, ck = 0.f, cv = 0.f;
#pragma unroll
            for (int i = 0; i < 5; ++i) { const int tt = t + i - 2; if (tt >= 0 && tt < SEQ) { const bf16* pr = Pgdn + ((size_t)b * SEQ + tt) * 1152 + h * 64 + e;
                    cq += cw[0][i] * bf2f(pr[0]); ck += cw[1][i] * bf2f(pr[384]); cv += cw[2][i] * bf2f(pr[768]); } }
            cq = siluf(cq); ck = siluf(ck); cv = siluf(cv);
            const float qn = cq * rsqrtf(wave_sum(cq * cq) + 1e-6f) * 0.125f, kn = ck * rsqrtf(wave_sum(ck * ck) + 1e-6f);
            LDS_WAIT(); asm volatile("" ::: "memory");
            qs[e] = qn; ks[e] = kn;
            LDS_WAIT(); asm volatile("" ::: "memory");
            const float g = al * softplusf_(Psm[m * 32 + dir * 6 + h] + dtb), beta = sigmoidf_(Psm[m * 32 + 12 + dir * 6 + h]), alpha = __expf(g);
            float kS = 0.f;
#pragma unroll
            for (int c4 = 0; c4 < 16; ++c4) { const f32x4 kq = ((const LAS f32x4*)ks)[c4];
                kS += (kq.x * S[4 * c4] + kq.y * S[4 * c4 + 1]) + (kq.z * S[4 * c4 + 2] + kq.w * S[4 * c4 + 3]);
                if ((c4 & 3) == 3) asm volatile("" ::: "memory"); }
            const float coef = beta * (cv - alpha * kS);
            float o = 0.f;
#pragma unroll
            for (int c4 = 0; c4 < 16; ++c4) { const f32x4 kq = ((const LAS f32x4*)ks)[c4], qq = ((const LAS f32x4*)qs)[c4];
                S[4 * c4] = alpha * S[4 * c4] + coef * kq.x; S[4 * c4 + 1] = alpha * S[4 * c4 + 1] + coef * kq.y; S[4 * c4 + 2] = alpha * S[4 * c4 + 2] + coef * kq.z; S[4 * c4 + 3] = alpha * S[4 * c4 + 3] + coef * kq.w;
                o += (qq.x * S[4 * c4] + qq.y * S[4 * c4 + 1]) + (qq.z * S[4 * c4 + 2] + qq.w * S[4 * c4 + 3]);
                if ((c4 & 3) == 3) asm volatile("" ::: "memory"); }
            bf16* op = Ogdn + m * 384 + h * 64 + e;
            if (n >= SEQ / 2) o += bf2f(*op);
            *op = (bf16)f2bf(o);
        }
    } else { __syncthreads(); }
}

__device__ __forceinline__ int next_unit(Frame& F, gu32* head) {
    __syncthreads();
    if (F.tid == 0) F.MISC[16] = __hip_atomic_fetch_add(head, 1u, RLX_AGENT);
    __syncthreads();
    return (int)F.MISC[16];
}
constexpr int U_GDN = 48, U_RWKV = 64, U_ATT = 384, U_ALL = U_GDN + U_RWKV + U_ATT;
__device__ __forceinline__ void p3_mixers(Frame& F, int l) {
    gu32* head = F.ctl + CW_QUEUE + 64 * l;
    for (;;) {
        const int u = next_unit(F, head);
        if (u >= U_ALL) break;
        asm volatile("" : "+v"(F.tid), "+v"(F.lane));
        if (u < U_GDN) gdn_unit(F, l, u);
        else if (u < U_GDN + U_RWKV) rwkv_unit(F, u - U_GDN);
        else attn_unit(F, u - U_GDN - U_RWKV);
    }
}
typedef unsigned u32x4 __attribute__((ext_vector_type(4)));
__device__ __forceinline__ float dot_bf16(const bf16* a, const bf16* b, int K) {
    float acc = 0.f;
    for (int k = 0; k < K; k += 8) {
        const u32x4 av = *(const u32x4*)(a + k), bv = *(const u32x4*)(b + k);
#pragma unroll
        for (int i = 0; i < 4; ++i) {
            acc += __uint_as_float(av[i] << 16) * __uint_as_float(bv[i] << 16);
            acc += __uint_as_float(av[i] & 0xffff0000u) * __uint_as_float(bv[i] & 0xffff0000u);
        }
    }
    return acc;
}
__global__ void __launch_bounds__(64) nk_mla_prep(const bf16* Pmla, const bf16* WuqT, const bf16* WukvT, const int* positions, bf16* Q, bf16* Kb, bf16* Vt) {
    __shared__ float raw[576 + 768];
    __shared__ float rs[2];
    const int m = blockIdx.x, lane = threadIdx.x, b = m / SEQ, t = m % SEQ;
    const bf16* p = Pmla + (size_t)m * 352;
    float s1 = 0.f, s2 = 0.f;
    for (int c = lane; c < 192; c += 64) { const float v = bf2f(p[c]); s1 += v * v; }
    for (int c = lane; c < 128; c += 64) { const float v = bf2f(p[192 + c]); s2 += v * v; }
    s1 = wave_sum(s1); s2 = wave_sum(s2);
    const float rq = rsqrtf(s1 * (1.f / 192.f) + NORM_EPS), rkv = rsqrtf(s2 * (1.f / 128.f) + NORM_EPS);
    for (int c = lane; c < 576; c += 64) raw[c] = dot_bf16(p, WuqT + (size_t)c * 192, 192) * rq;
    for (int c = lane; c < 768; c += 64) raw[576 + c] = dot_bf16(p + 192, WukvT + (size_t)c * 128, 128) * rkv;
    __syncthreads();
    const float pos = (float)positions[m];
    const float qs = 0.10206207261596575f * LOG2E;
    for (int i = lane; i < 6 * 80; i += 64) {
        const int h = i / 80, j = i % 80;
        bf16* qo = Q + (((size_t)b * 6 + h) * SEQ + t) * 96;
        if (j < 64) qo[j] = f2bf(raw[h * 96 + j] * qs);
        else { const int r = j - 64; const float inv = exp2f(-(float)r * (13.287712379549449f / 16.f)); float sn, cs; sincosf(pos * inv, &sn, &cs);
            const float x1 = raw[h * 96 + 64 + r], x2 = raw[h * 96 + 80 + r];
            qo[64 + r] = f2bf((x1 * cs - x2 * sn) * qs); qo[80 + r] = f2bf((x2 * cs + x1 * sn) * qs); }
    }
    for (int i = lane; i < 6 * 64; i += 64) {
        const int h = i / 64, j = i % 64;
        Kb[(((size_t)b * 6 + h) * SEQ + t) * 96 + j] = f2bf(raw[576 + h * 128 + j]);
        Vt[(((size_t)b * 6 + h) * 64 + j) * SEQ + t] = f2bf(raw[576 + h * 128 + 64 + j]);
    }
    if (lane < 16) {
        const int r = lane; const float inv = exp2f(-(float)r * (13.287712379549449f / 16.f)); float sn, cs; sincosf(pos * inv, &sn, &cs);
        const float x1 = bf2f(p[320 + r]), x2 = bf2f(p[336 + r]);
        const bf16 o1 = f2bf(x1 * cs - x2 * sn), o2 = f2bf(x2 * cs + x1 * sn);
        for (int h = 0; h < 6; ++h) { bf16* ko = Kb + (((size_t)b * 6 + h) * SEQ + t) * 96; ko[64 + r] = o1; ko[80 + r] = o2; }
    }
}
__global__ void __launch_bounds__(256) nk_rwkv_prep(const bf16* Prw, const float* mu, const float* w0, const float* w2, const float* a0, const float* a2,
                             const float* k_k, const float* k_a, const float* r_k, unsigned char* Rs, unsigned char* Rd, float* cb) {
    __shared__ float f[896];
    const int m = blockIdx.x, c = threadIdx.x, b = m / SEQ, t = m % SEQ, h = c >> 6, j = c & 63;
    for (int i = c; i < 896; i += 256) {
        const float x = bf2f(Prw[(size_t)m * 896 + i]);
        const float xp = t > 0 ? bf2f(Prw[(size_t)(m - 1) * 896 + i]) : 0.f;
        const float xn = t < SEQ - 1 ? bf2f(Prw[(size_t)(m + 1) * 896 + i]) : 0.f;
        float v = x + mu[i] * (xp - x) + mu[896 + i] * (xn - x);
        if (i >= 768 && i < 832) v = tanhf(v);
        f[i] = v;
    }
    __syncthreads();
    const float r = f[c], k = f[256 + c], v = f[512 + c];
    const float kkr = k * k_k[c];
    const float kn = wave_sum(kkr * kkr);
    const float kk = kkr * rsqrtf(kn + 1e-6f);
    float kmod[2], bb[2], lam[2];
#pragma unroll
    for (int e = 0; e < 2; ++e) {
        float lw = 0.f, la = 0.f;
        for (int d = 0; d < 64; ++d) { lw += f[768 + d] * w2[((size_t)e * 64 + d) * 256 + c]; la += f[832 + d] * a2[((size_t)e * 64 + d) * 256 + c]; }
        const float wl = -softplusf_(-(w0[e * 256 + c] + lw)) - 0.5f;
        lam[e] = __expf(wl);
        const float a = sigmoidf_(a0[e * 256 + c] + la);
        kmod[e] = k * (1.f + (a - 1.f) * k_a[c]);
        bb[e] = a * kk;
    }
    unsigned char* rs = Rs + (((size_t)b * 4 + h) * SEQ + t) * RS_REC;
    ((bf16*)rs)[j] = f2bf(kk); ((bf16*)(rs + 128))[j] = f2bf(v); ((bf16*)(rs + 256))[j] = f2bf(r);
#pragma unroll
    for (int e = 0; e < 2; ++e) {
        unsigned char* rd = Rd + e * RD_DIR + (((size_t)b * 4 + h) * SEQ + t) * RD_REC;
        ((__half*)rd)[j] = __float2half(lam[e]); ((bf16*)(rd + 128))[j] = f2bf(bb[e]); ((bf16*)(rd + 256))[j] = f2bf(kmod[e]);
        const float br = wave_sum(bb[e] * r), kr = wave_sum(kmod[e] * r);
        if (j == 0) { ((float*)(rd + 384))[0] = br; ((float*)(rd + 384))[1] = kr; }
    }
    const float cbv = wave_sum(r * 0.5f * (kmod[0] + kmod[1]) * r_k[c]);
    if (j == 0) cb[(size_t)m * 4 + h] = cbv;
}
__global__ void __launch_bounds__(128) nk_attn(const bf16* Q, const bf16* Kb, const bf16* Vt, bf16* Omla) {
    const int bh = blockIdx.y, q = blockIdx.x * 128 + threadIdx.x, b = bh / 6, h = bh % 6;
    const bf16* qp = Q + ((size_t)bh * SEQ + q) * 96;
    float qr[96];
#pragma unroll
    for (int i = 0; i < 96; ++i) qr[i] = bf2f(qp[i]);
    float acc[64];
#pragma unroll
    for (int i = 0; i < 64; ++i) acc[i] = 0.f;
    float mx = -1e30f, l = 0.f;
    const bf16* kb = Kb + (size_t)bh * SEQ * 96; const bf16* vt = Vt + (size_t)bh * 64 * SEQ;
    for (int k0 = 0; k0 < SEQ; k0 += 8) {
        float s[8];
#pragma unroll
        for (int kk = 0; kk < 8; ++kk) {
            const bf16* kr = kb + (size_t)(k0 + kk) * 96; float a = 0.f;
#pragma unroll
            for (int d = 0; d < 96; d += 8) { const u32x4 kv = *(const u32x4*)(kr + d);
#pragma unroll
                for (int i = 0; i < 4; ++i) { a += qr[d + 2 * i] * __uint_as_float(kv[i] << 16); a += qr[d + 2 * i + 1] * __uint_as_float(kv[i] & 0xffff0000u); } }
            s[kk] = a;
        }
        float cm = s[0];
#pragma unroll
        for (int kk = 1; kk < 8; ++kk) cm = fmaxf(cm, s[kk]);
        const float mn = fmaxf(mx, cm), sc = exp2f(mx - mn);
        l *= sc;
#pragma unroll
        for (int i = 0; i < 64; ++i) acc[i] *= sc;
        mx = mn;
#pragma unroll
        for (int kk = 0; kk < 8; ++kk) { s[kk] = exp2f(s[kk] - mn); l += s[kk]; }
#pragma unroll
        for (int d = 0; d < 64; ++d) { const u32x4 vv = *(const u32x4*)(vt + (size_t)d * SEQ + k0);
#pragma unroll
            for (int i = 0; i < 4; ++i) { acc[d] += s[2 * i] * __uint_as_float(vv[i] << 16); acc[d] += s[2 * i + 1] * __uint_as_float(vv[i] & 0xffff0000u); } }
    }
    const float il = 1.f / l;
    bf16* o = Omla + ((size_t)b * SEQ + q) * 384 + h * 64;
#pragma unroll
    for (int i = 0; i < 64; ++i) o[i] = f2bf(acc[i] * il);
}
__global__ void __launch_bounds__(64) nk_gdn(const bf16* Pgdn, const float* Psm, const float* conv_w, const float* a_log, const float* dt_bias, bf16* Ogdn, int dir) {
    __shared__ float qs[64], ks[64];
    const int bh = blockIdx.x, b = bh / 6, h = bh % 6, e = threadIdx.x;
    float S[64];
#pragma unroll
    for (int i = 0; i < 64; ++i) S[i] = 0.f;
    float cw[3][5];
#pragma unroll
    for (int i = 0; i < 5; ++i) { cw[0][i] = conv_w[i * 1152 + h * 64 + e]; cw[1][i] = conv_w[i * 1152 + 384 + h * 64 + e]; cw[2][i] = conv_w[i * 1152 + 768 + h * 64 + e]; }
    const float al = -__expf(a_log[dir * 6 + h]), dtb = dt_bias[dir * 6 + h];
    for (int n = 0; n < SEQ; ++n) {
        const int t = dir ? SEQ - 1 - n : n; const size_t m = (size_t)b * SEQ + t;
        float cq = 0.f, ck = 0.f, cv = 0.f;
#pragma unroll
        for (int i = 0; i < 5; ++i) { const int tt = t + i - 2; if (tt >= 0 && tt < SEQ) { const bf16* pr = Pgdn + ((size_t)b * SEQ + tt) * 1152 + h * 64 + e;
                cq += cw[0][i] * bf2f(pr[0]); ck += cw[1][i] * bf2f(pr[384]); cv += cw[2][i] * bf2f(pr[768]); } }
        cq = siluf(cq); ck = siluf(ck); cv = siluf(cv);
        const float qn = cq * rsqrtf(wave_sum(cq * cq) + 1e-6f) * 0.125f, kn = ck * rsqrtf(wave_sum(ck * ck) + 1e-6f);
        __syncthreads();
        qs[e] = qn; ks[e] = kn;
        __syncthreads();
        const float g = al * softplusf_(Psm[m * 32 + dir * 6 + h] + dtb), beta = sigmoidf_(Psm[m * 32 + 12 + dir * 6 + h]), alpha = __expf(g);
        float kS = 0.f;
#pragma unroll
        for (int d = 0; d < 64; ++d) kS += ks[d] * S[d];
        const float coef = beta * (cv - alpha * kS);
        float o = 0.f;
#pragma unroll
        for (int d = 0; d < 64; ++d) { S[d] = alpha * S[d] + coef * ks[d]; o += qs[d] * S[d]; }
        bf16* op = Ogdn + m * 384 + h * 64 + e;
        if (dir) o += bf2f(*op);
        *op = f2bf(o);
    }
}
__global__ void __launch_bounds__(64) nk_rwkv(const unsigned char* Rs, const unsigned char* Rd, bf16* Y, int dir) {
    const int bh = blockIdx.x, b = bh / 4, h = bh % 4, i = threadIdx.x;
    float S[64];
#pragma unroll
    for (int j = 0; j < 64; ++j) S[j] = 0.f;
    for (int n = 0; n < SEQ; ++n) {
        const int t = dir ? SEQ - 1 - n : n;
        const unsigned char* rs = Rs + ((size_t)bh * SEQ + t) * RS_REC;
        const unsigned char* rd = Rd + dir * RD_DIR + ((size_t)bh * SEQ + t) * RD_REC;
        const float v = bf2f(((const bf16*)(rs + 128))[i]);
        float sa = 0.f;
#pragma unroll
        for (int j = 0; j < 64; ++j) sa -= S[j] * bf2f(((const bf16*)rs)[j]);
        float y = 0.f;
#pragma unroll
        for (int j = 0; j < 64; ++j) {
            const float w = __expf(-__half2float(((const __half*)rd)[j]));
            S[j] = S[j] * w + sa * bf2f(((const bf16*)(rd + 128))[j]) + v * bf2f(((const bf16*)(rd + 256))[j]);
            y += S[j] * bf2f(((const bf16*)(rs + 256))[j]);
        }
        bf16* op = Y + ((size_t)b * SEQ + t) * 256 + h * 64 + i;
        if (dir) y += bf2f(*op);
        *op = f2bf(y);
    }
}
__global__ void __launch_bounds__(1024) nk_mix(const bf16* Ogdn, const bf16* Omla, const bf16* Y, const bf16* Pgate, const unsigned char* Rs, const float* cb,
                       const float* gdn_g, const float* ln_g, const float* ln_b, bf16* mix) {
    const int m = blockIdx.x, c = threadIdx.x, b = m / SEQ, t = m % SEQ;
    float val;
    if (c < 384) { const float o = bf2f(Ogdn[(size_t)m * 384 + c]); const float ss = wave_sum(o * o); val = o * rsqrtf(ss * (1.f / 64.f) + NORM_EPS) * gdn_g[c & 63]; }
    else if (c < 768) val = bf2f(Omla[(size_t)m * 384 + (c - 384)]);
    else { const int cc = c - 768, h = cc >> 6, j = cc & 63; const float y = bf2f(Y[(size_t)m * 256 + cc]);
        const float mean = wave_sum(y) * (1.f / 64.f); const float dv = y - mean; const float var = wave_sum(dv * dv) * (1.f / 64.f);
        const float v = bf2f(((const bf16*)(Rs + (((size_t)b * 4 + h) * SEQ + t) * RS_REC + 128))[j]);
        val = dv * rsqrtf(var + 64e-5f) * ln_g[cc] + ln_b[cc] + cb[(size_t)m * 4 + h] * v; }
    mix[(size_t)m * 1024 + c] = f2bf(val * siluf(bf2f(Pgate[(size_t)m * 1024 + c])));
}
#ifndef MK_SINGLE
#define MK_SINGLE 1
#endif
#ifndef MK_P2
#define MK_P2 1
#endif
#ifndef MK_P3
#define MK_P3 1
#endif
#ifndef MK_P4A
#define MK_P4A 1
#endif
constexpr int PT_OUT = 24, PT_WS = 25, PT_N = 26;
__device__ __forceinline__ void build_frame(Frame& F, LAS unsigned char* lds) {
    F.lds = lds; F.MISC = (volatile LAS unsigned*)(lds + MISC_OFF); F.ptab = (LAS const unsigned long long*)(lds + MISC_OFF + 256);
    const int t = pg8::mk_tid(lds);
    F.tid = t; F.lane = t & 63; F.wave = __builtin_amdgcn_readfirstlane(t >> 6);
    F.G = gridDim.x; { const int bx = blockIdx.x; F.vcu = (F.G % 8 == 0) ? (bx % 8) * (F.G / 8) + bx / 8 : bx; }
    F.ws = (unsigned char*)inptr(F, PT_WS); F.out = (float*)inptr(F, PT_OUT); F.ctl = (gu32*)F.ws;
}
__device__ __forceinline__ bool ph_in(LAS unsigned char* lds, int k) { volatile LAS unsigned* mi = (volatile LAS unsigned*)(lds + MISC_OFF); const int lo = __builtin_amdgcn_readfirstlane((int)mi[20]), hi = __builtin_amdgcn_readfirstlane((int)mi[21]); return lo <= k && k < hi; }
__device__ __forceinline__ void seam(LAS unsigned char* lds, int k) {
    if (ph_in(lds, k) && ph_in(lds, k + 1)) { Frame F; build_frame(F, lds);
        XcdBarrier bar; bar.bar = (unsigned*)(F.ctl + CW_BAR); bar.x = xb_xcc_id(); bar.st = F.MISC + 8; xcd_barrier(bar); }
}
template <int L> __device__ __forceinline__ void layer_phases(LAS unsigned char* lds) {
    constexpr int pb = 1 + 5 * L;
    if (ph_in(lds, pb)) { Frame F; build_frame(F, lds);
        pg8::Gemm g{(const pg8::bf16_t*)(F.ws + WS_XB), (const pg8::bf16_t*)(F.ws + WS_WIN) + (size_t)L * NP * D, M, NP, D};
        pg8::StaticOrder S; S.init(M, NP, F.G, (int)blockIdx.x);
        pg8::EpiRoute E{F.ws};
        pg8::gemm_phase<pg8::EpiRoute, pg8::StaticOrder, true, true>(F.lds + RING_OFF, g, S, E); }
    seam(lds, pb);
    if (ph_in(lds, pb + 1)) { Frame F; build_frame(F, lds); p2_prep(F, L); }
    seam(lds, pb + 1);
    if (ph_in(lds, pb + 2)) { Frame F; build_frame(F, lds); p3_mixers(F, L); }
    seam(lds, pb + 2);
    if (ph_in(lds, pb + 3)) { Frame F; build_frame(F, lds); p4a_mix(F, L); }
    seam(lds, pb + 3);
    if (ph_in(lds, pb + 4)) { Frame F; build_frame(F, lds);
        pg8::Gemm g{(const pg8::bf16_t*)(F.ws + WS_MIX), (const pg8::bf16_t*)(F.ws + WS_WOUT) + (size_t)L * D * D, M, D, D};
        pg8::StaticOrder S; S.init(M, D, F.G, (int)blockIdx.x);
        pg8::EpiOut E{L == 0 ? (const float*)inptr(F, 0) : (const float*)F.out, F.out, F.ws};
        pg8::gemm_phase<pg8::EpiOut, pg8::StaticOrder, true, true>(F.lds + RING_OFF, g, S, E); }
    seam(lds, pb + 4);
}
__global__ void __launch_bounds__(NWAVES * 64, 2) mk_fwd(Args args) {
    extern __shared__ __attribute__((aligned(16))) unsigned char lds_raw[];
    LAS unsigned char* lds = (LAS unsigned char*)lds_raw;
    for (int u = threadIdx.x; u < (LDS_BYTES - LDSCTL_OFF) / 4; u += NWAVES * 64) ((LAS unsigned*)(lds + LDSCTL_OFF))[u] = 0u;
    __syncthreads();
    if (threadIdx.x == 0) { LAS unsigned long long* pt = (LAS unsigned long long*)(lds + MISC_OFF + 256);
#define PT(k) pt[k] = (unsigned long long)args.in[k]
        PT(0); PT(1); PT(2); PT(3); PT(4); PT(5); PT(6); PT(7); PT(8); PT(9); PT(10); PT(11); PT(12); PT(13); PT(14); PT(15); PT(16); PT(17); PT(18); PT(19); PT(20); PT(21); PT(22); PT(23);
#undef PT
        pt[PT_OUT] = (unsigned long long)args.out; pt[PT_WS] = (unsigned long long)args.ws;
        volatile LAS unsigned* mi = (volatile LAS unsigned*)(lds + MISC_OFF); mi[20] = (unsigned)args.ph_lo; mi[21] = (unsigned)args.ph_hi;
        if (args.ph_hi - args.ph_lo > 1) (void)xcd_barrier_post((unsigned*)((gu32*)args.ws + CW_BAR), mi + 8);
    }
    if ((threadIdx.x & 63) == 0) ((volatile LAS unsigned*)(lds + pg8::TIDTAB_OFF))[pg8::hw_slot()] = threadIdx.x >> 6;
    __syncthreads();
    if (ph_in(lds, 0)) { Frame F; build_frame(F, lds); p0_prologue(F); }
    seam(lds, 0);
    layer_phases<0>(lds);
    layer_phases<1>(lds);
    if (ph_in(lds, 11)) { Frame F; build_frame(F, lds); p5_final(F); }
}

static void launch_phases(hipStream_t stream, int grid, Args a, int lo, int hi) {
    a.ph_lo = lo; a.ph_hi = hi;
    hipLaunchKernelGGL(mk_fwd, dim3(grid), dim3(NWAVES * 64), LDS_BYTES, stream, a);
}
extern "C" void kernel_launch(void* const* d_in, const int* in_sizes, int n_in, void* d_out, int out_size, void* d_ws, size_t ws_size, hipStream_t stream) {
    static int grid = 0;
    if (grid == 0) {
        if (n_in != 24 || ws_size < WS_END || out_size != M * D) { fprintf(stderr, "kernel_launch: unexpected inputs (%d), out (%d) or workspace (%zu)\n", n_in, out_size, ws_size); grid = -1; return; }
        int dev = 0, cus = 0;
        if (hipGetDevice(&dev) != hipSuccess || hipDeviceGetAttribute(&cus, hipDeviceAttributeMultiprocessorCount, dev) != hipSuccess) { grid = -1; return; }
        if (hipFuncSetAttribute((const void*)mk_fwd, hipFuncAttributeMaxDynamicSharedMemorySize, LDS_BYTES) != hipSuccess) { fprintf(stderr, "kernel_launch: hipFuncSetAttribute failed\n"); grid = -1; return; }
        (void)hipGetLastError();
        grid = cus;
    }
    if (grid < 0) return;
    unsigned char* ws = (unsigned char*)d_ws;
    hipMemsetAsync(ws + WS_CTL, 0, CTL_ZERO_BYTES, stream);
    Args a{};
    for (int i = 0; i < 24; ++i) a.in[i] = d_in[i];
    a.out = (float*)d_out; a.ws = ws;

    const int* positions = (const int*)d_in[1];
    const float* gdn_conv = (const float*)d_in[4]; const float* gdn_a_log = (const float*)d_in[5]; const float* gdn_dt_bias = (const float*)d_in[6]; const float* gdn_norm_g = (const float*)d_in[7];
    const float* mu = (const float*)d_in[12]; const float* w0 = (const float*)d_in[13]; const float* w2 = (const float*)d_in[14]; const float* a0 = (const float*)d_in[15];
    const float* a2 = (const float*)d_in[16]; const float* k_k = (const float*)d_in[17]; const float* k_a = (const float*)d_in[18]; const float* r_k = (const float*)d_in[19];
    const float* ln_g = (const float*)d_in[20]; const float* ln_b = (const float*)d_in[21];
    bf16* WuqT = (bf16*)(ws + WS_WSMALL + OFF_WUQ); bf16* WukvT = (bf16*)(ws + WS_WSMALL + OFF_WUKV);
    float* Psm = (float*)(ws + WS_PSM); float* cb = (float*)(ws + WS_CB);
    bf16* Pgate = (bf16*)(ws + WS_PGATE); bf16* Pgdn = (bf16*)(ws + WS_PGDN); bf16* Pmla = (bf16*)(ws + WS_PMLA); bf16* Prw = (bf16*)(ws + WS_PRW);
    bf16* Ogdn = (bf16*)(ws + WS_OGDN); bf16* Omla = (bf16*)(ws + WS_OMLA); bf16* Y = (bf16*)(ws + WS_Y);
    unsigned char* Rs = ws + WS_RS; unsigned char* Rd = ws + WS_RD;
    bf16* Q = (bf16*)(ws + WS_Q); bf16* Kb = (bf16*)(ws + WS_K); bf16* Vt = (bf16*)(ws + WS_VT); bf16* mix = (bf16*)(ws + WS_MIX);

#if MK_SINGLE
    launch_phases(stream, grid, a, 0, NPHASE);
    return;
#endif
    launch_phases(stream, grid, a, 0, 1);
    for (int l = 0; l < 2; ++l) {
        launch_phases(stream, grid, a, 1 + 5 * l, 2 + 5 * l);
#if MK_P2
        launch_phases(stream, grid, a, 2 + 5 * l, 3 + 5 * l);
#else
        hipLaunchKernelGGL(nk_mla_prep, dim3(M), dim3(64), 0, stream, Pmla, WuqT + (size_t)l * 576 * 192, WukvT + (size_t)l * 768 * 128, positions, Q, Kb, Vt);
        hipLaunchKernelGGL(nk_rwkv_prep, dim3(M), dim3(256), 0, stream, Prw, mu + l * 2 * 896, w0 + l * 512, w2 + (size_t)l * 2 * 64 * 256, a0 + l * 512, a2 + (size_t)l * 2 * 64 * 256,
                           k_k + l * 256, k_a + l * 256, r_k + l * 256, Rs, Rd, cb);
#endif
#if MK_P3
        launch_phases(stream, grid, a, 3 + 5 * l, 4 + 5 * l);
#else
        hipLaunchKernelGGL(nk_attn, dim3(SEQ / 128, BATCH * 6), dim3(128), 0, stream, Q, Kb, Vt, Omla);
        for (int dir = 0; dir < 2; ++dir) {
            hipLaunchKernelGGL(nk_gdn, dim3(BATCH * 6), dim3(64), 0, stream, Pgdn, Psm, gdn_conv + (size_t)l * 5 * 1152, gdn_a_log + l * 12, gdn_dt_bias + l * 12, Ogdn, dir);
            hipLaunchKernelGGL(nk_rwkv, dim3(BATCH * 4), dim3(64), 0, stream, Rs, Rd, Y, dir);
        }
#endif
#if MK_P4A
        launch_phases(stream, grid, a, 4 + 5 * l, 5 + 5 * l);
#else
        hipLaunchKernelGGL(nk_mix, dim3(M), dim3(1024), 0, stream, Ogdn, Omla, Y, Pgate, Rs, cb, gdn_norm_g + l * 64, ln_g + l * 256, ln_b + l * 256, mix);
#endif
        launch_phases(stream, grid, a, 5 + 5 * l, 6 + 5 * l);
    }
    launch_phases(stream, grid, a, 11, 12);
}
```

```cpp
#include <hip/hip_runtime.h>
#include <cstdio>
#include <cstdint>
#include <hip/hip_fp16.h>
namespace pg8 {
#define PG8_LAS __attribute__((address_space(3)))
typedef unsigned short bf16_t;
typedef short bf16x8 __attribute__((ext_vector_type(8)));
typedef float f32x4 __attribute__((ext_vector_type(4)));
typedef unsigned u32x4 __attribute__((ext_vector_type(4)));
constexpr int BM = 256, BK = 64, HALF = 128, HTB = HALF * BK * 2  , STAGE_BYTES = 8 * HTB, NXCD = 8, WGM = 8;

__host__ __device__ __forceinline__ int lds_byte(int r, int c) { const int st = (r >> 4) * 2 + (c >> 5), rr = r & 15, cc = c & 31, ob = rr * 64 + cc * 2; return st * 1024 + (ob ^ (((ob >> 9) & 1) << 5)); }
__host__ __device__ __forceinline__ void stage_rc(int b, int& R, int& C) { const int st = b / 1024, sb = b % 1024, swz = sb ^ (((sb >> 9) & 1) << 5); R = (st >> 1) * 16 + swz / 64; C = (st & 1) * 32 + (swz % 64) / 2; }
__host__ __device__ __forceinline__ int perm32(int rho) { const int n = rho >> 4, i = rho & 15; return 8 * (i >> 2) + 4 * n + (i & 3); }

struct Unit { int pm, pn; };
struct Gemm { const bf16_t* A; const bf16_t* Bt; int M, N, K; };

struct StaticOrder {
    int nM, nN, nwg, G, c;
    __host__ __device__ void init(int M, int N, int G_, int c_) { nM = M / BM; nN = N / BM; nwg = nM * nN; G = G_; c = c_; }
    __host__ __device__ bool next(int i, Unit& u) const {
        const long L = (long)i * G + c; if (L >= nwg) return false;
        int wgid = (int)L; { const int q = nwg / NXCD, r = nwg % NXCD, xcd = wgid % NXCD, off = wgid / NXCD; wgid = (xcd < r ? xcd * (q + 1) : r * (q + 1) + (xcd - r) * q) + off; }
        const int nig = WGM * nN, gid = wgid / nig, fm = gid * WGM, gsz = (nM - fm) < WGM ? (nM - fm) : WGM;
        u.pm = fm + ((wgid % nig) % gsz); u.pn = (wgid % nig) / gsz; return true;
    }
    __device__ __forceinline__ void a_ready(const Unit&) const {}
    __device__ __forceinline__ void done(const Unit&) const {}
};

__device__ __forceinline__ unsigned cvt_pk_bf16(float lo, float hi) { unsigned r; asm volatile("v_cvt_pk_bf16_f32 %0, %1, %2" : "=v"(r) : "v"(lo), "v"(hi)); return r; }
typedef float f32x2 __attribute__((ext_vector_type(2)));
constexpr int TIDTAB_OFF = 131072 + 320 + 512;
__device__ __forceinline__ unsigned hw_slot() { return (unsigned)__builtin_amdgcn_s_getreg((5 << 11) | 4) & 63u; }
__device__ __forceinline__ int mk_tid(PG8_LAS unsigned char* lds_base) {
    const unsigned lane = __builtin_amdgcn_mbcnt_hi(~0u, __builtin_amdgcn_mbcnt_lo(~0u, 0u));
    const unsigned w = __builtin_amdgcn_readfirstlane(((volatile PG8_LAS unsigned*)(lds_base + TIDTAB_OFF))[hw_slot()]);
    return (int)(w * 64u + lane);
}
struct EpiRoute {
    static constexpr bool PERM = true, AFTER_DRAIN = false;
    unsigned char* ws;
    __device__ __forceinline__ void operator()(const f32x4 (&acc)[2][2][4][2], const Unit& u, int wr, int wc, int fr, int fq) const {
        const int row0 = u.pm * BM + wr * 64 + fr;
        const float* rowss = (const float*)(ws + (1u << 20)); float* Psm = (float*)(ws + (22u << 20));
        unsigned base[2]; int ld[2], cc[2], kind[2];
#pragma unroll
        for (int bj = 0; bj < 2; ++bj) {
            const int cg = u.pn * BM + bj * HALF + wc * 32, col = cg + 8 * fq;
            if (cg < 1024) { base[bj] = 25u << 20; ld[bj] = 1024; cc[bj] = col; kind[bj] = 0; }
            else if (cg < 2176) { base[bj] = 57u << 20; ld[bj] = 1152; cc[bj] = col - 1024; kind[bj] = 0; }
            else if (cg < 2528) { base[bj] = 93u << 20; ld[bj] = 352; cc[bj] = col - 2176; kind[bj] = 0; }
            else if (cg < 3424) { base[bj] = 104u << 20; ld[bj] = 896; cc[bj] = col - 2528; kind[bj] = 0; }
            else if (cg < 3456) { base[bj] = 0u; ld[bj] = 32; cc[bj] = col - 3424; kind[bj] = 1; }
            else { base[bj] = 0u; ld[bj] = 0; cc[bj] = 0; kind[bj] = 2; }
        }
#pragma unroll
        for (int ai = 0; ai < 2; ++ai)
#pragma unroll
            for (int m = 0; m < 4; ++m) {
                const int row = row0 + ai * HALF + m * 16;
                const f32x4* rp = (const f32x4*)(rowss + (size_t)row * 16);
                const f32x4 s0 = rp[0], s1 = rp[1], s2 = rp[2], s3 = rp[3];
                const float ss = ((s0[0] + s0[1]) + (s0[2] + s0[3])) + ((s1[0] + s1[1]) + (s1[2] + s1[3])) + ((s2[0] + s2[1]) + (s2[2] + s2[3])) + ((s3[0] + s3[1]) + (s3[2] + s3[3]));
                const float rstd = __builtin_amdgcn_rsqf(ss * (1.0f / 1024.0f) + 1e-6f);
#pragma unroll
                for (int bj = 0; bj < 2; ++bj) {
                    const f32x4 v0 = acc[ai][bj][m][0] * rstd, v1 = acc[ai][bj][m][1] * rstd;
                    if (kind[bj] == 0) { u32x4 w; w.x = cvt_pk_bf16(v0[0], v0[1]); w.y = cvt_pk_bf16(v0[2], v0[3]); w.z = cvt_pk_bf16(v1[0], v1[1]); w.w = cvt_pk_bf16(v1[2], v1[3]);
                        *(u32x4*)((bf16_t*)(ws + base[bj]) + (size_t)row * ld[bj] + cc[bj]) = w; }
                    else if (kind[bj] == 1) { float* p = Psm + (size_t)row * 32 + cc[bj]; *(f32x4*)p = v0; *(f32x4*)(p + 4) = v1; }
                }
                asm volatile("" ::: "memory");
            }
    }
};
struct EpiOut {
    static constexpr bool PERM = false, AFTER_DRAIN = false;
    const float* xin; float* xout; unsigned char* ws;
    __device__ __forceinline__ void operator()(const f32x4 (&acc)[2][2][4][2], const Unit& u, int wr, int wc, int fr, int fq) const {
        typedef unsigned u32x2v __attribute__((ext_vector_type(2)));
        const int row0 = u.pm * BM + wr * 64 + fr, col0 = u.pn * BM + wc * 32 + 4 * fq;
        float* rowss = (float*)(ws + (1u << 20)); bf16_t* xb = (bf16_t*)(ws + (133u << 20));
#pragma unroll
        for (int ai = 0; ai < 2; ++ai)
#pragma unroll
            for (int m = 0; m < 4; ++m) {
                const int row = row0 + ai * HALF + m * 16; float ss = 0.f;
#pragma unroll
                for (int bj = 0; bj < 2; ++bj)
#pragma unroll
                    for (int n = 0; n < 2; ++n) {
                        const size_t off = (size_t)row * 1024 + col0 + bj * HALF + n * 16;
                        const f32x4 o = *(const f32x4*)(xin + off) + acc[ai][bj][m][n];
                        *(f32x4*)(xout + off) = o;
                        u32x2v w; w.x = cvt_pk_bf16(o[0], o[1]); w.y = cvt_pk_bf16(o[2], o[3]); *(u32x2v*)(xb + off) = w;
                        ss += (o[0] * o[0] + o[1] * o[1]) + (o[2] * o[2] + o[3] * o[3]);
                    }
                ss += __shfl_xor(ss, 16); ss += __shfl_xor(ss, 32);
                if (fq == 0) rowss[(size_t)row * 16 + u.pn * 4 + wc] = ss;
                asm volatile("" ::: "memory");
            }
    }
};
template <class Epi, class Sched, bool ALIGN_EPI = false, bool SP2 = false>
__device__ __forceinline__ void gemm_phase(PG8_LAS unsigned char* lds, const Gemm g, const Sched& S, const Epi& E) {
    const int tid_ = mk_tid(lds);
    const int tid = tid_, wid = __builtin_amdgcn_readfirstlane(tid >> 6), lane = tid & 63, wr = wid >> 2, wc = wid & 3, fr = lane & 15, fq = lane >> 4;
    const int K = g.K, nt = K / BK;
    unsigned voffA[2], voffB[2];
#pragma unroll
    for (int i = 0; i < 2; ++i) { int R, C; stage_rc(tid * 16 + i * 8192, R, C); const int Rb = Epi::PERM ? ((R & ~31) + perm32(R & 31)) : R;
        voffA[i] = (unsigned)(R * K + C) * 2u; voffB[i] = (unsigned)(Rb * K + C) * 2u; }
    const size_t kstep = (size_t)(BK * 2);
    const size_t hstep = (size_t)HALF * K * 2;
    const size_t tstep = 2 * hstep;
    const unsigned ldsw = (unsigned)wid * 1024u;
    const int aoff = lds_byte(wr * 64 + fr, fq * 8), boff = lds_byte(wc * 32 + fr, fq * 8);
#define PG8_SA(b, h) (((b) * 2 + (h)) * HTB)
#define PG8_SB(b, h) ((4 + (b) * 2 + (h)) * HTB)
#define PG8_STAGE(bufoff, gbase, voff) do { _Pragma("unroll") for (int _i = 0; _i < 2; ++_i) \
        __builtin_amdgcn_global_load_lds((const unsigned*)((const char*)(gbase) + (voff)[_i]), (PG8_LAS unsigned*)(lds + (bufoff) + ldsw + _i * 8192), 16, 0, 0); } while (0)
#define PG8_LDA(dst, b, h) do { _Pragma("unroll") for (int m = 0; m < 4; ++m) _Pragma("unroll") for (int k = 0; k < 2; ++k) dst[m][k] = *(const PG8_LAS bf16x8*)(lds + PG8_SA(b, h) + aoff + m * 2048 + k * 1024); } while (0)
#define PG8_LDB(dst, b, h) do { _Pragma("unroll") for (int n = 0; n < 2; ++n) _Pragma("unroll") for (int k = 0; k < 2; ++k) dst[n][k] = *(const PG8_LAS bf16x8*)(lds + PG8_SB(b, h) + boff + n * 2048 + k * 1024); } while (0)
#define PG8_MMA(ai, bj, At, Bt) do { __builtin_amdgcn_s_setprio(1); _Pragma("unroll") for (int m = 0; m < 4; ++m) _Pragma("unroll") for (int n = 0; n < 2; ++n) _Pragma("unroll") for (int k = 0; k < 2; ++k) \
        acc[ai][bj][m][n] = __builtin_amdgcn_mfma_f32_16x16x32_bf16(Bt[n][k], At[m][k], acc[ai][bj][m][n], 0, 0, 0); __builtin_amdgcn_s_setprio(0); } while (0)
#define PG8_WAIT_V(n) asm volatile("s_waitcnt vmcnt(" #n ")" ::: "memory")
#define PG8_WAIT_L(n) asm volatile("s_waitcnt lgkmcnt(" #n ")" ::: "memory")
#define PG8_BAR __builtin_amdgcn_s_barrier()
#define PG8_SCHED __builtin_amdgcn_sched_barrier(0)
    Unit cur, nxt; int ui = 0;
    if (!S.next(0, cur)) return;
    f32x4 acc[2][2][4][2];
#pragma unroll
    for (int a = 0; a < 2; ++a)
#pragma unroll
        for (int b = 0; b < 2; ++b)
#pragma unroll
            for (int m = 0; m < 4; ++m)
#pragma unroll
                for (int n = 0; n < 2; ++n) acc[a][b][m][n] = (f32x4){0.f, 0.f, 0.f, 0.f};
    bf16x8 At[4][2], B0[2][2], B1[2][2];
    const char* cA = (const char*)g.A + (size_t)cur.pm * tstep; const char* cB = (const char*)g.Bt + (size_t)cur.pn * tstep;
    S.a_ready(cur);
    if constexpr (SP2) {
        PG8_STAGE(PG8_SB(0, 0), cB, voffB); PG8_STAGE(PG8_SB(0, 1), cB + hstep, voffB); PG8_STAGE(PG8_SA(0, 0), cA, voffA); PG8_STAGE(PG8_SA(0, 1), cA + hstep, voffA);
        if (wr == 1) PG8_BAR;
        PG8_WAIT_V(2); PG8_BAR;
        PG8_STAGE(PG8_SB(1, 0), cB + kstep, voffB); PG8_STAGE(PG8_SA(1, 0), cA + kstep, voffA); PG8_STAGE(PG8_SB(1, 1), cB + hstep + kstep, voffB);
        PG8_WAIT_V(6); PG8_BAR;
    } else {
        PG8_STAGE(PG8_SB(0, 0), cB, voffB); PG8_STAGE(PG8_SA(0, 0), cA, voffA); PG8_STAGE(PG8_SB(0, 1), cB + hstep, voffB); PG8_STAGE(PG8_SA(0, 1), cA + hstep, voffA);
        if (wr == 1) PG8_BAR;
        PG8_WAIT_V(4); PG8_BAR;
        PG8_STAGE(PG8_SB(1, 0), cB + kstep, voffB); PG8_STAGE(PG8_SA(1, 0), cA + kstep, voffA); PG8_STAGE(PG8_SB(1, 1), cB + hstep + kstep, voffB);
        PG8_WAIT_V(6); PG8_BAR;
    }
    for (;;) {
        const bool has_next = S.next(ui + 1, nxt);
        const char* nA = has_next ? (const char*)g.A + (size_t)nxt.pm * tstep : cA; const char* nB = has_next ? (const char*)g.Bt + (size_t)nxt.pn * tstep : cB;
        for (int t = 0; t < nt; t += 2) {
            const bool last = (t == nt - 2);
            const char* a1 = cA + (size_t)(t + 1) * kstep;
            const char* a2 = last ? nA : cA + (size_t)(t + 2) * kstep; const char* b2 = last ? nB : cB + (size_t)(t + 2) * kstep;
            const char* a3 = a2 + kstep; const char* b3 = b2 + kstep;
            if (last && has_next) S.a_ready(nxt);
            if constexpr (SP2) {
            PG8_LDB(B0, 0, 0); PG8_LDB(B1, 0, 1); PG8_SCHED; PG8_LDA(At, 0, 0); PG8_STAGE(PG8_SA(1, 1), a1 + hstep, voffA);
            PG8_WAIT_V(8); PG8_WAIT_L(0); PG8_BAR; PG8_MMA(0, 0, At, B0); PG8_MMA(0, 1, At, B1); PG8_BAR; PG8_SCHED;
            PG8_LDA(At, 0, 1); PG8_STAGE(PG8_SB(0, 0), b2, voffB); PG8_STAGE(PG8_SB(0, 1), b2 + hstep, voffB); PG8_STAGE(PG8_SA(0, 0), a2, voffA);
            PG8_WAIT_V(8); PG8_WAIT_L(0); PG8_BAR; PG8_MMA(1, 0, At, B0); PG8_MMA(1, 1, At, B1); PG8_BAR; PG8_SCHED;
            PG8_LDB(B0, 1, 0); PG8_LDB(B1, 1, 1); PG8_SCHED; PG8_LDA(At, 1, 0); PG8_STAGE(PG8_SA(0, 1), a2 + hstep, voffA);
            PG8_WAIT_V(8); PG8_WAIT_L(0); PG8_BAR; PG8_MMA(0, 0, At, B0); PG8_MMA(0, 1, At, B1); PG8_BAR; PG8_SCHED;
            PG8_LDA(At, 1, 1); PG8_STAGE(PG8_SB(1, 0), b3, voffB); PG8_STAGE(PG8_SB(1, 1), b3 + hstep, voffB); PG8_STAGE(PG8_SA(1, 0), a3, voffA);
            PG8_WAIT_V(8); PG8_WAIT_L(0); PG8_BAR; PG8_MMA(1, 0, At, B0); PG8_MMA(1, 1, At, B1); PG8_BAR; PG8_SCHED;
            } else {
            PG8_LDB(B0, 0, 0); PG8_SCHED; PG8_LDA(At, 0, 0); PG8_STAGE(PG8_SA(1, 1), a1 + hstep, voffA);
            PG8_WAIT_L(8); PG8_BAR; PG8_WAIT_L(0); PG8_MMA(0, 0, At, B0); PG8_BAR; PG8_SCHED;
            PG8_LDB(B1, 0, 1); PG8_STAGE(PG8_SB(0, 0), b2, voffB);
            PG8_BAR; PG8_WAIT_L(0); PG8_MMA(0, 1, At, B1); PG8_BAR;
            PG8_LDA(At, 0, 1); PG8_STAGE(PG8_SA(0, 0), a2, voffA);
            PG8_BAR; PG8_WAIT_L(0); PG8_MMA(1, 0, At, B0); PG8_BAR; PG8_SCHED;
            PG8_STAGE(PG8_SB(0, 1), b2 + hstep, voffB);
            PG8_WAIT_V(6); PG8_BAR; PG8_MMA(1, 1, At, B1); PG8_BAR;
            PG8_LDB(B0, 1, 0); PG8_SCHED; PG8_LDA(At, 1, 0); PG8_STAGE(PG8_SA(0, 1), a2 + hstep, voffA);
            PG8_WAIT_L(8); PG8_BAR; PG8_WAIT_L(0); PG8_MMA(0, 0, At, B0); PG8_BAR; PG8_SCHED;
            PG8_LDB(B1, 1, 1); PG8_STAGE(PG8_SB(1, 0), b3, voffB);
            PG8_BAR; PG8_WAIT_L(0); PG8_MMA(0, 1, At, B1); PG8_BAR;
            PG8_LDA(At, 1, 1); PG8_STAGE(PG8_SA(1, 0), a3, voffA);
            PG8_BAR; PG8_WAIT_L(0); PG8_MMA(1, 0, At, B0); PG8_BAR; PG8_SCHED;
            PG8_STAGE(PG8_SB(1, 1), b3 + hstep, voffB);
            PG8_WAIT_V(6); PG8_BAR; PG8_MMA(1, 1, At, B1); PG8_BAR;
            }
        }
        if constexpr (ALIGN_EPI) { if (wr == 0) PG8_BAR; }
        if constexpr (!Epi::AFTER_DRAIN) { E(acc, cur, wr, wc, fr, fq); S.done(cur); }
        if (!has_next) break;
#pragma unroll
        for (int a = 0; a < 2; ++a)
#pragma unroll
            for (int b = 0; b < 2; ++b)
#pragma unroll
                for (int m = 0; m < 4; ++m)
#pragma unroll
                    for (int n = 0; n < 2; ++n) acc[a][b][m][n] = (f32x4){0.f, 0.f, 0.f, 0.f};
        cur = nxt; cA = nA; cB = nB; ++ui;
        if constexpr (ALIGN_EPI) { if (wr == 1) PG8_BAR; }
    }
    PG8_WAIT_V(0);
    if constexpr (!ALIGN_EPI) { if (wr == 0) PG8_BAR; }
    PG8_BAR;
    if constexpr (Epi::AFTER_DRAIN) { E.fused(acc, cur, wr, wc, fr, fq, lds, wid, lane); S.done(cur); }
#undef PG8_SA
#undef PG8_SB
#undef PG8_STAGE
#undef PG8_LDA
#undef PG8_LDB
#undef PG8_MMA
#undef PG8_WAIT_V
#undef PG8_WAIT_L
#undef PG8_BAR
#undef PG8_SCHED
}
}
#define GAS __attribute__((address_space(1)))
#define LAS __attribute__((address_space(3)))
typedef unsigned short bf16;
typedef unsigned v4u __attribute__((ext_vector_type(4)));
typedef float f32x4 __attribute__((ext_vector_type(4)));
typedef short bf16x8 __attribute__((ext_vector_type(8)));
typedef GAS unsigned gu32;
typedef GAS unsigned long long gu64;
#define RLX_AGENT __ATOMIC_RELAXED, __HIP_MEMORY_SCOPE_AGENT
#define LDS_WAIT() asm volatile("s_waitcnt lgkmcnt(0)" ::: "memory")
#define VM_WAIT() asm volatile("s_waitcnt vmcnt(0)" ::: "memory")
__device__ __forceinline__ unsigned long long rt() { return __builtin_amdgcn_s_memrealtime(); }
__device__ __forceinline__ unsigned f2bf(float f) { unsigned u = __builtin_bit_cast(unsigned, f); return (u + 0x7fffu + ((u >> 16) & 1u)) >> 16; }
__device__ __forceinline__ unsigned pk2(float lo, float hi) { return f2bf(lo) | (f2bf(hi) << 16); }

#define XB_TMO      128
#define XB_XCNT(j)  (256  + 64 * (j))
#define XB_XSUB(j)  (1280 + 64 * (j))
#define XB_XGEN(j)  (2304 + 64 * (j))
#define XB_TOP      3328
#define XB_TOPGEN   3392
#define XCD_BAR_WORDS 3456
#define XB_SPIN_CAP (1u << 18)

__device__ __forceinline__ unsigned xb_ld(unsigned* p)              { return __hip_atomic_load(p, __ATOMIC_RELAXED, __HIP_MEMORY_SCOPE_AGENT); }
__device__ __forceinline__ unsigned xb_add(unsigned* p, unsigned v) { return __hip_atomic_fetch_add(p, v, __ATOMIC_RELAXED, __HIP_MEMORY_SCOPE_AGENT); }
__device__ __forceinline__ unsigned xb_xcc_id() { return (unsigned)__builtin_amdgcn_s_getreg((3 << 11) | 20) & 0xFu; }
#define XB_SPIN(cond, bar) do { unsigned _sp = 0; while (cond) { __builtin_amdgcn_s_sleep(1); \
    if ((++_sp & 255u) == 0u) { if (xb_ld(&(bar)[XB_TMO])) break; if (_sp > XB_SPIN_CAP) { atomicAdd(&(bar)[XB_TMO], 1u); break; } } } } while (0)

struct XcdBarrier {
    unsigned* bar; unsigned x;
    volatile LAS unsigned* st;
};

__device__ __forceinline__ XcdBarrier xcd_barrier_post(unsigned* bar, volatile LAS unsigned* st) {
    XcdBarrier b; b.bar = bar; b.x = xb_xcc_id(); b.st = st;
    if (threadIdx.x == 0) (void)xb_add(&bar[XB_XCNT(b.x)], 1u);
    return b;
}
__device__ __forceinline__ void xcd_barrier_complete(unsigned* bar, unsigned x, unsigned& nloc, unsigned& nx) {
    const unsigned G = gridDim.x * gridDim.y * gridDim.z;
    unsigned sum, cnt, mine, sp = 0u;
    for (;;) {
        sum = 0u; cnt = 0u; mine = 0u;
#pragma unroll
        for (unsigned j = 0; j < 16; ++j) { const unsigned c = xb_ld(&bar[XB_XCNT(j)]); sum += c; cnt += (c > 0u) ? 1u : 0u; mine = (j == x) ? c : mine; }
        if (sum == G) break;
        __builtin_amdgcn_s_sleep(1);
        if ((++sp & 255u) == 0u) { if (xb_ld(&bar[XB_TMO])) break; if (sp > XB_SPIN_CAP) { atomicAdd(&bar[XB_TMO], 1u); break; } }
    }
    nloc = mine > 0u ? mine : 1u; nx = cnt > 0u ? cnt : 1u;
}

__device__ __forceinline__ void xcd_barrier(const XcdBarrier& b) {
    asm volatile("s_waitcnt vmcnt(0)" ::: "memory");
    __syncthreads();
    if (pg8::mk_tid((LAS unsigned char*)b.st - (131072 + 320 + 32)) == 0) {
        unsigned* bar = b.bar;
        __builtin_amdgcn_s_waitcnt(0);
        unsigned nloc = b.st[0], nx = b.st[1];
        if (nloc == 0u) { xcd_barrier_complete(bar, b.x, nloc, nx); b.st[0] = nloc; b.st[1] = nx; }
        const unsigned old = xb_add(&bar[XB_XSUB(b.x)], 1u);
        const unsigned gen = old / nloc;
        if (old + 1u == (gen + 1u) * nloc) {
            __builtin_amdgcn_fence(__ATOMIC_RELEASE, "agent");
            asm volatile("s_waitcnt vmcnt(0)" ::: "memory");
            const unsigned og = xb_add(&bar[XB_TOP], 1u);
            const unsigned tg = og / nx;
            if (og + 1u == (tg + 1u) * nx) xb_add(&bar[XB_TOPGEN], 1u);
            else XB_SPIN(xb_ld(&bar[XB_TOPGEN]) == tg, bar);
            __builtin_amdgcn_fence(__ATOMIC_ACQUIRE, "agent");
            xb_add(&bar[XB_XGEN(b.x)], 1u);
            asm volatile("s_waitcnt vmcnt(0)" ::: "memory");
        } else {
            XB_SPIN(xb_ld(&bar[XB_XGEN(b.x)]) == gen, bar);
            __builtin_amdgcn_fence(__ATOMIC_ACQUIRE, "agent");
            asm volatile("s_waitcnt vmcnt(0)" ::: "memory");
        }
    }
    __syncthreads();
}
constexpr int BATCH = 8, SEQ = 2048, M = BATCH * SEQ, D = 1024, NIN = 3448, NP = 3584;
constexpr float NORM_EPS = 1e-6f;
constexpr float LOG2E = 1.4426950408889634f;
constexpr size_t MiB = 1u << 20;
constexpr size_t WS_CTL = 0, CTL_ZERO_BYTES = 1 * MiB;
constexpr size_t WS_ROWSS = 1 * MiB;
constexpr size_t WS_WIN = 2 * MiB;
constexpr size_t WS_WOUT = 16 * MiB;
constexpr size_t WS_WSMALL = 20 * MiB;
constexpr size_t OFF_WUQ = 0, OFF_WUKV = 2 * 576 * 192 * 2, OFF_W2T = OFF_WUKV + 2 * 768 * 128 * 2, OFF_A2T = OFF_W2T + 2 * 2 * 256 * 64 * 2;
constexpr size_t WS_PSM = 22 * MiB;
constexpr size_t WS_CB = 24 * MiB;
constexpr size_t WS_PGATE = 25 * MiB;
constexpr size_t WS_PGDN = 57 * MiB;
constexpr size_t WS_PMLA = 93 * MiB;
constexpr size_t WS_PRW = 104 * MiB;
constexpr size_t WS_OGDN = 93 * MiB;
constexpr size_t WS_OMLA = 105 * MiB;
constexpr size_t WS_Y = 117 * MiB;
constexpr size_t WS_RS = 133 * MiB;
constexpr size_t WS_RD = 157 * MiB;
constexpr size_t WS_XB = 133 * MiB;
constexpr size_t WS_Q = 207 * MiB;
constexpr size_t WS_K = 225 * MiB;
constexpr size_t WS_VT = 243 * MiB;
constexpr size_t WS_MIX = 207 * MiB;
constexpr size_t WS_END = 255 * MiB;
constexpr int RS_REC = 384, RD_REC = 400;
constexpr size_t RD_DIR = (size_t)BATCH * 4 * SEQ * RD_REC;
constexpr int CW_BAR = 4096;
constexpr int CW_QUEUE = 16384;

constexpr int NWAVES = 8;
constexpr int RING_OFF = 0, RING_BYTES = 131072, LDSCTL_OFF = RING_BYTES, MISC_OFF = LDSCTL_OFF + 320, LDS_BYTES = 147456;
static_assert(pg8::TIDTAB_OFF == MISC_OFF + 512 && RING_OFF == 0, "LDS map");
constexpr int NPHASE = 12;

__device__ __forceinline__ float bf2f(bf16 v) { return __uint_as_float(((unsigned)v) << 16); }
__device__ __forceinline__ float wave_sum(float v) {
#pragma unroll
    for (int o = 1; o < 64; o <<= 1) v += __shfl_xor(v, o);
    return v;
}
__device__ __forceinline__ float siluf(float x) { return x / (1.f + __expf(-x)); }
__device__ __forceinline__ float sigmoidf_(float x) { return 1.f / (1.f + __expf(-x)); }
__device__ __forceinline__ float softplusf_(float x) { return x > 20.f ? x : log1pf(__expf(x)); }

struct Args { const void* in[24]; float* out; unsigned char* ws; int ph_lo, ph_hi; };

struct Frame {
    LAS unsigned char* lds;
    volatile LAS unsigned* MISC;
    gu32* ctl;
    int tid, lane, wave, vcu, G;
    unsigned char* ws;
    float* out;
    LAS const unsigned long long* ptab;
};
__device__ __forceinline__ const void* inptr(const Frame& F, int k) {
    const unsigned long long v = F.ptab[k];
    const unsigned lo = __builtin_amdgcn_readfirstlane((unsigned)v), hi = __builtin_amdgcn_readfirstlane((unsigned)(v >> 32));
    return (const void*)(((unsigned long long)hi << 32) | lo);
}

__device__ __forceinline__ void tr_item(const float* W, int K, int ldsrc, int scol, int nvalid, bf16* WT, const float* gs, LAS float* scr, int kb, int lane) {
    const int k0 = 64 * kb;
#pragma unroll 8
    for (int i = 0; i < 32; ++i) { const int kk = 2 * i + (lane >> 5), n = lane & 31; float v = 0.f;
        if (n < nvalid) { v = W[(size_t)(k0 + kk) * ldsrc + scol + n]; if (gs) v *= gs[k0 + kk]; }
        scr[kk * 33 + n] = v; }
    LDS_WAIT(); asm volatile("" ::: "memory");
    const int c = lane & 7;
#pragma unroll
    for (int j = 0; j < 4; ++j) { const int n = (lane >> 3) + 8 * j; const LAS float* s = scr + (8 * c) * 33 + n;
        v4u o; o.x = pk2(s[0 * 33], s[1 * 33]); o.y = pk2(s[2 * 33], s[3 * 33]); o.z = pk2(s[4 * 33], s[5 * 33]); o.w = pk2(s[6 * 33], s[7 * 33]);
        *(GAS v4u*)(WT + (size_t)n * K + k0 + 8 * c) = o; }
    LDS_WAIT(); asm volatile("" ::: "memory");
}
__device__ __forceinline__ void p0_prologue(Frame& F) {
    LAS float* scr = (LAS float*)(F.lds + RING_OFF + F.wave * 16384);
    const int gw = F.vcu * NWAVES + F.wave, NGW = F.G * NWAVES;
    constexpr int I_IN = 112 * 16, I_OUT = 32 * 16, I_UQ = 18 * 3, I_UKV = 24 * 2, I_W2 = 16, I_A2 = 16, I_L = I_IN + I_OUT + I_UQ + I_UKV + I_W2 + I_A2;
    for (int it = gw; it < 2 * I_L; it += NGW) {
        const int l = it / I_L; int r = it % I_L;
        if (r < I_IN) { const int nb = r >> 4, kb = r & 15, n0 = 32 * nb; int scol, nv;
            if (n0 < 2176) { scol = n0; nv = 32; } else if (n0 < 3424) { scol = n0 + 24; nv = 32; } else if (n0 == 3424) { scol = 2176; nv = 24; } else { scol = 0; nv = 0; }
            tr_item((const float*)inptr(F, 3) + (size_t)l * D * NIN, D, NIN, scol, nv, (bf16*)(F.ws + WS_WIN) + ((size_t)l * NP + n0) * D, (const float*)inptr(F, 2) + l * D, scr, kb, F.lane); continue; }
        r -= I_IN;
        if (r < I_OUT) { const int nb = r >> 4, kb = r & 15;
            tr_item((const float*)inptr(F, 22) + (size_t)l * D * D, D, D, 32 * nb, 32, (bf16*)(F.ws + WS_WOUT) + ((size_t)l * D + 32 * nb) * D, nullptr, scr, kb, F.lane); continue; }
        r -= I_OUT;
        if (r < I_UQ) { const int nb = r / 3, kb = r % 3;
            tr_item((const float*)inptr(F, 9) + (size_t)l * 192 * 576, 192, 576, 32 * nb, 32, (bf16*)(F.ws + WS_WSMALL + OFF_WUQ) + ((size_t)l * 576 + 32 * nb) * 192, (const float*)inptr(F, 8) + l * 192, scr, kb, F.lane); continue; }
        r -= I_UQ;
        if (r < I_UKV) { const int nb = r >> 1, kb = r & 1;
            tr_item((const float*)inptr(F, 11) + (size_t)l * 128 * 768, 128, 768, 32 * nb, 32, (bf16*)(F.ws + WS_WSMALL + OFF_WUKV) + ((size_t)l * 768 + 32 * nb) * 128, (const float*)inptr(F, 10) + l * 128, scr, kb, F.lane); continue; }
        r -= I_UKV;
        if (r < I_W2) { const int e = r >> 3, nb = r & 7;
            tr_item((const float*)inptr(F, 14) + ((size_t)l * 2 + e) * 64 * 256, 64, 256, 32 * nb, 32, (bf16*)(F.ws + WS_WSMALL + OFF_W2T) + (((size_t)l * 2 + e) * 256 + 32 * nb) * 64, nullptr, scr, 0, F.lane); continue; }
        r -= I_W2;
        { const int e = r >> 3, nb = r & 7;
            tr_item((const float*)inptr(F, 16) + ((size_t)l * 2 + e) * 64 * 256, 64, 256, 32 * nb, 32, (bf16*)(F.ws + WS_WSMALL + OFF_A2T) + (((size_t)l * 2 + e) * 256 + 32 * nb) * 64, nullptr, scr, 0, F.lane); }
    }
    const float* x = (const float*)inptr(F, 0); bf16* xb = (bf16*)(F.ws + WS_XB); float* rowss = (float*)(F.ws + WS_ROWSS);
    for (int m = gw; m < M; m += NGW) {
        const GAS f32x4* xr = (const GAS f32x4*)(x + (size_t)m * D) + F.lane;
        GAS unsigned long long* o8 = (GAS unsigned long long*)(xb + (size_t)m * D) + F.lane; float s = 0.f;
#pragma unroll
        for (int j = 0; j < 4; ++j) { const f32x4 v = xr[64 * j]; s += (v.x * v.x + v.y * v.y) + (v.z * v.z + v.w * v.w);
            o8[64 * j] = (unsigned long long)pk2(v.x, v.y) | ((unsigned long long)pk2(v.z, v.w) << 32); }
        s = wave_sum(s);
        if (F.lane < 16) rowss[(size_t)m * 16 + F.lane] = F.lane == 0 ? s : 0.f;
    }
}
__device__ __forceinline__ void p5_final(Frame& F) {
    const int gw = F.vcu * NWAVES + F.wave, NGW = F.G * NWAVES;
    const float* rowss = (const float*)(F.ws + WS_ROWSS); const float* g = (const float*)inptr(F, 23);
    f32x4 gv[4];
#pragma unroll
    for (int j = 0; j < 4; ++j) gv[j] = ((const f32x4*)g)[F.lane + 64 * j];
    for (int m = gw; m < M; m += NGW) {
        float ss = F.lane < 16 ? rowss[(size_t)m * 16 + F.lane] : 0.f;
        ss = wave_sum(ss);
        const float rstd = rsqrtf(ss * (1.f / D) + NORM_EPS);
        GAS f32x4* xr = (GAS f32x4*)(F.out + (size_t)m * D) + F.lane;
#pragma unroll
        for (int j = 0; j < 4; ++j) { f32x4 v = xr[64 * j]; v = v * rstd * gv[j]; xr[64 * j] = v; }
    }
}
__device__ __forceinline__ float dotbf(const bf16* a, const bf16* b, int K) {
    float acc = 0.f;
#pragma unroll 2
    for (int k = 0; k < K; k += 8) {
        const v4u av = *(const v4u*)(a + k), bv = *(const v4u*)(b + k);
#pragma unroll
        for (int i = 0; i < 4; ++i) {
            acc += __uint_as_float(av[i] << 16) * __uint_as_float(bv[i] << 16);
            acc += __uint_as_float(av[i] & 0xffff0000u) * __uint_as_float(bv[i] & 0xffff0000u);
        }
    }
    return acc;
}
__device__ __forceinline__ void p2_mla_token(Frame& F, int l, int m, LAS float* raw) {
    const bf16* Pmla = (const bf16*)(F.ws + WS_PMLA);
    const bf16* WuqT = (const bf16*)(F.ws + WS_WSMALL + OFF_WUQ) + (size_t)l * 576 * 192;
    const bf16* WukvT = (const bf16*)(F.ws + WS_WSMALL + OFF_WUKV) + (size_t)l * 768 * 128;
    bf16* Q = (bf16*)(F.ws + WS_Q); bf16* Kb = (bf16*)(F.ws + WS_K); bf16* Vt = (bf16*)(F.ws + WS_VT);
    const int lane = F.lane, b = m / SEQ, t = m % SEQ;
    const bf16* p = Pmla + (size_t)m * 352;
    float s1 = 0.f, s2 = 0.f;
    for (int c = lane; c < 192; c += 64) { const float v = bf2f(p[c]); s1 += v * v; }
    for (int c = lane; c < 128; c += 64) { const float v = bf2f(p[192 + c]); s2 += v * v; }
    s1 = wave_sum(s1); s2 = wave_sum(s2);
    const float rq = rsqrtf(s1 * (1.f / 192.f) + NORM_EPS), rkv = rsqrtf(s2 * (1.f / 128.f) + NORM_EPS);
#pragma unroll 1
    for (int c = lane; c < 576; c += 64) raw[c] = dotbf(p, WuqT + (size_t)c * 192, 192) * rq;
#pragma unroll 1
    for (int c = lane; c < 768; c += 64) raw[576 + c] = dotbf(p + 192, WukvT + (size_t)c * 128, 128) * rkv;
    LDS_WAIT(); asm volatile("" ::: "memory");
    const float pos = (float)((const int*)inptr(F, 1))[m];
    const float qs = 0.10206207261596575f * LOG2E;
#pragma unroll 1
    for (int i = lane; i < 6 * 80; i += 64) {
        const int h = i / 80, j = i % 80;
        bf16* qo = Q + (((size_t)b * 6 + h) * SEQ + t) * 96;
        if (j < 64) qo[j] = f2bf(raw[h * 96 + j] * qs);
        else { const int r = j - 64; const float inv = exp2f(-(float)r * (13.287712379549449f / 16.f)); float sn, cs; sincosf(pos * inv, &sn, &cs);
            const float x1 = raw[h * 96 + 64 + r], x2 = raw[h * 96 + 80 + r];
            qo[64 + r] = f2bf((x1 * cs - x2 * sn) * qs); qo[80 + r] = f2bf((x2 * cs + x1 * sn) * qs); }
    }
#pragma unroll 1
    for (int i = lane; i < 6 * 64; i += 64) {
        const int h = i / 64, j = i % 64;
        Kb[(((size_t)b * 6 + h) * SEQ + t) * 96 + j] = f2bf(raw[576 + h * 128 + j]);
        Vt[(((size_t)b * 6 + h) * 64 + j) * SEQ + t] = f2bf(raw[576 + h * 128 + 64 + j]);
    }
    if (lane < 16) {
        const int r = lane; const float inv = exp2f(-(float)r * (13.287712379549449f / 16.f)); float sn, cs; sincosf(pos * inv, &sn, &cs);
        const float x1 = bf2f(p[320 + r]), x2 = bf2f(p[336 + r]);
        const bf16 o1 = f2bf(x1 * cs - x2 * sn), o2 = f2bf(x2 * cs + x1 * sn);
        for (int h = 0; h < 6; ++h) { bf16* ko = Kb + (((size_t)b * 6 + h) * SEQ + t) * 96; ko[64 + r] = o1; ko[80 + r] = o2; }
    }
    LDS_WAIT(); asm volatile("" ::: "memory");
}
__device__ __forceinline__ void p2_rwkv_token(Frame& F, int l, int m, LAS float* f, int c) {
    const bf16* Prw = (const bf16*)(F.ws + WS_PRW);
    const float* mu = (const float*)inptr(F, 12) + l * 2 * 896; const float* w0 = (const float*)inptr(F, 13) + l * 512; const float* w2 = (const float*)inptr(F, 14) + (size_t)l * 2 * 64 * 256;
    const float* a0 = (const float*)inptr(F, 15) + l * 512; const float* a2 = (const float*)inptr(F, 16) + (size_t)l * 2 * 64 * 256;
    const float* k_k = (const float*)inptr(F, 17) + l * 256; const float* k_a = (const float*)inptr(F, 18) + l * 256; const float* r_k = (const float*)inptr(F, 19) + l * 256;
    unsigned char* Rs = F.ws + WS_RS; unsigned char* Rd = F.ws + WS_RD; float* cb = (float*)(F.ws + WS_CB);
    const int b = m / SEQ, t = m % SEQ, h = c >> 6, j = c & 63;
#pragma unroll 1
    for (int i = c; i < 896; i += 256) {
        const float x = bf2f(Prw[(size_t)m * 896 + i]);
        const float xp = t > 0 ? bf2f(Prw[(size_t)(m - 1) * 896 + i]) : 0.f;
        const float xn = t < SEQ - 1 ? bf2f(Prw[(size_t)(m + 1) * 896 + i]) : 0.f;
        float v = x + mu[i] * (xp - x) + mu[896 + i] * (xn - x);
        if (i >= 768 && i < 832) v = tanhf(v);
        f[i] = v;
    }
    __syncthreads();
    const float r = f[c], k = f[256 + c], v = f[512 + c];
    const float kkr = k * k_k[c];
    const float kn = wave_sum(kkr * kkr);
    const float kk = kkr * rsqrtf(kn + 1e-6f);
    float kmod[2], bb[2], lam[2];
#pragma unroll
    for (int e = 0; e < 2; ++e) {
        float lw = 0.f, la = 0.f;
#pragma unroll 8
        for (int d = 0; d < 64; ++d) { lw += f[768 + d] * w2[((size_t)e * 64 + d) * 256 + c]; la += f[832 + d] * a2[((size_t)e * 64 + d) * 256 + c]; }
        const float wl = -softplusf_(-(w0[e * 256 + c] + lw)) - 0.5f;
        lam[e] = __expf(wl);
        const float a = sigmoidf_(a0[e * 256 + c] + la);
        kmod[e] = k * (1.f + (a - 1.f) * k_a[c]);
        bb[e] = a * kk;
    }
    unsigned char* rs = Rs + (((size_t)b * 4 + h) * SEQ + t) * RS_REC;
    ((bf16*)rs)[j] = f2bf(kk); ((bf16*)(rs + 128))[j] = f2bf(v); ((bf16*)(rs + 256))[j] = f2bf(r);
#pragma unroll
    for (int e = 0; e < 2; ++e) {
        unsigned char* rd = Rd + e * RD_DIR + (((size_t)b * 4 + h) * SEQ + t) * RD_REC;
        ((__half*)rd)[j] = __float2half(lam[e]); ((bf16*)(rd + 128))[j] = f2bf(bb[e]); ((bf16*)(rd + 256))[j] = f2bf(kmod[e]);
        const float br = wave_sum(bb[e] * r), kr = wave_sum(kmod[e] * r);
        if (j == 0) { ((float*)(rd + 384))[0] = br; ((float*)(rd + 384))[1] = kr; }
    }
    const float cbv = wave_sum(r * 0.5f * (kmod[0] + kmod[1]) * r_k[c]);
    if (j == 0) cb[(size_t)m * 4 + h] = cbv;
    __syncthreads();
}
__device__ __forceinline__ void p2_prep(Frame& F, int l) {
    { LAS float* f = (LAS float*)(F.lds + RING_OFF) + (F.tid >> 8) * 896; const int c = F.tid & 255;
      for (int m = 2 * (int)blockIdx.x + (F.tid >> 8); m < M; m += 2 * F.G) p2_rwkv_token(F, l, m, f, c); }
    { LAS float* raw = (LAS float*)(F.lds + RING_OFF + 8192) + F.wave * 1344;
      const int gw = F.vcu * NWAVES + F.wave, NGW = F.G * NWAVES;
      for (int m = gw; m < M; m += NGW) p2_mla_token(F, l, m, raw); }
}
__device__ __forceinline__ void p4a_mix(Frame& F, int l) {
    const bf16* Ogdn = (const bf16*)(F.ws + WS_OGDN); const bf16* Omla = (const bf16*)(F.ws + WS_OMLA); const bf16* Y = (const bf16*)(F.ws + WS_Y);
    const bf16* Pgate = (const bf16*)(F.ws + WS_PGATE); const unsigned char* Rs = F.ws + WS_RS; const float* cb = (const float*)(F.ws + WS_CB); bf16* mix = (bf16*)(F.ws + WS_MIX);
    const float* gdn_g = (const float*)inptr(F, 7) + l * 64; const float* ln_g = (const float*)inptr(F, 20) + l * 256; const float* ln_b = (const float*)inptr(F, 21) + l * 256;
    const int gw = F.vcu * NWAVES + F.wave, NGW = F.G * NWAVES, j = F.lane;
    const float gg = gdn_g[j];
    for (int m = gw; m < M; m += NGW) {
        const int b = m / SEQ, t = m % SEQ;
#pragma unroll 2
        for (int g = 0; g < 16; ++g) {
            const int c = g * 64 + j; float val;
            if (g < 6) { const float o = bf2f(Ogdn[(size_t)m * 384 + c]); const float ss = wave_sum(o * o); val = o * rsqrtf(ss * (1.f / 64.f) + NORM_EPS) * gg; }
            else if (g < 12) val = bf2f(Omla[(size_t)m * 384 + (c - 384)]);
            else { const int cc = c - 768, h = g - 12; const float y = bf2f(Y[(size_t)m * 256 + cc]);
                const float mean = wave_sum(y) * (1.f / 64.f); const float dv = y - mean; const float var = wave_sum(dv * dv) * (1.f / 64.f);
                const float v = bf2f(((const bf16*)(Rs + (((size_t)b * 4 + h) * SEQ + t) * RS_REC + 128))[j]);
                val = dv * rsqrtf(var + 64e-5f) * ln_g[cc] + ln_b[cc] + cb[(size_t)m * 4 + h] * v; }
            mix[(size_t)m * 1024 + c] = f2bf(val * siluf(bf2f(Pgate[(size_t)m * 1024 + c])));
        }
    }
}
typedef float f32x16 __attribute__((ext_vector_type(16)));
typedef unsigned long long u64_t;
__device__ __forceinline__ bf16x8 mk_bf16x8(u64_t lo, u64_t hi) { typedef u64_t u64x2 __attribute__((ext_vector_type(2))); u64x2 v = {lo, hi}; return __builtin_bit_cast(bf16x8, v); }

constexpr int AT_KP = 208, AT_VP = 136, AT_KBYTES = 64 * AT_KP, AT_VBYTES = 64 * AT_VP, AT_BUF = AT_KBYTES + AT_VBYTES;
__device__ __forceinline__ void attn_unit(Frame& F, int unit) {
    const int bh = unit >> 3, qb = unit & 7, b = bh / 6, h = bh % 6;
    const int tid = F.tid, lane = F.lane, wave = F.wave, r32 = lane & 31, hi = lane >> 5;
    const bf16* Qg = (const bf16*)(F.ws + WS_Q) + ((size_t)bh * SEQ + qb * 256 + wave * 32 + r32) * 96;
    const bf16* Kg = (const bf16*)(F.ws + WS_K) + (size_t)bh * SEQ * 96;
    const bf16* Vg = (const bf16*)(F.ws + WS_VT) + (size_t)bh * 64 * SEQ;
    LAS unsigned char* lds = F.lds + RING_OFF;
    bf16x8 qf[6];
#pragma unroll
    for (int s = 0; s < 6; ++s) qf[s] = *(const bf16x8*)(Qg + 16 * s + 8 * hi);
    const int kr0 = tid / 12, kc0 = tid % 12, kr1 = (512 + tid) / 12, kc1 = (512 + tid) % 12, vd = tid >> 3, vc = tid & 7;
    const bool has1 = tid < 256;
    v4u kreg0, kreg1 = {0u, 0u, 0u, 0u}, vreg;
#define AT_LOAD(t0) do { kreg0 = *(const v4u*)(Kg + (size_t)((t0) + kr0) * 96 + kc0 * 8); if (has1) kreg1 = *(const v4u*)(Kg + (size_t)((t0) + kr1) * 96 + kc1 * 8); \
        vreg = *(const v4u*)(Vg + (size_t)vd * SEQ + (t0) + vc * 8); } while (0)
#define AT_STORE(buf) do { LAS unsigned char* bb_ = lds + (buf) * AT_BUF; *(LAS v4u*)(bb_ + kr0 * AT_KP + kc0 * 16) = kreg0; if (has1) *(LAS v4u*)(bb_ + kr1 * AT_KP + kc1 * 16) = kreg1; \
        LAS u64_t* vp_ = (LAS u64_t*)(bb_ + AT_KBYTES + vd * AT_VP + vc * 16); vp_[0] = (u64_t)vreg.x | ((u64_t)vreg.y << 32); vp_[1] = (u64_t)vreg.z | ((u64_t)vreg.w << 32); } while (0)
    AT_LOAD(0); AT_STORE(0);
    __syncthreads();
    f32x16 o0 = {}, o1 = {};
    float mrun = -1e30f, lsum = 0.f;
    for (int t = 0; t < SEQ / 64; ++t) {
        if (t + 1 < SEQ / 64) AT_LOAD((t + 1) * 64);
        LAS unsigned char* bb = lds + (t & 1) * AT_BUF;
        f32x16 p0 = {}, p1 = {};
        { const LAS unsigned char* kb = bb + r32 * AT_KP + hi * 16;
#pragma unroll
          for (int s = 0; s < 6; ++s) {
              const bf16x8 a0 = *(const LAS bf16x8*)(kb + 32 * s), a1 = *(const LAS bf16x8*)(kb + 32 * AT_KP + 32 * s);
              p0 = __builtin_amdgcn_mfma_f32_32x32x16_bf16(a0, qf[s], p0, 0, 0, 0);
              p1 = __builtin_amdgcn_mfma_f32_32x32x16_bf16(a1, qf[s], p1, 0, 0, 0); } }
        float mloc = fmaxf(p0[0], p1[0]);
#pragma unroll
        for (int r = 1; r < 16; ++r) mloc = fmaxf(mloc, fmaxf(p0[r], p1[r]));
        mloc = fmaxf(mloc, __shfl_xor(mloc, 32));
        const float mnew = fmaxf(mrun, mloc), alpha = __builtin_amdgcn_exp2f(mrun - mnew);
        mrun = mnew; lsum *= alpha;
#pragma unroll
        for (int r = 0; r < 16; ++r) { o0[r] *= alpha; o1[r] *= alpha; }
        float ps = 0.f;
#pragma unroll
        for (int r = 0; r < 16; ++r) { p0[r] = __builtin_amdgcn_exp2f(p0[r] - mnew); p1[r] = __builtin_amdgcn_exp2f(p1[r] - mnew); ps += p0[r] + p1[r]; }
        lsum += ps;
        v4u pk[4];
#pragma unroll
        for (int s2 = 0; s2 < 2; ++s2) {
            pk[s2] = (v4u){pg8::cvt_pk_bf16(p0[8 * s2], p0[8 * s2 + 1]), pg8::cvt_pk_bf16(p0[8 * s2 + 2], p0[8 * s2 + 3]), pg8::cvt_pk_bf16(p0[8 * s2 + 4], p0[8 * s2 + 5]), pg8::cvt_pk_bf16(p0[8 * s2 + 6], p0[8 * s2 + 7])};
            pk[2 + s2] = (v4u){pg8::cvt_pk_bf16(p1[8 * s2], p1[8 * s2 + 1]), pg8::cvt_pk_bf16(p1[8 * s2 + 2], p1[8 * s2 + 3]), pg8::cvt_pk_bf16(p1[8 * s2 + 4], p1[8 * s2 + 5]), pg8::cvt_pk_bf16(p1[8 * s2 + 6], p1[8 * s2 + 7])};
        }
        { const LAS unsigned char* vb = bb + AT_KBYTES + r32 * AT_VP + hi * 8;
#pragma unroll
          for (int ks = 0; ks < 4; ++ks) {
              const bf16x8 pb = __builtin_bit_cast(bf16x8, pk[ks]);
              const bf16x8 v0 = mk_bf16x8(*(const LAS u64_t*)(vb + ks * 32), *(const LAS u64_t*)(vb + ks * 32 + 16));
              const bf16x8 v1 = mk_bf16x8(*(const LAS u64_t*)(vb + 32 * AT_VP + ks * 32), *(const LAS u64_t*)(vb + 32 * AT_VP + ks * 32 + 16));
              o0 = __builtin_amdgcn_mfma_f32_32x32x16_bf16(v0, pb, o0, 0, 0, 0);
              o1 = __builtin_amdgcn_mfma_f32_32x32x16_bf16(v1, pb, o1, 0, 0, 0); } }
        if (t + 1 < SEQ / 64) AT_STORE((t + 1) & 1);
        __syncthreads();
    }
#undef AT_LOAD
#undef AT_STORE
    lsum += __shfl_xor(lsum, 32);
    const float inv = 1.f / lsum;
    bf16* Og = (bf16*)(F.ws + WS_OMLA) + ((size_t)b * SEQ + qb * 256 + wave * 32 + r32) * 384 + h * 64 + 4 * hi;
#pragma unroll
    for (int rg = 0; rg < 4; ++rg) {
        *(u64_t*)(Og + 8 * rg) = (u64_t)pg8::cvt_pk_bf16(o0[4 * rg] * inv, o0[4 * rg + 1] * inv) | ((u64_t)pg8::cvt_pk_bf16(o0[4 * rg + 2] * inv, o0[4 * rg + 3] * inv) << 32);
        *(u64_t*)(Og + 32 + 8 * rg) = (u64_t)pg8::cvt_pk_bf16(o1[4 * rg] * inv, o1[4 * rg + 1] * inv) | ((u64_t)pg8::cvt_pk_bf16(o1[4 * rg + 2] * inv, o1[4 * rg + 3] * inv) << 32);
    }
}

constexpr int RW_STEP = 1440, RW_CH = 16, RW_DIRB = RW_CH * RW_STEP, RW_BUF = 2 * RW_DIRB;
constexpr int RW_Y = 2 * RW_BUF;
static_assert(RW_Y + 2 * 4096 <= RING_BYTES, "RWKV LDS map");
__device__ __forceinline__ float dpp_xor1(float x) { return __builtin_bit_cast(float, __builtin_amdgcn_update_dpp(0, __builtin_bit_cast(int, x), 0xB1, 0xF, 0xF, true)); }
__device__ __forceinline__ float dpp_xor2(float x) { return __builtin_bit_cast(float, __builtin_amdgcn_update_dpp(0, __builtin_bit_cast(int, x), 0x4E, 0xF, 0xF, true)); }
__device__ __forceinline__ float dpp_hmir(float x) { return __builtin_bit_cast(float, __builtin_amdgcn_update_dpp(0, __builtin_bit_cast(int, x), 0x141, 0xF, 0xF, true)); }
__device__ __forceinline__ void rwkv_unit(Frame& F, int unit) {
    const int bh = unit >> 1, rowhalf = unit & 1, b = bh >> 2, h = bh & 3;
    const int tid = F.tid, lane = F.lane, dir = F.wave >> 2, w4 = F.wave & 3, ri = lane >> 3, cs = lane & 7;
    const unsigned char* Rs = F.ws + WS_RS + (size_t)bh * SEQ * RS_REC;
    LAS unsigned char* lds = F.lds + RING_OFF;
    const int sd = tid >> 8, ss = (tid >> 4) & 15, sp = tid & 15;
    const unsigned char* Rds = F.ws + WS_RD + sd * RD_DIR + (size_t)bh * SEQ * RD_REC;
    u64_t g_kk, g_r, g_lam, g_b, g_k, g_v = 0, g_s = 0;
#define RW_ISSUE(c_) do { const int n_ = (c_) * RW_CH + ss, t_ = sd ? SEQ - 1 - n_ : n_; const unsigned char* rs_ = Rs + (size_t)t_ * RS_REC; const unsigned char* rd_ = Rds + (size_t)t_ * RD_REC; \
        g_kk = *(const u64_t*)(rs_ + 8 * sp); g_r = *(const u64_t*)(rs_ + 256 + 8 * sp); g_lam = *(const u64_t*)(rd_ + 8 * sp); g_b = *(const u64_t*)(rd_ + 128 + 8 * sp); g_k = *(const u64_t*)(rd_ + 256 + 8 * sp); \
        if (sp < 8) g_v = *(const u64_t*)(rs_ + 128 + 64 * rowhalf + 8 * sp); if (sp == 8) g_s = *(const u64_t*)(rd_ + 384); } while (0)
#define RW_BF(x, j) __uint_as_float(((unsigned)((x) >> (16 * (j)))) << 16)
#define RW_STAGE(buf_) do { LAS unsigned char* d_ = lds + (buf_) * RW_BUF + sd * RW_DIRB + ss * RW_STEP + 16 * sp; f32x4 w_, t_; \
        w_[0] = __builtin_amdgcn_exp2f(-LOG2E * __half2float(__ushort_as_half((unsigned short)(g_lam)))); w_[1] = __builtin_amdgcn_exp2f(-LOG2E * __half2float(__ushort_as_half((unsigned short)(g_lam >> 16)))); \
        w_[2] = __builtin_amdgcn_exp2f(-LOG2E * __half2float(__ushort_as_half((unsigned short)(g_lam >> 32)))); w_[3] = __builtin_amdgcn_exp2f(-LOG2E * __half2float(__ushort_as_half((unsigned short)(g_lam >> 48)))); \
        *(LAS f32x4*)d_ = w_; \
        t_ = (f32x4){RW_BF(g_r, 0), RW_BF(g_r, 1), RW_BF(g_r, 2), RW_BF(g_r, 3)}; *(LAS f32x4*)(d_ + 256) = w_ * t_; \
        t_ = (f32x4){RW_BF(g_kk, 0), RW_BF(g_kk, 1), RW_BF(g_kk, 2), RW_BF(g_kk, 3)}; *(LAS f32x4*)(d_ + 512) = -t_; \
        t_ = (f32x4){RW_BF(g_b, 0), RW_BF(g_b, 1), RW_BF(g_b, 2), RW_BF(g_b, 3)}; *(LAS f32x4*)(d_ + 768) = t_; \
        t_ = (f32x4){RW_BF(g_k, 0), RW_BF(g_k, 1), RW_BF(g_k, 2), RW_BF(g_k, 3)}; *(LAS f32x4*)(d_ + 1024) = t_; \
        if (sp < 8) { t_ = (f32x4){RW_BF(g_v, 0), RW_BF(g_v, 1), RW_BF(g_v, 2), RW_BF(g_v, 3)}; *(LAS f32x4*)(d_ + 1280) = t_; } \
        if (sp == 8) *(LAS u64_t*)(lds + (buf_) * RW_BUF + sd * RW_DIRB + ss * RW_STEP + 1408) = g_s; } while (0)
    float S[8];
#pragma unroll
    for (int j = 0; j < 8; ++j) S[j] = 0.f;
    RW_ISSUE(0); RW_STAGE(0);
    __syncthreads();
    bf16* Yg = (bf16*)(F.ws + WS_Y) + (size_t)b * SEQ * 256 + h * 64 + 32 * rowhalf;
    const int NCH = SEQ / RW_CH;
    for (int c = 0; c < NCH; ++c) {
        if (c + 1 < NCH) RW_ISSUE(c + 1);
        LAS float* ybuf = (LAS float*)(lds + RW_Y + (c & 1) * 4096);
        const LAS unsigned char* cb_ = lds + (c & 1) * RW_BUF + dir * RW_DIRB + 32 * cs;
#pragma unroll 4
        for (int s = 0; s < RW_CH; ++s) {
            const LAS unsigned char* p = cb_ + s * RW_STEP;
            const f32x4 w0 = *(const LAS f32x4*)p, w1 = *(const LAS f32x4*)(p + 16), r0 = *(const LAS f32x4*)(p + 256), r1 = *(const LAS f32x4*)(p + 272);
            const f32x4 n0 = *(const LAS f32x4*)(p + 512), n1 = *(const LAS f32x4*)(p + 528), b0 = *(const LAS f32x4*)(p + 768), b1 = *(const LAS f32x4*)(p + 784);
            const f32x4 k0 = *(const LAS f32x4*)(p + 1024), k1 = *(const LAS f32x4*)(p + 1040);
            const LAS unsigned char* q = lds + (c & 1) * RW_BUF + dir * RW_DIRB + s * RW_STEP;
            const float v = *(const LAS float*)(q + 1280 + 4 * (8 * w4 + ri)); const float br = *(const LAS float*)(q + 1408), kr = *(const LAS float*)(q + 1412);
            float sa = (S[0] * n0[0] + S[1] * n0[1]) + (S[2] * n0[2] + S[3] * n0[3]) + (S[4] * n1[0] + S[5] * n1[1]) + (S[6] * n1[2] + S[7] * n1[3]);
            float ym = (S[0] * r0[0] + S[1] * r0[1]) + (S[2] * r0[2] + S[3] * r0[3]) + (S[4] * r1[0] + S[5] * r1[1]) + (S[6] * r1[2] + S[7] * r1[3]);
            sa += dpp_xor1(sa); ym += dpp_xor1(ym); sa += dpp_xor2(sa); ym += dpp_xor2(ym); sa += dpp_hmir(sa); ym += dpp_hmir(ym);
#pragma unroll
            for (int j = 0; j < 4; ++j) { S[j] = S[j] * w0[j] + (sa * b0[j] + v * k0[j]); S[4 + j] = S[4 + j] * w1[j] + (sa * b1[j] + v * k1[j]); }
            if (cs == 0) ybuf[(dir * RW_CH + s) * 32 + 8 * w4 + ri] = ym + sa * br + v * kr;
        }
        if (c + 1 < NCH) RW_STAGE((c + 1) & 1);
        if (c == NCH / 2) asm volatile("s_waitcnt vmcnt(0)" ::: "memory");
        __syncthreads();
#pragma unroll
        for (int k = 0; k < 2; ++k) { const int o = tid + 512 * k, od = o >> 9, os = (o >> 5) & 15, orow = o & 31, n = c * RW_CH + os, t = od ? SEQ - 1 - n : n;
            bf16* yp = Yg + (size_t)t * 256 + orow; float y = ybuf[o];
            if (c >= NCH / 2) y += bf2f(*yp);
            *yp = (bf16)f2bf(y); }
    }
#undef RW_ISSUE
#undef RW_STAGE
#undef RW_BF
    __syncthreads();
}

__device__ __forceinline__ void gdn_unit(Frame& F, int l, int unit) {
    const int bh = unit, b = bh / 6, h = bh % 6, e = F.lane, dir = F.wave;
    const bf16* Pgdn = (const bf16*)(F.ws + WS_PGDN); const float* Psm = (const float*)(F.ws + WS_PSM); bf16* Ogdn = (bf16*)(F.ws + WS_OGDN);
    const float* conv_w = (const float*)inptr(F, 4) + (size_t)l * 5 * 1152; const float* a_log = (const float*)inptr(F, 5) + l * 12; const float* dt_bias = (const float*)inptr(F, 6) + l * 12;
    LAS float* qs = (LAS float*)(F.lds + RING_OFF) + F.wave * 128; LAS float* ks = qs + 64;
    if (F.wave < 2) {
        float S[64];
#pragma unroll
        for (int i = 0; i < 64; ++i) S[i] = 0.f;
        float cw[3][5];
#pragma unroll
        for (int i = 0; i < 5; ++i) { cw[0][i] = conv_w[i * 1152 + h * 64 + e]; cw[1][i] = conv_w[i * 1152 + 384 + h * 64 + e]; cw[2][i] = conv_w[i * 1152 + 768 + h * 64 + e]; }
        const float al = -__expf(a_log[dir * 6 + h]), dtb = dt_bias[dir * 6 + h];
        for (int n = 0; n < SEQ; ++n) {
            if (n == SEQ / 2) { asm volatile("s_waitcnt vmcnt(0)" ::: "memory"); __syncthreads(); }
            const int t = dir ? SEQ - 1 - n : n; const size_t m = (size_t)b * SEQ + t;
            float cq = 0.f, ck = 0.f, cv = 0.f;
#pragma unroll
            for (int i = 0; i < 5; ++i) { const int tt = t + i - 2; if (tt >= 0 && tt < SEQ) { const bf16* pr = Pgdn + ((size_t)b * SEQ + tt) * 1152 + h * 64 + e;
                    cq += cw[0][i] * bf2f(pr[0]); ck += cw[1][i] * bf2f(pr[384]); cv += cw[2][i] * bf2f(pr[768]); } }
            cq = siluf(cq); ck = siluf(ck); cv = siluf(cv);
            const float qn = cq * rsqrtf(wave_sum(cq * cq) + 1e-6f) * 0.125f, kn = ck * rsqrtf(wave_sum(ck * ck) + 1e-6f);
            LDS_WAIT(); asm volatile("" ::: "memory");
            qs[e] = qn; ks[e] = kn;
            LDS_WAIT(); asm volatile("" ::: "memory");
            const float g = al * softplusf_(Psm[m * 32 + dir * 6 + h] + dtb), beta = sigmoidf_(Psm[m * 32 + 12 + dir * 6 + h]), alpha = __expf(g);
            float kS = 0.f;
#pragma unroll
            for (int c4 = 0; c4 < 16; ++c4) { const f32x4 kq = ((const LAS f32x4*)ks)[c4];
                kS += (kq.x * S[4 * c4] + kq.y * S[4 * c4 + 1]) + (kq.z * S[4 * c4 + 2] + kq.w * S[4 * c4 + 3]);
                if ((c4 & 3) == 3) asm volatile("" ::: "memory"); }
            const float coef = beta * (cv - alpha * kS);
            float o = 0.f;
#pragma unroll
            for (int c4 = 0; c4 < 16; ++c4) { const f32x4 kq = ((const LAS f32x4*)ks)[c4], qq = ((const LAS f32x4*)qs)[c4];
                S[4 * c4] = alpha * S[4 * c4] + coef * kq.x; S[4 * c4 + 1] = alpha * S[4 * c4 + 1] + coef * kq.y; S[4 * c4 + 2] = alpha * S[4 * c4 + 2] + coef * kq.z; S[4 * c4 + 3] = alpha * S[4 * c4 + 3] + coef * kq.w;
                o += (qq.x * S[4 * c4] + qq.y * S[4 * c4 + 1]) + (qq.z * S[4 * c4 + 2] + qq.w * S[4 * c4 + 3]);
                if ((c4 & 3) == 3) asm volatile("" ::: "memory"); }
            bf16* op = Ogdn + m * 384 + h * 64 + e;
            if (n >= SEQ / 2) o += bf2f(*op);
            *op = (bf16)f2bf(o);
        }
    } else { __syncthreads(); }
}

constexpr int GP = 144;
constexpr int G_Q = 0, G_K = 9216, G_V = 18432, G_KT = 27648, G_P = 36864, G_A = 46080, G_SM = 63488, G_GROUP = 64512;
constexpr int G_CW = 133120;
static_assert(2 * G_GROUP <= RING_BYTES && G_CW + 3840 <= LDS_BYTES && G_CW >= MISC_OFF + 1024, "GDN LDS map");
__device__ __forceinline__ bf16x8 ld2x8(const LAS unsigned char* p) { return mk_bf16x8(*(const LAS u64_t*)p, *(const LAS u64_t*)(p + 32)); }
__device__ __forceinline__ bf16x8 pack_acc(const f32x4& a, const f32x4& b) {
    v4u w; w.x = pg8::cvt_pk_bf16(a[0], a[1]); w.y = pg8::cvt_pk_bf16(a[2], a[3]); w.z = pg8::cvt_pk_bf16(b[0], b[1]); w.w = pg8::cvt_pk_bf16(b[2], b[3]); return __builtin_bit_cast(bf16x8, w); }
__device__ __forceinline__ void split_acc(const f32x4& a, const f32x4& b, bf16x8& hi, bf16x8& lo) {
    v4u wh; wh.x = pg8::cvt_pk_bf16(a[0], a[1]); wh.y = pg8::cvt_pk_bf16(a[2], a[3]); wh.z = pg8::cvt_pk_bf16(b[0], b[1]); wh.w = pg8::cvt_pk_bf16(b[2], b[3]);
    f32x4 ra, rb;
    ra[0] = a[0] - __uint_as_float(wh.x << 16); ra[1] = a[1] - __uint_as_float(wh.x & 0xffff0000u); ra[2] = a[2] - __uint_as_float(wh.y << 16); ra[3] = a[3] - __uint_as_float(wh.y & 0xffff0000u);
    rb[0] = b[0] - __uint_as_float(wh.z << 16); rb[1] = b[1] - __uint_as_float(wh.z & 0xffff0000u); rb[2] = b[2] - __uint_as_float(wh.w << 16); rb[3] = b[3] - __uint_as_float(wh.w & 0xffff0000u);
    hi = __builtin_bit_cast(bf16x8, wh); lo = pack_acc(ra, rb);
}
typedef _Float16 f16x8 __attribute__((ext_vector_type(8)));
__device__ __forceinline__ f16x8 pack_acc_f16(const f32x4& a, const f32x4& b) { return (f16x8){(_Float16)a[0], (_Float16)a[1], (_Float16)a[2], (_Float16)a[3], (_Float16)b[0], (_Float16)b[1], (_Float16)b[2], (_Float16)b[3]}; }
__device__ __forceinline__ void gdn_unit2(Frame& F, int l, int unit) {
    const int bh = unit, b = bh / 6, h = bh % 6;
    const int tid = F.tid, lane = F.lane, dir = F.wave >> 2, gw = F.wave & 3, gt = tid & 255;
    const bf16* Pgdn = (const bf16*)(F.ws + WS_PGDN) + (size_t)b * SEQ * 1152 + h * 64; const float* Psm = (const float*)(F.ws + WS_PSM) + (size_t)b * SEQ * 32;
    bf16* Og = (bf16*)(F.ws + WS_OGDN) + (size_t)b * SEQ * 384 + h * 64;
    LAS unsigned char* gb = F.lds + RING_OFF + dir * G_GROUP;
    LAS float* cwl = (LAS float*)(F.lds + G_CW);
    LAS float* sm = (LAS float*)(gb + G_SM);
    { const float* conv_w = (const float*)inptr(F, 4) + (size_t)l * 5 * 1152;
      for (int i = tid; i < 960; i += 512) { const int tn = i / 320, tap = (i % 320) / 64, ch = i % 64; cwl[i] = conv_w[tap * 1152 + tn * 384 + h * 64 + ch]; } }
    const float al = -__expf(((const float*)inptr(F, 5))[l * 12 + dir * 6 + h]), dtb = ((const float*)inptr(F, 6))[l * 12 + dir * 6 + h];
    f32x4 Sacc[4];
#pragma unroll
    for (int i = 0; i < 4; ++i) Sacc[i] = (f32x4){0.f, 0.f, 0.f, 0.f};
    __syncthreads();
    for (int c = 0; c < SEQ / 64; ++c) {
        if (gw == 0) {
            const int t = dir ? SEQ - 1 - 64 * c - lane : 64 * c + lane;
            const float a = Psm[(size_t)t * 32 + dir * 6 + h], bt = Psm[(size_t)t * 32 + 12 + dir * 6 + h];
            float x = al * softplusf_(a + dtb);
#pragma unroll
            for (int off = 1; off < 64; off <<= 1) { const float y = __shfl_up(x, off); if (lane >= off) x += y; }
            const float last = __shfl(x, 63);
            sm[lane] = x; sm[64 + lane] = sigmoidf_(bt); sm[128 + lane] = __expf(x); sm[192 + lane] = __expf(last - x);
        }
        { const int i = gt >> 2, cg = gt & 3, t = dir ? SEQ - 1 - 64 * c - i : 64 * c + i;
          float acc[3][16];
#pragma unroll
          for (int tn = 0; tn < 3; ++tn)
#pragma unroll
              for (int j = 0; j < 16; ++j) acc[tn][j] = 0.f;
#pragma unroll
          for (int tap = 0; tap < 5; ++tap) { const int tt = t + tap - 2;
              if (tt >= 0 && tt < SEQ) {
#pragma unroll
                  for (int tn = 0; tn < 3; ++tn) { const bf16* pr = Pgdn + (size_t)tt * 1152 + tn * 384 + 16 * cg; const v4u x0 = *(const v4u*)pr, x1 = *(const v4u*)(pr + 8);
                      const LAS float* w = cwl + tn * 320 + tap * 64 + 16 * cg;
#pragma unroll
                      for (int q = 0; q < 4; ++q) { acc[tn][2 * q] += w[2 * q] * __uint_as_float(x0[q] << 16); acc[tn][2 * q + 1] += w[2 * q + 1] * __uint_as_float(x0[q] & 0xffff0000u);
                          acc[tn][8 + 2 * q] += w[8 + 2 * q] * __uint_as_float(x1[q] << 16); acc[tn][8 + 2 * q + 1] += w[8 + 2 * q + 1] * __uint_as_float(x1[q] & 0xffff0000u); } } }
              asm volatile("" ::: "memory"); }
          float sq = 0.f, sk = 0.f;
#pragma unroll
          for (int j = 0; j < 16; ++j) { acc[0][j] = siluf(acc[0][j]); acc[1][j] = siluf(acc[1][j]); acc[2][j] = siluf(acc[2][j]); sq += acc[0][j] * acc[0][j]; sk += acc[1][j] * acc[1][j]; }
          sq += __shfl_xor(sq, 1); sq += __shfl_xor(sq, 2); sk += __shfl_xor(sk, 1); sk += __shfl_xor(sk, 2);
          const float rq = rsqrtf(sq + 1e-6f) * 0.125f, rk = rsqrtf(sk + 1e-6f);
          v4u wq[2], wk[2], wv[2];
#pragma unroll
          for (int q = 0; q < 8; ++q) { wq[q >> 2][q & 3] = pg8::cvt_pk_bf16(acc[0][2 * q] * rq, acc[0][2 * q + 1] * rq); wk[q >> 2][q & 3] = pg8::cvt_pk_bf16(acc[1][2 * q] * rk, acc[1][2 * q + 1] * rk);
              wv[q >> 2][q & 3] = pg8::cvt_pk_bf16(acc[2][2 * q], acc[2][2 * q + 1]); }
          LAS unsigned char* row = gb + i * GP + 32 * cg;
          *(LAS v4u*)(row + G_Q) = wq[0]; *(LAS v4u*)(row + G_Q + 16) = wq[1]; *(LAS v4u*)(row + G_K) = wk[0]; *(LAS v4u*)(row + G_K + 16) = wk[1]; *(LAS v4u*)(row + G_V) = wv[0]; *(LAS v4u*)(row + G_V + 16) = wv[1];
#pragma unroll
          for (int j = 0; j < 16; ++j) *(LAS bf16*)(gb + G_KT + (16 * cg + j) * GP + 2 * i) = (bf16)((j & 1) ? (wk[j >> 3][(j >> 1) & 3] >> 16) : (wk[j >> 3][(j >> 1) & 3] & 0xffffu)); }
        if (c == SEQ / 128) asm volatile("s_waitcnt vmcnt(0)" ::: "memory");
        __syncthreads();
        { const int ti = gw >> 1, tj = gw & 1, r32 = lane & 31, hi = lane >> 5;
          f32x16 kk = {}, qk = {};
          const LAS unsigned char* ar = gb + (32 * ti + r32) * GP + 16 * hi; const LAS unsigned char* br = gb + G_K + (32 * tj + r32) * GP + 16 * hi;
#pragma unroll
          for (int s = 0; s < 4; ++s) { const bf16x8 ak = *(const LAS bf16x8*)(ar + G_K + 32 * s), aq = *(const LAS bf16x8*)(ar + G_Q + 32 * s), bk = *(const LAS bf16x8*)(br + 32 * s);
              kk = __builtin_amdgcn_mfma_f32_32x32x16_bf16(ak, bk, kk, 0, 0, 0); qk = __builtin_amdgcn_mfma_f32_32x32x16_bf16(aq, bk, qk, 0, 0, 0); }
          const int j = 32 * tj + r32; const float cj = sm[j];
#pragma unroll
          for (int r = 0; r < 16; ++r) { const int i = 32 * ti + (r & 3) + 8 * (r >> 2) + 4 * hi;
              const float dl = __expf(fminf(sm[i] - cj, 0.f));
              ((LAS float*)(gb + G_A))[i * 68 + j] = (i > j) ? sm[64 + i] * kk[r] * dl : 0.f;
              *(LAS _Float16*)(gb + G_P + i * GP + 2 * j) = (_Float16)((i >= j) ? qk[r] * dl : 0.f); } }
        __syncthreads();
        float X[64];
#pragma unroll
        for (int i = 0; i < 64; ++i) X[i] = 0.f;
        if (gt < 128) {
            const int cc = gt & 63; const LAS unsigned char* src = gb + (gt < 64 ? G_V : G_K) + 2 * cc;
#pragma unroll
            for (int i = 0; i < 64; ++i) {
                unsigned z = 0u; if (i >= 2) asm("v_and_b32 %0, 0, %1" : "=v"(z) : "v"(X[i - 2]));
                const LAS unsigned char* arow = gb + G_A + z + i * 272;
                const float rhs = bf2f(*(const LAS bf16*)(src + i * GP)) * sm[64 + i] * (gt < 64 ? 1.f : sm[128 + i]);
                float a0 = 0.f, a1 = 0.f, a2 = 0.f, a3 = 0.f;
#pragma unroll
                for (int j4 = 0; j4 < (i + 3) / 4; ++j4) { const f32x4 av = *(const LAS f32x4*)(arow + 16 * j4);
                    a0 += av.x * X[4 * j4]; a1 += av.y * X[4 * j4 + 1]; a2 += av.z * X[4 * j4 + 2]; a3 += av.w * X[4 * j4 + 3]; }
                X[i] = rhs - ((a0 + a1) + (a2 + a3));
            }
        }
        __syncthreads();
        if (gt < 64) {
#pragma unroll
            for (int i = 0; i < 64; ++i) ((LAS float*)(gb + G_A))[i * 68 + gt] = X[i];
        } else if (gt < 128) {
#pragma unroll
            for (int i = 0; i < 64; ++i) { const unsigned hb = f2bf(-X[i]); *(LAS bf16*)(gb + G_V + i * GP + 2 * (gt - 64)) = (bf16)hb;
                *(LAS bf16*)(gb + G_K + i * GP + 2 * (gt - 64)) = (bf16)f2bf(-X[i] - __uint_as_float(hb << 16)); }
        }
        __syncthreads();
        { const int col = lane & 15, q4 = lane >> 4, e = 16 * gw + col;
          bf16x8 bS0, bS1, bS0l, bS1l; split_acc(Sacc[0], Sacc[1], bS0, bS0l); split_acc(Sacc[2], Sacc[3], bS1, bS1l);
          f32x4 U[4], T1[4];
          const LAS unsigned char* rowa = gb + col * GP + 8 * q4;
#pragma unroll
          for (int it = 0; it < 4; ++it) {
              const LAS float* u0p = (const LAS float*)(gb + G_A) + (16 * it + 4 * q4) * 68 + e;
              U[it] = (f32x4){u0p[0], u0p[68], u0p[136], u0p[204]};
              const LAS unsigned char* ra = rowa + 16 * it * GP;
              const bf16x8 wh0 = ld2x8(ra + G_V), wh1 = ld2x8(ra + G_V + 64), wl0 = ld2x8(ra + G_K), wl1 = ld2x8(ra + G_K + 64), qa0 = ld2x8(ra + G_Q), qa1 = ld2x8(ra + G_Q + 64);
              U[it] = __builtin_amdgcn_mfma_f32_16x16x32_bf16(wl0, bS0, U[it], 0, 0, 0);
              U[it] = __builtin_amdgcn_mfma_f32_16x16x32_bf16(wl1, bS1, U[it], 0, 0, 0);
              U[it] = __builtin_amdgcn_mfma_f32_16x16x32_bf16(wh0, bS0l, U[it], 0, 0, 0);
              U[it] = __builtin_amdgcn_mfma_f32_16x16x32_bf16(wh1, bS1l, U[it], 0, 0, 0);
              U[it] = __builtin_amdgcn_mfma_f32_16x16x32_bf16(wh0, bS0, U[it], 0, 0, 0);
              U[it] = __builtin_amdgcn_mfma_f32_16x16x32_bf16(wh1, bS1, U[it], 0, 0, 0);
              T1[it] = __builtin_amdgcn_mfma_f32_16x16x32_bf16(qa0, bS0l, (f32x4){0.f, 0.f, 0.f, 0.f}, 0, 0, 0);
              T1[it] = __builtin_amdgcn_mfma_f32_16x16x32_bf16(qa1, bS1l, T1[it], 0, 0, 0);
              T1[it] = __builtin_amdgcn_mfma_f32_16x16x32_bf16(qa0, bS0, T1[it], 0, 0, 0);
              T1[it] = __builtin_amdgcn_mfma_f32_16x16x32_bf16(qa1, bS1, T1[it], 0, 0, 0);
          }
          const f16x8 hU0 = pack_acc_f16(U[0], U[1]), hU1 = pack_acc_f16(U[2], U[3]);
          f32x4 Ud[4];
#pragma unroll
          for (int it = 0; it < 4; ++it) { const f32x4 dc = *(const LAS f32x4*)(sm + 192 + 16 * it + 4 * q4); Ud[it] = U[it] * dc; }
          bf16x8 bD0, bD1, bD0l, bD1l; split_acc(Ud[0], Ud[1], bD0, bD0l); split_acc(Ud[2], Ud[3], bD1, bD1l);
          const float gend = sm[191];
#pragma unroll
          for (int it = 0; it < 4; ++it) {
              const LAS unsigned char* ra = rowa + 16 * it * GP;
              const f32x4 gm = *(const LAS f32x4*)(sm + 128 + 16 * it + 4 * q4);
              const bf16x8 pa0 = ld2x8(ra + G_P), pa1 = ld2x8(ra + G_P + 64), ka0 = ld2x8(ra + G_KT), ka1 = ld2x8(ra + G_KT + 64);
              f32x4 O = T1[it] * gm;
              O = __builtin_amdgcn_mfma_f32_16x16x32_f16(__builtin_bit_cast(f16x8, pa0), hU0, O, 0, 0, 0);
              O = __builtin_amdgcn_mfma_f32_16x16x32_f16(__builtin_bit_cast(f16x8, pa1), hU1, O, 0, 0, 0);
              f32x4 Sn = Sacc[it] * gend;
              Sn = __builtin_amdgcn_mfma_f32_16x16x32_bf16(ka0, bD0l, Sn, 0, 0, 0);
              Sn = __builtin_amdgcn_mfma_f32_16x16x32_bf16(ka1, bD1l, Sn, 0, 0, 0);
              Sn = __builtin_amdgcn_mfma_f32_16x16x32_bf16(ka0, bD0, Sn, 0, 0, 0);
              Sn = __builtin_amdgcn_mfma_f32_16x16x32_bf16(ka1, bD1, Sn, 0, 0, 0);
              Sacc[it] = Sn;
#pragma unroll
              for (int r = 0; r < 4; ++r) { const int i = 16 * it + 4 * q4 + r, t = dir ? SEQ - 1 - 64 * c - i : 64 * c + i; bf16* op = Og + (size_t)t * 384 + e;
                  float o = O[r]; if (c >= SEQ / 128) o += bf2f(*op);
                  *op = (bf16)f2bf(o); }
          } }
        __syncthreads();
    }
}
__device__ __forceinline__ int next_unit(Frame& F, gu32* head) {
    __syncthreads();
    if (F.tid == 0) F.MISC[16] = __hip_atomic_fetch_add(head, 1u, RLX_AGENT);
    __syncthreads();
    return (int)F.MISC[16];
}
constexpr int U_GDN = 48, U_RWKV = 64, U_ATT = 384, U_ALL = U_GDN + U_RWKV + U_ATT;
__device__ __forceinline__ void p3_mixers(Frame& F, int l, int rep) {
    gu32* head = F.ctl + CW_QUEUE + 64 * (2 * l + rep);
    for (;;) {
        const int u = next_unit(F, head);
        if (u >= U_ALL) break;
        asm volatile("" : "+v"(F.tid), "+v"(F.lane));
        if (u < U_GDN) gdn_unit2(F, l, u);
        else if (u < U_GDN + U_RWKV) rwkv_unit(F, u - U_GDN);
        else attn_unit(F, u - U_GDN - U_RWKV);
    }
}
typedef unsigned u32x4 __attribute__((ext_vector_type(4)));
__device__ __forceinline__ float dot_bf16(const bf16* a, const bf16* b, int K) {
    float acc = 0.f;
    for (int k = 0; k < K; k += 8) {
        const u32x4 av = *(const u32x4*)(a + k), bv = *(const u32x4*)(b + k);
#pragma unroll
        for (int i = 0; i < 4; ++i) {
            acc += __uint_as_float(av[i] << 16) * __uint_as_float(bv[i] << 16);
            acc += __uint_as_float(av[i] & 0xffff0000u) * __uint_as_float(bv[i] & 0xffff0000u);
        }
    }
    return acc;
}
__global__ void __launch_bounds__(64) nk_mla_prep(const bf16* Pmla, const bf16* WuqT, const bf16* WukvT, const int* positions, bf16* Q, bf16* Kb, bf16* Vt) {
    __shared__ float raw[576 + 768];
    __shared__ float rs[2];
    const int m = blockIdx.x, lane = threadIdx.x, b = m / SEQ, t = m % SEQ;
    const bf16* p = Pmla + (size_t)m * 352;
    float s1 = 0.f, s2 = 0.f;
    for (int c = lane; c < 192; c += 64) { const float v = bf2f(p[c]); s1 += v * v; }
    for (int c = lane; c < 128; c += 64) { const float v = bf2f(p[192 + c]); s2 += v * v; }
    s1 = wave_sum(s1); s2 = wave_sum(s2);
    const float rq = rsqrtf(s1 * (1.f / 192.f) + NORM_EPS), rkv = rsqrtf(s2 * (1.f / 128.f) + NORM_EPS);
    for (int c = lane; c < 576; c += 64) raw[c] = dot_bf16(p, WuqT + (size_t)c * 192, 192) * rq;
    for (int c = lane; c < 768; c += 64) raw[576 + c] = dot_bf16(p + 192, WukvT + (size_t)c * 128, 128) * rkv;
    __syncthreads();
    const float pos = (float)positions[m];
    const float qs = 0.10206207261596575f * LOG2E;
    for (int i = lane; i < 6 * 80; i += 64) {
        const int h = i / 80, j = i % 80;
        bf16* qo = Q + (((size_t)b * 6 + h) * SEQ + t) * 96;
        if (j < 64) qo[j] = f2bf(raw[h * 96 + j] * qs);
        else { const int r = j - 64; const float inv = exp2f(-(float)r * (13.287712379549449f / 16.f)); float sn, cs; sincosf(pos * inv, &sn, &cs);
            const float x1 = raw[h * 96 + 64 + r], x2 = raw[h * 96 + 80 + r];
            qo[64 + r] = f2bf((x1 * cs - x2 * sn) * qs); qo[80 + r] = f2bf((x2 * cs + x1 * sn) * qs); }
    }
    for (int i = lane; i < 6 * 64; i += 64) {
        const int h = i / 64, j = i % 64;
        Kb[(((size_t)b * 6 + h) * SEQ + t) * 96 + j] = f2bf(raw[576 + h * 128 + j]);
        Vt[(((size_t)b * 6 + h) * 64 + j) * SEQ + t] = f2bf(raw[576 + h * 128 + 64 + j]);
    }
    if (lane < 16) {
        const int r = lane; const float inv = exp2f(-(float)r * (13.287712379549449f / 16.f)); float sn, cs; sincosf(pos * inv, &sn, &cs);
        const float x1 = bf2f(p[320 + r]), x2 = bf2f(p[336 + r]);
        const bf16 o1 = f2bf(x1 * cs - x2 * sn), o2 = f2bf(x2 * cs + x1 * sn);
        for (int h = 0; h < 6; ++h) { bf16* ko = Kb + (((size_t)b * 6 + h) * SEQ + t) * 96; ko[64 + r] = o1; ko[80 + r] = o2; }
    }
}
__global__ void __launch_bounds__(256) nk_rwkv_prep(const bf16* Prw, const float* mu, const float* w0, const float* w2, const float* a0, const float* a2,
                             const float* k_k, const float* k_a, const float* r_k, unsigned char* Rs, unsigned char* Rd, float* cb) {
    __shared__ float f[896];
    const int m = blockIdx.x, c = threadIdx.x, b = m / SEQ, t = m % SEQ, h = c >> 6, j = c & 63;
    for (int i = c; i < 896; i += 256) {
        const float x = bf2f(Prw[(size_t)m * 896 + i]);
        const float xp = t > 0 ? bf2f(Prw[(size_t)(m - 1) * 896 + i]) : 0.f;
        const float xn = t < SEQ - 1 ? bf2f(Prw[(size_t)(m + 1) * 896 + i]) : 0.f;
        float v = x + mu[i] * (xp - x) + mu[896 + i] * (xn - x);
        if (i >= 768 && i < 832) v = tanhf(v);
        f[i] = v;
    }
    __syncthreads();
    const float r = f[c], k = f[256 + c], v = f[512 + c];
    const float kkr = k * k_k[c];
    const float kn = wave_sum(kkr * kkr);
    const float kk = kkr * rsqrtf(kn + 1e-6f);
    float kmod[2], bb[2], lam[2];
#pragma unroll
    for (int e = 0; e < 2; ++e) {
        float lw = 0.f, la = 0.f;
        for (int d = 0; d < 64; ++d) { lw += f[768 + d] * w2[((size_t)e * 64 + d) * 256 + c]; la += f[832 + d] * a2[((size_t)e * 64 + d) * 256 + c]; }
        const float wl = -softplusf_(-(w0[e * 256 + c] + lw)) - 0.5f;
        lam[e] = __expf(wl);
        const float a = sigmoidf_(a0[e * 256 + c] + la);
        kmod[e] = k * (1.f + (a - 1.f) * k_a[c]);
        bb[e] = a * kk;
    }
    unsigned char* rs = Rs + (((size_t)b * 4 + h) * SEQ + t) * RS_REC;
    ((bf16*)rs)[j] = f2bf(kk); ((bf16*)(rs + 128))[j] = f2bf(v); ((bf16*)(rs + 256))[j] = f2bf(r);
#pragma unroll
    for (int e = 0; e < 2; ++e) {
        unsigned char* rd = Rd + e * RD_DIR + (((size_t)b * 4 + h) * SEQ + t) * RD_REC;
        ((__half*)rd)[j] = __float2half(lam[e]); ((bf16*)(rd + 128))[j] = f2bf(bb[e]); ((bf16*)(rd + 256))[j] = f2bf(kmod[e]);
        const float br = wave_sum(bb[e] * r), kr = wave_sum(kmod[e] * r);
        if (j == 0) { ((float*)(rd + 384))[0] = br; ((float*)(rd + 384))[1] = kr; }
    }
    const float cbv = wave_sum(r * 0.5f * (kmod[0] + kmod[1]) * r_k[c]);
    if (j == 0) cb[(size_t)m * 4 + h] = cbv;
}
__global__ void __launch_bounds__(128) nk_attn(const bf16* Q, const bf16* Kb, const bf16* Vt, bf16* Omla) {
    const int bh = blockIdx.y, q = blockIdx.x * 128 + threadIdx.x, b = bh / 6, h = bh % 6;
    const bf16* qp = Q + ((size_t)bh * SEQ + q) * 96;
    float qr[96];
#pragma unroll
    for (int i = 0; i < 96; ++i) qr[i] = bf2f(qp[i]);
    float acc[64];
#pragma unroll
    for (int i = 0; i < 64; ++i) acc[i] = 0.f;
    float mx = -1e30f, l = 0.f;
    const bf16* kb = Kb + (size_t)bh * SEQ * 96; const bf16* vt = Vt + (size_t)bh * 64 * SEQ;
    for (int k0 = 0; k0 < SEQ; k0 += 8) {
        float s[8];
#pragma unroll
        for (int kk = 0; kk < 8; ++kk) {
            const bf16* kr = kb + (size_t)(k0 + kk) * 96; float a = 0.f;
#pragma unroll
            for (int d = 0; d < 96; d += 8) { const u32x4 kv = *(const u32x4*)(kr + d);
#pragma unroll
                for (int i = 0; i < 4; ++i) { a += qr[d + 2 * i] * __uint_as_float(kv[i] << 16); a += qr[d + 2 * i + 1] * __uint_as_float(kv[i] & 0xffff0000u); } }
            s[kk] = a;
        }
        float cm = s[0];
#pragma unroll
        for (int kk = 1; kk < 8; ++kk) cm = fmaxf(cm, s[kk]);
        const float mn = fmaxf(mx, cm), sc = exp2f(mx - mn);
        l *= sc;
#pragma unroll
        for (int i = 0; i < 64; ++i) acc[i] *= sc;
        mx = mn;
#pragma unroll
        for (int kk = 0; kk < 8; ++kk) { s[kk] = exp2f(s[kk] - mn); l += s[kk]; }
#pragma unroll
        for (int d = 0; d < 64; ++d) { const u32x4 vv = *(const u32x4*)(vt + (size_t)d * SEQ + k0);
#pragma unroll
            for (int i = 0; i < 4; ++i) { acc[d] += s[2 * i] * __uint_as_float(vv[i] << 16); acc[d] += s[2 * i + 1] * __uint_as_float(vv[i] & 0xffff0000u); } }
    }
    const float il = 1.f / l;
    bf16* o = Omla + ((size_t)b * SEQ + q) * 384 + h * 64;
#pragma unroll
    for (int i = 0; i < 64; ++i) o[i] = f2bf(acc[i] * il);
}
__global__ void __launch_bounds__(64) nk_gdn(const bf16* Pgdn, const float* Psm, const float* conv_w, const float* a_log, const float* dt_bias, bf16* Ogdn, int dir) {
    __shared__ float qs[64], ks[64];
    const int bh = blockIdx.x, b = bh / 6, h = bh % 6, e = threadIdx.x;
    float S[64];
#pragma unroll
    for (int i = 0; i < 64; ++i) S[i] = 0.f;
    float cw[3][5];
#pragma unroll
    for (int i = 0; i < 5; ++i) { cw[0][i] = conv_w[i * 1152 + h * 64 + e]; cw[1][i] = conv_w[i * 1152 + 384 + h * 64 + e]; cw[2][i] = conv_w[i * 1152 + 768 + h * 64 + e]; }
    const float al = -__expf(a_log[dir * 6 + h]), dtb = dt_bias[dir * 6 + h];
    for (int n = 0; n < SEQ; ++n) {
        const int t = dir ? SEQ - 1 - n : n; const size_t m = (size_t)b * SEQ + t;
        float cq = 0.f, ck = 0.f, cv = 0.f;
#pragma unroll
        for (int i = 0; i < 5; ++i) { const int tt = t + i - 2; if (tt >= 0 && tt < SEQ) { const bf16* pr = Pgdn + ((size_t)b * SEQ + tt) * 1152 + h * 64 + e;
                cq += cw[0][i] * bf2f(pr[0]); ck += cw[1][i] * bf2f(pr[384]); cv += cw[2][i] * bf2f(pr[768]); } }
        cq = siluf(cq); ck = siluf(ck); cv = siluf(cv);
        const float qn = cq * rsqrtf(wave_sum(cq * cq) + 1e-6f) * 0.125f, kn = ck * rsqrtf(wave_sum(ck * ck) + 1e-6f);
        __syncthreads();
        qs[e] = qn; ks[e] = kn;
        __syncthreads();
        const float g = al * softplusf_(Psm[m * 32 + dir * 6 + h] + dtb), beta = sigmoidf_(Psm[m * 32 + 12 + dir * 6 + h]), alpha = __expf(g);
        float kS = 0.f;
#pragma unroll
        for (int d = 0; d < 64; ++d) kS += ks[d] * S[d];
        const float coef = beta * (cv - alpha * kS);
        float o = 0.f;
#pragma unroll
        for (int d = 0; d < 64; ++d) { S[d] = alpha * S[d] + coef * ks[d]; o += qs[d] * S[d]; }
        bf16* op = Ogdn + m * 384 + h * 64 + e;
        if (dir) o += bf2f(*op);
        *op = f2bf(o);
    }
}
__global__ void __launch_bounds__(64) nk_rwkv(const unsigned char* Rs, const unsigned char* Rd, bf16* Y, int dir) {
    const int bh = blockIdx.x, b = bh / 4, h = bh % 4, i = threadIdx.x;
    float S[64];
#pragma unroll
    for (int j = 0; j < 64; ++j) S[j] = 0.f;
    for (int n = 0; n < SEQ; ++n) {
        const int t = dir ? SEQ - 1 - n : n;
        const unsigned char* rs = Rs + ((size_t)bh * SEQ + t) * RS_REC;
        const unsigned char* rd = Rd + dir * RD_DIR + ((size_t)bh * SEQ + t) * RD_REC;
        const float v = bf2f(((const bf16*)(rs + 128))[i]);
        float sa = 0.f;
#pragma unroll
        for (int j = 0; j < 64; ++j) sa -= S[j] * bf2f(((const bf16*)rs)[j]);
        float y = 0.f;
#pragma unroll
        for (int j = 0; j < 64; ++j) {
            const float w = __expf(-__half2float(((const __half*)rd)[j]));
            S[j] = S[j] * w + sa * bf2f(((const bf16*)(rd + 128))[j]) + v * bf2f(((const bf16*)(rd + 256))[j]);
            y += S[j] * bf2f(((const bf16*)(rs + 256))[j]);
        }
        bf16* op = Y + ((size_t)b * SEQ + t) * 256 + h * 64 + i;
        if (dir) y += bf2f(*op);
        *op = f2bf(y);
    }
}
__global__ void __launch_bounds__(1024) nk_mix(const bf16* Ogdn, const bf16* Omla, const bf16* Y, const bf16* Pgate, const unsigned char* Rs, const float* cb,
                       const float* gdn_g, const float* ln_g, const float* ln_b, bf16* mix) {
    const int m = blockIdx.x, c = threadIdx.x, b = m / SEQ, t = m % SEQ;
    float val;
    if (c < 384) { const float o = bf2f(Ogdn[(size_t)m * 384 + c]); const float ss = wave_sum(o * o); val = o * rsqrtf(ss * (1.f / 64.f) + NORM_EPS) * gdn_g[c & 63]; }
    else if (c < 768) val = bf2f(Omla[(size_t)m * 384 + (c - 384)]);
    else { const int cc = c - 768, h = cc >> 6, j = cc & 63; const float y = bf2f(Y[(size_t)m * 256 + cc]);
        const float mean = wave_sum(y) * (1.f / 64.f); const float dv = y - mean; const float var = wave_sum(dv * dv) * (1.f / 64.f);
        const float v = bf2f(((const bf16*)(Rs + (((size_t)b * 4 + h) * SEQ + t) * RS_REC + 128))[j]);
        val = dv * rsqrtf(var + 64e-5f) * ln_g[cc] + ln_b[cc] + cb[(size_t)m * 4 + h] * v; }
    mix[(size_t)m * 1024 + c] = f2bf(val * siluf(bf2f(Pgate[(size_t)m * 1024 + c])));
}
#ifndef MK_SINGLE
#define MK_SINGLE 1
#endif
#ifndef MK_REPU
#define MK_REPU 0
#endif
#ifndef MK_REP2
#define MK_REP2 0
#endif
#ifndef MK_REP3
#define MK_REP3 0
#endif
#ifndef MK_P2
#define MK_P2 1
#endif
#ifndef MK_P3
#define MK_P3 1
#endif
#ifndef MK_P4A
#define MK_P4A 1
#endif
constexpr int PT_OUT = 24, PT_WS = 25, PT_N = 26;
__device__ __forceinline__ void build_frame(Frame& F, LAS unsigned char* lds) {
    F.lds = lds; F.MISC = (volatile LAS unsigned*)(lds + MISC_OFF); F.ptab = (LAS const unsigned long long*)(lds + MISC_OFF + 256);
    const int t = pg8::mk_tid(lds);
    F.tid = t; F.lane = t & 63; F.wave = __builtin_amdgcn_readfirstlane(t >> 6);
    F.G = gridDim.x; { const int bx = blockIdx.x; F.vcu = (F.G % 8 == 0) ? (bx % 8) * (F.G / 8) + bx / 8 : bx; }
    F.ws = (unsigned char*)inptr(F, PT_WS); F.out = (float*)inptr(F, PT_OUT); F.ctl = (gu32*)F.ws;
}
__device__ __forceinline__ bool ph_in(LAS unsigned char* lds, int k) { volatile LAS unsigned* mi = (volatile LAS unsigned*)(lds + MISC_OFF); const int lo = __builtin_amdgcn_readfirstlane((int)mi[20]), hi = __builtin_amdgcn_readfirstlane((int)mi[21]); return lo <= k && k < hi; }
__device__ __forceinline__ void seam(LAS unsigned char* lds, int k) {
    if (ph_in(lds, k) && ph_in(lds, k + 1)) { Frame F; build_frame(F, lds);
        XcdBarrier bar; bar.bar = (unsigned*)(F.ctl + CW_BAR); bar.x = xb_xcc_id(); bar.st = F.MISC + 8; xcd_barrier(bar); }
}
template <int L> __device__ __forceinline__ void layer_phases(LAS unsigned char* lds) {
    constexpr int pb = 1 + 5 * L;
    if (ph_in(lds, pb)) { Frame F; build_frame(F, lds);
        pg8::Gemm g{(const pg8::bf16_t*)(F.ws + WS_XB), (const pg8::bf16_t*)(F.ws + WS_WIN) + (size_t)L * NP * D, M, NP, D};
        pg8::StaticOrder S; S.init(M, NP, F.G, (int)blockIdx.x);
        pg8::EpiRoute E{F.ws};
        pg8::gemm_phase<pg8::EpiRoute, pg8::StaticOrder, true, true>(F.lds + RING_OFF, g, S, E); }
    seam(lds, pb);
    if (ph_in(lds, pb + 1)) { Frame F; build_frame(F, lds); p2_prep(F, L); }
#if MK_REP2
    seam(lds, pb);
    if (ph_in(lds, pb + 1)) { Frame F; build_frame(F, lds); p2_prep(F, L); }
#endif
    seam(lds, pb + 1);
#if MK_REPU
    if (ph_in(lds, pb + 2)) { Frame F; build_frame(F, lds); gu32* head = F.ctl + CW_QUEUE + 64 * (2 * L + 1);
        const int n = (MK_REPU == 1) ? U_GDN : (MK_REPU == 2) ? U_RWKV : U_ATT;
        for (;;) { const int u = next_unit(F, head); if (u >= n) break; if (MK_REPU == 1) gdn_unit2(F, L, u); else if (MK_REPU == 2) rwkv_unit(F, u); else attn_unit(F, u); } }
    seam(lds, pb + 1);
#endif
    if (ph_in(lds, pb + 2)) { Frame F; build_frame(F, lds); p3_mixers(F, L, 0); }
#if MK_REP3
    seam(lds, pb + 1);
    if (ph_in(lds, pb + 2)) { Frame F; build_frame(F, lds); p3_mixers(F, L, 1); }
#endif
    seam(lds, pb + 2);
    if (ph_in(lds, pb + 3)) { Frame F; build_frame(F, lds); p4a_mix(F, L); }
    seam(lds, pb + 3);
    if (ph_in(lds, pb + 4)) { Frame F; build_frame(F, lds);
        pg8::Gemm g{(const pg8::bf16_t*)(F.ws + WS_MIX), (const pg8::bf16_t*)(F.ws + WS_WOUT) + (size_t)L * D * D, M, D, D};
        pg8::StaticOrder S; S.init(M, D, F.G, (int)blockIdx.x);
        pg8::EpiOut E{L == 0 ? (const float*)inptr(F, 0) : (const float*)F.out, F.out, F.ws};
        pg8::gemm_phase<pg8::EpiOut, pg8::StaticOrder, true, true>(F.lds + RING_OFF, g, S, E); }
    seam(lds, pb + 4);
}
__global__ void __launch_bounds__(NWAVES * 64, 2) mk_fwd(Args args) {
    extern __shared__ __attribute__((aligned(16))) unsigned char lds_raw[];
    LAS unsigned char* lds = (LAS unsigned char*)lds_raw;
    for (int u = threadIdx.x; u < (LDS_BYTES - LDSCTL_OFF) / 4; u += NWAVES * 64) ((LAS unsigned*)(lds + LDSCTL_OFF))[u] = 0u;
    __syncthreads();
    if (threadIdx.x == 0) { LAS unsigned long long* pt = (LAS unsigned long long*)(lds + MISC_OFF + 256);
#define PT(k) pt[k] = (unsigned long long)args.in[k]
        PT(0); PT(1); PT(2); PT(3); PT(4); PT(5); PT(6); PT(7); PT(8); PT(9); PT(10); PT(11); PT(12); PT(13); PT(14); PT(15); PT(16); PT(17); PT(18); PT(19); PT(20); PT(21); PT(22); PT(23);
#undef PT
        pt[PT_OUT] = (unsigned long long)args.out; pt[PT_WS] = (unsigned long long)args.ws;
        volatile LAS unsigned* mi = (volatile LAS unsigned*)(lds + MISC_OFF); mi[20] = (unsigned)args.ph_lo; mi[21] = (unsigned)args.ph_hi;
        if (args.ph_hi - args.ph_lo > 1) (void)xcd_barrier_post((unsigned*)((gu32*)args.ws + CW_BAR), mi + 8);
    }
    if ((threadIdx.x & 63) == 0) ((volatile LAS unsigned*)(lds + pg8::TIDTAB_OFF))[pg8::hw_slot()] = threadIdx.x >> 6;
    __syncthreads();
    if (ph_in(lds, 0)) { Frame F; build_frame(F, lds); p0_prologue(F); }
    seam(lds, 0);
    layer_phases<0>(lds);
    layer_phases<1>(lds);
    if (ph_in(lds, 11)) { Frame F; build_frame(F, lds); p5_final(F); }
}

static void launch_phases(hipStream_t stream, int grid, Args a, int lo, int hi) {
    a.ph_lo = lo; a.ph_hi = hi;
    hipLaunchKernelGGL(mk_fwd, dim3(grid), dim3(NWAVES * 64), LDS_BYTES, stream, a);
}
extern "C" void kernel_launch(void* const* d_in, const int* in_sizes, int n_in, void* d_out, int out_size, void* d_ws, size_t ws_size, hipStream_t stream) {
    static int grid = 0;
    if (grid == 0) {
        if (n_in != 24 || ws_size < WS_END || out_size != M * D) { fprintf(stderr, "kernel_launch: unexpected inputs (%d), out (%d) or workspace (%zu)\n", n_in, out_size, ws_size); grid = -1; return; }
        int dev = 0, cus = 0;
        if (hipGetDevice(&dev) != hipSuccess || hipDeviceGetAttribute(&cus, hipDeviceAttributeMultiprocessorCount, dev) != hipSuccess) { grid = -1; return; }
        if (hipFuncSetAttribute((const void*)mk_fwd, hipFuncAttributeMaxDynamicSharedMemorySize, LDS_BYTES) != hipSuccess) { fprintf(stderr, "kernel_launch: hipFuncSetAttribute failed\n"); grid = -1; return; }
        (void)hipGetLastError();
        grid = cus;
    }
    if (grid < 0) return;
    unsigned char* ws = (unsigned char*)d_ws;
    hipMemsetAsync(ws + WS_CTL, 0, CTL_ZERO_BYTES, stream);
    Args a{};
    for (int i = 0; i < 24; ++i) a.in[i] = d_in[i];
    a.out = (float*)d_out; a.ws = ws;

    const int* positions = (const int*)d_in[1];
    const float* gdn_conv = (const float*)d_in[4]; const float* gdn_a_log = (const float*)d_in[5]; const float* gdn_dt_bias = (const float*)d_in[6]; const float* gdn_norm_g = (const float*)d_in[7];
    const float* mu = (const float*)d_in[12]; const float* w0 = (const float*)d_in[13]; const float* w2 = (const float*)d_in[14]; const float* a0 = (const float*)d_in[15];
    const float* a2 = (const float*)d_in[16]; const float* k_k = (const float*)d_in[17]; const float* k_a = (const float*)d_in[18]; const float* r_k = (const float*)d_in[19];
    const float* ln_g = (const float*)d_in[20]; const float* ln_b = (const float*)d_in[21];
    bf16* WuqT = (bf16*)(ws + WS_WSMALL + OFF_WUQ); bf16* WukvT = (bf16*)(ws + WS_WSMALL + OFF_WUKV);
    float* Psm = (float*)(ws + WS_PSM); float* cb = (float*)(ws + WS_CB);
    bf16* Pgate = (bf16*)(ws + WS_PGATE); bf16* Pgdn = (bf16*)(ws + WS_PGDN); bf16* Pmla = (bf16*)(ws + WS_PMLA); bf16* Prw = (bf16*)(ws + WS_PRW);
    bf16* Ogdn = (bf16*)(ws + WS_OGDN); bf16* Omla = (bf16*)(ws + WS_OMLA); bf16* Y = (bf16*)(ws + WS_Y);
    unsigned char* Rs = ws + WS_RS; unsigned char* Rd = ws + WS_RD;
    bf16* Q = (bf16*)(ws + WS_Q); bf16* Kb = (bf16*)(ws + WS_K); bf16* Vt = (bf16*)(ws + WS_VT); bf16* mix = (bf16*)(ws + WS_MIX);

#if MK_SINGLE
    launch_phases(stream, grid, a, 0, NPHASE);
    return;
#endif
    launch_phases(stream, grid, a, 0, 1);
    for (int l = 0; l < 2; ++l) {
        launch_phases(stream, grid, a, 1 + 5 * l, 2 + 5 * l);
#if MK_P2
        launch_phases(stream, grid, a, 2 + 5 * l, 3 + 5 * l);
#else
        hipLaunchKernelGGL(nk_mla_prep, dim3(M), dim3(64), 0, stream, Pmla, WuqT + (size_t)l * 576 * 192, WukvT + (size_t)l * 768 * 128, positions, Q, Kb, Vt);
        hipLaunchKernelGGL(nk_rwkv_prep, dim3(M), dim3(256), 0, stream, Prw, mu + l * 2 * 896, w0 + l * 512, w2 + (size_t)l * 2 * 64 * 256, a0 + l * 512, a2 + (size_t)l * 2 * 64 * 256,
                           k_k + l * 256, k_a + l * 256, r_k + l * 256, Rs, Rd, cb);
#endif
#if MK_P3
        launch_phases(stream, grid, a, 3 + 5 * l, 4 + 5 * l);
#else
        hipLaunchKernelGGL(nk_attn, dim3(SEQ / 128, BATCH * 6), dim3(128), 0, stream, Q, Kb, Vt, Omla);
        for (int dir = 0; dir < 2; ++dir) {
            hipLaunchKernelGGL(nk_gdn, dim3(BATCH * 6), dim3(64), 0, stream, Pgdn, Psm, gdn_conv + (size_t)l * 5 * 1152, gdn_a_log + l * 12, gdn_dt_bias + l * 12, Ogdn, dir);
            hipLaunchKernelGGL(nk_rwkv, dim3(BATCH * 4), dim3(64), 0, stream, Rs, Rd, Y, dir);
        }
#endif
#if MK_P4A
        launch_phases(stream, grid, a, 4 + 5 * l, 5 + 5 * l);
#else
        hipLaunchKernelGGL(nk_mix, dim3(M), dim3(1024), 0, stream, Ogdn, Omla, Y, Pgate, Rs, cb, gdn_norm_g + l * 64, ln_g + l * 256, ln_b + l * 256, mix);
#endif
        launch_phases(stream, grid, a, 5 + 5 * l, 6 + 5 * l);
    }
    launch_phases(stream, grid, a, 11, 12);
}
```

```cpp
#include <hip/hip_runtime.h>
#include <cstdio>
#include <cstdint>
#include <hip/hip_fp16.h>
namespace pg8 {
#define PG8_LAS __attribute__((address_space(3)))
typedef unsigned short bf16_t;
typedef short bf16x8 __attribute__((ext_vector_type(8)));
typedef float f32x4 __attribute__((ext_vector_type(4)));
typedef unsigned u32x4 __attribute__((ext_vector_type(4)));
constexpr int BM = 256, BK = 64, HALF = 128, HTB = HALF * BK * 2  , STAGE_BYTES = 8 * HTB, NXCD = 8, WGM = 8;

__host__ __device__ __forceinline__ int lds_byte(int r, int c) { const int st = (r >> 4) * 2 + (c >> 5), rr = r & 15, cc = c & 31, ob = rr * 64 + cc * 2; return st * 1024 + (ob ^ (((ob >> 9) & 1) << 5)); }
__host__ __device__ __forceinline__ void stage_rc(int b, int& R, int& C) { const int st = b / 1024, sb = b % 1024, swz = sb ^ (((sb >> 9) & 1) << 5); R = (st >> 1) * 16 + swz / 64; C = (st & 1) * 32 + (swz % 64) / 2; }
__host__ __device__ __forceinline__ int perm32(int rho) { const int n = rho >> 4, i = rho & 15; return 8 * (i >> 2) + 4 * n + (i & 3); }

struct Unit { int pm, pn; };
struct Gemm { const bf16_t* A; const bf16_t* Bt; int M, N, K; };

struct StaticOrder {
    int nM, nN, nwg, G, c;
    __host__ __device__ void init(int M, int N, int G_, int c_) { nM = M / BM; nN = N / BM; nwg = nM * nN; G = G_; c = c_; }
    __host__ __device__ bool next(int i, Unit& u) const {
        const long L = (long)i * G + c; if (L >= nwg) return false;
        int wgid = (int)L; { const int q = nwg / NXCD, r = nwg % NXCD, xcd = wgid % NXCD, off = wgid / NXCD; wgid = (xcd < r ? xcd * (q + 1) : r * (q + 1) + (xcd - r) * q) + off; }
        const int nig = WGM * nN, gid = wgid / nig, fm = gid * WGM, gsz = (nM - fm) < WGM ? (nM - fm) : WGM;
        u.pm = fm + ((wgid % nig) % gsz); u.pn = (wgid % nig) / gsz; return true;
    }
    __device__ __forceinline__ void a_ready(const Unit&) const {}
    __device__ __forceinline__ void done(const Unit&) const {}
};

__device__ __forceinline__ unsigned cvt_pk_bf16(float lo, float hi) { unsigned r; asm volatile("v_cvt_pk_bf16_f32 %0, %1, %2" : "=v"(r) : "v"(lo), "v"(hi)); return r; }
typedef float f32x2 __attribute__((ext_vector_type(2)));
constexpr int TIDTAB_OFF = 131072 + 320 + 512;
__device__ __forceinline__ unsigned hw_slot() { return (unsigned)__builtin_amdgcn_s_getreg((5 << 11) | 4) & 63u; }
__device__ __forceinline__ int mk_tid(PG8_LAS unsigned char* lds_base) {
    const unsigned lane = __builtin_amdgcn_mbcnt_hi(~0u, __builtin_amdgcn_mbcnt_lo(~0u, 0u));
    const unsigned w = __builtin_amdgcn_readfirstlane(((volatile PG8_LAS unsigned*)(lds_base + TIDTAB_OFF))[hw_slot()]);
    return (int)(w * 64u + lane);
}
struct EpiRoute {
    static constexpr bool PERM = true, AFTER_DRAIN = false;
    unsigned char* ws;
    __device__ __forceinline__ void operator()(const f32x4 (&acc)[2][2][4][2], const Unit& u, int wr, int wc, int fr, int fq) const {
        const int row0 = u.pm * BM + wr * 64 + fr;
        const float* rowss = (const float*)(ws + (1u << 20)); float* Psm = (float*)(ws + (22u << 20));
        unsigned base[2]; int ld[2], cc[2], kind[2];
#pragma unroll
        for (int bj = 0; bj < 2; ++bj) {
            const int cg = u.pn * BM + bj * HALF + wc * 32, col = cg + 8 * fq;
            if (cg < 1024) { base[bj] = 25u << 20; ld[bj] = 1024; cc[bj] = col; kind[bj] = 0; }
            else if (cg < 2176) { base[bj] = 57u << 20; ld[bj] = 1152; cc[bj] = col - 1024; kind[bj] = 0; }
            else if (cg < 2528) { base[bj] = 93u << 20; ld[bj] = 352; cc[bj] = col - 2176; kind[bj] = 0; }
            else if (cg < 3424) { base[bj] = 104u << 20; ld[bj] = 896; cc[bj] = col - 2528; kind[bj] = 0; }
            else if (cg < 3456) { base[bj] = 0u; ld[bj] = 32; cc[bj] = col - 3424; kind[bj] = 1; }
            else { base[bj] = 0u; ld[bj] = 0; cc[bj] = 0; kind[bj] = 2; }
        }
#pragma unroll
        for (int ai = 0; ai < 2; ++ai)
#pragma unroll
            for (int m = 0; m < 4; ++m) {
                const int row = row0 + ai * HALF + m * 16;
                const f32x4* rp = (const f32x4*)(rowss + (size_t)row * 16);
                const f32x4 s0 = rp[0], s1 = rp[1], s2 = rp[2], s3 = rp[3];
                const float ss = ((s0[0] + s0[1]) + (s0[2] + s0[3])) + ((s1[0] + s1[1]) + (s1[2] + s1[3])) + ((s2[0] + s2[1]) + (s2[2] + s2[3])) + ((s3[0] + s3[1]) + (s3[2] + s3[3]));
                const float rstd = __builtin_amdgcn_rsqf(ss * (1.0f / 1024.0f) + 1e-6f);
#pragma unroll
                for (int bj = 0; bj < 2; ++bj) {
                    const f32x4 v0 = acc[ai][bj][m][0] * rstd, v1 = acc[ai][bj][m][1] * rstd;
                    if (kind[bj] == 0) { u32x4 w; w.x = cvt_pk_bf16(v0[0], v0[1]); w.y = cvt_pk_bf16(v0[2], v0[3]); w.z = cvt_pk_bf16(v1[0], v1[1]); w.w = cvt_pk_bf16(v1[2], v1[3]);
                        *(u32x4*)((bf16_t*)(ws + base[bj]) + (size_t)row * ld[bj] + cc[bj]) = w; }
                    else if (kind[bj] == 1) { float* p = Psm + (size_t)row * 32 + cc[bj]; *(f32x4*)p = v0; *(f32x4*)(p + 4) = v1; }
                }
                asm volatile("" ::: "memory");
            }
    }
};
struct EpiOut {
    static constexpr bool PERM = false, AFTER_DRAIN = false;
    const float* xin; float* xout; unsigned char* ws;
    __device__ __forceinline__ void operator()(const f32x4 (&acc)[2][2][4][2], const Unit& u, int wr, int wc, int fr, int fq) const {
        typedef unsigned u32x2v __attribute__((ext_vector_type(2)));
        const int row0 = u.pm * BM + wr * 64 + fr, col0 = u.pn * BM + wc * 32 + 4 * fq;
        float* rowss = (float*)(ws + (1u << 20)); bf16_t* xb = (bf16_t*)(ws + (133u << 20));
#pragma unroll
        for (int ai = 0; ai < 2; ++ai)
#pragma unroll
            for (int m = 0; m < 4; ++m) {
                const int row = row0 + ai * HALF + m * 16; float ss = 0.f;
#pragma unroll
                for (int bj = 0; bj < 2; ++bj)
#pragma unroll
                    for (int n = 0; n < 2; ++n) {
                        const size_t off = (size_t)row * 1024 + col0 + bj * HALF + n * 16;
                        const f32x4 o = *(const f32x4*)(xin + off) + acc[ai][bj][m][n];
                        *(f32x4*)(xout + off) = o;
                        u32x2v w; w.x = cvt_pk_bf16(o[0], o[1]); w.y = cvt_pk_bf16(o[2], o[3]); *(u32x2v*)(xb + off) = w;
                        ss += (o[0] * o[0] + o[1] * o[1]) + (o[2] * o[2] + o[3] * o[3]);
                    }
                ss += __shfl_xor(ss, 16); ss += __shfl_xor(ss, 32);
                if (fq == 0) rowss[(size_t)row * 16 + u.pn * 4 + wc] = ss;
                asm volatile("" ::: "memory");
            }
    }
};
template <class Epi, class Sched, bool ALIGN_EPI = false, bool SP2 = false>
__device__ __forceinline__ void gemm_phase(PG8_LAS unsigned char* lds, const Gemm g, const Sched& S, const Epi& E) {
    const int tid_ = mk_tid(lds);
    const int tid = tid_, wid = __builtin_amdgcn_readfirstlane(tid >> 6), lane = tid & 63, wr = wid >> 2, wc = wid & 3, fr = lane & 15, fq = lane >> 4;
    const int K = g.K, nt = K / BK;
    unsigned voffA[2], voffB[2];
#pragma unroll
    for (int i = 0; i < 2; ++i) { int R, C; stage_rc(tid * 16 + i * 8192, R, C); const int Rb = Epi::PERM ? ((R & ~31) + perm32(R & 31)) : R;
        voffA[i] = (unsigned)(R * K + C) * 2u; voffB[i] = (unsigned)(Rb * K + C) * 2u; }
    const size_t kstep = (size_t)(BK * 2);
    const size_t hstep = (size_t)HALF * K * 2;
    const size_t tstep = 2 * hstep;
    const unsigned ldsw = (unsigned)wid * 1024u;
    const int aoff = lds_byte(wr * 64 + fr, fq * 8), boff = lds_byte(wc * 32 + fr, fq * 8);
#define PG8_SA(b, h) (((b) * 2 + (h)) * HTB)
#define PG8_SB(b, h) ((4 + (b) * 2 + (h)) * HTB)
#define PG8_STAGE(bufoff, gbase, voff) do { _Pragma("unroll") for (int _i = 0; _i < 2; ++_i) \
        __builtin_amdgcn_global_load_lds((const unsigned*)((const char*)(gbase) + (voff)[_i]), (PG8_LAS unsigned*)(lds + (bufoff) + ldsw + _i * 8192), 16, 0, 0); } while (0)
#define PG8_LDA(dst, b, h) do { _Pragma("unroll") for (int m = 0; m < 4; ++m) _Pragma("unroll") for (int k = 0; k < 2; ++k) dst[m][k] = *(const PG8_LAS bf16x8*)(lds + PG8_SA(b, h) + aoff + m * 2048 + k * 1024); } while (0)
#define PG8_LDB(dst, b, h) do { _Pragma("unroll") for (int n = 0; n < 2; ++n) _Pragma("unroll") for (int k = 0; k < 2; ++k) dst[n][k] = *(const PG8_LAS bf16x8*)(lds + PG8_SB(b, h) + boff + n * 2048 + k * 1024); } while (0)
#define PG8_MMA(ai, bj, At, Bt) do { __builtin_amdgcn_s_setprio(1); _Pragma("unroll") for (int m = 0; m < 4; ++m) _Pragma("unroll") for (int n = 0; n < 2; ++n) _Pragma("unroll") for (int k = 0; k < 2; ++k) \
        acc[ai][bj][m][n] = __builtin_amdgcn_mfma_f32_16x16x32_bf16(Bt[n][k], At[m][k], acc[ai][bj][m][n], 0, 0, 0); __builtin_amdgcn_s_setprio(0); } while (0)
#define PG8_WAIT_V(n) asm volatile("s_waitcnt vmcnt(" #n ")" ::: "memory")
#define PG8_WAIT_L(n) asm volatile("s_waitcnt lgkmcnt(" #n ")" ::: "memory")
#define PG8_BAR __builtin_amdgcn_s_barrier()
#define PG8_SCHED __builtin_amdgcn_sched_barrier(0)
    Unit cur, nxt; int ui = 0;
    if (!S.next(0, cur)) return;
    f32x4 acc[2][2][4][2];
#pragma unroll
    for (int a = 0; a < 2; ++a)
#pragma unroll
        for (int b = 0; b < 2; ++b)
#pragma unroll
            for (int m = 0; m < 4; ++m)
#pragma unroll
                for (int n = 0; n < 2; ++n) acc[a][b][m][n] = (f32x4){0.f, 0.f, 0.f, 0.f};
    bf16x8 At[4][2], B0[2][2], B1[2][2];
    const char* cA = (const char*)g.A + (size_t)cur.pm * tstep; const char* cB = (const char*)g.Bt + (size_t)cur.pn * tstep;
    S.a_ready(cur);
    if constexpr (SP2) {
        PG8_STAGE(PG8_SB(0, 0), cB, voffB); PG8_STAGE(PG8_SB(0, 1), cB + hstep, voffB); PG8_STAGE(PG8_SA(0, 0), cA, voffA); PG8_STAGE(PG8_SA(0, 1), cA + hstep, voffA);
        if (wr == 1) PG8_BAR;
        PG8_WAIT_V(2); PG8_BAR;
        PG8_STAGE(PG8_SB(1, 0), cB + kstep, voffB); PG8_STAGE(PG8_SA(1, 0), cA + kstep, voffA); PG8_STAGE(PG8_SB(1, 1), cB + hstep + kstep, voffB);
        PG8_WAIT_V(6); PG8_BAR;
    } else {
        PG8_STAGE(PG8_SB(0, 0), cB, voffB); PG8_STAGE(PG8_SA(0, 0), cA, voffA); PG8_STAGE(PG8_SB(0, 1), cB + hstep, voffB); PG8_STAGE(PG8_SA(0, 1), cA + hstep, voffA);
        if (wr == 1) PG8_BAR;
        PG8_WAIT_V(4); PG8_BAR;
        PG8_STAGE(PG8_SB(1, 0), cB + kstep, voffB); PG8_STAGE(PG8_SA(1, 0), cA + kstep, voffA); PG8_STAGE(PG8_SB(1, 1), cB + hstep + kstep, voffB);
        PG8_WAIT_V(6); PG8_BAR;
    }
    for (;;) {
        const bool has_next = S.next(ui + 1, nxt);
        const char* nA = has_next ? (const char*)g.A + (size_t)nxt.pm * tstep : cA; const char* nB = has_next ? (const char*)g.Bt + (size_t)nxt.pn * tstep : cB;
        for (int t = 0; t < nt; t += 2) {
            const bool last = (t == nt - 2);
            const char* a1 = cA + (size_t)(t + 1) * kstep;
            const char* a2 = last ? nA : cA + (size_t)(t + 2) * kstep; const char* b2 = last ? nB : cB + (size_t)(t + 2) * kstep;
            const char* a3 = a2 + kstep; const char* b3 = b2 + kstep;
            if (last && has_next) S.a_ready(nxt);
            if constexpr (SP2) {
            PG8_LDB(B0, 0, 0); PG8_LDB(B1, 0, 1); PG8_SCHED; PG8_LDA(At, 0, 0); PG8_STAGE(PG8_SA(1, 1), a1 + hstep, voffA);
            PG8_WAIT_V(8); PG8_WAIT_L(0); PG8_BAR; PG8_MMA(0, 0, At, B0); PG8_MMA(0, 1, At, B1); PG8_BAR; PG8_SCHED;
            PG8_LDA(At, 0, 1); PG8_STAGE(PG8_SB(0, 0), b2, voffB); PG8_STAGE(PG8_SB(0, 1), b2 + hstep, voffB); PG8_STAGE(PG8_SA(0, 0), a2, voffA);
            PG8_WAIT_V(8); PG8_WAIT_L(0); PG8_BAR; PG8_MMA(1, 0, At, B0); PG8_MMA(1, 1, At, B1); PG8_BAR; PG8_SCHED;
            PG8_LDB(B0, 1, 0); PG8_LDB(B1, 1, 1); PG8_SCHED; PG8_LDA(At, 1, 0); PG8_STAGE(PG8_SA(0, 1), a2 + hstep, voffA);
            PG8_WAIT_V(8); PG8_WAIT_L(0); PG8_BAR; PG8_MMA(0, 0, At, B0); PG8_MMA(0, 1, At, B1); PG8_BAR; PG8_SCHED;
            PG8_LDA(At, 1, 1); PG8_STAGE(PG8_SB(1, 0), b3, voffB); PG8_STAGE(PG8_SB(1, 1), b3 + hstep, voffB); PG8_STAGE(PG8_SA(1, 0), a3, voffA);
            PG8_WAIT_V(8); PG8_WAIT_L(0); PG8_BAR; PG8_MMA(1, 0, At, B0); PG8_MMA(1, 1, At, B1); PG8_BAR; PG8_SCHED;
            } else {
            PG8_LDB(B0, 0, 0); PG8_SCHED; PG8_LDA(At, 0, 0); PG8_STAGE(PG8_SA(1, 1), a1 + hstep, voffA);
            PG8_WAIT_L(8); PG8_BAR; PG8_WAIT_L(0); PG8_MMA(0, 0, At, B0); PG8_BAR; PG8_SCHED;
            PG8_LDB(B1, 0, 1); PG8_STAGE(PG8_SB(0, 0), b2, voffB);
            PG8_BAR; PG8_WAIT_L(0); PG8_MMA(0, 1, At, B1); PG8_BAR;
            PG8_LDA(At, 0, 1); PG8_STAGE(PG8_SA(0, 0), a2, voffA);
            PG8_BAR; PG8_WAIT_L(0); PG8_MMA(1, 0, At, B0); PG8_BAR; PG8_SCHED;
            PG8_STAGE(PG8_SB(0, 1), b2 + hstep, voffB);
            PG8_WAIT_V(6); PG8_BAR; PG8_MMA(1, 1, At, B1); PG8_BAR;
            PG8_LDB(B0, 1, 0); PG8_SCHED; PG8_LDA(At, 1, 0); PG8_STAGE(PG8_SA(0, 1), a2 + hstep, voffA);
            PG8_WAIT_L(8); PG8_BAR; PG8_WAIT_L(0); PG8_MMA(0, 0, At, B0); PG8_BAR; PG8_SCHED;
            PG8_LDB(B1, 1, 1); PG8_STAGE(PG8_SB(1, 0), b3, voffB);
            PG8_BAR; PG8_WAIT_L(0); PG8_MMA(0, 1, At, B1); PG8_BAR;
            PG8_LDA(At, 1, 1); PG8_STAGE(PG8_SA(1, 0), a3, voffA);
            PG8_BAR; PG8_WAIT_L(0); PG8_MMA(1, 0, At, B0); PG8_BAR; PG8_SCHED;
            PG8_STAGE(PG8_SB(1, 1), b3 + hstep, voffB);
            PG8_WAIT_V(6); PG8_BAR; PG8_MMA(1, 1, At, B1); PG8_BAR;
            }
        }
        if constexpr (ALIGN_EPI) { if (wr == 0) PG8_BAR; }
        if constexpr (!Epi::AFTER_DRAIN) { E(acc, cur, wr, wc, fr, fq); S.done(cur); }
        if (!has_next) break;
#pragma unroll
        for (int a = 0; a < 2; ++a)
#pragma unroll
            for (int b = 0; b < 2; ++b)
#pragma unroll
                for (int m = 0; m < 4; ++m)
#pragma unroll
                    for (int n = 0; n < 2; ++n) acc[a][b][m][n] = (f32x4){0.f, 0.f, 0.f, 0.f};
        cur = nxt; cA = nA; cB = nB; ++ui;
        if constexpr (ALIGN_EPI) { if (wr == 1) PG8_BAR; }
    }
    PG8_WAIT_V(0);
    if constexpr (!ALIGN_EPI) { if (wr == 0) PG8_BAR; }
    PG8_BAR;
    if constexpr (Epi::AFTER_DRAIN) { E.fused(acc, cur, wr, wc, fr, fq, lds, wid, lane); S.done(cur); }
#undef PG8_SA
#undef PG8_SB
#undef PG8_STAGE
#undef PG8_LDA
#undef PG8_LDB
#undef PG8_MMA
#undef PG8_WAIT_V
#undef PG8_WAIT_L
#undef PG8_BAR
#undef PG8_SCHED
}
}
#define GAS __attribute__((address_space(1)))
#define LAS __attribute__((address_space(3)))
typedef unsigned short bf16;
typedef unsigned v4u __attribute__((ext_vector_type(4)));
typedef float f32x4 __attribute__((ext_vector_type(4)));
typedef short bf16x8 __attribute__((ext_vector_type(8)));
typedef GAS unsigned gu32;
typedef GAS unsigned long long gu64;
#define RLX_AGENT __ATOMIC_RELAXED, __HIP_MEMORY_SCOPE_AGENT
#define LDS_WAIT() asm volatile("s_waitcnt lgkmcnt(0)" ::: "memory")
#define VM_WAIT() asm volatile("s_waitcnt vmcnt(0)" ::: "memory")
__device__ __forceinline__ unsigned long long rt() { return __builtin_amdgcn_s_memrealtime(); }
__device__ __forceinline__ unsigned f2bf(float f) { unsigned u = __builtin_bit_cast(unsigned, f); return (u + 0x7fffu + ((u >> 16) & 1u)) >> 16; }
__device__ __forceinline__ unsigned pk2(float lo, float hi) { return f2bf(lo) | (f2bf(hi) << 16); }

#define XB_TMO      128
#define XB_XCNT(j)  (256  + 64 * (j))
#define XB_XSUB(j)  (1280 + 64 * (j))
#define XB_XGEN(j)  (2304 + 64 * (j))
#define XB_TOP      3328
#define XB_TOPGEN   3392
#define XCD_BAR_WORDS 3456
#define XB_SPIN_CAP (1u << 18)

__device__ __forceinline__ unsigned xb_ld(unsigned* p)              { return __hip_atomic_load(p, __ATOMIC_RELAXED, __HIP_MEMORY_SCOPE_AGENT); }
__device__ __forceinline__ unsigned xb_add(unsigned* p, unsigned v) { return __hip_atomic_fetch_add(p, v, __ATOMIC_RELAXED, __HIP_MEMORY_SCOPE_AGENT); }
__device__ __forceinline__ unsigned xb_xcc_id() { return (unsigned)__builtin_amdgcn_s_getreg((3 << 11) | 20) & 0xFu; }
#define XB_SPIN(cond, bar) do { unsigned _sp = 0; while (cond) { __builtin_amdgcn_s_sleep(1); \
    if ((++_sp & 255u) == 0u) { if (xb_ld(&(bar)[XB_TMO])) break; if (_sp > XB_SPIN_CAP) { atomicAdd(&(bar)[XB_TMO], 1u); break; } } } } while (0)

struct XcdBarrier {
    unsigned* bar; unsigned x;
    volatile LAS unsigned* st;
};

__device__ __forceinline__ XcdBarrier xcd_barrier_post(unsigned* bar, volatile LAS unsigned* st) {
    XcdBarrier b; b.bar = bar; b.x = xb_xcc_id(); b.st = st;
    if (threadIdx.x == 0) (void)xb_add(&bar[XB_XCNT(b.x)], 1u);
    return b;
}
__device__ __forceinline__ void xcd_barrier_complete(unsigned* bar, unsigned x, unsigned& nloc, unsigned& nx) {
    const unsigned G = gridDim.x * gridDim.y * gridDim.z;
    unsigned sum, cnt, mine, sp = 0u;
    for (;;) {
        sum = 0u; cnt = 0u; mine = 0u;
#pragma unroll
        for (unsigned j = 0; j < 16; ++j) { const unsigned c = xb_ld(&bar[XB_XCNT(j)]); sum += c; cnt += (c > 0u) ? 1u : 0u; mine = (j == x) ? c : mine; }
        if (sum == G) break;
        __builtin_amdgcn_s_sleep(1);
        if ((++sp & 255u) == 0u) { if (xb_ld(&bar[XB_TMO])) break; if (sp > XB_SPIN_CAP) { atomicAdd(&bar[XB_TMO], 1u); break; } }
    }
    nloc = mine > 0u ? mine : 1u; nx = cnt > 0u ? cnt : 1u;
}

__device__ __forceinline__ void xcd_barrier(const XcdBarrier& b) {
    asm volatile("s_waitcnt vmcnt(0)" ::: "memory");
    __syncthreads();
    if (pg8::mk_tid((LAS unsigned char*)b.st - (131072 + 320 + 32)) == 0) {
        unsigned* bar = b.bar;
        __builtin_amdgcn_s_waitcnt(0);
        unsigned nloc = b.st[0], nx = b.st[1];
        if (nloc == 0u) { xcd_barrier_complete(bar, b.x, nloc, nx); b.st[0] = nloc; b.st[1] = nx; }
        const unsigned old = xb_add(&bar[XB_XSUB(b.x)], 1u);
        const unsigned gen = old / nloc;
        if (old + 1u == (gen + 1u) * nloc) {
            __builtin_amdgcn_fence(__ATOMIC_RELEASE, "agent");
            asm volatile("s_waitcnt vmcnt(0)" ::: "memory");
            const unsigned og = xb_add(&bar[XB_TOP], 1u);
            const unsigned tg = og / nx;
            if (og + 1u == (tg + 1u) * nx) xb_add(&bar[XB_TOPGEN], 1u);
            else XB_SPIN(xb_ld(&bar[XB_TOPGEN]) == tg, bar);
            __builtin_amdgcn_fence(__ATOMIC_ACQUIRE, "agent");
            xb_add(&bar[XB_XGEN(b.x)], 1u);
            asm volatile("s_waitcnt vmcnt(0)" ::: "memory");
        } else {
            XB_SPIN(xb_ld(&bar[XB_XGEN(b.x)]) == gen, bar);
            __builtin_amdgcn_fence(__ATOMIC_ACQUIRE, "agent");
            asm volatile("s_waitcnt vmcnt(0)" ::: "memory");
        }
    }
    __syncthreads();
}
constexpr int BATCH = 8, SEQ = 2048, M = BATCH * SEQ, D = 1024, NIN = 3448, NP = 3584;
constexpr float NORM_EPS = 1e-6f;
constexpr float LOG2E = 1.4426950408889634f;
constexpr size_t MiB = 1u << 20;
constexpr size_t WS_CTL = 0, CTL_ZERO_BYTES = 1 * MiB;
constexpr size_t WS_ROWSS = 1 * MiB;
constexpr size_t WS_WIN = 2 * MiB;
constexpr size_t WS_WOUT = 16 * MiB;
constexpr size_t WS_WSMALL = 20 * MiB;
constexpr size_t OFF_WUQ = 0, OFF_WUKV = 2 * 576 * 192 * 2, OFF_W2T = OFF_WUKV + 2 * 768 * 128 * 2, OFF_A2T = OFF_W2T + 2 * 2 * 256 * 64 * 2;
constexpr size_t WS_PSM = 22 * MiB;
constexpr size_t WS_CB = 24 * MiB;
constexpr size_t WS_PGATE = 25 * MiB;
constexpr size_t WS_PGDN = 57 * MiB;
constexpr size_t WS_PMLA = 93 * MiB;
constexpr size_t WS_PRW = 104 * MiB;
constexpr size_t WS_OGDN = 93 * MiB;
constexpr size_t WS_OMLA = 105 * MiB;
constexpr size_t WS_Y = 117 * MiB;
constexpr size_t WS_RS = 133 * MiB;
constexpr size_t WS_RD = 157 * MiB;
constexpr size_t WS_XB = 133 * MiB;
constexpr size_t WS_Q = 207 * MiB;
constexpr size_t WS_K = 225 * MiB;
constexpr size_t WS_VT = 243 * MiB;
constexpr size_t WS_MIX = 207 * MiB;
constexpr size_t WS_END = 255 * MiB;
constexpr int RS_REC = 384, RD_REC = 400;
constexpr size_t RD_DIR = (size_t)BATCH * 4 * SEQ * RD_REC;
constexpr int CW_BAR = 4096;
constexpr int CW_QUEUE = 16384;

constexpr int NWAVES = 8;
constexpr int RING_OFF = 0, RING_BYTES = 131072, LDSCTL_OFF = RING_BYTES, MISC_OFF = LDSCTL_OFF + 320, LDS_BYTES = 147456;
static_assert(pg8::TIDTAB_OFF == MISC_OFF + 512 && RING_OFF == 0, "LDS map");
constexpr int NPHASE = 12;

__device__ __forceinline__ float bf2f(bf16 v) { return __uint_as_float(((unsigned)v) << 16); }
__device__ __forceinline__ float wave_sum(float v) {
#pragma unroll
    for (int o = 1; o < 64; o <<= 1) v += __shfl_xor(v, o);
    return v;
}
__device__ __forceinline__ float siluf(float x) { return x / (1.f + __expf(-x)); }
__device__ __forceinline__ float sigmoidf_(float x) { return 1.f / (1.f + __expf(-x)); }
__device__ __forceinline__ float softplusf_(float x) { return x > 20.f ? x : log1pf(__expf(x)); }

struct Args { const void* in[24]; float* out; unsigned char* ws; int ph_lo, ph_hi; };

struct Frame {
    LAS unsigned char* lds;
    volatile LAS unsigned* MISC;
    gu32* ctl;
    int tid, lane, wave, vcu, G;
    unsigned char* ws;
    float* out;
    volatile LAS const unsigned long long* ptab;
};
__device__ __forceinline__ const void* inptr(const Frame& F, int k) {
    const unsigned long long v = F.ptab[k];
    const unsigned lo = __builtin_amdgcn_readfirstlane((unsigned)v), hi = __builtin_amdgcn_readfirstlane((unsigned)(v >> 32));
    return (const void*)(((unsigned long long)hi << 32) | lo);
}

__device__ __forceinline__ void tr_item(const float* W, int K, int ldsrc, int scol, int nvalid, bf16* WT, const float* gs, LAS float* scr, int kb, int lane) {
    const int k0 = 64 * kb;
#pragma unroll 8
    for (int i = 0; i < 32; ++i) { const int kk = 2 * i + (lane >> 5), n = lane & 31; float v = 0.f;
        if (n < nvalid) { v = W[(size_t)(k0 + kk) * ldsrc + scol + n]; if (gs) v *= gs[k0 + kk]; }
        scr[kk * 33 + n] = v; }
    LDS_WAIT(); asm volatile("" ::: "memory");
    const int c = lane & 7;
#pragma unroll
    for (int j = 0; j < 4; ++j) { const int n = (lane >> 3) + 8 * j; const LAS float* s = scr + (8 * c) * 33 + n;
        v4u o; o.x = pk2(s[0 * 33], s[1 * 33]); o.y = pk2(s[2 * 33], s[3 * 33]); o.z = pk2(s[4 * 33], s[5 * 33]); o.w = pk2(s[6 * 33], s[7 * 33]);
        *(GAS v4u*)(WT + (size_t)n * K + k0 + 8 * c) = o; }
    LDS_WAIT(); asm volatile("" ::: "memory");
}
__device__ __forceinline__ void p0_prologue(Frame& F) {
    LAS float* scr = (LAS float*)(F.lds + RING_OFF + F.wave * 16384);
    const int gw = F.vcu * NWAVES + F.wave, NGW = F.G * NWAVES;
    constexpr int I_IN = 112 * 16, I_OUT = 32 * 16, I_UQ = 18 * 3, I_UKV = 24 * 2, I_W2 = 16, I_A2 = 16, I_L = I_IN + I_OUT + I_UQ + I_UKV + I_W2 + I_A2;
    for (int it = gw; it < 2 * I_L; it += NGW) {
        const int l = it / I_L; int r = it % I_L;
        if (r < I_IN) { const int nb = r >> 4, kb = r & 15, n0 = 32 * nb; int scol, nv;
            if (n0 < 2176) { scol = n0; nv = 32; } else if (n0 < 3424) { scol = n0 + 24; nv = 32; } else if (n0 == 3424) { scol = 2176; nv = 24; } else { scol = 0; nv = 0; }
            tr_item((const float*)inptr(F, 3) + (size_t)l * D * NIN, D, NIN, scol, nv, (bf16*)(F.ws + WS_WIN) + ((size_t)l * NP + n0) * D, (const float*)inptr(F, 2) + l * D, scr, kb, F.lane); continue; }
        r -= I_IN;
        if (r < I_OUT) { const int nb = r >> 4, kb = r & 15;
            tr_item((const float*)inptr(F, 22) + (size_t)l * D * D, D, D, 32 * nb, 32, (bf16*)(F.ws + WS_WOUT) + ((size_t)l * D + 32 * nb) * D, nullptr, scr, kb, F.lane); continue; }
        r -= I_OUT;
        if (r < I_UQ) { const int nb = r / 3, kb = r % 3;
            tr_item((const float*)inptr(F, 9) + (size_t)l * 192 * 576, 192, 576, 32 * nb, 32, (bf16*)(F.ws + WS_WSMALL + OFF_WUQ) + ((size_t)l * 576 + 32 * nb) * 192, (const float*)inptr(F, 8) + l * 192, scr, kb, F.lane); continue; }
        r -= I_UQ;
        if (r < I_UKV) { const int nb = r >> 1, kb = r & 1;
            tr_item((const float*)inptr(F, 11) + (size_t)l * 128 * 768, 128, 768, 32 * nb, 32, (bf16*)(F.ws + WS_WSMALL + OFF_WUKV) + ((size_t)l * 768 + 32 * nb) * 128, (const float*)inptr(F, 10) + l * 128, scr, kb, F.lane); continue; }
        r -= I_UKV;
        if (r < I_W2) { const int e = r >> 3, nb = r & 7;
            tr_item((const float*)inptr(F, 14) + ((size_t)l * 2 + e) * 64 * 256, 64, 256, 32 * nb, 32, (bf16*)(F.ws + WS_WSMALL + OFF_W2T) + (((size_t)l * 2 + e) * 256 + 32 * nb) * 64, nullptr, scr, 0, F.lane); continue; }
        r -= I_W2;
        { const int e = r >> 3, nb = r & 7;
            tr_item((const float*)inptr(F, 16) + ((size_t)l * 2 + e) * 64 * 256, 64, 256, 32 * nb, 32, (bf16*)(F.ws + WS_WSMALL + OFF_A2T) + (((size_t)l * 2 + e) * 256 + 32 * nb) * 64, nullptr, scr, 0, F.lane); }
    }
    const float* x = (const float*)inptr(F, 0); bf16* xb = (bf16*)(F.ws + WS_XB); float* rowss = (float*)(F.ws + WS_ROWSS);
    for (int m = gw; m < M; m += NGW) {
        const GAS f32x4* xr = (const GAS f32x4*)(x + (size_t)m * D) + F.lane;
        GAS unsigned long long* o8 = (GAS unsigned long long*)(xb + (size_t)m * D) + F.lane; float s = 0.f;
#pragma unroll
        for (int j = 0; j < 4; ++j) { const f32x4 v = xr[64 * j]; s += (v.x * v.x + v.y * v.y) + (v.z * v.z + v.w * v.w);
            o8[64 * j] = (unsigned long long)pk2(v.x, v.y) | ((unsigned long long)pk2(v.z, v.w) << 32); }
        s = wave_sum(s);
        if (F.lane < 16) rowss[(size_t)m * 16 + F.lane] = F.lane == 0 ? s : 0.f;
    }
}
__device__ __forceinline__ void p5_final(Frame& F) {
    const int gw = F.vcu * NWAVES + F.wave, NGW = F.G * NWAVES;
    const float* rowss = (const float*)(F.ws + WS_ROWSS); const float* g = (const float*)inptr(F, 23);
    f32x4 gv[4];
#pragma unroll
    for (int j = 0; j < 4; ++j) gv[j] = ((const f32x4*)g)[F.lane + 64 * j];
    for (int m = gw; m < M; m += NGW) {
        float ss = F.lane < 16 ? rowss[(size_t)m * 16 + F.lane] : 0.f;
        ss = wave_sum(ss);
        const float rstd = rsqrtf(ss * (1.f / D) + NORM_EPS);
        GAS f32x4* xr = (GAS f32x4*)(F.out + (size_t)m * D) + F.lane;
#pragma unroll
        for (int j = 0; j < 4; ++j) { f32x4 v = xr[64 * j]; v = v * rstd * gv[j]; xr[64 * j] = v; }
    }
}
__device__ __forceinline__ float dotbf(const bf16* a, const bf16* b, int K) {
    float acc = 0.f;
#pragma unroll 2
    for (int k = 0; k < K; k += 8) {
        const v4u av = *(const v4u*)(a + k), bv = *(const v4u*)(b + k);
#pragma unroll
        for (int i = 0; i < 4; ++i) {
            acc += __uint_as_float(av[i] << 16) * __uint_as_float(bv[i] << 16);
            acc += __uint_as_float(av[i] & 0xffff0000u) * __uint_as_float(bv[i] & 0xffff0000u);
        }
    }
    return acc;
}
__device__ __forceinline__ void p2_mla_token(Frame& F, int l, int m, LAS float* raw) {
    const bf16* Pmla = (const bf16*)(F.ws + WS_PMLA);
    const bf16* WuqT = (const bf16*)(F.ws + WS_WSMALL + OFF_WUQ) + (size_t)l * 576 * 192;
    const bf16* WukvT = (const bf16*)(F.ws + WS_WSMALL + OFF_WUKV) + (size_t)l * 768 * 128;
    bf16* Q = (bf16*)(F.ws + WS_Q); bf16* Kb = (bf16*)(F.ws + WS_K); bf16* Vt = (bf16*)(F.ws + WS_VT);
    const int lane = F.lane, b = m / SEQ, t = m % SEQ;
    const bf16* p = Pmla + (size_t)m * 352;
    float s1 = 0.f, s2 = 0.f;
    for (int c = lane; c < 192; c += 64) { const float v = bf2f(p[c]); s1 += v * v; }
    for (int c = lane; c < 128; c += 64) { const float v = bf2f(p[192 + c]); s2 += v * v; }
    s1 = wave_sum(s1); s2 = wave_sum(s2);
    const float rq = rsqrtf(s1 * (1.f / 192.f) + NORM_EPS), rkv = rsqrtf(s2 * (1.f / 128.f) + NORM_EPS);
#pragma unroll 1
    for (int c = lane; c < 576; c += 64) raw[c] = dotbf(p, WuqT + (size_t)c * 192, 192) * rq;
#pragma unroll 1
    for (int c = lane; c < 768; c += 64) raw[576 + c] = dotbf(p + 192, WukvT + (size_t)c * 128, 128) * rkv;
    LDS_WAIT(); asm volatile("" ::: "memory");
    const float pos = (float)((const int*)inptr(F, 1))[m];
    const float qs = 0.10206207261596575f * LOG2E;
#pragma unroll 1
    for (int i = lane; i < 6 * 80; i += 64) {
        const int h = i / 80, j = i % 80;
        bf16* qo = Q + (((size_t)b * 6 + h) * SEQ + t) * 96;
        if (j < 64) qo[j] = f2bf(raw[h * 96 + j] * qs);
        else { const int r = j - 64; const float inv = exp2f(-(float)r * (13.287712379549449f / 16.f)); float sn, cs; sincosf(pos * inv, &sn, &cs);
            const float x1 = raw[h * 96 + 64 + r], x2 = raw[h * 96 + 80 + r];
            qo[64 + r] = f2bf((x1 * cs - x2 * sn) * qs); qo[80 + r] = f2bf((x2 * cs + x1 * sn) * qs); }
    }
#pragma unroll 1
    for (int i = lane; i < 6 * 64; i += 64) {
        const int h = i / 64, j = i % 64;
        Kb[(((size_t)b * 6 + h) * SEQ + t) * 96 + j] = f2bf(raw[576 + h * 128 + j]);
        Vt[(((size_t)b * 6 + h) * 64 + j) * SEQ + t] = f2bf(raw[576 + h * 128 + 64 + j]);
    }
    if (lane < 16) {
        const int r = lane; const float inv = exp2f(-(float)r * (13.287712379549449f / 16.f)); float sn, cs; sincosf(pos * inv, &sn, &cs);
        const float x1 = bf2f(p[320 + r]), x2 = bf2f(p[336 + r]);
        const bf16 o1 = f2bf(x1 * cs - x2 * sn), o2 = f2bf(x2 * cs + x1 * sn);
        for (int h = 0; h < 6; ++h) { bf16* ko = Kb + (((size_t)b * 6 + h) * SEQ + t) * 96; ko[64 + r] = o1; ko[80 + r] = o2; }
    }
    LDS_WAIT(); asm volatile("" ::: "memory");
}
__device__ __forceinline__ void p2_rwkv_token(Frame& F, int l, int m, LAS float* f, int c) {
    const bf16* Prw = (const bf16*)(F.ws + WS_PRW);
    const float* mu = (const float*)inptr(F, 12) + l * 2 * 896; const float* w0 = (const float*)inptr(F, 13) + l * 512; const float* w2 = (const float*)inptr(F, 14) + (size_t)l * 2 * 64 * 256;
    const float* a0 = (const float*)inptr(F, 15) + l * 512; const float* a2 = (const float*)inptr(F, 16) + (size_t)l * 2 * 64 * 256;
    const float* k_k = (const float*)inptr(F, 17) + l * 256; const float* k_a = (const float*)inptr(F, 18) + l * 256; const float* r_k = (const float*)inptr(F, 19) + l * 256;
    unsigned char* Rs = F.ws + WS_RS; unsigned char* Rd = F.ws + WS_RD; float* cb = (float*)(F.ws + WS_CB);
    const int b = m / SEQ, t = m % SEQ, h = c >> 6, j = c & 63;
#pragma unroll 1
    for (int i = c; i < 896; i += 256) {
        const float x = bf2f(Prw[(size_t)m * 896 + i]);
        const float xp = t > 0 ? bf2f(Prw[(size_t)(m - 1) * 896 + i]) : 0.f;
        const float xn = t < SEQ - 1 ? bf2f(Prw[(size_t)(m + 1) * 896 + i]) : 0.f;
        float v = x + mu[i] * (xp - x) + mu[896 + i] * (xn - x);
        if (i >= 768 && i < 832) v = tanhf(v);
        f[i] = v;
    }
    __syncthreads();
    const float r = f[c], k = f[256 + c], v = f[512 + c];
    const float kkr = k * k_k[c];
    const float kn = wave_sum(kkr * kkr);
    const float kk = kkr * rsqrtf(kn + 1e-6f);
    float kmod[2], bb[2], lam[2];
#pragma unroll
    for (int e = 0; e < 2; ++e) {
        float lw = 0.f, la = 0.f;
#pragma unroll 8
        for (int d = 0; d < 64; ++d) { lw += f[768 + d] * w2[((size_t)e * 64 + d) * 256 + c]; la += f[832 + d] * a2[((size_t)e * 64 + d) * 256 + c]; }
        const float wl = -softplusf_(-(w0[e * 256 + c] + lw)) - 0.5f;
        lam[e] = __expf(wl);
        const float a = sigmoidf_(a0[e * 256 + c] + la);
        kmod[e] = k * (1.f + (a - 1.f) * k_a[c]);
        bb[e] = a * kk;
    }
    unsigned char* rs = Rs + (((size_t)b * 4 + h) * SEQ + t) * RS_REC;
    ((bf16*)rs)[j] = f2bf(kk); ((bf16*)(rs + 128))[j] = f2bf(v); ((bf16*)(rs + 256))[j] = f2bf(r);
#pragma unroll
    for (int e = 0; e < 2; ++e) {
        unsigned char* rd = Rd + e * RD_DIR + (((size_t)b * 4 + h) * SEQ + t) * RD_REC;
        ((__half*)rd)[j] = __float2half(lam[e]); ((bf16*)(rd + 128))[j] = f2bf(bb[e]); ((bf16*)(rd + 256))[j] = f2bf(kmod[e]);
        const float br = wave_sum(bb[e] * r), kr = wave_sum(kmod[e] * r);
        if (j == 0) { ((float*)(rd + 384))[0] = br; ((float*)(rd + 384))[1] = kr; }
    }
    const float cbv = wave_sum(r * 0.5f * (kmod[0] + kmod[1]) * r_k[c]);
    if (j == 0) cb[(size_t)m * 4 + h] = cbv;
    __syncthreads();
}
__device__ __forceinline__ void p2_prep(Frame& F, int l) {
    { LAS float* f = (LAS float*)(F.lds + RING_OFF) + (F.tid >> 8) * 896; const int c = F.tid & 255;
      for (int m = 2 * (int)blockIdx.x + (F.tid >> 8); m < M; m += 2 * F.G) p2_rwkv_token(F, l, m, f, c); }
    { LAS float* raw = (LAS float*)(F.lds + RING_OFF + 8192) + F.wave * 1344;
      const int gw = F.vcu * NWAVES + F.wave, NGW = F.G * NWAVES;
      for (int m = gw; m < M; m += NGW) p2_mla_token(F, l, m, raw); }
}
__device__ __forceinline__ void p4a_mix(Frame& F, int l) {
    const bf16* Ogdn = (const bf16*)(F.ws + WS_OGDN); const bf16* Omla = (const bf16*)(F.ws + WS_OMLA); const bf16* Y = (const bf16*)(F.ws + WS_Y);
    const bf16* Pgate = (const bf16*)(F.ws + WS_PGATE); const unsigned char* Rs = F.ws + WS_RS; const float* cb = (const float*)(F.ws + WS_CB); bf16* mix = (bf16*)(F.ws + WS_MIX);
    const float* gdn_g = (const float*)inptr(F, 7) + l * 64; const float* ln_g = (const float*)inptr(F, 20) + l * 256; const float* ln_b = (const float*)inptr(F, 21) + l * 256;
    const int gw = F.vcu * NWAVES + F.wave, NGW = F.G * NWAVES, j = F.lane;
    const float gg = gdn_g[j];
    for (int m = gw; m < M; m += NGW) {
        const int b = m / SEQ, t = m % SEQ;
#pragma unroll 2
        for (int g = 0; g < 16; ++g) {
            const int c = g * 64 + j; float val;
            if (g < 6) { const float o = bf2f(Ogdn[(size_t)m * 384 + c]); const float ss = wave_sum(o * o); val = o * rsqrtf(ss * (1.f / 64.f) + NORM_EPS) * gg; }
            else if (g < 12) val = bf2f(Omla[(size_t)m * 384 + (c - 384)]);
            else { const int cc = c - 768, h = g - 12; const float y = bf2f(Y[(size_t)m * 256 + cc]);
                const float mean = wave_sum(y) * (1.f / 64.f); const float dv = y - mean; const float var = wave_sum(dv * dv) * (1.f / 64.f);
                const float v = bf2f(((const bf16*)(Rs + (((size_t)b * 4 + h) * SEQ + t) * RS_REC + 128))[j]);
                val = dv * rsqrtf(var + 64e-5f) * ln_g[cc] + ln_b[cc] + cb[(size_t)m * 4 + h] * v; }
            mix[(size_t)m * 1024 + c] = f2bf(val * siluf(bf2f(Pgate[(size_t)m * 1024 + c])));
        }
    }
}
typedef float f32x16 __attribute__((ext_vector_type(16)));
typedef unsigned long long u64_t;
__device__ __forceinline__ bf16x8 mk_bf16x8(u64_t lo, u64_t hi) { typedef u64_t u64x2 __attribute__((ext_vector_type(2))); u64x2 v = {lo, hi}; return __builtin_bit_cast(bf16x8, v); }

constexpr int AT_KP = 208, AT_VP = 136, AT_KBYTES = 64 * AT_KP, AT_VBYTES = 64 * AT_VP, AT_BUF = AT_KBYTES + AT_VBYTES;
__device__ __forceinline__ void attn_unit(Frame& F, int unit) {
    const int bh = unit >> 3, qb = unit & 7, b = bh / 6, h = bh % 6;
    const int tid = F.tid, lane = F.lane, wave = F.wave, r32 = lane & 31, hi = lane >> 5;
    const bf16* Qg = (const bf16*)(F.ws + WS_Q) + ((size_t)bh * SEQ + qb * 256 + wave * 32 + r32) * 96;
    const bf16* Kg = (const bf16*)(F.ws + WS_K) + (size_t)bh * SEQ * 96;
    const bf16* Vg = (const bf16*)(F.ws + WS_VT) + (size_t)bh * 64 * SEQ;
    LAS unsigned char* lds = F.lds + RING_OFF;
    bf16x8 qf[6];
#pragma unroll
    for (int s = 0; s < 6; ++s) qf[s] = *(const bf16x8*)(Qg + 16 * s + 8 * hi);
    const int kr0 = tid / 12, kc0 = tid % 12, kr1 = (512 + tid) / 12, kc1 = (512 + tid) % 12, vd = tid >> 3, vc = tid & 7;
    const bool has1 = tid < 256;
    v4u kreg0, kreg1 = {0u, 0u, 0u, 0u}, vreg;
#define AT_LOAD(t0) do { kreg0 = *(const v4u*)(Kg + (size_t)((t0) + kr0) * 96 + kc0 * 8); if (has1) kreg1 = *(const v4u*)(Kg + (size_t)((t0) + kr1) * 96 + kc1 * 8); \
        vreg = *(const v4u*)(Vg + (size_t)vd * SEQ + (t0) + vc * 8); } while (0)
#define AT_STORE(buf) do { LAS unsigned char* bb_ = lds + (buf) * AT_BUF; *(LAS v4u*)(bb_ + kr0 * AT_KP + kc0 * 16) = kreg0; if (has1) *(LAS v4u*)(bb_ + kr1 * AT_KP + kc1 * 16) = kreg1; \
        LAS u64_t* vp_ = (LAS u64_t*)(bb_ + AT_KBYTES + vd * AT_VP + vc * 16); vp_[0] = (u64_t)vreg.x | ((u64_t)vreg.y << 32); vp_[1] = (u64_t)vreg.z | ((u64_t)vreg.w << 32); } while (0)
    AT_LOAD(0); AT_STORE(0);
    __syncthreads();
    f32x16 o0 = {}, o1 = {};
    float mrun = -1e30f, lsum = 0.f;
    for (int t = 0; t < SEQ / 64; ++t) {
        if (t + 1 < SEQ / 64) AT_LOAD((t + 1) * 64);
        LAS unsigned char* bb = lds + (t & 1) * AT_BUF;
        f32x16 p0 = {}, p1 = {};
        { const LAS unsigned char* kb = bb + r32 * AT_KP + hi * 16;
#pragma unroll
          for (int s = 0; s < 6; ++s) {
              const bf16x8 a0 = *(const LAS bf16x8*)(kb + 32 * s), a1 = *(const LAS bf16x8*)(kb + 32 * AT_KP + 32 * s);
              p0 = __builtin_amdgcn_mfma_f32_32x32x16_bf16(a0, qf[s], p0, 0, 0, 0);
              p1 = __builtin_amdgcn_mfma_f32_32x32x16_bf16(a1, qf[s], p1, 0, 0, 0); } }
        float mloc = fmaxf(p0[0], p1[0]);
#pragma unroll
        for (int r = 1; r < 16; ++r) mloc = fmaxf(mloc, fmaxf(p0[r], p1[r]));
        mloc = fmaxf(mloc, __shfl_xor(mloc, 32));
        const float mnew = fmaxf(mrun, mloc), alpha = __builtin_amdgcn_exp2f(mrun - mnew);
        mrun = mnew; lsum *= alpha;
#pragma unroll
        for (int r = 0; r < 16; ++r) { o0[r] *= alpha; o1[r] *= alpha; }
        float ps = 0.f;
#pragma unroll
        for (int r = 0; r < 16; ++r) { p0[r] = __builtin_amdgcn_exp2f(p0[r] - mnew); p1[r] = __builtin_amdgcn_exp2f(p1[r] - mnew); ps += p0[r] + p1[r]; }
        lsum += ps;
        v4u pk[4];
#pragma unroll
        for (int s2 = 0; s2 < 2; ++s2) {
            pk[s2] = (v4u){pg8::cvt_pk_bf16(p0[8 * s2], p0[8 * s2 + 1]), pg8::cvt_pk_bf16(p0[8 * s2 + 2], p0[8 * s2 + 3]), pg8::cvt_pk_bf16(p0[8 * s2 + 4], p0[8 * s2 + 5]), pg8::cvt_pk_bf16(p0[8 * s2 + 6], p0[8 * s2 + 7])};
            pk[2 + s2] = (v4u){pg8::cvt_pk_bf16(p1[8 * s2], p1[8 * s2 + 1]), pg8::cvt_pk_bf16(p1[8 * s2 + 2], p1[8 * s2 + 3]), pg8::cvt_pk_bf16(p1[8 * s2 + 4], p1[8 * s2 + 5]), pg8::cvt_pk_bf16(p1[8 * s2 + 6], p1[8 * s2 + 7])};
        }
        { const LAS unsigned char* vb = bb + AT_KBYTES + r32 * AT_VP + hi * 8;
#pragma unroll
          for (int ks = 0; ks < 4; ++ks) {
              const bf16x8 pb = __builtin_bit_cast(bf16x8, pk[ks]);
              const bf16x8 v0 = mk_bf16x8(*(const LAS u64_t*)(vb + ks * 32), *(const LAS u64_t*)(vb + ks * 32 + 16));
              const bf16x8 v1 = mk_bf16x8(*(const LAS u64_t*)(vb + 32 * AT_VP + ks * 32), *(const LAS u64_t*)(vb + 32 * AT_VP + ks * 32 + 16));
              o0 = __builtin_amdgcn_mfma_f32_32x32x16_bf16(v0, pb, o0, 0, 0, 0);
              o1 = __builtin_amdgcn_mfma_f32_32x32x16_bf16(v1, pb, o1, 0, 0, 0); } }
        if (t + 1 < SEQ / 64) AT_STORE((t + 1) & 1);
        __syncthreads();
    }
#undef AT_LOAD
#undef AT_STORE
    lsum += __shfl_xor(lsum, 32);
    const float inv = 1.f / lsum;
    bf16* Og = (bf16*)(F.ws + WS_OMLA) + ((size_t)b * SEQ + qb * 256 + wave * 32 + r32) * 384 + h * 64 + 4 * hi;
#pragma unroll
    for (int rg = 0; rg < 4; ++rg) {
        *(u64_t*)(Og + 8 * rg) = (u64_t)pg8::cvt_pk_bf16(o0[4 * rg] * inv, o0[4 * rg + 1] * inv) | ((u64_t)pg8::cvt_pk_bf16(o0[4 * rg + 2] * inv, o0[4 * rg + 3] * inv) << 32);
        *(u64_t*)(Og + 32 + 8 * rg) = (u64_t)pg8::cvt_pk_bf16(o1[4 * rg] * inv, o1[4 * rg + 1] * inv) | ((u64_t)pg8::cvt_pk_bf16(o1[4 * rg + 2] * inv, o1[4 * rg + 3] * inv) << 32);
    }
}

constexpr int RW_STEP = 1440, RW_CH = 16, RW_DIRB = RW_CH * RW_STEP, RW_BUF = 2 * RW_DIRB;
constexpr int RW_Y = 2 * RW_BUF;
static_assert(RW_Y + 2 * 4096 <= RING_BYTES, "RWKV LDS map");
__device__ __forceinline__ float dpp_xor1(float x) { return __builtin_bit_cast(float, __builtin_amdgcn_update_dpp(0, __builtin_bit_cast(int, x), 0xB1, 0xF, 0xF, true)); }
__device__ __forceinline__ float dpp_xor2(float x) { return __builtin_bit_cast(float, __builtin_amdgcn_update_dpp(0, __builtin_bit_cast(int, x), 0x4E, 0xF, 0xF, true)); }
__device__ __forceinline__ float dpp_hmir(float x) { return __builtin_bit_cast(float, __builtin_amdgcn_update_dpp(0, __builtin_bit_cast(int, x), 0x141, 0xF, 0xF, true)); }
__device__ __forceinline__ void rwkv_unit(Frame& F, int unit) {
    const int bh = unit >> 1, rowhalf = unit & 1, b = bh >> 2, h = bh & 3;
    const int tid = F.tid, lane = F.lane, dir = F.wave >> 2, w4 = F.wave & 3, ri = lane >> 3, cs = lane & 7;
    const unsigned char* Rs = F.ws + WS_RS + (size_t)bh * SEQ * RS_REC;
    LAS unsigned char* lds = F.lds + RING_OFF;
    const int sd = tid >> 8, ss = (tid >> 4) & 15, sp = tid & 15;
    const unsigned char* Rds = F.ws + WS_RD + sd * RD_DIR + (size_t)bh * SEQ * RD_REC;
    u64_t g_kk, g_r, g_lam, g_b, g_k, g_v = 0, g_s = 0;
#define RW_ISSUE(c_) do { const int n_ = (c_) * RW_CH + ss, t_ = sd ? SEQ - 1 - n_ : n_; const unsigned char* rs_ = Rs + (size_t)t_ * RS_REC; const unsigned char* rd_ = Rds + (size_t)t_ * RD_REC; \
        g_kk = *(const u64_t*)(rs_ + 8 * sp); g_r = *(const u64_t*)(rs_ + 256 + 8 * sp); g_lam = *(const u64_t*)(rd_ + 8 * sp); g_b = *(const u64_t*)(rd_ + 128 + 8 * sp); g_k = *(const u64_t*)(rd_ + 256 + 8 * sp); \
        if (sp < 8) g_v = *(const u64_t*)(rs_ + 128 + 64 * rowhalf + 8 * sp); if (sp == 8) g_s = *(const u64_t*)(rd_ + 384); } while (0)
#define RW_BF(x, j) __uint_as_float(((unsigned)((x) >> (16 * (j)))) << 16)
#define RW_STAGE(buf_) do { LAS unsigned char* d_ = lds + (buf_) * RW_BUF + sd * RW_DIRB + ss * RW_STEP + 16 * sp; f32x4 w_, t_; \
        w_[0] = __builtin_amdgcn_exp2f(-LOG2E * __half2float(__ushort_as_half((unsigned short)(g_lam)))); w_[1] = __builtin_amdgcn_exp2f(-LOG2E * __half2float(__ushort_as_half((unsigned short)(g_lam >> 16)))); \
        w_[2] = __builtin_amdgcn_exp2f(-LOG2E * __half2float(__ushort_as_half((unsigned short)(g_lam >> 32)))); w_[3] = __builtin_amdgcn_exp2f(-LOG2E * __half2float(__ushort_as_half((unsigned short)(g_lam >> 48)))); \
        *(LAS f32x4*)d_ = w_; \
        t_ = (f32x4){RW_BF(g_r, 0), RW_BF(g_r, 1), RW_BF(g_r, 2), RW_BF(g_r, 3)}; *(LAS f32x4*)(d_ + 256) = w_ * t_; \
        t_ = (f32x4){RW_BF(g_kk, 0), RW_BF(g_kk, 1), RW_BF(g_kk, 2), RW_BF(g_kk, 3)}; *(LAS f32x4*)(d_ + 512) = -t_; \
        t_ = (f32x4){RW_BF(g_b, 0), RW_BF(g_b, 1), RW_BF(g_b, 2), RW_BF(g_b, 3)}; *(LAS f32x4*)(d_ + 768) = t_; \
        t_ = (f32x4){RW_BF(g_k, 0), RW_BF(g_k, 1), RW_BF(g_k, 2), RW_BF(g_k, 3)}; *(LAS f32x4*)(d_ + 1024) = t_; \
        if (sp < 8) { t_ = (f32x4){RW_BF(g_v, 0), RW_BF(g_v, 1), RW_BF(g_v, 2), RW_BF(g_v, 3)}; *(LAS f32x4*)(d_ + 1280) = t_; } \
        if (sp == 8) *(LAS u64_t*)(lds + (buf_) * RW_BUF + sd * RW_DIRB + ss * RW_STEP + 1408) = g_s; } while (0)
    float S[8];
#pragma unroll
    for (int j = 0; j < 8; ++j) S[j] = 0.f;
    RW_ISSUE(0); RW_STAGE(0);
    __syncthreads();
    bf16* Yg = (bf16*)(F.ws + WS_Y) + (size_t)b * SEQ * 256 + h * 64 + 32 * rowhalf;
    const int NCH = SEQ / RW_CH;
    for (int c = 0; c < NCH; ++c) {
        if (c + 1 < NCH) RW_ISSUE(c + 1);
        LAS float* ybuf = (LAS float*)(lds + RW_Y + (c & 1) * 4096);
        const LAS unsigned char* cb_ = lds + (c & 1) * RW_BUF + dir * RW_DIRB + 32 * cs;
#pragma unroll 4
        for (int s = 0; s < RW_CH; ++s) {
            const LAS unsigned char* p = cb_ + s * RW_STEP;
            const f32x4 w0 = *(const LAS f32x4*)p, w1 = *(const LAS f32x4*)(p + 16), r0 = *(const LAS f32x4*)(p + 256), r1 = *(const LAS f32x4*)(p + 272);
            const f32x4 n0 = *(const LAS f32x4*)(p + 512), n1 = *(const LAS f32x4*)(p + 528), b0 = *(const LAS f32x4*)(p + 768), b1 = *(const LAS f32x4*)(p + 784);
            const f32x4 k0 = *(const LAS f32x4*)(p + 1024), k1 = *(const LAS f32x4*)(p + 1040);
            const LAS unsigned char* q = lds + (c & 1) * RW_BUF + dir * RW_DIRB + s * RW_STEP;
            const float v = *(const LAS float*)(q + 1280 + 4 * (8 * w4 + ri)); const float br = *(const LAS float*)(q + 1408), kr = *(const LAS float*)(q + 1412);
            float sa = (S[0] * n0[0] + S[1] * n0[1]) + (S[2] * n0[2] + S[3] * n0[3]) + (S[4] * n1[0] + S[5] * n1[1]) + (S[6] * n1[2] + S[7] * n1[3]);
            float ym = (S[0] * r0[0] + S[1] * r0[1]) + (S[2] * r0[2] + S[3] * r0[3]) + (S[4] * r1[0] + S[5] * r1[1]) + (S[6] * r1[2] + S[7] * r1[3]);
            sa += dpp_xor1(sa); ym += dpp_xor1(ym); sa += dpp_xor2(sa); ym += dpp_xor2(ym); sa += dpp_hmir(sa); ym += dpp_hmir(ym);
#pragma unroll
            for (int j = 0; j < 4; ++j) { S[j] = S[j] * w0[j] + (sa * b0[j] + v * k0[j]); S[4 + j] = S[4 + j] * w1[j] + (sa * b1[j] + v * k1[j]); }
            if (cs == 0) ybuf[(dir * RW_CH + s) * 32 + 8 * w4 + ri] = ym + sa * br + v * kr;
        }
        if (c + 1 < NCH) RW_STAGE((c + 1) & 1);
        if (c == NCH / 2) asm volatile("s_waitcnt vmcnt(0)" ::: "memory");
        __syncthreads();
#pragma unroll
        for (int k = 0; k < 2; ++k) { const int o = tid + 512 * k, od = o >> 9, os = (o >> 5) & 15, orow = o & 31, n = c * RW_CH + os, t = od ? SEQ - 1 - n : n;
            bf16* yp = Yg + (size_t)t * 256 + orow; float y = ybuf[o];
            if (c >= NCH / 2) y += bf2f(*yp);
            *yp = (bf16)f2bf(y); }
    }
#undef RW_ISSUE
#undef RW_STAGE
#undef RW_BF
    __syncthreads();
}

__device__ __forceinline__ void gdn_unit(Frame& F, int l, int unit) {
    const int bh = unit, b = bh / 6, h = bh % 6, e = F.lane, dir = F.wave;
    const bf16* Pgdn = (const bf16*)(F.ws + WS_PGDN); const float* Psm = (const float*)(F.ws + WS_PSM); bf16* Ogdn = (bf16*)(F.ws + WS_OGDN);
    const float* conv_w = (const float*)inptr(F, 4) + (size_t)l * 5 * 1152; const float* a_log = (const float*)inptr(F, 5) + l * 12; const float* dt_bias = (const float*)inptr(F, 6) + l * 12;
    LAS float* qs = (LAS float*)(F.lds + RING_OFF) + F.wave * 128; LAS float* ks = qs + 64;
    if (F.wave < 2) {
        float S[64];
#pragma unroll
        for (int i = 0; i < 64; ++i) S[i] = 0.f;
        float cw[3][5];
#pragma unroll
        for (int i = 0; i < 5; ++i) { cw[0][i] = conv_w[i * 1152 + h * 64 + e]; cw[1][i] = conv_w[i * 1152 + 384 + h * 64 + e]; cw[2][i] = conv_w[i * 1152 + 768 + h * 64 + e]; }
        const float al = -__expf(a_log[dir * 6 + h]), dtb = dt_bias[dir * 6 + h];
        for (int n = 0; n < SEQ; ++n) {
            if (n == SEQ / 2) { asm volatile("s_waitcnt vmcnt(0)" ::: "memory"); __syncthreads(); }
            const int t = dir ? SEQ - 1 - n : n; const size_t m = (size_t)b * SEQ + t;
            float cq = 0.f, ck = 0.f, cv = 0.f;
#pragma unroll
            for (int i = 0; i < 5; ++i) { const int tt = t + i - 2; if (tt >= 0 && tt < SEQ) { const bf16* pr = Pgdn + ((size_t)b * SEQ + tt) * 1152 + h * 64 + e;
                    cq += cw[0][i] * bf2f(pr[0]); ck += cw[1][i] * bf2f(pr[384]); cv += cw[2][i] * bf2f(pr[768]); } }
            cq = siluf(cq); ck = siluf(ck); cv = siluf(cv);
            const float qn = cq * rsqrtf(wave_sum(cq * cq) + 1e-6f) * 0.125f, kn = ck * rsqrtf(wave_sum(ck * ck) + 1e-6f);
            LDS_WAIT(); asm volatile("" ::: "memory");
            qs[e] = qn; ks[e] = kn;
            LDS_WAIT(); asm volatile("" ::: "memory");
            const float g = al * softplusf_(Psm[m * 32 + dir * 6 + h] + dtb), beta = sigmoidf_(Psm[m * 32 + 12 + dir * 6 + h]), alpha = __expf(g);
            float kS = 0.f;
#pragma unroll
            for (int c4 = 0; c4 < 16; ++c4) { const f32x4 kq = ((const LAS f32x4*)ks)[c4];
                kS += (kq.x * S[4 * c4] + kq.y * S[4 * c4 + 1]) + (kq.z * S[4 * c4 + 2] + kq.w * S[4 * c4 + 3]);
                if ((c4 & 3) == 3) asm volatile("" ::: "memory"); }
            const float coef = beta * (cv - alpha * kS);
            float o = 0.f;
#pragma unroll
            for (int c4 = 0; c4 < 16; ++c4) { const f32x4 kq = ((const LAS f32x4*)ks)[c4], qq = ((const LAS f32x4*)qs)[c4];
                S[4 * c4] = alpha * S[4 * c4] + coef * kq.x; S[4 * c4 + 1] = alpha * S[4 * c4 + 1] + coef * kq.y; S[4 * c4 + 2] = alpha * S[4 * c4 + 2] + coef * kq.z; S[4 * c4 + 3] = alpha * S[4 * c4 + 3] + coef * kq.w;
                o += (qq.x * S[4 * c4] + qq.y * S[4 * c4 + 1]) + (qq.z * S[4 * c4 + 2] + qq.w * S[4 * c4 + 3]);
                if ((c4 & 3) == 3) asm volatile("" ::: "memory"); }
            bf16* op = Ogdn + m * 384 + h * 64 + e;
            if (n >= SEQ / 2) o += bf2f(*op);
            *op = (bf16)f2bf(o);
        }
    } else { __syncthreads(); }
}

constexpr int GP = 144;
constexpr int G_Q = 0, G_K = 9216, G_V = 18432, G_KT = 27648, G_P = 36864, G_A = 46080, G_SM = 63488, G_GROUP = 64512;
constexpr int G_CW = 133120;
static_assert(2 * G_GROUP <= RING_BYTES && G_CW + 3840 <= LDS_BYTES && G_CW >= MISC_OFF + 1024, "GDN LDS map");
__device__ __forceinline__ bf16x8 ld2x8(const LAS unsigned char* p) { return mk_bf16x8(*(const LAS u64_t*)p, *(const LAS u64_t*)(p + 32)); }
__device__ __forceinline__ bf16x8 pack_acc(const f32x4& a, const f32x4& b) {
    v4u w; w.x = pg8::cvt_pk_bf16(a[0], a[1]); w.y = pg8::cvt_pk_bf16(a[2], a[3]); w.z = pg8::cvt_pk_bf16(b[0], b[1]); w.w = pg8::cvt_pk_bf16(b[2], b[3]); return __builtin_bit_cast(bf16x8, w); }
__device__ __forceinline__ void split_acc(const f32x4& a, const f32x4& b, bf16x8& hi, bf16x8& lo) {
    v4u wh; wh.x = pg8::cvt_pk_bf16(a[0], a[1]); wh.y = pg8::cvt_pk_bf16(a[2], a[3]); wh.z = pg8::cvt_pk_bf16(b[0], b[1]); wh.w = pg8::cvt_pk_bf16(b[2], b[3]);
    f32x4 ra, rb;
    ra[0] = a[0] - __uint_as_float(wh.x << 16); ra[1] = a[1] - __uint_as_float(wh.x & 0xffff0000u); ra[2] = a[2] - __uint_as_float(wh.y << 16); ra[3] = a[3] - __uint_as_float(wh.y & 0xffff0000u);
    rb[0] = b[0] - __uint_as_float(wh.z << 16); rb[1] = b[1] - __uint_as_float(wh.z & 0xffff0000u); rb[2] = b[2] - __uint_as_float(wh.w << 16); rb[3] = b[3] - __uint_as_float(wh.w & 0xffff0000u);
    hi = __builtin_bit_cast(bf16x8, wh); lo = pack_acc(ra, rb);
}
typedef _Float16 f16x8 __attribute__((ext_vector_type(8)));
__device__ __forceinline__ f16x8 pack_acc_f16(const f32x4& a, const f32x4& b) { return (f16x8){(_Float16)a[0], (_Float16)a[1], (_Float16)a[2], (_Float16)a[3], (_Float16)b[0], (_Float16)b[1], (_Float16)b[2], (_Float16)b[3]}; }
__device__ __forceinline__ void gdn_unit2(Frame& F, int l, int unit) {
    const int bh = unit, b = bh / 6, h = bh % 6;
    const int tid = F.tid, lane = F.lane, dir = F.wave >> 2, gw = F.wave & 3, gt = tid & 255;
    const bf16* Pgdn = (const bf16*)(F.ws + WS_PGDN) + (size_t)b * SEQ * 1152 + h * 64; const float* Psm = (const float*)(F.ws + WS_PSM) + (size_t)b * SEQ * 32;
    bf16* Og = (bf16*)(F.ws + WS_OGDN) + (size_t)b * SEQ * 384 + h * 64;
    LAS unsigned char* gb = F.lds + RING_OFF + dir * G_GROUP;
    LAS float* cwl = (LAS float*)(F.lds + G_CW);
    LAS float* sm = (LAS float*)(gb + G_SM);
    { const float* conv_w = (const float*)inptr(F, 4) + (size_t)l * 5 * 1152;
      for (int i = tid; i < 960; i += 512) { const int tn = i / 320, tap = (i % 320) / 64, ch = i % 64; cwl[i] = conv_w[tap * 1152 + tn * 384 + h * 64 + ch]; } }
    const float al = -__expf(((const float*)inptr(F, 5))[l * 12 + dir * 6 + h]), dtb = ((const float*)inptr(F, 6))[l * 12 + dir * 6 + h];
    f32x4 Sacc[4];
#pragma unroll
    for (int i = 0; i < 4; ++i) Sacc[i] = (f32x4){0.f, 0.f, 0.f, 0.f};
    __syncthreads();
    for (int c = 0; c < SEQ / 64; ++c) {
        if (gw == 0) {
            const int t = dir ? SEQ - 1 - 64 * c - lane : 64 * c + lane;
            const float a = Psm[(size_t)t * 32 + dir * 6 + h], bt = Psm[(size_t)t * 32 + 12 + dir * 6 + h];
            float x = al * softplusf_(a + dtb);
#pragma unroll
            for (int off = 1; off < 64; off <<= 1) { const float y = __shfl_up(x, off); if (lane >= off) x += y; }
            const float last = __shfl(x, 63);
            sm[lane] = x; sm[64 + lane] = sigmoidf_(bt); sm[128 + lane] = __expf(x); sm[192 + lane] = __expf(last - x);
        }
        { const int i = gt >> 2, cg = gt & 3, t = dir ? SEQ - 1 - 64 * c - i : 64 * c + i;
          float acc[3][16];
#pragma unroll
          for (int tn = 0; tn < 3; ++tn)
#pragma unroll
              for (int j = 0; j < 16; ++j) acc[tn][j] = 0.f;
#pragma unroll
          for (int tap = 0; tap < 5; ++tap) { const int tt = t + tap - 2;
              if (tt >= 0 && tt < SEQ) {
#pragma unroll
                  for (int tn = 0; tn < 3; ++tn) { const bf16* pr = Pgdn + (size_t)tt * 1152 + tn * 384 + 16 * cg; const v4u x0 = *(const v4u*)pr, x1 = *(const v4u*)(pr + 8);
                      const LAS float* w = cwl + tn * 320 + tap * 64 + 16 * cg;
#pragma unroll
                      for (int q = 0; q < 4; ++q) { acc[tn][2 * q] += w[2 * q] * __uint_as_float(x0[q] << 16); acc[tn][2 * q + 1] += w[2 * q + 1] * __uint_as_float(x0[q] & 0xffff0000u);
                          acc[tn][8 + 2 * q] += w[8 + 2 * q] * __uint_as_float(x1[q] << 16); acc[tn][8 + 2 * q + 1] += w[8 + 2 * q + 1] * __uint_as_float(x1[q] & 0xffff0000u); } } }
              asm volatile("" ::: "memory"); }
          float sq = 0.f, sk = 0.f;
#pragma unroll
          for (int j = 0; j < 16; ++j) { acc[0][j] = siluf(acc[0][j]); acc[1][j] = siluf(acc[1][j]); acc[2][j] = siluf(acc[2][j]); sq += acc[0][j] * acc[0][j]; sk += acc[1][j] * acc[1][j]; }
          sq += __shfl_xor(sq, 1); sq += __shfl_xor(sq, 2); sk += __shfl_xor(sk, 1); sk += __shfl_xor(sk, 2);
          const float rq = rsqrtf(sq + 1e-6f) * 0.125f, rk = rsqrtf(sk + 1e-6f);
          v4u wq[2], wk[2], wv[2];
#pragma unroll
          for (int q = 0; q < 8; ++q) { wq[q >> 2][q & 3] = pg8::cvt_pk_bf16(acc[0][2 * q] * rq, acc[0][2 * q + 1] * rq); wk[q >> 2][q & 3] = pg8::cvt_pk_bf16(acc[1][2 * q] * rk, acc[1][2 * q + 1] * rk);
              wv[q >> 2][q & 3] = pg8::cvt_pk_bf16(acc[2][2 * q], acc[2][2 * q + 1]); }
          LAS unsigned char* row = gb + i * GP + 32 * cg;
          *(LAS v4u*)(row + G_Q) = wq[0]; *(LAS v4u*)(row + G_Q + 16) = wq[1]; *(LAS v4u*)(row + G_K) = wk[0]; *(LAS v4u*)(row + G_K + 16) = wk[1]; *(LAS v4u*)(row + G_V) = wv[0]; *(LAS v4u*)(row + G_V + 16) = wv[1];
#pragma unroll
          for (int j = 0; j < 16; ++j) *(LAS bf16*)(gb + G_KT + (16 * cg + j) * GP + 2 * i) = (bf16)((j & 1) ? (wk[j >> 3][(j >> 1) & 3] >> 16) : (wk[j >> 3][(j >> 1) & 3] & 0xffffu)); }
        if (c == SEQ / 128) asm volatile("s_waitcnt vmcnt(0)" ::: "memory");
        __syncthreads();
        { const int ti = gw >> 1, tj = gw & 1, r32 = lane & 31, hi = lane >> 5;
          f32x16 kk = {}, qk = {};
          const LAS unsigned char* ar = gb + (32 * ti + r32) * GP + 16 * hi; const LAS unsigned char* br = gb + G_K + (32 * tj + r32) * GP + 16 * hi;
#pragma unroll
          for (int s = 0; s < 4; ++s) { const bf16x8 ak = *(const LAS bf16x8*)(ar + G_K + 32 * s), aq = *(const LAS bf16x8*)(ar + G_Q + 32 * s), bk = *(const LAS bf16x8*)(br + 32 * s);
              kk = __builtin_amdgcn_mfma_f32_32x32x16_bf16(ak, bk, kk, 0, 0, 0); qk = __builtin_amdgcn_mfma_f32_32x32x16_bf16(aq, bk, qk, 0, 0, 0); }
          const int j = 32 * tj + r32; const float cj = sm[j];
#pragma unroll
          for (int r = 0; r < 16; ++r) { const int i = 32 * ti + (r & 3) + 8 * (r >> 2) + 4 * hi;
              const float dl = __expf(fminf(sm[i] - cj, 0.f));
              ((LAS float*)(gb + G_A))[i * 68 + j] = (i > j) ? sm[64 + i] * kk[r] * dl : 0.f;
              *(LAS _Float16*)(gb + G_P + i * GP + 2 * j) = (_Float16)((i >= j) ? qk[r] * dl : 0.f); } }
        __syncthreads();
        float X[64];
#pragma unroll
        for (int i = 0; i < 64; ++i) X[i] = 0.f;
        if (gt < 128) {
            const int cc = gt & 63; const LAS unsigned char* src = gb + (gt < 64 ? G_V : G_K) + 2 * cc;
#pragma unroll
            for (int i = 0; i < 64; ++i) {
                unsigned z = 0u; if (i >= 2) asm("v_and_b32 %0, 0, %1" : "=v"(z) : "v"(X[i - 2]));
                const LAS unsigned char* arow = gb + G_A + z + i * 272;
                const float rhs = bf2f(*(const LAS bf16*)(src + i * GP)) * sm[64 + i] * (gt < 64 ? 1.f : sm[128 + i]);
                float a0 = 0.f, a1 = 0.f, a2 = 0.f, a3 = 0.f;
#pragma unroll
                for (int j4 = 0; j4 < (i + 3) / 4; ++j4) { const f32x4 av = *(const LAS f32x4*)(arow + 16 * j4);
                    a0 += av.x * X[4 * j4]; a1 += av.y * X[4 * j4 + 1]; a2 += av.z * X[4 * j4 + 2]; a3 += av.w * X[4 * j4 + 3]; }
                X[i] = rhs - ((a0 + a1) + (a2 + a3));
            }
        }
        __syncthreads();
        if (gt < 64) {
#pragma unroll
            for (int i = 0; i < 64; ++i) ((LAS float*)(gb + G_A))[i * 68 + gt] = X[i];
        } else if (gt < 128) {
#pragma unroll
            for (int i = 0; i < 64; ++i) { const unsigned hb = f2bf(-X[i]); *(LAS bf16*)(gb + G_V + i * GP + 2 * (gt - 64)) = (bf16)hb;
                *(LAS bf16*)(gb + G_K + i * GP + 2 * (gt - 64)) = (bf16)f2bf(-X[i] - __uint_as_float(hb << 16)); }
        }
        __syncthreads();
        { const int col = lane & 15, q4 = lane >> 4, e = 16 * gw + col;
          bf16x8 bS0, bS1, bS0l, bS1l; split_acc(Sacc[0], Sacc[1], bS0, bS0l); split_acc(Sacc[2], Sacc[3], bS1, bS1l);
          f32x4 U[4], T1[4];
          const LAS unsigned char* rowa = gb + col * GP + 8 * q4;
#pragma unroll
          for (int it = 0; it < 4; ++it) {
              const LAS float* u0p = (const LAS float*)(gb + G_A) + (16 * it + 4 * q4) * 68 + e;
              U[it] = (f32x4){u0p[0], u0p[68], u0p[136], u0p[204]};
              const LAS unsigned char* ra = rowa + 16 * it * GP;
              const bf16x8 wh0 = ld2x8(ra + G_V), wh1 = ld2x8(ra + G_V + 64), wl0 = ld2x8(ra + G_K), wl1 = ld2x8(ra + G_K + 64), qa0 = ld2x8(ra + G_Q), qa1 = ld2x8(ra + G_Q + 64);
              U[it] = __builtin_amdgcn_mfma_f32_16x16x32_bf16(wl0, bS0, U[it], 0, 0, 0);
              U[it] = __builtin_amdgcn_mfma_f32_16x16x32_bf16(wl1, bS1, U[it], 0, 0, 0);
              U[it] = __builtin_amdgcn_mfma_f32_16x16x32_bf16(wh0, bS0l, U[it], 0, 0, 0);
              U[it] = __builtin_amdgcn_mfma_f32_16x16x32_bf16(wh1, bS1l, U[it], 0, 0, 0);
              U[it] = __builtin_amdgcn_mfma_f32_16x16x32_bf16(wh0, bS0, U[it], 0, 0, 0);
              U[it] = __builtin_amdgcn_mfma_f32_16x16x32_bf16(wh1, bS1, U[it], 0, 0, 0);
              T1[it] = __builtin_amdgcn_mfma_f32_16x16x32_bf16(qa0, bS0l, (f32x4){0.f, 0.f, 0.f, 0.f}, 0, 0, 0);
              T1[it] = __builtin_amdgcn_mfma_f32_16x16x32_bf16(qa1, bS1l, T1[it], 0, 0, 0);
              T1[it] = __builtin_amdgcn_mfma_f32_16x16x32_bf16(qa0, bS0, T1[it], 0, 0, 0);
              T1[it] = __builtin_amdgcn_mfma_f32_16x16x32_bf16(qa1, bS1, T1[it], 0, 0, 0);
          }
          const f16x8 hU0 = pack_acc_f16(U[0], U[1]), hU1 = pack_acc_f16(U[2], U[3]);
          f32x4 Ud[4];
#pragma unroll
          for (int it = 0; it < 4; ++it) { const f32x4 dc = *(const LAS f32x4*)(sm + 192 + 16 * it + 4 * q4); Ud[it] = U[it] * dc; }
          bf16x8 bD0, bD1, bD0l, bD1l; split_acc(Ud[0], Ud[1], bD0, bD0l); split_acc(Ud[2], Ud[3], bD1, bD1l);
          const float gend = sm[191];
#pragma unroll
          for (int it = 0; it < 4; ++it) {
              const LAS unsigned char* ra = rowa + 16 * it * GP;
              const f32x4 gm = *(const LAS f32x4*)(sm + 128 + 16 * it + 4 * q4);
              const bf16x8 pa0 = ld2x8(ra + G_P), pa1 = ld2x8(ra + G_P + 64), ka0 = ld2x8(ra + G_KT), ka1 = ld2x8(ra + G_KT + 64);
              f32x4 O = T1[it] * gm;
              O = __builtin_amdgcn_mfma_f32_16x16x32_f16(__builtin_bit_cast(f16x8, pa0), hU0, O, 0, 0, 0);
              O = __builtin_amdgcn_mfma_f32_16x16x32_f16(__builtin_bit_cast(f16x8, pa1), hU1, O, 0, 0, 0);
              f32x4 Sn = Sacc[it] * gend;
              Sn = __builtin_amdgcn_mfma_f32_16x16x32_bf16(ka0, bD0l, Sn, 0, 0, 0);
              Sn = __builtin_amdgcn_mfma_f32_16x16x32_bf16(ka1, bD1l, Sn, 0, 0, 0);
              Sn = __builtin_amdgcn_mfma_f32_16x16x32_bf16(ka0, bD0, Sn, 0, 0, 0);
              Sn = __builtin_amdgcn_mfma_f32_16x16x32_bf16(ka1, bD1, Sn, 0, 0, 0);
              Sacc[it] = Sn;
#pragma unroll
              for (int r = 0; r < 4; ++r) { const int i = 16 * it + 4 * q4 + r, t = dir ? SEQ - 1 - 64 * c - i : 64 * c + i; bf16* op = Og + (size_t)t * 384 + e;
                  float o = O[r]; if (c >= SEQ / 128) o += bf2f(*op);
                  *op = (bf16)f2bf(o); }
          } }
        __syncthreads();
    }
}
__device__ __forceinline__ int next_unit(Frame& F, gu32* head) {
    __syncthreads();
    if (F.tid == 0) F.MISC[16] = __hip_atomic_fetch_add(head, 1u, RLX_AGENT);
    __syncthreads();
    return (int)F.MISC[16];
}
constexpr int U_GDN = 48, U_RWKV = 64, U_ATT = 384, U_ALL = U_GDN + U_RWKV + U_ATT;
__device__ __forceinline__ void p3_mixers(Frame& F, int l, int rep) {
    gu32* head = F.ctl + CW_QUEUE + 64 * (2 * l + rep);
    for (;;) {
        const int u = next_unit(F, head);
        if (u >= U_ALL) break;
        asm volatile("" : "+v"(F.tid), "+v"(F.lane));
        if (u < U_GDN) gdn_unit2(F, l, u);
        else if (u < U_GDN + U_RWKV) rwkv_unit(F, u - U_GDN);
        else attn_unit(F, u - U_GDN - U_RWKV);
    }
}
__device__ __forceinline__ f32x4 bf4(u64_t x) { return (f32x4){__uint_as_float(((unsigned)x) << 16), __uint_as_float(((unsigned)x) & 0xffff0000u), __uint_as_float(((unsigned)(x >> 32)) << 16), __uint_as_float(((unsigned)(x >> 32)) & 0xffff0000u)}; }
__device__ __forceinline__ u64_t pk4(const f32x4& v) { return (u64_t)pg8::cvt_pk_bf16(v[0], v[1]) | ((u64_t)pg8::cvt_pk_bf16(v[2], v[3]) << 32); }
__device__ __forceinline__ void p2_mla_unit(Frame& F, int l, int unit) {
    const int lane = F.lane, col = lane & 15, q4 = lane >> 4, m = 16 * unit + col, b = m / SEQ, t = m % SEQ, t0 = (16 * unit) % SEQ;
    const bf16* prow = (const bf16*)(F.ws + WS_PMLA) + (size_t)m * 352;
    const bf16* WuqT = (const bf16*)(F.ws + WS_WSMALL + OFF_WUQ) + (size_t)l * 576 * 192 + (size_t)col * 192 + 8 * q4;
    const bf16* WukvT = (const bf16*)(F.ws + WS_WSMALL + OFF_WUKV) + (size_t)l * 768 * 128 + (size_t)col * 128 + 8 * q4;
    bf16x8 aq[6], akv[4]; float sq = 0.f, skv = 0.f;
#pragma unroll
    for (int s = 0; s < 6; ++s) { aq[s] = *(const bf16x8*)(prow + 32 * s + 8 * q4); const v4u u = __builtin_bit_cast(v4u, aq[s]);
#pragma unroll
        for (int i = 0; i < 4; ++i) { const float a = __uint_as_float(u[i] << 16), c = __uint_as_float(u[i] & 0xffff0000u); sq += a * a + c * c; } }
#pragma unroll
    for (int s = 0; s < 4; ++s) { akv[s] = *(const bf16x8*)(prow + 192 + 32 * s + 8 * q4); const v4u u = __builtin_bit_cast(v4u, akv[s]);
#pragma unroll
        for (int i = 0; i < 4; ++i) { const float a = __uint_as_float(u[i] << 16), c = __uint_as_float(u[i] & 0xffff0000u); skv += a * a + c * c; } }
    sq += __shfl_xor(sq, 16); sq += __shfl_xor(sq, 32); skv += __shfl_xor(skv, 16); skv += __shfl_xor(skv, 32);
    const float rq = rsqrtf(sq * (1.f / 192.f) + NORM_EPS) * (0.10206207261596575f * LOG2E), rkv = rsqrtf(skv * (1.f / 128.f) + NORM_EPS);
    const float pos = (float)((const int*)inptr(F, 1))[m];
    f32x4 cs, sn;
#pragma unroll
    for (int r = 0; r < 4; ++r) { const float inv = exp2f(-(float)(4 * q4 + r) * (13.287712379549449f / 16.f)); float s_, c_; sincosf(pos * inv, &s_, &c_); cs[r] = c_; sn[r] = s_; }
    bf16* Qo = (bf16*)(F.ws + WS_Q) + ((size_t)b * 6 * SEQ + t) * 96 + 4 * q4;
    bf16* Ko = (bf16*)(F.ws + WS_K) + ((size_t)b * 6 * SEQ + t) * 96 + 4 * q4;
    bf16* Vo = (bf16*)(F.ws + WS_VT) + (size_t)b * 6 * 64 * SEQ + (size_t)col * SEQ + t0 + 4 * q4;
    { const u64_t x1 = *(const u64_t*)(prow + 320 + 4 * q4), x2 = *(const u64_t*)(prow + 336 + 4 * q4); const f32x4 a = bf4(x1), c = bf4(x2);
      const u64_t o1 = pk4(a * cs - c * sn), o2 = pk4(c * cs + a * sn);
#pragma unroll
      for (int h = 0; h < 6; ++h) { *(u64_t*)(Ko + (size_t)h * SEQ * 96 + 64) = o1; *(u64_t*)(Ko + (size_t)h * SEQ * 96 + 80) = o2; } }
#pragma unroll 1
    for (int h = 0; h < 6; ++h) {
        f32x4 x1v = {0.f, 0.f, 0.f, 0.f};
#pragma unroll
        for (int nt = 0; nt < 6; ++nt) {
            const bf16* w = WuqT + (size_t)(h * 96 + 16 * nt) * 192; f32x4 acc = {0.f, 0.f, 0.f, 0.f};
#pragma unroll
            for (int s = 0; s < 6; ++s) acc = __builtin_amdgcn_mfma_f32_16x16x32_bf16(*(const bf16x8*)(w + 32 * s), aq[s], acc, 0, 0, 0);
            acc = acc * rq;
            if (nt < 4) *(u64_t*)(Qo + (size_t)h * SEQ * 96 + 16 * nt) = pk4(acc);
            else if (nt == 4) x1v = acc;
            else { *(u64_t*)(Qo + (size_t)h * SEQ * 96 + 64) = pk4(x1v * cs - acc * sn); *(u64_t*)(Qo + (size_t)h * SEQ * 96 + 80) = pk4(acc * cs + x1v * sn); }
        }
#pragma unroll
        for (int nt = 0; nt < 4; ++nt) {
            const bf16* w = WukvT + (size_t)(h * 128 + 16 * nt) * 128; f32x4 acc = {0.f, 0.f, 0.f, 0.f};
#pragma unroll
            for (int s = 0; s < 4; ++s) acc = __builtin_amdgcn_mfma_f32_16x16x32_bf16(*(const bf16x8*)(w + 32 * s), akv[s], acc, 0, 0, 0);
            *(u64_t*)(Ko + (size_t)h * SEQ * 96 + 16 * nt) = pk4(acc * rkv);
        }
        f32x4 rk4;
#pragma unroll
        for (int r = 0; r < 4; ++r) rk4[r] = __shfl(rkv, 4 * q4 + r);
#pragma unroll
        for (int nt = 0; nt < 4; ++nt) {
            const bf16* w = WukvT + (size_t)(h * 128 + 64 + 16 * nt) * 128; f32x4 acc = {0.f, 0.f, 0.f, 0.f};
#pragma unroll
            for (int s = 0; s < 4; ++s) acc = __builtin_amdgcn_mfma_f32_16x16x32_bf16(akv[s], *(const bf16x8*)(w + 32 * s), acc, 0, 0, 0);
            *(u64_t*)(Vo + (size_t)(h * 64 + 16 * nt) * SEQ) = pk4(acc * rk4);
        }
    }
}
__device__ __forceinline__ f32x4 rw_shift4(const bf16* P, size_t m, int c, bool hp, bool hn, const float* mu) {
    const f32x4 x = bf4(*(const u64_t*)(P + m * 896 + c)), xp = hp ? bf4(*(const u64_t*)(P + (m - 1) * 896 + c)) : (f32x4){0.f, 0.f, 0.f, 0.f}, xn = hn ? bf4(*(const u64_t*)(P + (m + 1) * 896 + c)) : (f32x4){0.f, 0.f, 0.f, 0.f};
    const f32x4 m0 = *(const f32x4*)(mu + c), m1 = *(const f32x4*)(mu + 896 + c);
    return x + m0 * (xp - x) + m1 * (xn - x);
}
__device__ __forceinline__ void p2_rwkv_unit(Frame& F, int l, int unit) {
    const int lane = F.lane, col = lane & 15, q4 = lane >> 4, b = (16 * unit) / SEQ, t = (16 * unit) % SEQ + col; const size_t m = (size_t)16 * unit + col;
    const bool hp = t > 0, hn = t < SEQ - 1;
    const bf16* Prw = (const bf16*)(F.ws + WS_PRW);
    const float* mu = (const float*)inptr(F, 12) + l * 2 * 896;
    const bf16* W2T = (const bf16*)(F.ws + WS_WSMALL + OFF_W2T) + (size_t)l * 2 * 256 * 64 + (size_t)col * 64 + 8 * q4;
    const bf16* A2T = (const bf16*)(F.ws + WS_WSMALL + OFF_A2T) + (size_t)l * 2 * 256 * 64 + (size_t)col * 64 + 8 * q4;
    bf16x8 awd[2], aad[2];
#pragma unroll
    for (int s = 0; s < 2; ++s) { const int c = 768 + 32 * s + 8 * q4;
        f32x4 lo = rw_shift4(Prw, m, c, hp, hn, mu), hi = rw_shift4(Prw, m, c + 4, hp, hn, mu);
#pragma unroll
        for (int i = 0; i < 4; ++i) { lo[i] = tanhf(lo[i]); hi[i] = tanhf(hi[i]); }
        awd[s] = pack_acc(lo, hi);
        aad[s] = pack_acc(rw_shift4(Prw, m, c + 64, hp, hn, mu), rw_shift4(Prw, m, c + 68, hp, hn, mu)); }
#pragma unroll 1
    for (int h = 0; h < 4; ++h) {
        f32x4 k[4]; float kn = 0.f;
        { const float* k_k = (const float*)inptr(F, 17) + l * 256;
#pragma unroll
          for (int nt = 0; nt < 4; ++nt) { const int c = 64 * h + 16 * nt + 4 * q4; k[nt] = rw_shift4(Prw, m, 256 + c, hp, hn, mu);
              const f32x4 x = k[nt] * *(const f32x4*)(k_k + c); kn += (x[0] * x[0] + x[1] * x[1]) + (x[2] * x[2] + x[3] * x[3]); } }
        kn += __shfl_xor(kn, 16); kn += __shfl_xor(kn, 32);
        const float rkn = rsqrtf(kn + 1e-6f);
        float br[2] = {0.f, 0.f}, kr[2] = {0.f, 0.f}, cbv = 0.f;
        unsigned char* rs = F.ws + WS_RS + (((size_t)b * 4 + h) * SEQ + t) * RS_REC + 8 * q4;
        unsigned char* rd0 = F.ws + WS_RD + (((size_t)b * 4 + h) * SEQ + t) * RD_REC + 8 * q4;
#pragma unroll 1
        for (int nt = 0; nt < 4; ++nt) { const int c = 64 * h + 16 * nt + 4 * q4;
            const f32x4 r = rw_shift4(Prw, m, c, hp, hn, mu), v = rw_shift4(Prw, m, 512 + c, hp, hn, mu);
            const f32x4 kk = k[nt] * *(const f32x4*)((const float*)inptr(F, 17) + l * 256 + c) * rkn;
            *(u64_t*)(rs + 32 * nt) = pk4(kk); *(u64_t*)(rs + 128 + 32 * nt) = pk4(v); *(u64_t*)(rs + 256 + 32 * nt) = pk4(r);
            f32x4 ksum = {0.f, 0.f, 0.f, 0.f};
#pragma unroll
            for (int e = 0; e < 2; ++e) { const bf16* w = W2T + (size_t)(e * 256 + 64 * h + 16 * nt) * 64; const bf16* a = A2T + (size_t)(e * 256 + 64 * h + 16 * nt) * 64;
                f32x4 x = {0.f, 0.f, 0.f, 0.f}, y = {0.f, 0.f, 0.f, 0.f};
#pragma unroll
                for (int s = 0; s < 2; ++s) { x = __builtin_amdgcn_mfma_f32_16x16x32_bf16(*(const bf16x8*)(w + 32 * s), awd[s], x, 0, 0, 0); y = __builtin_amdgcn_mfma_f32_16x16x32_bf16(*(const bf16x8*)(a + 32 * s), aad[s], y, 0, 0, 0); }
                const f32x4 w0v = *(const f32x4*)((const float*)inptr(F, 13) + l * 512 + e * 256 + c), a0v = *(const f32x4*)((const float*)inptr(F, 15) + l * 512 + e * 256 + c), kav = *(const f32x4*)((const float*)inptr(F, 18) + l * 256 + c);
                f32x4 lam, av;
#pragma unroll
                for (int i = 0; i < 4; ++i) { lam[i] = __expf(-softplusf_(-(w0v[i] + x[i])) - 0.5f); av[i] = sigmoidf_(a0v[i] + y[i]); }
                const f32x4 km = k[nt] * (1.f + (av - 1.f) * kav), bb = av * kk;
                ksum += km;
                br[e] += (bb[0] * r[0] + bb[1] * r[1]) + (bb[2] * r[2] + bb[3] * r[3]); kr[e] += (km[0] * r[0] + km[1] * r[1]) + (km[2] * r[2] + km[3] * r[3]);
                typedef _Float16 h4 __attribute__((ext_vector_type(4)));
                const h4 lh = {(_Float16)lam[0], (_Float16)lam[1], (_Float16)lam[2], (_Float16)lam[3]};
                unsigned char* rd = rd0 + e * RD_DIR;
                *(u64_t*)(rd + 32 * nt) = __builtin_bit_cast(u64_t, lh); *(u64_t*)(rd + 128 + 32 * nt) = pk4(bb); *(u64_t*)(rd + 256 + 32 * nt) = pk4(km); }
            const f32x4 rkv = *(const f32x4*)((const float*)inptr(F, 19) + l * 256 + c), xx = r * ksum * rkv; cbv += (xx[0] + xx[1]) + (xx[2] + xx[3]);
        }
#pragma unroll
        for (int e = 0; e < 2; ++e) { float x = br[e], y = kr[e]; x += __shfl_xor(x, 16); x += __shfl_xor(x, 32); y += __shfl_xor(y, 16); y += __shfl_xor(y, 32);
            if (q4 == 0) { typedef float f2 __attribute__((ext_vector_type(2))); *(f2*)(rd0 + e * RD_DIR + 384) = (f2){x, y}; } }
        cbv += __shfl_xor(cbv, 16); cbv += __shfl_xor(cbv, 32);
        if (q4 == 0) ((float*)(F.ws + WS_CB))[m * 4 + h] = 0.5f * cbv;
    }
}
__device__ __forceinline__ void p2_prep2(Frame& F, int l) {
    const int gw = F.vcu * NWAVES + F.wave, NGW = F.G * NWAVES;
    for (int u = gw; u < 2 * (M / 16); u += NGW) { if (u & 1) p2_rwkv_unit(F, l, u >> 1); else p2_mla_unit(F, l, u >> 1); }
}
typedef unsigned u32x4 __attribute__((ext_vector_type(4)));
__device__ __forceinline__ float dot_bf16(const bf16* a, const bf16* b, int K) {
    float acc = 0.f;
    for (int k = 0; k < K; k += 8) {
        const u32x4 av = *(const u32x4*)(a + k), bv = *(const u32x4*)(b + k);
#pragma unroll
        for (int i = 0; i < 4; ++i) {
            acc += __uint_as_float(av[i] << 16) * __uint_as_float(bv[i] << 16);
            acc += __uint_as_float(av[i] & 0xffff0000u) * __uint_as_float(bv[i] & 0xffff0000u);
        }
    }
    return acc;
}
__global__ void __launch_bounds__(64) nk_mla_prep(const bf16* Pmla, const bf16* WuqT, const bf16* WukvT, const int* positions, bf16* Q, bf16* Kb, bf16* Vt) {
    __shared__ float raw[576 + 768];
    __shared__ float rs[2];
    const int m = blockIdx.x, lane = threadIdx.x, b = m / SEQ, t = m % SEQ;
    const bf16* p = Pmla + (size_t)m * 352;
    float s1 = 0.f, s2 = 0.f;
    for (int c = lane; c < 192; c += 64) { const float v = bf2f(p[c]); s1 += v * v; }
    for (int c = lane; c < 128; c += 64) { const float v = bf2f(p[192 + c]); s2 += v * v; }
    s1 = wave_sum(s1); s2 = wave_sum(s2);
    const float rq = rsqrtf(s1 * (1.f / 192.f) + NORM_EPS), rkv = rsqrtf(s2 * (1.f / 128.f) + NORM_EPS);
    for (int c = lane; c < 576; c += 64) raw[c] = dot_bf16(p, WuqT + (size_t)c * 192, 192) * rq;
    for (int c = lane; c < 768; c += 64) raw[576 + c] = dot_bf16(p + 192, WukvT + (size_t)c * 128, 128) * rkv;
    __syncthreads();
    const float pos = (float)positions[m];
    const float qs = 0.10206207261596575f * LOG2E;
    for (int i = lane; i < 6 * 80; i += 64) {
        const int h = i / 80, j = i % 80;
        bf16* qo = Q + (((size_t)b * 6 + h) * SEQ + t) * 96;
        if (j < 64) qo[j] = f2bf(raw[h * 96 + j] * qs);
        else { const int r = j - 64; const float inv = exp2f(-(float)r * (13.287712379549449f / 16.f)); float sn, cs; sincosf(pos * inv, &sn, &cs);
            const float x1 = raw[h * 96 + 64 + r], x2 = raw[h * 96 + 80 + r];
            qo[64 + r] = f2bf((x1 * cs - x2 * sn) * qs); qo[80 + r] = f2bf((x2 * cs + x1 * sn) * qs); }
    }
    for (int i = lane; i < 6 * 64; i += 64) {
        const int h = i / 64, j = i % 64;
        Kb[(((size_t)b * 6 + h) * SEQ + t) * 96 + j] = f2bf(raw[576 + h * 128 + j]);
        Vt[(((size_t)b * 6 + h) * 64 + j) * SEQ + t] = f2bf(raw[576 + h * 128 + 64 + j]);
    }
    if (lane < 16) {
        const int r = lane; const float inv = exp2f(-(float)r * (13.287712379549449f / 16.f)); float sn, cs; sincosf(pos * inv, &sn, &cs);
        const float x1 = bf2f(p[320 + r]), x2 = bf2f(p[336 + r]);
        const bf16 o1 = f2bf(x1 * cs - x2 * sn), o2 = f2bf(x2 * cs + x1 * sn);
        for (int h = 0; h < 6; ++h) { bf16* ko = Kb + (((size_t)b * 6 + h) * SEQ + t) * 96; ko[64 + r] = o1; ko[80 + r] = o2; }
    }
}
__global__ void __launch_bounds__(256) nk_rwkv_prep(const bf16* Prw, const float* mu, const float* w0, const float* w2, const float* a0, const float* a2,
                             const float* k_k, const float* k_a, const float* r_k, unsigned char* Rs, unsigned char* Rd, float* cb) {
    __shared__ float f[896];
    const int m = blockIdx.x, c = threadIdx.x, b = m / SEQ, t = m % SEQ, h = c >> 6, j = c & 63;
    for (int i = c; i < 896; i += 256) {
        const float x = bf2f(Prw[(size_t)m * 896 + i]);
        const float xp = t > 0 ? bf2f(Prw[(size_t)(m - 1) * 896 + i]) : 0.f;
        const float xn = t < SEQ - 1 ? bf2f(Prw[(size_t)(m + 1) * 896 + i]) : 0.f;
        float v = x + mu[i] * (xp - x) + mu[896 + i] * (xn - x);
        if (i >= 768 && i < 832) v = tanhf(v);
        f[i] = v;
    }
    __syncthreads();
    const float r = f[c], k = f[256 + c], v = f[512 + c];
    const float kkr = k * k_k[c];
    const float kn = wave_sum(kkr * kkr);
    const float kk = kkr * rsqrtf(kn + 1e-6f);
    float kmod[2], bb[2], lam[2];
#pragma unroll
    for (int e = 0; e < 2; ++e) {
        float lw = 0.f, la = 0.f;
        for (int d = 0; d < 64; ++d) { lw += f[768 + d] * w2[((size_t)e * 64 + d) * 256 + c]; la += f[832 + d] * a2[((size_t)e * 64 + d) * 256 + c]; }
        const float wl = -softplusf_(-(w0[e * 256 + c] + lw)) - 0.5f;
        lam[e] = __expf(wl);
        const float a = sigmoidf_(a0[e * 256 + c] + la);
        kmod[e] = k * (1.f + (a - 1.f) * k_a[c]);
        bb[e] = a * kk;
    }
    unsigned char* rs = Rs + (((size_t)b * 4 + h) * SEQ + t) * RS_REC;
    ((bf16*)rs)[j] = f2bf(kk); ((bf16*)(rs + 128))[j] = f2bf(v); ((bf16*)(rs + 256))[j] = f2bf(r);
#pragma unroll
    for (int e = 0; e < 2; ++e) {
        unsigned char* rd = Rd + e * RD_DIR + (((size_t)b * 4 + h) * SEQ + t) * RD_REC;
        ((__half*)rd)[j] = __float2half(lam[e]); ((bf16*)(rd + 128))[j] = f2bf(bb[e]); ((bf16*)(rd + 256))[j] = f2bf(kmod[e]);
        const float br = wave_sum(bb[e] * r), kr = wave_sum(kmod[e] * r);
        if (j == 0) { ((float*)(rd + 384))[0] = br; ((float*)(rd + 384))[1] = kr; }
    }
    const float cbv = wave_sum(r * 0.5f * (kmod[0] + kmod[1]) * r_k[c]);
    if (j == 0) cb[(size_t)m * 4 + h] = cbv;
}
__global__ void __launch_bounds__(128) nk_attn(const bf16* Q, const bf16* Kb, const bf16* Vt, bf16* Omla) {
    const int bh = blockIdx.y, q = blockIdx.x * 128 + threadIdx.x, b = bh / 6, h = bh % 6;
    const bf16* qp = Q + ((size_t)bh * SEQ + q) * 96;
    float qr[96];
#pragma unroll
    for (int i = 0; i < 96; ++i) qr[i] = bf2f(qp[i]);
    float acc[64];
#pragma unroll
    for (int i = 0; i < 64; ++i) acc[i] = 0.f;
    float mx = -1e30f, l = 0.f;
    const bf16* kb = Kb + (size_t)bh * SEQ * 96; const bf16* vt = Vt + (size_t)bh * 64 * SEQ;
    for (int k0 = 0; k0 < SEQ; k0 += 8) {
        float s[8];
#pragma unroll
        for (int kk = 0; kk < 8; ++kk) {
            const bf16* kr = kb + (size_t)(k0 + kk) * 96; float a = 0.f;
#pragma unroll
            for (int d = 0; d < 96; d += 8) { const u32x4 kv = *(const u32x4*)(kr + d);
#pragma unroll
                for (int i = 0; i < 4; ++i) { a += qr[d + 2 * i] * __uint_as_float(kv[i] << 16); a += qr[d + 2 * i + 1] * __uint_as_float(kv[i] & 0xffff0000u); } }
            s[kk] = a;
        }
        float cm = s[0];
#pragma unroll
        for (int kk = 1; kk < 8; ++kk) cm = fmaxf(cm, s[kk]);
        const float mn = fmaxf(mx, cm), sc = exp2f(mx - mn);
        l *= sc;
#pragma unroll
        for (int i = 0; i < 64; ++i) acc[i] *= sc;
        mx = mn;
#pragma unroll
        for (int kk = 0; kk < 8; ++kk) { s[kk] = exp2f(s[kk] - mn); l += s[kk]; }
#pragma unroll
        for (int d = 0; d < 64; ++d) { const u32x4 vv = *(const u32x4*)(vt + (size_t)d * SEQ + k0);
#pragma unroll
            for (int i = 0; i < 4; ++i) { acc[d] += s[2 * i] * __uint_as_float(vv[i] << 16); acc[d] += s[2 * i + 1] * __uint_as_float(vv[i] & 0xffff0000u); } }
    }
    const float il = 1.f / l;
    bf16* o = Omla + ((size_t)b * SEQ + q) * 384 + h * 64;
#pragma unroll
    for (int i = 0; i < 64; ++i) o[i] = f2bf(acc[i] * il);
}
__global__ void __launch_bounds__(64) nk_gdn(const bf16* Pgdn, const float* Psm, const float* conv_w, const float* a_log, const float* dt_bias, bf16* Ogdn, int dir) {
    __shared__ float qs[64], ks[64];
    const int bh = blockIdx.x, b = bh / 6, h = bh % 6, e = threadIdx.x;
    float S[64];
#pragma unroll
    for (int i = 0; i < 64; ++i) S[i] = 0.f;
    float cw[3][5];
#pragma unroll
    for (int i = 0; i < 5; ++i) { cw[0][i] = conv_w[i * 1152 + h * 64 + e]; cw[1][i] = conv_w[i * 1152 + 384 + h * 64 + e]; cw[2][i] = conv_w[i * 1152 + 768 + h * 64 + e]; }
    const float al = -__expf(a_log[dir * 6 + h]), dtb = dt_bias[dir * 6 + h];
    for (int n = 0; n < SEQ; ++n) {
        const int t = dir ? SEQ - 1 - n : n; const size_t m = (size_t)b * SEQ + t;
        float cq = 0.f, ck = 0.f, cv = 0.f;
#pragma unroll
        for (int i = 0; i < 5; ++i) { const int tt = t + i - 2; if (tt >= 0 && tt < SEQ) { const bf16* pr = Pgdn + ((size_t)b * SEQ + tt) * 1152 + h * 64 + e;
                cq += cw[0][i] * bf2f(pr[0]); ck += cw[1][i] * bf2f(pr[384]); cv += cw[2][i] * bf2f(pr[768]); } }
        cq = siluf(cq); ck = siluf(ck); cv = siluf(cv);
        const float qn = cq * rsqrtf(wave_sum(cq * cq) + 1e-6f) * 0.125f, kn = ck * rsqrtf(wave_sum(ck * ck) + 1e-6f);
        __syncthreads();
        qs[e] = qn; ks[e] = kn;
        __syncthreads();
        const float g = al * softplusf_(Psm[m * 32 + dir * 6 + h] + dtb), beta = sigmoidf_(Psm[m * 32 + 12 + dir * 6 + h]), alpha = __expf(g);
        float kS = 0.f;
#pragma unroll
        for (int d = 0; d < 64; ++d) kS += ks[d] * S[d];
        const float coef = beta * (cv - alpha * kS);
        float o = 0.f;
#pragma unroll
        for (int d = 0; d < 64; ++d) { S[d] = alpha * S[d] + coef * ks[d]; o += qs[d] * S[d]; }
        bf16* op = Ogdn + m * 384 + h * 64 + e;
        if (dir) o += bf2f(*op);
        *op = f2bf(o);
    }
}
__global__ void __launch_bounds__(64) nk_rwkv(const unsigned char* Rs, const unsigned char* Rd, bf16* Y, int dir) {
    const int bh = blockIdx.x, b = bh / 4, h = bh % 4, i = threadIdx.x;
    float S[64];
#pragma unroll
    for (int j = 0; j < 64; ++j) S[j] = 0.f;
    for (int n = 0; n < SEQ; ++n) {
        const int t = dir ? SEQ - 1 - n : n;
        const unsigned char* rs = Rs + ((size_t)bh * SEQ + t) * RS_REC;
        const unsigned char* rd = Rd + dir * RD_DIR + ((size_t)bh * SEQ + t) * RD_REC;
        const float v = bf2f(((const bf16*)(rs + 128))[i]);
        float sa = 0.f;
#pragma unroll
        for (int j = 0; j < 64; ++j) sa -= S[j] * bf2f(((const bf16*)rs)[j]);
        float y = 0.f;
#pragma unroll
        for (int j = 0; j < 64; ++j) {
            const float w = __expf(-__half2float(((const __half*)rd)[j]));
            S[j] = S[j] * w + sa * bf2f(((const bf16*)(rd + 128))[j]) + v * bf2f(((const bf16*)(rd + 256))[j]);
            y += S[j] * bf2f(((const bf16*)(rs + 256))[j]);
        }
        bf16* op = Y + ((size_t)b * SEQ + t) * 256 + h * 64 + i;
        if (dir) y += bf2f(*op);
        *op = f2bf(y);
    }
}
__global__ void __launch_bounds__(1024) nk_mix(const bf16* Ogdn, const bf16* Omla, const bf16* Y, const bf16* Pgate, const unsigned char* Rs, const float* cb,
                       const float* gdn_g, const float* ln_g, const float* ln_b, bf16* mix) {
    const int m = blockIdx.x, c = threadIdx.x, b = m / SEQ, t = m % SEQ;
    float val;
    if (c < 384) { const float o = bf2f(Ogdn[(size_t)m * 384 + c]); const float ss = wave_sum(o * o); val = o * rsqrtf(ss * (1.f / 64.f) + NORM_EPS) * gdn_g[c & 63]; }
    else if (c < 768) val = bf2f(Omla[(size_t)m * 384 + (c - 384)]);
    else { const int cc = c - 768, h = cc >> 6, j = cc & 63; const float y = bf2f(Y[(size_t)m * 256 + cc]);
        const float mean = wave_sum(y) * (1.f / 64.f); const float dv = y - mean; const float var = wave_sum(dv * dv) * (1.f / 64.f);
        const float v = bf2f(((const bf16*)(Rs + (((size_t)b * 4 + h) * SEQ + t) * RS_REC + 128))[j]);
        val = dv * rsqrtf(var + 64e-5f) * ln_g[cc] + ln_b[cc] + cb[(size_t)m * 4 + h] * v; }
    mix[(size_t)m * 1024 + c] = f2bf(val * siluf(bf2f(Pgate[(size_t)m * 1024 + c])));
}
#ifndef MK_SINGLE
#define MK_SINGLE 1
#endif
#ifndef MK_REPU
#define MK_REPU 0
#endif
#ifndef MK_REP2
#define MK_REP2 0
#endif
#ifndef MK_REP3
#define MK_REP3 0
#endif
#ifndef MK_P2
#define MK_P2 1
#endif
#ifndef MK_P3
#define MK_P3 1
#endif
#ifndef MK_P4A
#define MK_P4A 1
#endif
constexpr int PT_OUT = 24, PT_WS = 25, PT_N = 26;
__device__ __forceinline__ void build_frame(Frame& F, LAS unsigned char* lds) {
    F.lds = lds; F.MISC = (volatile LAS unsigned*)(lds + MISC_OFF); F.ptab = (volatile LAS const unsigned long long*)(lds + MISC_OFF + 256);
    const int t = pg8::mk_tid(lds);
    F.tid = t; F.lane = t & 63; F.wave = __builtin_amdgcn_readfirstlane(t >> 6);
    F.G = gridDim.x; { const int bx = blockIdx.x; F.vcu = (F.G % 8 == 0) ? (bx % 8) * (F.G / 8) + bx / 8 : bx; }
    F.ws = (unsigned char*)inptr(F, PT_WS); F.out = (float*)inptr(F, PT_OUT); F.ctl = (gu32*)F.ws;
}
__device__ __forceinline__ bool ph_in(LAS unsigned char* lds, int k) { volatile LAS unsigned* mi = (volatile LAS unsigned*)(lds + MISC_OFF); const int lo = __builtin_amdgcn_readfirstlane((int)mi[20]), hi = __builtin_amdgcn_readfirstlane((int)mi[21]); return lo <= k && k < hi; }
__device__ __forceinline__ void seam(LAS unsigned char* lds, int k) {
    if (ph_in(lds, k) && ph_in(lds, k + 1)) { Frame F; build_frame(F, lds);
        XcdBarrier bar; bar.bar = (unsigned*)(F.ctl + CW_BAR); bar.x = xb_xcc_id(); bar.st = F.MISC + 8; xcd_barrier(bar); }
}
template <int L> __device__ __forceinline__ void layer_phases(LAS unsigned char* lds) {
    constexpr int pb = 1 + 5 * L;
    if (ph_in(lds, pb)) { Frame F; build_frame(F, lds);
        pg8::Gemm g{(const pg8::bf16_t*)(F.ws + WS_XB), (const pg8::bf16_t*)(F.ws + WS_WIN) + (size_t)L * NP * D, M, NP, D};
        pg8::StaticOrder S; S.init(M, NP, F.G, (int)blockIdx.x);
        pg8::EpiRoute E{F.ws};
        pg8::gemm_phase<pg8::EpiRoute, pg8::StaticOrder, true, true>(F.lds + RING_OFF, g, S, E); }
    seam(lds, pb);
    if (ph_in(lds, pb + 1)) { Frame F; build_frame(F, lds); p2_prep2(F, L); }
#if MK_REP2
    seam(lds, pb);
    if (ph_in(lds, pb + 1)) { Frame F; build_frame(F, lds); p2_prep2(F, L); }
#endif
    seam(lds, pb + 1);
#if MK_REPU
    if (ph_in(lds, pb + 2)) { Frame F; build_frame(F, lds); gu32* head = F.ctl + CW_QUEUE + 64 * (2 * L + 1);
        const int n = (MK_REPU == 1) ? U_GDN : (MK_REPU == 2) ? U_RWKV : U_ATT;
        for (;;) { const int u = next_unit(F, head); if (u >= n) break; if (MK_REPU == 1) gdn_unit2(F, L, u); else if (MK_REPU == 2) rwkv_unit(F, u); else attn_unit(F, u); } }
    seam(lds, pb + 1);
#endif
    if (ph_in(lds, pb + 2)) { Frame F; build_frame(F, lds); p3_mixers(F, L, 0); }
#if MK_REP3
    seam(lds, pb + 1);
    if (ph_in(lds, pb + 2)) { Frame F; build_frame(F, lds); p3_mixers(F, L, 1); }
#endif
    seam(lds, pb + 2);
    if (ph_in(lds, pb + 3)) { Frame F; build_frame(F, lds); p4a_mix(F, L); }
    seam(lds, pb + 3);
    if (ph_in(lds, pb + 4)) { Frame F; build_frame(F, lds);
        pg8::Gemm g{(const pg8::bf16_t*)(F.ws + WS_MIX), (const pg8::bf16_t*)(F.ws + WS_WOUT) + (size_t)L * D * D, M, D, D};
        pg8::StaticOrder S; S.init(M, D, F.G, (int)blockIdx.x);
        pg8::EpiOut E{L == 0 ? (const float*)inptr(F, 0) : (const float*)F.out, F.out, F.ws};
        pg8::gemm_phase<pg8::EpiOut, pg8::StaticOrder, true, true>(F.lds + RING_OFF, g, S, E); }
    seam(lds, pb + 4);
}
__global__ void __launch_bounds__(NWAVES * 64, 2) mk_fwd(Args args) {
    extern __shared__ __attribute__((aligned(16))) unsigned char lds_raw[];
    LAS unsigned char* lds = (LAS unsigned char*)lds_raw;
    for (int u = threadIdx.x; u < (LDS_BYTES - LDSCTL_OFF) / 4; u += NWAVES * 64) ((LAS unsigned*)(lds + LDSCTL_OFF))[u] = 0u;
    __syncthreads();
    if (threadIdx.x == 0) { LAS unsigned long long* pt = (LAS unsigned long long*)(lds + MISC_OFF + 256);
#define PT(k) pt[k] = (unsigned long long)args.in[k]
        PT(0); PT(1); PT(2); PT(3); PT(4); PT(5); PT(6); PT(7); PT(8); PT(9); PT(10); PT(11); PT(12); PT(13); PT(14); PT(15); PT(16); PT(17); PT(18); PT(19); PT(20); PT(21); PT(22); PT(23);
#undef PT
        pt[PT_OUT] = (unsigned long long)args.out; pt[PT_WS] = (unsigned long long)args.ws;
        volatile LAS unsigned* mi = (volatile LAS unsigned*)(lds + MISC_OFF); mi[20] = (unsigned)args.ph_lo; mi[21] = (unsigned)args.ph_hi;
        if (args.ph_hi - args.ph_lo > 1) (void)xcd_barrier_post((unsigned*)((gu32*)args.ws + CW_BAR), mi + 8);
    }
    if ((threadIdx.x & 63) == 0) ((volatile LAS unsigned*)(lds + pg8::TIDTAB_OFF))[pg8::hw_slot()] = threadIdx.x >> 6;
    __syncthreads();
    if (ph_in(lds, 0)) { Frame F; build_frame(F, lds); p0_prologue(F); }
    seam(lds, 0);
    layer_phases<0>(lds);
    layer_phases<1>(lds);
    if (ph_in(lds, 11)) { Frame F; build_frame(F, lds); p5_final(F); }
}

static void launch_phases(hipStream_t stream, int grid, Args a, int lo, int hi) {
    a.ph_lo = lo; a.ph_hi = hi;
    hipLaunchKernelGGL(mk_fwd, dim3(grid), dim3(NWAVES * 64), LDS_BYTES, stream, a);
}
extern "C" void kernel_launch(void* const* d_in, const int* in_sizes, int n_in, void* d_out, int out_size, void* d_ws, size_t ws_size, hipStream_t stream) {
    static int grid = 0;
    if (grid == 0) {
        if (n_in != 24 || ws_size < WS_END || out_size != M * D) { fprintf(stderr, "kernel_launch: unexpected inputs (%d), out (%d) or workspace (%zu)\n", n_in, out_size, ws_size); grid = -1; return; }
        int dev = 0, cus = 0;
        if (hipGetDevice(&dev) != hipSuccess || hipDeviceGetAttribute(&cus, hipDeviceAttributeMultiprocessorCount, dev) != hipSuccess) { grid = -1; return; }
        if (hipFuncSetAttribute((const void*)mk_fwd, hipFuncAttributeMaxDynamicSharedMemorySize, LDS_BYTES) != hipSuccess) { fprintf(stderr, "kernel_launch: hipFuncSetAttribute failed\n"); grid = -1; return; }
        (void)hipGetLastError();
        grid = cus;
    }
    if (grid < 0) return;
    unsigned char* ws = (unsigned char*)d_ws;
    hipMemsetAsync(ws + WS_CTL, 0, CTL_ZERO_BYTES, stream);
    Args a{};
    for (int i = 0; i < 24; ++i) a.in[i] = d_in[i];
    a.out = (float*)d_out; a.ws = ws;

    const int* positions = (const int*)d_in[1];
    const float* gdn_conv = (const float*)d_in[4]; const float* gdn_a_log = (const float*)d_in[5]; const float* gdn_dt_bias = (const float*)d_in[6]; const float* gdn_norm_g = (const float*)d_in[7];
    const float* mu = (const float*)d_in[12]; const float* w0 = (const float*)d_in[13]; const float* w2 = (const float*)d_in[14]; const float* a0 = (const float*)d_in[15];
    const float* a2 = (const float*)d_in[16]; const float* k_k = (const float*)d_in[17]; const float* k_a = (const float*)d_in[18]; const float* r_k = (const float*)d_in[19];
    const float* ln_g = (const float*)d_in[20]; const float* ln_b = (const float*)d_in[21];
    bf16* WuqT = (bf16*)(ws + WS_WSMALL + OFF_WUQ); bf16* WukvT = (bf16*)(ws + WS_WSMALL + OFF_WUKV);
    float* Psm = (float*)(ws + WS_PSM); float* cb = (float*)(ws + WS_CB);
    bf16* Pgate = (bf16*)(ws + WS_PGATE); bf16* Pgdn = (bf16*)(ws + WS_PGDN); bf16* Pmla = (bf16*)(ws + WS_PMLA); bf16* Prw = (bf16*)(ws + WS_PRW);
    bf16* Ogdn = (bf16*)(ws + WS_OGDN); bf16* Omla = (bf16*)(ws + WS_OMLA); bf16* Y = (bf16*)(ws + WS_Y);
    unsigned char* Rs = ws + WS_RS; unsigned char* Rd = ws + WS_RD;
    bf16* Q = (bf16*)(ws + WS_Q); bf16* Kb = (bf16*)(ws + WS_K); bf16* Vt = (bf16*)(ws + WS_VT); bf16* mix = (bf16*)(ws + WS_MIX);

#if MK_SINGLE
    launch_phases(stream, grid, a, 0, NPHASE);
    return;
#endif
    launch_phases(stream, grid, a, 0, 1);
    for (int l = 0; l < 2; ++l) {
        launch_phases(stream, grid, a, 1 + 5 * l, 2 + 5 * l);
#if MK_P2
        launch_phases(stream, grid, a, 2 + 5 * l, 3 + 5 * l);
#else
        hipLaunchKernelGGL(nk_mla_prep, dim3(M), dim3(64), 0, stream, Pmla, WuqT + (size_t)l * 576 * 192, WukvT + (size_t)l * 768 * 128, positions, Q, Kb, Vt);
        hipLaunchKernelGGL(nk_rwkv_prep, dim3(M), dim3(256), 0, stream, Prw, mu + l * 2 * 896, w0 + l * 512, w2 + (size_t)l * 2 * 64 * 256, a0 + l * 512, a2 + (size_t)l * 2 * 64 * 256,
                           k_k + l * 256, k_a + l * 256, r_k + l * 256, Rs, Rd, cb);
#endif
#if MK_P3
        launch_phases(stream, grid, a, 3 + 5 * l, 4 + 5 * l);
#else
        hipLaunchKernelGGL(nk_attn, dim3(SEQ / 128, BATCH * 6), dim3(128), 0, stream, Q, Kb, Vt, Omla);
        for (int dir = 0; dir < 2; ++dir) {
            hipLaunchKernelGGL(nk_gdn, dim3(BATCH * 6), dim3(64), 0, stream, Pgdn, Psm, gdn_conv + (size_t)l * 5 * 1152, gdn_a_log + l * 12, gdn_dt_bias + l * 12, Ogdn, dir);
            hipLaunchKernelGGL(nk_rwkv, dim3(BATCH * 4), dim3(64), 0, stream, Rs, Rd, Y, dir);
        }
#endif
#if MK_P4A
        launch_phases(stream, grid, a, 4 + 5 * l, 5 + 5 * l);
#else
        hipLaunchKernelGGL(nk_mix, dim3(M), dim3(1024), 0, stream, Ogdn, Omla, Y, Pgate, Rs, cb, gdn_norm_g + l * 64, ln_g + l * 256, ln_b + l * 256, mix);
#endif
        launch_phases(stream, grid, a, 5 + 5 * l, 6 + 5 * l);
    }
    launch_phases(stream, grid, a, 11, 12);
}
```

```cpp
#include <hip/hip_runtime.h>
#include <cstdio>
#include <cstdint>
#include <hip/hip_fp16.h>
namespace pg8 {
#define PG8_LAS __attribute__((address_space(3)))
typedef unsigned short bf16_t;
typedef short bf16x8 __attribute__((ext_vector_type(8)));
typedef float f32x4 __attribute__((ext_vector_type(4)));
typedef unsigned u32x4 __attribute__((ext_vector_type(4)));
constexpr int BM = 256, BK = 64, HALF = 128, HTB = HALF * BK * 2  , STAGE_BYTES = 8 * HTB, NXCD = 8, WGM = 8;

__host__ __device__ __forceinline__ int lds_byte(int r, int c) { const int st = (r >> 4) * 2 + (c >> 5), rr = r & 15, cc = c & 31, ob = rr * 64 + cc * 2; return st * 1024 + (ob ^ (((ob >> 9) & 1) << 5)); }
__host__ __device__ __forceinline__ void stage_rc(int b, int& R, int& C) { const int st = b / 1024, sb = b % 1024, swz = sb ^ (((sb >> 9) & 1) << 5); R = (st >> 1) * 16 + swz / 64; C = (st & 1) * 32 + (swz % 64) / 2; }
__host__ __device__ __forceinline__ int perm32(int rho) { const int n = rho >> 4, i = rho & 15; return 8 * (i >> 2) + 4 * n + (i & 3); }

struct Unit { int pm, pn; };
struct Gemm { const bf16_t* A; const bf16_t* Bt; int M, N, K; };

struct StaticOrder {
    int nM, nN, nwg, G, c;
    __host__ __device__ void init(int M, int N, int G_, int c_) { nM = M / BM; nN = N / BM; nwg = nM * nN; G = G_; c = c_; }
    __host__ __device__ bool next(int i, Unit& u) const {
        const long L = (long)i * G + c; if (L >= nwg) return false;
        int wgid = (int)L; { const int q = nwg / NXCD, r = nwg % NXCD, xcd = wgid % NXCD, off = wgid / NXCD; wgid = (xcd < r ? xcd * (q + 1) : r * (q + 1) + (xcd - r) * q) + off; }
        const int nig = WGM * nN, gid = wgid / nig, fm = gid * WGM, gsz = (nM - fm) < WGM ? (nM - fm) : WGM;
        u.pm = fm + ((wgid % nig) % gsz); u.pn = (wgid % nig) / gsz; return true;
    }
    __device__ __forceinline__ void a_ready(const Unit&) const {}
    __device__ __forceinline__ void done(const Unit&) const {}
};

__device__ __forceinline__ unsigned cvt_pk_bf16(float lo, float hi) { unsigned r; asm volatile("v_cvt_pk_bf16_f32 %0, %1, %2" : "=v"(r) : "v"(lo), "v"(hi)); return r; }
typedef float f32x2 __attribute__((ext_vector_type(2)));
constexpr int TIDTAB_OFF = 131072 + 320 + 512;
__device__ __forceinline__ unsigned hw_slot() { return (unsigned)__builtin_amdgcn_s_getreg((5 << 11) | 4) & 63u; }
__device__ __forceinline__ int mk_tid(PG8_LAS unsigned char* lds_base) {
    const unsigned lane = __builtin_amdgcn_mbcnt_hi(~0u, __builtin_amdgcn_mbcnt_lo(~0u, 0u));
    const unsigned w = __builtin_amdgcn_readfirstlane(((volatile PG8_LAS unsigned*)(lds_base + TIDTAB_OFF))[hw_slot()]);
    return (int)(w * 64u + lane);
}
struct EpiRoute {
    static constexpr bool PERM = true, AFTER_DRAIN = false;
    unsigned char* ws;
    __device__ __forceinline__ void operator()(const f32x4 (&acc)[2][2][4][2], const Unit& u, int wr, int wc, int fr, int fq) const {
        const int row0 = u.pm * BM + wr * 64 + fr;
        const float* rowss = (const float*)(ws + (1u << 20)); float* Psm = (float*)(ws + (22u << 20));
        unsigned base[2]; int ld[2], cc[2], kind[2];
#pragma unroll
        for (int bj = 0; bj < 2; ++bj) {
            const int cg = u.pn * BM + bj * HALF + wc * 32, col = cg + 8 * fq;
            if (cg < 1024) { base[bj] = 25u << 20; ld[bj] = 1024; cc[bj] = col; kind[bj] = 0; }
            else if (cg < 2176) { base[bj] = 57u << 20; ld[bj] = 1152; cc[bj] = col - 1024; kind[bj] = 0; }
            else if (cg < 2528) { base[bj] = 93u << 20; ld[bj] = 352; cc[bj] = col - 2176; kind[bj] = 0; }
            else if (cg < 3424) { base[bj] = 104u << 20; ld[bj] = 896; cc[bj] = col - 2528; kind[bj] = 0; }
            else if (cg < 3456) { base[bj] = 0u; ld[bj] = 32; cc[bj] = col - 3424; kind[bj] = 1; }
            else { base[bj] = 0u; ld[bj] = 0; cc[bj] = 0; kind[bj] = 2; }
        }
#pragma unroll
        for (int ai = 0; ai < 2; ++ai)
#pragma unroll
            for (int m = 0; m < 4; ++m) {
                const int row = row0 + ai * HALF + m * 16;
                const f32x4* rp = (const f32x4*)(rowss + (size_t)row * 16);
                const f32x4 s0 = rp[0], s1 = rp[1], s2 = rp[2], s3 = rp[3];
                const float ss = ((s0[0] + s0[1]) + (s0[2] + s0[3])) + ((s1[0] + s1[1]) + (s1[2] + s1[3])) + ((s2[0] + s2[1]) + (s2[2] + s2[3])) + ((s3[0] + s3[1]) + (s3[2] + s3[3]));
                const float rstd = __builtin_amdgcn_rsqf(ss * (1.0f / 1024.0f) + 1e-6f);
#pragma unroll
                for (int bj = 0; bj < 2; ++bj) {
                    const f32x4 v0 = acc[ai][bj][m][0] * rstd, v1 = acc[ai][bj][m][1] * rstd;
                    if (kind[bj] == 0) { u32x4 w; w.x = cvt_pk_bf16(v0[0], v0[1]); w.y = cvt_pk_bf16(v0[2], v0[3]); w.z = cvt_pk_bf16(v1[0], v1[1]); w.w = cvt_pk_bf16(v1[2], v1[3]);
                        *(u32x4*)((bf16_t*)(ws + base[bj]) + (size_t)row * ld[bj] + cc[bj]) = w; }
                    else if (kind[bj] == 1) { float* p = Psm + (size_t)row * 32 + cc[bj]; *(f32x4*)p = v0; *(f32x4*)(p + 4) = v1; }
                }
                asm volatile("" ::: "memory");
            }
    }
};
struct EpiOut {
    static constexpr bool PERM = false, AFTER_DRAIN = false;
    const float* xin; float* xout; unsigned char* ws;
    __device__ __forceinline__ void operator()(const f32x4 (&acc)[2][2][4][2], const Unit& u, int wr, int wc, int fr, int fq) const {
        typedef unsigned u32x2v __attribute__((ext_vector_type(2)));
        const int row0 = u.pm * BM + wr * 64 + fr, col0 = u.pn * BM + wc * 32 + 4 * fq;
        float* rowss = (float*)(ws + (1u << 20)); bf16_t* xb = (bf16_t*)(ws + (133u << 20));
#pragma unroll
        for (int ai = 0; ai < 2; ++ai)
#pragma unroll
            for (int m = 0; m < 4; ++m) {
                const int row = row0 + ai * HALF + m * 16; float ss = 0.f;
#pragma unroll
                for (int bj = 0; bj < 2; ++bj)
#pragma unroll
                    for (int n = 0; n < 2; ++n) {
                        const size_t off = (size_t)row * 1024 + col0 + bj * HALF + n * 16;
                        const f32x4 o = *(const f32x4*)(xin + off) + acc[ai][bj][m][n];
                        *(f32x4*)(xout + off) = o;
                        u32x2v w; w.x = cvt_pk_bf16(o[0], o[1]); w.y = cvt_pk_bf16(o[2], o[3]); *(u32x2v*)(xb + off) = w;
                        ss += (o[0] * o[0] + o[1] * o[1]) + (o[2] * o[2] + o[3] * o[3]);
                    }
                ss += __shfl_xor(ss, 16); ss += __shfl_xor(ss, 32);
                if (fq == 0) rowss[(size_t)row * 16 + u.pn * 4 + wc] = ss;
                asm volatile("" ::: "memory");
            }
    }
};
template <class Epi, class Sched, bool ALIGN_EPI = false, bool SP2 = false>
__device__ __forceinline__ void gemm_phase(PG8_LAS unsigned char* lds, const Gemm g, const Sched& S, const Epi& E) {
    const int tid_ = mk_tid(lds);
    const int tid = tid_, wid = __builtin_amdgcn_readfirstlane(tid >> 6), lane = tid & 63, wr = wid >> 2, wc = wid & 3, fr = lane & 15, fq = lane >> 4;
    const int K = g.K, nt = K / BK;
    unsigned voffA[2], voffB[2];
#pragma unroll
    for (int i = 0; i < 2; ++i) { int R, C; stage_rc(tid * 16 + i * 8192, R, C); const int Rb = Epi::PERM ? ((R & ~31) + perm32(R & 31)) : R;
        voffA[i] = (unsigned)(R * K + C) * 2u; voffB[i] = (unsigned)(Rb * K + C) * 2u; }
    const size_t kstep = (size_t)(BK * 2);
    const size_t hstep = (size_t)HALF * K * 2;
    const size_t tstep = 2 * hstep;
    const unsigned ldsw = (unsigned)wid * 1024u;
    const int aoff = lds_byte(wr * 64 + fr, fq * 8), boff = lds_byte(wc * 32 + fr, fq * 8);
#define PG8_SA(b, h) (((b) * 2 + (h)) * HTB)
#define PG8_SB(b, h) ((4 + (b) * 2 + (h)) * HTB)
#define PG8_STAGE(bufoff, gbase, voff) do { _Pragma("unroll") for (int _i = 0; _i < 2; ++_i) \
        __builtin_amdgcn_global_load_lds((const unsigned*)((const char*)(gbase) + (voff)[_i]), (PG8_LAS unsigned*)(lds + (bufoff) + ldsw + _i * 8192), 16, 0, 0); } while (0)
#define PG8_LDA(dst, b, h) do { _Pragma("unroll") for (int m = 0; m < 4; ++m) _Pragma("unroll") for (int k = 0; k < 2; ++k) dst[m][k] = *(const PG8_LAS bf16x8*)(lds + PG8_SA(b, h) + aoff + m * 2048 + k * 1024); } while (0)
#define PG8_LDB(dst, b, h) do { _Pragma("unroll") for (int n = 0; n < 2; ++n) _Pragma("unroll") for (int k = 0; k < 2; ++k) dst[n][k] = *(const PG8_LAS bf16x8*)(lds + PG8_SB(b, h) + boff + n * 2048 + k * 1024); } while (0)
#define PG8_MMA(ai, bj, At, Bt) do { __builtin_amdgcn_s_setprio(1); _Pragma("unroll") for (int m = 0; m < 4; ++m) _Pragma("unroll") for (int n = 0; n < 2; ++n) _Pragma("unroll") for (int k = 0; k < 2; ++k) \
        acc[ai][bj][m][n] = __builtin_amdgcn_mfma_f32_16x16x32_bf16(Bt[n][k], At[m][k], acc[ai][bj][m][n], 0, 0, 0); __builtin_amdgcn_s_setprio(0); } while (0)
#define PG8_WAIT_V(n) asm volatile("s_waitcnt vmcnt(" #n ")" ::: "memory")
#define PG8_WAIT_L(n) asm volatile("s_waitcnt lgkmcnt(" #n ")" ::: "memory")
#define PG8_BAR __builtin_amdgcn_s_barrier()
#define PG8_SCHED __builtin_amdgcn_sched_barrier(0)
    Unit cur, nxt; int ui = 0;
    if (!S.next(0, cur)) return;
    f32x4 acc[2][2][4][2];
#pragma unroll
    for (int a = 0; a < 2; ++a)
#pragma unroll
        for (int b = 0; b < 2; ++b)
#pragma unroll
            for (int m = 0; m < 4; ++m)
#pragma unroll
                for (int n = 0; n < 2; ++n) acc[a][b][m][n] = (f32x4){0.f, 0.f, 0.f, 0.f};
    bf16x8 At[4][2], B0[2][2], B1[2][2];
    const char* cA = (const char*)g.A + (size_t)cur.pm * tstep; const char* cB = (const char*)g.Bt + (size_t)cur.pn * tstep;
    S.a_ready(cur);
    if constexpr (SP2) {
        PG8_STAGE(PG8_SB(0, 0), cB, voffB); PG8_STAGE(PG8_SB(0, 1), cB + hstep, voffB); PG8_STAGE(PG8_SA(0, 0), cA, voffA); PG8_STAGE(PG8_SA(0, 1), cA + hstep, voffA);
        if (wr == 1) PG8_BAR;
        PG8_WAIT_V(2); PG8_BAR;
        PG8_STAGE(PG8_SB(1, 0), cB + kstep, voffB); PG8_STAGE(PG8_SA(1, 0), cA + kstep, voffA); PG8_STAGE(PG8_SB(1, 1), cB + hstep + kstep, voffB);
        PG8_WAIT_V(6); PG8_BAR;
    } else {
        PG8_STAGE(PG8_SB(0, 0), cB, voffB); PG8_STAGE(PG8_SA(0, 0), cA, voffA); PG8_STAGE(PG8_SB(0, 1), cB + hstep, voffB); PG8_STAGE(PG8_SA(0, 1), cA + hstep, voffA);
        if (wr == 1) PG8_BAR;
        PG8_WAIT_V(4); PG8_BAR;
        PG8_STAGE(PG8_SB(1, 0), cB + kstep, voffB); PG8_STAGE(PG8_SA(1, 0), cA + kstep, voffA); PG8_STAGE(PG8_SB(1, 1), cB + hstep + kstep, voffB);
        PG8_WAIT_V(6); PG8_BAR;
    }
    for (;;) {
        const bool has_next = S.next(ui + 1, nxt);
        const char* nA = has_next ? (const char*)g.A + (size_t)nxt.pm * tstep : cA; const char* nB = has_next ? (const char*)g.Bt + (size_t)nxt.pn * tstep : cB;
        for (int t = 0; t < nt; t += 2) {
            const bool last = (t == nt - 2);
            const char* a1 = cA + (size_t)(t + 1) * kstep;
            const char* a2 = last ? nA : cA + (size_t)(t + 2) * kstep; const char* b2 = last ? nB : cB + (size_t)(t + 2) * kstep;
            const char* a3 = a2 + kstep; const char* b3 = b2 + kstep;
            if (last && has_next) S.a_ready(nxt);
            if constexpr (SP2) {
            PG8_LDB(B0, 0, 0); PG8_LDB(B1, 0, 1); PG8_SCHED; PG8_LDA(At, 0, 0); PG8_STAGE(PG8_SA(1, 1), a1 + hstep, voffA);
            PG8_WAIT_V(8); PG8_WAIT_L(0); PG8_BAR; PG8_MMA(0, 0, At, B0); PG8_MMA(0, 1, At, B1); PG8_BAR; PG8_SCHED;
            PG8_LDA(At, 0, 1); PG8_STAGE(PG8_SB(0, 0), b2, voffB); PG8_STAGE(PG8_SB(0, 1), b2 + hstep, voffB); PG8_STAGE(PG8_SA(0, 0), a2, voffA);
            PG8_WAIT_V(8); PG8_WAIT_L(0); PG8_BAR; PG8_MMA(1, 0, At, B0); PG8_MMA(1, 1, At, B1); PG8_BAR; PG8_SCHED;
            PG8_LDB(B0, 1, 0); PG8_LDB(B1, 1, 1); PG8_SCHED; PG8_LDA(At, 1, 0); PG8_STAGE(PG8_SA(0, 1), a2 + hstep, voffA);
            PG8_WAIT_V(8); PG8_WAIT_L(0); PG8_BAR; PG8_MMA(0, 0, At, B0); PG8_MMA(0, 1, At, B1); PG8_BAR; PG8_SCHED;
            PG8_LDA(At, 1, 1); PG8_STAGE(PG8_SB(1, 0), b3, voffB); PG8_STAGE(PG8_SB(1, 1), b3 + hstep, voffB); PG8_STAGE(PG8_SA(1, 0), a3, voffA);
            PG8_WAIT_V(8); PG8_WAIT_L(0); PG8_BAR; PG8_MMA(1, 0, At, B0); PG8_MMA(1, 1, At, B1); PG8_BAR; PG8_SCHED;
            } else {
            PG8_LDB(B0, 0, 0); PG8_SCHED; PG8_LDA(At, 0, 0); PG8_STAGE(PG8_SA(1, 1), a1 + hstep, voffA);
            PG8_WAIT_L(8); PG8_BAR; PG8_WAIT_L(0); PG8_MMA(0, 0, At, B0); PG8_BAR; PG8_SCHED;
            PG8_LDB(B1, 0, 1); PG8_STAGE(PG8_SB(0, 0), b2, voffB);
            PG8_BAR; PG8_WAIT_L(0); PG8_MMA(0, 1, At, B1); PG8_BAR;
            PG8_LDA(At, 0, 1); PG8_STAGE(PG8_SA(0, 0), a2, voffA);
            PG8_BAR; PG8_WAIT_L(0); PG8_MMA(1, 0, At, B0); PG8_BAR; PG8_SCHED;
            PG8_STAGE(PG8_SB(0, 1), b2 + hstep, voffB);
            PG8_WAIT_V(6); PG8_BAR; PG8_MMA(1, 1, At, B1); PG8_BAR;
            PG8_LDB(B0, 1, 0); PG8_SCHED; PG8_LDA(At, 1, 0); PG8_STAGE(PG8_SA(0, 1), a2 + hstep, voffA);
            PG8_WAIT_L(8); PG8_BAR; PG8_WAIT_L(0); PG8_MMA(0, 0, At, B0); PG8_BAR; PG8_SCHED;
            PG8_LDB(B1, 1, 1); PG8_STAGE(PG8_SB(1, 0), b3, voffB);
            PG8_BAR; PG8_WAIT_L(0); PG8_MMA(0, 1, At, B1); PG8_BAR;
            PG8_LDA(At, 1, 1); PG8_STAGE(PG8_SA(1, 0), a3, voffA);
            PG8_BAR; PG8_WAIT_L(0); PG8_MMA(1, 0, At, B0); PG8_BAR; PG8_SCHED;
            PG8_STAGE(PG8_SB(1, 1), b3 + hstep, voffB);
            PG8_WAIT_V(6); PG8_BAR; PG8_MMA(1, 1, At, B1); PG8_BAR;
            }
        }
        if constexpr (ALIGN_EPI) { if (wr == 0) PG8_BAR; }
        if constexpr (!Epi::AFTER_DRAIN) { E(acc, cur, wr, wc, fr, fq); S.done(cur); }
        if (!has_next) break;
#pragma unroll
        for (int a = 0; a < 2; ++a)
#pragma unroll
            for (int b = 0; b < 2; ++b)
#pragma unroll
                for (int m = 0; m < 4; ++m)
#pragma unroll
                    for (int n = 0; n < 2; ++n) acc[a][b][m][n] = (f32x4){0.f, 0.f, 0.f, 0.f};
        cur = nxt; cA = nA; cB = nB; ++ui;
        if constexpr (ALIGN_EPI) { if (wr == 1) PG8_BAR; }
    }
    PG8_WAIT_V(0);
    if constexpr (!ALIGN_EPI) { if (wr == 0) PG8_BAR; }
    PG8_BAR;
    if constexpr (Epi::AFTER_DRAIN) { E.fused(acc, cur, wr, wc, fr, fq, lds, wid, lane); S.done(cur); }
#undef PG8_SA
#undef PG8_SB
#undef PG8_STAGE
#undef PG8_LDA
#undef PG8_LDB
#undef PG8_MMA
#undef PG8_WAIT_V
#undef PG8_WAIT_L
#undef PG8_BAR
#undef PG8_SCHED
}
}
#define GAS __attribute__((address_space(1)))
#define LAS __attribute__((address_space(3)))
typedef unsigned short bf16;
typedef unsigned v4u __attribute__((ext_vector_type(4)));
typedef float f32x4 __attribute__((ext_vector_type(4)));
typedef short bf16x8 __attribute__((ext_vector_type(8)));
typedef GAS unsigned gu32;
typedef GAS unsigned long long gu64;
#define RLX_AGENT __ATOMIC_RELAXED, __HIP_MEMORY_SCOPE_AGENT
#define LDS_WAIT() asm volatile("s_waitcnt lgkmcnt(0)" ::: "memory")
#define VM_WAIT() asm volatile("s_waitcnt vmcnt(0)" ::: "memory")
__device__ __forceinline__ unsigned long long rt() { return __builtin_amdgcn_s_memrealtime(); }
__device__ __forceinline__ unsigned f2bf(float f) { unsigned u = __builtin_bit_cast(unsigned, f); return (u + 0x7fffu + ((u >> 16) & 1u)) >> 16; }
__device__ __forceinline__ unsigned pk2(float lo, float hi) { return f2bf(lo) | (f2bf(hi) << 16); }

#define XB_TMO      128
#define XB_XCNT(j)  (256  + 64 * (j))
#define XB_XSUB(j)  (1280 + 64 * (j))
#define XB_XGEN(j)  (2304 + 64 * (j))
#define XB_TOP      3328
#define XB_TOPGEN   3392
#define XCD_BAR_WORDS 3456
#define XB_SPIN_CAP (1u << 18)

__device__ __forceinline__ unsigned xb_ld(unsigned* p)              { return __hip_atomic_load(p, __ATOMIC_RELAXED, __HIP_MEMORY_SCOPE_AGENT); }
__device__ __forceinline__ unsigned xb_add(unsigned* p, unsigned v) { return __hip_atomic_fetch_add(p, v, __ATOMIC_RELAXED, __HIP_MEMORY_SCOPE_AGENT); }
__device__ __forceinline__ unsigned xb_xcc_id() { return (unsigned)__builtin_amdgcn_s_getreg((3 << 11) | 20) & 0xFu; }
#define XB_SPIN(cond, bar) do { unsigned _sp = 0; while (cond) { __builtin_amdgcn_s_sleep(1); \
    if ((++_sp & 255u) == 0u) { if (xb_ld(&(bar)[XB_TMO])) break; if (_sp > XB_SPIN_CAP) { atomicAdd(&(bar)[XB_TMO], 1u); break; } } } } while (0)

struct XcdBarrier {
    unsigned* bar; unsigned x;
    volatile LAS unsigned* st;
};

__device__ __forceinline__ XcdBarrier xcd_barrier_post(unsigned* bar, volatile LAS unsigned* st) {
    XcdBarrier b; b.bar = bar; b.x = xb_xcc_id(); b.st = st;
    if (threadIdx.x == 0) (void)xb_add(&bar[XB_XCNT(b.x)], 1u);
    return b;
}
__device__ __forceinline__ void xcd_barrier_complete(unsigned* bar, unsigned x, unsigned& nloc, unsigned& nx) {
    const unsigned G = gridDim.x * gridDim.y * gridDim.z;
    unsigned sum, cnt, mine, sp = 0u;
    for (;;) {
        sum = 0u; cnt = 0u; mine = 0u;
#pragma unroll
        for (unsigned j = 0; j < 16; ++j) { const unsigned c = xb_ld(&bar[XB_XCNT(j)]); sum += c; cnt += (c > 0u) ? 1u : 0u; mine = (j == x) ? c : mine; }
        if (sum == G) break;
        __builtin_amdgcn_s_sleep(1);
        if ((++sp & 255u) == 0u) { if (xb_ld(&bar[XB_TMO])) break; if (sp > XB_SPIN_CAP) { atomicAdd(&bar[XB_TMO], 1u); break; } }
    }
    nloc = mine > 0u ? mine : 1u; nx = cnt > 0u ? cnt : 1u;
}

__device__ __forceinline__ void xcd_barrier(const XcdBarrier& b) {
    asm volatile("s_waitcnt vmcnt(0)" ::: "memory");
    __syncthreads();
    if (pg8::mk_tid((LAS unsigned char*)b.st - (131072 + 320 + 32)) == 0) {
        unsigned* bar = b.bar;
        __builtin_amdgcn_s_waitcnt(0);
        unsigned nloc = b.st[0], nx = b.st[1];
        if (nloc == 0u) { xcd_barrier_complete(bar, b.x, nloc, nx); b.st[0] = nloc; b.st[1] = nx; }
        const unsigned old = xb_add(&bar[XB_XSUB(b.x)], 1u);
        const unsigned gen = old / nloc;
        if (old + 1u == (gen + 1u) * nloc) {
            __builtin_amdgcn_fence(__ATOMIC_RELEASE, "agent");
            asm volatile("s_waitcnt vmcnt(0)" ::: "memory");
            const unsigned og = xb_add(&bar[XB_TOP], 1u);
            const unsigned tg = og / nx;
            if (og + 1u == (tg + 1u) * nx) xb_add(&bar[XB_TOPGEN], 1u);
            else XB_SPIN(xb_ld(&bar[XB_TOPGEN]) == tg, bar);
            __builtin_amdgcn_fence(__ATOMIC_ACQUIRE, "agent");
            xb_add(&bar[XB_XGEN(b.x)], 1u);
            asm volatile("s_waitcnt vmcnt(0)" ::: "memory");
        } else {
            XB_SPIN(xb_ld(&bar[XB_XGEN(b.x)]) == gen, bar);
            __builtin_amdgcn_fence(__ATOMIC_ACQUIRE, "agent");
            asm volatile("s_waitcnt vmcnt(0)" ::: "memory");
        }
    }
    __syncthreads();
}
constexpr int BATCH = 8, SEQ = 2048, M = BATCH * SEQ, D = 1024, NIN = 3448, NP = 3584;
constexpr float NORM_EPS = 1e-6f;
constexpr float LOG2E = 1.4426950408889634f;
constexpr size_t MiB = 1u << 20;
constexpr size_t WS_CTL = 0, CTL_ZERO_BYTES = 1 * MiB;
constexpr size_t WS_ROWSS = 1 * MiB;
constexpr size_t WS_WIN = 2 * MiB;
constexpr size_t WS_WOUT = 16 * MiB;
constexpr size_t WS_WSMALL = 20 * MiB;
constexpr size_t OFF_WUQ = 0, OFF_WUKV = 2 * 576 * 192 * 2, OFF_W2T = OFF_WUKV + 2 * 768 * 128 * 2, OFF_A2T = OFF_W2T + 2 * 2 * 256 * 64 * 2;
constexpr size_t WS_PSM = 22 * MiB;
constexpr size_t WS_CB = 24 * MiB;
constexpr size_t WS_PGATE = 25 * MiB;
constexpr size_t WS_PGDN = 57 * MiB;
constexpr size_t WS_PMLA = 93 * MiB;
constexpr size_t WS_PRW = 104 * MiB;
constexpr size_t WS_OGDN = 93 * MiB;
constexpr size_t WS_OMLA = 105 * MiB;
constexpr size_t WS_Y = 117 * MiB;
constexpr size_t WS_RS = 133 * MiB;
constexpr size_t WS_RD = 157 * MiB;
constexpr size_t WS_XB = 133 * MiB;
constexpr size_t WS_Q = 207 * MiB;
constexpr size_t WS_K = 225 * MiB;
constexpr size_t WS_VT = 243 * MiB;
constexpr size_t WS_MIX = 207 * MiB;
constexpr size_t WS_END = 255 * MiB;
constexpr int RS_REC = 384, RD_REC = 400;
constexpr size_t RD_DIR = (size_t)BATCH * 4 * SEQ * RD_REC;
constexpr int CW_BAR = 4096;
constexpr int CW_QUEUE = 16384;

constexpr int NWAVES = 8;
constexpr int RING_OFF = 0, RING_BYTES = 131072, LDSCTL_OFF = RING_BYTES, MISC_OFF = LDSCTL_OFF + 320, LDS_BYTES = 147456;
static_assert(pg8::TIDTAB_OFF == MISC_OFF + 512 && RING_OFF == 0, "LDS map");
constexpr int NPHASE = 12;

__device__ __forceinline__ float bf2f(bf16 v) { return __uint_as_float(((unsigned)v) << 16); }
__device__ __forceinline__ float wave_sum(float v) {
#pragma unroll
    for (int o = 1; o < 64; o <<= 1) v += __shfl_xor(v, o);
    return v;
}
__device__ __forceinline__ float siluf(float x) { return x / (1.f + __expf(-x)); }
__device__ __forceinline__ float sigmoidf_(float x) { return 1.f / (1.f + __expf(-x)); }
__device__ __forceinline__ float softplusf_(float x) { return x > 20.f ? x : log1pf(__expf(x)); }

struct Args { const void* in[24]; float* out; unsigned char* ws; int ph_lo, ph_hi; };

struct Frame {
    LAS unsigned char* lds;
    volatile LAS unsigned* MISC;
    gu32* ctl;
    int tid, lane, wave, vcu, G;
    unsigned char* ws;
    float* out;
    volatile LAS const unsigned long long* ptab;
};
__device__ __forceinline__ const void* inptr(const Frame& F, int k) {
    const unsigned long long v = F.ptab[k];
    const unsigned lo = __builtin_amdgcn_readfirstlane((unsigned)v), hi = __builtin_amdgcn_readfirstlane((unsigned)(v >> 32));
    return (const void*)(((unsigned long long)hi << 32) | lo);
}

__device__ __forceinline__ void tr_item(const float* W, int K, int ldsrc, int scol, int nvalid, bf16* WT, const float* gs, LAS float* scr, int kb, int lane) {
    const int k0 = 64 * kb;
#pragma unroll 8
    for (int i = 0; i < 32; ++i) { const int kk = 2 * i + (lane >> 5), n = lane & 31; float v = 0.f;
        if (n < nvalid) { v = W[(size_t)(k0 + kk) * ldsrc + scol + n]; if (gs) v *= gs[k0 + kk]; }
        scr[kk * 33 + n] = v; }
    LDS_WAIT(); asm volatile("" ::: "memory");
    const int c = lane & 7;
#pragma unroll
    for (int j = 0; j < 4; ++j) { const int n = (lane >> 3) + 8 * j; const LAS float* s = scr + (8 * c) * 33 + n;
        v4u o; o.x = pk2(s[0 * 33], s[1 * 33]); o.y = pk2(s[2 * 33], s[3 * 33]); o.z = pk2(s[4 * 33], s[5 * 33]); o.w = pk2(s[6 * 33], s[7 * 33]);
        *(GAS v4u*)(WT + (size_t)n * K + k0 + 8 * c) = o; }
    LDS_WAIT(); asm volatile("" ::: "memory");
}
__device__ __forceinline__ void p0_prologue(Frame& F) {
    LAS float* scr = (LAS float*)(F.lds + RING_OFF + F.wave * 16384);
    const int gw = F.vcu * NWAVES + F.wave, NGW = F.G * NWAVES;
    constexpr int I_IN = 112 * 16, I_OUT = 32 * 16, I_UQ = 18 * 3, I_UKV = 24 * 2, I_W2 = 16, I_A2 = 16, I_L = I_IN + I_OUT + I_UQ + I_UKV + I_W2 + I_A2;
    for (int it = gw; it < 2 * I_L; it += NGW) {
        const int l = it / I_L; int r = it % I_L;
        if (r < I_IN) { const int nb = r >> 4, kb = r & 15, n0 = 32 * nb; int scol, nv;
            if (n0 < 2176) { scol = n0; nv = 32; } else if (n0 < 3424) { scol = n0 + 24; nv = 32; } else if (n0 == 3424) { scol = 2176; nv = 24; } else { scol = 0; nv = 0; }
            tr_item((const float*)inptr(F, 3) + (size_t)l * D * NIN, D, NIN, scol, nv, (bf16*)(F.ws + WS_WIN) + ((size_t)l * NP + n0) * D, (const float*)inptr(F, 2) + l * D, scr, kb, F.lane); continue; }
        r -= I_IN;
        if (r < I_OUT) { const int nb = r >> 4, kb = r & 15;
            tr_item((const float*)inptr(F, 22) + (size_t)l * D * D, D, D, 32 * nb, 32, (bf16*)(F.ws + WS_WOUT) + ((size_t)l * D + 32 * nb) * D, nullptr, scr, kb, F.lane); continue; }
        r -= I_OUT;
        if (r < I_UQ) { const int nb = r / 3, kb = r % 3;
            tr_item((const float*)inptr(F, 9) + (size_t)l * 192 * 576, 192, 576, 32 * nb, 32, (bf16*)(F.ws + WS_WSMALL + OFF_WUQ) + ((size_t)l * 576 + 32 * nb) * 192, (const float*)inptr(F, 8) + l * 192, scr, kb, F.lane); continue; }
        r -= I_UQ;
        if (r < I_UKV) { const int nb = r >> 1, kb = r & 1;
            tr_item((const float*)inptr(F, 11) + (size_t)l * 128 * 768, 128, 768, 32 * nb, 32, (bf16*)(F.ws + WS_WSMALL + OFF_WUKV) + ((size_t)l * 768 + 32 * nb) * 128, (const float*)inptr(F, 10) + l * 128, scr, kb, F.lane); continue; }
        r -= I_UKV;
        if (r < I_W2) { const int e = r >> 3, nb = r & 7;
            tr_item((const float*)inptr(F, 14) + ((size_t)l * 2 + e) * 64 * 256, 64, 256, 32 * nb, 32, (bf16*)(F.ws + WS_WSMALL + OFF_W2T) + (((size_t)l * 2 + e) * 256 + 32 * nb) * 64, nullptr, scr, 0, F.lane); continue; }
        r -= I_W2;
        { const int e = r >> 3, nb = r & 7;
            tr_item((const float*)inptr(F, 16) + ((size_t)l * 2 + e) * 64 * 256, 64, 256, 32 * nb, 32, (bf16*)(F.ws + WS_WSMALL + OFF_A2T) + (((size_t)l * 2 + e) * 256 + 32 * nb) * 64, nullptr, scr, 0, F.lane); }
    }
    const float* x = (const float*)inptr(F, 0); bf16* xb = (bf16*)(F.ws + WS_XB); float* rowss = (float*)(F.ws + WS_ROWSS);
    for (int m = gw; m < M; m += NGW) {
        const GAS f32x4* xr = (const GAS f32x4*)(x + (size_t)m * D) + F.lane;
        GAS unsigned long long* o8 = (GAS unsigned long long*)(xb + (size_t)m * D) + F.lane; float s = 0.f;
#pragma unroll
        for (int j = 0; j < 4; ++j) { const f32x4 v = xr[64 * j]; s += (v.x * v.x + v.y * v.y) + (v.z * v.z + v.w * v.w);
            o8[64 * j] = (unsigned long long)pk2(v.x, v.y) | ((unsigned long long)pk2(v.z, v.w) << 32); }
        s = wave_sum(s);
        if (F.lane < 16) rowss[(size_t)m * 16 + F.lane] = F.lane == 0 ? s : 0.f;
    }
}
__device__ __forceinline__ void p5_final(Frame& F) {
    const int gw = F.vcu * NWAVES + F.wave, NGW = F.G * NWAVES;
    const float* rowss = (const float*)(F.ws + WS_ROWSS); const float* g = (const float*)inptr(F, 23);
    f32x4 gv[4];
#pragma unroll
    for (int j = 0; j < 4; ++j) gv[j] = ((const f32x4*)g)[F.lane + 64 * j];
    for (int m = gw; m < M; m += NGW) {
        float ss = F.lane < 16 ? rowss[(size_t)m * 16 + F.lane] : 0.f;
        ss = wave_sum(ss);
        const float rstd = rsqrtf(ss * (1.f / D) + NORM_EPS);
        GAS f32x4* xr = (GAS f32x4*)(F.out + (size_t)m * D) + F.lane;
#pragma unroll
        for (int j = 0; j < 4; ++j) { f32x4 v = xr[64 * j]; v = v * rstd * gv[j]; xr[64 * j] = v; }
    }
}
__device__ __forceinline__ float dotbf(const bf16* a, const bf16* b, int K) {
    float acc = 0.f;
#pragma unroll 2
    for (int k = 0; k < K; k += 8) {
        const v4u av = *(const v4u*)(a + k), bv = *(const v4u*)(b + k);
#pragma unroll
        for (int i = 0; i < 4; ++i) {
            acc += __uint_as_float(av[i] << 16) * __uint_as_float(bv[i] << 16);
            acc += __uint_as_float(av[i] & 0xffff0000u) * __uint_as_float(bv[i] & 0xffff0000u);
        }
    }
    return acc;
}
__device__ __forceinline__ void p2_mla_token(Frame& F, int l, int m, LAS float* raw) {
    const bf16* Pmla = (const bf16*)(F.ws + WS_PMLA);
    const bf16* WuqT = (const bf16*)(F.ws + WS_WSMALL + OFF_WUQ) + (size_t)l * 576 * 192;
    const bf16* WukvT = (const bf16*)(F.ws + WS_WSMALL + OFF_WUKV) + (size_t)l * 768 * 128;
    bf16* Q = (bf16*)(F.ws + WS_Q); bf16* Kb = (bf16*)(F.ws + WS_K); bf16* Vt = (bf16*)(F.ws + WS_VT);
    const int lane = F.lane, b = m / SEQ, t = m % SEQ;
    const bf16* p = Pmla + (size_t)m * 352;
    float s1 = 0.f, s2 = 0.f;
    for (int c = lane; c < 192; c += 64) { const float v = bf2f(p[c]); s1 += v * v; }
    for (int c = lane; c < 128; c += 64) { const float v = bf2f(p[192 + c]); s2 += v * v; }
    s1 = wave_sum(s1); s2 = wave_sum(s2);
    const float rq = rsqrtf(s1 * (1.f / 192.f) + NORM_EPS), rkv = rsqrtf(s2 * (1.f / 128.f) + NORM_EPS);
#pragma unroll 1
    for (int c = lane; c < 576; c += 64) raw[c] = dotbf(p, WuqT + (size_t)c * 192, 192) * rq;
#pragma unroll 1
    for (int c = lane; c < 768; c += 64) raw[576 + c] = dotbf(p + 192, WukvT + (size_t)c * 128, 128) * rkv;
    LDS_WAIT(); asm volatile("" ::: "memory");
    const float pos = (float)((const int*)inptr(F, 1))[m];
    const float qs = 0.10206207261596575f * LOG2E;
#pragma unroll 1
    for (int i = lane; i < 6 * 80; i += 64) {
        const int h = i / 80, j = i % 80;
        bf16* qo = Q + (((size_t)b * 6 + h) * SEQ + t) * 96;
        if (j < 64) qo[j] = f2bf(raw[h * 96 + j] * qs);
        else { const int r = j - 64; const float inv = exp2f(-(float)r * (13.287712379549449f / 16.f)); float sn, cs; sincosf(pos * inv, &sn, &cs);
            const float x1 = raw[h * 96 + 64 + r], x2 = raw[h * 96 + 80 + r];
            qo[64 + r] = f2bf((x1 * cs - x2 * sn) * qs); qo[80 + r] = f2bf((x2 * cs + x1 * sn) * qs); }
    }
#pragma unroll 1
    for (int i = lane; i < 6 * 64; i += 64) {
        const int h = i / 64, j = i % 64;
        Kb[(((size_t)b * 6 + h) * SEQ + t) * 96 + j] = f2bf(raw[576 + h * 128 + j]);
        Vt[(((size_t)b * 6 + h) * 64 + j) * SEQ + t] = f2bf(raw[576 + h * 128 + 64 + j]);
    }
    if (lane < 16) {
        const int r = lane; const float inv = exp2f(-(float)r * (13.287712379549449f / 16.f)); float sn, cs; sincosf(pos * inv, &sn, &cs);
        const float x1 = bf2f(p[320 + r]), x2 = bf2f(p[336 + r]);
        const bf16 o1 = f2bf(x1 * cs - x2 * sn), o2 = f2bf(x2 * cs + x1 * sn);
        for (int h = 0; h < 6; ++h) { bf16* ko = Kb + (((size_t)b * 6 + h) * SEQ + t) * 96; ko[64 + r] = o1; ko[80 + r] = o2; }
    }
    LDS_WAIT(); asm volatile("" ::: "memory");
}
__device__ __forceinline__ void p2_rwkv_token(Frame& F, int l, int m, LAS float* f, int c) {
    const bf16* Prw = (const bf16*)(F.ws + WS_PRW);
    const float* mu = (const float*)inptr(F, 12) + l * 2 * 896; const float* w0 = (const float*)inptr(F, 13) + l * 512; const float* w2 = (const float*)inptr(F, 14) + (size_t)l * 2 * 64 * 256;
    const float* a0 = (const float*)inptr(F, 15) + l * 512; const float* a2 = (const float*)inptr(F, 16) + (size_t)l * 2 * 64 * 256;
    const float* k_k = (const float*)inptr(F, 17) + l * 256; const float* k_a = (const float*)inptr(F, 18) + l * 256; const float* r_k = (const float*)inptr(F, 19) + l * 256;
    unsigned char* Rs = F.ws + WS_RS; unsigned char* Rd = F.ws + WS_RD; float* cb = (float*)(F.ws + WS_CB);
    const int b = m / SEQ, t = m % SEQ, h = c >> 6, j = c & 63;
#pragma unroll 1
    for (int i = c; i < 896; i += 256) {
        const float x = bf2f(Prw[(size_t)m * 896 + i]);
        const float xp = t > 0 ? bf2f(Prw[(size_t)(m - 1) * 896 + i]) : 0.f;
        const float xn = t < SEQ - 1 ? bf2f(Prw[(size_t)(m + 1) * 896 + i]) : 0.f;
        float v = x + mu[i] * (xp - x) + mu[896 + i] * (xn - x);
        if (i >= 768 && i < 832) v = tanhf(v);
        f[i] = v;
    }
    __syncthreads();
    const float r = f[c], k = f[256 + c], v = f[512 + c];
    const float kkr = k * k_k[c];
    const float kn = wave_sum(kkr * kkr);
    const float kk = kkr * rsqrtf(kn + 1e-6f);
    float kmod[2], bb[2], lam[2];
#pragma unroll
    for (int e = 0; e < 2; ++e) {
        float lw = 0.f, la = 0.f;
#pragma unroll 8
        for (int d = 0; d < 64; ++d) { lw += f[768 + d] * w2[((size_t)e * 64 + d) * 256 + c]; la += f[832 + d] * a2[((size_t)e * 64 + d) * 256 + c]; }
        const float wl = -softplusf_(-(w0[e * 256 + c] + lw)) - 0.5f;
        lam[e] = __expf(wl);
        const float a = sigmoidf_(a0[e * 256 + c] + la);
        kmod[e] = k * (1.f + (a - 1.f) * k_a[c]);
        bb[e] = a * kk;
    }
    unsigned char* rs = Rs + (((size_t)b * 4 + h) * SEQ + t) * RS_REC;
    ((bf16*)rs)[j] = f2bf(kk); ((bf16*)(rs + 128))[j] = f2bf(v); ((bf16*)(rs + 256))[j] = f2bf(r);
#pragma unroll
    for (int e = 0; e < 2; ++e) {
        unsigned char* rd = Rd + e * RD_DIR + (((size_t)b * 4 + h) * SEQ + t) * RD_REC;
        ((__half*)rd)[j] = __float2half(lam[e]); ((bf16*)(rd + 128))[j] = f2bf(bb[e]); ((bf16*)(rd + 256))[j] = f2bf(kmod[e]);
        const float br = wave_sum(bb[e] * r), kr = wave_sum(kmod[e] * r);
        if (j == 0) { ((float*)(rd + 384))[0] = br; ((float*)(rd + 384))[1] = kr; }
    }
    const float cbv = wave_sum(r * 0.5f * (kmod[0] + kmod[1]) * r_k[c]);
    if (j == 0) cb[(size_t)m * 4 + h] = cbv;
    __syncthreads();
}
__device__ __forceinline__ void p2_prep(Frame& F, int l) {
    { LAS float* f = (LAS float*)(F.lds + RING_OFF) + (F.tid >> 8) * 896; const int c = F.tid & 255;
      for (int m = 2 * (int)blockIdx.x + (F.tid >> 8); m < M; m += 2 * F.G) p2_rwkv_token(F, l, m, f, c); }
    { LAS float* raw = (LAS float*)(F.lds + RING_OFF + 8192) + F.wave * 1344;
      const int gw = F.vcu * NWAVES + F.wave, NGW = F.G * NWAVES;
      for (int m = gw; m < M; m += NGW) p2_mla_token(F, l, m, raw); }
}
__device__ __forceinline__ void p4a_mix(Frame& F, int l) {
    const bf16* Ogdn = (const bf16*)(F.ws + WS_OGDN); const bf16* Omla = (const bf16*)(F.ws + WS_OMLA); const bf16* Y = (const bf16*)(F.ws + WS_Y);
    const bf16* Pgate = (const bf16*)(F.ws + WS_PGATE); const unsigned char* Rs = F.ws + WS_RS; const float* cb = (const float*)(F.ws + WS_CB); bf16* mix = (bf16*)(F.ws + WS_MIX);
    const float* gdn_g = (const float*)inptr(F, 7) + l * 64; const float* ln_g = (const float*)inptr(F, 20) + l * 256; const float* ln_b = (const float*)inptr(F, 21) + l * 256;
    const int gw = F.vcu * NWAVES + F.wave, NGW = F.G * NWAVES, j = F.lane;
    const float gg = gdn_g[j];
    for (int m = gw; m < M; m += NGW) {
        const int b = m / SEQ, t = m % SEQ;
#pragma unroll 2
        for (int g = 0; g < 16; ++g) {
            const int c = g * 64 + j; float val;
            if (g < 6) { const float o = bf2f(Ogdn[(size_t)m * 384 + c]); const float ss = wave_sum(o * o); val = o * rsqrtf(ss * (1.f / 64.f) + NORM_EPS) * gg; }
            else if (g < 12) val = bf2f(Omla[(size_t)m * 384 + (c - 384)]);
            else { const int cc = c - 768, h = g - 12; const float y = bf2f(Y[(size_t)m * 256 + cc]);
                const float mean = wave_sum(y) * (1.f / 64.f); const float dv = y - mean; const float var = wave_sum(dv * dv) * (1.f / 64.f);
                const float v = bf2f(((const bf16*)(Rs + (((size_t)b * 4 + h) * SEQ + t) * RS_REC + 128))[j]);
                val = dv * rsqrtf(var + 64e-5f) * ln_g[cc] + ln_b[cc] + cb[(size_t)m * 4 + h] * v; }
            mix[(size_t)m * 1024 + c] = f2bf(val * siluf(bf2f(Pgate[(size_t)m * 1024 + c])));
        }
    }
}
typedef float f32x16 __attribute__((ext_vector_type(16)));
typedef unsigned long long u64_t;
__device__ __forceinline__ bf16x8 mk_bf16x8(u64_t lo, u64_t hi) { typedef u64_t u64x2 __attribute__((ext_vector_type(2))); u64x2 v = {lo, hi}; return __builtin_bit_cast(bf16x8, v); }

constexpr int AT_KP = 208, AT_VP = 136, AT_KBYTES = 64 * AT_KP, AT_VBYTES = 64 * AT_VP, AT_BUF = AT_KBYTES + AT_VBYTES;
__device__ __forceinline__ void attn_unit(Frame& F, int unit) {
    const int bh = unit >> 3, qb = unit & 7, b = bh / 6, h = bh % 6;
    const int tid = F.tid, lane = F.lane, wave = F.wave, r32 = lane & 31, hi = lane >> 5;
    const bf16* Qg = (const bf16*)(F.ws + WS_Q) + ((size_t)bh * SEQ + qb * 256 + wave * 32 + r32) * 96;
    const bf16* Kg = (const bf16*)(F.ws + WS_K) + (size_t)bh * SEQ * 96;
    const bf16* Vg = (const bf16*)(F.ws + WS_VT) + (size_t)bh * 64 * SEQ;
    LAS unsigned char* lds = F.lds + RING_OFF;
    bf16x8 qf[6];
#pragma unroll
    for (int s = 0; s < 6; ++s) qf[s] = *(const bf16x8*)(Qg + 16 * s + 8 * hi);
    const int kr0 = tid / 12, kc0 = tid % 12, kr1 = (512 + tid) / 12, kc1 = (512 + tid) % 12, vd = tid >> 3, vc = tid & 7;
    const bool has1 = tid < 256;
    v4u kreg0, kreg1 = {0u, 0u, 0u, 0u}, vreg;
#define AT_LOAD(t0) do { kreg0 = *(const v4u*)(Kg + (size_t)((t0) + kr0) * 96 + kc0 * 8); if (has1) kreg1 = *(const v4u*)(Kg + (size_t)((t0) + kr1) * 96 + kc1 * 8); \
        vreg = *(const v4u*)(Vg + (size_t)vd * SEQ + (t0) + vc * 8); } while (0)
#define AT_STORE(buf) do { LAS unsigned char* bb_ = lds + (buf) * AT_BUF; *(LAS v4u*)(bb_ + kr0 * AT_KP + kc0 * 16) = kreg0; if (has1) *(LAS v4u*)(bb_ + kr1 * AT_KP + kc1 * 16) = kreg1; \
        LAS u64_t* vp_ = (LAS u64_t*)(bb_ + AT_KBYTES + vd * AT_VP + vc * 16); vp_[0] = (u64_t)vreg.x | ((u64_t)vreg.y << 32); vp_[1] = (u64_t)vreg.z | ((u64_t)vreg.w << 32); } while (0)
    AT_LOAD(0); AT_STORE(0);
    __syncthreads();
    f32x16 o0 = {}, o1 = {};
    float mrun = -1e30f, lsum = 0.f;
    for (int t = 0; t < SEQ / 64; ++t) {
        if (t + 1 < SEQ / 64) AT_LOAD((t + 1) * 64);
        LAS unsigned char* bb = lds + (t & 1) * AT_BUF;
        f32x16 p0 = {}, p1 = {};
        { const LAS unsigned char* kb = bb + r32 * AT_KP + hi * 16;
#pragma unroll
          for (int s = 0; s < 6; ++s) {
              const bf16x8 a0 = *(const LAS bf16x8*)(kb + 32 * s), a1 = *(const LAS bf16x8*)(kb + 32 * AT_KP + 32 * s);
              p0 = __builtin_amdgcn_mfma_f32_32x32x16_bf16(a0, qf[s], p0, 0, 0, 0);
              p1 = __builtin_amdgcn_mfma_f32_32x32x16_bf16(a1, qf[s], p1, 0, 0, 0); } }
        float mloc = fmaxf(p0[0], p1[0]);
#pragma unroll
        for (int r = 1; r < 16; ++r) mloc = fmaxf(mloc, fmaxf(p0[r], p1[r]));
        mloc = fmaxf(mloc, __shfl_xor(mloc, 32));
        const float mnew = fmaxf(mrun, mloc), alpha = __builtin_amdgcn_exp2f(mrun - mnew);
        mrun = mnew; lsum *= alpha;
#pragma unroll
        for (int r = 0; r < 16; ++r) { o0[r] *= alpha; o1[r] *= alpha; }
        float ps = 0.f;
#pragma unroll
        for (int r = 0; r < 16; ++r) { p0[r] = __builtin_amdgcn_exp2f(p0[r] - mnew); p1[r] = __builtin_amdgcn_exp2f(p1[r] - mnew); ps += p0[r] + p1[r]; }
        lsum += ps;
        v4u pk[4];
#pragma unroll
        for (int s2 = 0; s2 < 2; ++s2) {
            pk[s2] = (v4u){pg8::cvt_pk_bf16(p0[8 * s2], p0[8 * s2 + 1]), pg8::cvt_pk_bf16(p0[8 * s2 + 2], p0[8 * s2 + 3]), pg8::cvt_pk_bf16(p0[8 * s2 + 4], p0[8 * s2 + 5]), pg8::cvt_pk_bf16(p0[8 * s2 + 6], p0[8 * s2 + 7])};
            pk[2 + s2] = (v4u){pg8::cvt_pk_bf16(p1[8 * s2], p1[8 * s2 + 1]), pg8::cvt_pk_bf16(p1[8 * s2 + 2], p1[8 * s2 + 3]), pg8::cvt_pk_bf16(p1[8 * s2 + 4], p1[8 * s2 + 5]), pg8::cvt_pk_bf16(p1[8 * s2 + 6], p1[8 * s2 + 7])};
        }
        { const LAS unsigned char* vb = bb + AT_KBYTES + r32 * AT_VP + hi * 8;
#pragma unroll
          for (int ks = 0; ks < 4; ++ks) {
              const bf16x8 pb = __builtin_bit_cast(bf16x8, pk[ks]);
              const bf16x8 v0 = mk_bf16x8(*(const LAS u64_t*)(vb + ks * 32), *(const LAS u64_t*)(vb + ks * 32 + 16));
              const bf16x8 v1 = mk_bf16x8(*(const LAS u64_t*)(vb + 32 * AT_VP + ks * 32), *(const LAS u64_t*)(vb + 32 * AT_VP + ks * 32 + 16));
              o0 = __builtin_amdgcn_mfma_f32_32x32x16_bf16(v0, pb, o0, 0, 0, 0);
              o1 = __builtin_amdgcn_mfma_f32_32x32x16_bf16(v1, pb, o1, 0, 0, 0); } }
        if (t + 1 < SEQ / 64) AT_STORE((t + 1) & 1);
        __syncthreads();
    }
#undef AT_LOAD
#undef AT_STORE
    lsum += __shfl_xor(lsum, 32);
    const float inv = 1.f / lsum;
    bf16* Og = (bf16*)(F.ws + WS_OMLA) + ((size_t)b * SEQ + qb * 256 + wave * 32 + r32) * 384 + h * 64 + 4 * hi;
#pragma unroll
    for (int rg = 0; rg < 4; ++rg) {
        *(u64_t*)(Og + 8 * rg) = (u64_t)pg8::cvt_pk_bf16(o0[4 * rg] * inv, o0[4 * rg + 1] * inv) | ((u64_t)pg8::cvt_pk_bf16(o0[4 * rg + 2] * inv, o0[4 * rg + 3] * inv) << 32);
        *(u64_t*)(Og + 32 + 8 * rg) = (u64_t)pg8::cvt_pk_bf16(o1[4 * rg] * inv, o1[4 * rg + 1] * inv) | ((u64_t)pg8::cvt_pk_bf16(o1[4 * rg + 2] * inv, o1[4 * rg + 3] * inv) << 32);
    }
}

constexpr int CW_FLAG = 32768;
__device__ __forceinline__ void partner_sync(Frame& F, gu32* mine, gu32* theirs) {
    asm volatile("s_waitcnt vmcnt(0)" ::: "memory");
    __syncthreads();
    if (F.tid == 0) {
        __builtin_amdgcn_fence(__ATOMIC_RELEASE, "agent");
        asm volatile("s_waitcnt vmcnt(0)" ::: "memory");
        __hip_atomic_store(mine, 1u, RLX_AGENT);
        unsigned spins = 0;
        while (__hip_atomic_load(theirs, RLX_AGENT) == 0u) { __builtin_amdgcn_s_sleep(4); if (++spins > (1u << 22)) break; }
        __builtin_amdgcn_fence(__ATOMIC_ACQUIRE, "agent");
        asm volatile("s_waitcnt vmcnt(0)" ::: "memory");
    }
    __syncthreads();
}
constexpr int RW_STEP = 1440, RW_CH = 16, RW_BUF = RW_CH * RW_STEP;
constexpr int RW_Y = 2 * RW_BUF;
static_assert(RW_Y + 2 * 2048 <= RING_BYTES, "RWKV LDS map");
__device__ __forceinline__ float dpp_xor1(float x) { return __builtin_bit_cast(float, __builtin_amdgcn_update_dpp(0, __builtin_bit_cast(int, x), 0xB1, 0xF, 0xF, true)); }
__device__ __forceinline__ float dpp_xor2(float x) { return __builtin_bit_cast(float, __builtin_amdgcn_update_dpp(0, __builtin_bit_cast(int, x), 0x4E, 0xF, 0xF, true)); }
__device__ __forceinline__ float dpp_hmir(float x) { return __builtin_bit_cast(float, __builtin_amdgcn_update_dpp(0, __builtin_bit_cast(int, x), 0x141, 0xF, 0xF, true)); }
__device__ __forceinline__ float dpp_rmir(float x) { return __builtin_bit_cast(float, __builtin_amdgcn_update_dpp(0, __builtin_bit_cast(int, x), 0x140, 0xF, 0xF, true)); }
__device__ __forceinline__ void rwkv_unit(Frame& F, int unit, gu32* flags) {
    const int bh = unit >> 2, rowhalf = (unit >> 1) & 1, dir = unit & 1, b = bh >> 2, h = bh & 3;
    const int tid = F.tid, lane = F.lane, w4 = F.wave & 3, ri = lane >> 4, cs = lane & 15;
    const bool stager = F.wave >= 4;
    const unsigned char* Rs = F.ws + WS_RS + (size_t)bh * SEQ * RS_REC;
    const unsigned char* Rd = F.ws + WS_RD + dir * RD_DIR + (size_t)bh * SEQ * RD_REC;
    LAS unsigned char* lds = F.lds + RING_OFF;
    const int ss = (tid >> 4) & 15, sp = tid & 15;
#define RW_BF(x, j) __uint_as_float(((unsigned)((x) >> (16 * (j)))) << 16)
#define RW_STAGE(c_, buf_) do { const int n_ = (c_) * RW_CH + ss, t_ = dir ? SEQ - 1 - n_ : n_; const unsigned char* rs_ = Rs + (size_t)t_ * RS_REC; const unsigned char* rd_ = Rd + (size_t)t_ * RD_REC; \
        const u64_t g_kk = *(const u64_t*)(rs_ + 8 * sp), g_r = *(const u64_t*)(rs_ + 256 + 8 * sp), g_lam = *(const u64_t*)(rd_ + 8 * sp), g_b = *(const u64_t*)(rd_ + 128 + 8 * sp), g_k = *(const u64_t*)(rd_ + 256 + 8 * sp); \
        u64_t g_v = 0, g_s = 0; if (sp < 8) g_v = *(const u64_t*)(rs_ + 128 + 64 * rowhalf + 8 * sp); if (sp == 8) g_s = *(const u64_t*)(rd_ + 384); \
        LAS unsigned char* d_ = lds + (buf_) * RW_BUF + ss * RW_STEP + 16 * sp; f32x4 w_, t4_; \
        w_[0] = __builtin_amdgcn_exp2f(-LOG2E * __half2float(__ushort_as_half((unsigned short)(g_lam)))); w_[1] = __builtin_amdgcn_exp2f(-LOG2E * __half2float(__ushort_as_half((unsigned short)(g_lam >> 16)))); \
        w_[2] = __builtin_amdgcn_exp2f(-LOG2E * __half2float(__ushort_as_half((unsigned short)(g_lam >> 32)))); w_[3] = __builtin_amdgcn_exp2f(-LOG2E * __half2float(__ushort_as_half((unsigned short)(g_lam >> 48)))); \
        *(LAS f32x4*)d_ = w_; \
        t4_ = (f32x4){RW_BF(g_r, 0), RW_BF(g_r, 1), RW_BF(g_r, 2), RW_BF(g_r, 3)}; *(LAS f32x4*)(d_ + 256) = w_ * t4_; \
        t4_ = (f32x4){RW_BF(g_kk, 0), RW_BF(g_kk, 1), RW_BF(g_kk, 2), RW_BF(g_kk, 3)}; *(LAS f32x4*)(d_ + 512) = -t4_; \
        t4_ = (f32x4){RW_BF(g_b, 0), RW_BF(g_b, 1), RW_BF(g_b, 2), RW_BF(g_b, 3)}; *(LAS f32x4*)(d_ + 768) = t4_; \
        t4_ = (f32x4){RW_BF(g_k, 0), RW_BF(g_k, 1), RW_BF(g_k, 2), RW_BF(g_k, 3)}; *(LAS f32x4*)(d_ + 1024) = t4_; \
        if (sp < 8) { t4_ = (f32x4){RW_BF(g_v, 0), RW_BF(g_v, 1), RW_BF(g_v, 2), RW_BF(g_v, 3)}; *(LAS f32x4*)(d_ + 1280) = t4_; } \
        if (sp == 8) *(LAS u64_t*)(lds + (buf_) * RW_BUF + ss * RW_STEP + 1408) = g_s; } while (0)
    f32x4 S0 = {0.f, 0.f, 0.f, 0.f}, S1 = {0.f, 0.f, 0.f, 0.f};
    if (stager) RW_STAGE(0, 0);
    __syncthreads();
    bf16* Yg = (bf16*)(F.ws + WS_Y) + (size_t)b * SEQ * 256 + h * 64 + 32 * rowhalf;
    const int NCH = SEQ / RW_CH;
    for (int c = 0; c < NCH; ++c) {
        LAS float* ybuf = (LAS float*)(lds + RW_Y + (c & 1) * 2048);
        if (stager) { if (c + 1 < NCH) RW_STAGE(c + 1, (c + 1) & 1); }
        else {
            const LAS unsigned char* cb_ = lds + (c & 1) * RW_BUF + 16 * cs;
            const LAS unsigned char* vb_ = lds + (c & 1) * RW_BUF + 1280 + 4 * (8 * w4 + 2 * ri);
#pragma unroll 4
            for (int s = 0; s < RW_CH; ++s) {
                const LAS unsigned char* p = cb_ + s * RW_STEP;
                const f32x4 w = *(const LAS f32x4*)p, wr = *(const LAS f32x4*)(p + 256), nk = *(const LAS f32x4*)(p + 512), bb = *(const LAS f32x4*)(p + 768), kv = *(const LAS f32x4*)(p + 1024);
                typedef float f2 __attribute__((ext_vector_type(2)));
                const f2 v = *(const LAS f2*)(vb_ + s * RW_STEP), brkr = *(const LAS f2*)(lds + (c & 1) * RW_BUF + s * RW_STEP + 1408);
                float sa0 = (S0[0] * nk[0] + S0[1] * nk[1]) + (S0[2] * nk[2] + S0[3] * nk[3]), sa1 = (S1[0] * nk[0] + S1[1] * nk[1]) + (S1[2] * nk[2] + S1[3] * nk[3]);
                float ym0 = (S0[0] * wr[0] + S0[1] * wr[1]) + (S0[2] * wr[2] + S0[3] * wr[3]), ym1 = (S1[0] * wr[0] + S1[1] * wr[1]) + (S1[2] * wr[2] + S1[3] * wr[3]);
                sa0 += dpp_xor1(sa0); sa1 += dpp_xor1(sa1); ym0 += dpp_xor1(ym0); ym1 += dpp_xor1(ym1);
                sa0 += dpp_xor2(sa0); sa1 += dpp_xor2(sa1); ym0 += dpp_xor2(ym0); ym1 += dpp_xor2(ym1);
                sa0 += dpp_hmir(sa0); sa1 += dpp_hmir(sa1); ym0 += dpp_hmir(ym0); ym1 += dpp_hmir(ym1);
                sa0 += dpp_rmir(sa0); sa1 += dpp_rmir(sa1); ym0 += dpp_rmir(ym0); ym1 += dpp_rmir(ym1);
                S0 = S0 * w + (sa0 * bb + v[0] * kv); S1 = S1 * w + (sa1 * bb + v[1] * kv);
                if (cs == 0) { *(LAS f2*)(ybuf + s * 32 + 8 * w4 + 2 * ri) = (f2){ym0 + sa0 * brkr[0] + v[0] * brkr[1], ym1 + sa1 * brkr[0] + v[1] * brkr[1]}; }
            }
        }
        __syncthreads();
        { const int os = tid >> 5, orow = tid & 31, n = c * RW_CH + os, t = dir ? SEQ - 1 - n : n;
          bf16* yp = Yg + (size_t)t * 256 + orow; float y = ybuf[tid];
          if (c >= NCH / 2) y += bf2f(*yp);
          *yp = (bf16)f2bf(y); }
        if (c == NCH / 2 - 1) partner_sync(F, flags + 64 * unit, flags + 64 * (unit ^ 1));
    }
#undef RW_STAGE
#undef RW_BF
    __syncthreads();
}

__device__ __forceinline__ void gdn_unit(Frame& F, int l, int unit) {
    const int bh = unit, b = bh / 6, h = bh % 6, e = F.lane, dir = F.wave;
    const bf16* Pgdn = (const bf16*)(F.ws + WS_PGDN); const float* Psm = (const float*)(F.ws + WS_PSM); bf16* Ogdn = (bf16*)(F.ws + WS_OGDN);
    const float* conv_w = (const float*)inptr(F, 4) + (size_t)l * 5 * 1152; const float* a_log = (const float*)inptr(F, 5) + l * 12; const float* dt_bias = (const float*)inptr(F, 6) + l * 12;
    LAS float* qs = (LAS float*)(F.lds + RING_OFF) + F.wave * 128; LAS float* ks = qs + 64;
    if (F.wave < 2) {
        float S[64];
#pragma unroll
        for (int i = 0; i < 64; ++i) S[i] = 0.f;
        float cw[3][5];
#pragma unroll
        for (int i = 0; i < 5; ++i) { cw[0][i] = conv_w[i * 1152 + h * 64 + e]; cw[1][i] = conv_w[i * 1152 + 384 + h * 64 + e]; cw[2][i] = conv_w[i * 1152 + 768 + h * 64 + e]; }
        const float al = -__expf(a_log[dir * 6 + h]), dtb = dt_bias[dir * 6 + h];
        for (int n = 0; n < SEQ; ++n) {
            if (n == SEQ / 2) { asm volatile("s_waitcnt vmcnt(0)" ::: "memory"); __syncthreads(); }
            const int t = dir ? SEQ - 1 - n : n; const size_t m = (size_t)b * SEQ + t;
            float cq = 0.f, ck = 0.f, cv = 0.f;
#pragma unroll
            for (int i = 0; i < 5; ++i) { const int tt = t + i - 2; if (tt >= 0 && tt < SEQ) { const bf16* pr = Pgdn + ((size_t)b * SEQ + tt) * 1152 + h * 64 + e;
                    cq += cw[0][i] * bf2f(pr[0]); ck += cw[1][i] * bf2f(pr[384]); cv += cw[2][i] * bf2f(pr[768]); } }
            cq = siluf(cq); ck = siluf(ck); cv = siluf(cv);
            const float qn = cq * rsqrtf(wave_sum(cq * cq) + 1e-6f) * 0.125f, kn = ck * rsqrtf(wave_sum(ck * ck) + 1e-6f);
            LDS_WAIT(); asm volatile("" ::: "memory");
            qs[e] = qn; ks[e] = kn;
            LDS_WAIT(); asm volatile("" ::: "memory");
            const float g = al * softplusf_(Psm[m * 32 + dir * 6 + h] + dtb), beta = sigmoidf_(Psm[m * 32 + 12 + dir * 6 + h]), alpha = __expf(g);
            float kS = 0.f;
#pragma unroll
            for (int c4 = 0; c4 < 16; ++c4) { const f32x4 kq = ((const LAS f32x4*)ks)[c4];
                kS += (kq.x * S[4 * c4] + kq.y * S[4 * c4 + 1]) + (kq.z * S[4 * c4 + 2] + kq.w * S[4 * c4 + 3]);
                if ((c4 & 3) == 3) asm volatile("" ::: "memory"); }
            const float coef = beta * (cv - alpha * kS);
            float o = 0.f;
#pragma unroll
            for (int c4 = 0; c4 < 16; ++c4) { const f32x4 kq = ((const LAS f32x4*)ks)[c4], qq = ((const LAS f32x4*)qs)[c4];
                S[4 * c4] = alpha * S[4 * c4] + coef * kq.x; S[4 * c4 + 1] = alpha * S[4 * c4 + 1] + coef * kq.y; S[4 * c4 + 2] = alpha * S[4 * c4 + 2] + coef * kq.z; S[4 * c4 + 3] = alpha * S[4 * c4 + 3] + coef * kq.w;
                o += (qq.x * S[4 * c4] + qq.y * S[4 * c4 + 1]) + (qq.z * S[4 * c4 + 2] + qq.w * S[4 * c4 + 3]);
                if ((c4 & 3) == 3) asm volatile("" ::: "memory"); }
            bf16* op = Ogdn + m * 384 + h * 64 + e;
            if (n >= SEQ / 2) o += bf2f(*op);
            *op = (bf16)f2bf(o);
        }
    } else { __syncthreads(); }
}

constexpr int GP = 144;
constexpr int G_Q = 0, G_K = 9216, G_V = 18432, G_KT = 27648, G_P = 36864, G_A = 46080, G_SM = 63488, G_GROUP = 64512;
constexpr int G_RAW = 65536;
constexpr int G_CW = 133120;
static_assert(2 * G_GROUP <= RING_BYTES && G_CW + 3840 <= LDS_BYTES && G_CW >= MISC_OFF + 1024, "GDN LDS map");
__device__ __forceinline__ bf16x8 ld2x8(const LAS unsigned char* p) { return mk_bf16x8(*(const LAS u64_t*)p, *(const LAS u64_t*)(p + 32)); }
__device__ __forceinline__ bf16x8 pack_acc(const f32x4& a, const f32x4& b) {
    v4u w; w.x = pg8::cvt_pk_bf16(a[0], a[1]); w.y = pg8::cvt_pk_bf16(a[2], a[3]); w.z = pg8::cvt_pk_bf16(b[0], b[1]); w.w = pg8::cvt_pk_bf16(b[2], b[3]); return __builtin_bit_cast(bf16x8, w); }
__device__ __forceinline__ void split_acc(const f32x4& a, const f32x4& b, bf16x8& hi, bf16x8& lo) {
    v4u wh; wh.x = pg8::cvt_pk_bf16(a[0], a[1]); wh.y = pg8::cvt_pk_bf16(a[2], a[3]); wh.z = pg8::cvt_pk_bf16(b[0], b[1]); wh.w = pg8::cvt_pk_bf16(b[2], b[3]);
    f32x4 ra, rb;
    ra[0] = a[0] - __uint_as_float(wh.x << 16); ra[1] = a[1] - __uint_as_float(wh.x & 0xffff0000u); ra[2] = a[2] - __uint_as_float(wh.y << 16); ra[3] = a[3] - __uint_as_float(wh.y & 0xffff0000u);
    rb[0] = b[0] - __uint_as_float(wh.z << 16); rb[1] = b[1] - __uint_as_float(wh.z & 0xffff0000u); rb[2] = b[2] - __uint_as_float(wh.w << 16); rb[3] = b[3] - __uint_as_float(wh.w & 0xffff0000u);
    hi = __builtin_bit_cast(bf16x8, wh); lo = pack_acc(ra, rb);
}
typedef _Float16 f16x8 __attribute__((ext_vector_type(8)));
__device__ __forceinline__ f16x8 pack_acc_f16(const f32x4& a, const f32x4& b) { return (f16x8){(_Float16)a[0], (_Float16)a[1], (_Float16)a[2], (_Float16)a[3], (_Float16)b[0], (_Float16)b[1], (_Float16)b[2], (_Float16)b[3]}; }
template <int SKIP> __device__ __forceinline__ void gdn_unit3(Frame& F, int l, int unit, gu32* flags) {
    const int bh = unit >> 1, dir = unit & 1, b = bh / 6, h = bh % 6;
    const int tid = F.tid, lane = F.lane, wave = F.wave;
    const bf16* Pgdn = (const bf16*)(F.ws + WS_PGDN) + (size_t)b * SEQ * 1152 + h * 64; const float* Psm = (const float*)(F.ws + WS_PSM) + (size_t)b * SEQ * 32;
    bf16* Og = (bf16*)(F.ws + WS_OGDN) + (size_t)b * SEQ * 384 + h * 64;
    LAS unsigned char* gb = F.lds + RING_OFF;
    LAS float* cwl = (LAS float*)(F.lds + G_CW);
    LAS float* sm = (LAS float*)(gb + G_SM);
    { const float* conv_w = (const float*)inptr(F, 4) + (size_t)l * 5 * 1152;
      for (int i = tid; i < 960; i += 512) { const int tn = i / 320, tap = (i % 320) / 64, ch = i % 64; cwl[i] = conv_w[tap * 1152 + tn * 384 + h * 64 + ch]; } }
    const float al = -__expf(((const float*)inptr(F, 5))[l * 12 + dir * 6 + h]), dtb = ((const float*)inptr(F, 6))[l * 12 + dir * 6 + h];
    f32x4 Sacc[4];
#pragma unroll
    for (int i = 0; i < 4; ++i) Sacc[i] = (f32x4){0.f, 0.f, 0.f, 0.f};
    const int ci = tid >> 3, cg = tid & 7;
#define GDN_RAW_STAGE(cc_, first_, nthr_) do { const int tlo_ = (dir ? SEQ - 64 * (cc_) - 64 : 64 * (cc_)) - 2; \
        for (int pc_ = (first_); pc_ < 68 * 24; pc_ += (nthr_)) { const int rr_ = pc_ / 24, sg_ = pc_ % 24, tt_ = tlo_ + rr_; v4u x_ = {0u, 0u, 0u, 0u}; \
            if (!(SKIP & 1) && tt_ >= 0 && tt_ < SEQ) x_ = *(const v4u*)(Pgdn + (size_t)tt_ * 1152 + (sg_ >> 3) * 384 + 8 * (sg_ & 7)); \
            *(LAS v4u*)(gb + G_RAW + rr_ * 384 + 16 * sg_) = x_; } } while (0)
#define GDN_WRITEOUT(cc_) do { if (!(SKIP & 4)) { const int t_ = dir ? SEQ - 1 - 64 * (cc_) - ci : 64 * (cc_) + ci; bf16* op_ = Og + (size_t)t_ * 384 + 8 * cg; \
            const LAS f32x4* src_ = (const LAS f32x4*)(gb + G_A + (ci * 68 + 8 * cg) * 4); f32x4 o0_ = src_[0], o1_ = src_[1]; \
            if ((cc_) >= SEQ / 128) { const v4u p0_ = *(const v4u*)op_; \
                o0_ += (f32x4){__uint_as_float(p0_.x << 16), __uint_as_float(p0_.x & 0xffff0000u), __uint_as_float(p0_.y << 16), __uint_as_float(p0_.y & 0xffff0000u)}; \
                o1_ += (f32x4){__uint_as_float(p0_.z << 16), __uint_as_float(p0_.z & 0xffff0000u), __uint_as_float(p0_.w << 16), __uint_as_float(p0_.w & 0xffff0000u)}; } \
            v4u w0_; w0_.x = pg8::cvt_pk_bf16(o0_[0], o0_[1]); w0_.y = pg8::cvt_pk_bf16(o0_[2], o0_[3]); w0_.z = pg8::cvt_pk_bf16(o1_[0], o1_[1]); w0_.w = pg8::cvt_pk_bf16(o1_[2], o1_[3]); \
            *(v4u*)op_ = w0_; } } while (0)
    GDN_RAW_STAGE(0, tid, 512);
    __syncthreads();
    for (int c = 0; c < SEQ / 64; ++c) {
        if (c > 0) GDN_WRITEOUT(c - 1);
        if (c == SEQ / 128) partner_sync(F, flags + 64 * unit, flags + 64 * (unit ^ 1));
        if (wave == 0) {
            const int t = dir ? SEQ - 1 - 64 * c - lane : 64 * c + lane;
            const float a = Psm[(size_t)t * 32 + dir * 6 + h], bt = Psm[(size_t)t * 32 + 12 + dir * 6 + h];
            float x = al * softplusf_(a + dtb);
#pragma unroll
            for (int off = 1; off < 64; off <<= 1) { const float y = __shfl_up(x, off); if (lane >= off) x += y; }
            const float last = __shfl(x, 63);
            sm[lane] = x; sm[64 + lane] = sigmoidf_(bt); sm[128 + lane] = __expf(x); sm[192 + lane] = __expf(last - x);
        }
        { float acc[3][8];
#pragma unroll
          for (int tn = 0; tn < 3; ++tn)
#pragma unroll
              for (int j = 0; j < 8; ++j) acc[tn][j] = 0.f;
          const int rr0 = dir ? 63 - ci : ci;
#pragma unroll
          for (int tap = 0; tap < 5; ++tap) {
#pragma unroll
              for (int tn = 0; tn < 3; ++tn) { const v4u x0 = *(const LAS v4u*)(gb + G_RAW + (rr0 + tap) * 384 + tn * 128 + 16 * cg); const LAS float* w = cwl + tn * 320 + tap * 64 + 8 * cg; const f32x4 w0 = *(const LAS f32x4*)w, w1 = *(const LAS f32x4*)(w + 4);
                  acc[tn][0] += w0[0] * __uint_as_float(x0[0] << 16); acc[tn][1] += w0[1] * __uint_as_float(x0[0] & 0xffff0000u); acc[tn][2] += w0[2] * __uint_as_float(x0[1] << 16); acc[tn][3] += w0[3] * __uint_as_float(x0[1] & 0xffff0000u);
                  acc[tn][4] += w1[0] * __uint_as_float(x0[2] << 16); acc[tn][5] += w1[1] * __uint_as_float(x0[2] & 0xffff0000u); acc[tn][6] += w1[2] * __uint_as_float(x0[3] << 16); acc[tn][7] += w1[3] * __uint_as_float(x0[3] & 0xffff0000u); }
              asm volatile("" ::: "memory"); }
          float sq = 0.f, sk = 0.f;
#pragma unroll
          for (int j = 0; j < 8; ++j) { acc[0][j] = siluf(acc[0][j]); acc[1][j] = siluf(acc[1][j]); acc[2][j] = siluf(acc[2][j]); sq += acc[0][j] * acc[0][j]; sk += acc[1][j] * acc[1][j]; }
          sq += dpp_xor1(sq); sk += dpp_xor1(sk); sq += dpp_xor2(sq); sk += dpp_xor2(sk); sq += dpp_hmir(sq); sk += dpp_hmir(sk);
          const float rq = rsqrtf(sq + 1e-6f) * 0.125f, rk = rsqrtf(sk + 1e-6f);
          v4u wq, wk, wv;
#pragma unroll
          for (int q = 0; q < 4; ++q) { wq[q] = pg8::cvt_pk_bf16(acc[0][2 * q] * rq, acc[0][2 * q + 1] * rq); wk[q] = pg8::cvt_pk_bf16(acc[1][2 * q] * rk, acc[1][2 * q + 1] * rk); wv[q] = pg8::cvt_pk_bf16(acc[2][2 * q], acc[2][2 * q + 1]); }
          LAS unsigned char* row = gb + ci * GP + 16 * cg;
          *(LAS v4u*)(row + G_Q) = wq; *(LAS v4u*)(row + G_K) = wk; *(LAS v4u*)(row + G_V) = wv;
#pragma unroll
          for (int j = 0; j < 8; ++j) *(LAS bf16*)(gb + G_KT + (8 * cg + j) * GP + 2 * ci) = (bf16)((j & 1) ? (wk[j >> 1] >> 16) : (wk[j >> 1] & 0xffffu)); }
        __syncthreads();
        { const int ti = (wave >> 1) & 1, tj = wave & 1, r32 = lane & 31, hi = lane >> 5; const bool isP = wave >= 4;
          f32x16 acc = {};
          const LAS unsigned char* ar = gb + (isP ? G_Q : G_K) + (32 * ti + r32) * GP + 16 * hi; const LAS unsigned char* br = gb + G_K + (32 * tj + r32) * GP + 16 * hi;
#pragma unroll
          for (int s = 0; s < 4; ++s) acc = __builtin_amdgcn_mfma_f32_32x32x16_bf16(*(const LAS bf16x8*)(ar + 32 * s), *(const LAS bf16x8*)(br + 32 * s), acc, 0, 0, 0);
          const int j = 32 * tj + r32; const float cj = sm[j];
#pragma unroll
          for (int r = 0; r < 16; ++r) { const int i = 32 * ti + (r & 3) + 8 * (r >> 2) + 4 * hi;
              const float dl = __expf(fminf(sm[i] - cj, 0.f));
              if (!isP) ((LAS float*)(gb + G_A))[i * 68 + j] = (i > j) ? sm[64 + i] * acc[r] * dl : 0.f;
              else *(LAS _Float16*)(gb + G_P + i * GP + 2 * j) = (_Float16)((i >= j) ? acc[r] * dl : 0.f); } }
        __syncthreads();
        f32x4 Xq[4];
#pragma unroll
        for (int g = 0; g < 4; ++g) Xq[g] = (f32x4){0.f, 0.f, 0.f, 0.f};
        if (!(SKIP & 2)) {
            const int cc = tid >> 2, p = tid & 3; const LAS unsigned char* src = gb + (cc < 64 ? G_V : G_K) + 2 * (cc & 63);
            float xm1 = 0.f, xm2 = 0.f, xm3 = 0.f;
#pragma unroll
            for (int i = 0; i < 64; ++i) {
                unsigned z = 0u; if (i >= 3) asm("v_and_b32 %0, 0, %1" : "=v"(z) : "v"(xm3));
                const LAS unsigned char* arow = gb + G_A + z + i * 272 + 16 * p;
                const float rhs = bf2f(*(const LAS bf16*)(src + i * GP)) * sm[64 + i] * (cc < 64 ? 1.f : sm[128 + i]);
                float a0 = 0.f, a1 = 0.f;
#pragma unroll
                for (int g = 0; g < (i + 3) / 4; g += 4) { const f32x4 av = *(const LAS f32x4*)(arow + 16 * g);
                    a0 += av.x * Xq[g >> 2][0] + av.z * Xq[g >> 2][2]; a1 += av.y * Xq[g >> 2][1] + av.w * Xq[g >> 2][3]; }
                float part = a0 + a1; part += dpp_xor1(part); part += dpp_xor2(part);
                const float xi = rhs - part;
                Xq[i >> 4][i & 3] = (p == ((i >> 2) & 3)) ? xi : Xq[i >> 4][i & 3];
                xm3 = xm2; xm2 = xm1; xm1 = xi;
            }
        }
        __syncthreads();
        { const int cc = tid >> 2, p = tid & 3;
          if (cc < 64) {
#pragma unroll
              for (int g = 0; g < 4; ++g)
#pragma unroll
                  for (int r = 0; r < 4; ++r) ((LAS float*)(gb + G_A))[(16 * g + 4 * p + r) * 68 + cc] = Xq[g][r];
          } else {
#pragma unroll
              for (int g = 0; g < 4; ++g)
#pragma unroll
                  for (int r = 0; r < 4; ++r) { const int i = 16 * g + 4 * p + r; const float x = -Xq[g][r]; const unsigned hb = f2bf(x);
                      *(LAS bf16*)(gb + G_V + i * GP + 2 * (cc - 64)) = (bf16)hb;
                      *(LAS bf16*)(gb + G_K + i * GP + 2 * (cc - 64)) = (bf16)f2bf(x - __uint_as_float(hb << 16)); }
          } }
        __syncthreads();
        if (wave < 4) { const int col = lane & 15, q4 = lane >> 4, e = 16 * wave + col;
          bf16x8 bS0, bS1, bS0l, bS1l; split_acc(Sacc[0], Sacc[1], bS0, bS0l); split_acc(Sacc[2], Sacc[3], bS1, bS1l);
          f32x4 U[4], T1[4];
          const LAS unsigned char* rowa = gb + col * GP + 8 * q4;
#pragma unroll
          for (int it = 0; it < 4; ++it) {
              const LAS float* u0p = (const LAS float*)(gb + G_A) + (16 * it + 4 * q4) * 68 + e;
              U[it] = (f32x4){u0p[0], u0p[68], u0p[136], u0p[204]};
              const LAS unsigned char* ra = rowa + 16 * it * GP;
              const bf16x8 wh0 = ld2x8(ra + G_V), wh1 = ld2x8(ra + G_V + 64), wl0 = ld2x8(ra + G_K), wl1 = ld2x8(ra + G_K + 64), qa0 = ld2x8(ra + G_Q), qa1 = ld2x8(ra + G_Q + 64);
              U[it] = __builtin_amdgcn_mfma_f32_16x16x32_bf16(wl0, bS0, U[it], 0, 0, 0);
              U[it] = __builtin_amdgcn_mfma_f32_16x16x32_bf16(wl1, bS1, U[it], 0, 0, 0);
              U[it] = __builtin_amdgcn_mfma_f32_16x16x32_bf16(wh0, bS0l, U[it], 0, 0, 0);
              U[it] = __builtin_amdgcn_mfma_f32_16x16x32_bf16(wh1, bS1l, U[it], 0, 0, 0);
              U[it] = __builtin_amdgcn_mfma_f32_16x16x32_bf16(wh0, bS0, U[it], 0, 0, 0);
              U[it] = __builtin_amdgcn_mfma_f32_16x16x32_bf16(wh1, bS1, U[it], 0, 0, 0);
              T1[it] = __builtin_amdgcn_mfma_f32_16x16x32_bf16(qa0, bS0l, (f32x4){0.f, 0.f, 0.f, 0.f}, 0, 0, 0);
              T1[it] = __builtin_amdgcn_mfma_f32_16x16x32_bf16(qa1, bS1l, T1[it], 0, 0, 0);
              T1[it] = __builtin_amdgcn_mfma_f32_16x16x32_bf16(qa0, bS0, T1[it], 0, 0, 0);
              T1[it] = __builtin_amdgcn_mfma_f32_16x16x32_bf16(qa1, bS1, T1[it], 0, 0, 0);
              asm volatile("" ::: "memory");
          }
          const f16x8 hU0 = pack_acc_f16(U[0], U[1]), hU1 = pack_acc_f16(U[2], U[3]);
          f32x4 Ud[4];
#pragma unroll
          for (int it = 0; it < 4; ++it) { const f32x4 dc = *(const LAS f32x4*)(sm + 192 + 16 * it + 4 * q4); Ud[it] = U[it] * dc; }
          bf16x8 bD0, bD1, bD0l, bD1l; split_acc(Ud[0], Ud[1], bD0, bD0l); split_acc(Ud[2], Ud[3], bD1, bD1l);
          const float gend = sm[191];
#pragma unroll
          for (int it = 0; it < 4; ++it) {
              const LAS unsigned char* ra = rowa + 16 * it * GP;
              const f32x4 gm = *(const LAS f32x4*)(sm + 128 + 16 * it + 4 * q4);
              const bf16x8 pa0 = ld2x8(ra + G_P), pa1 = ld2x8(ra + G_P + 64), ka0 = ld2x8(ra + G_KT), ka1 = ld2x8(ra + G_KT + 64);
              f32x4 O = T1[it] * gm;
              O = __builtin_amdgcn_mfma_f32_16x16x32_f16(__builtin_bit_cast(f16x8, pa0), hU0, O, 0, 0, 0);
              O = __builtin_amdgcn_mfma_f32_16x16x32_f16(__builtin_bit_cast(f16x8, pa1), hU1, O, 0, 0, 0);
              f32x4 Sn = Sacc[it] * gend;
              Sn = __builtin_amdgcn_mfma_f32_16x16x32_bf16(ka0, bD0l, Sn, 0, 0, 0);
              Sn = __builtin_amdgcn_mfma_f32_16x16x32_bf16(ka1, bD1l, Sn, 0, 0, 0);
              Sn = __builtin_amdgcn_mfma_f32_16x16x32_bf16(ka0, bD0, Sn, 0, 0, 0);
              Sn = __builtin_amdgcn_mfma_f32_16x16x32_bf16(ka1, bD1, Sn, 0, 0, 0);
              Sacc[it] = Sn;
#pragma unroll
              for (int r = 0; r < 4; ++r) ((LAS float*)(gb + G_A))[(16 * it + 4 * q4 + r) * 68 + e] = O[r];
              asm volatile("" ::: "memory");
          } }
        else if (c + 1 < SEQ / 64) GDN_RAW_STAGE(c + 1, tid - 256, 256);
        __syncthreads();
    }
    GDN_WRITEOUT(SEQ / 64 - 1);
#undef GDN_WRITEOUT
#undef GDN_RAW_STAGE
    __syncthreads();
}
__device__ __forceinline__ int next_unit(Frame& F, gu32* head) {
    __syncthreads();
    if (F.tid == 0) F.MISC[16] = __hip_atomic_fetch_add(head, 1u, RLX_AGENT);
    __syncthreads();
    return (int)F.MISC[16];
}
constexpr int U_GDN = 96, U_RWKV = 128, U_ATT = 384, U_ALL = U_GDN + U_RWKV + U_ATT;
__device__ __forceinline__ void p3_mixers(Frame& F, int l, int rep) {
    gu32* head = F.ctl + CW_QUEUE + 64 * (2 * l + rep);
    for (;;) {
        const int u = next_unit(F, head);
        if (u >= U_ALL) break;
        asm volatile("" : "+v"(F.tid), "+v"(F.lane));
        if (u < U_GDN) gdn_unit3<0>(F, l, u, F.ctl + CW_FLAG + 64 * 256 * (2 * l + rep) + 64 * 128);
        else if (u < U_GDN + U_RWKV) rwkv_unit(F, u - U_GDN, F.ctl + CW_FLAG + 64 * 256 * (2 * l + rep));
        else attn_unit(F, u - U_GDN - U_RWKV);
    }
}
__device__ __forceinline__ f32x4 bf4(u64_t x) { return (f32x4){__uint_as_float(((unsigned)x) << 16), __uint_as_float(((unsigned)x) & 0xffff0000u), __uint_as_float(((unsigned)(x >> 32)) << 16), __uint_as_float(((unsigned)(x >> 32)) & 0xffff0000u)}; }
__device__ __forceinline__ u64_t pk4(const f32x4& v) { return (u64_t)pg8::cvt_pk_bf16(v[0], v[1]) | ((u64_t)pg8::cvt_pk_bf16(v[2], v[3]) << 32); }
__device__ __forceinline__ void p2_mla_unit(Frame& F, int l, int unit) {
    const int lane = F.lane, col = lane & 15, q4 = lane >> 4, m = 16 * unit + col, b = m / SEQ, t = m % SEQ, t0 = (16 * unit) % SEQ;
    const bf16* prow = (const bf16*)(F.ws + WS_PMLA) + (size_t)m * 352;
    const bf16* WuqT = (const bf16*)(F.ws + WS_WSMALL + OFF_WUQ) + (size_t)l * 576 * 192 + (size_t)col * 192 + 8 * q4;
    const bf16* WukvT = (const bf16*)(F.ws + WS_WSMALL + OFF_WUKV) + (size_t)l * 768 * 128 + (size_t)col * 128 + 8 * q4;
    bf16x8 aq[6], akv[4]; float sq = 0.f, skv = 0.f;
#pragma unroll
    for (int s = 0; s < 6; ++s) { aq[s] = *(const bf16x8*)(prow + 32 * s + 8 * q4); const v4u u = __builtin_bit_cast(v4u, aq[s]);
#pragma unroll
        for (int i = 0; i < 4; ++i) { const float a = __uint_as_float(u[i] << 16), c = __uint_as_float(u[i] & 0xffff0000u); sq += a * a + c * c; } }
#pragma unroll
    for (int s = 0; s < 4; ++s) { akv[s] = *(const bf16x8*)(prow + 192 + 32 * s + 8 * q4); const v4u u = __builtin_bit_cast(v4u, akv[s]);
#pragma unroll
        for (int i = 0; i < 4; ++i) { const float a = __uint_as_float(u[i] << 16), c = __uint_as_float(u[i] & 0xffff0000u); skv += a * a + c * c; } }
    sq += __shfl_xor(sq, 16); sq += __shfl_xor(sq, 32); skv += __shfl_xor(skv, 16); skv += __shfl_xor(skv, 32);
    const float rq = rsqrtf(sq * (1.f / 192.f) + NORM_EPS) * (0.10206207261596575f * LOG2E), rkv = rsqrtf(skv * (1.f / 128.f) + NORM_EPS);
    const float pos = (float)((const int*)inptr(F, 1))[m];
    f32x4 cs, sn;
#pragma unroll
    for (int r = 0; r < 4; ++r) { const float inv = exp2f(-(float)(4 * q4 + r) * (13.287712379549449f / 16.f)); float s_, c_; sincosf(pos * inv, &s_, &c_); cs[r] = c_; sn[r] = s_; }
    bf16* Qo = (bf16*)(F.ws + WS_Q) + ((size_t)b * 6 * SEQ + t) * 96 + 4 * q4;
    bf16* Ko = (bf16*)(F.ws + WS_K) + ((size_t)b * 6 * SEQ + t) * 96 + 4 * q4;
    bf16* Vo = (bf16*)(F.ws + WS_VT) + (size_t)b * 6 * 64 * SEQ + (size_t)col * SEQ + t0 + 4 * q4;
    { const u64_t x1 = *(const u64_t*)(prow + 320 + 4 * q4), x2 = *(const u64_t*)(prow + 336 + 4 * q4); const f32x4 a = bf4(x1), c = bf4(x2);
      const u64_t o1 = pk4(a * cs - c * sn), o2 = pk4(c * cs + a * sn);
#pragma unroll
      for (int h = 0; h < 6; ++h) { *(u64_t*)(Ko + (size_t)h * SEQ * 96 + 64) = o1; *(u64_t*)(Ko + (size_t)h * SEQ * 96 + 80) = o2; } }
#pragma unroll 1
    for (int h = 0; h < 6; ++h) {
        f32x4 x1v = {0.f, 0.f, 0.f, 0.f};
#pragma unroll
        for (int nt = 0; nt < 6; ++nt) {
            const bf16* w = WuqT + (size_t)(h * 96 + 16 * nt) * 192; f32x4 acc = {0.f, 0.f, 0.f, 0.f};
#pragma unroll
            for (int s = 0; s < 6; ++s) acc = __builtin_amdgcn_mfma_f32_16x16x32_bf16(*(const bf16x8*)(w + 32 * s), aq[s], acc, 0, 0, 0);
            acc = acc * rq;
            if (nt < 4) *(u64_t*)(Qo + (size_t)h * SEQ * 96 + 16 * nt) = pk4(acc);
            else if (nt == 4) x1v = acc;
            else { *(u64_t*)(Qo + (size_t)h * SEQ * 96 + 64) = pk4(x1v * cs - acc * sn); *(u64_t*)(Qo + (size_t)h * SEQ * 96 + 80) = pk4(acc * cs + x1v * sn); }
        }
#pragma unroll
        for (int nt = 0; nt < 4; ++nt) {
            const bf16* w = WukvT + (size_t)(h * 128 + 16 * nt) * 128; f32x4 acc = {0.f, 0.f, 0.f, 0.f};
#pragma unroll
            for (int s = 0; s < 4; ++s) acc = __builtin_amdgcn_mfma_f32_16x16x32_bf16(*(const bf16x8*)(w + 32 * s), akv[s], acc, 0, 0, 0);
            *(u64_t*)(Ko + (size_t)h * SEQ * 96 + 16 * nt) = pk4(acc * rkv);
        }
        f32x4 rk4;
#pragma unroll
        for (int r = 0; r < 4; ++r) rk4[r] = __shfl(rkv, 4 * q4 + r);
#pragma unroll
        for (int nt = 0; nt < 4; ++nt) {
            const bf16* w = WukvT + (size_t)(h * 128 + 64 + 16 * nt) * 128; f32x4 acc = {0.f, 0.f, 0.f, 0.f};
#pragma unroll
            for (int s = 0; s < 4; ++s) acc = __builtin_amdgcn_mfma_f32_16x16x32_bf16(akv[s], *(const bf16x8*)(w + 32 * s), acc, 0, 0, 0);
            *(u64_t*)(Vo + (size_t)(h * 64 + 16 * nt) * SEQ) = pk4(acc * rk4);
        }
    }
}
__device__ __forceinline__ f32x4 rw_shift4(const bf16* P, size_t m, int c, bool hp, bool hn, const float* mu) {
    const f32x4 x = bf4(*(const u64_t*)(P + m * 896 + c)), xp = hp ? bf4(*(const u64_t*)(P + (m - 1) * 896 + c)) : (f32x4){0.f, 0.f, 0.f, 0.f}, xn = hn ? bf4(*(const u64_t*)(P + (m + 1) * 896 + c)) : (f32x4){0.f, 0.f, 0.f, 0.f};
    const f32x4 m0 = *(const f32x4*)(mu + c), m1 = *(const f32x4*)(mu + 896 + c);
    return x + m0 * (xp - x) + m1 * (xn - x);
}
__device__ __forceinline__ void p2_rwkv_unit(Frame& F, int l, int unit) {
    const int lane = F.lane, col = lane & 15, q4 = lane >> 4, b = (16 * unit) / SEQ, t = (16 * unit) % SEQ + col; const size_t m = (size_t)16 * unit + col;
    const bool hp = t > 0, hn = t < SEQ - 1;
    const bf16* Prw = (const bf16*)(F.ws + WS_PRW);
    const float* mu = (const float*)inptr(F, 12) + l * 2 * 896;
    const bf16* W2T = (const bf16*)(F.ws + WS_WSMALL + OFF_W2T) + (size_t)l * 2 * 256 * 64 + (size_t)col * 64 + 8 * q4;
    const bf16* A2T = (const bf16*)(F.ws + WS_WSMALL + OFF_A2T) + (size_t)l * 2 * 256 * 64 + (size_t)col * 64 + 8 * q4;
    bf16x8 awd[2], aad[2];
#pragma unroll
    for (int s = 0; s < 2; ++s) { const int c = 768 + 32 * s + 8 * q4;
        f32x4 lo = rw_shift4(Prw, m, c, hp, hn, mu), hi = rw_shift4(Prw, m, c + 4, hp, hn, mu);
#pragma unroll
        for (int i = 0; i < 4; ++i) { lo[i] = tanhf(lo[i]); hi[i] = tanhf(hi[i]); }
        awd[s] = pack_acc(lo, hi);
        aad[s] = pack_acc(rw_shift4(Prw, m, c + 64, hp, hn, mu), rw_shift4(Prw, m, c + 68, hp, hn, mu)); }
#pragma unroll 1
    for (int h = 0; h < 4; ++h) {
        f32x4 k[4]; float kn = 0.f;
        { const float* k_k = (const float*)inptr(F, 17) + l * 256;
#pragma unroll
          for (int nt = 0; nt < 4; ++nt) { const int c = 64 * h + 16 * nt + 4 * q4; k[nt] = rw_shift4(Prw, m, 256 + c, hp, hn, mu);
              const f32x4 x = k[nt] * *(const f32x4*)(k_k + c); kn += (x[0] * x[0] + x[1] * x[1]) + (x[2] * x[2] + x[3] * x[3]); } }
        kn += __shfl_xor(kn, 16); kn += __shfl_xor(kn, 32);
        const float rkn = rsqrtf(kn + 1e-6f);
        float br[2] = {0.f, 0.f}, kr[2] = {0.f, 0.f}, cbv = 0.f;
        unsigned char* rs = F.ws + WS_RS + (((size_t)b * 4 + h) * SEQ + t) * RS_REC + 8 * q4;
        unsigned char* rd0 = F.ws + WS_RD + (((size_t)b * 4 + h) * SEQ + t) * RD_REC + 8 * q4;
#pragma unroll 1
        for (int nt = 0; nt < 4; ++nt) { const int c = 64 * h + 16 * nt + 4 * q4;
            const f32x4 r = rw_shift4(Prw, m, c, hp, hn, mu), v = rw_shift4(Prw, m, 512 + c, hp, hn, mu);
            const f32x4 kk = k[nt] * *(const f32x4*)((const float*)inptr(F, 17) + l * 256 + c) * rkn;
            *(u64_t*)(rs + 32 * nt) = pk4(kk); *(u64_t*)(rs + 128 + 32 * nt) = pk4(v); *(u64_t*)(rs + 256 + 32 * nt) = pk4(r);
            f32x4 ksum = {0.f, 0.f, 0.f, 0.f};
#pragma unroll
            for (int e = 0; e < 2; ++e) { const bf16* w = W2T + (size_t)(e * 256 + 64 * h + 16 * nt) * 64; const bf16* a = A2T + (size_t)(e * 256 + 64 * h + 16 * nt) * 64;
                f32x4 x = {0.f, 0.f, 0.f, 0.f}, y = {0.f, 0.f, 0.f, 0.f};
#pragma unroll
                for (int s = 0; s < 2; ++s) { x = __builtin_amdgcn_mfma_f32_16x16x32_bf16(*(const bf16x8*)(w + 32 * s), awd[s], x, 0, 0, 0); y = __builtin_amdgcn_mfma_f32_16x16x32_bf16(*(const bf16x8*)(a + 32 * s), aad[s], y, 0, 0, 0); }
                const f32x4 w0v = *(const f32x4*)((const float*)inptr(F, 13) + l * 512 + e * 256 + c), a0v = *(const f32x4*)((const float*)inptr(F, 15) + l * 512 + e * 256 + c), kav = *(const f32x4*)((const float*)inptr(F, 18) + l * 256 + c);
                f32x4 lam, av;
#pragma unroll
                for (int i = 0; i < 4; ++i) { lam[i] = __expf(-softplusf_(-(w0v[i] + x[i])) - 0.5f); av[i] = sigmoidf_(a0v[i] + y[i]); }
                const f32x4 km = k[nt] * (1.f + (av - 1.f) * kav), bb = av * kk;
                ksum += km;
                br[e] += (bb[0] * r[0] + bb[1] * r[1]) + (bb[2] * r[2] + bb[3] * r[3]); kr[e] += (km[0] * r[0] + km[1] * r[1]) + (km[2] * r[2] + km[3] * r[3]);
                typedef _Float16 h4 __attribute__((ext_vector_type(4)));
                const h4 lh = {(_Float16)lam[0], (_Float16)lam[1], (_Float16)lam[2], (_Float16)lam[3]};
                unsigned char* rd = rd0 + e * RD_DIR;
                *(u64_t*)(rd + 32 * nt) = __builtin_bit_cast(u64_t, lh); *(u64_t*)(rd + 128 + 32 * nt) = pk4(bb); *(u64_t*)(rd + 256 + 32 * nt) = pk4(km); }
            const f32x4 rkv = *(const f32x4*)((const float*)inptr(F, 19) + l * 256 + c), xx = r * ksum * rkv; cbv += (xx[0] + xx[1]) + (xx[2] + xx[3]);
        }
#pragma unroll
        for (int e = 0; e < 2; ++e) { float x = br[e], y = kr[e]; x += __shfl_xor(x, 16); x += __shfl_xor(x, 32); y += __shfl_xor(y, 16); y += __shfl_xor(y, 32);
            if (q4 == 0) { typedef float f2 __attribute__((ext_vector_type(2))); *(f2*)(rd0 + e * RD_DIR + 384) = (f2){x, y}; } }
        cbv += __shfl_xor(cbv, 16); cbv += __shfl_xor(cbv, 32);
        if (q4 == 0) ((float*)(F.ws + WS_CB))[m * 4 + h] = 0.5f * cbv;
    }
}
__device__ __forceinline__ void p2_prep2(Frame& F, int l) {
    const int gw = F.vcu * NWAVES + F.wave, NGW = F.G * NWAVES;
    for (int u = gw; u < 2 * (M / 16); u += NGW) { if (u & 1) p2_rwkv_unit(F, l, u >> 1); else p2_mla_unit(F, l, u >> 1); }
}
typedef unsigned u32x4 __attribute__((ext_vector_type(4)));
__device__ __forceinline__ float dot_bf16(const bf16* a, const bf16* b, int K) {
    float acc = 0.f;
    for (int k = 0; k < K; k += 8) {
        const u32x4 av = *(const u32x4*)(a + k), bv = *(const u32x4*)(b + k);
#pragma unroll
        for (int i = 0; i < 4; ++i) {
            acc += __uint_as_float(av[i] << 16) * __uint_as_float(bv[i] << 16);
            acc += __uint_as_float(av[i] & 0xffff0000u) * __uint_as_float(bv[i] & 0xffff0000u);
        }
    }
    return acc;
}
__global__ void __launch_bounds__(64) nk_mla_prep(const bf16* Pmla, const bf16* WuqT, const bf16* WukvT, const int* positions, bf16* Q, bf16* Kb, bf16* Vt) {
    __shared__ float raw[576 + 768];
    __shared__ float rs[2];
    const int m = blockIdx.x, lane = threadIdx.x, b = m / SEQ, t = m % SEQ;
    const bf16* p = Pmla + (size_t)m * 352;
    float s1 = 0.f, s2 = 0.f;
    for (int c = lane; c < 192; c += 64) { const float v = bf2f(p[c]); s1 += v * v; }
    for (int c = lane; c < 128; c += 64) { const float v = bf2f(p[192 + c]); s2 += v * v; }
    s1 = wave_sum(s1); s2 = wave_sum(s2);
    const float rq = rsqrtf(s1 * (1.f / 192.f) + NORM_EPS), rkv = rsqrtf(s2 * (1.f / 128.f) + NORM_EPS);
    for (int c = lane; c < 576; c += 64) raw[c] = dot_bf16(p, WuqT + (size_t)c * 192, 192) * rq;
    for (int c = lane; c < 768; c += 64) raw[576 + c] = dot_bf16(p + 192, WukvT + (size_t)c * 128, 128) * rkv;
    __syncthreads();
    const float pos = (float)positions[m];
    const float qs = 0.10206207261596575f * LOG2E;
    for (int i = lane; i < 6 * 80; i += 64) {
        const int h = i / 80, j = i % 80;
        bf16* qo = Q + (((size_t)b * 6 + h) * SEQ + t) * 96;
        if (j < 64) qo[j] = f2bf(raw[h * 96 + j] * qs);
        else { const int r = j - 64; const float inv = exp2f(-(float)r * (13.287712379549449f / 16.f)); float sn, cs; sincosf(pos * inv, &sn, &cs);
            const float x1 = raw[h * 96 + 64 + r], x2 = raw[h * 96 + 80 + r];
            qo[64 + r] = f2bf((x1 * cs - x2 * sn) * qs); qo[80 + r] = f2bf((x2 * cs + x1 * sn) * qs); }
    }
    for (int i = lane; i < 6 * 64; i += 64) {
        const int h = i / 64, j = i % 64;
        Kb[(((size_t)b * 6 + h) * SEQ + t) * 96 + j] = f2bf(raw[576 + h * 128 + j]);
        Vt[(((size_t)b * 6 + h) * 64 + j) * SEQ + t] = f2bf(raw[576 + h * 128 + 64 + j]);
    }
    if (lane < 16) {
        const int r = lane; const float inv = exp2f(-(float)r * (13.287712379549449f / 16.f)); float sn, cs; sincosf(pos * inv, &sn, &cs);
        const float x1 = bf2f(p[320 + r]), x2 = bf2f(p[336 + r]);
        const bf16 o1 = f2bf(x1 * cs - x2 * sn), o2 = f2bf(x2 * cs + x1 * sn);
        for (int h = 0; h < 6; ++h) { bf16* ko = Kb + (((size_t)b * 6 + h) * SEQ + t) * 96; ko[64 + r] = o1; ko[80 + r] = o2; }
    }
}
__global__ void __launch_bounds__(256) nk_rwkv_prep(const bf16* Prw, const float* mu, const float* w0, const float* w2, const float* a0, const float* a2,
                             const float* k_k, const float* k_a, const float* r_k, unsigned char* Rs, unsigned char* Rd, float* cb) {
    __shared__ float f[896];
    const int m = blockIdx.x, c = threadIdx.x, b = m / SEQ, t = m % SEQ, h = c >> 6, j = c & 63;
    for (int i = c; i < 896; i += 256) {
        const float x = bf2f(Prw[(size_t)m * 896 + i]);
        const float xp = t > 0 ? bf2f(Prw[(size_t)(m - 1) * 896 + i]) : 0.f;
        const float xn = t < SEQ - 1 ? bf2f(Prw[(size_t)(m + 1) * 896 + i]) : 0.f;
        float v = x + mu[i] * (xp - x) + mu[896 + i] * (xn - x);
        if (i >= 768 && i < 832) v = tanhf(v);
        f[i] = v;
    }
    __syncthreads();
    const float r = f[c], k = f[256 + c], v = f[512 + c];
    const float kkr = k * k_k[c];
    const float kn = wave_sum(kkr * kkr);
    const float kk = kkr * rsqrtf(kn + 1e-6f);
    float kmod[2], bb[2], lam[2];
#pragma unroll
    for (int e = 0; e < 2; ++e) {
        float lw = 0.f, la = 0.f;
        for (int d = 0; d < 64; ++d) { lw += f[768 + d] * w2[((size_t)e * 64 + d) * 256 + c]; la += f[832 + d] * a2[((size_t)e * 64 + d) * 256 + c]; }
        const float wl = -softplusf_(-(w0[e * 256 + c] + lw)) - 0.5f;
        lam[e] = __expf(wl);
        const float a = sigmoidf_(a0[e * 256 + c] + la);
        kmod[e] = k * (1.f + (a - 1.f) * k_a[c]);
        bb[e] = a * kk;
    }
    unsigned char* rs = Rs + (((size_t)b * 4 + h) * SEQ + t) * RS_REC;
    ((bf16*)rs)[j] = f2bf(kk); ((bf16*)(rs + 128))[j] = f2bf(v); ((bf16*)(rs + 256))[j] = f2bf(r);
#pragma unroll
    for (int e = 0; e < 2; ++e) {
        unsigned char* rd = Rd + e * RD_DIR + (((size_t)b * 4 + h) * SEQ + t) * RD_REC;
        ((__half*)rd)[j] = __float2half(lam[e]); ((bf16*)(rd + 128))[j] = f2bf(bb[e]); ((bf16*)(rd + 256))[j] = f2bf(kmod[e]);
        const float br = wave_sum(bb[e] * r), kr = wave_sum(kmod[e] * r);
        if (j == 0) { ((float*)(rd + 384))[0] = br; ((float*)(rd + 384))[1] = kr; }
    }
    const float cbv = wave_sum(r * 0.5f * (kmod[0] + kmod[1]) * r_k[c]);
    if (j == 0) cb[(size_t)m * 4 + h] = cbv;
}
__global__ void __launch_bounds__(128) nk_attn(const bf16* Q, const bf16* Kb, const bf16* Vt, bf16* Omla) {
    const int bh = blockIdx.y, q = blockIdx.x * 128 + threadIdx.x, b = bh / 6, h = bh % 6;
    const bf16* qp = Q + ((size_t)bh * SEQ + q) * 96;
    float qr[96];
#pragma unroll
    for (int i = 0; i < 96; ++i) qr[i] = bf2f(qp[i]);
    float acc[64];
#pragma unroll
    for (int i = 0; i < 64; ++i) acc[i] = 0.f;
    float mx = -1e30f, l = 0.f;
    const bf16* kb = Kb + (size_t)bh * SEQ * 96; const bf16* vt = Vt + (size_t)bh * 64 * SEQ;
    for (int k0 = 0; k0 < SEQ; k0 += 8) {
        float s[8];
#pragma unroll
        for (int kk = 0; kk < 8; ++kk) {
            const bf16* kr = kb + (size_t)(k0 + kk) * 96; float a = 0.f;
#pragma unroll
            for (int d = 0; d < 96; d += 8) { const u32x4 kv = *(const u32x4*)(kr + d);
#pragma unroll
                for (int i = 0; i < 4; ++i) { a += qr[d + 2 * i] * __uint_as_float(kv[i] << 16); a += qr[d + 2 * i + 1] * __uint_as_float(kv[i] & 0xffff0000u); } }
            s[kk] = a;
        }
        float cm = s[0];
#pragma unroll
        for (int kk = 1; kk < 8; ++kk) cm = fmaxf(cm, s[kk]);
        const float mn = fmaxf(mx, cm), sc = exp2f(mx - mn);
        l *= sc;
#pragma unroll
        for (int i = 0; i < 64; ++i) acc[i] *= sc;
        mx = mn;
#pragma unroll
        for (int kk = 0; kk < 8; ++kk) { s[kk] = exp2f(s[kk] - mn); l += s[kk]; }
#pragma unroll
        for (int d = 0; d < 64; ++d) { const u32x4 vv = *(const u32x4*)(vt + (size_t)d * SEQ + k0);
#pragma unroll
            for (int i = 0; i < 4; ++i) { acc[d] += s[2 * i] * __uint_as_float(vv[i] << 16); acc[d] += s[2 * i + 1] * __uint_as_float(vv[i] & 0xffff0000u); } }
    }
    const float il = 1.f / l;
    bf16* o = Omla + ((size_t)b * SEQ + q) * 384 + h * 64;
#pragma unroll
    for (int i = 0; i < 64; ++i) o[i] = f2bf(acc[i] * il);
}
__global__ void __launch_bounds__(64) nk_gdn(const bf16* Pgdn, const float* Psm, const float* conv_w, const float* a_log, const float* dt_bias, bf16* Ogdn, int dir) {
    __shared__ float qs[64], ks[64];
    const int bh = blockIdx.x, b = bh / 6, h = bh % 6, e = threadIdx.x;
    float S[64];
#pragma unroll
    for (int i = 0; i < 64; ++i) S[i] = 0.f;
    float cw[3][5];
#pragma unroll
    for (int i = 0; i < 5; ++i) { cw[0][i] = conv_w[i * 1152 + h * 64 + e]; cw[1][i] = conv_w[i * 1152 + 384 + h * 64 + e]; cw[2][i] = conv_w[i * 1152 + 768 + h * 64 + e]; }
    const float al = -__expf(a_log[dir * 6 + h]), dtb = dt_bias[dir * 6 + h];
    for (int n = 0; n < SEQ; ++n) {
        const int t = dir ? SEQ - 1 - n : n; const size_t m = (size_t)b * SEQ + t;
        float cq = 0.f, ck = 0.f, cv = 0.f;
#pragma unroll
        for (int i = 0; i < 5; ++i) { const int tt = t + i - 2; if (tt >= 0 && tt < SEQ) { const bf16* pr = Pgdn + ((size_t)b * SEQ + tt) * 1152 + h * 64 + e;
                cq += cw[0][i] * bf2f(pr[0]); ck += cw[1][i] * bf2f(pr[384]); cv += cw[2][i] * bf2f(pr[768]); } }
        cq = siluf(cq); ck = siluf(ck); cv = siluf(cv);
        const float qn = cq * rsqrtf(wave_sum(cq * cq) + 1e-6f) * 0.125f, kn = ck * rsqrtf(wave_sum(ck * ck) + 1e-6f);
        __syncthreads();
        qs[e] = qn; ks[e] = kn;
        __syncthreads();
        const float g = al * softplusf_(Psm[m * 32 + dir * 6 + h] + dtb), beta = sigmoidf_(Psm[m * 32 + 12 + dir * 6 + h]), alpha = __expf(g);
        float kS = 0.f;
#pragma unroll
        for (int d = 0; d < 64; ++d) kS += ks[d] * S[d];
        const float coef = beta * (cv - alpha * kS);
        float o = 0.f;
#pragma unroll
        for (int d = 0; d < 64; ++d) { S[d] = alpha * S[d] + coef * ks[d]; o += qs[d] * S[d]; }
        bf16* op = Ogdn + m * 384 + h * 64 + e;
        if (dir) o += bf2f(*op);
        *op = f2bf(o);
    }
}
__global__ void __launch_bounds__(64) nk_rwkv(const unsigned char* Rs, const unsigned char* Rd, bf16* Y, int dir) {
    const int bh = blockIdx.x, b = bh / 4, h = bh % 4, i = threadIdx.x;
    float S[64];
#pragma unroll
    for (int j = 0; j < 64; ++j) S[j] = 0.f;
    for (int n = 0; n < SEQ; ++n) {
        const int t = dir ? SEQ - 1 - n : n;
        const unsigned char* rs = Rs + ((size_t)bh * SEQ + t) * RS_REC;
        const unsigned char* rd = Rd + dir * RD_DIR + ((size_t)bh * SEQ + t) * RD_REC;
        const float v = bf2f(((const bf16*)(rs + 128))[i]);
        float sa = 0.f;
#pragma unroll
        for (int j = 0; j < 64; ++j) sa -= S[j] * bf2f(((const bf16*)rs)[j]);
        float y = 0.f;
#pragma unroll
        for (int j = 0; j < 64; ++j) {
            const float w = __expf(-__half2float(((const __half*)rd)[j]));
            S[j] = S[j] * w + sa * bf2f(((const bf16*)(rd + 128))[j]) + v * bf2f(((const bf16*)(rd + 256))[j]);
            y += S[j] * bf2f(((const bf16*)(rs + 256))[j]);
        }
        bf16* op = Y + ((size_t)b * SEQ + t) * 256 + h * 64 + i;
        if (dir) y += bf2f(*op);
        *op = f2bf(y);
    }
}
__global__ void __launch_bounds__(1024) nk_mix(const bf16* Ogdn, const bf16* Omla, const bf16* Y, const bf16* Pgate, const unsigned char* Rs, const float* cb,
                       const float* gdn_g, const float* ln_g, const float* ln_b, bf16* mix) {
    const int m = blockIdx.x, c = threadIdx.x, b = m / SEQ, t = m % SEQ;
    float val;
    if (c < 384) { const float o = bf2f(Ogdn[(size_t)m * 384 + c]); const float ss = wave_sum(o * o); val = o * rsqrtf(ss * (1.f / 64.f) + NORM_EPS) * gdn_g[c & 63]; }
    else if (c < 768) val = bf2f(Omla[(size_t)m * 384 + (c - 384)]);
    else { const int cc = c - 768, h = cc >> 6, j = cc & 63; const float y = bf2f(Y[(size_t)m * 256 + cc]);
        const float mean = wave_sum(y) * (1.f / 64.f); const float dv = y - mean; const float var = wave_sum(dv * dv) * (1.f / 64.f);
        const float v = bf2f(((const bf16*)(Rs + (((size_t)b * 4 + h) * SEQ + t) * RS_REC + 128))[j]);
        val = dv * rsqrtf(var + 64e-5f) * ln_g[cc] + ln_b[cc] + cb[(size_t)m * 4 + h] * v; }
    mix[(size_t)m * 1024 + c] = f2bf(val * siluf(bf2f(Pgate[(size_t)m * 1024 + c])));
}
#ifndef MK_SINGLE
#define MK_SINGLE 1
#endif
#ifndef MK_REPU
#define MK_REPU 0
#endif
#ifndef MK_SKIP
#define MK_SKIP 0
#endif
#ifndef MK_REP2
#define MK_REP2 0
#endif
#ifndef MK_REP3
#define MK_REP3 0
#endif
#ifndef MK_P2
#define MK_P2 1
#endif
#ifndef MK_P3
#define MK_P3 1
#endif
#ifndef MK_P4A
#define MK_P4A 1
#endif
constexpr int PT_OUT = 24, PT_WS = 25, PT_N = 26;
__device__ __forceinline__ void build_frame(Frame& F, LAS unsigned char* lds) {
    F.lds = lds; F.MISC = (volatile LAS unsigned*)(lds + MISC_OFF); F.ptab = (volatile LAS const unsigned long long*)(lds + MISC_OFF + 256);
    const int t = pg8::mk_tid(lds);
    F.tid = t; F.lane = t & 63; F.wave = __builtin_amdgcn_readfirstlane(t >> 6);
    F.G = gridDim.x; { const int bx = blockIdx.x; F.vcu = (F.G % 8 == 0) ? (bx % 8) * (F.G / 8) + bx / 8 : bx; }
    F.ws = (unsigned char*)inptr(F, PT_WS); F.out = (float*)inptr(F, PT_OUT); F.ctl = (gu32*)F.ws;
}
__device__ __forceinline__ bool ph_in(LAS unsigned char* lds, int k) { volatile LAS unsigned* mi = (volatile LAS unsigned*)(lds + MISC_OFF); const int lo = __builtin_amdgcn_readfirstlane((int)mi[20]), hi = __builtin_amdgcn_readfirstlane((int)mi[21]); return lo <= k && k < hi; }
__device__ __forceinline__ void seam(LAS unsigned char* lds, int k) {
    if (ph_in(lds, k) && ph_in(lds, k + 1)) { Frame F; build_frame(F, lds);
        XcdBarrier bar; bar.bar = (unsigned*)(F.ctl + CW_BAR); bar.x = xb_xcc_id(); bar.st = F.MISC + 8; xcd_barrier(bar); }
}
template <int L> __device__ __forceinline__ void layer_phases(LAS unsigned char* lds) {
    constexpr int pb = 1 + 5 * L;
    if (ph_in(lds, pb)) { Frame F; build_frame(F, lds);
        pg8::Gemm g{(const pg8::bf16_t*)(F.ws + WS_XB), (const pg8::bf16_t*)(F.ws + WS_WIN) + (size_t)L * NP * D, M, NP, D};
        pg8::StaticOrder S; S.init(M, NP, F.G, (int)blockIdx.x);
        pg8::EpiRoute E{F.ws};
        pg8::gemm_phase<pg8::EpiRoute, pg8::StaticOrder, true, true>(F.lds + RING_OFF, g, S, E); }
    seam(lds, pb);
    if (ph_in(lds, pb + 1)) { Frame F; build_frame(F, lds); p2_prep2(F, L); }
#if MK_REP2
    seam(lds, pb);
    if (ph_in(lds, pb + 1)) { Frame F; build_frame(F, lds); p2_prep2(F, L); }
#endif
    seam(lds, pb + 1);
#if MK_REPU
    if (ph_in(lds, pb + 2)) { Frame F; build_frame(F, lds); gu32* head = F.ctl + CW_QUEUE + 64 * (2 * L + 1);
        const int n = (MK_REPU == 1) ? U_GDN : (MK_REPU == 2) ? U_RWKV : U_ATT;
        for (;;) { const int u = next_unit(F, head); if (u >= n) break; if (MK_REPU == 1) gdn_unit3<MK_SKIP>(F, L, u, F.ctl + CW_FLAG + 64 * 256 * (2 * L + 1) + 64 * 128); else if (MK_REPU == 2) rwkv_unit(F, u, F.ctl + CW_FLAG + 64 * 256 * (2 * L + 1)); else attn_unit(F, u); } }
    seam(lds, pb + 1);
#endif
    if (ph_in(lds, pb + 2)) { Frame F; build_frame(F, lds); p3_mixers(F, L, 0); }
#if MK_REP3
    seam(lds, pb + 1);
    if (ph_in(lds, pb + 2)) { Frame F; build_frame(F, lds); p3_mixers(F, L, 1); }
#endif
    seam(lds, pb + 2);
    if (ph_in(lds, pb + 3)) { Frame F; build_frame(F, lds); p4a_mix(F, L); }
    seam(lds, pb + 3);
    if (ph_in(lds, pb + 4)) { Frame F; build_frame(F, lds);
        pg8::Gemm g{(const pg8::bf16_t*)(F.ws + WS_MIX), (const pg8::bf16_t*)(F.ws + WS_WOUT) + (size_t)L * D * D, M, D, D};
        pg8::StaticOrder S; S.init(M, D, F.G, (int)blockIdx.x);
        pg8::EpiOut E{L == 0 ? (const float*)inptr(F, 0) : (const float*)F.out, F.out, F.ws};
        pg8::gemm_phase<pg8::EpiOut, pg8::StaticOrder, true, true>(F.lds + RING_OFF, g, S, E); }
    seam(lds, pb + 4);
}
__global__ void __launch_bounds__(NWAVES * 64, 2) mk_fwd(Args args) {
    extern __shared__ __attribute__((aligned(16))) unsigned char lds_raw[];
    LAS unsigned char* lds = (LAS unsigned char*)lds_raw;
    for (int u = threadIdx.x; u < (LDS_BYTES - LDSCTL_OFF) / 4; u += NWAVES * 64) ((LAS unsigned*)(lds + LDSCTL_OFF))[u] = 0u;
    __syncthreads();
    if (threadIdx.x == 0) { LAS unsigned long long* pt = (LAS unsigned long long*)(lds + MISC_OFF + 256);
#define PT(k) pt[k] = (unsigned long long)args.in[k]
        PT(0); PT(1); PT(2); PT(3); PT(4); PT(5); PT(6); PT(7); PT(8); PT(9); PT(10); PT(11); PT(12); PT(13); PT(14); PT(15); PT(16); PT(17); PT(18); PT(19); PT(20); PT(21); PT(22); PT(23);
#undef PT
        pt[PT_OUT] = (unsigned long long)args.out; pt[PT_WS] = (unsigned long long)args.ws;
        volatile LAS unsigned* mi = (volatile LAS unsigned*)(lds + MISC_OFF); mi[20] = (unsigned)args.ph_lo; mi[21] = (unsigned)args.ph_hi;
        if (args.ph_hi - args.ph_lo > 1) (void)xcd_barrier_post((unsigned*)((gu32*)args.ws + CW_BAR), mi + 8);
    }
    if ((threadIdx.x & 63) == 0) ((volatile LAS unsigned*)(lds + pg8::TIDTAB_OFF))[pg8::hw_slot()] = threadIdx.x >> 6;
    __syncthreads();
    if (ph_in(lds, 0)) { Frame F; build_frame(F, lds); p0_prologue(F); }
    seam(lds, 0);
    layer_phases<0>(lds);
    layer_phases<1>(lds);
    if (ph_in(lds, 11)) { Frame F; build_frame(F, lds); p5_final(F); }
}

static void launch_phases(hipStream_t stream, int grid, Args a, int lo, int hi) {
    a.ph_lo = lo; a.ph_hi = hi;
    hipLaunchKernelGGL(mk_fwd, dim3(grid), dim3(NWAVES * 64), LDS_BYTES, stream, a);
}
extern "C" void kernel_launch(void* const* d_in, const int* in_sizes, int n_in, void* d_out, int out_size, void* d_ws, size_t ws_size, hipStream_t stream) {
    static int grid = 0;
    if (grid == 0) {
        if (n_in != 24 || ws_size < WS_END || out_size != M * D) { fprintf(stderr, "kernel_launch: unexpected inputs (%d), out (%d) or workspace (%zu)\n", n_in, out_size, ws_size); grid = -1; return; }
        int dev = 0, cus = 0;
        if (hipGetDevice(&dev) != hipSuccess || hipDeviceGetAttribute(&cus, hipDeviceAttributeMultiprocessorCount, dev) != hipSuccess) { grid = -1; return; }
        if (hipFuncSetAttribute((const void*)mk_fwd, hipFuncAttributeMaxDynamicSharedMemorySize, LDS_BYTES) != hipSuccess) { fprintf(stderr, "kernel_launch: hipFuncSetAttribute failed\n"); grid = -1; return; }
        (void)hipGetLastError();
        grid = cus;
    }
    if (grid < 0) return;
    unsigned char* ws = (unsigned char*)d_ws;
    hipMemsetAsync(ws + WS_CTL, 0, CTL_ZERO_BYTES, stream);
    Args a{};
    for (int i = 0; i < 24; ++i) a.in[i] = d_in[i];
    a.out = (float*)d_out; a.ws = ws;

    const int* positions = (const int*)d_in[1];
    const float* gdn_conv = (const float*)d_in[4]; const float* gdn_a_log = (const float*)d_in[5]; const float* gdn_dt_bias = (const float*)d_in[6]; const float* gdn_norm_g = (const float*)d_in[7];
    const float* mu = (const float*)d_in[12]; const float* w0 = (const float*)d_in[13]; const float* w2 = (const float*)d_in[14]; const float* a0 = (const float*)d_in[15];
    const float* a2 = (const float*)d_in[16]; const float* k_k = (const float*)d_in[17]; const float* k_a = (const float*)d_in[18]; const float* r_k = (const float*)d_in[19];
    const float* ln_g = (const float*)d_in[20]; const float* ln_b = (const float*)d_in[21];
    bf16* WuqT = (bf16*)(ws + WS_WSMALL + OFF_WUQ); bf16* WukvT = (bf16*)(ws + WS_WSMALL + OFF_WUKV);
    float* Psm = (float*)(ws + WS_PSM); float* cb = (float*)(ws + WS_CB);
    bf16* Pgate = (bf16*)(ws + WS_PGATE); bf16* Pgdn = (bf16*)(ws + WS_PGDN); bf16* Pmla = (bf16*)(ws + WS_PMLA); bf16* Prw = (bf16*)(ws + WS_PRW);
    bf16* Ogdn = (bf16*)(ws + WS_OGDN); bf16* Omla = (bf16*)(ws + WS_OMLA); bf16* Y = (bf16*)(ws + WS_Y);
    unsigned char* Rs = ws + WS_RS; unsigned char* Rd = ws + WS_RD;
    bf16* Q = (bf16*)(ws + WS_Q); bf16* Kb = (bf16*)(ws + WS_K); bf16* Vt = (bf16*)(ws + WS_VT); bf16* mix = (bf16*)(ws + WS_MIX);

#if MK_SINGLE
    launch_phases(stream, grid, a, 0, NPHASE);
    return;
#endif
    launch_phases(stream, grid, a, 0, 1);
    for (int l = 0; l < 2; ++l) {
        launch_phases(stream, grid, a, 1 + 5 * l, 2 + 5 * l);
#if MK_P2
        launch_phases(stream, grid, a, 2 + 5 * l, 3 + 5 * l);
#else
        hipLaunchKernelGGL(nk_mla_prep, dim3(M), dim3(64), 0, stream, Pmla, WuqT + (size_t)l * 576 * 192, WukvT + (size_t)l * 768 * 128, positions, Q, Kb, Vt);
        hipLaunchKernelGGL(nk_rwkv_prep, dim3(M), dim3(256), 0, stream, Prw, mu + l * 2 * 896, w0 + l * 512, w2 + (size_t)l * 2 * 64 * 256, a0 + l * 512, a2 + (size_t)l * 2 * 64 * 256,
                           k_k + l * 256, k_a + l * 256, r_k + l * 256, Rs, Rd, cb);
#endif
#if MK_P3
        launch_phases(stream, grid, a, 3 + 5 * l, 4 + 5 * l);
#else
        hipLaunchKernelGGL(nk_attn, dim3(SEQ / 128, BATCH * 6), dim3(128), 0, stream, Q, Kb, Vt, Omla);
        for (int dir = 0; dir < 2; ++dir) {
            hipLaunchKernelGGL(nk_gdn, dim3(BATCH * 6), dim3(64), 0, stream, Pgdn, Psm, gdn_conv + (size_t)l * 5 * 1152, gdn_a_log + l * 12, gdn_dt_bias + l * 12, Ogdn, dir);
            hipLaunchKernelGGL(nk_rwkv, dim3(BATCH * 4), dim3(64), 0, stream, Rs, Rd, Y, dir);
        }
#endif
#if MK_P4A
        launch_phases(stream, grid, a, 4 + 5 * l, 5 + 5 * l);
#else
        hipLaunchKernelGGL(nk_mix, dim3(M), dim3(1024), 0, stream, Ogdn, Omla, Y, Pgate, Rs, cb, gdn_norm_g + l * 64, ln_g + l * 256, ln_b + l * 256, mix);
#endif
        launch_phases(stream, grid, a, 5 + 5 * l, 6 + 5 * l);
    }
    launch_phases(stream, grid, a, 11, 12);
}
```

```cpp
#include <hip/hip_runtime.h>
#include <cstdio>
#include <cstdint>
#include <hip/hip_fp16.h>
namespace pg8 {
#define PG8_LAS __attribute__((address_space(3)))
typedef unsigned short bf16_t;
typedef short bf16x8 __attribute__((ext_vector_type(8)));
typedef float f32x4 __attribute__((ext_vector_type(4)));
typedef unsigned u32x4 __attribute__((ext_vector_type(4)));
constexpr int BM = 256, BK = 64, HALF = 128, HTB = HALF * BK * 2  , STAGE_BYTES = 8 * HTB, NXCD = 8, WGM = 8;

__host__ __device__ __forceinline__ int lds_byte(int r, int c) { const int st = (r >> 4) * 2 + (c >> 5), rr = r & 15, cc = c & 31, ob = rr * 64 + cc * 2; return st * 1024 + (ob ^ (((ob >> 9) & 1) << 5)); }
__host__ __device__ __forceinline__ void stage_rc(int b, int& R, int& C) { const int st = b / 1024, sb = b % 1024, swz = sb ^ (((sb >> 9) & 1) << 5); R = (st >> 1) * 16 + swz / 64; C = (st & 1) * 32 + (swz % 64) / 2; }
__host__ __device__ __forceinline__ int perm32(int rho) { const int n = rho >> 4, i = rho & 15; return 8 * (i >> 2) + 4 * n + (i & 3); }

struct Unit { int pm, pn; };
struct Gemm { const bf16_t* A; const bf16_t* Bt; int M, N, K; };

struct StaticOrder {
    int nM, nN, nwg, G, c;
    __host__ __device__ void init(int M, int N, int G_, int c_) { nM = M / BM; nN = N / BM; nwg = nM * nN; G = G_; c = c_; }
    __host__ __device__ bool next(int i, Unit& u) const {
        const long L = (long)i * G + c; if (L >= nwg) return false;
        int wgid = (int)L; { const int q = nwg / NXCD, r = nwg % NXCD, xcd = wgid % NXCD, off = wgid / NXCD; wgid = (xcd < r ? xcd * (q + 1) : r * (q + 1) + (xcd - r) * q) + off; }
        const int nig = WGM * nN, gid = wgid / nig, fm = gid * WGM, gsz = (nM - fm) < WGM ? (nM - fm) : WGM;
        u.pm = fm + ((wgid % nig) % gsz); u.pn = (wgid % nig) / gsz; return true;
    }
    __device__ __forceinline__ void a_ready(const Unit&) const {}
    __device__ __forceinline__ void done(const Unit&) const {}
};

__device__ __forceinline__ unsigned cvt_pk_bf16(float lo, float hi) { unsigned r; asm volatile("v_cvt_pk_bf16_f32 %0, %1, %2" : "=v"(r) : "v"(lo), "v"(hi)); return r; }
typedef float f32x2 __attribute__((ext_vector_type(2)));
constexpr int TIDTAB_OFF = 131072 + 320 + 512;
__device__ __forceinline__ unsigned hw_slot() { return (unsigned)__builtin_amdgcn_s_getreg((5 << 11) | 4) & 63u; }
__device__ __forceinline__ int mk_tid(PG8_LAS unsigned char* lds_base) {
    const unsigned lane = __builtin_amdgcn_mbcnt_hi(~0u, __builtin_amdgcn_mbcnt_lo(~0u, 0u));
    const unsigned w = __builtin_amdgcn_readfirstlane(((volatile PG8_LAS unsigned*)(lds_base + TIDTAB_OFF))[hw_slot()]);
    return (int)(w * 64u + lane);
}
struct EpiRoute {
    static constexpr bool PERM = true, AFTER_DRAIN = false;
    unsigned char* ws;
    __device__ __forceinline__ void operator()(const f32x4 (&acc)[2][2][4][2], const Unit& u, int wr, int wc, int fr, int fq) const {
        const int row0 = u.pm * BM + wr * 64 + fr;
        const float* rowss = (const float*)(ws + (1u << 20)); float* Psm = (float*)(ws + (22u << 20));
        unsigned base[2]; int ld[2], cc[2], kind[2];
#pragma unroll
        for (int bj = 0; bj < 2; ++bj) {
            const int cg = u.pn * BM + bj * HALF + wc * 32, col = cg + 8 * fq;
            if (cg < 1024) { base[bj] = 25u << 20; ld[bj] = 1024; cc[bj] = col; kind[bj] = 0; }
            else if (cg < 2176) { base[bj] = 57u << 20; ld[bj] = 1152; cc[bj] = col - 1024; kind[bj] = 0; }
            else if (cg < 2528) { base[bj] = 93u << 20; ld[bj] = 352; cc[bj] = col - 2176; kind[bj] = 0; }
            else if (cg < 3424) { base[bj] = 104u << 20; ld[bj] = 896; cc[bj] = col - 2528; kind[bj] = 0; }
            else if (cg < 3456) { base[bj] = 0u; ld[bj] = 32; cc[bj] = col - 3424; kind[bj] = 1; }
            else { base[bj] = 0u; ld[bj] = 0; cc[bj] = 0; kind[bj] = 2; }
        }
#pragma unroll
        for (int ai = 0; ai < 2; ++ai)
#pragma unroll
            for (int m = 0; m < 4; ++m) {
                const int row = row0 + ai * HALF + m * 16;
                const f32x4* rp = (const f32x4*)(rowss + (size_t)row * 16);
                const f32x4 s0 = rp[0], s1 = rp[1], s2 = rp[2], s3 = rp[3];
                const float ss = ((s0[0] + s0[1]) + (s0[2] + s0[3])) + ((s1[0] + s1[1]) + (s1[2] + s1[3])) + ((s2[0] + s2[1]) + (s2[2] + s2[3])) + ((s3[0] + s3[1]) + (s3[2] + s3[3]));
                const float rstd = __builtin_amdgcn_rsqf(ss * (1.0f / 1024.0f) + 1e-6f);
#pragma unroll
                for (int bj = 0; bj < 2; ++bj) {
                    const f32x4 v0 = acc[ai][bj][m][0] * rstd, v1 = acc[ai][bj][m][1] * rstd;
                    if (kind[bj] == 0) { u32x4 w; w.x = cvt_pk_bf16(v0[0], v0[1]); w.y = cvt_pk_bf16(v0[2], v0[3]); w.z = cvt_pk_bf16(v1[0], v1[1]); w.w = cvt_pk_bf16(v1[2], v1[3]);
                        *(u32x4*)((bf16_t*)(ws + base[bj]) + (size_t)row * ld[bj] + cc[bj]) = w; }
                    else if (kind[bj] == 1) { float* p = Psm + (size_t)row * 32 + cc[bj]; *(f32x4*)p = v0; *(f32x4*)(p + 4) = v1; }
                }
                asm volatile("" ::: "memory");
            }
    }
};
struct EpiOut {
    static constexpr bool PERM = false, AFTER_DRAIN = false;
    const float* xin; float* xout; unsigned char* ws;
    __device__ __forceinline__ void operator()(const f32x4 (&acc)[2][2][4][2], const Unit& u, int wr, int wc, int fr, int fq) const {
        typedef unsigned u32x2v __attribute__((ext_vector_type(2)));
        const int row0 = u.pm * BM + wr * 64 + fr, col0 = u.pn * BM + wc * 32 + 4 * fq;
        float* rowss = (float*)(ws + (1u << 20)); bf16_t* xb = (bf16_t*)(ws + (133u << 20));
#pragma unroll
        for (int ai = 0; ai < 2; ++ai)
#pragma unroll
            for (int m = 0; m < 4; ++m) {
                const int row = row0 + ai * HALF + m * 16; float ss = 0.f;
#pragma unroll
                for (int bj = 0; bj < 2; ++bj)
#pragma unroll
                    for (int n = 0; n < 2; ++n) {
                        const size_t off = (size_t)row * 1024 + col0 + bj * HALF + n * 16;
                        const f32x4 o = *(const f32x4*)(xin + off) + acc[ai][bj][m][n];
                        *(f32x4*)(xout + off) = o;
                        u32x2v w; w.x = cvt_pk_bf16(o[0], o[1]); w.y = cvt_pk_bf16(o[2], o[3]); *(u32x2v*)(xb + off) = w;
                        ss += (o[0] * o[0] + o[1] * o[1]) + (o[2] * o[2] + o[3] * o[3]);
                    }
                ss += __shfl_xor(ss, 16); ss += __shfl_xor(ss, 32);
                if (fq == 0) rowss[(size_t)row * 16 + u.pn * 4 + wc] = ss;
                asm volatile("" ::: "memory");
            }
    }
};
template <class Epi, class Sched, bool ALIGN_EPI = false, bool SP2 = false>
__device__ __forceinline__ void gemm_phase(PG8_LAS unsigned char* lds, const Gemm g, const Sched& S, const Epi& E) {
    const int tid_ = mk_tid(lds);
    const int tid = tid_, wid = __builtin_amdgcn_readfirstlane(tid >> 6), lane = tid & 63, wr = wid >> 2, wc = wid & 3, fr = lane & 15, fq = lane >> 4;
    const int K = g.K, nt = K / BK;
    unsigned voffA[2], voffB[2];
#pragma unroll
    for (int i = 0; i < 2; ++i) { int R, C; stage_rc(tid * 16 + i * 8192, R, C); const int Rb = Epi::PERM ? ((R & ~31) + perm32(R & 31)) : R;
        voffA[i] = (unsigned)(R * K + C) * 2u; voffB[i] = (unsigned)(Rb * K + C) * 2u; }
    const size_t kstep = (size_t)(BK * 2);
    const size_t hstep = (size_t)HALF * K * 2;
    const size_t tstep = 2 * hstep;
    const unsigned ldsw = (unsigned)wid * 1024u;
    const int aoff = lds_byte(wr * 64 + fr, fq * 8), boff = lds_byte(wc * 32 + fr, fq * 8);
#define PG8_SA(b, h) (((b) * 2 + (h)) * HTB)
#define PG8_SB(b, h) ((4 + (b) * 2 + (h)) * HTB)
#define PG8_STAGE(bufoff, gbase, voff) do { _Pragma("unroll") for (int _i = 0; _i < 2; ++_i) \
        __builtin_amdgcn_global_load_lds((const unsigned*)((const char*)(gbase) + (voff)[_i]), (PG8_LAS unsigned*)(lds + (bufoff) + ldsw + _i * 8192), 16, 0, 0); } while (0)
#define PG8_LDA(dst, b, h) do { _Pragma("unroll") for (int m = 0; m < 4; ++m) _Pragma("unroll") for (int k = 0; k < 2; ++k) dst[m][k] = *(const PG8_LAS bf16x8*)(lds + PG8_SA(b, h) + aoff + m * 2048 + k * 1024); } while (0)
#define PG8_LDB(dst, b, h) do { _Pragma("unroll") for (int n = 0; n < 2; ++n) _Pragma("unroll") for (int k = 0; k < 2; ++k) dst[n][k] = *(const PG8_LAS bf16x8*)(lds + PG8_SB(b, h) + boff + n * 2048 + k * 1024); } while (0)
#define PG8_MMA(ai, bj, At, Bt) do { __builtin_amdgcn_s_setprio(1); _Pragma("unroll") for (int m = 0; m < 4; ++m) _Pragma("unroll") for (int n = 0; n < 2; ++n) _Pragma("unroll") for (int k = 0; k < 2; ++k) \
        acc[ai][bj][m][n] = __builtin_amdgcn_mfma_f32_16x16x32_bf16(Bt[n][k], At[m][k], acc[ai][bj][m][n], 0, 0, 0); __builtin_amdgcn_s_setprio(0); } while (0)
#define PG8_WAIT_V(n) asm volatile("s_waitcnt vmcnt(" #n ")" ::: "memory")
#define PG8_WAIT_L(n) asm volatile("s_waitcnt lgkmcnt(" #n ")" ::: "memory")
#define PG8_BAR __builtin_amdgcn_s_barrier()
#define PG8_SCHED __builtin_amdgcn_sched_barrier(0)
    Unit cur, nxt; int ui = 0;
    if (!S.next(0, cur)) return;
    f32x4 acc[2][2][4][2];
#pragma unroll
    for (int a = 0; a < 2; ++a)
#pragma unroll
        for (int b = 0; b < 2; ++b)
#pragma unroll
            for (int m = 0; m < 4; ++m)
#pragma unroll
                for (int n = 0; n < 2; ++n) acc[a][b][m][n] = (f32x4){0.f, 0.f, 0.f, 0.f};
    bf16x8 At[4][2], B0[2][2], B1[2][2];
    const char* cA = (const char*)g.A + (size_t)cur.pm * tstep; const char* cB = (const char*)g.Bt + (size_t)cur.pn * tstep;
    S.a_ready(cur);
    if constexpr (SP2) {
        PG8_STAGE(PG8_SB(0, 0), cB, voffB); PG8_STAGE(PG8_SB(0, 1), cB + hstep, voffB); PG8_STAGE(PG8_SA(0, 0), cA, voffA); PG8_STAGE(PG8_SA(0, 1), cA + hstep, voffA);
        if (wr == 1) PG8_BAR;
        PG8_WAIT_V(2); PG8_BAR;
        PG8_STAGE(PG8_SB(1, 0), cB + kstep, voffB); PG8_STAGE(PG8_SA(1, 0), cA + kstep, voffA); PG8_STAGE(PG8_SB(1, 1), cB + hstep + kstep, voffB);
        PG8_WAIT_V(6); PG8_BAR;
    } else {
        PG8_STAGE(PG8_SB(0, 0), cB, voffB); PG8_STAGE(PG8_SA(0, 0), cA, voffA); PG8_STAGE(PG8_SB(0, 1), cB + hstep, voffB); PG8_STAGE(PG8_SA(0, 1), cA + hstep, voffA);
        if (wr == 1) PG8_BAR;
        PG8_WAIT_V(4); PG8_BAR;
        PG8_STAGE(PG8_SB(1, 0), cB + kstep, voffB); PG8_STAGE(PG8_SA(1, 0), cA + kstep, voffA); PG8_STAGE(PG8_SB(1, 1), cB + hstep + kstep, voffB);
        PG8_WAIT_V(6); PG8_BAR;
    }
    for (;;) {
        const bool has_next = S.next(ui + 1, nxt);
        const char* nA = has_next ? (const char*)g.A + (size_t)nxt.pm * tstep : cA; const char* nB = has_next ? (const char*)g.Bt + (size_t)nxt.pn * tstep : cB;
        for (int t = 0; t < nt; t += 2) {
            const bool last = (t == nt - 2);
            const char* a1 = cA + (size_t)(t + 1) * kstep;
            const char* a2 = last ? nA : cA + (size_t)(t + 2) * kstep; const char* b2 = last ? nB : cB + (size_t)(t + 2) * kstep;
            const char* a3 = a2 + kstep; const char* b3 = b2 + kstep;
            if (last && has_next) S.a_ready(nxt);
            if constexpr (SP2) {
            PG8_LDB(B0, 0, 0); PG8_LDB(B1, 0, 1); PG8_SCHED; PG8_LDA(At, 0, 0); PG8_STAGE(PG8_SA(1, 1), a1 + hstep, voffA);
            PG8_WAIT_V(8); PG8_WAIT_L(0); PG8_BAR; PG8_MMA(0, 0, At, B0); PG8_MMA(0, 1, At, B1); PG8_BAR; PG8_SCHED;
            PG8_LDA(At, 0, 1); PG8_STAGE(PG8_SB(0, 0), b2, voffB); PG8_STAGE(PG8_SB(0, 1), b2 + hstep, voffB); PG8_STAGE(PG8_SA(0, 0), a2, voffA);
            PG8_WAIT_V(8); PG8_WAIT_L(0); PG8_BAR; PG8_MMA(1, 0, At, B0); PG8_MMA(1, 1, At, B1); PG8_BAR; PG8_SCHED;
            PG8_LDB(B0, 1, 0); PG8_LDB(B1, 1, 1); PG8_SCHED; PG8_LDA(At, 1, 0); PG8_STAGE(PG8_SA(0, 1), a2 + hstep, voffA);
            PG8_WAIT_V(8); PG8_WAIT_L(0); PG8_BAR; PG8_MMA(0, 0, At, B0); PG8_MMA(0, 1, At, B1); PG8_BAR; PG8_SCHED;
            PG8_LDA(At, 1, 1); PG8_STAGE(PG8_SB(1, 0), b3, voffB); PG8_STAGE(PG8_SB(1, 1), b3 + hstep, voffB); PG8_STAGE(PG8_SA(1, 0), a3, voffA);
            PG8_WAIT_V(8); PG8_WAIT_L(0); PG8_BAR; PG8_MMA(1, 0, At, B0); PG8_MMA(1, 1, At, B1); PG8_BAR; PG8_SCHED;
            } else {
            PG8_LDB(B0, 0, 0); PG8_SCHED; PG8_LDA(At, 0, 0); PG8_STAGE(PG8_SA(1, 1), a1 + hstep, voffA);
            PG8_WAIT_L(8); PG8_BAR; PG8_WAIT_L(0); PG8_MMA(0, 0, At, B0); PG8_BAR; PG8_SCHED;
            PG8_LDB(B1, 0, 1); PG8_STAGE(PG8_SB(0, 0), b2, voffB);
            PG8_BAR; PG8_WAIT_L(0); PG8_MMA(0, 1, At, B1); PG8_BAR;
            PG8_LDA(At, 0, 1); PG8_STAGE(PG8_SA(0, 0), a2, voffA);
            PG8_BAR; PG8_WAIT_L(0); PG8_MMA(1, 0, At, B0); PG8_BAR; PG8_SCHED;
            PG8_STAGE(PG8_SB(0, 1), b2 + hstep, voffB);
            PG8_WAIT_V(6); PG8_BAR; PG8_MMA(1, 1, At, B1); PG8_BAR;
            PG8_LDB(B0, 1, 0); PG8_SCHED; PG8_LDA(At, 1, 0); PG8_STAGE(PG8_SA(0, 1), a2 + hstep, voffA);
            PG8_WAIT_L(8); PG8_BAR; PG8_WAIT_L(0); PG8_MMA(0, 0, At, B0); PG8_BAR; PG8_SCHED;
            PG8_LDB(B1, 1, 1); PG8_STAGE(PG8_SB(1, 0), b3, voffB);
            PG8_BAR; PG8_WAIT_L(0); PG8_MMA(0, 1, At, B1); PG8_BAR;
            PG8_LDA(At, 1, 1); PG8_STAGE(PG8_SA(1, 0), a3, voffA);
            PG8_BAR; PG8_WAIT_L(0); PG8_MMA(1, 0, At, B0); PG8_BAR; PG8_SCHED;
            PG8_STAGE(PG8_SB(1, 1), b3 + hstep, voffB);
            PG8_WAIT_V(6); PG8_BAR; PG8_MMA(1, 1, At, B1); PG8_BAR;
            }
        }
        if constexpr (ALIGN_EPI) { if (wr == 0) PG8_BAR; }
        if constexpr (!Epi::AFTER_DRAIN) { E(acc, cur, wr, wc, fr, fq); S.done(cur); }
        if (!has_next) break;
#pragma unroll
        for (int a = 0; a < 2; ++a)
#pragma unroll
            for (int b = 0; b < 2; ++b)
#pragma unroll
                for (int m = 0; m < 4; ++m)
#pragma unroll
                    for (int n = 0; n < 2; ++n) acc[a][b][m][n] = (f32x4){0.f, 0.f, 0.f, 0.f};
        cur = nxt; cA = nA; cB = nB; ++ui;
        if constexpr (ALIGN_EPI) { if (wr == 1) PG8_BAR; }
    }
    PG8_WAIT_V(0);
    if constexpr (!ALIGN_EPI) { if (wr == 0) PG8_BAR; }
    PG8_BAR;
    if constexpr (Epi::AFTER_DRAIN) { E.fused(acc, cur, wr, wc, fr, fq, lds, wid, lane); S.done(cur); }
#undef PG8_SA
#undef PG8_SB
#undef PG8_STAGE
#undef PG8_LDA
#undef PG8_LDB
#undef PG8_MMA
#undef PG8_WAIT_V
#undef PG8_WAIT_L
#undef PG8_BAR
#undef PG8_SCHED
}
}
#define GAS __attribute__((address_space(1)))
#define LAS __attribute__((address_space(3)))
typedef unsigned short bf16;
typedef unsigned v4u __attribute__((ext_vector_type(4)));
typedef float f32x4 __attribute__((ext_vector_type(4)));
typedef short bf16x8 __attribute__((ext_vector_type(8)));
typedef GAS unsigned gu32;
typedef GAS unsigned long long gu64;
#define RLX_AGENT __ATOMIC_RELAXED, __HIP_MEMORY_SCOPE_AGENT
#define LDS_WAIT() asm volatile("s_waitcnt lgkmcnt(0)" ::: "memory")
#define VM_WAIT() asm volatile("s_waitcnt vmcnt(0)" ::: "memory")
__device__ __forceinline__ unsigned long long rt() { return __builtin_amdgcn_s_memrealtime(); }
__device__ __forceinline__ unsigned f2bf(float f) { unsigned u = __builtin_bit_cast(unsigned, f); return (u + 0x7fffu + ((u >> 16) & 1u)) >> 16; }
__device__ __forceinline__ unsigned pk2(float lo, float hi) { return f2bf(lo) | (f2bf(hi) << 16); }

#define XB_TMO      128
#define XB_XCNT(j)  (256  + 64 * (j))
#define XB_XSUB(j)  (1280 + 64 * (j))
#define XB_XGEN(j)  (2304 + 64 * (j))
#define XB_TOP      3328
#define XB_TOPGEN   3392
#define XCD_BAR_WORDS 3456
#define XB_SPIN_CAP (1u << 18)

__device__ __forceinline__ unsigned xb_ld(unsigned* p)              { return __hip_atomic_load(p, __ATOMIC_RELAXED, __HIP_MEMORY_SCOPE_AGENT); }
__device__ __forceinline__ unsigned xb_add(unsigned* p, unsigned v) { return __hip_atomic_fetch_add(p, v, __ATOMIC_RELAXED, __HIP_MEMORY_SCOPE_AGENT); }
__device__ __forceinline__ unsigned xb_xcc_id() { return (unsigned)__builtin_amdgcn_s_getreg((3 << 11) | 20) & 0xFu; }
#define XB_SPIN(cond, bar) do { unsigned _sp = 0; while (cond) { __builtin_amdgcn_s_sleep(1); \
    if ((++_sp & 255u) == 0u) { if (xb_ld(&(bar)[XB_TMO])) break; if (_sp > XB_SPIN_CAP) { atomicAdd(&(bar)[XB_TMO], 1u); break; } } } } while (0)

struct XcdBarrier {
    unsigned* bar; unsigned x;
    volatile LAS unsigned* st;
};

__device__ __forceinline__ XcdBarrier xcd_barrier_post(unsigned* bar, volatile LAS unsigned* st) {
    XcdBarrier b; b.bar = bar; b.x = xb_xcc_id(); b.st = st;
    if (threadIdx.x == 0) (void)xb_add(&bar[XB_XCNT(b.x)], 1u);
    return b;
}
__device__ __forceinline__ void xcd_barrier_complete(unsigned* bar, unsigned x, unsigned& nloc, unsigned& nx) {
    const unsigned G = gridDim.x * gridDim.y * gridDim.z;
    unsigned sum, cnt, mine, sp = 0u;
    for (;;) {
        sum = 0u; cnt = 0u; mine = 0u;
#pragma unroll
        for (unsigned j = 0; j < 16; ++j) { const unsigned c = xb_ld(&bar[XB_XCNT(j)]); sum += c; cnt += (c > 0u) ? 1u : 0u; mine = (j == x) ? c : mine; }
        if (sum == G) break;
        __builtin_amdgcn_s_sleep(1);
        if ((++sp & 255u) == 0u) { if (xb_ld(&bar[XB_TMO])) break; if (sp > XB_SPIN_CAP) { atomicAdd(&bar[XB_TMO], 1u); break; } }
    }
    nloc = mine > 0u ? mine : 1u; nx = cnt > 0u ? cnt : 1u;
}

__device__ __forceinline__ void xcd_barrier(const XcdBarrier& b) {
    asm volatile("s_waitcnt vmcnt(0)" ::: "memory");
    __syncthreads();
    if (pg8::mk_tid((LAS unsigned char*)b.st - (131072 + 320 + 32)) == 0) {
        unsigned* bar = b.bar;
        __builtin_amdgcn_s_waitcnt(0);
        unsigned nloc = b.st[0], nx = b.st[1];
        if (nloc == 0u) { xcd_barrier_complete(bar, b.x, nloc, nx); b.st[0] = nloc; b.st[1] = nx; }
        const unsigned old = xb_add(&bar[XB_XSUB(b.x)], 1u);
        const unsigned gen = old / nloc;
        if (old + 1u == (gen + 1u) * nloc) {
            __builtin_amdgcn_fence(__ATOMIC_RELEASE, "agent");
            asm volatile("s_waitcnt vmcnt(0)" ::: "memory");
            const unsigned og = xb_add(&bar[XB_TOP], 1u);
            const unsigned tg = og / nx;
            if (og + 1u == (tg + 1u) * nx) xb_add(&bar[XB_TOPGEN], 1u);
            else XB_SPIN(xb_ld(&bar[XB_TOPGEN]) == tg, bar);
            __builtin_amdgcn_fence(__ATOMIC_ACQUIRE, "agent");
            xb_add(&bar[XB_XGEN(b.x)], 1u);
            asm volatile("s_waitcnt vmcnt(0)" ::: "memory");
        } else {
            XB_SPIN(xb_ld(&bar[XB_XGEN(b.x)]) == gen, bar);
            __builtin_amdgcn_fence(__ATOMIC_ACQUIRE, "agent");
            asm volatile("s_waitcnt vmcnt(0)" ::: "memory");
        }
    }
    __syncthreads();
}
constexpr int BATCH = 8, SEQ = 2048, M = BATCH * SEQ, D = 1024, NIN = 3448, NP = 3584;
constexpr float NORM_EPS = 1e-6f;
constexpr float LOG2E = 1.4426950408889634f;
constexpr size_t MiB = 1u << 20;
constexpr size_t WS_CTL = 0, CTL_ZERO_BYTES = 1 * MiB;
constexpr size_t WS_ROWSS = 1 * MiB;
constexpr size_t WS_WIN = 2 * MiB;
constexpr size_t WS_WOUT = 16 * MiB;
constexpr size_t WS_WSMALL = 20 * MiB;
constexpr size_t OFF_WUQ = 0, OFF_WUKV = 2 * 576 * 192 * 2, OFF_W2T = OFF_WUKV + 2 * 768 * 128 * 2, OFF_A2T = OFF_W2T + 2 * 2 * 256 * 64 * 2;
constexpr size_t WS_PSM = 22 * MiB;
constexpr size_t WS_CB = 24 * MiB;
constexpr size_t WS_PGATE = 25 * MiB;
constexpr size_t WS_PGDN = 57 * MiB;
constexpr size_t WS_PMLA = 93 * MiB;
constexpr size_t WS_PRW = 104 * MiB;
constexpr size_t WS_OGDN = 93 * MiB;
constexpr size_t WS_OMLA = 105 * MiB;
constexpr size_t WS_Y = 117 * MiB;
constexpr size_t WS_RS = 133 * MiB;
constexpr size_t WS_RD = 157 * MiB;
constexpr size_t WS_XB = 133 * MiB;
constexpr size_t WS_Q = 207 * MiB;
constexpr size_t WS_K = 225 * MiB;
constexpr size_t WS_VT = 243 * MiB;
constexpr size_t WS_MIX = 207 * MiB;
constexpr size_t WS_END = 255 * MiB;
constexpr int RS_REC = 384, RD_REC = 400;
constexpr size_t RD_DIR = (size_t)BATCH * 4 * SEQ * RD_REC;
constexpr int CW_BAR = 4096;
constexpr int CW_QUEUE = 16384;

constexpr int NWAVES = 8;
constexpr int RING_OFF = 0, RING_BYTES = 131072, LDSCTL_OFF = RING_BYTES, MISC_OFF = LDSCTL_OFF + 320, LDS_BYTES = 147456;
static_assert(pg8::TIDTAB_OFF == MISC_OFF + 512 && RING_OFF == 0, "LDS map");
constexpr int NPHASE = 12;

__device__ __forceinline__ float bf2f(bf16 v) { return __uint_as_float(((unsigned)v) << 16); }
__device__ __forceinline__ float wave_sum(float v) {
#pragma unroll
    for (int o = 1; o < 64; o <<= 1) v += __shfl_xor(v, o);
    return v;
}
__device__ __forceinline__ float siluf(float x) { return x / (1.f + __expf(-x)); }
__device__ __forceinline__ float sigmoidf_(float x) { return 1.f / (1.f + __expf(-x)); }
__device__ __forceinline__ float softplusf_(float x) { return x > 20.f ? x : log1pf(__expf(x)); }

struct Args { const void* in[24]; float* out; unsigned char* ws; int ph_lo, ph_hi; };

struct Frame {
    LAS unsigned char* lds;
    volatile LAS unsigned* MISC;
    gu32* ctl;
    int tid, lane, wave, vcu, G;
    unsigned char* ws;
    float* out;
    volatile LAS const unsigned long long* ptab;
};
__device__ __forceinline__ const void* inptr(const Frame& F, int k) {
    const unsigned long long v = F.ptab[k];
    const unsigned lo = __builtin_amdgcn_readfirstlane((unsigned)v), hi = __builtin_amdgcn_readfirstlane((unsigned)(v >> 32));
    return (const void*)(GAS const void*)(((unsigned long long)hi << 32) | lo);
}

__device__ __forceinline__ void tr_item(const float* W, int K, int ldsrc, int scol, int nvalid, bf16* WT, const float* gs, LAS float* scr, int kb, int lane) {
    const int k0 = 64 * kb;
#pragma unroll 8
    for (int i = 0; i < 32; ++i) { const int kk = 2 * i + (lane >> 5), n = lane & 31; float v = 0.f;
        if (n < nvalid) { v = W[(size_t)(k0 + kk) * ldsrc + scol + n]; if (gs) v *= gs[k0 + kk]; }
        scr[kk * 33 + n] = v; }
    LDS_WAIT(); asm volatile("" ::: "memory");
    const int c = lane & 7;
#pragma unroll
    for (int j = 0; j < 4; ++j) { const int n = (lane >> 3) + 8 * j; const LAS float* s = scr + (8 * c) * 33 + n;
        v4u o; o.x = pk2(s[0 * 33], s[1 * 33]); o.y = pk2(s[2 * 33], s[3 * 33]); o.z = pk2(s[4 * 33], s[5 * 33]); o.w = pk2(s[6 * 33], s[7 * 33]);
        *(GAS v4u*)(WT + (size_t)n * K + k0 + 8 * c) = o; }
    LDS_WAIT(); asm volatile("" ::: "memory");
}
__device__ __forceinline__ void p0_prologue(Frame& F) {
    LAS float* scr = (LAS float*)(F.lds + RING_OFF + F.wave * 16384);
    const int gw = F.vcu * NWAVES + F.wave, NGW = F.G * NWAVES;
    constexpr int I_IN = 112 * 16, I_OUT = 32 * 16, I_UQ = 18 * 3, I_UKV = 24 * 2, I_W2 = 16, I_A2 = 16, I_L = I_IN + I_OUT + I_UQ + I_UKV + I_W2 + I_A2;
    for (int it = gw; it < 2 * I_L; it += NGW) {
        const int l = it / I_L; int r = it % I_L;
        if (r < I_IN) { const int nb = r >> 4, kb = r & 15, n0 = 32 * nb; int scol, nv;
            if (n0 < 2176) { scol = n0; nv = 32; } else if (n0 < 3424) { scol = n0 + 24; nv = 32; } else if (n0 == 3424) { scol = 2176; nv = 24; } else { scol = 0; nv = 0; }
            tr_item((const float*)inptr(F, 3) + (size_t)l * D * NIN, D, NIN, scol, nv, (bf16*)(F.ws + WS_WIN) + ((size_t)l * NP + n0) * D, (const float*)inptr(F, 2) + l * D, scr, kb, F.lane); continue; }
        r -= I_IN;
        if (r < I_OUT) { const int nb = r >> 4, kb = r & 15;
            tr_item((const float*)inptr(F, 22) + (size_t)l * D * D, D, D, 32 * nb, 32, (bf16*)(F.ws + WS_WOUT) + ((size_t)l * D + 32 * nb) * D, nullptr, scr, kb, F.lane); continue; }
        r -= I_OUT;
        if (r < I_UQ) { const int nb = r / 3, kb = r % 3;
            tr_item((const float*)inptr(F, 9) + (size_t)l * 192 * 576, 192, 576, 32 * nb, 32, (bf16*)(F.ws + WS_WSMALL + OFF_WUQ) + ((size_t)l * 576 + 32 * nb) * 192, (const float*)inptr(F, 8) + l * 192, scr, kb, F.lane); continue; }
        r -= I_UQ;
        if (r < I_UKV) { const int nb = r >> 1, kb = r & 1;
            tr_item((const float*)inptr(F, 11) + (size_t)l * 128 * 768, 128, 768, 32 * nb, 32, (bf16*)(F.ws + WS_WSMALL + OFF_WUKV) + ((size_t)l * 768 + 32 * nb) * 128, (const float*)inptr(F, 10) + l * 128, scr, kb, F.lane); continue; }
        r -= I_UKV;
        if (r < I_W2) { const int e = r >> 3, nb = r & 7;
            tr_item((const float*)inptr(F, 14) + ((size_t)l * 2 + e) * 64 * 256, 64, 256, 32 * nb, 32, (bf16*)(F.ws + WS_WSMALL + OFF_W2T) + (((size_t)l * 2 + e) * 256 + 32 * nb) * 64, nullptr, scr, 0, F.lane); continue; }
        r -= I_W2;
        { const int e = r >> 3, nb = r & 7;
            tr_item((const float*)inptr(F, 16) + ((size_t)l * 2 + e) * 64 * 256, 64, 256, 32 * nb, 32, (bf16*)(F.ws + WS_WSMALL + OFF_A2T) + (((size_t)l * 2 + e) * 256 + 32 * nb) * 64, nullptr, scr, 0, F.lane); }
    }
    const float* x = (const float*)inptr(F, 0); bf16* xb = (bf16*)(F.ws + WS_XB); float* rowss = (float*)(F.ws + WS_ROWSS);
    for (int m = gw; m < M; m += NGW) {
        const GAS f32x4* xr = (const GAS f32x4*)(x + (size_t)m * D) + F.lane;
        GAS unsigned long long* o8 = (GAS unsigned long long*)(xb + (size_t)m * D) + F.lane; float s = 0.f;
#pragma unroll
        for (int j = 0; j < 4; ++j) { const f32x4 v = xr[64 * j]; s += (v.x * v.x + v.y * v.y) + (v.z * v.z + v.w * v.w);
            o8[64 * j] = (unsigned long long)pk2(v.x, v.y) | ((unsigned long long)pk2(v.z, v.w) << 32); }
        s = wave_sum(s);
        if (F.lane < 16) rowss[(size_t)m * 16 + F.lane] = F.lane == 0 ? s : 0.f;
    }
}
__device__ __forceinline__ void p5_final(Frame& F) {
    const int gw = F.vcu * NWAVES + F.wave, NGW = F.G * NWAVES;
    const float* rowss = (const float*)(F.ws + WS_ROWSS); const float* g = (const float*)inptr(F, 23);
    f32x4 gv[4];
#pragma unroll
    for (int j = 0; j < 4; ++j) gv[j] = ((const f32x4*)g)[F.lane + 64 * j];
    for (int m = gw; m < M; m += NGW) {
        float ss = F.lane < 16 ? rowss[(size_t)m * 16 + F.lane] : 0.f;
        ss = wave_sum(ss);
        const float rstd = rsqrtf(ss * (1.f / D) + NORM_EPS);
        GAS f32x4* xr = (GAS f32x4*)(F.out + (size_t)m * D) + F.lane;
#pragma unroll
        for (int j = 0; j < 4; ++j) { f32x4 v = xr[64 * j]; v = v * rstd * gv[j]; xr[64 * j] = v; }
    }
}
__device__ __forceinline__ float dotbf(const bf16* a, const bf16* b, int K) {
    float acc = 0.f;
#pragma unroll 2
    for (int k = 0; k < K; k += 8) {
        const v4u av = *(const v4u*)(a + k), bv = *(const v4u*)(b + k);
#pragma unroll
        for (int i = 0; i < 4; ++i) {
            acc += __uint_as_float(av[i] << 16) * __uint_as_float(bv[i] << 16);
            acc += __uint_as_float(av[i] & 0xffff0000u) * __uint_as_float(bv[i] & 0xffff0000u);
        }
    }
    return acc;
}
__device__ __forceinline__ void p2_mla_token(Frame& F, int l, int m, LAS float* raw) {
    const bf16* Pmla = (const bf16*)(F.ws + WS_PMLA);
    const bf16* WuqT = (const bf16*)(F.ws + WS_WSMALL + OFF_WUQ) + (size_t)l * 576 * 192;
    const bf16* WukvT = (const bf16*)(F.ws + WS_WSMALL + OFF_WUKV) + (size_t)l * 768 * 128;
    bf16* Q = (bf16*)(F.ws + WS_Q); bf16* Kb = (bf16*)(F.ws + WS_K); bf16* Vt = (bf16*)(F.ws + WS_VT);
    const int lane = F.lane, b = m / SEQ, t = m % SEQ;
    const bf16* p = Pmla + (size_t)m * 352;
    float s1 = 0.f, s2 = 0.f;
    for (int c = lane; c < 192; c += 64) { const float v = bf2f(p[c]); s1 += v * v; }
    for (int c = lane; c < 128; c += 64) { const float v = bf2f(p[192 + c]); s2 += v * v; }
    s1 = wave_sum(s1); s2 = wave_sum(s2);
    const float rq = rsqrtf(s1 * (1.f / 192.f) + NORM_EPS), rkv = rsqrtf(s2 * (1.f / 128.f) + NORM_EPS);
#pragma unroll 1
    for (int c = lane; c < 576; c += 64) raw[c] = dotbf(p, WuqT + (size_t)c * 192, 192) * rq;
#pragma unroll 1
    for (int c = lane; c < 768; c += 64) raw[576 + c] = dotbf(p + 192, WukvT + (size_t)c * 128, 128) * rkv;
    LDS_WAIT(); asm volatile("" ::: "memory");
    const float pos = (float)((const int*)inptr(F, 1))[m];
    const float qs = 0.10206207261596575f * LOG2E;
#pragma unroll 1
    for (int i = lane; i < 6 * 80; i += 64) {
        const int h = i / 80, j = i % 80;
        bf16* qo = Q + (((size_t)b * 6 + h) * SEQ + t) * 96;
        if (j < 64) qo[j] = f2bf(raw[h * 96 + j] * qs);
        else { const int r = j - 64; const float inv = exp2f(-(float)r * (13.287712379549449f / 16.f)); float sn, cs; sincosf(pos * inv, &sn, &cs);
            const float x1 = raw[h * 96 + 64 + r], x2 = raw[h * 96 + 80 + r];
            qo[64 + r] = f2bf((x1 * cs - x2 * sn) * qs); qo[80 + r] = f2bf((x2 * cs + x1 * sn) * qs); }
    }
#pragma unroll 1
    for (int i = lane; i < 6 * 64; i += 64) {
        const int h = i / 64, j = i % 64;
        Kb[(((size_t)b * 6 + h) * SEQ + t) * 96 + j] = f2bf(raw[576 + h * 128 + j]);
        Vt[(((size_t)b * 6 + h) * 64 + j) * SEQ + t] = f2bf(raw[576 + h * 128 + 64 + j]);
    }
    if (lane < 16) {
        const int r = lane; const float inv = exp2f(-(float)r * (13.287712379549449f / 16.f)); float sn, cs; sincosf(pos * inv, &sn, &cs);
        const float x1 = bf2f(p[320 + r]), x2 = bf2f(p[336 + r]);
        const bf16 o1 = f2bf(x1 * cs - x2 * sn), o2 = f2bf(x2 * cs + x1 * sn);
        for (int h = 0; h < 6; ++h) { bf16* ko = Kb + (((size_t)b * 6 + h) * SEQ + t) * 96; ko[64 + r] = o1; ko[80 + r] = o2; }
    }
    LDS_WAIT(); asm volatile("" ::: "memory");
}
__device__ __forceinline__ void p2_rwkv_token(Frame& F, int l, int m, LAS float* f, int c) {
    const bf16* Prw = (const bf16*)(F.ws + WS_PRW);
    const float* mu = (const float*)inptr(F, 12) + l * 2 * 896; const float* w0 = (const float*)inptr(F, 13) + l * 512; const float* w2 = (const float*)inptr(F, 14) + (size_t)l * 2 * 64 * 256;
    const float* a0 = (const float*)inptr(F, 15) + l * 512; const float* a2 = (const float*)inptr(F, 16) + (size_t)l * 2 * 64 * 256;
    const float* k_k = (const float*)inptr(F, 17) + l * 256; const float* k_a = (const float*)inptr(F, 18) + l * 256; const float* r_k = (const float*)inptr(F, 19) + l * 256;
    unsigned char* Rs = F.ws + WS_RS; unsigned char* Rd = F.ws + WS_RD; float* cb = (float*)(F.ws + WS_CB);
    const int b = m / SEQ, t = m % SEQ, h = c >> 6, j = c & 63;
#pragma unroll 1
    for (int i = c; i < 896; i += 256) {
        const float x = bf2f(Prw[(size_t)m * 896 + i]);
        const float xp = t > 0 ? bf2f(Prw[(size_t)(m - 1) * 896 + i]) : 0.f;
        const float xn = t < SEQ - 1 ? bf2f(Prw[(size_t)(m + 1) * 896 + i]) : 0.f;
        float v = x + mu[i] * (xp - x) + mu[896 + i] * (xn - x);
        if (i >= 768 && i < 832) v = tanhf(v);
        f[i] = v;
    }
    __syncthreads();
    const float r = f[c], k = f[256 + c], v = f[512 + c];
    const float kkr = k * k_k[c];
    const float kn = wave_sum(kkr * kkr);
    const float kk = kkr * rsqrtf(kn + 1e-6f);
    float kmod[2], bb[2], lam[2];
#pragma unroll
    for (int e = 0; e < 2; ++e) {
        float lw = 0.f, la = 0.f;
#pragma unroll 8
        for (int d = 0; d < 64; ++d) { lw += f[768 + d] * w2[((size_t)e * 64 + d) * 256 + c]; la += f[832 + d] * a2[((size_t)e * 64 + d) * 256 + c]; }
        const float wl = -softplusf_(-(w0[e * 256 + c] + lw)) - 0.5f;
        lam[e] = __expf(wl);
        const float a = sigmoidf_(a0[e * 256 + c] + la);
        kmod[e] = k * (1.f + (a - 1.f) * k_a[c]);
        bb[e] = a * kk;
    }
    unsigned char* rs = Rs + (((size_t)b * 4 + h) * SEQ + t) * RS_REC;
    ((bf16*)rs)[j] = f2bf(kk); ((bf16*)(rs + 128))[j] = f2bf(v); ((bf16*)(rs + 256))[j] = f2bf(r);
#pragma unroll
    for (int e = 0; e < 2; ++e) {
        unsigned char* rd = Rd + e * RD_DIR + (((size_t)b * 4 + h) * SEQ + t) * RD_REC;
        ((__half*)rd)[j] = __float2half(lam[e]); ((bf16*)(rd + 128))[j] = f2bf(bb[e]); ((bf16*)(rd + 256))[j] = f2bf(kmod[e]);
        const float br = wave_sum(bb[e] * r), kr = wave_sum(kmod[e] * r);
        if (j == 0) { ((float*)(rd + 384))[0] = br; ((float*)(rd + 384))[1] = kr; }
    }
    const float cbv = wave_sum(r * 0.5f * (kmod[0] + kmod[1]) * r_k[c]);
    if (j == 0) cb[(size_t)m * 4 + h] = cbv;
    __syncthreads();
}
__device__ __forceinline__ void p2_prep(Frame& F, int l) {
    { LAS float* f = (LAS float*)(F.lds + RING_OFF) + (F.tid >> 8) * 896; const int c = F.tid & 255;
      for (int m = 2 * (int)blockIdx.x + (F.tid >> 8); m < M; m += 2 * F.G) p2_rwkv_token(F, l, m, f, c); }
    { LAS float* raw = (LAS float*)(F.lds + RING_OFF + 8192) + F.wave * 1344;
      const int gw = F.vcu * NWAVES + F.wave, NGW = F.G * NWAVES;
      for (int m = gw; m < M; m += NGW) p2_mla_token(F, l, m, raw); }
}
__device__ __forceinline__ void p4a_mix(Frame& F, int l) {
    const bf16* Ogdn = (const bf16*)(F.ws + WS_OGDN); const bf16* Omla = (const bf16*)(F.ws + WS_OMLA); const bf16* Y = (const bf16*)(F.ws + WS_Y);
    const bf16* Pgate = (const bf16*)(F.ws + WS_PGATE); const unsigned char* Rs = F.ws + WS_RS; const float* cb = (const float*)(F.ws + WS_CB); bf16* mix = (bf16*)(F.ws + WS_MIX);
    const float* gdn_g = (const float*)inptr(F, 7) + l * 64; const float* ln_g = (const float*)inptr(F, 20) + l * 256; const float* ln_b = (const float*)inptr(F, 21) + l * 256;
    const int gw = F.vcu * NWAVES + F.wave, NGW = F.G * NWAVES, j = F.lane;
    const float gg = gdn_g[j];
    for (int m = gw; m < M; m += NGW) {
        const int b = m / SEQ, t = m % SEQ;
#pragma unroll 2
        for (int g = 0; g < 16; ++g) {
            const int c = g * 64 + j; float val;
            if (g < 6) { const float o = bf2f(Ogdn[(size_t)m * 384 + c]); const float ss = wave_sum(o * o); val = o * rsqrtf(ss * (1.f / 64.f) + NORM_EPS) * gg; }
            else if (g < 12) val = bf2f(Omla[(size_t)m * 384 + (c - 384)]);
            else { const int cc = c - 768, h = g - 12; const float y = bf2f(Y[(size_t)m * 256 + cc]);
                const float mean = wave_sum(y) * (1.f / 64.f); const float dv = y - mean; const float var = wave_sum(dv * dv) * (1.f / 64.f);
                const float v = bf2f(((const bf16*)(Rs + (((size_t)b * 4 + h) * SEQ + t) * RS_REC + 128))[j]);
                val = dv * rsqrtf(var + 64e-5f) * ln_g[cc] + ln_b[cc] + cb[(size_t)m * 4 + h] * v; }
            mix[(size_t)m * 1024 + c] = f2bf(val * siluf(bf2f(Pgate[(size_t)m * 1024 + c])));
        }
    }
}
typedef float f32x16 __attribute__((ext_vector_type(16)));
typedef unsigned long long u64_t;
__device__ __forceinline__ bf16x8 mk_bf16x8(u64_t lo, u64_t hi) { typedef u64_t u64x2 __attribute__((ext_vector_type(2))); u64x2 v = {lo, hi}; return __builtin_bit_cast(bf16x8, v); }

constexpr int AT_KP = 208, AT_VP = 136, AT_KBYTES = 64 * AT_KP, AT_VBYTES = 64 * AT_VP, AT_BUF = AT_KBYTES + AT_VBYTES;
__device__ __forceinline__ void attn_unit(Frame& F, int unit) {
    const int bh = unit >> 3, qb = unit & 7, b = bh / 6, h = bh % 6;
    const int tid = F.tid, lane = F.lane, wave = F.wave, r32 = lane & 31, hi = lane >> 5;
    const bf16* Qg = (const bf16*)(F.ws + WS_Q) + ((size_t)bh * SEQ + qb * 256 + wave * 32 + r32) * 96;
    const bf16* Kg = (const bf16*)(F.ws + WS_K) + (size_t)bh * SEQ * 96;
    const bf16* Vg = (const bf16*)(F.ws + WS_VT) + (size_t)bh * 64 * SEQ;
    LAS unsigned char* lds = F.lds + RING_OFF;
    bf16x8 qf[6];
#pragma unroll
    for (int s = 0; s < 6; ++s) qf[s] = *(const bf16x8*)(Qg + 16 * s + 8 * hi);
    const int kr0 = tid / 12, kc0 = tid % 12, kr1 = (512 + tid) / 12, kc1 = (512 + tid) % 12, vd = tid >> 3, vc = tid & 7;
    const bool has1 = tid < 256;
    v4u kreg0, kreg1 = {0u, 0u, 0u, 0u}, vreg;
#define AT_LOAD(t0) do { kreg0 = *(const v4u*)(Kg + (size_t)((t0) + kr0) * 96 + kc0 * 8); if (has1) kreg1 = *(const v4u*)(Kg + (size_t)((t0) + kr1) * 96 + kc1 * 8); \
        vreg = *(const v4u*)(Vg + (size_t)vd * SEQ + (t0) + vc * 8); } while (0)
#define AT_STORE(buf) do { LAS unsigned char* bb_ = lds + (buf) * AT_BUF; *(LAS v4u*)(bb_ + kr0 * AT_KP + kc0 * 16) = kreg0; if (has1) *(LAS v4u*)(bb_ + kr1 * AT_KP + kc1 * 16) = kreg1; \
        LAS u64_t* vp_ = (LAS u64_t*)(bb_ + AT_KBYTES + vd * AT_VP + vc * 16); vp_[0] = (u64_t)vreg.x | ((u64_t)vreg.y << 32); vp_[1] = (u64_t)vreg.z | ((u64_t)vreg.w << 32); } while (0)
    AT_LOAD(0); AT_STORE(0);
    __syncthreads();
    f32x16 o0 = {}, o1 = {};
    float mrun = -1e30f, lsum = 0.f;
    for (int t = 0; t < SEQ / 64; ++t) {
        if (t + 1 < SEQ / 64) AT_LOAD((t + 1) * 64);
        LAS unsigned char* bb = lds + (t & 1) * AT_BUF;
        f32x16 p0 = {}, p1 = {};
        { const LAS unsigned char* kb = bb + r32 * AT_KP + hi * 16;
#pragma unroll
          for (int s = 0; s < 6; ++s) {
              const bf16x8 a0 = *(const LAS bf16x8*)(kb + 32 * s), a1 = *(const LAS bf16x8*)(kb + 32 * AT_KP + 32 * s);
              p0 = __builtin_amdgcn_mfma_f32_32x32x16_bf16(a0, qf[s], p0, 0, 0, 0);
              p1 = __builtin_amdgcn_mfma_f32_32x32x16_bf16(a1, qf[s], p1, 0, 0, 0); } }
        float mloc = fmaxf(p0[0], p1[0]);
#pragma unroll
        for (int r = 1; r < 16; ++r) mloc = fmaxf(mloc, fmaxf(p0[r], p1[r]));
        mloc = fmaxf(mloc, __shfl_xor(mloc, 32));
        const float mnew = fmaxf(mrun, mloc), alpha = __builtin_amdgcn_exp2f(mrun - mnew);
        mrun = mnew; lsum *= alpha;
#pragma unroll
        for (int r = 0; r < 16; ++r) { o0[r] *= alpha; o1[r] *= alpha; }
        float ps = 0.f;
#pragma unroll
        for (int r = 0; r < 16; ++r) { p0[r] = __builtin_amdgcn_exp2f(p0[r] - mnew); p1[r] = __builtin_amdgcn_exp2f(p1[r] - mnew); ps += p0[r] + p1[r]; }
        lsum += ps;
        v4u pk[4];
#pragma unroll
        for (int s2 = 0; s2 < 2; ++s2) {
            pk[s2] = (v4u){pg8::cvt_pk_bf16(p0[8 * s2], p0[8 * s2 + 1]), pg8::cvt_pk_bf16(p0[8 * s2 + 2], p0[8 * s2 + 3]), pg8::cvt_pk_bf16(p0[8 * s2 + 4], p0[8 * s2 + 5]), pg8::cvt_pk_bf16(p0[8 * s2 + 6], p0[8 * s2 + 7])};
            pk[2 + s2] = (v4u){pg8::cvt_pk_bf16(p1[8 * s2], p1[8 * s2 + 1]), pg8::cvt_pk_bf16(p1[8 * s2 + 2], p1[8 * s2 + 3]), pg8::cvt_pk_bf16(p1[8 * s2 + 4], p1[8 * s2 + 5]), pg8::cvt_pk_bf16(p1[8 * s2 + 6], p1[8 * s2 + 7])};
        }
        { const LAS unsigned char* vb = bb + AT_KBYTES + r32 * AT_VP + hi * 8;
#pragma unroll
          for (int ks = 0; ks < 4; ++ks) {
              const bf16x8 pb = __builtin_bit_cast(bf16x8, pk[ks]);
              const bf16x8 v0 = mk_bf16x8(*(const LAS u64_t*)(vb + ks * 32), *(const LAS u64_t*)(vb + ks * 32 + 16));
              const bf16x8 v1 = mk_bf16x8(*(const LAS u64_t*)(vb + 32 * AT_VP + ks * 32), *(const LAS u64_t*)(vb + 32 * AT_VP + ks * 32 + 16));
              o0 = __builtin_amdgcn_mfma_f32_32x32x16_bf16(v0, pb, o0, 0, 0, 0);
              o1 = __builtin_amdgcn_mfma_f32_32x32x16_bf16(v1, pb, o1, 0, 0, 0); } }
        if (t + 1 < SEQ / 64) AT_STORE((t + 1) & 1);
        __syncthreads();
    }
#undef AT_LOAD
#undef AT_STORE
    lsum += __shfl_xor(lsum, 32);
    const float inv = 1.f / lsum;
    bf16* Og = (bf16*)(F.ws + WS_OMLA) + ((size_t)b * SEQ + qb * 256 + wave * 32 + r32) * 384 + h * 64 + 4 * hi;
#pragma unroll
    for (int rg = 0; rg < 4; ++rg) {
        *(u64_t*)(Og + 8 * rg) = (u64_t)pg8::cvt_pk_bf16(o0[4 * rg] * inv, o0[4 * rg + 1] * inv) | ((u64_t)pg8::cvt_pk_bf16(o0[4 * rg + 2] * inv, o0[4 * rg + 3] * inv) << 32);
        *(u64_t*)(Og + 32 + 8 * rg) = (u64_t)pg8::cvt_pk_bf16(o1[4 * rg] * inv, o1[4 * rg + 1] * inv) | ((u64_t)pg8::cvt_pk_bf16(o1[4 * rg + 2] * inv, o1[4 * rg + 3] * inv) << 32);
    }
}

constexpr int CW_FLAG = 32768;
__device__ __forceinline__ void partner_sync(Frame& F, gu32* mine, gu32* theirs) {
    asm volatile("s_waitcnt vmcnt(0)" ::: "memory");
    __syncthreads();
    if (F.tid == 0) {
        __builtin_amdgcn_fence(__ATOMIC_RELEASE, "agent");
        asm volatile("s_waitcnt vmcnt(0)" ::: "memory");
        __hip_atomic_store(mine, 1u, RLX_AGENT);
        unsigned spins = 0;
        while (__hip_atomic_load(theirs, RLX_AGENT) == 0u) { __builtin_amdgcn_s_sleep(4); if (++spins > (1u << 22)) break; }
        __builtin_amdgcn_fence(__ATOMIC_ACQUIRE, "agent");
        asm volatile("s_waitcnt vmcnt(0)" ::: "memory");
    }
    __syncthreads();
}
constexpr int RW_STEP = 1440, RW_CH = 32, RW_BUF = RW_CH * RW_STEP;
constexpr int RW_Y = 2 * RW_BUF;
static_assert(RW_Y + 2 * 4096 <= RING_BYTES, "RWKV LDS map");
__device__ __forceinline__ float dpp_xor1(float x) { return __builtin_bit_cast(float, __builtin_amdgcn_update_dpp(0, __builtin_bit_cast(int, x), 0xB1, 0xF, 0xF, true)); }
__device__ __forceinline__ float dpp_xor2(float x) { return __builtin_bit_cast(float, __builtin_amdgcn_update_dpp(0, __builtin_bit_cast(int, x), 0x4E, 0xF, 0xF, true)); }
__device__ __forceinline__ float dpp_hmir(float x) { return __builtin_bit_cast(float, __builtin_amdgcn_update_dpp(0, __builtin_bit_cast(int, x), 0x141, 0xF, 0xF, true)); }
__device__ __forceinline__ float dpp_rmir(float x) { return __builtin_bit_cast(float, __builtin_amdgcn_update_dpp(0, __builtin_bit_cast(int, x), 0x140, 0xF, 0xF, true)); }
__device__ __forceinline__ void rwkv_unit(Frame& F, int unit, gu32* flags) {
    const int bh = unit >> 2, rowhalf = (unit >> 1) & 1, dir = unit & 1, b = bh >> 2, h = bh & 3;
    const int tid = F.tid, lane = F.lane, ri = lane >> 4, cs = lane & 15, row = 4 * F.wave + ri;
    const bool stager = true;
    const unsigned char* Rs = F.ws + WS_RS + (size_t)bh * SEQ * RS_REC;
    const unsigned char* Rd = F.ws + WS_RD + dir * RD_DIR + (size_t)bh * SEQ * RD_REC;
    LAS unsigned char* lds = F.lds + RING_OFF;
    const int ss = tid >> 4, sp = tid & 15;
    u64_t g_kk = 0, g_r = 0, g_lam = 0, g_b = 0, g_k = 0, g_v = 0, g_s = 0;
#define RW_ISSUE(c_) do { const int n_ = (c_) * RW_CH + ss, t_ = dir ? SEQ - 1 - n_ : n_; const unsigned char* rs_ = Rs + (size_t)t_ * RS_REC; const unsigned char* rd_ = Rd + (size_t)t_ * RD_REC; \
        g_kk = *(const u64_t*)(rs_ + 8 * sp); g_r = *(const u64_t*)(rs_ + 256 + 8 * sp); g_lam = *(const u64_t*)(rd_ + 8 * sp); g_b = *(const u64_t*)(rd_ + 128 + 8 * sp); g_k = *(const u64_t*)(rd_ + 256 + 8 * sp); \
        if (sp < 8) g_v = *(const u64_t*)(rs_ + 128 + 64 * rowhalf + 8 * sp); if (sp == 8) g_s = *(const u64_t*)(rd_ + 384); } while (0)
#define RW_BF(x, j) __uint_as_float(((unsigned)((x) >> (16 * (j)))) << 16)
#define RW_STAGE(buf_) do { LAS unsigned char* d_ = lds + (buf_) * RW_BUF + ss * RW_STEP + 16 * sp; f32x4 w_, t4_; \
        w_[0] = __builtin_amdgcn_exp2f(-LOG2E * __half2float(__ushort_as_half((unsigned short)(g_lam)))); w_[1] = __builtin_amdgcn_exp2f(-LOG2E * __half2float(__ushort_as_half((unsigned short)(g_lam >> 16)))); \
        w_[2] = __builtin_amdgcn_exp2f(-LOG2E * __half2float(__ushort_as_half((unsigned short)(g_lam >> 32)))); w_[3] = __builtin_amdgcn_exp2f(-LOG2E * __half2float(__ushort_as_half((unsigned short)(g_lam >> 48)))); \
        *(LAS f32x4*)d_ = w_; \
        t4_ = (f32x4){RW_BF(g_r, 0), RW_BF(g_r, 1), RW_BF(g_r, 2), RW_BF(g_r, 3)}; *(LAS f32x4*)(d_ + 256) = w_ * t4_; \
        t4_ = (f32x4){RW_BF(g_kk, 0), RW_BF(g_kk, 1), RW_BF(g_kk, 2), RW_BF(g_kk, 3)}; *(LAS f32x4*)(d_ + 512) = -t4_; \
        t4_ = (f32x4){RW_BF(g_b, 0), RW_BF(g_b, 1), RW_BF(g_b, 2), RW_BF(g_b, 3)}; *(LAS f32x4*)(d_ + 768) = t4_; \
        t4_ = (f32x4){RW_BF(g_k, 0), RW_BF(g_k, 1), RW_BF(g_k, 2), RW_BF(g_k, 3)}; *(LAS f32x4*)(d_ + 1024) = t4_; \
        if (sp < 8) { t4_ = (f32x4){RW_BF(g_v, 0), RW_BF(g_v, 1), RW_BF(g_v, 2), RW_BF(g_v, 3)}; *(LAS f32x4*)(d_ + 1280) = t4_; } \
        if (sp == 8) *(LAS u64_t*)(lds + (buf_) * RW_BUF + ss * RW_STEP + 1408) = g_s; } while (0)
    f32x4 S0 = {0.f, 0.f, 0.f, 0.f};
    if (stager) { RW_ISSUE(0); RW_STAGE(0); }
    __syncthreads();
    bf16* Yg = (bf16*)(F.ws + WS_Y) + (size_t)b * SEQ * 256 + h * 64 + 32 * rowhalf;
    const int NCH = SEQ / RW_CH;
    for (int c = 0; c < NCH; ++c) {
        LAS float* ybuf = (LAS float*)(lds + RW_Y + (c & 1) * 4096);
        if (stager && c + 1 < NCH) RW_ISSUE(c + 1);
        unsigned short yold[2] = {0, 0};
        if (c >= NCH / 2) {
#pragma unroll
            for (int k = 0; k < 2; ++k) { const int o = tid + 512 * k, n = c * RW_CH + (o >> 5), t = dir ? SEQ - 1 - n : n; yold[k] = Yg[(size_t)t * 256 + (o & 31)]; } }
        { const LAS unsigned char* cb_ = lds + (c & 1) * RW_BUF + 16 * cs;
          const LAS unsigned char* vb_ = lds + (c & 1) * RW_BUF + 1280 + 4 * row;
#pragma unroll 4
          for (int s = 0; s < RW_CH; ++s) {
              const LAS unsigned char* p = cb_ + s * RW_STEP;
              const f32x4 w = *(const LAS f32x4*)p, wr = *(const LAS f32x4*)(p + 256), nk = *(const LAS f32x4*)(p + 512), bb = *(const LAS f32x4*)(p + 768), kv = *(const LAS f32x4*)(p + 1024);
              typedef float f2 __attribute__((ext_vector_type(2)));
              const float v = *(const LAS float*)(vb_ + s * RW_STEP); const f2 brkr = *(const LAS f2*)(lds + (c & 1) * RW_BUF + s * RW_STEP + 1408);
              float sa0 = (S0[0] * nk[0] + S0[1] * nk[1]) + (S0[2] * nk[2] + S0[3] * nk[3]);
              float ym0 = (S0[0] * wr[0] + S0[1] * wr[1]) + (S0[2] * wr[2] + S0[3] * wr[3]);
              sa0 += dpp_xor1(sa0); ym0 += dpp_xor1(ym0);
              sa0 += dpp_xor2(sa0); ym0 += dpp_xor2(ym0);
              sa0 += dpp_hmir(sa0); ym0 += dpp_hmir(ym0);
              sa0 += dpp_rmir(sa0); ym0 += dpp_rmir(ym0);
              S0 = S0 * w + (sa0 * bb + v * kv);
              if (cs == 0) ybuf[s * 32 + row] = ym0 + sa0 * brkr[0] + v * brkr[1];
          } }
        if (stager && c + 1 < NCH) RW_STAGE((c + 1) & 1);
        __syncthreads();
#pragma unroll
        for (int k = 0; k < 2; ++k) { const int o = tid + 512 * k, n = c * RW_CH + (o >> 5), t = dir ? SEQ - 1 - n : n;
            float y = ybuf[o]; if (c >= NCH / 2) y += bf2f(yold[k]);
            Yg[(size_t)t * 256 + (o & 31)] = (bf16)f2bf(y); }
        if (c == NCH / 2 - 1) partner_sync(F, flags + 64 * unit, flags + 64 * (unit ^ 1));
    }
#undef RW_ISSUE
#undef RW_STAGE
#undef RW_BF
    __syncthreads();
}

__device__ __forceinline__ void gdn_unit(Frame& F, int l, int unit) {
    const int bh = unit, b = bh / 6, h = bh % 6, e = F.lane, dir = F.wave;
    const bf16* Pgdn = (const bf16*)(F.ws + WS_PGDN); const float* Psm = (const float*)(F.ws + WS_PSM); bf16* Ogdn = (bf16*)(F.ws + WS_OGDN);
    const float* conv_w = (const float*)inptr(F, 4) + (size_t)l * 5 * 1152; const float* a_log = (const float*)inptr(F, 5) + l * 12; const float* dt_bias = (const float*)inptr(F, 6) + l * 12;
    LAS float* qs = (LAS float*)(F.lds + RING_OFF) + F.wave * 128; LAS float* ks = qs + 64;
    if (F.wave < 2) {
        float S[64];
#pragma unroll
        for (int i = 0; i < 64; ++i) S[i] = 0.f;
        float cw[3][5];
#pragma unroll
        for (int i = 0; i < 5; ++i) { cw[0][i] = conv_w[i * 1152 + h * 64 + e]; cw[1][i] = conv_w[i * 1152 + 384 + h * 64 + e]; cw[2][i] = conv_w[i * 1152 + 768 + h * 64 + e]; }
        const float al = -__expf(a_log[dir * 6 + h]), dtb = dt_bias[dir * 6 + h];
        for (int n = 0; n < SEQ; ++n) {
            if (n == SEQ / 2) { asm volatile("s_waitcnt vmcnt(0)" ::: "memory"); __syncthreads(); }
            const int t = dir ? SEQ - 1 - n : n; const size_t m = (size_t)b * SEQ + t;
            float cq = 0.f, ck = 0.f, cv = 0.f;
#pragma unroll
            for (int i = 0; i < 5; ++i) { const int tt = t + i - 2; if (tt >= 0 && tt < SEQ) { const bf16* pr = Pgdn + ((size_t)b * SEQ + tt) * 1152 + h * 64 + e;
                    cq += cw[0][i] * bf2f(pr[0]); ck += cw[1][i] * bf2f(pr[384]); cv += cw[2][i] * bf2f(pr[768]); } }
            cq = siluf(cq); ck = siluf(ck); cv = siluf(cv);
            const float qn = cq * rsqrtf(wave_sum(cq * cq) + 1e-6f) * 0.125f, kn = ck * rsqrtf(wave_sum(ck * ck) + 1e-6f);
            LDS_WAIT(); asm volatile("" ::: "memory");
            qs[e] = qn; ks[e] = kn;
            LDS_WAIT(); asm volatile("" ::: "memory");
            const float g = al * softplusf_(Psm[m * 32 + dir * 6 + h] + dtb), beta = sigmoidf_(Psm[m * 32 + 12 + dir * 6 + h]), alpha = __expf(g);
            float kS = 0.f;
#pragma unroll
            for (int c4 = 0; c4 < 16; ++c4) { const f32x4 kq = ((const LAS f32x4*)ks)[c4];
                kS += (kq.x * S[4 * c4] + kq.y * S[4 * c4 + 1]) + (kq.z * S[4 * c4 + 2] + kq.w * S[4 * c4 + 3]);
                if ((c4 & 3) == 3) asm volatile("" ::: "memory"); }
            const float coef = beta * (cv - alpha * kS);
            float o = 0.f;
#pragma unroll
            for (int c4 = 0; c4 < 16; ++c4) { const f32x4 kq = ((const LAS f32x4*)ks)[c4], qq = ((const LAS f32x4*)qs)[c4];
                S[4 * c4] = alpha * S[4 * c4] + coef * kq.x; S[4 * c4 + 1] = alpha * S[4 * c4 + 1] + coef * kq.y; S[4 * c4 + 2] = alpha * S[4 * c4 + 2] + coef * kq.z; S[4 * c4 + 3] = alpha * S[4 * c4 + 3] + coef * kq.w;
                o += (qq.x * S[4 * c4] + qq.y * S[4 * c4 + 1]) + (qq.z * S[4 * c4 + 2] + qq.w * S[4 * c4 + 3]);
                if ((c4 & 3) == 3) asm volatile("" ::: "memory"); }
            bf16* op = Ogdn + m * 384 + h * 64 + e;
            if (n >= SEQ / 2) o += bf2f(*op);
            *op = (bf16)f2bf(o);
        }
    } else { __syncthreads(); }
}

constexpr int GP = 144;
constexpr int G_Q = 0, G_K = 9216, G_V = 18432, G_KT = 27648, G_P = 36864, G_A = 46080, G_SM = 63488, G_GROUP = 64512;
constexpr int G_RAW = 65536;
constexpr int G_CW = 133120;
static_assert(2 * G_GROUP <= RING_BYTES && G_CW + 3840 <= LDS_BYTES && G_CW >= MISC_OFF + 1024, "GDN LDS map");
__device__ __forceinline__ bf16x8 ld2x8(const LAS unsigned char* p) { return mk_bf16x8(*(const LAS u64_t*)p, *(const LAS u64_t*)(p + 32)); }
__device__ __forceinline__ bf16x8 pack_acc(const f32x4& a, const f32x4& b) {
    v4u w; w.x = pg8::cvt_pk_bf16(a[0], a[1]); w.y = pg8::cvt_pk_bf16(a[2], a[3]); w.z = pg8::cvt_pk_bf16(b[0], b[1]); w.w = pg8::cvt_pk_bf16(b[2], b[3]); return __builtin_bit_cast(bf16x8, w); }
__device__ __forceinline__ void split_acc(const f32x4& a, const f32x4& b, bf16x8& hi, bf16x8& lo) {
    v4u wh; wh.x = pg8::cvt_pk_bf16(a[0], a[1]); wh.y = pg8::cvt_pk_bf16(a[2], a[3]); wh.z = pg8::cvt_pk_bf16(b[0], b[1]); wh.w = pg8::cvt_pk_bf16(b[2], b[3]);
    f32x4 ra, rb;
    ra[0] = a[0] - __uint_as_float(wh.x << 16); ra[1] = a[1] - __uint_as_float(wh.x & 0xffff0000u); ra[2] = a[2] - __uint_as_float(wh.y << 16); ra[3] = a[3] - __uint_as_float(wh.y & 0xffff0000u);
    rb[0] = b[0] - __uint_as_float(wh.z << 16); rb[1] = b[1] - __uint_as_float(wh.z & 0xffff0000u); rb[2] = b[2] - __uint_as_float(wh.w << 16); rb[3] = b[3] - __uint_as_float(wh.w & 0xffff0000u);
    hi = __builtin_bit_cast(bf16x8, wh); lo = pack_acc(ra, rb);
}
typedef _Float16 f16x8 __attribute__((ext_vector_type(8)));
__device__ __forceinline__ f16x8 pack_acc_f16(const f32x4& a, const f32x4& b) { return (f16x8){(_Float16)a[0], (_Float16)a[1], (_Float16)a[2], (_Float16)a[3], (_Float16)b[0], (_Float16)b[1], (_Float16)b[2], (_Float16)b[3]}; }
template <int SKIP> __device__ __forceinline__ void gdn_unit3(Frame& F, int l, int unit, gu32* flags) {
    const int bh = unit >> 1, dir = unit & 1, b = bh / 6, h = bh % 6;
    const int tid = F.tid, lane = F.lane, wave = F.wave;
    const bf16* Pgdn = (const bf16*)(F.ws + WS_PGDN) + (size_t)b * SEQ * 1152 + h * 64; const float* Psm = (const float*)(F.ws + WS_PSM) + (size_t)b * SEQ * 32;
    bf16* Og = (bf16*)(F.ws + WS_OGDN) + (size_t)b * SEQ * 384 + h * 64;
    LAS unsigned char* gb = F.lds + RING_OFF;
    LAS float* cwl = (LAS float*)(F.lds + G_CW);
    LAS float* sm = (LAS float*)(gb + G_SM);
    { const float* conv_w = (const float*)inptr(F, 4) + (size_t)l * 5 * 1152;
      for (int i = tid; i < 960; i += 512) { const int tn = i / 320, tap = (i % 320) / 64, ch = i % 64; cwl[i] = conv_w[tap * 1152 + tn * 384 + h * 64 + ch]; } }
    const float al = -__expf(((const float*)inptr(F, 5))[l * 12 + dir * 6 + h]), dtb = ((const float*)inptr(F, 6))[l * 12 + dir * 6 + h];
    f32x4 Sacc[4];
#pragma unroll
    for (int i = 0; i < 4; ++i) Sacc[i] = (f32x4){0.f, 0.f, 0.f, 0.f};
    const int ci = tid >> 3, cg = tid & 7;
#define GDN_RAW_STAGE(cc_, first_, nthr_) do { const int tlo_ = (dir ? SEQ - 64 * (cc_) - 64 : 64 * (cc_)) - 2; \
        for (int pc_ = (first_); pc_ < 68 * 24; pc_ += (nthr_)) { const int rr_ = pc_ / 24, sg_ = pc_ % 24, tt_ = tlo_ + rr_; v4u x_ = {0u, 0u, 0u, 0u}; \
            if (!(SKIP & 1) && tt_ >= 0 && tt_ < SEQ) x_ = *(const v4u*)(Pgdn + (size_t)tt_ * 1152 + (sg_ >> 3) * 384 + 8 * (sg_ & 7)); \
            *(LAS v4u*)(gb + G_RAW + rr_ * 384 + 16 * sg_) = x_; } } while (0)
#define GDN_WRITEOUT(cc_) do { if (!(SKIP & 4)) { const int t_ = dir ? SEQ - 1 - 64 * (cc_) - ci : 64 * (cc_) + ci; bf16* op_ = Og + (size_t)t_ * 384 + 8 * cg; \
            const LAS f32x4* src_ = (const LAS f32x4*)(gb + G_A + (ci * 68 + 8 * cg) * 4); f32x4 o0_ = src_[0], o1_ = src_[1]; \
            if ((cc_) >= SEQ / 128) { const v4u p0_ = *(const v4u*)op_; \
                o0_ += (f32x4){__uint_as_float(p0_.x << 16), __uint_as_float(p0_.x & 0xffff0000u), __uint_as_float(p0_.y << 16), __uint_as_float(p0_.y & 0xffff0000u)}; \
                o1_ += (f32x4){__uint_as_float(p0_.z << 16), __uint_as_float(p0_.z & 0xffff0000u), __uint_as_float(p0_.w << 16), __uint_as_float(p0_.w & 0xffff0000u)}; } \
            v4u w0_; w0_.x = pg8::cvt_pk_bf16(o0_[0], o0_[1]); w0_.y = pg8::cvt_pk_bf16(o0_[2], o0_[3]); w0_.z = pg8::cvt_pk_bf16(o1_[0], o1_[1]); w0_.w = pg8::cvt_pk_bf16(o1_[2], o1_[3]); \
            *(v4u*)op_ = w0_; } } while (0)
    GDN_RAW_STAGE(0, tid, 512);
    __syncthreads();
    for (int c = 0; c < SEQ / 64; ++c) {
        if (c > 0) GDN_WRITEOUT(c - 1);
        if (c == SEQ / 128) partner_sync(F, flags + 64 * unit, flags + 64 * (unit ^ 1));
        if (wave == 0) {
            const int t = dir ? SEQ - 1 - 64 * c - lane : 64 * c + lane;
            const float a = Psm[(size_t)t * 32 + dir * 6 + h], bt = Psm[(size_t)t * 32 + 12 + dir * 6 + h];
            float x = al * softplusf_(a + dtb);
#pragma unroll
            for (int off = 1; off < 64; off <<= 1) { const float y = __shfl_up(x, off); if (lane >= off) x += y; }
            const float last = __shfl(x, 63);
            sm[lane] = x; sm[64 + lane] = sigmoidf_(bt); sm[128 + lane] = __expf(x); sm[192 + lane] = __expf(last - x);
        }
        { float acc[3][8];
#pragma unroll
          for (int tn = 0; tn < 3; ++tn)
#pragma unroll
              for (int j = 0; j < 8; ++j) acc[tn][j] = 0.f;
          const int rr0 = dir ? 63 - ci : ci;
#pragma unroll
          for (int tap = 0; tap < 5; ++tap) {
#pragma unroll
              for (int tn = 0; tn < 3; ++tn) { const v4u x0 = *(const LAS v4u*)(gb + G_RAW + (rr0 + tap) * 384 + tn * 128 + 16 * cg); const LAS float* w = cwl + tn * 320 + tap * 64 + 8 * cg; const f32x4 w0 = *(const LAS f32x4*)w, w1 = *(const LAS f32x4*)(w + 4);
                  acc[tn][0] += w0[0] * __uint_as_float(x0[0] << 16); acc[tn][1] += w0[1] * __uint_as_float(x0[0] & 0xffff0000u); acc[tn][2] += w0[2] * __uint_as_float(x0[1] << 16); acc[tn][3] += w0[3] * __uint_as_float(x0[1] & 0xffff0000u);
                  acc[tn][4] += w1[0] * __uint_as_float(x0[2] << 16); acc[tn][5] += w1[1] * __uint_as_float(x0[2] & 0xffff0000u); acc[tn][6] += w1[2] * __uint_as_float(x0[3] << 16); acc[tn][7] += w1[3] * __uint_as_float(x0[3] & 0xffff0000u); }
              asm volatile("" ::: "memory"); }
          float sq = 0.f, sk = 0.f;
#pragma unroll
          for (int j = 0; j < 8; ++j) { acc[0][j] = siluf(acc[0][j]); acc[1][j] = siluf(acc[1][j]); acc[2][j] = siluf(acc[2][j]); sq += acc[0][j] * acc[0][j]; sk += acc[1][j] * acc[1][j]; }
          sq += dpp_xor1(sq); sk += dpp_xor1(sk); sq += dpp_xor2(sq); sk += dpp_xor2(sk); sq += dpp_hmir(sq); sk += dpp_hmir(sk);
          const float rq = rsqrtf(sq + 1e-6f) * 0.125f, rk = rsqrtf(sk + 1e-6f);
          v4u wq, wk, wv;
#pragma unroll
          for (int q = 0; q < 4; ++q) { wq[q] = pg8::cvt_pk_bf16(acc[0][2 * q] * rq, acc[0][2 * q + 1] * rq); wk[q] = pg8::cvt_pk_bf16(acc[1][2 * q] * rk, acc[1][2 * q + 1] * rk); wv[q] = pg8::cvt_pk_bf16(acc[2][2 * q], acc[2][2 * q + 1]); }
          LAS unsigned char* row = gb + ci * GP + 16 * cg;
          *(LAS v4u*)(row + G_Q) = wq; *(LAS v4u*)(row + G_K) = wk; *(LAS v4u*)(row + G_V) = wv;
#pragma unroll
          for (int j = 0; j < 8; ++j) *(LAS bf16*)(gb + G_KT + (8 * cg + j) * GP + 2 * ci) = (bf16)((j & 1) ? (wk[j >> 1] >> 16) : (wk[j >> 1] & 0xffffu)); }
        __syncthreads();
        { const int ti = (wave >> 1) & 1, tj = wave & 1, r32 = lane & 31, hi = lane >> 5; const bool isP = wave >= 4;
          f32x16 acc = {};
          const LAS unsigned char* ar = gb + (isP ? G_Q : G_K) + (32 * ti + r32) * GP + 16 * hi; const LAS unsigned char* br = gb + G_K + (32 * tj + r32) * GP + 16 * hi;
#pragma unroll
          for (int s = 0; s < 4; ++s) acc = __builtin_amdgcn_mfma_f32_32x32x16_bf16(*(const LAS bf16x8*)(ar + 32 * s), *(const LAS bf16x8*)(br + 32 * s), acc, 0, 0, 0);
          const int j = 32 * tj + r32; const float cj = sm[j];
#pragma unroll
          for (int r = 0; r < 16; ++r) { const int i = 32 * ti + (r & 3) + 8 * (r >> 2) + 4 * hi;
              const float dl = __expf(fminf(sm[i] - cj, 0.f));
              if (!isP) ((LAS float*)(gb + G_A))[i * 68 + j] = (i > j) ? sm[64 + i] * acc[r] * dl : 0.f;
              else *(LAS _Float16*)(gb + G_P + i * GP + 2 * j) = (_Float16)((i >= j) ? acc[r] * dl : 0.f); } }
        __syncthreads();
        f32x4 Xq[4];
#pragma unroll
        for (int g = 0; g < 4; ++g) Xq[g] = (f32x4){0.f, 0.f, 0.f, 0.f};
        if (!(SKIP & 2)) {
            const int cc = tid >> 2, p = tid & 3; const LAS unsigned char* src = gb + (cc < 64 ? G_V : G_K) + 2 * (cc & 63);
            float xm1 = 0.f, xm2 = 0.f, xm3 = 0.f;
#pragma unroll
            for (int i = 0; i < 64; ++i) {
                unsigned z = 0u; if (i >= 3) asm("v_and_b32 %0, 0, %1" : "=v"(z) : "v"(xm3));
                const LAS unsigned char* arow = gb + G_A + z + i * 272 + 16 * p;
                const float rhs = bf2f(*(const LAS bf16*)(src + i * GP)) * sm[64 + i] * (cc < 64 ? 1.f : sm[128 + i]);
                float a0 = 0.f, a1 = 0.f;
#pragma unroll
                for (int g = 0; g < (i + 3) / 4; g += 4) { const f32x4 av = *(const LAS f32x4*)(arow + 16 * g);
                    a0 += av.x * Xq[g >> 2][0] + av.z * Xq[g >> 2][2]; a1 += av.y * Xq[g >> 2][1] + av.w * Xq[g >> 2][3]; }
                float part = a0 + a1; part += dpp_xor1(part); part += dpp_xor2(part);
                const float xi = rhs - part;
                Xq[i >> 4][i & 3] = (p == ((i >> 2) & 3)) ? xi : Xq[i >> 4][i & 3];
                xm3 = xm2; xm2 = xm1; xm1 = xi;
            }
        }
        __syncthreads();
        { const int cc = tid >> 2, p = tid & 3;
          if (cc < 64) {
#pragma unroll
              for (int g = 0; g < 4; ++g)
#pragma unroll
                  for (int r = 0; r < 4; ++r) ((LAS float*)(gb + G_A))[(16 * g + 4 * p + r) * 68 + cc] = Xq[g][r];
          } else {
#pragma unroll
              for (int g = 0; g < 4; ++g)
#pragma unroll
                  for (int r = 0; r < 4; ++r) { const int i = 16 * g + 4 * p + r; const float x = -Xq[g][r]; const unsigned hb = f2bf(x);
                      *(LAS bf16*)(gb + G_V + i * GP + 2 * (cc - 64)) = (bf16)hb;
                      *(LAS bf16*)(gb + G_K + i * GP + 2 * (cc - 64)) = (bf16)f2bf(x - __uint_as_float(hb << 16)); }
          } }
        __syncthreads();
        if (wave < 4) { const int col = lane & 15, q4 = lane >> 4, e = 16 * wave + col;
          bf16x8 bS0, bS1, bS0l, bS1l; split_acc(Sacc[0], Sacc[1], bS0, bS0l); split_acc(Sacc[2], Sacc[3], bS1, bS1l);
          f32x4 U[4], T1[4];
          const LAS unsigned char* rowa = gb + col * GP + 8 * q4;
#pragma unroll
          for (int it = 0; it < 4; ++it) {
              const LAS float* u0p = (const LAS float*)(gb + G_A) + (16 * it + 4 * q4) * 68 + e;
              U[it] = (f32x4){u0p[0], u0p[68], u0p[136], u0p[204]};
              const LAS unsigned char* ra = rowa + 16 * it * GP;
              const bf16x8 wh0 = ld2x8(ra + G_V), wh1 = ld2x8(ra + G_V + 64), wl0 = ld2x8(ra + G_K), wl1 = ld2x8(ra + G_K + 64), qa0 = ld2x8(ra + G_Q), qa1 = ld2x8(ra + G_Q + 64);
              U[it] = __builtin_amdgcn_mfma_f32_16x16x32_bf16(wl0, bS0, U[it], 0, 0, 0);
              U[it] = __builtin_amdgcn_mfma_f32_16x16x32_bf16(wl1, bS1, U[it], 0, 0, 0);
              U[it] = __builtin_amdgcn_mfma_f32_16x16x32_bf16(wh0, bS0l, U[it], 0, 0, 0);
              U[it] = __builtin_amdgcn_mfma_f32_16x16x32_bf16(wh1, bS1l, U[it], 0, 0, 0);
              U[it] = __builtin_amdgcn_mfma_f32_16x16x32_bf16(wh0, bS0, U[it], 0, 0, 0);
              U[it] = __builtin_amdgcn_mfma_f32_16x16x32_bf16(wh1, bS1, U[it], 0, 0, 0);
              T1[it] = __builtin_amdgcn_mfma_f32_16x16x32_bf16(qa0, bS0l, (f32x4){0.f, 0.f, 0.f, 0.f}, 0, 0, 0);
              T1[it] = __builtin_amdgcn_mfma_f32_16x16x32_bf16(qa1, bS1l, T1[it], 0, 0, 0);
              T1[it] = __builtin_amdgcn_mfma_f32_16x16x32_bf16(qa0, bS0, T1[it], 0, 0, 0);
              T1[it] = __builtin_amdgcn_mfma_f32_16x16x32_bf16(qa1, bS1, T1[it], 0, 0, 0);
              asm volatile("" ::: "memory");
          }
          const f16x8 hU0 = pack_acc_f16(U[0], U[1]), hU1 = pack_acc_f16(U[2], U[3]);
          f32x4 Ud[4];
#pragma unroll
          for (int it = 0; it < 4; ++it) { const f32x4 dc = *(const LAS f32x4*)(sm + 192 + 16 * it + 4 * q4); Ud[it] = U[it] * dc; }
          bf16x8 bD0, bD1, bD0l, bD1l; split_acc(Ud[0], Ud[1], bD0, bD0l); split_acc(Ud[2], Ud[3], bD1, bD1l);
          const float gend = sm[191];
#pragma unroll
          for (int it = 0; it < 4; ++it) {
              const LAS unsigned char* ra = rowa + 16 * it * GP;
              const f32x4 gm = *(const LAS f32x4*)(sm + 128 + 16 * it + 4 * q4);
              const bf16x8 pa0 = ld2x8(ra + G_P), pa1 = ld2x8(ra + G_P + 64), ka0 = ld2x8(ra + G_KT), ka1 = ld2x8(ra + G_KT + 64);
              f32x4 O = T1[it] * gm;
              O = __builtin_amdgcn_mfma_f32_16x16x32_f16(__builtin_bit_cast(f16x8, pa0), hU0, O, 0, 0, 0);
              O = __builtin_amdgcn_mfma_f32_16x16x32_f16(__builtin_bit_cast(f16x8, pa1), hU1, O, 0, 0, 0);
              f32x4 Sn = Sacc[it] * gend;
              Sn = __builtin_amdgcn_mfma_f32_16x16x32_bf16(ka0, bD0l, Sn, 0, 0, 0);
              Sn = __builtin_amdgcn_mfma_f32_16x16x32_bf16(ka1, bD1l, Sn, 0, 0, 0);
              Sn = __builtin_amdgcn_mfma_f32_16x16x32_bf16(ka0, bD0, Sn, 0, 0, 0);
              Sn = __builtin_amdgcn_mfma_f32_16x16x32_bf16(ka1, bD1, Sn, 0, 0, 0);
              Sacc[it] = Sn;
#pragma unroll
              for (int r = 0; r < 4; ++r) ((LAS float*)(gb + G_A))[(16 * it + 4 * q4 + r) * 68 + e] = O[r];
              asm volatile("" ::: "memory");
          } }
        else if (c + 1 < SEQ / 64) GDN_RAW_STAGE(c + 1, tid - 256, 256);
        __syncthreads();
    }
    GDN_WRITEOUT(SEQ / 64 - 1);
#undef GDN_WRITEOUT
#undef GDN_RAW_STAGE
    __syncthreads();
}
__device__ __forceinline__ int next_unit(Frame& F, gu32* head) {
    __syncthreads();
    if (F.tid == 0) F.MISC[16] = __hip_atomic_fetch_add(head, 1u, RLX_AGENT);
    __syncthreads();
    return (int)F.MISC[16];
}
constexpr int U_GDN = 96, U_RWKV = 128, U_ATT = 384, U_ALL = U_GDN + U_RWKV + U_ATT;
__device__ __forceinline__ void p3_mixers(Frame& F, int l, int rep) {
    gu32* head = F.ctl + CW_QUEUE + 64 * (2 * l + rep);
    for (;;) {
        const int u = next_unit(F, head);
        if (u >= U_ALL) break;
        asm volatile("" : "+v"(F.tid), "+v"(F.lane));
        if (u < U_GDN) gdn_unit3<0>(F, l, u, F.ctl + CW_FLAG + 64 * 256 * (2 * l + rep) + 64 * 128);
        else if (u < U_GDN + U_RWKV) rwkv_unit(F, u - U_GDN, F.ctl + CW_FLAG + 64 * 256 * (2 * l + rep));
        else attn_unit(F, u - U_GDN - U_RWKV);
    }
}
__device__ __forceinline__ f32x4 bf4(u64_t x) { return (f32x4){__uint_as_float(((unsigned)x) << 16), __uint_as_float(((unsigned)x) & 0xffff0000u), __uint_as_float(((unsigned)(x >> 32)) << 16), __uint_as_float(((unsigned)(x >> 32)) & 0xffff0000u)}; }
__device__ __forceinline__ u64_t pk4(const f32x4& v) { return (u64_t)pg8::cvt_pk_bf16(v[0], v[1]) | ((u64_t)pg8::cvt_pk_bf16(v[2], v[3]) << 32); }
__device__ __forceinline__ void p2_mla_unit(Frame& F, int l, int unit) {
    const int lane = F.lane, col = lane & 15, q4 = lane >> 4, m = 16 * unit + col, b = m / SEQ, t = m % SEQ, t0 = (16 * unit) % SEQ;
    const bf16* prow = (const bf16*)(F.ws + WS_PMLA) + (size_t)m * 352;
    const bf16* WuqT = (const bf16*)(F.ws + WS_WSMALL + OFF_WUQ) + (size_t)l * 576 * 192 + (size_t)col * 192 + 8 * q4;
    const bf16* WukvT = (const bf16*)(F.ws + WS_WSMALL + OFF_WUKV) + (size_t)l * 768 * 128 + (size_t)col * 128 + 8 * q4;
    bf16x8 aq[6], akv[4]; float sq = 0.f, skv = 0.f;
#pragma unroll
    for (int s = 0; s < 6; ++s) { aq[s] = *(const bf16x8*)(prow + 32 * s + 8 * q4); const v4u u = __builtin_bit_cast(v4u, aq[s]);
#pragma unroll
        for (int i = 0; i < 4; ++i) { const float a = __uint_as_float(u[i] << 16), c = __uint_as_float(u[i] & 0xffff0000u); sq += a * a + c * c; } }
#pragma unroll
    for (int s = 0; s < 4; ++s) { akv[s] = *(const bf16x8*)(prow + 192 + 32 * s + 8 * q4); const v4u u = __builtin_bit_cast(v4u, akv[s]);
#pragma unroll
        for (int i = 0; i < 4; ++i) { const float a = __uint_as_float(u[i] << 16), c = __uint_as_float(u[i] & 0xffff0000u); skv += a * a + c * c; } }
    sq += __shfl_xor(sq, 16); sq += __shfl_xor(sq, 32); skv += __shfl_xor(skv, 16); skv += __shfl_xor(skv, 32);
    const float rq = rsqrtf(sq * (1.f / 192.f) + NORM_EPS) * (0.10206207261596575f * LOG2E), rkv = rsqrtf(skv * (1.f / 128.f) + NORM_EPS);
    const float pos = (float)((const int*)inptr(F, 1))[m];
    f32x4 cs, sn;
#pragma unroll
    for (int r = 0; r < 4; ++r) { const float inv = exp2f(-(float)(4 * q4 + r) * (13.287712379549449f / 16.f)); float s_, c_; sincosf(pos * inv, &s_, &c_); cs[r] = c_; sn[r] = s_; }
    bf16* Qo = (bf16*)(F.ws + WS_Q) + ((size_t)b * 6 * SEQ + t) * 96 + 4 * q4;
    bf16* Ko = (bf16*)(F.ws + WS_K) + ((size_t)b * 6 * SEQ + t) * 96 + 4 * q4;
    bf16* Vo = (bf16*)(F.ws + WS_VT) + (size_t)b * 6 * 64 * SEQ + (size_t)col * SEQ + t0 + 4 * q4;
    { const u64_t x1 = *(const u64_t*)(prow + 320 + 4 * q4), x2 = *(const u64_t*)(prow + 336 + 4 * q4); const f32x4 a = bf4(x1), c = bf4(x2);
      const u64_t o1 = pk4(a * cs - c * sn), o2 = pk4(c * cs + a * sn);
#pragma unroll
      for (int h = 0; h < 6; ++h) { *(u64_t*)(Ko + (size_t)h * SEQ * 96 + 64) = o1; *(u64_t*)(Ko + (size_t)h * SEQ * 96 + 80) = o2; } }
#pragma unroll 1
    for (int h = 0; h < 6; ++h) {
        f32x4 x1v = {0.f, 0.f, 0.f, 0.f};
#pragma unroll
        for (int nt = 0; nt < 6; ++nt) {
            const bf16* w = WuqT + (size_t)(h * 96 + 16 * nt) * 192; f32x4 acc = {0.f, 0.f, 0.f, 0.f};
#pragma unroll
            for (int s = 0; s < 6; ++s) acc = __builtin_amdgcn_mfma_f32_16x16x32_bf16(*(const bf16x8*)(w + 32 * s), aq[s], acc, 0, 0, 0);
            acc = acc * rq;
            if (nt < 4) *(u64_t*)(Qo + (size_t)h * SEQ * 96 + 16 * nt) = pk4(acc);
            else if (nt == 4) x1v = acc;
            else { *(u64_t*)(Qo + (size_t)h * SEQ * 96 + 64) = pk4(x1v * cs - acc * sn); *(u64_t*)(Qo + (size_t)h * SEQ * 96 + 80) = pk4(acc * cs + x1v * sn); }
        }
#pragma unroll
        for (int nt = 0; nt < 4; ++nt) {
            const bf16* w = WukvT + (size_t)(h * 128 + 16 * nt) * 128; f32x4 acc = {0.f, 0.f, 0.f, 0.f};
#pragma unroll
            for (int s = 0; s < 4; ++s) acc = __builtin_amdgcn_mfma_f32_16x16x32_bf16(*(const bf16x8*)(w + 32 * s), akv[s], acc, 0, 0, 0);
            *(u64_t*)(Ko + (size_t)h * SEQ * 96 + 16 * nt) = pk4(acc * rkv);
        }
        f32x4 rk4;
#pragma unroll
        for (int r = 0; r < 4; ++r) rk4[r] = __shfl(rkv, 4 * q4 + r);
#pragma unroll
        for (int nt = 0; nt < 4; ++nt) {
            const bf16* w = WukvT + (size_t)(h * 128 + 64 + 16 * nt) * 128; f32x4 acc = {0.f, 0.f, 0.f, 0.f};
#pragma unroll
            for (int s = 0; s < 4; ++s) acc = __builtin_amdgcn_mfma_f32_16x16x32_bf16(akv[s], *(const bf16x8*)(w + 32 * s), acc, 0, 0, 0);
            *(u64_t*)(Vo + (size_t)(h * 64 + 16 * nt) * SEQ) = pk4(acc * rk4);
        }
    }
}
__device__ __forceinline__ f32x4 rw_shift4(const bf16* P, size_t m, int c, bool hp, bool hn, const float* mu) {
    const f32x4 x = bf4(*(const u64_t*)(P + m * 896 + c)), xp = hp ? bf4(*(const u64_t*)(P + (m - 1) * 896 + c)) : (f32x4){0.f, 0.f, 0.f, 0.f}, xn = hn ? bf4(*(const u64_t*)(P + (m + 1) * 896 + c)) : (f32x4){0.f, 0.f, 0.f, 0.f};
    const f32x4 m0 = *(const f32x4*)(mu + c), m1 = *(const f32x4*)(mu + 896 + c);
    return x + m0 * (xp - x) + m1 * (xn - x);
}
__device__ __forceinline__ void p2_rwkv_unit(Frame& F, int l, int unit, int h0, int h1) {
    const int lane = F.lane, col = lane & 15, q4 = lane >> 4, b = (16 * unit) / SEQ, t = (16 * unit) % SEQ + col; const size_t m = (size_t)16 * unit + col;
    const bool hp = t > 0, hn = t < SEQ - 1;
    const bf16* Prw = (const bf16*)(F.ws + WS_PRW);
    const float* mu = (const float*)inptr(F, 12) + l * 2 * 896;
    const bf16* W2T = (const bf16*)(F.ws + WS_WSMALL + OFF_W2T) + (size_t)l * 2 * 256 * 64 + (size_t)col * 64 + 8 * q4;
    const bf16* A2T = (const bf16*)(F.ws + WS_WSMALL + OFF_A2T) + (size_t)l * 2 * 256 * 64 + (size_t)col * 64 + 8 * q4;
    bf16x8 awd[2], aad[2];
#pragma unroll
    for (int s = 0; s < 2; ++s) { const int c = 768 + 32 * s + 8 * q4;
        f32x4 lo = rw_shift4(Prw, m, c, hp, hn, mu), hi = rw_shift4(Prw, m, c + 4, hp, hn, mu);
#pragma unroll
        for (int i = 0; i < 4; ++i) { lo[i] = 1.f - 2.f / (1.f + __expf(2.f * lo[i])); hi[i] = 1.f - 2.f / (1.f + __expf(2.f * hi[i])); }
        awd[s] = pack_acc(lo, hi);
        aad[s] = pack_acc(rw_shift4(Prw, m, c + 64, hp, hn, mu), rw_shift4(Prw, m, c + 68, hp, hn, mu)); }
#pragma unroll 1
    for (int h = h0; h < h1; ++h) {
        f32x4 k[4]; float kn = 0.f;
        { const float* k_k = (const float*)inptr(F, 17) + l * 256;
#pragma unroll
          for (int nt = 0; nt < 4; ++nt) { const int c = 64 * h + 16 * nt + 4 * q4; k[nt] = rw_shift4(Prw, m, 256 + c, hp, hn, mu);
              const f32x4 x = k[nt] * *(const f32x4*)(k_k + c); kn += (x[0] * x[0] + x[1] * x[1]) + (x[2] * x[2] + x[3] * x[3]); } }
        kn += __shfl_xor(kn, 16); kn += __shfl_xor(kn, 32);
        const float rkn = rsqrtf(kn + 1e-6f);
        float br[2] = {0.f, 0.f}, kr[2] = {0.f, 0.f}, cbv = 0.f;
        unsigned char* rs = F.ws + WS_RS + (((size_t)b * 4 + h) * SEQ + t) * RS_REC + 8 * q4;
        unsigned char* rd0 = F.ws + WS_RD + (((size_t)b * 4 + h) * SEQ + t) * RD_REC + 8 * q4;
#pragma unroll 2
        for (int nt = 0; nt < 4; ++nt) { const int c = 64 * h + 16 * nt + 4 * q4;
            const f32x4 r = rw_shift4(Prw, m, c, hp, hn, mu), v = rw_shift4(Prw, m, 512 + c, hp, hn, mu);
            const f32x4 kk = k[nt] * *(const f32x4*)((const float*)inptr(F, 17) + l * 256 + c) * rkn;
            *(u64_t*)(rs + 32 * nt) = pk4(kk); *(u64_t*)(rs + 128 + 32 * nt) = pk4(v); *(u64_t*)(rs + 256 + 32 * nt) = pk4(r);
            f32x4 ksum = {0.f, 0.f, 0.f, 0.f};
#pragma unroll
            for (int e = 0; e < 2; ++e) { const bf16* w = W2T + (size_t)(e * 256 + 64 * h + 16 * nt) * 64; const bf16* a = A2T + (size_t)(e * 256 + 64 * h + 16 * nt) * 64;
                f32x4 x = {0.f, 0.f, 0.f, 0.f}, y = {0.f, 0.f, 0.f, 0.f};
#pragma unroll
                for (int s = 0; s < 2; ++s) { x = __builtin_amdgcn_mfma_f32_16x16x32_bf16(*(const bf16x8*)(w + 32 * s), awd[s], x, 0, 0, 0); y = __builtin_amdgcn_mfma_f32_16x16x32_bf16(*(const bf16x8*)(a + 32 * s), aad[s], y, 0, 0, 0); }
                const f32x4 w0v = *(const f32x4*)((const float*)inptr(F, 13) + l * 512 + e * 256 + c), a0v = *(const f32x4*)((const float*)inptr(F, 15) + l * 512 + e * 256 + c), kav = *(const f32x4*)((const float*)inptr(F, 18) + l * 256 + c);
                f32x4 lam, av;
#pragma unroll
                for (int i = 0; i < 4; ++i) { lam[i] = 0.6065306597126334f * sigmoidf_(w0v[i] + x[i]); av[i] = sigmoidf_(a0v[i] + y[i]); }
                const f32x4 km = k[nt] * (1.f + (av - 1.f) * kav), bb = av * kk;
                ksum += km;
                br[e] += (bb[0] * r[0] + bb[1] * r[1]) + (bb[2] * r[2] + bb[3] * r[3]); kr[e] += (km[0] * r[0] + km[1] * r[1]) + (km[2] * r[2] + km[3] * r[3]);
                typedef _Float16 h4 __attribute__((ext_vector_type(4)));
                const h4 lh = {(_Float16)lam[0], (_Float16)lam[1], (_Float16)lam[2], (_Float16)lam[3]};
                unsigned char* rd = rd0 + e * RD_DIR;
                *(u64_t*)(rd + 32 * nt) = __builtin_bit_cast(u64_t, lh); *(u64_t*)(rd + 128 + 32 * nt) = pk4(bb); *(u64_t*)(rd + 256 + 32 * nt) = pk4(km); }
            const f32x4 rkv = *(const f32x4*)((const float*)inptr(F, 19) + l * 256 + c), xx = r * ksum * rkv; cbv += (xx[0] + xx[1]) + (xx[2] + xx[3]);
        }
#pragma unroll
        for (int e = 0; e < 2; ++e) { float x = br[e], y = kr[e]; x += __shfl_xor(x, 16); x += __shfl_xor(x, 32); y += __shfl_xor(y, 16); y += __shfl_xor(y, 32);
            if (q4 == 0) { typedef float f2 __attribute__((ext_vector_type(2))); *(f2*)(rd0 + e * RD_DIR + 384) = (f2){x, y}; } }
        cbv += __shfl_xor(cbv, 16); cbv += __shfl_xor(cbv, 32);
        if (q4 == 0) ((float*)(F.ws + WS_CB))[m * 4 + h] = 0.5f * cbv;
    }
}
template <int MODE> __device__ __forceinline__ void p2_prep2(Frame& F, int l) {
    const int gw = F.vcu * NWAVES + F.wave, NGW = F.G * NWAVES;
    for (int u = gw; u < 2 * (M / 16); u += NGW) { if (u & 1) { if (MODE != 1) p2_rwkv_unit(F, l, u >> 1, 0, 4); } else { if (MODE != 2) p2_mla_unit(F, l, u >> 1); } }
}
__device__ __forceinline__ void ld16(const bf16* p, f32x4 (&o)[4]) { const v4u a = *(const v4u*)p, b = *(const v4u*)(p + 8);
    o[0] = (f32x4){__uint_as_float(a.x << 16), __uint_as_float(a.x & 0xffff0000u), __uint_as_float(a.y << 16), __uint_as_float(a.y & 0xffff0000u)};
    o[1] = (f32x4){__uint_as_float(a.z << 16), __uint_as_float(a.z & 0xffff0000u), __uint_as_float(a.w << 16), __uint_as_float(a.w & 0xffff0000u)};
    o[2] = (f32x4){__uint_as_float(b.x << 16), __uint_as_float(b.x & 0xffff0000u), __uint_as_float(b.y << 16), __uint_as_float(b.y & 0xffff0000u)};
    o[3] = (f32x4){__uint_as_float(b.z << 16), __uint_as_float(b.z & 0xffff0000u), __uint_as_float(b.w << 16), __uint_as_float(b.w & 0xffff0000u)}; }
__device__ __forceinline__ void p4a_mix2(Frame& F, int l) {
    const bf16* Ogdn = (const bf16*)(F.ws + WS_OGDN); const bf16* Omla = (const bf16*)(F.ws + WS_OMLA); const bf16* Y = (const bf16*)(F.ws + WS_Y);
    const bf16* Pgate = (const bf16*)(F.ws + WS_PGATE); const unsigned char* Rs = F.ws + WS_RS; const float* cb = (const float*)(F.ws + WS_CB); bf16* mix = (bf16*)(F.ws + WS_MIX);
    const int gw = F.vcu * NWAVES + F.wave, NGW = F.G * NWAVES, lane = F.lane, g = lane >> 2, c0 = 16 * lane;
    f32x4 pg[4], pb[4];
    if (g < 6) { const float* gg = (const float*)inptr(F, 7) + l * 64 + (c0 & 63);
#pragma unroll
        for (int i = 0; i < 4; ++i) { pg[i] = *(const f32x4*)(gg + 4 * i); pb[i] = (f32x4){0.f, 0.f, 0.f, 0.f}; } }
    else if (g < 12) {
#pragma unroll
        for (int i = 0; i < 4; ++i) { pg[i] = (f32x4){1.f, 1.f, 1.f, 1.f}; pb[i] = (f32x4){0.f, 0.f, 0.f, 0.f}; } }
    else { const float* lg = (const float*)inptr(F, 20) + l * 256 + (c0 - 768); const float* lb = (const float*)inptr(F, 21) + l * 256 + (c0 - 768);
#pragma unroll
        for (int i = 0; i < 4; ++i) { pg[i] = *(const f32x4*)(lg + 4 * i); pb[i] = *(const f32x4*)(lb + 4 * i); } }
#pragma unroll 2
    for (int m = gw; m < M; m += NGW) {
        f32x4 x[4], gt[4];
        ld16(Pgate + (size_t)m * 1024 + c0, gt);
        if (g < 6) { ld16(Ogdn + (size_t)m * 384 + c0, x);
            float ss = 0.f;
#pragma unroll
            for (int i = 0; i < 4; ++i) ss += (x[i][0] * x[i][0] + x[i][1] * x[i][1]) + (x[i][2] * x[i][2] + x[i][3] * x[i][3]);
            ss += dpp_xor1(ss); ss += dpp_xor2(ss);
            const float rs = rsqrtf(ss * (1.f / 64.f) + NORM_EPS);
#pragma unroll
            for (int i = 0; i < 4; ++i) x[i] = x[i] * rs * pg[i]; }
        else if (g < 12) ld16(Omla + (size_t)m * 384 + (c0 - 384), x);
        else { const int cc = c0 - 768, h = g - 12, b = m / SEQ, t = m % SEQ; f32x4 v[4];
            ld16(Y + (size_t)m * 256 + cc, x); ld16((const bf16*)(Rs + (((size_t)b * 4 + h) * SEQ + t) * RS_REC + 128) + (cc & 63), v);
            const float cbv = cb[(size_t)m * 4 + h];
            float s1 = 0.f;
#pragma unroll
            for (int i = 0; i < 4; ++i) s1 += (x[i][0] + x[i][1]) + (x[i][2] + x[i][3]);
            s1 += dpp_xor1(s1); s1 += dpp_xor2(s1);
            const float mean = s1 * (1.f / 64.f); float s2 = 0.f;
#pragma unroll
            for (int i = 0; i < 4; ++i) { x[i] = x[i] - mean; s2 += (x[i][0] * x[i][0] + x[i][1] * x[i][1]) + (x[i][2] * x[i][2] + x[i][3] * x[i][3]); }
            s2 += dpp_xor1(s2); s2 += dpp_xor2(s2);
            const float rs = rsqrtf(s2 * (1.f / 64.f) + 64e-5f);
#pragma unroll
            for (int i = 0; i < 4; ++i) x[i] = x[i] * rs * pg[i] + pb[i] + cbv * v[i]; }
        v4u o0, o1;
#pragma unroll
        for (int i = 0; i < 4; ++i) {
#pragma unroll
            for (int j = 0; j < 4; ++j) x[i][j] = x[i][j] * siluf(gt[i][j]); }
        o0.x = pg8::cvt_pk_bf16(x[0][0], x[0][1]); o0.y = pg8::cvt_pk_bf16(x[0][2], x[0][3]); o0.z = pg8::cvt_pk_bf16(x[1][0], x[1][1]); o0.w = pg8::cvt_pk_bf16(x[1][2], x[1][3]);
        o1.x = pg8::cvt_pk_bf16(x[2][0], x[2][1]); o1.y = pg8::cvt_pk_bf16(x[2][2], x[2][3]); o1.z = pg8::cvt_pk_bf16(x[3][0], x[3][1]); o1.w = pg8::cvt_pk_bf16(x[3][2], x[3][3]);
        bf16* op = mix + (size_t)m * 1024 + c0; *(v4u*)op = o0; *(v4u*)(op + 8) = o1;
    }
}
typedef unsigned u32x4 __attribute__((ext_vector_type(4)));
__device__ __forceinline__ float dot_bf16(const bf16* a, const bf16* b, int K) {
    float acc = 0.f;
    for (int k = 0; k < K; k += 8) {
        const u32x4 av = *(const u32x4*)(a + k), bv = *(const u32x4*)(b + k);
#pragma unroll
        for (int i = 0; i < 4; ++i) {
            acc += __uint_as_float(av[i] << 16) * __uint_as_float(bv[i] << 16);
            acc += __uint_as_float(av[i] & 0xffff0000u) * __uint_as_float(bv[i] & 0xffff0000u);
        }
    }
    return acc;
}
__global__ void __launch_bounds__(64) nk_mla_prep(const bf16* Pmla, const bf16* WuqT, const bf16* WukvT, const int* positions, bf16* Q, bf16* Kb, bf16* Vt) {
    __shared__ float raw[576 + 768];
    __shared__ float rs[2];
    const int m = blockIdx.x, lane = threadIdx.x, b = m / SEQ, t = m % SEQ;
    const bf16* p = Pmla + (size_t)m * 352;
    float s1 = 0.f, s2 = 0.f;
    for (int c = lane; c < 192; c += 64) { const float v = bf2f(p[c]); s1 += v * v; }
    for (int c = lane; c < 128; c += 64) { const float v = bf2f(p[192 + c]); s2 += v * v; }
    s1 = wave_sum(s1); s2 = wave_sum(s2);
    const float rq = rsqrtf(s1 * (1.f / 192.f) + NORM_EPS), rkv = rsqrtf(s2 * (1.f / 128.f) + NORM_EPS);
    for (int c = lane; c < 576; c += 64) raw[c] = dot_bf16(p, WuqT + (size_t)c * 192, 192) * rq;
    for (int c = lane; c < 768; c += 64) raw[576 + c] = dot_bf16(p + 192, WukvT + (size_t)c * 128, 128) * rkv;
    __syncthreads();
    const float pos = (float)positions[m];
    const float qs = 0.10206207261596575f * LOG2E;
    for (int i = lane; i < 6 * 80; i += 64) {
        const int h = i / 80, j = i % 80;
        bf16* qo = Q + (((size_t)b * 6 + h) * SEQ + t) * 96;
        if (j < 64) qo[j] = f2bf(raw[h * 96 + j] * qs);
        else { const int r = j - 64; const float inv = exp2f(-(float)r * (13.287712379549449f / 16.f)); float sn, cs; sincosf(pos * inv, &sn, &cs);
            const float x1 = raw[h * 96 + 64 + r], x2 = raw[h * 96 + 80 + r];
            qo[64 + r] = f2bf((x1 * cs - x2 * sn) * qs); qo[80 + r] = f2bf((x2 * cs + x1 * sn) * qs); }
    }
    for (int i = lane; i < 6 * 64; i += 64) {
        const int h = i / 64, j = i % 64;
        Kb[(((size_t)b * 6 + h) * SEQ + t) * 96 + j] = f2bf(raw[576 + h * 128 + j]);
        Vt[(((size_t)b * 6 + h) * 64 + j) * SEQ + t] = f2bf(raw[576 + h * 128 + 64 + j]);
    }
    if (lane < 16) {
        const int r = lane; const float inv = exp2f(-(float)r * (13.287712379549449f / 16.f)); float sn, cs; sincosf(pos * inv, &sn, &cs);
        const float x1 = bf2f(p[320 + r]), x2 = bf2f(p[336 + r]);
        const bf16 o1 = f2bf(x1 * cs - x2 * sn), o2 = f2bf(x2 * cs + x1 * sn);
        for (int h = 0; h < 6; ++h) { bf16* ko = Kb + (((size_t)b * 6 + h) * SEQ + t) * 96; ko[64 + r] = o1; ko[80 + r] = o2; }
    }
}
__global__ void __launch_bounds__(256) nk_rwkv_prep(const bf16* Prw, const float* mu, const float* w0, const float* w2, const float* a0, const float* a2,
                             const float* k_k, const float* k_a, const float* r_k, unsigned char* Rs, unsigned char* Rd, float* cb) {
    __shared__ float f[896];
    const int m = blockIdx.x, c = threadIdx.x, b = m / SEQ, t = m % SEQ, h = c >> 6, j = c & 63;
    for (int i = c; i < 896; i += 256) {
        const float x = bf2f(Prw[(size_t)m * 896 + i]);
        const float xp = t > 0 ? bf2f(Prw[(size_t)(m - 1) * 896 + i]) : 0.f;
        const float xn = t < SEQ - 1 ? bf2f(Prw[(size_t)(m + 1) * 896 + i]) : 0.f;
        float v = x + mu[i] * (xp - x) + mu[896 + i] * (xn - x);
        if (i >= 768 && i < 832) v = tanhf(v);
        f[i] = v;
    }
    __syncthreads();
    const float r = f[c], k = f[256 + c], v = f[512 + c];
    const float kkr = k * k_k[c];
    const float kn = wave_sum(kkr * kkr);
    const float kk = kkr * rsqrtf(kn + 1e-6f);
    float kmod[2], bb[2], lam[2];
#pragma unroll
    for (int e = 0; e < 2; ++e) {
        float lw = 0.f, la = 0.f;
        for (int d = 0; d < 64; ++d) { lw += f[768 + d] * w2[((size_t)e * 64 + d) * 256 + c]; la += f[832 + d] * a2[((size_t)e * 64 + d) * 256 + c]; }
        const float wl = -softplusf_(-(w0[e * 256 + c] + lw)) - 0.5f;
        lam[e] = __expf(wl);
        const float a = sigmoidf_(a0[e * 256 + c] + la);
        kmod[e] = k * (1.f + (a - 1.f) * k_a[c]);
        bb[e] = a * kk;
    }
    unsigned char* rs = Rs + (((size_t)b * 4 + h) * SEQ + t) * RS_REC;
    ((bf16*)rs)[j] = f2bf(kk); ((bf16*)(rs + 128))[j] = f2bf(v); ((bf16*)(rs + 256))[j] = f2bf(r);
#pragma unroll
    for (int e = 0; e < 2; ++e) {
        unsigned char* rd = Rd + e * RD_DIR + (((size_t)b * 4 + h) * SEQ + t) * RD_REC;
        ((__half*)rd)[j] = __float2half(lam[e]); ((bf16*)(rd + 128))[j] = f2bf(bb[e]); ((bf16*)(rd + 256))[j] = f2bf(kmod[e]);
        const float br = wave_sum(bb[e] * r), kr = wave_sum(kmod[e] * r);
        if (j == 0) { ((float*)(rd + 384))[0] = br; ((float*)(rd + 384))[1] = kr; }
    }
    const float cbv = wave_sum(r * 0.5f * (kmod[0] + kmod[1]) * r_k[c]);
    if (j == 0) cb[(size_t)m * 4 + h] = cbv;
}
__global__ void __launch_bounds__(128) nk_attn(const bf16* Q, const bf16* Kb, const bf16* Vt, bf16* Omla) {
    const int bh = blockIdx.y, q = blockIdx.x * 128 + threadIdx.x, b = bh / 6, h = bh % 6;
    const bf16* qp = Q + ((size_t)bh * SEQ + q) * 96;
    float qr[96];
#pragma unroll
    for (int i = 0; i < 96; ++i) qr[i] = bf2f(qp[i]);
    float acc[64];
#pragma unroll
    for (int i = 0; i < 64; ++i) acc[i] = 0.f;
    float mx = -1e30f, l = 0.f;
    const bf16* kb = Kb + (size_t)bh * SEQ * 96; const bf16* vt = Vt + (size_t)bh * 64 * SEQ;
    for (int k0 = 0; k0 < SEQ; k0 += 8) {
        float s[8];
#pragma unroll
        for (int kk = 0; kk < 8; ++kk) {
            const bf16* kr = kb + (size_t)(k0 + kk) * 96; float a = 0.f;
#pragma unroll
            for (int d = 0; d < 96; d += 8) { const u32x4 kv = *(const u32x4*)(kr + d);
#pragma unroll
                for (int i = 0; i < 4; ++i) { a += qr[d + 2 * i] * __uint_as_float(kv[i] << 16); a += qr[d + 2 * i + 1] * __uint_as_float(kv[i] & 0xffff0000u); } }
            s[kk] = a;
        }
        float cm = s[0];
#pragma unroll
        for (int kk = 1; kk < 8; ++kk) cm = fmaxf(cm, s[kk]);
        const float mn = fmaxf(mx, cm), sc = exp2f(mx - mn);
        l *= sc;
#pragma unroll
        for (int i = 0; i < 64; ++i) acc[i] *= sc;
        mx = mn;
#pragma unroll
        for (int kk = 0; kk < 8; ++kk) { s[kk] = exp2f(s[kk] - mn); l += s[kk]; }
#pragma unroll
        for (int d = 0; d < 64; ++d) { const u32x4 vv = *(const u32x4*)(vt + (size_t)d * SEQ + k0);
#pragma unroll
            for (int i = 0; i < 4; ++i) { acc[d] += s[2 * i] * __uint_as_float(vv[i] << 16); acc[d] += s[2 * i + 1] * __uint_as_float(vv[i] & 0xffff0000u); } }
    }
    const float il = 1.f / l;
    bf16* o = Omla + ((size_t)b * SEQ + q) * 384 + h * 64;
#pragma unroll
    for (int i = 0; i < 64; ++i) o[i] = f2bf(acc[i] * il);
}
__global__ void __launch_bounds__(64) nk_gdn(const bf16* Pgdn, const float* Psm, const float* conv_w, const float* a_log, const float* dt_bias, bf16* Ogdn, int dir) {
    __shared__ float qs[64], ks[64];
    const int bh = blockIdx.x, b = bh / 6, h = bh % 6, e = threadIdx.x;
    float S[64];
#pragma unroll
    for (int i = 0; i < 64; ++i) S[i] = 0.f;
    float cw[3][5];
#pragma unroll
    for (int i = 0; i < 5; ++i) { cw[0][i] = conv_w[i * 1152 + h * 64 + e]; cw[1][i] = conv_w[i * 1152 + 384 + h * 64 + e]; cw[2][i] = conv_w[i * 1152 + 768 + h * 64 + e]; }
    const float al = -__expf(a_log[dir * 6 + h]), dtb = dt_bias[dir * 6 + h];
    for (int n = 0; n < SEQ; ++n) {
        const int t = dir ? SEQ - 1 - n : n; const size_t m = (size_t)b * SEQ + t;
        float cq = 0.f, ck = 0.f, cv = 0.f;
#pragma unroll
        for (int i = 0; i < 5; ++i) { const int tt = t + i - 2; if (tt >= 0 && tt < SEQ) { const bf16* pr = Pgdn + ((size_t)b * SEQ + tt) * 1152 + h * 64 + e;
                cq += cw[0][i] * bf2f(pr[0]); ck += cw[1][i] * bf2f(pr[384]); cv += cw[2][i] * bf2f(pr[768]); } }
        cq = siluf(cq); ck = siluf(ck); cv = siluf(cv);
        const float qn = cq * rsqrtf(wave_sum(cq * cq) + 1e-6f) * 0.125f, kn = ck * rsqrtf(wave_sum(ck * ck) + 1e-6f);
        __syncthreads();
        qs[e] = qn; ks[e] = kn;
        __syncthreads();
        const float g = al * softplusf_(Psm[m * 32 + dir * 6 + h] + dtb), beta = sigmoidf_(Psm[m * 32 + 12 + dir * 6 + h]), alpha = __expf(g);
        float kS = 0.f;
#pragma unroll
        for (int d = 0; d < 64; ++d) kS += ks[d] * S[d];
        const float coef = beta * (cv - alpha * kS);
        float o = 0.f;
#pragma unroll
        for (int d = 0; d < 64; ++d) { S[d] = alpha * S[d] + coef * ks[d]; o += qs[d] * S[d]; }
        bf16* op = Ogdn + m * 384 + h * 64 + e;
        if (dir) o += bf2f(*op);
        *op = f2bf(o);
    }
}
__global__ void __launch_bounds__(64) nk_rwkv(const unsigned char* Rs, const unsigned char* Rd, bf16* Y, int dir) {
    const int bh = blockIdx.x, b = bh / 4, h = bh % 4, i = threadIdx.x;
    float S[64];
#pragma unroll
    for (int j = 0; j < 64; ++j) S[j] = 0.f;
    for (int n = 0; n < SEQ; ++n) {
        const int t = dir ? SEQ - 1 - n : n;
        const unsigned char* rs = Rs + ((size_t)bh * SEQ + t) * RS_REC;
        const unsigned char* rd = Rd + dir * RD_DIR + ((size_t)bh * SEQ + t) * RD_REC;
        const float v = bf2f(((const bf16*)(rs + 128))[i]);
        float sa = 0.f;
#pragma unroll
        for (int j = 0; j < 64; ++j) sa -= S[j] * bf2f(((const bf16*)rs)[j]);
        float y = 0.f;
#pragma unroll
        for (int j = 0; j < 64; ++j) {
            const float w = __expf(-__half2float(((const __half*)rd)[j]));
            S[j] = S[j] * w + sa * bf2f(((const bf16*)(rd + 128))[j]) + v * bf2f(((const bf16*)(rd + 256))[j]);
            y += S[j] * bf2f(((const bf16*)(rs + 256))[j]);
        }
        bf16* op = Y + ((size_t)b * SEQ + t) * 256 + h * 64 + i;
        if (dir) y += bf2f(*op);
        *op = f2bf(y);
    }
}
__global__ void __launch_bounds__(1024) nk_mix(const bf16* Ogdn, const bf16* Omla, const bf16* Y, const bf16* Pgate, const unsigned char* Rs, const float* cb,
                       const float* gdn_g, const float* ln_g, const float* ln_b, bf16* mix) {
    const int m = blockIdx.x, c = threadIdx.x, b = m / SEQ, t = m % SEQ;
    float val;
    if (c < 384) { const float o = bf2f(Ogdn[(size_t)m * 384 + c]); const float ss = wave_sum(o * o); val = o * rsqrtf(ss * (1.f / 64.f) + NORM_EPS) * gdn_g[c & 63]; }
    else if (c < 768) val = bf2f(Omla[(size_t)m * 384 + (c - 384)]);
    else { const int cc = c - 768, h = cc >> 6, j = cc & 63; const float y = bf2f(Y[(size_t)m * 256 + cc]);
        const float mean = wave_sum(y) * (1.f / 64.f); const float dv = y - mean; const float var = wave_sum(dv * dv) * (1.f / 64.f);
        const float v = bf2f(((const bf16*)(Rs + (((size_t)b * 4 + h) * SEQ + t) * RS_REC + 128))[j]);
        val = dv * rsqrtf(var + 64e-5f) * ln_g[cc] + ln_b[cc] + cb[(size_t)m * 4 + h] * v; }
    mix[(size_t)m * 1024 + c] = f2bf(val * siluf(bf2f(Pgate[(size_t)m * 1024 + c])));
}
#ifndef MK_SINGLE
#define MK_SINGLE 1
#endif
#ifndef MK_REPU
#define MK_REPU 0
#endif
#ifndef MK_SKIP
#define MK_SKIP 0
#endif
#ifndef MK_REPK
#define MK_REPK 0
#endif
#ifndef MK_REP2
#define MK_REP2 0
#endif
#ifndef MK_REP3
#define MK_REP3 0
#endif
#ifndef MK_P2
#define MK_P2 1
#endif
#ifndef MK_P3
#define MK_P3 1
#endif
#ifndef MK_P4A
#define MK_P4A 1
#endif
constexpr int PT_OUT = 24, PT_WS = 25, PT_N = 26;
__device__ __forceinline__ void build_frame(Frame& F, LAS unsigned char* lds) {
    F.lds = lds; F.MISC = (volatile LAS unsigned*)(lds + MISC_OFF); F.ptab = (volatile LAS const unsigned long long*)(lds + MISC_OFF + 256);
    const int t = pg8::mk_tid(lds);
    F.tid = t; F.lane = t & 63; F.wave = __builtin_amdgcn_readfirstlane(t >> 6);
    F.G = gridDim.x; { const int bx = blockIdx.x; F.vcu = (F.G % 8 == 0) ? (bx % 8) * (F.G / 8) + bx / 8 : bx; }
    F.ws = (unsigned char*)inptr(F, PT_WS); F.out = (float*)inptr(F, PT_OUT); F.ctl = (gu32*)F.ws;
}
__device__ __forceinline__ bool ph_in(LAS unsigned char* lds, int k) { volatile LAS unsigned* mi = (volatile LAS unsigned*)(lds + MISC_OFF); const int lo = __builtin_amdgcn_readfirstlane((int)mi[20]), hi = __builtin_amdgcn_readfirstlane((int)mi[21]); return lo <= k && k < hi; }
__device__ __forceinline__ void seam(LAS unsigned char* lds, int k) {
    if (ph_in(lds, k) && ph_in(lds, k + 1)) { Frame F; build_frame(F, lds);
        XcdBarrier bar; bar.bar = (unsigned*)(F.ctl + CW_BAR); bar.x = xb_xcc_id(); bar.st = F.MISC + 8; xcd_barrier(bar); }
}
__device__ __forceinline__ void xcd_barrier_now(Frame& F) { XcdBarrier bar; bar.bar = (unsigned*)(F.ctl + CW_BAR); bar.x = xb_xcc_id(); bar.st = F.MISC + 8; xcd_barrier(bar); }
template <int L> __device__ __forceinline__ void layer_phases(LAS unsigned char* lds) {
    constexpr int pb = 1 + 5 * L;
    if (ph_in(lds, pb)) { Frame F; build_frame(F, lds);
        pg8::Gemm g{(const pg8::bf16_t*)(F.ws + WS_XB), (const pg8::bf16_t*)(F.ws + WS_WIN) + (size_t)L * NP * D, M, NP, D};
        pg8::StaticOrder S; S.init(M, NP, F.G, (int)blockIdx.x);
        pg8::EpiRoute E{F.ws};
        pg8::gemm_phase<pg8::EpiRoute, pg8::StaticOrder, true, true>(F.lds + RING_OFF, g, S, E);
#if MK_REPK == 2
        xcd_barrier_now(F);
        pg8::gemm_phase<pg8::EpiRoute, pg8::StaticOrder, true, true>(F.lds + RING_OFF, g, S, E);
#endif
    }
    seam(lds, pb);
    if (ph_in(lds, pb + 1)) { Frame F; build_frame(F, lds); p2_prep2<0>(F, L); }
#if MK_REP2
    seam(lds, pb);
    if (ph_in(lds, pb + 1)) { Frame F; build_frame(F, lds); p2_prep2<MK_REP2 - 1>(F, L); }
#endif
    seam(lds, pb + 1);
#if MK_REPU
    if (ph_in(lds, pb + 2)) { Frame F; build_frame(F, lds); gu32* head = F.ctl + CW_QUEUE + 64 * (2 * L + 1);
        const int n = (MK_REPU == 1) ? U_GDN : (MK_REPU == 2) ? U_RWKV : U_ATT;
        for (;;) { const int u = next_unit(F, head); if (u >= n) break; if (MK_REPU == 1) gdn_unit3<MK_SKIP>(F, L, u, F.ctl + CW_FLAG + 64 * 256 * (2 * L + 1) + 64 * 128); else if (MK_REPU == 2) rwkv_unit(F, u, F.ctl + CW_FLAG + 64 * 256 * (2 * L + 1)); else attn_unit(F, u); } }
    seam(lds, pb + 1);
#endif
    if (ph_in(lds, pb + 2)) { Frame F; build_frame(F, lds); p3_mixers(F, L, 0); }
#if MK_REP3
    seam(lds, pb + 1);
    if (ph_in(lds, pb + 2)) { Frame F; build_frame(F, lds); p3_mixers(F, L, 1); }
#endif
    seam(lds, pb + 2);
    if (ph_in(lds, pb + 3)) { Frame F; build_frame(F, lds); p4a_mix2(F, L);
#if MK_REPK == 3
        xcd_barrier_now(F); p4a_mix2(F, L);
#endif
    }
    seam(lds, pb + 3);
    if (ph_in(lds, pb + 4)) { Frame F; build_frame(F, lds);
        pg8::Gemm g{(const pg8::bf16_t*)(F.ws + WS_MIX), (const pg8::bf16_t*)(F.ws + WS_WOUT) + (size_t)L * D * D, M, D, D};
        pg8::StaticOrder S; S.init(M, D, F.G, (int)blockIdx.x);
        pg8::EpiOut E{L == 0 ? (const float*)inptr(F, 0) : (const float*)F.out, F.out, F.ws};
        pg8::gemm_phase<pg8::EpiOut, pg8::StaticOrder, true, true>(F.lds + RING_OFF, g, S, E);
#if MK_REPK == 4
        if (L == 0) { xcd_barrier_now(F); pg8::gemm_phase<pg8::EpiOut, pg8::StaticOrder, true, true>(F.lds + RING_OFF, g, S, E); }
#endif
    }
    seam(lds, pb + 4);
}
__global__ void __launch_bounds__(NWAVES * 64, 2) mk_fwd(Args args) {
    extern __shared__ __attribute__((aligned(16))) unsigned char lds_raw[];
    LAS unsigned char* lds = (LAS unsigned char*)lds_raw;
    for (int u = threadIdx.x; u < (LDS_BYTES - LDSCTL_OFF) / 4; u += NWAVES * 64) ((LAS unsigned*)(lds + LDSCTL_OFF))[u] = 0u;
    __syncthreads();
    if (threadIdx.x == 0) { LAS unsigned long long* pt = (LAS unsigned long long*)(lds + MISC_OFF + 256);
#define PT(k) pt[k] = (unsigned long long)args.in[k]
        PT(0); PT(1); PT(2); PT(3); PT(4); PT(5); PT(6); PT(7); PT(8); PT(9); PT(10); PT(11); PT(12); PT(13); PT(14); PT(15); PT(16); PT(17); PT(18); PT(19); PT(20); PT(21); PT(22); PT(23);
#undef PT
        pt[PT_OUT] = (unsigned long long)args.out; pt[PT_WS] = (unsigned long long)args.ws;
        volatile LAS unsigned* mi = (volatile LAS unsigned*)(lds + MISC_OFF); mi[20] = (unsigned)args.ph_lo; mi[21] = (unsigned)args.ph_hi;
        if (args.ph_hi - args.ph_lo > 1) (void)xcd_barrier_post((unsigned*)((gu32*)args.ws + CW_BAR), mi + 8);
    }
    if ((threadIdx.x & 63) == 0) ((volatile LAS unsigned*)(lds + pg8::TIDTAB_OFF))[pg8::hw_slot()] = threadIdx.x >> 6;
    __syncthreads();
    if (ph_in(lds, 0)) { Frame F; build_frame(F, lds); p0_prologue(F); }
#if MK_REPK == 1
    seam(lds, 0);
    if (ph_in(lds, 0)) { Frame F; build_frame(F, lds); p0_prologue(F); }
#endif
    seam(lds, 0);
    layer_phases<0>(lds);
    layer_phases<1>(lds);
    if (ph_in(lds, 11)) { Frame F; build_frame(F, lds); p5_final(F); }
}

static void launch_phases(hipStream_t stream, int grid, Args a, int lo, int hi) {
    a.ph_lo = lo; a.ph_hi = hi;
    hipLaunchKernelGGL(mk_fwd, dim3(grid), dim3(NWAVES * 64), LDS_BYTES, stream, a);
}
extern "C" void kernel_launch(void* const* d_in, const int* in_sizes, int n_in, void* d_out, int out_size, void* d_ws, size_t ws_size, hipStream_t stream) {
    static int grid = 0;
    if (grid == 0) {
        if (n_in != 24 || ws_size < WS_END || out_size != M * D) { fprintf(stderr, "kernel_launch: unexpected inputs (%d), out (%d) or workspace (%zu)\n", n_in, out_size, ws_size); grid = -1; return; }
        int dev = 0, cus = 0;
        if (hipGetDevice(&dev) != hipSuccess || hipDeviceGetAttribute(&cus, hipDeviceAttributeMultiprocessorCount, dev) != hipSuccess) { grid = -1; return; }
        if (hipFuncSetAttribute((const void*)mk_fwd, hipFuncAttributeMaxDynamicSharedMemorySize, LDS_BYTES) != hipSuccess) { fprintf(stderr, "kernel_launch: hipFuncSetAttribute failed\n"); grid = -1; return; }
        (void)hipGetLastError();
        grid = cus;
    }
    if (grid < 0) return;
    unsigned char* ws = (unsigned char*)d_ws;
    hipMemsetAsync(ws + WS_CTL, 0, CTL_ZERO_BYTES, stream);
    Args a{};
    for (int i = 0; i < 24; ++i) a.in[i] = d_in[i];
    a.out = (float*)d_out; a.ws = ws;

    const int* positions = (const int*)d_in[1];
    const float* gdn_conv = (const float*)d_in[4]; const float* gdn_a_log = (const float*)d_in[5]; const float* gdn_dt_bias = (const float*)d_in[6]; const float* gdn_norm_g = (const float*)d_in[7];
    const float* mu = (const float*)d_in[12]; const float* w0 = (const float*)d_in[13]; const float* w2 = (const float*)d_in[14]; const float* a0 = (const float*)d_in[15];
    const float* a2 = (const float*)d_in[16]; const float* k_k = (const float*)d_in[17]; const float* k_a = (const float*)d_in[18]; const float* r_k = (const float*)d_in[19];
    const float* ln_g = (const float*)d_in[20]; const float* ln_b = (const float*)d_in[21];
    bf16* WuqT = (bf16*)(ws + WS_WSMALL + OFF_WUQ); bf16* WukvT = (bf16*)(ws + WS_WSMALL + OFF_WUKV);
    float* Psm = (float*)(ws + WS_PSM); float* cb = (float*)(ws + WS_CB);
    bf16* Pgate = (bf16*)(ws + WS_PGATE); bf16* Pgdn = (bf16*)(ws + WS_PGDN); bf16* Pmla = (bf16*)(ws + WS_PMLA); bf16* Prw = (bf16*)(ws + WS_PRW);
    bf16* Ogdn = (bf16*)(ws + WS_OGDN); bf16* Omla = (bf16*)(ws + WS_OMLA); bf16* Y = (bf16*)(ws + WS_Y);
    unsigned char* Rs = ws + WS_RS; unsigned char* Rd = ws + WS_RD;
    bf16* Q = (bf16*)(ws + WS_Q); bf16* Kb = (bf16*)(ws + WS_K); bf16* Vt = (bf16*)(ws + WS_VT); bf16* mix = (bf16*)(ws + WS_MIX);

#if MK_SINGLE
    launch_phases(stream, grid, a, 0, NPHASE);
    return;
#endif
    launch_phases(stream, grid, a, 0, 1);
    for (int l = 0; l < 2; ++l) {
        launch_phases(stream, grid, a, 1 + 5 * l, 2 + 5 * l);
#if MK_P2
        launch_phases(stream, grid, a, 2 + 5 * l, 3 + 5 * l);
#else
        hipLaunchKernelGGL(nk_mla_prep, dim3(M), dim3(64), 0, stream, Pmla, WuqT + (size_t)l * 576 * 192, WukvT + (size_t)l * 768 * 128, positions, Q, Kb, Vt);
        hipLaunchKernelGGL(nk_rwkv_prep, dim3(M), dim3(256), 0, stream, Prw, mu + l * 2 * 896, w0 + l * 512, w2 + (size_t)l * 2 * 64 * 256, a0 + l * 512, a2 + (size_t)l * 2 * 64 * 256,
                           k_k + l * 256, k_a + l * 256, r_k + l * 256, Rs, Rd, cb);
#endif
#if MK_P3
        launch_phases(stream, grid, a, 3 + 5 * l, 4 + 5 * l);
#else
        hipLaunchKernelGGL(nk_attn, dim3(SEQ / 128, BATCH * 6), dim3(128), 0, stream, Q, Kb, Vt, Omla);
        for (int dir = 0; dir < 2; ++dir) {
            hipLaunchKernelGGL(nk_gdn, dim3(BATCH * 6), dim3(64), 0, stream, Pgdn, Psm, gdn_conv + (size_t)l * 5 * 1152, gdn_a_log + l * 12, gdn_dt_bias + l * 12, Ogdn, dir);
            hipLaunchKernelGGL(nk_rwkv, dim3(BATCH * 4), dim3(64), 0, stream, Rs, Rd, Y, dir);
        }
#endif
#if MK_P4A
        launch_phases(stream, grid, a, 4 + 5 * l, 5 + 5 * l);
#else
        hipLaunchKernelGGL(nk_mix, dim3(M), dim3(1024), 0, stream, Ogdn, Omla, Y, Pgate, Rs, cb, gdn_norm_g + l * 64, ln_g + l * 256, ln_b + l * 256, mix);
#endif
        launch_phases(stream, grid, a, 5 + 5 * l, 6 + 5 * l);
    }
    launch_phases(stream, grid, a, 11, 12);
}
```

```cpp
#include <hip/hip_runtime.h>
#include <cstdio>
#include <cstdint>
#include <hip/hip_fp16.h>
namespace pg8 {
#define PG8_LAS __attribute__((address_space(3)))
typedef unsigned short bf16_t;
typedef short bf16x8 __attribute__((ext_vector_type(8)));
typedef float f32x4 __attribute__((ext_vector_type(4)));
typedef unsigned u32x4 __attribute__((ext_vector_type(4)));
constexpr int BM = 256, BK = 64, HALF = 128, HTB = HALF * BK * 2  , STAGE_BYTES = 8 * HTB, NXCD = 8, WGM = 8;

__host__ __device__ __forceinline__ int lds_byte(int r, int c) { const int st = (r >> 4) * 2 + (c >> 5), rr = r & 15, cc = c & 31, ob = rr * 64 + cc * 2; return st * 1024 + (ob ^ (((ob >> 9) & 1) << 5)); }
__host__ __device__ __forceinline__ void stage_rc(int b, int& R, int& C) { const int st = b / 1024, sb = b % 1024, swz = sb ^ (((sb >> 9) & 1) << 5); R = (st >> 1) * 16 + swz / 64; C = (st & 1) * 32 + (swz % 64) / 2; }
__host__ __device__ __forceinline__ int perm32(int rho) { const int n = rho >> 4, i = rho & 15; return 8 * (i >> 2) + 4 * n + (i & 3); }

struct Unit { int pm, pn; };
struct Gemm { const bf16_t* A; const bf16_t* Bt; int M, N, K; };

struct StaticOrder {
    int nM, nN, nwg, G, c;
    __host__ __device__ void init(int M, int N, int G_, int c_) { nM = M / BM; nN = N / BM; nwg = nM * nN; G = G_; c = c_; }
    __host__ __device__ bool next(int i, Unit& u) const {
        const long L = (long)i * G + c; if (L >= nwg) return false;
        int wgid = (int)L; { const int q = nwg / NXCD, r = nwg % NXCD, xcd = wgid % NXCD, off = wgid / NXCD; wgid = (xcd < r ? xcd * (q + 1) : r * (q + 1) + (xcd - r) * q) + off; }
        const int nig = WGM * nN, gid = wgid / nig, fm = gid * WGM, gsz = (nM - fm) < WGM ? (nM - fm) : WGM;
        u.pm = fm + ((wgid % nig) % gsz); u.pn = (wgid % nig) / gsz; return true;
    }
    __device__ __forceinline__ void a_ready(const Unit&) const {}
    __device__ __forceinline__ void done(const Unit&) const {}
};

__device__ __forceinline__ unsigned cvt_pk_bf16(float lo, float hi) { unsigned r; asm volatile("v_cvt_pk_bf16_f32 %0, %1, %2" : "=v"(r) : "v"(lo), "v"(hi)); return r; }
typedef float f32x2 __attribute__((ext_vector_type(2)));
constexpr int TIDTAB_OFF = 131072 + 320 + 512;
__device__ __forceinline__ unsigned hw_slot() { return (unsigned)__builtin_amdgcn_s_getreg((5 << 11) | 4) & 63u; }
__device__ __forceinline__ int mk_tid(PG8_LAS unsigned char* lds_base) {
    const unsigned lane = __builtin_amdgcn_mbcnt_hi(~0u, __builtin_amdgcn_mbcnt_lo(~0u, 0u));
    const unsigned w = __builtin_amdgcn_readfirstlane(((volatile PG8_LAS unsigned*)(lds_base + TIDTAB_OFF))[hw_slot()]);
    return (int)(w * 64u + lane);
}
struct EpiRoute {
    static constexpr bool PERM = true, AFTER_DRAIN = false;
    unsigned char* ws;
    __device__ __forceinline__ void operator()(const f32x4 (&acc)[2][2][4][2], const Unit& u, int wr, int wc, int fr, int fq) const {
        const int row0 = u.pm * BM + wr * 64 + fr;
        const float* rowss = (const float*)(ws + (1u << 20)); float* Psm = (float*)(ws + (22u << 20));
        unsigned base[2]; int ld[2], cc[2], kind[2];
#pragma unroll
        for (int bj = 0; bj < 2; ++bj) {
            const int cg = u.pn * BM + bj * HALF + wc * 32, col = cg + 8 * fq;
            if (cg < 1024) { base[bj] = 25u << 20; ld[bj] = 1024; cc[bj] = col; kind[bj] = 0; }
            else if (cg < 2176) { base[bj] = 57u << 20; ld[bj] = 1152; cc[bj] = col - 1024; kind[bj] = 0; }
            else if (cg < 2528) { base[bj] = 93u << 20; ld[bj] = 352; cc[bj] = col - 2176; kind[bj] = 0; }
            else if (cg < 3424) { base[bj] = 104u << 20; ld[bj] = 896; cc[bj] = col - 2528; kind[bj] = 0; }
            else if (cg < 3456) { base[bj] = 0u; ld[bj] = 32; cc[bj] = col - 3424; kind[bj] = 1; }
            else { base[bj] = 0u; ld[bj] = 0; cc[bj] = 0; kind[bj] = 2; }
        }
#pragma unroll
        for (int ai = 0; ai < 2; ++ai)
#pragma unroll
            for (int m = 0; m < 4; ++m) {
                const int row = row0 + ai * HALF + m * 16;
                const f32x4* rp = (const f32x4*)(rowss + (size_t)row * 16);
                const f32x4 s0 = rp[0], s1 = rp[1], s2 = rp[2], s3 = rp[3];
                const float ss = ((s0[0] + s0[1]) + (s0[2] + s0[3])) + ((s1[0] + s1[1]) + (s1[2] + s1[3])) + ((s2[0] + s2[1]) + (s2[2] + s2[3])) + ((s3[0] + s3[1]) + (s3[2] + s3[3]));
                const float rstd = __builtin_amdgcn_rsqf(ss * (1.0f / 1024.0f) + 1e-6f);
#pragma unroll
                for (int bj = 0; bj < 2; ++bj) {
                    const f32x4 v0 = acc[ai][bj][m][0] * rstd, v1 = acc[ai][bj][m][1] * rstd;
                    if (kind[bj] == 0) { u32x4 w; w.x = cvt_pk_bf16(v0[0], v0[1]); w.y = cvt_pk_bf16(v0[2], v0[3]); w.z = cvt_pk_bf16(v1[0], v1[1]); w.w = cvt_pk_bf16(v1[2], v1[3]);
                        *(u32x4*)((bf16_t*)(ws + base[bj]) + (size_t)row * ld[bj] + cc[bj]) = w; }
                    else if (kind[bj] == 1) { float* p = Psm + (size_t)row * 32 + cc[bj]; *(f32x4*)p = v0; *(f32x4*)(p + 4) = v1; }
                }
                asm volatile("" ::: "memory");
            }
    }
};
struct EpiOut {
    static constexpr bool PERM = false, AFTER_DRAIN = false;
    const float* xin; float* xout; unsigned char* ws;
    __device__ __forceinline__ void operator()(const f32x4 (&acc)[2][2][4][2], const Unit& u, int wr, int wc, int fr, int fq) const {
        typedef unsigned u32x2v __attribute__((ext_vector_type(2)));
        const int row0 = u.pm * BM + wr * 64 + fr, col0 = u.pn * BM + wc * 32 + 4 * fq;
        float* rowss = (float*)(ws + (1u << 20)); bf16_t* xb = (bf16_t*)(ws + (133u << 20));
#pragma unroll
        for (int ai = 0; ai < 2; ++ai)
#pragma unroll
            for (int m = 0; m < 4; ++m) {
                const int row = row0 + ai * HALF + m * 16; float ss = 0.f;
#pragma unroll
                for (int bj = 0; bj < 2; ++bj)
#pragma unroll
                    for (int n = 0; n < 2; ++n) {
                        const size_t off = (size_t)row * 1024 + col0 + bj * HALF + n * 16;
                        const f32x4 o = *(const f32x4*)(xin + off) + acc[ai][bj][m][n];
                        *(f32x4*)(xout + off) = o;
                        u32x2v w; w.x = cvt_pk_bf16(o[0], o[1]); w.y = cvt_pk_bf16(o[2], o[3]); *(u32x2v*)(xb + off) = w;
                        ss += (o[0] * o[0] + o[1] * o[1]) + (o[2] * o[2] + o[3] * o[3]);
                    }
                ss += __shfl_xor(ss, 16); ss += __shfl_xor(ss, 32);
                if (fq == 0) rowss[(size_t)row * 16 + u.pn * 4 + wc] = ss;
                asm volatile("" ::: "memory");
            }
    }
};
template <class Epi, class Sched, bool ALIGN_EPI = false, bool SP2 = false>
__device__ __forceinline__ void gemm_phase(PG8_LAS unsigned char* lds, const Gemm g, const Sched& S, const Epi& E) {
    const int tid_ = mk_tid(lds);
    const int tid = tid_, wid = __builtin_amdgcn_readfirstlane(tid >> 6), lane = tid & 63, wr = wid >> 2, wc = wid & 3, fr = lane & 15, fq = lane >> 4;
    const int K = g.K, nt = K / BK;
    unsigned voffA[2], voffB[2];
#pragma unroll
    for (int i = 0; i < 2; ++i) { int R, C; stage_rc(tid * 16 + i * 8192, R, C); const int Rb = Epi::PERM ? ((R & ~31) + perm32(R & 31)) : R;
        voffA[i] = (unsigned)(R * K + C) * 2u; voffB[i] = (unsigned)(Rb * K + C) * 2u; }
    const size_t kstep = (size_t)(BK * 2);
    const size_t hstep = (size_t)HALF * K * 2;
    const size_t tstep = 2 * hstep;
    const unsigned ldsw = (unsigned)wid * 1024u;
    const int aoff = lds_byte(wr * 64 + fr, fq * 8), boff = lds_byte(wc * 32 + fr, fq * 8);
#define PG8_SA(b, h) (((b) * 2 + (h)) * HTB)
#define PG8_SB(b, h) ((4 + (b) * 2 + (h)) * HTB)
#define PG8_STAGE(bufoff, gbase, voff) do { _Pragma("unroll") for (int _i = 0; _i < 2; ++_i) \
        __builtin_amdgcn_global_load_lds((const unsigned*)((const char*)(gbase) + (voff)[_i]), (PG8_LAS unsigned*)(lds + (bufoff) + ldsw + _i * 8192), 16, 0, 0); } while (0)
#define PG8_LDA(dst, b, h) do { _Pragma("unroll") for (int m = 0; m < 4; ++m) _Pragma("unroll") for (int k = 0; k < 2; ++k) dst[m][k] = *(const PG8_LAS bf16x8*)(lds + PG8_SA(b, h) + aoff + m * 2048 + k * 1024); } while (0)
#define PG8_LDB(dst, b, h) do { _Pragma("unroll") for (int n = 0; n < 2; ++n) _Pragma("unroll") for (int k = 0; k < 2; ++k) dst[n][k] = *(const PG8_LAS bf16x8*)(lds + PG8_SB(b, h) + boff + n * 2048 + k * 1024); } while (0)
#define PG8_MMA(ai, bj, At, Bt) do { __builtin_amdgcn_s_setprio(1); _Pragma("unroll") for (int m = 0; m < 4; ++m) _Pragma("unroll") for (int n = 0; n < 2; ++n) _Pragma("unroll") for (int k = 0; k < 2; ++k) \
        acc[ai][bj][m][n] = __builtin_amdgcn_mfma_f32_16x16x32_bf16(Bt[n][k], At[m][k], acc[ai][bj][m][n], 0, 0, 0); __builtin_amdgcn_s_setprio(0); } while (0)
#define PG8_WAIT_V(n) asm volatile("s_waitcnt vmcnt(" #n ")" ::: "memory")
#define PG8_WAIT_L(n) asm volatile("s_waitcnt lgkmcnt(" #n ")" ::: "memory")
#define PG8_BAR __builtin_amdgcn_s_barrier()
#define PG8_SCHED __builtin_amdgcn_sched_barrier(0)
    Unit cur, nxt; int ui = 0;
    if (!S.next(0, cur)) return;
    f32x4 acc[2][2][4][2];
#pragma unroll
    for (int a = 0; a < 2; ++a)
#pragma unroll
        for (int b = 0; b < 2; ++b)
#pragma unroll
            for (int m = 0; m < 4; ++m)
#pragma unroll
                for (int n = 0; n < 2; ++n) acc[a][b][m][n] = (f32x4){0.f, 0.f, 0.f, 0.f};
    bf16x8 At[4][2], B0[2][2], B1[2][2];
    const char* cA = (const char*)g.A + (size_t)cur.pm * tstep; const char* cB = (const char*)g.Bt + (size_t)cur.pn * tstep;
    S.a_ready(cur);
    if constexpr (SP2) {
        PG8_STAGE(PG8_SB(0, 0), cB, voffB); PG8_STAGE(PG8_SB(0, 1), cB + hstep, voffB); PG8_STAGE(PG8_SA(0, 0), cA, voffA); PG8_STAGE(PG8_SA(0, 1), cA + hstep, voffA);
        if (wr == 1) PG8_BAR;
        PG8_WAIT_V(2); PG8_BAR;
        PG8_STAGE(PG8_SB(1, 0), cB + kstep, voffB); PG8_STAGE(PG8_SA(1, 0), cA + kstep, voffA); PG8_STAGE(PG8_SB(1, 1), cB + hstep + kstep, voffB);
        PG8_WAIT_V(6); PG8_BAR;
    } else {
        PG8_STAGE(PG8_SB(0, 0), cB, voffB); PG8_STAGE(PG8_SA(0, 0), cA, voffA); PG8_STAGE(PG8_SB(0, 1), cB + hstep, voffB); PG8_STAGE(PG8_SA(0, 1), cA + hstep, voffA);
        if (wr == 1) PG8_BAR;
        PG8_WAIT_V(4); PG8_BAR;
        PG8_STAGE(PG8_SB(1, 0), cB + kstep, voffB); PG8_STAGE(PG8_SA(1, 0), cA + kstep, voffA); PG8_STAGE(PG8_SB(1, 1), cB + hstep + kstep, voffB);
        PG8_WAIT_V(6); PG8_BAR;
    }
    for (;;) {
        const bool has_next = S.next(ui + 1, nxt);
        const char* nA = has_next ? (const char*)g.A + (size_t)nxt.pm * tstep : cA; const char* nB = has_next ? (const char*)g.Bt + (size_t)nxt.pn * tstep : cB;
        for (int t = 0; t < nt; t += 2) {
            const bool last = (t == nt - 2);
            const char* a1 = cA + (size_t)(t + 1) * kstep;
            const char* a2 = last ? nA : cA + (size_t)(t + 2) * kstep; const char* b2 = last ? nB : cB + (size_t)(t + 2) * kstep;
            const char* a3 = a2 + kstep; const char* b3 = b2 + kstep;
            if (last && has_next) S.a_ready(nxt);
            if constexpr (SP2) {
            PG8_LDB(B0, 0, 0); PG8_LDB(B1, 0, 1); PG8_SCHED; PG8_LDA(At, 0, 0); PG8_STAGE(PG8_SA(1, 1), a1 + hstep, voffA);
            PG8_WAIT_V(8); PG8_WAIT_L(0); PG8_BAR; PG8_MMA(0, 0, At, B0); PG8_MMA(0, 1, At, B1); PG8_BAR; PG8_SCHED;
            PG8_LDA(At, 0, 1); PG8_STAGE(PG8_SB(0, 0), b2, voffB); PG8_STAGE(PG8_SB(0, 1), b2 + hstep, voffB); PG8_STAGE(PG8_SA(0, 0), a2, voffA);
            PG8_WAIT_V(8); PG8_WAIT_L(0); PG8_BAR; PG8_MMA(1, 0, At, B0); PG8_MMA(1, 1, At, B1); PG8_BAR; PG8_SCHED;
            PG8_LDB(B0, 1, 0); PG8_LDB(B1, 1, 1); PG8_SCHED; PG8_LDA(At, 1, 0); PG8_STAGE(PG8_SA(0, 1), a2 + hstep, voffA);
            PG8_WAIT_V(8); PG8_WAIT_L(0); PG8_BAR; PG8_MMA(0, 0, At, B0); PG8_MMA(0, 1, At, B1); PG8_BAR; PG8_SCHED;
            PG8_LDA(At, 1, 1); PG8_STAGE(PG8_SB(1, 0), b3, voffB); PG8_STAGE(PG8_SB(1, 1), b3 + hstep, voffB); PG8_STAGE(PG8_SA(1, 0), a3, voffA);
            PG8_WAIT_V(8); PG8_WAIT_L(0); PG8_BAR; PG8_MMA(1, 0, At, B0); PG8_MMA(1, 1, At, B1); PG8_BAR; PG8_SCHED;
            } else {
            PG8_LDB(B0, 0, 0); PG8_SCHED; PG8_LDA(At, 0, 0); PG8_STAGE(PG8_SA(1, 1), a1 + hstep, voffA);
            PG8_WAIT_L(8); PG8_BAR; PG8_WAIT_L(0); PG8_MMA(0, 0, At, B0); PG8_BAR; PG8_SCHED;
            PG8_LDB(B1, 0, 1); PG8_STAGE(PG8_SB(0, 0), b2, voffB);
            PG8_BAR; PG8_WAIT_L(0); PG8_MMA(0, 1, At, B1); PG8_BAR;
            PG8_LDA(At, 0, 1); PG8_STAGE(PG8_SA(0, 0), a2, voffA);
            PG8_BAR; PG8_WAIT_L(0); PG8_MMA(1, 0, At, B0); PG8_BAR; PG8_SCHED;
            PG8_STAGE(PG8_SB(0, 1), b2 + hstep, voffB);
            PG8_WAIT_V(6); PG8_BAR; PG8_MMA(1, 1, At, B1); PG8_BAR;
            PG8_LDB(B0, 1, 0); PG8_SCHED; PG8_LDA(At, 1, 0); PG8_STAGE(PG8_SA(0, 1), a2 + hstep, voffA);
            PG8_WAIT_L(8); PG8_BAR; PG8_WAIT_L(0); PG8_MMA(0, 0, At, B0); PG8_BAR; PG8_SCHED;
            PG8_LDB(B1, 1, 1); PG8_STAGE(PG8_SB(1, 0), b3, voffB);
            PG8_BAR; PG8_WAIT_L(0); PG8_MMA(0, 1, At, B1); PG8_BAR;
            PG8_LDA(At, 1, 1); PG8_STAGE(PG8_SA(1, 0), a3, voffA);
            PG8_BAR; PG8_WAIT_L(0); PG8_MMA(1, 0, At, B0); PG8_BAR; PG8_SCHED;
            PG8_STAGE(PG8_SB(1, 1), b3 + hstep, voffB);
            PG8_WAIT_V(6); PG8_BAR; PG8_MMA(1, 1, At, B1); PG8_BAR;
            }
        }
        if constexpr (ALIGN_EPI) { if (wr == 0) PG8_BAR; }
        if constexpr (!Epi::AFTER_DRAIN) { E(acc, cur, wr, wc, fr, fq); S.done(cur); }
        if (!has_next) break;
#pragma unroll
        for (int a = 0; a < 2; ++a)
#pragma unroll
            for (int b = 0; b < 2; ++b)
#pragma unroll
                for (int m = 0; m < 4; ++m)
#pragma unroll
                    for (int n = 0; n < 2; ++n) acc[a][b][m][n] = (f32x4){0.f, 0.f, 0.f, 0.f};
        cur = nxt; cA = nA; cB = nB; ++ui;
        if constexpr (ALIGN_EPI) { if (wr == 1) PG8_BAR; }
    }
    PG8_WAIT_V(0);
    if constexpr (!ALIGN_EPI) { if (wr == 0) PG8_BAR; }
    PG8_BAR;
    if constexpr (Epi::AFTER_DRAIN) { E.fused(acc, cur, wr, wc, fr, fq, lds, wid, lane); S.done(cur); }
#undef PG8_SA
#undef PG8_SB
#undef PG8_STAGE
#undef PG8_LDA
#undef PG8_LDB
#undef PG8_MMA
#undef PG8_WAIT_V
#undef PG8_WAIT_L
#undef PG8_BAR
#undef PG8_SCHED
}
}
#define GAS __attribute__((address_space(1)))
#define LAS __attribute__((address_space(3)))
typedef unsigned short bf16;
typedef unsigned v4u __attribute__((ext_vector_type(4)));
typedef float f32x4 __attribute__((ext_vector_type(4)));
typedef short bf16x8 __attribute__((ext_vector_type(8)));
typedef GAS unsigned gu32;
typedef GAS unsigned long long gu64;
#define RLX_AGENT __ATOMIC_RELAXED, __HIP_MEMORY_SCOPE_AGENT
#define LDS_WAIT() asm volatile("s_waitcnt lgkmcnt(0)" ::: "memory")
#define VM_WAIT() asm volatile("s_waitcnt vmcnt(0)" ::: "memory")
__device__ __forceinline__ unsigned long long rt() { return __builtin_amdgcn_s_memrealtime(); }
__device__ __forceinline__ unsigned f2bf(float f) { unsigned u = __builtin_bit_cast(unsigned, f); return (u + 0x7fffu + ((u >> 16) & 1u)) >> 16; }
__device__ __forceinline__ unsigned pk2(float lo, float hi) { return f2bf(lo) | (f2bf(hi) << 16); }

#define XB_TMO      128
#define XB_XCNT(j)  (256  + 64 * (j))
#define XB_XSUB(j)  (1280 + 64 * (j))
#define XB_XGEN(j)  (2304 + 64 * (j))
#define XB_TOP      3328
#define XB_TOPGEN   3392
#define XCD_BAR_WORDS 3456
#define XB_SPIN_CAP (1u << 18)

__device__ __forceinline__ unsigned xb_ld(unsigned* p)              { return __hip_atomic_load(p, __ATOMIC_RELAXED, __HIP_MEMORY_SCOPE_AGENT); }
__device__ __forceinline__ unsigned xb_add(unsigned* p, unsigned v) { return __hip_atomic_fetch_add(p, v, __ATOMIC_RELAXED, __HIP_MEMORY_SCOPE_AGENT); }
__device__ __forceinline__ unsigned xb_xcc_id() { return (unsigned)__builtin_amdgcn_s_getreg((3 << 11) | 20) & 0xFu; }
#define XB_SPIN(cond, bar) do { unsigned _sp = 0; while (cond) { __builtin_amdgcn_s_sleep(1); \
    if ((++_sp & 255u) == 0u) { if (xb_ld(&(bar)[XB_TMO])) break; if (_sp > XB_SPIN_CAP) { atomicAdd(&(bar)[XB_TMO], 1u); break; } } } } while (0)

struct XcdBarrier {
    unsigned* bar; unsigned x;
    volatile LAS unsigned* st;
};

__device__ __forceinline__ XcdBarrier xcd_barrier_post(unsigned* bar, volatile LAS unsigned* st) {
    XcdBarrier b; b.bar = bar; b.x = xb_xcc_id(); b.st = st;
    if (threadIdx.x == 0) (void)xb_add(&bar[XB_XCNT(b.x)], 1u);
    return b;
}
__device__ __forceinline__ void xcd_barrier_complete(unsigned* bar, unsigned x, unsigned& nloc, unsigned& nx) {
    const unsigned G = gridDim.x * gridDim.y * gridDim.z;
    unsigned sum, cnt, mine, sp = 0u;
    for (;;) {
        sum = 0u; cnt = 0u; mine = 0u;
#pragma unroll
        for (unsigned j = 0; j < 16; ++j) { const unsigned c = xb_ld(&bar[XB_XCNT(j)]); sum += c; cnt += (c > 0u) ? 1u : 0u; mine = (j == x) ? c : mine; }
        if (sum == G) break;
        __builtin_amdgcn_s_sleep(1);
        if ((++sp & 255u) == 0u) { if (xb_ld(&bar[XB_TMO])) break; if (sp > XB_SPIN_CAP) { atomicAdd(&bar[XB_TMO], 1u); break; } }
    }
    nloc = mine > 0u ? mine : 1u; nx = cnt > 0u ? cnt : 1u;
}

__device__ __forceinline__ void xcd_barrier(const XcdBarrier& b) {
    asm volatile("s_waitcnt vmcnt(0)" ::: "memory");
    __syncthreads();
    if (pg8::mk_tid((LAS unsigned char*)b.st - (131072 + 320 + 32)) == 0) {
        unsigned* bar = b.bar;
        __builtin_amdgcn_s_waitcnt(0);
        unsigned nloc = b.st[0], nx = b.st[1];
        if (nloc == 0u) { xcd_barrier_complete(bar, b.x, nloc, nx); b.st[0] = nloc; b.st[1] = nx; }
        const unsigned old = xb_add(&bar[XB_XSUB(b.x)], 1u);
        const unsigned gen = old / nloc;
        if (old + 1u == (gen + 1u) * nloc) {
            __builtin_amdgcn_fence(__ATOMIC_RELEASE, "agent");
            asm volatile("s_waitcnt vmcnt(0)" ::: "memory");
            const unsigned og = xb_add(&bar[XB_TOP], 1u);
            const unsigned tg = og / nx;
            if (og + 1u == (tg + 1u) * nx) xb_add(&bar[XB_TOPGEN], 1u);
            else XB_SPIN(xb_ld(&bar[XB_TOPGEN]) == tg, bar);
            __builtin_amdgcn_fence(__ATOMIC_ACQUIRE, "agent");
            xb_add(&bar[XB_XGEN(b.x)], 1u);
            asm volatile("s_waitcnt vmcnt(0)" ::: "memory");
        } else {
            XB_SPIN(xb_ld(&bar[XB_XGEN(b.x)]) == gen, bar);
            __builtin_amdgcn_fence(__ATOMIC_ACQUIRE, "agent");
            asm volatile("s_waitcnt vmcnt(0)" ::: "memory");
        }
    }
    __syncthreads();
}
constexpr int BATCH = 8, SEQ = 2048, M = BATCH * SEQ, D = 1024, NIN = 3448, NP = 3584;
constexpr float NORM_EPS = 1e-6f;
constexpr float LOG2E = 1.4426950408889634f;
constexpr size_t MiB = 1u << 20;
constexpr size_t WS_CTL = 0, CTL_ZERO_BYTES = 1 * MiB;
constexpr size_t WS_ROWSS = 1 * MiB;
constexpr size_t WS_WIN = 2 * MiB;
constexpr size_t WS_WOUT = 16 * MiB;
constexpr size_t WS_WSMALL = 20 * MiB;
constexpr size_t OFF_WUQ = 0, OFF_WUKV = 2 * 576 * 192 * 2, OFF_W2T = OFF_WUKV + 2 * 768 * 128 * 2, OFF_A2T = OFF_W2T + 2 * 2 * 256 * 64 * 2;
constexpr size_t WS_PSM = 22 * MiB;
constexpr size_t WS_CB = 24 * MiB;
constexpr size_t WS_PGATE = 25 * MiB;
constexpr size_t WS_PGDN = 57 * MiB;
constexpr size_t WS_PMLA = 93 * MiB;
constexpr size_t WS_PRW = 104 * MiB;
constexpr size_t WS_OGDN = 93 * MiB;
constexpr size_t WS_OMLA = 105 * MiB;
constexpr size_t WS_Y = 117 * MiB;
constexpr size_t WS_RS = 133 * MiB;
constexpr size_t WS_RD = 157 * MiB;
constexpr size_t WS_XB = 133 * MiB;
constexpr size_t WS_Q = 207 * MiB;
constexpr size_t WS_K = 225 * MiB;
constexpr size_t WS_VT = 243 * MiB;
constexpr size_t WS_MIX = 207 * MiB;
constexpr size_t WS_END = 255 * MiB;
constexpr int RS_REC = 384, RD_REC = 400;
constexpr size_t RD_DIR = (size_t)BATCH * 4 * SEQ * RD_REC;
constexpr int CW_BAR = 4096;
constexpr int CW_QUEUE = 16384;

constexpr int NWAVES = 8;
constexpr int RING_OFF = 0, RING_BYTES = 131072, LDSCTL_OFF = RING_BYTES, MISC_OFF = LDSCTL_OFF + 320, LDS_BYTES = 147456;
static_assert(pg8::TIDTAB_OFF == MISC_OFF + 512 && RING_OFF == 0, "LDS map");
constexpr int NPHASE = 12;

__device__ __forceinline__ float bf2f(bf16 v) { return __uint_as_float(((unsigned)v) << 16); }
__device__ __forceinline__ float wave_sum(float v) {
#pragma unroll
    for (int o = 1; o < 64; o <<= 1) v += __shfl_xor(v, o);
    return v;
}
__device__ __forceinline__ float siluf(float x) { return x / (1.f + __expf(-x)); }
__device__ __forceinline__ float sigmoidf_(float x) { return 1.f / (1.f + __expf(-x)); }
__device__ __forceinline__ float softplusf_(float x) { return x > 20.f ? x : log1pf(__expf(x)); }

struct Args { const void* in[24]; float* out; unsigned char* ws; int ph_lo, ph_hi; };

struct Frame {
    LAS unsigned char* lds;
    volatile LAS unsigned* MISC;
    gu32* ctl;
    int tid, lane, wave, vcu, G;
    unsigned char* ws;
    float* out;
    volatile LAS const unsigned long long* ptab;
};
__device__ __forceinline__ const void* inptr(const Frame& F, int k) {
    const unsigned long long v = F.ptab[k];
    const unsigned lo = __builtin_amdgcn_readfirstlane((unsigned)v), hi = __builtin_amdgcn_readfirstlane((unsigned)(v >> 32));
    return (const void*)(GAS const void*)(((unsigned long long)hi << 32) | lo);
}

__device__ __forceinline__ void tr_item(const float* W, int K, int ldsrc, int scol, int nvalid, bf16* WT, const float* gs, LAS float* scr, int kb, int lane) {
    const int k0 = 64 * kb;
#pragma unroll 8
    for (int i = 0; i < 32; ++i) { const int kk = 2 * i + (lane >> 5), n = lane & 31; float v = 0.f;
        if (n < nvalid) { v = W[(size_t)(k0 + kk) * ldsrc + scol + n]; if (gs) v *= gs[k0 + kk]; }
        scr[kk * 33 + n] = v; }
    LDS_WAIT(); asm volatile("" ::: "memory");
    const int c = lane & 7;
#pragma unroll
    for (int j = 0; j < 4; ++j) { const int n = (lane >> 3) + 8 * j; const LAS float* s = scr + (8 * c) * 33 + n;
        v4u o; o.x = pk2(s[0 * 33], s[1 * 33]); o.y = pk2(s[2 * 33], s[3 * 33]); o.z = pk2(s[4 * 33], s[5 * 33]); o.w = pk2(s[6 * 33], s[7 * 33]);
        *(GAS v4u*)(WT + (size_t)n * K + k0 + 8 * c) = o; }
    LDS_WAIT(); asm volatile("" ::: "memory");
}
__device__ __forceinline__ void p0_prologue(Frame& F) {
    LAS float* scr = (LAS float*)(F.lds + RING_OFF + F.wave * 16384);
    const int gw = F.vcu * NWAVES + F.wave, NGW = F.G * NWAVES;
    constexpr int I_IN = 112 * 16, I_OUT = 32 * 16, I_UQ = 18 * 3, I_UKV = 24 * 2, I_W2 = 16, I_A2 = 16, I_L = I_IN + I_OUT + I_UQ + I_UKV + I_W2 + I_A2;
    for (int it = gw; it < 2 * I_L; it += NGW) {
        const int l = it / I_L; int r = it % I_L;
        if (r < I_IN) { const int nb = r >> 4, kb = r & 15, n0 = 32 * nb; int scol, nv;
            if (n0 < 2176) { scol = n0; nv = 32; } else if (n0 < 3424) { scol = n0 + 24; nv = 32; } else if (n0 == 3424) { scol = 2176; nv = 24; } else { scol = 0; nv = 0; }
            tr_item((const float*)inptr(F, 3) + (size_t)l * D * NIN, D, NIN, scol, nv, (bf16*)(F.ws + WS_WIN) + ((size_t)l * NP + n0) * D, (const float*)inptr(F, 2) + l * D, scr, kb, F.lane); continue; }
        r -= I_IN;
        if (r < I_OUT) { const int nb = r >> 4, kb = r & 15;
            tr_item((const float*)inptr(F, 22) + (size_t)l * D * D, D, D, 32 * nb, 32, (bf16*)(F.ws + WS_WOUT) + ((size_t)l * D + 32 * nb) * D, nullptr, scr, kb, F.lane); continue; }
        r -= I_OUT;
        if (r < I_UQ) { const int nb = r / 3, kb = r % 3;
            tr_item((const float*)inptr(F, 9) + (size_t)l * 192 * 576, 192, 576, 32 * nb, 32, (bf16*)(F.ws + WS_WSMALL + OFF_WUQ) + ((size_t)l * 576 + 32 * nb) * 192, (const float*)inptr(F, 8) + l * 192, scr, kb, F.lane); continue; }
        r -= I_UQ;
        if (r < I_UKV) { const int nb = r >> 1, kb = r & 1;
            tr_item((const float*)inptr(F, 11) + (size_t)l * 128 * 768, 128, 768, 32 * nb, 32, (bf16*)(F.ws + WS_WSMALL + OFF_WUKV) + ((size_t)l * 768 + 32 * nb) * 128, (const float*)inptr(F, 10) + l * 128, scr, kb, F.lane); continue; }
        r -= I_UKV;
        if (r < I_W2) { const int e = r >> 3, nb = r & 7;
            tr_item((const float*)inptr(F, 14) + ((size_t)l * 2 + e) * 64 * 256, 64, 256, 32 * nb, 32, (bf16*)(F.ws + WS_WSMALL + OFF_W2T) + (((size_t)l * 2 + e) * 256 + 32 * nb) * 64, nullptr, scr, 0, F.lane); continue; }
        r -= I_W2;
        { const int e = r >> 3, nb = r & 7;
            tr_item((const float*)inptr(F, 16) + ((size_t)l * 2 + e) * 64 * 256, 64, 256, 32 * nb, 32, (bf16*)(F.ws + WS_WSMALL + OFF_A2T) + (((size_t)l * 2 + e) * 256 + 32 * nb) * 64, nullptr, scr, 0, F.lane); }
    }
    const float* x = (const float*)inptr(F, 0); bf16* xb = (bf16*)(F.ws + WS_XB); float* rowss = (float*)(F.ws + WS_ROWSS);
    for (int m = gw; m < M; m += NGW) {
        const GAS f32x4* xr = (const GAS f32x4*)(x + (size_t)m * D) + F.lane;
        GAS unsigned long long* o8 = (GAS unsigned long long*)(xb + (size_t)m * D) + F.lane; float s = 0.f;
#pragma unroll
        for (int j = 0; j < 4; ++j) { const f32x4 v = xr[64 * j]; s += (v.x * v.x + v.y * v.y) + (v.z * v.z + v.w * v.w);
            o8[64 * j] = (unsigned long long)pk2(v.x, v.y) | ((unsigned long long)pk2(v.z, v.w) << 32); }
        s = wave_sum(s);
        if (F.lane < 16) rowss[(size_t)m * 16 + F.lane] = F.lane == 0 ? s : 0.f;
    }
}
__device__ __forceinline__ void p5_final(Frame& F) {
    const int gw = F.vcu * NWAVES + F.wave, NGW = F.G * NWAVES;
    const float* rowss = (const float*)(F.ws + WS_ROWSS); const float* g = (const float*)inptr(F, 23);
    f32x4 gv[4];
#pragma unroll
    for (int j = 0; j < 4; ++j) gv[j] = ((const f32x4*)g)[F.lane + 64 * j];
    for (int m = gw; m < M; m += NGW) {
        float ss = F.lane < 16 ? rowss[(size_t)m * 16 + F.lane] : 0.f;
        ss = wave_sum(ss);
        const float rstd = rsqrtf(ss * (1.f / D) + NORM_EPS);
        GAS f32x4* xr = (GAS f32x4*)(F.out + (size_t)m * D) + F.lane;
#pragma unroll
        for (int j = 0; j < 4; ++j) { f32x4 v = xr[64 * j]; v = v * rstd * gv[j]; xr[64 * j] = v; }
    }
}
__device__ __forceinline__ float dotbf(const bf16* a, const bf16* b, int K) {
    float acc = 0.f;
#pragma unroll 2
    for (int k = 0; k < K; k += 8) {
        const v4u av = *(const v4u*)(a + k), bv = *(const v4u*)(b + k);
#pragma unroll
        for (int i = 0; i < 4; ++i) {
            acc += __uint_as_float(av[i] << 16) * __uint_as_float(bv[i] << 16);
            acc += __uint_as_float(av[i] & 0xffff0000u) * __uint_as_float(bv[i] & 0xffff0000u);
        }
    }
    return acc;
}
__device__ __forceinline__ void p2_mla_token(Frame& F, int l, int m, LAS float* raw) {
    const bf16* Pmla = (const bf16*)(F.ws + WS_PMLA);
    const bf16* WuqT = (const bf16*)(F.ws + WS_WSMALL + OFF_WUQ) + (size_t)l * 576 * 192;
    const bf16* WukvT = (const bf16*)(F.ws + WS_WSMALL + OFF_WUKV) + (size_t)l * 768 * 128;
    bf16* Q = (bf16*)(F.ws + WS_Q); bf16* Kb = (bf16*)(F.ws + WS_K); bf16* Vt = (bf16*)(F.ws + WS_VT);
    const int lane = F.lane, b = m / SEQ, t = m % SEQ;
    const bf16* p = Pmla + (size_t)m * 352;
    float s1 = 0.f, s2 = 0.f;
    for (int c = lane; c < 192; c += 64) { const float v = bf2f(p[c]); s1 += v * v; }
    for (int c = lane; c < 128; c += 64) { const float v = bf2f(p[192 + c]); s2 += v * v; }
    s1 = wave_sum(s1); s2 = wave_sum(s2);
    const float rq = rsqrtf(s1 * (1.f / 192.f) + NORM_EPS), rkv = rsqrtf(s2 * (1.f / 128.f) + NORM_EPS);
#pragma unroll 1
    for (int c = lane; c < 576; c += 64) raw[c] = dotbf(p, WuqT + (size_t)c * 192, 192) * rq;
#pragma unroll 1
    for (int c = lane; c < 768; c += 64) raw[576 + c] = dotbf(p + 192, WukvT + (size_t)c * 128, 128) * rkv;
    LDS_WAIT(); asm volatile("" ::: "memory");
    const float pos = (float)((const int*)inptr(F, 1))[m];
    const float qs = 0.10206207261596575f * LOG2E;
#pragma unroll 1
    for (int i = lane; i < 6 * 80; i += 64) {
        const int h = i / 80, j = i % 80;
        bf16* qo = Q + (((size_t)b * 6 + h) * SEQ + t) * 96;
        if (j < 64) qo[j] = f2bf(raw[h * 96 + j] * qs);
        else { const int r = j - 64; const float inv = exp2f(-(float)r * (13.287712379549449f / 16.f)); float sn, cs; sincosf(pos * inv, &sn, &cs);
            const float x1 = raw[h * 96 + 64 + r], x2 = raw[h * 96 + 80 + r];
            qo[64 + r] = f2bf((x1 * cs - x2 * sn) * qs); qo[80 + r] = f2bf((x2 * cs + x1 * sn) * qs); }
    }
#pragma unroll 1
    for (int i = lane; i < 6 * 64; i += 64) {
        const int h = i / 64, j = i % 64;
        Kb[(((size_t)b * 6 + h) * SEQ + t) * 96 + j] = f2bf(raw[576 + h * 128 + j]);
        Vt[(((size_t)b * 6 + h) * 64 + j) * SEQ + t] = f2bf(raw[576 + h * 128 + 64 + j]);
    }
    if (lane < 16) {
        const int r = lane; const float inv = exp2f(-(float)r * (13.287712379549449f / 16.f)); float sn, cs; sincosf(pos * inv, &sn, &cs);
        const float x1 = bf2f(p[320 + r]), x2 = bf2f(p[336 + r]);
        const bf16 o1 = f2bf(x1 * cs - x2 * sn), o2 = f2bf(x2 * cs + x1 * sn);
        for (int h = 0; h < 6; ++h) { bf16* ko = Kb + (((size_t)b * 6 + h) * SEQ + t) * 96; ko[64 + r] = o1; ko[80 + r] = o2; }
    }
    LDS_WAIT(); asm volatile("" ::: "memory");
}
__device__ __forceinline__ void p2_rwkv_token(Frame& F, int l, int m, LAS float* f, int c) {
    const bf16* Prw = (const bf16*)(F.ws + WS_PRW);
    const float* mu = (const float*)inptr(F, 12) + l * 2 * 896; const float* w0 = (const float*)inptr(F, 13) + l * 512; const float* w2 = (const float*)inptr(F, 14) + (size_t)l * 2 * 64 * 256;
    const float* a0 = (const float*)inptr(F, 15) + l * 512; const float* a2 = (const float*)inptr(F, 16) + (size_t)l * 2 * 64 * 256;
    const float* k_k = (const float*)inptr(F, 17) + l * 256; const float* k_a = (const float*)inptr(F, 18) + l * 256; const float* r_k = (const float*)inptr(F, 19) + l * 256;
    unsigned char* Rs = F.ws + WS_RS; unsigned char* Rd = F.ws + WS_RD; float* cb = (float*)(F.ws + WS_CB);
    const int b = m / SEQ, t = m % SEQ, h = c >> 6, j = c & 63;
#pragma unroll 1
    for (int i = c; i < 896; i += 256) {
        const float x = bf2f(Prw[(size_t)m * 896 + i]);
        const float xp = t > 0 ? bf2f(Prw[(size_t)(m - 1) * 896 + i]) : 0.f;
        const float xn = t < SEQ - 1 ? bf2f(Prw[(size_t)(m + 1) * 896 + i]) : 0.f;
        float v = x + mu[i] * (xp - x) + mu[896 + i] * (xn - x);
        if (i >= 768 && i < 832) v = tanhf(v);
        f[i] = v;
    }
    __syncthreads();
    const float r = f[c], k = f[256 + c], v = f[512 + c];
    const float kkr = k * k_k[c];
    const float kn = wave_sum(kkr * kkr);
    const float kk = kkr * rsqrtf(kn + 1e-6f);
    float kmod[2], bb[2], lam[2];
#pragma unroll
    for (int e = 0; e < 2; ++e) {
        float lw = 0.f, la = 0.f;
#pragma unroll 8
        for (int d = 0; d < 64; ++d) { lw += f[768 + d] * w2[((size_t)e * 64 + d) * 256 + c]; la += f[832 + d] * a2[((size_t)e * 64 + d) * 256 + c]; }
        const float wl = -softplusf_(-(w0[e * 256 + c] + lw)) - 0.5f;
        lam[e] = __expf(wl);
        const float a = sigmoidf_(a0[e * 256 + c] + la);
        kmod[e] = k * (1.f + (a - 1.f) * k_a[c]);
        bb[e] = a * kk;
    }
    unsigned char* rs = Rs + (((size_t)b * 4 + h) * SEQ + t) * RS_REC;
    ((bf16*)rs)[j] = f2bf(kk); ((bf16*)(rs + 128))[j] = f2bf(v); ((bf16*)(rs + 256))[j] = f2bf(r);
#pragma unroll
    for (int e = 0; e < 2; ++e) {
        unsigned char* rd = Rd + e * RD_DIR + (((size_t)b * 4 + h) * SEQ + t) * RD_REC;
        ((__half*)rd)[j] = __float2half(lam[e]); ((bf16*)(rd + 128))[j] = f2bf(bb[e]); ((bf16*)(rd + 256))[j] = f2bf(kmod[e]);
        const float br = wave_sum(bb[e] * r), kr = wave_sum(kmod[e] * r);
        if (j == 0) { ((float*)(rd + 384))[0] = br; ((float*)(rd + 384))[1] = kr; }
    }
    const float cbv = wave_sum(r * 0.5f * (kmod[0] + kmod[1]) * r_k[c]);
    if (j == 0) cb[(size_t)m * 4 + h] = cbv;
    __syncthreads();
}
__device__ __forceinline__ void p2_prep(Frame& F, int l) {
    { LAS float* f = (LAS float*)(F.lds + RING_OFF) + (F.tid >> 8) * 896; const int c = F.tid & 255;
      for (int m = 2 * (int)blockIdx.x + (F.tid >> 8); m < M; m += 2 * F.G) p2_rwkv_token(F, l, m, f, c); }
    { LAS float* raw = (LAS float*)(F.lds + RING_OFF + 8192) + F.wave * 1344;
      const int gw = F.vcu * NWAVES + F.wave, NGW = F.G * NWAVES;
      for (int m = gw; m < M; m += NGW) p2_mla_token(F, l, m, raw); }
}
__device__ __forceinline__ void p4a_mix(Frame& F, int l) {
    const bf16* Ogdn = (const bf16*)(F.ws + WS_OGDN); const bf16* Omla = (const bf16*)(F.ws + WS_OMLA); const bf16* Y = (const bf16*)(F.ws + WS_Y);
    const bf16* Pgate = (const bf16*)(F.ws + WS_PGATE); const unsigned char* Rs = F.ws + WS_RS; const float* cb = (const float*)(F.ws + WS_CB); bf16* mix = (bf16*)(F.ws + WS_MIX);
    const float* gdn_g = (const float*)inptr(F, 7) + l * 64; const float* ln_g = (const float*)inptr(F, 20) + l * 256; const float* ln_b = (const float*)inptr(F, 21) + l * 256;
    const int gw = F.vcu * NWAVES + F.wave, NGW = F.G * NWAVES, j = F.lane;
    const float gg = gdn_g[j];
    for (int m = gw; m < M; m += NGW) {
        const int b = m / SEQ, t = m % SEQ;
#pragma unroll 2
        for (int g = 0; g < 16; ++g) {
            const int c = g * 64 + j; float val;
            if (g < 6) { const float o = bf2f(Ogdn[(size_t)m * 384 + c]); const float ss = wave_sum(o * o); val = o * rsqrtf(ss * (1.f / 64.f) + NORM_EPS) * gg; }
            else if (g < 12) val = bf2f(Omla[(size_t)m * 384 + (c - 384)]);
            else { const int cc = c - 768, h = g - 12; const float y = bf2f(Y[(size_t)m * 256 + cc]);
                const float mean = wave_sum(y) * (1.f / 64.f); const float dv = y - mean; const float var = wave_sum(dv * dv) * (1.f / 64.f);
                const float v = bf2f(((const bf16*)(Rs + (((size_t)b * 4 + h) * SEQ + t) * RS_REC + 128))[j]);
                val = dv * rsqrtf(var + 64e-5f) * ln_g[cc] + ln_b[cc] + cb[(size_t)m * 4 + h] * v; }
            mix[(size_t)m * 1024 + c] = f2bf(val * siluf(bf2f(Pgate[(size_t)m * 1024 + c])));
        }
    }
}
typedef float f32x16 __attribute__((ext_vector_type(16)));
typedef unsigned long long u64_t;
__device__ __forceinline__ bf16x8 mk_bf16x8(u64_t lo, u64_t hi) { typedef u64_t u64x2 __attribute__((ext_vector_type(2))); u64x2 v = {lo, hi}; return __builtin_bit_cast(bf16x8, v); }

constexpr int AT_KP = 208, AT_VP = 136, AT_KBYTES = 64 * AT_KP, AT_VBYTES = 64 * AT_VP, AT_BUF = AT_KBYTES + AT_VBYTES;
__device__ __forceinline__ float at_max3(float a, float b, float c) { float r; asm("v_max3_f32 %0, %1, %2, %3" : "=v"(r) : "v"(a), "v"(b), "v"(c)); return r; }
__device__ __forceinline__ void attn_unit(Frame& F, int unit) {
    const int bh = unit >> 3, qb = unit & 7, b = bh / 6, h = bh % 6;
    const int tid = F.tid, lane = F.lane, wave = F.wave, r32 = lane & 31, hi = lane >> 5;
    const bf16* Qg = (const bf16*)(F.ws + WS_Q) + ((size_t)bh * SEQ + qb * 256 + wave * 32 + r32) * 96;
    const bf16* Kg = (const bf16*)(F.ws + WS_K) + (size_t)bh * SEQ * 96;
    const bf16* Vg = (const bf16*)(F.ws + WS_VT) + (size_t)bh * 64 * SEQ;
    LAS unsigned char* lds = F.lds + RING_OFF;
    bf16x8 qf[6];
#pragma unroll
    for (int s = 0; s < 6; ++s) qf[s] = *(const bf16x8*)(Qg + 16 * s + 8 * hi);
    const int kr0 = tid / 12, kc0 = tid % 12, kr1 = (512 + tid) / 12, kc1 = (512 + tid) % 12, vd = tid >> 3, vc = tid & 7;
    const bool has1 = tid < 256;
    v4u ka0, ka1 = {0u, 0u, 0u, 0u}, va, kb0, kb1 = {0u, 0u, 0u, 0u}, vb;
#define AT_LOAD(K0, K1, V_, t0) do { K0 = *(const v4u*)(Kg + (size_t)((t0) + kr0) * 96 + kc0 * 8); if (has1) K1 = *(const v4u*)(Kg + (size_t)((t0) + kr1) * 96 + kc1 * 8); \
        V_ = *(const v4u*)(Vg + (size_t)vd * SEQ + (t0) + vc * 8); } while (0)
#define AT_STORE(K0, K1, V_, buf) do { LAS unsigned char* bb_ = lds + (buf) * AT_BUF; *(LAS v4u*)(bb_ + kr0 * AT_KP + kc0 * 16) = K0; if (has1) *(LAS v4u*)(bb_ + kr1 * AT_KP + kc1 * 16) = K1; \
        LAS u64_t* vp_ = (LAS u64_t*)(bb_ + AT_KBYTES + vd * AT_VP + vc * 16); vp_[0] = (u64_t)V_.x | ((u64_t)V_.y << 32); vp_[1] = (u64_t)V_.z | ((u64_t)V_.w << 32); } while (0)
    AT_LOAD(ka0, ka1, va, 0); AT_STORE(ka0, ka1, va, 0);
    AT_LOAD(ka0, ka1, va, 64);
    __syncthreads();
    f32x16 o0 = {}, o1 = {};
    float mrun = -1e30f, lsum = 0.f;
    constexpr int NT = SEQ / 64;
    auto tile = [&](int t) {
        LAS unsigned char* bb = lds + (t % 3) * AT_BUF;
        f32x16 p0 = {}, p1 = {};
        { const LAS unsigned char* kb = bb + r32 * AT_KP + hi * 16;
#pragma unroll
          for (int s = 0; s < 6; ++s) {
              const bf16x8 a0 = *(const LAS bf16x8*)(kb + 32 * s), a1 = *(const LAS bf16x8*)(kb + 32 * AT_KP + 32 * s);
              p0 = __builtin_amdgcn_mfma_f32_32x32x16_bf16(a0, qf[s], p0, 0, 0, 0);
              p1 = __builtin_amdgcn_mfma_f32_32x32x16_bf16(a1, qf[s], p1, 0, 0, 0); } }
        float ma = at_max3(p0[0], p0[1], p1[0]), mb = at_max3(p0[2], p0[3], p1[1]); ma = at_max3(ma, p1[2], p1[3]);
#pragma unroll
        for (int r = 4; r < 16; r += 4) { ma = at_max3(ma, p0[r], p0[r + 1]); mb = at_max3(mb, p0[r + 2], p0[r + 3]); ma = at_max3(ma, p1[r], p1[r + 1]); mb = at_max3(mb, p1[r + 2], p1[r + 3]); }
        float mloc = at_max3(ma, mb, mrun);
        { const auto rr = __builtin_amdgcn_permlane32_swap(__float_as_uint(mloc), __float_as_uint(mloc), false, false); mloc = at_max3(__uint_as_float(rr[0]), __uint_as_float(rr[1]), mloc); }
        const float mnew = mloc, alpha = __builtin_amdgcn_exp2f(mrun - mnew);
        mrun = mnew; lsum *= alpha;
#pragma unroll
        for (int r = 0; r < 16; ++r) { o0[r] *= alpha; o1[r] *= alpha; }
        float ps = 0.f;
#pragma unroll
        for (int r = 0; r < 16; ++r) { p0[r] = __builtin_amdgcn_exp2f(p0[r] - mnew); p1[r] = __builtin_amdgcn_exp2f(p1[r] - mnew); ps += p0[r] + p1[r]; }
        lsum += ps;
        v4u pk[4];
#pragma unroll
        for (int s2 = 0; s2 < 2; ++s2) {
            pk[s2] = (v4u){pg8::cvt_pk_bf16(p0[8 * s2], p0[8 * s2 + 1]), pg8::cvt_pk_bf16(p0[8 * s2 + 2], p0[8 * s2 + 3]), pg8::cvt_pk_bf16(p0[8 * s2 + 4], p0[8 * s2 + 5]), pg8::cvt_pk_bf16(p0[8 * s2 + 6], p0[8 * s2 + 7])};
            pk[2 + s2] = (v4u){pg8::cvt_pk_bf16(p1[8 * s2], p1[8 * s2 + 1]), pg8::cvt_pk_bf16(p1[8 * s2 + 2], p1[8 * s2 + 3]), pg8::cvt_pk_bf16(p1[8 * s2 + 4], p1[8 * s2 + 5]), pg8::cvt_pk_bf16(p1[8 * s2 + 6], p1[8 * s2 + 7])};
        }
        { const LAS unsigned char* vb_ = bb + AT_KBYTES + r32 * AT_VP + hi * 8;
#pragma unroll
          for (int ks = 0; ks < 4; ++ks) {
              const bf16x8 pb = __builtin_bit_cast(bf16x8, pk[ks]);
              const bf16x8 v0 = mk_bf16x8(*(const LAS u64_t*)(vb_ + ks * 32), *(const LAS u64_t*)(vb_ + ks * 32 + 16));
              const bf16x8 v1 = mk_bf16x8(*(const LAS u64_t*)(vb_ + 32 * AT_VP + ks * 32), *(const LAS u64_t*)(vb_ + 32 * AT_VP + ks * 32 + 16));
              o0 = __builtin_amdgcn_mfma_f32_32x32x16_bf16(v0, pb, o0, 0, 0, 0);
              o1 = __builtin_amdgcn_mfma_f32_32x32x16_bf16(v1, pb, o1, 0, 0, 0); } }
    };
    for (int t = 0; t < NT; t += 2) {
        if (t + 2 < NT) AT_LOAD(kb0, kb1, vb, (t + 2) * 64);
        tile(t);
        AT_STORE(ka0, ka1, va, (t + 1) % 3);
        __syncthreads();
        if (t + 3 < NT) AT_LOAD(ka0, ka1, va, (t + 3) * 64);
        tile(t + 1);
        if (t + 2 < NT) AT_STORE(kb0, kb1, vb, (t + 2) % 3);
        __syncthreads();
    }
#undef AT_LOAD
#undef AT_STORE
    lsum += __shfl_xor(lsum, 32);
    const float inv = 1.f / lsum;
    bf16* Og = (bf16*)(F.ws + WS_OMLA) + ((size_t)b * SEQ + qb * 256 + wave * 32 + r32) * 384 + h * 64 + 4 * hi;
#pragma unroll
    for (int rg = 0; rg < 4; ++rg) {
        *(u64_t*)(Og + 8 * rg) = (u64_t)pg8::cvt_pk_bf16(o0[4 * rg] * inv, o0[4 * rg + 1] * inv) | ((u64_t)pg8::cvt_pk_bf16(o0[4 * rg + 2] * inv, o0[4 * rg + 3] * inv) << 32);
        *(u64_t*)(Og + 32 + 8 * rg) = (u64_t)pg8::cvt_pk_bf16(o1[4 * rg] * inv, o1[4 * rg + 1] * inv) | ((u64_t)pg8::cvt_pk_bf16(o1[4 * rg + 2] * inv, o1[4 * rg + 3] * inv) << 32);
    }
}

constexpr int CW_FLAG = 32768;
__device__ __forceinline__ void partner_sync(Frame& F, gu32* mine, gu32* theirs) {
    asm volatile("s_waitcnt vmcnt(0)" ::: "memory");
    __syncthreads();
    if (F.tid == 0) {
        __builtin_amdgcn_fence(__ATOMIC_RELEASE, "agent");
        asm volatile("s_waitcnt vmcnt(0)" ::: "memory");
        __hip_atomic_store(mine, 1u, RLX_AGENT);
        unsigned spins = 0;
        while (__hip_atomic_load(theirs, RLX_AGENT) == 0u) { __builtin_amdgcn_s_sleep(4); if (++spins > (1u << 22)) break; }
        __builtin_amdgcn_fence(__ATOMIC_ACQUIRE, "agent");
        asm volatile("s_waitcnt vmcnt(0)" ::: "memory");
    }
    __syncthreads();
}
constexpr int RW_STEP = 1440, RW_CH = 32, RW_BUF = RW_CH * RW_STEP;
constexpr int RW_Y = 2 * RW_BUF;
static_assert(RW_Y + 2 * 4096 <= RING_BYTES, "RWKV LDS map");
__device__ __forceinline__ float dpp_xor1(float x) { return __builtin_bit_cast(float, __builtin_amdgcn_update_dpp(0, __builtin_bit_cast(int, x), 0xB1, 0xF, 0xF, true)); }
__device__ __forceinline__ float dpp_xor2(float x) { return __builtin_bit_cast(float, __builtin_amdgcn_update_dpp(0, __builtin_bit_cast(int, x), 0x4E, 0xF, 0xF, true)); }
__device__ __forceinline__ float dpp_hmir(float x) { return __builtin_bit_cast(float, __builtin_amdgcn_update_dpp(0, __builtin_bit_cast(int, x), 0x141, 0xF, 0xF, true)); }
__device__ __forceinline__ float dpp_rmir(float x) { return __builtin_bit_cast(float, __builtin_amdgcn_update_dpp(0, __builtin_bit_cast(int, x), 0x140, 0xF, 0xF, true)); }
template <int SKIP> __device__ __forceinline__ void rwkv_unit(Frame& F, int unit, gu32* flags) {
    const int bh = unit >> 2, rowhalf = (unit >> 1) & 1, dir = unit & 1, b = bh >> 2, h = bh & 3;
    const int tid = F.tid, lane = F.lane, ri = lane >> 4, cs = lane & 15, row = 4 * F.wave + ri;
    const bool stager = true;
    const unsigned char* Rs = F.ws + WS_RS + (size_t)bh * SEQ * RS_REC;
    const unsigned char* Rd = F.ws + WS_RD + dir * RD_DIR + (size_t)bh * SEQ * RD_REC;
    LAS unsigned char* lds = F.lds + RING_OFF;
    const int ss = tid >> 4, sp = tid & 15;
    u64_t g_kk = 0, g_r = 0, g_lam = 0, g_b = 0, g_k = 0, g_v = 0, g_s = 0;
#define RW_ISSUE(c_) do { const int n_ = (c_) * RW_CH + ss, t_ = dir ? SEQ - 1 - n_ : n_; const unsigned char* rs_ = Rs + (size_t)t_ * RS_REC; const unsigned char* rd_ = Rd + (size_t)t_ * RD_REC; \
        g_kk = *(const u64_t*)(rs_ + 8 * sp); g_r = *(const u64_t*)(rs_ + 256 + 8 * sp); g_lam = *(const u64_t*)(rd_ + 8 * sp); g_b = *(const u64_t*)(rd_ + 128 + 8 * sp); g_k = *(const u64_t*)(rd_ + 256 + 8 * sp); \
        if (sp < 8) g_v = *(const u64_t*)(rs_ + 128 + 64 * rowhalf + 8 * sp); if (sp == 8) g_s = *(const u64_t*)(rd_ + 384); } while (0)
#define RW_BF(x, j) __uint_as_float(((unsigned)((x) >> (16 * (j)))) << 16)
#define RW_STAGE(buf_) do { LAS unsigned char* d_ = lds + (buf_) * RW_BUF + ss * RW_STEP + 16 * sp; f32x4 w_, t4_; \
        w_[0] = __builtin_amdgcn_exp2f(-LOG2E * __half2float(__ushort_as_half((unsigned short)(g_lam)))); w_[1] = __builtin_amdgcn_exp2f(-LOG2E * __half2float(__ushort_as_half((unsigned short)(g_lam >> 16)))); \
        w_[2] = __builtin_amdgcn_exp2f(-LOG2E * __half2float(__ushort_as_half((unsigned short)(g_lam >> 32)))); w_[3] = __builtin_amdgcn_exp2f(-LOG2E * __half2float(__ushort_as_half((unsigned short)(g_lam >> 48)))); \
        *(LAS f32x4*)d_ = w_; \
        t4_ = (f32x4){RW_BF(g_r, 0), RW_BF(g_r, 1), RW_BF(g_r, 2), RW_BF(g_r, 3)}; *(LAS f32x4*)(d_ + 256) = w_ * t4_; \
        t4_ = (f32x4){RW_BF(g_kk, 0), RW_BF(g_kk, 1), RW_BF(g_kk, 2), RW_BF(g_kk, 3)}; *(LAS f32x4*)(d_ + 512) = -t4_; \
        t4_ = (f32x4){RW_BF(g_b, 0), RW_BF(g_b, 1), RW_BF(g_b, 2), RW_BF(g_b, 3)}; *(LAS f32x4*)(d_ + 768) = t4_; \
        t4_ = (f32x4){RW_BF(g_k, 0), RW_BF(g_k, 1), RW_BF(g_k, 2), RW_BF(g_k, 3)}; *(LAS f32x4*)(d_ + 1024) = t4_; \
        if (sp < 8) { t4_ = (f32x4){RW_BF(g_v, 0), RW_BF(g_v, 1), RW_BF(g_v, 2), RW_BF(g_v, 3)}; *(LAS f32x4*)(d_ + 1280) = t4_; } \
        if (sp == 8) *(LAS u64_t*)(lds + (buf_) * RW_BUF + ss * RW_STEP + 1408) = g_s; } while (0)
    f32x4 S0 = {0.f, 0.f, 0.f, 0.f};
    if (stager) { RW_ISSUE(0); RW_STAGE(0); }
    __syncthreads();
    bf16* Yg = (bf16*)(F.ws + WS_Y) + (size_t)b * SEQ * 256 + h * 64 + 32 * rowhalf;
    const int NCH = SEQ / RW_CH;
    for (int c = 0; c < NCH; ++c) {
        LAS float* ybuf = (LAS float*)(lds + RW_Y + (c & 1) * 4096);
        if (stager && c + 1 < NCH) RW_ISSUE(c + 1);
        unsigned short yold[2] = {0, 0};
        if (c >= NCH / 2) {
#pragma unroll
            for (int k = 0; k < 2; ++k) { const int o = tid + 512 * k, n = c * RW_CH + (o >> 5), t = dir ? SEQ - 1 - n : n; yold[k] = Yg[(size_t)t * 256 + (o & 31)]; } }
        { const LAS unsigned char* cb_ = lds + (c & 1) * RW_BUF + 16 * cs;
          const LAS unsigned char* vb_ = lds + (c & 1) * RW_BUF + 1280 + 4 * row;
#pragma unroll 4
          for (int s = 0; s < RW_CH; ++s) {
              const LAS unsigned char* p = cb_ + ((SKIP & 2) ? 0 : s) * RW_STEP;
              const f32x4 w = *(const LAS f32x4*)p, wr = *(const LAS f32x4*)(p + 256), nk = *(const LAS f32x4*)(p + 512), bb = *(const LAS f32x4*)(p + 768), kv = *(const LAS f32x4*)(p + 1024);
              typedef float f2 __attribute__((ext_vector_type(2)));
              const float v = *(const LAS float*)(vb_ + s * RW_STEP); const f2 brkr = *(const LAS f2*)(lds + (c & 1) * RW_BUF + s * RW_STEP + 1408);
              float sa0 = (S0[0] * nk[0] + S0[1] * nk[1]) + (S0[2] * nk[2] + S0[3] * nk[3]);
              float ym0 = (S0[0] * wr[0] + S0[1] * wr[1]) + (S0[2] * wr[2] + S0[3] * wr[3]);
              if (!(SKIP & 1)) {
              sa0 += dpp_xor1(sa0); ym0 += dpp_xor1(ym0);
              sa0 += dpp_xor2(sa0); ym0 += dpp_xor2(ym0);
              sa0 += dpp_hmir(sa0); ym0 += dpp_hmir(ym0);
              sa0 += dpp_rmir(sa0); ym0 += dpp_rmir(ym0); }
              S0 = S0 * w + (sa0 * bb + v * kv);
              if (cs == 0) ybuf[s * 32 + row] = ym0 + sa0 * brkr[0] + v * brkr[1];
          } }
        if (stager && c + 1 < NCH) RW_STAGE((c + 1) & 1);
        __syncthreads();
#pragma unroll
        for (int k = 0; k < 2; ++k) { const int o = tid + 512 * k, n = c * RW_CH + (o >> 5), t = dir ? SEQ - 1 - n : n;
            float y = ybuf[o]; if (c >= NCH / 2) y += bf2f(yold[k]);
            Yg[(size_t)t * 256 + (o & 31)] = (bf16)f2bf(y); }
        if (c == NCH / 2 - 1) partner_sync(F, flags + 64 * unit, flags + 64 * (unit ^ 1));
    }
#undef RW_ISSUE
#undef RW_STAGE
#undef RW_BF
    __syncthreads();
}

__device__ __forceinline__ void gdn_unit(Frame& F, int l, int unit) {
    const int bh = unit, b = bh / 6, h = bh % 6, e = F.lane, dir = F.wave;
    const bf16* Pgdn = (const bf16*)(F.ws + WS_PGDN); const float* Psm = (const float*)(F.ws + WS_PSM); bf16* Ogdn = (bf16*)(F.ws + WS_OGDN);
    const float* conv_w = (const float*)inptr(F, 4) + (size_t)l * 5 * 1152; const float* a_log = (const float*)inptr(F, 5) + l * 12; const float* dt_bias = (const float*)inptr(F, 6) + l * 12;
    LAS float* qs = (LAS float*)(F.lds + RING_OFF) + F.wave * 128; LAS float* ks = qs + 64;
    if (F.wave < 2) {
        float S[64];
#pragma unroll
        for (int i = 0; i < 64; ++i) S[i] = 0.f;
        float cw[3][5];
#pragma unroll
        for (int i = 0; i < 5; ++i) { cw[0][i] = conv_w[i * 1152 + h * 64 + e]; cw[1][i] = conv_w[i * 1152 + 384 + h * 64 + e]; cw[2][i] = conv_w[i * 1152 + 768 + h * 64 + e]; }
        const float al = -__expf(a_log[dir * 6 + h]), dtb = dt_bias[dir * 6 + h];
        for (int n = 0; n < SEQ; ++n) {
            if (n == SEQ / 2) { asm volatile("s_waitcnt vmcnt(0)" ::: "memory"); __syncthreads(); }
            const int t = dir ? SEQ - 1 - n : n; const size_t m = (size_t)b * SEQ + t;
            float cq = 0.f, ck = 0.f, cv = 0.f;
#pragma unroll
            for (int i = 0; i < 5; ++i) { const int tt = t + i - 2; if (tt >= 0 && tt < SEQ) { const bf16* pr = Pgdn + ((size_t)b * SEQ + tt) * 1152 + h * 64 + e;
                    cq += cw[0][i] * bf2f(pr[0]); ck += cw[1][i] * bf2f(pr[384]); cv += cw[2][i] * bf2f(pr[768]); } }
            cq = siluf(cq); ck = siluf(ck); cv = siluf(cv);
            const float qn = cq * rsqrtf(wave_sum(cq * cq) + 1e-6f) * 0.125f, kn = ck * rsqrtf(wave_sum(ck * ck) + 1e-6f);
            LDS_WAIT(); asm volatile("" ::: "memory");
            qs[e] = qn; ks[e] = kn;
            LDS_WAIT(); asm volatile("" ::: "memory");
            const float g = al * softplusf_(Psm[m * 32 + dir * 6 + h] + dtb), beta = sigmoidf_(Psm[m * 32 + 12 + dir * 6 + h]), alpha = __expf(g);
            float kS = 0.f;
#pragma unroll
            for (int c4 = 0; c4 < 16; ++c4) { const f32x4 kq = ((const LAS f32x4*)ks)[c4];
                kS += (kq.x * S[4 * c4] + kq.y * S[4 * c4 + 1]) + (kq.z * S[4 * c4 + 2] + kq.w * S[4 * c4 + 3]);
                if ((c4 & 3) == 3) asm volatile("" ::: "memory"); }
            const float coef = beta * (cv - alpha * kS);
            float o = 0.f;
#pragma unroll
            for (int c4 = 0; c4 < 16; ++c4) { const f32x4 kq = ((const LAS f32x4*)ks)[c4], qq = ((const LAS f32x4*)qs)[c4];
                S[4 * c4] = alpha * S[4 * c4] + coef * kq.x; S[4 * c4 + 1] = alpha * S[4 * c4 + 1] + coef * kq.y; S[4 * c4 + 2] = alpha * S[4 * c4 + 2] + coef * kq.z; S[4 * c4 + 3] = alpha * S[4 * c4 + 3] + coef * kq.w;
                o += (qq.x * S[4 * c4] + qq.y * S[4 * c4 + 1]) + (qq.z * S[4 * c4 + 2] + qq.w * S[4 * c4 + 3]);
                if ((c4 & 3) == 3) asm volatile("" ::: "memory"); }
            bf16* op = Ogdn + m * 384 + h * 64 + e;
            if (n >= SEQ / 2) o += bf2f(*op);
            *op = (bf16)f2bf(o);
        }
    } else { __syncthreads(); }
}

constexpr int GP = 144;
constexpr int G_Q = 0, G_K = 9216, G_V = 18432, G_KT = 27648, G_P = 36864, G_A = 46080, G_SM = 63488, G_GROUP = 64512;
constexpr int G_T = 92160;
constexpr int G_RAW = 65536;
constexpr int G_CW = 133120;
static_assert(2 * G_GROUP <= RING_BYTES && G_CW + 3840 <= LDS_BYTES && G_CW >= MISC_OFF + 1024, "GDN LDS map");
__device__ __forceinline__ bf16x8 ld2x8(const LAS unsigned char* p) { return mk_bf16x8(*(const LAS u64_t*)p, *(const LAS u64_t*)(p + 32)); }
__device__ __forceinline__ bf16x8 pack_acc(const f32x4& a, const f32x4& b) {
    v4u w; w.x = pg8::cvt_pk_bf16(a[0], a[1]); w.y = pg8::cvt_pk_bf16(a[2], a[3]); w.z = pg8::cvt_pk_bf16(b[0], b[1]); w.w = pg8::cvt_pk_bf16(b[2], b[3]); return __builtin_bit_cast(bf16x8, w); }
__device__ __forceinline__ void split_acc(const f32x4& a, const f32x4& b, bf16x8& hi, bf16x8& lo) {
    v4u wh; wh.x = pg8::cvt_pk_bf16(a[0], a[1]); wh.y = pg8::cvt_pk_bf16(a[2], a[3]); wh.z = pg8::cvt_pk_bf16(b[0], b[1]); wh.w = pg8::cvt_pk_bf16(b[2], b[3]);
    f32x4 ra, rb;
    ra[0] = a[0] - __uint_as_float(wh.x << 16); ra[1] = a[1] - __uint_as_float(wh.x & 0xffff0000u); ra[2] = a[2] - __uint_as_float(wh.y << 16); ra[3] = a[3] - __uint_as_float(wh.y & 0xffff0000u);
    rb[0] = b[0] - __uint_as_float(wh.z << 16); rb[1] = b[1] - __uint_as_float(wh.z & 0xffff0000u); rb[2] = b[2] - __uint_as_float(wh.w << 16); rb[3] = b[3] - __uint_as_float(wh.w & 0xffff0000u);
    hi = __builtin_bit_cast(bf16x8, wh); lo = pack_acc(ra, rb);
}
__device__ __forceinline__ void hilo4(const f32x4& a, u64_t& hi, u64_t& lo) {
    const unsigned h0 = pg8::cvt_pk_bf16(a[0], a[1]), h1 = pg8::cvt_pk_bf16(a[2], a[3]);
    const float r0 = a[0] - __uint_as_float(h0 << 16), r1 = a[1] - __uint_as_float(h0 & 0xffff0000u), r2 = a[2] - __uint_as_float(h1 << 16), r3 = a[3] - __uint_as_float(h1 & 0xffff0000u);
    hi = (u64_t)h0 | ((u64_t)h1 << 32); lo = (u64_t)pg8::cvt_pk_bf16(r0, r1) | ((u64_t)pg8::cvt_pk_bf16(r2, r3) << 32);
}
typedef _Float16 f16x8 __attribute__((ext_vector_type(8)));
__device__ __forceinline__ f16x8 pack_acc_f16(const f32x4& a, const f32x4& b) { return (f16x8){(_Float16)a[0], (_Float16)a[1], (_Float16)a[2], (_Float16)a[3], (_Float16)b[0], (_Float16)b[1], (_Float16)b[2], (_Float16)b[3]}; }
template <int SKIP> __device__ __forceinline__ void gdn_unit3(Frame& F, int l, int unit, gu32* flags) {
    const int bh = unit >> 1, dir = unit & 1, b = bh / 6, h = bh % 6;
    const int tid = F.tid, lane = F.lane, wave = F.wave;
    const bf16* Pgdn = (const bf16*)(F.ws + WS_PGDN) + (size_t)b * SEQ * 1152 + h * 64; const float* Psm = (const float*)(F.ws + WS_PSM) + (size_t)b * SEQ * 32;
    bf16* Og = (bf16*)(F.ws + WS_OGDN) + (size_t)b * SEQ * 384 + h * 64;
    LAS unsigned char* gb = F.lds + RING_OFF;
    LAS float* cwl = (LAS float*)(F.lds + G_CW);
    LAS float* sm = (LAS float*)(gb + G_SM);
    { const float* conv_w = (const float*)inptr(F, 4) + (size_t)l * 5 * 1152;
      for (int i = tid; i < 960; i += 512) { const int tn = i / 320, tap = (i % 320) / 64, ch = i % 64; cwl[i] = conv_w[tap * 1152 + tn * 384 + h * 64 + ch]; } }
    const float al = -__expf(((const float*)inptr(F, 5))[l * 12 + dir * 6 + h]), dtb = ((const float*)inptr(F, 6))[l * 12 + dir * 6 + h];
    f32x4 Sacc[4];
#pragma unroll
    for (int i = 0; i < 4; ++i) Sacc[i] = (f32x4){0.f, 0.f, 0.f, 0.f};
    const int ci = tid >> 3, cg = tid & 7;
#define GDN_RAW_STAGE(cc_, first_, nthr_) do { const int tlo_ = (dir ? SEQ - 64 * (cc_) - 64 : 64 * (cc_)) - 2; \
        for (int pc_ = (first_); pc_ < 68 * 24; pc_ += (nthr_)) { const int rr_ = pc_ / 24, sg_ = pc_ % 24, tt_ = tlo_ + rr_; v4u x_ = {0u, 0u, 0u, 0u}; \
            if (!(SKIP & 1) && tt_ >= 0 && tt_ < SEQ) x_ = *(const v4u*)(Pgdn + (size_t)tt_ * 1152 + (sg_ >> 3) * 384 + 8 * (sg_ & 7)); \
            *(LAS v4u*)(gb + G_RAW + rr_ * 384 + 16 * sg_) = x_; } } while (0)
#define GDN_WRITEOUT(cc_) do { if (!(SKIP & 4)) { const int t_ = dir ? SEQ - 1 - 64 * (cc_) - ci : 64 * (cc_) + ci; bf16* op_ = Og + (size_t)t_ * 384 + 8 * cg; \
            const LAS f32x4* src_ = (const LAS f32x4*)(gb + G_A + (ci * 68 + 8 * cg) * 4); f32x4 o0_ = src_[0], o1_ = src_[1]; \
            if ((cc_) >= SEQ / 128) { const v4u p0_ = *(const v4u*)op_; \
                o0_ += (f32x4){__uint_as_float(p0_.x << 16), __uint_as_float(p0_.x & 0xffff0000u), __uint_as_float(p0_.y << 16), __uint_as_float(p0_.y & 0xffff0000u)}; \
                o1_ += (f32x4){__uint_as_float(p0_.z << 16), __uint_as_float(p0_.z & 0xffff0000u), __uint_as_float(p0_.w << 16), __uint_as_float(p0_.w & 0xffff0000u)}; } \
            v4u w0_; w0_.x = pg8::cvt_pk_bf16(o0_[0], o0_[1]); w0_.y = pg8::cvt_pk_bf16(o0_[2], o0_[3]); w0_.z = pg8::cvt_pk_bf16(o1_[0], o1_[1]); w0_.w = pg8::cvt_pk_bf16(o1_[2], o1_[3]); \
            *(v4u*)op_ = w0_; } } while (0)
    GDN_RAW_STAGE(0, tid, 512);
    __syncthreads();
    for (int c = 0; c < SEQ / 64; ++c) {
        if (c > 0) GDN_WRITEOUT(c - 1);
        if (c == SEQ / 128) partner_sync(F, flags + 64 * unit, flags + 64 * (unit ^ 1));
        if (wave == 0) {
            const int t = dir ? SEQ - 1 - 64 * c - lane : 64 * c + lane;
            const float a = Psm[(size_t)t * 32 + dir * 6 + h], bt = Psm[(size_t)t * 32 + 12 + dir * 6 + h];
            float x = al * softplusf_(a + dtb);
#pragma unroll
            for (int off = 1; off < 64; off <<= 1) { const float y = __shfl_up(x, off); if (lane >= off) x += y; }
            const float last = __shfl(x, 63);
            sm[lane] = x; sm[64 + lane] = sigmoidf_(bt); sm[128 + lane] = __expf(x); sm[192 + lane] = __expf(last - x);
        }
        { float acc[3][8];
#pragma unroll
          for (int tn = 0; tn < 3; ++tn)
#pragma unroll
              for (int j = 0; j < 8; ++j) acc[tn][j] = 0.f;
          const int rr0 = dir ? 63 - ci : ci;
#pragma unroll
          for (int tap = 0; tap < 5; ++tap) {
#pragma unroll
              for (int tn = 0; tn < 3; ++tn) { const v4u x0 = *(const LAS v4u*)(gb + G_RAW + (rr0 + tap) * 384 + tn * 128 + 16 * cg); const LAS float* w = cwl + tn * 320 + tap * 64 + 8 * cg; const f32x4 w0 = *(const LAS f32x4*)w, w1 = *(const LAS f32x4*)(w + 4);
                  acc[tn][0] += w0[0] * __uint_as_float(x0[0] << 16); acc[tn][1] += w0[1] * __uint_as_float(x0[0] & 0xffff0000u); acc[tn][2] += w0[2] * __uint_as_float(x0[1] << 16); acc[tn][3] += w0[3] * __uint_as_float(x0[1] & 0xffff0000u);
                  acc[tn][4] += w1[0] * __uint_as_float(x0[2] << 16); acc[tn][5] += w1[1] * __uint_as_float(x0[2] & 0xffff0000u); acc[tn][6] += w1[2] * __uint_as_float(x0[3] << 16); acc[tn][7] += w1[3] * __uint_as_float(x0[3] & 0xffff0000u); }
              asm volatile("" ::: "memory"); }
          float sq = 0.f, sk = 0.f;
#pragma unroll
          for (int j = 0; j < 8; ++j) { acc[0][j] = siluf(acc[0][j]); acc[1][j] = siluf(acc[1][j]); acc[2][j] = siluf(acc[2][j]); sq += acc[0][j] * acc[0][j]; sk += acc[1][j] * acc[1][j]; }
          sq += dpp_xor1(sq); sk += dpp_xor1(sk); sq += dpp_xor2(sq); sk += dpp_xor2(sk); sq += dpp_hmir(sq); sk += dpp_hmir(sk);
          const float rq = rsqrtf(sq + 1e-6f) * 0.125f, rk = rsqrtf(sk + 1e-6f);
          v4u wq, wk, wv;
#pragma unroll
          for (int q = 0; q < 4; ++q) { wq[q] = pg8::cvt_pk_bf16(acc[0][2 * q] * rq, acc[0][2 * q + 1] * rq); wk[q] = pg8::cvt_pk_bf16(acc[1][2 * q] * rk, acc[1][2 * q + 1] * rk); wv[q] = pg8::cvt_pk_bf16(acc[2][2 * q], acc[2][2 * q + 1]); }
          LAS unsigned char* row = gb + ci * GP + 16 * cg;
          *(LAS v4u*)(row + G_Q) = wq; *(LAS v4u*)(row + G_K) = wk; *(LAS v4u*)(row + G_V) = wv;
#pragma unroll
          for (int j = 0; j < 8; ++j) *(LAS bf16*)(gb + G_KT + (8 * cg + j) * GP + 2 * ci) = (bf16)((j & 1) ? (wk[j >> 1] >> 16) : (wk[j >> 1] & 0xffffu)); }
        __syncthreads();
        { const int ti = (wave >> 1) & 1, tj = wave & 1, r32 = lane & 31, hi = lane >> 5; const bool isP = wave >= 4;
          f32x16 acc = {};
          const LAS unsigned char* ar = gb + (isP ? G_Q : G_K) + (32 * ti + r32) * GP + 16 * hi; const LAS unsigned char* br = gb + G_K + (32 * tj + r32) * GP + 16 * hi;
#pragma unroll
          for (int s = 0; s < 4; ++s) acc = __builtin_amdgcn_mfma_f32_32x32x16_bf16(*(const LAS bf16x8*)(ar + 32 * s), *(const LAS bf16x8*)(br + 32 * s), acc, 0, 0, 0);
          const int j = 32 * tj + r32; const float cj = sm[j];
#pragma unroll
          for (int r = 0; r < 16; ++r) { const int i = 32 * ti + (r & 3) + 8 * (r >> 2) + 4 * hi;
              const float dl = __expf(fminf(sm[i] - cj, 0.f));
              if (!isP) ((LAS float*)(gb + G_A))[i * 68 + j] = (i > j) ? sm[64 + i] * acc[r] * dl : 0.f;
              else *(LAS _Float16*)(gb + G_P + i * GP + 2 * j) = (_Float16)((i >= j) ? acc[r] * dl : 0.f); } }
        __syncthreads();
        if (!(SKIP & 2) && wave == 0) {
            const int bb = lane >> 4, cc = lane & 15; float T[16];
            const LAS float* Ab = (const LAS float*)(gb + G_A) + (16 * bb) * 68 + 16 * bb;
#pragma unroll
            for (int i = 0; i < 16; ++i) { float a0 = 0.f, a1 = 0.f;
#pragma unroll
                for (int j4 = 0; j4 < (i + 3) / 4; ++j4) { const f32x4 av = *(const LAS f32x4*)(Ab + i * 68 + 4 * j4);
                    a0 += av.x * T[4 * j4] + av.z * T[4 * j4 + 2]; a1 += av.y * T[4 * j4 + 1] + av.w * T[4 * j4 + 3]; }
                T[i] = (i == cc ? 1.f : 0.f) - (a0 + a1);
                if (i < 15 && (i & 3) == 3) asm volatile("" ::: "memory");
                if (i == 0) {
#pragma unroll
                    for (int k = 1; k < 16; ++k) T[k] = 0.f; } }
#pragma unroll
            for (int i = 0; i < 16; ++i) ((LAS float*)(gb + G_T))[(16 * bb + i) * 16 + cc] = T[i];
        }
        __syncthreads();
        f32x4 Xc[4];
#pragma unroll
        for (int g = 0; g < 4; ++g) Xc[g] = (f32x4){0.f, 0.f, 0.f, 0.f};
        if (!(SKIP & 2)) {
            const int col = lane & 15, q4 = lane >> 4, c = 16 * wave + col;
            const LAS unsigned char* src = gb + (c < 64 ? G_V : G_K) + 2 * (c & 63);
            u64_t xh[4], xl[4];
#pragma unroll
            for (int bk = 0; bk < 4; ++bk) {
                f32x4 Y; const f32x4 be = *(const LAS f32x4*)(sm + 64 + 16 * bk + 4 * q4), ga = *(const LAS f32x4*)(sm + 128 + 16 * bk + 4 * q4);
#pragma unroll
                for (int r = 0; r < 4; ++r) Y[r] = bf2f(*(const LAS bf16*)(src + (16 * bk + 4 * q4 + r) * GP)) * be[r] * (c < 64 ? 1.f : ga[r]);
#pragma unroll
                for (int b2 = 0; b2 < bk; b2 += 2) {
                    const LAS float* ar = (const LAS float*)(gb + G_A) + (16 * bk + col) * 68 + 16 * b2 + 4 * q4;
                    f32x4 a0 = -*(const LAS f32x4*)ar, a1 = (b2 + 1 < bk) ? -*(const LAS f32x4*)(ar + 16) : (f32x4){0.f, 0.f, 0.f, 0.f};
                    u64_t ah0, al0, ah1, al1; hilo4(a0, ah0, al0); hilo4(a1, ah1, al1);
                    const u64_t bh1 = (b2 + 1 < bk) ? xh[b2 + 1] : 0ull, bl1 = (b2 + 1 < bk) ? xl[b2 + 1] : 0ull;
                    const bf16x8 Ah = mk_bf16x8(ah0, ah1), Al = mk_bf16x8(al0, al1), Bh = mk_bf16x8(xh[b2], bh1), Bl = mk_bf16x8(xl[b2], bl1);
                    Y = __builtin_amdgcn_mfma_f32_16x16x32_bf16(Al, Bh, Y, 0, 0, 0);
                    Y = __builtin_amdgcn_mfma_f32_16x16x32_bf16(Ah, Bl, Y, 0, 0, 0);
                    Y = __builtin_amdgcn_mfma_f32_16x16x32_bf16(Ah, Bh, Y, 0, 0, 0); }
                { const f32x4 t0 = *(const LAS f32x4*)((const LAS float*)(gb + G_T) + (16 * bk + col) * 16 + 4 * q4);
                  u64_t th, tl, yh, yl; hilo4(t0, th, tl); hilo4(Y, yh, yl);
                  const bf16x8 Ah = mk_bf16x8(th, 0ull), Al = mk_bf16x8(tl, 0ull), Bh = mk_bf16x8(yh, 0ull), Bl = mk_bf16x8(yl, 0ull);
                  f32x4 X = {0.f, 0.f, 0.f, 0.f};
                  X = __builtin_amdgcn_mfma_f32_16x16x32_bf16(Al, Bh, X, 0, 0, 0);
                  X = __builtin_amdgcn_mfma_f32_16x16x32_bf16(Ah, Bl, X, 0, 0, 0);
                  X = __builtin_amdgcn_mfma_f32_16x16x32_bf16(Ah, Bh, X, 0, 0, 0);
                  Xc[bk] = X; hilo4(X, xh[bk], xl[bk]); }
            }
        }
        __syncthreads();
        { const int col = lane & 15, q4 = lane >> 4, c = 16 * wave + col;
          if (wave < 4) {
#pragma unroll
              for (int g = 0; g < 4; ++g)
#pragma unroll
                  for (int r = 0; r < 4; ++r) ((LAS float*)(gb + G_A))[(16 * g + 4 * q4 + r) * 68 + c] = Xc[g][r];
          } else {
#pragma unroll
              for (int g = 0; g < 4; ++g)
#pragma unroll
                  for (int r = 0; r < 4; ++r) { const int i = 16 * g + 4 * q4 + r; const float x = -Xc[g][r]; const unsigned hb = f2bf(x);
                      *(LAS bf16*)(gb + G_V + i * GP + 2 * (c - 64)) = (bf16)hb;
                      *(LAS bf16*)(gb + G_K + i * GP + 2 * (c - 64)) = (bf16)f2bf(x - __uint_as_float(hb << 16)); }
          } }
        __syncthreads();
        if (wave < 4) { const int col = lane & 15, q4 = lane >> 4, e = 16 * wave + col;
          bf16x8 bS0, bS1, bS0l, bS1l; split_acc(Sacc[0], Sacc[1], bS0, bS0l); split_acc(Sacc[2], Sacc[3], bS1, bS1l);
          f32x4 U[4], T1[4];
          const LAS unsigned char* rowa = gb + col * GP + 8 * q4;
#pragma unroll
          for (int it = 0; it < 4; ++it) {
              const LAS float* u0p = (const LAS float*)(gb + G_A) + (16 * it + 4 * q4) * 68 + e;
              U[it] = (f32x4){u0p[0], u0p[68], u0p[136], u0p[204]};
              const LAS unsigned char* ra = rowa + 16 * it * GP;
              const bf16x8 wh0 = ld2x8(ra + G_V), wh1 = ld2x8(ra + G_V + 64), wl0 = ld2x8(ra + G_K), wl1 = ld2x8(ra + G_K + 64), qa0 = ld2x8(ra + G_Q), qa1 = ld2x8(ra + G_Q + 64);
              U[it] = __builtin_amdgcn_mfma_f32_16x16x32_bf16(wl0, bS0, U[it], 0, 0, 0);
              U[it] = __builtin_amdgcn_mfma_f32_16x16x32_bf16(wl1, bS1, U[it], 0, 0, 0);
              U[it] = __builtin_amdgcn_mfma_f32_16x16x32_bf16(wh0, bS0l, U[it], 0, 0, 0);
              U[it] = __builtin_amdgcn_mfma_f32_16x16x32_bf16(wh1, bS1l, U[it], 0, 0, 0);
              U[it] = __builtin_amdgcn_mfma_f32_16x16x32_bf16(wh0, bS0, U[it], 0, 0, 0);
              U[it] = __builtin_amdgcn_mfma_f32_16x16x32_bf16(wh1, bS1, U[it], 0, 0, 0);
              T1[it] = __builtin_amdgcn_mfma_f32_16x16x32_bf16(qa0, bS0l, (f32x4){0.f, 0.f, 0.f, 0.f}, 0, 0, 0);
              T1[it] = __builtin_amdgcn_mfma_f32_16x16x32_bf16(qa1, bS1l, T1[it], 0, 0, 0);
              T1[it] = __builtin_amdgcn_mfma_f32_16x16x32_bf16(qa0, bS0, T1[it], 0, 0, 0);
              T1[it] = __builtin_amdgcn_mfma_f32_16x16x32_bf16(qa1, bS1, T1[it], 0, 0, 0);
              asm volatile("" ::: "memory");
          }
          const f16x8 hU0 = pack_acc_f16(U[0], U[1]), hU1 = pack_acc_f16(U[2], U[3]);
          f32x4 Ud[4];
#pragma unroll
          for (int it = 0; it < 4; ++it) { const f32x4 dc = *(const LAS f32x4*)(sm + 192 + 16 * it + 4 * q4); Ud[it] = U[it] * dc; }
          bf16x8 bD0, bD1, bD0l, bD1l; split_acc(Ud[0], Ud[1], bD0, bD0l); split_acc(Ud[2], Ud[3], bD1, bD1l);
          const float gend = sm[191];
#pragma unroll
          for (int it = 0; it < 4; ++it) {
              const LAS unsigned char* ra = rowa + 16 * it * GP;
              const f32x4 gm = *(const LAS f32x4*)(sm + 128 + 16 * it + 4 * q4);
              const bf16x8 pa0 = ld2x8(ra + G_P), pa1 = ld2x8(ra + G_P + 64), ka0 = ld2x8(ra + G_KT), ka1 = ld2x8(ra + G_KT + 64);
              f32x4 O = T1[it] * gm;
              O = __builtin_amdgcn_mfma_f32_16x16x32_f16(__builtin_bit_cast(f16x8, pa0), hU0, O, 0, 0, 0);
              O = __builtin_amdgcn_mfma_f32_16x16x32_f16(__builtin_bit_cast(f16x8, pa1), hU1, O, 0, 0, 0);
              f32x4 Sn = Sacc[it] * gend;
              Sn = __builtin_amdgcn_mfma_f32_16x16x32_bf16(ka0, bD0l, Sn, 0, 0, 0);
              Sn = __builtin_amdgcn_mfma_f32_16x16x32_bf16(ka1, bD1l, Sn, 0, 0, 0);
              Sn = __builtin_amdgcn_mfma_f32_16x16x32_bf16(ka0, bD0, Sn, 0, 0, 0);
              Sn = __builtin_amdgcn_mfma_f32_16x16x32_bf16(ka1, bD1, Sn, 0, 0, 0);
              Sacc[it] = Sn;
#pragma unroll
              for (int r = 0; r < 4; ++r) ((LAS float*)(gb + G_A))[(16 * it + 4 * q4 + r) * 68 + e] = O[r];
              asm volatile("" ::: "memory");
          } }
        else if (c + 1 < SEQ / 64) GDN_RAW_STAGE(c + 1, tid - 256, 256);
        __syncthreads();
    }
    GDN_WRITEOUT(SEQ / 64 - 1);
#undef GDN_WRITEOUT
#undef GDN_RAW_STAGE
    __syncthreads();
}
__device__ __forceinline__ int next_unit(Frame& F, gu32* head) {
    __syncthreads();
    if (F.tid == 0) F.MISC[16] = __hip_atomic_fetch_add(head, 1u, RLX_AGENT);
    __syncthreads();
    return (int)F.MISC[16];
}
constexpr int U_GDN = 96, U_RWKV = 128, U_ATT = 384, U_ALL = U_GDN + U_RWKV + U_ATT;
__device__ __forceinline__ void p3_mixers(Frame& F, int l, int rep) {
    gu32* head = F.ctl + CW_QUEUE + 64 * (2 * l + rep);
    for (;;) {
        const int u = next_unit(F, head);
        if (u >= U_ALL) break;
        asm volatile("" : "+v"(F.tid), "+v"(F.lane));
        if (u < U_GDN) gdn_unit3<0>(F, l, u, F.ctl + CW_FLAG + 64 * 256 * (2 * l + rep) + 64 * 128);
        else if (u < U_GDN + U_RWKV) rwkv_unit<0>(F, u - U_GDN, F.ctl + CW_FLAG + 64 * 256 * (2 * l + rep));
        else attn_unit(F, u - U_GDN - U_RWKV);
    }
}
__device__ __forceinline__ f32x4 bf4(u64_t x) { return (f32x4){__uint_as_float(((unsigned)x) << 16), __uint_as_float(((unsigned)x) & 0xffff0000u), __uint_as_float(((unsigned)(x >> 32)) << 16), __uint_as_float(((unsigned)(x >> 32)) & 0xffff0000u)}; }
__device__ __forceinline__ u64_t pk4(const f32x4& v) { return (u64_t)pg8::cvt_pk_bf16(v[0], v[1]) | ((u64_t)pg8::cvt_pk_bf16(v[2], v[3]) << 32); }
__device__ __forceinline__ void p2_mla_unit(Frame& F, int l, int unit) {
    const int lane = F.lane, col = lane & 15, q4 = lane >> 4, m = 16 * unit + col, b = m / SEQ, t = m % SEQ, t0 = (16 * unit) % SEQ;
    const bf16* prow = (const bf16*)(F.ws + WS_PMLA) + (size_t)m * 352;
    const bf16* WuqT = (const bf16*)(F.ws + WS_WSMALL + OFF_WUQ) + (size_t)l * 576 * 192 + (size_t)col * 192 + 8 * q4;
    const bf16* WukvT = (const bf16*)(F.ws + WS_WSMALL + OFF_WUKV) + (size_t)l * 768 * 128 + (size_t)col * 128 + 8 * q4;
    bf16x8 aq[6], akv[4]; float sq = 0.f, skv = 0.f;
#pragma unroll
    for (int s = 0; s < 6; ++s) { aq[s] = *(const bf16x8*)(prow + 32 * s + 8 * q4); const v4u u = __builtin_bit_cast(v4u, aq[s]);
#pragma unroll
        for (int i = 0; i < 4; ++i) { const float a = __uint_as_float(u[i] << 16), c = __uint_as_float(u[i] & 0xffff0000u); sq += a * a + c * c; } }
#pragma unroll
    for (int s = 0; s < 4; ++s) { akv[s] = *(const bf16x8*)(prow + 192 + 32 * s + 8 * q4); const v4u u = __builtin_bit_cast(v4u, akv[s]);
#pragma unroll
        for (int i = 0; i < 4; ++i) { const float a = __uint_as_float(u[i] << 16), c = __uint_as_float(u[i] & 0xffff0000u); skv += a * a + c * c; } }
    sq += __shfl_xor(sq, 16); sq += __shfl_xor(sq, 32); skv += __shfl_xor(skv, 16); skv += __shfl_xor(skv, 32);
    const float rq = rsqrtf(sq * (1.f / 192.f) + NORM_EPS) * (0.10206207261596575f * LOG2E), rkv = rsqrtf(skv * (1.f / 128.f) + NORM_EPS);
    const float pos = (float)((const int*)inptr(F, 1))[m];
    f32x4 cs, sn;
#pragma unroll
    for (int r = 0; r < 4; ++r) { const float inv = exp2f(-(float)(4 * q4 + r) * (13.287712379549449f / 16.f)); float s_, c_; sincosf(pos * inv, &s_, &c_); cs[r] = c_; sn[r] = s_; }
    bf16* Qo = (bf16*)(F.ws + WS_Q) + ((size_t)b * 6 * SEQ + t) * 96 + 4 * q4;
    bf16* Ko = (bf16*)(F.ws + WS_K) + ((size_t)b * 6 * SEQ + t) * 96 + 4 * q4;
    bf16* Vo = (bf16*)(F.ws + WS_VT) + (size_t)b * 6 * 64 * SEQ + (size_t)col * SEQ + t0 + 4 * q4;
    { const u64_t x1 = *(const u64_t*)(prow + 320 + 4 * q4), x2 = *(const u64_t*)(prow + 336 + 4 * q4); const f32x4 a = bf4(x1), c = bf4(x2);
      const u64_t o1 = pk4(a * cs - c * sn), o2 = pk4(c * cs + a * sn);
#pragma unroll
      for (int h = 0; h < 6; ++h) { *(u64_t*)(Ko + (size_t)h * SEQ * 96 + 64) = o1; *(u64_t*)(Ko + (size_t)h * SEQ * 96 + 80) = o2; } }
#pragma unroll 1
    for (int h = 0; h < 6; ++h) {
        f32x4 x1v = {0.f, 0.f, 0.f, 0.f};
#pragma unroll
        for (int nt = 0; nt < 6; ++nt) {
            const bf16* w = WuqT + (size_t)(h * 96 + 16 * nt) * 192; f32x4 acc = {0.f, 0.f, 0.f, 0.f};
#pragma unroll
            for (int s = 0; s < 6; ++s) acc = __builtin_amdgcn_mfma_f32_16x16x32_bf16(*(const bf16x8*)(w + 32 * s), aq[s], acc, 0, 0, 0);
            acc = acc * rq;
            if (nt < 4) *(u64_t*)(Qo + (size_t)h * SEQ * 96 + 16 * nt) = pk4(acc);
            else if (nt == 4) x1v = acc;
            else { *(u64_t*)(Qo + (size_t)h * SEQ * 96 + 64) = pk4(x1v * cs - acc * sn); *(u64_t*)(Qo + (size_t)h * SEQ * 96 + 80) = pk4(acc * cs + x1v * sn); }
        }
#pragma unroll
        for (int nt = 0; nt < 4; ++nt) {
            const bf16* w = WukvT + (size_t)(h * 128 + 16 * nt) * 128; f32x4 acc = {0.f, 0.f, 0.f, 0.f};
#pragma unroll
            for (int s = 0; s < 4; ++s) acc = __builtin_amdgcn_mfma_f32_16x16x32_bf16(*(const bf16x8*)(w + 32 * s), akv[s], acc, 0, 0, 0);
            *(u64_t*)(Ko + (size_t)h * SEQ * 96 + 16 * nt) = pk4(acc * rkv);
        }
        f32x4 rk4;
#pragma unroll
        for (int r = 0; r < 4; ++r) rk4[r] = __shfl(rkv, 4 * q4 + r);
#pragma unroll
        for (int nt = 0; nt < 4; ++nt) {
            const bf16* w = WukvT + (size_t)(h * 128 + 64 + 16 * nt) * 128; f32x4 acc = {0.f, 0.f, 0.f, 0.f};
#pragma unroll
            for (int s = 0; s < 4; ++s) acc = __builtin_amdgcn_mfma_f32_16x16x32_bf16(akv[s], *(const bf16x8*)(w + 32 * s), acc, 0, 0, 0);
            *(u64_t*)(Vo + (size_t)(h * 64 + 16 * nt) * SEQ) = pk4(acc * rk4);
        }
    }
}
__device__ __forceinline__ f32x4 rw_shift4(const bf16* P, size_t m, int c, bool hp, bool hn, const float* mu) {
    const f32x4 x = bf4(*(const u64_t*)(P + m * 896 + c)), xp = hp ? bf4(*(const u64_t*)(P + (m - 1) * 896 + c)) : (f32x4){0.f, 0.f, 0.f, 0.f}, xn = hn ? bf4(*(const u64_t*)(P + (m + 1) * 896 + c)) : (f32x4){0.f, 0.f, 0.f, 0.f};
    const f32x4 m0 = *(const f32x4*)(mu + c), m1 = *(const f32x4*)(mu + 896 + c);
    return x + m0 * (xp - x) + m1 * (xn - x);
}
__device__ __forceinline__ void p2_rwkv_unit(Frame& F, int l, int unit, int h0, int h1) {
    const int lane = F.lane, col = lane & 15, q4 = lane >> 4, b = (16 * unit) / SEQ, t = (16 * unit) % SEQ + col; const size_t m = (size_t)16 * unit + col;
    const bool hp = t > 0, hn = t < SEQ - 1;
    const bf16* Prw = (const bf16*)(F.ws + WS_PRW);
    const float* mu = (const float*)inptr(F, 12) + l * 2 * 896;
    const bf16* W2T = (const bf16*)(F.ws + WS_WSMALL + OFF_W2T) + (size_t)l * 2 * 256 * 64 + (size_t)col * 64 + 8 * q4;
    const bf16* A2T = (const bf16*)(F.ws + WS_WSMALL + OFF_A2T) + (size_t)l * 2 * 256 * 64 + (size_t)col * 64 + 8 * q4;
    bf16x8 awd[2], aad[2];
#pragma unroll
    for (int s = 0; s < 2; ++s) { const int c = 768 + 32 * s + 8 * q4;
        f32x4 lo = rw_shift4(Prw, m, c, hp, hn, mu), hi = rw_shift4(Prw, m, c + 4, hp, hn, mu);
#pragma unroll
        for (int i = 0; i < 4; ++i) { lo[i] = 1.f - 2.f / (1.f + __expf(2.f * lo[i])); hi[i] = 1.f - 2.f / (1.f + __expf(2.f * hi[i])); }
        awd[s] = pack_acc(lo, hi);
        aad[s] = pack_acc(rw_shift4(Prw, m, c + 64, hp, hn, mu), rw_shift4(Prw, m, c + 68, hp, hn, mu)); }
#pragma unroll 1
    for (int h = h0; h < h1; ++h) {
        f32x4 k[4]; float kn = 0.f;
        { const float* k_k = (const float*)inptr(F, 17) + l * 256;
#pragma unroll
          for (int nt = 0; nt < 4; ++nt) { const int c = 64 * h + 16 * nt + 4 * q4; k[nt] = rw_shift4(Prw, m, 256 + c, hp, hn, mu);
              const f32x4 x = k[nt] * *(const f32x4*)(k_k + c); kn += (x[0] * x[0] + x[1] * x[1]) + (x[2] * x[2] + x[3] * x[3]); } }
        kn += __shfl_xor(kn, 16); kn += __shfl_xor(kn, 32);
        const float rkn = rsqrtf(kn + 1e-6f);
        float br[2] = {0.f, 0.f}, kr[2] = {0.f, 0.f}, cbv = 0.f;
        unsigned char* rs = F.ws + WS_RS + (((size_t)b * 4 + h) * SEQ + t) * RS_REC + 8 * q4;
        unsigned char* rd0 = F.ws + WS_RD + (((size_t)b * 4 + h) * SEQ + t) * RD_REC + 8 * q4;
#pragma unroll 2
        for (int nt = 0; nt < 4; ++nt) { const int c = 64 * h + 16 * nt + 4 * q4;
            const f32x4 r = rw_shift4(Prw, m, c, hp, hn, mu), v = rw_shift4(Prw, m, 512 + c, hp, hn, mu);
            const f32x4 kk = k[nt] * *(const f32x4*)((const float*)inptr(F, 17) + l * 256 + c) * rkn;
            *(u64_t*)(rs + 32 * nt) = pk4(kk); *(u64_t*)(rs + 128 + 32 * nt) = pk4(v); *(u64_t*)(rs + 256 + 32 * nt) = pk4(r);
            f32x4 ksum = {0.f, 0.f, 0.f, 0.f};
#pragma unroll
            for (int e = 0; e < 2; ++e) { const bf16* w = W2T + (size_t)(e * 256 + 64 * h + 16 * nt) * 64; const bf16* a = A2T + (size_t)(e * 256 + 64 * h + 16 * nt) * 64;
                f32x4 x = {0.f, 0.f, 0.f, 0.f}, y = {0.f, 0.f, 0.f, 0.f};
#pragma unroll
                for (int s = 0; s < 2; ++s) { x = __builtin_amdgcn_mfma_f32_16x16x32_bf16(*(const bf16x8*)(w + 32 * s), awd[s], x, 0, 0, 0); y = __builtin_amdgcn_mfma_f32_16x16x32_bf16(*(const bf16x8*)(a + 32 * s), aad[s], y, 0, 0, 0); }
                const f32x4 w0v = *(const f32x4*)((const float*)inptr(F, 13) + l * 512 + e * 256 + c), a0v = *(const f32x4*)((const float*)inptr(F, 15) + l * 512 + e * 256 + c), kav = *(const f32x4*)((const float*)inptr(F, 18) + l * 256 + c);
                f32x4 lam, av;
#pragma unroll
                for (int i = 0; i < 4; ++i) { lam[i] = 0.6065306597126334f * sigmoidf_(w0v[i] + x[i]); av[i] = sigmoidf_(a0v[i] + y[i]); }
                const f32x4 km = k[nt] * (1.f + (av - 1.f) * kav), bb = av * kk;
                ksum += km;
                br[e] += (bb[0] * r[0] + bb[1] * r[1]) + (bb[2] * r[2] + bb[3] * r[3]); kr[e] += (km[0] * r[0] + km[1] * r[1]) + (km[2] * r[2] + km[3] * r[3]);
                typedef _Float16 h4 __attribute__((ext_vector_type(4)));
                const h4 lh = {(_Float16)lam[0], (_Float16)lam[1], (_Float16)lam[2], (_Float16)lam[3]};
                unsigned char* rd = rd0 + e * RD_DIR;
                *(u64_t*)(rd + 32 * nt) = __builtin_bit_cast(u64_t, lh); *(u64_t*)(rd + 128 + 32 * nt) = pk4(bb); *(u64_t*)(rd + 256 + 32 * nt) = pk4(km); }
            const f32x4 rkv = *(const f32x4*)((const float*)inptr(F, 19) + l * 256 + c), xx = r * ksum * rkv; cbv += (xx[0] + xx[1]) + (xx[2] + xx[3]);
        }
#pragma unroll
        for (int e = 0; e < 2; ++e) { float x = br[e], y = kr[e]; x += __shfl_xor(x, 16); x += __shfl_xor(x, 32); y += __shfl_xor(y, 16); y += __shfl_xor(y, 32);
            if (q4 == 0) { typedef float f2 __attribute__((ext_vector_type(2))); *(f2*)(rd0 + e * RD_DIR + 384) = (f2){x, y}; } }
        cbv += __shfl_xor(cbv, 16); cbv += __shfl_xor(cbv, 32);
        if (q4 == 0) ((float*)(F.ws + WS_CB))[m * 4 + h] = 0.5f * cbv;
    }
}
template <int MODE> __device__ __forceinline__ void p2_prep2(Frame& F, int l) {
    const int gw = F.vcu * NWAVES + F.wave, NGW = F.G * NWAVES;
    for (int u = gw; u < 2 * (M / 16); u += NGW) { if (u & 1) { if (MODE != 1) p2_rwkv_unit(F, l, u >> 1, 0, 4); } else { if (MODE != 2) p2_mla_unit(F, l, u >> 1); } }
}
__device__ __forceinline__ void ld16(const bf16* p, f32x4 (&o)[4]) { const v4u a = *(const v4u*)p, b = *(const v4u*)(p + 8);
    o[0] = (f32x4){__uint_as_float(a.x << 16), __uint_as_float(a.x & 0xffff0000u), __uint_as_float(a.y << 16), __uint_as_float(a.y & 0xffff0000u)};
    o[1] = (f32x4){__uint_as_float(a.z << 16), __uint_as_float(a.z & 0xffff0000u), __uint_as_float(a.w << 16), __uint_as_float(a.w & 0xffff0000u)};
    o[2] = (f32x4){__uint_as_float(b.x << 16), __uint_as_float(b.x & 0xffff0000u), __uint_as_float(b.y << 16), __uint_as_float(b.y & 0xffff0000u)};
    o[3] = (f32x4){__uint_as_float(b.z << 16), __uint_as_float(b.z & 0xffff0000u), __uint_as_float(b.w << 16), __uint_as_float(b.w & 0xffff0000u)}; }
__device__ __forceinline__ void p4a_mix2(Frame& F, int l) {
    const bf16* Ogdn = (const bf16*)(F.ws + WS_OGDN); const bf16* Omla = (const bf16*)(F.ws + WS_OMLA); const bf16* Y = (const bf16*)(F.ws + WS_Y);
    const bf16* Pgate = (const bf16*)(F.ws + WS_PGATE); const unsigned char* Rs = F.ws + WS_RS; const float* cb = (const float*)(F.ws + WS_CB); bf16* mix = (bf16*)(F.ws + WS_MIX);
    const int gw = F.vcu * NWAVES + F.wave, NGW = F.G * NWAVES, lane = F.lane, g = lane >> 2, c0 = 16 * lane;
    f32x4 pg[4], pb[4];
    if (g < 6) { const float* gg = (const float*)inptr(F, 7) + l * 64 + (c0 & 63);
#pragma unroll
        for (int i = 0; i < 4; ++i) { pg[i] = *(const f32x4*)(gg + 4 * i); pb[i] = (f32x4){0.f, 0.f, 0.f, 0.f}; } }
    else if (g < 12) {
#pragma unroll
        for (int i = 0; i < 4; ++i) { pg[i] = (f32x4){1.f, 1.f, 1.f, 1.f}; pb[i] = (f32x4){0.f, 0.f, 0.f, 0.f}; } }
    else { const float* lg = (const float*)inptr(F, 20) + l * 256 + (c0 - 768); const float* lb = (const float*)inptr(F, 21) + l * 256 + (c0 - 768);
#pragma unroll
        for (int i = 0; i < 4; ++i) { pg[i] = *(const f32x4*)(lg + 4 * i); pb[i] = *(const f32x4*)(lb + 4 * i); } }
#pragma unroll 2
    for (int m = gw; m < M; m += NGW) {
        f32x4 x[4], gt[4];
        ld16(Pgate + (size_t)m * 1024 + c0, gt);
        if (g < 6) { ld16(Ogdn + (size_t)m * 384 + c0, x);
            float ss = 0.f;
#pragma unroll
            for (int i = 0; i < 4; ++i) ss += (x[i][0] * x[i][0] + x[i][1] * x[i][1]) + (x[i][2] * x[i][2] + x[i][3] * x[i][3]);
            ss += dpp_xor1(ss); ss += dpp_xor2(ss);
            const float rs = rsqrtf(ss * (1.f / 64.f) + NORM_EPS);
#pragma unroll
            for (int i = 0; i < 4; ++i) x[i] = x[i] * rs * pg[i]; }
        else if (g < 12) ld16(Omla + (size_t)m * 384 + (c0 - 384), x);
        else { const int cc = c0 - 768, h = g - 12, b = m / SEQ, t = m % SEQ; f32x4 v[4];
            ld16(Y + (size_t)m * 256 + cc, x); ld16((const bf16*)(Rs + (((size_t)b * 4 + h) * SEQ + t) * RS_REC + 128) + (cc & 63), v);
            const float cbv = cb[(size_t)m * 4 + h];
            float s1 = 0.f;
#pragma unroll
            for (int i = 0; i < 4; ++i) s1 += (x[i][0] + x[i][1]) + (x[i][2] + x[i][3]);
            s1 += dpp_xor1(s1); s1 += dpp_xor2(s1);
            const float mean = s1 * (1.f / 64.f); float s2 = 0.f;
#pragma unroll
            for (int i = 0; i < 4; ++i) { x[i] = x[i] - mean; s2 += (x[i][0] * x[i][0] + x[i][1] * x[i][1]) + (x[i][2] * x[i][2] + x[i][3] * x[i][3]); }
            s2 += dpp_xor1(s2); s2 += dpp_xor2(s2);
            const float rs = rsqrtf(s2 * (1.f / 64.f) + 64e-5f);
#pragma unroll
            for (int i = 0; i < 4; ++i) x[i] = x[i] * rs * pg[i] + pb[i] + cbv * v[i]; }
        v4u o0, o1;
#pragma unroll
        for (int i = 0; i < 4; ++i) {
#pragma unroll
            for (int j = 0; j < 4; ++j) x[i][j] = x[i][j] * siluf(gt[i][j]); }
        o0.x = pg8::cvt_pk_bf16(x[0][0], x[0][1]); o0.y = pg8::cvt_pk_bf16(x[0][2], x[0][3]); o0.z = pg8::cvt_pk_bf16(x[1][0], x[1][1]); o0.w = pg8::cvt_pk_bf16(x[1][2], x[1][3]);
        o1.x = pg8::cvt_pk_bf16(x[2][0], x[2][1]); o1.y = pg8::cvt_pk_bf16(x[2][2], x[2][3]); o1.z = pg8::cvt_pk_bf16(x[3][0], x[3][1]); o1.w = pg8::cvt_pk_bf16(x[3][2], x[3][3]);
        bf16* op = mix + (size_t)m * 1024 + c0; *(v4u*)op = o0; *(v4u*)(op + 8) = o1;
    }
}
typedef unsigned u32x4 __attribute__((ext_vector_type(4)));
__device__ __forceinline__ float dot_bf16(const bf16* a, const bf16* b, int K) {
    float acc = 0.f;
    for (int k = 0; k < K; k += 8) {
        const u32x4 av = *(const u32x4*)(a + k), bv = *(const u32x4*)(b + k);
#pragma unroll
        for (int i = 0; i < 4; ++i) {
            acc += __uint_as_float(av[i] << 16) * __uint_as_float(bv[i] << 16);
            acc += __uint_as_float(av[i] & 0xffff0000u) * __uint_as_float(bv[i] & 0xffff0000u);
        }
    }
    return acc;
}
__global__ void __launch_bounds__(64) nk_mla_prep(const bf16* Pmla, const bf16* WuqT, const bf16* WukvT, const int* positions, bf16* Q, bf16* Kb, bf16* Vt) {
    __shared__ float raw[576 + 768];
    __shared__ float rs[2];
    const int m = blockIdx.x, lane = threadIdx.x, b = m / SEQ, t = m % SEQ;
    const bf16* p = Pmla + (size_t)m * 352;
    float s1 = 0.f, s2 = 0.f;
    for (int c = lane; c < 192; c += 64) { const float v = bf2f(p[c]); s1 += v * v; }
    for (int c = lane; c < 128; c += 64) { const float v = bf2f(p[192 + c]); s2 += v * v; }
    s1 = wave_sum(s1); s2 = wave_sum(s2);
    const float rq = rsqrtf(s1 * (1.f / 192.f) + NORM_EPS), rkv = rsqrtf(s2 * (1.f / 128.f) + NORM_EPS);
    for (int c = lane; c < 576; c += 64) raw[c] = dot_bf16(p, WuqT + (size_t)c * 192, 192) * rq;
    for (int c = lane; c < 768; c += 64) raw[576 + c] = dot_bf16(p + 192, WukvT + (size_t)c * 128, 128) * rkv;
    __syncthreads();
    const float pos = (float)positions[m];
    const float qs = 0.10206207261596575f * LOG2E;
    for (int i = lane; i < 6 * 80; i += 64) {
        const int h = i / 80, j = i % 80;
        bf16* qo = Q + (((size_t)b * 6 + h) * SEQ + t) * 96;
        if (j < 64) qo[j] = f2bf(raw[h * 96 + j] * qs);
        else { const int r = j - 64; const float inv = exp2f(-(float)r * (13.287712379549449f / 16.f)); float sn, cs; sincosf(pos * inv, &sn, &cs);
            const float x1 = raw[h * 96 + 64 + r], x2 = raw[h * 96 + 80 + r];
            qo[64 + r] = f2bf((x1 * cs - x2 * sn) * qs); qo[80 + r] = f2bf((x2 * cs + x1 * sn) * qs); }
    }
    for (int i = lane; i < 6 * 64; i += 64) {
        const int h = i / 64, j = i % 64;
        Kb[(((size_t)b * 6 + h) * SEQ + t) * 96 + j] = f2bf(raw[576 + h * 128 + j]);
        Vt[(((size_t)b * 6 + h) * 64 + j) * SEQ + t] = f2bf(raw[576 + h * 128 + 64 + j]);
    }
    if (lane < 16) {
        const int r = lane; const float inv = exp2f(-(float)r * (13.287712379549449f / 16.f)); float sn, cs; sincosf(pos * inv, &sn, &cs);
        const float x1 = bf2f(p[320 + r]), x2 = bf2f(p[336 + r]);
        const bf16 o1 = f2bf(x1 * cs - x2 * sn), o2 = f2bf(x2 * cs + x1 * sn);
        for (int h = 0; h < 6; ++h) { bf16* ko = Kb + (((size_t)b * 6 + h) * SEQ + t) * 96; ko[64 + r] = o1; ko[80 + r] = o2; }
    }
}
__global__ void __launch_bounds__(256) nk_rwkv_prep(const bf16* Prw, const float* mu, const float* w0, const float* w2, const float* a0, const float* a2,
                             const float* k_k, const float* k_a, const float* r_k, unsigned char* Rs, unsigned char* Rd, float* cb) {
    __shared__ float f[896];
    const int m = blockIdx.x, c = threadIdx.x, b = m / SEQ, t = m % SEQ, h = c >> 6, j = c & 63;
    for (int i = c; i < 896; i += 256) {
        const float x = bf2f(Prw[(size_t)m * 896 + i]);
        const float xp = t > 0 ? bf2f(Prw[(size_t)(m - 1) * 896 + i]) : 0.f;
        const float xn = t < SEQ - 1 ? bf2f(Prw[(size_t)(m + 1) * 896 + i]) : 0.f;
        float v = x + mu[i] * (xp - x) + mu[896 + i] * (xn - x);
        if (i >= 768 && i < 832) v = tanhf(v);
        f[i] = v;
    }
    __syncthreads();
    const float r = f[c], k = f[256 + c], v = f[512 + c];
    const float kkr = k * k_k[c];
    const float kn = wave_sum(kkr * kkr);
    const float kk = kkr * rsqrtf(kn + 1e-6f);
    float kmod[2], bb[2], lam[2];
#pragma unroll
    for (int e = 0; e < 2; ++e) {
        float lw = 0.f, la = 0.f;
        for (int d = 0; d < 64; ++d) { lw += f[768 + d] * w2[((size_t)e * 64 + d) * 256 + c]; la += f[832 + d] * a2[((size_t)e * 64 + d) * 256 + c]; }
        const float wl = -softplusf_(-(w0[e * 256 + c] + lw)) - 0.5f;
        lam[e] = __expf(wl);
        const float a = sigmoidf_(a0[e * 256 + c] + la);
        kmod[e] = k * (1.f + (a - 1.f) * k_a[c]);
        bb[e] = a * kk;
    }
    unsigned char* rs = Rs + (((size_t)b * 4 + h) * SEQ + t) * RS_REC;
    ((bf16*)rs)[j] = f2bf(kk); ((bf16*)(rs + 128))[j] = f2bf(v); ((bf16*)(rs + 256))[j] = f2bf(r);
#pragma unroll
    for (int e = 0; e < 2; ++e) {
        unsigned char* rd = Rd + e * RD_DIR + (((size_t)b * 4 + h) * SEQ + t) * RD_REC;
        ((__half*)rd)[j] = __float2half(lam[e]); ((bf16*)(rd + 128))[j] = f2bf(bb[e]); ((bf16*)(rd + 256))[j] = f2bf(kmod[e]);
        const float br = wave_sum(bb[e] * r), kr = wave_sum(kmod[e] * r);
        if (j == 0) { ((float*)(rd + 384))[0] = br; ((float*)(rd + 384))[1] = kr; }
    }
    const float cbv = wave_sum(r * 0.5f * (kmod[0] + kmod[1]) * r_k[c]);
    if (j == 0) cb[(size_t)m * 4 + h] = cbv;
}
__global__ void __launch_bounds__(128) nk_attn(const bf16* Q, const bf16* Kb, const bf16* Vt, bf16* Omla) {
    const int bh = blockIdx.y, q = blockIdx.x * 128 + threadIdx.x, b = bh / 6, h = bh % 6;
    const bf16* qp = Q + ((size_t)bh * SEQ + q) * 96;
    float qr[96];
#pragma unroll
    for (int i = 0; i < 96; ++i) qr[i] = bf2f(qp[i]);
    float acc[64];
#pragma unroll
    for (int i = 0; i < 64; ++i) acc[i] = 0.f;
    float mx = -1e30f, l = 0.f;
    const bf16* kb = Kb + (size_t)bh * SEQ * 96; const bf16* vt = Vt + (size_t)bh * 64 * SEQ;
    for (int k0 = 0; k0 < SEQ; k0 += 8) {
        float s[8];
#pragma unroll
        for (int kk = 0; kk < 8; ++kk) {
            const bf16* kr = kb + (size_t)(k0 + kk) * 96; float a = 0.f;
#pragma unroll
            for (int d = 0; d < 96; d += 8) { const u32x4 kv = *(const u32x4*)(kr + d);
#pragma unroll
                for (int i = 0; i < 4; ++i) { a += qr[d + 2 * i] * __uint_as_float(kv[i] << 16); a += qr[d + 2 * i + 1] * __uint_as_float(kv[i] & 0xffff0000u); } }
            s[kk] = a;
        }
        float cm = s[0];
#pragma unroll
        for (int kk = 1; kk < 8; ++kk) cm = fmaxf(cm, s[kk]);
        const float mn = fmaxf(mx, cm), sc = exp2f(mx - mn);
        l *= sc;
#pragma unroll
        for (int i = 0; i < 64; ++i) acc[i] *= sc;
        mx = mn;
#pragma unroll
        for (int kk = 0; kk < 8; ++kk) { s[kk] = exp2f(s[kk] - mn); l += s[kk]; }
#pragma unroll
        for (int d = 0; d < 64; ++d) { const u32x4 vv = *(const u32x4*)(vt + (size_t)d * SEQ + k0);
#pragma unroll
            for (int i = 0; i < 4; ++i) { acc[d] += s[2 * i] * __uint_as_float(vv[i] << 16); acc[d] += s[2 * i + 1] * __uint_as_float(vv[i] & 0xffff0000u); } }
    }
    const float il = 1.f / l;
    bf16* o = Omla + ((size_t)b * SEQ + q) * 384 + h * 64;
#pragma unroll
    for (int i = 0; i < 64; ++i) o[i] = f2bf(acc[i] * il);
}
__global__ void __launch_bounds__(64) nk_gdn(const bf16* Pgdn, const float* Psm, const float* conv_w, const float* a_log, const float* dt_bias, bf16* Ogdn, int dir) {
    __shared__ float qs[64], ks[64];
    const int bh = blockIdx.x, b = bh / 6, h = bh % 6, e = threadIdx.x;
    float S[64];
#pragma unroll
    for (int i = 0; i < 64; ++i) S[i] = 0.f;
    float cw[3][5];
#pragma unroll
    for (int i = 0; i < 5; ++i) { cw[0][i] = conv_w[i * 1152 + h * 64 + e]; cw[1][i] = conv_w[i * 1152 + 384 + h * 64 + e]; cw[2][i] = conv_w[i * 1152 + 768 + h * 64 + e]; }
    const float al = -__expf(a_log[dir * 6 + h]), dtb = dt_bias[dir * 6 + h];
    for (int n = 0; n < SEQ; ++n) {
        const int t = dir ? SEQ - 1 - n : n; const size_t m = (size_t)b * SEQ + t;
        float cq = 0.f, ck = 0.f, cv = 0.f;
#pragma unroll
        for (int i = 0; i < 5; ++i) { const int tt = t + i - 2; if (tt >= 0 && tt < SEQ) { const bf16* pr = Pgdn + ((size_t)b * SEQ + tt) * 1152 + h * 64 + e;
                cq += cw[0][i] * bf2f(pr[0]); ck += cw[1][i] * bf2f(pr[384]); cv += cw[2][i] * bf2f(pr[768]); } }
        cq = siluf(cq); ck = siluf(ck); cv = siluf(cv);
        const float qn = cq * rsqrtf(wave_sum(cq * cq) + 1e-6f) * 0.125f, kn = ck * rsqrtf(wave_sum(ck * ck) + 1e-6f);
        __syncthreads();
        qs[e] = qn; ks[e] = kn;
        __syncthreads();
        const float g = al * softplusf_(Psm[m * 32 + dir * 6 + h] + dtb), beta = sigmoidf_(Psm[m * 32 + 12 + dir * 6 + h]), alpha = __expf(g);
        float kS = 0.f;
#pragma unroll
        for (int d = 0; d < 64; ++d) kS += ks[d] * S[d];
        const float coef = beta * (cv - alpha * kS);
        float o = 0.f;
#pragma unroll
        for (int d = 0; d < 64; ++d) { S[d] = alpha * S[d] + coef * ks[d]; o += qs[d] * S[d]; }
        bf16* op = Ogdn + m * 384 + h * 64 + e;
        if (dir) o += bf2f(*op);
        *op = f2bf(o);
    }
}
__global__ void __launch_bounds__(64) nk_rwkv(const unsigned char* Rs, const unsigned char* Rd, bf16* Y, int dir) {
    const int bh = blockIdx.x, b = bh / 4, h = bh % 4, i = threadIdx.x;
    float S[64];
#pragma unroll
    for (int j = 0; j < 64; ++j) S[j] = 0.f;
    for (int n = 0; n < SEQ; ++n) {
        const int t = dir ? SEQ - 1 - n : n;
        const unsigned char* rs = Rs + ((size_t)bh * SEQ + t) * RS_REC;
        const unsigned char* rd = Rd + dir * RD_DIR + ((size_t)bh * SEQ + t) * RD_REC;
        const float v = bf2f(((const bf16*)(rs + 128))[i]);
        float sa = 0.f;
#pragma unroll
        for (int j = 0; j < 64; ++j) sa -= S[j] * bf2f(((const bf16*)rs)[j]);
        float y = 0.f;
#pragma unroll
        for (int j = 0; j < 64; ++j) {
            const float w = __expf(-__half2float(((const __half*)rd)[j]));
            S[j] = S[j] * w + sa * bf2f(((const bf16*)(rd + 128))[j]) + v * bf2f(((const bf16*)(rd + 256))[j]);
            y += S[j] * bf2f(((const bf16*)(rs + 256))[j]);
        }
        bf16* op = Y + ((size_t)b * SEQ + t) * 256 + h * 64 + i;
        if (dir) y += bf2f(*op);
        *op = f2bf(y);
    }
}
__global__ void __launch_bounds__(1024) nk_mix(const bf16* Ogdn, const bf16* Omla, const bf16* Y, const bf16* Pgate, const unsigned char* Rs, const float* cb,
                       const float* gdn_g, const float* ln_g, const float* ln_b, bf16* mix) {
    const int m = blockIdx.x, c = threadIdx.x, b = m / SEQ, t = m % SEQ;
    float val;
    if (c < 384) { const float o = bf2f(Ogdn[(size_t)m * 384 + c]); const float ss = wave_sum(o * o); val = o * rsqrtf(ss * (1.f / 64.f) + NORM_EPS) * gdn_g[c & 63]; }
    else if (c < 768) val = bf2f(Omla[(size_t)m * 384 + (c - 384)]);
    else { const int cc = c - 768, h = cc >> 6, j = cc & 63; const float y = bf2f(Y[(size_t)m * 256 + cc]);
        const float mean = wave_sum(y) * (1.f / 64.f); const float dv = y - mean; const float var = wave_sum(dv * dv) * (1.f / 64.f);
        const float v = bf2f(((const bf16*)(Rs + (((size_t)b * 4 + h) * SEQ + t) * RS_REC + 128))[j]);
        val = dv * rsqrtf(var + 64e-5f) * ln_g[cc] + ln_b[cc] + cb[(size_t)m * 4 + h] * v; }
    mix[(size_t)m * 1024 + c] = f2bf(val * siluf(bf2f(Pgate[(size_t)m * 1024 + c])));
}
#ifndef MK_SINGLE
#define MK_SINGLE 1
#endif
#ifndef MK_REPU
#define MK_REPU 0
#endif
#ifndef MK_SKIP
#define MK_SKIP 0
#endif
#ifndef MK_REPK
#define MK_REPK 0
#endif
#ifndef MK_REP2
#define MK_REP2 0
#endif
#ifndef MK_REP3
#define MK_REP3 0
#endif
#ifndef MK_P2
#define MK_P2 1
#endif
#ifndef MK_P3
#define MK_P3 1
#endif
#ifndef MK_P4A
#define MK_P4A 1
#endif
constexpr int PT_OUT = 24, PT_WS = 25, PT_N = 26;
__device__ __forceinline__ void build_frame(Frame& F, LAS unsigned char* lds) {
    F.lds = lds; F.MISC = (volatile LAS unsigned*)(lds + MISC_OFF); F.ptab = (volatile LAS const unsigned long long*)(lds + MISC_OFF + 256);
    const int t = pg8::mk_tid(lds);
    F.tid = t; F.lane = t & 63; F.wave = __builtin_amdgcn_readfirstlane(t >> 6);
    F.G = gridDim.x; { const int bx = blockIdx.x; F.vcu = (F.G % 8 == 0) ? (bx % 8) * (F.G / 8) + bx / 8 : bx; }
    F.ws = (unsigned char*)inptr(F, PT_WS); F.out = (float*)inptr(F, PT_OUT); F.ctl = (gu32*)F.ws;
}
__device__ __forceinline__ bool ph_in(LAS unsigned char* lds, int k) { volatile LAS unsigned* mi = (volatile LAS unsigned*)(lds + MISC_OFF); const int lo = __builtin_amdgcn_readfirstlane((int)mi[20]), hi = __builtin_amdgcn_readfirstlane((int)mi[21]); return lo <= k && k < hi; }
__device__ __forceinline__ void seam(LAS unsigned char* lds, int k) {
    if (ph_in(lds, k) && ph_in(lds, k + 1)) { Frame F; build_frame(F, lds);
        XcdBarrier bar; bar.bar = (unsigned*)(F.ctl + CW_BAR); bar.x = xb_xcc_id(); bar.st = F.MISC + 8; xcd_barrier(bar); }
}
__device__ __forceinline__ void xcd_barrier_now(Frame& F) { XcdBarrier bar; bar.bar = (unsigned*)(F.ctl + CW_BAR); bar.x = xb_xcc_id(); bar.st = F.MISC + 8; xcd_barrier(bar); }
template <int L> __device__ __forceinline__ void layer_phases(LAS unsigned char* lds) {
    constexpr int pb = 1 + 5 * L;
    if (ph_in(lds, pb)) { Frame F; build_frame(F, lds);
        pg8::Gemm g{(const pg8::bf16_t*)(F.ws + WS_XB), (const pg8::bf16_t*)(F.ws + WS_WIN) + (size_t)L * NP * D, M, NP, D};
        pg8::StaticOrder S; S.init(M, NP, F.G, (int)blockIdx.x);
        pg8::EpiRoute E{F.ws};
        pg8::gemm_phase<pg8::EpiRoute, pg8::StaticOrder, true, true>(F.lds + RING_OFF, g, S, E);
#if MK_REPK == 2
        xcd_barrier_now(F);
        pg8::gemm_phase<pg8::EpiRoute, pg8::StaticOrder, true, true>(F.lds + RING_OFF, g, S, E);
#endif
    }
    seam(lds, pb);
    if (ph_in(lds, pb + 1)) { Frame F; build_frame(F, lds); p2_prep2<0>(F, L); }
#if MK_REP2
    seam(lds, pb);
    if (ph_in(lds, pb + 1)) { Frame F; build_frame(F, lds); p2_prep2<MK_REP2 - 1>(F, L); }
#endif
    seam(lds, pb + 1);
#if MK_REPU
    if (ph_in(lds, pb + 2)) { Frame F; build_frame(F, lds); gu32* head = F.ctl + CW_QUEUE + 64 * (2 * L + 1);
        const int n = (MK_REPU == 1) ? U_GDN : (MK_REPU == 2) ? U_RWKV : U_ATT;
        for (;;) { const int u = next_unit(F, head); if (u >= n) break; if (MK_REPU == 1) gdn_unit3<MK_SKIP>(F, L, u, F.ctl + CW_FLAG + 64 * 256 * (2 * L + 1) + 64 * 128); else if (MK_REPU == 2) rwkv_unit<MK_SKIP>(F, u, F.ctl + CW_FLAG + 64 * 256 * (2 * L + 1)); else attn_unit(F, u); } }
    seam(lds, pb + 1);
#endif
    if (ph_in(lds, pb + 2)) { Frame F; build_frame(F, lds); p3_mixers(F, L, 0); }
#if MK_REP3
    seam(lds, pb + 1);
    if (ph_in(lds, pb + 2)) { Frame F; build_frame(F, lds); p3_mixers(F, L, 1); }
#endif
    seam(lds, pb + 2);
    if (ph_in(lds, pb + 3)) { Frame F; build_frame(F, lds); p4a_mix2(F, L);
#if MK_REPK == 3
        xcd_barrier_now(F); p4a_mix2(F, L);
#endif
    }
    seam(lds, pb + 3);
    if (ph_in(lds, pb + 4)) { Frame F; build_frame(F, lds);
        pg8::Gemm g{(const pg8::bf16_t*)(F.ws + WS_MIX), (const pg8::bf16_t*)(F.ws + WS_WOUT) + (size_t)L * D * D, M, D, D};
        pg8::StaticOrder S; S.init(M, D, F.G, (int)blockIdx.x);
        pg8::EpiOut E{L == 0 ? (const float*)inptr(F, 0) : (const float*)F.out, F.out, F.ws};
        pg8::gemm_phase<pg8::EpiOut, pg8::StaticOrder, true, true>(F.lds + RING_OFF, g, S, E);
#if MK_REPK == 4
        if (L == 0) { xcd_barrier_now(F); pg8::gemm_phase<pg8::EpiOut, pg8::StaticOrder, true, true>(F.lds + RING_OFF, g, S, E); }
#endif
    }
    seam(lds, pb + 4);
}
__global__ void __launch_bounds__(NWAVES * 64, 2) mk_fwd(Args args) {
    extern __shared__ __attribute__((aligned(16))) unsigned char lds_raw[];
    LAS unsigned char* lds = (LAS unsigned char*)lds_raw;
    for (int u = threadIdx.x; u < (LDS_BYTES - LDSCTL_OFF) / 4; u += NWAVES * 64) ((LAS unsigned*)(lds + LDSCTL_OFF))[u] = 0u;
    __syncthreads();
    if (threadIdx.x == 0) { LAS unsigned long long* pt = (LAS unsigned long long*)(lds + MISC_OFF + 256);
#define PT(k) pt[k] = (unsigned long long)args.in[k]
        PT(0); PT(1); PT(2); PT(3); PT(4); PT(5); PT(6); PT(7); PT(8); PT(9); PT(10); PT(11); PT(12); PT(13); PT(14); PT(15); PT(16); PT(17); PT(18); PT(19); PT(20); PT(21); PT(22); PT(23);
#undef PT
        pt[PT_OUT] = (unsigned long long)args.out; pt[PT_WS] = (unsigned long long)args.ws;
        volatile LAS unsigned* mi = (volatile LAS unsigned*)(lds + MISC_OFF); mi[20] = (unsigned)args.ph_lo; mi[21] = (unsigned)args.ph_hi;
        if (args.ph_hi - args.ph_lo > 1) (void)xcd_barrier_post((unsigned*)((gu32*)args.ws + CW_BAR), mi + 8);
    }
    if ((threadIdx.x & 63) == 0) ((volatile LAS unsigned*)(lds + pg8::TIDTAB_OFF))[pg8::hw_slot()] = threadIdx.x >> 6;
    __syncthreads();
    if (ph_in(lds, 0)) { Frame F; build_frame(F, lds); p0_prologue(F); }
#if MK_REPK == 1
    seam(lds, 0);
    if (ph_in(lds, 0)) { Frame F; build_frame(F, lds); p0_prologue(F); }
#endif
    seam(lds, 0);
    layer_phases<0>(lds);
    layer_phases<1>(lds);
    if (ph_in(lds, 11)) { Frame F; build_frame(F, lds); p5_final(F); }
}

static void launch_phases(hipStream_t stream, int grid, Args a, int lo, int hi) {
    a.ph_lo = lo; a.ph_hi = hi;
    hipLaunchKernelGGL(mk_fwd, dim3(grid), dim3(NWAVES * 64), LDS_BYTES, stream, a);
}
extern "C" void kernel_launch(void* const* d_in, const int* in_sizes, int n_in, void* d_out, int out_size, void* d_ws, size_t ws_size, hipStream_t stream) {
    static int grid = 0;
    if (grid == 0) {
        if (n_in != 24 || ws_size < WS_END || out_size != M * D) { fprintf(stderr, "kernel_launch: unexpected inputs (%d), out (%d) or workspace (%zu)\n", n_in, out_size, ws_size); grid = -1; return; }
        int dev = 0, cus = 0;
        if (hipGetDevice(&dev) != hipSuccess || hipDeviceGetAttribute(&cus, hipDeviceAttributeMultiprocessorCount, dev) != hipSuccess) { grid = -1; return; }
        if (hipFuncSetAttribute((const void*)mk_fwd, hipFuncAttributeMaxDynamicSharedMemorySize, LDS_BYTES) != hipSuccess) { fprintf(stderr, "kernel_launch: hipFuncSetAttribute failed\n"); grid = -1; return; }
        (void)hipGetLastError();
        grid = cus;
    }
    if (grid < 0) return;
    unsigned char* ws = (unsigned char*)d_ws;
    hipMemsetAsync(ws + WS_CTL, 0, CTL_ZERO_BYTES, stream);
    Args a{};
    for (int i = 0; i < 24; ++i) a.in[i] = d_in[i];
    a.out = (float*)d_out; a.ws = ws;

    const int* positions = (const int*)d_in[1];
    const float* gdn_conv = (const float*)d_in[4]; const float* gdn_a_log = (const float*)d_in[5]; const float* gdn_dt_bias = (const float*)d_in[6]; const float* gdn_norm_g = (const float*)d_in[7];
    const float* mu = (const float*)d_in[12]; const float* w0 = (const float*)d_in[13]; const float* w2 = (const float*)d_in[14]; const float* a0 = (const float*)d_in[15];
    const float* a2 = (const float*)d_in[16]; const float* k_k = (const float*)d_in[17]; const float* k_a = (const float*)d_in[18]; const float* r_k = (const float*)d_in[19];
    const float* ln_g = (const float*)d_in[20]; const float* ln_b = (const float*)d_in[21];
    bf16* WuqT = (bf16*)(ws + WS_WSMALL + OFF_WUQ); bf16* WukvT = (bf16*)(ws + WS_WSMALL + OFF_WUKV);
    float* Psm = (float*)(ws + WS_PSM); float* cb = (float*)(ws + WS_CB);
    bf16* Pgate = (bf16*)(ws + WS_PGATE); bf16* Pgdn = (bf16*)(ws + WS_PGDN); bf16* Pmla = (bf16*)(ws + WS_PMLA); bf16* Prw = (bf16*)(ws + WS_PRW);
    bf16* Ogdn = (bf16*)(ws + WS_OGDN); bf16* Omla = (bf16*)(ws + WS_OMLA); bf16* Y = (bf16*)(ws + WS_Y);
    unsigned char* Rs = ws + WS_RS; unsigned char* Rd = ws + WS_RD;
    bf16* Q = (bf16*)(ws + WS_Q); bf16* Kb = (bf16*)(ws + WS_K); bf16* Vt = (bf16*)(ws + WS_VT); bf16* mix = (bf16*)(ws + WS_MIX);

#if MK_SINGLE
    launch_phases(stream, grid, a, 0, NPHASE);
    return;
#endif
    launch_phases(stream, grid, a, 0, 1);
    for (int l = 0; l < 2; ++l) {
        launch_phases(stream, grid, a, 1 + 5 * l, 2 + 5 * l);
#if MK_P2
        launch_phases(stream, grid, a, 2 + 5 * l, 3 + 5 * l);
#else
        hipLaunchKernelGGL(nk_mla_prep, dim3(M), dim3(64), 0, stream, Pmla, WuqT + (size_t)l * 576 * 192, WukvT + (size_t)l * 768 * 128, positions, Q, Kb, Vt);
        hipLaunchKernelGGL(nk_rwkv_prep, dim3(M), dim3(256), 0, stream, Prw, mu + l * 2 * 896, w0 + l * 512, w2 + (size_t)l * 2 * 64 * 256, a0 + l * 512, a2 + (size_t)l * 2 * 64 * 256,
                           k_k + l * 256, k_a + l * 256, r_k + l * 256, Rs, Rd, cb);
#endif
#if MK_P3
        launch_phases(stream, grid, a, 3 + 5 * l, 4 + 5 * l);
#else
        hipLaunchKernelGGL(nk_attn, dim3(SEQ / 128, BATCH * 6), dim3(128), 0, stream, Q, Kb, Vt, Omla);
        for (int dir = 0; dir < 2; ++dir) {
            hipLaunchKernelGGL(nk_gdn, dim3(BATCH * 6), dim3(64), 0, stream, Pgdn, Psm, gdn_conv + (size_t)l * 5 * 1152, gdn_a_log + l * 12, gdn_dt_bias + l * 12, Ogdn, dir);
            hipLaunchKernelGGL(nk_rwkv, dim3(BATCH * 4), dim3(64), 0, stream, Rs, Rd, Y, dir);
        }
#endif
#if MK_P4A
        launch_phases(stream, grid, a, 4 + 5 * l, 5 + 5 * l);
#else
        hipLaunchKernelGGL(nk_mix, dim3(M), dim3(1024), 0, stream, Ogdn, Omla, Y, Pgate, Rs, cb, gdn_norm_g + l * 64, ln_g + l * 256, ln_b + l * 256, mix);
#endif
        launch_phases(stream, grid, a, 5 + 5 * l, 6 + 5 * l);
    }
    launch_phases(stream, grid, a, 11, 12);
}
```

```cpp
#include <hip/hip_runtime.h>
#include <cstdio>
#include <cstdint>
#include <hip/hip_fp16.h>
namespace pg8 {
#define PG8_LAS __attribute__((address_space(3)))
typedef unsigned short bf16_t;
typedef short bf16x8 __attribute__((ext_vector_type(8)));
typedef float f32x4 __attribute__((ext_vector_type(4)));
typedef unsigned u32x4 __attribute__((ext_vector_type(4)));
constexpr int BM = 256, BK = 64, HALF = 128, HTB = HALF * BK * 2  , STAGE_BYTES = 8 * HTB, NXCD = 8, WGM = 8;

__host__ __device__ __forceinline__ int lds_byte(int r, int c) { const int st = (r >> 4) * 2 + (c >> 5), rr = r & 15, cc = c & 31, ob = rr * 64 + cc * 2; return st * 1024 + (ob ^ (((ob >> 9) & 1) << 5)); }
__host__ __device__ __forceinline__ void stage_rc(int b, int& R, int& C) { const int st = b / 1024, sb = b % 1024, swz = sb ^ (((sb >> 9) & 1) << 5); R = (st >> 1) * 16 + swz / 64; C = (st & 1) * 32 + (swz % 64) / 2; }
__host__ __device__ __forceinline__ int perm32(int rho) { const int n = rho >> 4, i = rho & 15; return 8 * (i >> 2) + 4 * n + (i & 3); }

struct Unit { int pm, pn; };
struct Gemm { const bf16_t* A; const bf16_t* Bt; int M, N, K; };

struct StaticOrder {
    int nM, nN, nwg, G, c;
    __host__ __device__ void init(int M, int N, int G_, int c_) { nM = M / BM; nN = N / BM; nwg = nM * nN; G = G_; c = c_; }
    __host__ __device__ bool next(int i, Unit& u) const {
        const long L = (long)i * G + c; if (L >= nwg) return false;
        int wgid = (int)L; { const int q = nwg / NXCD, r = nwg % NXCD, xcd = wgid % NXCD, off = wgid / NXCD; wgid = (xcd < r ? xcd * (q + 1) : r * (q + 1) + (xcd - r) * q) + off; }
        const int nig = WGM * nN, gid = wgid / nig, fm = gid * WGM, gsz = (nM - fm) < WGM ? (nM - fm) : WGM;
        u.pm = fm + ((wgid % nig) % gsz); u.pn = (wgid % nig) / gsz; return true;
    }
    __device__ __forceinline__ void a_ready(const Unit&) const {}
    __device__ __forceinline__ void done(const Unit&) const {}
};

__device__ __forceinline__ unsigned cvt_pk_bf16(float lo, float hi) { unsigned r; asm volatile("v_cvt_pk_bf16_f32 %0, %1, %2" : "=v"(r) : "v"(lo), "v"(hi)); return r; }
typedef float f32x2 __attribute__((ext_vector_type(2)));
constexpr int TIDTAB_OFF = 131072 + 320 + 512;
__device__ __forceinline__ unsigned hw_slot() { return (unsigned)__builtin_amdgcn_s_getreg((5 << 11) | 4) & 63u; }
__device__ __forceinline__ int mk_tid(PG8_LAS unsigned char* lds_base) {
    const unsigned lane = __builtin_amdgcn_mbcnt_hi(~0u, __builtin_amdgcn_mbcnt_lo(~0u, 0u));
    const unsigned w = __builtin_amdgcn_readfirstlane(((volatile PG8_LAS unsigned*)(lds_base + TIDTAB_OFF))[hw_slot()]);
    return (int)(w * 64u + lane);
}
struct EpiRoute {
    static constexpr bool PERM = true, AFTER_DRAIN = false;
    unsigned char* ws;
    __device__ __forceinline__ void operator()(const f32x4 (&acc)[2][2][4][2], const Unit& u, int wr, int wc, int fr, int fq) const {
        const int row0 = u.pm * BM + wr * 64 + fr;
        const float* rowss = (const float*)(ws + (1u << 20)); float* Psm = (float*)(ws + (22u << 20));
        unsigned base[2]; int ld[2], cc[2], kind[2];
#pragma unroll
        for (int bj = 0; bj < 2; ++bj) {
            const int cg = u.pn * BM + bj * HALF + wc * 32, col = cg + 8 * fq;
            if (cg < 1024) { base[bj] = 25u << 20; ld[bj] = 1024; cc[bj] = col; kind[bj] = 0; }
            else if (cg < 2176) { base[bj] = 57u << 20; ld[bj] = 1152; cc[bj] = col - 1024; kind[bj] = 0; }
            else if (cg < 2528) { base[bj] = 93u << 20; ld[bj] = 352; cc[bj] = col - 2176; kind[bj] = 0; }
            else if (cg < 3424) { base[bj] = 104u << 20; ld[bj] = 896; cc[bj] = col - 2528; kind[bj] = 0; }
            else if (cg < 3456) { base[bj] = 0u; ld[bj] = 32; cc[bj] = col - 3424; kind[bj] = 1; }
            else { base[bj] = 0u; ld[bj] = 0; cc[bj] = 0; kind[bj] = 2; }
        }
#pragma unroll
        for (int ai = 0; ai < 2; ++ai)
#pragma unroll
            for (int m = 0; m < 4; ++m) {
                const int row = row0 + ai * HALF + m * 16;
                const f32x4* rp = (const f32x4*)(rowss + (size_t)row * 16);
                const f32x4 s0 = rp[0], s1 = rp[1], s2 = rp[2], s3 = rp[3];
                const float ss = ((s0[0] + s0[1]) + (s0[2] + s0[3])) + ((s1[0] + s1[1]) + (s1[2] + s1[3])) + ((s2[0] + s2[1]) + (s2[2] + s2[3])) + ((s3[0] + s3[1]) + (s3[2] + s3[3]));
                const float rstd = __builtin_amdgcn_rsqf(ss * (1.0f / 1024.0f) + 1e-6f);
#pragma unroll
                for (int bj = 0; bj < 2; ++bj) {
                    const f32x4 v0 = acc[ai][bj][m][0] * rstd, v1 = acc[ai][bj][m][1] * rstd;
                    if (kind[bj] == 0) { u32x4 w; w.x = cvt_pk_bf16(v0[0], v0[1]); w.y = cvt_pk_bf16(v0[2], v0[3]); w.z = cvt_pk_bf16(v1[0], v1[1]); w.w = cvt_pk_bf16(v1[2], v1[3]);
                        *(u32x4*)((bf16_t*)(ws + base[bj]) + (size_t)row * ld[bj] + cc[bj]) = w; }
                    else if (kind[bj] == 1) { float* p = Psm + (size_t)row * 32 + cc[bj]; *(f32x4*)p = v0; *(f32x4*)(p + 4) = v1; }
                }
                asm volatile("" ::: "memory");
            }
    }
};
struct EpiOut {
    static constexpr bool PERM = false, AFTER_DRAIN = false;
    const float* xin; float* xout; unsigned char* ws;
    __device__ __forceinline__ void operator()(const f32x4 (&acc)[2][2][4][2], const Unit& u, int wr, int wc, int fr, int fq) const {
        typedef unsigned u32x2v __attribute__((ext_vector_type(2)));
        const int row0 = u.pm * BM + wr * 64 + fr, col0 = u.pn * BM + wc * 32 + 4 * fq;
        float* rowss = (float*)(ws + (1u << 20)); bf16_t* xb = (bf16_t*)(ws + (133u << 20));
#pragma unroll
        for (int ai = 0; ai < 2; ++ai)
#pragma unroll
            for (int m = 0; m < 4; ++m) {
                const int row = row0 + ai * HALF + m * 16; float ss = 0.f;
#pragma unroll
                for (int bj = 0; bj < 2; ++bj)
#pragma unroll
                    for (int n = 0; n < 2; ++n) {
                        const size_t off = (size_t)row * 1024 + col0 + bj * HALF + n * 16;
                        const f32x4 o = *(const f32x4*)(xin + off) + acc[ai][bj][m][n];
                        *(f32x4*)(xout + off) = o;
                        u32x2v w; w.x = cvt_pk_bf16(o[0], o[1]); w.y = cvt_pk_bf16(o[2], o[3]); *(u32x2v*)(xb + off) = w;
                        ss += (o[0] * o[0] + o[1] * o[1]) + (o[2] * o[2] + o[3] * o[3]);
                    }
                ss += __shfl_xor(ss, 16); ss += __shfl_xor(ss, 32);
                if (fq == 0) rowss[(size_t)row * 16 + u.pn * 4 + wc] = ss;
                asm volatile("" ::: "memory");
            }
    }
};
template <class Epi, class Sched, bool ALIGN_EPI = false, bool SP2 = false>
__device__ __forceinline__ void gemm_phase(PG8_LAS unsigned char* lds, const Gemm g, const Sched& S, const Epi& E) {
    const int tid_ = mk_tid(lds);
    const int tid = tid_, wid = __builtin_amdgcn_readfirstlane(tid >> 6), lane = tid & 63, wr = wid >> 2, wc = wid & 3, fr = lane & 15, fq = lane >> 4;
    const int K = g.K, nt = K / BK;
    unsigned voffA[2], voffB[2];
#pragma unroll
    for (int i = 0; i < 2; ++i) { int R, C; stage_rc(tid * 16 + i * 8192, R, C); const int Rb = Epi::PERM ? ((R & ~31) + perm32(R & 31)) : R;
        voffA[i] = (unsigned)(R * K + C) * 2u; voffB[i] = (unsigned)(Rb * K + C) * 2u; }
    const size_t kstep = (size_t)(BK * 2);
    const size_t hstep = (size_t)HALF * K * 2;
    const size_t tstep = 2 * hstep;
    const unsigned ldsw = (unsigned)wid * 1024u;
    const int aoff = lds_byte(wr * 64 + fr, fq * 8), boff = lds_byte(wc * 32 + fr, fq * 8);
#define PG8_SA(b, h) (((b) * 2 + (h)) * HTB)
#define PG8_SB(b, h) ((4 + (b) * 2 + (h)) * HTB)
#define PG8_STAGE(bufoff, gbase, voff) do { _Pragma("unroll") for (int _i = 0; _i < 2; ++_i) \
        __builtin_amdgcn_global_load_lds((const unsigned*)((const char*)(gbase) + (voff)[_i]), (PG8_LAS unsigned*)(lds + (bufoff) + ldsw + _i * 8192), 16, 0, 0); } while (0)
#define PG8_LDA(dst, b, h) do { _Pragma("unroll") for (int m = 0; m < 4; ++m) _Pragma("unroll") for (int k = 0; k < 2; ++k) dst[m][k] = *(const PG8_LAS bf16x8*)(lds + PG8_SA(b, h) + aoff + m * 2048 + k * 1024); } while (0)
#define PG8_LDB(dst, b, h) do { _Pragma("unroll") for (int n = 0; n < 2; ++n) _Pragma("unroll") for (int k = 0; k < 2; ++k) dst[n][k] = *(const PG8_LAS bf16x8*)(lds + PG8_SB(b, h) + boff + n * 2048 + k * 1024); } while (0)
#define PG8_MMA(ai, bj, At, Bt) do { __builtin_amdgcn_s_setprio(1); _Pragma("unroll") for (int m = 0; m < 4; ++m) _Pragma("unroll") for (int n = 0; n < 2; ++n) _Pragma("unroll") for (int k = 0; k < 2; ++k) \
        acc[ai][bj][m][n] = __builtin_amdgcn_mfma_f32_16x16x32_bf16(Bt[n][k], At[m][k], acc[ai][bj][m][n], 0, 0, 0); __builtin_amdgcn_s_setprio(0); } while (0)
#define PG8_WAIT_V(n) asm volatile("s_waitcnt vmcnt(" #n ")" ::: "memory")
#define PG8_WAIT_L(n) asm volatile("s_waitcnt lgkmcnt(" #n ")" ::: "memory")
#define PG8_BAR __builtin_amdgcn_s_barrier()
#define PG8_SCHED __builtin_amdgcn_sched_barrier(0)
    Unit cur, nxt; int ui = 0;
    if (!S.next(0, cur)) return;
    f32x4 acc[2][2][4][2];
#pragma unroll
    for (int a = 0; a < 2; ++a)
#pragma unroll
        for (int b = 0; b < 2; ++b)
#pragma unroll
            for (int m = 0; m < 4; ++m)
#pragma unroll
                for (int n = 0; n < 2; ++n) acc[a][b][m][n] = (f32x4){0.f, 0.f, 0.f, 0.f};
    bf16x8 At[4][2], B0[2][2], B1[2][2];
    const char* cA = (const char*)g.A + (size_t)cur.pm * tstep; const char* cB = (const char*)g.Bt + (size_t)cur.pn * tstep;
    S.a_ready(cur);
    if constexpr (SP2) {
        PG8_STAGE(PG8_SB(0, 0), cB, voffB); PG8_STAGE(PG8_SB(0, 1), cB + hstep, voffB); PG8_STAGE(PG8_SA(0, 0), cA, voffA); PG8_STAGE(PG8_SA(0, 1), cA + hstep, voffA);
        if (wr == 1) PG8_BAR;
        PG8_WAIT_V(2); PG8_BAR;
        PG8_STAGE(PG8_SB(1, 0), cB + kstep, voffB); PG8_STAGE(PG8_SA(1, 0), cA + kstep, voffA); PG8_STAGE(PG8_SB(1, 1), cB + hstep + kstep, voffB);
        PG8_WAIT_V(6); PG8_BAR;
    } else {
        PG8_STAGE(PG8_SB(0, 0), cB, voffB); PG8_STAGE(PG8_SA(0, 0), cA, voffA); PG8_STAGE(PG8_SB(0, 1), cB + hstep, voffB); PG8_STAGE(PG8_SA(0, 1), cA + hstep, voffA);
        if (wr == 1) PG8_BAR;
        PG8_WAIT_V(4); PG8_BAR;
        PG8_STAGE(PG8_SB(1, 0), cB + kstep, voffB); PG8_STAGE(PG8_SA(1, 0), cA + kstep, voffA); PG8_STAGE(PG8_SB(1, 1), cB + hstep + kstep, voffB);
        PG8_WAIT_V(6); PG8_BAR;
    }
    for (;;) {
        const bool has_next = S.next(ui + 1, nxt);
        const char* nA = has_next ? (const char*)g.A + (size_t)nxt.pm * tstep : cA; const char* nB = has_next ? (const char*)g.Bt + (size_t)nxt.pn * tstep : cB;
        for (int t = 0; t < nt; t += 2) {
            const bool last = (t == nt - 2);
            const char* a1 = cA + (size_t)(t + 1) * kstep;
            const char* a2 = last ? nA : cA + (size_t)(t + 2) * kstep; const char* b2 = last ? nB : cB + (size_t)(t + 2) * kstep;
            const char* a3 = a2 + kstep; const char* b3 = b2 + kstep;
            if (last && has_next) S.a_ready(nxt);
            if constexpr (SP2) {
            PG8_LDB(B0, 0, 0); PG8_LDB(B1, 0, 1); PG8_SCHED; PG8_LDA(At, 0, 0); PG8_STAGE(PG8_SA(1, 1), a1 + hstep, voffA);
            PG8_WAIT_V(8); PG8_WAIT_L(0); PG8_BAR; PG8_MMA(0, 0, At, B0); PG8_MMA(0, 1, At, B1); PG8_BAR; PG8_SCHED;
            PG8_LDA(At, 0, 1); PG8_STAGE(PG8_SB(0, 0), b2, voffB); PG8_STAGE(PG8_SB(0, 1), b2 + hstep, voffB); PG8_STAGE(PG8_SA(0, 0), a2, voffA);
            PG8_WAIT_V(8); PG8_WAIT_L(0); PG8_BAR; PG8_MMA(1, 0, At, B0); PG8_MMA(1, 1, At, B1); PG8_BAR; PG8_SCHED;
            PG8_LDB(B0, 1, 0); PG8_LDB(B1, 1, 1); PG8_SCHED; PG8_LDA(At, 1, 0); PG8_STAGE(PG8_SA(0, 1), a2 + hstep, voffA);
            PG8_WAIT_V(8); PG8_WAIT_L(0); PG8_BAR; PG8_MMA(0, 0, At, B0); PG8_MMA(0, 1, At, B1); PG8_BAR; PG8_SCHED;
            PG8_LDA(At, 1, 1); PG8_STAGE(PG8_SB(1, 0), b3, voffB); PG8_STAGE(PG8_SB(1, 1), b3 + hstep, voffB); PG8_STAGE(PG8_SA(1, 0), a3, voffA);
            PG8_WAIT_V(8); PG8_WAIT_L(0); PG8_BAR; PG8_MMA(1, 0, At, B0); PG8_MMA(1, 1, At, B1); PG8_BAR; PG8_SCHED;
            } else {
            PG8_LDB(B0, 0, 0); PG8_SCHED; PG8_LDA(At, 0, 0); PG8_STAGE(PG8_SA(1, 1), a1 + hstep, voffA);
            PG8_WAIT_L(8); PG8_BAR; PG8_WAIT_L(0); PG8_MMA(0, 0, At, B0); PG8_BAR; PG8_SCHED;
            PG8_LDB(B1, 0, 1); PG8_STAGE(PG8_SB(0, 0), b2, voffB);
            PG8_BAR; PG8_WAIT_L(0); PG8_MMA(0, 1, At, B1); PG8_BAR;
            PG8_LDA(At, 0, 1); PG8_STAGE(PG8_SA(0, 0), a2, voffA);
            PG8_BAR; PG8_WAIT_L(0); PG8_MMA(1, 0, At, B0); PG8_BAR; PG8_SCHED;
            PG8_STAGE(PG8_SB(0, 1), b2 + hstep, voffB);
            PG8_WAIT_V(6); PG8_BAR; PG8_MMA(1, 1, At, B1); PG8_BAR;
            PG8_LDB(B0, 1, 0); PG8_SCHED; PG8_LDA(At, 1, 0); PG8_STAGE(PG8_SA(0, 1), a2 + hstep, voffA);
            PG8_WAIT_L(8); PG8_BAR; PG8_WAIT_L(0); PG8_MMA(0, 0, At, B0); PG8_BAR; PG8_SCHED;
            PG8_LDB(B1, 1, 1); PG8_STAGE(PG8_SB(1, 0), b3, voffB);
            PG8_BAR; PG8_WAIT_L(0); PG8_MMA(0, 1, At, B1); PG8_BAR;
            PG8_LDA(At, 1, 1); PG8_STAGE(PG8_SA(1, 0), a3, voffA);
            PG8_BAR; PG8_WAIT_L(0); PG8_MMA(1, 0, At, B0); PG8_BAR; PG8_SCHED;
            PG8_STAGE(PG8_SB(1, 1), b3 + hstep, voffB);
            PG8_WAIT_V(6); PG8_BAR; PG8_MMA(1, 1, At, B1); PG8_BAR;
            }
        }
        if constexpr (ALIGN_EPI) { if (wr == 0) PG8_BAR; }
        if constexpr (!Epi::AFTER_DRAIN) { E(acc, cur, wr, wc, fr, fq); S.done(cur); }
        if (!has_next) break;
#pragma unroll
        for (int a = 0; a < 2; ++a)
#pragma unroll
            for (int b = 0; b < 2; ++b)
#pragma unroll
                for (int m = 0; m < 4; ++m)
#pragma unroll
                    for (int n = 0; n < 2; ++n) acc[a][b][m][n] = (f32x4){0.f, 0.f, 0.f, 0.f};
        cur = nxt; cA = nA; cB = nB; ++ui;
        if constexpr (ALIGN_EPI) { if (wr == 1) PG8_BAR; }
    }
    PG8_WAIT_V(0);
    if constexpr (!ALIGN_EPI) { if (wr == 0) PG8_BAR; }
    PG8_BAR;
    if constexpr (Epi::AFTER_DRAIN) { E.fused(acc, cur, wr, wc, fr, fq, lds, wid, lane); S.done(cur); }
#undef PG8_SA
#undef PG8_SB
#undef PG8_STAGE
#undef PG8_LDA
#undef PG8_LDB
#undef PG8_MMA
#undef PG8_WAIT_V
#undef PG8_WAIT_L
#undef PG8_BAR
#undef PG8_SCHED
}
}
#define GAS __attribute__((address_space(1)))
#define LAS __attribute__((address_space(3)))
typedef unsigned short bf16;
typedef unsigned v4u __attribute__((ext_vector_type(4)));
typedef float f32x4 __attribute__((ext_vector_type(4)));
typedef short bf16x8 __attribute__((ext_vector_type(8)));
typedef GAS unsigned gu32;
typedef GAS unsigned long long gu64;
#define RLX_AGENT __ATOMIC_RELAXED, __HIP_MEMORY_SCOPE_AGENT
#define LDS_WAIT() asm volatile("s_waitcnt lgkmcnt(0)" ::: "memory")
#define VM_WAIT() asm volatile("s_waitcnt vmcnt(0)" ::: "memory")
__device__ __forceinline__ unsigned long long rt() { return __builtin_amdgcn_s_memrealtime(); }
__device__ __forceinline__ unsigned f2bf(float f) { unsigned u = __builtin_bit_cast(unsigned, f); return (u + 0x7fffu + ((u >> 16) & 1u)) >> 16; }
__device__ __forceinline__ unsigned pk2(float lo, float hi) { return f2bf(lo) | (f2bf(hi) << 16); }

#define XB_TMO      128
#define XB_XCNT(j)  (256  + 64 * (j))
#define XB_XSUB(j)  (1280 + 64 * (j))
#define XB_XGEN(j)  (2304 + 64 * (j))
#define XB_TOP      3328
#define XB_TOPGEN   3392
#define XCD_BAR_WORDS 3456
#define XB_SPIN_CAP (1u << 18)

__device__ __forceinline__ unsigned xb_ld(unsigned* p)              { return __hip_atomic_load(p, __ATOMIC_RELAXED, __HIP_MEMORY_SCOPE_AGENT); }
__device__ __forceinline__ unsigned xb_add(unsigned* p, unsigned v) { return __hip_atomic_fetch_add(p, v, __ATOMIC_RELAXED, __HIP_MEMORY_SCOPE_AGENT); }
__device__ __forceinline__ unsigned xb_xcc_id() { return (unsigned)__builtin_amdgcn_s_getreg((3 << 11) | 20) & 0xFu; }
#define XB_SPIN(cond, bar) do { unsigned _sp = 0; while (cond) { __builtin_amdgcn_s_sleep(1); \
    if ((++_sp & 255u) == 0u) { if (xb_ld(&(bar)[XB_TMO])) break; if (_sp > XB_SPIN_CAP) { atomicAdd(&(bar)[XB_TMO], 1u); break; } } } } while (0)

struct XcdBarrier {
    unsigned* bar; unsigned x;
    volatile LAS unsigned* st;
};

__device__ __forceinline__ XcdBarrier xcd_barrier_post(unsigned* bar, volatile LAS unsigned* st) {
    XcdBarrier b; b.bar = bar; b.x = xb_xcc_id(); b.st = st;
    if (threadIdx.x == 0) (void)xb_add(&bar[XB_XCNT(b.x)], 1u);
    return b;
}
__device__ __forceinline__ void xcd_barrier_complete(unsigned* bar, unsigned x, unsigned& nloc, unsigned& nx) {
    const unsigned G = gridDim.x * gridDim.y * gridDim.z;
    unsigned sum, cnt, mine, sp = 0u;
    for (;;) {
        sum = 0u; cnt = 0u; mine = 0u;
#pragma unroll
        for (unsigned j = 0; j < 16; ++j) { const unsigned c = xb_ld(&bar[XB_XCNT(j)]); sum += c; cnt += (c > 0u) ? 1u : 0u; mine = (j == x) ? c : mine; }
        if (sum == G) break;
        __builtin_amdgcn_s_sleep(1);
        if ((++sp & 255u) == 0u) { if (xb_ld(&bar[XB_TMO])) break; if (sp > XB_SPIN_CAP) { atomicAdd(&bar[XB_TMO], 1u); break; } }
    }
    nloc = mine > 0u ? mine : 1u; nx = cnt > 0u ? cnt : 1u;
}

__device__ __forceinline__ void xcd_barrier(const XcdBarrier& b) {
    asm volatile("s_waitcnt vmcnt(0)" ::: "memory");
    __syncthreads();
    if (pg8::mk_tid((LAS unsigned char*)b.st - (131072 + 320 + 32)) == 0) {
        unsigned* bar = b.bar;
        __builtin_amdgcn_s_waitcnt(0);
        unsigned nloc = b.st[0], nx = b.st[1];
        if (nloc == 0u) { xcd_barrier_complete(bar, b.x, nloc, nx); b.st[0] = nloc; b.st[1] = nx; }
        const unsigned old = xb_add(&bar[XB_XSUB(b.x)], 1u);
        const unsigned gen = old / nloc;
        if (old + 1u == (gen + 1u) * nloc) {
            __builtin_amdgcn_fence(__ATOMIC_RELEASE, "agent");
            asm volatile("s_waitcnt vmcnt(0)" ::: "memory");
            const unsigned og = xb_add(&bar[XB_TOP], 1u);
            const unsigned tg = og / nx;
            if (og + 1u == (tg + 1u) * nx) xb_add(&bar[XB_TOPGEN], 1u);
            else XB_SPIN(xb_ld(&bar[XB_TOPGEN]) == tg, bar);
            __builtin_amdgcn_fence(__ATOMIC_ACQUIRE, "agent");
            xb_add(&bar[XB_XGEN(b.x)], 1u);
            asm volatile("s_waitcnt vmcnt(0)" ::: "memory");
        } else {
            XB_SPIN(xb_ld(&bar[XB_XGEN(b.x)]) == gen, bar);
            __builtin_amdgcn_fence(__ATOMIC_ACQUIRE, "agent");
            asm volatile("s_waitcnt vmcnt(0)" ::: "memory");
        }
    }
    __syncthreads();
}
constexpr int BATCH = 8, SEQ = 2048, M = BATCH * SEQ, D = 1024, NIN = 3448, NP = 3584;
constexpr float NORM_EPS = 1e-6f;
constexpr float LOG2E = 1.4426950408889634f;
constexpr size_t MiB = 1u << 20;
constexpr size_t WS_CTL = 0, CTL_ZERO_BYTES = 1 * MiB;
constexpr size_t WS_ROWSS = 1 * MiB;
constexpr size_t WS_WIN = 2 * MiB;
constexpr size_t WS_WOUT = 16 * MiB;
constexpr size_t WS_WSMALL = 20 * MiB;
constexpr size_t OFF_WUQ = 0, OFF_WUKV = 2 * 576 * 192 * 2, OFF_W2T = OFF_WUKV + 2 * 768 * 128 * 2, OFF_A2T = OFF_W2T + 2 * 2 * 256 * 64 * 2;
constexpr size_t WS_PSM = 22 * MiB;
constexpr size_t WS_CB = 24 * MiB;
constexpr size_t WS_PGATE = 25 * MiB;
constexpr size_t WS_PGDN = 57 * MiB;
constexpr size_t WS_PMLA = 93 * MiB;
constexpr size_t WS_PRW = 104 * MiB;
constexpr size_t WS_OGDN = 93 * MiB;
constexpr size_t WS_OMLA = 105 * MiB;
constexpr size_t WS_Y = 117 * MiB;
constexpr size_t WS_RS = 133 * MiB;
constexpr size_t WS_RD = 157 * MiB;
constexpr size_t WS_XB = 133 * MiB;
constexpr size_t WS_Q = 207 * MiB;
constexpr size_t WS_K = 225 * MiB;
constexpr size_t WS_VT = 243 * MiB;
constexpr size_t WS_MIX = 207 * MiB;
constexpr size_t WS_END = 255 * MiB;
constexpr int RS_REC = 384, RD_REC = 400;
constexpr size_t RD_DIR = (size_t)BATCH * 4 * SEQ * RD_REC;
constexpr int CW_BAR = 4096;
constexpr int CW_QUEUE = 16384;

constexpr int NWAVES = 8;
constexpr int RING_OFF = 0, RING_BYTES = 131072, LDSCTL_OFF = RING_BYTES, MISC_OFF = LDSCTL_OFF + 320, LDS_BYTES = 147456;
static_assert(pg8::TIDTAB_OFF == MISC_OFF + 512 && RING_OFF == 0, "LDS map");
constexpr int NPHASE = 12;

__device__ __forceinline__ float bf2f(bf16 v) { return __uint_as_float(((unsigned)v) << 16); }
__device__ __forceinline__ float wave_sum(float v) {
#pragma unroll
    for (int o = 1; o < 64; o <<= 1) v += __shfl_xor(v, o);
    return v;
}
__device__ __forceinline__ float siluf(float x) { return x * __builtin_amdgcn_rcpf(1.f + __expf(-x)); }
__device__ __forceinline__ float sigmoidf_(float x) { return __builtin_amdgcn_rcpf(1.f + __expf(-x)); }
__device__ __forceinline__ float softplusf_(float x) { return x > 20.f ? x : log1pf(__expf(x)); }

struct Args { const void* in[24]; float* out; unsigned char* ws; int ph_lo, ph_hi; };

struct Frame {
    LAS unsigned char* lds;
    volatile LAS unsigned* MISC;
    gu32* ctl;
    int tid, lane, wave, vcu, G;
    unsigned char* ws;
    float* out;
    volatile LAS const unsigned long long* ptab;
};
__device__ __forceinline__ const void* inptr(const Frame& F, int k) {
    const unsigned long long v = F.ptab[k];
    const unsigned lo = __builtin_amdgcn_readfirstlane((unsigned)v), hi = __builtin_amdgcn_readfirstlane((unsigned)(v >> 32));
    return (const void*)(GAS const void*)(((unsigned long long)hi << 32) | lo);
}

__device__ __forceinline__ void tr_item(const float* W, int K, int ldsrc, int scol, int nvalid, bf16* WT, const float* gs, LAS float* scr, int kb, int lane) {
    const int k0 = 64 * kb;
#pragma unroll 8
    for (int i = 0; i < 32; ++i) { const int kk = 2 * i + (lane >> 5), n = lane & 31; float v = 0.f;
        if (n < nvalid) { v = W[(size_t)(k0 + kk) * ldsrc + scol + n]; if (gs) v *= gs[k0 + kk]; }
        scr[kk * 33 + n] = v; }
    LDS_WAIT(); asm volatile("" ::: "memory");
    const int c = lane & 7;
#pragma unroll
    for (int j = 0; j < 4; ++j) { const int n = (lane >> 3) + 8 * j; const LAS float* s = scr + (8 * c) * 33 + n;
        v4u o; o.x = pk2(s[0 * 33], s[1 * 33]); o.y = pk2(s[2 * 33], s[3 * 33]); o.z = pk2(s[4 * 33], s[5 * 33]); o.w = pk2(s[6 * 33], s[7 * 33]);
        *(GAS v4u*)(WT + (size_t)n * K + k0 + 8 * c) = o; }
    LDS_WAIT(); asm volatile("" ::: "memory");
}
__device__ __forceinline__ void p0_prologue(Frame& F) {
    LAS float* scr = (LAS float*)(F.lds + RING_OFF + F.wave * 16384);
    const int gw = F.vcu * NWAVES + F.wave, NGW = F.G * NWAVES;
    constexpr int I_IN = 112 * 16, I_OUT = 32 * 16, I_UQ = 18 * 3, I_UKV = 24 * 2, I_W2 = 16, I_A2 = 16, I_L = I_IN + I_OUT + I_UQ + I_UKV + I_W2 + I_A2;
    for (int it = gw; it < 2 * I_L; it += NGW) {
        const int l = it / I_L; int r = it % I_L;
        if (r < I_IN) { const int nb = r >> 4, kb = r & 15, n0 = 32 * nb; int scol, nv;
            if (n0 < 2176) { scol = n0; nv = 32; } else if (n0 < 3424) { scol = n0 + 24; nv = 32; } else if (n0 == 3424) { scol = 2176; nv = 24; } else { scol = 0; nv = 0; }
            tr_item((const float*)inptr(F, 3) + (size_t)l * D * NIN, D, NIN, scol, nv, (bf16*)(F.ws + WS_WIN) + ((size_t)l * NP + n0) * D, (const float*)inptr(F, 2) + l * D, scr, kb, F.lane); continue; }
        r -= I_IN;
        if (r < I_OUT) { const int nb = r >> 4, kb = r & 15;
            tr_item((const float*)inptr(F, 22) + (size_t)l * D * D, D, D, 32 * nb, 32, (bf16*)(F.ws + WS_WOUT) + ((size_t)l * D + 32 * nb) * D, nullptr, scr, kb, F.lane); continue; }
        r -= I_OUT;
        if (r < I_UQ) { const int nb = r / 3, kb = r % 3;
            tr_item((const float*)inptr(F, 9) + (size_t)l * 192 * 576, 192, 576, 32 * nb, 32, (bf16*)(F.ws + WS_WSMALL + OFF_WUQ) + ((size_t)l * 576 + 32 * nb) * 192, (const float*)inptr(F, 8) + l * 192, scr, kb, F.lane); continue; }
        r -= I_UQ;
        if (r < I_UKV) { const int nb = r >> 1, kb = r & 1;
            tr_item((const float*)inptr(F, 11) + (size_t)l * 128 * 768, 128, 768, 32 * nb, 32, (bf16*)(F.ws + WS_WSMALL + OFF_WUKV) + ((size_t)l * 768 + 32 * nb) * 128, (const float*)inptr(F, 10) + l * 128, scr, kb, F.lane); continue; }
        r -= I_UKV;
        if (r < I_W2) { const int e = r >> 3, nb = r & 7;
            tr_item((const float*)inptr(F, 14) + ((size_t)l * 2 + e) * 64 * 256, 64, 256, 32 * nb, 32, (bf16*)(F.ws + WS_WSMALL + OFF_W2T) + (((size_t)l * 2 + e) * 256 + 32 * nb) * 64, nullptr, scr, 0, F.lane); continue; }
        r -= I_W2;
        { const int e = r >> 3, nb = r & 7;
            tr_item((const float*)inptr(F, 16) + ((size_t)l * 2 + e) * 64 * 256, 64, 256, 32 * nb, 32, (bf16*)(F.ws + WS_WSMALL + OFF_A2T) + (((size_t)l * 2 + e) * 256 + 32 * nb) * 64, nullptr, scr, 0, F.lane); }
    }
    const float* x = (const float*)inptr(F, 0); bf16* xb = (bf16*)(F.ws + WS_XB); float* rowss = (float*)(F.ws + WS_ROWSS);
    for (int m = gw; m < M; m += NGW) {
        const GAS f32x4* xr = (const GAS f32x4*)(x + (size_t)m * D) + F.lane;
        GAS unsigned long long* o8 = (GAS unsigned long long*)(xb + (size_t)m * D) + F.lane; float s = 0.f;
#pragma unroll
        for (int j = 0; j < 4; ++j) { const f32x4 v = xr[64 * j]; s += (v.x * v.x + v.y * v.y) + (v.z * v.z + v.w * v.w);
            o8[64 * j] = (unsigned long long)pk2(v.x, v.y) | ((unsigned long long)pk2(v.z, v.w) << 32); }
        s = wave_sum(s);
        if (F.lane < 16) rowss[(size_t)m * 16 + F.lane] = F.lane == 0 ? s : 0.f;
    }
}
__device__ __forceinline__ void p5_final(Frame& F) {
    const int gw = F.vcu * NWAVES + F.wave, NGW = F.G * NWAVES;
    const float* rowss = (const float*)(F.ws + WS_ROWSS); const float* g = (const float*)inptr(F, 23);
    f32x4 gv[4];
#pragma unroll
    for (int j = 0; j < 4; ++j) gv[j] = ((const f32x4*)g)[F.lane + 64 * j];
    for (int m = gw; m < M; m += NGW) {
        float ss = F.lane < 16 ? rowss[(size_t)m * 16 + F.lane] : 0.f;
        ss = wave_sum(ss);
        const float rstd = rsqrtf(ss * (1.f / D) + NORM_EPS);
        GAS f32x4* xr = (GAS f32x4*)(F.out + (size_t)m * D) + F.lane;
#pragma unroll
        for (int j = 0; j < 4; ++j) { f32x4 v = xr[64 * j]; v = v * rstd * gv[j]; xr[64 * j] = v; }
    }
}
typedef float f32x16 __attribute__((ext_vector_type(16)));
typedef unsigned long long u64_t;
__device__ __forceinline__ bf16x8 mk_bf16x8(u64_t lo, u64_t hi) { typedef u64_t u64x2 __attribute__((ext_vector_type(2))); u64x2 v = {lo, hi}; return __builtin_bit_cast(bf16x8, v); }

constexpr int AT_KP = 208, AT_VP = 136, AT_KBYTES = 64 * AT_KP, AT_VBYTES = 64 * AT_VP, AT_BUF = AT_KBYTES + AT_VBYTES;
__device__ __forceinline__ float at_max3(float a, float b, float c) { float r; asm("v_max3_f32 %0, %1, %2, %3" : "=v"(r) : "v"(a), "v"(b), "v"(c)); return r; }
__device__ __forceinline__ void attn_unit(Frame& F, int unit) {
    const int bh = unit >> 3, qb = unit & 7, b = bh / 6, h = bh % 6;
    const int tid = F.tid, lane = F.lane, wave = F.wave, r32 = lane & 31, hi = lane >> 5;
    const bf16* Qg = (const bf16*)(F.ws + WS_Q) + ((size_t)bh * SEQ + qb * 256 + wave * 32 + r32) * 96;
    const bf16* Kg = (const bf16*)(F.ws + WS_K) + (size_t)bh * SEQ * 96;
    const bf16* Vg = (const bf16*)(F.ws + WS_VT) + (size_t)bh * 64 * SEQ;
    LAS unsigned char* lds = F.lds + RING_OFF;
    bf16x8 qf[6];
#pragma unroll
    for (int s = 0; s < 6; ++s) qf[s] = *(const bf16x8*)(Qg + 16 * s + 8 * hi);
    const int kr0 = tid / 12, kc0 = tid % 12, kr1 = (512 + tid) / 12, kc1 = (512 + tid) % 12, vd = tid >> 3, vc = tid & 7;
    const bool has1 = tid < 256;
    v4u ka0, ka1 = {0u, 0u, 0u, 0u}, va, kb0, kb1 = {0u, 0u, 0u, 0u}, vb;
#define AT_LOAD(K0, K1, V_, t0) do { K0 = *(const v4u*)(Kg + (size_t)((t0) + kr0) * 96 + kc0 * 8); if (has1) K1 = *(const v4u*)(Kg + (size_t)((t0) + kr1) * 96 + kc1 * 8); \
        V_ = *(const v4u*)(Vg + (size_t)vd * SEQ + (t0) + vc * 8); } while (0)
#define AT_STORE(K0, K1, V_, buf) do { LAS unsigned char* bb_ = lds + (buf) * AT_BUF; *(LAS v4u*)(bb_ + kr0 * AT_KP + kc0 * 16) = K0; if (has1) *(LAS v4u*)(bb_ + kr1 * AT_KP + kc1 * 16) = K1; \
        LAS u64_t* vp_ = (LAS u64_t*)(bb_ + AT_KBYTES + vd * AT_VP + vc * 16); vp_[0] = (u64_t)V_.x | ((u64_t)V_.y << 32); vp_[1] = (u64_t)V_.z | ((u64_t)V_.w << 32); } while (0)
    AT_LOAD(ka0, ka1, va, 0); AT_STORE(ka0, ka1, va, 0);
    AT_LOAD(ka0, ka1, va, 64);
    __syncthreads();
    f32x16 o0 = {}, o1 = {};
    float mrun = -1e30f, lsum = 0.f;
    constexpr int NT = SEQ / 64;
    auto tile = [&](int t) {
        LAS unsigned char* bb = lds + (t % 3) * AT_BUF;
        f32x16 p0 = {}, p1 = {};
        { const LAS unsigned char* kb = bb + r32 * AT_KP + hi * 16;
#pragma unroll
          for (int s = 0; s < 6; ++s) {
              const bf16x8 a0 = *(const LAS bf16x8*)(kb + 32 * s), a1 = *(const LAS bf16x8*)(kb + 32 * AT_KP + 32 * s);
              p0 = __builtin_amdgcn_mfma_f32_32x32x16_bf16(a0, qf[s], p0, 0, 0, 0);
              p1 = __builtin_amdgcn_mfma_f32_32x32x16_bf16(a1, qf[s], p1, 0, 0, 0); } }
        float ma = at_max3(p0[0], p0[1], p1[0]), mb = at_max3(p0[2], p0[3], p1[1]); ma = at_max3(ma, p1[2], p1[3]);
#pragma unroll
        for (int r = 4; r < 16; r += 4) { ma = at_max3(ma, p0[r], p0[r + 1]); mb = at_max3(mb, p0[r + 2], p0[r + 3]); ma = at_max3(ma, p1[r], p1[r + 1]); mb = at_max3(mb, p1[r + 2], p1[r + 3]); }
        float mloc = at_max3(ma, mb, mrun);
        { const auto rr = __builtin_amdgcn_permlane32_swap(__float_as_uint(mloc), __float_as_uint(mloc), false, false); mloc = at_max3(__uint_as_float(rr[0]), __uint_as_float(rr[1]), mloc); }
        const float mnew = mloc, alpha = __builtin_amdgcn_exp2f(mrun - mnew);
        mrun = mnew; lsum *= alpha;
#pragma unroll
        for (int r = 0; r < 16; ++r) { o0[r] *= alpha; o1[r] *= alpha; }
        float ps = 0.f;
#pragma unroll
        for (int r = 0; r < 16; ++r) { p0[r] = __builtin_amdgcn_exp2f(p0[r] - mnew); p1[r] = __builtin_amdgcn_exp2f(p1[r] - mnew); ps += p0[r] + p1[r]; }
        lsum += ps;
        v4u pk[4];
#pragma unroll
        for (int s2 = 0; s2 < 2; ++s2) {
            pk[s2] = (v4u){pg8::cvt_pk_bf16(p0[8 * s2], p0[8 * s2 + 1]), pg8::cvt_pk_bf16(p0[8 * s2 + 2], p0[8 * s2 + 3]), pg8::cvt_pk_bf16(p0[8 * s2 + 4], p0[8 * s2 + 5]), pg8::cvt_pk_bf16(p0[8 * s2 + 6], p0[8 * s2 + 7])};
            pk[2 + s2] = (v4u){pg8::cvt_pk_bf16(p1[8 * s2], p1[8 * s2 + 1]), pg8::cvt_pk_bf16(p1[8 * s2 + 2], p1[8 * s2 + 3]), pg8::cvt_pk_bf16(p1[8 * s2 + 4], p1[8 * s2 + 5]), pg8::cvt_pk_bf16(p1[8 * s2 + 6], p1[8 * s2 + 7])};
        }
        { const LAS unsigned char* vb_ = bb + AT_KBYTES + r32 * AT_VP + hi * 8;
#pragma unroll
          for (int ks = 0; ks < 4; ++ks) {
              const bf16x8 pb = __builtin_bit_cast(bf16x8, pk[ks]);
              const bf16x8 v0 = mk_bf16x8(*(const LAS u64_t*)(vb_ + ks * 32), *(const LAS u64_t*)(vb_ + ks * 32 + 16));
              const bf16x8 v1 = mk_bf16x8(*(const LAS u64_t*)(vb_ + 32 * AT_VP + ks * 32), *(const LAS u64_t*)(vb_ + 32 * AT_VP + ks * 32 + 16));
              o0 = __builtin_amdgcn_mfma_f32_32x32x16_bf16(v0, pb, o0, 0, 0, 0);
              o1 = __builtin_amdgcn_mfma_f32_32x32x16_bf16(v1, pb, o1, 0, 0, 0); } }
    };
    for (int t = 0; t < NT; t += 2) {
        if (t + 2 < NT) AT_LOAD(kb0, kb1, vb, (t + 2) * 64);
        tile(t);
        AT_STORE(ka0, ka1, va, (t + 1) % 3);
        __syncthreads();
        if (t + 3 < NT) AT_LOAD(ka0, ka1, va, (t + 3) * 64);
        tile(t + 1);
        if (t + 2 < NT) AT_STORE(kb0, kb1, vb, (t + 2) % 3);
        __syncthreads();
    }
#undef AT_LOAD
#undef AT_STORE
    lsum += __shfl_xor(lsum, 32);
    const float inv = 1.f / lsum;
    bf16* Og = (bf16*)(F.ws + WS_OMLA) + ((size_t)b * SEQ + qb * 256 + wave * 32 + r32) * 384 + h * 64 + 4 * hi;
#pragma unroll
    for (int rg = 0; rg < 4; ++rg) {
        *(u64_t*)(Og + 8 * rg) = (u64_t)pg8::cvt_pk_bf16(o0[4 * rg] * inv, o0[4 * rg + 1] * inv) | ((u64_t)pg8::cvt_pk_bf16(o0[4 * rg + 2] * inv, o0[4 * rg + 3] * inv) << 32);
        *(u64_t*)(Og + 32 + 8 * rg) = (u64_t)pg8::cvt_pk_bf16(o1[4 * rg] * inv, o1[4 * rg + 1] * inv) | ((u64_t)pg8::cvt_pk_bf16(o1[4 * rg + 2] * inv, o1[4 * rg + 3] * inv) << 32);
    }
}

constexpr int CW_FLAG = 32768;
__device__ __forceinline__ void partner_sync(Frame& F, gu32* mine, gu32* theirs) {
    asm volatile("s_waitcnt vmcnt(0)" ::: "memory");
    __syncthreads();
    if (F.tid == 0) {
        __builtin_amdgcn_fence(__ATOMIC_RELEASE, "agent");
        asm volatile("s_waitcnt vmcnt(0)" ::: "memory");
        __hip_atomic_store(mine, 1u, RLX_AGENT);
        unsigned spins = 0;
        while (__hip_atomic_load(theirs, RLX_AGENT) == 0u) { __builtin_amdgcn_s_sleep(4); if (++spins > (1u << 22)) break; }
        __builtin_amdgcn_fence(__ATOMIC_ACQUIRE, "agent");
        asm volatile("s_waitcnt vmcnt(0)" ::: "memory");
    }
    __syncthreads();
}
constexpr int RW_STEP = 1440, RW_CH = 32, RW_BUF = RW_CH * RW_STEP;
constexpr int RW_Y = 2 * RW_BUF;
static_assert(RW_Y + 2 * 4096 <= RING_BYTES, "RWKV LDS map");
__device__ __forceinline__ float dpp_xor1(float x) { return __builtin_bit_cast(float, __builtin_amdgcn_update_dpp(0, __builtin_bit_cast(int, x), 0xB1, 0xF, 0xF, true)); }
__device__ __forceinline__ float dpp_xor2(float x) { return __builtin_bit_cast(float, __builtin_amdgcn_update_dpp(0, __builtin_bit_cast(int, x), 0x4E, 0xF, 0xF, true)); }
__device__ __forceinline__ float dpp_hmir(float x) { return __builtin_bit_cast(float, __builtin_amdgcn_update_dpp(0, __builtin_bit_cast(int, x), 0x141, 0xF, 0xF, true)); }
__device__ __forceinline__ float dpp_rmir(float x) { return __builtin_bit_cast(float, __builtin_amdgcn_update_dpp(0, __builtin_bit_cast(int, x), 0x140, 0xF, 0xF, true)); }
template <int SKIP> __device__ __forceinline__ void rwkv_unit(Frame& F, int unit, gu32* flags) {
    const int bh = unit >> 2, rowhalf = (unit >> 1) & 1, dir = unit & 1, b = bh >> 2, h = bh & 3;
    const int tid = F.tid, lane = F.lane, ri = lane >> 4, cs = lane & 15, row = 4 * F.wave + ri;
    const bool stager = true;
    const unsigned char* Rs = F.ws + WS_RS + (size_t)bh * SEQ * RS_REC;
    const unsigned char* Rd = F.ws + WS_RD + dir * RD_DIR + (size_t)bh * SEQ * RD_REC;
    LAS unsigned char* lds = F.lds + RING_OFF;
    const int ss = tid >> 4, sp = tid & 15;
    u64_t g_kk = 0, g_r = 0, g_lam = 0, g_b = 0, g_k = 0, g_v = 0, g_s = 0;
#define RW_ISSUE(c_) do { const int n_ = (c_) * RW_CH + ss, t_ = dir ? SEQ - 1 - n_ : n_; const unsigned char* rs_ = Rs + (size_t)t_ * RS_REC; const unsigned char* rd_ = Rd + (size_t)t_ * RD_REC; \
        g_kk = *(const u64_t*)(rs_ + 8 * sp); g_r = *(const u64_t*)(rs_ + 256 + 8 * sp); g_lam = *(const u64_t*)(rd_ + 8 * sp); g_b = *(const u64_t*)(rd_ + 128 + 8 * sp); g_k = *(const u64_t*)(rd_ + 256 + 8 * sp); \
        if (sp < 8) g_v = *(const u64_t*)(rs_ + 128 + 64 * rowhalf + 8 * sp); if (sp == 8) g_s = *(const u64_t*)(rd_ + 384); } while (0)
#define RW_BF(x, j) __uint_as_float(((unsigned)((x) >> (16 * (j)))) << 16)
#define RW_STAGE(buf_) do { LAS unsigned char* d_ = lds + (buf_) * RW_BUF + ss * RW_STEP + 16 * sp; f32x4 w_, t4_; \
        w_[0] = __builtin_amdgcn_exp2f(-LOG2E * __half2float(__ushort_as_half((unsigned short)(g_lam)))); w_[1] = __builtin_amdgcn_exp2f(-LOG2E * __half2float(__ushort_as_half((unsigned short)(g_lam >> 16)))); \
        w_[2] = __builtin_amdgcn_exp2f(-LOG2E * __half2float(__ushort_as_half((unsigned short)(g_lam >> 32)))); w_[3] = __builtin_amdgcn_exp2f(-LOG2E * __half2float(__ushort_as_half((unsigned short)(g_lam >> 48)))); \
        *(LAS f32x4*)d_ = w_; \
        t4_ = (f32x4){RW_BF(g_r, 0), RW_BF(g_r, 1), RW_BF(g_r, 2), RW_BF(g_r, 3)}; *(LAS f32x4*)(d_ + 256) = w_ * t4_; \
        t4_ = (f32x4){RW_BF(g_kk, 0), RW_BF(g_kk, 1), RW_BF(g_kk, 2), RW_BF(g_kk, 3)}; *(LAS f32x4*)(d_ + 512) = -t4_; \
        t4_ = (f32x4){RW_BF(g_b, 0), RW_BF(g_b, 1), RW_BF(g_b, 2), RW_BF(g_b, 3)}; *(LAS f32x4*)(d_ + 768) = t4_; \
        t4_ = (f32x4){RW_BF(g_k, 0), RW_BF(g_k, 1), RW_BF(g_k, 2), RW_BF(g_k, 3)}; *(LAS f32x4*)(d_ + 1024) = t4_; \
        if (sp < 8) { t4_ = (f32x4){RW_BF(g_v, 0), RW_BF(g_v, 1), RW_BF(g_v, 2), RW_BF(g_v, 3)}; *(LAS f32x4*)(d_ + 1280) = t4_; } \
        if (sp == 8) *(LAS u64_t*)(lds + (buf_) * RW_BUF + ss * RW_STEP + 1408) = g_s; } while (0)
    f32x4 S0 = {0.f, 0.f, 0.f, 0.f};
    if (stager) { RW_ISSUE(0); RW_STAGE(0); }
    __syncthreads();
    bf16* Yg = (bf16*)(F.ws + WS_Y) + (size_t)b * SEQ * 256 + h * 64 + 32 * rowhalf;
    const int NCH = SEQ / RW_CH;
    for (int c = 0; c < NCH; ++c) {
        LAS float* ybuf = (LAS float*)(lds + RW_Y + (c & 1) * 4096);
        if (stager && c + 1 < NCH) RW_ISSUE(c + 1);
        unsigned short yold[2] = {0, 0};
        if (c >= NCH / 2) {
#pragma unroll
            for (int k = 0; k < 2; ++k) { const int o = tid + 512 * k, n = c * RW_CH + (o >> 5), t = dir ? SEQ - 1 - n : n; yold[k] = Yg[(size_t)t * 256 + (o & 31)]; } }
        { const LAS unsigned char* cb_ = lds + (c & 1) * RW_BUF + 16 * cs;
          const LAS unsigned char* vb_ = lds + (c & 1) * RW_BUF + 1280 + 4 * row;
#pragma unroll 4
          for (int s = 0; s < RW_CH; ++s) {
              const LAS unsigned char* p = cb_ + ((SKIP & 2) ? 0 : s) * RW_STEP;
              const f32x4 w = *(const LAS f32x4*)p, wr = *(const LAS f32x4*)(p + 256), nk = *(const LAS f32x4*)(p + 512), bb = *(const LAS f32x4*)(p + 768), kv = *(const LAS f32x4*)(p + 1024);
              typedef float f2 __attribute__((ext_vector_type(2)));
              const float v = *(const LAS float*)(vb_ + s * RW_STEP); const f2 brkr = *(const LAS f2*)(lds + (c & 1) * RW_BUF + s * RW_STEP + 1408);
              float sa0 = (S0[0] * nk[0] + S0[1] * nk[1]) + (S0[2] * nk[2] + S0[3] * nk[3]);
              float ym0 = (S0[0] * wr[0] + S0[1] * wr[1]) + (S0[2] * wr[2] + S0[3] * wr[3]);
              if (!(SKIP & 1)) {
              sa0 += dpp_xor1(sa0); ym0 += dpp_xor1(ym0);
              sa0 += dpp_xor2(sa0); ym0 += dpp_xor2(ym0);
              sa0 += dpp_hmir(sa0); ym0 += dpp_hmir(ym0);
              sa0 += dpp_rmir(sa0); ym0 += dpp_rmir(ym0); }
              S0 = S0 * w + (sa0 * bb + v * kv);
              if (cs == 0) ybuf[s * 32 + row] = ym0 + sa0 * brkr[0] + v * brkr[1];
          } }
        if (stager && c + 1 < NCH) RW_STAGE((c + 1) & 1);
        __syncthreads();
#pragma unroll
        for (int k = 0; k < 2; ++k) { const int o = tid + 512 * k, n = c * RW_CH + (o >> 5), t = dir ? SEQ - 1 - n : n;
            float y = ybuf[o]; if (c >= NCH / 2) y += bf2f(yold[k]);
            Yg[(size_t)t * 256 + (o & 31)] = (bf16)f2bf(y); }
        if (c == NCH / 2 - 1) partner_sync(F, flags + 64 * unit, flags + 64 * (unit ^ 1));
    }
#undef RW_ISSUE
#undef RW_STAGE
#undef RW_BF
    __syncthreads();
}

constexpr int GP = 144;
constexpr int G_Q = 0, G_K = 9216, G_V = 18432, G_KT = 27648, G_P = 36864, G_A = 46080, G_SM = 63488, G_GROUP = 64512;
constexpr int G_T = 92160;
constexpr int G_RAW = 65536;
constexpr int G_CW = 133120;
static_assert(2 * G_GROUP <= RING_BYTES && G_CW + 3840 <= LDS_BYTES && G_CW >= MISC_OFF + 1024, "GDN LDS map");
__device__ __forceinline__ bf16x8 ld2x8(const LAS unsigned char* p) { return mk_bf16x8(*(const LAS u64_t*)p, *(const LAS u64_t*)(p + 32)); }
__device__ __forceinline__ bf16x8 pack_acc(const f32x4& a, const f32x4& b) {
    v4u w; w.x = pg8::cvt_pk_bf16(a[0], a[1]); w.y = pg8::cvt_pk_bf16(a[2], a[3]); w.z = pg8::cvt_pk_bf16(b[0], b[1]); w.w = pg8::cvt_pk_bf16(b[2], b[3]); return __builtin_bit_cast(bf16x8, w); }
__device__ __forceinline__ void split_acc(const f32x4& a, const f32x4& b, bf16x8& hi, bf16x8& lo) {
    v4u wh; wh.x = pg8::cvt_pk_bf16(a[0], a[1]); wh.y = pg8::cvt_pk_bf16(a[2], a[3]); wh.z = pg8::cvt_pk_bf16(b[0], b[1]); wh.w = pg8::cvt_pk_bf16(b[2], b[3]);
    f32x4 ra, rb;
    ra[0] = a[0] - __uint_as_float(wh.x << 16); ra[1] = a[1] - __uint_as_float(wh.x & 0xffff0000u); ra[2] = a[2] - __uint_as_float(wh.y << 16); ra[3] = a[3] - __uint_as_float(wh.y & 0xffff0000u);
    rb[0] = b[0] - __uint_as_float(wh.z << 16); rb[1] = b[1] - __uint_as_float(wh.z & 0xffff0000u); rb[2] = b[2] - __uint_as_float(wh.w << 16); rb[3] = b[3] - __uint_as_float(wh.w & 0xffff0000u);
    hi = __builtin_bit_cast(bf16x8, wh); lo = pack_acc(ra, rb);
}
__device__ __forceinline__ void hilo4(const f32x4& a, u64_t& hi, u64_t& lo) {
    const unsigned h0 = pg8::cvt_pk_bf16(a[0], a[1]), h1 = pg8::cvt_pk_bf16(a[2], a[3]);
    const float r0 = a[0] - __uint_as_float(h0 << 16), r1 = a[1] - __uint_as_float(h0 & 0xffff0000u), r2 = a[2] - __uint_as_float(h1 << 16), r3 = a[3] - __uint_as_float(h1 & 0xffff0000u);
    hi = (u64_t)h0 | ((u64_t)h1 << 32); lo = (u64_t)pg8::cvt_pk_bf16(r0, r1) | ((u64_t)pg8::cvt_pk_bf16(r2, r3) << 32);
}
typedef _Float16 f16x8 __attribute__((ext_vector_type(8)));
__device__ __forceinline__ f16x8 pack_acc_f16(const f32x4& a, const f32x4& b) { return (f16x8){(_Float16)a[0], (_Float16)a[1], (_Float16)a[2], (_Float16)a[3], (_Float16)b[0], (_Float16)b[1], (_Float16)b[2], (_Float16)b[3]}; }
template <int SKIP> __device__ __forceinline__ void gdn_unit3(Frame& F, int l, int unit, gu32* flags) {
    const int bh = unit >> 1, dir = unit & 1, b = bh / 6, h = bh % 6;
    const int tid = F.tid, lane = F.lane, wave = F.wave;
    const bf16* Pgdn = (const bf16*)(F.ws + WS_PGDN) + (size_t)b * SEQ * 1152 + h * 64; const float* Psm = (const float*)(F.ws + WS_PSM) + (size_t)b * SEQ * 32;
    bf16* Og = (bf16*)(F.ws + WS_OGDN) + (size_t)b * SEQ * 384 + h * 64;
    LAS unsigned char* gb = F.lds + RING_OFF;
    LAS float* cwl = (LAS float*)(F.lds + G_CW);
    LAS float* sm = (LAS float*)(gb + G_SM);
    { const float* conv_w = (const float*)inptr(F, 4) + (size_t)l * 5 * 1152;
      for (int i = tid; i < 960; i += 512) { const int tn = i / 320, tap = (i % 320) / 64, ch = i % 64; cwl[i] = conv_w[tap * 1152 + tn * 384 + h * 64 + ch]; } }
    const float al = -__expf(((const float*)inptr(F, 5))[l * 12 + dir * 6 + h]), dtb = ((const float*)inptr(F, 6))[l * 12 + dir * 6 + h];
    f32x4 Sacc[4];
#pragma unroll
    for (int i = 0; i < 4; ++i) Sacc[i] = (f32x4){0.f, 0.f, 0.f, 0.f};
    const int ci = tid >> 3, cg = tid & 7;
#define GDN_RAW_STAGE(cc_, first_, nthr_) do { const int tlo_ = (dir ? SEQ - 64 * (cc_) - 64 : 64 * (cc_)) - 2; \
        for (int pc_ = (first_); pc_ < 68 * 24; pc_ += (nthr_)) { const int rr_ = pc_ / 24, sg_ = pc_ % 24, tt_ = tlo_ + rr_; v4u x_ = {0u, 0u, 0u, 0u}; \
            if (!(SKIP & 1) && tt_ >= 0 && tt_ < SEQ) x_ = *(const v4u*)(Pgdn + (size_t)tt_ * 1152 + (sg_ >> 3) * 384 + 8 * (sg_ & 7)); \
            *(LAS v4u*)(gb + G_RAW + rr_ * 384 + 16 * sg_) = x_; } } while (0)
#define GDN_WRITEOUT(cc_) do { if (!(SKIP & 4)) { const int t_ = dir ? SEQ - 1 - 64 * (cc_) - ci : 64 * (cc_) + ci; bf16* op_ = Og + (size_t)t_ * 384 + 8 * cg; \
            const LAS f32x4* src_ = (const LAS f32x4*)(gb + G_A + (ci * 68 + 8 * cg) * 4); f32x4 o0_ = src_[0], o1_ = src_[1]; \
            if ((cc_) >= SEQ / 128) { const v4u p0_ = *(const v4u*)op_; \
                o0_ += (f32x4){__uint_as_float(p0_.x << 16), __uint_as_float(p0_.x & 0xffff0000u), __uint_as_float(p0_.y << 16), __uint_as_float(p0_.y & 0xffff0000u)}; \
                o1_ += (f32x4){__uint_as_float(p0_.z << 16), __uint_as_float(p0_.z & 0xffff0000u), __uint_as_float(p0_.w << 16), __uint_as_float(p0_.w & 0xffff0000u)}; } \
            v4u w0_; w0_.x = pg8::cvt_pk_bf16(o0_[0], o0_[1]); w0_.y = pg8::cvt_pk_bf16(o0_[2], o0_[3]); w0_.z = pg8::cvt_pk_bf16(o1_[0], o1_[1]); w0_.w = pg8::cvt_pk_bf16(o1_[2], o1_[3]); \
            *(v4u*)op_ = w0_; } } while (0)
    GDN_RAW_STAGE(0, tid, 512);
    __syncthreads();
    for (int c = 0; c < SEQ / 64; ++c) {
        if (c > 0) GDN_WRITEOUT(c - 1);
        if (c == SEQ / 128) partner_sync(F, flags + 64 * unit, flags + 64 * (unit ^ 1));
        if (wave == 0) {
            const int t = dir ? SEQ - 1 - 64 * c - lane : 64 * c + lane;
            const float a = Psm[(size_t)t * 32 + dir * 6 + h], bt = Psm[(size_t)t * 32 + 12 + dir * 6 + h];
            float x = al * softplusf_(a + dtb);
#pragma unroll
            for (int off = 1; off < 64; off <<= 1) { const float y = __shfl_up(x, off); if (lane >= off) x += y; }
            const float last = __shfl(x, 63);
            sm[lane] = x; sm[64 + lane] = sigmoidf_(bt); sm[128 + lane] = __expf(x); sm[192 + lane] = __expf(last - x);
        }
        { float acc[3][8];
#pragma unroll
          for (int tn = 0; tn < 3; ++tn)
#pragma unroll
              for (int j = 0; j < 8; ++j) acc[tn][j] = 0.f;
          const int rr0 = dir ? 63 - ci : ci;
#pragma unroll
          for (int tap = 0; tap < 5; ++tap) {
#pragma unroll
              for (int tn = 0; tn < 3; ++tn) { const v4u x0 = *(const LAS v4u*)(gb + G_RAW + (rr0 + tap) * 384 + tn * 128 + 16 * cg); const LAS float* w = cwl + tn * 320 + tap * 64 + 8 * cg; const f32x4 w0 = *(const LAS f32x4*)w, w1 = *(const LAS f32x4*)(w + 4);
                  acc[tn][0] += w0[0] * __uint_as_float(x0[0] << 16); acc[tn][1] += w0[1] * __uint_as_float(x0[0] & 0xffff0000u); acc[tn][2] += w0[2] * __uint_as_float(x0[1] << 16); acc[tn][3] += w0[3] * __uint_as_float(x0[1] & 0xffff0000u);
                  acc[tn][4] += w1[0] * __uint_as_float(x0[2] << 16); acc[tn][5] += w1[1] * __uint_as_float(x0[2] & 0xffff0000u); acc[tn][6] += w1[2] * __uint_as_float(x0[3] << 16); acc[tn][7] += w1[3] * __uint_as_float(x0[3] & 0xffff0000u); }
              asm volatile("" ::: "memory"); }
          float sq = 0.f, sk = 0.f;
#pragma unroll
          for (int j = 0; j < 8; ++j) { acc[0][j] = siluf(acc[0][j]); acc[1][j] = siluf(acc[1][j]); acc[2][j] = siluf(acc[2][j]); sq += acc[0][j] * acc[0][j]; sk += acc[1][j] * acc[1][j]; }
          sq += dpp_xor1(sq); sk += dpp_xor1(sk); sq += dpp_xor2(sq); sk += dpp_xor2(sk); sq += dpp_hmir(sq); sk += dpp_hmir(sk);
          const float rq = rsqrtf(sq + 1e-6f) * 0.125f, rk = rsqrtf(sk + 1e-6f);
          v4u wq, wk, wv;
#pragma unroll
          for (int q = 0; q < 4; ++q) { wq[q] = pg8::cvt_pk_bf16(acc[0][2 * q] * rq, acc[0][2 * q + 1] * rq); wk[q] = pg8::cvt_pk_bf16(acc[1][2 * q] * rk, acc[1][2 * q + 1] * rk); wv[q] = pg8::cvt_pk_bf16(acc[2][2 * q], acc[2][2 * q + 1]); }
          LAS unsigned char* row = gb + ci * GP + 16 * cg;
          *(LAS v4u*)(row + G_Q) = wq; *(LAS v4u*)(row + G_K) = wk; *(LAS v4u*)(row + G_V) = wv;
#pragma unroll
          for (int j = 0; j < 8; ++j) *(LAS bf16*)(gb + G_KT + (8 * cg + j) * GP + 2 * ci) = (bf16)((j & 1) ? (wk[j >> 1] >> 16) : (wk[j >> 1] & 0xffffu)); }
        __syncthreads();
        { const int ti = (wave >> 1) & 1, tj = wave & 1, r32 = lane & 31, hi = lane >> 5; const bool isP = wave >= 4;
          f32x16 acc = {};
          const LAS unsigned char* ar = gb + (isP ? G_Q : G_K) + (32 * ti + r32) * GP + 16 * hi; const LAS unsigned char* br = gb + G_K + (32 * tj + r32) * GP + 16 * hi;
#pragma unroll
          for (int s = 0; s < 4; ++s) acc = __builtin_amdgcn_mfma_f32_32x32x16_bf16(*(const LAS bf16x8*)(ar + 32 * s), *(const LAS bf16x8*)(br + 32 * s), acc, 0, 0, 0);
          const int j = 32 * tj + r32; const float cj = sm[j];
#pragma unroll
          for (int r = 0; r < 16; ++r) { const int i = 32 * ti + (r & 3) + 8 * (r >> 2) + 4 * hi;
              const float dl = __expf(fminf(sm[i] - cj, 0.f));
              if (!isP) ((LAS float*)(gb + G_A))[i * 68 + j] = (i > j) ? sm[64 + i] * acc[r] * dl : 0.f;
              else *(LAS _Float16*)(gb + G_P + i * GP + 2 * j) = (_Float16)((i >= j) ? acc[r] * dl : 0.f); } }
        __syncthreads();
        if (!(SKIP & 2) && wave == 0) {
            const int bb = lane >> 4, cc = lane & 15; float T[16];
            const LAS float* Ab = (const LAS float*)(gb + G_A) + (16 * bb) * 68 + 16 * bb;
#pragma unroll
            for (int i = 0; i < 16; ++i) { float a0 = 0.f, a1 = 0.f;
#pragma unroll
                for (int j4 = 0; j4 < (i + 3) / 4; ++j4) { const f32x4 av = *(const LAS f32x4*)(Ab + i * 68 + 4 * j4);
                    a0 += av.x * T[4 * j4] + av.z * T[4 * j4 + 2]; a1 += av.y * T[4 * j4 + 1] + av.w * T[4 * j4 + 3]; }
                T[i] = (i == cc ? 1.f : 0.f) - (a0 + a1);
                if (i < 15 && (i & 3) == 3) asm volatile("" ::: "memory");
                if (i == 0) {
#pragma unroll
                    for (int k = 1; k < 16; ++k) T[k] = 0.f; } }
#pragma unroll
            for (int i = 0; i < 16; ++i) ((LAS float*)(gb + G_T))[(16 * bb + i) * 16 + cc] = T[i];
        }
        __syncthreads();
        f32x4 Xc[4];
#pragma unroll
        for (int g = 0; g < 4; ++g) Xc[g] = (f32x4){0.f, 0.f, 0.f, 0.f};
        if (!(SKIP & 2)) {
            const int col = lane & 15, q4 = lane >> 4, c = 16 * wave + col;
            const LAS unsigned char* src = gb + (c < 64 ? G_V : G_K) + 2 * (c & 63);
            u64_t xh[4], xl[4];
#pragma unroll
            for (int bk = 0; bk < 4; ++bk) {
                f32x4 Y; const f32x4 be = *(const LAS f32x4*)(sm + 64 + 16 * bk + 4 * q4), ga = *(const LAS f32x4*)(sm + 128 + 16 * bk + 4 * q4);
#pragma unroll
                for (int r = 0; r < 4; ++r) Y[r] = bf2f(*(const LAS bf16*)(src + (16 * bk + 4 * q4 + r) * GP)) * be[r] * (c < 64 ? 1.f : ga[r]);
#pragma unroll
                for (int b2 = 0; b2 < bk; b2 += 2) {
                    const LAS float* ar = (const LAS float*)(gb + G_A) + (16 * bk + col) * 68 + 16 * b2 + 4 * q4;
                    f32x4 a0 = -*(const LAS f32x4*)ar, a1 = (b2 + 1 < bk) ? -*(const LAS f32x4*)(ar + 16) : (f32x4){0.f, 0.f, 0.f, 0.f};
                    u64_t ah0, al0, ah1, al1; hilo4(a0, ah0, al0); hilo4(a1, ah1, al1);
                    const u64_t bh1 = (b2 + 1 < bk) ? xh[b2 + 1] : 0ull, bl1 = (b2 + 1 < bk) ? xl[b2 + 1] : 0ull;
                    const bf16x8 Ah = mk_bf16x8(ah0, ah1), Al = mk_bf16x8(al0, al1), Bh = mk_bf16x8(xh[b2], bh1), Bl = mk_bf16x8(xl[b2], bl1);
                    Y = __builtin_amdgcn_mfma_f32_16x16x32_bf16(Al, Bh, Y, 0, 0, 0);
                    Y = __builtin_amdgcn_mfma_f32_16x16x32_bf16(Ah, Bl, Y, 0, 0, 0);
                    Y = __builtin_amdgcn_mfma_f32_16x16x32_bf16(Ah, Bh, Y, 0, 0, 0); }
                { const f32x4 t0 = *(const LAS f32x4*)((const LAS float*)(gb + G_T) + (16 * bk + col) * 16 + 4 * q4);
                  u64_t th, tl, yh, yl; hilo4(t0, th, tl); hilo4(Y, yh, yl);
                  const bf16x8 Ah = mk_bf16x8(th, 0ull), Al = mk_bf16x8(tl, 0ull), Bh = mk_bf16x8(yh, 0ull), Bl = mk_bf16x8(yl, 0ull);
                  f32x4 X = {0.f, 0.f, 0.f, 0.f};
                  X = __builtin_amdgcn_mfma_f32_16x16x32_bf16(Al, Bh, X, 0, 0, 0);
                  X = __builtin_amdgcn_mfma_f32_16x16x32_bf16(Ah, Bl, X, 0, 0, 0);
                  X = __builtin_amdgcn_mfma_f32_16x16x32_bf16(Ah, Bh, X, 0, 0, 0);
                  Xc[bk] = X; hilo4(X, xh[bk], xl[bk]); }
            }
        }
        __syncthreads();
        { const int col = lane & 15, q4 = lane >> 4, c = 16 * wave + col;
          if (wave < 4) {
#pragma unroll
              for (int g = 0; g < 4; ++g)
#pragma unroll
                  for (int r = 0; r < 4; ++r) ((LAS float*)(gb + G_A))[(16 * g + 4 * q4 + r) * 68 + c] = Xc[g][r];
          } else {
#pragma unroll
              for (int g = 0; g < 4; ++g)
#pragma unroll
                  for (int r = 0; r < 4; ++r) { const int i = 16 * g + 4 * q4 + r; const float x = -Xc[g][r]; const unsigned hb = f2bf(x);
                      *(LAS bf16*)(gb + G_V + i * GP + 2 * (c - 64)) = (bf16)hb;
                      *(LAS bf16*)(gb + G_K + i * GP + 2 * (c - 64)) = (bf16)f2bf(x - __uint_as_float(hb << 16)); }
          } }
        __syncthreads();
        if (wave < 4) { const int col = lane & 15, q4 = lane >> 4, e = 16 * wave + col;
          bf16x8 bS0, bS1, bS0l, bS1l; split_acc(Sacc[0], Sacc[1], bS0, bS0l); split_acc(Sacc[2], Sacc[3], bS1, bS1l);
          f32x4 U[4], T1[4];
          const LAS unsigned char* rowa = gb + col * GP + 8 * q4;
#pragma unroll
          for (int it = 0; it < 4; ++it) {
              const LAS float* u0p = (const LAS float*)(gb + G_A) + (16 * it + 4 * q4) * 68 + e;
              U[it] = (f32x4){u0p[0], u0p[68], u0p[136], u0p[204]};
              const LAS unsigned char* ra = rowa + 16 * it * GP;
              const bf16x8 wh0 = ld2x8(ra + G_V), wh1 = ld2x8(ra + G_V + 64), wl0 = ld2x8(ra + G_K), wl1 = ld2x8(ra + G_K + 64), qa0 = ld2x8(ra + G_Q), qa1 = ld2x8(ra + G_Q + 64);
              U[it] = __builtin_amdgcn_mfma_f32_16x16x32_bf16(wl0, bS0, U[it], 0, 0, 0);
              U[it] = __builtin_amdgcn_mfma_f32_16x16x32_bf16(wl1, bS1, U[it], 0, 0, 0);
              U[it] = __builtin_amdgcn_mfma_f32_16x16x32_bf16(wh0, bS0l, U[it], 0, 0, 0);
              U[it] = __builtin_amdgcn_mfma_f32_16x16x32_bf16(wh1, bS1l, U[it], 0, 0, 0);
              U[it] = __builtin_amdgcn_mfma_f32_16x16x32_bf16(wh0, bS0, U[it], 0, 0, 0);
              U[it] = __builtin_amdgcn_mfma_f32_16x16x32_bf16(wh1, bS1, U[it], 0, 0, 0);
              T1[it] = __builtin_amdgcn_mfma_f32_16x16x32_bf16(qa0, bS0l, (f32x4){0.f, 0.f, 0.f, 0.f}, 0, 0, 0);
              T1[it] = __builtin_amdgcn_mfma_f32_16x16x32_bf16(qa1, bS1l, T1[it], 0, 0, 0);
              T1[it] = __builtin_amdgcn_mfma_f32_16x16x32_bf16(qa0, bS0, T1[it], 0, 0, 0);
              T1[it] = __builtin_amdgcn_mfma_f32_16x16x32_bf16(qa1, bS1, T1[it], 0, 0, 0);
              asm volatile("" ::: "memory");
          }
          const f16x8 hU0 = pack_acc_f16(U[0], U[1]), hU1 = pack_acc_f16(U[2], U[3]);
          f32x4 Ud[4];
#pragma unroll
          for (int it = 0; it < 4; ++it) { const f32x4 dc = *(const LAS f32x4*)(sm + 192 + 16 * it + 4 * q4); Ud[it] = U[it] * dc; }
          bf16x8 bD0, bD1, bD0l, bD1l; split_acc(Ud[0], Ud[1], bD0, bD0l); split_acc(Ud[2], Ud[3], bD1, bD1l);
          const float gend = sm[191];
#pragma unroll
          for (int it = 0; it < 4; ++it) {
              const LAS unsigned char* ra = rowa + 16 * it * GP;
              const f32x4 gm = *(const LAS f32x4*)(sm + 128 + 16 * it + 4 * q4);
              const bf16x8 pa0 = ld2x8(ra + G_P), pa1 = ld2x8(ra + G_P + 64), ka0 = ld2x8(ra + G_KT), ka1 = ld2x8(ra + G_KT + 64);
              f32x4 O = T1[it] * gm;
              O = __builtin_amdgcn_mfma_f32_16x16x32_f16(__builtin_bit_cast(f16x8, pa0), hU0, O, 0, 0, 0);
              O = __builtin_amdgcn_mfma_f32_16x16x32_f16(__builtin_bit_cast(f16x8, pa1), hU1, O, 0, 0, 0);
              f32x4 Sn = Sacc[it] * gend;
              Sn = __builtin_amdgcn_mfma_f32_16x16x32_bf16(ka0, bD0l, Sn, 0, 0, 0);
              Sn = __builtin_amdgcn_mfma_f32_16x16x32_bf16(ka1, bD1l, Sn, 0, 0, 0);
              Sn = __builtin_amdgcn_mfma_f32_16x16x32_bf16(ka0, bD0, Sn, 0, 0, 0);
              Sn = __builtin_amdgcn_mfma_f32_16x16x32_bf16(ka1, bD1, Sn, 0, 0, 0);
              Sacc[it] = Sn;
#pragma unroll
              for (int r = 0; r < 4; ++r) ((LAS float*)(gb + G_A))[(16 * it + 4 * q4 + r) * 68 + e] = O[r];
              asm volatile("" ::: "memory");
          } }
        else if (c + 1 < SEQ / 64) GDN_RAW_STAGE(c + 1, tid - 256, 256);
        __syncthreads();
    }
    GDN_WRITEOUT(SEQ / 64 - 1);
#undef GDN_WRITEOUT
#undef GDN_RAW_STAGE
    __syncthreads();
}
__device__ __forceinline__ int next_unit(Frame& F, gu32* head) {
    __syncthreads();
    if (F.tid == 0) F.MISC[16] = __hip_atomic_fetch_add(head, 1u, RLX_AGENT);
    __syncthreads();
    return (int)F.MISC[16];
}
constexpr int U_GDN = 96, U_RWKV = 128, U_ATT = 384, U_ALL = U_GDN + U_RWKV + U_ATT;
__device__ __forceinline__ void p3_mixers(Frame& F, int l, int rep) {
    gu32* head = F.ctl + CW_QUEUE + 64 * (2 * l + rep);
    for (;;) {
        const int u = next_unit(F, head);
        if (u >= U_ALL) break;
        asm volatile("" : "+v"(F.tid), "+v"(F.lane));
        if (u < U_GDN) gdn_unit3<0>(F, l, u, F.ctl + CW_FLAG + 64 * 256 * (2 * l + rep) + 64 * 128);
        else if (u < U_GDN + U_RWKV) rwkv_unit<0>(F, u - U_GDN, F.ctl + CW_FLAG + 64 * 256 * (2 * l + rep));
        else attn_unit(F, u - U_GDN - U_RWKV);
    }
}
__device__ __forceinline__ f32x4 bf4(u64_t x) { return (f32x4){__uint_as_float(((unsigned)x) << 16), __uint_as_float(((unsigned)x) & 0xffff0000u), __uint_as_float(((unsigned)(x >> 32)) << 16), __uint_as_float(((unsigned)(x >> 32)) & 0xffff0000u)}; }
__device__ __forceinline__ u64_t pk4(const f32x4& v) { return (u64_t)pg8::cvt_pk_bf16(v[0], v[1]) | ((u64_t)pg8::cvt_pk_bf16(v[2], v[3]) << 32); }
__device__ __forceinline__ void p2_mla_unit(Frame& F, int l, int unit) {
    const int lane = F.lane, col = lane & 15, q4 = lane >> 4, m = 16 * unit + col, b = m / SEQ, t = m % SEQ, t0 = (16 * unit) % SEQ;
    const bf16* prow = (const bf16*)(F.ws + WS_PMLA) + (size_t)m * 352;
    const bf16* WuqT = (const bf16*)(F.ws + WS_WSMALL + OFF_WUQ) + (size_t)l * 576 * 192 + (size_t)col * 192 + 8 * q4;
    const bf16* WukvT = (const bf16*)(F.ws + WS_WSMALL + OFF_WUKV) + (size_t)l * 768 * 128 + (size_t)col * 128 + 8 * q4;
    bf16x8 aq[6], akv[4]; float sq = 0.f, skv = 0.f;
#pragma unroll
    for (int s = 0; s < 6; ++s) { aq[s] = *(const bf16x8*)(prow + 32 * s + 8 * q4); const v4u u = __builtin_bit_cast(v4u, aq[s]);
#pragma unroll
        for (int i = 0; i < 4; ++i) { const float a = __uint_as_float(u[i] << 16), c = __uint_as_float(u[i] & 0xffff0000u); sq += a * a + c * c; } }
#pragma unroll
    for (int s = 0; s < 4; ++s) { akv[s] = *(const bf16x8*)(prow + 192 + 32 * s + 8 * q4); const v4u u = __builtin_bit_cast(v4u, akv[s]);
#pragma unroll
        for (int i = 0; i < 4; ++i) { const float a = __uint_as_float(u[i] << 16), c = __uint_as_float(u[i] & 0xffff0000u); skv += a * a + c * c; } }
    sq += __shfl_xor(sq, 16); sq += __shfl_xor(sq, 32); skv += __shfl_xor(skv, 16); skv += __shfl_xor(skv, 32);
    const float rq = rsqrtf(sq * (1.f / 192.f) + NORM_EPS) * (0.10206207261596575f * LOG2E), rkv = rsqrtf(skv * (1.f / 128.f) + NORM_EPS);
    const float pos = (float)((const int*)inptr(F, 1))[m];
    f32x4 cs, sn;
#pragma unroll
    for (int r = 0; r < 4; ++r) { const float inv = exp2f(-(float)(4 * q4 + r) * (13.287712379549449f / 16.f)); float s_, c_; sincosf(pos * inv, &s_, &c_); cs[r] = c_; sn[r] = s_; }
    bf16* Qo = (bf16*)(F.ws + WS_Q) + ((size_t)b * 6 * SEQ + t) * 96 + 4 * q4;
    bf16* Ko = (bf16*)(F.ws + WS_K) + ((size_t)b * 6 * SEQ + t) * 96 + 4 * q4;
    bf16* Vo = (bf16*)(F.ws + WS_VT) + (size_t)b * 6 * 64 * SEQ + (size_t)col * SEQ + t0 + 4 * q4;
    { const u64_t x1 = *(const u64_t*)(prow + 320 + 4 * q4), x2 = *(const u64_t*)(prow + 336 + 4 * q4); const f32x4 a = bf4(x1), c = bf4(x2);
      const u64_t o1 = pk4(a * cs - c * sn), o2 = pk4(c * cs + a * sn);
#pragma unroll
      for (int h = 0; h < 6; ++h) { *(u64_t*)(Ko + (size_t)h * SEQ * 96 + 64) = o1; *(u64_t*)(Ko + (size_t)h * SEQ * 96 + 80) = o2; } }
#pragma unroll 1
    for (int h = 0; h < 6; ++h) {
        f32x4 x1v = {0.f, 0.f, 0.f, 0.f};
#pragma unroll
        for (int nt = 0; nt < 6; ++nt) {
            const bf16* w = WuqT + (size_t)(h * 96 + 16 * nt) * 192; f32x4 acc = {0.f, 0.f, 0.f, 0.f};
#pragma unroll
            for (int s = 0; s < 6; ++s) acc = __builtin_amdgcn_mfma_f32_16x16x32_bf16(*(const bf16x8*)(w + 32 * s), aq[s], acc, 0, 0, 0);
            acc = acc * rq;
            if (nt < 4) *(u64_t*)(Qo + (size_t)h * SEQ * 96 + 16 * nt) = pk4(acc);
            else if (nt == 4) x1v = acc;
            else { *(u64_t*)(Qo + (size_t)h * SEQ * 96 + 64) = pk4(x1v * cs - acc * sn); *(u64_t*)(Qo + (size_t)h * SEQ * 96 + 80) = pk4(acc * cs + x1v * sn); }
        }
#pragma unroll
        for (int nt = 0; nt < 4; ++nt) {
            const bf16* w = WukvT + (size_t)(h * 128 + 16 * nt) * 128; f32x4 acc = {0.f, 0.f, 0.f, 0.f};
#pragma unroll
            for (int s = 0; s < 4; ++s) acc = __builtin_amdgcn_mfma_f32_16x16x32_bf16(*(const bf16x8*)(w + 32 * s), akv[s], acc, 0, 0, 0);
            *(u64_t*)(Ko + (size_t)h * SEQ * 96 + 16 * nt) = pk4(acc * rkv);
        }
        f32x4 rk4;
#pragma unroll
        for (int r = 0; r < 4; ++r) rk4[r] = __shfl(rkv, 4 * q4 + r);
#pragma unroll
        for (int nt = 0; nt < 4; ++nt) {
            const bf16* w = WukvT + (size_t)(h * 128 + 64 + 16 * nt) * 128; f32x4 acc = {0.f, 0.f, 0.f, 0.f};
#pragma unroll
            for (int s = 0; s < 4; ++s) acc = __builtin_amdgcn_mfma_f32_16x16x32_bf16(akv[s], *(const bf16x8*)(w + 32 * s), acc, 0, 0, 0);
            *(u64_t*)(Vo + (size_t)(h * 64 + 16 * nt) * SEQ) = pk4(acc * rk4);
        }
    }
}
__device__ __forceinline__ f32x4 rw_shift4(const bf16* P, size_t m, int c, bool hp, bool hn, const float* mu) {
    const f32x4 x = bf4(*(const u64_t*)(P + m * 896 + c)), xp = hp ? bf4(*(const u64_t*)(P + (m - 1) * 896 + c)) : (f32x4){0.f, 0.f, 0.f, 0.f}, xn = hn ? bf4(*(const u64_t*)(P + (m + 1) * 896 + c)) : (f32x4){0.f, 0.f, 0.f, 0.f};
    const f32x4 m0 = *(const f32x4*)(mu + c), m1 = *(const f32x4*)(mu + 896 + c);
    return x + m0 * (xp - x) + m1 * (xn - x);
}
__device__ __forceinline__ void p2_rwkv_unit(Frame& F, int l, int unit, int h0, int h1) {
    const int lane = F.lane, col = lane & 15, q4 = lane >> 4, b = (16 * unit) / SEQ, t = (16 * unit) % SEQ + col; const size_t m = (size_t)16 * unit + col;
    const bool hp = t > 0, hn = t < SEQ - 1;
    const bf16* Prw = (const bf16*)(F.ws + WS_PRW);
    const float* mu = (const float*)inptr(F, 12) + l * 2 * 896;
    const bf16* W2T = (const bf16*)(F.ws + WS_WSMALL + OFF_W2T) + (size_t)l * 2 * 256 * 64 + (size_t)col * 64 + 8 * q4;
    const bf16* A2T = (const bf16*)(F.ws + WS_WSMALL + OFF_A2T) + (size_t)l * 2 * 256 * 64 + (size_t)col * 64 + 8 * q4;
    bf16x8 awd[2], aad[2];
#pragma unroll
    for (int s = 0; s < 2; ++s) { const int c = 768 + 32 * s + 8 * q4;
        f32x4 lo = rw_shift4(Prw, m, c, hp, hn, mu), hi = rw_shift4(Prw, m, c + 4, hp, hn, mu);
#pragma unroll
        for (int i = 0; i < 4; ++i) { lo[i] = 1.f - 2.f * __builtin_amdgcn_rcpf(1.f + __expf(2.f * lo[i])); hi[i] = 1.f - 2.f * __builtin_amdgcn_rcpf(1.f + __expf(2.f * hi[i])); }
        awd[s] = pack_acc(lo, hi);
        aad[s] = pack_acc(rw_shift4(Prw, m, c + 64, hp, hn, mu), rw_shift4(Prw, m, c + 68, hp, hn, mu)); }
#pragma unroll 1
    for (int h = h0; h < h1; ++h) {
        f32x4 k[4]; float kn = 0.f;
        { const float* k_k = (const float*)inptr(F, 17) + l * 256;
#pragma unroll
          for (int nt = 0; nt < 4; ++nt) { const int c = 64 * h + 16 * nt + 4 * q4; k[nt] = rw_shift4(Prw, m, 256 + c, hp, hn, mu);
              const f32x4 x = k[nt] * *(const f32x4*)(k_k + c); kn += (x[0] * x[0] + x[1] * x[1]) + (x[2] * x[2] + x[3] * x[3]); } }
        kn += __shfl_xor(kn, 16); kn += __shfl_xor(kn, 32);
        const float rkn = rsqrtf(kn + 1e-6f);
        float br[2] = {0.f, 0.f}, kr[2] = {0.f, 0.f}, cbv = 0.f;
        unsigned char* rs = F.ws + WS_RS + (((size_t)b * 4 + h) * SEQ + t) * RS_REC + 8 * q4;
        unsigned char* rd0 = F.ws + WS_RD + (((size_t)b * 4 + h) * SEQ + t) * RD_REC + 8 * q4;
#pragma unroll
        for (int nt = 0; nt < 4; ++nt) { const int c = 64 * h + 16 * nt + 4 * q4;
            const f32x4 r = rw_shift4(Prw, m, c, hp, hn, mu), v = rw_shift4(Prw, m, 512 + c, hp, hn, mu);
            const f32x4 kk = k[nt] * *(const f32x4*)((const float*)inptr(F, 17) + l * 256 + c) * rkn;
            *(u64_t*)(rs + 32 * nt) = pk4(kk); *(u64_t*)(rs + 128 + 32 * nt) = pk4(v); *(u64_t*)(rs + 256 + 32 * nt) = pk4(r);
            f32x4 ksum = {0.f, 0.f, 0.f, 0.f};
#pragma unroll
            for (int e = 0; e < 2; ++e) { const bf16* w = W2T + (size_t)(e * 256 + 64 * h + 16 * nt) * 64; const bf16* a = A2T + (size_t)(e * 256 + 64 * h + 16 * nt) * 64;
                f32x4 x = {0.f, 0.f, 0.f, 0.f}, y = {0.f, 0.f, 0.f, 0.f};
#pragma unroll
                for (int s = 0; s < 2; ++s) { x = __builtin_amdgcn_mfma_f32_16x16x32_bf16(*(const bf16x8*)(w + 32 * s), awd[s], x, 0, 0, 0); y = __builtin_amdgcn_mfma_f32_16x16x32_bf16(*(const bf16x8*)(a + 32 * s), aad[s], y, 0, 0, 0); }
                const f32x4 w0v = *(const f32x4*)((const float*)inptr(F, 13) + l * 512 + e * 256 + c), a0v = *(const f32x4*)((const float*)inptr(F, 15) + l * 512 + e * 256 + c), kav = *(const f32x4*)((const float*)inptr(F, 18) + l * 256 + c);
                f32x4 lam, av;
#pragma unroll
                for (int i = 0; i < 4; ++i) { lam[i] = 0.6065306597126334f * sigmoidf_(w0v[i] + x[i]); av[i] = sigmoidf_(a0v[i] + y[i]); }
                const f32x4 km = k[nt] * (1.f + (av - 1.f) * kav), bb = av * kk;
                ksum += km;
                br[e] += (bb[0] * r[0] + bb[1] * r[1]) + (bb[2] * r[2] + bb[3] * r[3]); kr[e] += (km[0] * r[0] + km[1] * r[1]) + (km[2] * r[2] + km[3] * r[3]);
                typedef _Float16 h4 __attribute__((ext_vector_type(4)));
                const h4 lh = {(_Float16)lam[0], (_Float16)lam[1], (_Float16)lam[2], (_Float16)lam[3]};
                unsigned char* rd = rd0 + e * RD_DIR;
                *(u64_t*)(rd + 32 * nt) = __builtin_bit_cast(u64_t, lh); *(u64_t*)(rd + 128 + 32 * nt) = pk4(bb); *(u64_t*)(rd + 256 + 32 * nt) = pk4(km); }
            const f32x4 rkv = *(const f32x4*)((const float*)inptr(F, 19) + l * 256 + c), xx = r * ksum * rkv; cbv += (xx[0] + xx[1]) + (xx[2] + xx[3]);
        }
#pragma unroll
        for (int e = 0; e < 2; ++e) { float x = br[e], y = kr[e]; x += __shfl_xor(x, 16); x += __shfl_xor(x, 32); y += __shfl_xor(y, 16); y += __shfl_xor(y, 32);
            if (q4 == 0) { typedef float f2 __attribute__((ext_vector_type(2))); *(f2*)(rd0 + e * RD_DIR + 384) = (f2){x, y}; } }
        cbv += __shfl_xor(cbv, 16); cbv += __shfl_xor(cbv, 32);
        if (q4 == 0) ((float*)(F.ws + WS_CB))[m * 4 + h] = 0.5f * cbv;
    }
}
template <int MODE> __device__ __forceinline__ void p2_prep2(Frame& F, int l) {
    const int gw = F.vcu * NWAVES + F.wave, NGW = F.G * NWAVES;
    for (int u = gw; u < 2 * (M / 16); u += NGW) { if (u & 1) { if (MODE != 1) p2_rwkv_unit(F, l, u >> 1, 0, 4); } else { if (MODE != 2) p2_mla_unit(F, l, u >> 1); } }
}
__device__ __forceinline__ void ld16(const bf16* p, f32x4 (&o)[4]) { const v4u a = *(const v4u*)p, b = *(const v4u*)(p + 8);
    o[0] = (f32x4){__uint_as_float(a.x << 16), __uint_as_float(a.x & 0xffff0000u), __uint_as_float(a.y << 16), __uint_as_float(a.y & 0xffff0000u)};
    o[1] = (f32x4){__uint_as_float(a.z << 16), __uint_as_float(a.z & 0xffff0000u), __uint_as_float(a.w << 16), __uint_as_float(a.w & 0xffff0000u)};
    o[2] = (f32x4){__uint_as_float(b.x << 16), __uint_as_float(b.x & 0xffff0000u), __uint_as_float(b.y << 16), __uint_as_float(b.y & 0xffff0000u)};
    o[3] = (f32x4){__uint_as_float(b.z << 16), __uint_as_float(b.z & 0xffff0000u), __uint_as_float(b.w << 16), __uint_as_float(b.w & 0xffff0000u)}; }
__device__ __forceinline__ void p4a_mix2(Frame& F, int l) {
    const bf16* Ogdn = (const bf16*)(F.ws + WS_OGDN); const bf16* Omla = (const bf16*)(F.ws + WS_OMLA); const bf16* Y = (const bf16*)(F.ws + WS_Y);
    const bf16* Pgate = (const bf16*)(F.ws + WS_PGATE); const unsigned char* Rs = F.ws + WS_RS; const float* cb = (const float*)(F.ws + WS_CB); bf16* mix = (bf16*)(F.ws + WS_MIX);
    const int gw = F.vcu * NWAVES + F.wave, NGW = F.G * NWAVES, lane = F.lane, g = lane >> 2, c0 = 16 * lane;
    f32x4 pg[4], pb[4];
    if (g < 6) { const float* gg = (const float*)inptr(F, 7) + l * 64 + (c0 & 63);
#pragma unroll
        for (int i = 0; i < 4; ++i) { pg[i] = *(const f32x4*)(gg + 4 * i); pb[i] = (f32x4){0.f, 0.f, 0.f, 0.f}; } }
    else if (g < 12) {
#pragma unroll
        for (int i = 0; i < 4; ++i) { pg[i] = (f32x4){1.f, 1.f, 1.f, 1.f}; pb[i] = (f32x4){0.f, 0.f, 0.f, 0.f}; } }
    else { const float* lg = (const float*)inptr(F, 20) + l * 256 + (c0 - 768); const float* lb = (const float*)inptr(F, 21) + l * 256 + (c0 - 768);
#pragma unroll
        for (int i = 0; i < 4; ++i) { pg[i] = *(const f32x4*)(lg + 4 * i); pb[i] = *(const f32x4*)(lb + 4 * i); } }
#pragma unroll 2
    for (int m = gw; m < M; m += NGW) {
        f32x4 x[4], gt[4];
        ld16(Pgate + (size_t)m * 1024 + c0, gt);
        if (g < 6) { ld16(Ogdn + (size_t)m * 384 + c0, x);
            float ss = 0.f;
#pragma unroll
            for (int i = 0; i < 4; ++i) ss += (x[i][0] * x[i][0] + x[i][1] * x[i][1]) + (x[i][2] * x[i][2] + x[i][3] * x[i][3]);
            ss += dpp_xor1(ss); ss += dpp_xor2(ss);
            const float rs = rsqrtf(ss * (1.f / 64.f) + NORM_EPS);
#pragma unroll
            for (int i = 0; i < 4; ++i) x[i] = x[i] * rs * pg[i]; }
        else if (g < 12) ld16(Omla + (size_t)m * 384 + (c0 - 384), x);
        else { const int cc = c0 - 768, h = g - 12, b = m / SEQ, t = m % SEQ; f32x4 v[4];
            ld16(Y + (size_t)m * 256 + cc, x); ld16((const bf16*)(Rs + (((size_t)b * 4 + h) * SEQ + t) * RS_REC + 128) + (cc & 63), v);
            const float cbv = cb[(size_t)m * 4 + h];
            float s1 = 0.f;
#pragma unroll
            for (int i = 0; i < 4; ++i) s1 += (x[i][0] + x[i][1]) + (x[i][2] + x[i][3]);
            s1 += dpp_xor1(s1); s1 += dpp_xor2(s1);
            const float mean = s1 * (1.f / 64.f); float s2 = 0.f;
#pragma unroll
            for (int i = 0; i < 4; ++i) { x[i] = x[i] - mean; s2 += (x[i][0] * x[i][0] + x[i][1] * x[i][1]) + (x[i][2] * x[i][2] + x[i][3] * x[i][3]); }
            s2 += dpp_xor1(s2); s2 += dpp_xor2(s2);
            const float rs = rsqrtf(s2 * (1.f / 64.f) + 64e-5f);
#pragma unroll
            for (int i = 0; i < 4; ++i) x[i] = x[i] * rs * pg[i] + pb[i] + cbv * v[i]; }
        v4u o0, o1;
#pragma unroll
        for (int i = 0; i < 4; ++i) {
#pragma unroll
            for (int j = 0; j < 4; ++j) x[i][j] = x[i][j] * siluf(gt[i][j]); }
        o0.x = pg8::cvt_pk_bf16(x[0][0], x[0][1]); o0.y = pg8::cvt_pk_bf16(x[0][2], x[0][3]); o0.z = pg8::cvt_pk_bf16(x[1][0], x[1][1]); o0.w = pg8::cvt_pk_bf16(x[1][2], x[1][3]);
        o1.x = pg8::cvt_pk_bf16(x[2][0], x[2][1]); o1.y = pg8::cvt_pk_bf16(x[2][2], x[2][3]); o1.z = pg8::cvt_pk_bf16(x[3][0], x[3][1]); o1.w = pg8::cvt_pk_bf16(x[3][2], x[3][3]);
        bf16* op = mix + (size_t)m * 1024 + c0; *(v4u*)op = o0; *(v4u*)(op + 8) = o1;
    }
}
constexpr int PT_OUT = 24, PT_WS = 25, PT_N = 26;
__device__ __forceinline__ void build_frame(Frame& F, LAS unsigned char* lds) {
    F.lds = lds; F.MISC = (volatile LAS unsigned*)(lds + MISC_OFF); F.ptab = (volatile LAS const unsigned long long*)(lds + MISC_OFF + 256);
    const int t = pg8::mk_tid(lds);
    F.tid = t; F.lane = t & 63; F.wave = __builtin_amdgcn_readfirstlane(t >> 6);
    F.G = gridDim.x; { const int bx = blockIdx.x; F.vcu = (F.G % 8 == 0) ? (bx % 8) * (F.G / 8) + bx / 8 : bx; }
    F.ws = (unsigned char*)inptr(F, PT_WS); F.out = (float*)inptr(F, PT_OUT); F.ctl = (gu32*)F.ws;
}
__device__ __forceinline__ bool ph_in(LAS unsigned char* lds, int k) { volatile LAS unsigned* mi = (volatile LAS unsigned*)(lds + MISC_OFF); const int lo = __builtin_amdgcn_readfirstlane((int)mi[20]), hi = __builtin_amdgcn_readfirstlane((int)mi[21]); return lo <= k && k < hi; }
__device__ __forceinline__ void seam(LAS unsigned char* lds, int k) {
    if (ph_in(lds, k) && ph_in(lds, k + 1)) { Frame F; build_frame(F, lds);
        XcdBarrier bar; bar.bar = (unsigned*)(F.ctl + CW_BAR); bar.x = xb_xcc_id(); bar.st = F.MISC + 8; xcd_barrier(bar); }
}
template <int L> __device__ __forceinline__ void layer_phases(LAS unsigned char* lds) {
    constexpr int pb = 1 + 5 * L;
    if (ph_in(lds, pb)) { Frame F; build_frame(F, lds);
        pg8::Gemm g{(const pg8::bf16_t*)(F.ws + WS_XB), (const pg8::bf16_t*)(F.ws + WS_WIN) + (size_t)L * NP * D, M, NP, D};
        pg8::StaticOrder S; S.init(M, NP, F.G, (int)blockIdx.x);
        pg8::EpiRoute E{F.ws};
        pg8::gemm_phase<pg8::EpiRoute, pg8::StaticOrder, true, true>(F.lds + RING_OFF, g, S, E);
    }
    seam(lds, pb);
    if (ph_in(lds, pb + 1)) { Frame F; build_frame(F, lds); p2_prep2<0>(F, L); }
    seam(lds, pb + 1);
    if (ph_in(lds, pb + 2)) { Frame F; build_frame(F, lds); p3_mixers(F, L, 0); }
    seam(lds, pb + 2);
    if (ph_in(lds, pb + 3)) { Frame F; build_frame(F, lds); p4a_mix2(F, L);
    }
    seam(lds, pb + 3);
    if (ph_in(lds, pb + 4)) { Frame F; build_frame(F, lds);
        pg8::Gemm g{(const pg8::bf16_t*)(F.ws + WS_MIX), (const pg8::bf16_t*)(F.ws + WS_WOUT) + (size_t)L * D * D, M, D, D};
        pg8::StaticOrder S; S.init(M, D, F.G, (int)blockIdx.x);
        pg8::EpiOut E{L == 0 ? (const float*)inptr(F, 0) : (const float*)F.out, F.out, F.ws};
        pg8::gemm_phase<pg8::EpiOut, pg8::StaticOrder, true, true>(F.lds + RING_OFF, g, S, E);
    }
    seam(lds, pb + 4);
}
__global__ void __launch_bounds__(NWAVES * 64, 2) mk_fwd(Args args) {
    extern __shared__ __attribute__((aligned(16))) unsigned char lds_raw[];
    LAS unsigned char* lds = (LAS unsigned char*)lds_raw;
    for (int u = threadIdx.x; u < (LDS_BYTES - LDSCTL_OFF) / 4; u += NWAVES * 64) ((LAS unsigned*)(lds + LDSCTL_OFF))[u] = 0u;
    __syncthreads();
    if (threadIdx.x == 0) { LAS unsigned long long* pt = (LAS unsigned long long*)(lds + MISC_OFF + 256);
#define PT(k) pt[k] = (unsigned long long)args.in[k]
        PT(0); PT(1); PT(2); PT(3); PT(4); PT(5); PT(6); PT(7); PT(8); PT(9); PT(10); PT(11); PT(12); PT(13); PT(14); PT(15); PT(16); PT(17); PT(18); PT(19); PT(20); PT(21); PT(22); PT(23);
#undef PT
        pt[PT_OUT] = (unsigned long long)args.out; pt[PT_WS] = (unsigned long long)args.ws;
        volatile LAS unsigned* mi = (volatile LAS unsigned*)(lds + MISC_OFF); mi[20] = (unsigned)args.ph_lo; mi[21] = (unsigned)args.ph_hi;
        if (args.ph_hi - args.ph_lo > 1) (void)xcd_barrier_post((unsigned*)((gu32*)args.ws + CW_BAR), mi + 8);
    }
    if ((threadIdx.x & 63) == 0) ((volatile LAS unsigned*)(lds + pg8::TIDTAB_OFF))[pg8::hw_slot()] = threadIdx.x >> 6;
    __syncthreads();
    if (ph_in(lds, 0)) { Frame F; build_frame(F, lds); p0_prologue(F); }
    seam(lds, 0);
    layer_phases<0>(lds);
    layer_phases<1>(lds);
    if (ph_in(lds, 11)) { Frame F; build_frame(F, lds); p5_final(F); }
}

extern "C" void kernel_launch(void* const* d_in, const int* in_sizes, int n_in, void* d_out, int out_size, void* d_ws, size_t ws_size, hipStream_t stream) {
    static int grid = 0;
    if (grid == 0) {
        if (n_in != 24 || ws_size < WS_END || out_size != M * D) { fprintf(stderr, "kernel_launch: unexpected inputs (%d), out (%d) or workspace (%zu)\n", n_in, out_size, ws_size); grid = -1; return; }
        int dev = 0, cus = 0;
        if (hipGetDevice(&dev) != hipSuccess || hipDeviceGetAttribute(&cus, hipDeviceAttributeMultiprocessorCount, dev) != hipSuccess) { grid = -1; return; }
        if (hipFuncSetAttribute((const void*)mk_fwd, hipFuncAttributeMaxDynamicSharedMemorySize, LDS_BYTES) != hipSuccess) { fprintf(stderr, "kernel_launch: hipFuncSetAttribute failed\n"); grid = -1; return; }
        (void)hipGetLastError();
        grid = cus;
    }
    if (grid < 0) return;
    unsigned char* ws = (unsigned char*)d_ws;
    (void)hipMemsetAsync(ws + WS_CTL, 0, CTL_ZERO_BYTES, stream);
    Args a{};
    for (int i = 0; i < 24; ++i) a.in[i] = d_in[i];
    a.out = (float*)d_out; a.ws = ws; a.ph_lo = 0; a.ph_hi = NPHASE;
    hipLaunchKernelGGL(mk_fwd, dim3(grid), dim3(NWAVES * 64), LDS_BYTES, stream, a);
}
```

```cpp
#include <hip/hip_runtime.h>
#include <cstdio>
#include <cstdint>
#include <hip/hip_fp16.h>
namespace pg8 {
#define PG8_LAS __attribute__((address_space(3)))
typedef unsigned short bf16_t;
typedef short bf16x8 __attribute__((ext_vector_type(8)));
typedef float f32x4 __attribute__((ext_vector_type(4)));
typedef unsigned u32x4 __attribute__((ext_vector_type(4)));
constexpr int BM = 256, BK = 64, HALF = 128, HTB = HALF * BK * 2  , STAGE_BYTES = 8 * HTB, NXCD = 8, WGM = 8;

__host__ __device__ __forceinline__ int lds_byte(int r, int c) { const int st = (r >> 4) * 2 + (c >> 5), rr = r & 15, cc = c & 31, ob = rr * 64 + cc * 2; return st * 1024 + (ob ^ (((ob >> 9) & 1) << 5)); }
__host__ __device__ __forceinline__ void stage_rc(int b, int& R, int& C) { const int st = b / 1024, sb = b % 1024, swz = sb ^ (((sb >> 9) & 1) << 5); R = (st >> 1) * 16 + swz / 64; C = (st & 1) * 32 + (swz % 64) / 2; }
__host__ __device__ __forceinline__ int perm32(int rho) { const int n = rho >> 4, i = rho & 15; return 8 * (i >> 2) + 4 * n + (i & 3); }

struct Unit { int pm, pn; };
struct Gemm { const bf16_t* A; const bf16_t* Bt; int M, N, K; };

struct StaticOrder {
    int nM, nN, nwg, G, c;
    __host__ __device__ void init(int M, int N, int G_, int c_) { nM = M / BM; nN = N / BM; nwg = nM * nN; G = G_; c = c_; }
    __host__ __device__ bool next(int i, Unit& u) const {
        const long L = (long)i * G + c; if (L >= nwg) return false;
        int wgid = (int)L; { const int q = nwg / NXCD, r = nwg % NXCD, xcd = wgid % NXCD, off = wgid / NXCD; wgid = (xcd < r ? xcd * (q + 1) : r * (q + 1) + (xcd - r) * q) + off; }
        const int nig = WGM * nN, gid = wgid / nig, fm = gid * WGM, gsz = (nM - fm) < WGM ? (nM - fm) : WGM;
        u.pm = fm + ((wgid % nig) % gsz); u.pn = (wgid % nig) / gsz; return true;
    }
    __device__ __forceinline__ void a_ready(const Unit&) const {}
    __device__ __forceinline__ void done(const Unit&) const {}
};

__device__ __forceinline__ unsigned cvt_pk_bf16(float lo, float hi) { unsigned r; asm volatile("v_cvt_pk_bf16_f32 %0, %1, %2" : "=v"(r) : "v"(lo), "v"(hi)); return r; }
typedef float f32x2 __attribute__((ext_vector_type(2)));
constexpr int TIDTAB_OFF = 131072 + 320 + 512;
__device__ __forceinline__ unsigned hw_slot() { return (unsigned)__builtin_amdgcn_s_getreg((5 << 11) | 4) & 63u; }
__device__ __forceinline__ int mk_tid(PG8_LAS unsigned char* lds_base) {
    const unsigned lane = __builtin_amdgcn_mbcnt_hi(~0u, __builtin_amdgcn_mbcnt_lo(~0u, 0u));
    const unsigned w = __builtin_amdgcn_readfirstlane(((volatile PG8_LAS unsigned*)(lds_base + TIDTAB_OFF))[hw_slot()]);
    return (int)(w * 64u + lane);
}
struct EpiRoute {
    static constexpr bool PERM = true, AFTER_DRAIN = false;
    unsigned char* ws;
    __device__ __forceinline__ void operator()(const f32x4 (&acc)[2][2][4][2], const Unit& u, int wr, int wc, int fr, int fq) const {
        const int row0 = u.pm * BM + wr * 64 + fr;
        const float* rowss = (const float*)(ws + (1u << 20)); float* Psm = (float*)(ws + (22u << 20));
        unsigned base[2]; int ld[2], cc[2], kind[2];
#pragma unroll
        for (int bj = 0; bj < 2; ++bj) {
            const int cg = u.pn * BM + bj * HALF + wc * 32, col = cg + 8 * fq;
            if (cg < 1024) { base[bj] = 25u << 20; ld[bj] = 1024; cc[bj] = col; kind[bj] = 0; }
            else if (cg < 2176) { base[bj] = 57u << 20; ld[bj] = 1152; cc[bj] = col - 1024; kind[bj] = 0; }
            else if (cg < 2528) { base[bj] = 93u << 20; ld[bj] = 352; cc[bj] = col - 2176; kind[bj] = 0; }
            else if (cg < 3424) { base[bj] = 104u << 20; ld[bj] = 896; cc[bj] = col - 2528; kind[bj] = 0; }
            else if (cg < 3456) { base[bj] = 0u; ld[bj] = 32; cc[bj] = col - 3424; kind[bj] = 1; }
            else { base[bj] = 0u; ld[bj] = 0; cc[bj] = 0; kind[bj] = 2; }
        }
#pragma unroll
        for (int ai = 0; ai < 2; ++ai)
#pragma unroll
            for (int m = 0; m < 4; ++m) {
                const int row = row0 + ai * HALF + m * 16;
                const f32x4* rp = (const f32x4*)(rowss + (size_t)row * 16);
                const f32x4 s0 = rp[0], s1 = rp[1], s2 = rp[2], s3 = rp[3];
                const float ss = ((s0[0] + s0[1]) + (s0[2] + s0[3])) + ((s1[0] + s1[1]) + (s1[2] + s1[3])) + ((s2[0] + s2[1]) + (s2[2] + s2[3])) + ((s3[0] + s3[1]) + (s3[2] + s3[3]));
                const float rstd = __builtin_amdgcn_rsqf(ss * (1.0f / 1024.0f) + 1e-6f);
#pragma unroll
                for (int bj = 0; bj < 2; ++bj) {
                    const f32x4 v0 = acc[ai][bj][m][0] * rstd, v1 = acc[ai][bj][m][1] * rstd;
                    if (kind[bj] == 0) { u32x4 w; w.x = cvt_pk_bf16(v0[0], v0[1]); w.y = cvt_pk_bf16(v0[2], v0[3]); w.z = cvt_pk_bf16(v1[0], v1[1]); w.w = cvt_pk_bf16(v1[2], v1[3]);
                        *(u32x4*)((bf16_t*)(ws + base[bj]) + (size_t)row * ld[bj] + cc[bj]) = w; }
                    else if (kind[bj] == 1) { float* p = Psm + (size_t)row * 32 + cc[bj]; *(f32x4*)p = v0; *(f32x4*)(p + 4) = v1; }
                }
                asm volatile("" ::: "memory");
            }
    }
};
template <bool WRITE_XB> struct EpiOut {
    static constexpr bool PERM = false, AFTER_DRAIN = false;
    const float* xin; float* xout; unsigned char* ws;
    __device__ __forceinline__ void operator()(const f32x4 (&acc)[2][2][4][2], const Unit& u, int wr, int wc, int fr, int fq) const {
        typedef unsigned u32x2v __attribute__((ext_vector_type(2)));
        const int row0 = u.pm * BM + wr * 64 + fr, col0 = u.pn * BM + wc * 32 + 4 * fq;
        float* rowss = (float*)(ws + (1u << 20)); bf16_t* xb = (bf16_t*)(ws + (133u << 20));
#pragma unroll
        for (int ai = 0; ai < 2; ++ai)
#pragma unroll
            for (int m = 0; m < 4; ++m) {
                const int row = row0 + ai * HALF + m * 16; float ss = 0.f;
#pragma unroll
                for (int bj = 0; bj < 2; ++bj)
#pragma unroll
                    for (int n = 0; n < 2; ++n) {
                        const size_t off = (size_t)row * 1024 + col0 + bj * HALF + n * 16;
                        const f32x4 o = *(const f32x4*)(xin + off) + acc[ai][bj][m][n];
                        *(f32x4*)(xout + off) = o;
                        if (WRITE_XB) { u32x2v w; w.x = cvt_pk_bf16(o[0], o[1]); w.y = cvt_pk_bf16(o[2], o[3]); *(u32x2v*)(xb + off) = w; }
                        ss += (o[0] * o[0] + o[1] * o[1]) + (o[2] * o[2] + o[3] * o[3]);
                    }
                ss += __shfl_xor(ss, 16); ss += __shfl_xor(ss, 32);
                if (fq == 0) rowss[(size_t)row * 16 + u.pn * 4 + wc] = ss;
                asm volatile("" ::: "memory");
            }
    }
};
template <class Epi, class Sched, bool ALIGN_EPI = false, bool SP2 = false>
__device__ __forceinline__ void gemm_phase(PG8_LAS unsigned char* lds, const Gemm g, const Sched& S, const Epi& E) {
    const int tid_ = mk_tid(lds);
    const int tid = tid_, wid = __builtin_amdgcn_readfirstlane(tid >> 6), lane = tid & 63, wr = wid >> 2, wc = wid & 3, fr = lane & 15, fq = lane >> 4;
    const int K = g.K, nt = K / BK;
    unsigned voffA[2], voffB[2];
#pragma unroll
    for (int i = 0; i < 2; ++i) { int R, C; stage_rc(tid * 16 + i * 8192, R, C); const int Rb = Epi::PERM ? ((R & ~31) + perm32(R & 31)) : R;
        voffA[i] = (unsigned)(R * K + C) * 2u; voffB[i] = (unsigned)(Rb * K + C) * 2u; }
    const size_t kstep = (size_t)(BK * 2);
    const size_t hstep = (size_t)HALF * K * 2;
    const size_t tstep = 2 * hstep;
    const unsigned ldsw = (unsigned)wid * 1024u;
    const int aoff = lds_byte(wr * 64 + fr, fq * 8), boff = lds_byte(wc * 32 + fr, fq * 8);
#define PG8_SA(b, h) (((b) * 2 + (h)) * HTB)
#define PG8_SB(b, h) ((4 + (b) * 2 + (h)) * HTB)
#define PG8_STAGE(bufoff, gbase, voff) do { _Pragma("unroll") for (int _i = 0; _i < 2; ++_i) \
        __builtin_amdgcn_global_load_lds((const unsigned*)((const char*)(gbase) + (voff)[_i]), (PG8_LAS unsigned*)(lds + (bufoff) + ldsw + _i * 8192), 16, 0, 0); } while (0)
#define PG8_LDA(dst, b, h) do { _Pragma("unroll") for (int m = 0; m < 4; ++m) _Pragma("unroll") for (int k = 0; k < 2; ++k) dst[m][k] = *(const PG8_LAS bf16x8*)(lds + PG8_SA(b, h) + aoff + m * 2048 + k * 1024); } while (0)
#define PG8_LDB(dst, b, h) do { _Pragma("unroll") for (int n = 0; n < 2; ++n) _Pragma("unroll") for (int k = 0; k < 2; ++k) dst[n][k] = *(const PG8_LAS bf16x8*)(lds + PG8_SB(b, h) + boff + n * 2048 + k * 1024); } while (0)
#define PG8_MMA(ai, bj, At, Bt) do { __builtin_amdgcn_s_setprio(1); _Pragma("unroll") for (int m = 0; m < 4; ++m) _Pragma("unroll") for (int n = 0; n < 2; ++n) _Pragma("unroll") for (int k = 0; k < 2; ++k) \
        acc[ai][bj][m][n] = __builtin_amdgcn_mfma_f32_16x16x32_bf16(Bt[n][k], At[m][k], acc[ai][bj][m][n], 0, 0, 0); __builtin_amdgcn_s_setprio(0); } while (0)
#define PG8_WAIT_V(n) asm volatile("s_waitcnt vmcnt(" #n ")" ::: "memory")
#define PG8_WAIT_L(n) asm volatile("s_waitcnt lgkmcnt(" #n ")" ::: "memory")
#define PG8_BAR __builtin_amdgcn_s_barrier()
#define PG8_SCHED __builtin_amdgcn_sched_barrier(0)
    Unit cur, nxt; int ui = 0;
    if (!S.next(0, cur)) return;
    f32x4 acc[2][2][4][2];
#pragma unroll
    for (int a = 0; a < 2; ++a)
#pragma unroll
        for (int b = 0; b < 2; ++b)
#pragma unroll
            for (int m = 0; m < 4; ++m)
#pragma unroll
                for (int n = 0; n < 2; ++n) acc[a][b][m][n] = (f32x4){0.f, 0.f, 0.f, 0.f};
    bf16x8 At[4][2], B0[2][2], B1[2][2];
    const char* cA = (const char*)g.A + (size_t)cur.pm * tstep; const char* cB = (const char*)g.Bt + (size_t)cur.pn * tstep;
    S.a_ready(cur);
    if constexpr (SP2) {
        PG8_STAGE(PG8_SB(0, 0), cB, voffB); PG8_STAGE(PG8_SB(0, 1), cB + hstep, voffB); PG8_STAGE(PG8_SA(0, 0), cA, voffA); PG8_STAGE(PG8_SA(0, 1), cA + hstep, voffA);
        if (wr == 1) PG8_BAR;
        PG8_WAIT_V(2); PG8_BAR;
        PG8_STAGE(PG8_SB(1, 0), cB + kstep, voffB); PG8_STAGE(PG8_SA(1, 0), cA + kstep, voffA); PG8_STAGE(PG8_SB(1, 1), cB + hstep + kstep, voffB);
        PG8_WAIT_V(6); PG8_BAR;
    } else {
        PG8_STAGE(PG8_SB(0, 0), cB, voffB); PG8_STAGE(PG8_SA(0, 0), cA, voffA); PG8_STAGE(PG8_SB(0, 1), cB + hstep, voffB); PG8_STAGE(PG8_SA(0, 1), cA + hstep, voffA);
        if (wr == 1) PG8_BAR;
        PG8_WAIT_V(4); PG8_BAR;
        PG8_STAGE(PG8_SB(1, 0), cB + kstep, voffB); PG8_STAGE(PG8_SA(1, 0), cA + kstep, voffA); PG8_STAGE(PG8_SB(1, 1), cB + hstep + kstep, voffB);
        PG8_WAIT_V(6); PG8_BAR;
    }
    for (;;) {
        const bool has_next = S.next(ui + 1, nxt);
        const char* nA = has_next ? (const char*)g.A + (size_t)nxt.pm * tstep : cA; const char* nB = has_next ? (const char*)g.Bt + (size_t)nxt.pn * tstep : cB;
        for (int t = 0; t < nt; t += 2) {
            const bool last = (t == nt - 2);
            const char* a1 = cA + (size_t)(t + 1) * kstep;
            const char* a2 = last ? nA : cA + (size_t)(t + 2) * kstep; const char* b2 = last ? nB : cB + (size_t)(t + 2) * kstep;
            const char* a3 = a2 + kstep; const char* b3 = b2 + kstep;
            if (last && has_next) S.a_ready(nxt);
            if constexpr (SP2) {
            PG8_LDB(B0, 0, 0); PG8_LDB(B1, 0, 1); PG8_SCHED; PG8_LDA(At, 0, 0); PG8_STAGE(PG8_SA(1, 1), a1 + hstep, voffA);
            PG8_WAIT_V(8); PG8_WAIT_L(0); PG8_BAR; PG8_MMA(0, 0, At, B0); PG8_MMA(0, 1, At, B1); PG8_BAR; PG8_SCHED;
            PG8_LDA(At, 0, 1); PG8_STAGE(PG8_SB(0, 0), b2, voffB); PG8_STAGE(PG8_SB(0, 1), b2 + hstep, voffB); PG8_STAGE(PG8_SA(0, 0), a2, voffA);
            PG8_WAIT_V(8); PG8_WAIT_L(0); PG8_BAR; PG8_MMA(1, 0, At, B0); PG8_MMA(1, 1, At, B1); PG8_BAR; PG8_SCHED;
            PG8_LDB(B0, 1, 0); PG8_LDB(B1, 1, 1); PG8_SCHED; PG8_LDA(At, 1, 0); PG8_STAGE(PG8_SA(0, 1), a2 + hstep, voffA);
            PG8_WAIT_V(8); PG8_WAIT_L(0); PG8_BAR; PG8_MMA(0, 0, At, B0); PG8_MMA(0, 1, At, B1); PG8_BAR; PG8_SCHED;
            PG8_LDA(At, 1, 1); PG8_STAGE(PG8_SB(1, 0), b3, voffB); PG8_STAGE(PG8_SB(1, 1), b3 + hstep, voffB); PG8_STAGE(PG8_SA(1, 0), a3, voffA);
            PG8_WAIT_V(8); PG8_WAIT_L(0); PG8_BAR; PG8_MMA(1, 0, At, B0); PG8_MMA(1, 1, At, B1); PG8_BAR; PG8_SCHED;
            } else {
            PG8_LDB(B0, 0, 0); PG8_SCHED; PG8_LDA(At, 0, 0); PG8_STAGE(PG8_SA(1, 1), a1 + hstep, voffA);
            PG8_WAIT_L(8); PG8_BAR; PG8_WAIT_L(0); PG8_MMA(0, 0, At, B0); PG8_BAR; PG8_SCHED;
            PG8_LDB(B1, 0, 1); PG8_STAGE(PG8_SB(0, 0), b2, voffB);
            PG8_BAR; PG8_WAIT_L(0); PG8_MMA(0, 1, At, B1); PG8_BAR;
            PG8_LDA(At, 0, 1); PG8_STAGE(PG8_SA(0, 0), a2, voffA);
            PG8_BAR; PG8_WAIT_L(0); PG8_MMA(1, 0, At, B0); PG8_BAR; PG8_SCHED;
            PG8_STAGE(PG8_SB(0, 1), b2 + hstep, voffB);
            PG8_WAIT_V(6); PG8_BAR; PG8_MMA(1, 1, At, B1); PG8_BAR;
            PG8_LDB(B0, 1, 0); PG8_SCHED; PG8_LDA(At, 1, 0); PG8_STAGE(PG8_SA(0, 1), a2 + hstep, voffA);
            PG8_WAIT_L(8); PG8_BAR; PG8_WAIT_L(0); PG8_MMA(0, 0, At, B0); PG8_BAR; PG8_SCHED;
            PG8_LDB(B1, 1, 1); PG8_STAGE(PG8_SB(1, 0), b3, voffB);
            PG8_BAR; PG8_WAIT_L(0); PG8_MMA(0, 1, At, B1); PG8_BAR;
            PG8_LDA(At, 1, 1); PG8_STAGE(PG8_SA(1, 0), a3, voffA);
            PG8_BAR; PG8_WAIT_L(0); PG8_MMA(1, 0, At, B0); PG8_BAR; PG8_SCHED;
            PG8_STAGE(PG8_SB(1, 1), b3 + hstep, voffB);
            PG8_WAIT_V(6); PG8_BAR; PG8_MMA(1, 1, At, B1); PG8_BAR;
            }
        }
        if constexpr (ALIGN_EPI) { if (wr == 0) PG8_BAR; }
        if constexpr (!Epi::AFTER_DRAIN) { E(acc, cur, wr, wc, fr, fq); S.done(cur); }
        if (!has_next) break;
#pragma unroll
        for (int a = 0; a < 2; ++a)
#pragma unroll
            for (int b = 0; b < 2; ++b)
#pragma unroll
                for (int m = 0; m < 4; ++m)
#pragma unroll
                    for (int n = 0; n < 2; ++n) acc[a][b][m][n] = (f32x4){0.f, 0.f, 0.f, 0.f};
        cur = nxt; cA = nA; cB = nB; ++ui;
        if constexpr (ALIGN_EPI) { if (wr == 1) PG8_BAR; }
    }
    PG8_WAIT_V(0);
    if constexpr (!ALIGN_EPI) { if (wr == 0) PG8_BAR; }
    PG8_BAR;
    if constexpr (Epi::AFTER_DRAIN) { E.fused(acc, cur, wr, wc, fr, fq, lds, wid, lane); S.done(cur); }
#undef PG8_SA
#undef PG8_SB
#undef PG8_STAGE
#undef PG8_LDA
#undef PG8_LDB
#undef PG8_MMA
#undef PG8_WAIT_V
#undef PG8_WAIT_L
#undef PG8_BAR
#undef PG8_SCHED
}
}
#define GAS __attribute__((address_space(1)))
#define LAS __attribute__((address_space(3)))
typedef unsigned short bf16;
typedef unsigned v4u __attribute__((ext_vector_type(4)));
typedef float f32x4 __attribute__((ext_vector_type(4)));
typedef short bf16x8 __attribute__((ext_vector_type(8)));
typedef GAS unsigned gu32;
typedef GAS unsigned long long gu64;
#define RLX_AGENT __ATOMIC_RELAXED, __HIP_MEMORY_SCOPE_AGENT
#define LDS_WAIT() asm volatile("s_waitcnt lgkmcnt(0)" ::: "memory")
#define VM_WAIT() asm volatile("s_waitcnt vmcnt(0)" ::: "memory")
__device__ __forceinline__ unsigned long long rt() { return __builtin_amdgcn_s_memrealtime(); }
__device__ __forceinline__ unsigned f2bf(float f) { unsigned u = __builtin_bit_cast(unsigned, f); return (u + 0x7fffu + ((u >> 16) & 1u)) >> 16; }
__device__ __forceinline__ unsigned pk2(float lo, float hi) { return f2bf(lo) | (f2bf(hi) << 16); }

#define XB_TMO      128
#define XB_XCNT(j)  (256  + 64 * (j))
#define XB_XSUB(j)  (1280 + 64 * (j))
#define XB_XGEN(j)  (2304 + 64 * (j))
#define XB_TOP      3328
#define XB_TOPGEN   3392
#define XCD_BAR_WORDS 3456
#define XB_SPIN_CAP (1u << 18)

__device__ __forceinline__ unsigned xb_ld(unsigned* p)              { return __hip_atomic_load(p, __ATOMIC_RELAXED, __HIP_MEMORY_SCOPE_AGENT); }
__device__ __forceinline__ unsigned xb_add(unsigned* p, unsigned v) { return __hip_atomic_fetch_add(p, v, __ATOMIC_RELAXED, __HIP_MEMORY_SCOPE_AGENT); }
__device__ __forceinline__ unsigned xb_xcc_id() { return (unsigned)__builtin_amdgcn_s_getreg((3 << 11) | 20) & 0xFu; }
#define XB_SPIN(cond, bar) do { unsigned _sp = 0; while (cond) { __builtin_amdgcn_s_sleep(1); \
    if ((++_sp & 255u) == 0u) { if (xb_ld(&(bar)[XB_TMO])) break; if (_sp > XB_SPIN_CAP) { atomicAdd(&(bar)[XB_TMO], 1u); break; } } } } while (0)

struct XcdBarrier {
    unsigned* bar; unsigned x;
    volatile LAS unsigned* st;
};

__device__ __forceinline__ XcdBarrier xcd_barrier_post(unsigned* bar, volatile LAS unsigned* st) {
    XcdBarrier b; b.bar = bar; b.x = xb_xcc_id(); b.st = st;
    if (threadIdx.x == 0) (void)xb_add(&bar[XB_XCNT(b.x)], 1u);
    return b;
}
__device__ __forceinline__ void xcd_barrier_complete(unsigned* bar, unsigned x, unsigned& nloc, unsigned& nx) {
    const unsigned G = gridDim.x * gridDim.y * gridDim.z;
    unsigned sum, cnt, mine, sp = 0u;
    for (;;) {
        sum = 0u; cnt = 0u; mine = 0u;
#pragma unroll
        for (unsigned j = 0; j < 16; ++j) { const unsigned c = xb_ld(&bar[XB_XCNT(j)]); sum += c; cnt += (c > 0u) ? 1u : 0u; mine = (j == x) ? c : mine; }
        if (sum == G) break;
        __builtin_amdgcn_s_sleep(1);
        if ((++sp & 255u) == 0u) { if (xb_ld(&bar[XB_TMO])) break; if (sp > XB_SPIN_CAP) { atomicAdd(&bar[XB_TMO], 1u); break; } }
    }
    nloc = mine > 0u ? mine : 1u; nx = cnt > 0u ? cnt : 1u;
}

__device__ __forceinline__ void xcd_barrier(const XcdBarrier& b) {
    asm volatile("s_waitcnt vmcnt(0)" ::: "memory");
    __syncthreads();
    if (pg8::mk_tid((LAS unsigned char*)b.st - (131072 + 320 + 32)) == 0) {
        unsigned* bar = b.bar;
        __builtin_amdgcn_s_waitcnt(0);
        unsigned nloc = b.st[0], nx = b.st[1];
        if (nloc == 0u) { xcd_barrier_complete(bar, b.x, nloc, nx); b.st[0] = nloc; b.st[1] = nx; }
        const unsigned old = xb_add(&bar[XB_XSUB(b.x)], 1u);
        const unsigned gen = old / nloc;
        if (old + 1u == (gen + 1u) * nloc) {
            __builtin_amdgcn_fence(__ATOMIC_RELEASE, "agent");
            asm volatile("s_waitcnt vmcnt(0)" ::: "memory");
            const unsigned og = xb_add(&bar[XB_TOP], 1u);
            const unsigned tg = og / nx;
            if (og + 1u == (tg + 1u) * nx) xb_add(&bar[XB_TOPGEN], 1u);
            else XB_SPIN(xb_ld(&bar[XB_TOPGEN]) == tg, bar);
            __builtin_amdgcn_fence(__ATOMIC_ACQUIRE, "agent");
            xb_add(&bar[XB_XGEN(b.x)], 1u);
            asm volatile("s_waitcnt vmcnt(0)" ::: "memory");
        } else {
            XB_SPIN(xb_ld(&bar[XB_XGEN(b.x)]) == gen, bar);
            __builtin_amdgcn_fence(__ATOMIC_ACQUIRE, "agent");
            asm volatile("s_waitcnt vmcnt(0)" ::: "memory");
        }
    }
    __syncthreads();
}
constexpr int BATCH = 8, SEQ = 2048, M = BATCH * SEQ, D = 1024, NIN = 3448, NP = 3584;
constexpr float NORM_EPS = 1e-6f;
constexpr float LOG2E = 1.4426950408889634f;
constexpr size_t MiB = 1u << 20;
constexpr size_t WS_CTL = 0, CTL_ZERO_BYTES = 1 * MiB;
constexpr size_t WS_ROWSS = 1 * MiB;
constexpr size_t WS_WIN = 2 * MiB;
constexpr size_t WS_WOUT = 16 * MiB;
constexpr size_t WS_WSMALL = 20 * MiB;
constexpr size_t OFF_WUQ = 0, OFF_WUKV = 2 * 576 * 192 * 2, OFF_W2T = OFF_WUKV + 2 * 768 * 128 * 2, OFF_A2T = OFF_W2T + 2 * 2 * 256 * 64 * 2;
constexpr size_t WS_PSM = 22 * MiB;
constexpr size_t WS_CB = 24 * MiB;
constexpr size_t WS_PGATE = 25 * MiB;
constexpr size_t WS_PGDN = 57 * MiB;
constexpr size_t WS_PMLA = 93 * MiB;
constexpr size_t WS_PRW = 104 * MiB;
constexpr size_t WS_OGDN = 93 * MiB;
constexpr size_t WS_OMLA = 105 * MiB;
constexpr size_t WS_Y = 117 * MiB;
constexpr size_t WS_RS = 133 * MiB;
constexpr size_t WS_RD = 157 * MiB;
constexpr size_t WS_XB = 133 * MiB;
constexpr size_t WS_Q = 207 * MiB;
constexpr size_t WS_K = 225 * MiB;
constexpr size_t WS_VT = 243 * MiB;
constexpr size_t WS_MIX = 207 * MiB;
constexpr size_t WS_END = 255 * MiB;
constexpr int RS_REC = 384, RD_REC = 400;
constexpr size_t RD_DIR = (size_t)BATCH * 4 * SEQ * RD_REC;
constexpr int CW_BAR = 4096;
constexpr int CW_QUEUE = 16384;

constexpr int NWAVES = 8;
constexpr int RING_OFF = 0, RING_BYTES = 131072, LDSCTL_OFF = RING_BYTES, MISC_OFF = LDSCTL_OFF + 320, LDS_BYTES = 147456;
static_assert(pg8::TIDTAB_OFF == MISC_OFF + 512 && RING_OFF == 0, "LDS map");
constexpr int NPHASE = 12;

__device__ __forceinline__ float bf2f(bf16 v) { return __uint_as_float(((unsigned)v) << 16); }
__device__ __forceinline__ float wave_sum(float v) {
#pragma unroll
    for (int o = 1; o < 64; o <<= 1) v += __shfl_xor(v, o);
    return v;
}
__device__ __forceinline__ float siluf(float x) { return x * __builtin_amdgcn_rcpf(1.f + __expf(-x)); }
__device__ __forceinline__ float sigmoidf_(float x) { return __builtin_amdgcn_rcpf(1.f + __expf(-x)); }
__device__ __forceinline__ float softplusf_(float x) { return x > 20.f ? x : log1pf(__expf(x)); }

struct Args { const void* in[24]; float* out; unsigned char* ws; int ph_lo, ph_hi; };

struct Frame {
    LAS unsigned char* lds;
    volatile LAS unsigned* MISC;
    gu32* ctl;
    int tid, lane, wave, vcu, G;
    unsigned char* ws;
    float* out;
    volatile LAS const unsigned long long* ptab;
};
__device__ __forceinline__ const void* inptr(const Frame& F, int k) {
    const unsigned long long v = F.ptab[k];
    const unsigned lo = __builtin_amdgcn_readfirstlane((unsigned)v), hi = __builtin_amdgcn_readfirstlane((unsigned)(v >> 32));
    return (const void*)(GAS const void*)(((unsigned long long)hi << 32) | lo);
}

__device__ __forceinline__ void tr_item(const float* W, int K, int ldsrc, int scol, int nvalid, bf16* WT, const float* gs, LAS float* scr, int kb, int lane) {
    const int k0 = 64 * kb;
#pragma unroll 8
    for (int i = 0; i < 32; ++i) { const int kk = 2 * i + (lane >> 5), n = lane & 31; float v = 0.f;
        if (n < nvalid) { v = W[(size_t)(k0 + kk) * ldsrc + scol + n]; if (gs) v *= gs[k0 + kk]; }
        scr[kk * 33 + n] = v; }
    LDS_WAIT(); asm volatile("" ::: "memory");
    const int c = lane & 7;
#pragma unroll
    for (int j = 0; j < 4; ++j) { const int n = (lane >> 3) + 8 * j; const LAS float* s = scr + (8 * c) * 33 + n;
        v4u o; o.x = pk2(s[0 * 33], s[1 * 33]); o.y = pk2(s[2 * 33], s[3 * 33]); o.z = pk2(s[4 * 33], s[5 * 33]); o.w = pk2(s[6 * 33], s[7 * 33]);
        *(GAS v4u*)(WT + (size_t)n * K + k0 + 8 * c) = o; }
    LDS_WAIT(); asm volatile("" ::: "memory");
}
__device__ __forceinline__ void p0_prologue(Frame& F) {
    LAS float* scr = (LAS float*)(F.lds + RING_OFF + F.wave * 16384);
    const int gw = F.vcu * NWAVES + F.wave, NGW = F.G * NWAVES;
    constexpr int I_IN = 112 * 16, I_OUT = 32 * 16, I_UQ = 18 * 3, I_UKV = 24 * 2, I_W2 = 16, I_A2 = 16, I_L = I_IN + I_OUT + I_UQ + I_UKV + I_W2 + I_A2;
    for (int it = gw; it < 2 * I_L; it += NGW) {
        const int l = it / I_L; int r = it % I_L;
        if (r < I_IN) { const int nb = r >> 4, kb = r & 15, n0 = 32 * nb; int scol, nv;
            if (n0 < 2176) { scol = n0; nv = 32; } else if (n0 < 3424) { scol = n0 + 24; nv = 32; } else if (n0 == 3424) { scol = 2176; nv = 24; } else { scol = 0; nv = 0; }
            tr_item((const float*)inptr(F, 3) + (size_t)l * D * NIN, D, NIN, scol, nv, (bf16*)(F.ws + WS_WIN) + ((size_t)l * NP + n0) * D, (const float*)inptr(F, 2) + l * D, scr, kb, F.lane); continue; }
        r -= I_IN;
        if (r < I_OUT) { const int nb = r >> 4, kb = r & 15;
            tr_item((const float*)inptr(F, 22) + (size_t)l * D * D, D, D, 32 * nb, 32, (bf16*)(F.ws + WS_WOUT) + ((size_t)l * D + 32 * nb) * D, nullptr, scr, kb, F.lane); continue; }
        r -= I_OUT;
        if (r < I_UQ) { const int nb = r / 3, kb = r % 3;
            tr_item((const float*)inptr(F, 9) + (size_t)l * 192 * 576, 192, 576, 32 * nb, 32, (bf16*)(F.ws + WS_WSMALL + OFF_WUQ) + ((size_t)l * 576 + 32 * nb) * 192, (const float*)inptr(F, 8) + l * 192, scr, kb, F.lane); continue; }
        r -= I_UQ;
        if (r < I_UKV) { const int nb = r >> 1, kb = r & 1;
            tr_item((const float*)inptr(F, 11) + (size_t)l * 128 * 768, 128, 768, 32 * nb, 32, (bf16*)(F.ws + WS_WSMALL + OFF_WUKV) + ((size_t)l * 768 + 32 * nb) * 128, (const float*)inptr(F, 10) + l * 128, scr, kb, F.lane); continue; }
        r -= I_UKV;
        if (r < I_W2) { const int e = r >> 3, nb = r & 7;
            tr_item((const float*)inptr(F, 14) + ((size_t)l * 2 + e) * 64 * 256, 64, 256, 32 * nb, 32, (bf16*)(F.ws + WS_WSMALL + OFF_W2T) + (((size_t)l * 2 + e) * 256 + 32 * nb) * 64, nullptr, scr, 0, F.lane); continue; }
        r -= I_W2;
        { const int e = r >> 3, nb = r & 7;
            tr_item((const float*)inptr(F, 16) + ((size_t)l * 2 + e) * 64 * 256, 64, 256, 32 * nb, 32, (bf16*)(F.ws + WS_WSMALL + OFF_A2T) + (((size_t)l * 2 + e) * 256 + 32 * nb) * 64, nullptr, scr, 0, F.lane); }
    }
    const float* x = (const float*)inptr(F, 0); bf16* xb = (bf16*)(F.ws + WS_XB); float* rowss = (float*)(F.ws + WS_ROWSS);
    for (int m = gw; m < M; m += NGW) {
        const GAS f32x4* xr = (const GAS f32x4*)(x + (size_t)m * D) + F.lane;
        GAS unsigned long long* o8 = (GAS unsigned long long*)(xb + (size_t)m * D) + F.lane; float s = 0.f;
#pragma unroll
        for (int j = 0; j < 4; ++j) { const f32x4 v = xr[64 * j]; s += (v.x * v.x + v.y * v.y) + (v.z * v.z + v.w * v.w);
            o8[64 * j] = (unsigned long long)pk2(v.x, v.y) | ((unsigned long long)pk2(v.z, v.w) << 32); }
        s = wave_sum(s);
        if (F.lane < 16) rowss[(size_t)m * 16 + F.lane] = F.lane == 0 ? s : 0.f;
    }
}
__device__ __forceinline__ void p5_final(Frame& F) {
    const int gw = F.vcu * NWAVES + F.wave, NGW = F.G * NWAVES;
    const float* rowss = (const float*)(F.ws + WS_ROWSS); const float* g = (const float*)inptr(F, 23);
    f32x4 gv[4];
#pragma unroll
    for (int j = 0; j < 4; ++j) gv[j] = ((const f32x4*)g)[F.lane + 64 * j];
    for (int m = gw; m < M; m += NGW) {
        float ss = F.lane < 16 ? rowss[(size_t)m * 16 + F.lane] : 0.f;
        ss = wave_sum(ss);
        const float rstd = rsqrtf(ss * (1.f / D) + NORM_EPS);
        GAS f32x4* xr = (GAS f32x4*)(F.out + (size_t)m * D) + F.lane;
#pragma unroll
        for (int j = 0; j < 4; ++j) { f32x4 v = xr[64 * j]; v = v * rstd * gv[j]; xr[64 * j] = v; }
    }
}
typedef float f32x16 __attribute__((ext_vector_type(16)));
typedef unsigned long long u64_t;
__device__ __forceinline__ bf16x8 mk_bf16x8(u64_t lo, u64_t hi) { typedef u64_t u64x2 __attribute__((ext_vector_type(2))); u64x2 v = {lo, hi}; return __builtin_bit_cast(bf16x8, v); }

constexpr int AT_KP = 208, AT_VP = 136, AT_KBYTES = 64 * AT_KP, AT_VBYTES = 64 * AT_VP, AT_BUF = AT_KBYTES + AT_VBYTES;
__device__ __forceinline__ float at_max3(float a, float b, float c) { float r; asm("v_max3_f32 %0, %1, %2, %3" : "=v"(r) : "v"(a), "v"(b), "v"(c)); return r; }
__device__ __forceinline__ void attn_unit(Frame& F, int unit) {
    const int bh = unit >> 3, qb = unit & 7, b = bh / 6, h = bh % 6;
    const int tid = F.tid, lane = F.lane, wave = F.wave, r32 = lane & 31, hi = lane >> 5;
    const bf16* Qg = (const bf16*)(F.ws + WS_Q) + ((size_t)bh * SEQ + qb * 256 + wave * 32 + r32) * 96;
    const bf16* Kg = (const bf16*)(F.ws + WS_K) + (size_t)bh * SEQ * 96;
    const bf16* Vg = (const bf16*)(F.ws + WS_VT) + (size_t)bh * 64 * SEQ;
    LAS unsigned char* lds = F.lds + RING_OFF;
    bf16x8 qf[6];
#pragma unroll
    for (int s = 0; s < 6; ++s) qf[s] = *(const bf16x8*)(Qg + 16 * s + 8 * hi);
    const int kr0 = tid / 12, kc0 = tid % 12, kr1 = (512 + tid) / 12, kc1 = (512 + tid) % 12, vd = tid >> 3, vc = tid & 7;
    const bool has1 = tid < 256;
    v4u ka0, ka1 = {0u, 0u, 0u, 0u}, va, kb0, kb1 = {0u, 0u, 0u, 0u}, vb;
#define AT_LOAD(K0, K1, V_, t0) do { K0 = *(const v4u*)(Kg + (size_t)((t0) + kr0) * 96 + kc0 * 8); if (has1) K1 = *(const v4u*)(Kg + (size_t)((t0) + kr1) * 96 + kc1 * 8); \
        V_ = *(const v4u*)(Vg + (size_t)vd * SEQ + (t0) + vc * 8); } while (0)
#define AT_STORE(K0, K1, V_, buf) do { LAS unsigned char* bb_ = lds + (buf) * AT_BUF; *(LAS v4u*)(bb_ + kr0 * AT_KP + kc0 * 16) = K0; if (has1) *(LAS v4u*)(bb_ + kr1 * AT_KP + kc1 * 16) = K1; \
        LAS u64_t* vp_ = (LAS u64_t*)(bb_ + AT_KBYTES + vd * AT_VP + vc * 16); vp_[0] = (u64_t)V_.x | ((u64_t)V_.y << 32); vp_[1] = (u64_t)V_.z | ((u64_t)V_.w << 32); } while (0)
    AT_LOAD(ka0, ka1, va, 0); AT_STORE(ka0, ka1, va, 0);
    AT_LOAD(ka0, ka1, va, 64);
    __syncthreads();
    f32x16 o0 = {}, o1 = {};
    float mrun = -1e30f, lsum = 0.f;
    constexpr int NT = SEQ / 64;
    auto tile = [&](int t) {
        LAS unsigned char* bb = lds + (t % 3) * AT_BUF;
        f32x16 p0 = {}, p1 = {};
        { const LAS unsigned char* kb = bb + r32 * AT_KP + hi * 16;
#pragma unroll
          for (int s = 0; s < 6; ++s) {
              const bf16x8 a0 = *(const LAS bf16x8*)(kb + 32 * s), a1 = *(const LAS bf16x8*)(kb + 32 * AT_KP + 32 * s);
              p0 = __builtin_amdgcn_mfma_f32_32x32x16_bf16(a0, qf[s], p0, 0, 0, 0);
              p1 = __builtin_amdgcn_mfma_f32_32x32x16_bf16(a1, qf[s], p1, 0, 0, 0); } }
        float ma = at_max3(p0[0], p0[1], p1[0]), mb = at_max3(p0[2], p0[3], p1[1]); ma = at_max3(ma, p1[2], p1[3]);
#pragma unroll
        for (int r = 4; r < 16; r += 4) { ma = at_max3(ma, p0[r], p0[r + 1]); mb = at_max3(mb, p0[r + 2], p0[r + 3]); ma = at_max3(ma, p1[r], p1[r + 1]); mb = at_max3(mb, p1[r + 2], p1[r + 3]); }
        float mloc = at_max3(ma, mb, mrun);
        { const auto rr = __builtin_amdgcn_permlane32_swap(__float_as_uint(mloc), __float_as_uint(mloc), false, false); mloc = at_max3(__uint_as_float(rr[0]), __uint_as_float(rr[1]), mloc); }
        const float mnew = mloc, alpha = __builtin_amdgcn_exp2f(mrun - mnew);
        mrun = mnew; lsum *= alpha;
#pragma unroll
        for (int r = 0; r < 16; ++r) { o0[r] *= alpha; o1[r] *= alpha; }
        float ps = 0.f;
#pragma unroll
        for (int r = 0; r < 16; ++r) { p0[r] = __builtin_amdgcn_exp2f(p0[r] - mnew); p1[r] = __builtin_amdgcn_exp2f(p1[r] - mnew); ps += p0[r] + p1[r]; }
        lsum += ps;
        v4u pk[4];
#pragma unroll
        for (int s2 = 0; s2 < 2; ++s2) {
            pk[s2] = (v4u){pg8::cvt_pk_bf16(p0[8 * s2], p0[8 * s2 + 1]), pg8::cvt_pk_bf16(p0[8 * s2 + 2], p0[8 * s2 + 3]), pg8::cvt_pk_bf16(p0[8 * s2 + 4], p0[8 * s2 + 5]), pg8::cvt_pk_bf16(p0[8 * s2 + 6], p0[8 * s2 + 7])};
            pk[2 + s2] = (v4u){pg8::cvt_pk_bf16(p1[8 * s2], p1[8 * s2 + 1]), pg8::cvt_pk_bf16(p1[8 * s2 + 2], p1[8 * s2 + 3]), pg8::cvt_pk_bf16(p1[8 * s2 + 4], p1[8 * s2 + 5]), pg8::cvt_pk_bf16(p1[8 * s2 + 6], p1[8 * s2 + 7])};
        }
        { const LAS unsigned char* vb_ = bb + AT_KBYTES + r32 * AT_VP + hi * 8;
#pragma unroll
          for (int ks = 0; ks < 4; ++ks) {
              const bf16x8 pb = __builtin_bit_cast(bf16x8, pk[ks]);
              const bf16x8 v0 = mk_bf16x8(*(const LAS u64_t*)(vb_ + ks * 32), *(const LAS u64_t*)(vb_ + ks * 32 + 16));
              const bf16x8 v1 = mk_bf16x8(*(const LAS u64_t*)(vb_ + 32 * AT_VP + ks * 32), *(const LAS u64_t*)(vb_ + 32 * AT_VP + ks * 32 + 16));
              o0 = __builtin_amdgcn_mfma_f32_32x32x16_bf16(v0, pb, o0, 0, 0, 0);
              o1 = __builtin_amdgcn_mfma_f32_32x32x16_bf16(v1, pb, o1, 0, 0, 0); } }
    };
    for (int t = 0; t < NT; t += 2) {
        if (t + 2 < NT) AT_LOAD(kb0, kb1, vb, (t + 2) * 64);
        tile(t);
        AT_STORE(ka0, ka1, va, (t + 1) % 3);
        __syncthreads();
        if (t + 3 < NT) AT_LOAD(ka0, ka1, va, (t + 3) * 64);
        tile(t + 1);
        if (t + 2 < NT) AT_STORE(kb0, kb1, vb, (t + 2) % 3);
        __syncthreads();
    }
#undef AT_LOAD
#undef AT_STORE
    lsum += __shfl_xor(lsum, 32);
    const float inv = 1.f / lsum;
    bf16* Og = (bf16*)(F.ws + WS_OMLA) + ((size_t)b * SEQ + qb * 256 + wave * 32 + r32) * 384 + h * 64 + 4 * hi;
#pragma unroll
    for (int rg = 0; rg < 4; ++rg) {
        *(u64_t*)(Og + 8 * rg) = (u64_t)pg8::cvt_pk_bf16(o0[4 * rg] * inv, o0[4 * rg + 1] * inv) | ((u64_t)pg8::cvt_pk_bf16(o0[4 * rg + 2] * inv, o0[4 * rg + 3] * inv) << 32);
        *(u64_t*)(Og + 32 + 8 * rg) = (u64_t)pg8::cvt_pk_bf16(o1[4 * rg] * inv, o1[4 * rg + 1] * inv) | ((u64_t)pg8::cvt_pk_bf16(o1[4 * rg + 2] * inv, o1[4 * rg + 3] * inv) << 32);
    }
}

constexpr int CW_FLAG = 32768;
__device__ __forceinline__ void partner_sync(Frame& F, gu32* mine, gu32* theirs) {
    asm volatile("s_waitcnt vmcnt(0)" ::: "memory");
    __syncthreads();
    if (F.tid == 0) {
        __builtin_amdgcn_fence(__ATOMIC_RELEASE, "agent");
        asm volatile("s_waitcnt vmcnt(0)" ::: "memory");
        __hip_atomic_store(mine, 1u, RLX_AGENT);
        unsigned spins = 0;
        while (__hip_atomic_load(theirs, RLX_AGENT) == 0u) { __builtin_amdgcn_s_sleep(4); if (++spins > (1u << 22)) break; }
        __builtin_amdgcn_fence(__ATOMIC_ACQUIRE, "agent");
        asm volatile("s_waitcnt vmcnt(0)" ::: "memory");
    }
    __syncthreads();
}
constexpr int RW_STEP = 1440, RW_CH = 32, RW_BUF = RW_CH * RW_STEP;
constexpr int RW_Y = 2 * RW_BUF;
static_assert(RW_Y + 2 * 4096 <= RING_BYTES, "RWKV LDS map");
__device__ __forceinline__ float dpp_xor1(float x) { return __builtin_bit_cast(float, __builtin_amdgcn_update_dpp(0, __builtin_bit_cast(int, x), 0xB1, 0xF, 0xF, true)); }
__device__ __forceinline__ float dpp_xor2(float x) { return __builtin_bit_cast(float, __builtin_amdgcn_update_dpp(0, __builtin_bit_cast(int, x), 0x4E, 0xF, 0xF, true)); }
__device__ __forceinline__ float dpp_hmir(float x) { return __builtin_bit_cast(float, __builtin_amdgcn_update_dpp(0, __builtin_bit_cast(int, x), 0x141, 0xF, 0xF, true)); }
__device__ __forceinline__ float dpp_rmir(float x) { return __builtin_bit_cast(float, __builtin_amdgcn_update_dpp(0, __builtin_bit_cast(int, x), 0x140, 0xF, 0xF, true)); }
template <int SKIP> __device__ __forceinline__ void rwkv_unit(Frame& F, int unit, gu32* flags) {
    const int bh = unit >> 2, rowhalf = (unit >> 1) & 1, dir = unit & 1, b = bh >> 2, h = bh & 3;
    const int tid = F.tid, lane = F.lane, ri = lane >> 4, cs = lane & 15, row = 4 * F.wave + ri;
    const bool stager = true;
    const unsigned char* Rs = F.ws + WS_RS + (size_t)bh * SEQ * RS_REC;
    const unsigned char* Rd = F.ws + WS_RD + dir * RD_DIR + (size_t)bh * SEQ * RD_REC;
    LAS unsigned char* lds = F.lds + RING_OFF;
    const int ss = tid >> 4, sp = tid & 15;
    u64_t g_kk = 0, g_r = 0, g_lam = 0, g_b = 0, g_k = 0, g_v = 0, g_s = 0;
#define RW_ISSUE(c_) do { const int n_ = (c_) * RW_CH + ss, t_ = dir ? SEQ - 1 - n_ : n_; const unsigned char* rs_ = Rs + (size_t)t_ * RS_REC; const unsigned char* rd_ = Rd + (size_t)t_ * RD_REC; \
        g_kk = *(const u64_t*)(rs_ + 8 * sp); g_r = *(const u64_t*)(rs_ + 256 + 8 * sp); g_lam = *(const u64_t*)(rd_ + 8 * sp); g_b = *(const u64_t*)(rd_ + 128 + 8 * sp); g_k = *(const u64_t*)(rd_ + 256 + 8 * sp); \
        if (sp < 8) g_v = *(const u64_t*)(rs_ + 128 + 64 * rowhalf + 8 * sp); if (sp == 8) g_s = *(const u64_t*)(rd_ + 384); } while (0)
#define RW_BF(x, j) __uint_as_float(((unsigned)((x) >> (16 * (j)))) << 16)
#define RW_STAGE(buf_) do { LAS unsigned char* d_ = lds + (buf_) * RW_BUF + ss * RW_STEP + 16 * sp; f32x4 w_, t4_; \
        w_[0] = __builtin_amdgcn_exp2f(-LOG2E * __half2float(__ushort_as_half((unsigned short)(g_lam)))); w_[1] = __builtin_amdgcn_exp2f(-LOG2E * __half2float(__ushort_as_half((unsigned short)(g_lam >> 16)))); \
        w_[2] = __builtin_amdgcn_exp2f(-LOG2E * __half2float(__ushort_as_half((unsigned short)(g_lam >> 32)))); w_[3] = __builtin_amdgcn_exp2f(-LOG2E * __half2float(__ushort_as_half((unsigned short)(g_lam >> 48)))); \
        *(LAS f32x4*)d_ = w_; \
        t4_ = (f32x4){RW_BF(g_r, 0), RW_BF(g_r, 1), RW_BF(g_r, 2), RW_BF(g_r, 3)}; *(LAS f32x4*)(d_ + 256) = w_ * t4_; \
        t4_ = (f32x4){RW_BF(g_kk, 0), RW_BF(g_kk, 1), RW_BF(g_kk, 2), RW_BF(g_kk, 3)}; *(LAS f32x4*)(d_ + 512) = -t4_; \
        t4_ = (f32x4){RW_BF(g_b, 0), RW_BF(g_b, 1), RW_BF(g_b, 2), RW_BF(g_b, 3)}; *(LAS f32x4*)(d_ + 768) = t4_; \
        t4_ = (f32x4){RW_BF(g_k, 0), RW_BF(g_k, 1), RW_BF(g_k, 2), RW_BF(g_k, 3)}; *(LAS f32x4*)(d_ + 1024) = t4_; \
        if (sp < 8) { t4_ = (f32x4){RW_BF(g_v, 0), RW_BF(g_v, 1), RW_BF(g_v, 2), RW_BF(g_v, 3)}; *(LAS f32x4*)(d_ + 1280) = t4_; } \
        if (sp == 8) *(LAS u64_t*)(lds + (buf_) * RW_BUF + ss * RW_STEP + 1408) = g_s; } while (0)
    f32x4 S0 = {0.f, 0.f, 0.f, 0.f};
    if (stager) { RW_ISSUE(0); RW_STAGE(0); }
    __syncthreads();
    bf16* Yg = (bf16*)(F.ws + WS_Y) + (size_t)b * SEQ * 256 + h * 64 + 32 * rowhalf;
    const int NCH = SEQ / RW_CH;
    for (int c = 0; c < NCH; ++c) {
        LAS float* ybuf = (LAS float*)(lds + RW_Y + (c & 1) * 4096);
        if (stager && c + 1 < NCH) RW_ISSUE(c + 1);
        unsigned short yold[2] = {0, 0};
        if (c >= NCH / 2) {
#pragma unroll
            for (int k = 0; k < 2; ++k) { const int o = tid + 512 * k, n = c * RW_CH + (o >> 5), t = dir ? SEQ - 1 - n : n; yold[k] = Yg[(size_t)t * 256 + (o & 31)]; } }
        { const LAS unsigned char* cb_ = lds + (c & 1) * RW_BUF + 16 * cs;
          const LAS unsigned char* vb_ = lds + (c & 1) * RW_BUF + 1280 + 4 * row;
#pragma unroll 4
          for (int s = 0; s < RW_CH; ++s) {
              const LAS unsigned char* p = cb_ + ((SKIP & 2) ? 0 : s) * RW_STEP;
              const f32x4 w = *(const LAS f32x4*)p, wr = *(const LAS f32x4*)(p + 256), nk = *(const LAS f32x4*)(p + 512), bb = *(const LAS f32x4*)(p + 768), kv = *(const LAS f32x4*)(p + 1024);
              typedef float f2 __attribute__((ext_vector_type(2)));
              const float v = *(const LAS float*)(vb_ + s * RW_STEP); const f2 brkr = *(const LAS f2*)(lds + (c & 1) * RW_BUF + s * RW_STEP + 1408);
              float sa0 = (S0[0] * nk[0] + S0[1] * nk[1]) + (S0[2] * nk[2] + S0[3] * nk[3]);
              float ym0 = (S0[0] * wr[0] + S0[1] * wr[1]) + (S0[2] * wr[2] + S0[3] * wr[3]);
              if (!(SKIP & 1)) {
              sa0 += dpp_xor1(sa0); ym0 += dpp_xor1(ym0);
              sa0 += dpp_xor2(sa0); ym0 += dpp_xor2(ym0);
              sa0 += dpp_hmir(sa0); ym0 += dpp_hmir(ym0);
              sa0 += dpp_rmir(sa0); ym0 += dpp_rmir(ym0); }
              S0 = S0 * w + (sa0 * bb + v * kv);
              if (cs == 0) ybuf[s * 32 + row] = ym0 + sa0 * brkr[0] + v * brkr[1];
          } }
        if (stager && c + 1 < NCH) RW_STAGE((c + 1) & 1);
        __syncthreads();
#pragma unroll
        for (int k = 0; k < 2; ++k) { const int o = tid + 512 * k, n = c * RW_CH + (o >> 5), t = dir ? SEQ - 1 - n : n;
            float y = ybuf[o]; if (c >= NCH / 2) y += bf2f(yold[k]);
            Yg[(size_t)t * 256 + (o & 31)] = (bf16)f2bf(y); }
        if (c == NCH / 2 - 1) partner_sync(F, flags + 64 * unit, flags + 64 * (unit ^ 1));
    }
#undef RW_ISSUE
#undef RW_STAGE
#undef RW_BF
    __syncthreads();
}

constexpr int GP = 144;
constexpr int G_Q = 0, G_K = 9216, G_V = 18432, G_KT = 27648, G_P = 36864, G_A = 46080, G_SM = 63488, G_GROUP = 64512;
constexpr int G_T = 92160;
constexpr int G_RAW = 65536;
constexpr int G_CW = 133120;
static_assert(2 * G_GROUP <= RING_BYTES && G_CW + 3840 <= LDS_BYTES && G_CW >= MISC_OFF + 1024, "GDN LDS map");
__device__ __forceinline__ bf16x8 ld2x8(const LAS unsigned char* p) { return mk_bf16x8(*(const LAS u64_t*)p, *(const LAS u64_t*)(p + 32)); }
__device__ __forceinline__ bf16x8 pack_acc(const f32x4& a, const f32x4& b) {
    v4u w; w.x = pg8::cvt_pk_bf16(a[0], a[1]); w.y = pg8::cvt_pk_bf16(a[2], a[3]); w.z = pg8::cvt_pk_bf16(b[0], b[1]); w.w = pg8::cvt_pk_bf16(b[2], b[3]); return __builtin_bit_cast(bf16x8, w); }
__device__ __forceinline__ void split_acc(const f32x4& a, const f32x4& b, bf16x8& hi, bf16x8& lo) {
    v4u wh; wh.x = pg8::cvt_pk_bf16(a[0], a[1]); wh.y = pg8::cvt_pk_bf16(a[2], a[3]); wh.z = pg8::cvt_pk_bf16(b[0], b[1]); wh.w = pg8::cvt_pk_bf16(b[2], b[3]);
    f32x4 ra, rb;
    ra[0] = a[0] - __uint_as_float(wh.x << 16); ra[1] = a[1] - __uint_as_float(wh.x & 0xffff0000u); ra[2] = a[2] - __uint_as_float(wh.y << 16); ra[3] = a[3] - __uint_as_float(wh.y & 0xffff0000u);
    rb[0] = b[0] - __uint_as_float(wh.z << 16); rb[1] = b[1] - __uint_as_float(wh.z & 0xffff0000u); rb[2] = b[2] - __uint_as_float(wh.w << 16); rb[3] = b[3] - __uint_as_float(wh.w & 0xffff0000u);
    hi = __builtin_bit_cast(bf16x8, wh); lo = pack_acc(ra, rb);
}
__device__ __forceinline__ void hilo4(const f32x4& a, u64_t& hi, u64_t& lo) {
    const unsigned h0 = pg8::cvt_pk_bf16(a[0], a[1]), h1 = pg8::cvt_pk_bf16(a[2], a[3]);
    const float r0 = a[0] - __uint_as_float(h0 << 16), r1 = a[1] - __uint_as_float(h0 & 0xffff0000u), r2 = a[2] - __uint_as_float(h1 << 16), r3 = a[3] - __uint_as_float(h1 & 0xffff0000u);
    hi = (u64_t)h0 | ((u64_t)h1 << 32); lo = (u64_t)pg8::cvt_pk_bf16(r0, r1) | ((u64_t)pg8::cvt_pk_bf16(r2, r3) << 32);
}
typedef _Float16 f16x8 __attribute__((ext_vector_type(8)));
__device__ __forceinline__ f16x8 pack_acc_f16(const f32x4& a, const f32x4& b) { return (f16x8){(_Float16)a[0], (_Float16)a[1], (_Float16)a[2], (_Float16)a[3], (_Float16)b[0], (_Float16)b[1], (_Float16)b[2], (_Float16)b[3]}; }
template <int SKIP> __device__ __forceinline__ void gdn_unit3(Frame& F, int l, int unit, gu32* flags) {
    const int bh = unit >> 1, dir = unit & 1, b = bh / 6, h = bh % 6;
    const int tid = F.tid, lane = F.lane, wave = F.wave;
    const bf16* Pgdn = (const bf16*)(F.ws + WS_PGDN) + (size_t)b * SEQ * 1152 + h * 64; const float* Psm = (const float*)(F.ws + WS_PSM) + (size_t)b * SEQ * 32;
    bf16* Og = (bf16*)(F.ws + WS_OGDN) + (size_t)b * SEQ * 384 + h * 64;
    LAS unsigned char* gb = F.lds + RING_OFF;
    LAS float* cwl = (LAS float*)(F.lds + G_CW);
    LAS float* sm = (LAS float*)(gb + G_SM);
    { const float* conv_w = (const float*)inptr(F, 4) + (size_t)l * 5 * 1152;
      for (int i = tid; i < 960; i += 512) { const int tn = i / 320, tap = (i % 320) / 64, ch = i % 64; cwl[i] = conv_w[tap * 1152 + tn * 384 + h * 64 + ch]; } }
    const float al = -__expf(((const float*)inptr(F, 5))[l * 12 + dir * 6 + h]), dtb = ((const float*)inptr(F, 6))[l * 12 + dir * 6 + h];
    f32x4 Sacc[4];
#pragma unroll
    for (int i = 0; i < 4; ++i) Sacc[i] = (f32x4){0.f, 0.f, 0.f, 0.f};
    const int ci = tid >> 3, cg = tid & 7;
#define GDN_RAW_STAGE(cc_, first_, nthr_) do { const int tlo_ = (dir ? SEQ - 64 * (cc_) - 64 : 64 * (cc_)) - 2; \
        for (int pc_ = (first_); pc_ < 68 * 24; pc_ += (nthr_)) { const int rr_ = pc_ / 24, sg_ = pc_ % 24, tt_ = tlo_ + rr_; v4u x_ = {0u, 0u, 0u, 0u}; \
            if (!(SKIP & 1) && tt_ >= 0 && tt_ < SEQ) x_ = *(const v4u*)(Pgdn + (size_t)tt_ * 1152 + (sg_ >> 3) * 384 + 8 * (sg_ & 7)); \
            *(LAS v4u*)(gb + G_RAW + rr_ * 384 + 16 * sg_) = x_; } } while (0)
#define GDN_WRITEOUT(cc_) do { if (!(SKIP & 4)) { const int t_ = dir ? SEQ - 1 - 64 * (cc_) - ci : 64 * (cc_) + ci; bf16* op_ = Og + (size_t)t_ * 384 + 8 * cg; \
            const LAS f32x4* src_ = (const LAS f32x4*)(gb + G_A + (ci * 68 + 8 * cg) * 4); f32x4 o0_ = src_[0], o1_ = src_[1]; \
            if ((cc_) >= SEQ / 128) { const v4u p0_ = *(const v4u*)op_; \
                o0_ += (f32x4){__uint_as_float(p0_.x << 16), __uint_as_float(p0_.x & 0xffff0000u), __uint_as_float(p0_.y << 16), __uint_as_float(p0_.y & 0xffff0000u)}; \
                o1_ += (f32x4){__uint_as_float(p0_.z << 16), __uint_as_float(p0_.z & 0xffff0000u), __uint_as_float(p0_.w << 16), __uint_as_float(p0_.w & 0xffff0000u)}; } \
            v4u w0_; w0_.x = pg8::cvt_pk_bf16(o0_[0], o0_[1]); w0_.y = pg8::cvt_pk_bf16(o0_[2], o0_[3]); w0_.z = pg8::cvt_pk_bf16(o1_[0], o1_[1]); w0_.w = pg8::cvt_pk_bf16(o1_[2], o1_[3]); \
            *(v4u*)op_ = w0_; } } while (0)
    GDN_RAW_STAGE(0, tid, 512);
    __syncthreads();
    for (int c = 0; c < SEQ / 64; ++c) {
        if (c > 0) GDN_WRITEOUT(c - 1);
        if (c == SEQ / 128) partner_sync(F, flags + 64 * unit, flags + 64 * (unit ^ 1));
        if (wave == 0) {
            const int t = dir ? SEQ - 1 - 64 * c - lane : 64 * c + lane;
            const float a = Psm[(size_t)t * 32 + dir * 6 + h], bt = Psm[(size_t)t * 32 + 12 + dir * 6 + h];
            float x = al * softplusf_(a + dtb);
#pragma unroll
            for (int off = 1; off < 64; off <<= 1) { const float y = __shfl_up(x, off); if (lane >= off) x += y; }
            const float last = __shfl(x, 63);
            sm[lane] = x; sm[64 + lane] = sigmoidf_(bt); sm[128 + lane] = __expf(x); sm[192 + lane] = __expf(last - x);
        }
        { float acc[3][8];
#pragma unroll
          for (int tn = 0; tn < 3; ++tn)
#pragma unroll
              for (int j = 0; j < 8; ++j) acc[tn][j] = 0.f;
          const int rr0 = dir ? 63 - ci : ci;
#pragma unroll
          for (int tap = 0; tap < 5; ++tap) {
#pragma unroll
              for (int tn = 0; tn < 3; ++tn) { const v4u x0 = *(const LAS v4u*)(gb + G_RAW + (rr0 + tap) * 384 + tn * 128 + 16 * cg); const LAS float* w = cwl + tn * 320 + tap * 64 + 8 * cg; const f32x4 w0 = *(const LAS f32x4*)w, w1 = *(const LAS f32x4*)(w + 4);
                  acc[tn][0] += w0[0] * __uint_as_float(x0[0] << 16); acc[tn][1] += w0[1] * __uint_as_float(x0[0] & 0xffff0000u); acc[tn][2] += w0[2] * __uint_as_float(x0[1] << 16); acc[tn][3] += w0[3] * __uint_as_float(x0[1] & 0xffff0000u);
                  acc[tn][4] += w1[0] * __uint_as_float(x0[2] << 16); acc[tn][5] += w1[1] * __uint_as_float(x0[2] & 0xffff0000u); acc[tn][6] += w1[2] * __uint_as_float(x0[3] << 16); acc[tn][7] += w1[3] * __uint_as_float(x0[3] & 0xffff0000u); }
              asm volatile("" ::: "memory"); }
          float sq = 0.f, sk = 0.f;
#pragma unroll
          for (int j = 0; j < 8; ++j) { acc[0][j] = siluf(acc[0][j]); acc[1][j] = siluf(acc[1][j]); acc[2][j] = siluf(acc[2][j]); sq += acc[0][j] * acc[0][j]; sk += acc[1][j] * acc[1][j]; }
          sq += dpp_xor1(sq); sk += dpp_xor1(sk); sq += dpp_xor2(sq); sk += dpp_xor2(sk); sq += dpp_hmir(sq); sk += dpp_hmir(sk);
          const float rq = rsqrtf(sq + 1e-6f) * 0.125f, rk = rsqrtf(sk + 1e-6f);
          v4u wq, wk, wv;
#pragma unroll
          for (int q = 0; q < 4; ++q) { wq[q] = pg8::cvt_pk_bf16(acc[0][2 * q] * rq, acc[0][2 * q + 1] * rq); wk[q] = pg8::cvt_pk_bf16(acc[1][2 * q] * rk, acc[1][2 * q + 1] * rk); wv[q] = pg8::cvt_pk_bf16(acc[2][2 * q], acc[2][2 * q + 1]); }
          LAS unsigned char* row = gb + ci * GP + 16 * cg;
          *(LAS v4u*)(row + G_Q) = wq; *(LAS v4u*)(row + G_K) = wk; *(LAS v4u*)(row + G_V) = wv;
#pragma unroll
          for (int j = 0; j < 8; ++j) *(LAS bf16*)(gb + G_KT + (8 * cg + j) * GP + 2 * ci) = (bf16)((j & 1) ? (wk[j >> 1] >> 16) : (wk[j >> 1] & 0xffffu)); }
        __syncthreads();
        { const int ti = (wave >> 1) & 1, tj = wave & 1, r32 = lane & 31, hi = lane >> 5; const bool isP = wave >= 4;
          f32x16 acc = {};
          const LAS unsigned char* ar = gb + (isP ? G_Q : G_K) + (32 * ti + r32) * GP + 16 * hi; const LAS unsigned char* br = gb + G_K + (32 * tj + r32) * GP + 16 * hi;
#pragma unroll
          for (int s = 0; s < 4; ++s) acc = __builtin_amdgcn_mfma_f32_32x32x16_bf16(*(const LAS bf16x8*)(ar + 32 * s), *(const LAS bf16x8*)(br + 32 * s), acc, 0, 0, 0);
          const int j = 32 * tj + r32; const float cj = sm[j];
#pragma unroll
          for (int r = 0; r < 16; ++r) { const int i = 32 * ti + (r & 3) + 8 * (r >> 2) + 4 * hi;
              const float dl = __expf(fminf(sm[i] - cj, 0.f));
              if (!isP) ((LAS float*)(gb + G_A))[i * 68 + j] = (i > j) ? sm[64 + i] * acc[r] * dl : 0.f;
              else *(LAS _Float16*)(gb + G_P + i * GP + 2 * j) = (_Float16)((i >= j) ? acc[r] * dl : 0.f); } }
        __syncthreads();
        if (!(SKIP & 2) && wave == 0) {
            const int bb = lane >> 4, cc = lane & 15; float T[16];
            const LAS float* Ab = (const LAS float*)(gb + G_A) + (16 * bb) * 68 + 16 * bb;
#pragma unroll
            for (int i = 0; i < 16; ++i) { float a0 = 0.f, a1 = 0.f;
#pragma unroll
                for (int j4 = 0; j4 < (i + 3) / 4; ++j4) { const f32x4 av = *(const LAS f32x4*)(Ab + i * 68 + 4 * j4);
                    a0 += av.x * T[4 * j4] + av.z * T[4 * j4 + 2]; a1 += av.y * T[4 * j4 + 1] + av.w * T[4 * j4 + 3]; }
                T[i] = (i == cc ? 1.f : 0.f) - (a0 + a1);
                if (i < 15 && (i & 3) == 3) asm volatile("" ::: "memory");
                if (i == 0) {
#pragma unroll
                    for (int k = 1; k < 16; ++k) T[k] = 0.f; } }
#pragma unroll
            for (int i = 0; i < 16; ++i) ((LAS float*)(gb + G_T))[(16 * bb + i) * 16 + cc] = T[i];
        }
        __syncthreads();
        f32x4 Xc[4];
#pragma unroll
        for (int g = 0; g < 4; ++g) Xc[g] = (f32x4){0.f, 0.f, 0.f, 0.f};
        if (!(SKIP & 2)) {
            const int col = lane & 15, q4 = lane >> 4, c = 16 * wave + col;
            const LAS unsigned char* src = gb + (c < 64 ? G_V : G_K) + 2 * (c & 63);
            u64_t xh[4], xl[4];
#pragma unroll
            for (int bk = 0; bk < 4; ++bk) {
                f32x4 Y; const f32x4 be = *(const LAS f32x4*)(sm + 64 + 16 * bk + 4 * q4), ga = *(const LAS f32x4*)(sm + 128 + 16 * bk + 4 * q4);
#pragma unroll
                for (int r = 0; r < 4; ++r) Y[r] = bf2f(*(const LAS bf16*)(src + (16 * bk + 4 * q4 + r) * GP)) * be[r] * (c < 64 ? 1.f : ga[r]);
#pragma unroll
                for (int b2 = 0; b2 < bk; b2 += 2) {
                    const LAS float* ar = (const LAS float*)(gb + G_A) + (16 * bk + col) * 68 + 16 * b2 + 4 * q4;
                    f32x4 a0 = -*(const LAS f32x4*)ar, a1 = (b2 + 1 < bk) ? -*(const LAS f32x4*)(ar + 16) : (f32x4){0.f, 0.f, 0.f, 0.f};
                    u64_t ah0, al0, ah1, al1; hilo4(a0, ah0, al0); hilo4(a1, ah1, al1);
                    const u64_t bh1 = (b2 + 1 < bk) ? xh[b2 + 1] : 0ull, bl1 = (b2 + 1 < bk) ? xl[b2 + 1] : 0ull;
                    const bf16x8 Ah = mk_bf16x8(ah0, ah1), Al = mk_bf16x8(al0, al1), Bh = mk_bf16x8(xh[b2], bh1), Bl = mk_bf16x8(xl[b2], bl1);
                    Y = __builtin_amdgcn_mfma_f32_16x16x32_bf16(Al, Bh, Y, 0, 0, 0);
                    Y = __builtin_amdgcn_mfma_f32_16x16x32_bf16(Ah, Bl, Y, 0, 0, 0);
                    Y = __builtin_amdgcn_mfma_f32_16x16x32_bf16(Ah, Bh, Y, 0, 0, 0); }
                { const f32x4 t0 = *(const LAS f32x4*)((const LAS float*)(gb + G_T) + (16 * bk + col) * 16 + 4 * q4);
                  u64_t th, tl, yh, yl; hilo4(t0, th, tl); hilo4(Y, yh, yl);
                  const bf16x8 Ah = mk_bf16x8(th, 0ull), Al = mk_bf16x8(tl, 0ull), Bh = mk_bf16x8(yh, 0ull), Bl = mk_bf16x8(yl, 0ull);
                  f32x4 X = {0.f, 0.f, 0.f, 0.f};
                  X = __builtin_amdgcn_mfma_f32_16x16x32_bf16(Al, Bh, X, 0, 0, 0);
                  X = __builtin_amdgcn_mfma_f32_16x16x32_bf16(Ah, Bl, X, 0, 0, 0);
                  X = __builtin_amdgcn_mfma_f32_16x16x32_bf16(Ah, Bh, X, 0, 0, 0);
                  Xc[bk] = X; hilo4(X, xh[bk], xl[bk]); }
            }
        }
        __syncthreads();
        { const int col = lane & 15, q4 = lane >> 4, c = 16 * wave + col;
          if (wave < 4) {
#pragma unroll
              for (int g = 0; g < 4; ++g)
#pragma unroll
                  for (int r = 0; r < 4; ++r) ((LAS float*)(gb + G_A))[(16 * g + 4 * q4 + r) * 68 + c] = Xc[g][r];
          } else {
#pragma unroll
              for (int g = 0; g < 4; ++g)
#pragma unroll
                  for (int r = 0; r < 4; ++r) { const int i = 16 * g + 4 * q4 + r; const float x = -Xc[g][r]; const unsigned hb = f2bf(x);
                      *(LAS bf16*)(gb + G_V + i * GP + 2 * (c - 64)) = (bf16)hb;
                      *(LAS bf16*)(gb + G_K + i * GP + 2 * (c - 64)) = (bf16)f2bf(x - __uint_as_float(hb << 16)); }
          } }
        __syncthreads();
        if (wave < 4) { const int col = lane & 15, q4 = lane >> 4, e = 16 * wave + col;
          bf16x8 bS0, bS1, bS0l, bS1l; split_acc(Sacc[0], Sacc[1], bS0, bS0l); split_acc(Sacc[2], Sacc[3], bS1, bS1l);
          f32x4 U[4], T1[4];
          const LAS unsigned char* rowa = gb + col * GP + 8 * q4;
#pragma unroll
          for (int it = 0; it < 4; ++it) {
              const LAS float* u0p = (const LAS float*)(gb + G_A) + (16 * it + 4 * q4) * 68 + e;
              U[it] = (f32x4){u0p[0], u0p[68], u0p[136], u0p[204]};
              const LAS unsigned char* ra = rowa + 16 * it * GP;
              const bf16x8 wh0 = ld2x8(ra + G_V), wh1 = ld2x8(ra + G_V + 64), wl0 = ld2x8(ra + G_K), wl1 = ld2x8(ra + G_K + 64), qa0 = ld2x8(ra + G_Q), qa1 = ld2x8(ra + G_Q + 64);
              U[it] = __builtin_amdgcn_mfma_f32_16x16x32_bf16(wl0, bS0, U[it], 0, 0, 0);
              U[it] = __builtin_amdgcn_mfma_f32_16x16x32_bf16(wl1, bS1, U[it], 0, 0, 0);
              U[it] = __builtin_amdgcn_mfma_f32_16x16x32_bf16(wh0, bS0l, U[it], 0, 0, 0);
              U[it] = __builtin_amdgcn_mfma_f32_16x16x32_bf16(wh1, bS1l, U[it], 0, 0, 0);
              U[it] = __builtin_amdgcn_mfma_f32_16x16x32_bf16(wh0, bS0, U[it], 0, 0, 0);
              U[it] = __builtin_amdgcn_mfma_f32_16x16x32_bf16(wh1, bS1, U[it], 0, 0, 0);
              T1[it] = __builtin_amdgcn_mfma_f32_16x16x32_bf16(qa0, bS0l, (f32x4){0.f, 0.f, 0.f, 0.f}, 0, 0, 0);
              T1[it] = __builtin_amdgcn_mfma_f32_16x16x32_bf16(qa1, bS1l, T1[it], 0, 0, 0);
              T1[it] = __builtin_amdgcn_mfma_f32_16x16x32_bf16(qa0, bS0, T1[it], 0, 0, 0);
              T1[it] = __builtin_amdgcn_mfma_f32_16x16x32_bf16(qa1, bS1, T1[it], 0, 0, 0);
              asm volatile("" ::: "memory");
          }
          const f16x8 hU0 = pack_acc_f16(U[0], U[1]), hU1 = pack_acc_f16(U[2], U[3]);
          f32x4 Ud[4];
#pragma unroll
          for (int it = 0; it < 4; ++it) { const f32x4 dc = *(const LAS f32x4*)(sm + 192 + 16 * it + 4 * q4); Ud[it] = U[it] * dc; }
          bf16x8 bD0, bD1, bD0l, bD1l; split_acc(Ud[0], Ud[1], bD0, bD0l); split_acc(Ud[2], Ud[3], bD1, bD1l);
          const float gend = sm[191];
#pragma unroll
          for (int it = 0; it < 4; ++it) {
              const LAS unsigned char* ra = rowa + 16 * it * GP;
              const f32x4 gm = *(const LAS f32x4*)(sm + 128 + 16 * it + 4 * q4);
              const bf16x8 pa0 = ld2x8(ra + G_P), pa1 = ld2x8(ra + G_P + 64), ka0 = ld2x8(ra + G_KT), ka1 = ld2x8(ra + G_KT + 64);
              f32x4 O = T1[it] * gm;
              O = __builtin_amdgcn_mfma_f32_16x16x32_f16(__builtin_bit_cast(f16x8, pa0), hU0, O, 0, 0, 0);
              O = __builtin_amdgcn_mfma_f32_16x16x32_f16(__builtin_bit_cast(f16x8, pa1), hU1, O, 0, 0, 0);
              f32x4 Sn = Sacc[it] * gend;
              Sn = __builtin_amdgcn_mfma_f32_16x16x32_bf16(ka0, bD0l, Sn, 0, 0, 0);
              Sn = __builtin_amdgcn_mfma_f32_16x16x32_bf16(ka1, bD1l, Sn, 0, 0, 0);
              Sn = __builtin_amdgcn_mfma_f32_16x16x32_bf16(ka0, bD0, Sn, 0, 0, 0);
              Sn = __builtin_amdgcn_mfma_f32_16x16x32_bf16(ka1, bD1, Sn, 0, 0, 0);
              Sacc[it] = Sn;
#pragma unroll
              for (int r = 0; r < 4; ++r) ((LAS float*)(gb + G_A))[(16 * it + 4 * q4 + r) * 68 + e] = O[r];
              asm volatile("" ::: "memory");
          } }
        else if (c + 1 < SEQ / 64) GDN_RAW_STAGE(c + 1, tid - 256, 256);
        __syncthreads();
    }
    GDN_WRITEOUT(SEQ / 64 - 1);
#undef GDN_WRITEOUT
#undef GDN_RAW_STAGE
    __syncthreads();
}
__device__ __forceinline__ int next_unit(Frame& F, gu32* head) {
    __syncthreads();
    if (F.tid == 0) F.MISC[16] = __hip_atomic_fetch_add(head, 1u, RLX_AGENT);
    __syncthreads();
    return (int)F.MISC[16];
}
constexpr int U_GDN = 96, U_RWKV = 128, U_ATT = 384, U_ALL = U_GDN + U_RWKV + U_ATT;
__device__ __forceinline__ void p3_mixers(Frame& F, int l, int rep) {
    gu32* head = F.ctl + CW_QUEUE + 64 * (2 * l + rep);
    for (;;) {
        const int u = next_unit(F, head);
        if (u >= U_ALL) break;
        asm volatile("" : "+v"(F.tid), "+v"(F.lane));
        if (u < U_GDN) gdn_unit3<0>(F, l, u, F.ctl + CW_FLAG + 64 * 256 * (2 * l + rep) + 64 * 128);
        else if (u < U_GDN + U_RWKV) rwkv_unit<0>(F, u - U_GDN, F.ctl + CW_FLAG + 64 * 256 * (2 * l + rep));
        else attn_unit(F, u - U_GDN - U_RWKV);
    }
}
__device__ __forceinline__ f32x4 bf4(u64_t x) { return (f32x4){__uint_as_float(((unsigned)x) << 16), __uint_as_float(((unsigned)x) & 0xffff0000u), __uint_as_float(((unsigned)(x >> 32)) << 16), __uint_as_float(((unsigned)(x >> 32)) & 0xffff0000u)}; }
__device__ __forceinline__ u64_t pk4(const f32x4& v) { return (u64_t)pg8::cvt_pk_bf16(v[0], v[1]) | ((u64_t)pg8::cvt_pk_bf16(v[2], v[3]) << 32); }
__device__ __forceinline__ void p2_mla_unit(Frame& F, int l, int unit) {
    const int lane = F.lane, col = lane & 15, q4 = lane >> 4, m = 16 * unit + col, b = m / SEQ, t = m % SEQ, t0 = (16 * unit) % SEQ;
    const bf16* prow = (const bf16*)(F.ws + WS_PMLA) + (size_t)m * 352;
    const bf16* WuqT = (const bf16*)(F.ws + WS_WSMALL + OFF_WUQ) + (size_t)l * 576 * 192 + (size_t)col * 192 + 8 * q4;
    const bf16* WukvT = (const bf16*)(F.ws + WS_WSMALL + OFF_WUKV) + (size_t)l * 768 * 128 + (size_t)col * 128 + 8 * q4;
    bf16x8 aq[6], akv[4]; float sq = 0.f, skv = 0.f;
#pragma unroll
    for (int s = 0; s < 6; ++s) { aq[s] = *(const bf16x8*)(prow + 32 * s + 8 * q4); const v4u u = __builtin_bit_cast(v4u, aq[s]);
#pragma unroll
        for (int i = 0; i < 4; ++i) { const float a = __uint_as_float(u[i] << 16), c = __uint_as_float(u[i] & 0xffff0000u); sq += a * a + c * c; } }
#pragma unroll
    for (int s = 0; s < 4; ++s) { akv[s] = *(const bf16x8*)(prow + 192 + 32 * s + 8 * q4); const v4u u = __builtin_bit_cast(v4u, akv[s]);
#pragma unroll
        for (int i = 0; i < 4; ++i) { const float a = __uint_as_float(u[i] << 16), c = __uint_as_float(u[i] & 0xffff0000u); skv += a * a + c * c; } }
    sq += __shfl_xor(sq, 16); sq += __shfl_xor(sq, 32); skv += __shfl_xor(skv, 16); skv += __shfl_xor(skv, 32);
    const float rq = rsqrtf(sq * (1.f / 192.f) + NORM_EPS) * (0.10206207261596575f * LOG2E), rkv = rsqrtf(skv * (1.f / 128.f) + NORM_EPS);
    const float pos = (float)((const int*)inptr(F, 1))[m];
    f32x4 cs, sn;
#pragma unroll
    for (int r = 0; r < 4; ++r) { const float inv = exp2f(-(float)(4 * q4 + r) * (13.287712379549449f / 16.f)); float s_, c_; sincosf(pos * inv, &s_, &c_); cs[r] = c_; sn[r] = s_; }
    bf16* Qo = (bf16*)(F.ws + WS_Q) + ((size_t)b * 6 * SEQ + t) * 96 + 4 * q4;
    bf16* Ko = (bf16*)(F.ws + WS_K) + ((size_t)b * 6 * SEQ + t) * 96 + 4 * q4;
    bf16* Vo = (bf16*)(F.ws + WS_VT) + (size_t)b * 6 * 64 * SEQ + (size_t)col * SEQ + t0 + 4 * q4;
    { const u64_t x1 = *(const u64_t*)(prow + 320 + 4 * q4), x2 = *(const u64_t*)(prow + 336 + 4 * q4); const f32x4 a = bf4(x1), c = bf4(x2);
      const u64_t o1 = pk4(a * cs - c * sn), o2 = pk4(c * cs + a * sn);
#pragma unroll
      for (int h = 0; h < 6; ++h) { *(u64_t*)(Ko + (size_t)h * SEQ * 96 + 64) = o1; *(u64_t*)(Ko + (size_t)h * SEQ * 96 + 80) = o2; } }
#pragma unroll 2
    for (int h = 0; h < 6; ++h) {
        f32x4 x1v = {0.f, 0.f, 0.f, 0.f};
#pragma unroll
        for (int nt = 0; nt < 6; ++nt) {
            const bf16* w = WuqT + (size_t)(h * 96 + 16 * nt) * 192; f32x4 acc = {0.f, 0.f, 0.f, 0.f};
#pragma unroll
            for (int s = 0; s < 6; ++s) acc = __builtin_amdgcn_mfma_f32_16x16x32_bf16(*(const bf16x8*)(w + 32 * s), aq[s], acc, 0, 0, 0);
            acc = acc * rq;
            if (nt < 4) *(u64_t*)(Qo + (size_t)h * SEQ * 96 + 16 * nt) = pk4(acc);
            else if (nt == 4) x1v = acc;
            else { *(u64_t*)(Qo + (size_t)h * SEQ * 96 + 64) = pk4(x1v * cs - acc * sn); *(u64_t*)(Qo + (size_t)h * SEQ * 96 + 80) = pk4(acc * cs + x1v * sn); }
        }
#pragma unroll
        for (int nt = 0; nt < 4; ++nt) {
            const bf16* w = WukvT + (size_t)(h * 128 + 16 * nt) * 128; f32x4 acc = {0.f, 0.f, 0.f, 0.f};
#pragma unroll
            for (int s = 0; s < 4; ++s) acc = __builtin_amdgcn_mfma_f32_16x16x32_bf16(*(const bf16x8*)(w + 32 * s), akv[s], acc, 0, 0, 0);
            *(u64_t*)(Ko + (size_t)h * SEQ * 96 + 16 * nt) = pk4(acc * rkv);
        }
        f32x4 rk4;
#pragma unroll
        for (int r = 0; r < 4; ++r) rk4[r] = __shfl(rkv, 4 * q4 + r);
#pragma unroll
        for (int nt = 0; nt < 4; ++nt) {
            const bf16* w = WukvT + (size_t)(h * 128 + 64 + 16 * nt) * 128; f32x4 acc = {0.f, 0.f, 0.f, 0.f};
#pragma unroll
            for (int s = 0; s < 4; ++s) acc = __builtin_amdgcn_mfma_f32_16x16x32_bf16(akv[s], *(const bf16x8*)(w + 32 * s), acc, 0, 0, 0);
            *(u64_t*)(Vo + (size_t)(h * 64 + 16 * nt) * SEQ) = pk4(acc * rk4);
        }
    }
}
__device__ __forceinline__ f32x4 rw_shift4(const bf16* P, size_t m, int c, bool hp, bool hn, const float* mu) {
    const f32x4 x = bf4(*(const u64_t*)(P + m * 896 + c)), xp = hp ? bf4(*(const u64_t*)(P + (m - 1) * 896 + c)) : (f32x4){0.f, 0.f, 0.f, 0.f}, xn = hn ? bf4(*(const u64_t*)(P + (m + 1) * 896 + c)) : (f32x4){0.f, 0.f, 0.f, 0.f};
    const f32x4 m0 = *(const f32x4*)(mu + c), m1 = *(const f32x4*)(mu + 896 + c);
    return x + m0 * (xp - x) + m1 * (xn - x);
}
__device__ __forceinline__ void p2_rwkv_unit(Frame& F, int l, int unit, int h0, int h1) {
    const int lane = F.lane, col = lane & 15, q4 = lane >> 4, b = (16 * unit) / SEQ, t = (16 * unit) % SEQ + col; const size_t m = (size_t)16 * unit + col;
    const bool hp = t > 0, hn = t < SEQ - 1;
    const bf16* Prw = (const bf16*)(F.ws + WS_PRW);
    const float* mu = (const float*)inptr(F, 12) + l * 2 * 896;
    const bf16* W2T = (const bf16*)(F.ws + WS_WSMALL + OFF_W2T) + (size_t)l * 2 * 256 * 64 + (size_t)col * 64 + 8 * q4;
    const bf16* A2T = (const bf16*)(F.ws + WS_WSMALL + OFF_A2T) + (size_t)l * 2 * 256 * 64 + (size_t)col * 64 + 8 * q4;
    bf16x8 awd[2], aad[2];
#pragma unroll
    for (int s = 0; s < 2; ++s) { const int c = 768 + 32 * s + 8 * q4;
        f32x4 lo = rw_shift4(Prw, m, c, hp, hn, mu), hi = rw_shift4(Prw, m, c + 4, hp, hn, mu);
#pragma unroll
        for (int i = 0; i < 4; ++i) { lo[i] = 1.f - 2.f * __builtin_amdgcn_rcpf(1.f + __expf(2.f * lo[i])); hi[i] = 1.f - 2.f * __builtin_amdgcn_rcpf(1.f + __expf(2.f * hi[i])); }
        awd[s] = pack_acc(lo, hi);
        aad[s] = pack_acc(rw_shift4(Prw, m, c + 64, hp, hn, mu), rw_shift4(Prw, m, c + 68, hp, hn, mu)); }
#pragma unroll 1
    for (int h = h0; h < h1; ++h) {
        f32x4 k[4]; float kn = 0.f;
        { const float* k_k = (const float*)inptr(F, 17) + l * 256;
#pragma unroll
          for (int nt = 0; nt < 4; ++nt) { const int c = 64 * h + 16 * nt + 4 * q4; k[nt] = rw_shift4(Prw, m, 256 + c, hp, hn, mu);
              const f32x4 x = k[nt] * *(const f32x4*)(k_k + c); kn += (x[0] * x[0] + x[1] * x[1]) + (x[2] * x[2] + x[3] * x[3]); } }
        kn += __shfl_xor(kn, 16); kn += __shfl_xor(kn, 32);
        const float rkn = rsqrtf(kn + 1e-6f);
        float br[2] = {0.f, 0.f}, kr[2] = {0.f, 0.f}, cbv = 0.f;
        unsigned char* rs = F.ws + WS_RS + (((size_t)b * 4 + h) * SEQ + t) * RS_REC + 8 * q4;
        unsigned char* rd0 = F.ws + WS_RD + (((size_t)b * 4 + h) * SEQ + t) * RD_REC + 8 * q4;
#pragma unroll
        for (int nt = 0; nt < 4; ++nt) { const int c = 64 * h + 16 * nt + 4 * q4;
            const f32x4 r = rw_shift4(Prw, m, c, hp, hn, mu), v = rw_shift4(Prw, m, 512 + c, hp, hn, mu);
            const f32x4 kk = k[nt] * *(const f32x4*)((const float*)inptr(F, 17) + l * 256 + c) * rkn;
            *(u64_t*)(rs + 32 * nt) = pk4(kk); *(u64_t*)(rs + 128 + 32 * nt) = pk4(v); *(u64_t*)(rs + 256 + 32 * nt) = pk4(r);
            f32x4 ksum = {0.f, 0.f, 0.f, 0.f};
#pragma unroll
            for (int e = 0; e < 2; ++e) { const bf16* w = W2T + (size_t)(e * 256 + 64 * h + 16 * nt) * 64; const bf16* a = A2T + (size_t)(e * 256 + 64 * h + 16 * nt) * 64;
                f32x4 x = {0.f, 0.f, 0.f, 0.f}, y = {0.f, 0.f, 0.f, 0.f};
#pragma unroll
                for (int s = 0; s < 2; ++s) { x = __builtin_amdgcn_mfma_f32_16x16x32_bf16(*(const bf16x8*)(w + 32 * s), awd[s], x, 0, 0, 0); y = __builtin_amdgcn_mfma_f32_16x16x32_bf16(*(const bf16x8*)(a + 32 * s), aad[s], y, 0, 0, 0); }
                const f32x4 w0v = *(const f32x4*)((const float*)inptr(F, 13) + l * 512 + e * 256 + c), a0v = *(const f32x4*)((const float*)inptr(F, 15) + l * 512 + e * 256 + c), kav = *(const f32x4*)((const float*)inptr(F, 18) + l * 256 + c);
                f32x4 lam, av;
#pragma unroll
                for (int i = 0; i < 4; ++i) { lam[i] = 0.6065306597126334f * sigmoidf_(w0v[i] + x[i]); av[i] = sigmoidf_(a0v[i] + y[i]); }
                const f32x4 km = k[nt] * (1.f + (av - 1.f) * kav), bb = av * kk;
                ksum += km;
                br[e] += (bb[0] * r[0] + bb[1] * r[1]) + (bb[2] * r[2] + bb[3] * r[3]); kr[e] += (km[0] * r[0] + km[1] * r[1]) + (km[2] * r[2] + km[3] * r[3]);
                typedef _Float16 h4 __attribute__((ext_vector_type(4)));
                const h4 lh = {(_Float16)lam[0], (_Float16)lam[1], (_Float16)lam[2], (_Float16)lam[3]};
                unsigned char* rd = rd0 + e * RD_DIR;
                *(u64_t*)(rd + 32 * nt) = __builtin_bit_cast(u64_t, lh); *(u64_t*)(rd + 128 + 32 * nt) = pk4(bb); *(u64_t*)(rd + 256 + 32 * nt) = pk4(km); }
            const f32x4 rkv = *(const f32x4*)((const float*)inptr(F, 19) + l * 256 + c), xx = r * ksum * rkv; cbv += (xx[0] + xx[1]) + (xx[2] + xx[3]);
        }
#pragma unroll
        for (int e = 0; e < 2; ++e) { float x = br[e], y = kr[e]; x += __shfl_xor(x, 16); x += __shfl_xor(x, 32); y += __shfl_xor(y, 16); y += __shfl_xor(y, 32);
            if (q4 == 0) { typedef float f2 __attribute__((ext_vector_type(2))); *(f2*)(rd0 + e * RD_DIR + 384) = (f2){x, y}; } }
        cbv += __shfl_xor(cbv, 16); cbv += __shfl_xor(cbv, 32);
        if (q4 == 0) ((float*)(F.ws + WS_CB))[m * 4 + h] = 0.5f * cbv;
    }
}
template <int MODE> __device__ __forceinline__ void p2_prep2(Frame& F, int l) {
    const int gw = F.vcu * NWAVES + F.wave, NGW = F.G * NWAVES;
    for (int u = gw; u < 2 * (M / 16); u += NGW) { if (u & 1) { if (MODE != 1) p2_rwkv_unit(F, l, u >> 1, 0, 4); } else { if (MODE != 2) p2_mla_unit(F, l, u >> 1); } }
}
__device__ __forceinline__ void ld16(const bf16* p, f32x4 (&o)[4]) { const v4u a = *(const v4u*)p, b = *(const v4u*)(p + 8);
    o[0] = (f32x4){__uint_as_float(a.x << 16), __uint_as_float(a.x & 0xffff0000u), __uint_as_float(a.y << 16), __uint_as_float(a.y & 0xffff0000u)};
    o[1] = (f32x4){__uint_as_float(a.z << 16), __uint_as_float(a.z & 0xffff0000u), __uint_as_float(a.w << 16), __uint_as_float(a.w & 0xffff0000u)};
    o[2] = (f32x4){__uint_as_float(b.x << 16), __uint_as_float(b.x & 0xffff0000u), __uint_as_float(b.y << 16), __uint_as_float(b.y & 0xffff0000u)};
    o[3] = (f32x4){__uint_as_float(b.z << 16), __uint_as_float(b.z & 0xffff0000u), __uint_as_float(b.w << 16), __uint_as_float(b.w & 0xffff0000u)}; }
__device__ __forceinline__ void p4a_mix2(Frame& F, int l) {
    const bf16* Ogdn = (const bf16*)(F.ws + WS_OGDN); const bf16* Omla = (const bf16*)(F.ws + WS_OMLA); const bf16* Y = (const bf16*)(F.ws + WS_Y);
    const bf16* Pgate = (const bf16*)(F.ws + WS_PGATE); const unsigned char* Rs = F.ws + WS_RS; const float* cb = (const float*)(F.ws + WS_CB); bf16* mix = (bf16*)(F.ws + WS_MIX);
    const int gw = F.vcu * NWAVES + F.wave, NGW = F.G * NWAVES, lane = F.lane, g = lane >> 2, c0 = 16 * lane;
    f32x4 pg[4], pb[4];
    if (g < 6) { const float* gg = (const float*)inptr(F, 7) + l * 64 + (c0 & 63);
#pragma unroll
        for (int i = 0; i < 4; ++i) { pg[i] = *(const f32x4*)(gg + 4 * i); pb[i] = (f32x4){0.f, 0.f, 0.f, 0.f}; } }
    else if (g < 12) {
#pragma unroll
        for (int i = 0; i < 4; ++i) { pg[i] = (f32x4){1.f, 1.f, 1.f, 1.f}; pb[i] = (f32x4){0.f, 0.f, 0.f, 0.f}; } }
    else { const float* lg = (const float*)inptr(F, 20) + l * 256 + (c0 - 768); const float* lb = (const float*)inptr(F, 21) + l * 256 + (c0 - 768);
#pragma unroll
        for (int i = 0; i < 4; ++i) { pg[i] = *(const f32x4*)(lg + 4 * i); pb[i] = *(const f32x4*)(lb + 4 * i); } }
#pragma unroll 2
    for (int m = gw; m < M; m += NGW) {
        f32x4 x[4], gt[4];
        ld16(Pgate + (size_t)m * 1024 + c0, gt);
        if (g < 6) { ld16(Ogdn + (size_t)m * 384 + c0, x);
            float ss = 0.f;
#pragma unroll
            for (int i = 0; i < 4; ++i) ss += (x[i][0] * x[i][0] + x[i][1] * x[i][1]) + (x[i][2] * x[i][2] + x[i][3] * x[i][3]);
            ss += dpp_xor1(ss); ss += dpp_xor2(ss);
            const float rs = rsqrtf(ss * (1.f / 64.f) + NORM_EPS);
#pragma unroll
            for (int i = 0; i < 4; ++i) x[i] = x[i] * rs * pg[i]; }
        else if (g < 12) ld16(Omla + (size_t)m * 384 + (c0 - 384), x);
        else { const int cc = c0 - 768, h = g - 12, b = m / SEQ, t = m % SEQ; f32x4 v[4];
            ld16(Y + (size_t)m * 256 + cc, x); ld16((const bf16*)(Rs + (((size_t)b * 4 + h) * SEQ + t) * RS_REC + 128) + (cc & 63), v);
            const float cbv = cb[(size_t)m * 4 + h];
            float s1 = 0.f;
#pragma unroll
            for (int i = 0; i < 4; ++i) s1 += (x[i][0] + x[i][1]) + (x[i][2] + x[i][3]);
            s1 += dpp_xor1(s1); s1 += dpp_xor2(s1);
            const float mean = s1 * (1.f / 64.f); float s2 = 0.f;
#pragma unroll
            for (int i = 0; i < 4; ++i) { x[i] = x[i] - mean; s2 += (x[i][0] * x[i][0] + x[i][1] * x[i][1]) + (x[i][2] * x[i][2] + x[i][3] * x[i][3]); }
            s2 += dpp_xor1(s2); s2 += dpp_xor2(s2);
            const float rs = rsqrtf(s2 * (1.f / 64.f) + 64e-5f);
#pragma unroll
            for (int i = 0; i < 4; ++i) x[i] = x[i] * rs * pg[i] + pb[i] + cbv * v[i]; }
        v4u o0, o1;
#pragma unroll
        for (int i = 0; i < 4; ++i) {
#pragma unroll
            for (int j = 0; j < 4; ++j) x[i][j] = x[i][j] * siluf(gt[i][j]); }
        o0.x = pg8::cvt_pk_bf16(x[0][0], x[0][1]); o0.y = pg8::cvt_pk_bf16(x[0][2], x[0][3]); o0.z = pg8::cvt_pk_bf16(x[1][0], x[1][1]); o0.w = pg8::cvt_pk_bf16(x[1][2], x[1][3]);
        o1.x = pg8::cvt_pk_bf16(x[2][0], x[2][1]); o1.y = pg8::cvt_pk_bf16(x[2][2], x[2][3]); o1.z = pg8::cvt_pk_bf16(x[3][0], x[3][1]); o1.w = pg8::cvt_pk_bf16(x[3][2], x[3][3]);
        bf16* op = mix + (size_t)m * 1024 + c0; *(v4u*)op = o0; *(v4u*)(op + 8) = o1;
    }
}
constexpr int PT_OUT = 24, PT_WS = 25, PT_N = 26;
__device__ __forceinline__ void build_frame(Frame& F, LAS unsigned char* lds) {
    F.lds = lds; F.MISC = (volatile LAS unsigned*)(lds + MISC_OFF); F.ptab = (volatile LAS const unsigned long long*)(lds + MISC_OFF + 256);
    const int t = pg8::mk_tid(lds);
    F.tid = t; F.lane = t & 63; F.wave = __builtin_amdgcn_readfirstlane(t >> 6);
    F.G = gridDim.x; { const int bx = blockIdx.x; F.vcu = (F.G % 8 == 0) ? (bx % 8) * (F.G / 8) + bx / 8 : bx; }
    F.ws = (unsigned char*)inptr(F, PT_WS); F.out = (float*)inptr(F, PT_OUT); F.ctl = (gu32*)F.ws;
}
__device__ __forceinline__ bool ph_in(LAS unsigned char* lds, int k) { volatile LAS unsigned* mi = (volatile LAS unsigned*)(lds + MISC_OFF); const int lo = __builtin_amdgcn_readfirstlane((int)mi[20]), hi = __builtin_amdgcn_readfirstlane((int)mi[21]); return lo <= k && k < hi; }
__device__ __forceinline__ void seam(LAS unsigned char* lds, int k) {
    if (ph_in(lds, k) && ph_in(lds, k + 1)) { Frame F; build_frame(F, lds);
        XcdBarrier bar; bar.bar = (unsigned*)(F.ctl + CW_BAR); bar.x = xb_xcc_id(); bar.st = F.MISC + 8; xcd_barrier(bar); }
}
template <int L> __device__ __forceinline__ void layer_phases(LAS unsigned char* lds) {
    constexpr int pb = 1 + 5 * L;
    if (ph_in(lds, pb)) { Frame F; build_frame(F, lds);
        pg8::Gemm g{(const pg8::bf16_t*)(F.ws + WS_XB), (const pg8::bf16_t*)(F.ws + WS_WIN) + (size_t)L * NP * D, M, NP, D};
        pg8::StaticOrder S; S.init(M, NP, F.G, (int)blockIdx.x);
        pg8::EpiRoute E{F.ws};
        pg8::gemm_phase<pg8::EpiRoute, pg8::StaticOrder, true, true>(F.lds + RING_OFF, g, S, E);
    }
    seam(lds, pb);
    if (ph_in(lds, pb + 1)) { Frame F; build_frame(F, lds); p2_prep2<0>(F, L); }
    seam(lds, pb + 1);
    if (ph_in(lds, pb + 2)) { Frame F; build_frame(F, lds); p3_mixers(F, L, 0); }
    seam(lds, pb + 2);
    if (ph_in(lds, pb + 3)) { Frame F; build_frame(F, lds); p4a_mix2(F, L);
    }
    seam(lds, pb + 3);
    if (ph_in(lds, pb + 4)) { Frame F; build_frame(F, lds);
        pg8::Gemm g{(const pg8::bf16_t*)(F.ws + WS_MIX), (const pg8::bf16_t*)(F.ws + WS_WOUT) + (size_t)L * D * D, M, D, D};
        pg8::StaticOrder S; S.init(M, D, F.G, (int)blockIdx.x);
        pg8::EpiOut<L == 0> E{L == 0 ? (const float*)inptr(F, 0) : (const float*)F.out, F.out, F.ws};
        pg8::gemm_phase<pg8::EpiOut<L == 0>, pg8::StaticOrder, true, true>(F.lds + RING_OFF, g, S, E);
    }
    seam(lds, pb + 4);
}
__global__ void __launch_bounds__(NWAVES * 64, 2) mk_fwd(Args args) {
    extern __shared__ __attribute__((aligned(16))) unsigned char lds_raw[];
    LAS unsigned char* lds = (LAS unsigned char*)lds_raw;
    for (int u = threadIdx.x; u < (LDS_BYTES - LDSCTL_OFF) / 4; u += NWAVES * 64) ((LAS unsigned*)(lds + LDSCTL_OFF))[u] = 0u;
    __syncthreads();
    if (threadIdx.x == 0) { LAS unsigned long long* pt = (LAS unsigned long long*)(lds + MISC_OFF + 256);
#define PT(k) pt[k] = (unsigned long long)args.in[k]
        PT(0); PT(1); PT(2); PT(3); PT(4); PT(5); PT(6); PT(7); PT(8); PT(9); PT(10); PT(11); PT(12); PT(13); PT(14); PT(15); PT(16); PT(17); PT(18); PT(19); PT(20); PT(21); PT(22); PT(23);
#undef PT
        pt[PT_OUT] = (unsigned long long)args.out; pt[PT_WS] = (unsigned long long)args.ws;
        volatile LAS unsigned* mi = (volatile LAS unsigned*)(lds + MISC_OFF); mi[20] = (unsigned)args.ph_lo; mi[21] = (unsigned)args.ph_hi;
        if (args.ph_hi - args.ph_lo > 1) (void)xcd_barrier_post((unsigned*)((gu32*)args.ws + CW_BAR), mi + 8);
    }
    if ((threadIdx.x & 63) == 0) ((volatile LAS unsigned*)(lds + pg8::TIDTAB_OFF))[pg8::hw_slot()] = threadIdx.x >> 6;
    __syncthreads();
    if (ph_in(lds, 0)) { Frame F; build_frame(F, lds); p0_prologue(F); }
    seam(lds, 0);
    layer_phases<0>(lds);
    layer_phases<1>(lds);
    if (ph_in(lds, 11)) { Frame F; build_frame(F, lds); p5_final(F); }
}

extern "C" void kernel_launch(void* const* d_in, const int* in_sizes, int n_in, void* d_out, int out_size, void* d_ws, size_t ws_size, hipStream_t stream) {
    static int grid = 0;
    if (grid == 0) {
        if (n_in != 24 || ws_size < WS_END || out_size != M * D) { fprintf(stderr, "kernel_launch: unexpected inputs (%d), out (%d) or workspace (%zu)\n", n_in, out_size, ws_size); grid = -1; return; }
        int dev = 0, cus = 0;
        if (hipGetDevice(&dev) != hipSuccess || hipDeviceGetAttribute(&cus, hipDeviceAttributeMultiprocessorCount, dev) != hipSuccess) { grid = -1; return; }
        if (hipFuncSetAttribute((const void*)mk_fwd, hipFuncAttributeMaxDynamicSharedMemorySize, LDS_BYTES) != hipSuccess) { fprintf(stderr, "kernel_launch: hipFuncSetAttribute failed\n"); grid = -1; return; }
        (void)hipGetLastError();
        grid = cus;
    }
    if (grid < 0) return;
    unsigned char* ws = (unsigned char*)d_ws;
    (void)hipMemsetAsync(ws + WS_CTL, 0, CTL_ZERO_BYTES, stream);
    Args a{};
    for (int i = 0; i < 24; ++i) a.in[i] = d_in[i];
    a.out = (float*)d_out; a.ws = ws; a.ph_lo = 0; a.ph_hi = NPHASE;
    hipLaunchKernelGGL(mk_fwd, dim3(grid), dim3(NWAVES * 64), LDS_BYTES, stream, a);
}
```

```cpp
#include <hip/hip_runtime.h>
#include <cstdio>
#include <cstdint>
#include <hip/hip_fp16.h>
namespace pg8 {
#define PG8_LAS __attribute__((address_space(3)))
typedef unsigned short bf16_t;
typedef short bf16x8 __attribute__((ext_vector_type(8)));
typedef float f32x4 __attribute__((ext_vector_type(4)));
typedef unsigned u32x4 __attribute__((ext_vector_type(4)));
constexpr int BM = 256, BK = 64, HALF = 128, HTB = HALF * BK * 2  , STAGE_BYTES = 8 * HTB, NXCD = 8, WGM = 8;

__host__ __device__ __forceinline__ int lds_byte(int r, int c) { const int st = (r >> 4) * 2 + (c >> 5), rr = r & 15, cc = c & 31, ob = rr * 64 + cc * 2; return st * 1024 + (ob ^ (((ob >> 9) & 1) << 5)); }
__host__ __device__ __forceinline__ void stage_rc(int b, int& R, int& C) { const int st = b / 1024, sb = b % 1024, swz = sb ^ (((sb >> 9) & 1) << 5); R = (st >> 1) * 16 + swz / 64; C = (st & 1) * 32 + (swz % 64) / 2; }
__host__ __device__ __forceinline__ int perm32(int rho) { const int n = rho >> 4, i = rho & 15; return 8 * (i >> 2) + 4 * n + (i & 3); }

struct Unit { int pm, pn; };
struct Gemm { const bf16_t* A; const bf16_t* Bt; int M, N, K; };

struct StaticOrder {
    int nM, nN, nwg, G, c;
    __host__ __device__ void init(int M, int N, int G_, int c_) { nM = M / BM; nN = N / BM; nwg = nM * nN; G = G_; c = c_; }
    __host__ __device__ bool next(int i, Unit& u) const {
        const long L = (long)i * G + c; if (L >= nwg) return false;
        int wgid = (int)L; { const int q = nwg / NXCD, r = nwg % NXCD, xcd = wgid % NXCD, off = wgid / NXCD; wgid = (xcd < r ? xcd * (q + 1) : r * (q + 1) + (xcd - r) * q) + off; }
        const int nig = WGM * nN, gid = wgid / nig, fm = gid * WGM, gsz = (nM - fm) < WGM ? (nM - fm) : WGM;
        u.pm = fm + ((wgid % nig) % gsz); u.pn = (wgid % nig) / gsz; return true;
    }
    __device__ __forceinline__ void a_ready(const Unit&) const {}
    __device__ __forceinline__ void done(const Unit&) const {}
};

__device__ __forceinline__ unsigned cvt_pk_bf16(float lo, float hi) { unsigned r; asm volatile("v_cvt_pk_bf16_f32 %0, %1, %2" : "=v"(r) : "v"(lo), "v"(hi)); return r; }
typedef float f32x2 __attribute__((ext_vector_type(2)));
constexpr int TIDTAB_OFF = 131072 + 320 + 512;
__device__ __forceinline__ unsigned hw_slot() { return (unsigned)__builtin_amdgcn_s_getreg((5 << 11) | 4) & 63u; }
__device__ __forceinline__ int mk_tid(PG8_LAS unsigned char* lds_base) {
    const unsigned lane = __builtin_amdgcn_mbcnt_hi(~0u, __builtin_amdgcn_mbcnt_lo(~0u, 0u));
    const unsigned w = __builtin_amdgcn_readfirstlane(((volatile PG8_LAS unsigned*)(lds_base + TIDTAB_OFF))[hw_slot()]);
    return (int)(w * 64u + lane);
}
struct EpiRoute {
    static constexpr bool PERM = true, AFTER_DRAIN = false;
    unsigned char* ws;
    __device__ __forceinline__ void operator()(const f32x4 (&acc)[2][2][4][2], const Unit& u, int wr, int wc, int fr, int fq) const {
        const int row0 = u.pm * BM + wr * 64 + fr;
        const float* rowss = (const float*)(ws + (1u << 20)); float* Psm = (float*)(ws + (22u << 20));
        unsigned base[2]; int ld[2], cc[2], kind[2];
#pragma unroll
        for (int bj = 0; bj < 2; ++bj) {
            const int cg = u.pn * BM + bj * HALF + wc * 32, col = cg + 8 * fq;
            if (cg < 1024) { base[bj] = 25u << 20; ld[bj] = 1024; cc[bj] = col; kind[bj] = 0; }
            else if (cg < 2176) { base[bj] = 57u << 20; ld[bj] = 1152; cc[bj] = col - 1024; kind[bj] = 0; }
            else if (cg < 2528) { base[bj] = 93u << 20; ld[bj] = 352; cc[bj] = col - 2176; kind[bj] = 0; }
            else if (cg < 3424) { base[bj] = 104u << 20; ld[bj] = 896; cc[bj] = col - 2528; kind[bj] = 0; }
            else if (cg < 3456) { base[bj] = 0u; ld[bj] = 32; cc[bj] = col - 3424; kind[bj] = 1; }
            else { base[bj] = 0u; ld[bj] = 0; cc[bj] = 0; kind[bj] = 2; }
        }
#pragma unroll
        for (int ai = 0; ai < 2; ++ai)
#pragma unroll
            for (int m = 0; m < 4; ++m) {
                const int row = row0 + ai * HALF + m * 16;
                const f32x4* rp = (const f32x4*)(rowss + (size_t)row * 16);
                const f32x4 s0 = rp[0], s1 = rp[1], s2 = rp[2], s3 = rp[3];
                const float ss = ((s0[0] + s0[1]) + (s0[2] + s0[3])) + ((s1[0] + s1[1]) + (s1[2] + s1[3])) + ((s2[0] + s2[1]) + (s2[2] + s2[3])) + ((s3[0] + s3[1]) + (s3[2] + s3[3]));
                const float rstd = __builtin_amdgcn_rsqf(ss * (1.0f / 1024.0f) + 1e-6f);
#pragma unroll
                for (int bj = 0; bj < 2; ++bj) {
                    const f32x4 v0 = acc[ai][bj][m][0] * rstd, v1 = acc[ai][bj][m][1] * rstd;
                    if (kind[bj] == 0) { u32x4 w; w.x = cvt_pk_bf16(v0[0], v0[1]); w.y = cvt_pk_bf16(v0[2], v0[3]); w.z = cvt_pk_bf16(v1[0], v1[1]); w.w = cvt_pk_bf16(v1[2], v1[3]);
                        *(u32x4*)((bf16_t*)(ws + base[bj]) + (size_t)row * ld[bj] + cc[bj]) = w; }
                    else if (kind[bj] == 1) { float* p = Psm + (size_t)row * 32 + cc[bj]; *(f32x4*)p = v0; *(f32x4*)(p + 4) = v1; }
                }
                asm volatile("" ::: "memory");
            }
    }
};
template <bool WRITE_XB> struct EpiOut {
    static constexpr bool PERM = false, AFTER_DRAIN = false;
    const float* xin; float* xout; unsigned char* ws;
    __device__ __forceinline__ void operator()(const f32x4 (&acc)[2][2][4][2], const Unit& u, int wr, int wc, int fr, int fq) const {
        typedef unsigned u32x2v __attribute__((ext_vector_type(2)));
        const int row0 = u.pm * BM + wr * 64 + fr, col0 = u.pn * BM + wc * 32 + 4 * fq;
        float* rowss = (float*)(ws + (1u << 20)); bf16_t* xb = (bf16_t*)(ws + (133u << 20));
#pragma unroll
        for (int ai = 0; ai < 2; ++ai)
#pragma unroll
            for (int m = 0; m < 4; ++m) {
                const int row = row0 + ai * HALF + m * 16; float ss = 0.f;
#pragma unroll
                for (int bj = 0; bj < 2; ++bj)
#pragma unroll
                    for (int n = 0; n < 2; ++n) {
                        const size_t off = (size_t)row * 1024 + col0 + bj * HALF + n * 16;
                        const f32x4 o = *(const f32x4*)(xin + off) + acc[ai][bj][m][n];
                        *(f32x4*)(xout + off) = o;
                        if (WRITE_XB) { u32x2v w; w.x = cvt_pk_bf16(o[0], o[1]); w.y = cvt_pk_bf16(o[2], o[3]); *(u32x2v*)(xb + off) = w; }
                        ss += (o[0] * o[0] + o[1] * o[1]) + (o[2] * o[2] + o[3] * o[3]);
                    }
                ss += __shfl_xor(ss, 16); ss += __shfl_xor(ss, 32);
                if (fq == 0) rowss[(size_t)row * 16 + u.pn * 4 + wc] = ss;
                asm volatile("" ::: "memory");
            }
    }
};
template <class Epi, class Sched, bool ALIGN_EPI = false, bool SP2 = false>
__device__ __forceinline__ void gemm_phase(PG8_LAS unsigned char* lds, const Gemm g, const Sched& S, const Epi& E) {
    const int tid_ = mk_tid(lds);
    const int tid = tid_, wid = __builtin_amdgcn_readfirstlane(tid >> 6), lane = tid & 63, wr = wid >> 2, wc = wid & 3, fr = lane & 15, fq = lane >> 4;
    const int K = g.K, nt = K / BK;
    unsigned voffA[2], voffB[2];
#pragma unroll
    for (int i = 0; i < 2; ++i) { int R, C; stage_rc(tid * 16 + i * 8192, R, C); const int Rb = Epi::PERM ? ((R & ~31) + perm32(R & 31)) : R;
        voffA[i] = (unsigned)(R * K + C) * 2u; voffB[i] = (unsigned)(Rb * K + C) * 2u; }
    const size_t kstep = (size_t)(BK * 2);
    const size_t hstep = (size_t)HALF * K * 2;
    const size_t tstep = 2 * hstep;
    const unsigned ldsw = (unsigned)wid * 1024u;
    const int aoff = lds_byte(wr * 64 + fr, fq * 8), boff = lds_byte(wc * 32 + fr, fq * 8);
#define PG8_SA(b, h) (((b) * 2 + (h)) * HTB)
#define PG8_SB(b, h) ((4 + (b) * 2 + (h)) * HTB)
#define PG8_STAGE(bufoff, gbase, voff) do { _Pragma("unroll") for (int _i = 0; _i < 2; ++_i) \
        __builtin_amdgcn_global_load_lds((const unsigned*)((const char*)(gbase) + (voff)[_i]), (PG8_LAS unsigned*)(lds + (bufoff) + ldsw + _i * 8192), 16, 0, 0); } while (0)
#define PG8_LDA(dst, b, h) do { _Pragma("unroll") for (int m = 0; m < 4; ++m) _Pragma("unroll") for (int k = 0; k < 2; ++k) dst[m][k] = *(const PG8_LAS bf16x8*)(lds + PG8_SA(b, h) + aoff + m * 2048 + k * 1024); } while (0)
#define PG8_LDB(dst, b, h) do { _Pragma("unroll") for (int n = 0; n < 2; ++n) _Pragma("unroll") for (int k = 0; k < 2; ++k) dst[n][k] = *(const PG8_LAS bf16x8*)(lds + PG8_SB(b, h) + boff + n * 2048 + k * 1024); } while (0)
#define PG8_MMA(ai, bj, At, Bt) do { __builtin_amdgcn_s_setprio(1); _Pragma("unroll") for (int m = 0; m < 4; ++m) _Pragma("unroll") for (int n = 0; n < 2; ++n) _Pragma("unroll") for (int k = 0; k < 2; ++k) \
        acc[ai][bj][m][n] = __builtin_amdgcn_mfma_f32_16x16x32_bf16(Bt[n][k], At[m][k], acc[ai][bj][m][n], 0, 0, 0); __builtin_amdgcn_s_setprio(0); } while (0)
#define PG8_WAIT_V(n) asm volatile("s_waitcnt vmcnt(" #n ")" ::: "memory")
#define PG8_WAIT_L(n) asm volatile("s_waitcnt lgkmcnt(" #n ")" ::: "memory")
#define PG8_BAR __builtin_amdgcn_s_barrier()
#define PG8_SCHED __builtin_amdgcn_sched_barrier(0)
    Unit cur, nxt; int ui = 0;
    if (!S.next(0, cur)) return;
    f32x4 acc[2][2][4][2];
#pragma unroll
    for (int a = 0; a < 2; ++a)
#pragma unroll
        for (int b = 0; b < 2; ++b)
#pragma unroll
            for (int m = 0; m < 4; ++m)
#pragma unroll
                for (int n = 0; n < 2; ++n) acc[a][b][m][n] = (f32x4){0.f, 0.f, 0.f, 0.f};
    bf16x8 At[4][2], B0[2][2], B1[2][2];
    const char* cA = (const char*)g.A + (size_t)cur.pm * tstep; const char* cB = (const char*)g.Bt + (size_t)cur.pn * tstep;
    S.a_ready(cur);
    if constexpr (SP2) {
        PG8_STAGE(PG8_SB(0, 0), cB, voffB); PG8_STAGE(PG8_SB(0, 1), cB + hstep, voffB); PG8_STAGE(PG8_SA(0, 0), cA, voffA); PG8_STAGE(PG8_SA(0, 1), cA + hstep, voffA);
        if (wr == 1) PG8_BAR;
        PG8_WAIT_V(2); PG8_BAR;
        PG8_STAGE(PG8_SB(1, 0), cB + kstep, voffB); PG8_STAGE(PG8_SA(1, 0), cA + kstep, voffA); PG8_STAGE(PG8_SB(1, 1), cB + hstep + kstep, voffB);
        PG8_WAIT_V(6); PG8_BAR;
    } else {
        PG8_STAGE(PG8_SB(0, 0), cB, voffB); PG8_STAGE(PG8_SA(0, 0), cA, voffA); PG8_STAGE(PG8_SB(0, 1), cB + hstep, voffB); PG8_STAGE(PG8_SA(0, 1), cA + hstep, voffA);
        if (wr == 1) PG8_BAR;
        PG8_WAIT_V(4); PG8_BAR;
        PG8_STAGE(PG8_SB(1, 0), cB + kstep, voffB); PG8_STAGE(PG8_SA(1, 0), cA + kstep, voffA); PG8_STAGE(PG8_SB(1, 1), cB + hstep + kstep, voffB);
        PG8_WAIT_V(6); PG8_BAR;
    }
    for (;;) {
        const bool has_next = S.next(ui + 1, nxt);
        const char* nA = has_next ? (const char*)g.A + (size_t)nxt.pm * tstep : cA; const char* nB = has_next ? (const char*)g.Bt + (size_t)nxt.pn * tstep : cB;
        for (int t = 0; t < nt; t += 2) {
            const bool last = (t == nt - 2);
            const char* a1 = cA + (size_t)(t + 1) * kstep;
            const char* a2 = last ? nA : cA + (size_t)(t + 2) * kstep; const char* b2 = last ? nB : cB + (size_t)(t + 2) * kstep;
            const char* a3 = a2 + kstep; const char* b3 = b2 + kstep;
            if (last && has_next) S.a_ready(nxt);
            if constexpr (SP2) {
            PG8_LDB(B0, 0, 0); PG8_LDB(B1, 0, 1); PG8_SCHED; PG8_LDA(At, 0, 0); PG8_STAGE(PG8_SA(1, 1), a1 + hstep, voffA);
            PG8_WAIT_V(8); PG8_WAIT_L(0); PG8_BAR; PG8_MMA(0, 0, At, B0); PG8_MMA(0, 1, At, B1); PG8_BAR; PG8_SCHED;
            PG8_LDA(At, 0, 1); PG8_STAGE(PG8_SB(0, 0), b2, voffB); PG8_STAGE(PG8_SB(0, 1), b2 + hstep, voffB); PG8_STAGE(PG8_SA(0, 0), a2, voffA);
            PG8_WAIT_V(8); PG8_WAIT_L(0); PG8_BAR; PG8_MMA(1, 0, At, B0); PG8_MMA(1, 1, At, B1); PG8_BAR; PG8_SCHED;
            PG8_LDB(B0, 1, 0); PG8_LDB(B1, 1, 1); PG8_SCHED; PG8_LDA(At, 1, 0); PG8_STAGE(PG8_SA(0, 1), a2 + hstep, voffA);
            PG8_WAIT_V(8); PG8_WAIT_L(0); PG8_BAR; PG8_MMA(0, 0, At, B0); PG8_MMA(0, 1, At, B1); PG8_BAR; PG8_SCHED;
            PG8_LDA(At, 1, 1); PG8_STAGE(PG8_SB(1, 0), b3, voffB); PG8_STAGE(PG8_SB(1, 1), b3 + hstep, voffB); PG8_STAGE(PG8_SA(1, 0), a3, voffA);
            PG8_WAIT_V(8); PG8_WAIT_L(0); PG8_BAR; PG8_MMA(1, 0, At, B0); PG8_MMA(1, 1, At, B1); PG8_BAR; PG8_SCHED;
            } else {
            PG8_LDB(B0, 0, 0); PG8_SCHED; PG8_LDA(At, 0, 0); PG8_STAGE(PG8_SA(1, 1), a1 + hstep, voffA);
            PG8_WAIT_L(8); PG8_BAR; PG8_WAIT_L(0); PG8_MMA(0, 0, At, B0); PG8_BAR; PG8_SCHED;
            PG8_LDB(B1, 0, 1); PG8_STAGE(PG8_SB(0, 0), b2, voffB);
            PG8_BAR; PG8_WAIT_L(0); PG8_MMA(0, 1, At, B1); PG8_BAR;
            PG8_LDA(At, 0, 1); PG8_STAGE(PG8_SA(0, 0), a2, voffA);
            PG8_BAR; PG8_WAIT_L(0); PG8_MMA(1, 0, At, B0); PG8_BAR; PG8_SCHED;
            PG8_STAGE(PG8_SB(0, 1), b2 + hstep, voffB);
            PG8_WAIT_V(6); PG8_BAR; PG8_MMA(1, 1, At, B1); PG8_BAR;
            PG8_LDB(B0, 1, 0); PG8_SCHED; PG8_LDA(At, 1, 0); PG8_STAGE(PG8_SA(0, 1), a2 + hstep, voffA);
            PG8_WAIT_L(8); PG8_BAR; PG8_WAIT_L(0); PG8_MMA(0, 0, At, B0); PG8_BAR; PG8_SCHED;
            PG8_LDB(B1, 1, 1); PG8_STAGE(PG8_SB(1, 0), b3, voffB);
            PG8_BAR; PG8_WAIT_L(0); PG8_MMA(0, 1, At, B1); PG8_BAR;
            PG8_LDA(At, 1, 1); PG8_STAGE(PG8_SA(1, 0), a3, voffA);
            PG8_BAR; PG8_WAIT_L(0); PG8_MMA(1, 0, At, B0); PG8_BAR; PG8_SCHED;
            PG8_STAGE(PG8_SB(1, 1), b3 + hstep, voffB);
            PG8_WAIT_V(6); PG8_BAR; PG8_MMA(1, 1, At, B1); PG8_BAR;
            }
        }
        if constexpr (ALIGN_EPI) { if (wr == 0) PG8_BAR; }
        if constexpr (!Epi::AFTER_DRAIN) { E(acc, cur, wr, wc, fr, fq); S.done(cur); }
        if (!has_next) break;
#pragma unroll
        for (int a = 0; a < 2; ++a)
#pragma unroll
            for (int b = 0; b < 2; ++b)
#pragma unroll
                for (int m = 0; m < 4; ++m)
#pragma unroll
                    for (int n = 0; n < 2; ++n) acc[a][b][m][n] = (f32x4){0.f, 0.f, 0.f, 0.f};
        cur = nxt; cA = nA; cB = nB; ++ui;
        if constexpr (ALIGN_EPI) { if (wr == 1) PG8_BAR; }
    }
    PG8_WAIT_V(0);
    if constexpr (!ALIGN_EPI) { if (wr == 0) PG8_BAR; }
    PG8_BAR;
    if constexpr (Epi::AFTER_DRAIN) { E.fused(acc, cur, wr, wc, fr, fq, lds, wid, lane); S.done(cur); }
#undef PG8_SA
#undef PG8_SB
#undef PG8_STAGE
#undef PG8_LDA
#undef PG8_LDB
#undef PG8_MMA
#undef PG8_WAIT_V
#undef PG8_WAIT_L
#undef PG8_BAR
#undef PG8_SCHED
}
}
#define GAS __attribute__((address_space(1)))
#define LAS __attribute__((address_space(3)))
typedef unsigned short bf16;
typedef unsigned v4u __attribute__((ext_vector_type(4)));
typedef float f32x4 __attribute__((ext_vector_type(4)));
typedef short bf16x8 __attribute__((ext_vector_type(8)));
typedef GAS unsigned gu32;
typedef GAS unsigned long long gu64;
#define RLX_AGENT __ATOMIC_RELAXED, __HIP_MEMORY_SCOPE_AGENT
#define LDS_WAIT() asm volatile("s_waitcnt lgkmcnt(0)" ::: "memory")
#define VM_WAIT() asm volatile("s_waitcnt vmcnt(0)" ::: "memory")
__device__ __forceinline__ unsigned long long rt() { return __builtin_amdgcn_s_memrealtime(); }
__device__ __forceinline__ unsigned f2bf(float f) { unsigned u = __builtin_bit_cast(unsigned, f); return (u + 0x7fffu + ((u >> 16) & 1u)) >> 16; }
__device__ __forceinline__ unsigned pk2(float lo, float hi) { return f2bf(lo) | (f2bf(hi) << 16); }

#define XB_TMO      128
#define XB_XCNT(j)  (256  + 64 * (j))
#define XB_XSUB(j)  (1280 + 64 * (j))
#define XB_XGEN(j)  (2304 + 64 * (j))
#define XB_TOP      3328
#define XB_TOPGEN   3392
#define XCD_BAR_WORDS 3456
#define XB_SPIN_CAP (1u << 18)

__device__ __forceinline__ unsigned xb_ld(unsigned* p)              { return __hip_atomic_load(p, __ATOMIC_RELAXED, __HIP_MEMORY_SCOPE_AGENT); }
__device__ __forceinline__ unsigned xb_add(unsigned* p, unsigned v) { return __hip_atomic_fetch_add(p, v, __ATOMIC_RELAXED, __HIP_MEMORY_SCOPE_AGENT); }
__device__ __forceinline__ unsigned xb_xcc_id() { return (unsigned)__builtin_amdgcn_s_getreg((3 << 11) | 20) & 0xFu; }
#define XB_SPIN(cond, bar) do { unsigned _sp = 0; while (cond) { __builtin_amdgcn_s_sleep(1); \
    if ((++_sp & 255u) == 0u) { if (xb_ld(&(bar)[XB_TMO])) break; if (_sp > XB_SPIN_CAP) { atomicAdd(&(bar)[XB_TMO], 1u); break; } } } } while (0)

struct XcdBarrier {
    unsigned* bar; unsigned x;
    volatile LAS unsigned* st;
};

__device__ __forceinline__ XcdBarrier xcd_barrier_post(unsigned* bar, volatile LAS unsigned* st) {
    XcdBarrier b; b.bar = bar; b.x = xb_xcc_id(); b.st = st;
    if (threadIdx.x == 0) (void)xb_add(&bar[XB_XCNT(b.x)], 1u);
    return b;
}
__device__ __forceinline__ void xcd_barrier_complete(unsigned* bar, unsigned x, unsigned& nloc, unsigned& nx) {
    const unsigned G = gridDim.x * gridDim.y * gridDim.z;
    unsigned sum, cnt, mine, sp = 0u;
    for (;;) {
        sum = 0u; cnt = 0u; mine = 0u;
#pragma unroll
        for (unsigned j = 0; j < 16; ++j) { const unsigned c = xb_ld(&bar[XB_XCNT(j)]); sum += c; cnt += (c > 0u) ? 1u : 0u; mine = (j == x) ? c : mine; }
        if (sum == G) break;
        __builtin_amdgcn_s_sleep(1);
        if ((++sp & 255u) == 0u) { if (xb_ld(&bar[XB_TMO])) break; if (sp > XB_SPIN_CAP) { atomicAdd(&bar[XB_TMO], 1u); break; } }
    }
    nloc = mine > 0u ? mine : 1u; nx = cnt > 0u ? cnt : 1u;
}

__device__ __forceinline__ void xcd_barrier(const XcdBarrier& b) {
    asm volatile("s_waitcnt vmcnt(0)" ::: "memory");
    __syncthreads();
    if (pg8::mk_tid((LAS unsigned char*)b.st - (131072 + 320 + 32)) == 0) {
        unsigned* bar = b.bar;
        __builtin_amdgcn_s_waitcnt(0);
        unsigned nloc = b.st[0], nx = b.st[1];
        if (nloc == 0u) { xcd_barrier_complete(bar, b.x, nloc, nx); b.st[0] = nloc; b.st[1] = nx; }
        const unsigned old = xb_add(&bar[XB_XSUB(b.x)], 1u);
        const unsigned gen = old / nloc;
        if (old + 1u == (gen + 1u) * nloc) {
            __builtin_amdgcn_fence(__ATOMIC_RELEASE, "agent");
            asm volatile("s_waitcnt vmcnt(0)" ::: "memory");
            const unsigned og = xb_add(&bar[XB_TOP], 1u);
            const unsigned tg = og / nx;
            if (og + 1u == (tg + 1u) * nx) xb_add(&bar[XB_TOPGEN], 1u);
            else XB_SPIN(xb_ld(&bar[XB_TOPGEN]) == tg, bar);
            __builtin_amdgcn_fence(__ATOMIC_ACQUIRE, "agent");
            xb_add(&bar[XB_XGEN(b.x)], 1u);
            asm volatile("s_waitcnt vmcnt(0)" ::: "memory");
        } else {
            XB_SPIN(xb_ld(&bar[XB_XGEN(b.x)]) == gen, bar);
            __builtin_amdgcn_fence(__ATOMIC_ACQUIRE, "agent");
            asm volatile("s_waitcnt vmcnt(0)" ::: "memory");
        }
    }
    __syncthreads();
}
constexpr int BATCH = 8, SEQ = 2048, M = BATCH * SEQ, D = 1024, NIN = 3448, NP = 3584;
constexpr float NORM_EPS = 1e-6f;
constexpr float LOG2E = 1.4426950408889634f;
constexpr size_t MiB = 1u << 20;
constexpr size_t WS_CTL = 0, CTL_ZERO_BYTES = 1 * MiB;
constexpr size_t WS_ROWSS = 1 * MiB;
constexpr size_t WS_WIN = 2 * MiB;
constexpr size_t WS_WOUT = 16 * MiB;
constexpr size_t WS_WSMALL = 20 * MiB;
constexpr size_t OFF_WUQ = 0, OFF_WUKV = 2 * 576 * 192 * 2, OFF_W2T = OFF_WUKV + 2 * 768 * 128 * 2, OFF_A2T = OFF_W2T + 2 * 2 * 256 * 64 * 2;
constexpr size_t WS_PSM = 22 * MiB;
constexpr size_t WS_CB = 24 * MiB;
constexpr size_t WS_PGATE = 25 * MiB;
constexpr size_t WS_PGDN = 57 * MiB;
constexpr size_t WS_PMLA = 93 * MiB;
constexpr size_t WS_PRW = 104 * MiB;
constexpr size_t WS_OGDN = 93 * MiB;
constexpr size_t WS_OMLA = 105 * MiB;
constexpr size_t WS_Y = 117 * MiB;
constexpr size_t WS_RS = 133 * MiB;
constexpr size_t WS_RD = 157 * MiB;
constexpr size_t WS_XB = 133 * MiB;
constexpr size_t WS_Q = 207 * MiB;
constexpr size_t WS_K = 225 * MiB;
constexpr size_t WS_VT = 243 * MiB;
constexpr size_t WS_MIX = 207 * MiB;
constexpr size_t WS_END = 255 * MiB;
constexpr int RS_REC = 384, RD_REC = 400;
constexpr size_t RD_DIR = (size_t)BATCH * 4 * SEQ * RD_REC;
constexpr int CW_BAR = 4096;
constexpr int CW_QUEUE = 16384;

constexpr int NWAVES = 8;
constexpr int RING_OFF = 0, RING_BYTES = 131072, LDSCTL_OFF = RING_BYTES, MISC_OFF = LDSCTL_OFF + 320, LDS_BYTES = 147456;
static_assert(pg8::TIDTAB_OFF == MISC_OFF + 512 && RING_OFF == 0, "LDS map");
constexpr int NPHASE = 12;

__device__ __forceinline__ float bf2f(bf16 v) { return __uint_as_float(((unsigned)v) << 16); }
__device__ __forceinline__ float wave_sum(float v) {
#pragma unroll
    for (int o = 1; o < 64; o <<= 1) v += __shfl_xor(v, o);
    return v;
}
__device__ __forceinline__ float siluf(float x) { return x * __builtin_amdgcn_rcpf(1.f + __expf(-x)); }
__device__ __forceinline__ float sigmoidf_(float x) { return __builtin_amdgcn_rcpf(1.f + __expf(-x)); }
__device__ __forceinline__ float softplusf_(float x) { return x > 20.f ? x : log1pf(__expf(x)); }

struct Args { const void* in[24]; float* out; unsigned char* ws; int ph_lo, ph_hi; };

struct Frame {
    LAS unsigned char* lds;
    volatile LAS unsigned* MISC;
    gu32* ctl;
    int tid, lane, wave, vcu, G;
    unsigned char* ws;
    float* out;
    volatile LAS const unsigned long long* ptab;
};
__device__ __forceinline__ const void* inptr(const Frame& F, int k) {
    const unsigned long long v = F.ptab[k];
    const unsigned lo = __builtin_amdgcn_readfirstlane((unsigned)v), hi = __builtin_amdgcn_readfirstlane((unsigned)(v >> 32));
    return (const void*)(GAS const void*)(((unsigned long long)hi << 32) | lo);
}

__device__ __forceinline__ void tr_item(const float* W, int K, int ldsrc, int scol, int nvalid, bf16* WT, const float* gs, LAS float* scr, int kb, int lane) {
    const int k0 = 64 * kb;
#pragma unroll 8
    for (int i = 0; i < 32; ++i) { const int kk = 2 * i + (lane >> 5), n = lane & 31; float v = 0.f;
        if (n < nvalid) { v = W[(size_t)(k0 + kk) * ldsrc + scol + n]; if (gs) v *= gs[k0 + kk]; }
        scr[kk * 33 + n] = v; }
    LDS_WAIT(); asm volatile("" ::: "memory");
    const int c = lane & 7;
#pragma unroll
    for (int j = 0; j < 4; ++j) { const int n = (lane >> 3) + 8 * j; const LAS float* s = scr + (8 * c) * 33 + n;
        v4u o; o.x = pk2(s[0 * 33], s[1 * 33]); o.y = pk2(s[2 * 33], s[3 * 33]); o.z = pk2(s[4 * 33], s[5 * 33]); o.w = pk2(s[6 * 33], s[7 * 33]);
        *(GAS v4u*)(WT + (size_t)n * K + k0 + 8 * c) = o; }
    LDS_WAIT(); asm volatile("" ::: "memory");
}
__device__ __forceinline__ void p0_prologue(Frame& F) {
    LAS float* scr = (LAS float*)(F.lds + RING_OFF + F.wave * 16384);
    const int gw = F.vcu * NWAVES + F.wave, NGW = F.G * NWAVES;
    constexpr int I_IN = 112 * 16, I_OUT = 32 * 16, I_UQ = 18 * 3, I_UKV = 24 * 2, I_W2 = 16, I_A2 = 16, I_L = I_IN + I_OUT + I_UQ + I_UKV + I_W2 + I_A2;
    for (int it = gw; it < 2 * I_L; it += NGW) {
        const int l = it / I_L; int r = it % I_L;
        if (r < I_IN) { const int nb = r >> 4, kb = r & 15, n0 = 32 * nb; int scol, nv;
            if (n0 < 2176) { scol = n0; nv = 32; } else if (n0 < 3424) { scol = n0 + 24; nv = 32; } else if (n0 == 3424) { scol = 2176; nv = 24; } else { scol = 0; nv = 0; }
            tr_item((const float*)inptr(F, 3) + (size_t)l * D * NIN, D, NIN, scol, nv, (bf16*)(F.ws + WS_WIN) + ((size_t)l * NP + n0) * D, (const float*)inptr(F, 2) + l * D, scr, kb, F.lane); continue; }
        r -= I_IN;
        if (r < I_OUT) { const int nb = r >> 4, kb = r & 15;
            tr_item((const float*)inptr(F, 22) + (size_t)l * D * D, D, D, 32 * nb, 32, (bf16*)(F.ws + WS_WOUT) + ((size_t)l * D + 32 * nb) * D, nullptr, scr, kb, F.lane); continue; }
        r -= I_OUT;
        if (r < I_UQ) { const int nb = r / 3, kb = r % 3;
            tr_item((const float*)inptr(F, 9) + (size_t)l * 192 * 576, 192, 576, 32 * nb, 32, (bf16*)(F.ws + WS_WSMALL + OFF_WUQ) + ((size_t)l * 576 + 32 * nb) * 192, (const float*)inptr(F, 8) + l * 192, scr, kb, F.lane); continue; }
        r -= I_UQ;
        if (r < I_UKV) { const int nb = r >> 1, kb = r & 1;
            tr_item((const float*)inptr(F, 11) + (size_t)l * 128 * 768, 128, 768, 32 * nb, 32, (bf16*)(F.ws + WS_WSMALL + OFF_WUKV) + ((size_t)l * 768 + 32 * nb) * 128, (const float*)inptr(F, 10) + l * 128, scr, kb, F.lane); continue; }
        r -= I_UKV;
        if (r < I_W2) { const int e = r >> 3, nb = r & 7;
            tr_item((const float*)inptr(F, 14) + ((size_t)l * 2 + e) * 64 * 256, 64, 256, 32 * nb, 32, (bf16*)(F.ws + WS_WSMALL + OFF_W2T) + (((size_t)l * 2 + e) * 256 + 32 * nb) * 64, nullptr, scr, 0, F.lane); continue; }
        r -= I_W2;
        { const int e = r >> 3, nb = r & 7;
            tr_item((const float*)inptr(F, 16) + ((size_t)l * 2 + e) * 64 * 256, 64, 256, 32 * nb, 32, (bf16*)(F.ws + WS_WSMALL + OFF_A2T) + (((size_t)l * 2 + e) * 256 + 32 * nb) * 64, nullptr, scr, 0, F.lane); }
    }
    const float* x = (const float*)inptr(F, 0); bf16* xb = (bf16*)(F.ws + WS_XB); float* rowss = (float*)(F.ws + WS_ROWSS);
    for (int m = gw; m < M; m += NGW) {
        const GAS f32x4* xr = (const GAS f32x4*)(x + (size_t)m * D) + F.lane;
        GAS unsigned long long* o8 = (GAS unsigned long long*)(xb + (size_t)m * D) + F.lane; float s = 0.f;
#pragma unroll
        for (int j = 0; j < 4; ++j) { const f32x4 v = xr[64 * j]; s += (v.x * v.x + v.y * v.y) + (v.z * v.z + v.w * v.w);
            o8[64 * j] = (unsigned long long)pk2(v.x, v.y) | ((unsigned long long)pk2(v.z, v.w) << 32); }
        s = wave_sum(s);
        if (F.lane < 16) rowss[(size_t)m * 16 + F.lane] = F.lane == 0 ? s : 0.f;
    }
}
__device__ __forceinline__ void p5_final(Frame& F) {
    const int gw = F.vcu * NWAVES + F.wave, NGW = F.G * NWAVES;
    const float* rowss = (const float*)(F.ws + WS_ROWSS); const float* g = (const float*)inptr(F, 23);
    f32x4 gv[4];
#pragma unroll
    for (int j = 0; j < 4; ++j) gv[j] = ((const f32x4*)g)[F.lane + 64 * j];
    for (int m = gw; m < M; m += NGW) {
        float ss = F.lane < 16 ? rowss[(size_t)m * 16 + F.lane] : 0.f;
        ss = wave_sum(ss);
        const float rstd = rsqrtf(ss * (1.f / D) + NORM_EPS);
        GAS f32x4* xr = (GAS f32x4*)(F.out + (size_t)m * D) + F.lane;
#pragma unroll
        for (int j = 0; j < 4; ++j) { f32x4 v = xr[64 * j]; v = v * rstd * gv[j]; xr[64 * j] = v; }
    }
}
typedef float f32x16 __attribute__((ext_vector_type(16)));
typedef unsigned long long u64_t;
__device__ __forceinline__ bf16x8 mk_bf16x8(u64_t lo, u64_t hi) { typedef u64_t u64x2 __attribute__((ext_vector_type(2))); u64x2 v = {lo, hi}; return __builtin_bit_cast(bf16x8, v); }

constexpr int AT_KP = 208, AT_VP = 136, AT_KBYTES = 64 * AT_KP, AT_VBYTES = 64 * AT_VP, AT_BUF = AT_KBYTES + AT_VBYTES;
__device__ __forceinline__ float at_max3(float a, float b, float c) { float r; asm("v_max3_f32 %0, %1, %2, %3" : "=v"(r) : "v"(a), "v"(b), "v"(c)); return r; }
__device__ __forceinline__ void attn_unit(Frame& F, int unit) {
    const int bh = unit >> 3, qb = unit & 7, b = bh / 6, h = bh % 6;
    const int tid = F.tid, lane = F.lane, wave = F.wave, r32 = lane & 31, hi = lane >> 5;
    const bf16* Qg = (const bf16*)(F.ws + WS_Q) + ((size_t)bh * SEQ + qb * 256 + wave * 32 + r32) * 96;
    const bf16* Kg = (const bf16*)(F.ws + WS_K) + (size_t)bh * SEQ * 96;
    const bf16* Vg = (const bf16*)(F.ws + WS_VT) + (size_t)bh * 64 * SEQ;
    LAS unsigned char* lds = F.lds + RING_OFF;
    bf16x8 qf[6];
#pragma unroll
    for (int s = 0; s < 6; ++s) qf[s] = *(const bf16x8*)(Qg + 16 * s + 8 * hi);
    const int kr0 = tid / 12, kc0 = tid % 12, kr1 = (512 + tid) / 12, kc1 = (512 + tid) % 12, vd = tid >> 3, vc = tid & 7;
    const bool has1 = tid < 256;
    v4u ka0, ka1 = {0u, 0u, 0u, 0u}, va, kb0, kb1 = {0u, 0u, 0u, 0u}, vb;
#define AT_LOAD(K0, K1, V_, t0) do { K0 = *(const v4u*)(Kg + (size_t)((t0) + kr0) * 96 + kc0 * 8); if (has1) K1 = *(const v4u*)(Kg + (size_t)((t0) + kr1) * 96 + kc1 * 8); \
        V_ = *(const v4u*)(Vg + (size_t)vd * SEQ + (t0) + vc * 8); } while (0)
#define AT_STORE(K0, K1, V_, buf) do { LAS unsigned char* bb_ = lds + (buf) * AT_BUF; *(LAS v4u*)(bb_ + kr0 * AT_KP + kc0 * 16) = K0; if (has1) *(LAS v4u*)(bb_ + kr1 * AT_KP + kc1 * 16) = K1; \
        LAS u64_t* vp_ = (LAS u64_t*)(bb_ + AT_KBYTES + vd * AT_VP + vc * 16); vp_[0] = (u64_t)V_.x | ((u64_t)V_.y << 32); vp_[1] = (u64_t)V_.z | ((u64_t)V_.w << 32); } while (0)
    AT_LOAD(ka0, ka1, va, 0); AT_STORE(ka0, ka1, va, 0);
    AT_LOAD(ka0, ka1, va, 64);
    __syncthreads();
    f32x16 o0 = {}, o1 = {};
    float mrun = -1e30f, lsum = 0.f;
    constexpr int NT = SEQ / 64;
    auto tile = [&](int t) {
        LAS unsigned char* bb = lds + (t % 3) * AT_BUF;
        f32x16 p0 = {}, p1 = {};
        { const LAS unsigned char* kb = bb + r32 * AT_KP + hi * 16;
#pragma unroll
          for (int s = 0; s < 6; ++s) {
              const bf16x8 a0 = *(const LAS bf16x8*)(kb + 32 * s), a1 = *(const LAS bf16x8*)(kb + 32 * AT_KP + 32 * s);
              p0 = __builtin_amdgcn_mfma_f32_32x32x16_bf16(a0, qf[s], p0, 0, 0, 0);
              p1 = __builtin_amdgcn_mfma_f32_32x32x16_bf16(a1, qf[s], p1, 0, 0, 0); } }
        float ma = at_max3(p0[0], p0[1], p1[0]), mb = at_max3(p0[2], p0[3], p1[1]); ma = at_max3(ma, p1[2], p1[3]);
#pragma unroll
        for (int r = 4; r < 16; r += 4) { ma = at_max3(ma, p0[r], p0[r + 1]); mb = at_max3(mb, p0[r + 2], p0[r + 3]); ma = at_max3(ma, p1[r], p1[r + 1]); mb = at_max3(mb, p1[r + 2], p1[r + 3]); }
        float mloc = at_max3(ma, mb, mrun);
        { const auto rr = __builtin_amdgcn_permlane32_swap(__float_as_uint(mloc), __float_as_uint(mloc), false, false); mloc = at_max3(__uint_as_float(rr[0]), __uint_as_float(rr[1]), mloc); }
        const float mnew = mloc, alpha = __builtin_amdgcn_exp2f(mrun - mnew);
        mrun = mnew; lsum *= alpha;
#pragma unroll
        for (int r = 0; r < 16; ++r) { o0[r] *= alpha; o1[r] *= alpha; }
        float ps = 0.f;
#pragma unroll
        for (int r = 0; r < 16; ++r) { p0[r] = __builtin_amdgcn_exp2f(p0[r] - mnew); p1[r] = __builtin_amdgcn_exp2f(p1[r] - mnew); ps += p0[r] + p1[r]; }
        lsum += ps;
        v4u pk[4];
#pragma unroll
        for (int s2 = 0; s2 < 2; ++s2) {
            pk[s2] = (v4u){pg8::cvt_pk_bf16(p0[8 * s2], p0[8 * s2 + 1]), pg8::cvt_pk_bf16(p0[8 * s2 + 2], p0[8 * s2 + 3]), pg8::cvt_pk_bf16(p0[8 * s2 + 4], p0[8 * s2 + 5]), pg8::cvt_pk_bf16(p0[8 * s2 + 6], p0[8 * s2 + 7])};
            pk[2 + s2] = (v4u){pg8::cvt_pk_bf16(p1[8 * s2], p1[8 * s2 + 1]), pg8::cvt_pk_bf16(p1[8 * s2 + 2], p1[8 * s2 + 3]), pg8::cvt_pk_bf16(p1[8 * s2 + 4], p1[8 * s2 + 5]), pg8::cvt_pk_bf16(p1[8 * s2 + 6], p1[8 * s2 + 7])};
        }
        { const LAS unsigned char* vb_ = bb + AT_KBYTES + r32 * AT_VP + hi * 8;
#pragma unroll
          for (int ks = 0; ks < 4; ++ks) {
              const bf16x8 pb = __builtin_bit_cast(bf16x8, pk[ks]);
              const bf16x8 v0 = mk_bf16x8(*(const LAS u64_t*)(vb_ + ks * 32), *(const LAS u64_t*)(vb_ + ks * 32 + 16));
              const bf16x8 v1 = mk_bf16x8(*(const LAS u64_t*)(vb_ + 32 * AT_VP + ks * 32), *(const LAS u64_t*)(vb_ + 32 * AT_VP + ks * 32 + 16));
              o0 = __builtin_amdgcn_mfma_f32_32x32x16_bf16(v0, pb, o0, 0, 0, 0);
              o1 = __builtin_amdgcn_mfma_f32_32x32x16_bf16(v1, pb, o1, 0, 0, 0); } }
    };
    for (int t = 0; t < NT; t += 2) {
        if (t + 2 < NT) AT_LOAD(kb0, kb1, vb, (t + 2) * 64);
        tile(t);
        AT_STORE(ka0, ka1, va, (t + 1) % 3);
        __syncthreads();
        if (t + 3 < NT) AT_LOAD(ka0, ka1, va, (t + 3) * 64);
        tile(t + 1);
        if (t + 2 < NT) AT_STORE(kb0, kb1, vb, (t + 2) % 3);
        __syncthreads();
    }
#undef AT_LOAD
#undef AT_STORE
    lsum += __shfl_xor(lsum, 32);
    const float inv = 1.f / lsum;
    bf16* Og = (bf16*)(F.ws + WS_OMLA) + ((size_t)b * SEQ + qb * 256 + wave * 32 + r32) * 384 + h * 64 + 4 * hi;
#pragma unroll
    for (int rg = 0; rg < 4; ++rg) {
        *(u64_t*)(Og + 8 * rg) = (u64_t)pg8::cvt_pk_bf16(o0[4 * rg] * inv, o0[4 * rg + 1] * inv) | ((u64_t)pg8::cvt_pk_bf16(o0[4 * rg + 2] * inv, o0[4 * rg + 3] * inv) << 32);
        *(u64_t*)(Og + 32 + 8 * rg) = (u64_t)pg8::cvt_pk_bf16(o1[4 * rg] * inv, o1[4 * rg + 1] * inv) | ((u64_t)pg8::cvt_pk_bf16(o1[4 * rg + 2] * inv, o1[4 * rg + 3] * inv) << 32);
    }
}

constexpr int CW_FLAG = 32768;
__device__ __forceinline__ void partner_sync(Frame& F, gu32* mine, gu32* theirs) {
    asm volatile("s_waitcnt vmcnt(0)" ::: "memory");
    __syncthreads();
    if (F.tid == 0) {
        __builtin_amdgcn_fence(__ATOMIC_RELEASE, "agent");
        asm volatile("s_waitcnt vmcnt(0)" ::: "memory");
        __hip_atomic_store(mine, 1u, RLX_AGENT);
        unsigned spins = 0;
        while (__hip_atomic_load(theirs, RLX_AGENT) == 0u) { __builtin_amdgcn_s_sleep(4); if (++spins > (1u << 22)) break; }
        __builtin_amdgcn_fence(__ATOMIC_ACQUIRE, "agent");
        asm volatile("s_waitcnt vmcnt(0)" ::: "memory");
    }
    __syncthreads();
}
constexpr int RW_STEP = 1440, RW_CH = 32, RW_BUF = RW_CH * RW_STEP;
constexpr int RW_Y = 2 * RW_BUF;
static_assert(RW_Y + 2 * 4096 <= RING_BYTES, "RWKV LDS map");
__device__ __forceinline__ float dpp_xor1(float x) { return __builtin_bit_cast(float, __builtin_amdgcn_update_dpp(0, __builtin_bit_cast(int, x), 0xB1, 0xF, 0xF, true)); }
__device__ __forceinline__ float dpp_xor2(float x) { return __builtin_bit_cast(float, __builtin_amdgcn_update_dpp(0, __builtin_bit_cast(int, x), 0x4E, 0xF, 0xF, true)); }
__device__ __forceinline__ float dpp_hmir(float x) { return __builtin_bit_cast(float, __builtin_amdgcn_update_dpp(0, __builtin_bit_cast(int, x), 0x141, 0xF, 0xF, true)); }
__device__ __forceinline__ float dpp_rmir(float x) { return __builtin_bit_cast(float, __builtin_amdgcn_update_dpp(0, __builtin_bit_cast(int, x), 0x140, 0xF, 0xF, true)); }
template <int SKIP> __device__ __forceinline__ void rwkv_unit(Frame& F, int unit, gu32* flags) {
    const int bh = unit >> 2, rowhalf = (unit >> 1) & 1, dir = unit & 1, b = bh >> 2, h = bh & 3;
    const int tid = F.tid, lane = F.lane, ri = lane >> 4, cs = lane & 15, row = 4 * F.wave + ri;
    const bool stager = true;
    const unsigned char* Rs = F.ws + WS_RS + (size_t)bh * SEQ * RS_REC;
    const unsigned char* Rd = F.ws + WS_RD + dir * RD_DIR + (size_t)bh * SEQ * RD_REC;
    LAS unsigned char* lds = F.lds + RING_OFF;
    const int ss = tid >> 4, sp = tid & 15;
    u64_t g_kk = 0, g_r = 0, g_lam = 0, g_b = 0, g_k = 0, g_v = 0, g_s = 0;
#define RW_ISSUE(c_) do { const int n_ = (c_) * RW_CH + ss, t_ = dir ? SEQ - 1 - n_ : n_; const unsigned char* rs_ = Rs + (size_t)t_ * RS_REC; const unsigned char* rd_ = Rd + (size_t)t_ * RD_REC; \
        g_kk = *(const u64_t*)(rs_ + 8 * sp); g_r = *(const u64_t*)(rs_ + 256 + 8 * sp); g_lam = *(const u64_t*)(rd_ + 8 * sp); g_b = *(const u64_t*)(rd_ + 128 + 8 * sp); g_k = *(const u64_t*)(rd_ + 256 + 8 * sp); \
        if (sp < 8) g_v = *(const u64_t*)(rs_ + 128 + 64 * rowhalf + 8 * sp); if (sp == 8) g_s = *(const u64_t*)(rd_ + 384); } while (0)
#define RW_BF(x, j) __uint_as_float(((unsigned)((x) >> (16 * (j)))) << 16)
#define RW_STAGE(buf_) do { LAS unsigned char* d_ = lds + (buf_) * RW_BUF + ss * RW_STEP + 16 * sp; f32x4 w_, t4_; \
        w_[0] = __builtin_amdgcn_exp2f(-LOG2E * __half2float(__ushort_as_half((unsigned short)(g_lam)))); w_[1] = __builtin_amdgcn_exp2f(-LOG2E * __half2float(__ushort_as_half((unsigned short)(g_lam >> 16)))); \
        w_[2] = __builtin_amdgcn_exp2f(-LOG2E * __half2float(__ushort_as_half((unsigned short)(g_lam >> 32)))); w_[3] = __builtin_amdgcn_exp2f(-LOG2E * __half2float(__ushort_as_half((unsigned short)(g_lam >> 48)))); \
        *(LAS f32x4*)d_ = w_; \
        t4_ = (f32x4){RW_BF(g_r, 0), RW_BF(g_r, 1), RW_BF(g_r, 2), RW_BF(g_r, 3)}; *(LAS f32x4*)(d_ + 256) = w_ * t4_; \
        t4_ = (f32x4){RW_BF(g_kk, 0), RW_BF(g_kk, 1), RW_BF(g_kk, 2), RW_BF(g_kk, 3)}; *(LAS f32x4*)(d_ + 512) = -t4_; \
        t4_ = (f32x4){RW_BF(g_b, 0), RW_BF(g_b, 1), RW_BF(g_b, 2), RW_BF(g_b, 3)}; *(LAS f32x4*)(d_ + 768) = t4_; \
        t4_ = (f32x4){RW_BF(g_k, 0), RW_BF(g_k, 1), RW_BF(g_k, 2), RW_BF(g_k, 3)}; *(LAS f32x4*)(d_ + 1024) = t4_; \
        if (sp < 8) { t4_ = (f32x4){RW_BF(g_v, 0), RW_BF(g_v, 1), RW_BF(g_v, 2), RW_BF(g_v, 3)}; *(LAS f32x4*)(d_ + 1280) = t4_; } \
        if (sp == 8) *(LAS u64_t*)(lds + (buf_) * RW_BUF + ss * RW_STEP + 1408) = g_s; } while (0)
    f32x4 S0 = {0.f, 0.f, 0.f, 0.f};
    if (stager) { RW_ISSUE(0); RW_STAGE(0); }
    __syncthreads();
    bf16* Yg = (bf16*)(F.ws + WS_Y) + (size_t)b * SEQ * 256 + h * 64 + 32 * rowhalf;
    const int NCH = SEQ / RW_CH;
    for (int c = 0; c < NCH; ++c) {
        LAS float* ybuf = (LAS float*)(lds + RW_Y + (c & 1) * 4096);
        if (stager && c + 1 < NCH) RW_ISSUE(c + 1);
        unsigned short yold[2] = {0, 0};
        if (c >= NCH / 2) {
#pragma unroll
            for (int k = 0; k < 2; ++k) { const int o = tid + 512 * k, n = c * RW_CH + (o >> 5), t = dir ? SEQ - 1 - n : n; yold[k] = Yg[(size_t)t * 256 + (o & 31)]; } }
        { const LAS unsigned char* cb_ = lds + (c & 1) * RW_BUF + 16 * cs;
          const LAS unsigned char* vb_ = lds + (c & 1) * RW_BUF + 1280 + 4 * row;
#pragma unroll 8
          for (int s = 0; s < RW_CH; ++s) {
              const LAS unsigned char* p = cb_ + ((SKIP & 2) ? 0 : s) * RW_STEP;
              const f32x4 w = *(const LAS f32x4*)p, wr = *(const LAS f32x4*)(p + 256), nk = *(const LAS f32x4*)(p + 512), bb = *(const LAS f32x4*)(p + 768), kv = *(const LAS f32x4*)(p + 1024);
              typedef float f2 __attribute__((ext_vector_type(2)));
              const float v = *(const LAS float*)(vb_ + s * RW_STEP); const f2 brkr = *(const LAS f2*)(lds + (c & 1) * RW_BUF + s * RW_STEP + 1408);
              float sa0 = (S0[0] * nk[0] + S0[1] * nk[1]) + (S0[2] * nk[2] + S0[3] * nk[3]);
              float ym0 = (S0[0] * wr[0] + S0[1] * wr[1]) + (S0[2] * wr[2] + S0[3] * wr[3]);
              if (!(SKIP & 1)) {
              sa0 += dpp_xor1(sa0); ym0 += dpp_xor1(ym0);
              sa0 += dpp_xor2(sa0); ym0 += dpp_xor2(ym0);
              sa0 += dpp_hmir(sa0); ym0 += dpp_hmir(ym0);
              sa0 += dpp_rmir(sa0); ym0 += dpp_rmir(ym0); }
              S0 = S0 * w + (sa0 * bb + v * kv);
              if (cs == 0) ybuf[s * 32 + row] = ym0 + sa0 * brkr[0] + v * brkr[1];
          } }
        if (stager && c + 1 < NCH) RW_STAGE((c + 1) & 1);
        __syncthreads();
#pragma unroll
        for (int k = 0; k < 2; ++k) { const int o = tid + 512 * k, n = c * RW_CH + (o >> 5), t = dir ? SEQ - 1 - n : n;
            float y = ybuf[o]; if (c >= NCH / 2) y += bf2f(yold[k]);
            Yg[(size_t)t * 256 + (o & 31)] = (bf16)f2bf(y); }
        if (c == NCH / 2 - 1) partner_sync(F, flags + 64 * unit, flags + 64 * (unit ^ 1));
    }
#undef RW_ISSUE
#undef RW_STAGE
#undef RW_BF
    __syncthreads();
}

constexpr int GP = 144;
constexpr int G_Q = 0, G_K = 9216, G_V = 18432, G_KT = 27648, G_P = 36864, G_A = 46080, G_SM = 63488, G_GROUP = 64512;
constexpr int G_T = 92160;
constexpr int G_RAW = 65536;
constexpr int G_CW = 133120;
static_assert(2 * G_GROUP <= RING_BYTES && G_CW + 3840 <= LDS_BYTES && G_CW >= MISC_OFF + 1024, "GDN LDS map");
__device__ __forceinline__ bf16x8 ld2x8(const LAS unsigned char* p) { return mk_bf16x8(*(const LAS u64_t*)p, *(const LAS u64_t*)(p + 32)); }
__device__ __forceinline__ bf16x8 pack_acc(const f32x4& a, const f32x4& b) {
    v4u w; w.x = pg8::cvt_pk_bf16(a[0], a[1]); w.y = pg8::cvt_pk_bf16(a[2], a[3]); w.z = pg8::cvt_pk_bf16(b[0], b[1]); w.w = pg8::cvt_pk_bf16(b[2], b[3]); return __builtin_bit_cast(bf16x8, w); }
__device__ __forceinline__ void split_acc(const f32x4& a, const f32x4& b, bf16x8& hi, bf16x8& lo) {
    v4u wh; wh.x = pg8::cvt_pk_bf16(a[0], a[1]); wh.y = pg8::cvt_pk_bf16(a[2], a[3]); wh.z = pg8::cvt_pk_bf16(b[0], b[1]); wh.w = pg8::cvt_pk_bf16(b[2], b[3]);
    f32x4 ra, rb;
    ra[0] = a[0] - __uint_as_float(wh.x << 16); ra[1] = a[1] - __uint_as_float(wh.x & 0xffff0000u); ra[2] = a[2] - __uint_as_float(wh.y << 16); ra[3] = a[3] - __uint_as_float(wh.y & 0xffff0000u);
    rb[0] = b[0] - __uint_as_float(wh.z << 16); rb[1] = b[1] - __uint_as_float(wh.z & 0xffff0000u); rb[2] = b[2] - __uint_as_float(wh.w << 16); rb[3] = b[3] - __uint_as_float(wh.w & 0xffff0000u);
    hi = __builtin_bit_cast(bf16x8, wh); lo = pack_acc(ra, rb);
}
__device__ __forceinline__ void hilo4(const f32x4& a, u64_t& hi, u64_t& lo) {
    const unsigned h0 = pg8::cvt_pk_bf16(a[0], a[1]), h1 = pg8::cvt_pk_bf16(a[2], a[3]);
    const float r0 = a[0] - __uint_as_float(h0 << 16), r1 = a[1] - __uint_as_float(h0 & 0xffff0000u), r2 = a[2] - __uint_as_float(h1 << 16), r3 = a[3] - __uint_as_float(h1 & 0xffff0000u);
    hi = (u64_t)h0 | ((u64_t)h1 << 32); lo = (u64_t)pg8::cvt_pk_bf16(r0, r1) | ((u64_t)pg8::cvt_pk_bf16(r2, r3) << 32);
}
typedef _Float16 f16x8 __attribute__((ext_vector_type(8)));
__device__ __forceinline__ f16x8 pack_acc_f16(const f32x4& a, const f32x4& b) { return (f16x8){(_Float16)a[0], (_Float16)a[1], (_Float16)a[2], (_Float16)a[3], (_Float16)b[0], (_Float16)b[1], (_Float16)b[2], (_Float16)b[3]}; }
template <int SKIP> __device__ __forceinline__ void gdn_unit3(Frame& F, int l, int unit, gu32* flags) {
    const int bh = unit >> 1, dir = unit & 1, b = bh / 6, h = bh % 6;
    const int tid = F.tid, lane = F.lane, wave = F.wave;
    const bf16* Pgdn = (const bf16*)(F.ws + WS_PGDN) + (size_t)b * SEQ * 1152 + h * 64; const float* Psm = (const float*)(F.ws + WS_PSM) + (size_t)b * SEQ * 32;
    bf16* Og = (bf16*)(F.ws + WS_OGDN) + (size_t)b * SEQ * 384 + h * 64;
    LAS unsigned char* gb = F.lds + RING_OFF;
    LAS float* cwl = (LAS float*)(F.lds + G_CW);
    LAS float* sm = (LAS float*)(gb + G_SM);
    { const float* conv_w = (const float*)inptr(F, 4) + (size_t)l * 5 * 1152;
      for (int i = tid; i < 960; i += 512) { const int tn = i / 320, tap = (i % 320) / 64, ch = i % 64; cwl[i] = conv_w[tap * 1152 + tn * 384 + h * 64 + ch]; } }
    const float al = -__expf(((const float*)inptr(F, 5))[l * 12 + dir * 6 + h]), dtb = ((const float*)inptr(F, 6))[l * 12 + dir * 6 + h];
    f32x4 Sacc[4];
#pragma unroll
    for (int i = 0; i < 4; ++i) Sacc[i] = (f32x4){0.f, 0.f, 0.f, 0.f};
    const int ci = tid >> 3, cg = tid & 7;
#define GDN_RAW_STAGE(cc_, first_, nthr_) do { const int tlo_ = (dir ? SEQ - 64 * (cc_) - 64 : 64 * (cc_)) - 2; \
        for (int pc_ = (first_); pc_ < 68 * 24; pc_ += (nthr_)) { const int rr_ = pc_ / 24, sg_ = pc_ % 24, tt_ = tlo_ + rr_; v4u x_ = {0u, 0u, 0u, 0u}; \
            if (!(SKIP & 1) && tt_ >= 0 && tt_ < SEQ) x_ = *(const v4u*)(Pgdn + (size_t)tt_ * 1152 + (sg_ >> 3) * 384 + 8 * (sg_ & 7)); \
            *(LAS v4u*)(gb + G_RAW + rr_ * 384 + 16 * sg_) = x_; } } while (0)
#define GDN_WRITEOUT(cc_) do { if (!(SKIP & 4)) { const int t_ = dir ? SEQ - 1 - 64 * (cc_) - ci : 64 * (cc_) + ci; bf16* op_ = Og + (size_t)t_ * 384 + 8 * cg; \
            const LAS f32x4* src_ = (const LAS f32x4*)(gb + G_A + (ci * 68 + 8 * cg) * 4); f32x4 o0_ = src_[0], o1_ = src_[1]; \
            if ((cc_) >= SEQ / 128) { const v4u p0_ = *(const v4u*)op_; \
                o0_ += (f32x4){__uint_as_float(p0_.x << 16), __uint_as_float(p0_.x & 0xffff0000u), __uint_as_float(p0_.y << 16), __uint_as_float(p0_.y & 0xffff0000u)}; \
                o1_ += (f32x4){__uint_as_float(p0_.z << 16), __uint_as_float(p0_.z & 0xffff0000u), __uint_as_float(p0_.w << 16), __uint_as_float(p0_.w & 0xffff0000u)}; } \
            v4u w0_; w0_.x = pg8::cvt_pk_bf16(o0_[0], o0_[1]); w0_.y = pg8::cvt_pk_bf16(o0_[2], o0_[3]); w0_.z = pg8::cvt_pk_bf16(o1_[0], o1_[1]); w0_.w = pg8::cvt_pk_bf16(o1_[2], o1_[3]); \
            *(v4u*)op_ = w0_; } } while (0)
    GDN_RAW_STAGE(0, tid, 512);
    __syncthreads();
    for (int c = 0; c < SEQ / 64; ++c) {
        if (c > 0) GDN_WRITEOUT(c - 1);
        if (c == SEQ / 128) partner_sync(F, flags + 64 * unit, flags + 64 * (unit ^ 1));
        if (wave == 0) {
            const int t = dir ? SEQ - 1 - 64 * c - lane : 64 * c + lane;
            const float a = Psm[(size_t)t * 32 + dir * 6 + h], bt = Psm[(size_t)t * 32 + 12 + dir * 6 + h];
            float x = al * softplusf_(a + dtb);
#pragma unroll
            for (int off = 1; off < 64; off <<= 1) { const float y = __shfl_up(x, off); if (lane >= off) x += y; }
            const float last = __shfl(x, 63);
            sm[lane] = x; sm[64 + lane] = sigmoidf_(bt); sm[128 + lane] = __expf(x); sm[192 + lane] = __expf(last - x);
        }
        { float acc[3][8];
#pragma unroll
          for (int tn = 0; tn < 3; ++tn)
#pragma unroll
              for (int j = 0; j < 8; ++j) acc[tn][j] = 0.f;
          const int rr0 = dir ? 63 - ci : ci;
#pragma unroll
          for (int tap = 0; tap < 5; ++tap) {
#pragma unroll
              for (int tn = 0; tn < 3; ++tn) { const v4u x0 = *(const LAS v4u*)(gb + G_RAW + (rr0 + tap) * 384 + tn * 128 + 16 * cg); const LAS float* w = cwl + tn * 320 + tap * 64 + 8 * cg; const f32x4 w0 = *(const LAS f32x4*)w, w1 = *(const LAS f32x4*)(w + 4);
                  acc[tn][0] += w0[0] * __uint_as_float(x0[0] << 16); acc[tn][1] += w0[1] * __uint_as_float(x0[0] & 0xffff0000u); acc[tn][2] += w0[2] * __uint_as_float(x0[1] << 16); acc[tn][3] += w0[3] * __uint_as_float(x0[1] & 0xffff0000u);
                  acc[tn][4] += w1[0] * __uint_as_float(x0[2] << 16); acc[tn][5] += w1[1] * __uint_as_float(x0[2] & 0xffff0000u); acc[tn][6] += w1[2] * __uint_as_float(x0[3] << 16); acc[tn][7] += w1[3] * __uint_as_float(x0[3] & 0xffff0000u); }
              asm volatile("" ::: "memory"); }
          float sq = 0.f, sk = 0.f;
#pragma unroll
          for (int j = 0; j < 8; ++j) { acc[0][j] = siluf(acc[0][j]); acc[1][j] = siluf(acc[1][j]); acc[2][j] = siluf(acc[2][j]); sq += acc[0][j] * acc[0][j]; sk += acc[1][j] * acc[1][j]; }
          sq += dpp_xor1(sq); sk += dpp_xor1(sk); sq += dpp_xor2(sq); sk += dpp_xor2(sk); sq += dpp_hmir(sq); sk += dpp_hmir(sk);
          const float rq = rsqrtf(sq + 1e-6f) * 0.125f, rk = rsqrtf(sk + 1e-6f);
          v4u wq, wk, wv;
#pragma unroll
          for (int q = 0; q < 4; ++q) { wq[q] = pg8::cvt_pk_bf16(acc[0][2 * q] * rq, acc[0][2 * q + 1] * rq); wk[q] = pg8::cvt_pk_bf16(acc[1][2 * q] * rk, acc[1][2 * q + 1] * rk); wv[q] = pg8::cvt_pk_bf16(acc[2][2 * q], acc[2][2 * q + 1]); }
          LAS unsigned char* row = gb + ci * GP + 16 * cg;
          *(LAS v4u*)(row + G_Q) = wq; *(LAS v4u*)(row + G_K) = wk; *(LAS v4u*)(row + G_V) = wv;
#pragma unroll
          for (int j = 0; j < 8; ++j) *(LAS bf16*)(gb + G_KT + (8 * cg + j) * GP + 2 * ci) = (bf16)((j & 1) ? (wk[j >> 1] >> 16) : (wk[j >> 1] & 0xffffu)); }
        __syncthreads();
        { const int ti = (wave >> 1) & 1, tj = wave & 1, r32 = lane & 31, hi = lane >> 5; const bool isP = wave >= 4;
          f32x16 acc = {};
          const LAS unsigned char* ar = gb + (isP ? G_Q : G_K) + (32 * ti + r32) * GP + 16 * hi; const LAS unsigned char* br = gb + G_K + (32 * tj + r32) * GP + 16 * hi;
#pragma unroll
          for (int s = 0; s < 4; ++s) acc = __builtin_amdgcn_mfma_f32_32x32x16_bf16(*(const LAS bf16x8*)(ar + 32 * s), *(const LAS bf16x8*)(br + 32 * s), acc, 0, 0, 0);
          const int j = 32 * tj + r32; const float cj = sm[j];
#pragma unroll
          for (int r = 0; r < 16; ++r) { const int i = 32 * ti + (r & 3) + 8 * (r >> 2) + 4 * hi;
              const float dl = __expf(fminf(sm[i] - cj, 0.f));
              if (!isP) ((LAS float*)(gb + G_A))[i * 68 + j] = (i > j) ? sm[64 + i] * acc[r] * dl : 0.f;
              else *(LAS _Float16*)(gb + G_P + i * GP + 2 * j) = (_Float16)((i >= j) ? acc[r] * dl : 0.f); } }
        __syncthreads();
        if (!(SKIP & 2) && wave == 0) {
            const int bb = lane >> 4, cc = lane & 15; float T[16];
            const LAS float* Ab = (const LAS float*)(gb + G_A) + (16 * bb) * 68 + 16 * bb;
#pragma unroll
            for (int i = 0; i < 16; ++i) { float a0 = 0.f, a1 = 0.f;
#pragma unroll
                for (int j4 = 0; j4 < (i + 3) / 4; ++j4) { const f32x4 av = *(const LAS f32x4*)(Ab + i * 68 + 4 * j4);
                    a0 += av.x * T[4 * j4] + av.z * T[4 * j4 + 2]; a1 += av.y * T[4 * j4 + 1] + av.w * T[4 * j4 + 3]; }
                T[i] = (i == cc ? 1.f : 0.f) - (a0 + a1);
                if (i < 15 && (i & 3) == 3) asm volatile("" ::: "memory");
                if (i == 0) {
#pragma unroll
                    for (int k = 1; k < 16; ++k) T[k] = 0.f; } }
#pragma unroll
            for (int i = 0; i < 16; ++i) ((LAS float*)(gb + G_T))[(16 * bb + i) * 16 + cc] = T[i];
        }
        __syncthreads();
        f32x4 Xc[4];
#pragma unroll
        for (int g = 0; g < 4; ++g) Xc[g] = (f32x4){0.f, 0.f, 0.f, 0.f};
        if (!(SKIP & 2)) {
            const int col = lane & 15, q4 = lane >> 4, c = 16 * wave + col;
            const LAS unsigned char* src = gb + (c < 64 ? G_V : G_K) + 2 * (c & 63);
            u64_t xh[4], xl[4];
#pragma unroll
            for (int bk = 0; bk < 4; ++bk) {
                f32x4 Y; const f32x4 be = *(const LAS f32x4*)(sm + 64 + 16 * bk + 4 * q4), ga = *(const LAS f32x4*)(sm + 128 + 16 * bk + 4 * q4);
#pragma unroll
                for (int r = 0; r < 4; ++r) Y[r] = bf2f(*(const LAS bf16*)(src + (16 * bk + 4 * q4 + r) * GP)) * be[r] * (c < 64 ? 1.f : ga[r]);
#pragma unroll
                for (int b2 = 0; b2 < bk; b2 += 2) {
                    const LAS float* ar = (const LAS float*)(gb + G_A) + (16 * bk + col) * 68 + 16 * b2 + 4 * q4;
                    f32x4 a0 = -*(const LAS f32x4*)ar, a1 = (b2 + 1 < bk) ? -*(const LAS f32x4*)(ar + 16) : (f32x4){0.f, 0.f, 0.f, 0.f};
                    u64_t ah0, al0, ah1, al1; hilo4(a0, ah0, al0); hilo4(a1, ah1, al1);
                    const u64_t bh1 = (b2 + 1 < bk) ? xh[b2 + 1] : 0ull, bl1 = (b2 + 1 < bk) ? xl[b2 + 1] : 0ull;
                    const bf16x8 Ah = mk_bf16x8(ah0, ah1), Al = mk_bf16x8(al0, al1), Bh = mk_bf16x8(xh[b2], bh1), Bl = mk_bf16x8(xl[b2], bl1);
                    Y = __builtin_amdgcn_mfma_f32_16x16x32_bf16(Al, Bh, Y, 0, 0, 0);
                    Y = __builtin_amdgcn_mfma_f32_16x16x32_bf16(Ah, Bl, Y, 0, 0, 0);
                    Y = __builtin_amdgcn_mfma_f32_16x16x32_bf16(Ah, Bh, Y, 0, 0, 0); }
                { const f32x4 t0 = *(const LAS f32x4*)((const LAS float*)(gb + G_T) + (16 * bk + col) * 16 + 4 * q4);
                  u64_t th, tl, yh, yl; hilo4(t0, th, tl); hilo4(Y, yh, yl);
                  const bf16x8 Ah = mk_bf16x8(th, 0ull), Al = mk_bf16x8(tl, 0ull), Bh = mk_bf16x8(yh, 0ull), Bl = mk_bf16x8(yl, 0ull);
                  f32x4 X = {0.f, 0.f, 0.f, 0.f};
                  X = __builtin_amdgcn_mfma_f32_16x16x32_bf16(Al, Bh, X, 0, 0, 0);
                  X = __builtin_amdgcn_mfma_f32_16x16x32_bf16(Ah, Bl, X, 0, 0, 0);
                  X = __builtin_amdgcn_mfma_f32_16x16x32_bf16(Ah, Bh, X, 0, 0, 0);
                  Xc[bk] = X; hilo4(X, xh[bk], xl[bk]); }
            }
        }
        __syncthreads();
        { const int col = lane & 15, q4 = lane >> 4, c = 16 * wave + col;
          if (wave < 4) {
#pragma unroll
              for (int g = 0; g < 4; ++g)
#pragma unroll
                  for (int r = 0; r < 4; ++r) ((LAS float*)(gb + G_A))[(16 * g + 4 * q4 + r) * 68 + c] = Xc[g][r];
          } else {
#pragma unroll
              for (int g = 0; g < 4; ++g)
#pragma unroll
                  for (int r = 0; r < 4; ++r) { const int i = 16 * g + 4 * q4 + r; const float x = -Xc[g][r]; const unsigned hb = f2bf(x);
                      *(LAS bf16*)(gb + G_V + i * GP + 2 * (c - 64)) = (bf16)hb;
                      *(LAS bf16*)(gb + G_K + i * GP + 2 * (c - 64)) = (bf16)f2bf(x - __uint_as_float(hb << 16)); }
          } }
        __syncthreads();
        if (wave < 4) { const int col = lane & 15, q4 = lane >> 4, e = 16 * wave + col;
          bf16x8 bS0, bS1, bS0l, bS1l; split_acc(Sacc[0], Sacc[1], bS0, bS0l); split_acc(Sacc[2], Sacc[3], bS1, bS1l);
          f32x4 U[4], T1[4];
          const LAS unsigned char* rowa = gb + col * GP + 8 * q4;
#pragma unroll
          for (int it = 0; it < 4; ++it) {
              const LAS float* u0p = (const LAS float*)(gb + G_A) + (16 * it + 4 * q4) * 68 + e;
              U[it] = (f32x4){u0p[0], u0p[68], u0p[136], u0p[204]};
              const LAS unsigned char* ra = rowa + 16 * it * GP;
              const bf16x8 wh0 = ld2x8(ra + G_V), wh1 = ld2x8(ra + G_V + 64), wl0 = ld2x8(ra + G_K), wl1 = ld2x8(ra + G_K + 64), qa0 = ld2x8(ra + G_Q), qa1 = ld2x8(ra + G_Q + 64);
              U[it] = __builtin_amdgcn_mfma_f32_16x16x32_bf16(wl0, bS0, U[it], 0, 0, 0);
              U[it] = __builtin_amdgcn_mfma_f32_16x16x32_bf16(wl1, bS1, U[it], 0, 0, 0);
              U[it] = __builtin_amdgcn_mfma_f32_16x16x32_bf16(wh0, bS0l, U[it], 0, 0, 0);
              U[it] = __builtin_amdgcn_mfma_f32_16x16x32_bf16(wh1, bS1l, U[it], 0, 0, 0);
              U[it] = __builtin_amdgcn_mfma_f32_16x16x32_bf16(wh0, bS0, U[it], 0, 0, 0);
              U[it] = __builtin_amdgcn_mfma_f32_16x16x32_bf16(wh1, bS1, U[it], 0, 0, 0);
              T1[it] = __builtin_amdgcn_mfma_f32_16x16x32_bf16(qa0, bS0l, (f32x4){0.f, 0.f, 0.f, 0.f}, 0, 0, 0);
              T1[it] = __builtin_amdgcn_mfma_f32_16x16x32_bf16(qa1, bS1l, T1[it], 0, 0, 0);
              T1[it] = __builtin_amdgcn_mfma_f32_16x16x32_bf16(qa0, bS0, T1[it], 0, 0, 0);
              T1[it] = __builtin_amdgcn_mfma_f32_16x16x32_bf16(qa1, bS1, T1[it], 0, 0, 0);
              asm volatile("" ::: "memory");
          }
          const f16x8 hU0 = pack_acc_f16(U[0], U[1]), hU1 = pack_acc_f16(U[2], U[3]);
          f32x4 Ud[4];
#pragma unroll
          for (int it = 0; it < 4; ++it) { const f32x4 dc = *(const LAS f32x4*)(sm + 192 + 16 * it + 4 * q4); Ud[it] = U[it] * dc; }
          bf16x8 bD0, bD1, bD0l, bD1l; split_acc(Ud[0], Ud[1], bD0, bD0l); split_acc(Ud[2], Ud[3], bD1, bD1l);
          const float gend = sm[191];
#pragma unroll
          for (int it = 0; it < 4; ++it) {
              const LAS unsigned char* ra = rowa + 16 * it * GP;
              const f32x4 gm = *(const LAS f32x4*)(sm + 128 + 16 * it + 4 * q4);
              const bf16x8 pa0 = ld2x8(ra + G_P), pa1 = ld2x8(ra + G_P + 64), ka0 = ld2x8(ra + G_KT), ka1 = ld2x8(ra + G_KT + 64);
              f32x4 O = T1[it] * gm;
              O = __builtin_amdgcn_mfma_f32_16x16x32_f16(__builtin_bit_cast(f16x8, pa0), hU0, O, 0, 0, 0);
              O = __builtin_amdgcn_mfma_f32_16x16x32_f16(__builtin_bit_cast(f16x8, pa1), hU1, O, 0, 0, 0);
              f32x4 Sn = Sacc[it] * gend;
              Sn = __builtin_amdgcn_mfma_f32_16x16x32_bf16(ka0, bD0l, Sn, 0, 0, 0);
              Sn = __builtin_amdgcn_mfma_f32_16x16x32_bf16(ka1, bD1l, Sn, 0, 0, 0);
              Sn = __builtin_amdgcn_mfma_f32_16x16x32_bf16(ka0, bD0, Sn, 0, 0, 0);
              Sn = __builtin_amdgcn_mfma_f32_16x16x32_bf16(ka1, bD1, Sn, 0, 0, 0);
              Sacc[it] = Sn;
#pragma unroll
              for (int r = 0; r < 4; ++r) ((LAS float*)(gb + G_A))[(16 * it + 4 * q4 + r) * 68 + e] = O[r];
              asm volatile("" ::: "memory");
          } }
        else if (c + 1 < SEQ / 64) GDN_RAW_STAGE(c + 1, tid - 256, 256);
        __syncthreads();
    }
    GDN_WRITEOUT(SEQ / 64 - 1);
#undef GDN_WRITEOUT
#undef GDN_RAW_STAGE
    __syncthreads();
}
__device__ __forceinline__ int next_unit(Frame& F, gu32* head) {
    __syncthreads();
    if (F.tid == 0) F.MISC[16] = __hip_atomic_fetch_add(head, 1u, RLX_AGENT);
    __syncthreads();
    return (int)F.MISC[16];
}
constexpr int U_GDN = 96, U_RWKV = 128, U_ATT = 384, U_ALL = U_GDN + U_RWKV + U_ATT;
__device__ __forceinline__ void p3_mixers(Frame& F, int l, int rep) {
    gu32* head = F.ctl + CW_QUEUE + 64 * (2 * l + rep);
    for (;;) {
        const int u = next_unit(F, head);
        if (u >= U_ALL) break;
        asm volatile("" : "+v"(F.tid), "+v"(F.lane));
        if (u < U_GDN) gdn_unit3<0>(F, l, u, F.ctl + CW_FLAG + 64 * 256 * (2 * l + rep) + 64 * 128);
        else if (u < U_GDN + U_RWKV) rwkv_unit<0>(F, u - U_GDN, F.ctl + CW_FLAG + 64 * 256 * (2 * l + rep));
        else attn_unit(F, u - U_GDN - U_RWKV);
    }
}
__device__ __forceinline__ f32x4 bf4(u64_t x) { return (f32x4){__uint_as_float(((unsigned)x) << 16), __uint_as_float(((unsigned)x) & 0xffff0000u), __uint_as_float(((unsigned)(x >> 32)) << 16), __uint_as_float(((unsigned)(x >> 32)) & 0xffff0000u)}; }
__device__ __forceinline__ u64_t pk4(const f32x4& v) { return (u64_t)pg8::cvt_pk_bf16(v[0], v[1]) | ((u64_t)pg8::cvt_pk_bf16(v[2], v[3]) << 32); }
__device__ __forceinline__ void p2_mla_unit(Frame& F, int l, int unit) {
    const int lane = F.lane, col = lane & 15, q4 = lane >> 4, m = 16 * unit + col, b = m / SEQ, t = m % SEQ, t0 = (16 * unit) % SEQ;
    const bf16* prow = (const bf16*)(F.ws + WS_PMLA) + (size_t)m * 352;
    const bf16* WuqT = (const bf16*)(F.ws + WS_WSMALL + OFF_WUQ) + (size_t)l * 576 * 192 + (size_t)col * 192 + 8 * q4;
    const bf16* WukvT = (const bf16*)(F.ws + WS_WSMALL + OFF_WUKV) + (size_t)l * 768 * 128 + (size_t)col * 128 + 8 * q4;
    bf16x8 aq[6], akv[4]; float sq = 0.f, skv = 0.f;
#pragma unroll
    for (int s = 0; s < 6; ++s) { aq[s] = *(const bf16x8*)(prow + 32 * s + 8 * q4); const v4u u = __builtin_bit_cast(v4u, aq[s]);
#pragma unroll
        for (int i = 0; i < 4; ++i) { const float a = __uint_as_float(u[i] << 16), c = __uint_as_float(u[i] & 0xffff0000u); sq += a * a + c * c; } }
#pragma unroll
    for (int s = 0; s < 4; ++s) { akv[s] = *(const bf16x8*)(prow + 192 + 32 * s + 8 * q4); const v4u u = __builtin_bit_cast(v4u, akv[s]);
#pragma unroll
        for (int i = 0; i < 4; ++i) { const float a = __uint_as_float(u[i] << 16), c = __uint_as_float(u[i] & 0xffff0000u); skv += a * a + c * c; } }
    sq += __shfl_xor(sq, 16); sq += __shfl_xor(sq, 32); skv += __shfl_xor(skv, 16); skv += __shfl_xor(skv, 32);
    const float rq = rsqrtf(sq * (1.f / 192.f) + NORM_EPS) * (0.10206207261596575f * LOG2E), rkv = rsqrtf(skv * (1.f / 128.f) + NORM_EPS);
    const float pos = (float)((const int*)inptr(F, 1))[m];
    f32x4 cs, sn;
#pragma unroll
    for (int r = 0; r < 4; ++r) { const float inv = exp2f(-(float)(4 * q4 + r) * (13.287712379549449f / 16.f)); float s_, c_; sincosf(pos * inv, &s_, &c_); cs[r] = c_; sn[r] = s_; }
    bf16* Qo = (bf16*)(F.ws + WS_Q) + ((size_t)b * 6 * SEQ + t) * 96 + 4 * q4;
    bf16* Ko = (bf16*)(F.ws + WS_K) + ((size_t)b * 6 * SEQ + t) * 96 + 4 * q4;
    bf16* Vo = (bf16*)(F.ws + WS_VT) + (size_t)b * 6 * 64 * SEQ + (size_t)col * SEQ + t0 + 4 * q4;
    { const u64_t x1 = *(const u64_t*)(prow + 320 + 4 * q4), x2 = *(const u64_t*)(prow + 336 + 4 * q4); const f32x4 a = bf4(x1), c = bf4(x2);
      const u64_t o1 = pk4(a * cs - c * sn), o2 = pk4(c * cs + a * sn);
#pragma unroll
      for (int h = 0; h < 6; ++h) { *(u64_t*)(Ko + (size_t)h * SEQ * 96 + 64) = o1; *(u64_t*)(Ko + (size_t)h * SEQ * 96 + 80) = o2; } }
#pragma unroll 2
    for (int h = 0; h < 6; ++h) {
        f32x4 x1v = {0.f, 0.f, 0.f, 0.f};
#pragma unroll
        for (int nt = 0; nt < 6; ++nt) {
            const bf16* w = WuqT + (size_t)(h * 96 + 16 * nt) * 192; f32x4 acc = {0.f, 0.f, 0.f, 0.f};
#pragma unroll
            for (int s = 0; s < 6; ++s) acc = __builtin_amdgcn_mfma_f32_16x16x32_bf16(*(const bf16x8*)(w + 32 * s), aq[s], acc, 0, 0, 0);
            acc = acc * rq;
            if (nt < 4) *(u64_t*)(Qo + (size_t)h * SEQ * 96 + 16 * nt) = pk4(acc);
            else if (nt == 4) x1v = acc;
            else { *(u64_t*)(Qo + (size_t)h * SEQ * 96 + 64) = pk4(x1v * cs - acc * sn); *(u64_t*)(Qo + (size_t)h * SEQ * 96 + 80) = pk4(acc * cs + x1v * sn); }
        }
#pragma unroll
        for (int nt = 0; nt < 4; ++nt) {
            const bf16* w = WukvT + (size_t)(h * 128 + 16 * nt) * 128; f32x4 acc = {0.f, 0.f, 0.f, 0.f};
#pragma unroll
            for (int s = 0; s < 4; ++s) acc = __builtin_amdgcn_mfma_f32_16x16x32_bf16(*(const bf16x8*)(w + 32 * s), akv[s], acc, 0, 0, 0);
            *(u64_t*)(Ko + (size_t)h * SEQ * 96 + 16 * nt) = pk4(acc * rkv);
        }
        f32x4 rk4;
#pragma unroll
        for (int r = 0; r < 4; ++r) rk4[r] = __shfl(rkv, 4 * q4 + r);
#pragma unroll
        for (int nt = 0; nt < 4; ++nt) {
            const bf16* w = WukvT + (size_t)(h * 128 + 64 + 16 * nt) * 128; f32x4 acc = {0.f, 0.f, 0.f, 0.f};
#pragma unroll
            for (int s = 0; s < 4; ++s) acc = __builtin_amdgcn_mfma_f32_16x16x32_bf16(akv[s], *(const bf16x8*)(w + 32 * s), acc, 0, 0, 0);
            *(u64_t*)(Vo + (size_t)(h * 64 + 16 * nt) * SEQ) = pk4(acc * rk4);
        }
    }
}
__device__ __forceinline__ f32x4 rw_shift4(const bf16* P, size_t m, int c, bool hp, bool hn, const float* mu) {
    const f32x4 x = bf4(*(const u64_t*)(P + m * 896 + c)), xp = hp ? bf4(*(const u64_t*)(P + (m - 1) * 896 + c)) : (f32x4){0.f, 0.f, 0.f, 0.f}, xn = hn ? bf4(*(const u64_t*)(P + (m + 1) * 896 + c)) : (f32x4){0.f, 0.f, 0.f, 0.f};
    const f32x4 m0 = *(const f32x4*)(mu + c), m1 = *(const f32x4*)(mu + 896 + c);
    return x + m0 * (xp - x) + m1 * (xn - x);
}
__device__ __forceinline__ void p2_rwkv_unit(Frame& F, int l, int unit, int h0, int h1) {
    const int lane = F.lane, col = lane & 15, q4 = lane >> 4, b = (16 * unit) / SEQ, t = (16 * unit) % SEQ + col; const size_t m = (size_t)16 * unit + col;
    const bool hp = t > 0, hn = t < SEQ - 1;
    const bf16* Prw = (const bf16*)(F.ws + WS_PRW);
    const float* mu = (const float*)inptr(F, 12) + l * 2 * 896;
    const bf16* W2T = (const bf16*)(F.ws + WS_WSMALL + OFF_W2T) + (size_t)l * 2 * 256 * 64 + (size_t)col * 64 + 8 * q4;
    const bf16* A2T = (const bf16*)(F.ws + WS_WSMALL + OFF_A2T) + (size_t)l * 2 * 256 * 64 + (size_t)col * 64 + 8 * q4;
    bf16x8 awd[2], aad[2];
#pragma unroll
    for (int s = 0; s < 2; ++s) { const int c = 768 + 32 * s + 8 * q4;
        f32x4 lo = rw_shift4(Prw, m, c, hp, hn, mu), hi = rw_shift4(Prw, m, c + 4, hp, hn, mu);
#pragma unroll
        for (int i = 0; i < 4; ++i) { lo[i] = 1.f - 2.f * __builtin_amdgcn_rcpf(1.f + __expf(2.f * lo[i])); hi[i] = 1.f - 2.f * __builtin_amdgcn_rcpf(1.f + __expf(2.f * hi[i])); }
        awd[s] = pack_acc(lo, hi);
        aad[s] = pack_acc(rw_shift4(Prw, m, c + 64, hp, hn, mu), rw_shift4(Prw, m, c + 68, hp, hn, mu)); }
#pragma unroll 1
    for (int h = h0; h < h1; ++h) {
        f32x4 k[4]; float kn = 0.f;
        { const float* k_k = (const float*)inptr(F, 17) + l * 256;
#pragma unroll
          for (int nt = 0; nt < 4; ++nt) { const int c = 64 * h + 16 * nt + 4 * q4; k[nt] = rw_shift4(Prw, m, 256 + c, hp, hn, mu);
              const f32x4 x = k[nt] * *(const f32x4*)(k_k + c); kn += (x[0] * x[0] + x[1] * x[1]) + (x[2] * x[2] + x[3] * x[3]); } }
        kn += __shfl_xor(kn, 16); kn += __shfl_xor(kn, 32);
        const float rkn = rsqrtf(kn + 1e-6f);
        float br[2] = {0.f, 0.f}, kr[2] = {0.f, 0.f}, cbv = 0.f;
        unsigned char* rs = F.ws + WS_RS + (((size_t)b * 4 + h) * SEQ + t) * RS_REC + 8 * q4;
        unsigned char* rd0 = F.ws + WS_RD + (((size_t)b * 4 + h) * SEQ + t) * RD_REC + 8 * q4;
#pragma unroll
        for (int nt = 0; nt < 4; ++nt) { const int c = 64 * h + 16 * nt + 4 * q4;
            const f32x4 r = rw_shift4(Prw, m, c, hp, hn, mu), v = rw_shift4(Prw, m, 512 + c, hp, hn, mu);
            const f32x4 kk = k[nt] * *(const f32x4*)((const float*)inptr(F, 17) + l * 256 + c) * rkn;
            *(u64_t*)(rs + 32 * nt) = pk4(kk); *(u64_t*)(rs + 128 + 32 * nt) = pk4(v); *(u64_t*)(rs + 256 + 32 * nt) = pk4(r);
            f32x4 ksum = {0.f, 0.f, 0.f, 0.f};
#pragma unroll
            for (int e = 0; e < 2; ++e) { const bf16* w = W2T + (size_t)(e * 256 + 64 * h + 16 * nt) * 64; const bf16* a = A2T + (size_t)(e * 256 + 64 * h + 16 * nt) * 64;
                f32x4 x = {0.f, 0.f, 0.f, 0.f}, y = {0.f, 0.f, 0.f, 0.f};
#pragma unroll
                for (int s = 0; s < 2; ++s) { x = __builtin_amdgcn_mfma_f32_16x16x32_bf16(*(const bf16x8*)(w + 32 * s), awd[s], x, 0, 0, 0); y = __builtin_amdgcn_mfma_f32_16x16x32_bf16(*(const bf16x8*)(a + 32 * s), aad[s], y, 0, 0, 0); }
                const f32x4 w0v = *(const f32x4*)((const float*)inptr(F, 13) + l * 512 + e * 256 + c), a0v = *(const f32x4*)((const float*)inptr(F, 15) + l * 512 + e * 256 + c), kav = *(const f32x4*)((const float*)inptr(F, 18) + l * 256 + c);
                f32x4 lam, av;
#pragma unroll
                for (int i = 0; i < 4; ++i) { lam[i] = 0.6065306597126334f * sigmoidf_(w0v[i] + x[i]); av[i] = sigmoidf_(a0v[i] + y[i]); }
                const f32x4 km = k[nt] * (1.f + (av - 1.f) * kav), bb = av * kk;
                ksum += km;
                br[e] += (bb[0] * r[0] + bb[1] * r[1]) + (bb[2] * r[2] + bb[3] * r[3]); kr[e] += (km[0] * r[0] + km[1] * r[1]) + (km[2] * r[2] + km[3] * r[3]);
                typedef _Float16 h4 __attribute__((ext_vector_type(4)));
                const h4 lh = {(_Float16)lam[0], (_Float16)lam[1], (_Float16)lam[2], (_Float16)lam[3]};
                unsigned char* rd = rd0 + e * RD_DIR;
                *(u64_t*)(rd + 32 * nt) = __builtin_bit_cast(u64_t, lh); *(u64_t*)(rd + 128 + 32 * nt) = pk4(bb); *(u64_t*)(rd + 256 + 32 * nt) = pk4(km); }
            const f32x4 rkv = *(const f32x4*)((const float*)inptr(F, 19) + l * 256 + c), xx = r * ksum * rkv; cbv += (xx[0] + xx[1]) + (xx[2] + xx[3]);
        }
#pragma unroll
        for (int e = 0; e < 2; ++e) { float x = br[e], y = kr[e]; x += __shfl_xor(x, 16); x += __shfl_xor(x, 32); y += __shfl_xor(y, 16); y += __shfl_xor(y, 32);
            if (q4 == 0) { typedef float f2 __attribute__((ext_vector_type(2))); *(f2*)(rd0 + e * RD_DIR + 384) = (f2){x, y}; } }
        cbv += __shfl_xor(cbv, 16); cbv += __shfl_xor(cbv, 32);
        if (q4 == 0) ((float*)(F.ws + WS_CB))[m * 4 + h] = 0.5f * cbv;
    }
}
template <int MODE> __device__ __forceinline__ void p2_prep2(Frame& F, int l) {
    const int gw = F.vcu * NWAVES + F.wave, NGW = F.G * NWAVES;
    for (int u = gw; u < 2 * (M / 16); u += NGW) { if (u & 1) { if (MODE != 1) p2_rwkv_unit(F, l, u >> 1, 0, 4); } else { if (MODE != 2) p2_mla_unit(F, l, u >> 1); } }
}
__device__ __forceinline__ void ld16(const bf16* p, f32x4 (&o)[4]) { const v4u a = *(const v4u*)p, b = *(const v4u*)(p + 8);
    o[0] = (f32x4){__uint_as_float(a.x << 16), __uint_as_float(a.x & 0xffff0000u), __uint_as_float(a.y << 16), __uint_as_float(a.y & 0xffff0000u)};
    o[1] = (f32x4){__uint_as_float(a.z << 16), __uint_as_float(a.z & 0xffff0000u), __uint_as_float(a.w << 16), __uint_as_float(a.w & 0xffff0000u)};
    o[2] = (f32x4){__uint_as_float(b.x << 16), __uint_as_float(b.x & 0xffff0000u), __uint_as_float(b.y << 16), __uint_as_float(b.y & 0xffff0000u)};
    o[3] = (f32x4){__uint_as_float(b.z << 16), __uint_as_float(b.z & 0xffff0000u), __uint_as_float(b.w << 16), __uint_as_float(b.w & 0xffff0000u)}; }
__device__ __forceinline__ void p4a_mix2(Frame& F, int l) {
    const bf16* Ogdn = (const bf16*)(F.ws + WS_OGDN); const bf16* Omla = (const bf16*)(F.ws + WS_OMLA); const bf16* Y = (const bf16*)(F.ws + WS_Y);
    const bf16* Pgate = (const bf16*)(F.ws + WS_PGATE); const unsigned char* Rs = F.ws + WS_RS; const float* cb = (const float*)(F.ws + WS_CB); bf16* mix = (bf16*)(F.ws + WS_MIX);
    const int gw = F.vcu * NWAVES + F.wave, NGW = F.G * NWAVES, lane = F.lane, g = lane >> 2, c0 = 16 * lane;
    f32x4 pg[4], pb[4];
    if (g < 6) { const float* gg = (const float*)inptr(F, 7) + l * 64 + (c0 & 63);
#pragma unroll
        for (int i = 0; i < 4; ++i) { pg[i] = *(const f32x4*)(gg + 4 * i); pb[i] = (f32x4){0.f, 0.f, 0.f, 0.f}; } }
    else if (g < 12) {
#pragma unroll
        for (int i = 0; i < 4; ++i) { pg[i] = (f32x4){1.f, 1.f, 1.f, 1.f}; pb[i] = (f32x4){0.f, 0.f, 0.f, 0.f}; } }
    else { const float* lg = (const float*)inptr(F, 20) + l * 256 + (c0 - 768); const float* lb = (const float*)inptr(F, 21) + l * 256 + (c0 - 768);
#pragma unroll
        for (int i = 0; i < 4; ++i) { pg[i] = *(const f32x4*)(lg + 4 * i); pb[i] = *(const f32x4*)(lb + 4 * i); } }
#pragma unroll 2
    for (int m = gw; m < M; m += NGW) {
        f32x4 x[4], gt[4];
        ld16(Pgate + (size_t)m * 1024 + c0, gt);
        if (g < 6) { ld16(Ogdn + (size_t)m * 384 + c0, x);
            float ss = 0.f;
#pragma unroll
            for (int i = 0; i < 4; ++i) ss += (x[i][0] * x[i][0] + x[i][1] * x[i][1]) + (x[i][2] * x[i][2] + x[i][3] * x[i][3]);
            ss += dpp_xor1(ss); ss += dpp_xor2(ss);
            const float rs = rsqrtf(ss * (1.f / 64.f) + NORM_EPS);
#pragma unroll
            for (int i = 0; i < 4; ++i) x[i] = x[i] * rs * pg[i]; }
        else if (g < 12) ld16(Omla + (size_t)m * 384 + (c0 - 384), x);
        else { const int cc = c0 - 768, h = g - 12, b = m / SEQ, t = m % SEQ; f32x4 v[4];
            ld16(Y + (size_t)m * 256 + cc, x); ld16((const bf16*)(Rs + (((size_t)b * 4 + h) * SEQ + t) * RS_REC + 128) + (cc & 63), v);
            const float cbv = cb[(size_t)m * 4 + h];
            float s1 = 0.f;
#pragma unroll
            for (int i = 0; i < 4; ++i) s1 += (x[i][0] + x[i][1]) + (x[i][2] + x[i][3]);
            s1 += dpp_xor1(s1); s1 += dpp_xor2(s1);
            const float mean = s1 * (1.f / 64.f); float s2 = 0.f;
#pragma unroll
            for (int i = 0; i < 4; ++i) { x[i] = x[i] - mean; s2 += (x[i][0] * x[i][0] + x[i][1] * x[i][1]) + (x[i][2] * x[i][2] + x[i][3] * x[i][3]); }
            s2 += dpp_xor1(s2); s2 += dpp_xor2(s2);
            const float rs = rsqrtf(s2 * (1.f / 64.f) + 64e-5f);
#pragma unroll
            for (int i = 0; i < 4; ++i) x[i] = x[i] * rs * pg[i] + pb[i] + cbv * v[i]; }
        v4u o0, o1;
#pragma unroll
        for (int i = 0; i < 4; ++i) {
#pragma unroll
            for (int j = 0; j < 4; ++j) x[i][j] = x[i][j] * siluf(gt[i][j]); }
        o0.x = pg8::cvt_pk_bf16(x[0][0], x[0][1]); o0.y = pg8::cvt_pk_bf16(x[0][2], x[0][3]); o0.z = pg8::cvt_pk_bf16(x[1][0], x[1][1]); o0.w = pg8::cvt_pk_bf16(x[1][2], x[1][3]);
        o1.x = pg8::cvt_pk_bf16(x[2][0], x[2][1]); o1.y = pg8::cvt_pk_bf16(x[2][2], x[2][3]); o1.z = pg8::cvt_pk_bf16(x[3][0], x[3][1]); o1.w = pg8::cvt_pk_bf16(x[3][2], x[3][3]);
        bf16* op = mix + (size_t)m * 1024 + c0; *(v4u*)op = o0; *(v4u*)(op + 8) = o1;
    }
}
constexpr int PT_OUT = 24, PT_WS = 25, PT_N = 26;
__device__ __forceinline__ void build_frame(Frame& F, LAS unsigned char* lds) {
    F.lds = lds; F.MISC = (volatile LAS unsigned*)(lds + MISC_OFF); F.ptab = (volatile LAS const unsigned long long*)(lds + MISC_OFF + 256);
    const int t = pg8::mk_tid(lds);
    F.tid = t; F.lane = t & 63; F.wave = __builtin_amdgcn_readfirstlane(t >> 6);
    F.G = gridDim.x; { const int bx = blockIdx.x; F.vcu = (F.G % 8 == 0) ? (bx % 8) * (F.G / 8) + bx / 8 : bx; }
    F.ws = (unsigned char*)inptr(F, PT_WS); F.out = (float*)inptr(F, PT_OUT); F.ctl = (gu32*)F.ws;
}
__device__ __forceinline__ bool ph_in(LAS unsigned char* lds, int k) { volatile LAS unsigned* mi = (volatile LAS unsigned*)(lds + MISC_OFF); const int lo = __builtin_amdgcn_readfirstlane((int)mi[20]), hi = __builtin_amdgcn_readfirstlane((int)mi[21]); return lo <= k && k < hi; }
__device__ __forceinline__ void seam(LAS unsigned char* lds, int k) {
    if (ph_in(lds, k) && ph_in(lds, k + 1)) { Frame F; build_frame(F, lds);
        XcdBarrier bar; bar.bar = (unsigned*)(F.ctl + CW_BAR); bar.x = xb_xcc_id(); bar.st = F.MISC + 8; xcd_barrier(bar); }
}
template <int L> __device__ __forceinline__ void layer_phases(LAS unsigned char* lds) {
    constexpr int pb = 1 + 5 * L;
    if (ph_in(lds, pb)) { Frame F; build_frame(F, lds);
        pg8::Gemm g{(const pg8::bf16_t*)(F.ws + WS_XB), (const pg8::bf16_t*)(F.ws + WS_WIN) + (size_t)L * NP * D, M, NP, D};
        pg8::StaticOrder S; S.init(M, NP, F.G, (int)blockIdx.x);
        pg8::EpiRoute E{F.ws};
        pg8::gemm_phase<pg8::EpiRoute, pg8::StaticOrder, true, true>(F.lds + RING_OFF, g, S, E);
    }
    seam(lds, pb);
    if (ph_in(lds, pb + 1)) { Frame F; build_frame(F, lds); p2_prep2<0>(F, L); }
    seam(lds, pb + 1);
    if (ph_in(lds, pb + 2)) { Frame F; build_frame(F, lds); p3_mixers(F, L, 0); }
    seam(lds, pb + 2);
    if (ph_in(lds, pb + 3)) { Frame F; build_frame(F, lds); p4a_mix2(F, L);
    }
    seam(lds, pb + 3);
    if (ph_in(lds, pb + 4)) { Frame F; build_frame(F, lds);
        pg8::Gemm g{(const pg8::bf16_t*)(F.ws + WS_MIX), (const pg8::bf16_t*)(F.ws + WS_WOUT) + (size_t)L * D * D, M, D, D};
        pg8::StaticOrder S; S.init(M, D, F.G, (int)blockIdx.x);
        pg8::EpiOut<L == 0> E{L == 0 ? (const float*)inptr(F, 0) : (const float*)F.out, F.out, F.ws};
        pg8::gemm_phase<pg8::EpiOut<L == 0>, pg8::StaticOrder, true, true>(F.lds + RING_OFF, g, S, E);
    }
    seam(lds, pb + 4);
}
__global__ void __launch_bounds__(NWAVES * 64, 2) mk_fwd(Args args) {
    extern __shared__ __attribute__((aligned(16))) unsigned char lds_raw[];
    LAS unsigned char* lds = (LAS unsigned char*)lds_raw;
    for (int u = threadIdx.x; u < (LDS_BYTES - LDSCTL_OFF) / 4; u += NWAVES * 64) ((LAS unsigned*)(lds + LDSCTL_OFF))[u] = 0u;
    __syncthreads();
    if (threadIdx.x == 0) { LAS unsigned long long* pt = (LAS unsigned long long*)(lds + MISC_OFF + 256);
#define PT(k) pt[k] = (unsigned long long)args.in[k]
        PT(0); PT(1); PT(2); PT(3); PT(4); PT(5); PT(6); PT(7); PT(8); PT(9); PT(10); PT(11); PT(12); PT(13); PT(14); PT(15); PT(16); PT(17); PT(18); PT(19); PT(20); PT(21); PT(22); PT(23);
#undef PT
        pt[PT_OUT] = (unsigned long long)args.out; pt[PT_WS] = (unsigned long long)args.ws;
        volatile LAS unsigned* mi = (volatile LAS unsigned*)(lds + MISC_OFF); mi[20] = (unsigned)args.ph_lo; mi[21] = (unsigned)args.ph_hi;
        if (args.ph_hi - args.ph_lo > 1) (void)xcd_barrier_post((unsigned*)((gu32*)args.ws + CW_BAR), mi + 8);
    }
    if ((threadIdx.x & 63) == 0) ((volatile LAS unsigned*)(lds + pg8::TIDTAB_OFF))[pg8::hw_slot()] = threadIdx.x >> 6;
    __syncthreads();
    if (ph_in(lds, 0)) { Frame F; build_frame(F, lds); p0_prologue(F); }
    seam(lds, 0);
    layer_phases<0>(lds);
    layer_phases<1>(lds);
    if (ph_in(lds, 11)) { Frame F; build_frame(F, lds); p5_final(F); }
}

extern "C" void kernel_launch(void* const* d_in, const int* in_sizes, int n_in, void* d_out, int out_size, void* d_ws, size_t ws_size, hipStream_t stream) {
    static int grid = 0;
    if (grid == 0) {
        if (n_in != 24 || ws_size < WS_END || out_size != M * D) { fprintf(stderr, "kernel_launch: unexpected inputs (%d), out (%d) or workspace (%zu)\n", n_in, out_size, ws_size); grid = -1; return; }
        int dev = 0, cus = 0;
        if (hipGetDevice(&dev) != hipSuccess || hipDeviceGetAttribute(&cus, hipDeviceAttributeMultiprocessorCount, dev) != hipSuccess) { grid = -1; return; }
        if (hipFuncSetAttribute((const void*)mk_fwd, hipFuncAttributeMaxDynamicSharedMemorySize, LDS_BYTES) != hipSuccess) { fprintf(stderr, "kernel_launch: hipFuncSetAttribute failed\n"); grid = -1; return; }
        (void)hipGetLastError();
        grid = cus;
    }
    if (grid < 0) return;
    unsigned char* ws = (unsigned char*)d_ws;
    (void)hipMemsetAsync(ws + WS_CTL, 0, CTL_ZERO_BYTES, stream);
    Args a{};
    for (int i = 0; i < 24; ++i) a.in[i] = d_in[i];
    a.out = (float*)d_out; a.ws = ws; a.ph_lo = 0; a.ph_hi = NPHASE;
    hipLaunchKernelGGL(mk_fwd, dim3(grid), dim3(NWAVES * 64), LDS_BYTES, stream, a);
}
```

```cpp
#include <hip/hip_runtime.h>
#include <cstdio>
#include <cstdint>
#include <hip/hip_fp16.h>
namespace pg8 {
#define PG8_LAS __attribute__((address_space(3)))
typedef unsigned short bf16_t;
typedef short bf16x8 __attribute__((ext_vector_type(8)));
typedef float f32x4 __attribute__((ext_vector_type(4)));
typedef unsigned u32x4 __attribute__((ext_vector_type(4)));
constexpr int BM = 256, BK = 64, HALF = 128, HTB = HALF * BK * 2  , STAGE_BYTES = 8 * HTB, NXCD = 8, WGM = 8;

__host__ __device__ __forceinline__ int lds_byte(int r, int c) { const int st = (r >> 4) * 2 + (c >> 5), rr = r & 15, cc = c & 31, ob = rr * 64 + cc * 2; return st * 1024 + (ob ^ (((ob >> 9) & 1) << 5)); }
__host__ __device__ __forceinline__ void stage_rc(int b, int& R, int& C) { const int st = b / 1024, sb = b % 1024, swz = sb ^ (((sb >> 9) & 1) << 5); R = (st >> 1) * 16 + swz / 64; C = (st & 1) * 32 + (swz % 64) / 2; }
__host__ __device__ __forceinline__ int perm32(int rho) { const int n = rho >> 4, i = rho & 15; return 8 * (i >> 2) + 4 * n + (i & 3); }

struct Unit { int pm, pn; };
struct Gemm { const bf16_t* A; const bf16_t* Bt; int M, N, K; };

struct StaticOrder {
    int nM, nN, nwg, G, c;
    __host__ __device__ void init(int M, int N, int G_, int c_) { nM = M / BM; nN = N / BM; nwg = nM * nN; G = G_; c = c_; }
    __host__ __device__ bool next(int i, Unit& u) const {
        const long L = (long)i * G + c; if (L >= nwg) return false;
        int wgid = (int)L; { const int q = nwg / NXCD, r = nwg % NXCD, xcd = wgid % NXCD, off = wgid / NXCD; wgid = (xcd < r ? xcd * (q + 1) : r * (q + 1) + (xcd - r) * q) + off; }
        const int nig = WGM * nN, gid = wgid / nig, fm = gid * WGM, gsz = (nM - fm) < WGM ? (nM - fm) : WGM;
        u.pm = fm + ((wgid % nig) % gsz); u.pn = (wgid % nig) / gsz; return true;
    }
    __device__ __forceinline__ void a_ready(const Unit&) const {}
    __device__ __forceinline__ void done(const Unit&) const {}
};

__device__ __forceinline__ unsigned cvt_pk_bf16(float lo, float hi) { unsigned r; asm volatile("v_cvt_pk_bf16_f32 %0, %1, %2" : "=v"(r) : "v"(lo), "v"(hi)); return r; }
typedef float f32x2 __attribute__((ext_vector_type(2)));
constexpr int TIDTAB_OFF = 131072 + 320 + 512;
__device__ __forceinline__ unsigned hw_slot() { return (unsigned)__builtin_amdgcn_s_getreg((5 << 11) | 4) & 63u; }
__device__ __forceinline__ int mk_tid(PG8_LAS unsigned char* lds_base) {
    const unsigned lane = __builtin_amdgcn_mbcnt_hi(~0u, __builtin_amdgcn_mbcnt_lo(~0u, 0u));
    const unsigned w = __builtin_amdgcn_readfirstlane(((volatile PG8_LAS unsigned*)(lds_base + TIDTAB_OFF))[hw_slot()]);
    return (int)(w * 64u + lane);
}
struct EpiRoute {
    static constexpr bool PERM = true, AFTER_DRAIN = false;
    unsigned char* ws;
    __device__ __forceinline__ void operator()(const f32x4 (&acc)[2][2][4][2], const Unit& u, int wr, int wc, int fr, int fq) const {
        const int row0 = u.pm * BM + wr * 64 + fr;
        const float* rowss = (const float*)(ws + (1u << 20)); float* Psm = (float*)(ws + (22u << 20));
        unsigned base[2]; int ld[2], cc[2], kind[2];
#pragma unroll
        for (int bj = 0; bj < 2; ++bj) {
            const int cg = u.pn * BM + bj * HALF + wc * 32, col = cg + 8 * fq;
            if (cg < 1024) { base[bj] = 25u << 20; ld[bj] = 1024; cc[bj] = col; kind[bj] = 0; }
            else if (cg < 2176) { base[bj] = 57u << 20; ld[bj] = 1152; cc[bj] = col - 1024; kind[bj] = 0; }
            else if (cg < 2528) { base[bj] = 93u << 20; ld[bj] = 352; cc[bj] = col - 2176; kind[bj] = 0; }
            else if (cg < 3424) { base[bj] = 104u << 20; ld[bj] = 896; cc[bj] = col - 2528; kind[bj] = 0; }
            else if (cg < 3456) { base[bj] = 0u; ld[bj] = 32; cc[bj] = col - 3424; kind[bj] = 1; }
            else { base[bj] = 0u; ld[bj] = 0; cc[bj] = 0; kind[bj] = 2; }
        }
#pragma unroll
        for (int ai = 0; ai < 2; ++ai)
#pragma unroll
            for (int m = 0; m < 4; ++m) {
                const int row = row0 + ai * HALF + m * 16;
                const f32x4* rp = (const f32x4*)(rowss + (size_t)row * 16);
                const f32x4 s0 = rp[0], s1 = rp[1], s2 = rp[2], s3 = rp[3];
                const float ss = ((s0[0] + s0[1]) + (s0[2] + s0[3])) + ((s1[0] + s1[1]) + (s1[2] + s1[3])) + ((s2[0] + s2[1]) + (s2[2] + s2[3])) + ((s3[0] + s3[1]) + (s3[2] + s3[3]));
                const float rstd = __builtin_amdgcn_rsqf(ss * (1.0f / 1024.0f) + 1e-6f);
#pragma unroll
                for (int bj = 0; bj < 2; ++bj) {
                    const f32x4 v0 = acc[ai][bj][m][0] * rstd, v1 = acc[ai][bj][m][1] * rstd;
                    if (kind[bj] == 0) { u32x4 w; w.x = cvt_pk_bf16(v0[0], v0[1]); w.y = cvt_pk_bf16(v0[2], v0[3]); w.z = cvt_pk_bf16(v1[0], v1[1]); w.w = cvt_pk_bf16(v1[2], v1[3]);
                        *(u32x4*)((bf16_t*)(ws + base[bj]) + (size_t)row * ld[bj] + cc[bj]) = w; }
                    else if (kind[bj] == 1) { float* p = Psm + (size_t)row * 32 + cc[bj]; *(f32x4*)p = v0; *(f32x4*)(p + 4) = v1; }
                }
                asm volatile("" ::: "memory");
            }
    }
};
template <bool WRITE_XB> struct EpiOut {
    static constexpr bool PERM = false, AFTER_DRAIN = false;
    const float* xin; float* xout; unsigned char* ws;
    __device__ __forceinline__ void operator()(const f32x4 (&acc)[2][2][4][2], const Unit& u, int wr, int wc, int fr, int fq) const {
        typedef unsigned u32x2v __attribute__((ext_vector_type(2)));
        const int row0 = u.pm * BM + wr * 64 + fr, col0 = u.pn * BM + wc * 32 + 4 * fq;
        float* rowss = (float*)(ws + (1u << 20)); bf16_t* xb = (bf16_t*)(ws + (133u << 20));
#pragma unroll
        for (int ai = 0; ai < 2; ++ai)
#pragma unroll
            for (int m = 0; m < 4; ++m) {
                const int row = row0 + ai * HALF + m * 16; float ss = 0.f;
#pragma unroll
                for (int bj = 0; bj < 2; ++bj)
#pragma unroll
                    for (int n = 0; n < 2; ++n) {
                        const size_t off = (size_t)row * 1024 + col0 + bj * HALF + n * 16;
                        const f32x4 o = *(const f32x4*)(xin + off) + acc[ai][bj][m][n];
                        *(f32x4*)(xout + off) = o;
                        if (WRITE_XB) { u32x2v w; w.x = cvt_pk_bf16(o[0], o[1]); w.y = cvt_pk_bf16(o[2], o[3]); *(u32x2v*)(xb + off) = w; }
                        ss += (o[0] * o[0] + o[1] * o[1]) + (o[2] * o[2] + o[3] * o[3]);
                    }
                ss += __shfl_xor(ss, 16); ss += __shfl_xor(ss, 32);
                if (fq == 0) rowss[(size_t)row * 16 + u.pn * 4 + wc] = ss;
                asm volatile("" ::: "memory");
            }
    }
};
template <class Epi, class Sched, bool ALIGN_EPI = false, bool SP2 = false>
__device__ __forceinline__ void gemm_phase(PG8_LAS unsigned char* lds, const Gemm g, const Sched& S, const Epi& E) {
    const int tid_ = mk_tid(lds);
    const int tid = tid_, wid = __builtin_amdgcn_readfirstlane(tid >> 6), lane = tid & 63, wr = wid >> 2, wc = wid & 3, fr = lane & 15, fq = lane >> 4;
    const int K = g.K, nt = K / BK;
    unsigned voffA[2], voffB[2];
#pragma unroll
    for (int i = 0; i < 2; ++i) { int R, C; stage_rc(tid * 16 + i * 8192, R, C); const int Rb = Epi::PERM ? ((R & ~31) + perm32(R & 31)) : R;
        voffA[i] = (unsigned)(R * K + C) * 2u; voffB[i] = (unsigned)(Rb * K + C) * 2u; }
    const size_t kstep = (size_t)(BK * 2);
    const size_t hstep = (size_t)HALF * K * 2;
    const size_t tstep = 2 * hstep;
    const unsigned ldsw = (unsigned)wid * 1024u;
    const int aoff = lds_byte(wr * 64 + fr, fq * 8), boff = lds_byte(wc * 32 + fr, fq * 8);
#define PG8_SA(b, h) (((b) * 2 + (h)) * HTB)
#define PG8_SB(b, h) ((4 + (b) * 2 + (h)) * HTB)
#define PG8_STAGE(bufoff, gbase, voff) do { _Pragma("unroll") for (int _i = 0; _i < 2; ++_i) \
        __builtin_amdgcn_global_load_lds((const unsigned*)((const char*)(gbase) + (voff)[_i]), (PG8_LAS unsigned*)(lds + (bufoff) + ldsw + _i * 8192), 16, 0, 0); } while (0)
#define PG8_LDA(dst, b, h) do { _Pragma("unroll") for (int m = 0; m < 4; ++m) _Pragma("unroll") for (int k = 0; k < 2; ++k) dst[m][k] = *(const PG8_LAS bf16x8*)(lds + PG8_SA(b, h) + aoff + m * 2048 + k * 1024); } while (0)
#define PG8_LDB(dst, b, h) do { _Pragma("unroll") for (int n = 0; n < 2; ++n) _Pragma("unroll") for (int k = 0; k < 2; ++k) dst[n][k] = *(const PG8_LAS bf16x8*)(lds + PG8_SB(b, h) + boff + n * 2048 + k * 1024); } while (0)
#define PG8_MMA(ai, bj, At, Bt) do { __builtin_amdgcn_s_setprio(1); _Pragma("unroll") for (int m = 0; m < 4; ++m) _Pragma("unroll") for (int n = 0; n < 2; ++n) _Pragma("unroll") for (int k = 0; k < 2; ++k) \
        acc[ai][bj][m][n] = __builtin_amdgcn_mfma_f32_16x16x32_bf16(Bt[n][k], At[m][k], acc[ai][bj][m][n], 0, 0, 0); __builtin_amdgcn_s_setprio(0); } while (0)
#define PG8_WAIT_V(n) asm volatile("s_waitcnt vmcnt(" #n ")" ::: "memory")
#define PG8_WAIT_L(n) asm volatile("s_waitcnt lgkmcnt(" #n ")" ::: "memory")
#define PG8_BAR __builtin_amdgcn_s_barrier()
#define PG8_SCHED __builtin_amdgcn_sched_barrier(0)
    Unit cur, nxt; int ui = 0;
    if (!S.next(0, cur)) return;
    f32x4 acc[2][2][4][2];
#pragma unroll
    for (int a = 0; a < 2; ++a)
#pragma unroll
        for (int b = 0; b < 2; ++b)
#pragma unroll
            for (int m = 0; m < 4; ++m)
#pragma unroll
                for (int n = 0; n < 2; ++n) acc[a][b][m][n] = (f32x4){0.f, 0.f, 0.f, 0.f};
    bf16x8 At[4][2], B0[2][2], B1[2][2];
    const char* cA = (const char*)g.A + (size_t)cur.pm * tstep; const char* cB = (const char*)g.Bt + (size_t)cur.pn * tstep;
    S.a_ready(cur);
    if constexpr (SP2) {
        PG8_STAGE(PG8_SB(0, 0), cB, voffB); PG8_STAGE(PG8_SB(0, 1), cB + hstep, voffB); PG8_STAGE(PG8_SA(0, 0), cA, voffA); PG8_STAGE(PG8_SA(0, 1), cA + hstep, voffA);
        if (wr == 1) PG8_BAR;
        PG8_WAIT_V(2); PG8_BAR;
        PG8_STAGE(PG8_SB(1, 0), cB + kstep, voffB); PG8_STAGE(PG8_SA(1, 0), cA + kstep, voffA); PG8_STAGE(PG8_SB(1, 1), cB + hstep + kstep, voffB);
        PG8_WAIT_V(6); PG8_BAR;
    } else {
        PG8_STAGE(PG8_SB(0, 0), cB, voffB); PG8_STAGE(PG8_SA(0, 0), cA, voffA); PG8_STAGE(PG8_SB(0, 1), cB + hstep, voffB); PG8_STAGE(PG8_SA(0, 1), cA + hstep, voffA);
        if (wr == 1) PG8_BAR;
        PG8_WAIT_V(4); PG8_BAR;
        PG8_STAGE(PG8_SB(1, 0), cB + kstep, voffB); PG8_STAGE(PG8_SA(1, 0), cA + kstep, voffA); PG8_STAGE(PG8_SB(1, 1), cB + hstep + kstep, voffB);
        PG8_WAIT_V(6); PG8_BAR;
    }
    for (;;) {
        const bool has_next = S.next(ui + 1, nxt);
        const char* nA = has_next ? (const char*)g.A + (size_t)nxt.pm * tstep : cA; const char* nB = has_next ? (const char*)g.Bt + (size_t)nxt.pn * tstep : cB;
        for (int t = 0; t < nt; t += 2) {
            const bool last = (t == nt - 2);
            const char* a1 = cA + (size_t)(t + 1) * kstep;
            const char* a2 = last ? nA : cA + (size_t)(t + 2) * kstep; const char* b2 = last ? nB : cB + (size_t)(t + 2) * kstep;
            const char* a3 = a2 + kstep; const char* b3 = b2 + kstep;
            if (last && has_next) S.a_ready(nxt);
            if constexpr (SP2) {
            PG8_LDB(B0, 0, 0); PG8_LDB(B1, 0, 1); PG8_SCHED; PG8_LDA(At, 0, 0); PG8_STAGE(PG8_SA(1, 1), a1 + hstep, voffA);
            PG8_WAIT_V(8); PG8_WAIT_L(0); PG8_BAR; PG8_MMA(0, 0, At, B0); PG8_MMA(0, 1, At, B1); PG8_BAR; PG8_SCHED;
            PG8_LDA(At, 0, 1); PG8_STAGE(PG8_SB(0, 0), b2, voffB); PG8_STAGE(PG8_SB(0, 1), b2 + hstep, voffB); PG8_STAGE(PG8_SA(0, 0), a2, voffA);
            PG8_WAIT_V(8); PG8_WAIT_L(0); PG8_BAR; PG8_MMA(1, 0, At, B0); PG8_MMA(1, 1, At, B1); PG8_BAR; PG8_SCHED;
            PG8_LDB(B0, 1, 0); PG8_LDB(B1, 1, 1); PG8_SCHED; PG8_LDA(At, 1, 0); PG8_STAGE(PG8_SA(0, 1), a2 + hstep, voffA);
            PG8_WAIT_V(8); PG8_WAIT_L(0); PG8_BAR; PG8_MMA(0, 0, At, B0); PG8_MMA(0, 1, At, B1); PG8_BAR; PG8_SCHED;
            PG8_LDA(At, 1, 1); PG8_STAGE(PG8_SB(1, 0), b3, voffB); PG8_STAGE(PG8_SB(1, 1), b3 + hstep, voffB); PG8_STAGE(PG8_SA(1, 0), a3, voffA);
            PG8_WAIT_V(8); PG8_WAIT_L(0); PG8_BAR; PG8_MMA(1, 0, At, B0); PG8_MMA(1, 1, At, B1); PG8_BAR; PG8_SCHED;
            } else {
            PG8_LDB(B0, 0, 0); PG8_SCHED; PG8_LDA(At, 0, 0); PG8_STAGE(PG8_SA(1, 1), a1 + hstep, voffA);
            PG8_WAIT_L(8); PG8_BAR; PG8_WAIT_L(0); PG8_MMA(0, 0, At, B0); PG8_BAR; PG8_SCHED;
            PG8_LDB(B1, 0, 1); PG8_STAGE(PG8_SB(0, 0), b2, voffB);
            PG8_BAR; PG8_WAIT_L(0); PG8_MMA(0, 1, At, B1); PG8_BAR;
            PG8_LDA(At, 0, 1); PG8_STAGE(PG8_SA(0, 0), a2, voffA);
            PG8_BAR; PG8_WAIT_L(0); PG8_MMA(1, 0, At, B0); PG8_BAR; PG8_SCHED;
            PG8_STAGE(PG8_SB(0, 1), b2 + hstep, voffB);
            PG8_WAIT_V(6); PG8_BAR; PG8_MMA(1, 1, At, B1); PG8_BAR;
            PG8_LDB(B0, 1, 0); PG8_SCHED; PG8_LDA(At, 1, 0); PG8_STAGE(PG8_SA(0, 1), a2 + hstep, voffA);
            PG8_WAIT_L(8); PG8_BAR; PG8_WAIT_L(0); PG8_MMA(0, 0, At, B0); PG8_BAR; PG8_SCHED;
            PG8_LDB(B1, 1, 1); PG8_STAGE(PG8_SB(1, 0), b3, voffB);
            PG8_BAR; PG8_WAIT_L(0); PG8_MMA(0, 1, At, B1); PG8_BAR;
            PG8_LDA(At, 1, 1); PG8_STAGE(PG8_SA(1, 0), a3, voffA);
            PG8_BAR; PG8_WAIT_L(0); PG8_MMA(1, 0, At, B0); PG8_BAR; PG8_SCHED;
            PG8_STAGE(PG8_SB(1, 1), b3 + hstep, voffB);
            PG8_WAIT_V(6); PG8_BAR; PG8_MMA(1, 1, At, B1); PG8_BAR;
            }
        }
        if constexpr (ALIGN_EPI) { if (wr == 0) PG8_BAR; }
        if constexpr (!Epi::AFTER_DRAIN) { E(acc, cur, wr, wc, fr, fq); S.done(cur); }
        if (!has_next) break;
#pragma unroll
        for (int a = 0; a < 2; ++a)
#pragma unroll
            for (int b = 0; b < 2; ++b)
#pragma unroll
                for (int m = 0; m < 4; ++m)
#pragma unroll
                    for (int n = 0; n < 2; ++n) acc[a][b][m][n] = (f32x4){0.f, 0.f, 0.f, 0.f};
        cur = nxt; cA = nA; cB = nB; ++ui;
        if constexpr (ALIGN_EPI) { if (wr == 1) PG8_BAR; }
    }
    PG8_WAIT_V(0);
    if constexpr (!ALIGN_EPI) { if (wr == 0) PG8_BAR; }
    PG8_BAR;
    if constexpr (Epi::AFTER_DRAIN) { E.fused(acc, cur, wr, wc, fr, fq, lds, wid, lane); S.done(cur); }
#undef PG8_SA
#undef PG8_SB
#undef PG8_STAGE
#undef PG8_LDA
#undef PG8_LDB
#undef PG8_MMA
#undef PG8_WAIT_V
#undef PG8_WAIT_L
#undef PG8_BAR
#undef PG8_SCHED
}
}
#define GAS __attribute__((address_space(1)))
#define LAS __attribute__((address_space(3)))
typedef unsigned short bf16;
typedef unsigned v4u __attribute__((ext_vector_type(4)));
typedef float f32x4 __attribute__((ext_vector_type(4)));
typedef short bf16x8 __attribute__((ext_vector_type(8)));
typedef GAS unsigned gu32;
typedef GAS unsigned long long gu64;
#define RLX_AGENT __ATOMIC_RELAXED, __HIP_MEMORY_SCOPE_AGENT
#define LDS_WAIT() asm volatile("s_waitcnt lgkmcnt(0)" ::: "memory")
#define VM_WAIT() asm volatile("s_waitcnt vmcnt(0)" ::: "memory")
__device__ __forceinline__ unsigned long long rt() { return __builtin_amdgcn_s_memrealtime(); }
__device__ __forceinline__ unsigned f2bf(float f) { unsigned u = __builtin_bit_cast(unsigned, f); return (u + 0x7fffu + ((u >> 16) & 1u)) >> 16; }
__device__ __forceinline__ unsigned pk2(float lo, float hi) { return f2bf(lo) | (f2bf(hi) << 16); }

#define XB_TMO      128
#define XB_XCNT(j)  (256  + 64 * (j))
#define XB_XSUB(j)  (1280 + 64 * (j))
#define XB_XGEN(j)  (2304 + 64 * (j))
#define XB_TOP      3328
#define XB_TOPGEN   3392
#define XCD_BAR_WORDS 3456
#define XB_SPIN_CAP (1u << 18)

__device__ __forceinline__ unsigned xb_ld(unsigned* p)              { return __hip_atomic_load(p, __ATOMIC_RELAXED, __HIP_MEMORY_SCOPE_AGENT); }
__device__ __forceinline__ unsigned xb_add(unsigned* p, unsigned v) { return __hip_atomic_fetch_add(p, v, __ATOMIC_RELAXED, __HIP_MEMORY_SCOPE_AGENT); }
__device__ __forceinline__ unsigned xb_xcc_id() { return (unsigned)__builtin_amdgcn_s_getreg((3 << 11) | 20) & 0xFu; }
#define XB_SPIN(cond, bar) do { unsigned _sp = 0; while (cond) { __builtin_amdgcn_s_sleep(1); \
    if ((++_sp & 255u) == 0u) { if (xb_ld(&(bar)[XB_TMO])) break; if (_sp > XB_SPIN_CAP) { atomicAdd(&(bar)[XB_TMO], 1u); break; } } } } while (0)

struct XcdBarrier {
    unsigned* bar; unsigned x;
    volatile LAS unsigned* st;
};

__device__ __forceinline__ XcdBarrier xcd_barrier_post(unsigned* bar, volatile LAS unsigned* st) {
    XcdBarrier b; b.bar = bar; b.x = xb_xcc_id(); b.st = st;
    if (threadIdx.x == 0) (void)xb_add(&bar[XB_XCNT(b.x)], 1u);
    return b;
}
__device__ __forceinline__ void xcd_barrier_complete(unsigned* bar, unsigned x, unsigned& nloc, unsigned& nx) {
    const unsigned G = gridDim.x * gridDim.y * gridDim.z;
    unsigned sum, cnt, mine, sp = 0u;
    for (;;) {
        sum = 0u; cnt = 0u; mine = 0u;
#pragma unroll
        for (unsigned j = 0; j < 16; ++j) { const unsigned c = xb_ld(&bar[XB_XCNT(j)]); sum += c; cnt += (c > 0u) ? 1u : 0u; mine = (j == x) ? c : mine; }
        if (sum == G) break;
        __builtin_amdgcn_s_sleep(1);
        if ((++sp & 255u) == 0u) { if (xb_ld(&bar[XB_TMO])) break; if (sp > XB_SPIN_CAP) { atomicAdd(&bar[XB_TMO], 1u); break; } }
    }
    nloc = mine > 0u ? mine : 1u; nx = cnt > 0u ? cnt : 1u;
}

__device__ __forceinline__ void xcd_barrier(const XcdBarrier& b) {
    asm volatile("s_waitcnt vmcnt(0)" ::: "memory");
    __syncthreads();
    if (pg8::mk_tid((LAS unsigned char*)b.st - (131072 + 320 + 32)) == 0) {
        unsigned* bar = b.bar;
        __builtin_amdgcn_s_waitcnt(0);
        unsigned nloc = b.st[0], nx = b.st[1];
        if (nloc == 0u) { xcd_barrier_complete(bar, b.x, nloc, nx); b.st[0] = nloc; b.st[1] = nx; }
        const unsigned old = xb_add(&bar[XB_XSUB(b.x)], 1u);
        const unsigned gen = old / nloc;
        if (old + 1u == (gen + 1u) * nloc) {
            __builtin_amdgcn_fence(__ATOMIC_RELEASE, "agent");
            asm volatile("s_waitcnt vmcnt(0)" ::: "memory");
            const unsigned og = xb_add(&bar[XB_TOP], 1u);
            const unsigned tg = og / nx;
            if (og + 1u == (tg + 1u) * nx) xb_add(&bar[XB_TOPGEN], 1u);
            else XB_SPIN(xb_ld(&bar[XB_TOPGEN]) == tg, bar);
            __builtin_amdgcn_fence(__ATOMIC_ACQUIRE, "agent");
            xb_add(&bar[XB_XGEN(b.x)], 1u);
            asm volatile("s_waitcnt vmcnt(0)" ::: "memory");
        } else {
            XB_SPIN(xb_ld(&bar[XB_XGEN(b.x)]) == gen, bar);
            __builtin_amdgcn_fence(__ATOMIC_ACQUIRE, "agent");
            asm volatile("s_waitcnt vmcnt(0)" ::: "memory");
        }
    }
    __syncthreads();
}
constexpr int BATCH = 8, SEQ = 2048, M = BATCH * SEQ, D = 1024, NIN = 3448, NP = 3584;
constexpr float NORM_EPS = 1e-6f;
constexpr float LOG2E = 1.4426950408889634f;
constexpr size_t MiB = 1u << 20;
constexpr size_t WS_CTL = 0, CTL_ZERO_BYTES = 1 * MiB;
constexpr size_t WS_ROWSS = 1 * MiB;
constexpr size_t WS_WIN = 2 * MiB;
constexpr size_t WS_WOUT = 16 * MiB;
constexpr size_t WS_WSMALL = 20 * MiB;
constexpr size_t OFF_WUQ = 0, OFF_WUKV = 2 * 576 * 192 * 2, OFF_W2T = OFF_WUKV + 2 * 768 * 128 * 2, OFF_A2T = OFF_W2T + 2 * 2 * 256 * 64 * 2;
constexpr size_t WS_PSM = 22 * MiB;
constexpr size_t WS_CB = 24 * MiB;
constexpr size_t WS_PGATE = 25 * MiB;
constexpr size_t WS_PGDN = 57 * MiB;
constexpr size_t WS_PMLA = 93 * MiB;
constexpr size_t WS_PRW = 104 * MiB;
constexpr size_t WS_OGDN = 93 * MiB;
constexpr size_t WS_OMLA = 105 * MiB;
constexpr size_t WS_Y = 117 * MiB;
constexpr size_t WS_RS = 133 * MiB;
constexpr size_t WS_RD = 157 * MiB;
constexpr size_t WS_XB = 133 * MiB;
constexpr size_t WS_Q = 207 * MiB;
constexpr size_t WS_K = 225 * MiB;
constexpr size_t WS_VT = 243 * MiB;
constexpr size_t WS_MIX = 207 * MiB;
constexpr size_t WS_END = 255 * MiB;
constexpr int RS_REC = 384, RD_REC = 400;
constexpr size_t RD_DIR = (size_t)BATCH * 4 * SEQ * RD_REC;
constexpr int CW_BAR = 4096;
constexpr int CW_QUEUE = 16384;

constexpr int NWAVES = 8;
constexpr int RING_OFF = 0, RING_BYTES = 131072, LDSCTL_OFF = RING_BYTES, MISC_OFF = LDSCTL_OFF + 320, LDS_BYTES = 147456;
static_assert(pg8::TIDTAB_OFF == MISC_OFF + 512 && RING_OFF == 0, "LDS map");
constexpr int NPHASE = 12;

__device__ __forceinline__ float bf2f(bf16 v) { return __uint_as_float(((unsigned)v) << 16); }
__device__ __forceinline__ float wave_sum(float v) {
#pragma unroll
    for (int o = 1; o < 64; o <<= 1) v += __shfl_xor(v, o);
    return v;
}
__device__ __forceinline__ float siluf(float x) { return x * __builtin_amdgcn_rcpf(1.f + __expf(-x)); }
__device__ __forceinline__ float sigmoidf_(float x) { return __builtin_amdgcn_rcpf(1.f + __expf(-x)); }
__device__ __forceinline__ float softplusf_(float x) { return x > 20.f ? x : log1pf(__expf(x)); }

typedef float f32x2_t __attribute__((ext_vector_type(2))); typedef __bf16 bf16x2_t __attribute__((ext_vector_type(2)));
__device__ __forceinline__ unsigned cvt2bf(float lo, float hi) { const f32x2_t v = {lo, hi}; const bf16x2_t b = __builtin_convertvector(v, bf16x2_t); return __builtin_bit_cast(unsigned, b); }

struct Args { const void* in[24]; float* out; unsigned char* ws; int ph_lo, ph_hi; };

struct Frame {
    LAS unsigned char* lds;
    volatile LAS unsigned* MISC;
    gu32* ctl;
    int tid, lane, wave, vcu, G;
    unsigned char* ws;
    float* out;
    volatile LAS const unsigned long long* ptab;
};
__device__ __forceinline__ const void* inptr(const Frame& F, int k) {
    const unsigned long long v = F.ptab[k];
    const unsigned lo = __builtin_amdgcn_readfirstlane((unsigned)v), hi = __builtin_amdgcn_readfirstlane((unsigned)(v >> 32));
    return (const void*)(GAS const void*)(((unsigned long long)hi << 32) | lo);
}

__device__ __forceinline__ void tr_item(const float* W, int K, int ldsrc, int scol, int nvalid, bf16* WT, const float* gs, LAS float* scr, int kb, int lane) {
    const int k0 = 64 * kb;
#pragma unroll 8
    for (int i = 0; i < 32; ++i) { const int kk = 2 * i + (lane >> 5), n = lane & 31; float v = 0.f;
        if (n < nvalid) { v = W[(size_t)(k0 + kk) * ldsrc + scol + n]; if (gs) v *= gs[k0 + kk]; }
        scr[kk * 33 + n] = v; }
    LDS_WAIT(); asm volatile("" ::: "memory");
    const int c = lane & 7;
#pragma unroll
    for (int j = 0; j < 4; ++j) { const int n = (lane >> 3) + 8 * j; const LAS float* s = scr + (8 * c) * 33 + n;
        v4u o; o.x = pk2(s[0 * 33], s[1 * 33]); o.y = pk2(s[2 * 33], s[3 * 33]); o.z = pk2(s[4 * 33], s[5 * 33]); o.w = pk2(s[6 * 33], s[7 * 33]);
        *(GAS v4u*)(WT + (size_t)n * K + k0 + 8 * c) = o; }
    LDS_WAIT(); asm volatile("" ::: "memory");
}
__device__ __forceinline__ void p0_prologue(Frame& F) {
    LAS float* scr = (LAS float*)(F.lds + RING_OFF + F.wave * 16384);
    const int gw = F.vcu * NWAVES + F.wave, NGW = F.G * NWAVES;
    constexpr int I_IN = 112 * 16, I_OUT = 32 * 16, I_UQ = 18 * 3, I_UKV = 24 * 2, I_W2 = 16, I_A2 = 16, I_L = I_IN + I_OUT + I_UQ + I_UKV + I_W2 + I_A2;
    for (int it = gw; it < 2 * I_L; it += NGW) {
        const int l = it / I_L; int r = it % I_L;
        if (r < I_IN) { const int nb = r >> 4, kb = r & 15, n0 = 32 * nb; int scol, nv;
            if (n0 < 2176) { scol = n0; nv = 32; } else if (n0 < 3424) { scol = n0 + 24; nv = 32; } else if (n0 == 3424) { scol = 2176; nv = 24; } else { scol = 0; nv = 0; }
            tr_item((const float*)inptr(F, 3) + (size_t)l * D * NIN, D, NIN, scol, nv, (bf16*)(F.ws + WS_WIN) + ((size_t)l * NP + n0) * D, (const float*)inptr(F, 2) + l * D, scr, kb, F.lane); continue; }
        r -= I_IN;
        if (r < I_OUT) { const int nb = r >> 4, kb = r & 15;
            tr_item((const float*)inptr(F, 22) + (size_t)l * D * D, D, D, 32 * nb, 32, (bf16*)(F.ws + WS_WOUT) + ((size_t)l * D + 32 * nb) * D, nullptr, scr, kb, F.lane); continue; }
        r -= I_OUT;
        if (r < I_UQ) { const int nb = r / 3, kb = r % 3;
            tr_item((const float*)inptr(F, 9) + (size_t)l * 192 * 576, 192, 576, 32 * nb, 32, (bf16*)(F.ws + WS_WSMALL + OFF_WUQ) + ((size_t)l * 576 + 32 * nb) * 192, (const float*)inptr(F, 8) + l * 192, scr, kb, F.lane); continue; }
        r -= I_UQ;
        if (r < I_UKV) { const int nb = r >> 1, kb = r & 1;
            tr_item((const float*)inptr(F, 11) + (size_t)l * 128 * 768, 128, 768, 32 * nb, 32, (bf16*)(F.ws + WS_WSMALL + OFF_WUKV) + ((size_t)l * 768 + 32 * nb) * 128, (const float*)inptr(F, 10) + l * 128, scr, kb, F.lane); continue; }
        r -= I_UKV;
        if (r < I_W2) { const int e = r >> 3, nb = r & 7;
            tr_item((const float*)inptr(F, 14) + ((size_t)l * 2 + e) * 64 * 256, 64, 256, 32 * nb, 32, (bf16*)(F.ws + WS_WSMALL + OFF_W2T) + (((size_t)l * 2 + e) * 256 + 32 * nb) * 64, nullptr, scr, 0, F.lane); continue; }
        r -= I_W2;
        { const int e = r >> 3, nb = r & 7;
            tr_item((const float*)inptr(F, 16) + ((size_t)l * 2 + e) * 64 * 256, 64, 256, 32 * nb, 32, (bf16*)(F.ws + WS_WSMALL + OFF_A2T) + (((size_t)l * 2 + e) * 256 + 32 * nb) * 64, nullptr, scr, 0, F.lane); }
    }
    const float* x = (const float*)inptr(F, 0); bf16* xb = (bf16*)(F.ws + WS_XB); float* rowss = (float*)(F.ws + WS_ROWSS);
    for (int m = gw; m < M; m += NGW) {
        const GAS f32x4* xr = (const GAS f32x4*)(x + (size_t)m * D) + F.lane;
        GAS unsigned long long* o8 = (GAS unsigned long long*)(xb + (size_t)m * D) + F.lane; float s = 0.f;
#pragma unroll
        for (int j = 0; j < 4; ++j) { const f32x4 v = xr[64 * j]; s += (v.x * v.x + v.y * v.y) + (v.z * v.z + v.w * v.w);
            o8[64 * j] = (unsigned long long)pk2(v.x, v.y) | ((unsigned long long)pk2(v.z, v.w) << 32); }
        s = wave_sum(s);
        if (F.lane < 16) rowss[(size_t)m * 16 + F.lane] = F.lane == 0 ? s : 0.f;
    }
}
__device__ __forceinline__ void p5_final(Frame& F) {
    const int gw = F.vcu * NWAVES + F.wave, NGW = F.G * NWAVES;
    const float* rowss = (const float*)(F.ws + WS_ROWSS); const float* g = (const float*)inptr(F, 23);
    f32x4 gv[4];
#pragma unroll
    for (int j = 0; j < 4; ++j) gv[j] = ((const f32x4*)g)[F.lane + 64 * j];
    for (int m = gw; m < M; m += NGW) {
        float ss = F.lane < 16 ? rowss[(size_t)m * 16 + F.lane] : 0.f;
        ss = wave_sum(ss);
        const float rstd = rsqrtf(ss * (1.f / D) + NORM_EPS);
        GAS f32x4* xr = (GAS f32x4*)(F.out + (size_t)m * D) + F.lane;
#pragma unroll
        for (int j = 0; j < 4; ++j) { f32x4 v = xr[64 * j]; v = v * rstd * gv[j]; xr[64 * j] = v; }
    }
}
typedef float f32x16 __attribute__((ext_vector_type(16)));
typedef unsigned long long u64_t;
__device__ __forceinline__ bf16x8 mk_bf16x8(u64_t lo, u64_t hi) { typedef u64_t u64x2 __attribute__((ext_vector_type(2))); u64x2 v = {lo, hi}; return __builtin_bit_cast(bf16x8, v); }

constexpr int AT_KP = 208, AT_VP = 136, AT_KBYTES = 64 * AT_KP, AT_VBYTES = 64 * AT_VP, AT_BUF = AT_KBYTES + AT_VBYTES;
__device__ __forceinline__ float at_max3(float a, float b, float c) { float r; asm("v_max3_f32 %0, %1, %2, %3" : "=v"(r) : "v"(a), "v"(b), "v"(c)); return r; }
__device__ __forceinline__ void attn_unit(Frame& F, int unit) {
    const int bh = unit >> 3, qb = unit & 7, b = bh / 6, h = bh % 6;
    const int tid = F.tid, lane = F.lane, wave = F.wave, r32 = lane & 31, hi = lane >> 5;
    const bf16* Qg = (const bf16*)(F.ws + WS_Q) + ((size_t)bh * SEQ + qb * 256 + wave * 32 + r32) * 96;
    const bf16* Kg = (const bf16*)(F.ws + WS_K) + (size_t)bh * SEQ * 96;
    const bf16* Vg = (const bf16*)(F.ws + WS_VT) + (size_t)bh * 64 * SEQ;
    LAS unsigned char* lds = F.lds + RING_OFF;
    bf16x8 qf[6];
#pragma unroll
    for (int s = 0; s < 6; ++s) qf[s] = *(const bf16x8*)(Qg + 16 * s + 8 * hi);
    const int kr0 = tid / 12, kc0 = tid % 12, kr1 = (512 + tid) / 12, kc1 = (512 + tid) % 12, vd = tid >> 3, vc = tid & 7;
    const bool has1 = tid < 256;
    v4u ka0, ka1 = {0u, 0u, 0u, 0u}, va, kb0, kb1 = {0u, 0u, 0u, 0u}, vb;
#define AT_LOAD(K0, K1, V_, t0) do { K0 = *(const v4u*)(Kg + (size_t)((t0) + kr0) * 96 + kc0 * 8); if (has1) K1 = *(const v4u*)(Kg + (size_t)((t0) + kr1) * 96 + kc1 * 8); \
        V_ = *(const v4u*)(Vg + (size_t)vd * SEQ + (t0) + vc * 8); } while (0)
#define AT_STORE(K0, K1, V_, buf) do { LAS unsigned char* bb_ = lds + (buf) * AT_BUF; *(LAS v4u*)(bb_ + kr0 * AT_KP + kc0 * 16) = K0; if (has1) *(LAS v4u*)(bb_ + kr1 * AT_KP + kc1 * 16) = K1; \
        LAS u64_t* vp_ = (LAS u64_t*)(bb_ + AT_KBYTES + vd * AT_VP + vc * 16); vp_[0] = (u64_t)V_.x | ((u64_t)V_.y << 32); vp_[1] = (u64_t)V_.z | ((u64_t)V_.w << 32); } while (0)
    AT_LOAD(ka0, ka1, va, 0); AT_STORE(ka0, ka1, va, 0);
    AT_LOAD(ka0, ka1, va, 64);
    __syncthreads();
    f32x16 o0 = {}, o1 = {};
    float mrun = -1e30f, lsum = 0.f;
    constexpr int NT = SEQ / 64;
    auto tile = [&](int t) {
        LAS unsigned char* bb = lds + (t % 3) * AT_BUF;
        f32x16 p0 = {}, p1 = {};
        { const LAS unsigned char* kb = bb + r32 * AT_KP + hi * 16;
#pragma unroll
          for (int s = 0; s < 6; ++s) {
              const bf16x8 a0 = *(const LAS bf16x8*)(kb + 32 * s), a1 = *(const LAS bf16x8*)(kb + 32 * AT_KP + 32 * s);
              p0 = __builtin_amdgcn_mfma_f32_32x32x16_bf16(a0, qf[s], p0, 0, 0, 0);
              p1 = __builtin_amdgcn_mfma_f32_32x32x16_bf16(a1, qf[s], p1, 0, 0, 0); } }
        asm volatile("s_nop 15\n\ts_nop 7" : "+v"(p0), "+v"(p1));
        float ma = at_max3(p0[0], p0[1], p1[0]), mb = at_max3(p0[2], p0[3], p1[1]); ma = at_max3(ma, p1[2], p1[3]);
#pragma unroll
        for (int r = 4; r < 16; r += 4) { ma = at_max3(ma, p0[r], p0[r + 1]); mb = at_max3(mb, p0[r + 2], p0[r + 3]); ma = at_max3(ma, p1[r], p1[r + 1]); mb = at_max3(mb, p1[r + 2], p1[r + 3]); }
        float mloc = at_max3(ma, mb, mrun);
        { const auto rr = __builtin_amdgcn_permlane32_swap(__float_as_uint(mloc), __float_as_uint(mloc), false, false); mloc = at_max3(__uint_as_float(rr[0]), __uint_as_float(rr[1]), mloc); }
        const float mnew = mloc, alpha = __builtin_amdgcn_exp2f(mrun - mnew);
        mrun = mnew; lsum *= alpha;
#pragma unroll
        for (int r = 0; r < 16; ++r) { o0[r] *= alpha; o1[r] *= alpha; }
        float ps = 0.f;
#pragma unroll
        for (int r = 0; r < 16; ++r) { p0[r] = __builtin_amdgcn_exp2f(p0[r] - mnew); p1[r] = __builtin_amdgcn_exp2f(p1[r] - mnew); ps += p0[r] + p1[r]; }
        lsum += ps;
        v4u pk[4];
#pragma unroll
        for (int s2 = 0; s2 < 2; ++s2) {
            pk[s2] = (v4u){pg8::cvt_pk_bf16(p0[8 * s2], p0[8 * s2 + 1]), pg8::cvt_pk_bf16(p0[8 * s2 + 2], p0[8 * s2 + 3]), pg8::cvt_pk_bf16(p0[8 * s2 + 4], p0[8 * s2 + 5]), pg8::cvt_pk_bf16(p0[8 * s2 + 6], p0[8 * s2 + 7])};
            pk[2 + s2] = (v4u){pg8::cvt_pk_bf16(p1[8 * s2], p1[8 * s2 + 1]), pg8::cvt_pk_bf16(p1[8 * s2 + 2], p1[8 * s2 + 3]), pg8::cvt_pk_bf16(p1[8 * s2 + 4], p1[8 * s2 + 5]), pg8::cvt_pk_bf16(p1[8 * s2 + 6], p1[8 * s2 + 7])};
        }
        { const LAS unsigned char* vb_ = bb + AT_KBYTES + r32 * AT_VP + hi * 8;
#pragma unroll
          for (int ks = 0; ks < 4; ++ks) {
              const bf16x8 pb = __builtin_bit_cast(bf16x8, pk[ks]);
              const bf16x8 v0 = mk_bf16x8(*(const LAS u64_t*)(vb_ + ks * 32), *(const LAS u64_t*)(vb_ + ks * 32 + 16));
              const bf16x8 v1 = mk_bf16x8(*(const LAS u64_t*)(vb_ + 32 * AT_VP + ks * 32), *(const LAS u64_t*)(vb_ + 32 * AT_VP + ks * 32 + 16));
              o0 = __builtin_amdgcn_mfma_f32_32x32x16_bf16(v0, pb, o0, 0, 0, 0);
              o1 = __builtin_amdgcn_mfma_f32_32x32x16_bf16(v1, pb, o1, 0, 0, 0); } }
    };
    for (int t = 0; t < NT; t += 2) {
        if (t + 2 < NT) AT_LOAD(kb0, kb1, vb, (t + 2) * 64);
        tile(t);
        AT_STORE(ka0, ka1, va, (t + 1) % 3);
        __syncthreads();
        if (t + 3 < NT) AT_LOAD(ka0, ka1, va, (t + 3) * 64);
        tile(t + 1);
        if (t + 2 < NT) AT_STORE(kb0, kb1, vb, (t + 2) % 3);
        __syncthreads();
    }
#undef AT_LOAD
#undef AT_STORE
    lsum += __shfl_xor(lsum, 32);
    const float inv = 1.f / lsum;
    bf16* Og = (bf16*)(F.ws + WS_OMLA) + ((size_t)b * SEQ + qb * 256 + wave * 32 + r32) * 384 + h * 64 + 4 * hi;
#pragma unroll
    for (int rg = 0; rg < 4; ++rg) {
        *(u64_t*)(Og + 8 * rg) = (u64_t)pg8::cvt_pk_bf16(o0[4 * rg] * inv, o0[4 * rg + 1] * inv) | ((u64_t)pg8::cvt_pk_bf16(o0[4 * rg + 2] * inv, o0[4 * rg + 3] * inv) << 32);
        *(u64_t*)(Og + 32 + 8 * rg) = (u64_t)pg8::cvt_pk_bf16(o1[4 * rg] * inv, o1[4 * rg + 1] * inv) | ((u64_t)pg8::cvt_pk_bf16(o1[4 * rg + 2] * inv, o1[4 * rg + 3] * inv) << 32);
    }
}

constexpr int CW_FLAG = 32768;
__device__ __forceinline__ void partner_sync(Frame& F, gu32* mine, gu32* theirs) {
    asm volatile("s_waitcnt vmcnt(0)" ::: "memory");
    __syncthreads();
    if (F.tid == 0) {
        __builtin_amdgcn_fence(__ATOMIC_RELEASE, "agent");
        asm volatile("s_waitcnt vmcnt(0)" ::: "memory");
        __hip_atomic_store(mine, 1u, RLX_AGENT);
        unsigned spins = 0;
        while (__hip_atomic_load(theirs, RLX_AGENT) == 0u) { __builtin_amdgcn_s_sleep(4); if (++spins > (1u << 22)) break; }
        __builtin_amdgcn_fence(__ATOMIC_ACQUIRE, "agent");
        asm volatile("s_waitcnt vmcnt(0)" ::: "memory");
    }
    __syncthreads();
}
constexpr int RW_STEP = 1440, RW_CH = 32, RW_BUF = RW_CH * RW_STEP;
constexpr int RW_Y = 2 * RW_BUF;
static_assert(RW_Y + 2 * 4096 <= RING_BYTES, "RWKV LDS map");
__device__ __forceinline__ float dpp_xor1(float x) { return __builtin_bit_cast(float, __builtin_amdgcn_update_dpp(0, __builtin_bit_cast(int, x), 0xB1, 0xF, 0xF, true)); }
__device__ __forceinline__ float dpp_xor2(float x) { return __builtin_bit_cast(float, __builtin_amdgcn_update_dpp(0, __builtin_bit_cast(int, x), 0x4E, 0xF, 0xF, true)); }
__device__ __forceinline__ float dpp_hmir(float x) { return __builtin_bit_cast(float, __builtin_amdgcn_update_dpp(0, __builtin_bit_cast(int, x), 0x141, 0xF, 0xF, true)); }
__device__ __forceinline__ float dpp_rmir(float x) { return __builtin_bit_cast(float, __builtin_amdgcn_update_dpp(0, __builtin_bit_cast(int, x), 0x140, 0xF, 0xF, true)); }
template <int SKIP> __device__ __forceinline__ void rwkv_unit(Frame& F, int unit, gu32* flags) {
    const int bh = unit >> 2, rowhalf = (unit >> 1) & 1, dir = unit & 1, b = bh >> 2, h = bh & 3;
    const int tid = F.tid, lane = F.lane, ri = lane >> 4, cs = lane & 15, row = 4 * F.wave + ri;
    const bool stager = true;
    const unsigned char* Rs = F.ws + WS_RS + (size_t)bh * SEQ * RS_REC;
    const unsigned char* Rd = F.ws + WS_RD + dir * RD_DIR + (size_t)bh * SEQ * RD_REC;
    LAS unsigned char* lds = F.lds + RING_OFF;
    const int ss = tid >> 4, sp = tid & 15;
    u64_t g_kk = 0, g_r = 0, g_lam = 0, g_b = 0, g_k = 0, g_v = 0, g_s = 0;
#define RW_ISSUE(c_) do { const int n_ = (c_) * RW_CH + ss, t_ = dir ? SEQ - 1 - n_ : n_; const unsigned char* rs_ = Rs + (size_t)t_ * RS_REC; const unsigned char* rd_ = Rd + (size_t)t_ * RD_REC; \
        g_kk = *(const u64_t*)(rs_ + 8 * sp); g_r = *(const u64_t*)(rs_ + 256 + 8 * sp); g_lam = *(const u64_t*)(rd_ + 8 * sp); g_b = *(const u64_t*)(rd_ + 128 + 8 * sp); g_k = *(const u64_t*)(rd_ + 256 + 8 * sp); \
        if (sp < 8) g_v = *(const u64_t*)(rs_ + 128 + 64 * rowhalf + 8 * sp); if (sp == 8) g_s = *(const u64_t*)(rd_ + 384); } while (0)
#define RW_BF(x, j) __uint_as_float(((unsigned)((x) >> (16 * (j)))) << 16)
#define RW_STAGE(buf_) do { LAS unsigned char* d_ = lds + (buf_) * RW_BUF + ss * RW_STEP + 16 * sp; f32x4 w_, t4_; \
        w_[0] = __builtin_amdgcn_exp2f(-LOG2E * __half2float(__ushort_as_half((unsigned short)(g_lam)))); w_[1] = __builtin_amdgcn_exp2f(-LOG2E * __half2float(__ushort_as_half((unsigned short)(g_lam >> 16)))); \
        w_[2] = __builtin_amdgcn_exp2f(-LOG2E * __half2float(__ushort_as_half((unsigned short)(g_lam >> 32)))); w_[3] = __builtin_amdgcn_exp2f(-LOG2E * __half2float(__ushort_as_half((unsigned short)(g_lam >> 48)))); \
        *(LAS f32x4*)d_ = w_; \
        t4_ = (f32x4){RW_BF(g_r, 0), RW_BF(g_r, 1), RW_BF(g_r, 2), RW_BF(g_r, 3)}; *(LAS f32x4*)(d_ + 256) = w_ * t4_; \
        t4_ = (f32x4){RW_BF(g_kk, 0), RW_BF(g_kk, 1), RW_BF(g_kk, 2), RW_BF(g_kk, 3)}; *(LAS f32x4*)(d_ + 512) = -t4_; \
        t4_ = (f32x4){RW_BF(g_b, 0), RW_BF(g_b, 1), RW_BF(g_b, 2), RW_BF(g_b, 3)}; *(LAS f32x4*)(d_ + 768) = t4_; \
        t4_ = (f32x4){RW_BF(g_k, 0), RW_BF(g_k, 1), RW_BF(g_k, 2), RW_BF(g_k, 3)}; *(LAS f32x4*)(d_ + 1024) = t4_; \
        if (sp < 8) { t4_ = (f32x4){RW_BF(g_v, 0), RW_BF(g_v, 1), RW_BF(g_v, 2), RW_BF(g_v, 3)}; *(LAS f32x4*)(d_ + 1280) = t4_; } \
        if (sp == 8) *(LAS u64_t*)(lds + (buf_) * RW_BUF + ss * RW_STEP + 1408) = g_s; } while (0)
    f32x4 S0 = {0.f, 0.f, 0.f, 0.f};
    if (stager) { RW_ISSUE(0); RW_STAGE(0); }
    __syncthreads();
    bf16* Yg = (bf16*)(F.ws + WS_Y) + (size_t)b * SEQ * 256 + h * 64 + 32 * rowhalf;
    const int NCH = SEQ / RW_CH;
    for (int c = 0; c < NCH; ++c) {
        LAS float* ybuf = (LAS float*)(lds + RW_Y + (c & 1) * 4096);
        if (stager && c + 1 < NCH) RW_ISSUE(c + 1);
        unsigned short yold[2] = {0, 0};
        if (c >= NCH / 2) {
#pragma unroll
            for (int k = 0; k < 2; ++k) { const int o = tid + 512 * k, n = c * RW_CH + (o >> 5), t = dir ? SEQ - 1 - n : n; yold[k] = Yg[(size_t)t * 256 + (o & 31)]; } }
        { const LAS unsigned char* cb_ = lds + (c & 1) * RW_BUF + 16 * cs;
          const LAS unsigned char* vb_ = lds + (c & 1) * RW_BUF + 1280 + 4 * row;
#pragma unroll 8
          for (int s = 0; s < RW_CH; ++s) {
              const LAS unsigned char* p = cb_ + ((SKIP & 2) ? 0 : s) * RW_STEP;
              const f32x4 w = *(const LAS f32x4*)p, wr = *(const LAS f32x4*)(p + 256), nk = *(const LAS f32x4*)(p + 512), bb = *(const LAS f32x4*)(p + 768), kv = *(const LAS f32x4*)(p + 1024);
              typedef float f2 __attribute__((ext_vector_type(2)));
              const float v = *(const LAS float*)(vb_ + s * RW_STEP); const f2 brkr = *(const LAS f2*)(lds + (c & 1) * RW_BUF + s * RW_STEP + 1408);
              float sa0 = (S0[0] * nk[0] + S0[1] * nk[1]) + (S0[2] * nk[2] + S0[3] * nk[3]);
              float ym0 = (S0[0] * wr[0] + S0[1] * wr[1]) + (S0[2] * wr[2] + S0[3] * wr[3]);
              if (!(SKIP & 1)) {
              sa0 += dpp_xor1(sa0); ym0 += dpp_xor1(ym0);
              sa0 += dpp_xor2(sa0); ym0 += dpp_xor2(ym0);
              sa0 += dpp_hmir(sa0); ym0 += dpp_hmir(ym0);
              sa0 += dpp_rmir(sa0); ym0 += dpp_rmir(ym0); }
              S0 = S0 * w + (sa0 * bb + v * kv);
              if (cs == 0) ybuf[s * 32 + row] = ym0 + sa0 * brkr[0] + v * brkr[1];
          } }
        if (stager && c + 1 < NCH) RW_STAGE((c + 1) & 1);
        __syncthreads();
#pragma unroll
        for (int k = 0; k < 2; ++k) { const int o = tid + 512 * k, n = c * RW_CH + (o >> 5), t = dir ? SEQ - 1 - n : n;
            float y = ybuf[o]; if (c >= NCH / 2) y += bf2f(yold[k]);
            Yg[(size_t)t * 256 + (o & 31)] = (bf16)f2bf(y); }
        if (c == NCH / 2 - 1) partner_sync(F, flags + 64 * unit, flags + 64 * (unit ^ 1));
    }
#undef RW_ISSUE
#undef RW_STAGE
#undef RW_BF
    __syncthreads();
}

constexpr int GP = 144;
constexpr int G_Q = 0, G_K = 9216, G_V = 18432, G_KT = 27648, G_P = 36864, G_A = 46080, G_SM = 63488, G_GROUP = 64512;
constexpr int G_T = 92160;
constexpr int G_RAW = 65536;
constexpr int G_CW = 133120;
static_assert(2 * G_GROUP <= RING_BYTES && G_CW + 3840 <= LDS_BYTES && G_CW >= MISC_OFF + 1024, "GDN LDS map");
__device__ __forceinline__ bf16x8 ld2x8(const LAS unsigned char* p) { return mk_bf16x8(*(const LAS u64_t*)p, *(const LAS u64_t*)(p + 32)); }
__device__ __forceinline__ bf16x8 pack_acc(const f32x4& a, const f32x4& b) {
    v4u w; w.x = pg8::cvt_pk_bf16(a[0], a[1]); w.y = pg8::cvt_pk_bf16(a[2], a[3]); w.z = pg8::cvt_pk_bf16(b[0], b[1]); w.w = pg8::cvt_pk_bf16(b[2], b[3]); return __builtin_bit_cast(bf16x8, w); }
__device__ __forceinline__ void split_acc(const f32x4& a, const f32x4& b, bf16x8& hi, bf16x8& lo) {
    v4u wh; wh.x = cvt2bf(a[0], a[1]); wh.y = cvt2bf(a[2], a[3]); wh.z = cvt2bf(b[0], b[1]); wh.w = cvt2bf(b[2], b[3]);
    f32x4 ra, rb;
    ra[0] = a[0] - __uint_as_float(wh.x << 16); ra[1] = a[1] - __uint_as_float(wh.x & 0xffff0000u); ra[2] = a[2] - __uint_as_float(wh.y << 16); ra[3] = a[3] - __uint_as_float(wh.y & 0xffff0000u);
    rb[0] = b[0] - __uint_as_float(wh.z << 16); rb[1] = b[1] - __uint_as_float(wh.z & 0xffff0000u); rb[2] = b[2] - __uint_as_float(wh.w << 16); rb[3] = b[3] - __uint_as_float(wh.w & 0xffff0000u);
    hi = __builtin_bit_cast(bf16x8, wh); lo = pack_acc(ra, rb);
}
__device__ __forceinline__ void hilo4(const f32x4& a, u64_t& hi, u64_t& lo) {
    const unsigned h0 = cvt2bf(a[0], a[1]), h1 = cvt2bf(a[2], a[3]);
    const float r0 = a[0] - __uint_as_float(h0 << 16), r1 = a[1] - __uint_as_float(h0 & 0xffff0000u), r2 = a[2] - __uint_as_float(h1 << 16), r3 = a[3] - __uint_as_float(h1 & 0xffff0000u);
    hi = (u64_t)h0 | ((u64_t)h1 << 32); lo = (u64_t)cvt2bf(r0, r1) | ((u64_t)cvt2bf(r2, r3) << 32);
}
typedef _Float16 f16x8 __attribute__((ext_vector_type(8)));
__device__ __forceinline__ f16x8 pack_acc_f16(const f32x4& a, const f32x4& b) { return (f16x8){(_Float16)a[0], (_Float16)a[1], (_Float16)a[2], (_Float16)a[3], (_Float16)b[0], (_Float16)b[1], (_Float16)b[2], (_Float16)b[3]}; }
template <int SKIP> __device__ __forceinline__ void gdn_unit3(Frame& F, int l, int unit, gu32* flags) {
    const int bh = unit >> 1, dir = unit & 1, b = bh / 6, h = bh % 6;
    const int tid = F.tid, lane = F.lane, wave = F.wave;
    const bf16* Pgdn = (const bf16*)(F.ws + WS_PGDN) + (size_t)b * SEQ * 1152 + h * 64; const float* Psm = (const float*)(F.ws + WS_PSM) + (size_t)b * SEQ * 32;
    bf16* Og = (bf16*)(F.ws + WS_OGDN) + (size_t)b * SEQ * 384 + h * 64;
    LAS unsigned char* gb = F.lds + RING_OFF;
    LAS float* cwl = (LAS float*)(F.lds + G_CW);
    LAS float* sm = (LAS float*)(gb + G_SM);
    { const float* conv_w = (const float*)inptr(F, 4) + (size_t)l * 5 * 1152;
      for (int i = tid; i < 960; i += 512) { const int tn = i / 320, tap = (i % 320) / 64, ch = i % 64; cwl[i] = conv_w[tap * 1152 + tn * 384 + h * 64 + ch]; } }
    const float al = -__expf(((const float*)inptr(F, 5))[l * 12 + dir * 6 + h]), dtb = ((const float*)inptr(F, 6))[l * 12 + dir * 6 + h];
    f32x4 Sacc[4];
#pragma unroll
    for (int i = 0; i < 4; ++i) Sacc[i] = (f32x4){0.f, 0.f, 0.f, 0.f};
    const int ci = tid >> 3, cg = tid & 7;
#define GDN_RAW_STAGE(cc_, first_, nthr_) do { const int tlo_ = (dir ? SEQ - 64 * (cc_) - 64 : 64 * (cc_)) - 2; \
        for (int pc_ = (first_); pc_ < 68 * 24; pc_ += (nthr_)) { const int rr_ = pc_ / 24, sg_ = pc_ % 24, tt_ = tlo_ + rr_; v4u x_ = {0u, 0u, 0u, 0u}; \
            if (!(SKIP & 1) && tt_ >= 0 && tt_ < SEQ) x_ = *(const v4u*)(Pgdn + (size_t)tt_ * 1152 + (sg_ >> 3) * 384 + 8 * (sg_ & 7)); \
            *(LAS v4u*)(gb + G_RAW + rr_ * 384 + 16 * sg_) = x_; } } while (0)
#define GDN_WRITEOUT(cc_) do { if (!(SKIP & 4)) { const int t_ = dir ? SEQ - 1 - 64 * (cc_) - ci : 64 * (cc_) + ci; bf16* op_ = Og + (size_t)t_ * 384 + 8 * cg; \
            const LAS f32x4* src_ = (const LAS f32x4*)(gb + G_A + (ci * 68 + 8 * cg) * 4); f32x4 o0_ = src_[0], o1_ = src_[1]; \
            if ((cc_) >= SEQ / 128) { const v4u p0_ = *(const v4u*)op_; \
                o0_ += (f32x4){__uint_as_float(p0_.x << 16), __uint_as_float(p0_.x & 0xffff0000u), __uint_as_float(p0_.y << 16), __uint_as_float(p0_.y & 0xffff0000u)}; \
                o1_ += (f32x4){__uint_as_float(p0_.z << 16), __uint_as_float(p0_.z & 0xffff0000u), __uint_as_float(p0_.w << 16), __uint_as_float(p0_.w & 0xffff0000u)}; } \
            v4u w0_; w0_.x = pg8::cvt_pk_bf16(o0_[0], o0_[1]); w0_.y = pg8::cvt_pk_bf16(o0_[2], o0_[3]); w0_.z = pg8::cvt_pk_bf16(o1_[0], o1_[1]); w0_.w = pg8::cvt_pk_bf16(o1_[2], o1_[3]); \
            *(v4u*)op_ = w0_; } } while (0)
    GDN_RAW_STAGE(0, tid, 512);
    __syncthreads();
    for (int c = 0; c < SEQ / 64; ++c) {
        if (c > 0) GDN_WRITEOUT(c - 1);
        if (c == SEQ / 128) partner_sync(F, flags + 64 * unit, flags + 64 * (unit ^ 1));
        if (wave == 0) {
            const int t = dir ? SEQ - 1 - 64 * c - lane : 64 * c + lane;
            const float a = Psm[(size_t)t * 32 + dir * 6 + h], bt = Psm[(size_t)t * 32 + 12 + dir * 6 + h];
            float x = al * softplusf_(a + dtb);
#pragma unroll
            for (int off = 1; off < 64; off <<= 1) { const float y = __shfl_up(x, off); if (lane >= off) x += y; }
            const float last = __shfl(x, 63);
            sm[lane] = x; sm[64 + lane] = sigmoidf_(bt); sm[128 + lane] = __expf(x); sm[192 + lane] = __expf(last - x);
        }
        { float acc[3][8];
#pragma unroll
          for (int tn = 0; tn < 3; ++tn)
#pragma unroll
              for (int j = 0; j < 8; ++j) acc[tn][j] = 0.f;
          const int rr0 = dir ? 63 - ci : ci;
#pragma unroll
          for (int tap = 0; tap < 5; ++tap) {
#pragma unroll
              for (int tn = 0; tn < 3; ++tn) { const v4u x0 = *(const LAS v4u*)(gb + G_RAW + (rr0 + tap) * 384 + tn * 128 + 16 * cg); const LAS float* w = cwl + tn * 320 + tap * 64 + 8 * cg; const f32x4 w0 = *(const LAS f32x4*)w, w1 = *(const LAS f32x4*)(w + 4);
                  acc[tn][0] += w0[0] * __uint_as_float(x0[0] << 16); acc[tn][1] += w0[1] * __uint_as_float(x0[0] & 0xffff0000u); acc[tn][2] += w0[2] * __uint_as_float(x0[1] << 16); acc[tn][3] += w0[3] * __uint_as_float(x0[1] & 0xffff0000u);
                  acc[tn][4] += w1[0] * __uint_as_float(x0[2] << 16); acc[tn][5] += w1[1] * __uint_as_float(x0[2] & 0xffff0000u); acc[tn][6] += w1[2] * __uint_as_float(x0[3] << 16); acc[tn][7] += w1[3] * __uint_as_float(x0[3] & 0xffff0000u); }
              asm volatile("" ::: "memory"); }
          float sq = 0.f, sk = 0.f;
#pragma unroll
          for (int j = 0; j < 8; ++j) { acc[0][j] = siluf(acc[0][j]); acc[1][j] = siluf(acc[1][j]); acc[2][j] = siluf(acc[2][j]); sq += acc[0][j] * acc[0][j]; sk += acc[1][j] * acc[1][j]; }
          sq += dpp_xor1(sq); sk += dpp_xor1(sk); sq += dpp_xor2(sq); sk += dpp_xor2(sk); sq += dpp_hmir(sq); sk += dpp_hmir(sk);
          const float rq = rsqrtf(sq + 1e-6f) * 0.125f, rk = rsqrtf(sk + 1e-6f);
          v4u wq, wk, wv;
#pragma unroll
          for (int q = 0; q < 4; ++q) { wq[q] = pg8::cvt_pk_bf16(acc[0][2 * q] * rq, acc[0][2 * q + 1] * rq); wk[q] = pg8::cvt_pk_bf16(acc[1][2 * q] * rk, acc[1][2 * q + 1] * rk); wv[q] = pg8::cvt_pk_bf16(acc[2][2 * q], acc[2][2 * q + 1]); }
          LAS unsigned char* row = gb + ci * GP + 16 * cg;
          *(LAS v4u*)(row + G_Q) = wq; *(LAS v4u*)(row + G_K) = wk; *(LAS v4u*)(row + G_V) = wv;
#pragma unroll
          for (int j = 0; j < 8; ++j) *(LAS bf16*)(gb + G_KT + (8 * cg + j) * GP + 2 * ci) = (bf16)((j & 1) ? (wk[j >> 1] >> 16) : (wk[j >> 1] & 0xffffu)); }
        __syncthreads();
        { const int ti = (wave >> 1) & 1, tj = wave & 1, r32 = lane & 31, hi = lane >> 5; const bool isP = wave >= 4;
          f32x16 acc = {};
          const LAS unsigned char* ar = gb + (isP ? G_Q : G_K) + (32 * ti + r32) * GP + 16 * hi; const LAS unsigned char* br = gb + G_K + (32 * tj + r32) * GP + 16 * hi;
#pragma unroll
          for (int s = 0; s < 4; ++s) acc = __builtin_amdgcn_mfma_f32_32x32x16_bf16(*(const LAS bf16x8*)(ar + 32 * s), *(const LAS bf16x8*)(br + 32 * s), acc, 0, 0, 0);
          const int j = 32 * tj + r32; const float cj = sm[j];
#pragma unroll
          for (int r = 0; r < 16; ++r) { const int i = 32 * ti + (r & 3) + 8 * (r >> 2) + 4 * hi;
              const float dl = __expf(fminf(sm[i] - cj, 0.f));
              if (!isP) ((LAS float*)(gb + G_A))[i * 68 + j] = (i > j) ? sm[64 + i] * acc[r] * dl : 0.f;
              else *(LAS _Float16*)(gb + G_P + i * GP + 2 * j) = (_Float16)((i >= j) ? acc[r] * dl : 0.f); } }
        __syncthreads();
        if (!(SKIP & 2) && wave == 0) {
            const int bb = lane >> 4, cc = lane & 15; float T[16];
            const LAS float* Ab = (const LAS float*)(gb + G_A) + (16 * bb) * 68 + 16 * bb;
#pragma unroll
            for (int i = 0; i < 16; ++i) { float a0 = 0.f, a1 = 0.f;
#pragma unroll
                for (int j4 = 0; j4 < (i + 3) / 4; ++j4) { const f32x4 av = *(const LAS f32x4*)(Ab + i * 68 + 4 * j4);
                    a0 += av.x * T[4 * j4] + av.z * T[4 * j4 + 2]; a1 += av.y * T[4 * j4 + 1] + av.w * T[4 * j4 + 3]; }
                T[i] = (i == cc ? 1.f : 0.f) - (a0 + a1);
                if (i < 15 && (i & 3) == 3) asm volatile("" ::: "memory");
                if (i == 0) {
#pragma unroll
                    for (int k = 1; k < 16; ++k) T[k] = 0.f; } }
#pragma unroll
            for (int i = 0; i < 16; ++i) ((LAS float*)(gb + G_T))[(16 * bb + i) * 16 + cc] = T[i];
        }
        __syncthreads();
        f32x4 Xc[4];
#pragma unroll
        for (int g = 0; g < 4; ++g) Xc[g] = (f32x4){0.f, 0.f, 0.f, 0.f};
        if (!(SKIP & 2)) {
            const int col = lane & 15, q4 = lane >> 4, c = 16 * wave + col;
            const LAS unsigned char* src = gb + (c < 64 ? G_V : G_K) + 2 * (c & 63);
            u64_t xh[4], xl[4];
#pragma unroll
            for (int bk = 0; bk < 4; ++bk) {
                f32x4 Y; const f32x4 be = *(const LAS f32x4*)(sm + 64 + 16 * bk + 4 * q4), ga = *(const LAS f32x4*)(sm + 128 + 16 * bk + 4 * q4);
#pragma unroll
                for (int r = 0; r < 4; ++r) Y[r] = bf2f(*(const LAS bf16*)(src + (16 * bk + 4 * q4 + r) * GP)) * be[r] * (c < 64 ? 1.f : ga[r]);
#pragma unroll
                for (int b2 = 0; b2 < bk; b2 += 2) {
                    const LAS float* ar = (const LAS float*)(gb + G_A) + (16 * bk + col) * 68 + 16 * b2 + 4 * q4;
                    f32x4 a0 = -*(const LAS f32x4*)ar, a1 = (b2 + 1 < bk) ? -*(const LAS f32x4*)(ar + 16) : (f32x4){0.f, 0.f, 0.f, 0.f};
                    u64_t ah0, al0, ah1, al1; hilo4(a0, ah0, al0); hilo4(a1, ah1, al1);
                    const u64_t bh1 = (b2 + 1 < bk) ? xh[b2 + 1] : 0ull, bl1 = (b2 + 1 < bk) ? xl[b2 + 1] : 0ull;
                    const bf16x8 Ah = mk_bf16x8(ah0, ah1), Al = mk_bf16x8(al0, al1), Bh = mk_bf16x8(xh[b2], bh1), Bl = mk_bf16x8(xl[b2], bl1);
                    Y = __builtin_amdgcn_mfma_f32_16x16x32_bf16(Al, Bh, Y, 0, 0, 0);
                    Y = __builtin_amdgcn_mfma_f32_16x16x32_bf16(Ah, Bl, Y, 0, 0, 0);
                    Y = __builtin_amdgcn_mfma_f32_16x16x32_bf16(Ah, Bh, Y, 0, 0, 0); }
                { const f32x4 t0 = *(const LAS f32x4*)((const LAS float*)(gb + G_T) + (16 * bk + col) * 16 + 4 * q4);
                  u64_t th, tl, yh, yl; hilo4(t0, th, tl); hilo4(Y, yh, yl);
                  const bf16x8 Ah = mk_bf16x8(th, 0ull), Al = mk_bf16x8(tl, 0ull), Bh = mk_bf16x8(yh, 0ull), Bl = mk_bf16x8(yl, 0ull);
                  f32x4 X = {0.f, 0.f, 0.f, 0.f};
                  X = __builtin_amdgcn_mfma_f32_16x16x32_bf16(Al, Bh, X, 0, 0, 0);
                  X = __builtin_amdgcn_mfma_f32_16x16x32_bf16(Ah, Bl, X, 0, 0, 0);
                  X = __builtin_amdgcn_mfma_f32_16x16x32_bf16(Ah, Bh, X, 0, 0, 0);
                  Xc[bk] = X; hilo4(X, xh[bk], xl[bk]); }
            }
        }
        __syncthreads();
        { const int col = lane & 15, q4 = lane >> 4, c = 16 * wave + col;
          if (wave < 4) {
#pragma unroll
              for (int g = 0; g < 4; ++g)
#pragma unroll
                  for (int r = 0; r < 4; ++r) ((LAS float*)(gb + G_A))[(16 * g + 4 * q4 + r) * 68 + c] = Xc[g][r];
          } else {
#pragma unroll
              for (int g = 0; g < 4; ++g)
#pragma unroll
                  for (int r = 0; r < 4; ++r) { const int i = 16 * g + 4 * q4 + r; const float x = -Xc[g][r]; const unsigned hb = f2bf(x);
                      *(LAS bf16*)(gb + G_V + i * GP + 2 * (c - 64)) = (bf16)hb;
                      *(LAS bf16*)(gb + G_K + i * GP + 2 * (c - 64)) = (bf16)f2bf(x - __uint_as_float(hb << 16)); }
          } }
        __syncthreads();
        if (wave < 4) { const int col = lane & 15, q4 = lane >> 4, e = 16 * wave + col;
          bf16x8 bS0, bS1, bS0l, bS1l; split_acc(Sacc[0], Sacc[1], bS0, bS0l); split_acc(Sacc[2], Sacc[3], bS1, bS1l);
          f32x4 U[4], T1[4];
          const LAS unsigned char* rowa = gb + col * GP + 8 * q4;
#pragma unroll
          for (int it = 0; it < 4; ++it) {
              const LAS float* u0p = (const LAS float*)(gb + G_A) + (16 * it + 4 * q4) * 68 + e;
              U[it] = (f32x4){u0p[0], u0p[68], u0p[136], u0p[204]};
              const LAS unsigned char* ra = rowa + 16 * it * GP;
              const bf16x8 wh0 = ld2x8(ra + G_V), wh1 = ld2x8(ra + G_V + 64), wl0 = ld2x8(ra + G_K), wl1 = ld2x8(ra + G_K + 64), qa0 = ld2x8(ra + G_Q), qa1 = ld2x8(ra + G_Q + 64);
              U[it] = __builtin_amdgcn_mfma_f32_16x16x32_bf16(wl0, bS0, U[it], 0, 0, 0);
              U[it] = __builtin_amdgcn_mfma_f32_16x16x32_bf16(wl1, bS1, U[it], 0, 0, 0);
              U[it] = __builtin_amdgcn_mfma_f32_16x16x32_bf16(wh0, bS0l, U[it], 0, 0, 0);
              U[it] = __builtin_amdgcn_mfma_f32_16x16x32_bf16(wh1, bS1l, U[it], 0, 0, 0);
              U[it] = __builtin_amdgcn_mfma_f32_16x16x32_bf16(wh0, bS0, U[it], 0, 0, 0);
              U[it] = __builtin_amdgcn_mfma_f32_16x16x32_bf16(wh1, bS1, U[it], 0, 0, 0);
              T1[it] = __builtin_amdgcn_mfma_f32_16x16x32_bf16(qa0, bS0l, (f32x4){0.f, 0.f, 0.f, 0.f}, 0, 0, 0);
              T1[it] = __builtin_amdgcn_mfma_f32_16x16x32_bf16(qa1, bS1l, T1[it], 0, 0, 0);
              T1[it] = __builtin_amdgcn_mfma_f32_16x16x32_bf16(qa0, bS0, T1[it], 0, 0, 0);
              T1[it] = __builtin_amdgcn_mfma_f32_16x16x32_bf16(qa1, bS1, T1[it], 0, 0, 0);
              asm volatile("" ::: "memory");
          }
          const f16x8 hU0 = pack_acc_f16(U[0], U[1]), hU1 = pack_acc_f16(U[2], U[3]);
          f32x4 Ud[4];
#pragma unroll
          for (int it = 0; it < 4; ++it) { const f32x4 dc = *(const LAS f32x4*)(sm + 192 + 16 * it + 4 * q4); Ud[it] = U[it] * dc; }
          bf16x8 bD0, bD1, bD0l, bD1l; split_acc(Ud[0], Ud[1], bD0, bD0l); split_acc(Ud[2], Ud[3], bD1, bD1l);
          const float gend = sm[191];
#pragma unroll
          for (int it = 0; it < 4; ++it) {
              const LAS unsigned char* ra = rowa + 16 * it * GP;
              const f32x4 gm = *(const LAS f32x4*)(sm + 128 + 16 * it + 4 * q4);
              const bf16x8 pa0 = ld2x8(ra + G_P), pa1 = ld2x8(ra + G_P + 64), ka0 = ld2x8(ra + G_KT), ka1 = ld2x8(ra + G_KT + 64);
              f32x4 O = T1[it] * gm;
              O = __builtin_amdgcn_mfma_f32_16x16x32_f16(__builtin_bit_cast(f16x8, pa0), hU0, O, 0, 0, 0);
              O = __builtin_amdgcn_mfma_f32_16x16x32_f16(__builtin_bit_cast(f16x8, pa1), hU1, O, 0, 0, 0);
              f32x4 Sn = Sacc[it] * gend;
              Sn = __builtin_amdgcn_mfma_f32_16x16x32_bf16(ka0, bD0l, Sn, 0, 0, 0);
              Sn = __builtin_amdgcn_mfma_f32_16x16x32_bf16(ka1, bD1l, Sn, 0, 0, 0);
              Sn = __builtin_amdgcn_mfma_f32_16x16x32_bf16(ka0, bD0, Sn, 0, 0, 0);
              Sn = __builtin_amdgcn_mfma_f32_16x16x32_bf16(ka1, bD1, Sn, 0, 0, 0);
              Sacc[it] = Sn;
#pragma unroll
              for (int r = 0; r < 4; ++r) ((LAS float*)(gb + G_A))[(16 * it + 4 * q4 + r) * 68 + e] = O[r];
              asm volatile("" ::: "memory");
          } }
        else if (c + 1 < SEQ / 64) GDN_RAW_STAGE(c + 1, tid - 256, 256);
        __syncthreads();
    }
    GDN_WRITEOUT(SEQ / 64 - 1);
#undef GDN_WRITEOUT
#undef GDN_RAW_STAGE
    __syncthreads();
}

constexpr int RC_AT = 0, RC_RT = 9216, RC_BT = 18432, RC_KT = 27648, RC_BH = 36864, RC_KH = 46080, RC_VT = 55296, RC_V = 64512, RC_A = 73728  ,
              RC_AK = 91136, RC_RB = 100352, RC_RK = 109568, RC_T = 118784  , RC_SM = 122880  , RC_R2 = RC_BT  ;
static_assert(RC_SM + 256 <= RING_BYTES && RC_R2 + 17408 <= RC_BH, "chunked RWKV LDS map");
__device__ __forceinline__ void rwkv_unit_c(Frame& F, int unit, gu32* flags) {
    const int bh = unit >> 1, dir = unit & 1, b = bh >> 2, h = bh & 3;
    const int tid = F.tid, lane = F.lane, wave = F.wave;
    const unsigned char* Rs = F.ws + WS_RS + (size_t)bh * SEQ * RS_REC;
    const unsigned char* Rd = F.ws + WS_RD + dir * RD_DIR + (size_t)bh * SEQ * RD_REC;
    bf16* Yg = (bf16*)(F.ws + WS_Y) + (size_t)b * SEQ * 256 + h * 64;
    LAS unsigned char* gb = F.lds + RING_OFF;
    LAS float* gamT = (LAS float*)(gb + RC_SM);
    f32x4 Zacc[4];
#pragma unroll
    for (int i = 0; i < 4; ++i) Zacc[i] = (f32x4){0.f, 0.f, 0.f, 0.f};
    const int ci = tid >> 3, cg = tid & 7;
#define RC_WRITEOUT(cc_) do { const int t_ = dir ? SEQ - 1 - 64 * (cc_) - ci : 64 * (cc_) + ci; bf16* op_ = Yg + (size_t)t_ * 256 + 8 * cg; \
        const LAS f32x4* src_ = (const LAS f32x4*)(gb + RC_A + (ci * 68 + 8 * cg) * 4); f32x4 o0_ = src_[0], o1_ = src_[1]; \
        if ((cc_) >= SEQ / 128) { const v4u p0_ = *(const v4u*)op_; \
            o0_ += (f32x4){__uint_as_float(p0_.x << 16), __uint_as_float(p0_.x & 0xffff0000u), __uint_as_float(p0_.y << 16), __uint_as_float(p0_.y & 0xffff0000u)}; \
            o1_ += (f32x4){__uint_as_float(p0_.z << 16), __uint_as_float(p0_.z & 0xffff0000u), __uint_as_float(p0_.w << 16), __uint_as_float(p0_.w & 0xffff0000u)}; } \
        v4u w0_; w0_.x = pg8::cvt_pk_bf16(o0_[0], o0_[1]); w0_.y = pg8::cvt_pk_bf16(o0_[2], o0_[3]); w0_.z = pg8::cvt_pk_bf16(o1_[0], o1_[1]); w0_.w = pg8::cvt_pk_bf16(o1_[2], o1_[3]); \
        *(v4u*)op_ = w0_; } while (0)
    __syncthreads();
    for (int c = 0; c < SEQ / 64; ++c) {
        if (c > 0) RC_WRITEOUT(c - 1);
        if (c == SEQ / 128) partner_sync(F, flags + 64 * unit, flags + 64 * (unit ^ 1));
        { const int t = lane, tok = dir ? SEQ - 1 - 64 * c - t : 64 * c + t, j0 = 8 * wave;
          const unsigned char* rs = Rs + (size_t)tok * RS_REC + 2 * j0; const unsigned char* rd = Rd + (size_t)tok * RD_REC + 2 * j0;
          const v4u gkk = *(const v4u*)rs, gv = *(const v4u*)(rs + 128), gr = *(const v4u*)(rs + 256), glam = *(const v4u*)rd, gbv = *(const v4u*)(rd + 128), gk = *(const v4u*)(rd + 256);
          float lam[8], cum[8];
#pragma unroll
          for (int q = 0; q < 4; ++q) { lam[2 * q] = __half2float(__ushort_as_half((unsigned short)(glam[q] & 0xffffu))); lam[2 * q + 1] = __half2float(__ushort_as_half((unsigned short)(glam[q] >> 16))); }
#pragma unroll
          for (int q = 0; q < 8; ++q) { float x = lam[q];
#pragma unroll
              for (int off = 1; off < 64; off <<= 1) { const float y = __shfl_up(x, off); if (lane >= off) x += y; }
              cum[q] = x; }
          v4u wa = {0u, 0u, 0u, 0u}, wr = {0u, 0u, 0u, 0u}, wb = {0u, 0u, 0u, 0u}, wk = {0u, 0u, 0u, 0u}; unsigned short bh_[8], kh_[8];
#pragma unroll
          for (int q = 0; q < 8; ++q) { const float cT = __shfl(cum[q], 63);
              const float e1 = __builtin_amdgcn_exp2f(-LOG2E * (cum[q] - lam[q])), e2 = __builtin_amdgcn_exp2f(-LOG2E * cum[q]), e3 = __builtin_amdgcn_exp2f(LOG2E * cum[q]), e4 = __builtin_amdgcn_exp2f(-LOG2E * (cT - cum[q]));
              const float kkq = __uint_as_float((q & 1) ? (gkk[q >> 1] & 0xffff0000u) : (gkk[q >> 1] << 16)), rq = __uint_as_float((q & 1) ? (gr[q >> 1] & 0xffff0000u) : (gr[q >> 1] << 16));
              const float bq = __uint_as_float((q & 1) ? (gbv[q >> 1] & 0xffff0000u) : (gbv[q >> 1] << 16)), kq = __uint_as_float((q & 1) ? (gk[q >> 1] & 0xffff0000u) : (gk[q >> 1] << 16));
              const unsigned a16 = f2bf(-kkq * e1), r16 = f2bf(rq * e2), b16 = f2bf(bq * e3), k16 = f2bf(kq * e3);
              if (q & 1) { wa[q >> 1] |= a16 << 16; wr[q >> 1] |= r16 << 16; wb[q >> 1] |= b16 << 16; wk[q >> 1] |= k16 << 16; } else { wa[q >> 1] = a16; wr[q >> 1] = r16; wb[q >> 1] = b16; wk[q >> 1] = k16; }
              bh_[q] = (unsigned short)f2bf(bq * e4); kh_[q] = (unsigned short)f2bf(kq * e4);
              if (lane == 63) gamT[j0 + q] = e2; }
          LAS unsigned char* row = gb + t * GP + 2 * j0;
          *(LAS v4u*)(row + RC_AT) = wa; *(LAS v4u*)(row + RC_RT) = wr; *(LAS v4u*)(row + RC_BT) = wb; *(LAS v4u*)(row + RC_KT) = wk; *(LAS v4u*)(row + RC_V) = gv;
#pragma unroll
          for (int q = 0; q < 8; ++q) { LAS unsigned char* tr = gb + (j0 + q) * GP + 2 * t;
              *(LAS bf16*)(tr + RC_BH) = bh_[q]; *(LAS bf16*)(tr + RC_KH) = kh_[q];
              *(LAS bf16*)(tr + RC_VT) = (bf16)((q & 1) ? (gv[q >> 1] >> 16) : (gv[q >> 1] & 0xffffu)); } }
        __syncthreads();
        { const int rb = wave >> 1, r32 = lane & 31, hi = lane >> 5;
          const LAS unsigned char* ar = gb + (rb < 2 ? RC_AT : RC_RT) + (32 * (rb & 1) + r32) * GP + 16 * hi;
#pragma unroll
          for (int k2 = 0; k2 < 2; ++k2) { const int cb = 2 * (wave & 1) + k2;
              const LAS unsigned char* br = gb + (cb < 2 ? RC_BT : RC_KT) + (32 * (cb & 1) + r32) * GP + 16 * hi;
              f32x16 acc = {};
#pragma unroll
              for (int s = 0; s < 4; ++s) acc = __builtin_amdgcn_mfma_f32_32x32x16_bf16(*(const LAS bf16x8*)(ar + 32 * s), *(const LAS bf16x8*)(br + 32 * s), acc, 0, 0, 0);
              const int sc = 32 * (cb & 1) + r32;
#pragma unroll
              for (int r = 0; r < 16; ++r) { const int tr_ = 32 * (rb & 1) + (r & 3) + 8 * (r >> 2) + 4 * hi;
                  if (rb < 2 && cb < 2) ((LAS float*)(gb + RC_A))[tr_ * 68 + sc] = (tr_ > sc) ? -acc[r] : 0.f;
                  else if (rb < 2) *(LAS bf16*)(gb + RC_AK + tr_ * GP + 2 * sc) = (bf16)f2bf((tr_ > sc) ? acc[r] : 0.f);
                  else *(LAS bf16*)(gb + (cb < 2 ? RC_RB : RC_RK) + tr_ * GP + 2 * sc) = (bf16)f2bf((tr_ >= sc) ? acc[r] : 0.f); } } }
        __syncthreads();
        { const int col = lane & 15, q4 = lane >> 4, it = wave >> 1;
#pragma unroll
          for (int k2 = 0; k2 < 2; ++k2) { const int ct = 2 * (wave & 1) + k2; f32x4 acc = {0.f, 0.f, 0.f, 0.f};
              const LAS unsigned char* pa = gb + RC_AK + (16 * it + col) * GP + 8 * q4; const LAS unsigned char* pb = gb + RC_VT + (16 * ct + col) * GP + 8 * q4;
              acc = __builtin_amdgcn_mfma_f32_16x16x32_bf16(ld2x8(pa), ld2x8(pb), acc, 0, 0, 0);
              acc = __builtin_amdgcn_mfma_f32_16x16x32_bf16(ld2x8(pa + 64), ld2x8(pb + 64), acc, 0, 0, 0);
#pragma unroll
              for (int r = 0; r < 4; ++r) ((LAS float*)(gb + RC_R2))[(16 * it + 4 * q4 + r) * 68 + 16 * ct + col] = acc[r]; } }
        if (wave == 0) {
            const int bb = lane >> 4, cc = lane & 15; float T[16];
            const LAS float* Ab = (const LAS float*)(gb + RC_A) + (16 * bb) * 68 + 16 * bb;
#pragma unroll
            for (int i = 0; i < 16; ++i) { float a0 = 0.f, a1 = 0.f;
#pragma unroll
                for (int j4 = 0; j4 < (i + 3) / 4; ++j4) { const f32x4 av = *(const LAS f32x4*)(Ab + i * 68 + 4 * j4);
                    a0 += av.x * T[4 * j4] + av.z * T[4 * j4 + 2]; a1 += av.y * T[4 * j4 + 1] + av.w * T[4 * j4 + 3]; }
                T[i] = (i == cc ? 1.f : 0.f) - (a0 + a1);
                if (i < 15 && (i & 3) == 3) asm volatile("" ::: "memory");
                if (i == 0) {
#pragma unroll
                    for (int k = 1; k < 16; ++k) T[k] = 0.f; } }
#pragma unroll
            for (int i = 0; i < 16; ++i) ((LAS float*)(gb + RC_T))[(16 * bb + i) * 16 + cc] = T[i];
        }
        __syncthreads();
        f32x4 Xc[4];
        { const int col = lane & 15, q4 = lane >> 4, cidx = 16 * wave + col;
          u64_t xh[4], xl[4];
#pragma unroll
          for (int bk = 0; bk < 4; ++bk) {
              f32x4 Y;
#pragma unroll
              for (int r = 0; r < 4; ++r) { const int tt = 16 * bk + 4 * q4 + r;
                  Y[r] = (wave < 4) ? bf2f(*(const LAS bf16*)(gb + RC_AT + tt * GP + 2 * cidx)) : ((const LAS float*)(gb + RC_R2))[tt * 68 + (cidx - 64)]; }
#pragma unroll
              for (int b2 = 0; b2 < bk; b2 += 2) {
                  const LAS float* ar = (const LAS float*)(gb + RC_A) + (16 * bk + col) * 68 + 16 * b2 + 4 * q4;
                  f32x4 a0 = -*(const LAS f32x4*)ar, a1 = (b2 + 1 < bk) ? -*(const LAS f32x4*)(ar + 16) : (f32x4){0.f, 0.f, 0.f, 0.f};
                  u64_t ah0, al0, ah1, al1; hilo4(a0, ah0, al0); hilo4(a1, ah1, al1);
                  const u64_t bh1 = (b2 + 1 < bk) ? xh[b2 + 1] : 0ull, bl1 = (b2 + 1 < bk) ? xl[b2 + 1] : 0ull;
                  const bf16x8 Ah = mk_bf16x8(ah0, ah1), Al = mk_bf16x8(al0, al1), Bh = mk_bf16x8(xh[b2], bh1), Bl = mk_bf16x8(xl[b2], bl1);
                  Y = __builtin_amdgcn_mfma_f32_16x16x32_bf16(Al, Bh, Y, 0, 0, 0);
                  Y = __builtin_amdgcn_mfma_f32_16x16x32_bf16(Ah, Bl, Y, 0, 0, 0);
                  Y = __builtin_amdgcn_mfma_f32_16x16x32_bf16(Ah, Bh, Y, 0, 0, 0); }
              { const f32x4 t0 = *(const LAS f32x4*)((const LAS float*)(gb + RC_T) + (16 * bk + col) * 16 + 4 * q4);
                u64_t th, tl, yh, yl; hilo4(t0, th, tl); hilo4(Y, yh, yl);
                const bf16x8 Ah = mk_bf16x8(th, 0ull), Al = mk_bf16x8(tl, 0ull), Bh = mk_bf16x8(yh, 0ull), Bl = mk_bf16x8(yl, 0ull);
                f32x4 X = {0.f, 0.f, 0.f, 0.f};
                X = __builtin_amdgcn_mfma_f32_16x16x32_bf16(Al, Bh, X, 0, 0, 0);
                X = __builtin_amdgcn_mfma_f32_16x16x32_bf16(Ah, Bl, X, 0, 0, 0);
                X = __builtin_amdgcn_mfma_f32_16x16x32_bf16(Ah, Bh, X, 0, 0, 0);
                Xc[bk] = X; hilo4(X, xh[bk], xl[bk]); }
          } }
        __syncthreads();
        { const int col = lane & 15, q4 = lane >> 4, cidx = 16 * wave + col;
          if (wave < 4) {
#pragma unroll
              for (int g = 0; g < 4; ++g)
#pragma unroll
                  for (int r = 0; r < 4; ++r) { const int i = 16 * g + 4 * q4 + r; const float x = Xc[g][r]; const unsigned hb = f2bf(x);
                      *(LAS bf16*)(gb + RC_AT + i * GP + 2 * cidx) = (bf16)hb; *(LAS bf16*)(gb + RC_AK + i * GP + 2 * cidx) = (bf16)f2bf(x - __uint_as_float(hb << 16)); }
          } else {
#pragma unroll
              for (int g = 0; g < 4; ++g)
#pragma unroll
                  for (int r = 0; r < 4; ++r) ((LAS float*)(gb + RC_A))[(16 * g + 4 * q4 + r) * 68 + (cidx - 64)] = Xc[g][r];
          } }
        __syncthreads();
        if (wave < 4) { const int col = lane & 15, q4 = lane >> 4, e = 16 * wave + col;
          bf16x8 bZ0, bZ1, bZ0l, bZ1l; split_acc(Zacc[0], Zacc[1], bZ0, bZ0l); split_acc(Zacc[2], Zacc[3], bZ1, bZ1l);
          f32x4 U[4], Yo[4], Vc[4];
          const LAS unsigned char* rowa = gb + col * GP + 8 * q4;
#pragma unroll
          for (int it = 0; it < 4; ++it) {
              const LAS float* u0p = (const LAS float*)(gb + RC_A) + (16 * it + 4 * q4) * 68 + e;
              U[it] = (f32x4){u0p[0], u0p[68], u0p[136], u0p[204]};
#pragma unroll
              for (int r = 0; r < 4; ++r) Vc[it][r] = bf2f(*(const LAS bf16*)(gb + RC_V + (16 * it + 4 * q4 + r) * GP + 2 * e));
              const LAS unsigned char* ra = rowa + 16 * it * GP;
              const bf16x8 wh0 = ld2x8(ra + RC_AT), wh1 = ld2x8(ra + RC_AT + 64), wl0 = ld2x8(ra + RC_AK), wl1 = ld2x8(ra + RC_AK + 64), qa0 = ld2x8(ra + RC_RT), qa1 = ld2x8(ra + RC_RT + 64);
              U[it] = __builtin_amdgcn_mfma_f32_16x16x32_bf16(wl0, bZ0, U[it], 0, 0, 0);
              U[it] = __builtin_amdgcn_mfma_f32_16x16x32_bf16(wl1, bZ1, U[it], 0, 0, 0);
              U[it] = __builtin_amdgcn_mfma_f32_16x16x32_bf16(wh0, bZ0l, U[it], 0, 0, 0);
              U[it] = __builtin_amdgcn_mfma_f32_16x16x32_bf16(wh1, bZ1l, U[it], 0, 0, 0);
              U[it] = __builtin_amdgcn_mfma_f32_16x16x32_bf16(wh0, bZ0, U[it], 0, 0, 0);
              U[it] = __builtin_amdgcn_mfma_f32_16x16x32_bf16(wh1, bZ1, U[it], 0, 0, 0);
              Yo[it] = __builtin_amdgcn_mfma_f32_16x16x32_bf16(qa0, bZ0l, (f32x4){0.f, 0.f, 0.f, 0.f}, 0, 0, 0);
              Yo[it] = __builtin_amdgcn_mfma_f32_16x16x32_bf16(qa1, bZ1l, Yo[it], 0, 0, 0);
              Yo[it] = __builtin_amdgcn_mfma_f32_16x16x32_bf16(qa0, bZ0, Yo[it], 0, 0, 0);
              Yo[it] = __builtin_amdgcn_mfma_f32_16x16x32_bf16(qa1, bZ1, Yo[it], 0, 0, 0);
              asm volatile("" ::: "memory");
          }
          bf16x8 bU0, bU1, bU0l, bU1l; split_acc(U[0], U[1], bU0, bU0l); split_acc(U[2], U[3], bU1, bU1l);
          const bf16x8 bV0 = pack_acc(Vc[0], Vc[1]), bV1 = pack_acc(Vc[2], Vc[3]);
#pragma unroll
          for (int it = 0; it < 4; ++it) {
              const LAS unsigned char* ra = rowa + 16 * it * GP;
              const bf16x8 pb0 = ld2x8(ra + RC_RB), pb1 = ld2x8(ra + RC_RB + 64), pk0 = ld2x8(ra + RC_RK), pk1 = ld2x8(ra + RC_RK + 64);
              const bf16x8 hb0 = ld2x8(ra + RC_BH), hb1 = ld2x8(ra + RC_BH + 64), hk0 = ld2x8(ra + RC_KH), hk1 = ld2x8(ra + RC_KH + 64);
              f32x4 O = Yo[it];
              O = __builtin_amdgcn_mfma_f32_16x16x32_bf16(pb0, bU0l, O, 0, 0, 0);
              O = __builtin_amdgcn_mfma_f32_16x16x32_bf16(pb1, bU1l, O, 0, 0, 0);
              O = __builtin_amdgcn_mfma_f32_16x16x32_bf16(pk0, bV0, O, 0, 0, 0);
              O = __builtin_amdgcn_mfma_f32_16x16x32_bf16(pk1, bV1, O, 0, 0, 0);
              O = __builtin_amdgcn_mfma_f32_16x16x32_bf16(pb0, bU0, O, 0, 0, 0);
              O = __builtin_amdgcn_mfma_f32_16x16x32_bf16(pb1, bU1, O, 0, 0, 0);
              const f32x4 gz = *(const LAS f32x4*)(gamT + 16 * it + 4 * q4);
              f32x4 Zn = Zacc[it] * gz;
              Zn = __builtin_amdgcn_mfma_f32_16x16x32_bf16(hb0, bU0l, Zn, 0, 0, 0);
              Zn = __builtin_amdgcn_mfma_f32_16x16x32_bf16(hb1, bU1l, Zn, 0, 0, 0);
              Zn = __builtin_amdgcn_mfma_f32_16x16x32_bf16(hk0, bV0, Zn, 0, 0, 0);
              Zn = __builtin_amdgcn_mfma_f32_16x16x32_bf16(hk1, bV1, Zn, 0, 0, 0);
              Zn = __builtin_amdgcn_mfma_f32_16x16x32_bf16(hb0, bU0, Zn, 0, 0, 0);
              Zn = __builtin_amdgcn_mfma_f32_16x16x32_bf16(hb1, bU1, Zn, 0, 0, 0);
              Zacc[it] = Zn;
#pragma unroll
              for (int r = 0; r < 4; ++r) ((LAS float*)(gb + RC_A))[(16 * it + 4 * q4 + r) * 68 + e] = O[r];
              asm volatile("" ::: "memory");
          } }
        __syncthreads();
    }
    RC_WRITEOUT(SEQ / 64 - 1);
#undef RC_WRITEOUT
    __syncthreads();
}
__device__ __forceinline__ int next_unit(Frame& F, gu32* head) {
    __syncthreads();
    if (F.tid == 0) F.MISC[16] = __hip_atomic_fetch_add(head, 1u, RLX_AGENT);
    __syncthreads();
    return (int)F.MISC[16];
}
constexpr int U_GDN = 96, U_RWKV = 64, U_ATT = 384, U_ALL = U_GDN + U_RWKV + U_ATT;
__device__ __forceinline__ void p3_mixers(Frame& F, int l, int rep) {
    gu32* head = F.ctl + CW_QUEUE + 64 * (2 * l + rep);
    for (;;) {
        const int u = next_unit(F, head);
        if (u >= U_ALL) break;
        asm volatile("" : "+v"(F.tid), "+v"(F.lane));
        if (u < U_GDN) gdn_unit3<0>(F, l, u, F.ctl + CW_FLAG + 64 * 256 * (2 * l + rep) + 64 * 128);
        else if (u < U_GDN + U_RWKV) rwkv_unit_c(F, u - U_GDN, F.ctl + CW_FLAG + 64 * 256 * (2 * l + rep));
        else attn_unit(F, u - U_GDN - U_RWKV);
    }
}
__device__ __forceinline__ f32x4 bf4(u64_t x) { return (f32x4){__uint_as_float(((unsigned)x) << 16), __uint_as_float(((unsigned)x) & 0xffff0000u), __uint_as_float(((unsigned)(x >> 32)) << 16), __uint_as_float(((unsigned)(x >> 32)) & 0xffff0000u)}; }
__device__ __forceinline__ u64_t pk4(const f32x4& v) { return (u64_t)pg8::cvt_pk_bf16(v[0], v[1]) | ((u64_t)pg8::cvt_pk_bf16(v[2], v[3]) << 32); }
__device__ __forceinline__ void p2_mla_unit(Frame& F, int l, int unit) {
    const int lane = F.lane, col = lane & 15, q4 = lane >> 4, m = 16 * unit + col, b = m / SEQ, t = m % SEQ, t0 = (16 * unit) % SEQ;
    const bf16* prow = (const bf16*)(F.ws + WS_PMLA) + (size_t)m * 352;
    const bf16* WuqT = (const bf16*)(F.ws + WS_WSMALL + OFF_WUQ) + (size_t)l * 576 * 192 + (size_t)col * 192 + 8 * q4;
    const bf16* WukvT = (const bf16*)(F.ws + WS_WSMALL + OFF_WUKV) + (size_t)l * 768 * 128 + (size_t)col * 128 + 8 * q4;
    bf16x8 aq[6], akv[4]; float sq = 0.f, skv = 0.f;
#pragma unroll
    for (int s = 0; s < 6; ++s) { aq[s] = *(const bf16x8*)(prow + 32 * s + 8 * q4); const v4u u = __builtin_bit_cast(v4u, aq[s]);
#pragma unroll
        for (int i = 0; i < 4; ++i) { const float a = __uint_as_float(u[i] << 16), c = __uint_as_float(u[i] & 0xffff0000u); sq += a * a + c * c; } }
#pragma unroll
    for (int s = 0; s < 4; ++s) { akv[s] = *(const bf16x8*)(prow + 192 + 32 * s + 8 * q4); const v4u u = __builtin_bit_cast(v4u, akv[s]);
#pragma unroll
        for (int i = 0; i < 4; ++i) { const float a = __uint_as_float(u[i] << 16), c = __uint_as_float(u[i] & 0xffff0000u); skv += a * a + c * c; } }
    sq += __shfl_xor(sq, 16); sq += __shfl_xor(sq, 32); skv += __shfl_xor(skv, 16); skv += __shfl_xor(skv, 32);
    const float rq = rsqrtf(sq * (1.f / 192.f) + NORM_EPS) * (0.10206207261596575f * LOG2E), rkv = rsqrtf(skv * (1.f / 128.f) + NORM_EPS);
    const float pos = (float)((const int*)inptr(F, 1))[m];
    f32x4 cs, sn;
#pragma unroll
    for (int r = 0; r < 4; ++r) { const float inv = exp2f(-(float)(4 * q4 + r) * (13.287712379549449f / 16.f)); float s_, c_; sincosf(pos * inv, &s_, &c_); cs[r] = c_; sn[r] = s_; }
    bf16* Qo = (bf16*)(F.ws + WS_Q) + ((size_t)b * 6 * SEQ + t) * 96 + 4 * q4;
    bf16* Ko = (bf16*)(F.ws + WS_K) + ((size_t)b * 6 * SEQ + t) * 96 + 4 * q4;
    bf16* Vo = (bf16*)(F.ws + WS_VT) + (size_t)b * 6 * 64 * SEQ + (size_t)col * SEQ + t0 + 4 * q4;
    { const u64_t x1 = *(const u64_t*)(prow + 320 + 4 * q4), x2 = *(const u64_t*)(prow + 336 + 4 * q4); const f32x4 a = bf4(x1), c = bf4(x2);
      const u64_t o1 = pk4(a * cs - c * sn), o2 = pk4(c * cs + a * sn);
#pragma unroll
      for (int h = 0; h < 6; ++h) { *(u64_t*)(Ko + (size_t)h * SEQ * 96 + 64) = o1; *(u64_t*)(Ko + (size_t)h * SEQ * 96 + 80) = o2; } }
#pragma unroll 2
    for (int h = 0; h < 6; ++h) {
        f32x4 x1v = {0.f, 0.f, 0.f, 0.f};
#pragma unroll
        for (int nt = 0; nt < 6; ++nt) {
            const bf16* w = WuqT + (size_t)(h * 96 + 16 * nt) * 192; f32x4 acc = {0.f, 0.f, 0.f, 0.f};
#pragma unroll
            for (int s = 0; s < 6; ++s) acc = __builtin_amdgcn_mfma_f32_16x16x32_bf16(*(const bf16x8*)(w + 32 * s), aq[s], acc, 0, 0, 0);
            acc = acc * rq;
            if (nt < 4) *(u64_t*)(Qo + (size_t)h * SEQ * 96 + 16 * nt) = pk4(acc);
            else if (nt == 4) x1v = acc;
            else { *(u64_t*)(Qo + (size_t)h * SEQ * 96 + 64) = pk4(x1v * cs - acc * sn); *(u64_t*)(Qo + (size_t)h * SEQ * 96 + 80) = pk4(acc * cs + x1v * sn); }
        }
#pragma unroll
        for (int nt = 0; nt < 4; ++nt) {
            const bf16* w = WukvT + (size_t)(h * 128 + 16 * nt) * 128; f32x4 acc = {0.f, 0.f, 0.f, 0.f};
#pragma unroll
            for (int s = 0; s < 4; ++s) acc = __builtin_amdgcn_mfma_f32_16x16x32_bf16(*(const bf16x8*)(w + 32 * s), akv[s], acc, 0, 0, 0);
            *(u64_t*)(Ko + (size_t)h * SEQ * 96 + 16 * nt) = pk4(acc * rkv);
        }
        f32x4 rk4;
#pragma unroll
        for (int r = 0; r < 4; ++r) rk4[r] = __shfl(rkv, 4 * q4 + r);
#pragma unroll
        for (int nt = 0; nt < 4; ++nt) {
            const bf16* w = WukvT + (size_t)(h * 128 + 64 + 16 * nt) * 128; f32x4 acc = {0.f, 0.f, 0.f, 0.f};
#pragma unroll
            for (int s = 0; s < 4; ++s) acc = __builtin_amdgcn_mfma_f32_16x16x32_bf16(akv[s], *(const bf16x8*)(w + 32 * s), acc, 0, 0, 0);
            *(u64_t*)(Vo + (size_t)(h * 64 + 16 * nt) * SEQ) = pk4(acc * rk4);
        }
    }
}
__device__ __forceinline__ f32x4 rw_shift4(const bf16* P, size_t m, int c, bool hp, bool hn, const float* mu) {
    const f32x4 x = bf4(*(const u64_t*)(P + m * 896 + c)), xp = hp ? bf4(*(const u64_t*)(P + (m - 1) * 896 + c)) : (f32x4){0.f, 0.f, 0.f, 0.f}, xn = hn ? bf4(*(const u64_t*)(P + (m + 1) * 896 + c)) : (f32x4){0.f, 0.f, 0.f, 0.f};
    const f32x4 m0 = *(const f32x4*)(mu + c), m1 = *(const f32x4*)(mu + 896 + c);
    return x + m0 * (xp - x) + m1 * (xn - x);
}
__device__ __forceinline__ void p2_rwkv_unit(Frame& F, int l, int unit, int h0, int h1) {
    const int lane = F.lane, col = lane & 15, q4 = lane >> 4, b = (16 * unit) / SEQ, t = (16 * unit) % SEQ + col; const size_t m = (size_t)16 * unit + col;
    const bool hp = t > 0, hn = t < SEQ - 1;
    const bf16* Prw = (const bf16*)(F.ws + WS_PRW);
    const float* mu = (const float*)inptr(F, 12) + l * 2 * 896;
    const bf16* W2T = (const bf16*)(F.ws + WS_WSMALL + OFF_W2T) + (size_t)l * 2 * 256 * 64 + (size_t)col * 64 + 8 * q4;
    const bf16* A2T = (const bf16*)(F.ws + WS_WSMALL + OFF_A2T) + (size_t)l * 2 * 256 * 64 + (size_t)col * 64 + 8 * q4;
    bf16x8 awd[2], aad[2];
#pragma unroll
    for (int s = 0; s < 2; ++s) { const int c = 768 + 32 * s + 8 * q4;
        f32x4 lo = rw_shift4(Prw, m, c, hp, hn, mu), hi = rw_shift4(Prw, m, c + 4, hp, hn, mu);
#pragma unroll
        for (int i = 0; i < 4; ++i) { lo[i] = 1.f - 2.f * __builtin_amdgcn_rcpf(1.f + __expf(2.f * lo[i])); hi[i] = 1.f - 2.f * __builtin_amdgcn_rcpf(1.f + __expf(2.f * hi[i])); }
        awd[s] = pack_acc(lo, hi);
        aad[s] = pack_acc(rw_shift4(Prw, m, c + 64, hp, hn, mu), rw_shift4(Prw, m, c + 68, hp, hn, mu)); }
#pragma unroll 1
    for (int h = h0; h < h1; ++h) {
        f32x4 k[4]; float kn = 0.f;
        { const float* k_k = (const float*)inptr(F, 17) + l * 256;
#pragma unroll
          for (int nt = 0; nt < 4; ++nt) { const int c = 64 * h + 16 * nt + 4 * q4; k[nt] = rw_shift4(Prw, m, 256 + c, hp, hn, mu);
              const f32x4 x = k[nt] * *(const f32x4*)(k_k + c); kn += (x[0] * x[0] + x[1] * x[1]) + (x[2] * x[2] + x[3] * x[3]); } }
        kn += __shfl_xor(kn, 16); kn += __shfl_xor(kn, 32);
        const float rkn = rsqrtf(kn + 1e-6f);
        float br[2] = {0.f, 0.f}, kr[2] = {0.f, 0.f}, cbv = 0.f;
        unsigned char* rs = F.ws + WS_RS + (((size_t)b * 4 + h) * SEQ + t) * RS_REC + 8 * q4;
        unsigned char* rd0 = F.ws + WS_RD + (((size_t)b * 4 + h) * SEQ + t) * RD_REC + 8 * q4;
#pragma unroll
        for (int nt = 0; nt < 4; ++nt) { const int c = 64 * h + 16 * nt + 4 * q4;
            const f32x4 r = rw_shift4(Prw, m, c, hp, hn, mu), v = rw_shift4(Prw, m, 512 + c, hp, hn, mu);
            const f32x4 kk = k[nt] * *(const f32x4*)((const float*)inptr(F, 17) + l * 256 + c) * rkn;
            *(u64_t*)(rs + 32 * nt) = pk4(kk); *(u64_t*)(rs + 128 + 32 * nt) = pk4(v); *(u64_t*)(rs + 256 + 32 * nt) = pk4(r);
            f32x4 ksum = {0.f, 0.f, 0.f, 0.f};
#pragma unroll
            for (int e = 0; e < 2; ++e) { const bf16* w = W2T + (size_t)(e * 256 + 64 * h + 16 * nt) * 64; const bf16* a = A2T + (size_t)(e * 256 + 64 * h + 16 * nt) * 64;
                f32x4 x = {0.f, 0.f, 0.f, 0.f}, y = {0.f, 0.f, 0.f, 0.f};
#pragma unroll
                for (int s = 0; s < 2; ++s) { x = __builtin_amdgcn_mfma_f32_16x16x32_bf16(*(const bf16x8*)(w + 32 * s), awd[s], x, 0, 0, 0); y = __builtin_amdgcn_mfma_f32_16x16x32_bf16(*(const bf16x8*)(a + 32 * s), aad[s], y, 0, 0, 0); }
                const f32x4 w0v = *(const f32x4*)((const float*)inptr(F, 13) + l * 512 + e * 256 + c), a0v = *(const f32x4*)((const float*)inptr(F, 15) + l * 512 + e * 256 + c), kav = *(const f32x4*)((const float*)inptr(F, 18) + l * 256 + c);
                f32x4 lam, av;
#pragma unroll
                for (int i = 0; i < 4; ++i) { lam[i] = 0.6065306597126334f * sigmoidf_(w0v[i] + x[i]); av[i] = sigmoidf_(a0v[i] + y[i]); }
                const f32x4 km = k[nt] * (1.f + (av - 1.f) * kav), bb = av * kk;
                ksum += km;
                br[e] += (bb[0] * r[0] + bb[1] * r[1]) + (bb[2] * r[2] + bb[3] * r[3]); kr[e] += (km[0] * r[0] + km[1] * r[1]) + (km[2] * r[2] + km[3] * r[3]);
                typedef _Float16 h4 __attribute__((ext_vector_type(4)));
                const h4 lh = {(_Float16)lam[0], (_Float16)lam[1], (_Float16)lam[2], (_Float16)lam[3]};
                unsigned char* rd = rd0 + e * RD_DIR;
                *(u64_t*)(rd + 32 * nt) = __builtin_bit_cast(u64_t, lh); *(u64_t*)(rd + 128 + 32 * nt) = pk4(bb); *(u64_t*)(rd + 256 + 32 * nt) = pk4(km); }
            const f32x4 rkv = *(const f32x4*)((const float*)inptr(F, 19) + l * 256 + c), xx = r * ksum * rkv; cbv += (xx[0] + xx[1]) + (xx[2] + xx[3]);
        }
#pragma unroll
        for (int e = 0; e < 2; ++e) { float x = br[e], y = kr[e]; x += __shfl_xor(x, 16); x += __shfl_xor(x, 32); y += __shfl_xor(y, 16); y += __shfl_xor(y, 32);
            if (q4 == 0) { typedef float f2 __attribute__((ext_vector_type(2))); *(f2*)(rd0 + e * RD_DIR + 384) = (f2){x, y}; } }
        cbv += __shfl_xor(cbv, 16); cbv += __shfl_xor(cbv, 32);
        if (q4 == 0) ((float*)(F.ws + WS_CB))[m * 4 + h] = 0.5f * cbv;
    }
}
template <int MODE> __device__ __forceinline__ void p2_prep2(Frame& F, int l) {
    const int gw = F.vcu * NWAVES + F.wave, NGW = F.G * NWAVES;
    for (int u = gw; u < 2 * (M / 16); u += NGW) { if (u & 1) { if (MODE != 1) p2_rwkv_unit(F, l, u >> 1, 0, 4); } else { if (MODE != 2) p2_mla_unit(F, l, u >> 1); } }
}
__device__ __forceinline__ void ld16(const bf16* p, f32x4 (&o)[4]) { const v4u a = *(const v4u*)p, b = *(const v4u*)(p + 8);
    o[0] = (f32x4){__uint_as_float(a.x << 16), __uint_as_float(a.x & 0xffff0000u), __uint_as_float(a.y << 16), __uint_as_float(a.y & 0xffff0000u)};
    o[1] = (f32x4){__uint_as_float(a.z << 16), __uint_as_float(a.z & 0xffff0000u), __uint_as_float(a.w << 16), __uint_as_float(a.w & 0xffff0000u)};
    o[2] = (f32x4){__uint_as_float(b.x << 16), __uint_as_float(b.x & 0xffff0000u), __uint_as_float(b.y << 16), __uint_as_float(b.y & 0xffff0000u)};
    o[3] = (f32x4){__uint_as_float(b.z << 16), __uint_as_float(b.z & 0xffff0000u), __uint_as_float(b.w << 16), __uint_as_float(b.w & 0xffff0000u)}; }
__device__ __forceinline__ void p4a_mix2(Frame& F, int l) {
    const bf16* Ogdn = (const bf16*)(F.ws + WS_OGDN); const bf16* Omla = (const bf16*)(F.ws + WS_OMLA); const bf16* Y = (const bf16*)(F.ws + WS_Y);
    const bf16* Pgate = (const bf16*)(F.ws + WS_PGATE); const unsigned char* Rs = F.ws + WS_RS; const float* cb = (const float*)(F.ws + WS_CB); bf16* mix = (bf16*)(F.ws + WS_MIX);
    const int gw = F.vcu * NWAVES + F.wave, NGW = F.G * NWAVES, lane = F.lane, g = lane >> 2, c0 = 16 * lane;
    f32x4 pg[4], pb[4];
    if (g < 6) { const float* gg = (const float*)inptr(F, 7) + l * 64 + (c0 & 63);
#pragma unroll
        for (int i = 0; i < 4; ++i) { pg[i] = *(const f32x4*)(gg + 4 * i); pb[i] = (f32x4){0.f, 0.f, 0.f, 0.f}; } }
    else if (g < 12) {
#pragma unroll
        for (int i = 0; i < 4; ++i) { pg[i] = (f32x4){1.f, 1.f, 1.f, 1.f}; pb[i] = (f32x4){0.f, 0.f, 0.f, 0.f}; } }
    else { const float* lg = (const float*)inptr(F, 20) + l * 256 + (c0 - 768); const float* lb = (const float*)inptr(F, 21) + l * 256 + (c0 - 768);
#pragma unroll
        for (int i = 0; i < 4; ++i) { pg[i] = *(const f32x4*)(lg + 4 * i); pb[i] = *(const f32x4*)(lb + 4 * i); } }
#pragma unroll 2
    for (int m = gw; m < M; m += NGW) {
        f32x4 x[4], gt[4];
        ld16(Pgate + (size_t)m * 1024 + c0, gt);
        if (g < 6) { ld16(Ogdn + (size_t)m * 384 + c0, x);
            float ss = 0.f;
#pragma unroll
            for (int i = 0; i < 4; ++i) ss += (x[i][0] * x[i][0] + x[i][1] * x[i][1]) + (x[i][2] * x[i][2] + x[i][3] * x[i][3]);
            ss += dpp_xor1(ss); ss += dpp_xor2(ss);
            const float rs = rsqrtf(ss * (1.f / 64.f) + NORM_EPS);
#pragma unroll
            for (int i = 0; i < 4; ++i) x[i] = x[i] * rs * pg[i]; }
        else if (g < 12) ld16(Omla + (size_t)m * 384 + (c0 - 384), x);
        else { const int cc = c0 - 768, h = g - 12, b = m / SEQ, t = m % SEQ; f32x4 v[4];
            ld16(Y + (size_t)m * 256 + cc, x); ld16((const bf16*)(Rs + (((size_t)b * 4 + h) * SEQ + t) * RS_REC + 128) + (cc & 63), v);
            const float cbv = cb[(size_t)m * 4 + h];
            float s1 = 0.f;
#pragma unroll
            for (int i = 0; i < 4; ++i) s1 += (x[i][0] + x[i][1]) + (x[i][2] + x[i][3]);
            s1 += dpp_xor1(s1); s1 += dpp_xor2(s1);
            const float mean = s1 * (1.f / 64.f); float s2 = 0.f;
#pragma unroll
            for (int i = 0; i < 4; ++i) { x[i] = x[i] - mean; s2 += (x[i][0] * x[i][0] + x[i][1] * x[i][1]) + (x[i][2] * x[i][2] + x[i][3] * x[i][3]); }
            s2 += dpp_xor1(s2); s2 += dpp_xor2(s2);
            const float rs = rsqrtf(s2 * (1.f / 64.f) + 64e-5f);
#pragma unroll
            for (int i = 0; i < 4; ++i) x[i] = x[i] * rs * pg[i] + pb[i] + cbv * v[i]; }
        v4u o0, o1;
#pragma unroll
        for (int i = 0; i < 4; ++i) {
#pragma unroll
            for (int j = 0; j < 4; ++j) x[i][j] = x[i][j] * siluf(gt[i][j]); }
        o0.x = pg8::cvt_pk_bf16(x[0][0], x[0][1]); o0.y = pg8::cvt_pk_bf16(x[0][2], x[0][3]); o0.z = pg8::cvt_pk_bf16(x[1][0], x[1][1]); o0.w = pg8::cvt_pk_bf16(x[1][2], x[1][3]);
        o1.x = pg8::cvt_pk_bf16(x[2][0], x[2][1]); o1.y = pg8::cvt_pk_bf16(x[2][2], x[2][3]); o1.z = pg8::cvt_pk_bf16(x[3][0], x[3][1]); o1.w = pg8::cvt_pk_bf16(x[3][2], x[3][3]);
        bf16* op = mix + (size_t)m * 1024 + c0; *(v4u*)op = o0; *(v4u*)(op + 8) = o1;
    }
}
constexpr int PT_OUT = 24, PT_WS = 25, PT_N = 26;
__device__ __forceinline__ void build_frame(Frame& F, LAS unsigned char* lds) {
    F.lds = lds; F.MISC = (volatile LAS unsigned*)(lds + MISC_OFF); F.ptab = (volatile LAS const unsigned long long*)(lds + MISC_OFF + 256);
    const int t = pg8::mk_tid(lds);
    F.tid = t; F.lane = t & 63; F.wave = __builtin_amdgcn_readfirstlane(t >> 6);
    F.G = gridDim.x; { const int bx = blockIdx.x; F.vcu = (F.G % 8 == 0) ? (bx % 8) * (F.G / 8) + bx / 8 : bx; }
    F.ws = (unsigned char*)inptr(F, PT_WS); F.out = (float*)inptr(F, PT_OUT); F.ctl = (gu32*)F.ws;
}
__device__ __forceinline__ bool ph_in(LAS unsigned char* lds, int k) { volatile LAS unsigned* mi = (volatile LAS unsigned*)(lds + MISC_OFF); const int lo = __builtin_amdgcn_readfirstlane((int)mi[20]), hi = __builtin_amdgcn_readfirstlane((int)mi[21]); return lo <= k && k < hi; }
__device__ __forceinline__ void seam(LAS unsigned char* lds, int k) {
    if (ph_in(lds, k) && ph_in(lds, k + 1)) { Frame F; build_frame(F, lds);
        XcdBarrier bar; bar.bar = (unsigned*)(F.ctl + CW_BAR); bar.x = xb_xcc_id(); bar.st = F.MISC + 8; xcd_barrier(bar); }
}
template <int L> __device__ __forceinline__ void layer_phases(LAS unsigned char* lds) {
    constexpr int pb = 1 + 5 * L;
    if (ph_in(lds, pb)) { Frame F; build_frame(F, lds);
        pg8::Gemm g{(const pg8::bf16_t*)(F.ws + WS_XB), (const pg8::bf16_t*)(F.ws + WS_WIN) + (size_t)L * NP * D, M, NP, D};
        pg8::StaticOrder S; S.init(M, NP, F.G, (int)blockIdx.x);
        pg8::EpiRoute E{F.ws};
        pg8::gemm_phase<pg8::EpiRoute, pg8::StaticOrder, true, true>(F.lds + RING_OFF, g, S, E);
    }
    seam(lds, pb);
    if (ph_in(lds, pb + 1)) { Frame F; build_frame(F, lds); p2_prep2<0>(F, L); }
    seam(lds, pb + 1);
    if (ph_in(lds, pb + 2)) { Frame F; build_frame(F, lds); p3_mixers(F, L, 0); }
    seam(lds, pb + 2);
    if (ph_in(lds, pb + 3)) { Frame F; build_frame(F, lds); p4a_mix2(F, L);
    }
    seam(lds, pb + 3);
    if (ph_in(lds, pb + 4)) { Frame F; build_frame(F, lds);
        pg8::Gemm g{(const pg8::bf16_t*)(F.ws + WS_MIX), (const pg8::bf16_t*)(F.ws + WS_WOUT) + (size_t)L * D * D, M, D, D};
        pg8::StaticOrder S; S.init(M, D, F.G, (int)blockIdx.x);
        pg8::EpiOut<L == 0> E{L == 0 ? (const float*)inptr(F, 0) : (const float*)F.out, F.out, F.ws};
        pg8::gemm_phase<pg8::EpiOut<L == 0>, pg8::StaticOrder, true, true>(F.lds + RING_OFF, g, S, E);
    }
    seam(lds, pb + 4);
}
__global__ void __launch_bounds__(NWAVES * 64, 2) mk_fwd(Args args) {
    extern __shared__ __attribute__((aligned(16))) unsigned char lds_raw[];
    LAS unsigned char* lds = (LAS unsigned char*)lds_raw;
    for (int u = threadIdx.x; u < (LDS_BYTES - LDSCTL_OFF) / 4; u += NWAVES * 64) ((LAS unsigned*)(lds + LDSCTL_OFF))[u] = 0u;
    __syncthreads();
    if (threadIdx.x == 0) { LAS unsigned long long* pt = (LAS unsigned long long*)(lds + MISC_OFF + 256);
#define PT(k) pt[k] = (unsigned long long)args.in[k]
        PT(0); PT(1); PT(2); PT(3); PT(4); PT(5); PT(6); PT(7); PT(8); PT(9); PT(10); PT(11); PT(12); PT(13); PT(14); PT(15); PT(16); PT(17); PT(18); PT(19); PT(20); PT(21); PT(22); PT(23);
#undef PT
        pt[PT_OUT] = (unsigned long long)args.out; pt[PT_WS] = (unsigned long long)args.ws;
        volatile LAS unsigned* mi = (volatile LAS unsigned*)(lds + MISC_OFF); mi[20] = (unsigned)args.ph_lo; mi[21] = (unsigned)args.ph_hi;
        if (args.ph_hi - args.ph_lo > 1) (void)xcd_barrier_post((unsigned*)((gu32*)args.ws + CW_BAR), mi + 8);
    }
    if ((threadIdx.x & 63) == 0) ((volatile LAS unsigned*)(lds + pg8::TIDTAB_OFF))[pg8::hw_slot()] = threadIdx.x >> 6;
    __syncthreads();
    if (ph_in(lds, 0)) { Frame F; build_frame(F, lds); p0_prologue(F); }
    seam(lds, 0);
    layer_phases<0>(lds);
    layer_phases<1>(lds);
    if (ph_in(lds, 11)) { Frame F; build_frame(F, lds); p5_final(F); }
}

extern "C" void kernel_launch(void* const* d_in, const int* in_sizes, int n_in, void* d_out, int out_size, void* d_ws, size_t ws_size, hipStream_t stream) {
    static int grid = 0;
    if (grid == 0) {
        if (n_in != 24 || ws_size < WS_END || out_size != M * D) { fprintf(stderr, "kernel_launch: unexpected inputs (%d), out (%d) or workspace (%zu)\n", n_in, out_size, ws_size); grid = -1; return; }
        int dev = 0, cus = 0;
        if (hipGetDevice(&dev) != hipSuccess || hipDeviceGetAttribute(&cus, hipDeviceAttributeMultiprocessorCount, dev) != hipSuccess) { grid = -1; return; }
        if (hipFuncSetAttribute((const void*)mk_fwd, hipFuncAttributeMaxDynamicSharedMemorySize, LDS_BYTES) != hipSuccess) { fprintf(stderr, "kernel_launch: hipFuncSetAttribute failed\n"); grid = -1; return; }
        (void)hipGetLastError();
        grid = cus;
    }
    if (grid < 0) return;
    unsigned char* ws = (unsigned char*)d_ws;
    (void)hipMemsetAsync(ws + WS_CTL, 0, CTL_ZERO_BYTES, stream);
    Args a{};
    for (int i = 0; i < 24; ++i) a.in[i] = d_in[i];
    a.out = (float*)d_out; a.ws = ws; a.ph_lo = 0; a.ph_hi = NPHASE;
    hipLaunchKernelGGL(mk_fwd, dim3(grid), dim3(NWAVES * 64), LDS_BYTES, stream, a);
}
```

```cpp
#include <hip/hip_runtime.h>
#include <cstdio>
#include <cstdint>
#include <hip/hip_fp16.h>
namespace pg8 {
#define PG8_LAS __attribute__((address_space(3)))
typedef unsigned short bf16_t;
typedef short bf16x8 __attribute__((ext_vector_type(8)));
typedef float f32x4 __attribute__((ext_vector_type(4)));
typedef unsigned u32x4 __attribute__((ext_vector_type(4)));
constexpr int BM = 256, BK = 64, HALF = 128, HTB = HALF * BK * 2  , STAGE_BYTES = 8 * HTB, NXCD = 8, WGM = 8;

__host__ __device__ __forceinline__ int lds_byte(int r, int c) { const int st = (r >> 4) * 2 + (c >> 5), rr = r & 15, cc = c & 31, ob = rr * 64 + cc * 2; return st * 1024 + (ob ^ (((ob >> 9) & 1) << 5)); }
__host__ __device__ __forceinline__ void stage_rc(int b, int& R, int& C) { const int st = b / 1024, sb = b % 1024, swz = sb ^ (((sb >> 9) & 1) << 5); R = (st >> 1) * 16 + swz / 64; C = (st & 1) * 32 + (swz % 64) / 2; }
__host__ __device__ __forceinline__ int perm32(int rho) { const int n = rho >> 4, i = rho & 15; return 8 * (i >> 2) + 4 * n + (i & 3); }

struct Unit { int pm, pn; };
struct Gemm { const bf16_t* A; const bf16_t* Bt; int M, N, K; };

struct StaticOrder {
    int nM, nN, nwg, G, c;
    __host__ __device__ void init(int M, int N, int G_, int c_) { nM = M / BM; nN = N / BM; nwg = nM * nN; G = G_; c = c_; }
    __host__ __device__ bool next(int i, Unit& u) const {
        const long L = (long)i * G + c; if (L >= nwg) return false;
        int wgid = (int)L; { const int q = nwg / NXCD, r = nwg % NXCD, xcd = wgid % NXCD, off = wgid / NXCD; wgid = (xcd < r ? xcd * (q + 1) : r * (q + 1) + (xcd - r) * q) + off; }
        const int nig = WGM * nN, gid = wgid / nig, fm = gid * WGM, gsz = (nM - fm) < WGM ? (nM - fm) : WGM;
        u.pm = fm + ((wgid % nig) % gsz); u.pn = (wgid % nig) / gsz; return true;
    }
    __device__ __forceinline__ void a_ready(const Unit&) const {}
    __device__ __forceinline__ void done(const Unit&) const {}
};

__device__ __forceinline__ unsigned cvt_pk_bf16(float lo, float hi) { unsigned r; asm volatile("v_cvt_pk_bf16_f32 %0, %1, %2" : "=v"(r) : "v"(lo), "v"(hi)); return r; }
typedef float f32x2 __attribute__((ext_vector_type(2)));
constexpr int TIDTAB_OFF = 131072 + 320 + 512;
__device__ __forceinline__ unsigned hw_slot() { return (unsigned)__builtin_amdgcn_s_getreg((5 << 11) | 4) & 63u; }
__device__ __forceinline__ int mk_tid(PG8_LAS unsigned char* lds_base) {
    const unsigned lane = __builtin_amdgcn_mbcnt_hi(~0u, __builtin_amdgcn_mbcnt_lo(~0u, 0u));
    const unsigned w = __builtin_amdgcn_readfirstlane(((volatile PG8_LAS unsigned*)(lds_base + TIDTAB_OFF))[hw_slot()]);
    return (int)(w * 64u + lane);
}
struct EpiRoute {
    static constexpr bool PERM = true, AFTER_DRAIN = false;
    unsigned char* ws;
    __device__ __forceinline__ void operator()(const f32x4 (&acc)[2][2][4][2], const Unit& u, int wr, int wc, int fr, int fq) const {
        const int row0 = u.pm * BM + wr * 64 + fr;
        const float* rowss = (const float*)(ws + (1u << 20)); float* Psm = (float*)(ws + (22u << 20));
        unsigned base[2]; int ld[2], cc[2], kind[2];
#pragma unroll
        for (int bj = 0; bj < 2; ++bj) {
            const int cg = u.pn * BM + bj * HALF + wc * 32, col = cg + 8 * fq;
            if (cg < 1024) { base[bj] = 25u << 20; ld[bj] = 1024; cc[bj] = col; kind[bj] = 0; }
            else if (cg < 2176) { base[bj] = 57u << 20; ld[bj] = 1152; cc[bj] = col - 1024; kind[bj] = 0; }
            else if (cg < 2528) { base[bj] = 93u << 20; ld[bj] = 352; cc[bj] = col - 2176; kind[bj] = 0; }
            else if (cg < 3424) { base[bj] = 104u << 20; ld[bj] = 896; cc[bj] = col - 2528; kind[bj] = 0; }
            else if (cg < 3456) { base[bj] = 0u; ld[bj] = 32; cc[bj] = col - 3424; kind[bj] = 1; }
            else { base[bj] = 0u; ld[bj] = 0; cc[bj] = 0; kind[bj] = 2; }
        }
#pragma unroll
        for (int ai = 0; ai < 2; ++ai)
#pragma unroll
            for (int m = 0; m < 4; ++m) {
                const int row = row0 + ai * HALF + m * 16;
                const f32x4* rp = (const f32x4*)(rowss + (size_t)row * 16);
                const f32x4 s0 = rp[0], s1 = rp[1], s2 = rp[2], s3 = rp[3];
                const float ss = ((s0[0] + s0[1]) + (s0[2] + s0[3])) + ((s1[0] + s1[1]) + (s1[2] + s1[3])) + ((s2[0] + s2[1]) + (s2[2] + s2[3])) + ((s3[0] + s3[1]) + (s3[2] + s3[3]));
                const float rstd = __builtin_amdgcn_rsqf(ss * (1.0f / 1024.0f) + 1e-6f);
#pragma unroll
                for (int bj = 0; bj < 2; ++bj) {
                    const f32x4 v0 = acc[ai][bj][m][0] * rstd, v1 = acc[ai][bj][m][1] * rstd;
                    if (kind[bj] == 0) { u32x4 w; w.x = cvt_pk_bf16(v0[0], v0[1]); w.y = cvt_pk_bf16(v0[2], v0[3]); w.z = cvt_pk_bf16(v1[0], v1[1]); w.w = cvt_pk_bf16(v1[2], v1[3]);
                        *(u32x4*)((bf16_t*)(ws + base[bj]) + (size_t)row * ld[bj] + cc[bj]) = w; }
                    else if (kind[bj] == 1) { float* p = Psm + (size_t)row * 32 + cc[bj]; *(f32x4*)p = v0; *(f32x4*)(p + 4) = v1; }
                }
                asm volatile("" ::: "memory");
            }
    }
};
template <bool WRITE_XB> struct EpiOut {
    static constexpr bool PERM = false, AFTER_DRAIN = false;
    const float* xin; float* xout; unsigned char* ws;
    __device__ __forceinline__ void operator()(const f32x4 (&acc)[2][2][4][2], const Unit& u, int wr, int wc, int fr, int fq) const {
        typedef unsigned u32x2v __attribute__((ext_vector_type(2)));
        const int row0 = u.pm * BM + wr * 64 + fr, col0 = u.pn * BM + wc * 32 + 4 * fq;
        float* rowss = (float*)(ws + (1u << 20)); bf16_t* xb = (bf16_t*)(ws + (133u << 20));
#pragma unroll
        for (int ai = 0; ai < 2; ++ai)
#pragma unroll
            for (int m = 0; m < 4; ++m) {
                const int row = row0 + ai * HALF + m * 16; float ss = 0.f;
#pragma unroll
                for (int bj = 0; bj < 2; ++bj)
#pragma unroll
                    for (int n = 0; n < 2; ++n) {
                        const size_t off = (size_t)row * 1024 + col0 + bj * HALF + n * 16;
                        const f32x4 o = *(const f32x4*)(xin + off) + acc[ai][bj][m][n];
                        *(f32x4*)(xout + off) = o;
                        if (WRITE_XB) { u32x2v w; w.x = cvt_pk_bf16(o[0], o[1]); w.y = cvt_pk_bf16(o[2], o[3]); *(u32x2v*)(xb + off) = w; }
                        ss += (o[0] * o[0] + o[1] * o[1]) + (o[2] * o[2] + o[3] * o[3]);
                    }
                ss += __shfl_xor(ss, 16); ss += __shfl_xor(ss, 32);
                if (fq == 0) rowss[(size_t)row * 16 + u.pn * 4 + wc] = ss;
                asm volatile("" ::: "memory");
            }
    }
};
template <class Epi, class Sched, bool ALIGN_EPI = false, bool SP2 = false>
__device__ __forceinline__ void gemm_phase(PG8_LAS unsigned char* lds, const Gemm g, const Sched& S, const Epi& E) {
    const int tid_ = mk_tid(lds);
    const int tid = tid_, wid = __builtin_amdgcn_readfirstlane(tid >> 6), lane = tid & 63, wr = wid >> 2, wc = wid & 3, fr = lane & 15, fq = lane >> 4;
    const int K = g.K, nt = K / BK;
    unsigned voffA[2], voffB[2];
#pragma unroll
    for (int i = 0; i < 2; ++i) { int R, C; stage_rc(tid * 16 + i * 8192, R, C); const int Rb = Epi::PERM ? ((R & ~31) + perm32(R & 31)) : R;
        voffA[i] = (unsigned)(R * K + C) * 2u; voffB[i] = (unsigned)(Rb * K + C) * 2u; }
    const size_t kstep = (size_t)(BK * 2);
    const size_t hstep = (size_t)HALF * K * 2;
    const size_t tstep = 2 * hstep;
    const unsigned ldsw = (unsigned)wid * 1024u;
    const int aoff = lds_byte(wr * 64 + fr, fq * 8), boff = lds_byte(wc * 32 + fr, fq * 8);
#define PG8_SA(b, h) (((b) * 2 + (h)) * HTB)
#define PG8_SB(b, h) ((4 + (b) * 2 + (h)) * HTB)
#define PG8_STAGE(bufoff, gbase, voff) do { _Pragma("unroll") for (int _i = 0; _i < 2; ++_i) \
        __builtin_amdgcn_global_load_lds((const unsigned*)((const char*)(gbase) + (voff)[_i]), (PG8_LAS unsigned*)(lds + (bufoff) + ldsw + _i * 8192), 16, 0, 0); } while (0)
#define PG8_LDA(dst, b, h) do { _Pragma("unroll") for (int m = 0; m < 4; ++m) _Pragma("unroll") for (int k = 0; k < 2; ++k) dst[m][k] = *(const PG8_LAS bf16x8*)(lds + PG8_SA(b, h) + aoff + m * 2048 + k * 1024); } while (0)
#define PG8_LDB(dst, b, h) do { _Pragma("unroll") for (int n = 0; n < 2; ++n) _Pragma("unroll") for (int k = 0; k < 2; ++k) dst[n][k] = *(const PG8_LAS bf16x8*)(lds + PG8_SB(b, h) + boff + n * 2048 + k * 1024); } while (0)
#define PG8_MMA(ai, bj, At, Bt) do { __builtin_amdgcn_s_setprio(1); _Pragma("unroll") for (int m = 0; m < 4; ++m) _Pragma("unroll") for (int n = 0; n < 2; ++n) _Pragma("unroll") for (int k = 0; k < 2; ++k) \
        acc[ai][bj][m][n] = __builtin_amdgcn_mfma_f32_16x16x32_bf16(Bt[n][k], At[m][k], acc[ai][bj][m][n], 0, 0, 0); __builtin_amdgcn_s_setprio(0); } while (0)
#define PG8_WAIT_V(n) asm volatile("s_waitcnt vmcnt(" #n ")" ::: "memory")
#define PG8_WAIT_L(n) asm volatile("s_waitcnt lgkmcnt(" #n ")" ::: "memory")
#define PG8_BAR __builtin_amdgcn_s_barrier()
#define PG8_SCHED __builtin_amdgcn_sched_barrier(0)
    Unit cur, nxt; int ui = 0;
    if (!S.next(0, cur)) return;
    f32x4 acc[2][2][4][2];
#pragma unroll
    for (int a = 0; a < 2; ++a)
#pragma unroll
        for (int b = 0; b < 2; ++b)
#pragma unroll
            for (int m = 0; m < 4; ++m)
#pragma unroll
                for (int n = 0; n < 2; ++n) acc[a][b][m][n] = (f32x4){0.f, 0.f, 0.f, 0.f};
    bf16x8 At[4][2], B0[2][2], B1[2][2];
    const char* cA = (const char*)g.A + (size_t)cur.pm * tstep; const char* cB = (const char*)g.Bt + (size_t)cur.pn * tstep;
    S.a_ready(cur);
    if constexpr (SP2) {
        PG8_STAGE(PG8_SB(0, 0), cB, voffB); PG8_STAGE(PG8_SB(0, 1), cB + hstep, voffB); PG8_STAGE(PG8_SA(0, 0), cA, voffA); PG8_STAGE(PG8_SA(0, 1), cA + hstep, voffA);
        if (wr == 1) PG8_BAR;
        PG8_WAIT_V(2); PG8_BAR;
        PG8_STAGE(PG8_SB(1, 0), cB + kstep, voffB); PG8_STAGE(PG8_SA(1, 0), cA + kstep, voffA); PG8_STAGE(PG8_SB(1, 1), cB + hstep + kstep, voffB);
        PG8_WAIT_V(6); PG8_BAR;
    } else {
        PG8_STAGE(PG8_SB(0, 0), cB, voffB); PG8_STAGE(PG8_SA(0, 0), cA, voffA); PG8_STAGE(PG8_SB(0, 1), cB + hstep, voffB); PG8_STAGE(PG8_SA(0, 1), cA + hstep, voffA);
        if (wr == 1) PG8_BAR;
        PG8_WAIT_V(4); PG8_BAR;
        PG8_STAGE(PG8_SB(1, 0), cB + kstep, voffB); PG8_STAGE(PG8_SA(1, 0), cA + kstep, voffA); PG8_STAGE(PG8_SB(1, 1), cB + hstep + kstep, voffB);
        PG8_WAIT_V(6); PG8_BAR;
    }
    for (;;) {
        const bool has_next = S.next(ui + 1, nxt);
        const char* nA = has_next ? (const char*)g.A + (size_t)nxt.pm * tstep : cA; const char* nB = has_next ? (const char*)g.Bt + (size_t)nxt.pn * tstep : cB;
        for (int t = 0; t < nt; t += 2) {
            const bool last = (t == nt - 2);
            const char* a1 = cA + (size_t)(t + 1) * kstep;
            const char* a2 = last ? nA : cA + (size_t)(t + 2) * kstep; const char* b2 = last ? nB : cB + (size_t)(t + 2) * kstep;
            const char* a3 = a2 + kstep; const char* b3 = b2 + kstep;
            if (last && has_next) S.a_ready(nxt);
            if constexpr (SP2) {
            PG8_LDB(B0, 0, 0); PG8_LDB(B1, 0, 1); PG8_SCHED; PG8_LDA(At, 0, 0); PG8_STAGE(PG8_SA(1, 1), a1 + hstep, voffA);
            PG8_WAIT_V(8); PG8_WAIT_L(0); PG8_BAR; PG8_MMA(0, 0, At, B0); PG8_MMA(0, 1, At, B1); PG8_BAR; PG8_SCHED;
            PG8_LDA(At, 0, 1); PG8_STAGE(PG8_SB(0, 0), b2, voffB); PG8_STAGE(PG8_SB(0, 1), b2 + hstep, voffB); PG8_STAGE(PG8_SA(0, 0), a2, voffA);
            PG8_WAIT_V(8); PG8_WAIT_L(0); PG8_BAR; PG8_MMA(1, 0, At, B0); PG8_MMA(1, 1, At, B1); PG8_BAR; PG8_SCHED;
            PG8_LDB(B0, 1, 0); PG8_LDB(B1, 1, 1); PG8_SCHED; PG8_LDA(At, 1, 0); PG8_STAGE(PG8_SA(0, 1), a2 + hstep, voffA);
            PG8_WAIT_V(8); PG8_WAIT_L(0); PG8_BAR; PG8_MMA(0, 0, At, B0); PG8_MMA(0, 1, At, B1); PG8_BAR; PG8_SCHED;
            PG8_LDA(At, 1, 1); PG8_STAGE(PG8_SB(1, 0), b3, voffB); PG8_STAGE(PG8_SB(1, 1), b3 + hstep, voffB); PG8_STAGE(PG8_SA(1, 0), a3, voffA);
            PG8_WAIT_V(8); PG8_WAIT_L(0); PG8_BAR; PG8_MMA(1, 0, At, B0); PG8_MMA(1, 1, At, B1); PG8_BAR; PG8_SCHED;
            } else {
            PG8_LDB(B0, 0, 0); PG8_SCHED; PG8_LDA(At, 0, 0); PG8_STAGE(PG8_SA(1, 1), a1 + hstep, voffA);
            PG8_WAIT_L(8); PG8_BAR; PG8_WAIT_L(0); PG8_MMA(0, 0, At, B0); PG8_BAR; PG8_SCHED;
            PG8_LDB(B1, 0, 1); PG8_STAGE(PG8_SB(0, 0), b2, voffB);
            PG8_BAR; PG8_WAIT_L(0); PG8_MMA(0, 1, At, B1); PG8_BAR;
            PG8_LDA(At, 0, 1); PG8_STAGE(PG8_SA(0, 0), a2, voffA);
            PG8_BAR; PG8_WAIT_L(0); PG8_MMA(1, 0, At, B0); PG8_BAR; PG8_SCHED;
            PG8_STAGE(PG8_SB(0, 1), b2 + hstep, voffB);
            PG8_WAIT_V(6); PG8_BAR; PG8_MMA(1, 1, At, B1); PG8_BAR;
            PG8_LDB(B0, 1, 0); PG8_SCHED; PG8_LDA(At, 1, 0); PG8_STAGE(PG8_SA(0, 1), a2 + hstep, voffA);
            PG8_WAIT_L(8); PG8_BAR; PG8_WAIT_L(0); PG8_MMA(0, 0, At, B0); PG8_BAR; PG8_SCHED;
            PG8_LDB(B1, 1, 1); PG8_STAGE(PG8_SB(1, 0), b3, voffB);
            PG8_BAR; PG8_WAIT_L(0); PG8_MMA(0, 1, At, B1); PG8_BAR;
            PG8_LDA(At, 1, 1); PG8_STAGE(PG8_SA(1, 0), a3, voffA);
            PG8_BAR; PG8_WAIT_L(0); PG8_MMA(1, 0, At, B0); PG8_BAR; PG8_SCHED;
            PG8_STAGE(PG8_SB(1, 1), b3 + hstep, voffB);
            PG8_WAIT_V(6); PG8_BAR; PG8_MMA(1, 1, At, B1); PG8_BAR;
            }
        }
        if constexpr (ALIGN_EPI) { if (wr == 0) PG8_BAR; }
        if constexpr (!Epi::AFTER_DRAIN) { E(acc, cur, wr, wc, fr, fq); S.done(cur); }
        if (!has_next) break;
#pragma unroll
        for (int a = 0; a < 2; ++a)
#pragma unroll
            for (int b = 0; b < 2; ++b)
#pragma unroll
                for (int m = 0; m < 4; ++m)
#pragma unroll
                    for (int n = 0; n < 2; ++n) acc[a][b][m][n] = (f32x4){0.f, 0.f, 0.f, 0.f};
        cur = nxt; cA = nA; cB = nB; ++ui;
        if constexpr (ALIGN_EPI) { if (wr == 1) PG8_BAR; }
    }
    PG8_WAIT_V(0);
    if constexpr (!ALIGN_EPI) { if (wr == 0) PG8_BAR; }
    PG8_BAR;
    if constexpr (Epi::AFTER_DRAIN) { E.fused(acc, cur, wr, wc, fr, fq, lds, wid, lane); S.done(cur); }
#undef PG8_SA
#undef PG8_SB
#undef PG8_STAGE
#undef PG8_LDA
#undef PG8_LDB
#undef PG8_MMA
#undef PG8_WAIT_V
#undef PG8_WAIT_L
#undef PG8_BAR
#undef PG8_SCHED
}
}
#define GAS __attribute__((address_space(1)))
#define LAS __attribute__((address_space(3)))
typedef unsigned short bf16;
typedef unsigned v4u __attribute__((ext_vector_type(4)));
typedef float f32x4 __attribute__((ext_vector_type(4)));
typedef short bf16x8 __attribute__((ext_vector_type(8)));
typedef GAS unsigned gu32;
typedef GAS unsigned long long gu64;
#define RLX_AGENT __ATOMIC_RELAXED, __HIP_MEMORY_SCOPE_AGENT
#define LDS_WAIT() asm volatile("s_waitcnt lgkmcnt(0)" ::: "memory")
#define VM_WAIT() asm volatile("s_waitcnt vmcnt(0)" ::: "memory")
__device__ __forceinline__ unsigned long long rt() { return __builtin_amdgcn_s_memrealtime(); }
__device__ __forceinline__ unsigned f2bf(float f) { unsigned u = __builtin_bit_cast(unsigned, f); return (u + 0x7fffu + ((u >> 16) & 1u)) >> 16; }
__device__ __forceinline__ unsigned pk2(float lo, float hi) { return f2bf(lo) | (f2bf(hi) << 16); }

#define XB_TMO      128
#define XB_XCNT(j)  (256  + 64 * (j))
#define XB_XSUB(j)  (1280 + 64 * (j))
#define XB_XGEN(j)  (2304 + 64 * (j))
#define XB_TOP      3328
#define XB_TOPGEN   3392
#define XCD_BAR_WORDS 3456
#define XB_SPIN_CAP (1u << 18)

__device__ __forceinline__ unsigned xb_ld(unsigned* p)              { return __hip_atomic_load(p, __ATOMIC_RELAXED, __HIP_MEMORY_SCOPE_AGENT); }
__device__ __forceinline__ unsigned xb_add(unsigned* p, unsigned v) { return __hip_atomic_fetch_add(p, v, __ATOMIC_RELAXED, __HIP_MEMORY_SCOPE_AGENT); }
__device__ __forceinline__ unsigned xb_xcc_id() { return (unsigned)__builtin_amdgcn_s_getreg((3 << 11) | 20) & 0xFu; }
#define XB_SPIN(cond, bar) do { unsigned _sp = 0; while (cond) { __builtin_amdgcn_s_sleep(1); \
    if ((++_sp & 255u) == 0u) { if (xb_ld(&(bar)[XB_TMO])) break; if (_sp > XB_SPIN_CAP) { atomicAdd(&(bar)[XB_TMO], 1u); break; } } } } while (0)

struct XcdBarrier {
    unsigned* bar; unsigned x;
    volatile LAS unsigned* st;
};

__device__ __forceinline__ XcdBarrier xcd_barrier_post(unsigned* bar, volatile LAS unsigned* st) {
    XcdBarrier b; b.bar = bar; b.x = xb_xcc_id(); b.st = st;
    if (threadIdx.x == 0) (void)xb_add(&bar[XB_XCNT(b.x)], 1u);
    return b;
}
__device__ __forceinline__ void xcd_barrier_complete(unsigned* bar, unsigned x, unsigned& nloc, unsigned& nx) {
    const unsigned G = gridDim.x * gridDim.y * gridDim.z;
    unsigned sum, cnt, mine, sp = 0u;
    for (;;) {
        sum = 0u; cnt = 0u; mine = 0u;
#pragma unroll
        for (unsigned j = 0; j < 16; ++j) { const unsigned c = xb_ld(&bar[XB_XCNT(j)]); sum += c; cnt += (c > 0u) ? 1u : 0u; mine = (j == x) ? c : mine; }
        if (sum == G) break;
        __builtin_amdgcn_s_sleep(1);
        if ((++sp & 255u) == 0u) { if (xb_ld(&bar[XB_TMO])) break; if (sp > XB_SPIN_CAP) { atomicAdd(&bar[XB_TMO], 1u); break; } }
    }
    nloc = mine > 0u ? mine : 1u; nx = cnt > 0u ? cnt : 1u;
}

__device__ __forceinline__ void xcd_barrier(const XcdBarrier& b) {
    asm volatile("s_waitcnt vmcnt(0)" ::: "memory");
    __syncthreads();
    if (pg8::mk_tid((LAS unsigned char*)b.st - (131072 + 320 + 32)) == 0) {
        unsigned* bar = b.bar;
        __builtin_amdgcn_s_waitcnt(0);
        unsigned nloc = b.st[0], nx = b.st[1];
        if (nloc == 0u) { xcd_barrier_complete(bar, b.x, nloc, nx); b.st[0] = nloc; b.st[1] = nx; }
        const unsigned old = xb_add(&bar[XB_XSUB(b.x)], 1u);
        const unsigned gen = old / nloc;
        if (old + 1u == (gen + 1u) * nloc) {
            __builtin_amdgcn_fence(__ATOMIC_RELEASE, "agent");
            asm volatile("s_waitcnt vmcnt(0)" ::: "memory");
            const unsigned og = xb_add(&bar[XB_TOP], 1u);
            const unsigned tg = og / nx;
            if (og + 1u == (tg + 1u) * nx) xb_add(&bar[XB_TOPGEN], 1u);
            else XB_SPIN(xb_ld(&bar[XB_TOPGEN]) == tg, bar);
            __builtin_amdgcn_fence(__ATOMIC_ACQUIRE, "agent");
            xb_add(&bar[XB_XGEN(b.x)], 1u);
            asm volatile("s_waitcnt vmcnt(0)" ::: "memory");
        } else {
            XB_SPIN(xb_ld(&bar[XB_XGEN(b.x)]) == gen, bar);
            __builtin_amdgcn_fence(__ATOMIC_ACQUIRE, "agent");
            asm volatile("s_waitcnt vmcnt(0)" ::: "memory");
        }
    }
    __syncthreads();
}
constexpr int BATCH = 8, SEQ = 2048, M = BATCH * SEQ, D = 1024, NIN = 3448, NP = 3584;
constexpr float NORM_EPS = 1e-6f;
constexpr float LOG2E = 1.4426950408889634f;
constexpr size_t MiB = 1u << 20;
constexpr size_t WS_CTL = 0, CTL_ZERO_BYTES = 1 * MiB;
constexpr size_t WS_ROWSS = 1 * MiB;
constexpr size_t WS_WIN = 2 * MiB;
constexpr size_t WS_WOUT = 16 * MiB;
constexpr size_t WS_WSMALL = 20 * MiB;
constexpr size_t OFF_WUQ = 0, OFF_WUKV = 2 * 576 * 192 * 2, OFF_W2T = OFF_WUKV + 2 * 768 * 128 * 2, OFF_A2T = OFF_W2T + 2 * 2 * 256 * 64 * 2;
constexpr size_t WS_PSM = 22 * MiB;
constexpr size_t WS_CB = 24 * MiB;
constexpr size_t WS_PGATE = 25 * MiB;
constexpr size_t WS_PGDN = 57 * MiB;
constexpr size_t WS_PMLA = 93 * MiB;
constexpr size_t WS_PRW = 104 * MiB;
constexpr size_t WS_OGDN = 93 * MiB;
constexpr size_t WS_OMLA = 105 * MiB;
constexpr size_t WS_Y = 117 * MiB;
constexpr size_t WS_RS = 133 * MiB;
constexpr size_t WS_RD = 157 * MiB;
constexpr size_t WS_XB = 133 * MiB;
constexpr size_t WS_Q = 207 * MiB;
constexpr size_t WS_K = 225 * MiB;
constexpr size_t WS_VT = 243 * MiB;
constexpr size_t WS_MIX = 207 * MiB;
constexpr size_t WS_END = 255 * MiB;
constexpr int RS_REC = 384, RD_REC = 400;
constexpr size_t RD_DIR = (size_t)BATCH * 4 * SEQ * RD_REC;
constexpr int CW_BAR = 4096;
constexpr int CW_QUEUE = 16384;

constexpr int NWAVES = 8;
constexpr int RING_OFF = 0, RING_BYTES = 131072, LDSCTL_OFF = RING_BYTES, MISC_OFF = LDSCTL_OFF + 320, LDS_BYTES = 147456;
static_assert(pg8::TIDTAB_OFF == MISC_OFF + 512 && RING_OFF == 0, "LDS map");
constexpr int NPHASE = 12;

__device__ __forceinline__ float bf2f(bf16 v) { return __uint_as_float(((unsigned)v) << 16); }
__device__ __forceinline__ float wave_sum(float v) {
#pragma unroll
    for (int o = 1; o < 64; o <<= 1) v += __shfl_xor(v, o);
    return v;
}
__device__ __forceinline__ float siluf(float x) { return x * __builtin_amdgcn_rcpf(1.f + __expf(-x)); }
__device__ __forceinline__ float sigmoidf_(float x) { return __builtin_amdgcn_rcpf(1.f + __expf(-x)); }
__device__ __forceinline__ float softplusf_(float x) { return x > 20.f ? x : log1pf(__expf(x)); }

typedef float f32x2_t __attribute__((ext_vector_type(2))); typedef __bf16 bf16x2_t __attribute__((ext_vector_type(2)));
__device__ __forceinline__ unsigned cvt2bf(float lo, float hi) { const f32x2_t v = {lo, hi}; const bf16x2_t b = __builtin_convertvector(v, bf16x2_t); return __builtin_bit_cast(unsigned, b); }

struct Args { const void* in[24]; float* out; unsigned char* ws; int ph_lo, ph_hi; };

struct Frame {
    LAS unsigned char* lds;
    volatile LAS unsigned* MISC;
    gu32* ctl;
    int tid, lane, wave, vcu, G;
    unsigned char* ws;
    float* out;
    volatile LAS const unsigned long long* ptab;
};
__device__ __forceinline__ const void* inptr(const Frame& F, int k) {
    const unsigned long long v = F.ptab[k];
    const unsigned lo = __builtin_amdgcn_readfirstlane((unsigned)v), hi = __builtin_amdgcn_readfirstlane((unsigned)(v >> 32));
    return (const void*)(GAS const void*)(((unsigned long long)hi << 32) | lo);
}

__device__ __forceinline__ void tr_item(const float* W, int K, int ldsrc, int scol, int nvalid, bf16* WT, const float* gs, LAS float* scr, int kb, int lane) {
    const int k0 = 64 * kb;
#pragma unroll 8
    for (int i = 0; i < 32; ++i) { const int kk = 2 * i + (lane >> 5), n = lane & 31; float v = 0.f;
        if (n < nvalid) { v = W[(size_t)(k0 + kk) * ldsrc + scol + n]; if (gs) v *= gs[k0 + kk]; }
        scr[kk * 33 + n] = v; }
    LDS_WAIT(); asm volatile("" ::: "memory");
    const int c = lane & 7;
#pragma unroll
    for (int j = 0; j < 4; ++j) { const int n = (lane >> 3) + 8 * j; const LAS float* s = scr + (8 * c) * 33 + n;
        v4u o; o.x = pk2(s[0 * 33], s[1 * 33]); o.y = pk2(s[2 * 33], s[3 * 33]); o.z = pk2(s[4 * 33], s[5 * 33]); o.w = pk2(s[6 * 33], s[7 * 33]);
        *(GAS v4u*)(WT + (size_t)n * K + k0 + 8 * c) = o; }
    LDS_WAIT(); asm volatile("" ::: "memory");
}
__device__ __forceinline__ void p0_prologue(Frame& F) {
    LAS float* scr = (LAS float*)(F.lds + RING_OFF + F.wave * 16384);
    const int gw = F.vcu * NWAVES + F.wave, NGW = F.G * NWAVES;
    constexpr int I_IN = 112 * 16, I_OUT = 32 * 16, I_UQ = 18 * 3, I_UKV = 24 * 2, I_W2 = 16, I_A2 = 16, I_L = I_IN + I_OUT + I_UQ + I_UKV + I_W2 + I_A2;
    for (int it = gw; it < 2 * I_L; it += NGW) {
        const int l = it / I_L; int r = it % I_L;
        if (r < I_IN) { const int nb = r >> 4, kb = r & 15, n0 = 32 * nb; int scol, nv;
            if (n0 < 2176) { scol = n0; nv = 32; } else if (n0 < 3424) { scol = n0 + 24; nv = 32; } else if (n0 == 3424) { scol = 2176; nv = 24; } else { scol = 0; nv = 0; }
            tr_item((const float*)inptr(F, 3) + (size_t)l * D * NIN, D, NIN, scol, nv, (bf16*)(F.ws + WS_WIN) + ((size_t)l * NP + n0) * D, (const float*)inptr(F, 2) + l * D, scr, kb, F.lane); continue; }
        r -= I_IN;
        if (r < I_OUT) { const int nb = r >> 4, kb = r & 15;
            tr_item((const float*)inptr(F, 22) + (size_t)l * D * D, D, D, 32 * nb, 32, (bf16*)(F.ws + WS_WOUT) + ((size_t)l * D + 32 * nb) * D, nullptr, scr, kb, F.lane); continue; }
        r -= I_OUT;
        if (r < I_UQ) { const int nb = r / 3, kb = r % 3;
            tr_item((const float*)inptr(F, 9) + (size_t)l * 192 * 576, 192, 576, 32 * nb, 32, (bf16*)(F.ws + WS_WSMALL + OFF_WUQ) + ((size_t)l * 576 + 32 * nb) * 192, (const float*)inptr(F, 8) + l * 192, scr, kb, F.lane); continue; }
        r -= I_UQ;
        if (r < I_UKV) { const int nb = r >> 1, kb = r & 1;
            tr_item((const float*)inptr(F, 11) + (size_t)l * 128 * 768, 128, 768, 32 * nb, 32, (bf16*)(F.ws + WS_WSMALL + OFF_WUKV) + ((size_t)l * 768 + 32 * nb) * 128, (const float*)inptr(F, 10) + l * 128, scr, kb, F.lane); continue; }
        r -= I_UKV;
        if (r < I_W2) { const int e = r >> 3, nb = r & 7;
            tr_item((const float*)inptr(F, 14) + ((size_t)l * 2 + e) * 64 * 256, 64, 256, 32 * nb, 32, (bf16*)(F.ws + WS_WSMALL + OFF_W2T) + (((size_t)l * 2 + e) * 256 + 32 * nb) * 64, nullptr, scr, 0, F.lane); continue; }
        r -= I_W2;
        { const int e = r >> 3, nb = r & 7;
            tr_item((const float*)inptr(F, 16) + ((size_t)l * 2 + e) * 64 * 256, 64, 256, 32 * nb, 32, (bf16*)(F.ws + WS_WSMALL + OFF_A2T) + (((size_t)l * 2 + e) * 256 + 32 * nb) * 64, nullptr, scr, 0, F.lane); }
    }
    const float* x = (const float*)inptr(F, 0); bf16* xb = (bf16*)(F.ws + WS_XB); float* rowss = (float*)(F.ws + WS_ROWSS);
    for (int m = gw; m < M; m += NGW) {
        const GAS f32x4* xr = (const GAS f32x4*)(x + (size_t)m * D) + F.lane;
        GAS unsigned long long* o8 = (GAS unsigned long long*)(xb + (size_t)m * D) + F.lane; float s = 0.f;
#pragma unroll
        for (int j = 0; j < 4; ++j) { const f32x4 v = xr[64 * j]; s += (v.x * v.x + v.y * v.y) + (v.z * v.z + v.w * v.w);
            o8[64 * j] = (unsigned long long)pk2(v.x, v.y) | ((unsigned long long)pk2(v.z, v.w) << 32); }
        s = wave_sum(s);
        if (F.lane < 16) rowss[(size_t)m * 16 + F.lane] = F.lane == 0 ? s : 0.f;
    }
}
__device__ __forceinline__ void p5_final(Frame& F) {
    const int gw = F.vcu * NWAVES + F.wave, NGW = F.G * NWAVES;
    const float* rowss = (const float*)(F.ws + WS_ROWSS); const float* g = (const float*)inptr(F, 23);
    f32x4 gv[4];
#pragma unroll
    for (int j = 0; j < 4; ++j) gv[j] = ((const f32x4*)g)[F.lane + 64 * j];
    for (int m = gw; m < M; m += NGW) {
        float ss = F.lane < 16 ? rowss[(size_t)m * 16 + F.lane] : 0.f;
        ss = wave_sum(ss);
        const float rstd = rsqrtf(ss * (1.f / D) + NORM_EPS);
        GAS f32x4* xr = (GAS f32x4*)(F.out + (size_t)m * D) + F.lane;
#pragma unroll
        for (int j = 0; j < 4; ++j) { f32x4 v = xr[64 * j]; v = v * rstd * gv[j]; xr[64 * j] = v; }
    }
}
typedef float f32x16 __attribute__((ext_vector_type(16)));
typedef unsigned long long u64_t;
__device__ __forceinline__ bf16x8 mk_bf16x8(u64_t lo, u64_t hi) { typedef u64_t u64x2 __attribute__((ext_vector_type(2))); u64x2 v = {lo, hi}; return __builtin_bit_cast(bf16x8, v); }

constexpr int AT_KP = 208, AT_VP = 136, AT_KBYTES = 64 * AT_KP, AT_VBYTES = 64 * AT_VP, AT_BUF = AT_KBYTES + AT_VBYTES;
__device__ __forceinline__ float at_max3(float a, float b, float c) { float r; asm("v_max3_f32 %0, %1, %2, %3" : "=v"(r) : "v"(a), "v"(b), "v"(c)); return r; }
__device__ __forceinline__ void attn_unit(Frame& F, int unit) {
    const int bh = unit >> 3, qb = unit & 7, b = bh / 6, h = bh % 6;
    const int tid = F.tid, lane = F.lane, wave = F.wave, r32 = lane & 31, hi = lane >> 5;
    const bf16* Qg = (const bf16*)(F.ws + WS_Q) + ((size_t)bh * SEQ + qb * 256 + wave * 32 + r32) * 96;
    const bf16* Kg = (const bf16*)(F.ws + WS_K) + (size_t)bh * SEQ * 96;
    const bf16* Vg = (const bf16*)(F.ws + WS_VT) + (size_t)bh * 64 * SEQ;
    LAS unsigned char* lds = F.lds + RING_OFF;
    bf16x8 qf[6];
#pragma unroll
    for (int s = 0; s < 6; ++s) qf[s] = *(const bf16x8*)(Qg + 16 * s + 8 * hi);
    const int kr0 = tid / 12, kc0 = tid % 12, kr1 = (512 + tid) / 12, kc1 = (512 + tid) % 12, vd = tid >> 3, vc = tid & 7;
    const bool has1 = tid < 256;
    v4u ka0, ka1 = {0u, 0u, 0u, 0u}, va, kb0, kb1 = {0u, 0u, 0u, 0u}, vb;
#define AT_LOAD(K0, K1, V_, t0) do { K0 = *(const v4u*)(Kg + (size_t)((t0) + kr0) * 96 + kc0 * 8); if (has1) K1 = *(const v4u*)(Kg + (size_t)((t0) + kr1) * 96 + kc1 * 8); \
        V_ = *(const v4u*)(Vg + (size_t)vd * SEQ + (t0) + vc * 8); } while (0)
#define AT_STORE(K0, K1, V_, buf) do { LAS unsigned char* bb_ = lds + (buf) * AT_BUF; *(LAS v4u*)(bb_ + kr0 * AT_KP + kc0 * 16) = K0; if (has1) *(LAS v4u*)(bb_ + kr1 * AT_KP + kc1 * 16) = K1; \
        LAS u64_t* vp_ = (LAS u64_t*)(bb_ + AT_KBYTES + vd * AT_VP + vc * 16); vp_[0] = (u64_t)V_.x | ((u64_t)V_.y << 32); vp_[1] = (u64_t)V_.z | ((u64_t)V_.w << 32); } while (0)
    AT_LOAD(ka0, ka1, va, 0); AT_STORE(ka0, ka1, va, 0);
    AT_LOAD(ka0, ka1, va, 64);
    __syncthreads();
    f32x16 o0 = {}, o1 = {};
    float mrun = -1e30f, lsum = 0.f;
    constexpr int NT = SEQ / 64;
    auto tile = [&](int t) {
        LAS unsigned char* bb = lds + (t % 3) * AT_BUF;
        f32x16 p0 = {}, p1 = {};
        { const LAS unsigned char* kb = bb + r32 * AT_KP + hi * 16;
#pragma unroll
          for (int s = 0; s < 6; ++s) {
              const bf16x8 a0 = *(const LAS bf16x8*)(kb + 32 * s), a1 = *(const LAS bf16x8*)(kb + 32 * AT_KP + 32 * s);
              p0 = __builtin_amdgcn_mfma_f32_32x32x16_bf16(a0, qf[s], p0, 0, 0, 0);
              p1 = __builtin_amdgcn_mfma_f32_32x32x16_bf16(a1, qf[s], p1, 0, 0, 0); } }
        asm volatile("s_nop 15\n\ts_nop 7" : "+v"(p0), "+v"(p1));
        float ma = at_max3(p0[0], p0[1], p1[0]), mb = at_max3(p0[2], p0[3], p1[1]); ma = at_max3(ma, p1[2], p1[3]);
#pragma unroll
        for (int r = 4; r < 16; r += 4) { ma = at_max3(ma, p0[r], p0[r + 1]); mb = at_max3(mb, p0[r + 2], p0[r + 3]); ma = at_max3(ma, p1[r], p1[r + 1]); mb = at_max3(mb, p1[r + 2], p1[r + 3]); }
        float mloc = at_max3(ma, mb, mrun);
        { const auto rr = __builtin_amdgcn_permlane32_swap(__float_as_uint(mloc), __float_as_uint(mloc), false, false); mloc = at_max3(__uint_as_float(rr[0]), __uint_as_float(rr[1]), mloc); }
        const float mnew = mloc, alpha = __builtin_amdgcn_exp2f(mrun - mnew);
        mrun = mnew; lsum *= alpha;
#pragma unroll
        for (int r = 0; r < 16; ++r) { o0[r] *= alpha; o1[r] *= alpha; }
        float ps = 0.f;
#pragma unroll
        for (int r = 0; r < 16; ++r) { p0[r] = __builtin_amdgcn_exp2f(p0[r] - mnew); p1[r] = __builtin_amdgcn_exp2f(p1[r] - mnew); ps += p0[r] + p1[r]; }
        lsum += ps;
        v4u pk[4];
#pragma unroll
        for (int s2 = 0; s2 < 2; ++s2) {
            pk[s2] = (v4u){pg8::cvt_pk_bf16(p0[8 * s2], p0[8 * s2 + 1]), pg8::cvt_pk_bf16(p0[8 * s2 + 2], p0[8 * s2 + 3]), pg8::cvt_pk_bf16(p0[8 * s2 + 4], p0[8 * s2 + 5]), pg8::cvt_pk_bf16(p0[8 * s2 + 6], p0[8 * s2 + 7])};
            pk[2 + s2] = (v4u){pg8::cvt_pk_bf16(p1[8 * s2], p1[8 * s2 + 1]), pg8::cvt_pk_bf16(p1[8 * s2 + 2], p1[8 * s2 + 3]), pg8::cvt_pk_bf16(p1[8 * s2 + 4], p1[8 * s2 + 5]), pg8::cvt_pk_bf16(p1[8 * s2 + 6], p1[8 * s2 + 7])};
        }
        { const LAS unsigned char* vb_ = bb + AT_KBYTES + r32 * AT_VP + hi * 8;
#pragma unroll
          for (int ks = 0; ks < 4; ++ks) {
              const bf16x8 pb = __builtin_bit_cast(bf16x8, pk[ks]);
              const bf16x8 v0 = mk_bf16x8(*(const LAS u64_t*)(vb_ + ks * 32), *(const LAS u64_t*)(vb_ + ks * 32 + 16));
              const bf16x8 v1 = mk_bf16x8(*(const LAS u64_t*)(vb_ + 32 * AT_VP + ks * 32), *(const LAS u64_t*)(vb_ + 32 * AT_VP + ks * 32 + 16));
              o0 = __builtin_amdgcn_mfma_f32_32x32x16_bf16(v0, pb, o0, 0, 0, 0);
              o1 = __builtin_amdgcn_mfma_f32_32x32x16_bf16(v1, pb, o1, 0, 0, 0); } }
    };
    for (int t = 0; t < NT; t += 2) {
        if (t + 2 < NT) AT_LOAD(kb0, kb1, vb, (t + 2) * 64);
        tile(t);
        AT_STORE(ka0, ka1, va, (t + 1) % 3);
        __syncthreads();
        if (t + 3 < NT) AT_LOAD(ka0, ka1, va, (t + 3) * 64);
        tile(t + 1);
        if (t + 2 < NT) AT_STORE(kb0, kb1, vb, (t + 2) % 3);
        __syncthreads();
    }
#undef AT_LOAD
#undef AT_STORE
    lsum += __shfl_xor(lsum, 32);
    const float inv = 1.f / lsum;
    bf16* Og = (bf16*)(F.ws + WS_OMLA) + ((size_t)b * SEQ + qb * 256 + wave * 32 + r32) * 384 + h * 64 + 4 * hi;
#pragma unroll
    for (int rg = 0; rg < 4; ++rg) {
        *(u64_t*)(Og + 8 * rg) = (u64_t)pg8::cvt_pk_bf16(o0[4 * rg] * inv, o0[4 * rg + 1] * inv) | ((u64_t)pg8::cvt_pk_bf16(o0[4 * rg + 2] * inv, o0[4 * rg + 3] * inv) << 32);
        *(u64_t*)(Og + 32 + 8 * rg) = (u64_t)pg8::cvt_pk_bf16(o1[4 * rg] * inv, o1[4 * rg + 1] * inv) | ((u64_t)pg8::cvt_pk_bf16(o1[4 * rg + 2] * inv, o1[4 * rg + 3] * inv) << 32);
    }
}

constexpr int CW_FLAG = 32768;
__device__ __forceinline__ void partner_sync(Frame& F, gu32* mine, gu32* theirs) {
    asm volatile("s_waitcnt vmcnt(0)" ::: "memory");
    __syncthreads();
    if (F.tid == 0) {
        __builtin_amdgcn_fence(__ATOMIC_RELEASE, "agent");
        asm volatile("s_waitcnt vmcnt(0)" ::: "memory");
        __hip_atomic_store(mine, 1u, RLX_AGENT);
        unsigned spins = 0;
        while (__hip_atomic_load(theirs, RLX_AGENT) == 0u) { __builtin_amdgcn_s_sleep(4); if (++spins > (1u << 22)) break; }
        __builtin_amdgcn_fence(__ATOMIC_ACQUIRE, "agent");
        asm volatile("s_waitcnt vmcnt(0)" ::: "memory");
    }
    __syncthreads();
}
constexpr int RW_STEP = 1440, RW_CH = 32, RW_BUF = RW_CH * RW_STEP;
constexpr int RW_Y = 2 * RW_BUF;
static_assert(RW_Y + 2 * 4096 <= RING_BYTES, "RWKV LDS map");
__device__ __forceinline__ float dpp_xor1(float x) { return __builtin_bit_cast(float, __builtin_amdgcn_update_dpp(0, __builtin_bit_cast(int, x), 0xB1, 0xF, 0xF, true)); }
__device__ __forceinline__ float dpp_xor2(float x) { return __builtin_bit_cast(float, __builtin_amdgcn_update_dpp(0, __builtin_bit_cast(int, x), 0x4E, 0xF, 0xF, true)); }
__device__ __forceinline__ float dpp_hmir(float x) { return __builtin_bit_cast(float, __builtin_amdgcn_update_dpp(0, __builtin_bit_cast(int, x), 0x141, 0xF, 0xF, true)); }
__device__ __forceinline__ float dpp_rmir(float x) { return __builtin_bit_cast(float, __builtin_amdgcn_update_dpp(0, __builtin_bit_cast(int, x), 0x140, 0xF, 0xF, true)); }
template <int SKIP> __device__ __forceinline__ void rwkv_unit(Frame& F, int unit, gu32* flags) {
    const int bh = unit >> 2, rowhalf = (unit >> 1) & 1, dir = unit & 1, b = bh >> 2, h = bh & 3;
    const int tid = F.tid, lane = F.lane, ri = lane >> 4, cs = lane & 15, row = 4 * F.wave + ri;
    const bool stager = true;
    const unsigned char* Rs = F.ws + WS_RS + (size_t)bh * SEQ * RS_REC;
    const unsigned char* Rd = F.ws + WS_RD + dir * RD_DIR + (size_t)bh * SEQ * RD_REC;
    LAS unsigned char* lds = F.lds + RING_OFF;
    const int ss = tid >> 4, sp = tid & 15;
    u64_t g_kk = 0, g_r = 0, g_lam = 0, g_b = 0, g_k = 0, g_v = 0, g_s = 0;
#define RW_ISSUE(c_) do { const int n_ = (c_) * RW_CH + ss, t_ = dir ? SEQ - 1 - n_ : n_; const unsigned char* rs_ = Rs + (size_t)t_ * RS_REC; const unsigned char* rd_ = Rd + (size_t)t_ * RD_REC; \
        g_kk = *(const u64_t*)(rs_ + 8 * sp); g_r = *(const u64_t*)(rs_ + 256 + 8 * sp); g_lam = *(const u64_t*)(rd_ + 8 * sp); g_b = *(const u64_t*)(rd_ + 128 + 8 * sp); g_k = *(const u64_t*)(rd_ + 256 + 8 * sp); \
        if (sp < 8) g_v = *(const u64_t*)(rs_ + 128 + 64 * rowhalf + 8 * sp); if (sp == 8) g_s = *(const u64_t*)(rd_ + 384); } while (0)
#define RW_BF(x, j) __uint_as_float(((unsigned)((x) >> (16 * (j)))) << 16)
#define RW_STAGE(buf_) do { LAS unsigned char* d_ = lds + (buf_) * RW_BUF + ss * RW_STEP + 16 * sp; f32x4 w_, t4_; \
        w_[0] = __builtin_amdgcn_exp2f(-LOG2E * __half2float(__ushort_as_half((unsigned short)(g_lam)))); w_[1] = __builtin_amdgcn_exp2f(-LOG2E * __half2float(__ushort_as_half((unsigned short)(g_lam >> 16)))); \
        w_[2] = __builtin_amdgcn_exp2f(-LOG2E * __half2float(__ushort_as_half((unsigned short)(g_lam >> 32)))); w_[3] = __builtin_amdgcn_exp2f(-LOG2E * __half2float(__ushort_as_half((unsigned short)(g_lam >> 48)))); \
        *(LAS f32x4*)d_ = w_; \
        t4_ = (f32x4){RW_BF(g_r, 0), RW_BF(g_r, 1), RW_BF(g_r, 2), RW_BF(g_r, 3)}; *(LAS f32x4*)(d_ + 256) = w_ * t4_; \
        t4_ = (f32x4){RW_BF(g_kk, 0), RW_BF(g_kk, 1), RW_BF(g_kk, 2), RW_BF(g_kk, 3)}; *(LAS f32x4*)(d_ + 512) = -t4_; \
        t4_ = (f32x4){RW_BF(g_b, 0), RW_BF(g_b, 1), RW_BF(g_b, 2), RW_BF(g_b, 3)}; *(LAS f32x4*)(d_ + 768) = t4_; \
        t4_ = (f32x4){RW_BF(g_k, 0), RW_BF(g_k, 1), RW_BF(g_k, 2), RW_BF(g_k, 3)}; *(LAS f32x4*)(d_ + 1024) = t4_; \
        if (sp < 8) { t4_ = (f32x4){RW_BF(g_v, 0), RW_BF(g_v, 1), RW_BF(g_v, 2), RW_BF(g_v, 3)}; *(LAS f32x4*)(d_ + 1280) = t4_; } \
        if (sp == 8) *(LAS u64_t*)(lds + (buf_) * RW_BUF + ss * RW_STEP + 1408) = g_s; } while (0)
    f32x4 S0 = {0.f, 0.f, 0.f, 0.f};
    if (stager) { RW_ISSUE(0); RW_STAGE(0); }
    __syncthreads();
    bf16* Yg = (bf16*)(F.ws + WS_Y) + (size_t)b * SEQ * 256 + h * 64 + 32 * rowhalf;
    const int NCH = SEQ / RW_CH;
    for (int c = 0; c < NCH; ++c) {
        LAS float* ybuf = (LAS float*)(lds + RW_Y + (c & 1) * 4096);
        if (stager && c + 1 < NCH) RW_ISSUE(c + 1);
        unsigned short yold[2] = {0, 0};
        if (c >= NCH / 2) {
#pragma unroll
            for (int k = 0; k < 2; ++k) { const int o = tid + 512 * k, n = c * RW_CH + (o >> 5), t = dir ? SEQ - 1 - n : n; yold[k] = Yg[(size_t)t * 256 + (o & 31)]; } }
        { const LAS unsigned char* cb_ = lds + (c & 1) * RW_BUF + 16 * cs;
          const LAS unsigned char* vb_ = lds + (c & 1) * RW_BUF + 1280 + 4 * row;
#pragma unroll 8
          for (int s = 0; s < RW_CH; ++s) {
              const LAS unsigned char* p = cb_ + ((SKIP & 2) ? 0 : s) * RW_STEP;
              const f32x4 w = *(const LAS f32x4*)p, wr = *(const LAS f32x4*)(p + 256), nk = *(const LAS f32x4*)(p + 512), bb = *(const LAS f32x4*)(p + 768), kv = *(const LAS f32x4*)(p + 1024);
              typedef float f2 __attribute__((ext_vector_type(2)));
              const float v = *(const LAS float*)(vb_ + s * RW_STEP); const f2 brkr = *(const LAS f2*)(lds + (c & 1) * RW_BUF + s * RW_STEP + 1408);
              float sa0 = (S0[0] * nk[0] + S0[1] * nk[1]) + (S0[2] * nk[2] + S0[3] * nk[3]);
              float ym0 = (S0[0] * wr[0] + S0[1] * wr[1]) + (S0[2] * wr[2] + S0[3] * wr[3]);
              if (!(SKIP & 1)) {
              sa0 += dpp_xor1(sa0); ym0 += dpp_xor1(ym0);
              sa0 += dpp_xor2(sa0); ym0 += dpp_xor2(ym0);
              sa0 += dpp_hmir(sa0); ym0 += dpp_hmir(ym0);
              sa0 += dpp_rmir(sa0); ym0 += dpp_rmir(ym0); }
              S0 = S0 * w + (sa0 * bb + v * kv);
              if (cs == 0) ybuf[s * 32 + row] = ym0 + sa0 * brkr[0] + v * brkr[1];
          } }
        if (stager && c + 1 < NCH) RW_STAGE((c + 1) & 1);
        __syncthreads();
#pragma unroll
        for (int k = 0; k < 2; ++k) { const int o = tid + 512 * k, n = c * RW_CH + (o >> 5), t = dir ? SEQ - 1 - n : n;
            float y = ybuf[o]; if (c >= NCH / 2) y += bf2f(yold[k]);
            Yg[(size_t)t * 256 + (o & 31)] = (bf16)f2bf(y); }
        if (c == NCH / 2 - 1) partner_sync(F, flags + 64 * unit, flags + 64 * (unit ^ 1));
    }
#undef RW_ISSUE
#undef RW_STAGE
#undef RW_BF
    __syncthreads();
}

constexpr int GP = 144;
constexpr int G_Q = 0, G_K = 9216, G_V = 18432, G_KT = 27648, G_P = 36864, G_A = 46080, G_SM = 63488, G_GROUP = 64512;
constexpr int G_T = 92160;
constexpr int G_RAW = 65536;
constexpr int G_CW = 133120;
static_assert(2 * G_GROUP <= RING_BYTES && G_CW + 3840 <= LDS_BYTES && G_CW >= MISC_OFF + 1024, "GDN LDS map");
__device__ __forceinline__ bf16x8 ld2x8(const LAS unsigned char* p) { return mk_bf16x8(*(const LAS u64_t*)p, *(const LAS u64_t*)(p + 32)); }
__device__ __forceinline__ bf16x8 pack_acc(const f32x4& a, const f32x4& b) {
    v4u w; w.x = pg8::cvt_pk_bf16(a[0], a[1]); w.y = pg8::cvt_pk_bf16(a[2], a[3]); w.z = pg8::cvt_pk_bf16(b[0], b[1]); w.w = pg8::cvt_pk_bf16(b[2], b[3]); return __builtin_bit_cast(bf16x8, w); }
__device__ __forceinline__ void split_acc(const f32x4& a, const f32x4& b, bf16x8& hi, bf16x8& lo) {
    v4u wh; wh.x = cvt2bf(a[0], a[1]); wh.y = cvt2bf(a[2], a[3]); wh.z = cvt2bf(b[0], b[1]); wh.w = cvt2bf(b[2], b[3]);
    f32x4 ra, rb;
    ra[0] = a[0] - __uint_as_float(wh.x << 16); ra[1] = a[1] - __uint_as_float(wh.x & 0xffff0000u); ra[2] = a[2] - __uint_as_float(wh.y << 16); ra[3] = a[3] - __uint_as_float(wh.y & 0xffff0000u);
    rb[0] = b[0] - __uint_as_float(wh.z << 16); rb[1] = b[1] - __uint_as_float(wh.z & 0xffff0000u); rb[2] = b[2] - __uint_as_float(wh.w << 16); rb[3] = b[3] - __uint_as_float(wh.w & 0xffff0000u);
    hi = __builtin_bit_cast(bf16x8, wh); lo = pack_acc(ra, rb);
}
__device__ __forceinline__ void hilo4(const f32x4& a, u64_t& hi, u64_t& lo) {
    const unsigned h0 = cvt2bf(a[0], a[1]), h1 = cvt2bf(a[2], a[3]);
    const float r0 = a[0] - __uint_as_float(h0 << 16), r1 = a[1] - __uint_as_float(h0 & 0xffff0000u), r2 = a[2] - __uint_as_float(h1 << 16), r3 = a[3] - __uint_as_float(h1 & 0xffff0000u);
    hi = (u64_t)h0 | ((u64_t)h1 << 32); lo = (u64_t)cvt2bf(r0, r1) | ((u64_t)cvt2bf(r2, r3) << 32);
}
typedef _Float16 f16x8 __attribute__((ext_vector_type(8)));
typedef _Float16 h4_t __attribute__((ext_vector_type(4)));
__device__ __forceinline__ f16x8 pack_acc_f16(const f32x4& a, const f32x4& b) { return (f16x8){(_Float16)a[0], (_Float16)a[1], (_Float16)a[2], (_Float16)a[3], (_Float16)b[0], (_Float16)b[1], (_Float16)b[2], (_Float16)b[3]}; }
template <int SKIP> __device__ __forceinline__ void gdn_unit3(Frame& F, int l, int unit, gu32* flags) {
    const int bh = unit >> 1, dir = unit & 1, b = bh / 6, h = bh % 6;
    const int tid = F.tid, lane = F.lane, wave = F.wave;
    const bf16* Pgdn = (const bf16*)(F.ws + WS_PGDN) + (size_t)b * SEQ * 1152 + h * 64; const float* Psm = (const float*)(F.ws + WS_PSM) + (size_t)b * SEQ * 32;
    bf16* Og = (SKIP & 128) ? (bf16*)(F.ws + WS_Y + 8 * MiB) + (size_t)(b % 5) * SEQ * 384 + h * 64 : (bf16*)(F.ws + WS_OGDN) + (size_t)b * SEQ * 384 + h * 64;
    LAS unsigned char* gb = F.lds + RING_OFF;
    LAS float* cwl = (LAS float*)(F.lds + G_CW);
    LAS float* sm = (LAS float*)(gb + G_SM);
    { const float* conv_w = (const float*)inptr(F, 4) + (size_t)l * 5 * 1152;
      for (int i = tid; i < 960; i += 512) { const int tn = i / 320, tap = (i % 320) / 64, ch = i % 64; cwl[i] = conv_w[tap * 1152 + tn * 384 + h * 64 + ch]; } }
    const float al = -__expf(((const float*)inptr(F, 5))[l * 12 + dir * 6 + h]), dtb = ((const float*)inptr(F, 6))[l * 12 + dir * 6 + h];
    f32x4 Sacc[4];
#pragma unroll
    for (int i = 0; i < 4; ++i) Sacc[i] = (f32x4){0.f, 0.f, 0.f, 0.f};
    const int ci = tid >> 3, cg = tid & 7;
#define GDN_RAW_STAGE(cc_, first_, nthr_) do { const int tlo_ = (dir ? SEQ - 64 * (cc_) - 64 : 64 * (cc_)) - 2; \
        for (int pc_ = (first_); pc_ < 68 * 24; pc_ += (nthr_)) { const int rr_ = pc_ / 24, sg_ = pc_ % 24, tt_ = tlo_ + rr_; v4u x_ = {0u, 0u, 0u, 0u}; \
            if (!(SKIP & 1) && tt_ >= 0 && tt_ < SEQ) x_ = *(const v4u*)(Pgdn + (size_t)tt_ * 1152 + (sg_ >> 3) * 384 + 8 * (sg_ & 7)); \
            *(LAS v4u*)(gb + G_RAW + rr_ * 384 + 16 * sg_) = x_; } } while (0)
#define GDN_WRITEOUT(cc_) do { if (!(SKIP & 4)) { const int t_ = dir ? SEQ - 1 - 64 * (cc_) - ci : 64 * (cc_) + ci; bf16* op_ = Og + (size_t)t_ * 384 + 8 * cg; \
            const LAS f32x4* src_ = (const LAS f32x4*)(gb + G_A + (ci * 68 + 8 * cg) * 4); f32x4 o0_ = src_[0], o1_ = src_[1]; \
            if ((cc_) >= SEQ / 128) { const v4u p0_ = *(const v4u*)op_; \
                o0_ += (f32x4){__uint_as_float(p0_.x << 16), __uint_as_float(p0_.x & 0xffff0000u), __uint_as_float(p0_.y << 16), __uint_as_float(p0_.y & 0xffff0000u)}; \
                o1_ += (f32x4){__uint_as_float(p0_.z << 16), __uint_as_float(p0_.z & 0xffff0000u), __uint_as_float(p0_.w << 16), __uint_as_float(p0_.w & 0xffff0000u)}; } \
            v4u w0_; w0_.x = pg8::cvt_pk_bf16(o0_[0], o0_[1]); w0_.y = pg8::cvt_pk_bf16(o0_[2], o0_[3]); w0_.z = pg8::cvt_pk_bf16(o1_[0], o1_[1]); w0_.w = pg8::cvt_pk_bf16(o1_[2], o1_[3]); \
            *(v4u*)op_ = w0_; } } while (0)
    GDN_RAW_STAGE(0, tid, 512);
    __syncthreads();
    for (int c = 0; c < SEQ / 64; ++c) {
        if (c > 0) GDN_WRITEOUT(c - 1);
        if (c == SEQ / 128) partner_sync(F, flags + 64 * unit, flags + 64 * (unit ^ 1));
        if (!(SKIP & 64) && wave == 0) {
            const int t = dir ? SEQ - 1 - 64 * c - lane : 64 * c + lane;
            const float a = Psm[(size_t)t * 32 + dir * 6 + h], bt = Psm[(size_t)t * 32 + 12 + dir * 6 + h];
            float x = al * softplusf_(a + dtb);
#pragma unroll
            for (int off = 1; off < 64; off <<= 1) { const float y = __shfl_up(x, off); if (lane >= off) x += y; }
            const float last = __shfl(x, 63);
            sm[lane] = x; sm[64 + lane] = sigmoidf_(bt); sm[128 + lane] = __expf(x); sm[192 + lane] = __expf(last - x);
        }
        if (!(SKIP & 16)) { float acc[3][8];
#pragma unroll
          for (int tn = 0; tn < 3; ++tn)
#pragma unroll
              for (int j = 0; j < 8; ++j) acc[tn][j] = 0.f;
          const int rr0 = dir ? 63 - ci : ci;
#pragma unroll
          for (int tap = 0; tap < 5; ++tap) {
#pragma unroll
              for (int tn = 0; tn < 3; ++tn) { const v4u x0 = *(const LAS v4u*)(gb + G_RAW + (rr0 + tap) * 384 + tn * 128 + 16 * cg); const LAS float* w = cwl + tn * 320 + tap * 64 + 8 * cg; const f32x4 w0 = *(const LAS f32x4*)w, w1 = *(const LAS f32x4*)(w + 4);
                  acc[tn][0] += w0[0] * __uint_as_float(x0[0] << 16); acc[tn][1] += w0[1] * __uint_as_float(x0[0] & 0xffff0000u); acc[tn][2] += w0[2] * __uint_as_float(x0[1] << 16); acc[tn][3] += w0[3] * __uint_as_float(x0[1] & 0xffff0000u);
                  acc[tn][4] += w1[0] * __uint_as_float(x0[2] << 16); acc[tn][5] += w1[1] * __uint_as_float(x0[2] & 0xffff0000u); acc[tn][6] += w1[2] * __uint_as_float(x0[3] << 16); acc[tn][7] += w1[3] * __uint_as_float(x0[3] & 0xffff0000u); }
              asm volatile("" ::: "memory"); }
          float sq = 0.f, sk = 0.f;
#pragma unroll
          for (int j = 0; j < 8; ++j) { acc[0][j] = siluf(acc[0][j]); acc[1][j] = siluf(acc[1][j]); acc[2][j] = siluf(acc[2][j]); sq += acc[0][j] * acc[0][j]; sk += acc[1][j] * acc[1][j]; }
          sq += dpp_xor1(sq); sk += dpp_xor1(sk); sq += dpp_xor2(sq); sk += dpp_xor2(sk); sq += dpp_hmir(sq); sk += dpp_hmir(sk);
          const float rq = rsqrtf(sq + 1e-6f) * 0.125f, rk = rsqrtf(sk + 1e-6f);
          v4u wq, wk, wv;
#pragma unroll
          for (int q = 0; q < 4; ++q) { wq[q] = pg8::cvt_pk_bf16(acc[0][2 * q] * rq, acc[0][2 * q + 1] * rq); wk[q] = pg8::cvt_pk_bf16(acc[1][2 * q] * rk, acc[1][2 * q + 1] * rk); wv[q] = pg8::cvt_pk_bf16(acc[2][2 * q], acc[2][2 * q + 1]); }
          LAS unsigned char* row = gb + ci * GP + 16 * cg;
          *(LAS v4u*)(row + G_Q) = wq; *(LAS v4u*)(row + G_K) = wk; *(LAS v4u*)(row + G_V) = wv;
#pragma unroll
          for (int j = 0; j < 8; ++j) *(LAS bf16*)(gb + G_KT + (8 * cg + j) * GP + 2 * ci) = (bf16)((j & 1) ? (wk[j >> 1] >> 16) : (wk[j >> 1] & 0xffffu)); }
        __syncthreads();
        if (!(SKIP & 32)) { const int ti = (wave >> 1) & 1, tj = wave & 1, r32 = lane & 31, hi = lane >> 5;
          f32x16 acc = {};
          const LAS unsigned char* ir = gb + (wave >= 4 ? G_Q : G_K) + (32 * ti + r32) * GP + 16 * hi; const LAS unsigned char* jr = gb + G_K + (32 * tj + r32) * GP + 16 * hi;
#pragma unroll
          for (int s = 0; s < 4; ++s) acc = __builtin_amdgcn_mfma_f32_32x32x16_bf16(*(const LAS bf16x8*)(jr + 32 * s), *(const LAS bf16x8*)(ir + 32 * s), acc, 0, 0, 0);
          const int i = 32 * ti + r32; const float ci = sm[i];
          if (wave < 4) { const float bi = sm[64 + i];
#pragma unroll
              for (int g = 0; g < 4; ++g) { const int j0 = 32 * tj + 8 * g + 4 * hi; const f32x4 cj = *(const LAS f32x4*)(sm + j0); f32x4 o;
#pragma unroll
                  for (int r = 0; r < 4; ++r) o[r] = (i > j0 + r) ? bi * acc[4 * g + r] * __expf(fminf(ci - cj[r], 0.f)) : 0.f;
                  *(LAS f32x4*)((LAS float*)(gb + G_A) + i * 68 + j0) = o; } }
          else {
#pragma unroll
              for (int g = 0; g < 4; ++g) { const int j0 = 32 * tj + 8 * g + 4 * hi; const f32x4 cj = *(const LAS f32x4*)(sm + j0); h4_t o;
#pragma unroll
                  for (int r = 0; r < 4; ++r) o[r] = (_Float16)((i >= j0 + r) ? acc[4 * g + r] * __expf(fminf(ci - cj[r], 0.f)) : 0.f);
                  *(LAS h4_t*)(gb + G_P + i * GP + 2 * j0) = o; } } }
        __syncthreads();
        if (!(SKIP & 2) && wave == 0) {
            const int bb = lane >> 4, cc = lane & 15; float T[16];
            const LAS float* Ab = (const LAS float*)(gb + G_A) + (16 * bb) * 68 + 16 * bb;
#pragma unroll
            for (int i = 0; i < 16; ++i) { float a0 = 0.f, a1 = 0.f;
#pragma unroll
                for (int j4 = 0; j4 < (i + 3) / 4; ++j4) { const f32x4 av = *(const LAS f32x4*)(Ab + i * 68 + 4 * j4);
                    a0 += av.x * T[4 * j4] + av.z * T[4 * j4 + 2]; a1 += av.y * T[4 * j4 + 1] + av.w * T[4 * j4 + 3]; }
                T[i] = (i == cc ? 1.f : 0.f) - (a0 + a1);
                if (i < 15 && (i & 3) == 3) asm volatile("" ::: "memory");
                if (i == 0) {
#pragma unroll
                    for (int k = 1; k < 16; ++k) T[k] = 0.f; } }
#pragma unroll
            for (int i = 0; i < 16; ++i) ((LAS float*)(gb + G_T))[(16 * bb + i) * 16 + cc] = T[i];
        }
        __syncthreads();
        f32x4 Xc[4];
#pragma unroll
        for (int g = 0; g < 4; ++g) Xc[g] = (f32x4){0.f, 0.f, 0.f, 0.f};
        if (!(SKIP & 2)) {
            const int col = lane & 15, q4 = lane >> 4, c = 16 * wave + col;
            const LAS unsigned char* src = gb + (c < 64 ? G_V : G_K) + 2 * (c & 63);
            u64_t xh[4], xl[4];
#pragma unroll
            for (int bk = 0; bk < 4; ++bk) {
                f32x4 Y; const f32x4 be = *(const LAS f32x4*)(sm + 64 + 16 * bk + 4 * q4), ga = *(const LAS f32x4*)(sm + 128 + 16 * bk + 4 * q4);
#pragma unroll
                for (int r = 0; r < 4; ++r) Y[r] = bf2f(*(const LAS bf16*)(src + (16 * bk + 4 * q4 + r) * GP)) * be[r] * (c < 64 ? 1.f : ga[r]);
#pragma unroll
                for (int b2 = 0; b2 < bk; b2 += 2) {
                    const LAS float* ar = (const LAS float*)(gb + G_A) + (16 * bk + col) * 68 + 16 * b2 + 4 * q4;
                    f32x4 a0 = -*(const LAS f32x4*)ar, a1 = (b2 + 1 < bk) ? -*(const LAS f32x4*)(ar + 16) : (f32x4){0.f, 0.f, 0.f, 0.f};
                    u64_t ah0, al0, ah1, al1; hilo4(a0, ah0, al0); hilo4(a1, ah1, al1);
                    const u64_t bh1 = (b2 + 1 < bk) ? xh[b2 + 1] : 0ull, bl1 = (b2 + 1 < bk) ? xl[b2 + 1] : 0ull;
                    const bf16x8 Ah = mk_bf16x8(ah0, ah1), Al = mk_bf16x8(al0, al1), Bh = mk_bf16x8(xh[b2], bh1), Bl = mk_bf16x8(xl[b2], bl1);
                    Y = __builtin_amdgcn_mfma_f32_16x16x32_bf16(Al, Bh, Y, 0, 0, 0);
                    Y = __builtin_amdgcn_mfma_f32_16x16x32_bf16(Ah, Bl, Y, 0, 0, 0);
                    Y = __builtin_amdgcn_mfma_f32_16x16x32_bf16(Ah, Bh, Y, 0, 0, 0); }
                { const f32x4 t0 = *(const LAS f32x4*)((const LAS float*)(gb + G_T) + (16 * bk + col) * 16 + 4 * q4);
                  u64_t th, tl, yh, yl; hilo4(t0, th, tl); hilo4(Y, yh, yl);
                  const bf16x8 Ah = mk_bf16x8(th, 0ull), Al = mk_bf16x8(tl, 0ull), Bh = mk_bf16x8(yh, 0ull), Bl = mk_bf16x8(yl, 0ull);
                  f32x4 X = {0.f, 0.f, 0.f, 0.f};
                  X = __builtin_amdgcn_mfma_f32_16x16x32_bf16(Al, Bh, X, 0, 0, 0);
                  X = __builtin_amdgcn_mfma_f32_16x16x32_bf16(Ah, Bl, X, 0, 0, 0);
                  X = __builtin_amdgcn_mfma_f32_16x16x32_bf16(Ah, Bh, X, 0, 0, 0);
                  Xc[bk] = X; hilo4(X, xh[bk], xl[bk]); }
            }
        }
        __syncthreads();
        { const int col = lane & 15, q4 = lane >> 4, c = 16 * wave + col;
          if (wave < 4) {
#pragma unroll
              for (int g = 0; g < 4; ++g)
#pragma unroll
                  for (int r = 0; r < 4; ++r) ((LAS float*)(gb + G_A))[(16 * g + 4 * q4 + r) * 68 + c] = Xc[g][r];
          } else {
#pragma unroll
              for (int g = 0; g < 4; ++g)
#pragma unroll
                  for (int r = 0; r < 4; ++r) { const int i = 16 * g + 4 * q4 + r; const float x = -Xc[g][r]; const unsigned hb = f2bf(x);
                      *(LAS bf16*)(gb + G_V + i * GP + 2 * (c - 64)) = (bf16)hb;
                      *(LAS bf16*)(gb + G_K + i * GP + 2 * (c - 64)) = (bf16)f2bf(x - __uint_as_float(hb << 16)); }
          } }
        __syncthreads();
        if ((SKIP & 8) && wave < 4) {} else
        if (wave < 4) { const int col = lane & 15, q4 = lane >> 4, e = 16 * wave + col;
          bf16x8 bS0, bS1, bS0l, bS1l; split_acc(Sacc[0], Sacc[1], bS0, bS0l); split_acc(Sacc[2], Sacc[3], bS1, bS1l);
          f32x4 U[4], T1[4];
          const LAS unsigned char* rowa = gb + col * GP + 8 * q4;
#pragma unroll
          for (int it = 0; it < 4; ++it) {
              const LAS float* u0p = (const LAS float*)(gb + G_A) + (16 * it + 4 * q4) * 68 + e;
              U[it] = (f32x4){u0p[0], u0p[68], u0p[136], u0p[204]};
              const LAS unsigned char* ra = rowa + 16 * it * GP;
              const bf16x8 wh0 = ld2x8(ra + G_V), wh1 = ld2x8(ra + G_V + 64), wl0 = ld2x8(ra + G_K), wl1 = ld2x8(ra + G_K + 64), qa0 = ld2x8(ra + G_Q), qa1 = ld2x8(ra + G_Q + 64);
              U[it] = __builtin_amdgcn_mfma_f32_16x16x32_bf16(wl0, bS0, U[it], 0, 0, 0);
              U[it] = __builtin_amdgcn_mfma_f32_16x16x32_bf16(wl1, bS1, U[it], 0, 0, 0);
              U[it] = __builtin_amdgcn_mfma_f32_16x16x32_bf16(wh0, bS0l, U[it], 0, 0, 0);
              U[it] = __builtin_amdgcn_mfma_f32_16x16x32_bf16(wh1, bS1l, U[it], 0, 0, 0);
              U[it] = __builtin_amdgcn_mfma_f32_16x16x32_bf16(wh0, bS0, U[it], 0, 0, 0);
              U[it] = __builtin_amdgcn_mfma_f32_16x16x32_bf16(wh1, bS1, U[it], 0, 0, 0);
              T1[it] = __builtin_amdgcn_mfma_f32_16x16x32_bf16(qa0, bS0l, (f32x4){0.f, 0.f, 0.f, 0.f}, 0, 0, 0);
              T1[it] = __builtin_amdgcn_mfma_f32_16x16x32_bf16(qa1, bS1l, T1[it], 0, 0, 0);
              T1[it] = __builtin_amdgcn_mfma_f32_16x16x32_bf16(qa0, bS0, T1[it], 0, 0, 0);
              T1[it] = __builtin_amdgcn_mfma_f32_16x16x32_bf16(qa1, bS1, T1[it], 0, 0, 0);
              asm volatile("" ::: "memory");
          }
          const f16x8 hU0 = pack_acc_f16(U[0], U[1]), hU1 = pack_acc_f16(U[2], U[3]);
          f32x4 Ud[4];
#pragma unroll
          for (int it = 0; it < 4; ++it) { const f32x4 dc = *(const LAS f32x4*)(sm + 192 + 16 * it + 4 * q4); Ud[it] = U[it] * dc; }
          bf16x8 bD0, bD1, bD0l, bD1l; split_acc(Ud[0], Ud[1], bD0, bD0l); split_acc(Ud[2], Ud[3], bD1, bD1l);
          const float gend = sm[191];
#pragma unroll
          for (int it = 0; it < 4; ++it) {
              const LAS unsigned char* ra = rowa + 16 * it * GP;
              const f32x4 gm = *(const LAS f32x4*)(sm + 128 + 16 * it + 4 * q4);
              const bf16x8 pa0 = ld2x8(ra + G_P), pa1 = ld2x8(ra + G_P + 64), ka0 = ld2x8(ra + G_KT), ka1 = ld2x8(ra + G_KT + 64);
              f32x4 O = T1[it] * gm;
              O = __builtin_amdgcn_mfma_f32_16x16x32_f16(__builtin_bit_cast(f16x8, pa0), hU0, O, 0, 0, 0);
              O = __builtin_amdgcn_mfma_f32_16x16x32_f16(__builtin_bit_cast(f16x8, pa1), hU1, O, 0, 0, 0);
              f32x4 Sn = Sacc[it] * gend;
              Sn = __builtin_amdgcn_mfma_f32_16x16x32_bf16(ka0, bD0l, Sn, 0, 0, 0);
              Sn = __builtin_amdgcn_mfma_f32_16x16x32_bf16(ka1, bD1l, Sn, 0, 0, 0);
              Sn = __builtin_amdgcn_mfma_f32_16x16x32_bf16(ka0, bD0, Sn, 0, 0, 0);
              Sn = __builtin_amdgcn_mfma_f32_16x16x32_bf16(ka1, bD1, Sn, 0, 0, 0);
              Sacc[it] = Sn;
#pragma unroll
              for (int r = 0; r < 4; ++r) ((LAS float*)(gb + G_A))[(16 * it + 4 * q4 + r) * 68 + e] = O[r];
              asm volatile("" ::: "memory");
          } }
        else if (c + 1 < SEQ / 64) GDN_RAW_STAGE(c + 1, tid - 256, 256);
        __syncthreads();
    }
    GDN_WRITEOUT(SEQ / 64 - 1);
#undef GDN_WRITEOUT
#undef GDN_RAW_STAGE
    __syncthreads();
}

constexpr int RC_AT = 0, RC_RT = 9216, RC_BT = 18432, RC_KT = 27648, RC_BH = 36864, RC_KH = 46080, RC_VT = 55296, RC_V = 64512, RC_A = 73728  ,
              RC_AK = 91136, RC_RB = 100352, RC_RK = 109568, RC_T = 118784  , RC_SM = 122880  , RC_R2 = RC_BT  ;
static_assert(RC_SM + 256 <= RING_BYTES && RC_R2 + 17408 <= RC_BH, "chunked RWKV LDS map");
template <int SK> __device__ __forceinline__ void rwkv_unit_c(Frame& F, int unit, gu32* flags) {
    const int bh = unit >> 1, dir = unit & 1, b = bh >> 2, h = bh & 3;
    const int tid = F.tid, lane = F.lane, wave = F.wave;
    const unsigned char* Rs = F.ws + WS_RS + (size_t)bh * SEQ * RS_REC;
    const unsigned char* Rd = F.ws + WS_RD + dir * RD_DIR + (size_t)bh * SEQ * RD_REC;
    bf16* Yg = (bf16*)(F.ws + WS_Y + (SK ? 8 * MiB : 0)) + (size_t)b * SEQ * 256 + h * 64;
    LAS unsigned char* gb = F.lds + RING_OFF;
    LAS float* gamT = (LAS float*)(gb + RC_SM);
    f32x4 Zacc[4];
#pragma unroll
    for (int i = 0; i < 4; ++i) Zacc[i] = (f32x4){0.f, 0.f, 0.f, 0.f};
    const int ci = tid >> 3, cg = tid & 7;
#define RC_WRITEOUT(cc_) do { const int t_ = dir ? SEQ - 1 - 64 * (cc_) - ci : 64 * (cc_) + ci; bf16* op_ = Yg + (size_t)t_ * 256 + 8 * cg; \
        const LAS f32x4* src_ = (const LAS f32x4*)(gb + RC_A + (ci * 68 + 8 * cg) * 4); f32x4 o0_ = src_[0], o1_ = src_[1]; \
        if ((cc_) >= SEQ / 128) { const v4u p0_ = *(const v4u*)op_; \
            o0_ += (f32x4){__uint_as_float(p0_.x << 16), __uint_as_float(p0_.x & 0xffff0000u), __uint_as_float(p0_.y << 16), __uint_as_float(p0_.y & 0xffff0000u)}; \
            o1_ += (f32x4){__uint_as_float(p0_.z << 16), __uint_as_float(p0_.z & 0xffff0000u), __uint_as_float(p0_.w << 16), __uint_as_float(p0_.w & 0xffff0000u)}; } \
        v4u w0_; w0_.x = pg8::cvt_pk_bf16(o0_[0], o0_[1]); w0_.y = pg8::cvt_pk_bf16(o0_[2], o0_[3]); w0_.z = pg8::cvt_pk_bf16(o1_[0], o1_[1]); w0_.w = pg8::cvt_pk_bf16(o1_[2], o1_[3]); \
        *(v4u*)op_ = w0_; } while (0)
    __syncthreads();
    for (int c = 0; c < SEQ / 64; ++c) {
        if (c > 0) RC_WRITEOUT(c - 1);
        if (c == SEQ / 128) partner_sync(F, flags + 64 * unit, flags + 64 * (unit ^ 1));
        if (!(SK & 32)) { const int t = lane, tok = dir ? SEQ - 1 - 64 * c - t : 64 * c + t, j0 = 8 * wave;
          const unsigned char* rs = Rs + (size_t)tok * RS_REC + 2 * j0; const unsigned char* rd = Rd + (size_t)tok * RD_REC + 2 * j0;
          v4u gkk = {0u, 0u, 0u, 0u}, gv = gkk, gr = gkk, glam = gkk, gbv = gkk, gk = gkk;
          if (!(SK & 1)) { gkk = *(const v4u*)rs; gv = *(const v4u*)(rs + 128); gr = *(const v4u*)(rs + 256); glam = *(const v4u*)rd; gbv = *(const v4u*)(rd + 128); gk = *(const v4u*)(rd + 256); }
          else asm volatile("" : "+v"(gkk), "+v"(gv), "+v"(gr), "+v"(glam), "+v"(gbv), "+v"(gk));
          float lam[8], cum[8];
#pragma unroll
          for (int q = 0; q < 4; ++q) { lam[2 * q] = __half2float(__ushort_as_half((unsigned short)(glam[q] & 0xffffu))); lam[2 * q + 1] = __half2float(__ushort_as_half((unsigned short)(glam[q] >> 16))); }
#pragma unroll
          for (int q = 0; q < 8; ++q) { float x = lam[q];
#pragma unroll
              for (int off = 1; off < 64; off <<= 1) { const float y = __shfl_up(x, off); if (lane >= off) x += y; }
              cum[q] = x; }
          v4u wa = {0u, 0u, 0u, 0u}, wr = {0u, 0u, 0u, 0u}, wb = {0u, 0u, 0u, 0u}, wk = {0u, 0u, 0u, 0u}; unsigned short bh_[8], kh_[8];
#pragma unroll
          for (int q = 0; q < 8; ++q) { const float cT = __shfl(cum[q], 63);
              const float e1 = __builtin_amdgcn_exp2f(-LOG2E * (cum[q] - lam[q])), e2 = __builtin_amdgcn_exp2f(-LOG2E * cum[q]), e3 = __builtin_amdgcn_exp2f(LOG2E * cum[q]), e4 = __builtin_amdgcn_exp2f(-LOG2E * (cT - cum[q]));
              const float kkq = __uint_as_float((q & 1) ? (gkk[q >> 1] & 0xffff0000u) : (gkk[q >> 1] << 16)), rq = __uint_as_float((q & 1) ? (gr[q >> 1] & 0xffff0000u) : (gr[q >> 1] << 16));
              const float bq = __uint_as_float((q & 1) ? (gbv[q >> 1] & 0xffff0000u) : (gbv[q >> 1] << 16)), kq = __uint_as_float((q & 1) ? (gk[q >> 1] & 0xffff0000u) : (gk[q >> 1] << 16));
              const unsigned a16 = f2bf(-kkq * e1), r16 = f2bf(rq * e2), b16 = f2bf(bq * e3), k16 = f2bf(kq * e3);
              if (q & 1) { wa[q >> 1] |= a16 << 16; wr[q >> 1] |= r16 << 16; wb[q >> 1] |= b16 << 16; wk[q >> 1] |= k16 << 16; } else { wa[q >> 1] = a16; wr[q >> 1] = r16; wb[q >> 1] = b16; wk[q >> 1] = k16; }
              bh_[q] = (unsigned short)f2bf(bq * e4); kh_[q] = (unsigned short)f2bf(kq * e4);
              if (lane == 63) gamT[j0 + q] = e2; }
          LAS unsigned char* row = gb + t * GP + 2 * j0;
          *(LAS v4u*)(row + RC_AT) = wa; *(LAS v4u*)(row + RC_RT) = wr; *(LAS v4u*)(row + RC_BT) = wb; *(LAS v4u*)(row + RC_KT) = wk; *(LAS v4u*)(row + RC_V) = gv;
#pragma unroll
          for (int q = 0; q < 8; ++q) { LAS unsigned char* tr = gb + (j0 + q) * GP + 2 * t;
              *(LAS bf16*)(tr + RC_BH) = bh_[q]; *(LAS bf16*)(tr + RC_KH) = kh_[q];
              *(LAS bf16*)(tr + RC_VT) = (bf16)((q & 1) ? (gv[q >> 1] >> 16) : (gv[q >> 1] & 0xffffu)); } }
        __syncthreads();
        if (!(SK & 2)) { const int rb = wave >> 1, r32 = lane & 31, hi = lane >> 5;
          const LAS unsigned char* xr = gb + (rb < 2 ? RC_AT : RC_RT) + (32 * (rb & 1) + r32) * GP + 16 * hi; const int tt = 32 * (rb & 1) + r32;
#pragma unroll
          for (int k2 = 0; k2 < 2; ++k2) { const int cb = 2 * (wave & 1) + k2;
              const LAS unsigned char* yr = gb + (cb < 2 ? RC_BT : RC_KT) + (32 * (cb & 1) + r32) * GP + 16 * hi;
              f32x16 acc = {};
#pragma unroll
              for (int s = 0; s < 4; ++s) acc = __builtin_amdgcn_mfma_f32_32x32x16_bf16(*(const LAS bf16x8*)(yr + 32 * s), *(const LAS bf16x8*)(xr + 32 * s), acc, 0, 0, 0);
              if (rb < 2 && cb < 2) {
#pragma unroll
                  for (int g = 0; g < 4; ++g) { const int s0 = 32 * (cb & 1) + 8 * g + 4 * hi; f32x4 o;
#pragma unroll
                      for (int r = 0; r < 4; ++r) o[r] = (tt > s0 + r) ? -acc[4 * g + r] : 0.f;
                      *(LAS f32x4*)((LAS float*)(gb + RC_A) + tt * 68 + s0) = o; } }
              else { const int incl = rb >= 2 ? 1 : 0; LAS unsigned char* dst = gb + (rb < 2 ? RC_AK : (cb < 2 ? RC_RB : RC_RK)) + tt * GP;
#pragma unroll
                  for (int g = 0; g < 4; ++g) { const int s0 = 32 * (cb & 1) + 8 * g + 4 * hi; f32x4 o;
#pragma unroll
                      for (int r = 0; r < 4; ++r) o[r] = (tt + incl > s0 + r) ? acc[4 * g + r] : 0.f;
                      *(LAS u64_t*)(dst + 2 * s0) = (u64_t)pg8::cvt_pk_bf16(o[0], o[1]) | ((u64_t)pg8::cvt_pk_bf16(o[2], o[3]) << 32); } } } }
        __syncthreads();
        if (!(SK & 4)) { const int col = lane & 15, q4 = lane >> 4, it = wave >> 1;
#pragma unroll
          for (int k2 = 0; k2 < 2; ++k2) { const int ct = 2 * (wave & 1) + k2; f32x4 acc = {0.f, 0.f, 0.f, 0.f};
              const LAS unsigned char* pa = gb + RC_AK + (16 * it + col) * GP + 8 * q4; const LAS unsigned char* pb = gb + RC_VT + (16 * ct + col) * GP + 8 * q4;
              acc = __builtin_amdgcn_mfma_f32_16x16x32_bf16(ld2x8(pa), ld2x8(pb), acc, 0, 0, 0);
              acc = __builtin_amdgcn_mfma_f32_16x16x32_bf16(ld2x8(pa + 64), ld2x8(pb + 64), acc, 0, 0, 0);
#pragma unroll
              for (int r = 0; r < 4; ++r) ((LAS float*)(gb + RC_R2))[(16 * it + 4 * q4 + r) * 68 + 16 * ct + col] = acc[r]; } }
        if (!(SK & 4) && wave == 0) {
            const int bb = lane >> 4, cc = lane & 15; float T[16];
            const LAS float* Ab = (const LAS float*)(gb + RC_A) + (16 * bb) * 68 + 16 * bb;
#pragma unroll
            for (int i = 0; i < 16; ++i) { float a0 = 0.f, a1 = 0.f;
#pragma unroll
                for (int j4 = 0; j4 < (i + 3) / 4; ++j4) { const f32x4 av = *(const LAS f32x4*)(Ab + i * 68 + 4 * j4);
                    a0 += av.x * T[4 * j4] + av.z * T[4 * j4 + 2]; a1 += av.y * T[4 * j4 + 1] + av.w * T[4 * j4 + 3]; }
                T[i] = (i == cc ? 1.f : 0.f) - (a0 + a1);
                if (i < 15 && (i & 3) == 3) asm volatile("" ::: "memory");
                if (i == 0) {
#pragma unroll
                    for (int k = 1; k < 16; ++k) T[k] = 0.f; } }
#pragma unroll
            for (int i = 0; i < 16; ++i) ((LAS float*)(gb + RC_T))[(16 * bb + i) * 16 + cc] = T[i];
        }
        __syncthreads();
        f32x4 Xc[4];
#pragma unroll
        for (int g = 0; g < 4; ++g) Xc[g] = (f32x4){0.f, 0.f, 0.f, 0.f};
        if (!(SK & 8)) { const int col = lane & 15, q4 = lane >> 4, cidx = 16 * wave + col;
          u64_t xh[4], xl[4];
#pragma unroll
          for (int bk = 0; bk < 4; ++bk) {
              f32x4 Y;
#pragma unroll
              for (int r = 0; r < 4; ++r) { const int tt = 16 * bk + 4 * q4 + r;
                  Y[r] = (wave < 4) ? bf2f(*(const LAS bf16*)(gb + RC_AT + tt * GP + 2 * cidx)) : ((const LAS float*)(gb + RC_R2))[tt * 68 + (cidx - 64)]; }
#pragma unroll
              for (int b2 = 0; b2 < bk; b2 += 2) {
                  const LAS float* ar = (const LAS float*)(gb + RC_A) + (16 * bk + col) * 68 + 16 * b2 + 4 * q4;
                  f32x4 a0 = -*(const LAS f32x4*)ar, a1 = (b2 + 1 < bk) ? -*(const LAS f32x4*)(ar + 16) : (f32x4){0.f, 0.f, 0.f, 0.f};
                  u64_t ah0, al0, ah1, al1; hilo4(a0, ah0, al0); hilo4(a1, ah1, al1);
                  const u64_t bh1 = (b2 + 1 < bk) ? xh[b2 + 1] : 0ull, bl1 = (b2 + 1 < bk) ? xl[b2 + 1] : 0ull;
                  const bf16x8 Ah = mk_bf16x8(ah0, ah1), Al = mk_bf16x8(al0, al1), Bh = mk_bf16x8(xh[b2], bh1), Bl = mk_bf16x8(xl[b2], bl1);
                  Y = __builtin_amdgcn_mfma_f32_16x16x32_bf16(Al, Bh, Y, 0, 0, 0);
                  Y = __builtin_amdgcn_mfma_f32_16x16x32_bf16(Ah, Bl, Y, 0, 0, 0);
                  Y = __builtin_amdgcn_mfma_f32_16x16x32_bf16(Ah, Bh, Y, 0, 0, 0); }
              { const f32x4 t0 = *(const LAS f32x4*)((const LAS float*)(gb + RC_T) + (16 * bk + col) * 16 + 4 * q4);
                u64_t th, tl, yh, yl; hilo4(t0, th, tl); hilo4(Y, yh, yl);
                const bf16x8 Ah = mk_bf16x8(th, 0ull), Al = mk_bf16x8(tl, 0ull), Bh = mk_bf16x8(yh, 0ull), Bl = mk_bf16x8(yl, 0ull);
                f32x4 X = {0.f, 0.f, 0.f, 0.f};
                X = __builtin_amdgcn_mfma_f32_16x16x32_bf16(Al, Bh, X, 0, 0, 0);
                X = __builtin_amdgcn_mfma_f32_16x16x32_bf16(Ah, Bl, X, 0, 0, 0);
                X = __builtin_amdgcn_mfma_f32_16x16x32_bf16(Ah, Bh, X, 0, 0, 0);
                Xc[bk] = X; hilo4(X, xh[bk], xl[bk]); }
          } }
        __syncthreads();
        { const int col = lane & 15, q4 = lane >> 4, cidx = 16 * wave + col;
          if (wave < 4) {
#pragma unroll
              for (int g = 0; g < 4; ++g)
#pragma unroll
                  for (int r = 0; r < 4; ++r) { const int i = 16 * g + 4 * q4 + r; const float x = Xc[g][r]; const unsigned hb = f2bf(x);
                      *(LAS bf16*)(gb + RC_AT + i * GP + 2 * cidx) = (bf16)hb; *(LAS bf16*)(gb + RC_AK + i * GP + 2 * cidx) = (bf16)f2bf(x - __uint_as_float(hb << 16)); }
          } else {
#pragma unroll
              for (int g = 0; g < 4; ++g)
#pragma unroll
                  for (int r = 0; r < 4; ++r) ((LAS float*)(gb + RC_A))[(16 * g + 4 * q4 + r) * 68 + (cidx - 64)] = Xc[g][r];
          } }
        __syncthreads();
        if (!(SK & 16) && wave < 4) { const int col = lane & 15, q4 = lane >> 4, e = 16 * wave + col;
          bf16x8 bZ0, bZ1, bZ0l, bZ1l; split_acc(Zacc[0], Zacc[1], bZ0, bZ0l); split_acc(Zacc[2], Zacc[3], bZ1, bZ1l);
          f32x4 U[4], Yo[4], Vc[4];
          const LAS unsigned char* rowa = gb + col * GP + 8 * q4;
#pragma unroll
          for (int it = 0; it < 4; ++it) {
              const LAS float* u0p = (const LAS float*)(gb + RC_A) + (16 * it + 4 * q4) * 68 + e;
              U[it] = (f32x4){u0p[0], u0p[68], u0p[136], u0p[204]};
#pragma unroll
              for (int r = 0; r < 4; ++r) Vc[it][r] = bf2f(*(const LAS bf16*)(gb + RC_V + (16 * it + 4 * q4 + r) * GP + 2 * e));
              const LAS unsigned char* ra = rowa + 16 * it * GP;
              const bf16x8 wh0 = ld2x8(ra + RC_AT), wh1 = ld2x8(ra + RC_AT + 64), wl0 = ld2x8(ra + RC_AK), wl1 = ld2x8(ra + RC_AK + 64), qa0 = ld2x8(ra + RC_RT), qa1 = ld2x8(ra + RC_RT + 64);
              U[it] = __builtin_amdgcn_mfma_f32_16x16x32_bf16(wl0, bZ0, U[it], 0, 0, 0);
              U[it] = __builtin_amdgcn_mfma_f32_16x16x32_bf16(wl1, bZ1, U[it], 0, 0, 0);
              U[it] = __builtin_amdgcn_mfma_f32_16x16x32_bf16(wh0, bZ0l, U[it], 0, 0, 0);
              U[it] = __builtin_amdgcn_mfma_f32_16x16x32_bf16(wh1, bZ1l, U[it], 0, 0, 0);
              U[it] = __builtin_amdgcn_mfma_f32_16x16x32_bf16(wh0, bZ0, U[it], 0, 0, 0);
              U[it] = __builtin_amdgcn_mfma_f32_16x16x32_bf16(wh1, bZ1, U[it], 0, 0, 0);
              Yo[it] = __builtin_amdgcn_mfma_f32_16x16x32_bf16(qa0, bZ0l, (f32x4){0.f, 0.f, 0.f, 0.f}, 0, 0, 0);
              Yo[it] = __builtin_amdgcn_mfma_f32_16x16x32_bf16(qa1, bZ1l, Yo[it], 0, 0, 0);
              Yo[it] = __builtin_amdgcn_mfma_f32_16x16x32_bf16(qa0, bZ0, Yo[it], 0, 0, 0);
              Yo[it] = __builtin_amdgcn_mfma_f32_16x16x32_bf16(qa1, bZ1, Yo[it], 0, 0, 0);
              asm volatile("" ::: "memory");
          }
          bf16x8 bU0, bU1, bU0l, bU1l; split_acc(U[0], U[1], bU0, bU0l); split_acc(U[2], U[3], bU1, bU1l);
          const bf16x8 bV0 = pack_acc(Vc[0], Vc[1]), bV1 = pack_acc(Vc[2], Vc[3]);
#pragma unroll
          for (int it = 0; it < 4; ++it) {
              const LAS unsigned char* ra = rowa + 16 * it * GP;
              const bf16x8 pb0 = ld2x8(ra + RC_RB), pb1 = ld2x8(ra + RC_RB + 64), pk0 = ld2x8(ra + RC_RK), pk1 = ld2x8(ra + RC_RK + 64);
              const bf16x8 hb0 = ld2x8(ra + RC_BH), hb1 = ld2x8(ra + RC_BH + 64), hk0 = ld2x8(ra + RC_KH), hk1 = ld2x8(ra + RC_KH + 64);
              f32x4 O = Yo[it];
              O = __builtin_amdgcn_mfma_f32_16x16x32_bf16(pb0, bU0l, O, 0, 0, 0);
              O = __builtin_amdgcn_mfma_f32_16x16x32_bf16(pb1, bU1l, O, 0, 0, 0);
              O = __builtin_amdgcn_mfma_f32_16x16x32_bf16(pk0, bV0, O, 0, 0, 0);
              O = __builtin_amdgcn_mfma_f32_16x16x32_bf16(pk1, bV1, O, 0, 0, 0);
              O = __builtin_amdgcn_mfma_f32_16x16x32_bf16(pb0, bU0, O, 0, 0, 0);
              O = __builtin_amdgcn_mfma_f32_16x16x32_bf16(pb1, bU1, O, 0, 0, 0);
              const f32x4 gz = *(const LAS f32x4*)(gamT + 16 * it + 4 * q4);
              f32x4 Zn = Zacc[it] * gz;
              Zn = __builtin_amdgcn_mfma_f32_16x16x32_bf16(hb0, bU0l, Zn, 0, 0, 0);
              Zn = __builtin_amdgcn_mfma_f32_16x16x32_bf16(hb1, bU1l, Zn, 0, 0, 0);
              Zn = __builtin_amdgcn_mfma_f32_16x16x32_bf16(hk0, bV0, Zn, 0, 0, 0);
              Zn = __builtin_amdgcn_mfma_f32_16x16x32_bf16(hk1, bV1, Zn, 0, 0, 0);
              Zn = __builtin_amdgcn_mfma_f32_16x16x32_bf16(hb0, bU0, Zn, 0, 0, 0);
              Zn = __builtin_amdgcn_mfma_f32_16x16x32_bf16(hb1, bU1, Zn, 0, 0, 0);
              Zacc[it] = Zn;
#pragma unroll
              for (int r = 0; r < 4; ++r) ((LAS float*)(gb + RC_A))[(16 * it + 4 * q4 + r) * 68 + e] = O[r];
              asm volatile("" ::: "memory");
          } }
        __syncthreads();
    }
    RC_WRITEOUT(SEQ / 64 - 1);
#undef RC_WRITEOUT
    __syncthreads();
}
__device__ __forceinline__ int next_unit(Frame& F, gu32* head) {
    __syncthreads();
    if (F.tid == 0) F.MISC[16] = __hip_atomic_fetch_add(head, 1u, RLX_AGENT);
    __syncthreads();
    return (int)F.MISC[16];
}
constexpr int U_GDN = 96, U_RWKV = 64, U_ATT = 384, U_ALL = U_GDN + U_RWKV + U_ATT;
__device__ __forceinline__ void p3_mixers(Frame& F, int l, int rep) {
    gu32* head = F.ctl + CW_QUEUE + 64 * (2 * l + rep);
    for (;;) {
        const int u = next_unit(F, head);
        if (u >= U_ALL) break;
        asm volatile("" : "+v"(F.tid), "+v"(F.lane));
        if (u < U_GDN) {
#ifdef EXP_GDN
            gdn_unit3<EXP_GDN>(F, l, u, F.ctl + CW_FLAG + 64 * 256 * (4 + 2 * l + rep) + 64 * 128); asm volatile("" : "+v"(F.tid), "+v"(F.lane));
#endif
            gdn_unit3<0>(F, l, u, F.ctl + CW_FLAG + 64 * 256 * (2 * l + rep) + 64 * 128); }
        else if (u < U_GDN + U_RWKV) {
#ifdef EXP_RWKV
            rwkv_unit_c<EXP_RWKV>(F, u - U_GDN, F.ctl + CW_FLAG + 64 * 256 * (4 + 2 * l + rep)); asm volatile("" : "+v"(F.tid), "+v"(F.lane));
#endif
            rwkv_unit_c<0>(F, u - U_GDN, F.ctl + CW_FLAG + 64 * 256 * (2 * l + rep)); }
        else attn_unit(F, u - U_GDN - U_RWKV);
    }
}
__device__ __forceinline__ f32x4 bf4(u64_t x) { return (f32x4){__uint_as_float(((unsigned)x) << 16), __uint_as_float(((unsigned)x) & 0xffff0000u), __uint_as_float(((unsigned)(x >> 32)) << 16), __uint_as_float(((unsigned)(x >> 32)) & 0xffff0000u)}; }
__device__ __forceinline__ u64_t pk4(const f32x4& v) { return (u64_t)pg8::cvt_pk_bf16(v[0], v[1]) | ((u64_t)pg8::cvt_pk_bf16(v[2], v[3]) << 32); }
__device__ __forceinline__ void p2_mla_unit(Frame& F, int l, int unit) {
    const int lane = F.lane, col = lane & 15, q4 = lane >> 4, m = 16 * unit + col, b = m / SEQ, t = m % SEQ, t0 = (16 * unit) % SEQ;
    const bf16* prow = (const bf16*)(F.ws + WS_PMLA) + (size_t)m * 352;
    const bf16* WuqT = (const bf16*)(F.ws + WS_WSMALL + OFF_WUQ) + (size_t)l * 576 * 192 + (size_t)col * 192 + 8 * q4;
    const bf16* WukvT = (const bf16*)(F.ws + WS_WSMALL + OFF_WUKV) + (size_t)l * 768 * 128 + (size_t)col * 128 + 8 * q4;
    bf16x8 aq[6], akv[4]; float sq = 0.f, skv = 0.f;
#pragma unroll
    for (int s = 0; s < 6; ++s) { aq[s] = *(const bf16x8*)(prow + 32 * s + 8 * q4); const v4u u = __builtin_bit_cast(v4u, aq[s]);
#pragma unroll
        for (int i = 0; i < 4; ++i) { const float a = __uint_as_float(u[i] << 16), c = __uint_as_float(u[i] & 0xffff0000u); sq += a * a + c * c; } }
#pragma unroll
    for (int s = 0; s < 4; ++s) { akv[s] = *(const bf16x8*)(prow + 192 + 32 * s + 8 * q4); const v4u u = __builtin_bit_cast(v4u, akv[s]);
#pragma unroll
        for (int i = 0; i < 4; ++i) { const float a = __uint_as_float(u[i] << 16), c = __uint_as_float(u[i] & 0xffff0000u); skv += a * a + c * c; } }
    sq += __shfl_xor(sq, 16); sq += __shfl_xor(sq, 32); skv += __shfl_xor(skv, 16); skv += __shfl_xor(skv, 32);
    const float rq = rsqrtf(sq * (1.f / 192.f) + NORM_EPS) * (0.10206207261596575f * LOG2E), rkv = rsqrtf(skv * (1.f / 128.f) + NORM_EPS);
    const float pos = (float)((const int*)inptr(F, 1))[m];
    f32x4 cs, sn;
#pragma unroll
    for (int r = 0; r < 4; ++r) { const float inv = exp2f(-(float)(4 * q4 + r) * (13.287712379549449f / 16.f)); float s_, c_; sincosf(pos * inv, &s_, &c_); cs[r] = c_; sn[r] = s_; }
    bf16* Qo = (bf16*)(F.ws + WS_Q) + ((size_t)b * 6 * SEQ + t) * 96 + 4 * q4;
    bf16* Ko = (bf16*)(F.ws + WS_K) + ((size_t)b * 6 * SEQ + t) * 96 + 4 * q4;
    bf16* Vo = (bf16*)(F.ws + WS_VT) + (size_t)b * 6 * 64 * SEQ + (size_t)col * SEQ + t0 + 4 * q4;
    { const u64_t x1 = *(const u64_t*)(prow + 320 + 4 * q4), x2 = *(const u64_t*)(prow + 336 + 4 * q4); const f32x4 a = bf4(x1), c = bf4(x2);
      const u64_t o1 = pk4(a * cs - c * sn), o2 = pk4(c * cs + a * sn);
#pragma unroll
      for (int h = 0; h < 6; ++h) { *(u64_t*)(Ko + (size_t)h * SEQ * 96 + 64) = o1; *(u64_t*)(Ko + (size_t)h * SEQ * 96 + 80) = o2; } }
#pragma unroll 2
    for (int h = 0; h < 6; ++h) {
        f32x4 x1v = {0.f, 0.f, 0.f, 0.f};
#pragma unroll
        for (int nt = 0; nt < 6; ++nt) {
            const bf16* w = WuqT + (size_t)(h * 96 + 16 * nt) * 192; f32x4 acc = {0.f, 0.f, 0.f, 0.f};
#pragma unroll
            for (int s = 0; s < 6; ++s) acc = __builtin_amdgcn_mfma_f32_16x16x32_bf16(*(const bf16x8*)(w + 32 * s), aq[s], acc, 0, 0, 0);
            acc = acc * rq;
            if (nt < 4) *(u64_t*)(Qo + (size_t)h * SEQ * 96 + 16 * nt) = pk4(acc);
            else if (nt == 4) x1v = acc;
            else { *(u64_t*)(Qo + (size_t)h * SEQ * 96 + 64) = pk4(x1v * cs - acc * sn); *(u64_t*)(Qo + (size_t)h * SEQ * 96 + 80) = pk4(acc * cs + x1v * sn); }
        }
#pragma unroll
        for (int nt = 0; nt < 4; ++nt) {
            const bf16* w = WukvT + (size_t)(h * 128 + 16 * nt) * 128; f32x4 acc = {0.f, 0.f, 0.f, 0.f};
#pragma unroll
            for (int s = 0; s < 4; ++s) acc = __builtin_amdgcn_mfma_f32_16x16x32_bf16(*(const bf16x8*)(w + 32 * s), akv[s], acc, 0, 0, 0);
            *(u64_t*)(Ko + (size_t)h * SEQ * 96 + 16 * nt) = pk4(acc * rkv);
        }
        f32x4 rk4;
#pragma unroll
        for (int r = 0; r < 4; ++r) rk4[r] = __shfl(rkv, 4 * q4 + r);
#pragma unroll
        for (int nt = 0; nt < 4; ++nt) {
            const bf16* w = WukvT + (size_t)(h * 128 + 64 + 16 * nt) * 128; f32x4 acc = {0.f, 0.f, 0.f, 0.f};
#pragma unroll
            for (int s = 0; s < 4; ++s) acc = __builtin_amdgcn_mfma_f32_16x16x32_bf16(akv[s], *(const bf16x8*)(w + 32 * s), acc, 0, 0, 0);
            *(u64_t*)(Vo + (size_t)(h * 64 + 16 * nt) * SEQ) = pk4(acc * rk4);
        }
    }
}
__device__ __forceinline__ f32x4 rw_shift4(const bf16* P, size_t m, int c, bool hp, bool hn, const float* mu) {
    const f32x4 x = bf4(*(const u64_t*)(P + m * 896 + c)), xp = hp ? bf4(*(const u64_t*)(P + (m - 1) * 896 + c)) : (f32x4){0.f, 0.f, 0.f, 0.f}, xn = hn ? bf4(*(const u64_t*)(P + (m + 1) * 896 + c)) : (f32x4){0.f, 0.f, 0.f, 0.f};
    const f32x4 m0 = *(const f32x4*)(mu + c), m1 = *(const f32x4*)(mu + 896 + c);
    return x + m0 * (xp - x) + m1 * (xn - x);
}
__device__ __forceinline__ void p2_rwkv_unit(Frame& F, int l, int unit, int h0, int h1) {
    const int lane = F.lane, col = lane & 15, q4 = lane >> 4, b = (16 * unit) / SEQ, t = (16 * unit) % SEQ + col; const size_t m = (size_t)16 * unit + col;
    const bool hp = t > 0, hn = t < SEQ - 1;
    const bf16* Prw = (const bf16*)(F.ws + WS_PRW);
    const float* mu = (const float*)inptr(F, 12) + l * 2 * 896;
    const bf16* W2T = (const bf16*)(F.ws + WS_WSMALL + OFF_W2T) + (size_t)l * 2 * 256 * 64 + (size_t)col * 64 + 8 * q4;
    const bf16* A2T = (const bf16*)(F.ws + WS_WSMALL + OFF_A2T) + (size_t)l * 2 * 256 * 64 + (size_t)col * 64 + 8 * q4;
    bf16x8 awd[2], aad[2];
#pragma unroll
    for (int s = 0; s < 2; ++s) { const int c = 768 + 32 * s + 8 * q4;
        f32x4 lo = rw_shift4(Prw, m, c, hp, hn, mu), hi = rw_shift4(Prw, m, c + 4, hp, hn, mu);
#pragma unroll
        for (int i = 0; i < 4; ++i) { lo[i] = 1.f - 2.f * __builtin_amdgcn_rcpf(1.f + __expf(2.f * lo[i])); hi[i] = 1.f - 2.f * __builtin_amdgcn_rcpf(1.f + __expf(2.f * hi[i])); }
        awd[s] = pack_acc(lo, hi);
        aad[s] = pack_acc(rw_shift4(Prw, m, c + 64, hp, hn, mu), rw_shift4(Prw, m, c + 68, hp, hn, mu)); }
#pragma unroll 1
    for (int h = h0; h < h1; ++h) {
        f32x4 k[4]; float kn = 0.f;
        { const float* k_k = (const float*)inptr(F, 17) + l * 256;
#pragma unroll
          for (int nt = 0; nt < 4; ++nt) { const int c = 64 * h + 16 * nt + 4 * q4; k[nt] = rw_shift4(Prw, m, 256 + c, hp, hn, mu);
              const f32x4 x = k[nt] * *(const f32x4*)(k_k + c); kn += (x[0] * x[0] + x[1] * x[1]) + (x[2] * x[2] + x[3] * x[3]); } }
        kn += __shfl_xor(kn, 16); kn += __shfl_xor(kn, 32);
        const float rkn = rsqrtf(kn + 1e-6f);
        float br[2] = {0.f, 0.f}, kr[2] = {0.f, 0.f}, cbv = 0.f;
        unsigned char* rs = F.ws + WS_RS + (((size_t)b * 4 + h) * SEQ + t) * RS_REC + 8 * q4;
        unsigned char* rd0 = F.ws + WS_RD + (((size_t)b * 4 + h) * SEQ + t) * RD_REC + 8 * q4;
#pragma unroll
        for (int nt = 0; nt < 4; ++nt) { const int c = 64 * h + 16 * nt + 4 * q4;
            const f32x4 r = rw_shift4(Prw, m, c, hp, hn, mu), v = rw_shift4(Prw, m, 512 + c, hp, hn, mu);
            const f32x4 kk = k[nt] * *(const f32x4*)((const float*)inptr(F, 17) + l * 256 + c) * rkn;
            *(u64_t*)(rs + 32 * nt) = pk4(kk); *(u64_t*)(rs + 128 + 32 * nt) = pk4(v); *(u64_t*)(rs + 256 + 32 * nt) = pk4(r);
            f32x4 ksum = {0.f, 0.f, 0.f, 0.f};
#pragma unroll
            for (int e = 0; e < 2; ++e) { const bf16* w = W2T + (size_t)(e * 256 + 64 * h + 16 * nt) * 64; const bf16* a = A2T + (size_t)(e * 256 + 64 * h + 16 * nt) * 64;
                f32x4 x = {0.f, 0.f, 0.f, 0.f}, y = {0.f, 0.f, 0.f, 0.f};
#pragma unroll
                for (int s = 0; s < 2; ++s) { x = __builtin_amdgcn_mfma_f32_16x16x32_bf16(*(const bf16x8*)(w + 32 * s), awd[s], x, 0, 0, 0); y = __builtin_amdgcn_mfma_f32_16x16x32_bf16(*(const bf16x8*)(a + 32 * s), aad[s], y, 0, 0, 0); }
                const f32x4 w0v = *(const f32x4*)((const float*)inptr(F, 13) + l * 512 + e * 256 + c), a0v = *(const f32x4*)((const float*)inptr(F, 15) + l * 512 + e * 256 + c), kav = *(const f32x4*)((const float*)inptr(F, 18) + l * 256 + c);
                f32x4 lam, av;
#pragma unroll
                for (int i = 0; i < 4; ++i) { lam[i] = 0.6065306597126334f * sigmoidf_(w0v[i] + x[i]); av[i] = sigmoidf_(a0v[i] + y[i]); }
                const f32x4 km = k[nt] * (1.f + (av - 1.f) * kav), bb = av * kk;
                ksum += km;
                br[e] += (bb[0] * r[0] + bb[1] * r[1]) + (bb[2] * r[2] + bb[3] * r[3]); kr[e] += (km[0] * r[0] + km[1] * r[1]) + (km[2] * r[2] + km[3] * r[3]);
                typedef _Float16 h4 __attribute__((ext_vector_type(4)));
                const h4 lh = {(_Float16)lam[0], (_Float16)lam[1], (_Float16)lam[2], (_Float16)lam[3]};
                unsigned char* rd = rd0 + e * RD_DIR;
                *(u64_t*)(rd + 32 * nt) = __builtin_bit_cast(u64_t, lh); *(u64_t*)(rd + 128 + 32 * nt) = pk4(bb); *(u64_t*)(rd + 256 + 32 * nt) = pk4(km); }
            const f32x4 rkv = *(const f32x4*)((const float*)inptr(F, 19) + l * 256 + c), xx = r * ksum * rkv; cbv += (xx[0] + xx[1]) + (xx[2] + xx[3]);
        }
#pragma unroll
        for (int e = 0; e < 2; ++e) { float x = br[e], y = kr[e]; x += __shfl_xor(x, 16); x += __shfl_xor(x, 32); y += __shfl_xor(y, 16); y += __shfl_xor(y, 32);
            if (q4 == 0) { typedef float f2 __attribute__((ext_vector_type(2))); *(f2*)(rd0 + e * RD_DIR + 384) = (f2){x, y}; } }
        cbv += __shfl_xor(cbv, 16); cbv += __shfl_xor(cbv, 32);
        if (q4 == 0) ((float*)(F.ws + WS_CB))[m * 4 + h] = 0.5f * cbv;
    }
}
template <int MODE> __device__ __forceinline__ void p2_prep2(Frame& F, int l) {
    const int gw = F.vcu * NWAVES + F.wave, NGW = F.G * NWAVES;
    for (int u = gw; u < 2 * (M / 16); u += NGW) { if (u & 1) { if (MODE != 1) p2_rwkv_unit(F, l, u >> 1, 0, 4); } else { if (MODE != 2) p2_mla_unit(F, l, u >> 1); } }
}
__device__ __forceinline__ void ld16(const bf16* p, f32x4 (&o)[4]) { const v4u a = *(const v4u*)p, b = *(const v4u*)(p + 8);
    o[0] = (f32x4){__uint_as_float(a.x << 16), __uint_as_float(a.x & 0xffff0000u), __uint_as_float(a.y << 16), __uint_as_float(a.y & 0xffff0000u)};
    o[1] = (f32x4){__uint_as_float(a.z << 16), __uint_as_float(a.z & 0xffff0000u), __uint_as_float(a.w << 16), __uint_as_float(a.w & 0xffff0000u)};
    o[2] = (f32x4){__uint_as_float(b.x << 16), __uint_as_float(b.x & 0xffff0000u), __uint_as_float(b.y << 16), __uint_as_float(b.y & 0xffff0000u)};
    o[3] = (f32x4){__uint_as_float(b.z << 16), __uint_as_float(b.z & 0xffff0000u), __uint_as_float(b.w << 16), __uint_as_float(b.w & 0xffff0000u)}; }
__device__ __forceinline__ void p4a_mix2(Frame& F, int l) {
    const bf16* Ogdn = (const bf16*)(F.ws + WS_OGDN); const bf16* Omla = (const bf16*)(F.ws + WS_OMLA); const bf16* Y = (const bf16*)(F.ws + WS_Y);
    const bf16* Pgate = (const bf16*)(F.ws + WS_PGATE); const unsigned char* Rs = F.ws + WS_RS; const float* cb = (const float*)(F.ws + WS_CB); bf16* mix = (bf16*)(F.ws + WS_MIX);
    const int gw = F.vcu * NWAVES + F.wave, NGW = F.G * NWAVES, lane = F.lane, g = lane >> 2, c0 = 16 * lane;
    f32x4 pg[4], pb[4];
    if (g < 6) { const float* gg = (const float*)inptr(F, 7) + l * 64 + (c0 & 63);
#pragma unroll
        for (int i = 0; i < 4; ++i) { pg[i] = *(const f32x4*)(gg + 4 * i); pb[i] = (f32x4){0.f, 0.f, 0.f, 0.f}; } }
    else if (g < 12) {
#pragma unroll
        for (int i = 0; i < 4; ++i) { pg[i] = (f32x4){1.f, 1.f, 1.f, 1.f}; pb[i] = (f32x4){0.f, 0.f, 0.f, 0.f}; } }
    else { const float* lg = (const float*)inptr(F, 20) + l * 256 + (c0 - 768); const float* lb = (const float*)inptr(F, 21) + l * 256 + (c0 - 768);
#pragma unroll
        for (int i = 0; i < 4; ++i) { pg[i] = *(const f32x4*)(lg + 4 * i); pb[i] = *(const f32x4*)(lb + 4 * i); } }
#pragma unroll 2
    for (int m = gw; m < M; m += NGW) {
        f32x4 x[4], gt[4];
        ld16(Pgate + (size_t)m * 1024 + c0, gt);
        if (g < 6) { ld16(Ogdn + (size_t)m * 384 + c0, x);
            float ss = 0.f;
#pragma unroll
            for (int i = 0; i < 4; ++i) ss += (x[i][0] * x[i][0] + x[i][1] * x[i][1]) + (x[i][2] * x[i][2] + x[i][3] * x[i][3]);
            ss += dpp_xor1(ss); ss += dpp_xor2(ss);
            const float rs = rsqrtf(ss * (1.f / 64.f) + NORM_EPS);
#pragma unroll
            for (int i = 0; i < 4; ++i) x[i] = x[i] * rs * pg[i]; }
        else if (g < 12) ld16(Omla + (size_t)m * 384 + (c0 - 384), x);
        else { const int cc = c0 - 768, h = g - 12, b = m / SEQ, t = m % SEQ; f32x4 v[4];
            ld16(Y + (size_t)m * 256 + cc, x); ld16((const bf16*)(Rs + (((size_t)b * 4 + h) * SEQ + t) * RS_REC + 128) + (cc & 63), v);
            const float cbv = cb[(size_t)m * 4 + h];
            float s1 = 0.f;
#pragma unroll
            for (int i = 0; i < 4; ++i) s1 += (x[i][0] + x[i][1]) + (x[i][2] + x[i][3]);
            s1 += dpp_xor1(s1); s1 += dpp_xor2(s1);
            const float mean = s1 * (1.f / 64.f); float s2 = 0.f;
#pragma unroll
            for (int i = 0; i < 4; ++i) { x[i] = x[i] - mean; s2 += (x[i][0] * x[i][0] + x[i][1] * x[i][1]) + (x[i][2] * x[i][2] + x[i][3] * x[i][3]); }
            s2 += dpp_xor1(s2); s2 += dpp_xor2(s2);
            const float rs = rsqrtf(s2 * (1.f / 64.f) + 64e-5f);
#pragma unroll
            for (int i = 0; i < 4; ++i) x[i] = x[i] * rs * pg[i] + pb[i] + cbv * v[i]; }
        v4u o0, o1;
#pragma unroll
        for (int i = 0; i < 4; ++i) {
#pragma unroll
            for (int j = 0; j < 4; ++j) x[i][j] = x[i][j] * siluf(gt[i][j]); }
        o0.x = pg8::cvt_pk_bf16(x[0][0], x[0][1]); o0.y = pg8::cvt_pk_bf16(x[0][2], x[0][3]); o0.z = pg8::cvt_pk_bf16(x[1][0], x[1][1]); o0.w = pg8::cvt_pk_bf16(x[1][2], x[1][3]);
        o1.x = pg8::cvt_pk_bf16(x[2][0], x[2][1]); o1.y = pg8::cvt_pk_bf16(x[2][2], x[2][3]); o1.z = pg8::cvt_pk_bf16(x[3][0], x[3][1]); o1.w = pg8::cvt_pk_bf16(x[3][2], x[3][3]);
        bf16* op = mix + (size_t)m * 1024 + c0; *(v4u*)op = o0; *(v4u*)(op + 8) = o1;
    }
}
constexpr int PT_OUT = 24, PT_WS = 25, PT_N = 26;
__device__ __forceinline__ void build_frame(Frame& F, LAS unsigned char* lds) {
    F.lds = lds; F.MISC = (volatile LAS unsigned*)(lds + MISC_OFF); F.ptab = (volatile LAS const unsigned long long*)(lds + MISC_OFF + 256);
    const int t = pg8::mk_tid(lds);
    F.tid = t; F.lane = t & 63; F.wave = __builtin_amdgcn_readfirstlane(t >> 6);
    F.G = gridDim.x; { const int bx = blockIdx.x; F.vcu = (F.G % 8 == 0) ? (bx % 8) * (F.G / 8) + bx / 8 : bx; }
    F.ws = (unsigned char*)inptr(F, PT_WS); F.out = (float*)inptr(F, PT_OUT); F.ctl = (gu32*)F.ws;
}
__device__ __forceinline__ bool ph_in(LAS unsigned char* lds, int k) { volatile LAS unsigned* mi = (volatile LAS unsigned*)(lds + MISC_OFF); const int lo = __builtin_amdgcn_readfirstlane((int)mi[20]), hi = __builtin_amdgcn_readfirstlane((int)mi[21]); return lo <= k && k < hi; }
__device__ __forceinline__ void seam(LAS unsigned char* lds, int k) {
    if (ph_in(lds, k) && ph_in(lds, k + 1)) { Frame F; build_frame(F, lds);
        XcdBarrier bar; bar.bar = (unsigned*)(F.ctl + CW_BAR); bar.x = xb_xcc_id(); bar.st = F.MISC + 8; xcd_barrier(bar); }
}
template <int L> __device__ __forceinline__ void layer_phases(LAS unsigned char* lds) {
    constexpr int pb = 1 + 5 * L;
    if (ph_in(lds, pb)) { Frame F; build_frame(F, lds);
        pg8::Gemm g{(const pg8::bf16_t*)(F.ws + WS_XB), (const pg8::bf16_t*)(F.ws + WS_WIN) + (size_t)L * NP * D, M, NP, D};
        pg8::StaticOrder S; S.init(M, NP, F.G, (int)blockIdx.x);
        pg8::EpiRoute E{F.ws};
        pg8::gemm_phase<pg8::EpiRoute, pg8::StaticOrder, true, true>(F.lds + RING_OFF, g, S, E);
    }
    seam(lds, pb);
    if (ph_in(lds, pb + 1)) { Frame F; build_frame(F, lds); p2_prep2<0>(F, L); }
    seam(lds, pb + 1);
    if (ph_in(lds, pb + 2)) { Frame F; build_frame(F, lds); p3_mixers(F, L, 0); }
    seam(lds, pb + 2);
    if (ph_in(lds, pb + 3)) { Frame F; build_frame(F, lds); p4a_mix2(F, L);
    }
    seam(lds, pb + 3);
    if (ph_in(lds, pb + 4)) { Frame F; build_frame(F, lds);
        pg8::Gemm g{(const pg8::bf16_t*)(F.ws + WS_MIX), (const pg8::bf16_t*)(F.ws + WS_WOUT) + (size_t)L * D * D, M, D, D};
        pg8::StaticOrder S; S.init(M, D, F.G, (int)blockIdx.x);
        pg8::EpiOut<L == 0> E{L == 0 ? (const float*)inptr(F, 0) : (const float*)F.out, F.out, F.ws};
        pg8::gemm_phase<pg8::EpiOut<L == 0>, pg8::StaticOrder, true, true>(F.lds + RING_OFF, g, S, E);
    }
    seam(lds, pb + 4);
}
__global__ void __launch_bounds__(NWAVES * 64, 2) mk_fwd(Args args) {
    extern __shared__ __attribute__((aligned(16))) unsigned char lds_raw[];
    LAS unsigned char* lds = (LAS unsigned char*)lds_raw;
    for (int u = threadIdx.x; u < (LDS_BYTES - LDSCTL_OFF) / 4; u += NWAVES * 64) ((LAS unsigned*)(lds + LDSCTL_OFF))[u] = 0u;
    __syncthreads();
    if (threadIdx.x == 0) { LAS unsigned long long* pt = (LAS unsigned long long*)(lds + MISC_OFF + 256);
#define PT(k) pt[k] = (unsigned long long)args.in[k]
        PT(0); PT(1); PT(2); PT(3); PT(4); PT(5); PT(6); PT(7); PT(8); PT(9); PT(10); PT(11); PT(12); PT(13); PT(14); PT(15); PT(16); PT(17); PT(18); PT(19); PT(20); PT(21); PT(22); PT(23);
#undef PT
        pt[PT_OUT] = (unsigned long long)args.out; pt[PT_WS] = (unsigned long long)args.ws;
        volatile LAS unsigned* mi = (volatile LAS unsigned*)(lds + MISC_OFF); mi[20] = (unsigned)args.ph_lo; mi[21] = (unsigned)args.ph_hi;
        if (args.ph_hi - args.ph_lo > 1) (void)xcd_barrier_post((unsigned*)((gu32*)args.ws + CW_BAR), mi + 8);
    }
    if ((threadIdx.x & 63) == 0) ((volatile LAS unsigned*)(lds + pg8::TIDTAB_OFF))[pg8::hw_slot()] = threadIdx.x >> 6;
    __syncthreads();
    if (ph_in(lds, 0)) { Frame F; build_frame(F, lds); p0_prologue(F); }
    seam(lds, 0);
    layer_phases<0>(lds);
    layer_phases<1>(lds);
    if (ph_in(lds, 11)) { Frame F; build_frame(F, lds); p5_final(F); }
}

extern "C" void kernel_launch(void* const* d_in, const int* in_sizes, int n_in, void* d_out, int out_size, void* d_ws, size_t ws_size, hipStream_t stream) {
    static int grid = 0;
    if (grid == 0) {
        if (n_in != 24 || ws_size < WS_END || out_size != M * D) { fprintf(stderr, "kernel_launch: unexpected inputs (%d), out (%d) or workspace (%zu)\n", n_in, out_size, ws_size); grid = -1; return; }
        int dev = 0, cus = 0;
        if (hipGetDevice(&dev) != hipSuccess || hipDeviceGetAttribute(&cus, hipDeviceAttributeMultiprocessorCount, dev) != hipSuccess) { grid = -1; return; }
        if (hipFuncSetAttribute((const void*)mk_fwd, hipFuncAttributeMaxDynamicSharedMemorySize, LDS_BYTES) != hipSuccess) { fprintf(stderr, "kernel_launch: hipFuncSetAttribute failed\n"); grid = -1; return; }
        (void)hipGetLastError();
        grid = cus;
    }
    if (grid < 0) return;
    unsigned char* ws = (unsigned char*)d_ws;
    (void)hipMemsetAsync(ws + WS_CTL, 0, CTL_ZERO_BYTES, stream);
    Args a{};
    for (int i = 0; i < 24; ++i) a.in[i] = d_in[i];
    a.out = (float*)d_out; a.ws = ws; a.ph_lo = 0; a.ph_hi = NPHASE;
    hipLaunchKernelGGL(mk_fwd, dim3(grid), dim3(NWAVES * 64), LDS_BYTES, stream, a);
}
```

```cpp
#include <hip/hip_runtime.h>
#include <cstdio>
#include <cstdint>
#include <hip/hip_fp16.h>
namespace pg8 {
#define PG8_LAS __attribute__((address_space(3)))
typedef unsigned short bf16_t;
typedef short bf16x8 __attribute__((ext_vector_type(8)));
typedef float f32x4 __attribute__((ext_vector_type(4)));
typedef unsigned u32x4 __attribute__((ext_vector_type(4)));
constexpr int BM = 256, BK = 64, HALF = 128, HTB = HALF * BK * 2  , STAGE_BYTES = 8 * HTB, NXCD = 8, WGM = 8;

__host__ __device__ __forceinline__ int lds_byte(int r, int c) { const int st = (r >> 4) * 2 + (c >> 5), rr = r & 15, cc = c & 31, ob = rr * 64 + cc * 2; return st * 1024 + (ob ^ (((ob >> 9) & 1) << 5)); }
__host__ __device__ __forceinline__ void stage_rc(int b, int& R, int& C) { const int st = b / 1024, sb = b % 1024, swz = sb ^ (((sb >> 9) & 1) << 5); R = (st >> 1) * 16 + swz / 64; C = (st & 1) * 32 + (swz % 64) / 2; }
__host__ __device__ __forceinline__ int perm32(int rho) { const int n = rho >> 4, i = rho & 15; return 8 * (i >> 2) + 4 * n + (i & 3); }

struct Unit { int pm, pn; };
struct Gemm { const bf16_t* A; const bf16_t* Bt; int M, N, K; };

struct StaticOrder {
    int nM, nN, nwg, G, c;
    __host__ __device__ void init(int M, int N, int G_, int c_) { nM = M / BM; nN = N / BM; nwg = nM * nN; G = G_; c = c_; }
    __host__ __device__ bool next(int i, Unit& u) const {
        const long L = (long)i * G + c; if (L >= nwg) return false;
        int wgid = (int)L; { const int q = nwg / NXCD, r = nwg % NXCD, xcd = wgid % NXCD, off = wgid / NXCD; wgid = (xcd < r ? xcd * (q + 1) : r * (q + 1) + (xcd - r) * q) + off; }
        const int nig = WGM * nN, gid = wgid / nig, fm = gid * WGM, gsz = (nM - fm) < WGM ? (nM - fm) : WGM;
        u.pm = fm + ((wgid % nig) % gsz); u.pn = (wgid % nig) / gsz; return true;
    }
    __device__ __forceinline__ void a_ready(const Unit&) const {}
    __device__ __forceinline__ void done(const Unit&) const {}
};

__device__ __forceinline__ unsigned cvt_pk_bf16(float lo, float hi) { unsigned r; asm volatile("v_cvt_pk_bf16_f32 %0, %1, %2" : "=v"(r) : "v"(lo), "v"(hi)); return r; }
typedef float f32x2 __attribute__((ext_vector_type(2)));
constexpr int TIDTAB_OFF = 131072 + 320 + 512;
__device__ __forceinline__ unsigned hw_slot() { return (unsigned)__builtin_amdgcn_s_getreg((5 << 11) | 4) & 63u; }
__device__ __forceinline__ int mk_tid(PG8_LAS unsigned char* lds_base) {
    const unsigned lane = __builtin_amdgcn_mbcnt_hi(~0u, __builtin_amdgcn_mbcnt_lo(~0u, 0u));
    const unsigned w = __builtin_amdgcn_readfirstlane(((volatile PG8_LAS unsigned*)(lds_base + TIDTAB_OFF))[hw_slot()]);
    return (int)(w * 64u + lane);
}
struct EpiRoute {
    static constexpr bool PERM = true, AFTER_DRAIN = false;
    unsigned char* ws;
    __device__ __forceinline__ void operator()(const f32x4 (&acc)[2][2][4][2], const Unit& u, int wr, int wc, int fr, int fq) const {
        const int row0 = u.pm * BM + wr * 64 + fr;
        const float* rowss = (const float*)(ws + (1u << 20)); float* Psm = (float*)(ws + (22u << 20));
        unsigned base[2]; int ld[2], cc[2], kind[2];
#pragma unroll
        for (int bj = 0; bj < 2; ++bj) {
            const int cg = u.pn * BM + bj * HALF + wc * 32, col = cg + 8 * fq;
            if (cg < 1024) { base[bj] = 25u << 20; ld[bj] = 1024; cc[bj] = col; kind[bj] = 0; }
            else if (cg < 2176) { base[bj] = 57u << 20; ld[bj] = 1152; cc[bj] = col - 1024; kind[bj] = 0; }
            else if (cg < 2528) { base[bj] = 93u << 20; ld[bj] = 352; cc[bj] = col - 2176; kind[bj] = 0; }
            else if (cg < 3424) { base[bj] = 104u << 20; ld[bj] = 896; cc[bj] = col - 2528; kind[bj] = 0; }
            else if (cg < 3456) { base[bj] = 0u; ld[bj] = 32; cc[bj] = col - 3424; kind[bj] = 1; }
            else { base[bj] = 0u; ld[bj] = 0; cc[bj] = 0; kind[bj] = 2; }
        }
#pragma unroll
        for (int ai = 0; ai < 2; ++ai)
#pragma unroll
            for (int m = 0; m < 4; ++m) {
                const int row = row0 + ai * HALF + m * 16;
                const f32x4* rp = (const f32x4*)(rowss + (size_t)row * 16);
                const f32x4 s0 = rp[0], s1 = rp[1], s2 = rp[2], s3 = rp[3];
                const float ss = ((s0[0] + s0[1]) + (s0[2] + s0[3])) + ((s1[0] + s1[1]) + (s1[2] + s1[3])) + ((s2[0] + s2[1]) + (s2[2] + s2[3])) + ((s3[0] + s3[1]) + (s3[2] + s3[3]));
                const float rstd = __builtin_amdgcn_rsqf(ss * (1.0f / 1024.0f) + 1e-6f);
#pragma unroll
                for (int bj = 0; bj < 2; ++bj) {
                    const f32x4 v0 = acc[ai][bj][m][0] * rstd, v1 = acc[ai][bj][m][1] * rstd;
                    if (kind[bj] == 0) { u32x4 w; w.x = cvt_pk_bf16(v0[0], v0[1]); w.y = cvt_pk_bf16(v0[2], v0[3]); w.z = cvt_pk_bf16(v1[0], v1[1]); w.w = cvt_pk_bf16(v1[2], v1[3]);
                        *(u32x4*)((bf16_t*)(ws + base[bj]) + (size_t)row * ld[bj] + cc[bj]) = w; }
                    else if (kind[bj] == 1) { float* p = Psm + (size_t)row * 32 + cc[bj]; *(f32x4*)p = v0; *(f32x4*)(p + 4) = v1; }
                }
                asm volatile("" ::: "memory");
            }
    }
};
template <bool WRITE_XB> struct EpiOut {
    static constexpr bool PERM = false, AFTER_DRAIN = false;
    const float* xin; float* xout; unsigned char* ws;
    __device__ __forceinline__ void operator()(const f32x4 (&acc)[2][2][4][2], const Unit& u, int wr, int wc, int fr, int fq) const {
        typedef unsigned u32x2v __attribute__((ext_vector_type(2)));
        const int row0 = u.pm * BM + wr * 64 + fr, col0 = u.pn * BM + wc * 32 + 4 * fq;
        float* rowss = (float*)(ws + (1u << 20)); bf16_t* xb = (bf16_t*)(ws + (133u << 20));
#pragma unroll
        for (int ai = 0; ai < 2; ++ai)
#pragma unroll
            for (int m = 0; m < 4; ++m) {
                const int row = row0 + ai * HALF + m * 16; float ss = 0.f;
#pragma unroll
                for (int bj = 0; bj < 2; ++bj)
#pragma unroll
                    for (int n = 0; n < 2; ++n) {
                        const size_t off = (size_t)row * 1024 + col0 + bj * HALF + n * 16;
                        const f32x4 o = *(const f32x4*)(xin + off) + acc[ai][bj][m][n];
                        *(f32x4*)(xout + off) = o;
                        if (WRITE_XB) { u32x2v w; w.x = cvt_pk_bf16(o[0], o[1]); w.y = cvt_pk_bf16(o[2], o[3]); *(u32x2v*)(xb + off) = w; }
                        ss += (o[0] * o[0] + o[1] * o[1]) + (o[2] * o[2] + o[3] * o[3]);
                    }
                ss += __shfl_xor(ss, 16); ss += __shfl_xor(ss, 32);
                if (fq == 0) rowss[(size_t)row * 16 + u.pn * 4 + wc] = ss;
                asm volatile("" ::: "memory");
            }
    }
};
template <class Epi, class Sched, bool ALIGN_EPI = false, bool SP2 = false>
__device__ __forceinline__ void gemm_phase(PG8_LAS unsigned char* lds, const Gemm g, const Sched& S, const Epi& E) {
    const int tid_ = mk_tid(lds);
    const int tid = tid_, wid = __builtin_amdgcn_readfirstlane(tid >> 6), lane = tid & 63, wr = wid >> 2, wc = wid & 3, fr = lane & 15, fq = lane >> 4;
    const int K = g.K, nt = K / BK;
    unsigned voffA[2], voffB[2];
#pragma unroll
    for (int i = 0; i < 2; ++i) { int R, C; stage_rc(tid * 16 + i * 8192, R, C); const int Rb = Epi::PERM ? ((R & ~31) + perm32(R & 31)) : R;
        voffA[i] = (unsigned)(R * K + C) * 2u; voffB[i] = (unsigned)(Rb * K + C) * 2u; }
    const size_t kstep = (size_t)(BK * 2);
    const size_t hstep = (size_t)HALF * K * 2;
    const size_t tstep = 2 * hstep;
    const unsigned ldsw = (unsigned)wid * 1024u;
    const int aoff = lds_byte(wr * 64 + fr, fq * 8), boff = lds_byte(wc * 32 + fr, fq * 8);
#define PG8_SA(b, h) (((b) * 2 + (h)) * HTB)
#define PG8_SB(b, h) ((4 + (b) * 2 + (h)) * HTB)
#define PG8_STAGE(bufoff, gbase, voff) do { _Pragma("unroll") for (int _i = 0; _i < 2; ++_i) \
        __builtin_amdgcn_global_load_lds((const unsigned*)((const char*)(gbase) + (voff)[_i]), (PG8_LAS unsigned*)(lds + (bufoff) + ldsw + _i * 8192), 16, 0, 0); } while (0)
#define PG8_LDA(dst, b, h) do { _Pragma("unroll") for (int m = 0; m < 4; ++m) _Pragma("unroll") for (int k = 0; k < 2; ++k) dst[m][k] = *(const PG8_LAS bf16x8*)(lds + PG8_SA(b, h) + aoff + m * 2048 + k * 1024); } while (0)
#define PG8_LDB(dst, b, h) do { _Pragma("unroll") for (int n = 0; n < 2; ++n) _Pragma("unroll") for (int k = 0; k < 2; ++k) dst[n][k] = *(const PG8_LAS bf16x8*)(lds + PG8_SB(b, h) + boff + n * 2048 + k * 1024); } while (0)
#define PG8_MMA(ai, bj, At, Bt) do { __builtin_amdgcn_s_setprio(1); _Pragma("unroll") for (int m = 0; m < 4; ++m) _Pragma("unroll") for (int n = 0; n < 2; ++n) _Pragma("unroll") for (int k = 0; k < 2; ++k) \
        acc[ai][bj][m][n] = __builtin_amdgcn_mfma_f32_16x16x32_bf16(Bt[n][k], At[m][k], acc[ai][bj][m][n], 0, 0, 0); __builtin_amdgcn_s_setprio(0); } while (0)
#define PG8_WAIT_V(n) asm volatile("s_waitcnt vmcnt(" #n ")" ::: "memory")
#define PG8_WAIT_L(n) asm volatile("s_waitcnt lgkmcnt(" #n ")" ::: "memory")
#define PG8_BAR __builtin_amdgcn_s_barrier()
#define PG8_SCHED __builtin_amdgcn_sched_barrier(0)
    Unit cur, nxt; int ui = 0;
    if (!S.next(0, cur)) return;
    f32x4 acc[2][2][4][2];
#pragma unroll
    for (int a = 0; a < 2; ++a)
#pragma unroll
        for (int b = 0; b < 2; ++b)
#pragma unroll
            for (int m = 0; m < 4; ++m)
#pragma unroll
                for (int n = 0; n < 2; ++n) acc[a][b][m][n] = (f32x4){0.f, 0.f, 0.f, 0.f};
    bf16x8 At[4][2], B0[2][2], B1[2][2];
    const char* cA = (const char*)g.A + (size_t)cur.pm * tstep; const char* cB = (const char*)g.Bt + (size_t)cur.pn * tstep;
    S.a_ready(cur);
    if constexpr (SP2) {
        PG8_STAGE(PG8_SB(0, 0), cB, voffB); PG8_STAGE(PG8_SB(0, 1), cB + hstep, voffB); PG8_STAGE(PG8_SA(0, 0), cA, voffA); PG8_STAGE(PG8_SA(0, 1), cA + hstep, voffA);
        if (wr == 1) PG8_BAR;
        PG8_WAIT_V(2); PG8_BAR;
        PG8_STAGE(PG8_SB(1, 0), cB + kstep, voffB); PG8_STAGE(PG8_SA(1, 0), cA + kstep, voffA); PG8_STAGE(PG8_SB(1, 1), cB + hstep + kstep, voffB);
        PG8_WAIT_V(6); PG8_BAR;
    } else {
        PG8_STAGE(PG8_SB(0, 0), cB, voffB); PG8_STAGE(PG8_SA(0, 0), cA, voffA); PG8_STAGE(PG8_SB(0, 1), cB + hstep, voffB); PG8_STAGE(PG8_SA(0, 1), cA + hstep, voffA);
        if (wr == 1) PG8_BAR;
        PG8_WAIT_V(4); PG8_BAR;
        PG8_STAGE(PG8_SB(1, 0), cB + kstep, voffB); PG8_STAGE(PG8_SA(1, 0), cA + kstep, voffA); PG8_STAGE(PG8_SB(1, 1), cB + hstep + kstep, voffB);
        PG8_WAIT_V(6); PG8_BAR;
    }
    for (;;) {
        const bool has_next = S.next(ui + 1, nxt);
        const char* nA = has_next ? (const char*)g.A + (size_t)nxt.pm * tstep : cA; const char* nB = has_next ? (const char*)g.Bt + (size_t)nxt.pn * tstep : cB;
        for (int t = 0; t < nt; t += 2) {
            const bool last = (t == nt - 2);
            const char* a1 = cA + (size_t)(t + 1) * kstep;
            const char* a2 = last ? nA : cA + (size_t)(t + 2) * kstep; const char* b2 = last ? nB : cB + (size_t)(t + 2) * kstep;
            const char* a3 = a2 + kstep; const char* b3 = b2 + kstep;
            if (last && has_next) S.a_ready(nxt);
            if constexpr (SP2) {
            PG8_LDB(B0, 0, 0); PG8_LDB(B1, 0, 1); PG8_SCHED; PG8_LDA(At, 0, 0); PG8_STAGE(PG8_SA(1, 1), a1 + hstep, voffA);
            PG8_WAIT_V(8); PG8_WAIT_L(0); PG8_BAR; PG8_MMA(0, 0, At, B0); PG8_MMA(0, 1, At, B1); PG8_BAR; PG8_SCHED;
            PG8_LDA(At, 0, 1); PG8_STAGE(PG8_SB(0, 0), b2, voffB); PG8_STAGE(PG8_SB(0, 1), b2 + hstep, voffB); PG8_STAGE(PG8_SA(0, 0), a2, voffA);
            PG8_WAIT_V(8); PG8_WAIT_L(0); PG8_BAR; PG8_MMA(1, 0, At, B0); PG8_MMA(1, 1, At, B1); PG8_BAR; PG8_SCHED;
            PG8_LDB(B0, 1, 0); PG8_LDB(B1, 1, 1); PG8_SCHED; PG8_LDA(At, 1, 0); PG8_STAGE(PG8_SA(0, 1), a2 + hstep, voffA);
            PG8_WAIT_V(8); PG8_WAIT_L(0); PG8_BAR; PG8_MMA(0, 0, At, B0); PG8_MMA(0, 1, At, B1); PG8_BAR; PG8_SCHED;
            PG8_LDA(At, 1, 1); PG8_STAGE(PG8_SB(1, 0), b3, voffB); PG8_STAGE(PG8_SB(1, 1), b3 + hstep, voffB); PG8_STAGE(PG8_SA(1, 0), a3, voffA);
            PG8_WAIT_V(8); PG8_WAIT_L(0); PG8_BAR; PG8_MMA(1, 0, At, B0); PG8_MMA(1, 1, At, B1); PG8_BAR; PG8_SCHED;
            } else {
            PG8_LDB(B0, 0, 0); PG8_SCHED; PG8_LDA(At, 0, 0); PG8_STAGE(PG8_SA(1, 1), a1 + hstep, voffA);
            PG8_WAIT_L(8); PG8_BAR; PG8_WAIT_L(0); PG8_MMA(0, 0, At, B0); PG8_BAR; PG8_SCHED;
            PG8_LDB(B1, 0, 1); PG8_STAGE(PG8_SB(0, 0), b2, voffB);
            PG8_BAR; PG8_WAIT_L(0); PG8_MMA(0, 1, At, B1); PG8_BAR;
            PG8_LDA(At, 0, 1); PG8_STAGE(PG8_SA(0, 0), a2, voffA);
            PG8_BAR; PG8_WAIT_L(0); PG8_MMA(1, 0, At, B0); PG8_BAR; PG8_SCHED;
            PG8_STAGE(PG8_SB(0, 1), b2 + hstep, voffB);
            PG8_WAIT_V(6); PG8_BAR; PG8_MMA(1, 1, At, B1); PG8_BAR;
            PG8_LDB(B0, 1, 0); PG8_SCHED; PG8_LDA(At, 1, 0); PG8_STAGE(PG8_SA(0, 1), a2 + hstep, voffA);
            PG8_WAIT_L(8); PG8_BAR; PG8_WAIT_L(0); PG8_MMA(0, 0, At, B0); PG8_BAR; PG8_SCHED;
            PG8_LDB(B1, 1, 1); PG8_STAGE(PG8_SB(1, 0), b3, voffB);
            PG8_BAR; PG8_WAIT_L(0); PG8_MMA(0, 1, At, B1); PG8_BAR;
            PG8_LDA(At, 1, 1); PG8_STAGE(PG8_SA(1, 0), a3, voffA);
            PG8_BAR; PG8_WAIT_L(0); PG8_MMA(1, 0, At, B0); PG8_BAR; PG8_SCHED;
            PG8_STAGE(PG8_SB(1, 1), b3 + hstep, voffB);
            PG8_WAIT_V(6); PG8_BAR; PG8_MMA(1, 1, At, B1); PG8_BAR;
            }
        }
        if constexpr (ALIGN_EPI) { if (wr == 0) PG8_BAR; }
        if constexpr (!Epi::AFTER_DRAIN) { E(acc, cur, wr, wc, fr, fq); S.done(cur); }
        if (!has_next) break;
#pragma unroll
        for (int a = 0; a < 2; ++a)
#pragma unroll
            for (int b = 0; b < 2; ++b)
#pragma unroll
                for (int m = 0; m < 4; ++m)
#pragma unroll
                    for (int n = 0; n < 2; ++n) acc[a][b][m][n] = (f32x4){0.f, 0.f, 0.f, 0.f};
        cur = nxt; cA = nA; cB = nB; ++ui;
        if constexpr (ALIGN_EPI) { if (wr == 1) PG8_BAR; }
    }
    PG8_WAIT_V(0);
    if constexpr (!ALIGN_EPI) { if (wr == 0) PG8_BAR; }
    PG8_BAR;
    if constexpr (Epi::AFTER_DRAIN) { E.fused(acc, cur, wr, wc, fr, fq, lds, wid, lane); S.done(cur); }
#undef PG8_SA
#undef PG8_SB
#undef PG8_STAGE
#undef PG8_LDA
#undef PG8_LDB
#undef PG8_MMA
#undef PG8_WAIT_V
#undef PG8_WAIT_L
#undef PG8_BAR
#undef PG8_SCHED
}
}
#define GAS __attribute__((address_space(1)))
#define LAS __attribute__((address_space(3)))
typedef unsigned short bf16;
typedef unsigned v4u __attribute__((ext_vector_type(4)));
typedef float f32x4 __attribute__((ext_vector_type(4)));
typedef short bf16x8 __attribute__((ext_vector_type(8)));
typedef GAS unsigned gu32;
typedef GAS unsigned long long gu64;
#define RLX_AGENT __ATOMIC_RELAXED, __HIP_MEMORY_SCOPE_AGENT
#define LDS_WAIT() asm volatile("s_waitcnt lgkmcnt(0)" ::: "memory")
#define VM_WAIT() asm volatile("s_waitcnt vmcnt(0)" ::: "memory")
__device__ __forceinline__ unsigned long long rt() { return __builtin_amdgcn_s_memrealtime(); }
__device__ __forceinline__ unsigned f2bf(float f) { unsigned u = __builtin_bit_cast(unsigned, f); return (u + 0x7fffu + ((u >> 16) & 1u)) >> 16; }
__device__ __forceinline__ unsigned pk2(float lo, float hi) { return f2bf(lo) | (f2bf(hi) << 16); }

#define XB_TMO      128
#define XB_XCNT(j)  (256  + 64 * (j))
#define XB_XSUB(j)  (1280 + 64 * (j))
#define XB_XGEN(j)  (2304 + 64 * (j))
#define XB_TOP      3328
#define XB_TOPGEN   3392
#define XCD_BAR_WORDS 3456
#define XB_SPIN_CAP (1u << 18)

__device__ __forceinline__ unsigned xb_ld(unsigned* p)              { return __hip_atomic_load(p, __ATOMIC_RELAXED, __HIP_MEMORY_SCOPE_AGENT); }
__device__ __forceinline__ unsigned xb_add(unsigned* p, unsigned v) { return __hip_atomic_fetch_add(p, v, __ATOMIC_RELAXED, __HIP_MEMORY_SCOPE_AGENT); }
__device__ __forceinline__ unsigned xb_xcc_id() { return (unsigned)__builtin_amdgcn_s_getreg((3 << 11) | 20) & 0xFu; }
#define XB_SPIN(cond, bar) do { unsigned _sp = 0; while (cond) { __builtin_amdgcn_s_sleep(1); \
    if ((++_sp & 255u) == 0u) { if (xb_ld(&(bar)[XB_TMO])) break; if (_sp > XB_SPIN_CAP) { atomicAdd(&(bar)[XB_TMO], 1u); break; } } } } while (0)

struct XcdBarrier {
    unsigned* bar; unsigned x;
    volatile LAS unsigned* st;
};

__device__ __forceinline__ XcdBarrier xcd_barrier_post(unsigned* bar, volatile LAS unsigned* st) {
    XcdBarrier b; b.bar = bar; b.x = xb_xcc_id(); b.st = st;
    if (threadIdx.x == 0) (void)xb_add(&bar[XB_XCNT(b.x)], 1u);
    return b;
}
__device__ __forceinline__ void xcd_barrier_complete(unsigned* bar, unsigned x, unsigned& nloc, unsigned& nx) {
    const unsigned G = gridDim.x * gridDim.y * gridDim.z;
    unsigned sum, cnt, mine, sp = 0u;
    for (;;) {
        sum = 0u; cnt = 0u; mine = 0u;
#pragma unroll
        for (unsigned j = 0; j < 16; ++j) { const unsigned c = xb_ld(&bar[XB_XCNT(j)]); sum += c; cnt += (c > 0u) ? 1u : 0u; mine = (j == x) ? c : mine; }
        if (sum == G) break;
        __builtin_amdgcn_s_sleep(1);
        if ((++sp & 255u) == 0u) { if (xb_ld(&bar[XB_TMO])) break; if (sp > XB_SPIN_CAP) { atomicAdd(&bar[XB_TMO], 1u); break; } }
    }
    nloc = mine > 0u ? mine : 1u; nx = cnt > 0u ? cnt : 1u;
}

__device__ __forceinline__ void xcd_barrier(const XcdBarrier& b) {
    asm volatile("s_waitcnt vmcnt(0)" ::: "memory");
    __syncthreads();
    if (pg8::mk_tid((LAS unsigned char*)b.st - (131072 + 320 + 32)) == 0) {
        unsigned* bar = b.bar;
        __builtin_amdgcn_s_waitcnt(0);
        unsigned nloc = b.st[0], nx = b.st[1];
        if (nloc == 0u) { xcd_barrier_complete(bar, b.x, nloc, nx); b.st[0] = nloc; b.st[1] = nx; }
        const unsigned old = xb_add(&bar[XB_XSUB(b.x)], 1u);
        const unsigned gen = old / nloc;
        if (old + 1u == (gen + 1u) * nloc) {
            __builtin_amdgcn_fence(__ATOMIC_RELEASE, "agent");
            asm volatile("s_waitcnt vmcnt(0)" ::: "memory");
            const unsigned og = xb_add(&bar[XB_TOP], 1u);
            const unsigned tg = og / nx;
            if (og + 1u == (tg + 1u) * nx) xb_add(&bar[XB_TOPGEN], 1u);
            else XB_SPIN(xb_ld(&bar[XB_TOPGEN]) == tg, bar);
            __builtin_amdgcn_fence(__ATOMIC_ACQUIRE, "agent");
            xb_add(&bar[XB_XGEN(b.x)], 1u);
            asm volatile("s_waitcnt vmcnt(0)" ::: "memory");
        } else {
            XB_SPIN(xb_ld(&bar[XB_XGEN(b.x)]) == gen, bar);
            __builtin_amdgcn_fence(__ATOMIC_ACQUIRE, "agent");
            asm volatile("s_waitcnt vmcnt(0)" ::: "memory");
        }
    }
    __syncthreads();
}
constexpr int BATCH = 8, SEQ = 2048, M = BATCH * SEQ, D = 1024, NIN = 3448, NP = 3584;
constexpr float NORM_EPS = 1e-6f;
constexpr float LOG2E = 1.4426950408889634f;
constexpr size_t MiB = 1u << 20;
constexpr size_t WS_CTL = 0, CTL_ZERO_BYTES = 1 * MiB;
constexpr size_t WS_ROWSS = 1 * MiB;
constexpr size_t WS_WIN = 2 * MiB;
constexpr size_t WS_WOUT = 16 * MiB;
constexpr size_t WS_WSMALL = 20 * MiB;
constexpr size_t OFF_WUQ = 0, OFF_WUKV = 2 * 576 * 192 * 2, OFF_W2T = OFF_WUKV + 2 * 768 * 128 * 2, OFF_A2T = OFF_W2T + 2 * 2 * 256 * 64 * 2;
constexpr size_t WS_PSM = 22 * MiB;
constexpr size_t WS_CB = 24 * MiB;
constexpr size_t WS_PGATE = 25 * MiB;
constexpr size_t WS_PGDN = 57 * MiB;
constexpr size_t WS_PMLA = 93 * MiB;
constexpr size_t WS_PRW = 104 * MiB;
constexpr size_t WS_OGDN = 93 * MiB;
constexpr size_t WS_OMLA = 105 * MiB;
constexpr size_t WS_Y = 117 * MiB;
constexpr size_t WS_RS = 133 * MiB;
constexpr size_t WS_RD = 157 * MiB;
constexpr size_t WS_XB = 133 * MiB;
constexpr size_t WS_Q = 207 * MiB;
constexpr size_t WS_K = 225 * MiB;
constexpr size_t WS_VT = 243 * MiB;
constexpr size_t WS_MIX = 207 * MiB;
constexpr size_t WS_END = 255 * MiB;
constexpr int RS_REC = 384;
constexpr size_t RD_DIR = (size_t)BATCH * 4 * SEQ * RS_REC;
__device__ __forceinline__ size_t rw_rec_off(int bh, int t, int arr, int w) { return ((size_t)(bh * (SEQ / 64) + (t >> 6)) * 3 + arr) * 8192 + w * 1024 + (t & 63) * 16; }
constexpr int CW_BAR = 4096;
constexpr int CW_QUEUE = 16384;

constexpr int NWAVES = 8;
constexpr int RING_OFF = 0, RING_BYTES = 131072, LDSCTL_OFF = RING_BYTES, MISC_OFF = LDSCTL_OFF + 320, LDS_BYTES = 147456;
static_assert(pg8::TIDTAB_OFF == MISC_OFF + 512 && RING_OFF == 0, "LDS map");
constexpr int NPHASE = 12;

__device__ __forceinline__ float bf2f(bf16 v) { return __uint_as_float(((unsigned)v) << 16); }
__device__ __forceinline__ float wave_sum(float v) {
#pragma unroll
    for (int o = 1; o < 64; o <<= 1) v += __shfl_xor(v, o);
    return v;
}
__device__ __forceinline__ float siluf(float x) { return x * __builtin_amdgcn_rcpf(1.f + __expf(-x)); }
__device__ __forceinline__ float sigmoidf_(float x) { return __builtin_amdgcn_rcpf(1.f + __expf(-x)); }
__device__ __forceinline__ float softplusf_(float x) { return x > 20.f ? x : log1pf(__expf(x)); }

typedef float f32x2_t __attribute__((ext_vector_type(2))); typedef __bf16 bf16x2_t __attribute__((ext_vector_type(2)));
__device__ __forceinline__ unsigned cvt2bf(float lo, float hi) { const f32x2_t v = {lo, hi}; const bf16x2_t b = __builtin_convertvector(v, bf16x2_t); return __builtin_bit_cast(unsigned, b); }

struct Args { const void* in[24]; float* out; unsigned char* ws; int ph_lo, ph_hi; };

struct Frame {
    LAS unsigned char* lds;
    volatile LAS unsigned* MISC;
    gu32* ctl;
    int tid, lane, wave, vcu, G;
    unsigned char* ws;
    float* out;
    volatile LAS const unsigned long long* ptab;
};
__device__ __forceinline__ const void* inptr(const Frame& F, int k) {
    const unsigned long long v = F.ptab[k];
    const unsigned lo = __builtin_amdgcn_readfirstlane((unsigned)v), hi = __builtin_amdgcn_readfirstlane((unsigned)(v >> 32));
    return (const void*)(GAS const void*)(((unsigned long long)hi << 32) | lo);
}

__device__ __forceinline__ void tr_item(const float* W, int K, int ldsrc, int scol, int nvalid, bf16* WT, const float* gs, LAS float* scr, int kb, int lane) {
    const int k0 = 64 * kb;
#pragma unroll 8
    for (int i = 0; i < 32; ++i) { const int kk = 2 * i + (lane >> 5), n = lane & 31; float v = 0.f;
        if (n < nvalid) { v = W[(size_t)(k0 + kk) * ldsrc + scol + n]; if (gs) v *= gs[k0 + kk]; }
        scr[kk * 33 + n] = v; }
    LDS_WAIT(); asm volatile("" ::: "memory");
    const int c = lane & 7;
#pragma unroll
    for (int j = 0; j < 4; ++j) { const int n = (lane >> 3) + 8 * j; const LAS float* s = scr + (8 * c) * 33 + n;
        v4u o; o.x = pk2(s[0 * 33], s[1 * 33]); o.y = pk2(s[2 * 33], s[3 * 33]); o.z = pk2(s[4 * 33], s[5 * 33]); o.w = pk2(s[6 * 33], s[7 * 33]);
        *(GAS v4u*)(WT + (size_t)n * K + k0 + 8 * c) = o; }
    LDS_WAIT(); asm volatile("" ::: "memory");
}
__device__ __forceinline__ void p0_prologue(Frame& F) {
    LAS float* scr = (LAS float*)(F.lds + RING_OFF + F.wave * 16384);
    const int gw = F.vcu * NWAVES + F.wave, NGW = F.G * NWAVES;
    constexpr int I_IN = 112 * 16, I_OUT = 32 * 16, I_UQ = 18 * 3, I_UKV = 24 * 2, I_W2 = 16, I_A2 = 16, I_L = I_IN + I_OUT + I_UQ + I_UKV + I_W2 + I_A2;
    for (int it = gw; it < 2 * I_L; it += NGW) {
        const int l = it / I_L; int r = it % I_L;
        if (r < I_IN) { const int nb = r >> 4, kb = r & 15, n0 = 32 * nb; int scol, nv;
            if (n0 < 2176) { scol = n0; nv = 32; } else if (n0 < 3424) { scol = n0 + 24; nv = 32; } else if (n0 == 3424) { scol = 2176; nv = 24; } else { scol = 0; nv = 0; }
            tr_item((const float*)inptr(F, 3) + (size_t)l * D * NIN, D, NIN, scol, nv, (bf16*)(F.ws + WS_WIN) + ((size_t)l * NP + n0) * D, (const float*)inptr(F, 2) + l * D, scr, kb, F.lane); continue; }
        r -= I_IN;
        if (r < I_OUT) { const int nb = r >> 4, kb = r & 15;
            tr_item((const float*)inptr(F, 22) + (size_t)l * D * D, D, D, 32 * nb, 32, (bf16*)(F.ws + WS_WOUT) + ((size_t)l * D + 32 * nb) * D, nullptr, scr, kb, F.lane); continue; }
        r -= I_OUT;
        if (r < I_UQ) { const int nb = r / 3, kb = r % 3;
            tr_item((const float*)inptr(F, 9) + (size_t)l * 192 * 576, 192, 576, 32 * nb, 32, (bf16*)(F.ws + WS_WSMALL + OFF_WUQ) + ((size_t)l * 576 + 32 * nb) * 192, (const float*)inptr(F, 8) + l * 192, scr, kb, F.lane); continue; }
        r -= I_UQ;
        if (r < I_UKV) { const int nb = r >> 1, kb = r & 1;
            tr_item((const float*)inptr(F, 11) + (size_t)l * 128 * 768, 128, 768, 32 * nb, 32, (bf16*)(F.ws + WS_WSMALL + OFF_WUKV) + ((size_t)l * 768 + 32 * nb) * 128, (const float*)inptr(F, 10) + l * 128, scr, kb, F.lane); continue; }
        r -= I_UKV;
        if (r < I_W2) { const int e = r >> 3, nb = r & 7;
            tr_item((const float*)inptr(F, 14) + ((size_t)l * 2 + e) * 64 * 256, 64, 256, 32 * nb, 32, (bf16*)(F.ws + WS_WSMALL + OFF_W2T) + (((size_t)l * 2 + e) * 256 + 32 * nb) * 64, nullptr, scr, 0, F.lane); continue; }
        r -= I_W2;
        { const int e = r >> 3, nb = r & 7;
            tr_item((const float*)inptr(F, 16) + ((size_t)l * 2 + e) * 64 * 256, 64, 256, 32 * nb, 32, (bf16*)(F.ws + WS_WSMALL + OFF_A2T) + (((size_t)l * 2 + e) * 256 + 32 * nb) * 64, nullptr, scr, 0, F.lane); }
    }
    const float* x = (const float*)inptr(F, 0); bf16* xb = (bf16*)(F.ws + WS_XB); float* rowss = (float*)(F.ws + WS_ROWSS);
    for (int m = gw; m < M; m += NGW) {
        const GAS f32x4* xr = (const GAS f32x4*)(x + (size_t)m * D) + F.lane;
        GAS unsigned long long* o8 = (GAS unsigned long long*)(xb + (size_t)m * D) + F.lane; float s = 0.f;
#pragma unroll
        for (int j = 0; j < 4; ++j) { const f32x4 v = xr[64 * j]; s += (v.x * v.x + v.y * v.y) + (v.z * v.z + v.w * v.w);
            o8[64 * j] = (unsigned long long)pk2(v.x, v.y) | ((unsigned long long)pk2(v.z, v.w) << 32); }
        s = wave_sum(s);
        if (F.lane < 16) rowss[(size_t)m * 16 + F.lane] = F.lane == 0 ? s : 0.f;
    }
}
__device__ __forceinline__ void p5_final(Frame& F) {
    const int gw = F.vcu * NWAVES + F.wave, NGW = F.G * NWAVES;
    const float* rowss = (const float*)(F.ws + WS_ROWSS); const float* g = (const float*)inptr(F, 23);
    f32x4 gv[4];
#pragma unroll
    for (int j = 0; j < 4; ++j) gv[j] = ((const f32x4*)g)[F.lane + 64 * j];
    for (int m = gw; m < M; m += NGW) {
        float ss = F.lane < 16 ? rowss[(size_t)m * 16 + F.lane] : 0.f;
        ss = wave_sum(ss);
        const float rstd = rsqrtf(ss * (1.f / D) + NORM_EPS);
        GAS f32x4* xr = (GAS f32x4*)(F.out + (size_t)m * D) + F.lane;
#pragma unroll
        for (int j = 0; j < 4; ++j) { f32x4 v = xr[64 * j]; v = v * rstd * gv[j]; xr[64 * j] = v; }
    }
}
typedef float f32x16 __attribute__((ext_vector_type(16)));
typedef unsigned long long u64_t;
__device__ __forceinline__ bf16x8 mk_bf16x8(u64_t lo, u64_t hi) { typedef u64_t u64x2 __attribute__((ext_vector_type(2))); u64x2 v = {lo, hi}; return __builtin_bit_cast(bf16x8, v); }

constexpr int AT_KP = 208, AT_VP = 136, AT_KBYTES = 64 * AT_KP, AT_VBYTES = 64 * AT_VP, AT_BUF = AT_KBYTES + AT_VBYTES;
__device__ __forceinline__ float at_max3(float a, float b, float c) { float r; asm("v_max3_f32 %0, %1, %2, %3" : "=v"(r) : "v"(a), "v"(b), "v"(c)); return r; }
__device__ __forceinline__ void attn_unit(Frame& F, int unit) {
    const int bh = unit >> 3, qb = unit & 7, b = bh / 6, h = bh % 6;
    const int tid = F.tid, lane = F.lane, wave = F.wave, r32 = lane & 31, hi = lane >> 5;
    const bf16* Qg = (const bf16*)(F.ws + WS_Q) + ((size_t)bh * SEQ + qb * 256 + wave * 32 + r32) * 96;
    const bf16* Kg = (const bf16*)(F.ws + WS_K) + (size_t)bh * SEQ * 96;
    const bf16* Vg = (const bf16*)(F.ws + WS_VT) + (size_t)bh * 64 * SEQ;
    LAS unsigned char* lds = F.lds + RING_OFF;
    bf16x8 qf[6];
#pragma unroll
    for (int s = 0; s < 6; ++s) qf[s] = *(const bf16x8*)(Qg + 16 * s + 8 * hi);
    const int kr0 = tid / 12, kc0 = tid % 12, kr1 = (512 + tid) / 12, kc1 = (512 + tid) % 12, vd = tid >> 3, vc = tid & 7;
    const bool has1 = tid < 256;
    v4u ka0, ka1 = {0u, 0u, 0u, 0u}, va, kb0, kb1 = {0u, 0u, 0u, 0u}, vb;
#define AT_LOAD(K0, K1, V_, t0) do { K0 = *(const v4u*)(Kg + (size_t)((t0) + kr0) * 96 + kc0 * 8); if (has1) K1 = *(const v4u*)(Kg + (size_t)((t0) + kr1) * 96 + kc1 * 8); \
        V_ = *(const v4u*)(Vg + (size_t)vd * SEQ + (t0) + vc * 8); } while (0)
#define AT_STORE(K0, K1, V_, buf) do { LAS unsigned char* bb_ = lds + (buf) * AT_BUF; *(LAS v4u*)(bb_ + kr0 * AT_KP + kc0 * 16) = K0; if (has1) *(LAS v4u*)(bb_ + kr1 * AT_KP + kc1 * 16) = K1; \
        LAS u64_t* vp_ = (LAS u64_t*)(bb_ + AT_KBYTES + vd * AT_VP + vc * 16); vp_[0] = (u64_t)V_.x | ((u64_t)V_.y << 32); vp_[1] = (u64_t)V_.z | ((u64_t)V_.w << 32); } while (0)
    AT_LOAD(ka0, ka1, va, 0); AT_STORE(ka0, ka1, va, 0);
    AT_LOAD(ka0, ka1, va, 64);
    __syncthreads();
    f32x16 o0 = {}, o1 = {};
    float mrun = -1e30f, lsum = 0.f;
    constexpr int NT = SEQ / 64;
    auto tile = [&](int t) {
        LAS unsigned char* bb = lds + (t % 3) * AT_BUF;
        f32x16 p0 = {}, p1 = {};
        { const LAS unsigned char* kb = bb + r32 * AT_KP + hi * 16;
#pragma unroll
          for (int s = 0; s < 6; ++s) {
              const bf16x8 a0 = *(const LAS bf16x8*)(kb + 32 * s), a1 = *(const LAS bf16x8*)(kb + 32 * AT_KP + 32 * s);
              p0 = __builtin_amdgcn_mfma_f32_32x32x16_bf16(a0, qf[s], p0, 0, 0, 0);
              p1 = __builtin_amdgcn_mfma_f32_32x32x16_bf16(a1, qf[s], p1, 0, 0, 0); } }
        asm volatile("s_nop 15\n\ts_nop 7" : "+v"(p0), "+v"(p1));
        float ma = at_max3(p0[0], p0[1], p1[0]), mb = at_max3(p0[2], p0[3], p1[1]); ma = at_max3(ma, p1[2], p1[3]);
#pragma unroll
        for (int r = 4; r < 16; r += 4) { ma = at_max3(ma, p0[r], p0[r + 1]); mb = at_max3(mb, p0[r + 2], p0[r + 3]); ma = at_max3(ma, p1[r], p1[r + 1]); mb = at_max3(mb, p1[r + 2], p1[r + 3]); }
        float mloc = at_max3(ma, mb, mrun);
        { const auto rr = __builtin_amdgcn_permlane32_swap(__float_as_uint(mloc), __float_as_uint(mloc), false, false); mloc = at_max3(__uint_as_float(rr[0]), __uint_as_float(rr[1]), mloc); }
        const float mnew = mloc, alpha = __builtin_amdgcn_exp2f(mrun - mnew);
        mrun = mnew; lsum *= alpha;
#pragma unroll
        for (int r = 0; r < 16; ++r) { o0[r] *= alpha; o1[r] *= alpha; }
        float ps = 0.f;
#pragma unroll
        for (int r = 0; r < 16; ++r) { p0[r] = __builtin_amdgcn_exp2f(p0[r] - mnew); p1[r] = __builtin_amdgcn_exp2f(p1[r] - mnew); ps += p0[r] + p1[r]; }
        lsum += ps;
        v4u pk[4];
#pragma unroll
        for (int s2 = 0; s2 < 2; ++s2) {
            pk[s2] = (v4u){pg8::cvt_pk_bf16(p0[8 * s2], p0[8 * s2 + 1]), pg8::cvt_pk_bf16(p0[8 * s2 + 2], p0[8 * s2 + 3]), pg8::cvt_pk_bf16(p0[8 * s2 + 4], p0[8 * s2 + 5]), pg8::cvt_pk_bf16(p0[8 * s2 + 6], p0[8 * s2 + 7])};
            pk[2 + s2] = (v4u){pg8::cvt_pk_bf16(p1[8 * s2], p1[8 * s2 + 1]), pg8::cvt_pk_bf16(p1[8 * s2 + 2], p1[8 * s2 + 3]), pg8::cvt_pk_bf16(p1[8 * s2 + 4], p1[8 * s2 + 5]), pg8::cvt_pk_bf16(p1[8 * s2 + 6], p1[8 * s2 + 7])};
        }
        { const LAS unsigned char* vb_ = bb + AT_KBYTES + r32 * AT_VP + hi * 8;
#pragma unroll
          for (int ks = 0; ks < 4; ++ks) {
              const bf16x8 pb = __builtin_bit_cast(bf16x8, pk[ks]);
              const bf16x8 v0 = mk_bf16x8(*(const LAS u64_t*)(vb_ + ks * 32), *(const LAS u64_t*)(vb_ + ks * 32 + 16));
              const bf16x8 v1 = mk_bf16x8(*(const LAS u64_t*)(vb_ + 32 * AT_VP + ks * 32), *(const LAS u64_t*)(vb_ + 32 * AT_VP + ks * 32 + 16));
              o0 = __builtin_amdgcn_mfma_f32_32x32x16_bf16(v0, pb, o0, 0, 0, 0);
              o1 = __builtin_amdgcn_mfma_f32_32x32x16_bf16(v1, pb, o1, 0, 0, 0); } }
    };
    for (int t = 0; t < NT; t += 2) {
        if (t + 2 < NT) AT_LOAD(kb0, kb1, vb, (t + 2) * 64);
        tile(t);
        AT_STORE(ka0, ka1, va, (t + 1) % 3);
        __syncthreads();
        if (t + 3 < NT) AT_LOAD(ka0, ka1, va, (t + 3) * 64);
        tile(t + 1);
        if (t + 2 < NT) AT_STORE(kb0, kb1, vb, (t + 2) % 3);
        __syncthreads();
    }
#undef AT_LOAD
#undef AT_STORE
    lsum += __shfl_xor(lsum, 32);
    const float inv = 1.f / lsum;
    bf16* Og = (bf16*)(F.ws + WS_OMLA) + ((size_t)b * SEQ + qb * 256 + wave * 32 + r32) * 384 + h * 64 + 4 * hi;
#pragma unroll
    for (int rg = 0; rg < 4; ++rg) {
        *(u64_t*)(Og + 8 * rg) = (u64_t)pg8::cvt_pk_bf16(o0[4 * rg] * inv, o0[4 * rg + 1] * inv) | ((u64_t)pg8::cvt_pk_bf16(o0[4 * rg + 2] * inv, o0[4 * rg + 3] * inv) << 32);
        *(u64_t*)(Og + 32 + 8 * rg) = (u64_t)pg8::cvt_pk_bf16(o1[4 * rg] * inv, o1[4 * rg + 1] * inv) | ((u64_t)pg8::cvt_pk_bf16(o1[4 * rg + 2] * inv, o1[4 * rg + 3] * inv) << 32);
    }
}

constexpr int CW_FLAG = 32768;
__device__ __forceinline__ void partner_sync(Frame& F, gu32* mine, gu32* theirs) {
    asm volatile("s_waitcnt vmcnt(0)" ::: "memory");
    __syncthreads();
    if (F.tid == 0) {
        __builtin_amdgcn_fence(__ATOMIC_RELEASE, "agent");
        asm volatile("s_waitcnt vmcnt(0)" ::: "memory");
        __hip_atomic_store(mine, 1u, RLX_AGENT);
        unsigned spins = 0;
        while (__hip_atomic_load(theirs, RLX_AGENT) == 0u) { __builtin_amdgcn_s_sleep(4); if (++spins > (1u << 22)) break; }
        __builtin_amdgcn_fence(__ATOMIC_ACQUIRE, "agent");
        asm volatile("s_waitcnt vmcnt(0)" ::: "memory");
    }
    __syncthreads();
}
constexpr int RW_STEP = 1440, RW_CH = 32, RW_BUF = RW_CH * RW_STEP;
constexpr int RW_Y = 2 * RW_BUF;
static_assert(RW_Y + 2 * 4096 <= RING_BYTES, "RWKV LDS map");
__device__ __forceinline__ float dpp_xor1(float x) { return __builtin_bit_cast(float, __builtin_amdgcn_update_dpp(0, __builtin_bit_cast(int, x), 0xB1, 0xF, 0xF, true)); }
__device__ __forceinline__ float dpp_xor2(float x) { return __builtin_bit_cast(float, __builtin_amdgcn_update_dpp(0, __builtin_bit_cast(int, x), 0x4E, 0xF, 0xF, true)); }
__device__ __forceinline__ float dpp_hmir(float x) { return __builtin_bit_cast(float, __builtin_amdgcn_update_dpp(0, __builtin_bit_cast(int, x), 0x141, 0xF, 0xF, true)); }
__device__ __forceinline__ float dpp_rmir(float x) { return __builtin_bit_cast(float, __builtin_amdgcn_update_dpp(0, __builtin_bit_cast(int, x), 0x140, 0xF, 0xF, true)); }
template <int CTRL, int RM> __device__ __forceinline__ float dpp_sh(float x) { return __builtin_bit_cast(float, __builtin_amdgcn_update_dpp(0, __builtin_bit_cast(int, x), CTRL, RM, 0xF, false)); }
__device__ __forceinline__ float wave_scan(float x) {
    x += dpp_sh<0x111, 0xF>(x); x += dpp_sh<0x112, 0xF>(x); x += dpp_sh<0x114, 0xF>(x); x += dpp_sh<0x118, 0xF>(x);
    x += dpp_sh<0x142, 0xA>(x); x += dpp_sh<0x143, 0xC>(x); return x; }
__device__ __forceinline__ float lane63(float x) { return __builtin_bit_cast(float, __builtin_amdgcn_readlane(__builtin_bit_cast(int, x), 63)); }
constexpr int GP = 144;
constexpr int G_Q = 0, G_K = 9216, G_V = 18432, G_KT = 27648, G_P = 36864, G_A = 46080, G_SM = 63488, G_GROUP = 64512;
constexpr int G_T = 92160;
constexpr int G_RAW = 65536;
constexpr int G_CW = 133120;
static_assert(2 * G_GROUP <= RING_BYTES && G_CW + 3840 <= LDS_BYTES && G_CW >= MISC_OFF + 1024, "GDN LDS map");
__device__ __forceinline__ bf16x8 ld2x8(const LAS unsigned char* p) { return mk_bf16x8(*(const LAS u64_t*)p, *(const LAS u64_t*)(p + 32)); }
__device__ __forceinline__ bf16x8 pack_acc(const f32x4& a, const f32x4& b) {
    v4u w; w.x = pg8::cvt_pk_bf16(a[0], a[1]); w.y = pg8::cvt_pk_bf16(a[2], a[3]); w.z = pg8::cvt_pk_bf16(b[0], b[1]); w.w = pg8::cvt_pk_bf16(b[2], b[3]); return __builtin_bit_cast(bf16x8, w); }
__device__ __forceinline__ void split_acc(const f32x4& a, const f32x4& b, bf16x8& hi, bf16x8& lo) {
    v4u wh; wh.x = cvt2bf(a[0], a[1]); wh.y = cvt2bf(a[2], a[3]); wh.z = cvt2bf(b[0], b[1]); wh.w = cvt2bf(b[2], b[3]);
    f32x4 ra, rb;
    ra[0] = a[0] - __uint_as_float(wh.x << 16); ra[1] = a[1] - __uint_as_float(wh.x & 0xffff0000u); ra[2] = a[2] - __uint_as_float(wh.y << 16); ra[3] = a[3] - __uint_as_float(wh.y & 0xffff0000u);
    rb[0] = b[0] - __uint_as_float(wh.z << 16); rb[1] = b[1] - __uint_as_float(wh.z & 0xffff0000u); rb[2] = b[2] - __uint_as_float(wh.w << 16); rb[3] = b[3] - __uint_as_float(wh.w & 0xffff0000u);
    hi = __builtin_bit_cast(bf16x8, wh); lo = pack_acc(ra, rb);
}
__device__ __forceinline__ void hilo4(const f32x4& a, u64_t& hi, u64_t& lo) {
    const unsigned h0 = cvt2bf(a[0], a[1]), h1 = cvt2bf(a[2], a[3]);
    const float r0 = a[0] - __uint_as_float(h0 << 16), r1 = a[1] - __uint_as_float(h0 & 0xffff0000u), r2 = a[2] - __uint_as_float(h1 << 16), r3 = a[3] - __uint_as_float(h1 & 0xffff0000u);
    hi = (u64_t)h0 | ((u64_t)h1 << 32); lo = (u64_t)cvt2bf(r0, r1) | ((u64_t)cvt2bf(r2, r3) << 32);
}
typedef _Float16 f16x8 __attribute__((ext_vector_type(8)));
typedef _Float16 h4_t __attribute__((ext_vector_type(4)));
__device__ __forceinline__ f16x8 pack_acc_f16(const f32x4& a, const f32x4& b) { return (f16x8){(_Float16)a[0], (_Float16)a[1], (_Float16)a[2], (_Float16)a[3], (_Float16)b[0], (_Float16)b[1], (_Float16)b[2], (_Float16)b[3]}; }
template <int SKIP> __device__ __forceinline__ void gdn_unit3(Frame& F, int l, int unit, gu32* flags) {
    const int bh = unit >> 1, dir = unit & 1, b = bh / 6, h = bh % 6;
    const int tid = F.tid, lane = F.lane, wave = F.wave;
    const bf16* Pgdn = (const bf16*)(F.ws + WS_PGDN) + (size_t)b * SEQ * 1152 + h * 64; const float* Psm = (const float*)(F.ws + WS_PSM) + (size_t)b * SEQ * 32;
    bf16* Og = (SKIP & 128) ? (bf16*)(F.ws + WS_Y + 8 * MiB) + (size_t)(b % 5) * SEQ * 384 + h * 64 : (bf16*)(F.ws + WS_OGDN) + (size_t)b * SEQ * 384 + h * 64;
    LAS unsigned char* gb = F.lds + RING_OFF;
    LAS float* cwl = (LAS float*)(F.lds + G_CW);
    LAS float* sm = (LAS float*)(gb + G_SM);
    { const float* conv_w = (const float*)inptr(F, 4) + (size_t)l * 5 * 1152;
      for (int i = tid; i < 960; i += 512) { const int tn = i / 320, tap = (i % 320) / 64, ch = i % 64; cwl[i] = conv_w[tap * 1152 + tn * 384 + h * 64 + ch]; } }
    const float al = -__expf(((const float*)inptr(F, 5))[l * 12 + dir * 6 + h]), dtb = ((const float*)inptr(F, 6))[l * 12 + dir * 6 + h];
    f32x4 Sacc[4];
#pragma unroll
    for (int i = 0; i < 4; ++i) Sacc[i] = (f32x4){0.f, 0.f, 0.f, 0.f};
    const int ci = tid >> 3, cg = tid & 7;
#define GDN_RAW_STAGE(cc_, first_, nthr_) do { const int tlo_ = (dir ? SEQ - 64 * (cc_) - 64 : 64 * (cc_)) - 2; \
        for (int pc_ = (first_); pc_ < 68 * 24; pc_ += (nthr_)) { const int rr_ = pc_ / 24, sg_ = pc_ % 24, tt_ = tlo_ + rr_; v4u x_ = {0u, 0u, 0u, 0u}; \
            if (!(SKIP & 1) && tt_ >= 0 && tt_ < SEQ) x_ = *(const v4u*)(Pgdn + (size_t)tt_ * 1152 + (sg_ >> 3) * 384 + 8 * (sg_ & 7)); \
            *(LAS v4u*)(gb + G_RAW + rr_ * 384 + 16 * sg_) = x_; } } while (0)
#define GDN_WRITEOUT(cc_) do { if (!(SKIP & 4)) { const int t_ = dir ? SEQ - 1 - 64 * (cc_) - ci : 64 * (cc_) + ci; bf16* op_ = Og + (size_t)t_ * 384 + 8 * cg; \
            const LAS f32x4* src_ = (const LAS f32x4*)(gb + G_A + (ci * 68 + 8 * cg) * 4); f32x4 o0_ = src_[0], o1_ = src_[1]; \
            if ((cc_) >= SEQ / 128) { const v4u p0_ = *(const v4u*)op_; \
                o0_ += (f32x4){__uint_as_float(p0_.x << 16), __uint_as_float(p0_.x & 0xffff0000u), __uint_as_float(p0_.y << 16), __uint_as_float(p0_.y & 0xffff0000u)}; \
                o1_ += (f32x4){__uint_as_float(p0_.z << 16), __uint_as_float(p0_.z & 0xffff0000u), __uint_as_float(p0_.w << 16), __uint_as_float(p0_.w & 0xffff0000u)}; } \
            v4u w0_; w0_.x = pg8::cvt_pk_bf16(o0_[0], o0_[1]); w0_.y = pg8::cvt_pk_bf16(o0_[2], o0_[3]); w0_.z = pg8::cvt_pk_bf16(o1_[0], o1_[1]); w0_.w = pg8::cvt_pk_bf16(o1_[2], o1_[3]); \
            *(v4u*)op_ = w0_; } } while (0)
    GDN_RAW_STAGE(0, tid, 512);
#define GDN_RAW_LOAD(cc_) do { const int tlo_ = (dir ? SEQ - 64 * (cc_) - 64 : 64 * (cc_)) - 2; \
        _Pragma("unroll") for (int k_ = 0; k_ < 4; ++k_) { const int pc_ = tid + 512 * k_, rr_ = pc_ / 24, sg_ = pc_ % 24, tt_ = tlo_ + rr_; rawn[k_] = (v4u){0u, 0u, 0u, 0u}; \
            if (!(SKIP & 1) && pc_ < 68 * 24 && tt_ >= 0 && tt_ < SEQ) rawn[k_] = *(const v4u*)(Pgdn + (size_t)tt_ * 1152 + (sg_ >> 3) * 384 + 8 * (sg_ & 7)); } } while (0)
#define GDN_RAW_STORE() do { _Pragma("unroll") for (int k_ = 0; k_ < 4; ++k_) { const int pc_ = tid + 512 * k_, rr_ = pc_ / 24, sg_ = pc_ % 24; \
            if (pc_ < 68 * 24) *(LAS v4u*)(gb + G_RAW + rr_ * 384 + 16 * sg_) = rawn[k_]; } } while (0)
    v4u rawn[4];
    __syncthreads();
    for (int c = 0; c < SEQ / 64; ++c) {
        if (c > 0) GDN_WRITEOUT(c - 1);
        if (c == SEQ / 128) partner_sync(F, flags + 64 * unit, flags + 64 * (unit ^ 1));
        if (!(SKIP & 64) && wave == 0) {
            const int t = dir ? SEQ - 1 - 64 * c - lane : 64 * c + lane;
            const float a = Psm[(size_t)t * 32 + dir * 6 + h], bt = Psm[(size_t)t * 32 + 12 + dir * 6 + h];
            float x = al * softplusf_(a + dtb);
            x = wave_scan(x);
            const float last = lane63(x);
            sm[lane] = x; sm[64 + lane] = sigmoidf_(bt); sm[128 + lane] = __expf(x); sm[192 + lane] = __expf(last - x);
        }
        if (!(SKIP & 16)) { float acc[3][8];
#pragma unroll
          for (int tn = 0; tn < 3; ++tn)
#pragma unroll
              for (int j = 0; j < 8; ++j) acc[tn][j] = 0.f;
          const int rr0 = dir ? 63 - ci : ci;
#pragma unroll
          for (int tap = 0; tap < 5; ++tap) {
#pragma unroll
              for (int tn = 0; tn < 3; ++tn) { const v4u x0 = *(const LAS v4u*)(gb + G_RAW + (rr0 + tap) * 384 + tn * 128 + 16 * cg); const LAS float* w = cwl + tn * 320 + tap * 64 + 8 * cg; const f32x4 w0 = *(const LAS f32x4*)w, w1 = *(const LAS f32x4*)(w + 4);
                  acc[tn][0] += w0[0] * __uint_as_float(x0[0] << 16); acc[tn][1] += w0[1] * __uint_as_float(x0[0] & 0xffff0000u); acc[tn][2] += w0[2] * __uint_as_float(x0[1] << 16); acc[tn][3] += w0[3] * __uint_as_float(x0[1] & 0xffff0000u);
                  acc[tn][4] += w1[0] * __uint_as_float(x0[2] << 16); acc[tn][5] += w1[1] * __uint_as_float(x0[2] & 0xffff0000u); acc[tn][6] += w1[2] * __uint_as_float(x0[3] << 16); acc[tn][7] += w1[3] * __uint_as_float(x0[3] & 0xffff0000u); }
              asm volatile("" ::: "memory"); }
          float sq = 0.f, sk = 0.f;
#pragma unroll
          for (int j = 0; j < 8; ++j) { acc[0][j] = siluf(acc[0][j]); acc[1][j] = siluf(acc[1][j]); acc[2][j] = siluf(acc[2][j]); sq += acc[0][j] * acc[0][j]; sk += acc[1][j] * acc[1][j]; }
          sq += dpp_xor1(sq); sk += dpp_xor1(sk); sq += dpp_xor2(sq); sk += dpp_xor2(sk); sq += dpp_hmir(sq); sk += dpp_hmir(sk);
          const float rq = rsqrtf(sq + 1e-6f) * 0.125f, rk = rsqrtf(sk + 1e-6f);
          v4u wq, wk, wv;
#pragma unroll
          for (int q = 0; q < 4; ++q) { wq[q] = pg8::cvt_pk_bf16(acc[0][2 * q] * rq, acc[0][2 * q + 1] * rq); wk[q] = pg8::cvt_pk_bf16(acc[1][2 * q] * rk, acc[1][2 * q + 1] * rk); wv[q] = pg8::cvt_pk_bf16(acc[2][2 * q], acc[2][2 * q + 1]); }
          LAS unsigned char* row = gb + ci * GP + 16 * cg;
          *(LAS v4u*)(row + G_Q) = wq; *(LAS v4u*)(row + G_K) = wk; *(LAS v4u*)(row + G_V) = wv;
#pragma unroll
          for (int j = 0; j < 8; ++j) *(LAS bf16*)(gb + G_KT + (8 * cg + j) * GP + 2 * ci) = (bf16)((j & 1) ? (wk[j >> 1] >> 16) : (wk[j >> 1] & 0xffffu)); }
        __syncthreads();
        if (c + 1 < SEQ / 64) GDN_RAW_LOAD(c + 1);
        if (!(SKIP & 32)) { const int ti = (wave >> 1) & 1, tj = wave & 1, r32 = lane & 31, hi = lane >> 5;
          f32x16 acc = {};
          const LAS unsigned char* ir = gb + (wave >= 4 ? G_Q : G_K) + (32 * ti + r32) * GP + 16 * hi; const LAS unsigned char* jr = gb + G_K + (32 * tj + r32) * GP + 16 * hi;
#pragma unroll
          for (int s = 0; s < 4; ++s) acc = __builtin_amdgcn_mfma_f32_32x32x16_bf16(*(const LAS bf16x8*)(jr + 32 * s), *(const LAS bf16x8*)(ir + 32 * s), acc, 0, 0, 0);
          const int i = 32 * ti + r32; const float ci = sm[i];
          if (wave < 4) { const float bi = sm[64 + i];
#pragma unroll
              for (int g = 0; g < 4; ++g) { const int j0 = 32 * tj + 8 * g + 4 * hi; const f32x4 cj = *(const LAS f32x4*)(sm + j0); f32x4 o;
#pragma unroll
                  for (int r = 0; r < 4; ++r) o[r] = (i > j0 + r) ? bi * acc[4 * g + r] * __expf(fminf(ci - cj[r], 0.f)) : 0.f;
                  *(LAS f32x4*)((LAS float*)(gb + G_A) + i * 68 + j0) = o; } }
          else {
#pragma unroll
              for (int g = 0; g < 4; ++g) { const int j0 = 32 * tj + 8 * g + 4 * hi; const f32x4 cj = *(const LAS f32x4*)(sm + j0); h4_t o;
#pragma unroll
                  for (int r = 0; r < 4; ++r) o[r] = (_Float16)((i >= j0 + r) ? acc[4 * g + r] * __expf(fminf(ci - cj[r], 0.f)) : 0.f);
                  *(LAS h4_t*)(gb + G_P + i * GP + 2 * j0) = o; } } }
        __syncthreads();
        if (!(SKIP & 2) && wave == 0) {
            const int bb = lane >> 4, cc = lane & 15; float T[16];
            const LAS float* Ab = (const LAS float*)(gb + G_A) + (16 * bb) * 68 + 16 * bb;
#pragma unroll
            for (int i = 0; i < 16; ++i) { float a0 = 0.f, a1 = 0.f;
#pragma unroll
                for (int j4 = 0; j4 < (i + 3) / 4; ++j4) { const f32x4 av = *(const LAS f32x4*)(Ab + i * 68 + 4 * j4);
                    a0 += av.x * T[4 * j4] + av.z * T[4 * j4 + 2]; a1 += av.y * T[4 * j4 + 1] + av.w * T[4 * j4 + 3]; }
                T[i] = (i == cc ? 1.f : 0.f) - (a0 + a1);
                if (i < 15 && (i & 3) == 3) asm volatile("" ::: "memory");
                if (i == 0) {
#pragma unroll
                    for (int k = 1; k < 16; ++k) T[k] = 0.f; } }
#pragma unroll
            for (int i = 0; i < 16; ++i) ((LAS float*)(gb + G_T))[(16 * bb + i) * 16 + cc] = T[i];
        }
        __syncthreads();
        f32x4 Xc[4];
#pragma unroll
        for (int g = 0; g < 4; ++g) Xc[g] = (f32x4){0.f, 0.f, 0.f, 0.f};
        if (!(SKIP & 2)) {
            const int col = lane & 15, q4 = lane >> 4, c = 16 * wave + col;
            const LAS unsigned char* src = gb + (c < 64 ? G_V : G_K) + 2 * (c & 63);
            u64_t xh[4], xl[4];
#pragma unroll
            for (int bk = 0; bk < 4; ++bk) {
                f32x4 Y; const f32x4 be = *(const LAS f32x4*)(sm + 64 + 16 * bk + 4 * q4), ga = *(const LAS f32x4*)(sm + 128 + 16 * bk + 4 * q4);
#pragma unroll
                for (int r = 0; r < 4; ++r) Y[r] = bf2f(*(const LAS bf16*)(src + (16 * bk + 4 * q4 + r) * GP)) * be[r] * (c < 64 ? 1.f : ga[r]);
#pragma unroll
                for (int b2 = 0; b2 < bk; b2 += 2) {
                    const LAS float* ar = (const LAS float*)(gb + G_A) + (16 * bk + col) * 68 + 16 * b2 + 4 * q4;
                    f32x4 a0 = -*(const LAS f32x4*)ar, a1 = (b2 + 1 < bk) ? -*(const LAS f32x4*)(ar + 16) : (f32x4){0.f, 0.f, 0.f, 0.f};
                    u64_t ah0, al0, ah1, al1; hilo4(a0, ah0, al0); hilo4(a1, ah1, al1);
                    const u64_t bh1 = (b2 + 1 < bk) ? xh[b2 + 1] : 0ull, bl1 = (b2 + 1 < bk) ? xl[b2 + 1] : 0ull;
                    const bf16x8 Ah = mk_bf16x8(ah0, ah1), Al = mk_bf16x8(al0, al1), Bh = mk_bf16x8(xh[b2], bh1), Bl = mk_bf16x8(xl[b2], bl1);
                    Y = __builtin_amdgcn_mfma_f32_16x16x32_bf16(Al, Bh, Y, 0, 0, 0);
                    Y = __builtin_amdgcn_mfma_f32_16x16x32_bf16(Ah, Bl, Y, 0, 0, 0);
                    Y = __builtin_amdgcn_mfma_f32_16x16x32_bf16(Ah, Bh, Y, 0, 0, 0); }
                { const f32x4 t0 = *(const LAS f32x4*)((const LAS float*)(gb + G_T) + (16 * bk + col) * 16 + 4 * q4);
                  u64_t th, tl, yh, yl; hilo4(t0, th, tl); hilo4(Y, yh, yl);
                  const bf16x8 Ah = mk_bf16x8(th, 0ull), Al = mk_bf16x8(tl, 0ull), Bh = mk_bf16x8(yh, 0ull), Bl = mk_bf16x8(yl, 0ull);
                  f32x4 X = {0.f, 0.f, 0.f, 0.f};
                  X = __builtin_amdgcn_mfma_f32_16x16x32_bf16(Al, Bh, X, 0, 0, 0);
                  X = __builtin_amdgcn_mfma_f32_16x16x32_bf16(Ah, Bl, X, 0, 0, 0);
                  X = __builtin_amdgcn_mfma_f32_16x16x32_bf16(Ah, Bh, X, 0, 0, 0);
                  Xc[bk] = X; hilo4(X, xh[bk], xl[bk]); }
            }
        }
        __syncthreads();
        if (c + 1 < SEQ / 64) GDN_RAW_STORE();
        { const int col = lane & 15, q4 = lane >> 4, c = 16 * wave + col;
          if (wave < 4) {
#pragma unroll
              for (int g = 0; g < 4; ++g)
#pragma unroll
                  for (int r = 0; r < 4; ++r) ((LAS float*)(gb + G_A))[(16 * g + 4 * q4 + r) * 68 + c] = Xc[g][r];
          } else {
#pragma unroll
              for (int g = 0; g < 4; ++g)
#pragma unroll
                  for (int r = 0; r < 4; ++r) { const int i = 16 * g + 4 * q4 + r; const float x = -Xc[g][r]; const unsigned hb = f2bf(x);
                      *(LAS bf16*)(gb + G_V + i * GP + 2 * (c - 64)) = (bf16)hb;
                      *(LAS bf16*)(gb + G_K + i * GP + 2 * (c - 64)) = (bf16)f2bf(x - __uint_as_float(hb << 16)); }
          } }
        __syncthreads();
        if ((SKIP & 8) && wave < 4) {} else
        if (wave < 4) { const int col = lane & 15, q4 = lane >> 4, e = 16 * wave + col;
          bf16x8 bS0, bS1, bS0l, bS1l; split_acc(Sacc[0], Sacc[1], bS0, bS0l); split_acc(Sacc[2], Sacc[3], bS1, bS1l);
          f32x4 U[4], T1[4];
          const LAS unsigned char* rowa = gb + col * GP + 8 * q4;
#pragma unroll
          for (int it = 0; it < 4; ++it) {
              const LAS float* u0p = (const LAS float*)(gb + G_A) + (16 * it + 4 * q4) * 68 + e;
              U[it] = (f32x4){u0p[0], u0p[68], u0p[136], u0p[204]};
              const LAS unsigned char* ra = rowa + 16 * it * GP;
              const bf16x8 wh0 = ld2x8(ra + G_V), wh1 = ld2x8(ra + G_V + 64), wl0 = ld2x8(ra + G_K), wl1 = ld2x8(ra + G_K + 64), qa0 = ld2x8(ra + G_Q), qa1 = ld2x8(ra + G_Q + 64);
              U[it] = __builtin_amdgcn_mfma_f32_16x16x32_bf16(wl0, bS0, U[it], 0, 0, 0);
              U[it] = __builtin_amdgcn_mfma_f32_16x16x32_bf16(wl1, bS1, U[it], 0, 0, 0);
              U[it] = __builtin_amdgcn_mfma_f32_16x16x32_bf16(wh0, bS0l, U[it], 0, 0, 0);
              U[it] = __builtin_amdgcn_mfma_f32_16x16x32_bf16(wh1, bS1l, U[it], 0, 0, 0);
              U[it] = __builtin_amdgcn_mfma_f32_16x16x32_bf16(wh0, bS0, U[it], 0, 0, 0);
              U[it] = __builtin_amdgcn_mfma_f32_16x16x32_bf16(wh1, bS1, U[it], 0, 0, 0);
              T1[it] = __builtin_amdgcn_mfma_f32_16x16x32_bf16(qa0, bS0l, (f32x4){0.f, 0.f, 0.f, 0.f}, 0, 0, 0);
              T1[it] = __builtin_amdgcn_mfma_f32_16x16x32_bf16(qa1, bS1l, T1[it], 0, 0, 0);
              T1[it] = __builtin_amdgcn_mfma_f32_16x16x32_bf16(qa0, bS0, T1[it], 0, 0, 0);
              T1[it] = __builtin_amdgcn_mfma_f32_16x16x32_bf16(qa1, bS1, T1[it], 0, 0, 0);
              asm volatile("" ::: "memory");
          }
          const f16x8 hU0 = pack_acc_f16(U[0], U[1]), hU1 = pack_acc_f16(U[2], U[3]);
          f32x4 Ud[4];
#pragma unroll
          for (int it = 0; it < 4; ++it) { const f32x4 dc = *(const LAS f32x4*)(sm + 192 + 16 * it + 4 * q4); Ud[it] = U[it] * dc; }
          bf16x8 bD0, bD1, bD0l, bD1l; split_acc(Ud[0], Ud[1], bD0, bD0l); split_acc(Ud[2], Ud[3], bD1, bD1l);
          const float gend = sm[191];
#pragma unroll
          for (int it = 0; it < 4; ++it) {
              const LAS unsigned char* ra = rowa + 16 * it * GP;
              const f32x4 gm = *(const LAS f32x4*)(sm + 128 + 16 * it + 4 * q4);
              const bf16x8 pa0 = ld2x8(ra + G_P), pa1 = ld2x8(ra + G_P + 64), ka0 = ld2x8(ra + G_KT), ka1 = ld2x8(ra + G_KT + 64);
              f32x4 O = T1[it] * gm;
              O = __builtin_amdgcn_mfma_f32_16x16x32_f16(__builtin_bit_cast(f16x8, pa0), hU0, O, 0, 0, 0);
              O = __builtin_amdgcn_mfma_f32_16x16x32_f16(__builtin_bit_cast(f16x8, pa1), hU1, O, 0, 0, 0);
              f32x4 Sn = Sacc[it] * gend;
              Sn = __builtin_amdgcn_mfma_f32_16x16x32_bf16(ka0, bD0l, Sn, 0, 0, 0);
              Sn = __builtin_amdgcn_mfma_f32_16x16x32_bf16(ka1, bD1l, Sn, 0, 0, 0);
              Sn = __builtin_amdgcn_mfma_f32_16x16x32_bf16(ka0, bD0, Sn, 0, 0, 0);
              Sn = __builtin_amdgcn_mfma_f32_16x16x32_bf16(ka1, bD1, Sn, 0, 0, 0);
              Sacc[it] = Sn;
#pragma unroll
              for (int r = 0; r < 4; ++r) ((LAS float*)(gb + G_A))[(16 * it + 4 * q4 + r) * 68 + e] = O[r];
              asm volatile("" ::: "memory");
          } }
        __syncthreads();
    }
    GDN_WRITEOUT(SEQ / 64 - 1);
#undef GDN_WRITEOUT
#undef GDN_RAW_STAGE
#undef GDN_RAW_LOAD
#undef GDN_RAW_STORE
    __syncthreads();
}

constexpr int RC_AT = 0, RC_RT = 9216, RC_BT = 18432, RC_KT = 27648, RC_BH = 36864, RC_KH = 46080, RC_VT = 55296, RC_V = 64512, RC_A = 73728  ,
              RC_AK = 91136, RC_RB = 100352, RC_RK = 109568, RC_T = 118784  , RC_SM = 122880  , RC_R2 = RC_BT  ;
static_assert(RC_SM + 256 <= RING_BYTES && RC_R2 + 17408 <= RC_BH, "chunked RWKV LDS map");
template <int SK> __device__ __forceinline__ void rwkv_unit_c(Frame& F, int unit, gu32* flags) {
    const int bh = unit >> 1, dir = unit & 1, b = bh >> 2, h = bh & 3;
    const int tid = F.tid, lane = F.lane, wave = F.wave;
    const unsigned char* Rs = F.ws + WS_RS;
    const unsigned char* Rd = F.ws + WS_RD + dir * RD_DIR;
    bf16* Yg = (bf16*)(F.ws + WS_Y + (SK ? 8 * MiB : 0)) + (size_t)b * SEQ * 256 + h * 64;
    LAS unsigned char* gb = F.lds + RING_OFF;
    LAS float* gamT = (LAS float*)(gb + RC_SM);
    f32x4 Zacc[4];
#pragma unroll
    for (int i = 0; i < 4; ++i) Zacc[i] = (f32x4){0.f, 0.f, 0.f, 0.f};
    const int ci = tid >> 3, cg = tid & 7;
#define RC_WRITEOUT(cc_) do { const int t_ = dir ? SEQ - 1 - 64 * (cc_) - ci : 64 * (cc_) + ci; bf16* op_ = Yg + (size_t)t_ * 256 + 8 * cg; \
        const LAS f32x4* src_ = (const LAS f32x4*)(gb + RC_A + (ci * 68 + 8 * cg) * 4); f32x4 o0_ = src_[0], o1_ = src_[1]; \
        if ((cc_) >= SEQ / 128) { const v4u p0_ = *(const v4u*)op_; \
            o0_ += (f32x4){__uint_as_float(p0_.x << 16), __uint_as_float(p0_.x & 0xffff0000u), __uint_as_float(p0_.y << 16), __uint_as_float(p0_.y & 0xffff0000u)}; \
            o1_ += (f32x4){__uint_as_float(p0_.z << 16), __uint_as_float(p0_.z & 0xffff0000u), __uint_as_float(p0_.w << 16), __uint_as_float(p0_.w & 0xffff0000u)}; } \
        v4u w0_; w0_.x = pg8::cvt_pk_bf16(o0_[0], o0_[1]); w0_.y = pg8::cvt_pk_bf16(o0_[2], o0_[3]); w0_.z = pg8::cvt_pk_bf16(o1_[0], o1_[1]); w0_.w = pg8::cvt_pk_bf16(o1_[2], o1_[3]); \
        *(v4u*)op_ = w0_; } while (0)
    v4u gkk = {0u, 0u, 0u, 0u}, gv = gkk, gr = gkk, glam = gkk, gbv = gkk, gk = gkk;
#define RC_LOAD(cc_) do { if (!(SK & 1)) { const size_t o_ = rw_rec_off(bh, dir ? SEQ - 1 - 64 * (cc_) - lane : 64 * (cc_) + lane, 0, wave); const unsigned char* rs_ = Rs + o_; const unsigned char* rd_ = Rd + o_; \
        gkk = *(const v4u*)rs_; gv = *(const v4u*)(rs_ + 8192); gr = *(const v4u*)(rs_ + 16384); glam = *(const v4u*)rd_; gbv = *(const v4u*)(rd_ + 8192); gk = *(const v4u*)(rd_ + 16384); } } while (0)
    RC_LOAD(0);
    __syncthreads();
    for (int c = 0; c < SEQ / 64; ++c) {
        if (c > 0) RC_WRITEOUT(c - 1);
        if (c == SEQ / 128) partner_sync(F, flags + 64 * unit, flags + 64 * (unit ^ 1));
        if (!(SK & 32)) { const int t = lane, tok = dir ? SEQ - 1 - 64 * c - t : 64 * c + t, j0 = 8 * wave;
          float lam[8], cum[8];
#pragma unroll
          for (int q = 0; q < 4; ++q) { lam[2 * q] = __half2float(__ushort_as_half((unsigned short)(glam[q] & 0xffffu))); lam[2 * q + 1] = __half2float(__ushort_as_half((unsigned short)(glam[q] >> 16))); }
#pragma unroll
          for (int q = 0; q < 8; ++q) cum[q] = wave_scan(lam[q]);
          v4u wa = {0u, 0u, 0u, 0u}, wr = {0u, 0u, 0u, 0u}, wb = {0u, 0u, 0u, 0u}, wk = {0u, 0u, 0u, 0u}; unsigned short bh_[8], kh_[8];
#pragma unroll
          for (int q = 0; q < 8; ++q) { const float cT = lane63(cum[q]);
              const float e1 = __builtin_amdgcn_exp2f(-LOG2E * (cum[q] - lam[q])), e2 = __builtin_amdgcn_exp2f(-LOG2E * cum[q]), e3 = __builtin_amdgcn_exp2f(LOG2E * cum[q]), e4 = __builtin_amdgcn_exp2f(-LOG2E * (cT - cum[q]));
              const float kkq = __uint_as_float((q & 1) ? (gkk[q >> 1] & 0xffff0000u) : (gkk[q >> 1] << 16)), rq = __uint_as_float((q & 1) ? (gr[q >> 1] & 0xffff0000u) : (gr[q >> 1] << 16));
              const float bq = __uint_as_float((q & 1) ? (gbv[q >> 1] & 0xffff0000u) : (gbv[q >> 1] << 16)), kq = __uint_as_float((q & 1) ? (gk[q >> 1] & 0xffff0000u) : (gk[q >> 1] << 16));
              const unsigned a16 = f2bf(-kkq * e1), r16 = f2bf(rq * e2), b16 = f2bf(bq * e3), k16 = f2bf(kq * e3);
              if (q & 1) { wa[q >> 1] |= a16 << 16; wr[q >> 1] |= r16 << 16; wb[q >> 1] |= b16 << 16; wk[q >> 1] |= k16 << 16; } else { wa[q >> 1] = a16; wr[q >> 1] = r16; wb[q >> 1] = b16; wk[q >> 1] = k16; }
              bh_[q] = (unsigned short)f2bf(bq * e4); kh_[q] = (unsigned short)f2bf(kq * e4);
              if (lane == 63) gamT[j0 + q] = e2; }
          LAS unsigned char* row = gb + t * GP + 2 * j0;
          *(LAS v4u*)(row + RC_AT) = wa; *(LAS v4u*)(row + RC_RT) = wr; *(LAS v4u*)(row + RC_BT) = wb; *(LAS v4u*)(row + RC_KT) = wk; *(LAS v4u*)(row + RC_V) = gv;
#pragma unroll
          for (int q = 0; q < 8; ++q) { LAS unsigned char* tr = gb + (j0 + q) * GP + 2 * t;
              *(LAS bf16*)(tr + RC_BH) = bh_[q]; *(LAS bf16*)(tr + RC_KH) = kh_[q];
              *(LAS bf16*)(tr + RC_VT) = (bf16)((q & 1) ? (gv[q >> 1] >> 16) : (gv[q >> 1] & 0xffffu)); } }
        __syncthreads();
        if (c + 1 < SEQ / 64) RC_LOAD(c + 1);
        if (!(SK & 2)) { const int rb = wave >> 1, r32 = lane & 31, hi = lane >> 5;
          const LAS unsigned char* xr = gb + (rb < 2 ? RC_AT : RC_RT) + (32 * (rb & 1) + r32) * GP + 16 * hi; const int tt = 32 * (rb & 1) + r32;
#pragma unroll
          for (int k2 = 0; k2 < 2; ++k2) { const int cb = 2 * (wave & 1) + k2;
              const LAS unsigned char* yr = gb + (cb < 2 ? RC_BT : RC_KT) + (32 * (cb & 1) + r32) * GP + 16 * hi;
              f32x16 acc = {};
#pragma unroll
              for (int s = 0; s < 4; ++s) acc = __builtin_amdgcn_mfma_f32_32x32x16_bf16(*(const LAS bf16x8*)(yr + 32 * s), *(const LAS bf16x8*)(xr + 32 * s), acc, 0, 0, 0);
              if (rb < 2 && cb < 2) {
#pragma unroll
                  for (int g = 0; g < 4; ++g) { const int s0 = 32 * (cb & 1) + 8 * g + 4 * hi; f32x4 o;
#pragma unroll
                      for (int r = 0; r < 4; ++r) o[r] = (tt > s0 + r) ? -acc[4 * g + r] : 0.f;
                      *(LAS f32x4*)((LAS float*)(gb + RC_A) + tt * 68 + s0) = o; } }
              else { const int incl = rb >= 2 ? 1 : 0; LAS unsigned char* dst = gb + (rb < 2 ? RC_AK : (cb < 2 ? RC_RB : RC_RK)) + tt * GP;
#pragma unroll
                  for (int g = 0; g < 4; ++g) { const int s0 = 32 * (cb & 1) + 8 * g + 4 * hi; f32x4 o;
#pragma unroll
                      for (int r = 0; r < 4; ++r) o[r] = (tt + incl > s0 + r) ? acc[4 * g + r] : 0.f;
                      *(LAS u64_t*)(dst + 2 * s0) = (u64_t)pg8::cvt_pk_bf16(o[0], o[1]) | ((u64_t)pg8::cvt_pk_bf16(o[2], o[3]) << 32); } } } }
        __syncthreads();
        if (!(SK & 4)) { const int col = lane & 15, q4 = lane >> 4, it = wave >> 1;
#pragma unroll
          for (int k2 = 0; k2 < 2; ++k2) { const int ct = 2 * (wave & 1) + k2; f32x4 acc = {0.f, 0.f, 0.f, 0.f};
              const LAS unsigned char* pa = gb + RC_AK + (16 * it + col) * GP + 8 * q4; const LAS unsigned char* pb = gb + RC_VT + (16 * ct + col) * GP + 8 * q4;
              acc = __builtin_amdgcn_mfma_f32_16x16x32_bf16(ld2x8(pa), ld2x8(pb), acc, 0, 0, 0);
              acc = __builtin_amdgcn_mfma_f32_16x16x32_bf16(ld2x8(pa + 64), ld2x8(pb + 64), acc, 0, 0, 0);
#pragma unroll
              for (int r = 0; r < 4; ++r) ((LAS float*)(gb + RC_R2))[(16 * it + 4 * q4 + r) * 68 + 16 * ct + col] = acc[r]; } }
        if (!(SK & 4) && wave == 0) {
            const int bb = lane >> 4, cc = lane & 15; float T[16];
            const LAS float* Ab = (const LAS float*)(gb + RC_A) + (16 * bb) * 68 + 16 * bb;
#pragma unroll
            for (int i = 0; i < 16; ++i) { float a0 = 0.f, a1 = 0.f;
#pragma unroll
                for (int j4 = 0; j4 < (i + 3) / 4; ++j4) { const f32x4 av = *(const LAS f32x4*)(Ab + i * 68 + 4 * j4);
                    a0 += av.x * T[4 * j4] + av.z * T[4 * j4 + 2]; a1 += av.y * T[4 * j4 + 1] + av.w * T[4 * j4 + 3]; }
                T[i] = (i == cc ? 1.f : 0.f) - (a0 + a1);
                if (i < 15 && (i & 3) == 3) asm volatile("" ::: "memory");
                if (i == 0) {
#pragma unroll
                    for (int k = 1; k < 16; ++k) T[k] = 0.f; } }
#pragma unroll
            for (int i = 0; i < 16; ++i) ((LAS float*)(gb + RC_T))[(16 * bb + i) * 16 + cc] = T[i];
        }
        __syncthreads();
        f32x4 Xc[4];
#pragma unroll
        for (int g = 0; g < 4; ++g) Xc[g] = (f32x4){0.f, 0.f, 0.f, 0.f};
        if (!(SK & 8)) { const int col = lane & 15, q4 = lane >> 4, cidx = 16 * wave + col;
          u64_t xh[4], xl[4]; f32x4 Yin[4];
          if (wave < 4) {
#pragma unroll
              for (int bk = 0; bk < 4; ++bk)
#pragma unroll
                  for (int r = 0; r < 4; ++r) Yin[bk][r] = bf2f(*(const LAS bf16*)(gb + RC_AT + (16 * bk + 4 * q4 + r) * GP + 2 * cidx));
          } else {
#pragma unroll
              for (int bk = 0; bk < 4; ++bk)
#pragma unroll
                  for (int r = 0; r < 4; ++r) Yin[bk][r] = ((const LAS float*)(gb + RC_R2))[(16 * bk + 4 * q4 + r) * 68 + (cidx - 64)];
          }
#pragma unroll
          for (int bk = 0; bk < 4; ++bk) {
              f32x4 Y = Yin[bk];
#pragma unroll
              for (int b2 = 0; b2 < bk; b2 += 2) {
                  const LAS float* ar = (const LAS float*)(gb + RC_A) + (16 * bk + col) * 68 + 16 * b2 + 4 * q4;
                  f32x4 a0 = -*(const LAS f32x4*)ar, a1 = (b2 + 1 < bk) ? -*(const LAS f32x4*)(ar + 16) : (f32x4){0.f, 0.f, 0.f, 0.f};
                  u64_t ah0, al0, ah1, al1; hilo4(a0, ah0, al0); hilo4(a1, ah1, al1);
                  const u64_t bh1 = (b2 + 1 < bk) ? xh[b2 + 1] : 0ull, bl1 = (b2 + 1 < bk) ? xl[b2 + 1] : 0ull;
                  const bf16x8 Ah = mk_bf16x8(ah0, ah1), Al = mk_bf16x8(al0, al1), Bh = mk_bf16x8(xh[b2], bh1), Bl = mk_bf16x8(xl[b2], bl1);
                  Y = __builtin_amdgcn_mfma_f32_16x16x32_bf16(Al, Bh, Y, 0, 0, 0);
                  Y = __builtin_amdgcn_mfma_f32_16x16x32_bf16(Ah, Bl, Y, 0, 0, 0);
                  Y = __builtin_amdgcn_mfma_f32_16x16x32_bf16(Ah, Bh, Y, 0, 0, 0); }
              { const f32x4 t0 = *(const LAS f32x4*)((const LAS float*)(gb + RC_T) + (16 * bk + col) * 16 + 4 * q4);
                u64_t th, tl, yh, yl; hilo4(t0, th, tl); hilo4(Y, yh, yl);
                const bf16x8 Ah = mk_bf16x8(th, 0ull), Al = mk_bf16x8(tl, 0ull), Bh = mk_bf16x8(yh, 0ull), Bl = mk_bf16x8(yl, 0ull);
                f32x4 X = {0.f, 0.f, 0.f, 0.f};
                X = __builtin_amdgcn_mfma_f32_16x16x32_bf16(Al, Bh, X, 0, 0, 0);
                X = __builtin_amdgcn_mfma_f32_16x16x32_bf16(Ah, Bl, X, 0, 0, 0);
                X = __builtin_amdgcn_mfma_f32_16x16x32_bf16(Ah, Bh, X, 0, 0, 0);
                Xc[bk] = X; hilo4(X, xh[bk], xl[bk]); }
          } }
        __syncthreads();
        { const int col = lane & 15, q4 = lane >> 4, cidx = 16 * wave + col;
          if (wave < 4) {
#pragma unroll
              for (int g = 0; g < 4; ++g)
#pragma unroll
                  for (int r = 0; r < 4; ++r) { const int i = 16 * g + 4 * q4 + r; const float x = Xc[g][r]; const unsigned hb = f2bf(x);
                      *(LAS bf16*)(gb + RC_AT + i * GP + 2 * cidx) = (bf16)hb; *(LAS bf16*)(gb + RC_AK + i * GP + 2 * cidx) = (bf16)f2bf(x - __uint_as_float(hb << 16)); }
          } else {
#pragma unroll
              for (int g = 0; g < 4; ++g)
#pragma unroll
                  for (int r = 0; r < 4; ++r) ((LAS float*)(gb + RC_A))[(16 * g + 4 * q4 + r) * 68 + (cidx - 64)] = Xc[g][r];
          } }
        __syncthreads();
        if (!(SK & 16) && wave < 4) { const int col = lane & 15, q4 = lane >> 4, e = 16 * wave + col;
          bf16x8 bZ0, bZ1, bZ0l, bZ1l; split_acc(Zacc[0], Zacc[1], bZ0, bZ0l); split_acc(Zacc[2], Zacc[3], bZ1, bZ1l);
          f32x4 U[4], Yo[4], Vc[4];
          const LAS unsigned char* rowa = gb + col * GP + 8 * q4;
#pragma unroll
          for (int it = 0; it < 4; ++it) {
              const LAS float* u0p = (const LAS float*)(gb + RC_A) + (16 * it + 4 * q4) * 68 + e;
              U[it] = (f32x4){u0p[0], u0p[68], u0p[136], u0p[204]};
#pragma unroll
              for (int r = 0; r < 4; ++r) Vc[it][r] = bf2f(*(const LAS bf16*)(gb + RC_V + (16 * it + 4 * q4 + r) * GP + 2 * e));
              const LAS unsigned char* ra = rowa + 16 * it * GP;
              const bf16x8 wh0 = ld2x8(ra + RC_AT), wh1 = ld2x8(ra + RC_AT + 64), wl0 = ld2x8(ra + RC_AK), wl1 = ld2x8(ra + RC_AK + 64), qa0 = ld2x8(ra + RC_RT), qa1 = ld2x8(ra + RC_RT + 64);
              U[it] = __builtin_amdgcn_mfma_f32_16x16x32_bf16(wl0, bZ0, U[it], 0, 0, 0);
              U[it] = __builtin_amdgcn_mfma_f32_16x16x32_bf16(wl1, bZ1, U[it], 0, 0, 0);
              U[it] = __builtin_amdgcn_mfma_f32_16x16x32_bf16(wh0, bZ0l, U[it], 0, 0, 0);
              U[it] = __builtin_amdgcn_mfma_f32_16x16x32_bf16(wh1, bZ1l, U[it], 0, 0, 0);
              U[it] = __builtin_amdgcn_mfma_f32_16x16x32_bf16(wh0, bZ0, U[it], 0, 0, 0);
              U[it] = __builtin_amdgcn_mfma_f32_16x16x32_bf16(wh1, bZ1, U[it], 0, 0, 0);
              Yo[it] = __builtin_amdgcn_mfma_f32_16x16x32_bf16(qa0, bZ0l, (f32x4){0.f, 0.f, 0.f, 0.f}, 0, 0, 0);
              Yo[it] = __builtin_amdgcn_mfma_f32_16x16x32_bf16(qa1, bZ1l, Yo[it], 0, 0, 0);
              Yo[it] = __builtin_amdgcn_mfma_f32_16x16x32_bf16(qa0, bZ0, Yo[it], 0, 0, 0);
              Yo[it] = __builtin_amdgcn_mfma_f32_16x16x32_bf16(qa1, bZ1, Yo[it], 0, 0, 0);
              asm volatile("" ::: "memory");
          }
          bf16x8 bU0, bU1, bU0l, bU1l; split_acc(U[0], U[1], bU0, bU0l); split_acc(U[2], U[3], bU1, bU1l);
          const bf16x8 bV0 = pack_acc(Vc[0], Vc[1]), bV1 = pack_acc(Vc[2], Vc[3]);
#pragma unroll
          for (int it = 0; it < 4; ++it) {
              const LAS unsigned char* ra = rowa + 16 * it * GP;
              const bf16x8 pb0 = ld2x8(ra + RC_RB), pb1 = ld2x8(ra + RC_RB + 64), pk0 = ld2x8(ra + RC_RK), pk1 = ld2x8(ra + RC_RK + 64);
              const bf16x8 hb0 = ld2x8(ra + RC_BH), hb1 = ld2x8(ra + RC_BH + 64), hk0 = ld2x8(ra + RC_KH), hk1 = ld2x8(ra + RC_KH + 64);
              f32x4 O = Yo[it];
              O = __builtin_amdgcn_mfma_f32_16x16x32_bf16(pb0, bU0l, O, 0, 0, 0);
              O = __builtin_amdgcn_mfma_f32_16x16x32_bf16(pb1, bU1l, O, 0, 0, 0);
              O = __builtin_amdgcn_mfma_f32_16x16x32_bf16(pk0, bV0, O, 0, 0, 0);
              O = __builtin_amdgcn_mfma_f32_16x16x32_bf16(pk1, bV1, O, 0, 0, 0);
              O = __builtin_amdgcn_mfma_f32_16x16x32_bf16(pb0, bU0, O, 0, 0, 0);
              O = __builtin_amdgcn_mfma_f32_16x16x32_bf16(pb1, bU1, O, 0, 0, 0);
              const f32x4 gz = *(const LAS f32x4*)(gamT + 16 * it + 4 * q4);
              f32x4 Zn = Zacc[it] * gz;
              Zn = __builtin_amdgcn_mfma_f32_16x16x32_bf16(hb0, bU0l, Zn, 0, 0, 0);
              Zn = __builtin_amdgcn_mfma_f32_16x16x32_bf16(hb1, bU1l, Zn, 0, 0, 0);
              Zn = __builtin_amdgcn_mfma_f32_16x16x32_bf16(hk0, bV0, Zn, 0, 0, 0);
              Zn = __builtin_amdgcn_mfma_f32_16x16x32_bf16(hk1, bV1, Zn, 0, 0, 0);
              Zn = __builtin_amdgcn_mfma_f32_16x16x32_bf16(hb0, bU0, Zn, 0, 0, 0);
              Zn = __builtin_amdgcn_mfma_f32_16x16x32_bf16(hb1, bU1, Zn, 0, 0, 0);
              Zacc[it] = Zn;
#pragma unroll
              for (int r = 0; r < 4; ++r) ((LAS float*)(gb + RC_A))[(16 * it + 4 * q4 + r) * 68 + e] = O[r];
              asm volatile("" ::: "memory");
          } }
        __syncthreads();
    }
    RC_WRITEOUT(SEQ / 64 - 1);
#undef RC_WRITEOUT
#undef RC_LOAD
    __syncthreads();
}
__device__ __forceinline__ int next_unit(Frame& F, gu32* head) {
    __syncthreads();
    if (F.tid == 0) F.MISC[16] = __hip_atomic_fetch_add(head, 1u, RLX_AGENT);
    __syncthreads();
    return (int)F.MISC[16];
}
constexpr int U_GDN = 96, U_RWKV = 64, U_ATT = 384, U_ALL = U_GDN + U_RWKV + U_ATT;
__device__ __forceinline__ void p3_mixers(Frame& F, int l, int rep) {
    gu32* head = F.ctl + CW_QUEUE + 64 * (2 * l + rep);
    for (;;) {
        const int u = next_unit(F, head);
        if (u >= U_ALL) break;
        asm volatile("" : "+v"(F.tid), "+v"(F.lane));
        if (u < U_GDN) {
#ifdef EXP_GDN
            gdn_unit3<EXP_GDN>(F, l, u, F.ctl + CW_FLAG + 64 * 256 * (4 + 2 * l + rep) + 64 * 128); asm volatile("" : "+v"(F.tid), "+v"(F.lane));
#endif
            gdn_unit3<0>(F, l, u, F.ctl + CW_FLAG + 64 * 256 * (2 * l + rep) + 64 * 128); }
        else if (u < U_GDN + U_RWKV) {
#ifdef EXP_RWKV
            rwkv_unit_c<EXP_RWKV>(F, u - U_GDN, F.ctl + CW_FLAG + 64 * 256 * (4 + 2 * l + rep)); asm volatile("" : "+v"(F.tid), "+v"(F.lane));
#endif
            rwkv_unit_c<0>(F, u - U_GDN, F.ctl + CW_FLAG + 64 * 256 * (2 * l + rep)); }
        else attn_unit(F, u - U_GDN - U_RWKV);
    }
}
__device__ __forceinline__ f32x4 bf4(u64_t x) { return (f32x4){__uint_as_float(((unsigned)x) << 16), __uint_as_float(((unsigned)x) & 0xffff0000u), __uint_as_float(((unsigned)(x >> 32)) << 16), __uint_as_float(((unsigned)(x >> 32)) & 0xffff0000u)}; }
__device__ __forceinline__ u64_t pk4(const f32x4& v) { return (u64_t)pg8::cvt_pk_bf16(v[0], v[1]) | ((u64_t)pg8::cvt_pk_bf16(v[2], v[3]) << 32); }
__device__ __forceinline__ void p2_mla_unit(Frame& F, int l, int unit) {
    const int lane = F.lane, col = lane & 15, q4 = lane >> 4, m = 16 * unit + col, b = m / SEQ, t = m % SEQ, t0 = (16 * unit) % SEQ;
    const bf16* prow = (const bf16*)(F.ws + WS_PMLA) + (size_t)m * 352;
    const bf16* WuqT = (const bf16*)(F.ws + WS_WSMALL + OFF_WUQ) + (size_t)l * 576 * 192 + (size_t)col * 192 + 8 * q4;
    const bf16* WukvT = (const bf16*)(F.ws + WS_WSMALL + OFF_WUKV) + (size_t)l * 768 * 128 + (size_t)col * 128 + 8 * q4;
    bf16x8 aq[6], akv[4]; float sq = 0.f, skv = 0.f;
#pragma unroll
    for (int s = 0; s < 6; ++s) { aq[s] = *(const bf16x8*)(prow + 32 * s + 8 * q4); const v4u u = __builtin_bit_cast(v4u, aq[s]);
#pragma unroll
        for (int i = 0; i < 4; ++i) { const float a = __uint_as_float(u[i] << 16), c = __uint_as_float(u[i] & 0xffff0000u); sq += a * a + c * c; } }
#pragma unroll
    for (int s = 0; s < 4; ++s) { akv[s] = *(const bf16x8*)(prow + 192 + 32 * s + 8 * q4); const v4u u = __builtin_bit_cast(v4u, akv[s]);
#pragma unroll
        for (int i = 0; i < 4; ++i) { const float a = __uint_as_float(u[i] << 16), c = __uint_as_float(u[i] & 0xffff0000u); skv += a * a + c * c; } }
    sq += __shfl_xor(sq, 16); sq += __shfl_xor(sq, 32); skv += __shfl_xor(skv, 16); skv += __shfl_xor(skv, 32);
    const float rq = rsqrtf(sq * (1.f / 192.f) + NORM_EPS) * (0.10206207261596575f * LOG2E), rkv = rsqrtf(skv * (1.f / 128.f) + NORM_EPS);
    const float pos = (float)((const int*)inptr(F, 1))[m];
    f32x4 cs, sn;
#pragma unroll
    for (int r = 0; r < 4; ++r) { const float inv = exp2f(-(float)(4 * q4 + r) * (13.287712379549449f / 16.f)); float s_, c_; sincosf(pos * inv, &s_, &c_); cs[r] = c_; sn[r] = s_; }
    bf16* Qo = (bf16*)(F.ws + WS_Q) + ((size_t)b * 6 * SEQ + t) * 96 + 4 * q4;
    bf16* Ko = (bf16*)(F.ws + WS_K) + ((size_t)b * 6 * SEQ + t) * 96 + 4 * q4;
    bf16* Vo = (bf16*)(F.ws + WS_VT) + (size_t)b * 6 * 64 * SEQ + (size_t)col * SEQ + t0 + 4 * q4;
    { const u64_t x1 = *(const u64_t*)(prow + 320 + 4 * q4), x2 = *(const u64_t*)(prow + 336 + 4 * q4); const f32x4 a = bf4(x1), c = bf4(x2);
      const u64_t o1 = pk4(a * cs - c * sn), o2 = pk4(c * cs + a * sn);
#pragma unroll
      for (int h = 0; h < 6; ++h) { *(u64_t*)(Ko + (size_t)h * SEQ * 96 + 64) = o1; *(u64_t*)(Ko + (size_t)h * SEQ * 96 + 80) = o2; } }
#pragma unroll 2
    for (int h = 0; h < 6; ++h) {
        f32x4 x1v = {0.f, 0.f, 0.f, 0.f};
#pragma unroll
        for (int nt = 0; nt < 6; ++nt) {
            const bf16* w = WuqT + (size_t)(h * 96 + 16 * nt) * 192; f32x4 acc = {0.f, 0.f, 0.f, 0.f};
#pragma unroll
            for (int s = 0; s < 6; ++s) acc = __builtin_amdgcn_mfma_f32_16x16x32_bf16(*(const bf16x8*)(w + 32 * s), aq[s], acc, 0, 0, 0);
            acc = acc * rq;
            if (nt < 4) *(u64_t*)(Qo + (size_t)h * SEQ * 96 + 16 * nt) = pk4(acc);
            else if (nt == 4) x1v = acc;
            else { *(u64_t*)(Qo + (size_t)h * SEQ * 96 + 64) = pk4(x1v * cs - acc * sn); *(u64_t*)(Qo + (size_t)h * SEQ * 96 + 80) = pk4(acc * cs + x1v * sn); }
        }
#pragma unroll
        for (int nt = 0; nt < 4; ++nt) {
            const bf16* w = WukvT + (size_t)(h * 128 + 16 * nt) * 128; f32x4 acc = {0.f, 0.f, 0.f, 0.f};
#pragma unroll
            for (int s = 0; s < 4; ++s) acc = __builtin_amdgcn_mfma_f32_16x16x32_bf16(*(const bf16x8*)(w + 32 * s), akv[s], acc, 0, 0, 0);
            *(u64_t*)(Ko + (size_t)h * SEQ * 96 + 16 * nt) = pk4(acc * rkv);
        }
        f32x4 rk4;
#pragma unroll
        for (int r = 0; r < 4; ++r) rk4[r] = __shfl(rkv, 4 * q4 + r);
#pragma unroll
        for (int nt = 0; nt < 4; ++nt) {
            const bf16* w = WukvT + (size_t)(h * 128 + 64 + 16 * nt) * 128; f32x4 acc = {0.f, 0.f, 0.f, 0.f};
#pragma unroll
            for (int s = 0; s < 4; ++s) acc = __builtin_amdgcn_mfma_f32_16x16x32_bf16(akv[s], *(const bf16x8*)(w + 32 * s), acc, 0, 0, 0);
            *(u64_t*)(Vo + (size_t)(h * 64 + 16 * nt) * SEQ) = pk4(acc * rk4);
        }
    }
}
__device__ __forceinline__ f32x4 rw_shift4(const bf16* P, size_t m, int c, bool hp, bool hn, const float* mu) {
    const f32x4 x = bf4(*(const u64_t*)(P + m * 896 + c)), xp = hp ? bf4(*(const u64_t*)(P + (m - 1) * 896 + c)) : (f32x4){0.f, 0.f, 0.f, 0.f}, xn = hn ? bf4(*(const u64_t*)(P + (m + 1) * 896 + c)) : (f32x4){0.f, 0.f, 0.f, 0.f};
    const f32x4 m0 = *(const f32x4*)(mu + c), m1 = *(const f32x4*)(mu + 896 + c);
    return x + m0 * (xp - x) + m1 * (xn - x);
}
__device__ __forceinline__ void p2_rwkv_unit(Frame& F, int l, int unit, int h0, int h1) {
    const int lane = F.lane, col = lane & 15, q4 = lane >> 4, b = (16 * unit) / SEQ, t = (16 * unit) % SEQ + col; const size_t m = (size_t)16 * unit + col;
    const bool hp = t > 0, hn = t < SEQ - 1;
    const bf16* Prw = (const bf16*)(F.ws + WS_PRW);
    const float* mu = (const float*)inptr(F, 12) + l * 2 * 896;
    const bf16* W2T = (const bf16*)(F.ws + WS_WSMALL + OFF_W2T) + (size_t)l * 2 * 256 * 64 + (size_t)col * 64 + 8 * q4;
    const bf16* A2T = (const bf16*)(F.ws + WS_WSMALL + OFF_A2T) + (size_t)l * 2 * 256 * 64 + (size_t)col * 64 + 8 * q4;
    bf16x8 awd[2], aad[2];
#pragma unroll
    for (int s = 0; s < 2; ++s) { const int c = 768 + 32 * s + 8 * q4;
        f32x4 lo = rw_shift4(Prw, m, c, hp, hn, mu), hi = rw_shift4(Prw, m, c + 4, hp, hn, mu);
#pragma unroll
        for (int i = 0; i < 4; ++i) { lo[i] = 1.f - 2.f * __builtin_amdgcn_rcpf(1.f + __expf(2.f * lo[i])); hi[i] = 1.f - 2.f * __builtin_amdgcn_rcpf(1.f + __expf(2.f * hi[i])); }
        awd[s] = pack_acc(lo, hi);
        aad[s] = pack_acc(rw_shift4(Prw, m, c + 64, hp, hn, mu), rw_shift4(Prw, m, c + 68, hp, hn, mu)); }
#pragma unroll 1
    for (int h = h0; h < h1; ++h) {
        f32x4 k[4]; float kn = 0.f;
        { const float* k_k = (const float*)inptr(F, 17) + l * 256;
#pragma unroll
          for (int nt = 0; nt < 4; ++nt) { const int c = 64 * h + 16 * nt + 4 * q4; k[nt] = rw_shift4(Prw, m, 256 + c, hp, hn, mu);
              const f32x4 x = k[nt] * *(const f32x4*)(k_k + c); kn += (x[0] * x[0] + x[1] * x[1]) + (x[2] * x[2] + x[3] * x[3]); } }
        kn += __shfl_xor(kn, 16); kn += __shfl_xor(kn, 32);
        const float rkn = rsqrtf(kn + 1e-6f);
        float cbv = 0.f;
        const size_t ro = rw_rec_off(b * 4 + h, t, 0, q4 >> 1) + 8 * (q4 & 1);
        unsigned char* rs = F.ws + WS_RS + ro;
        unsigned char* rd0 = F.ws + WS_RD + ro;
#pragma unroll
        for (int nt = 0; nt < 4; ++nt) { const int c = 64 * h + 16 * nt + 4 * q4;
            const f32x4 r = rw_shift4(Prw, m, c, hp, hn, mu), v = rw_shift4(Prw, m, 512 + c, hp, hn, mu);
            const f32x4 kk = k[nt] * *(const f32x4*)((const float*)inptr(F, 17) + l * 256 + c) * rkn;
            *(u64_t*)(rs + 2048 * nt) = pk4(kk); *(u64_t*)(rs + 8192 + 2048 * nt) = pk4(v); *(u64_t*)(rs + 16384 + 2048 * nt) = pk4(r);
            f32x4 ksum = {0.f, 0.f, 0.f, 0.f};
#pragma unroll
            for (int e = 0; e < 2; ++e) { const bf16* w = W2T + (size_t)(e * 256 + 64 * h + 16 * nt) * 64; const bf16* a = A2T + (size_t)(e * 256 + 64 * h + 16 * nt) * 64;
                f32x4 x = {0.f, 0.f, 0.f, 0.f}, y = {0.f, 0.f, 0.f, 0.f};
#pragma unroll
                for (int s = 0; s < 2; ++s) { x = __builtin_amdgcn_mfma_f32_16x16x32_bf16(*(const bf16x8*)(w + 32 * s), awd[s], x, 0, 0, 0); y = __builtin_amdgcn_mfma_f32_16x16x32_bf16(*(const bf16x8*)(a + 32 * s), aad[s], y, 0, 0, 0); }
                const f32x4 w0v = *(const f32x4*)((const float*)inptr(F, 13) + l * 512 + e * 256 + c), a0v = *(const f32x4*)((const float*)inptr(F, 15) + l * 512 + e * 256 + c), kav = *(const f32x4*)((const float*)inptr(F, 18) + l * 256 + c);
                f32x4 lam, av;
#pragma unroll
                for (int i = 0; i < 4; ++i) { lam[i] = 0.6065306597126334f * sigmoidf_(w0v[i] + x[i]); av[i] = sigmoidf_(a0v[i] + y[i]); }
                const f32x4 km = k[nt] * (1.f + (av - 1.f) * kav), bb = av * kk;
                ksum += km;
                typedef _Float16 h4 __attribute__((ext_vector_type(4)));
                const h4 lh = {(_Float16)lam[0], (_Float16)lam[1], (_Float16)lam[2], (_Float16)lam[3]};
                unsigned char* rd = rd0 + e * RD_DIR;
                *(u64_t*)(rd + 2048 * nt) = __builtin_bit_cast(u64_t, lh); *(u64_t*)(rd + 8192 + 2048 * nt) = pk4(bb); *(u64_t*)(rd + 16384 + 2048 * nt) = pk4(km); }
            const f32x4 rkv = *(const f32x4*)((const float*)inptr(F, 19) + l * 256 + c), xx = r * ksum * rkv; cbv += (xx[0] + xx[1]) + (xx[2] + xx[3]);
        }
        cbv += __shfl_xor(cbv, 16); cbv += __shfl_xor(cbv, 32);
        if (q4 == 0) ((float*)(F.ws + WS_CB))[m * 4 + h] = 0.5f * cbv;
    }
}
template <int MODE> __device__ __forceinline__ void p2_prep2(Frame& F, int l) {
    const int gw = F.vcu * NWAVES + F.wave, NGW = F.G * NWAVES;
    for (int u = gw; u < 2 * (M / 16); u += NGW) { if (u & 1) { if (MODE != 1) p2_rwkv_unit(F, l, u >> 1, 0, 4); } else { if (MODE != 2) p2_mla_unit(F, l, u >> 1); } }
}
__device__ __forceinline__ void ld16(const bf16* p, f32x4 (&o)[4]) { const v4u a = *(const v4u*)p, b = *(const v4u*)(p + 8);
    o[0] = (f32x4){__uint_as_float(a.x << 16), __uint_as_float(a.x & 0xffff0000u), __uint_as_float(a.y << 16), __uint_as_float(a.y & 0xffff0000u)};
    o[1] = (f32x4){__uint_as_float(a.z << 16), __uint_as_float(a.z & 0xffff0000u), __uint_as_float(a.w << 16), __uint_as_float(a.w & 0xffff0000u)};
    o[2] = (f32x4){__uint_as_float(b.x << 16), __uint_as_float(b.x & 0xffff0000u), __uint_as_float(b.y << 16), __uint_as_float(b.y & 0xffff0000u)};
    o[3] = (f32x4){__uint_as_float(b.z << 16), __uint_as_float(b.z & 0xffff0000u), __uint_as_float(b.w << 16), __uint_as_float(b.w & 0xffff0000u)}; }
__device__ __forceinline__ void p4a_mix2(Frame& F, int l) {
    const bf16* Ogdn = (const bf16*)(F.ws + WS_OGDN); const bf16* Omla = (const bf16*)(F.ws + WS_OMLA); const bf16* Y = (const bf16*)(F.ws + WS_Y);
    const bf16* Pgate = (const bf16*)(F.ws + WS_PGATE); const unsigned char* Rs = F.ws + WS_RS; const float* cb = (const float*)(F.ws + WS_CB); bf16* mix = (bf16*)(F.ws + WS_MIX);
    const int gw = F.vcu * NWAVES + F.wave, NGW = F.G * NWAVES, lane = F.lane, g = lane >> 2, c0 = 16 * lane;
    f32x4 pg[4], pb[4];
    if (g < 6) { const float* gg = (const float*)inptr(F, 7) + l * 64 + (c0 & 63);
#pragma unroll
        for (int i = 0; i < 4; ++i) { pg[i] = *(const f32x4*)(gg + 4 * i); pb[i] = (f32x4){0.f, 0.f, 0.f, 0.f}; } }
    else if (g < 12) {
#pragma unroll
        for (int i = 0; i < 4; ++i) { pg[i] = (f32x4){1.f, 1.f, 1.f, 1.f}; pb[i] = (f32x4){0.f, 0.f, 0.f, 0.f}; } }
    else { const float* lg = (const float*)inptr(F, 20) + l * 256 + (c0 - 768); const float* lb = (const float*)inptr(F, 21) + l * 256 + (c0 - 768);
#pragma unroll
        for (int i = 0; i < 4; ++i) { pg[i] = *(const f32x4*)(lg + 4 * i); pb[i] = *(const f32x4*)(lb + 4 * i); } }
#pragma unroll 2
    for (int m = gw; m < M; m += NGW) {
        f32x4 x[4], gt[4];
        ld16(Pgate + (size_t)m * 1024 + c0, gt);
        if (g < 6) { ld16(Ogdn + (size_t)m * 384 + c0, x);
            float ss = 0.f;
#pragma unroll
            for (int i = 0; i < 4; ++i) ss += (x[i][0] * x[i][0] + x[i][1] * x[i][1]) + (x[i][2] * x[i][2] + x[i][3] * x[i][3]);
            ss += dpp_xor1(ss); ss += dpp_xor2(ss);
            const float rs = rsqrtf(ss * (1.f / 64.f) + NORM_EPS);
#pragma unroll
            for (int i = 0; i < 4; ++i) x[i] = x[i] * rs * pg[i]; }
        else if (g < 12) ld16(Omla + (size_t)m * 384 + (c0 - 384), x);
        else { const int cc = c0 - 768, h = g - 12, b = m / SEQ, t = m % SEQ; f32x4 v[4];
            ld16(Y + (size_t)m * 256 + cc, x); { const unsigned char* vp = Rs + rw_rec_off(b * 4 + h, t, 1, (cc & 63) >> 3); const v4u a = *(const v4u*)vp, bq = *(const v4u*)(vp + 1024);
              v[0] = (f32x4){__uint_as_float(a.x << 16), __uint_as_float(a.x & 0xffff0000u), __uint_as_float(a.y << 16), __uint_as_float(a.y & 0xffff0000u)}; v[1] = (f32x4){__uint_as_float(a.z << 16), __uint_as_float(a.z & 0xffff0000u), __uint_as_float(a.w << 16), __uint_as_float(a.w & 0xffff0000u)};
              v[2] = (f32x4){__uint_as_float(bq.x << 16), __uint_as_float(bq.x & 0xffff0000u), __uint_as_float(bq.y << 16), __uint_as_float(bq.y & 0xffff0000u)}; v[3] = (f32x4){__uint_as_float(bq.z << 16), __uint_as_float(bq.z & 0xffff0000u), __uint_as_float(bq.w << 16), __uint_as_float(bq.w & 0xffff0000u)}; }
            const float cbv = cb[(size_t)m * 4 + h];
            float s1 = 0.f;
#pragma unroll
            for (int i = 0; i < 4; ++i) s1 += (x[i][0] + x[i][1]) + (x[i][2] + x[i][3]);
            s1 += dpp_xor1(s1); s1 += dpp_xor2(s1);
            const float mean = s1 * (1.f / 64.f); float s2 = 0.f;
#pragma unroll
            for (int i = 0; i < 4; ++i) { x[i] = x[i] - mean; s2 += (x[i][0] * x[i][0] + x[i][1] * x[i][1]) + (x[i][2] * x[i][2] + x[i][3] * x[i][3]); }
            s2 += dpp_xor1(s2); s2 += dpp_xor2(s2);
            const float rs = rsqrtf(s2 * (1.f / 64.f) + 64e-5f);
#pragma unroll
            for (int i = 0; i < 4; ++i) x[i] = x[i] * rs * pg[i] + pb[i] + cbv * v[i]; }
        v4u o0, o1;
#pragma unroll
        for (int i = 0; i < 4; ++i) {
#pragma unroll
            for (int j = 0; j < 4; ++j) x[i][j] = x[i][j] * siluf(gt[i][j]); }
        o0.x = pg8::cvt_pk_bf16(x[0][0], x[0][1]); o0.y = pg8::cvt_pk_bf16(x[0][2], x[0][3]); o0.z = pg8::cvt_pk_bf16(x[1][0], x[1][1]); o0.w = pg8::cvt_pk_bf16(x[1][2], x[1][3]);
        o1.x = pg8::cvt_pk_bf16(x[2][0], x[2][1]); o1.y = pg8::cvt_pk_bf16(x[2][2], x[2][3]); o1.z = pg8::cvt_pk_bf16(x[3][0], x[3][1]); o1.w = pg8::cvt_pk_bf16(x[3][2], x[3][3]);
        bf16* op = mix + (size_t)m * 1024 + c0; *(v4u*)op = o0; *(v4u*)(op + 8) = o1;
    }
}
constexpr int PT_OUT = 24, PT_WS = 25, PT_N = 26;
__device__ __forceinline__ void build_frame(Frame& F, LAS unsigned char* lds) {
    F.lds = lds; F.MISC = (volatile LAS unsigned*)(lds + MISC_OFF); F.ptab = (volatile LAS const unsigned long long*)(lds + MISC_OFF + 256);
    const int t = pg8::mk_tid(lds);
    F.tid = t; F.lane = t & 63; F.wave = __builtin_amdgcn_readfirstlane(t >> 6);
    F.G = gridDim.x; { const int bx = blockIdx.x; F.vcu = (F.G % 8 == 0) ? (bx % 8) * (F.G / 8) + bx / 8 : bx; }
    F.ws = (unsigned char*)inptr(F, PT_WS); F.out = (float*)inptr(F, PT_OUT); F.ctl = (gu32*)F.ws;
}
__device__ __forceinline__ bool ph_in(LAS unsigned char* lds, int k) { volatile LAS unsigned* mi = (volatile LAS unsigned*)(lds + MISC_OFF); const int lo = __builtin_amdgcn_readfirstlane((int)mi[20]), hi = __builtin_amdgcn_readfirstlane((int)mi[21]); return lo <= k && k < hi; }
__device__ __forceinline__ void seam(LAS unsigned char* lds, int k) {
    if (ph_in(lds, k) && ph_in(lds, k + 1)) { Frame F; build_frame(F, lds);
        XcdBarrier bar; bar.bar = (unsigned*)(F.ctl + CW_BAR); bar.x = xb_xcc_id(); bar.st = F.MISC + 8; xcd_barrier(bar); }
}
template <int L> __device__ __forceinline__ void layer_phases(LAS unsigned char* lds) {
    constexpr int pb = 1 + 5 * L;
    if (ph_in(lds, pb)) { Frame F; build_frame(F, lds);
        pg8::Gemm g{(const pg8::bf16_t*)(F.ws + WS_XB), (const pg8::bf16_t*)(F.ws + WS_WIN) + (size_t)L * NP * D, M, NP, D};
        pg8::StaticOrder S; S.init(M, NP, F.G, (int)blockIdx.x);
        pg8::EpiRoute E{F.ws};
        pg8::gemm_phase<pg8::EpiRoute, pg8::StaticOrder, true, true>(F.lds + RING_OFF, g, S, E);
    }
    seam(lds, pb);
    if (ph_in(lds, pb + 1)) { Frame F; build_frame(F, lds); p2_prep2<0>(F, L); }
    seam(lds, pb + 1);
    if (ph_in(lds, pb + 2)) { Frame F; build_frame(F, lds); p3_mixers(F, L, 0); }
    seam(lds, pb + 2);
    if (ph_in(lds, pb + 3)) { Frame F; build_frame(F, lds); p4a_mix2(F, L);
    }
    seam(lds, pb + 3);
    if (ph_in(lds, pb + 4)) { Frame F; build_frame(F, lds);
        pg8::Gemm g{(const pg8::bf16_t*)(F.ws + WS_MIX), (const pg8::bf16_t*)(F.ws + WS_WOUT) + (size_t)L * D * D, M, D, D};
        pg8::StaticOrder S; S.init(M, D, F.G, (int)blockIdx.x);
        pg8::EpiOut<L == 0> E{L == 0 ? (const float*)inptr(F, 0) : (const float*)F.out, F.out, F.ws};
        pg8::gemm_phase<pg8::EpiOut<L == 0>, pg8::StaticOrder, true, true>(F.lds + RING_OFF, g, S, E);
    }
    seam(lds, pb + 4);
}
__global__ void __launch_bounds__(NWAVES * 64, 2) mk_fwd(Args args) {
    extern __shared__ __attribute__((aligned(16))) unsigned char lds_raw[];
    LAS unsigned char* lds = (LAS unsigned char*)lds_raw;
    for (int u = threadIdx.x; u < (LDS_BYTES - LDSCTL_OFF) / 4; u += NWAVES * 64) ((LAS unsigned*)(lds + LDSCTL_OFF))[u] = 0u;
    __syncthreads();
    if (threadIdx.x == 0) { LAS unsigned long long* pt = (LAS unsigned long long*)(lds + MISC_OFF + 256);
#define PT(k) pt[k] = (unsigned long long)args.in[k]
        PT(0); PT(1); PT(2); PT(3); PT(4); PT(5); PT(6); PT(7); PT(8); PT(9); PT(10); PT(11); PT(12); PT(13); PT(14); PT(15); PT(16); PT(17); PT(18); PT(19); PT(20); PT(21); PT(22); PT(23);
#undef PT
        pt[PT_OUT] = (unsigned long long)args.out; pt[PT_WS] = (unsigned long long)args.ws;
        volatile LAS unsigned* mi = (volatile LAS unsigned*)(lds + MISC_OFF); mi[20] = (unsigned)args.ph_lo; mi[21] = (unsigned)args.ph_hi;
        if (args.ph_hi - args.ph_lo > 1) (void)xcd_barrier_post((unsigned*)((gu32*)args.ws + CW_BAR), mi + 8);
    }
    if ((threadIdx.x & 63) == 0) ((volatile LAS unsigned*)(lds + pg8::TIDTAB_OFF))[pg8::hw_slot()] = threadIdx.x >> 6;
    __syncthreads();
    if (ph_in(lds, 0)) { Frame F; build_frame(F, lds); p0_prologue(F); }
    seam(lds, 0);
    layer_phases<0>(lds);
    layer_phases<1>(lds);
    if (ph_in(lds, 11)) { Frame F; build_frame(F, lds); p5_final(F); }
}

extern "C" void kernel_launch(void* const* d_in, const int* in_sizes, int n_in, void* d_out, int out_size, void* d_ws, size_t ws_size, hipStream_t stream) {
    static int grid = 0;
    if (grid == 0) {
        if (n_in != 24 || ws_size < WS_END || out_size != M * D) { fprintf(stderr, "kernel_launch: unexpected inputs (%d), out (%d) or workspace (%zu)\n", n_in, out_size, ws_size); grid = -1; return; }
        int dev = 0, cus = 0;
        if (hipGetDevice(&dev) != hipSuccess || hipDeviceGetAttribute(&cus, hipDeviceAttributeMultiprocessorCount, dev) != hipSuccess) { grid = -1; return; }
        if (hipFuncSetAttribute((const void*)mk_fwd, hipFuncAttributeMaxDynamicSharedMemorySize, LDS_BYTES) != hipSuccess) { fprintf(stderr, "kernel_launch: hipFuncSetAttribute failed\n"); grid = -1; return; }
        (void)hipGetLastError();
        grid = cus;
    }
    if (grid < 0) return;
    unsigned char* ws = (unsigned char*)d_ws;
    (void)hipMemsetAsync(ws + WS_CTL, 0, CTL_ZERO_BYTES, stream);
    Args a{};
    for (int i = 0; i < 24; ++i) a.in[i] = d_in[i];
    a.out = (float*)d_out; a.ws = ws; a.ph_lo = 0; a.ph_hi = NPHASE;
    hipLaunchKernelGGL(mk_fwd, dim3(grid), dim3(NWAVES * 64), LDS_BYTES, stream, a);
}
```

```cpp
#include <hip/hip_runtime.h>
#include <cstdio>
#include <cstdint>
#include <hip/hip_fp16.h>
namespace pg8 {
#define PG8_LAS __attribute__((address_space(3)))
typedef unsigned short bf16_t;
typedef short bf16x8 __attribute__((ext_vector_type(8)));
typedef float f32x4 __attribute__((ext_vector_type(4)));
typedef unsigned u32x4 __attribute__((ext_vector_type(4)));
constexpr int BM = 256, BK = 64, HALF = 128, HTB = HALF * BK * 2  , STAGE_BYTES = 8 * HTB, NXCD = 8, WGM = 8;

__host__ __device__ __forceinline__ int lds_byte(int r, int c) { const int st = (r >> 4) * 2 + (c >> 5), rr = r & 15, cc = c & 31, ob = rr * 64 + cc * 2; return st * 1024 + (ob ^ (((ob >> 9) & 1) << 5)); }
__host__ __device__ __forceinline__ void stage_rc(int b, int& R, int& C) { const int st = b / 1024, sb = b % 1024, swz = sb ^ (((sb >> 9) & 1) << 5); R = (st >> 1) * 16 + swz / 64; C = (st & 1) * 32 + (swz % 64) / 2; }
__host__ __device__ __forceinline__ int perm32(int rho) { const int n = rho >> 4, i = rho & 15; return 8 * (i >> 2) + 4 * n + (i & 3); }

struct Unit { int pm, pn; };
struct Gemm { const bf16_t* A; const bf16_t* Bt; int M, N, K; };

struct StaticOrder {
    int nM, nN, nwg, G, c;
    __host__ __device__ void init(int M, int N, int G_, int c_) { nM = M / BM; nN = N / BM; nwg = nM * nN; G = G_; c = c_; }
    __host__ __device__ bool next(int i, Unit& u) const {
        const long L = (long)i * G + c; if (L >= nwg) return false;
        int wgid = (int)L; { const int q = nwg / NXCD, r = nwg % NXCD, xcd = wgid % NXCD, off = wgid / NXCD; wgid = (xcd < r ? xcd * (q + 1) : r * (q + 1) + (xcd - r) * q) + off; }
        const int nig = WGM * nN, gid = wgid / nig, fm = gid * WGM, gsz = (nM - fm) < WGM ? (nM - fm) : WGM;
        u.pm = fm + ((wgid % nig) % gsz); u.pn = (wgid % nig) / gsz; return true;
    }
    __device__ __forceinline__ void a_ready(const Unit&) const {}
    __device__ __forceinline__ void done(const Unit&) const {}
};

__device__ __forceinline__ unsigned cvt_pk_bf16(float lo, float hi) { unsigned r; asm volatile("v_cvt_pk_bf16_f32 %0, %1, %2" : "=v"(r) : "v"(lo), "v"(hi)); return r; }
typedef float f32x2 __attribute__((ext_vector_type(2)));
constexpr int TIDTAB_OFF = 131072 + 320 + 512;
__device__ __forceinline__ unsigned hw_slot() { return (unsigned)__builtin_amdgcn_s_getreg((5 << 11) | 4) & 63u; }
__device__ __forceinline__ int mk_tid(PG8_LAS unsigned char* lds_base) {
    const unsigned lane = __builtin_amdgcn_mbcnt_hi(~0u, __builtin_amdgcn_mbcnt_lo(~0u, 0u));
    const unsigned w = __builtin_amdgcn_readfirstlane(((volatile PG8_LAS unsigned*)(lds_base + TIDTAB_OFF))[hw_slot()]);
    return (int)(w * 64u + lane);
}
struct EpiRoute {
    static constexpr bool PERM = true, AFTER_DRAIN = false;
    unsigned char* ws;
    __device__ __forceinline__ void operator()(const f32x4 (&acc)[2][2][4][2], const Unit& u, int wr, int wc, int fr, int fq) const {
        const int row0 = u.pm * BM + wr * 64 + fr;
        const float* rowss = (const float*)(ws + (1u << 20)); float* Psm = (float*)(ws + (22u << 20));
        unsigned base[2]; int ld[2], cc[2], kind[2];
#pragma unroll
        for (int bj = 0; bj < 2; ++bj) {
            const int cg = u.pn * BM + bj * HALF + wc * 32, col = cg + 8 * fq;
            if (cg < 1024) { base[bj] = 25u << 20; ld[bj] = 1024; cc[bj] = col; kind[bj] = 0; }
            else if (cg < 2176) { base[bj] = 57u << 20; ld[bj] = 1152; cc[bj] = col - 1024; kind[bj] = 0; }
            else if (cg < 2528) { base[bj] = 93u << 20; ld[bj] = 352; cc[bj] = col - 2176; kind[bj] = 0; }
            else if (cg < 3424) { base[bj] = 104u << 20; ld[bj] = 896; cc[bj] = col - 2528; kind[bj] = 0; }
            else if (cg < 3456) { base[bj] = 0u; ld[bj] = 32; cc[bj] = col - 3424; kind[bj] = 1; }
            else { base[bj] = 0u; ld[bj] = 0; cc[bj] = 0; kind[bj] = 2; }
        }
#pragma unroll
        for (int ai = 0; ai < 2; ++ai)
#pragma unroll
            for (int m = 0; m < 4; ++m) {
                const int row = row0 + ai * HALF + m * 16;
                const f32x4* rp = (const f32x4*)(rowss + (size_t)row * 16);
                const f32x4 s0 = rp[0], s1 = rp[1], s2 = rp[2], s3 = rp[3];
                const float ss = ((s0[0] + s0[1]) + (s0[2] + s0[3])) + ((s1[0] + s1[1]) + (s1[2] + s1[3])) + ((s2[0] + s2[1]) + (s2[2] + s2[3])) + ((s3[0] + s3[1]) + (s3[2] + s3[3]));
                const float rstd = __builtin_amdgcn_rsqf(ss * (1.0f / 1024.0f) + 1e-6f);
#pragma unroll
                for (int bj = 0; bj < 2; ++bj) {
                    const f32x4 v0 = acc[ai][bj][m][0] * rstd, v1 = acc[ai][bj][m][1] * rstd;
                    if (kind[bj] == 0) { u32x4 w; w.x = cvt_pk_bf16(v0[0], v0[1]); w.y = cvt_pk_bf16(v0[2], v0[3]); w.z = cvt_pk_bf16(v1[0], v1[1]); w.w = cvt_pk_bf16(v1[2], v1[3]);
                        *(u32x4*)((bf16_t*)(ws + base[bj]) + (size_t)row * ld[bj] + cc[bj]) = w; }
                    else if (kind[bj] == 1) { float* p = Psm + (size_t)row * 32 + cc[bj]; *(f32x4*)p = v0; *(f32x4*)(p + 4) = v1; }
                }
                asm volatile("" ::: "memory");
            }
    }
};
template <bool WRITE_XB> struct EpiOut {
    static constexpr bool PERM = false, AFTER_DRAIN = false;
    const float* xin; float* xout; unsigned char* ws;
    __device__ __forceinline__ void operator()(const f32x4 (&acc)[2][2][4][2], const Unit& u, int wr, int wc, int fr, int fq) const {
        typedef unsigned u32x2v __attribute__((ext_vector_type(2)));
        const int row0 = u.pm * BM + wr * 64 + fr, col0 = u.pn * BM + wc * 32 + 4 * fq;
        float* rowss = (float*)(ws + (1u << 20)); bf16_t* xb = (bf16_t*)(ws + (133u << 20));
#pragma unroll
        for (int ai = 0; ai < 2; ++ai)
#pragma unroll
            for (int m = 0; m < 4; ++m) {
                const int row = row0 + ai * HALF + m * 16; float ss = 0.f;
#pragma unroll
                for (int bj = 0; bj < 2; ++bj)
#pragma unroll
                    for (int n = 0; n < 2; ++n) {
                        const size_t off = (size_t)row * 1024 + col0 + bj * HALF + n * 16;
                        const f32x4 o = *(const f32x4*)(xin + off) + acc[ai][bj][m][n];
                        *(f32x4*)(xout + off) = o;
                        if (WRITE_XB) { u32x2v w; w.x = cvt_pk_bf16(o[0], o[1]); w.y = cvt_pk_bf16(o[2], o[3]); *(u32x2v*)(xb + off) = w; }
                        ss += (o[0] * o[0] + o[1] * o[1]) + (o[2] * o[2] + o[3] * o[3]);
                    }
                ss += __shfl_xor(ss, 16); ss += __shfl_xor(ss, 32);
                if (fq == 0) rowss[(size_t)row * 16 + u.pn * 4 + wc] = ss;
                asm volatile("" ::: "memory");
            }
    }
};
template <class Epi, class Sched, bool ALIGN_EPI = false, bool SP2 = false>
__device__ __forceinline__ void gemm_phase(PG8_LAS unsigned char* lds, const Gemm g, const Sched& S, const Epi& E) {
    const int tid_ = mk_tid(lds);
    const int tid = tid_, wid = __builtin_amdgcn_readfirstlane(tid >> 6), lane = tid & 63, wr = wid >> 2, wc = wid & 3, fr = lane & 15, fq = lane >> 4;
    const int K = g.K, nt = K / BK;
    unsigned voffA[2], voffB[2];
#pragma unroll
    for (int i = 0; i < 2; ++i) { int R, C; stage_rc(tid * 16 + i * 8192, R, C); const int Rb = Epi::PERM ? ((R & ~31) + perm32(R & 31)) : R;
        voffA[i] = (unsigned)(R * K + C) * 2u; voffB[i] = (unsigned)(Rb * K + C) * 2u; }
    const size_t kstep = (size_t)(BK * 2);
    const size_t hstep = (size_t)HALF * K * 2;
    const size_t tstep = 2 * hstep;
    const unsigned ldsw = (unsigned)wid * 1024u;
    const int aoff = lds_byte(wr * 64 + fr, fq * 8), boff = lds_byte(wc * 32 + fr, fq * 8);
#define PG8_SA(b, h) (((b) * 2 + (h)) * HTB)
#define PG8_SB(b, h) ((4 + (b) * 2 + (h)) * HTB)
#define PG8_STAGE(bufoff, gbase, voff) do { _Pragma("unroll") for (int _i = 0; _i < 2; ++_i) \
        __builtin_amdgcn_global_load_lds((const unsigned*)((const char*)(gbase) + (voff)[_i]), (PG8_LAS unsigned*)(lds + (bufoff) + ldsw + _i * 8192), 16, 0, 0); } while (0)
#define PG8_LDA(dst, b, h) do { _Pragma("unroll") for (int m = 0; m < 4; ++m) _Pragma("unroll") for (int k = 0; k < 2; ++k) dst[m][k] = *(const PG8_LAS bf16x8*)(lds + PG8_SA(b, h) + aoff + m * 2048 + k * 1024); } while (0)
#define PG8_LDB(dst, b, h) do { _Pragma("unroll") for (int n = 0; n < 2; ++n) _Pragma("unroll") for (int k = 0; k < 2; ++k) dst[n][k] = *(const PG8_LAS bf16x8*)(lds + PG8_SB(b, h) + boff + n * 2048 + k * 1024); } while (0)
#define PG8_MMA(ai, bj, At, Bt) do { __builtin_amdgcn_s_setprio(1); _Pragma("unroll") for (int m = 0; m < 4; ++m) _Pragma("unroll") for (int n = 0; n < 2; ++n) _Pragma("unroll") for (int k = 0; k < 2; ++k) \
        acc[ai][bj][m][n] = __builtin_amdgcn_mfma_f32_16x16x32_bf16(Bt[n][k], At[m][k], acc[ai][bj][m][n], 0, 0, 0); __builtin_amdgcn_s_setprio(0); } while (0)
#define PG8_WAIT_V(n) asm volatile("s_waitcnt vmcnt(" #n ")" ::: "memory")
#define PG8_WAIT_L(n) asm volatile("s_waitcnt lgkmcnt(" #n ")" ::: "memory")
#define PG8_BAR __builtin_amdgcn_s_barrier()
#define PG8_SCHED __builtin_amdgcn_sched_barrier(0)
    Unit cur, nxt; int ui = 0;
    if (!S.next(0, cur)) return;
    f32x4 acc[2][2][4][2];
#pragma unroll
    for (int a = 0; a < 2; ++a)
#pragma unroll
        for (int b = 0; b < 2; ++b)
#pragma unroll
            for (int m = 0; m < 4; ++m)
#pragma unroll
                for (int n = 0; n < 2; ++n) acc[a][b][m][n] = (f32x4){0.f, 0.f, 0.f, 0.f};
    bf16x8 At[4][2], B0[2][2], B1[2][2];
    const char* cA = (const char*)g.A + (size_t)cur.pm * tstep; const char* cB = (const char*)g.Bt + (size_t)cur.pn * tstep;
    S.a_ready(cur);
    if constexpr (SP2) {
        PG8_STAGE(PG8_SB(0, 0), cB, voffB); PG8_STAGE(PG8_SB(0, 1), cB + hstep, voffB); PG8_STAGE(PG8_SA(0, 0), cA, voffA); PG8_STAGE(PG8_SA(0, 1), cA + hstep, voffA);
        if (wr == 1) PG8_BAR;
        PG8_WAIT_V(2); PG8_BAR;
        PG8_STAGE(PG8_SB(1, 0), cB + kstep, voffB); PG8_STAGE(PG8_SA(1, 0), cA + kstep, voffA); PG8_STAGE(PG8_SB(1, 1), cB + hstep + kstep, voffB);
        PG8_WAIT_V(6); PG8_BAR;
    } else {
        PG8_STAGE(PG8_SB(0, 0), cB, voffB); PG8_STAGE(PG8_SA(0, 0), cA, voffA); PG8_STAGE(PG8_SB(0, 1), cB + hstep, voffB); PG8_STAGE(PG8_SA(0, 1), cA + hstep, voffA);
        if (wr == 1) PG8_BAR;
        PG8_WAIT_V(4); PG8_BAR;
        PG8_STAGE(PG8_SB(1, 0), cB + kstep, voffB); PG8_STAGE(PG8_SA(1, 0), cA + kstep, voffA); PG8_STAGE(PG8_SB(1, 1), cB + hstep + kstep, voffB);
        PG8_WAIT_V(6); PG8_BAR;
    }
    for (;;) {
        const bool has_next = S.next(ui + 1, nxt);
        const char* nA = has_next ? (const char*)g.A + (size_t)nxt.pm * tstep : cA; const char* nB = has_next ? (const char*)g.Bt + (size_t)nxt.pn * tstep : cB;
        for (int t = 0; t < nt; t += 2) {
            const bool last = (t == nt - 2);
            const char* a1 = cA + (size_t)(t + 1) * kstep;
            const char* a2 = last ? nA : cA + (size_t)(t + 2) * kstep; const char* b2 = last ? nB : cB + (size_t)(t + 2) * kstep;
            const char* a3 = a2 + kstep; const char* b3 = b2 + kstep;
            if (last && has_next) S.a_ready(nxt);
            if constexpr (SP2) {
            PG8_LDB(B0, 0, 0); PG8_LDB(B1, 0, 1); PG8_SCHED; PG8_LDA(At, 0, 0); PG8_STAGE(PG8_SA(1, 1), a1 + hstep, voffA);
            PG8_WAIT_V(8); PG8_WAIT_L(0); PG8_BAR; PG8_MMA(0, 0, At, B0); PG8_MMA(0, 1, At, B1); PG8_BAR; PG8_SCHED;
            PG8_LDA(At, 0, 1); PG8_STAGE(PG8_SB(0, 0), b2, voffB); PG8_STAGE(PG8_SB(0, 1), b2 + hstep, voffB); PG8_STAGE(PG8_SA(0, 0), a2, voffA);
            PG8_WAIT_V(8); PG8_WAIT_L(0); PG8_BAR; PG8_MMA(1, 0, At, B0); PG8_MMA(1, 1, At, B1); PG8_BAR; PG8_SCHED;
            PG8_LDB(B0, 1, 0); PG8_LDB(B1, 1, 1); PG8_SCHED; PG8_LDA(At, 1, 0); PG8_STAGE(PG8_SA(0, 1), a2 + hstep, voffA);
            PG8_WAIT_V(8); PG8_WAIT_L(0); PG8_BAR; PG8_MMA(0, 0, At, B0); PG8_MMA(0, 1, At, B1); PG8_BAR; PG8_SCHED;
            PG8_LDA(At, 1, 1); PG8_STAGE(PG8_SB(1, 0), b3, voffB); PG8_STAGE(PG8_SB(1, 1), b3 + hstep, voffB); PG8_STAGE(PG8_SA(1, 0), a3, voffA);
            PG8_WAIT_V(8); PG8_WAIT_L(0); PG8_BAR; PG8_MMA(1, 0, At, B0); PG8_MMA(1, 1, At, B1); PG8_BAR; PG8_SCHED;
            } else {
            PG8_LDB(B0, 0, 0); PG8_SCHED; PG8_LDA(At, 0, 0); PG8_STAGE(PG8_SA(1, 1), a1 + hstep, voffA);
            PG8_WAIT_L(8); PG8_BAR; PG8_WAIT_L(0); PG8_MMA(0, 0, At, B0); PG8_BAR; PG8_SCHED;
            PG8_LDB(B1, 0, 1); PG8_STAGE(PG8_SB(0, 0), b2, voffB);
            PG8_BAR; PG8_WAIT_L(0); PG8_MMA(0, 1, At, B1); PG8_BAR;
            PG8_LDA(At, 0, 1); PG8_STAGE(PG8_SA(0, 0), a2, voffA);
            PG8_BAR; PG8_WAIT_L(0); PG8_MMA(1, 0, At, B0); PG8_BAR; PG8_SCHED;
            PG8_STAGE(PG8_SB(0, 1), b2 + hstep, voffB);
            PG8_WAIT_V(6); PG8_BAR; PG8_MMA(1, 1, At, B1); PG8_BAR;
            PG8_LDB(B0, 1, 0); PG8_SCHED; PG8_LDA(At, 1, 0); PG8_STAGE(PG8_SA(0, 1), a2 + hstep, voffA);
            PG8_WAIT_L(8); PG8_BAR; PG8_WAIT_L(0); PG8_MMA(0, 0, At, B0); PG8_BAR; PG8_SCHED;
            PG8_LDB(B1, 1, 1); PG8_STAGE(PG8_SB(1, 0), b3, voffB);
            PG8_BAR; PG8_WAIT_L(0); PG8_MMA(0, 1, At, B1); PG8_BAR;
            PG8_LDA(At, 1, 1); PG8_STAGE(PG8_SA(1, 0), a3, voffA);
            PG8_BAR; PG8_WAIT_L(0); PG8_MMA(1, 0, At, B0); PG8_BAR; PG8_SCHED;
            PG8_STAGE(PG8_SB(1, 1), b3 + hstep, voffB);
            PG8_WAIT_V(6); PG8_BAR; PG8_MMA(1, 1, At, B1); PG8_BAR;
            }
        }
        if constexpr (ALIGN_EPI) { if (wr == 0) PG8_BAR; }
        if constexpr (!Epi::AFTER_DRAIN) { E(acc, cur, wr, wc, fr, fq); S.done(cur); }
        if (!has_next) break;
#pragma unroll
        for (int a = 0; a < 2; ++a)
#pragma unroll
            for (int b = 0; b < 2; ++b)
#pragma unroll
                for (int m = 0; m < 4; ++m)
#pragma unroll
                    for (int n = 0; n < 2; ++n) acc[a][b][m][n] = (f32x4){0.f, 0.f, 0.f, 0.f};
        cur = nxt; cA = nA; cB = nB; ++ui;
        if constexpr (ALIGN_EPI) { if (wr == 1) PG8_BAR; }
    }
    PG8_WAIT_V(0);
    if constexpr (!ALIGN_EPI) { if (wr == 0) PG8_BAR; }
    PG8_BAR;
    if constexpr (Epi::AFTER_DRAIN) { E.fused(acc, cur, wr, wc, fr, fq, lds, wid, lane); S.done(cur); }
#undef PG8_SA
#undef PG8_SB
#undef PG8_STAGE
#undef PG8_LDA
#undef PG8_LDB
#undef PG8_MMA
#undef PG8_WAIT_V
#undef PG8_WAIT_L
#undef PG8_BAR
#undef PG8_SCHED
}
}
#define GAS __attribute__((address_space(1)))
#define LAS __attribute__((address_space(3)))
typedef unsigned short bf16;
typedef unsigned v4u __attribute__((ext_vector_type(4)));
typedef float f32x4 __attribute__((ext_vector_type(4)));
typedef short bf16x8 __attribute__((ext_vector_type(8)));
typedef GAS unsigned gu32;
typedef GAS unsigned long long gu64;
#define RLX_AGENT __ATOMIC_RELAXED, __HIP_MEMORY_SCOPE_AGENT
#define LDS_WAIT() asm volatile("s_waitcnt lgkmcnt(0)" ::: "memory")
#define VM_WAIT() asm volatile("s_waitcnt vmcnt(0)" ::: "memory")
__device__ __forceinline__ unsigned long long rt() { return __builtin_amdgcn_s_memrealtime(); }
__device__ __forceinline__ unsigned f2bf(float f) { unsigned u = __builtin_bit_cast(unsigned, f); return (u + 0x7fffu + ((u >> 16) & 1u)) >> 16; }
__device__ __forceinline__ unsigned pk2(float lo, float hi) { return f2bf(lo) | (f2bf(hi) << 16); }

#define XB_TMO      128
#define XB_XCNT(j)  (256  + 64 * (j))
#define XB_XSUB(j)  (1280 + 64 * (j))
#define XB_XGEN(j)  (2304 + 64 * (j))
#define XB_TOP      3328
#define XB_TOPGEN   3392
#define XCD_BAR_WORDS 3456
#define XB_SPIN_CAP (1u << 18)

__device__ __forceinline__ unsigned xb_ld(unsigned* p)              { return __hip_atomic_load(p, __ATOMIC_RELAXED, __HIP_MEMORY_SCOPE_AGENT); }
__device__ __forceinline__ unsigned xb_add(unsigned* p, unsigned v) { return __hip_atomic_fetch_add(p, v, __ATOMIC_RELAXED, __HIP_MEMORY_SCOPE_AGENT); }
__device__ __forceinline__ unsigned xb_xcc_id() { return (unsigned)__builtin_amdgcn_s_getreg((3 << 11) | 20) & 0xFu; }
#define XB_SPIN(cond, bar) do { unsigned _sp = 0; while (cond) { __builtin_amdgcn_s_sleep(1); \
    if ((++_sp & 255u) == 0u) { if (xb_ld(&(bar)[XB_TMO])) break; if (_sp > XB_SPIN_CAP) { atomicAdd(&(bar)[XB_TMO], 1u); break; } } } } while (0)

struct XcdBarrier {
    unsigned* bar; unsigned x;
    volatile LAS unsigned* st;
};

__device__ __forceinline__ XcdBarrier xcd_barrier_post(unsigned* bar, volatile LAS unsigned* st) {
    XcdBarrier b; b.bar = bar; b.x = xb_xcc_id(); b.st = st;
    if (threadIdx.x == 0) (void)xb_add(&bar[XB_XCNT(b.x)], 1u);
    return b;
}
__device__ __forceinline__ void xcd_barrier_complete(unsigned* bar, unsigned x, unsigned& nloc, unsigned& nx) {
    const unsigned G = gridDim.x * gridDim.y * gridDim.z;
    unsigned sum, cnt, mine, sp = 0u;
    for (;;) {
        sum = 0u; cnt = 0u; mine = 0u;
#pragma unroll
        for (unsigned j = 0; j < 16; ++j) { const unsigned c = xb_ld(&bar[XB_XCNT(j)]); sum += c; cnt += (c > 0u) ? 1u : 0u; mine = (j == x) ? c : mine; }
        if (sum == G) break;
        __builtin_amdgcn_s_sleep(1);
        if ((++sp & 255u) == 0u) { if (xb_ld(&bar[XB_TMO])) break; if (sp > XB_SPIN_CAP) { atomicAdd(&bar[XB_TMO], 1u); break; } }
    }
    nloc = mine > 0u ? mine : 1u; nx = cnt > 0u ? cnt : 1u;
}

__device__ __forceinline__ void xcd_barrier(const XcdBarrier& b) {
    asm volatile("s_waitcnt vmcnt(0)" ::: "memory");
    __syncthreads();
    if (pg8::mk_tid((LAS unsigned char*)b.st - (131072 + 320 + 32)) == 0) {
        unsigned* bar = b.bar;
        __builtin_amdgcn_s_waitcnt(0);
        unsigned nloc = b.st[0], nx = b.st[1];
        if (nloc == 0u) { xcd_barrier_complete(bar, b.x, nloc, nx); b.st[0] = nloc; b.st[1] = nx; }
        const unsigned old = xb_add(&bar[XB_XSUB(b.x)], 1u);
        const unsigned gen = old / nloc;
        if (old + 1u == (gen + 1u) * nloc) {
            __builtin_amdgcn_fence(__ATOMIC_RELEASE, "agent");
            asm volatile("s_waitcnt vmcnt(0)" ::: "memory");
            const unsigned og = xb_add(&bar[XB_TOP], 1u);
            const unsigned tg = og / nx;
            if (og + 1u == (tg + 1u) * nx) xb_add(&bar[XB_TOPGEN], 1u);
            else XB_SPIN(xb_ld(&bar[XB_TOPGEN]) == tg, bar);
            __builtin_amdgcn_fence(__ATOMIC_ACQUIRE, "agent");
            xb_add(&bar[XB_XGEN(b.x)], 1u);
            asm volatile("s_waitcnt vmcnt(0)" ::: "memory");
        } else {
            XB_SPIN(xb_ld(&bar[XB_XGEN(b.x)]) == gen, bar);
            __builtin_amdgcn_fence(__ATOMIC_ACQUIRE, "agent");
            asm volatile("s_waitcnt vmcnt(0)" ::: "memory");
        }
    }
    __syncthreads();
}
constexpr int BATCH = 8, SEQ = 2048, M = BATCH * SEQ, D = 1024, NIN = 3448, NP = 3584;
constexpr float NORM_EPS = 1e-6f;
constexpr float LOG2E = 1.4426950408889634f;
constexpr size_t MiB = 1u << 20;
constexpr size_t WS_CTL = 0, CTL_ZERO_BYTES = 1 * MiB;
constexpr size_t WS_ROWSS = 1 * MiB;
constexpr size_t WS_WIN = 2 * MiB;
constexpr size_t WS_WOUT = 16 * MiB;
constexpr size_t WS_WSMALL = 20 * MiB;
constexpr size_t OFF_WUQ = 0, OFF_WUKV = 2 * 576 * 192 * 2, OFF_W2T = OFF_WUKV + 2 * 768 * 128 * 2, OFF_A2T = OFF_W2T + 2 * 2 * 256 * 64 * 2;
constexpr size_t WS_PSM = 22 * MiB;
constexpr size_t WS_CB = 24 * MiB;
constexpr size_t WS_PGATE = 25 * MiB;
constexpr size_t WS_PGDN = 57 * MiB;
constexpr size_t WS_PMLA = 93 * MiB;
constexpr size_t WS_PRW = 104 * MiB;
constexpr size_t WS_OGDN = 93 * MiB;
constexpr size_t WS_OMLA = 105 * MiB;
constexpr size_t WS_Y = 117 * MiB;
constexpr size_t WS_RS = 133 * MiB;
constexpr size_t WS_RD = 157 * MiB;
constexpr size_t WS_XB = 133 * MiB;
constexpr size_t WS_Q = 207 * MiB;
constexpr size_t WS_K = 225 * MiB;
constexpr size_t WS_VT = 243 * MiB;
constexpr size_t WS_MIX = 207 * MiB;
constexpr size_t WS_END = 255 * MiB;
constexpr int RS_REC = 384;
constexpr size_t RD_DIR = (size_t)BATCH * 4 * SEQ * RS_REC;
__device__ __forceinline__ size_t rw_rec_off(int bh, int t, int arr, int w) { return ((size_t)(bh * (SEQ / 64) + (t >> 6)) * 3 + arr) * 8192 + w * 1024 + (t & 63) * 16; }
constexpr int CW_BAR = 4096;
constexpr int CW_QUEUE = 16384;

constexpr int NWAVES = 8;
constexpr int RING_OFF = 0, RING_BYTES = 131072, LDSCTL_OFF = RING_BYTES, MISC_OFF = LDSCTL_OFF + 320, LDS_BYTES = 147456;
static_assert(pg8::TIDTAB_OFF == MISC_OFF + 512 && RING_OFF == 0, "LDS map");
constexpr int NPHASE = 12;

__device__ __forceinline__ float bf2f(bf16 v) { return __uint_as_float(((unsigned)v) << 16); }
__device__ __forceinline__ float wave_sum(float v) {
#pragma unroll
    for (int o = 1; o < 64; o <<= 1) v += __shfl_xor(v, o);
    return v;
}
__device__ __forceinline__ float siluf(float x) { return x * __builtin_amdgcn_rcpf(1.f + __expf(-x)); }
__device__ __forceinline__ float sigmoidf_(float x) { return __builtin_amdgcn_rcpf(1.f + __expf(-x)); }
__device__ __forceinline__ float softplusf_(float x) { return x > 20.f ? x : log1pf(__expf(x)); }

typedef float f32x2_t __attribute__((ext_vector_type(2))); typedef __bf16 bf16x2_t __attribute__((ext_vector_type(2)));
__device__ __forceinline__ unsigned cvt2bf(float lo, float hi) { const f32x2_t v = {lo, hi}; const bf16x2_t b = __builtin_convertvector(v, bf16x2_t); return __builtin_bit_cast(unsigned, b); }

struct Args { const void* in[24]; float* out; unsigned char* ws; int ph_lo, ph_hi; };

struct Frame {
    LAS unsigned char* lds;
    volatile LAS unsigned* MISC;
    gu32* ctl;
    int tid, lane, wave, vcu, G;
    unsigned char* ws;
    float* out;
    volatile LAS const unsigned long long* ptab;
};
__device__ __forceinline__ const void* inptr(const Frame& F, int k) {
    const unsigned long long v = F.ptab[k];
    const unsigned lo = __builtin_amdgcn_readfirstlane((unsigned)v), hi = __builtin_amdgcn_readfirstlane((unsigned)(v >> 32));
    return (const void*)(GAS const void*)(((unsigned long long)hi << 32) | lo);
}

__device__ __forceinline__ void tr_item(const float* W, int K, int ldsrc, int scol, int nvalid, bf16* WT, const float* gs, LAS float* scr, int kb, int lane) {
    const int k0 = 64 * kb;
#pragma unroll 8
    for (int i = 0; i < 32; ++i) { const int kk = 2 * i + (lane >> 5), n = lane & 31; float v = 0.f;
        if (n < nvalid) { v = W[(size_t)(k0 + kk) * ldsrc + scol + n]; if (gs) v *= gs[k0 + kk]; }
        scr[kk * 33 + n] = v; }
    LDS_WAIT(); asm volatile("" ::: "memory");
    const int c = lane & 7;
#pragma unroll
    for (int j = 0; j < 4; ++j) { const int n = (lane >> 3) + 8 * j; const LAS float* s = scr + (8 * c) * 33 + n;
        v4u o; o.x = pk2(s[0 * 33], s[1 * 33]); o.y = pk2(s[2 * 33], s[3 * 33]); o.z = pk2(s[4 * 33], s[5 * 33]); o.w = pk2(s[6 * 33], s[7 * 33]);
        *(GAS v4u*)(WT + (size_t)n * K + k0 + 8 * c) = o; }
    LDS_WAIT(); asm volatile("" ::: "memory");
}
__device__ __forceinline__ void p0_prologue(Frame& F) {
    LAS float* scr = (LAS float*)(F.lds + RING_OFF + F.wave * 16384);
    const int gw = F.vcu * NWAVES + F.wave, NGW = F.G * NWAVES;
    constexpr int I_IN = 112 * 16, I_OUT = 32 * 16, I_UQ = 18 * 3, I_UKV = 24 * 2, I_W2 = 16, I_A2 = 16, I_L = I_IN + I_OUT + I_UQ + I_UKV + I_W2 + I_A2;
    for (int it = gw; it < 2 * I_L; it += NGW) {
        const int l = it / I_L; int r = it % I_L;
        if (r < I_IN) { const int nb = r >> 4, kb = r & 15, n0 = 32 * nb; int scol, nv;
            if (n0 < 2176) { scol = n0; nv = 32; } else if (n0 < 3424) { scol = n0 + 24; nv = 32; } else if (n0 == 3424) { scol = 2176; nv = 24; } else { scol = 0; nv = 0; }
            tr_item((const float*)inptr(F, 3) + (size_t)l * D * NIN, D, NIN, scol, nv, (bf16*)(F.ws + WS_WIN) + ((size_t)l * NP + n0) * D, (const float*)inptr(F, 2) + l * D, scr, kb, F.lane); continue; }
        r -= I_IN;
        if (r < I_OUT) { const int nb = r >> 4, kb = r & 15;
            tr_item((const float*)inptr(F, 22) + (size_t)l * D * D, D, D, 32 * nb, 32, (bf16*)(F.ws + WS_WOUT) + ((size_t)l * D + 32 * nb) * D, nullptr, scr, kb, F.lane); continue; }
        r -= I_OUT;
        if (r < I_UQ) { const int nb = r / 3, kb = r % 3;
            tr_item((const float*)inptr(F, 9) + (size_t)l * 192 * 576, 192, 576, 32 * nb, 32, (bf16*)(F.ws + WS_WSMALL + OFF_WUQ) + ((size_t)l * 576 + 32 * nb) * 192, (const float*)inptr(F, 8) + l * 192, scr, kb, F.lane); continue; }
        r -= I_UQ;
        if (r < I_UKV) { const int nb = r >> 1, kb = r & 1;
            tr_item((const float*)inptr(F, 11) + (size_t)l * 128 * 768, 128, 768, 32 * nb, 32, (bf16*)(F.ws + WS_WSMALL + OFF_WUKV) + ((size_t)l * 768 + 32 * nb) * 128, (const float*)inptr(F, 10) + l * 128, scr, kb, F.lane); continue; }
        r -= I_UKV;
        if (r < I_W2) { const int e = r >> 3, nb = r & 7;
            tr_item((const float*)inptr(F, 14) + ((size_t)l * 2 + e) * 64 * 256, 64, 256, 32 * nb, 32, (bf16*)(F.ws + WS_WSMALL + OFF_W2T) + (((size_t)l * 2 + e) * 256 + 32 * nb) * 64, nullptr, scr, 0, F.lane); continue; }
        r -= I_W2;
        { const int e = r >> 3, nb = r & 7;
            tr_item((const float*)inptr(F, 16) + ((size_t)l * 2 + e) * 64 * 256, 64, 256, 32 * nb, 32, (bf16*)(F.ws + WS_WSMALL + OFF_A2T) + (((size_t)l * 2 + e) * 256 + 32 * nb) * 64, nullptr, scr, 0, F.lane); }
    }
    const float* x = (const float*)inptr(F, 0); bf16* xb = (bf16*)(F.ws + WS_XB); float* rowss = (float*)(F.ws + WS_ROWSS);
    for (int m = gw; m < M; m += NGW) {
        const GAS f32x4* xr = (const GAS f32x4*)(x + (size_t)m * D) + F.lane;
        GAS unsigned long long* o8 = (GAS unsigned long long*)(xb + (size_t)m * D) + F.lane; float s = 0.f;
#pragma unroll
        for (int j = 0; j < 4; ++j) { const f32x4 v = xr[64 * j]; s += (v.x * v.x + v.y * v.y) + (v.z * v.z + v.w * v.w);
            o8[64 * j] = (unsigned long long)pk2(v.x, v.y) | ((unsigned long long)pk2(v.z, v.w) << 32); }
        s = wave_sum(s);
        if (F.lane < 16) rowss[(size_t)m * 16 + F.lane] = F.lane == 0 ? s : 0.f;
    }
}
__device__ __forceinline__ void p5_final(Frame& F) {
    const int gw = F.vcu * NWAVES + F.wave, NGW = F.G * NWAVES;
    const float* rowss = (const float*)(F.ws + WS_ROWSS); const float* g = (const float*)inptr(F, 23);
    f32x4 gv[4];
#pragma unroll
    for (int j = 0; j < 4; ++j) gv[j] = ((const f32x4*)g)[F.lane + 64 * j];
    for (int m = gw; m < M; m += NGW) {
        float ss = F.lane < 16 ? rowss[(size_t)m * 16 + F.lane] : 0.f;
        ss = wave_sum(ss);
        const float rstd = rsqrtf(ss * (1.f / D) + NORM_EPS);
        GAS f32x4* xr = (GAS f32x4*)(F.out + (size_t)m * D) + F.lane;
#pragma unroll
        for (int j = 0; j < 4; ++j) { f32x4 v = xr[64 * j]; v = v * rstd * gv[j]; xr[64 * j] = v; }
    }
}
typedef float f32x16 __attribute__((ext_vector_type(16)));
typedef unsigned long long u64_t;
__device__ __forceinline__ bf16x8 mk_bf16x8(u64_t lo, u64_t hi) { typedef u64_t u64x2 __attribute__((ext_vector_type(2))); u64x2 v = {lo, hi}; return __builtin_bit_cast(bf16x8, v); }

constexpr int AT_KP = 208, AT_VP = 136, AT_KBYTES = 64 * AT_KP, AT_VBYTES = 64 * AT_VP, AT_BUF = AT_KBYTES + AT_VBYTES;
__device__ __forceinline__ float at_max3(float a, float b, float c) { float r; asm("v_max3_f32 %0, %1, %2, %3" : "=v"(r) : "v"(a), "v"(b), "v"(c)); return r; }
__device__ __forceinline__ void attn_unit(Frame& F, int unit) {
    const int bh = unit >> 3, qb = unit & 7, b = bh / 6, h = bh % 6;
    const int tid = F.tid, lane = F.lane, wave = F.wave, r32 = lane & 31, hi = lane >> 5;
    const bf16* Qg = (const bf16*)(F.ws + WS_Q) + ((size_t)bh * SEQ + qb * 256 + wave * 32 + r32) * 96;
    const bf16* Kg = (const bf16*)(F.ws + WS_K) + (size_t)bh * SEQ * 96;
    const bf16* Vg = (const bf16*)(F.ws + WS_VT) + (size_t)bh * 64 * SEQ;
    LAS unsigned char* lds = F.lds + RING_OFF;
    bf16x8 qf[6];
#pragma unroll
    for (int s = 0; s < 6; ++s) qf[s] = *(const bf16x8*)(Qg + 16 * s + 8 * hi);
    const int kr0 = tid / 12, kc0 = tid % 12, kr1 = (512 + tid) / 12, kc1 = (512 + tid) % 12, vd = tid >> 3, vc = tid & 7;
    const bool has1 = tid < 256;
    v4u ka0, ka1 = {0u, 0u, 0u, 0u}, va, kb0, kb1 = {0u, 0u, 0u, 0u}, vb;
#define AT_LOAD(K0, K1, V_, t0) do { K0 = *(const v4u*)(Kg + (size_t)((t0) + kr0) * 96 + kc0 * 8); if (has1) K1 = *(const v4u*)(Kg + (size_t)((t0) + kr1) * 96 + kc1 * 8); \
        V_ = *(const v4u*)(Vg + (size_t)vd * SEQ + (t0) + vc * 8); } while (0)
#define AT_STORE(K0, K1, V_, buf) do { LAS unsigned char* bb_ = lds + (buf) * AT_BUF; *(LAS v4u*)(bb_ + kr0 * AT_KP + kc0 * 16) = K0; if (has1) *(LAS v4u*)(bb_ + kr1 * AT_KP + kc1 * 16) = K1; \
        LAS u64_t* vp_ = (LAS u64_t*)(bb_ + AT_KBYTES + vd * AT_VP + vc * 16); vp_[0] = (u64_t)V_.x | ((u64_t)V_.y << 32); vp_[1] = (u64_t)V_.z | ((u64_t)V_.w << 32); } while (0)
    AT_LOAD(ka0, ka1, va, 0); AT_STORE(ka0, ka1, va, 0);
    AT_LOAD(ka0, ka1, va, 64);
    __syncthreads();
    f32x16 o0 = {}, o1 = {};
    float mrun = -1e30f, lsum = 0.f;
    constexpr int NT = SEQ / 64;
    auto tile = [&](int t) {
        LAS unsigned char* bb = lds + (t % 3) * AT_BUF;
        f32x16 p0 = {}, p1 = {};
        { const LAS unsigned char* kb = bb + r32 * AT_KP + hi * 16;
#pragma unroll
          for (int s = 0; s < 6; ++s) {
              const bf16x8 a0 = *(const LAS bf16x8*)(kb + 32 * s), a1 = *(const LAS bf16x8*)(kb + 32 * AT_KP + 32 * s);
              p0 = __builtin_amdgcn_mfma_f32_32x32x16_bf16(a0, qf[s], p0, 0, 0, 0);
              p1 = __builtin_amdgcn_mfma_f32_32x32x16_bf16(a1, qf[s], p1, 0, 0, 0); } }
        asm volatile("s_nop 15\n\ts_nop 7" : "+v"(p0), "+v"(p1));
        float ma = at_max3(p0[0], p0[1], p1[0]), mb = at_max3(p0[2], p0[3], p1[1]); ma = at_max3(ma, p1[2], p1[3]);
#pragma unroll
        for (int r = 4; r < 16; r += 4) { ma = at_max3(ma, p0[r], p0[r + 1]); mb = at_max3(mb, p0[r + 2], p0[r + 3]); ma = at_max3(ma, p1[r], p1[r + 1]); mb = at_max3(mb, p1[r + 2], p1[r + 3]); }
        float mloc = at_max3(ma, mb, mrun);
        { const auto rr = __builtin_amdgcn_permlane32_swap(__float_as_uint(mloc), __float_as_uint(mloc), false, false); mloc = at_max3(__uint_as_float(rr[0]), __uint_as_float(rr[1]), mloc); }
        const float mnew = mloc, alpha = __builtin_amdgcn_exp2f(mrun - mnew);
        mrun = mnew; lsum *= alpha;
#pragma unroll
        for (int r = 0; r < 16; ++r) { o0[r] *= alpha; o1[r] *= alpha; }
        float ps = 0.f;
#pragma unroll
        for (int r = 0; r < 16; ++r) { p0[r] = __builtin_amdgcn_exp2f(p0[r] - mnew); p1[r] = __builtin_amdgcn_exp2f(p1[r] - mnew); ps += p0[r] + p1[r]; }
        lsum += ps;
        v4u pk[4];
#pragma unroll
        for (int s2 = 0; s2 < 2; ++s2) {
            pk[s2] = (v4u){pg8::cvt_pk_bf16(p0[8 * s2], p0[8 * s2 + 1]), pg8::cvt_pk_bf16(p0[8 * s2 + 2], p0[8 * s2 + 3]), pg8::cvt_pk_bf16(p0[8 * s2 + 4], p0[8 * s2 + 5]), pg8::cvt_pk_bf16(p0[8 * s2 + 6], p0[8 * s2 + 7])};
            pk[2 + s2] = (v4u){pg8::cvt_pk_bf16(p1[8 * s2], p1[8 * s2 + 1]), pg8::cvt_pk_bf16(p1[8 * s2 + 2], p1[8 * s2 + 3]), pg8::cvt_pk_bf16(p1[8 * s2 + 4], p1[8 * s2 + 5]), pg8::cvt_pk_bf16(p1[8 * s2 + 6], p1[8 * s2 + 7])};
        }
        { const LAS unsigned char* vb_ = bb + AT_KBYTES + r32 * AT_VP + hi * 8;
#pragma unroll
          for (int ks = 0; ks < 4; ++ks) {
              const bf16x8 pb = __builtin_bit_cast(bf16x8, pk[ks]);
              const bf16x8 v0 = mk_bf16x8(*(const LAS u64_t*)(vb_ + ks * 32), *(const LAS u64_t*)(vb_ + ks * 32 + 16));
              const bf16x8 v1 = mk_bf16x8(*(const LAS u64_t*)(vb_ + 32 * AT_VP + ks * 32), *(const LAS u64_t*)(vb_ + 32 * AT_VP + ks * 32 + 16));
              o0 = __builtin_amdgcn_mfma_f32_32x32x16_bf16(v0, pb, o0, 0, 0, 0);
              o1 = __builtin_amdgcn_mfma_f32_32x32x16_bf16(v1, pb, o1, 0, 0, 0); } }
    };
    for (int t = 0; t < NT; t += 2) {
        if (t + 2 < NT) AT_LOAD(kb0, kb1, vb, (t + 2) * 64);
        tile(t);
        AT_STORE(ka0, ka1, va, (t + 1) % 3);
        __syncthreads();
        if (t + 3 < NT) AT_LOAD(ka0, ka1, va, (t + 3) * 64);
        tile(t + 1);
        if (t + 2 < NT) AT_STORE(kb0, kb1, vb, (t + 2) % 3);
        __syncthreads();
    }
#undef AT_LOAD
#undef AT_STORE
    lsum += __shfl_xor(lsum, 32);
    const float inv = 1.f / lsum;
    bf16* Og = (bf16*)(F.ws + WS_OMLA) + ((size_t)b * SEQ + qb * 256 + wave * 32 + r32) * 384 + h * 64 + 4 * hi;
#pragma unroll
    for (int rg = 0; rg < 4; ++rg) {
        *(u64_t*)(Og + 8 * rg) = (u64_t)pg8::cvt_pk_bf16(o0[4 * rg] * inv, o0[4 * rg + 1] * inv) | ((u64_t)pg8::cvt_pk_bf16(o0[4 * rg + 2] * inv, o0[4 * rg + 3] * inv) << 32);
        *(u64_t*)(Og + 32 + 8 * rg) = (u64_t)pg8::cvt_pk_bf16(o1[4 * rg] * inv, o1[4 * rg + 1] * inv) | ((u64_t)pg8::cvt_pk_bf16(o1[4 * rg + 2] * inv, o1[4 * rg + 3] * inv) << 32);
    }
}

constexpr int CW_FLAG = 32768;
__device__ __forceinline__ void partner_sync(Frame& F, gu32* mine, gu32* theirs) {
    asm volatile("s_waitcnt vmcnt(0)" ::: "memory");
    __syncthreads();
    if (F.tid == 0) {
        __builtin_amdgcn_fence(__ATOMIC_RELEASE, "agent");
        asm volatile("s_waitcnt vmcnt(0)" ::: "memory");
        __hip_atomic_store(mine, 1u, RLX_AGENT);
        unsigned spins = 0;
        while (__hip_atomic_load(theirs, RLX_AGENT) == 0u) { __builtin_amdgcn_s_sleep(4); if (++spins > (1u << 22)) break; }
        __builtin_amdgcn_fence(__ATOMIC_ACQUIRE, "agent");
        asm volatile("s_waitcnt vmcnt(0)" ::: "memory");
    }
    __syncthreads();
}
constexpr int RW_STEP = 1440, RW_CH = 32, RW_BUF = RW_CH * RW_STEP;
constexpr int RW_Y = 2 * RW_BUF;
static_assert(RW_Y + 2 * 4096 <= RING_BYTES, "RWKV LDS map");
__device__ __forceinline__ float dpp_xor1(float x) { return __builtin_bit_cast(float, __builtin_amdgcn_update_dpp(0, __builtin_bit_cast(int, x), 0xB1, 0xF, 0xF, true)); }
__device__ __forceinline__ float dpp_xor2(float x) { return __builtin_bit_cast(float, __builtin_amdgcn_update_dpp(0, __builtin_bit_cast(int, x), 0x4E, 0xF, 0xF, true)); }
__device__ __forceinline__ float dpp_hmir(float x) { return __builtin_bit_cast(float, __builtin_amdgcn_update_dpp(0, __builtin_bit_cast(int, x), 0x141, 0xF, 0xF, true)); }
__device__ __forceinline__ float dpp_rmir(float x) { return __builtin_bit_cast(float, __builtin_amdgcn_update_dpp(0, __builtin_bit_cast(int, x), 0x140, 0xF, 0xF, true)); }
template <int CTRL, int RM> __device__ __forceinline__ float dpp_sh(float x) { return __builtin_bit_cast(float, __builtin_amdgcn_update_dpp(0, __builtin_bit_cast(int, x), CTRL, RM, 0xF, false)); }
__device__ __forceinline__ float wave_scan(float x) {
    x += dpp_sh<0x111, 0xF>(x); x += dpp_sh<0x112, 0xF>(x); x += dpp_sh<0x114, 0xF>(x); x += dpp_sh<0x118, 0xF>(x);
    x += dpp_sh<0x142, 0xA>(x); x += dpp_sh<0x143, 0xC>(x); return x; }
__device__ __forceinline__ float lane63(float x) { return __builtin_bit_cast(float, __builtin_amdgcn_readlane(__builtin_bit_cast(int, x), 63)); }
constexpr int GP = 144;
constexpr int G_Q = 0, G_K = 9216, G_V = 18432, G_KT = 27648, G_P = 36864, G_A = 46080, G_SM = 63488, G_GROUP = 64512;
constexpr int G_T = 92160;
constexpr int G_RAW = 65536;
constexpr int G_CW = 133120;
static_assert(2 * G_GROUP <= RING_BYTES && G_CW + 3840 <= LDS_BYTES && G_CW >= MISC_OFF + 1024, "GDN LDS map");
__device__ __forceinline__ bf16x8 ld2x8(const LAS unsigned char* p) { return mk_bf16x8(*(const LAS u64_t*)p, *(const LAS u64_t*)(p + 32)); }
__device__ __forceinline__ bf16x8 pack_acc(const f32x4& a, const f32x4& b) {
    v4u w; w.x = pg8::cvt_pk_bf16(a[0], a[1]); w.y = pg8::cvt_pk_bf16(a[2], a[3]); w.z = pg8::cvt_pk_bf16(b[0], b[1]); w.w = pg8::cvt_pk_bf16(b[2], b[3]); return __builtin_bit_cast(bf16x8, w); }
__device__ __forceinline__ void split_acc(const f32x4& a, const f32x4& b, bf16x8& hi, bf16x8& lo) {
    v4u wh; wh.x = cvt2bf(a[0], a[1]); wh.y = cvt2bf(a[2], a[3]); wh.z = cvt2bf(b[0], b[1]); wh.w = cvt2bf(b[2], b[3]);
    f32x4 ra, rb;
    ra[0] = a[0] - __uint_as_float(wh.x << 16); ra[1] = a[1] - __uint_as_float(wh.x & 0xffff0000u); ra[2] = a[2] - __uint_as_float(wh.y << 16); ra[3] = a[3] - __uint_as_float(wh.y & 0xffff0000u);
    rb[0] = b[0] - __uint_as_float(wh.z << 16); rb[1] = b[1] - __uint_as_float(wh.z & 0xffff0000u); rb[2] = b[2] - __uint_as_float(wh.w << 16); rb[3] = b[3] - __uint_as_float(wh.w & 0xffff0000u);
    hi = __builtin_bit_cast(bf16x8, wh); lo = pack_acc(ra, rb);
}
__device__ __forceinline__ void hilo4(const f32x4& a, u64_t& hi, u64_t& lo) {
    const unsigned h0 = cvt2bf(a[0], a[1]), h1 = cvt2bf(a[2], a[3]);
    const float r0 = a[0] - __uint_as_float(h0 << 16), r1 = a[1] - __uint_as_float(h0 & 0xffff0000u), r2 = a[2] - __uint_as_float(h1 << 16), r3 = a[3] - __uint_as_float(h1 & 0xffff0000u);
    hi = (u64_t)h0 | ((u64_t)h1 << 32); lo = (u64_t)cvt2bf(r0, r1) | ((u64_t)cvt2bf(r2, r3) << 32);
}
typedef _Float16 f16x8 __attribute__((ext_vector_type(8)));
typedef _Float16 h4_t __attribute__((ext_vector_type(4)));
__device__ __forceinline__ f16x8 pack_acc_f16(const f32x4& a, const f32x4& b) { return (f16x8){(_Float16)a[0], (_Float16)a[1], (_Float16)a[2], (_Float16)a[3], (_Float16)b[0], (_Float16)b[1], (_Float16)b[2], (_Float16)b[3]}; }
template <int SKIP> __device__ __forceinline__ void gdn_unit3(Frame& F, int l, int unit, gu32* flags) {
    const int bh = unit >> 1, dir = unit & 1, b = bh / 6, h = bh % 6;
    const int tid = F.tid, lane = F.lane, wave = F.wave;
    const bf16* Pgdn = (const bf16*)(F.ws + WS_PGDN) + (size_t)b * SEQ * 1152 + h * 64; const float* Psm = (const float*)(F.ws + WS_PSM) + (size_t)b * SEQ * 32;
    bf16* Og = (SKIP & 128) ? (bf16*)(F.ws + WS_Y + 8 * MiB) + (size_t)(b % 5) * SEQ * 384 + h * 64 : (bf16*)(F.ws + WS_OGDN) + (size_t)b * SEQ * 384 + h * 64;
    LAS unsigned char* gb = F.lds + RING_OFF;
    LAS float* cwl = (LAS float*)(F.lds + G_CW);
    LAS float* sm = (LAS float*)(gb + G_SM);
    { const float* conv_w = (const float*)inptr(F, 4) + (size_t)l * 5 * 1152;
      for (int i = tid; i < 960; i += 512) { const int tn = i / 320, tap = (i % 320) / 64, ch = i % 64; cwl[i] = conv_w[tap * 1152 + tn * 384 + h * 64 + ch]; } }
    const float al = -__expf(((const float*)inptr(F, 5))[l * 12 + dir * 6 + h]), dtb = ((const float*)inptr(F, 6))[l * 12 + dir * 6 + h];
    f32x4 Sacc[4];
#pragma unroll
    for (int i = 0; i < 4; ++i) Sacc[i] = (f32x4){0.f, 0.f, 0.f, 0.f};
    const int ci = tid >> 3, cg = tid & 7;
#define GDN_RAW_STAGE(cc_, first_, nthr_) do { const int tlo_ = (dir ? SEQ - 64 * (cc_) - 64 : 64 * (cc_)) - 2; \
        for (int pc_ = (first_); pc_ < 68 * 24; pc_ += (nthr_)) { const int rr_ = pc_ / 24, sg_ = pc_ % 24, tt_ = tlo_ + rr_; v4u x_ = {0u, 0u, 0u, 0u}; \
            if (!(SKIP & 1) && tt_ >= 0 && tt_ < SEQ) x_ = *(const v4u*)(Pgdn + (size_t)tt_ * 1152 + (sg_ >> 3) * 384 + 8 * (sg_ & 7)); \
            *(LAS v4u*)(gb + G_RAW + rr_ * 384 + 16 * sg_) = x_; } } while (0)
#define GDN_WRITEOUT(cc_) do { if (!(SKIP & 4)) { const int t_ = dir ? SEQ - 1 - 64 * (cc_) - ci : 64 * (cc_) + ci; bf16* op_ = Og + (size_t)t_ * 384 + 8 * cg; \
            const LAS f32x4* src_ = (const LAS f32x4*)(gb + G_A + (ci * 68 + 8 * cg) * 4); f32x4 o0_ = src_[0], o1_ = src_[1]; \
            if ((cc_) >= SEQ / 128) { const v4u p0_ = *(const v4u*)op_; \
                o0_ += (f32x4){__uint_as_float(p0_.x << 16), __uint_as_float(p0_.x & 0xffff0000u), __uint_as_float(p0_.y << 16), __uint_as_float(p0_.y & 0xffff0000u)}; \
                o1_ += (f32x4){__uint_as_float(p0_.z << 16), __uint_as_float(p0_.z & 0xffff0000u), __uint_as_float(p0_.w << 16), __uint_as_float(p0_.w & 0xffff0000u)}; } \
            v4u w0_; w0_.x = pg8::cvt_pk_bf16(o0_[0], o0_[1]); w0_.y = pg8::cvt_pk_bf16(o0_[2], o0_[3]); w0_.z = pg8::cvt_pk_bf16(o1_[0], o1_[1]); w0_.w = pg8::cvt_pk_bf16(o1_[2], o1_[3]); \
            *(v4u*)op_ = w0_; } } while (0)
    GDN_RAW_STAGE(0, tid, 512);
#define GDN_RAW_LOAD(cc_) do { const int tlo_ = (dir ? SEQ - 64 * (cc_) - 64 : 64 * (cc_)) - 2; \
        _Pragma("unroll") for (int k_ = 0; k_ < 4; ++k_) { const int pc_ = tid + 512 * k_, rr_ = pc_ / 24, sg_ = pc_ % 24, tt_ = tlo_ + rr_; rawn[k_] = (v4u){0u, 0u, 0u, 0u}; \
            if (!(SKIP & 1) && pc_ < 68 * 24 && tt_ >= 0 && tt_ < SEQ) rawn[k_] = *(const v4u*)(Pgdn + (size_t)tt_ * 1152 + (sg_ >> 3) * 384 + 8 * (sg_ & 7)); } } while (0)
#define GDN_RAW_STORE() do { _Pragma("unroll") for (int k_ = 0; k_ < 4; ++k_) { const int pc_ = tid + 512 * k_, rr_ = pc_ / 24, sg_ = pc_ % 24; \
            if (pc_ < 68 * 24) *(LAS v4u*)(gb + G_RAW + rr_ * 384 + 16 * sg_) = rawn[k_]; } } while (0)
    v4u rawn[4];
    __syncthreads();
    for (int c = 0; c < SEQ / 64; ++c) {
        if (c > 0) GDN_WRITEOUT(c - 1);
        if (c == SEQ / 128) partner_sync(F, flags + 64 * unit, flags + 64 * (unit ^ 1));
        if (!(SKIP & 64) && wave == 0) {
            const int t = dir ? SEQ - 1 - 64 * c - lane : 64 * c + lane;
            const float a = Psm[(size_t)t * 32 + dir * 6 + h], bt = Psm[(size_t)t * 32 + 12 + dir * 6 + h];
            float x = al * softplusf_(a + dtb);
            x = wave_scan(x);
            const float last = lane63(x);
            sm[lane] = x; sm[64 + lane] = sigmoidf_(bt); sm[128 + lane] = __expf(x); sm[192 + lane] = __expf(last - x);
        }
        if (!(SKIP & 16)) { float acc[3][8];
#pragma unroll
          for (int tn = 0; tn < 3; ++tn)
#pragma unroll
              for (int j = 0; j < 8; ++j) acc[tn][j] = 0.f;
          const int rr0 = dir ? 63 - ci : ci;
#pragma unroll
          for (int tap = 0; tap < 5; ++tap) {
#pragma unroll
              for (int tn = 0; tn < 3; ++tn) { const v4u x0 = *(const LAS v4u*)(gb + G_RAW + (rr0 + tap) * 384 + tn * 128 + 16 * cg); const LAS float* w = cwl + tn * 320 + tap * 64 + 8 * cg; const f32x4 w0 = *(const LAS f32x4*)w, w1 = *(const LAS f32x4*)(w + 4);
                  acc[tn][0] += w0[0] * __uint_as_float(x0[0] << 16); acc[tn][1] += w0[1] * __uint_as_float(x0[0] & 0xffff0000u); acc[tn][2] += w0[2] * __uint_as_float(x0[1] << 16); acc[tn][3] += w0[3] * __uint_as_float(x0[1] & 0xffff0000u);
                  acc[tn][4] += w1[0] * __uint_as_float(x0[2] << 16); acc[tn][5] += w1[1] * __uint_as_float(x0[2] & 0xffff0000u); acc[tn][6] += w1[2] * __uint_as_float(x0[3] << 16); acc[tn][7] += w1[3] * __uint_as_float(x0[3] & 0xffff0000u); }
              asm volatile("" ::: "memory"); }
          float sq = 0.f, sk = 0.f;
#pragma unroll
          for (int j = 0; j < 8; ++j) { acc[0][j] = siluf(acc[0][j]); acc[1][j] = siluf(acc[1][j]); acc[2][j] = siluf(acc[2][j]); sq += acc[0][j] * acc[0][j]; sk += acc[1][j] * acc[1][j]; }
          sq += dpp_xor1(sq); sk += dpp_xor1(sk); sq += dpp_xor2(sq); sk += dpp_xor2(sk); sq += dpp_hmir(sq); sk += dpp_hmir(sk);
          const float rq = rsqrtf(sq + 1e-6f) * 0.125f, rk = rsqrtf(sk + 1e-6f);
          v4u wq, wk, wv;
#pragma unroll
          for (int q = 0; q < 4; ++q) { wq[q] = pg8::cvt_pk_bf16(acc[0][2 * q] * rq, acc[0][2 * q + 1] * rq); wk[q] = pg8::cvt_pk_bf16(acc[1][2 * q] * rk, acc[1][2 * q + 1] * rk); wv[q] = pg8::cvt_pk_bf16(acc[2][2 * q], acc[2][2 * q + 1]); }
          LAS unsigned char* row = gb + ci * GP + 16 * cg;
          *(LAS v4u*)(row + G_Q) = wq; *(LAS v4u*)(row + G_K) = wk; *(LAS v4u*)(row + G_V) = wv;
#pragma unroll
          for (int j = 0; j < 8; ++j) *(LAS bf16*)(gb + G_KT + (8 * cg + j) * GP + 2 * ci) = (bf16)((j & 1) ? (wk[j >> 1] >> 16) : (wk[j >> 1] & 0xffffu)); }
        __syncthreads();
        if (c + 1 < SEQ / 64) GDN_RAW_LOAD(c + 1);
        if (!(SKIP & 32)) { const int ti = (wave >> 1) & 1, tj = wave & 1, r32 = lane & 31, hi = lane >> 5;
          f32x16 acc = {};
          const LAS unsigned char* ir = gb + (wave >= 4 ? G_Q : G_K) + (32 * ti + r32) * GP + 16 * hi; const LAS unsigned char* jr = gb + G_K + (32 * tj + r32) * GP + 16 * hi;
#pragma unroll
          for (int s = 0; s < 4; ++s) acc = __builtin_amdgcn_mfma_f32_32x32x16_bf16(*(const LAS bf16x8*)(jr + 32 * s), *(const LAS bf16x8*)(ir + 32 * s), acc, 0, 0, 0);
          const int i = 32 * ti + r32; const float ci = sm[i];
          if (wave < 4) { const float bi = sm[64 + i];
#pragma unroll
              for (int g = 0; g < 4; ++g) { const int j0 = 32 * tj + 8 * g + 4 * hi; const f32x4 cj = *(const LAS f32x4*)(sm + j0); f32x4 o;
#pragma unroll
                  for (int r = 0; r < 4; ++r) o[r] = (i > j0 + r) ? bi * acc[4 * g + r] * __expf(fminf(ci - cj[r], 0.f)) : 0.f;
                  *(LAS f32x4*)((LAS float*)(gb + G_A) + i * 68 + j0) = o; } }
          else {
#pragma unroll
              for (int g = 0; g < 4; ++g) { const int j0 = 32 * tj + 8 * g + 4 * hi; const f32x4 cj = *(const LAS f32x4*)(sm + j0); h4_t o;
#pragma unroll
                  for (int r = 0; r < 4; ++r) o[r] = (_Float16)((i >= j0 + r) ? acc[4 * g + r] * __expf(fminf(ci - cj[r], 0.f)) : 0.f);
                  *(LAS h4_t*)(gb + G_P + i * GP + 2 * j0) = o; } } }
        __syncthreads();
        if (!(SKIP & 2) && wave == 0) {
            const int bb = lane >> 4, cc = lane & 15; float T[16];
            const LAS float* Ab = (const LAS float*)(gb + G_A) + (16 * bb) * 68 + 16 * bb;
#pragma unroll
            for (int i = 0; i < 16; ++i) { float a0 = 0.f, a1 = 0.f;
#pragma unroll
                for (int j4 = 0; j4 < (i + 3) / 4; ++j4) { const f32x4 av = *(const LAS f32x4*)(Ab + i * 68 + 4 * j4);
                    a0 += av.x * T[4 * j4] + av.z * T[4 * j4 + 2]; a1 += av.y * T[4 * j4 + 1] + av.w * T[4 * j4 + 3]; }
                T[i] = (i == cc ? 1.f : 0.f) - (a0 + a1);
                if (i < 15 && (i & 3) == 3) asm volatile("" ::: "memory");
                if (i == 0) {
#pragma unroll
                    for (int k = 1; k < 16; ++k) T[k] = 0.f; } }
#pragma unroll
            for (int i = 0; i < 16; ++i) ((LAS float*)(gb + G_T))[(16 * bb + i) * 16 + cc] = T[i];
        }
        __syncthreads();
        f32x4 Xc[4];
#pragma unroll
        for (int g = 0; g < 4; ++g) Xc[g] = (f32x4){0.f, 0.f, 0.f, 0.f};
        if (!(SKIP & 2)) {
            const int col = lane & 15, q4 = lane >> 4, c = 16 * wave + col;
            const LAS unsigned char* src = gb + (c < 64 ? G_V : G_K) + 2 * (c & 63);
            u64_t xh[4], xl[4];
#pragma unroll
            for (int bk = 0; bk < 4; ++bk) {
                f32x4 Y; const f32x4 be = *(const LAS f32x4*)(sm + 64 + 16 * bk + 4 * q4), ga = *(const LAS f32x4*)(sm + 128 + 16 * bk + 4 * q4);
#pragma unroll
                for (int r = 0; r < 4; ++r) Y[r] = bf2f(*(const LAS bf16*)(src + (16 * bk + 4 * q4 + r) * GP)) * be[r] * (c < 64 ? 1.f : ga[r]);
#pragma unroll
                for (int b2 = 0; b2 < bk; b2 += 2) {
                    const LAS float* ar = (const LAS float*)(gb + G_A) + (16 * bk + col) * 68 + 16 * b2 + 4 * q4;
                    f32x4 a0 = -*(const LAS f32x4*)ar, a1 = (b2 + 1 < bk) ? -*(const LAS f32x4*)(ar + 16) : (f32x4){0.f, 0.f, 0.f, 0.f};
                    u64_t ah0, al0, ah1, al1; hilo4(a0, ah0, al0); hilo4(a1, ah1, al1);
                    const u64_t bh1 = (b2 + 1 < bk) ? xh[b2 + 1] : 0ull, bl1 = (b2 + 1 < bk) ? xl[b2 + 1] : 0ull;
                    const bf16x8 Ah = mk_bf16x8(ah0, ah1), Al = mk_bf16x8(al0, al1), Bh = mk_bf16x8(xh[b2], bh1), Bl = mk_bf16x8(xl[b2], bl1);
                    Y = __builtin_amdgcn_mfma_f32_16x16x32_bf16(Al, Bh, Y, 0, 0, 0);
                    Y = __builtin_amdgcn_mfma_f32_16x16x32_bf16(Ah, Bl, Y, 0, 0, 0);
                    Y = __builtin_amdgcn_mfma_f32_16x16x32_bf16(Ah, Bh, Y, 0, 0, 0); }
                { const f32x4 t0 = *(const LAS f32x4*)((const LAS float*)(gb + G_T) + (16 * bk + col) * 16 + 4 * q4);
                  u64_t th, tl, yh, yl; hilo4(t0, th, tl); hilo4(Y, yh, yl);
                  const bf16x8 Ah = mk_bf16x8(th, 0ull), Al = mk_bf16x8(tl, 0ull), Bh = mk_bf16x8(yh, 0ull), Bl = mk_bf16x8(yl, 0ull);
                  f32x4 X = {0.f, 0.f, 0.f, 0.f};
                  X = __builtin_amdgcn_mfma_f32_16x16x32_bf16(Al, Bh, X, 0, 0, 0);
                  X = __builtin_amdgcn_mfma_f32_16x16x32_bf16(Ah, Bl, X, 0, 0, 0);
                  X = __builtin_amdgcn_mfma_f32_16x16x32_bf16(Ah, Bh, X, 0, 0, 0);
                  Xc[bk] = X; hilo4(X, xh[bk], xl[bk]); }
            }
        }
        __syncthreads();
        if (c + 1 < SEQ / 64) GDN_RAW_STORE();
        { const int col = lane & 15, q4 = lane >> 4, c = 16 * wave + col;
          if (wave < 4) {
#pragma unroll
              for (int g = 0; g < 4; ++g)
#pragma unroll
                  for (int r = 0; r < 4; ++r) ((LAS float*)(gb + G_A))[(16 * g + 4 * q4 + r) * 68 + c] = Xc[g][r];
          } else {
#pragma unroll
              for (int g = 0; g < 4; ++g)
#pragma unroll
                  for (int r = 0; r < 4; ++r) { const int i = 16 * g + 4 * q4 + r; const float x = -Xc[g][r]; const unsigned hb = f2bf(x);
                      *(LAS bf16*)(gb + G_V + i * GP + 2 * (c - 64)) = (bf16)hb;
                      *(LAS bf16*)(gb + G_K + i * GP + 2 * (c - 64)) = (bf16)f2bf(x - __uint_as_float(hb << 16)); }
          } }
        __syncthreads();
        if ((SKIP & 8) && wave < 4) {} else
        if (wave < 4) { const int col = lane & 15, q4 = lane >> 4, e = 16 * wave + col;
          bf16x8 bS0, bS1, bS0l, bS1l; split_acc(Sacc[0], Sacc[1], bS0, bS0l); split_acc(Sacc[2], Sacc[3], bS1, bS1l);
          f32x4 U[4], T1[4];
          const LAS unsigned char* rowa = gb + col * GP + 8 * q4;
#pragma unroll
          for (int it = 0; it < 4; ++it) {
              const LAS float* u0p = (const LAS float*)(gb + G_A) + (16 * it + 4 * q4) * 68 + e;
              U[it] = (f32x4){u0p[0], u0p[68], u0p[136], u0p[204]};
              const LAS unsigned char* ra = rowa + 16 * it * GP;
              const bf16x8 wh0 = ld2x8(ra + G_V), wh1 = ld2x8(ra + G_V + 64), wl0 = ld2x8(ra + G_K), wl1 = ld2x8(ra + G_K + 64), qa0 = ld2x8(ra + G_Q), qa1 = ld2x8(ra + G_Q + 64);
              U[it] = __builtin_amdgcn_mfma_f32_16x16x32_bf16(wl0, bS0, U[it], 0, 0, 0);
              U[it] = __builtin_amdgcn_mfma_f32_16x16x32_bf16(wl1, bS1, U[it], 0, 0, 0);
              U[it] = __builtin_amdgcn_mfma_f32_16x16x32_bf16(wh0, bS0l, U[it], 0, 0, 0);
              U[it] = __builtin_amdgcn_mfma_f32_16x16x32_bf16(wh1, bS1l, U[it], 0, 0, 0);
              U[it] = __builtin_amdgcn_mfma_f32_16x16x32_bf16(wh0, bS0, U[it], 0, 0, 0);
              U[it] = __builtin_amdgcn_mfma_f32_16x16x32_bf16(wh1, bS1, U[it], 0, 0, 0);
              T1[it] = __builtin_amdgcn_mfma_f32_16x16x32_bf16(qa0, bS0l, (f32x4){0.f, 0.f, 0.f, 0.f}, 0, 0, 0);
              T1[it] = __builtin_amdgcn_mfma_f32_16x16x32_bf16(qa1, bS1l, T1[it], 0, 0, 0);
              T1[it] = __builtin_amdgcn_mfma_f32_16x16x32_bf16(qa0, bS0, T1[it], 0, 0, 0);
              T1[it] = __builtin_amdgcn_mfma_f32_16x16x32_bf16(qa1, bS1, T1[it], 0, 0, 0);
              asm volatile("" ::: "memory");
          }
          const f16x8 hU0 = pack_acc_f16(U[0], U[1]), hU1 = pack_acc_f16(U[2], U[3]);
          f32x4 Ud[4];
#pragma unroll
          for (int it = 0; it < 4; ++it) { const f32x4 dc = *(const LAS f32x4*)(sm + 192 + 16 * it + 4 * q4); Ud[it] = U[it] * dc; }
          bf16x8 bD0, bD1, bD0l, bD1l; split_acc(Ud[0], Ud[1], bD0, bD0l); split_acc(Ud[2], Ud[3], bD1, bD1l);
          const float gend = sm[191];
#pragma unroll
          for (int it = 0; it < 4; ++it) {
              const LAS unsigned char* ra = rowa + 16 * it * GP;
              const f32x4 gm = *(const LAS f32x4*)(sm + 128 + 16 * it + 4 * q4);
              const bf16x8 pa0 = ld2x8(ra + G_P), pa1 = ld2x8(ra + G_P + 64), ka0 = ld2x8(ra + G_KT), ka1 = ld2x8(ra + G_KT + 64);
              f32x4 O = T1[it] * gm;
              O = __builtin_amdgcn_mfma_f32_16x16x32_f16(__builtin_bit_cast(f16x8, pa0), hU0, O, 0, 0, 0);
              O = __builtin_amdgcn_mfma_f32_16x16x32_f16(__builtin_bit_cast(f16x8, pa1), hU1, O, 0, 0, 0);
              f32x4 Sn = Sacc[it] * gend;
              Sn = __builtin_amdgcn_mfma_f32_16x16x32_bf16(ka0, bD0l, Sn, 0, 0, 0);
              Sn = __builtin_amdgcn_mfma_f32_16x16x32_bf16(ka1, bD1l, Sn, 0, 0, 0);
              Sn = __builtin_amdgcn_mfma_f32_16x16x32_bf16(ka0, bD0, Sn, 0, 0, 0);
              Sn = __builtin_amdgcn_mfma_f32_16x16x32_bf16(ka1, bD1, Sn, 0, 0, 0);
              Sacc[it] = Sn;
#pragma unroll
              for (int r = 0; r < 4; ++r) ((LAS float*)(gb + G_A))[(16 * it + 4 * q4 + r) * 68 + e] = O[r];
              asm volatile("" ::: "memory");
          } }
        __syncthreads();
    }
    GDN_WRITEOUT(SEQ / 64 - 1);
#undef GDN_WRITEOUT
#undef GDN_RAW_STAGE
#undef GDN_RAW_LOAD
#undef GDN_RAW_STORE
    __syncthreads();
}

constexpr int RC_AT = 0, RC_RT = 9216, RC_BT = 18432, RC_KT = 27648, RC_BH = 36864, RC_KH = 46080, RC_VT = 55296, RC_V = 64512, RC_A = 73728  ,
              RC_AK = 91136, RC_RB = 100352, RC_RK = 109568, RC_T = 118784  , RC_SM = 122880  , RC_R2 = RC_BT  ;
static_assert(RC_SM + 256 <= RING_BYTES && RC_R2 + 17408 <= RC_BH, "chunked RWKV LDS map");
template <int SK> __device__ __forceinline__ void rwkv_unit_c(Frame& F, int unit, gu32* flags) {
    const int bh = unit >> 1, dir = unit & 1, b = bh >> 2, h = bh & 3;
    const int tid = F.tid, lane = F.lane, wave = F.wave;
    const unsigned char* Rs = F.ws + WS_RS;
    const unsigned char* Rd = F.ws + WS_RD + dir * RD_DIR;
    bf16* Yg = (bf16*)(F.ws + WS_Y + (SK ? 8 * MiB : 0)) + (size_t)b * SEQ * 256 + h * 64;
    LAS unsigned char* gb = F.lds + RING_OFF;
    LAS float* gamT = (LAS float*)(gb + RC_SM);
    f32x4 Zacc[4];
#pragma unroll
    for (int i = 0; i < 4; ++i) Zacc[i] = (f32x4){0.f, 0.f, 0.f, 0.f};
    const int ci = tid >> 3, cg = tid & 7;
#define RC_WRITEOUT(cc_) do { const int t_ = dir ? SEQ - 1 - 64 * (cc_) - ci : 64 * (cc_) + ci; bf16* op_ = Yg + (size_t)t_ * 256 + 8 * cg; \
        const LAS f32x4* src_ = (const LAS f32x4*)(gb + RC_A + (ci * 68 + 8 * cg) * 4); f32x4 o0_ = src_[0], o1_ = src_[1]; \
        if ((cc_) >= SEQ / 128) { const v4u p0_ = *(const v4u*)op_; \
            o0_ += (f32x4){__uint_as_float(p0_.x << 16), __uint_as_float(p0_.x & 0xffff0000u), __uint_as_float(p0_.y << 16), __uint_as_float(p0_.y & 0xffff0000u)}; \
            o1_ += (f32x4){__uint_as_float(p0_.z << 16), __uint_as_float(p0_.z & 0xffff0000u), __uint_as_float(p0_.w << 16), __uint_as_float(p0_.w & 0xffff0000u)}; } \
        v4u w0_; w0_.x = pg8::cvt_pk_bf16(o0_[0], o0_[1]); w0_.y = pg8::cvt_pk_bf16(o0_[2], o0_[3]); w0_.z = pg8::cvt_pk_bf16(o1_[0], o1_[1]); w0_.w = pg8::cvt_pk_bf16(o1_[2], o1_[3]); \
        *(v4u*)op_ = w0_; } while (0)
    v4u gkk = {0u, 0u, 0u, 0u}, gv = gkk, gr = gkk, glam = gkk, gbv = gkk, gk = gkk;
#define RC_LOAD(cc_) do { if (!(SK & 1)) { const size_t o_ = rw_rec_off(bh, dir ? SEQ - 1 - 64 * (cc_) - lane : 64 * (cc_) + lane, 0, wave); const unsigned char* rs_ = Rs + o_; const unsigned char* rd_ = Rd + o_; \
        gkk = *(const v4u*)rs_; gv = *(const v4u*)(rs_ + 8192); gr = *(const v4u*)(rs_ + 16384); glam = *(const v4u*)rd_; gbv = *(const v4u*)(rd_ + 8192); gk = *(const v4u*)(rd_ + 16384); } } while (0)
    RC_LOAD(0);
    __syncthreads();
    for (int c = 0; c < SEQ / 64; ++c) {
        if (c > 0) RC_WRITEOUT(c - 1);
        if (c == SEQ / 128) partner_sync(F, flags + 64 * unit, flags + 64 * (unit ^ 1));
        if (!(SK & 32)) { const int t = lane, tok = dir ? SEQ - 1 - 64 * c - t : 64 * c + t, j0 = 8 * wave;
          float lam[8], cum[8];
#pragma unroll
          for (int q = 0; q < 4; ++q) { lam[2 * q] = __half2float(__ushort_as_half((unsigned short)(glam[q] & 0xffffu))); lam[2 * q + 1] = __half2float(__ushort_as_half((unsigned short)(glam[q] >> 16))); }
#pragma unroll
          for (int q = 0; q < 8; ++q) cum[q] = wave_scan(lam[q]);
          v4u wa = {0u, 0u, 0u, 0u}, wr = {0u, 0u, 0u, 0u}, wb = {0u, 0u, 0u, 0u}, wk = {0u, 0u, 0u, 0u}; unsigned short bh_[8], kh_[8];
#pragma unroll
          for (int q = 0; q < 8; ++q) { const float cT = lane63(cum[q]);
              const float e1 = __builtin_amdgcn_exp2f(-LOG2E * (cum[q] - lam[q])), e2 = __builtin_amdgcn_exp2f(-LOG2E * cum[q]), e3 = __builtin_amdgcn_exp2f(LOG2E * cum[q]), e4 = __builtin_amdgcn_exp2f(-LOG2E * (cT - cum[q]));
              const float kkq = __uint_as_float((q & 1) ? (gkk[q >> 1] & 0xffff0000u) : (gkk[q >> 1] << 16)), rq = __uint_as_float((q & 1) ? (gr[q >> 1] & 0xffff0000u) : (gr[q >> 1] << 16));
              const float bq = __uint_as_float((q & 1) ? (gbv[q >> 1] & 0xffff0000u) : (gbv[q >> 1] << 16)), kq = __uint_as_float((q & 1) ? (gk[q >> 1] & 0xffff0000u) : (gk[q >> 1] << 16));
              const unsigned a16 = f2bf(-kkq * e1), r16 = f2bf(rq * e2), b16 = f2bf(bq * e3), k16 = f2bf(kq * e3);
              if (q & 1) { wa[q >> 1] |= a16 << 16; wr[q >> 1] |= r16 << 16; wb[q >> 1] |= b16 << 16; wk[q >> 1] |= k16 << 16; } else { wa[q >> 1] = a16; wr[q >> 1] = r16; wb[q >> 1] = b16; wk[q >> 1] = k16; }
              bh_[q] = (unsigned short)f2bf(bq * e4); kh_[q] = (unsigned short)f2bf(kq * e4);
              if (lane == 63) gamT[j0 + q] = e2; }
          LAS unsigned char* row = gb + t * GP + 2 * j0;
          *(LAS v4u*)(row + RC_AT) = wa; *(LAS v4u*)(row + RC_RT) = wr; *(LAS v4u*)(row + RC_BT) = wb; *(LAS v4u*)(row + RC_KT) = wk; *(LAS v4u*)(row + RC_V) = gv;
#pragma unroll
          for (int q = 0; q < 8; ++q) { LAS unsigned char* tr = gb + (j0 + q) * GP + 2 * t;
              *(LAS bf16*)(tr + RC_BH) = bh_[q]; *(LAS bf16*)(tr + RC_KH) = kh_[q];
              *(LAS bf16*)(tr + RC_VT) = (bf16)((q & 1) ? (gv[q >> 1] >> 16) : (gv[q >> 1] & 0xffffu)); } }
        __syncthreads();
        if (c + 1 < SEQ / 64) RC_LOAD(c + 1);
        if (!(SK & 2)) { const int rb = wave >> 1, r32 = lane & 31, hi = lane >> 5;
          const LAS unsigned char* xr = gb + (rb < 2 ? RC_AT : RC_RT) + (32 * (rb & 1) + r32) * GP + 16 * hi; const int tt = 32 * (rb & 1) + r32;
#pragma unroll
          for (int k2 = 0; k2 < 2; ++k2) { const int cb = 2 * (wave & 1) + k2;
              const LAS unsigned char* yr = gb + (cb < 2 ? RC_BT : RC_KT) + (32 * (cb & 1) + r32) * GP + 16 * hi;
              f32x16 acc = {};
#pragma unroll
              for (int s = 0; s < 4; ++s) acc = __builtin_amdgcn_mfma_f32_32x32x16_bf16(*(const LAS bf16x8*)(yr + 32 * s), *(const LAS bf16x8*)(xr + 32 * s), acc, 0, 0, 0);
              if (rb < 2 && cb < 2) {
#pragma unroll
                  for (int g = 0; g < 4; ++g) { const int s0 = 32 * (cb & 1) + 8 * g + 4 * hi; f32x4 o;
#pragma unroll
                      for (int r = 0; r < 4; ++r) o[r] = (tt > s0 + r) ? -acc[4 * g + r] : 0.f;
                      *(LAS f32x4*)((LAS float*)(gb + RC_A) + tt * 68 + s0) = o; } }
              else { const int incl = rb >= 2 ? 1 : 0; LAS unsigned char* dst = gb + (rb < 2 ? RC_AK : (cb < 2 ? RC_RB : RC_RK)) + tt * GP;
#pragma unroll
                  for (int g = 0; g < 4; ++g) { const int s0 = 32 * (cb & 1) + 8 * g + 4 * hi; f32x4 o;
#pragma unroll
                      for (int r = 0; r < 4; ++r) o[r] = (tt + incl > s0 + r) ? acc[4 * g + r] : 0.f;
                      *(LAS u64_t*)(dst + 2 * s0) = (u64_t)pg8::cvt_pk_bf16(o[0], o[1]) | ((u64_t)pg8::cvt_pk_bf16(o[2], o[3]) << 32); } } } }
        __syncthreads();
        if (!(SK & 4)) { const int col = lane & 15, q4 = lane >> 4, it = wave >> 1;
#pragma unroll
          for (int k2 = 0; k2 < 2; ++k2) { const int ct = 2 * (wave & 1) + k2; f32x4 acc = {0.f, 0.f, 0.f, 0.f};
              const LAS unsigned char* pa = gb + RC_AK + (16 * it + col) * GP + 8 * q4; const LAS unsigned char* pb = gb + RC_VT + (16 * ct + col) * GP + 8 * q4;
              acc = __builtin_amdgcn_mfma_f32_16x16x32_bf16(ld2x8(pa), ld2x8(pb), acc, 0, 0, 0);
              acc = __builtin_amdgcn_mfma_f32_16x16x32_bf16(ld2x8(pa + 64), ld2x8(pb + 64), acc, 0, 0, 0);
#pragma unroll
              for (int r = 0; r < 4; ++r) ((LAS float*)(gb + RC_R2))[(16 * it + 4 * q4 + r) * 68 + 16 * ct + col] = acc[r]; } }
        if (!(SK & 4) && wave == 0) {
            const int bb = lane >> 4, cc = lane & 15; float T[16];
            const LAS float* Ab = (const LAS float*)(gb + RC_A) + (16 * bb) * 68 + 16 * bb;
#pragma unroll
            for (int i = 0; i < 16; ++i) { float a0 = 0.f, a1 = 0.f;
#pragma unroll
                for (int j4 = 0; j4 < (i + 3) / 4; ++j4) { const f32x4 av = *(const LAS f32x4*)(Ab + i * 68 + 4 * j4);
                    a0 += av.x * T[4 * j4] + av.z * T[4 * j4 + 2]; a1 += av.y * T[4 * j4 + 1] + av.w * T[4 * j4 + 3]; }
                T[i] = (i == cc ? 1.f : 0.f) - (a0 + a1);
                if (i < 15 && (i & 3) == 3) asm volatile("" ::: "memory");
                if (i == 0) {
#pragma unroll
                    for (int k = 1; k < 16; ++k) T[k] = 0.f; } }
#pragma unroll
            for (int i = 0; i < 16; ++i) ((LAS float*)(gb + RC_T))[(16 * bb + i) * 16 + cc] = T[i];
        }
        __syncthreads();
        f32x4 Xc[4];
#pragma unroll
        for (int g = 0; g < 4; ++g) Xc[g] = (f32x4){0.f, 0.f, 0.f, 0.f};
        if (!(SK & 8)) { const int col = lane & 15, q4 = lane >> 4, cidx = 16 * wave + col;
          u64_t xh[4], xl[4]; f32x4 Yin[4];
          if (wave < 4) {
#pragma unroll
              for (int bk = 0; bk < 4; ++bk)
#pragma unroll
                  for (int r = 0; r < 4; ++r) Yin[bk][r] = bf2f(*(const LAS bf16*)(gb + RC_AT + (16 * bk + 4 * q4 + r) * GP + 2 * cidx));
          } else {
#pragma unroll
              for (int bk = 0; bk < 4; ++bk)
#pragma unroll
                  for (int r = 0; r < 4; ++r) Yin[bk][r] = ((const LAS float*)(gb + RC_R2))[(16 * bk + 4 * q4 + r) * 68 + (cidx - 64)];
          }
#pragma unroll
          for (int bk = 0; bk < 4; ++bk) {
              f32x4 Y = Yin[bk];
#pragma unroll
              for (int b2 = 0; b2 < bk; b2 += 2) {
                  const LAS float* ar = (const LAS float*)(gb + RC_A) + (16 * bk + col) * 68 + 16 * b2 + 4 * q4;
                  f32x4 a0 = -*(const LAS f32x4*)ar, a1 = (b2 + 1 < bk) ? -*(const LAS f32x4*)(ar + 16) : (f32x4){0.f, 0.f, 0.f, 0.f};
                  u64_t ah0, al0, ah1, al1; hilo4(a0, ah0, al0); hilo4(a1, ah1, al1);
                  const u64_t bh1 = (b2 + 1 < bk) ? xh[b2 + 1] : 0ull, bl1 = (b2 + 1 < bk) ? xl[b2 + 1] : 0ull;
                  const bf16x8 Ah = mk_bf16x8(ah0, ah1), Al = mk_bf16x8(al0, al1), Bh = mk_bf16x8(xh[b2], bh1), Bl = mk_bf16x8(xl[b2], bl1);
                  Y = __builtin_amdgcn_mfma_f32_16x16x32_bf16(Al, Bh, Y, 0, 0, 0);
                  Y = __builtin_amdgcn_mfma_f32_16x16x32_bf16(Ah, Bl, Y, 0, 0, 0);
                  Y = __builtin_amdgcn_mfma_f32_16x16x32_bf16(Ah, Bh, Y, 0, 0, 0); }
              { const f32x4 t0 = *(const LAS f32x4*)((const LAS float*)(gb + RC_T) + (16 * bk + col) * 16 + 4 * q4);
                u64_t th, tl, yh, yl; hilo4(t0, th, tl); hilo4(Y, yh, yl);
                const bf16x8 Ah = mk_bf16x8(th, 0ull), Al = mk_bf16x8(tl, 0ull), Bh = mk_bf16x8(yh, 0ull), Bl = mk_bf16x8(yl, 0ull);
                f32x4 X = {0.f, 0.f, 0.f, 0.f};
                X = __builtin_amdgcn_mfma_f32_16x16x32_bf16(Al, Bh, X, 0, 0, 0);
                X = __builtin_amdgcn_mfma_f32_16x16x32_bf16(Ah, Bl, X, 0, 0, 0);
                X = __builtin_amdgcn_mfma_f32_16x16x32_bf16(Ah, Bh, X, 0, 0, 0);
                Xc[bk] = X; hilo4(X, xh[bk], xl[bk]); }
          } }
        __syncthreads();
        { const int col = lane & 15, q4 = lane >> 4, cidx = 16 * wave + col;
          if (wave < 4) {
#pragma unroll
              for (int g = 0; g < 4; ++g)
#pragma unroll
                  for (int r = 0; r < 4; ++r) { const int i = 16 * g + 4 * q4 + r; const float x = Xc[g][r]; const unsigned hb = f2bf(x);
                      *(LAS bf16*)(gb + RC_AT + i * GP + 2 * cidx) = (bf16)hb; *(LAS bf16*)(gb + RC_AK + i * GP + 2 * cidx) = (bf16)f2bf(x - __uint_as_float(hb << 16)); }
          } else {
#pragma unroll
              for (int g = 0; g < 4; ++g)
#pragma unroll
                  for (int r = 0; r < 4; ++r) ((LAS float*)(gb + RC_A))[(16 * g + 4 * q4 + r) * 68 + (cidx - 64)] = Xc[g][r];
          } }
        __syncthreads();
        if (!(SK & 16) && wave < 4) { const int col = lane & 15, q4 = lane >> 4, e = 16 * wave + col;
          bf16x8 bZ0, bZ1, bZ0l, bZ1l; split_acc(Zacc[0], Zacc[1], bZ0, bZ0l); split_acc(Zacc[2], Zacc[3], bZ1, bZ1l);
          f32x4 U[4], Yo[4], Vc[4];
          const LAS unsigned char* rowa = gb + col * GP + 8 * q4;
#pragma unroll
          for (int it = 0; it < 4; ++it) {
              const LAS float* u0p = (const LAS float*)(gb + RC_A) + (16 * it + 4 * q4) * 68 + e;
              U[it] = (f32x4){u0p[0], u0p[68], u0p[136], u0p[204]};
#pragma unroll
              for (int r = 0; r < 4; ++r) Vc[it][r] = bf2f(*(const LAS bf16*)(gb + RC_V + (16 * it + 4 * q4 + r) * GP + 2 * e));
              const LAS unsigned char* ra = rowa + 16 * it * GP;
              const bf16x8 wh0 = ld2x8(ra + RC_AT), wh1 = ld2x8(ra + RC_AT + 64), wl0 = ld2x8(ra + RC_AK), wl1 = ld2x8(ra + RC_AK + 64), qa0 = ld2x8(ra + RC_RT), qa1 = ld2x8(ra + RC_RT + 64);
              U[it] = __builtin_amdgcn_mfma_f32_16x16x32_bf16(wl0, bZ0, U[it], 0, 0, 0);
              U[it] = __builtin_amdgcn_mfma_f32_16x16x32_bf16(wl1, bZ1, U[it], 0, 0, 0);
              U[it] = __builtin_amdgcn_mfma_f32_16x16x32_bf16(wh0, bZ0l, U[it], 0, 0, 0);
              U[it] = __builtin_amdgcn_mfma_f32_16x16x32_bf16(wh1, bZ1l, U[it], 0, 0, 0);
              U[it] = __builtin_amdgcn_mfma_f32_16x16x32_bf16(wh0, bZ0, U[it], 0, 0, 0);
              U[it] = __builtin_amdgcn_mfma_f32_16x16x32_bf16(wh1, bZ1, U[it], 0, 0, 0);
              Yo[it] = __builtin_amdgcn_mfma_f32_16x16x32_bf16(qa0, bZ0l, (f32x4){0.f, 0.f, 0.f, 0.f}, 0, 0, 0);
              Yo[it] = __builtin_amdgcn_mfma_f32_16x16x32_bf16(qa1, bZ1l, Yo[it], 0, 0, 0);
              Yo[it] = __builtin_amdgcn_mfma_f32_16x16x32_bf16(qa0, bZ0, Yo[it], 0, 0, 0);
              Yo[it] = __builtin_amdgcn_mfma_f32_16x16x32_bf16(qa1, bZ1, Yo[it], 0, 0, 0);
              asm volatile("" ::: "memory");
          }
          bf16x8 bU0, bU1, bU0l, bU1l; split_acc(U[0], U[1], bU0, bU0l); split_acc(U[2], U[3], bU1, bU1l);
          const bf16x8 bV0 = pack_acc(Vc[0], Vc[1]), bV1 = pack_acc(Vc[2], Vc[3]);
#pragma unroll
          for (int it = 0; it < 4; ++it) {
              const LAS unsigned char* ra = rowa + 16 * it * GP;
              const bf16x8 pb0 = ld2x8(ra + RC_RB), pb1 = ld2x8(ra + RC_RB + 64), pk0 = ld2x8(ra + RC_RK), pk1 = ld2x8(ra + RC_RK + 64);
              const bf16x8 hb0 = ld2x8(ra + RC_BH), hb1 = ld2x8(ra + RC_BH + 64), hk0 = ld2x8(ra + RC_KH), hk1 = ld2x8(ra + RC_KH + 64);
              f32x4 O = Yo[it];
              O = __builtin_amdgcn_mfma_f32_16x16x32_bf16(pb0, bU0l, O, 0, 0, 0);
              O = __builtin_amdgcn_mfma_f32_16x16x32_bf16(pb1, bU1l, O, 0, 0, 0);
              O = __builtin_amdgcn_mfma_f32_16x16x32_bf16(pk0, bV0, O, 0, 0, 0);
              O = __builtin_amdgcn_mfma_f32_16x16x32_bf16(pk1, bV1, O, 0, 0, 0);
              O = __builtin_amdgcn_mfma_f32_16x16x32_bf16(pb0, bU0, O, 0, 0, 0);
              O = __builtin_amdgcn_mfma_f32_16x16x32_bf16(pb1, bU1, O, 0, 0, 0);
              const f32x4 gz = *(const LAS f32x4*)(gamT + 16 * it + 4 * q4);
              f32x4 Zn = Zacc[it] * gz;
              Zn = __builtin_amdgcn_mfma_f32_16x16x32_bf16(hb0, bU0l, Zn, 0, 0, 0);
              Zn = __builtin_amdgcn_mfma_f32_16x16x32_bf16(hb1, bU1l, Zn, 0, 0, 0);
              Zn = __builtin_amdgcn_mfma_f32_16x16x32_bf16(hk0, bV0, Zn, 0, 0, 0);
              Zn = __builtin_amdgcn_mfma_f32_16x16x32_bf16(hk1, bV1, Zn, 0, 0, 0);
              Zn = __builtin_amdgcn_mfma_f32_16x16x32_bf16(hb0, bU0, Zn, 0, 0, 0);
              Zn = __builtin_amdgcn_mfma_f32_16x16x32_bf16(hb1, bU1, Zn, 0, 0, 0);
              Zacc[it] = Zn;
#pragma unroll
              for (int r = 0; r < 4; ++r) ((LAS float*)(gb + RC_A))[(16 * it + 4 * q4 + r) * 68 + e] = O[r];
              asm volatile("" ::: "memory");
          } }
        __syncthreads();
    }
    RC_WRITEOUT(SEQ / 64 - 1);
#undef RC_WRITEOUT
#undef RC_LOAD
    __syncthreads();
}
__device__ __forceinline__ int next_unit(Frame& F, gu32* head) {
    __syncthreads();
    if (F.tid == 0) F.MISC[16] = __hip_atomic_fetch_add(head, 1u, RLX_AGENT);
    __syncthreads();
    return (int)F.MISC[16];
}
constexpr int U_GDN = 96, U_RWKV = 64, U_ATT = 384, U_ALL = U_GDN + U_RWKV + U_ATT;
template <int DUMMY> __device__ __forceinline__ void p3_mixers(Frame& F, int l, int rep) {
    gu32* head = F.ctl + CW_QUEUE + 64 * (2 * l + rep);
    for (;;) {
        const int u = next_unit(F, head);
        if (u >= U_ALL) break;
        asm volatile("" : "+v"(F.tid), "+v"(F.lane));
        if (u < U_GDN) {
#ifdef EXP_GDN
            gdn_unit3<EXP_GDN>(F, l, u, F.ctl + CW_FLAG + 64 * 256 * (4 + 2 * l + rep) + 64 * 128); asm volatile("" : "+v"(F.tid), "+v"(F.lane));
#endif
            gdn_unit3<DUMMY ? 128 : 0>(F, l, u, F.ctl + CW_FLAG + 64 * 256 * (2 * l + rep) + 64 * 128); }
        else if (u < U_GDN + U_RWKV) {
#ifdef EXP_RWKV
            rwkv_unit_c<EXP_RWKV>(F, u - U_GDN, F.ctl + CW_FLAG + 64 * 256 * (4 + 2 * l + rep)); asm volatile("" : "+v"(F.tid), "+v"(F.lane));
#endif
            rwkv_unit_c<DUMMY ? 64 : 0>(F, u - U_GDN, F.ctl + CW_FLAG + 64 * 256 * (2 * l + rep)); }
        else {
#ifdef EXP_ATT
            attn_unit(F, u - U_GDN - U_RWKV); asm volatile("" : "+v"(F.tid), "+v"(F.lane));
#endif
            attn_unit(F, u - U_GDN - U_RWKV); }
    }
}
__device__ __forceinline__ f32x4 bf4(u64_t x) { return (f32x4){__uint_as_float(((unsigned)x) << 16), __uint_as_float(((unsigned)x) & 0xffff0000u), __uint_as_float(((unsigned)(x >> 32)) << 16), __uint_as_float(((unsigned)(x >> 32)) & 0xffff0000u)}; }
__device__ __forceinline__ u64_t pk4(const f32x4& v) { return (u64_t)pg8::cvt_pk_bf16(v[0], v[1]) | ((u64_t)pg8::cvt_pk_bf16(v[2], v[3]) << 32); }
__device__ __forceinline__ void p2_mla_unit(Frame& F, int l, int unit) {
    const int lane = F.lane, col = lane & 15, q4 = lane >> 4, m = 16 * unit + col, b = m / SEQ, t = m % SEQ, t0 = (16 * unit) % SEQ;
    const bf16* prow = (const bf16*)(F.ws + WS_PMLA) + (size_t)m * 352;
    const bf16* WuqT = (const bf16*)(F.ws + WS_WSMALL + OFF_WUQ) + (size_t)l * 576 * 192 + (size_t)col * 192 + 8 * q4;
    const bf16* WukvT = (const bf16*)(F.ws + WS_WSMALL + OFF_WUKV) + (size_t)l * 768 * 128 + (size_t)col * 128 + 8 * q4;
    bf16x8 aq[6], akv[4]; float sq = 0.f, skv = 0.f;
#pragma unroll
    for (int s = 0; s < 6; ++s) { aq[s] = *(const bf16x8*)(prow + 32 * s + 8 * q4); const v4u u = __builtin_bit_cast(v4u, aq[s]);
#pragma unroll
        for (int i = 0; i < 4; ++i) { const float a = __uint_as_float(u[i] << 16), c = __uint_as_float(u[i] & 0xffff0000u); sq += a * a + c * c; } }
#pragma unroll
    for (int s = 0; s < 4; ++s) { akv[s] = *(const bf16x8*)(prow + 192 + 32 * s + 8 * q4); const v4u u = __builtin_bit_cast(v4u, akv[s]);
#pragma unroll
        for (int i = 0; i < 4; ++i) { const float a = __uint_as_float(u[i] << 16), c = __uint_as_float(u[i] & 0xffff0000u); skv += a * a + c * c; } }
    sq += __shfl_xor(sq, 16); sq += __shfl_xor(sq, 32); skv += __shfl_xor(skv, 16); skv += __shfl_xor(skv, 32);
    const float rq = rsqrtf(sq * (1.f / 192.f) + NORM_EPS) * (0.10206207261596575f * LOG2E), rkv = rsqrtf(skv * (1.f / 128.f) + NORM_EPS);
    const float pos = (float)((const int*)inptr(F, 1))[m];
    f32x4 cs, sn;
#pragma unroll
    for (int r = 0; r < 4; ++r) { const float inv = exp2f(-(float)(4 * q4 + r) * (13.287712379549449f / 16.f)); float s_, c_; sincosf(pos * inv, &s_, &c_); cs[r] = c_; sn[r] = s_; }
    bf16* Qo = (bf16*)(F.ws + WS_Q) + ((size_t)b * 6 * SEQ + t) * 96 + 4 * q4;
    bf16* Ko = (bf16*)(F.ws + WS_K) + ((size_t)b * 6 * SEQ + t) * 96 + 4 * q4;
    bf16* Vo = (bf16*)(F.ws + WS_VT) + (size_t)b * 6 * 64 * SEQ + (size_t)col * SEQ + t0 + 4 * q4;
    { const u64_t x1 = *(const u64_t*)(prow + 320 + 4 * q4), x2 = *(const u64_t*)(prow + 336 + 4 * q4); const f32x4 a = bf4(x1), c = bf4(x2);
      const u64_t o1 = pk4(a * cs - c * sn), o2 = pk4(c * cs + a * sn);
#pragma unroll
      for (int h = 0; h < 6; ++h) { *(u64_t*)(Ko + (size_t)h * SEQ * 96 + 64) = o1; *(u64_t*)(Ko + (size_t)h * SEQ * 96 + 80) = o2; } }
#pragma unroll 2
    for (int h = 0; h < 6; ++h) {
        f32x4 x1v = {0.f, 0.f, 0.f, 0.f};
#pragma unroll
        for (int nt = 0; nt < 6; ++nt) {
            const bf16* w = WuqT + (size_t)(h * 96 + 16 * nt) * 192; f32x4 acc = {0.f, 0.f, 0.f, 0.f};
#pragma unroll
            for (int s = 0; s < 6; ++s) acc = __builtin_amdgcn_mfma_f32_16x16x32_bf16(*(const bf16x8*)(w + 32 * s), aq[s], acc, 0, 0, 0);
            acc = acc * rq;
            if (nt < 4) *(u64_t*)(Qo + (size_t)h * SEQ * 96 + 16 * nt) = pk4(acc);
            else if (nt == 4) x1v = acc;
            else { *(u64_t*)(Qo + (size_t)h * SEQ * 96 + 64) = pk4(x1v * cs - acc * sn); *(u64_t*)(Qo + (size_t)h * SEQ * 96 + 80) = pk4(acc * cs + x1v * sn); }
        }
#pragma unroll
        for (int nt = 0; nt < 4; ++nt) {
            const bf16* w = WukvT + (size_t)(h * 128 + 16 * nt) * 128; f32x4 acc = {0.f, 0.f, 0.f, 0.f};
#pragma unroll
            for (int s = 0; s < 4; ++s) acc = __builtin_amdgcn_mfma_f32_16x16x32_bf16(*(const bf16x8*)(w + 32 * s), akv[s], acc, 0, 0, 0);
            *(u64_t*)(Ko + (size_t)h * SEQ * 96 + 16 * nt) = pk4(acc * rkv);
        }
        f32x4 rk4;
#pragma unroll
        for (int r = 0; r < 4; ++r) rk4[r] = __shfl(rkv, 4 * q4 + r);
#pragma unroll
        for (int nt = 0; nt < 4; ++nt) {
            const bf16* w = WukvT + (size_t)(h * 128 + 64 + 16 * nt) * 128; f32x4 acc = {0.f, 0.f, 0.f, 0.f};
#pragma unroll
            for (int s = 0; s < 4; ++s) acc = __builtin_amdgcn_mfma_f32_16x16x32_bf16(akv[s], *(const bf16x8*)(w + 32 * s), acc, 0, 0, 0);
            *(u64_t*)(Vo + (size_t)(h * 64 + 16 * nt) * SEQ) = pk4(acc * rk4);
        }
    }
}
__device__ __forceinline__ f32x4 rw_shift4(const bf16* P, size_t m, int c, bool hp, bool hn, const float* mu) {
    const f32x4 x = bf4(*(const u64_t*)(P + m * 896 + c)), xp = hp ? bf4(*(const u64_t*)(P + (m - 1) * 896 + c)) : (f32x4){0.f, 0.f, 0.f, 0.f}, xn = hn ? bf4(*(const u64_t*)(P + (m + 1) * 896 + c)) : (f32x4){0.f, 0.f, 0.f, 0.f};
    const f32x4 m0 = *(const f32x4*)(mu + c), m1 = *(const f32x4*)(mu + 896 + c);
    return x + m0 * (xp - x) + m1 * (xn - x);
}
__device__ __forceinline__ void p2_rwkv_unit(Frame& F, int l, int unit, int h0, int h1) {
    const int lane = F.lane, col = lane & 15, q4 = lane >> 4, b = (16 * unit) / SEQ, t = (16 * unit) % SEQ + col; const size_t m = (size_t)16 * unit + col;
    const bool hp = t > 0, hn = t < SEQ - 1;
    const bf16* Prw = (const bf16*)(F.ws + WS_PRW);
    const float* mu = (const float*)inptr(F, 12) + l * 2 * 896;
    const bf16* W2T = (const bf16*)(F.ws + WS_WSMALL + OFF_W2T) + (size_t)l * 2 * 256 * 64 + (size_t)col * 64 + 8 * q4;
    const bf16* A2T = (const bf16*)(F.ws + WS_WSMALL + OFF_A2T) + (size_t)l * 2 * 256 * 64 + (size_t)col * 64 + 8 * q4;
    bf16x8 awd[2], aad[2];
#pragma unroll
    for (int s = 0; s < 2; ++s) { const int c = 768 + 32 * s + 8 * q4;
        f32x4 lo = rw_shift4(Prw, m, c, hp, hn, mu), hi = rw_shift4(Prw, m, c + 4, hp, hn, mu);
#pragma unroll
        for (int i = 0; i < 4; ++i) { lo[i] = 1.f - 2.f * __builtin_amdgcn_rcpf(1.f + __expf(2.f * lo[i])); hi[i] = 1.f - 2.f * __builtin_amdgcn_rcpf(1.f + __expf(2.f * hi[i])); }
        awd[s] = pack_acc(lo, hi);
        aad[s] = pack_acc(rw_shift4(Prw, m, c + 64, hp, hn, mu), rw_shift4(Prw, m, c + 68, hp, hn, mu)); }
#pragma unroll 1
    for (int h = h0; h < h1; ++h) {
        f32x4 k[4]; float kn = 0.f;
        { const float* k_k = (const float*)inptr(F, 17) + l * 256;
#pragma unroll
          for (int nt = 0; nt < 4; ++nt) { const int c = 64 * h + 16 * nt + 4 * q4; k[nt] = rw_shift4(Prw, m, 256 + c, hp, hn, mu);
              const f32x4 x = k[nt] * *(const f32x4*)(k_k + c); kn += (x[0] * x[0] + x[1] * x[1]) + (x[2] * x[2] + x[3] * x[3]); } }
        kn += __shfl_xor(kn, 16); kn += __shfl_xor(kn, 32);
        const float rkn = rsqrtf(kn + 1e-6f);
        float cbv = 0.f;
        const size_t ro = rw_rec_off(b * 4 + h, t, 0, q4 >> 1) + 8 * (q4 & 1);
        unsigned char* rs = F.ws + WS_RS + ro;
        unsigned char* rd0 = F.ws + WS_RD + ro;
#pragma unroll
        for (int nt = 0; nt < 4; ++nt) { const int c = 64 * h + 16 * nt + 4 * q4;
            const f32x4 r = rw_shift4(Prw, m, c, hp, hn, mu), v = rw_shift4(Prw, m, 512 + c, hp, hn, mu);
            const f32x4 kk = k[nt] * *(const f32x4*)((const float*)inptr(F, 17) + l * 256 + c) * rkn;
            *(u64_t*)(rs + 2048 * nt) = pk4(kk); *(u64_t*)(rs + 8192 + 2048 * nt) = pk4(v); *(u64_t*)(rs + 16384 + 2048 * nt) = pk4(r);
            f32x4 ksum = {0.f, 0.f, 0.f, 0.f};
#pragma unroll
            for (int e = 0; e < 2; ++e) { const bf16* w = W2T + (size_t)(e * 256 + 64 * h + 16 * nt) * 64; const bf16* a = A2T + (size_t)(e * 256 + 64 * h + 16 * nt) * 64;
                f32x4 x = {0.f, 0.f, 0.f, 0.f}, y = {0.f, 0.f, 0.f, 0.f};
#pragma unroll
                for (int s = 0; s < 2; ++s) { x = __builtin_amdgcn_mfma_f32_16x16x32_bf16(*(const bf16x8*)(w + 32 * s), awd[s], x, 0, 0, 0); y = __builtin_amdgcn_mfma_f32_16x16x32_bf16(*(const bf16x8*)(a + 32 * s), aad[s], y, 0, 0, 0); }
                const f32x4 w0v = *(const f32x4*)((const float*)inptr(F, 13) + l * 512 + e * 256 + c), a0v = *(const f32x4*)((const float*)inptr(F, 15) + l * 512 + e * 256 + c), kav = *(const f32x4*)((const float*)inptr(F, 18) + l * 256 + c);
                f32x4 lam, av;
#pragma unroll
                for (int i = 0; i < 4; ++i) { lam[i] = 0.6065306597126334f * sigmoidf_(w0v[i] + x[i]); av[i] = sigmoidf_(a0v[i] + y[i]); }
                const f32x4 km = k[nt] * (1.f + (av - 1.f) * kav), bb = av * kk;
                ksum += km;
                typedef _Float16 h4 __attribute__((ext_vector_type(4)));
                const h4 lh = {(_Float16)lam[0], (_Float16)lam[1], (_Float16)lam[2], (_Float16)lam[3]};
                unsigned char* rd = rd0 + e * RD_DIR;
                *(u64_t*)(rd + 2048 * nt) = __builtin_bit_cast(u64_t, lh); *(u64_t*)(rd + 8192 + 2048 * nt) = pk4(bb); *(u64_t*)(rd + 16384 + 2048 * nt) = pk4(km); }
            const f32x4 rkv = *(const f32x4*)((const float*)inptr(F, 19) + l * 256 + c), xx = r * ksum * rkv; cbv += (xx[0] + xx[1]) + (xx[2] + xx[3]);
        }
        cbv += __shfl_xor(cbv, 16); cbv += __shfl_xor(cbv, 32);
        if (q4 == 0) ((float*)(F.ws + WS_CB))[m * 4 + h] = 0.5f * cbv;
    }
}
constexpr int ML_QP = 400, ML_KP = 272, ML_KW = 96 * ML_QP, ML_SLAB = ML_KW + 128 * ML_KP;
static_assert(ML_SLAB <= RING_BYTES, "MLA slab");
__device__ __forceinline__ void p2_mla_wg(Frame& F, int l, int tb) {
    const int tid = F.tid, lane = F.lane, wave = F.wave, col = lane & 15, q4 = lane >> 4, tt = wave & 3, half = wave >> 2;
    const int m = 64 * tb + 16 * tt + col, b = m / SEQ, t = m % SEQ, t0 = (64 * tb + 16 * tt) % SEQ;
    const bf16* prow = (const bf16*)(F.ws + WS_PMLA) + (size_t)m * 352;
    const bf16* WuqT = (const bf16*)(F.ws + WS_WSMALL + OFF_WUQ) + (size_t)l * 576 * 192;
    const bf16* WukvT = (const bf16*)(F.ws + WS_WSMALL + OFF_WUKV) + (size_t)l * 768 * 128;
    LAS unsigned char* sl = F.lds + RING_OFF;
    v4u wreg[5];
#define ML_LOADQ(h_) do { _Pragma("unroll") for (int k_ = 0; k_ < 5; ++k_) { const int p_ = tid + 512 * k_; \
        if (p_ < 96 * 24) wreg[k_] = *(const v4u*)(WuqT + (size_t)((h_) * 96 + p_ / 24) * 192 + 8 * (p_ % 24)); } } while (0)
#define ML_STOREQ() do { _Pragma("unroll") for (int k_ = 0; k_ < 5; ++k_) { const int p_ = tid + 512 * k_; \
        if (p_ < 96 * 24) *(LAS v4u*)(sl + (p_ / 24) * ML_QP + 16 * (p_ % 24)) = wreg[k_]; } } while (0)
#define ML_LOADK(h_) do { _Pragma("unroll") for (int k_ = 0; k_ < 4; ++k_) { const int p_ = tid + 512 * k_; \
        wreg[k_] = *(const v4u*)(WukvT + (size_t)((h_) * 128 + (p_ >> 4)) * 128 + 8 * (p_ & 15)); } } while (0)
#define ML_STOREK() do { _Pragma("unroll") for (int k_ = 0; k_ < 4; ++k_) { const int p_ = tid + 512 * k_; \
        *(LAS v4u*)(sl + ML_KW + (p_ >> 4) * ML_KP + 16 * (p_ & 15)) = wreg[k_]; } } while (0)
    ML_LOADQ(0);
    bf16x8 aq[6], akv[4]; float sq = 0.f, skv = 0.f;
#pragma unroll
    for (int s = 0; s < 6; ++s) { aq[s] = *(const bf16x8*)(prow + 32 * s + 8 * q4); const v4u u = __builtin_bit_cast(v4u, aq[s]);
#pragma unroll
        for (int i = 0; i < 4; ++i) { const float a = __uint_as_float(u[i] << 16), c = __uint_as_float(u[i] & 0xffff0000u); sq += a * a + c * c; } }
#pragma unroll
    for (int s = 0; s < 4; ++s) { akv[s] = *(const bf16x8*)(prow + 192 + 32 * s + 8 * q4); const v4u u = __builtin_bit_cast(v4u, akv[s]);
#pragma unroll
        for (int i = 0; i < 4; ++i) { const float a = __uint_as_float(u[i] << 16), c = __uint_as_float(u[i] & 0xffff0000u); skv += a * a + c * c; } }
    sq += __shfl_xor(sq, 16); sq += __shfl_xor(sq, 32); skv += __shfl_xor(skv, 16); skv += __shfl_xor(skv, 32);
    const float rq = rsqrtf(sq * (1.f / 192.f) + NORM_EPS) * (0.10206207261596575f * LOG2E), rkv = rsqrtf(skv * (1.f / 128.f) + NORM_EPS);
    const float pos = (float)((const int*)inptr(F, 1))[m];
    f32x4 cs, sn;
#pragma unroll
    for (int r = 0; r < 4; ++r) { const float inv = exp2f(-(float)(4 * q4 + r) * (13.287712379549449f / 16.f)); float s_, c_; sincosf(pos * inv, &s_, &c_); cs[r] = c_; sn[r] = s_; }
    bf16* Qo = (bf16*)(F.ws + WS_Q) + ((size_t)b * 6 * SEQ + t) * 96 + 4 * q4;
    bf16* Ko = (bf16*)(F.ws + WS_K) + ((size_t)b * 6 * SEQ + t) * 96 + 4 * q4;
    bf16* Vo = (bf16*)(F.ws + WS_VT) + (size_t)b * 6 * 64 * SEQ + (size_t)col * SEQ + t0 + 4 * q4;
    if (half == 0) { const u64_t x1 = *(const u64_t*)(prow + 320 + 4 * q4), x2 = *(const u64_t*)(prow + 336 + 4 * q4); const f32x4 a = bf4(x1), c = bf4(x2);
      const u64_t o1 = pk4(a * cs - c * sn), o2 = pk4(c * cs + a * sn);
#pragma unroll
      for (int h = 0; h < 6; ++h) { *(u64_t*)(Ko + (size_t)h * SEQ * 96 + 64) = o1; *(u64_t*)(Ko + (size_t)h * SEQ * 96 + 80) = o2; } }
    f32x4 rk4;
#pragma unroll
    for (int r = 0; r < 4; ++r) rk4[r] = __shfl(rkv, 4 * q4 + r);
    const LAS unsigned char* wq = sl + col * ML_QP + 16 * q4; const LAS unsigned char* wk = sl + ML_KW + col * ML_KP + 16 * q4;
    ML_STOREQ();
    __syncthreads();
#pragma unroll 1
    for (int h = 0; h < 6; ++h) {
        ML_LOADK(h);
        { f32x4 x1v = {0.f, 0.f, 0.f, 0.f};
#pragma unroll
          for (int n3 = 0; n3 < 3; ++n3) { const int nt = 3 * half + n3; f32x4 acc = {0.f, 0.f, 0.f, 0.f};
#pragma unroll
              for (int s = 0; s < 6; ++s) acc = __builtin_amdgcn_mfma_f32_16x16x32_bf16(*(const LAS bf16x8*)(wq + 16 * nt * ML_QP + 64 * s), aq[s], acc, 0, 0, 0);
              acc = acc * rq;
              if (half == 0 || n3 == 0) *(u64_t*)(Qo + (size_t)h * SEQ * 96 + 16 * nt) = pk4(acc);
              else if (n3 == 1) x1v = acc;
              else { *(u64_t*)(Qo + (size_t)h * SEQ * 96 + 64) = pk4(x1v * cs - acc * sn); *(u64_t*)(Qo + (size_t)h * SEQ * 96 + 80) = pk4(acc * cs + x1v * sn); }
              asm volatile("" ::: "memory"); } }
        ML_STOREK();
        __syncthreads();
        if (h + 1 < 6) ML_LOADQ(h + 1);
        if (half == 0) {
#pragma unroll
            for (int nt = 0; nt < 4; ++nt) { f32x4 acc = {0.f, 0.f, 0.f, 0.f};
#pragma unroll
                for (int s = 0; s < 4; ++s) acc = __builtin_amdgcn_mfma_f32_16x16x32_bf16(*(const LAS bf16x8*)(wk + 16 * nt * ML_KP + 64 * s), akv[s], acc, 0, 0, 0);
                *(u64_t*)(Ko + (size_t)h * SEQ * 96 + 16 * nt) = pk4(acc * rkv); asm volatile("" ::: "memory"); }
        } else {
#pragma unroll
            for (int nt = 0; nt < 4; ++nt) { f32x4 acc = {0.f, 0.f, 0.f, 0.f};
#pragma unroll
                for (int s = 0; s < 4; ++s) acc = __builtin_amdgcn_mfma_f32_16x16x32_bf16(akv[s], *(const LAS bf16x8*)(wk + (64 + 16 * nt) * ML_KP + 64 * s), acc, 0, 0, 0);
                *(u64_t*)(Vo + (size_t)(h * 64 + 16 * nt) * SEQ) = pk4(acc * rk4); asm volatile("" ::: "memory"); }
        }
        if (h + 1 < 6) ML_STOREQ();
        __syncthreads();
    }
#undef ML_LOADQ
#undef ML_STOREQ
#undef ML_LOADK
#undef ML_STOREK
}
__device__ __forceinline__ void p2_prep3(Frame& F, int l) {
    for (int tb = F.vcu; tb < M / 64; tb += F.G) {
        p2_mla_wg(F, l, tb);
        p2_rwkv_unit(F, l, 4 * tb + (F.wave & 3), 2 * (F.wave >> 2), 2 * (F.wave >> 2) + 2);
    }
}
template <int MODE> __device__ __forceinline__ void p2_prep2(Frame& F, int l) {
    const int gw = F.vcu * NWAVES + F.wave, NGW = F.G * NWAVES;
    for (int u = gw; u < 2 * (M / 16); u += NGW) { if (u & 1) { if (MODE != 1) p2_rwkv_unit(F, l, u >> 1, 0, 4); } else { if (MODE != 2) p2_mla_unit(F, l, u >> 1); } }
}
__device__ __forceinline__ void ld16(const bf16* p, f32x4 (&o)[4]) { const v4u a = *(const v4u*)p, b = *(const v4u*)(p + 8);
    o[0] = (f32x4){__uint_as_float(a.x << 16), __uint_as_float(a.x & 0xffff0000u), __uint_as_float(a.y << 16), __uint_as_float(a.y & 0xffff0000u)};
    o[1] = (f32x4){__uint_as_float(a.z << 16), __uint_as_float(a.z & 0xffff0000u), __uint_as_float(a.w << 16), __uint_as_float(a.w & 0xffff0000u)};
    o[2] = (f32x4){__uint_as_float(b.x << 16), __uint_as_float(b.x & 0xffff0000u), __uint_as_float(b.y << 16), __uint_as_float(b.y & 0xffff0000u)};
    o[3] = (f32x4){__uint_as_float(b.z << 16), __uint_as_float(b.z & 0xffff0000u), __uint_as_float(b.w << 16), __uint_as_float(b.w & 0xffff0000u)}; }
__device__ __forceinline__ void p4a_mix2(Frame& F, int l) {
    const bf16* Ogdn = (const bf16*)(F.ws + WS_OGDN); const bf16* Omla = (const bf16*)(F.ws + WS_OMLA); const bf16* Y = (const bf16*)(F.ws + WS_Y);
    const bf16* Pgate = (const bf16*)(F.ws + WS_PGATE); const unsigned char* Rs = F.ws + WS_RS; const float* cb = (const float*)(F.ws + WS_CB); bf16* mix = (bf16*)(F.ws + WS_MIX);
    const int gw = F.vcu * NWAVES + F.wave, NGW = F.G * NWAVES, lane = F.lane, g = lane >> 2, c0 = 16 * lane;
    f32x4 pg[4], pb[4];
    if (g < 6) { const float* gg = (const float*)inptr(F, 7) + l * 64 + (c0 & 63);
#pragma unroll
        for (int i = 0; i < 4; ++i) { pg[i] = *(const f32x4*)(gg + 4 * i); pb[i] = (f32x4){0.f, 0.f, 0.f, 0.f}; } }
    else if (g < 12) {
#pragma unroll
        for (int i = 0; i < 4; ++i) { pg[i] = (f32x4){1.f, 1.f, 1.f, 1.f}; pb[i] = (f32x4){0.f, 0.f, 0.f, 0.f}; } }
    else { const float* lg = (const float*)inptr(F, 20) + l * 256 + (c0 - 768); const float* lb = (const float*)inptr(F, 21) + l * 256 + (c0 - 768);
#pragma unroll
        for (int i = 0; i < 4; ++i) { pg[i] = *(const f32x4*)(lg + 4 * i); pb[i] = *(const f32x4*)(lb + 4 * i); } }
#pragma unroll 2
    for (int m = gw; m < M; m += NGW) {
        f32x4 x[4], gt[4];
        ld16(Pgate + (size_t)m * 1024 + c0, gt);
        if (g < 6) { ld16(Ogdn + (size_t)m * 384 + c0, x);
            float ss = 0.f;
#pragma unroll
            for (int i = 0; i < 4; ++i) ss += (x[i][0] * x[i][0] + x[i][1] * x[i][1]) + (x[i][2] * x[i][2] + x[i][3] * x[i][3]);
            ss += dpp_xor1(ss); ss += dpp_xor2(ss);
            const float rs = rsqrtf(ss * (1.f / 64.f) + NORM_EPS);
#pragma unroll
            for (int i = 0; i < 4; ++i) x[i] = x[i] * rs * pg[i]; }
        else if (g < 12) ld16(Omla + (size_t)m * 384 + (c0 - 384), x);
        else { const int cc = c0 - 768, h = g - 12, b = m / SEQ, t = m % SEQ; f32x4 v[4];
            ld16(Y + (size_t)m * 256 + cc, x); { const unsigned char* vp = Rs + rw_rec_off(b * 4 + h, t, 1, (cc & 63) >> 3); const v4u a = *(const v4u*)vp, bq = *(const v4u*)(vp + 1024);
              v[0] = (f32x4){__uint_as_float(a.x << 16), __uint_as_float(a.x & 0xffff0000u), __uint_as_float(a.y << 16), __uint_as_float(a.y & 0xffff0000u)}; v[1] = (f32x4){__uint_as_float(a.z << 16), __uint_as_float(a.z & 0xffff0000u), __uint_as_float(a.w << 16), __uint_as_float(a.w & 0xffff0000u)};
              v[2] = (f32x4){__uint_as_float(bq.x << 16), __uint_as_float(bq.x & 0xffff0000u), __uint_as_float(bq.y << 16), __uint_as_float(bq.y & 0xffff0000u)}; v[3] = (f32x4){__uint_as_float(bq.z << 16), __uint_as_float(bq.z & 0xffff0000u), __uint_as_float(bq.w << 16), __uint_as_float(bq.w & 0xffff0000u)}; }
            const float cbv = cb[(size_t)m * 4 + h];
            float s1 = 0.f;
#pragma unroll
            for (int i = 0; i < 4; ++i) s1 += (x[i][0] + x[i][1]) + (x[i][2] + x[i][3]);
            s1 += dpp_xor1(s1); s1 += dpp_xor2(s1);
            const float mean = s1 * (1.f / 64.f); float s2 = 0.f;
#pragma unroll
            for (int i = 0; i < 4; ++i) { x[i] = x[i] - mean; s2 += (x[i][0] * x[i][0] + x[i][1] * x[i][1]) + (x[i][2] * x[i][2] + x[i][3] * x[i][3]); }
            s2 += dpp_xor1(s2); s2 += dpp_xor2(s2);
            const float rs = rsqrtf(s2 * (1.f / 64.f) + 64e-5f);
#pragma unroll
            for (int i = 0; i < 4; ++i) x[i] = x[i] * rs * pg[i] + pb[i] + cbv * v[i]; }
        v4u o0, o1;
#pragma unroll
        for (int i = 0; i < 4; ++i) {
#pragma unroll
            for (int j = 0; j < 4; ++j) x[i][j] = x[i][j] * siluf(gt[i][j]); }
        o0.x = pg8::cvt_pk_bf16(x[0][0], x[0][1]); o0.y = pg8::cvt_pk_bf16(x[0][2], x[0][3]); o0.z = pg8::cvt_pk_bf16(x[1][0], x[1][1]); o0.w = pg8::cvt_pk_bf16(x[1][2], x[1][3]);
        o1.x = pg8::cvt_pk_bf16(x[2][0], x[2][1]); o1.y = pg8::cvt_pk_bf16(x[2][2], x[2][3]); o1.z = pg8::cvt_pk_bf16(x[3][0], x[3][1]); o1.w = pg8::cvt_pk_bf16(x[3][2], x[3][3]);
        bf16* op = mix + (size_t)m * 1024 + c0; *(v4u*)op = o0; *(v4u*)(op + 8) = o1;
    }
}
constexpr int PT_OUT = 24, PT_WS = 25, PT_N = 26;
__device__ __forceinline__ void build_frame(Frame& F, LAS unsigned char* lds) {
    F.lds = lds; F.MISC = (volatile LAS unsigned*)(lds + MISC_OFF); F.ptab = (volatile LAS const unsigned long long*)(lds + MISC_OFF + 256);
    const int t = pg8::mk_tid(lds);
    F.tid = t; F.lane = t & 63; F.wave = __builtin_amdgcn_readfirstlane(t >> 6);
    F.G = gridDim.x; { const int bx = blockIdx.x; F.vcu = (F.G % 8 == 0) ? (bx % 8) * (F.G / 8) + bx / 8 : bx; }
    F.ws = (unsigned char*)inptr(F, PT_WS); F.out = (float*)inptr(F, PT_OUT); F.ctl = (gu32*)F.ws;
}
__device__ __forceinline__ bool ph_in(LAS unsigned char* lds, int k) { volatile LAS unsigned* mi = (volatile LAS unsigned*)(lds + MISC_OFF); const int lo = __builtin_amdgcn_readfirstlane((int)mi[20]), hi = __builtin_amdgcn_readfirstlane((int)mi[21]); return lo <= k && k < hi; }
__device__ __forceinline__ void seam(LAS unsigned char* lds, int k) {
    if (ph_in(lds, k) && ph_in(lds, k + 1)) { Frame F; build_frame(F, lds);
        XcdBarrier bar; bar.bar = (unsigned*)(F.ctl + CW_BAR); bar.x = xb_xcc_id(); bar.st = F.MISC + 8; xcd_barrier(bar);
#ifdef EXP_BAR
        xcd_barrier(bar); xcd_barrier(bar);
#endif
    }
}
template <int L> __device__ __forceinline__ void layer_phases(LAS unsigned char* lds) {
    constexpr int pb = 1 + 5 * L;
    if (ph_in(lds, pb)) { Frame F; build_frame(F, lds);
        pg8::Gemm g{(const pg8::bf16_t*)(F.ws + WS_XB), (const pg8::bf16_t*)(F.ws + WS_WIN) + (size_t)L * NP * D, M, NP, D};
        pg8::StaticOrder S; S.init(M, NP, F.G, (int)blockIdx.x);
        pg8::EpiRoute E{F.ws};
        pg8::gemm_phase<pg8::EpiRoute, pg8::StaticOrder, true, true>(F.lds + RING_OFF, g, S, E);
#ifdef EXP_REP1
        __syncthreads(); S.init(M, NP, F.G, (int)blockIdx.x); pg8::gemm_phase<pg8::EpiRoute, pg8::StaticOrder, true, true>(F.lds + RING_OFF, g, S, E);
#endif
    }
    seam(lds, pb);
    if (ph_in(lds, pb + 1)) { Frame F; build_frame(F, lds); p2_prep3(F, L);
#ifdef EXP_REP2
        __syncthreads(); p2_prep3(F, L);
#endif
    }
    seam(lds, pb + 1);
    if (ph_in(lds, pb + 2)) { Frame F; build_frame(F, lds);
#ifdef EXP_REP3
        p3_mixers<1>(F, L, 1); __syncthreads();
#endif
        p3_mixers<0>(F, L, 0); }
    seam(lds, pb + 2);
    if (ph_in(lds, pb + 3)) { Frame F; build_frame(F, lds); p4a_mix2(F, L);
#ifdef EXP_REP4A
        __syncthreads(); p4a_mix2(F, L);
#endif
    }
    seam(lds, pb + 3);
    if (ph_in(lds, pb + 4)) { Frame F; build_frame(F, lds);
        pg8::Gemm g{(const pg8::bf16_t*)(F.ws + WS_MIX), (const pg8::bf16_t*)(F.ws + WS_WOUT) + (size_t)L * D * D, M, D, D};
        pg8::StaticOrder S; S.init(M, D, F.G, (int)blockIdx.x);
        pg8::EpiOut<L == 0> E{L == 0 ? (const float*)inptr(F, 0) : (const float*)F.out, F.out, F.ws};
        pg8::gemm_phase<pg8::EpiOut<L == 0>, pg8::StaticOrder, true, true>(F.lds + RING_OFF, g, S, E);
#ifdef EXP_REP4
        if (L == 0) { __syncthreads(); S.init(M, D, F.G, (int)blockIdx.x); pg8::gemm_phase<pg8::EpiOut<L == 0>, pg8::StaticOrder, true, true>(F.lds + RING_OFF, g, S, E); }
#endif
    }
    seam(lds, pb + 4);
}
__global__ void __launch_bounds__(NWAVES * 64, 2) mk_fwd(Args args) {
    extern __shared__ __attribute__((aligned(16))) unsigned char lds_raw[];
    LAS unsigned char* lds = (LAS unsigned char*)lds_raw;
    for (int u = threadIdx.x; u < (LDS_BYTES - LDSCTL_OFF) / 4; u += NWAVES * 64) ((LAS unsigned*)(lds + LDSCTL_OFF))[u] = 0u;
    __syncthreads();
    if (threadIdx.x == 0) { LAS unsigned long long* pt = (LAS unsigned long long*)(lds + MISC_OFF + 256);
#define PT(k) pt[k] = (unsigned long long)args.in[k]
        PT(0); PT(1); PT(2); PT(3); PT(4); PT(5); PT(6); PT(7); PT(8); PT(9); PT(10); PT(11); PT(12); PT(13); PT(14); PT(15); PT(16); PT(17); PT(18); PT(19); PT(20); PT(21); PT(22); PT(23);
#undef PT
        pt[PT_OUT] = (unsigned long long)args.out; pt[PT_WS] = (unsigned long long)args.ws;
        volatile LAS unsigned* mi = (volatile LAS unsigned*)(lds + MISC_OFF); mi[20] = (unsigned)args.ph_lo; mi[21] = (unsigned)args.ph_hi;
        if (args.ph_hi - args.ph_lo > 1) (void)xcd_barrier_post((unsigned*)((gu32*)args.ws + CW_BAR), mi + 8);
    }
    if ((threadIdx.x & 63) == 0) ((volatile LAS unsigned*)(lds + pg8::TIDTAB_OFF))[pg8::hw_slot()] = threadIdx.x >> 6;
    __syncthreads();
    if (ph_in(lds, 0)) { Frame F; build_frame(F, lds); p0_prologue(F);
#ifdef EXP_REP0
        __syncthreads(); p0_prologue(F);
#endif
    }
    seam(lds, 0);
    layer_phases<0>(lds);
    layer_phases<1>(lds);
    if (ph_in(lds, 11)) { Frame F; build_frame(F, lds); p5_final(F); }
}

extern "C" void kernel_launch(void* const* d_in, const int* in_sizes, int n_in, void* d_out, int out_size, void* d_ws, size_t ws_size, hipStream_t stream) {
    static int grid = 0;
    if (grid == 0) {
        if (n_in != 24 || ws_size < WS_END || out_size != M * D) { fprintf(stderr, "kernel_launch: unexpected inputs (%d), out (%d) or workspace (%zu)\n", n_in, out_size, ws_size); grid = -1; return; }
        int dev = 0, cus = 0;
        if (hipGetDevice(&dev) != hipSuccess || hipDeviceGetAttribute(&cus, hipDeviceAttributeMultiprocessorCount, dev) != hipSuccess) { grid = -1; return; }
        if (hipFuncSetAttribute((const void*)mk_fwd, hipFuncAttributeMaxDynamicSharedMemorySize, LDS_BYTES) != hipSuccess) { fprintf(stderr, "kernel_launch: hipFuncSetAttribute failed\n"); grid = -1; return; }
        (void)hipGetLastError();
        grid = cus;
    }
    if (grid < 0) return;
    unsigned char* ws = (unsigned char*)d_ws;
    (void)hipMemsetAsync(ws + WS_CTL, 0, CTL_ZERO_BYTES, stream);
    Args a{};
    for (int i = 0; i < 24; ++i) a.in[i] = d_in[i];
    a.out = (float*)d_out; a.ws = ws; a.ph_lo = 0; a.ph_hi = NPHASE;
    hipLaunchKernelGGL(mk_fwd, dim3(grid), dim3(NWAVES * 64), LDS_BYTES, stream, a);
}
```

```cpp
#include <hip/hip_runtime.h>
#include <cstdio>
#include <cstdint>
#include <hip/hip_fp16.h>
namespace pg8 {
#define PG8_LAS __attribute__((address_space(3)))
typedef unsigned short bf16_t;
typedef short bf16x8 __attribute__((ext_vector_type(8)));
typedef float f32x4 __attribute__((ext_vector_type(4)));
typedef unsigned u32x4 __attribute__((ext_vector_type(4)));
constexpr int BM = 256, BK = 64, HALF = 128, HTB = HALF * BK * 2  , STAGE_BYTES = 8 * HTB, NXCD = 8, WGM = 8;

__host__ __device__ __forceinline__ int lds_byte(int r, int c) { const int st = (r >> 4) * 2 + (c >> 5), rr = r & 15, cc = c & 31, ob = rr * 64 + cc * 2; return st * 1024 + (ob ^ (((ob >> 9) & 1) << 5)); }
__host__ __device__ __forceinline__ void stage_rc(int b, int& R, int& C) { const int st = b / 1024, sb = b % 1024, swz = sb ^ (((sb >> 9) & 1) << 5); R = (st >> 1) * 16 + swz / 64; C = (st & 1) * 32 + (swz % 64) / 2; }
__host__ __device__ __forceinline__ int perm32(int rho) { const int n = rho >> 4, i = rho & 15; return 8 * (i >> 2) + 4 * n + (i & 3); }

struct Unit { int pm, pn; };
struct Gemm { const bf16_t* A; const bf16_t* Bt; int M, N, K; };

struct StaticOrder {
    int nM, nN, nwg, G, c;
    __host__ __device__ void init(int M, int N, int G_, int c_) { nM = M / BM; nN = N / BM; nwg = nM * nN; G = G_; c = c_; }
    __host__ __device__ bool next(int i, Unit& u) const {
        const long L = (long)i * G + c; if (L >= nwg) return false;
        int wgid = (int)L; { const int q = nwg / NXCD, r = nwg % NXCD, xcd = wgid % NXCD, off = wgid / NXCD; wgid = (xcd < r ? xcd * (q + 1) : r * (q + 1) + (xcd - r) * q) + off; }
        const int nig = WGM * nN, gid = wgid / nig, fm = gid * WGM, gsz = (nM - fm) < WGM ? (nM - fm) : WGM;
        u.pm = fm + ((wgid % nig) % gsz); u.pn = (wgid % nig) / gsz; return true;
    }
    __device__ __forceinline__ void a_ready(const Unit&) const {}
    __device__ __forceinline__ void done(const Unit&) const {}
};

__device__ __forceinline__ unsigned cvt_pk_bf16(float lo, float hi) { unsigned r; asm volatile("v_cvt_pk_bf16_f32 %0, %1, %2" : "=v"(r) : "v"(lo), "v"(hi)); return r; }
typedef float f32x2 __attribute__((ext_vector_type(2)));
constexpr int TIDTAB_OFF = 131072 + 320 + 512;
__device__ __forceinline__ unsigned hw_slot() { return (unsigned)__builtin_amdgcn_s_getreg((5 << 11) | 4) & 63u; }
__device__ __forceinline__ int mk_tid(PG8_LAS unsigned char* lds_base) {
    const unsigned lane = __builtin_amdgcn_mbcnt_hi(~0u, __builtin_amdgcn_mbcnt_lo(~0u, 0u));
    const unsigned w = __builtin_amdgcn_readfirstlane(((volatile PG8_LAS unsigned*)(lds_base + TIDTAB_OFF))[hw_slot()]);
    return (int)(w * 64u + lane);
}
struct EpiRoute {
    static constexpr bool PERM = true, AFTER_DRAIN = false;
    unsigned char* ws;
    __device__ __forceinline__ void operator()(const f32x4 (&acc)[2][2][4][2], const Unit& u, int wr, int wc, int fr, int fq) const {
        const int row0 = u.pm * BM + wr * 64 + fr;
        const float* rowss = (const float*)(ws + (1u << 20)); float* Psm = (float*)(ws + (22u << 20));
        unsigned base[2]; int ld[2], cc[2], kind[2];
#pragma unroll
        for (int bj = 0; bj < 2; ++bj) {
            const int cg = u.pn * BM + bj * HALF + wc * 32, col = cg + 8 * fq;
            if (cg < 1024) { base[bj] = 25u << 20; ld[bj] = 1024; cc[bj] = col; kind[bj] = 0; }
            else if (cg < 2176) { base[bj] = 57u << 20; ld[bj] = 1152; cc[bj] = col - 1024; kind[bj] = 0; }
            else if (cg < 2528) { base[bj] = 93u << 20; ld[bj] = 352; cc[bj] = col - 2176; kind[bj] = 0; }
            else if (cg < 3424) { base[bj] = 104u << 20; ld[bj] = 896; cc[bj] = col - 2528; kind[bj] = 0; }
            else if (cg < 3456) { base[bj] = 0u; ld[bj] = 32; cc[bj] = col - 3424; kind[bj] = 1; }
            else { base[bj] = 0u; ld[bj] = 0; cc[bj] = 0; kind[bj] = 2; }
        }
#pragma unroll
        for (int ai = 0; ai < 2; ++ai)
#pragma unroll
            for (int m = 0; m < 4; ++m) {
                const int row = row0 + ai * HALF + m * 16;
                const f32x4* rp = (const f32x4*)(rowss + (size_t)row * 16);
                const f32x4 s0 = rp[0], s1 = rp[1], s2 = rp[2], s3 = rp[3];
                const float ss = ((s0[0] + s0[1]) + (s0[2] + s0[3])) + ((s1[0] + s1[1]) + (s1[2] + s1[3])) + ((s2[0] + s2[1]) + (s2[2] + s2[3])) + ((s3[0] + s3[1]) + (s3[2] + s3[3]));
                const float rstd = __builtin_amdgcn_rsqf(ss * (1.0f / 1024.0f) + 1e-6f);
#pragma unroll
                for (int bj = 0; bj < 2; ++bj) {
                    const f32x4 v0 = acc[ai][bj][m][0] * rstd, v1 = acc[ai][bj][m][1] * rstd;
                    if (kind[bj] == 0) { u32x4 w; w.x = cvt_pk_bf16(v0[0], v0[1]); w.y = cvt_pk_bf16(v0[2], v0[3]); w.z = cvt_pk_bf16(v1[0], v1[1]); w.w = cvt_pk_bf16(v1[2], v1[3]);
                        *(u32x4*)((bf16_t*)(ws + base[bj]) + (size_t)row * ld[bj] + cc[bj]) = w; }
                    else if (kind[bj] == 1) { float* p = Psm + (size_t)row * 32 + cc[bj]; *(f32x4*)p = v0; *(f32x4*)(p + 4) = v1; }
                }
                asm volatile("" ::: "memory");
            }
    }
};
template <bool WRITE_XB> struct EpiOut {
    static constexpr bool PERM = false, AFTER_DRAIN = false;
    const float* xin; float* xout; unsigned char* ws;
    __device__ __forceinline__ void operator()(const f32x4 (&acc)[2][2][4][2], const Unit& u, int wr, int wc, int fr, int fq) const {
        typedef unsigned u32x2v __attribute__((ext_vector_type(2)));
        const int row0 = u.pm * BM + wr * 64 + fr, col0 = u.pn * BM + wc * 32 + 4 * fq;
        float* rowss = (float*)(ws + (1u << 20)); bf16_t* xb = (bf16_t*)(ws + (133u << 20));
#pragma unroll
        for (int ai = 0; ai < 2; ++ai)
#pragma unroll
            for (int m = 0; m < 4; ++m) {
                const int row = row0 + ai * HALF + m * 16; float ss = 0.f;
#pragma unroll
                for (int bj = 0; bj < 2; ++bj)
#pragma unroll
                    for (int n = 0; n < 2; ++n) {
                        const size_t off = (size_t)row * 1024 + col0 + bj * HALF + n * 16;
                        const f32x4 o = *(const f32x4*)(xin + off) + acc[ai][bj][m][n];
                        *(f32x4*)(xout + off) = o;
                        if (WRITE_XB) { u32x2v w; w.x = cvt_pk_bf16(o[0], o[1]); w.y = cvt_pk_bf16(o[2], o[3]); *(u32x2v*)(xb + off) = w; }
                        ss += (o[0] * o[0] + o[1] * o[1]) + (o[2] * o[2] + o[3] * o[3]);
                    }
                ss += __shfl_xor(ss, 16); ss += __shfl_xor(ss, 32);
                if (fq == 0) rowss[(size_t)row * 16 + u.pn * 4 + wc] = ss;
                asm volatile("" ::: "memory");
            }
    }
};
template <class Epi, class Sched, bool ALIGN_EPI = false, bool SP2 = false>
__device__ __forceinline__ void gemm_phase(PG8_LAS unsigned char* lds, const Gemm g, const Sched& S, const Epi& E) {
    const int tid_ = mk_tid(lds);
    const int tid = tid_, wid = __builtin_amdgcn_readfirstlane(tid >> 6), lane = tid & 63, wr = wid >> 2, wc = wid & 3, fr = lane & 15, fq = lane >> 4;
    const int K = g.K, nt = K / BK;
    unsigned voffA[2], voffB[2];
#pragma unroll
    for (int i = 0; i < 2; ++i) { int R, C; stage_rc(tid * 16 + i * 8192, R, C); const int Rb = Epi::PERM ? ((R & ~31) + perm32(R & 31)) : R;
        voffA[i] = (unsigned)(R * K + C) * 2u; voffB[i] = (unsigned)(Rb * K + C) * 2u; }
    const size_t kstep = (size_t)(BK * 2);
    const size_t hstep = (size_t)HALF * K * 2;
    const size_t tstep = 2 * hstep;
    const unsigned ldsw = (unsigned)wid * 1024u;
    const int aoff = lds_byte(wr * 64 + fr, fq * 8), boff = lds_byte(wc * 32 + fr, fq * 8);
#define PG8_SA(b, h) (((b) * 2 + (h)) * HTB)
#define PG8_SB(b, h) ((4 + (b) * 2 + (h)) * HTB)
#define PG8_STAGE(bufoff, gbase, voff) do { _Pragma("unroll") for (int _i = 0; _i < 2; ++_i) \
        __builtin_amdgcn_global_load_lds((const unsigned*)((const char*)(gbase) + (voff)[_i]), (PG8_LAS unsigned*)(lds + (bufoff) + ldsw + _i * 8192), 16, 0, 0); } while (0)
#define PG8_LDA(dst, b, h) do { _Pragma("unroll") for (int m = 0; m < 4; ++m) _Pragma("unroll") for (int k = 0; k < 2; ++k) dst[m][k] = *(const PG8_LAS bf16x8*)(lds + PG8_SA(b, h) + aoff + m * 2048 + k * 1024); } while (0)
#define PG8_LDB(dst, b, h) do { _Pragma("unroll") for (int n = 0; n < 2; ++n) _Pragma("unroll") for (int k = 0; k < 2; ++k) dst[n][k] = *(const PG8_LAS bf16x8*)(lds + PG8_SB(b, h) + boff + n * 2048 + k * 1024); } while (0)
#define PG8_MMA(ai, bj, At, Bt) do { __builtin_amdgcn_s_setprio(1); _Pragma("unroll") for (int m = 0; m < 4; ++m) _Pragma("unroll") for (int n = 0; n < 2; ++n) _Pragma("unroll") for (int k = 0; k < 2; ++k) \
        acc[ai][bj][m][n] = __builtin_amdgcn_mfma_f32_16x16x32_bf16(Bt[n][k], At[m][k], acc[ai][bj][m][n], 0, 0, 0); __builtin_amdgcn_s_setprio(0); } while (0)
#define PG8_WAIT_V(n) asm volatile("s_waitcnt vmcnt(" #n ")" ::: "memory")
#define PG8_WAIT_L(n) asm volatile("s_waitcnt lgkmcnt(" #n ")" ::: "memory")
#define PG8_BAR __builtin_amdgcn_s_barrier()
#define PG8_SCHED __builtin_amdgcn_sched_barrier(0)
    Unit cur, nxt; int ui = 0;
    if (!S.next(0, cur)) return;
    f32x4 acc[2][2][4][2];
#pragma unroll
    for (int a = 0; a < 2; ++a)
#pragma unroll
        for (int b = 0; b < 2; ++b)
#pragma unroll
            for (int m = 0; m < 4; ++m)
#pragma unroll
                for (int n = 0; n < 2; ++n) acc[a][b][m][n] = (f32x4){0.f, 0.f, 0.f, 0.f};
    bf16x8 At[4][2], B0[2][2], B1[2][2];
    const char* cA = (const char*)g.A + (size_t)cur.pm * tstep; const char* cB = (const char*)g.Bt + (size_t)cur.pn * tstep;
    S.a_ready(cur);
    if constexpr (SP2) {
        PG8_STAGE(PG8_SB(0, 0), cB, voffB); PG8_STAGE(PG8_SB(0, 1), cB + hstep, voffB); PG8_STAGE(PG8_SA(0, 0), cA, voffA); PG8_STAGE(PG8_SA(0, 1), cA + hstep, voffA);
        if (wr == 1) PG8_BAR;
        PG8_WAIT_V(2); PG8_BAR;
        PG8_STAGE(PG8_SB(1, 0), cB + kstep, voffB); PG8_STAGE(PG8_SA(1, 0), cA + kstep, voffA); PG8_STAGE(PG8_SB(1, 1), cB + hstep + kstep, voffB);
        PG8_WAIT_V(6); PG8_BAR;
    } else {
        PG8_STAGE(PG8_SB(0, 0), cB, voffB); PG8_STAGE(PG8_SA(0, 0), cA, voffA); PG8_STAGE(PG8_SB(0, 1), cB + hstep, voffB); PG8_STAGE(PG8_SA(0, 1), cA + hstep, voffA);
        if (wr == 1) PG8_BAR;
        PG8_WAIT_V(4); PG8_BAR;
        PG8_STAGE(PG8_SB(1, 0), cB + kstep, voffB); PG8_STAGE(PG8_SA(1, 0), cA + kstep, voffA); PG8_STAGE(PG8_SB(1, 1), cB + hstep + kstep, voffB);
        PG8_WAIT_V(6); PG8_BAR;
    }
    for (;;) {
        const bool has_next = S.next(ui + 1, nxt);
        const char* nA = has_next ? (const char*)g.A + (size_t)nxt.pm * tstep : cA; const char* nB = has_next ? (const char*)g.Bt + (size_t)nxt.pn * tstep : cB;
        for (int t = 0; t < nt; t += 2) {
            const bool last = (t == nt - 2);
            const char* a1 = cA + (size_t)(t + 1) * kstep;
            const char* a2 = last ? nA : cA + (size_t)(t + 2) * kstep; const char* b2 = last ? nB : cB + (size_t)(t + 2) * kstep;
            const char* a3 = a2 + kstep; const char* b3 = b2 + kstep;
            if (last && has_next) S.a_ready(nxt);
            if constexpr (SP2) {
            PG8_LDB(B0, 0, 0); PG8_LDB(B1, 0, 1); PG8_SCHED; PG8_LDA(At, 0, 0); PG8_STAGE(PG8_SA(1, 1), a1 + hstep, voffA);
            PG8_WAIT_V(8); PG8_WAIT_L(0); PG8_BAR; PG8_MMA(0, 0, At, B0); PG8_MMA(0, 1, At, B1); PG8_BAR; PG8_SCHED;
            PG8_LDA(At, 0, 1); PG8_STAGE(PG8_SB(0, 0), b2, voffB); PG8_STAGE(PG8_SB(0, 1), b2 + hstep, voffB); PG8_STAGE(PG8_SA(0, 0), a2, voffA);
            PG8_WAIT_V(8); PG8_WAIT_L(0); PG8_BAR; PG8_MMA(1, 0, At, B0); PG8_MMA(1, 1, At, B1); PG8_BAR; PG8_SCHED;
            PG8_LDB(B0, 1, 0); PG8_LDB(B1, 1, 1); PG8_SCHED; PG8_LDA(At, 1, 0); PG8_STAGE(PG8_SA(0, 1), a2 + hstep, voffA);
            PG8_WAIT_V(8); PG8_WAIT_L(0); PG8_BAR; PG8_MMA(0, 0, At, B0); PG8_MMA(0, 1, At, B1); PG8_BAR; PG8_SCHED;
            PG8_LDA(At, 1, 1); PG8_STAGE(PG8_SB(1, 0), b3, voffB); PG8_STAGE(PG8_SB(1, 1), b3 + hstep, voffB); PG8_STAGE(PG8_SA(1, 0), a3, voffA);
            PG8_WAIT_V(8); PG8_WAIT_L(0); PG8_BAR; PG8_MMA(1, 0, At, B0); PG8_MMA(1, 1, At, B1); PG8_BAR; PG8_SCHED;
            } else {
            PG8_LDB(B0, 0, 0); PG8_SCHED; PG8_LDA(At, 0, 0); PG8_STAGE(PG8_SA(1, 1), a1 + hstep, voffA);
            PG8_WAIT_L(8); PG8_BAR; PG8_WAIT_L(0); PG8_MMA(0, 0, At, B0); PG8_BAR; PG8_SCHED;
            PG8_LDB(B1, 0, 1); PG8_STAGE(PG8_SB(0, 0), b2, voffB);
            PG8_BAR; PG8_WAIT_L(0); PG8_MMA(0, 1, At, B1); PG8_BAR;
            PG8_LDA(At, 0, 1); PG8_STAGE(PG8_SA(0, 0), a2, voffA);
            PG8_BAR; PG8_WAIT_L(0); PG8_MMA(1, 0, At, B0); PG8_BAR; PG8_SCHED;
            PG8_STAGE(PG8_SB(0, 1), b2 + hstep, voffB);
            PG8_WAIT_V(6); PG8_BAR; PG8_MMA(1, 1, At, B1); PG8_BAR;
            PG8_LDB(B0, 1, 0); PG8_SCHED; PG8_LDA(At, 1, 0); PG8_STAGE(PG8_SA(0, 1), a2 + hstep, voffA);
            PG8_WAIT_L(8); PG8_BAR; PG8_WAIT_L(0); PG8_MMA(0, 0, At, B0); PG8_BAR; PG8_SCHED;
            PG8_LDB(B1, 1, 1); PG8_STAGE(PG8_SB(1, 0), b3, voffB);
            PG8_BAR; PG8_WAIT_L(0); PG8_MMA(0, 1, At, B1); PG8_BAR;
            PG8_LDA(At, 1, 1); PG8_STAGE(PG8_SA(1, 0), a3, voffA);
            PG8_BAR; PG8_WAIT_L(0); PG8_MMA(1, 0, At, B0); PG8_BAR; PG8_SCHED;
            PG8_STAGE(PG8_SB(1, 1), b3 + hstep, voffB);
            PG8_WAIT_V(6); PG8_BAR; PG8_MMA(1, 1, At, B1); PG8_BAR;
            }
        }
        if constexpr (ALIGN_EPI) { if (wr == 0) PG8_BAR; }
        if constexpr (!Epi::AFTER_DRAIN) { E(acc, cur, wr, wc, fr, fq); S.done(cur); }
        if (!has_next) break;
#pragma unroll
        for (int a = 0; a < 2; ++a)
#pragma unroll
            for (int b = 0; b < 2; ++b)
#pragma unroll
                for (int m = 0; m < 4; ++m)
#pragma unroll
                    for (int n = 0; n < 2; ++n) acc[a][b][m][n] = (f32x4){0.f, 0.f, 0.f, 0.f};
        cur = nxt; cA = nA; cB = nB; ++ui;
        if constexpr (ALIGN_EPI) { if (wr == 1) PG8_BAR; }
    }
    PG8_WAIT_V(0);
    if constexpr (!ALIGN_EPI) { if (wr == 0) PG8_BAR; }
    PG8_BAR;
    if constexpr (Epi::AFTER_DRAIN) { E.fused(acc, cur, wr, wc, fr, fq, lds, wid, lane); S.done(cur); }
#undef PG8_SA
#undef PG8_SB
#undef PG8_STAGE
#undef PG8_LDA
#undef PG8_LDB
#undef PG8_MMA
#undef PG8_WAIT_V
#undef PG8_WAIT_L
#undef PG8_BAR
#undef PG8_SCHED
}
}
#define GAS __attribute__((address_space(1)))
#define LAS __attribute__((address_space(3)))
typedef unsigned short bf16;
typedef unsigned v4u __attribute__((ext_vector_type(4)));
typedef float f32x4 __attribute__((ext_vector_type(4)));
typedef short bf16x8 __attribute__((ext_vector_type(8)));
typedef GAS unsigned gu32;
typedef GAS unsigned long long gu64;
#define RLX_AGENT __ATOMIC_RELAXED, __HIP_MEMORY_SCOPE_AGENT
#define LDS_WAIT() asm volatile("s_waitcnt lgkmcnt(0)" ::: "memory")
#define VM_WAIT() asm volatile("s_waitcnt vmcnt(0)" ::: "memory")
__device__ __forceinline__ unsigned long long rt() { return __builtin_amdgcn_s_memrealtime(); }
__device__ __forceinline__ unsigned f2bf(float f) { unsigned u = __builtin_bit_cast(unsigned, f); return (u + 0x7fffu + ((u >> 16) & 1u)) >> 16; }
__device__ __forceinline__ unsigned pk2(float lo, float hi) { return f2bf(lo) | (f2bf(hi) << 16); }

#define XB_TMO      128
#define XB_XCNT(j)  (256  + 64 * (j))
#define XB_XSUB(j)  (1280 + 64 * (j))
#define XB_XGEN(j)  (2304 + 64 * (j))
#define XB_TOP      3328
#define XB_TOPGEN   3392
#define XCD_BAR_WORDS 3456
#define XB_SPIN_CAP (1u << 18)

__device__ __forceinline__ unsigned xb_ld(unsigned* p)              { return __hip_atomic_load(p, __ATOMIC_RELAXED, __HIP_MEMORY_SCOPE_AGENT); }
__device__ __forceinline__ unsigned xb_add(unsigned* p, unsigned v) { return __hip_atomic_fetch_add(p, v, __ATOMIC_RELAXED, __HIP_MEMORY_SCOPE_AGENT); }
__device__ __forceinline__ unsigned xb_xcc_id() { return (unsigned)__builtin_amdgcn_s_getreg((3 << 11) | 20) & 0xFu; }
#define XB_SPIN(cond, bar) do { unsigned _sp = 0; while (cond) { __builtin_amdgcn_s_sleep(1); \
    if ((++_sp & 255u) == 0u) { if (xb_ld(&(bar)[XB_TMO])) break; if (_sp > XB_SPIN_CAP) { atomicAdd(&(bar)[XB_TMO], 1u); break; } } } } while (0)

struct XcdBarrier {
    unsigned* bar; unsigned x;
    volatile LAS unsigned* st;
};

__device__ __forceinline__ XcdBarrier xcd_barrier_post(unsigned* bar, volatile LAS unsigned* st) {
    XcdBarrier b; b.bar = bar; b.x = xb_xcc_id(); b.st = st;
    if (threadIdx.x == 0) (void)xb_add(&bar[XB_XCNT(b.x)], 1u);
    return b;
}
__device__ __forceinline__ void xcd_barrier_complete(unsigned* bar, unsigned x, unsigned& nloc, unsigned& nx) {
    const unsigned G = gridDim.x * gridDim.y * gridDim.z;
    unsigned sum, cnt, mine, sp = 0u;
    for (;;) {
        sum = 0u; cnt = 0u; mine = 0u;
#pragma unroll
        for (unsigned j = 0; j < 16; ++j) { const unsigned c = xb_ld(&bar[XB_XCNT(j)]); sum += c; cnt += (c > 0u) ? 1u : 0u; mine = (j == x) ? c : mine; }
        if (sum == G) break;
        __builtin_amdgcn_s_sleep(1);
        if ((++sp & 255u) == 0u) { if (xb_ld(&bar[XB_TMO])) break; if (sp > XB_SPIN_CAP) { atomicAdd(&bar[XB_TMO], 1u); break; } }
    }
    nloc = mine > 0u ? mine : 1u; nx = cnt > 0u ? cnt : 1u;
}

__device__ __forceinline__ void xcd_barrier(const XcdBarrier& b) {
    asm volatile("s_waitcnt vmcnt(0)" ::: "memory");
    __syncthreads();
    if (pg8::mk_tid((LAS unsigned char*)b.st - (131072 + 320 + 32)) == 0) {
        unsigned* bar = b.bar;
        __builtin_amdgcn_s_waitcnt(0);
        unsigned nloc = b.st[0], nx = b.st[1];
        if (nloc == 0u) { xcd_barrier_complete(bar, b.x, nloc, nx); b.st[0] = nloc; b.st[1] = nx; }
        const unsigned old = xb_add(&bar[XB_XSUB(b.x)], 1u);
        const unsigned gen = old / nloc;
        if (old + 1u == (gen + 1u) * nloc) {
            __builtin_amdgcn_fence(__ATOMIC_RELEASE, "agent");
            asm volatile("s_waitcnt vmcnt(0)" ::: "memory");
            const unsigned og = xb_add(&bar[XB_TOP], 1u);
            const unsigned tg = og / nx;
            if (og + 1u == (tg + 1u) * nx) xb_add(&bar[XB_TOPGEN], 1u);
            else XB_SPIN(xb_ld(&bar[XB_TOPGEN]) == tg, bar);
            __builtin_amdgcn_fence(__ATOMIC_ACQUIRE, "agent");
            xb_add(&bar[XB_XGEN(b.x)], 1u);
            asm volatile("s_waitcnt vmcnt(0)" ::: "memory");
        } else {
            XB_SPIN(xb_ld(&bar[XB_XGEN(b.x)]) == gen, bar);
            __builtin_amdgcn_fence(__ATOMIC_ACQUIRE, "agent");
            asm volatile("s_waitcnt vmcnt(0)" ::: "memory");
        }
    }
    __syncthreads();
}
constexpr int BATCH = 8, SEQ = 2048, M = BATCH * SEQ, D = 1024, NIN = 3448, NP = 3584;
constexpr float NORM_EPS = 1e-6f;
constexpr float LOG2E = 1.4426950408889634f;
constexpr size_t MiB = 1u << 20;
constexpr size_t WS_CTL = 0, CTL_ZERO_BYTES = 1 * MiB;
constexpr size_t WS_ROWSS = 1 * MiB;
constexpr size_t WS_WIN = 2 * MiB;
constexpr size_t WS_WOUT = 16 * MiB;
constexpr size_t WS_WSMALL = 20 * MiB;
constexpr size_t OFF_WUQ = 0, OFF_WUKV = 2 * 576 * 192 * 2, OFF_W2T = OFF_WUKV + 2 * 768 * 128 * 2, OFF_A2T = OFF_W2T + 2 * 2 * 256 * 64 * 2;
constexpr size_t WS_PSM = 22 * MiB;
constexpr size_t WS_CB = 24 * MiB;
constexpr size_t WS_PGATE = 25 * MiB;
constexpr size_t WS_PGDN = 57 * MiB;
constexpr size_t WS_PMLA = 93 * MiB;
constexpr size_t WS_PRW = 104 * MiB;
constexpr size_t WS_OGDN = 93 * MiB;
constexpr size_t WS_OMLA = 105 * MiB;
constexpr size_t WS_Y = 117 * MiB;
constexpr size_t WS_RS = 133 * MiB;
constexpr size_t WS_RD = 157 * MiB;
constexpr size_t WS_XB = 133 * MiB;
constexpr size_t WS_Q = 207 * MiB;
constexpr size_t WS_K = 225 * MiB;
constexpr size_t WS_VT = 243 * MiB;
constexpr size_t WS_MIX = 207 * MiB;
constexpr size_t WS_END = 255 * MiB;
constexpr int RS_REC = 384;
constexpr size_t RD_DIR = (size_t)BATCH * 4 * SEQ * RS_REC;
__device__ __forceinline__ size_t rw_rec_off(int bh, int t, int arr, int w) { return ((size_t)(bh * (SEQ / 64) + (t >> 6)) * 3 + arr) * 8192 + w * 1024 + (t & 63) * 16; }
constexpr int CW_BAR = 4096;
constexpr int CW_QUEUE = 16384;

constexpr int NWAVES = 8;
constexpr int RING_OFF = 0, RING_BYTES = 131072, LDSCTL_OFF = RING_BYTES, MISC_OFF = LDSCTL_OFF + 320, LDS_BYTES = 147456;
static_assert(pg8::TIDTAB_OFF == MISC_OFF + 512 && RING_OFF == 0, "LDS map");
constexpr int NPHASE = 12;

__device__ __forceinline__ float bf2f(bf16 v) { return __uint_as_float(((unsigned)v) << 16); }
__device__ __forceinline__ float wave_sum(float v) {
#pragma unroll
    for (int o = 1; o < 64; o <<= 1) v += __shfl_xor(v, o);
    return v;
}
__device__ __forceinline__ float siluf(float x) { return x * __builtin_amdgcn_rcpf(1.f + __expf(-x)); }
__device__ __forceinline__ float sigmoidf_(float x) { return __builtin_amdgcn_rcpf(1.f + __expf(-x)); }
__device__ __forceinline__ float softplusf_(float x) { return x > 20.f ? x : log1pf(__expf(x)); }

typedef float f32x2_t __attribute__((ext_vector_type(2))); typedef __bf16 bf16x2_t __attribute__((ext_vector_type(2)));
__device__ __forceinline__ unsigned cvt2bf(float lo, float hi) { const f32x2_t v = {lo, hi}; const bf16x2_t b = __builtin_convertvector(v, bf16x2_t); return __builtin_bit_cast(unsigned, b); }

struct Args { const void* in[24]; float* out; unsigned char* ws; int ph_lo, ph_hi; };

struct Frame {
    LAS unsigned char* lds;
    volatile LAS unsigned* MISC;
    gu32* ctl;
    int tid, lane, wave, vcu, G;
    unsigned char* ws;
    float* out;
    volatile LAS const unsigned long long* ptab;
};
__device__ __forceinline__ const void* inptr(const Frame& F, int k) {
    const unsigned long long v = F.ptab[k];
    const unsigned lo = __builtin_amdgcn_readfirstlane((unsigned)v), hi = __builtin_amdgcn_readfirstlane((unsigned)(v >> 32));
    return (const void*)(GAS const void*)(((unsigned long long)hi << 32) | lo);
}

__device__ __forceinline__ void tr_item(const float* W, int K, int ldsrc, int scol, int nvalid, bf16* WT, const float* gs, LAS float* scr, int kb, int lane) {
    const int k0 = 64 * kb;
#pragma unroll 8
    for (int i = 0; i < 32; ++i) { const int kk = 2 * i + (lane >> 5), n = lane & 31; float v = 0.f;
        if (n < nvalid) { v = W[(size_t)(k0 + kk) * ldsrc + scol + n]; if (gs) v *= gs[k0 + kk]; }
        scr[kk * 33 + n] = v; }
    LDS_WAIT(); asm volatile("" ::: "memory");
    const int c = lane & 7;
#pragma unroll
    for (int j = 0; j < 4; ++j) { const int n = (lane >> 3) + 8 * j; const LAS float* s = scr + (8 * c) * 33 + n;
        v4u o; o.x = pk2(s[0 * 33], s[1 * 33]); o.y = pk2(s[2 * 33], s[3 * 33]); o.z = pk2(s[4 * 33], s[5 * 33]); o.w = pk2(s[6 * 33], s[7 * 33]);
        *(GAS v4u*)(WT + (size_t)n * K + k0 + 8 * c) = o; }
    LDS_WAIT(); asm volatile("" ::: "memory");
}
__device__ __forceinline__ void p0_prologue(Frame& F) {
    LAS float* scr = (LAS float*)(F.lds + RING_OFF + F.wave * 16384);
    const int gw = F.vcu * NWAVES + F.wave, NGW = F.G * NWAVES;
    constexpr int I_IN = 112 * 16, I_OUT = 32 * 16, I_UQ = 18 * 3, I_UKV = 24 * 2, I_W2 = 16, I_A2 = 16, I_L = I_IN + I_OUT + I_UQ + I_UKV + I_W2 + I_A2;
    for (int it = gw; it < 2 * I_L; it += NGW) {
        const int l = it / I_L; int r = it % I_L;
        if (r < I_IN) { const int nb = r >> 4, kb = r & 15, n0 = 32 * nb; int scol, nv;
            if (n0 < 2176) { scol = n0; nv = 32; } else if (n0 < 3424) { scol = n0 + 24; nv = 32; } else if (n0 == 3424) { scol = 2176; nv = 24; } else { scol = 0; nv = 0; }
            tr_item((const float*)inptr(F, 3) + (size_t)l * D * NIN, D, NIN, scol, nv, (bf16*)(F.ws + WS_WIN) + ((size_t)l * NP + n0) * D, (const float*)inptr(F, 2) + l * D, scr, kb, F.lane); continue; }
        r -= I_IN;
        if (r < I_OUT) { const int nb = r >> 4, kb = r & 15;
            tr_item((const float*)inptr(F, 22) + (size_t)l * D * D, D, D, 32 * nb, 32, (bf16*)(F.ws + WS_WOUT) + ((size_t)l * D + 32 * nb) * D, nullptr, scr, kb, F.lane); continue; }
        r -= I_OUT;
        if (r < I_UQ) { const int nb = r / 3, kb = r % 3;
            tr_item((const float*)inptr(F, 9) + (size_t)l * 192 * 576, 192, 576, 32 * nb, 32, (bf16*)(F.ws + WS_WSMALL + OFF_WUQ) + ((size_t)l * 576 + 32 * nb) * 192, (const float*)inptr(F, 8) + l * 192, scr, kb, F.lane); continue; }
        r -= I_UQ;
        if (r < I_UKV) { const int nb = r >> 1, kb = r & 1;
            tr_item((const float*)inptr(F, 11) + (size_t)l * 128 * 768, 128, 768, 32 * nb, 32, (bf16*)(F.ws + WS_WSMALL + OFF_WUKV) + ((size_t)l * 768 + 32 * nb) * 128, (const float*)inptr(F, 10) + l * 128, scr, kb, F.lane); continue; }
        r -= I_UKV;
        if (r < I_W2) { const int e = r >> 3, nb = r & 7;
            tr_item((const float*)inptr(F, 14) + ((size_t)l * 2 + e) * 64 * 256, 64, 256, 32 * nb, 32, (bf16*)(F.ws + WS_WSMALL + OFF_W2T) + (((size_t)l * 2 + e) * 256 + 32 * nb) * 64, nullptr, scr, 0, F.lane); continue; }
        r -= I_W2;
        { const int e = r >> 3, nb = r & 7;
            tr_item((const float*)inptr(F, 16) + ((size_t)l * 2 + e) * 64 * 256, 64, 256, 32 * nb, 32, (bf16*)(F.ws + WS_WSMALL + OFF_A2T) + (((size_t)l * 2 + e) * 256 + 32 * nb) * 64, nullptr, scr, 0, F.lane); }
    }
    const float* x = (const float*)inptr(F, 0); bf16* xb = (bf16*)(F.ws + WS_XB); float* rowss = (float*)(F.ws + WS_ROWSS);
    for (int m = gw; m < M; m += NGW) {
        const GAS f32x4* xr = (const GAS f32x4*)(x + (size_t)m * D) + F.lane;
        GAS unsigned long long* o8 = (GAS unsigned long long*)(xb + (size_t)m * D) + F.lane; float s = 0.f;
#pragma unroll
        for (int j = 0; j < 4; ++j) { const f32x4 v = xr[64 * j]; s += (v.x * v.x + v.y * v.y) + (v.z * v.z + v.w * v.w);
            o8[64 * j] = (unsigned long long)pk2(v.x, v.y) | ((unsigned long long)pk2(v.z, v.w) << 32); }
        s = wave_sum(s);
        if (F.lane < 16) rowss[(size_t)m * 16 + F.lane] = F.lane == 0 ? s : 0.f;
    }
}
__device__ __forceinline__ void p5_final(Frame& F) {
    const int gw = F.vcu * NWAVES + F.wave, NGW = F.G * NWAVES;
    const float* rowss = (const float*)(F.ws + WS_ROWSS); const float* g = (const float*)inptr(F, 23);
    f32x4 gv[4];
#pragma unroll
    for (int j = 0; j < 4; ++j) gv[j] = ((const f32x4*)g)[F.lane + 64 * j];
    for (int m = gw; m < M; m += NGW) {
        float ss = F.lane < 16 ? rowss[(size_t)m * 16 + F.lane] : 0.f;
        ss = wave_sum(ss);
        const float rstd = rsqrtf(ss * (1.f / D) + NORM_EPS);
        GAS f32x4* xr = (GAS f32x4*)(F.out + (size_t)m * D) + F.lane;
#pragma unroll
        for (int j = 0; j < 4; ++j) { f32x4 v = xr[64 * j]; v = v * rstd * gv[j]; xr[64 * j] = v; }
    }
}
typedef float f32x16 __attribute__((ext_vector_type(16)));
typedef unsigned long long u64_t;
__device__ __forceinline__ bf16x8 mk_bf16x8(u64_t lo, u64_t hi) { typedef u64_t u64x2 __attribute__((ext_vector_type(2))); u64x2 v = {lo, hi}; return __builtin_bit_cast(bf16x8, v); }

constexpr int AT_KP = 208, AT_VP = 136, AT_KBYTES = 64 * AT_KP, AT_VBYTES = 64 * AT_VP, AT_BUF = AT_KBYTES + AT_VBYTES;
__device__ __forceinline__ float at_max3(float a, float b, float c) { float r; asm("v_max3_f32 %0, %1, %2, %3" : "=v"(r) : "v"(a), "v"(b), "v"(c)); return r; }
__device__ __forceinline__ void attn_unit(Frame& F, int unit) {
    const int bh = unit >> 3, qb = unit & 7, b = bh / 6, h = bh % 6;
    const int tid = F.tid, lane = F.lane, wave = F.wave, r32 = lane & 31, hi = lane >> 5;
    const bf16* Qg = (const bf16*)(F.ws + WS_Q) + ((size_t)bh * SEQ + qb * 256 + wave * 32 + r32) * 96;
    const bf16* Kg = (const bf16*)(F.ws + WS_K) + (size_t)bh * SEQ * 96;
    const bf16* Vg = (const bf16*)(F.ws + WS_VT) + (size_t)bh * 64 * SEQ;
    LAS unsigned char* lds = F.lds + RING_OFF;
    bf16x8 qf[6];
#pragma unroll
    for (int s = 0; s < 6; ++s) qf[s] = *(const bf16x8*)(Qg + 16 * s + 8 * hi);
    const int kr0 = tid / 12, kc0 = tid % 12, kr1 = (512 + tid) / 12, kc1 = (512 + tid) % 12, vd = tid >> 3, vc = tid & 7;
    const bool has1 = tid < 256;
    v4u ka0, ka1 = {0u, 0u, 0u, 0u}, va, kb0, kb1 = {0u, 0u, 0u, 0u}, vb;
#define AT_LOAD(K0, K1, V_, t0) do { K0 = *(const v4u*)(Kg + (size_t)((t0) + kr0) * 96 + kc0 * 8); if (has1) K1 = *(const v4u*)(Kg + (size_t)((t0) + kr1) * 96 + kc1 * 8); \
        V_ = *(const v4u*)(Vg + (size_t)vd * SEQ + (t0) + vc * 8); } while (0)
#define AT_STORE(K0, K1, V_, buf) do { LAS unsigned char* bb_ = lds + (buf) * AT_BUF; *(LAS v4u*)(bb_ + kr0 * AT_KP + kc0 * 16) = K0; if (has1) *(LAS v4u*)(bb_ + kr1 * AT_KP + kc1 * 16) = K1; \
        LAS u64_t* vp_ = (LAS u64_t*)(bb_ + AT_KBYTES + vd * AT_VP + vc * 16); vp_[0] = (u64_t)V_.x | ((u64_t)V_.y << 32); vp_[1] = (u64_t)V_.z | ((u64_t)V_.w << 32); } while (0)
    AT_LOAD(ka0, ka1, va, 0); AT_STORE(ka0, ka1, va, 0);
    AT_LOAD(ka0, ka1, va, 64);
    __syncthreads();
    f32x16 o0 = {}, o1 = {};
    float mrun = -1e30f, lsum = 0.f;
    constexpr int NT = SEQ / 64;
    auto tile = [&](int t) {
        LAS unsigned char* bb = lds + (t % 3) * AT_BUF;
        f32x16 p0 = {}, p1 = {};
        { const LAS unsigned char* kb = bb + r32 * AT_KP + hi * 16;
#pragma unroll
          for (int s = 0; s < 6; ++s) {
              const bf16x8 a0 = *(const LAS bf16x8*)(kb + 32 * s), a1 = *(const LAS bf16x8*)(kb + 32 * AT_KP + 32 * s);
              p0 = __builtin_amdgcn_mfma_f32_32x32x16_bf16(a0, qf[s], p0, 0, 0, 0);
              p1 = __builtin_amdgcn_mfma_f32_32x32x16_bf16(a1, qf[s], p1, 0, 0, 0); } }
        asm volatile("s_nop 15\n\ts_nop 7" : "+v"(p0), "+v"(p1));
        float ma = at_max3(p0[0], p0[1], p1[0]), mb = at_max3(p0[2], p0[3], p1[1]); ma = at_max3(ma, p1[2], p1[3]);
#pragma unroll
        for (int r = 4; r < 16; r += 4) { ma = at_max3(ma, p0[r], p0[r + 1]); mb = at_max3(mb, p0[r + 2], p0[r + 3]); ma = at_max3(ma, p1[r], p1[r + 1]); mb = at_max3(mb, p1[r + 2], p1[r + 3]); }
        float mloc = at_max3(ma, mb, mrun);
        { const auto rr = __builtin_amdgcn_permlane32_swap(__float_as_uint(mloc), __float_as_uint(mloc), false, false); mloc = at_max3(__uint_as_float(rr[0]), __uint_as_float(rr[1]), mloc); }
        const float mnew = mloc, alpha = __builtin_amdgcn_exp2f(mrun - mnew);
        mrun = mnew; lsum *= alpha;
#pragma unroll
        for (int r = 0; r < 16; ++r) { o0[r] *= alpha; o1[r] *= alpha; }
        float ps = 0.f;
#pragma unroll
        for (int r = 0; r < 16; ++r) { p0[r] = __builtin_amdgcn_exp2f(p0[r] - mnew); p1[r] = __builtin_amdgcn_exp2f(p1[r] - mnew); ps += p0[r] + p1[r]; }
        lsum += ps;
        v4u pk[4];
#pragma unroll
        for (int s2 = 0; s2 < 2; ++s2) {
            pk[s2] = (v4u){pg8::cvt_pk_bf16(p0[8 * s2], p0[8 * s2 + 1]), pg8::cvt_pk_bf16(p0[8 * s2 + 2], p0[8 * s2 + 3]), pg8::cvt_pk_bf16(p0[8 * s2 + 4], p0[8 * s2 + 5]), pg8::cvt_pk_bf16(p0[8 * s2 + 6], p0[8 * s2 + 7])};
            pk[2 + s2] = (v4u){pg8::cvt_pk_bf16(p1[8 * s2], p1[8 * s2 + 1]), pg8::cvt_pk_bf16(p1[8 * s2 + 2], p1[8 * s2 + 3]), pg8::cvt_pk_bf16(p1[8 * s2 + 4], p1[8 * s2 + 5]), pg8::cvt_pk_bf16(p1[8 * s2 + 6], p1[8 * s2 + 7])};
        }
        { const LAS unsigned char* vb_ = bb + AT_KBYTES + r32 * AT_VP + hi * 8;
#pragma unroll
          for (int ks = 0; ks < 4; ++ks) {
              const bf16x8 pb = __builtin_bit_cast(bf16x8, pk[ks]);
              const bf16x8 v0 = mk_bf16x8(*(const LAS u64_t*)(vb_ + ks * 32), *(const LAS u64_t*)(vb_ + ks * 32 + 16));
              const bf16x8 v1 = mk_bf16x8(*(const LAS u64_t*)(vb_ + 32 * AT_VP + ks * 32), *(const LAS u64_t*)(vb_ + 32 * AT_VP + ks * 32 + 16));
              o0 = __builtin_amdgcn_mfma_f32_32x32x16_bf16(v0, pb, o0, 0, 0, 0);
              o1 = __builtin_amdgcn_mfma_f32_32x32x16_bf16(v1, pb, o1, 0, 0, 0); } }
    };
    for (int t = 0; t < NT; t += 2) {
        if (t + 2 < NT) AT_LOAD(kb0, kb1, vb, (t + 2) * 64);
        tile(t);
        AT_STORE(ka0, ka1, va, (t + 1) % 3);
        __syncthreads();
        if (t + 3 < NT) AT_LOAD(ka0, ka1, va, (t + 3) * 64);
        tile(t + 1);
        if (t + 2 < NT) AT_STORE(kb0, kb1, vb, (t + 2) % 3);
        __syncthreads();
    }
#undef AT_LOAD
#undef AT_STORE
    lsum += __shfl_xor(lsum, 32);
    const float inv = 1.f / lsum;
    bf16* Og = (bf16*)(F.ws + WS_OMLA) + ((size_t)b * SEQ + qb * 256 + wave * 32 + r32) * 384 + h * 64 + 4 * hi;
#pragma unroll
    for (int rg = 0; rg < 4; ++rg) {
        *(u64_t*)(Og + 8 * rg) = (u64_t)pg8::cvt_pk_bf16(o0[4 * rg] * inv, o0[4 * rg + 1] * inv) | ((u64_t)pg8::cvt_pk_bf16(o0[4 * rg + 2] * inv, o0[4 * rg + 3] * inv) << 32);
        *(u64_t*)(Og + 32 + 8 * rg) = (u64_t)pg8::cvt_pk_bf16(o1[4 * rg] * inv, o1[4 * rg + 1] * inv) | ((u64_t)pg8::cvt_pk_bf16(o1[4 * rg + 2] * inv, o1[4 * rg + 3] * inv) << 32);
    }
}

constexpr int CW_FLAG = 32768;
__device__ __forceinline__ void partner_sync(Frame& F, gu32* mine, gu32* theirs) {
    asm volatile("s_waitcnt vmcnt(0)" ::: "memory");
    __syncthreads();
    if (F.tid == 0) {
        __builtin_amdgcn_fence(__ATOMIC_RELEASE, "agent");
        asm volatile("s_waitcnt vmcnt(0)" ::: "memory");
        __hip_atomic_store(mine, 1u, RLX_AGENT);
        unsigned spins = 0;
        while (__hip_atomic_load(theirs, RLX_AGENT) == 0u) { __builtin_amdgcn_s_sleep(4); if (++spins > (1u << 22)) break; }
        __builtin_amdgcn_fence(__ATOMIC_ACQUIRE, "agent");
        asm volatile("s_waitcnt vmcnt(0)" ::: "memory");
    }
    __syncthreads();
}
constexpr int RW_STEP = 1440, RW_CH = 32, RW_BUF = RW_CH * RW_STEP;
constexpr int RW_Y = 2 * RW_BUF;
static_assert(RW_Y + 2 * 4096 <= RING_BYTES, "RWKV LDS map");
__device__ __forceinline__ float dpp_xor1(float x) { return __builtin_bit_cast(float, __builtin_amdgcn_update_dpp(0, __builtin_bit_cast(int, x), 0xB1, 0xF, 0xF, true)); }
__device__ __forceinline__ float dpp_xor2(float x) { return __builtin_bit_cast(float, __builtin_amdgcn_update_dpp(0, __builtin_bit_cast(int, x), 0x4E, 0xF, 0xF, true)); }
__device__ __forceinline__ float dpp_hmir(float x) { return __builtin_bit_cast(float, __builtin_amdgcn_update_dpp(0, __builtin_bit_cast(int, x), 0x141, 0xF, 0xF, true)); }
__device__ __forceinline__ float dpp_rmir(float x) { return __builtin_bit_cast(float, __builtin_amdgcn_update_dpp(0, __builtin_bit_cast(int, x), 0x140, 0xF, 0xF, true)); }
template <int CTRL, int RM> __device__ __forceinline__ float dpp_sh(float x) { return __builtin_bit_cast(float, __builtin_amdgcn_update_dpp(0, __builtin_bit_cast(int, x), CTRL, RM, 0xF, false)); }
__device__ __forceinline__ float wave_scan(float x) {
    x += dpp_sh<0x111, 0xF>(x); x += dpp_sh<0x112, 0xF>(x); x += dpp_sh<0x114, 0xF>(x); x += dpp_sh<0x118, 0xF>(x);
    x += dpp_sh<0x142, 0xA>(x); x += dpp_sh<0x143, 0xC>(x); return x; }
__device__ __forceinline__ float lane63(float x) { return __builtin_bit_cast(float, __builtin_amdgcn_readlane(__builtin_bit_cast(int, x), 63)); }
constexpr int GP = 144;
constexpr int G_Q = 0, G_K = 9216, G_V = 18432, G_KT = 27648, G_P = 36864, G_A = 46080, G_SM = 63488, G_GROUP = 64512;
constexpr int G_T = 92160;
constexpr int G_RAW = 65536;
constexpr int G_CW = 133120;
static_assert(2 * G_GROUP <= RING_BYTES && G_CW + 3840 <= LDS_BYTES && G_CW >= MISC_OFF + 1024, "GDN LDS map");
__device__ __forceinline__ bf16x8 ld2x8(const LAS unsigned char* p) { return mk_bf16x8(*(const LAS u64_t*)p, *(const LAS u64_t*)(p + 32)); }
__device__ __forceinline__ bf16x8 pack_acc(const f32x4& a, const f32x4& b) {
    v4u w; w.x = pg8::cvt_pk_bf16(a[0], a[1]); w.y = pg8::cvt_pk_bf16(a[2], a[3]); w.z = pg8::cvt_pk_bf16(b[0], b[1]); w.w = pg8::cvt_pk_bf16(b[2], b[3]); return __builtin_bit_cast(bf16x8, w); }
__device__ __forceinline__ void split_acc(const f32x4& a, const f32x4& b, bf16x8& hi, bf16x8& lo) {
    v4u wh; wh.x = cvt2bf(a[0], a[1]); wh.y = cvt2bf(a[2], a[3]); wh.z = cvt2bf(b[0], b[1]); wh.w = cvt2bf(b[2], b[3]);
    f32x4 ra, rb;
    ra[0] = a[0] - __uint_as_float(wh.x << 16); ra[1] = a[1] - __uint_as_float(wh.x & 0xffff0000u); ra[2] = a[2] - __uint_as_float(wh.y << 16); ra[3] = a[3] - __uint_as_float(wh.y & 0xffff0000u);
    rb[0] = b[0] - __uint_as_float(wh.z << 16); rb[1] = b[1] - __uint_as_float(wh.z & 0xffff0000u); rb[2] = b[2] - __uint_as_float(wh.w << 16); rb[3] = b[3] - __uint_as_float(wh.w & 0xffff0000u);
    hi = __builtin_bit_cast(bf16x8, wh); lo = pack_acc(ra, rb);
}
__device__ __forceinline__ void hilo4(const f32x4& a, u64_t& hi, u64_t& lo) {
    const unsigned h0 = cvt2bf(a[0], a[1]), h1 = cvt2bf(a[2], a[3]);
    const float r0 = a[0] - __uint_as_float(h0 << 16), r1 = a[1] - __uint_as_float(h0 & 0xffff0000u), r2 = a[2] - __uint_as_float(h1 << 16), r3 = a[3] - __uint_as_float(h1 & 0xffff0000u);
    hi = (u64_t)h0 | ((u64_t)h1 << 32); lo = (u64_t)cvt2bf(r0, r1) | ((u64_t)cvt2bf(r2, r3) << 32);
}
typedef _Float16 f16x8 __attribute__((ext_vector_type(8)));
typedef _Float16 h4_t __attribute__((ext_vector_type(4)));
__device__ __forceinline__ f16x8 pack_acc_f16(const f32x4& a, const f32x4& b) { return (f16x8){(_Float16)a[0], (_Float16)a[1], (_Float16)a[2], (_Float16)a[3], (_Float16)b[0], (_Float16)b[1], (_Float16)b[2], (_Float16)b[3]}; }
template <int SKIP> __device__ __forceinline__ void gdn_unit3(Frame& F, int l, int unit, gu32* flags) {
    const int bh = unit >> 1, dir = unit & 1, b = bh / 6, h = bh % 6;
    const int tid = F.tid, lane = F.lane, wave = F.wave;
    const bf16* Pgdn = (const bf16*)(F.ws + WS_PGDN) + (size_t)b * SEQ * 1152 + h * 64; const float* Psm = (const float*)(F.ws + WS_PSM) + (size_t)b * SEQ * 32;
    bf16* Og = (SKIP & 128) ? (bf16*)(F.ws + WS_Y + 8 * MiB) + (size_t)(b % 5) * SEQ * 384 + h * 64 : (bf16*)(F.ws + WS_OGDN) + (size_t)b * SEQ * 384 + h * 64;
    LAS unsigned char* gb = F.lds + RING_OFF;
    LAS float* cwl = (LAS float*)(F.lds + G_CW);
    LAS float* sm = (LAS float*)(gb + G_SM);
    { const float* conv_w = (const float*)inptr(F, 4) + (size_t)l * 5 * 1152;
      for (int i = tid; i < 960; i += 512) { const int tn = i / 320, tap = (i % 320) / 64, ch = i % 64; cwl[i] = conv_w[tap * 1152 + tn * 384 + h * 64 + ch]; } }
    const float al = -__expf(((const float*)inptr(F, 5))[l * 12 + dir * 6 + h]), dtb = ((const float*)inptr(F, 6))[l * 12 + dir * 6 + h];
    f32x4 Sacc[4];
#pragma unroll
    for (int i = 0; i < 4; ++i) Sacc[i] = (f32x4){0.f, 0.f, 0.f, 0.f};
    const int ci = tid >> 3, cg = tid & 7;
#define GDN_RAW_STAGE(cc_, first_, nthr_) do { const int tlo_ = (dir ? SEQ - 64 * (cc_) - 64 : 64 * (cc_)) - 2; \
        for (int pc_ = (first_); pc_ < 68 * 24; pc_ += (nthr_)) { const int rr_ = pc_ / 24, sg_ = pc_ % 24, tt_ = tlo_ + rr_; v4u x_ = {0u, 0u, 0u, 0u}; \
            if (!(SKIP & 1) && tt_ >= 0 && tt_ < SEQ) x_ = *(const v4u*)(Pgdn + (size_t)tt_ * 1152 + (sg_ >> 3) * 384 + 8 * (sg_ & 7)); \
            *(LAS v4u*)(gb + G_RAW + rr_ * 384 + 16 * sg_) = x_; } } while (0)
#define GDN_WRITEOUT(cc_) do { if (!(SKIP & 4)) { const int t_ = dir ? SEQ - 1 - 64 * (cc_) - ci : 64 * (cc_) + ci; bf16* op_ = Og + (size_t)t_ * 384 + 8 * cg; \
            const LAS f32x4* src_ = (const LAS f32x4*)(gb + G_A + (ci * 68 + 8 * cg) * 4); f32x4 o0_ = src_[0], o1_ = src_[1]; \
            if ((cc_) >= SEQ / 128) { const v4u p0_ = *(const v4u*)op_; \
                o0_ += (f32x4){__uint_as_float(p0_.x << 16), __uint_as_float(p0_.x & 0xffff0000u), __uint_as_float(p0_.y << 16), __uint_as_float(p0_.y & 0xffff0000u)}; \
                o1_ += (f32x4){__uint_as_float(p0_.z << 16), __uint_as_float(p0_.z & 0xffff0000u), __uint_as_float(p0_.w << 16), __uint_as_float(p0_.w & 0xffff0000u)}; } \
            v4u w0_; w0_.x = pg8::cvt_pk_bf16(o0_[0], o0_[1]); w0_.y = pg8::cvt_pk_bf16(o0_[2], o0_[3]); w0_.z = pg8::cvt_pk_bf16(o1_[0], o1_[1]); w0_.w = pg8::cvt_pk_bf16(o1_[2], o1_[3]); \
            *(v4u*)op_ = w0_; } } while (0)
    GDN_RAW_STAGE(0, tid, 512);
#define GDN_RAW_LOAD(cc_) do { const int tlo_ = (dir ? SEQ - 64 * (cc_) - 64 : 64 * (cc_)) - 2; \
        _Pragma("unroll") for (int k_ = 0; k_ < 4; ++k_) { const int pc_ = tid + 512 * k_, rr_ = pc_ / 24, sg_ = pc_ % 24, tt_ = tlo_ + rr_; rawn[k_] = (v4u){0u, 0u, 0u, 0u}; \
            if (!(SKIP & 1) && pc_ < 68 * 24 && tt_ >= 0 && tt_ < SEQ) rawn[k_] = *(const v4u*)(Pgdn + (size_t)tt_ * 1152 + (sg_ >> 3) * 384 + 8 * (sg_ & 7)); } } while (0)
#define GDN_RAW_STORE() do { _Pragma("unroll") for (int k_ = 0; k_ < 4; ++k_) { const int pc_ = tid + 512 * k_, rr_ = pc_ / 24, sg_ = pc_ % 24; \
            if (pc_ < 68 * 24) *(LAS v4u*)(gb + G_RAW + rr_ * 384 + 16 * sg_) = rawn[k_]; } } while (0)
    v4u rawn[4];
    __syncthreads();
    for (int c = 0; c < SEQ / 64; ++c) {
        if (c > 0) GDN_WRITEOUT(c - 1);
        if (c == SEQ / 128) partner_sync(F, flags + 64 * unit, flags + 64 * (unit ^ 1));
        if (!(SKIP & 64) && wave == 0) {
            const int t = dir ? SEQ - 1 - 64 * c - lane : 64 * c + lane;
            const float a = Psm[(size_t)t * 32 + dir * 6 + h], bt = Psm[(size_t)t * 32 + 12 + dir * 6 + h];
            float x = al * softplusf_(a + dtb);
            x = wave_scan(x);
            const float last = lane63(x);
            sm[lane] = x; sm[64 + lane] = sigmoidf_(bt); sm[128 + lane] = __expf(x); sm[192 + lane] = __expf(last - x);
        }
        if (!(SKIP & 16)) { float acc[3][8];
#pragma unroll
          for (int tn = 0; tn < 3; ++tn)
#pragma unroll
              for (int j = 0; j < 8; ++j) acc[tn][j] = 0.f;
          const int rr0 = dir ? 63 - ci : ci;
#pragma unroll
          for (int tap = 0; tap < 5; ++tap) {
#pragma unroll
              for (int tn = 0; tn < 3; ++tn) { const v4u x0 = *(const LAS v4u*)(gb + G_RAW + (rr0 + tap) * 384 + tn * 128 + 16 * cg); const LAS float* w = cwl + tn * 320 + tap * 64 + 8 * cg; const f32x4 w0 = *(const LAS f32x4*)w, w1 = *(const LAS f32x4*)(w + 4);
                  acc[tn][0] += w0[0] * __uint_as_float(x0[0] << 16); acc[tn][1] += w0[1] * __uint_as_float(x0[0] & 0xffff0000u); acc[tn][2] += w0[2] * __uint_as_float(x0[1] << 16); acc[tn][3] += w0[3] * __uint_as_float(x0[1] & 0xffff0000u);
                  acc[tn][4] += w1[0] * __uint_as_float(x0[2] << 16); acc[tn][5] += w1[1] * __uint_as_float(x0[2] & 0xffff0000u); acc[tn][6] += w1[2] * __uint_as_float(x0[3] << 16); acc[tn][7] += w1[3] * __uint_as_float(x0[3] & 0xffff0000u); }
              asm volatile("" ::: "memory"); }
          float sq = 0.f, sk = 0.f;
#pragma unroll
          for (int j = 0; j < 8; ++j) { acc[0][j] = siluf(acc[0][j]); acc[1][j] = siluf(acc[1][j]); acc[2][j] = siluf(acc[2][j]); sq += acc[0][j] * acc[0][j]; sk += acc[1][j] * acc[1][j]; }
          sq += dpp_xor1(sq); sk += dpp_xor1(sk); sq += dpp_xor2(sq); sk += dpp_xor2(sk); sq += dpp_hmir(sq); sk += dpp_hmir(sk);
          const float rq = rsqrtf(sq + 1e-6f) * 0.125f, rk = rsqrtf(sk + 1e-6f);
          v4u wq, wk, wv;
#pragma unroll
          for (int q = 0; q < 4; ++q) { wq[q] = pg8::cvt_pk_bf16(acc[0][2 * q] * rq, acc[0][2 * q + 1] * rq); wk[q] = pg8::cvt_pk_bf16(acc[1][2 * q] * rk, acc[1][2 * q + 1] * rk); wv[q] = pg8::cvt_pk_bf16(acc[2][2 * q], acc[2][2 * q + 1]); }
          LAS unsigned char* row = gb + ci * GP + 16 * cg;
          *(LAS v4u*)(row + G_Q) = wq; *(LAS v4u*)(row + G_K) = wk; *(LAS v4u*)(row + G_V) = wv;
#pragma unroll
          for (int j = 0; j < 8; ++j) *(LAS bf16*)(gb + G_KT + (8 * cg + j) * GP + 2 * ci) = (bf16)((j & 1) ? (wk[j >> 1] >> 16) : (wk[j >> 1] & 0xffffu)); }
        __syncthreads();
        if (c + 1 < SEQ / 64) GDN_RAW_LOAD(c + 1);
        if (!(SKIP & 32)) { const int ti = (wave >> 1) & 1, tj = wave & 1, r32 = lane & 31, hi = lane >> 5;
          f32x16 acc = {};
          const LAS unsigned char* ir = gb + (wave >= 4 ? G_Q : G_K) + (32 * ti + r32) * GP + 16 * hi; const LAS unsigned char* jr = gb + G_K + (32 * tj + r32) * GP + 16 * hi;
#pragma unroll
          for (int s = 0; s < 4; ++s) acc = __builtin_amdgcn_mfma_f32_32x32x16_bf16(*(const LAS bf16x8*)(jr + 32 * s), *(const LAS bf16x8*)(ir + 32 * s), acc, 0, 0, 0);
          const int i = 32 * ti + r32; const float ci = sm[i];
          if (wave < 4) { const float bi = sm[64 + i];
#pragma unroll
              for (int g = 0; g < 4; ++g) { const int j0 = 32 * tj + 8 * g + 4 * hi; const f32x4 cj = *(const LAS f32x4*)(sm + j0); f32x4 o;
#pragma unroll
                  for (int r = 0; r < 4; ++r) o[r] = (i > j0 + r) ? bi * acc[4 * g + r] * __expf(fminf(ci - cj[r], 0.f)) : 0.f;
                  *(LAS f32x4*)((LAS float*)(gb + G_A) + i * 68 + j0) = o; } }
          else {
#pragma unroll
              for (int g = 0; g < 4; ++g) { const int j0 = 32 * tj + 8 * g + 4 * hi; const f32x4 cj = *(const LAS f32x4*)(sm + j0); h4_t o;
#pragma unroll
                  for (int r = 0; r < 4; ++r) o[r] = (_Float16)((i >= j0 + r) ? acc[4 * g + r] * __expf(fminf(ci - cj[r], 0.f)) : 0.f);
                  *(LAS h4_t*)(gb + G_P + i * GP + 2 * j0) = o; } } }
        __syncthreads();
        if (!(SKIP & 2) && wave == 0) {
            const int bb = lane >> 4, cc = lane & 15; float T[16];
            const LAS float* Ab = (const LAS float*)(gb + G_A) + (16 * bb) * 68 + 16 * bb;
#pragma unroll
            for (int i = 0; i < 16; ++i) { float a0 = 0.f, a1 = 0.f;
#pragma unroll
                for (int j4 = 0; j4 < (i + 3) / 4; ++j4) { const f32x4 av = *(const LAS f32x4*)(Ab + i * 68 + 4 * j4);
                    a0 += av.x * T[4 * j4] + av.z * T[4 * j4 + 2]; a1 += av.y * T[4 * j4 + 1] + av.w * T[4 * j4 + 3]; }
                T[i] = (i == cc ? 1.f : 0.f) - (a0 + a1);
                if (i < 15 && (i & 3) == 3) asm volatile("" ::: "memory");
                if (i == 0) {
#pragma unroll
                    for (int k = 1; k < 16; ++k) T[k] = 0.f; } }
#pragma unroll
            for (int i = 0; i < 16; ++i) ((LAS float*)(gb + G_T))[(16 * bb + i) * 16 + cc] = T[i];
        }
        __syncthreads();
        f32x4 Xc[4];
#pragma unroll
        for (int g = 0; g < 4; ++g) Xc[g] = (f32x4){0.f, 0.f, 0.f, 0.f};
        if (!(SKIP & 2)) {
            const int col = lane & 15, q4 = lane >> 4, c = 16 * wave + col;
            const LAS unsigned char* src = gb + (c < 64 ? G_V : G_K) + 2 * (c & 63);
            u64_t xh[4], xl[4];
#pragma unroll
            for (int bk = 0; bk < 4; ++bk) {
                f32x4 Y; const f32x4 be = *(const LAS f32x4*)(sm + 64 + 16 * bk + 4 * q4), ga = *(const LAS f32x4*)(sm + 128 + 16 * bk + 4 * q4);
#pragma unroll
                for (int r = 0; r < 4; ++r) Y[r] = bf2f(*(const LAS bf16*)(src + (16 * bk + 4 * q4 + r) * GP)) * be[r] * (c < 64 ? 1.f : ga[r]);
#pragma unroll
                for (int b2 = 0; b2 < bk; b2 += 2) {
                    const LAS float* ar = (const LAS float*)(gb + G_A) + (16 * bk + col) * 68 + 16 * b2 + 4 * q4;
                    f32x4 a0 = -*(const LAS f32x4*)ar, a1 = (b2 + 1 < bk) ? -*(const LAS f32x4*)(ar + 16) : (f32x4){0.f, 0.f, 0.f, 0.f};
                    u64_t ah0, al0, ah1, al1; hilo4(a0, ah0, al0); hilo4(a1, ah1, al1);
                    const u64_t bh1 = (b2 + 1 < bk) ? xh[b2 + 1] : 0ull, bl1 = (b2 + 1 < bk) ? xl[b2 + 1] : 0ull;
                    const bf16x8 Ah = mk_bf16x8(ah0, ah1), Al = mk_bf16x8(al0, al1), Bh = mk_bf16x8(xh[b2], bh1), Bl = mk_bf16x8(xl[b2], bl1);
                    Y = __builtin_amdgcn_mfma_f32_16x16x32_bf16(Al, Bh, Y, 0, 0, 0);
                    Y = __builtin_amdgcn_mfma_f32_16x16x32_bf16(Ah, Bl, Y, 0, 0, 0);
                    Y = __builtin_amdgcn_mfma_f32_16x16x32_bf16(Ah, Bh, Y, 0, 0, 0); }
                { const f32x4 t0 = *(const LAS f32x4*)((const LAS float*)(gb + G_T) + (16 * bk + col) * 16 + 4 * q4);
                  u64_t th, tl, yh, yl; hilo4(t0, th, tl); hilo4(Y, yh, yl);
                  const bf16x8 Ah = mk_bf16x8(th, 0ull), Al = mk_bf16x8(tl, 0ull), Bh = mk_bf16x8(yh, 0ull), Bl = mk_bf16x8(yl, 0ull);
                  f32x4 X = {0.f, 0.f, 0.f, 0.f};
                  X = __builtin_amdgcn_mfma_f32_16x16x32_bf16(Al, Bh, X, 0, 0, 0);
                  X = __builtin_amdgcn_mfma_f32_16x16x32_bf16(Ah, Bl, X, 0, 0, 0);
                  X = __builtin_amdgcn_mfma_f32_16x16x32_bf16(Ah, Bh, X, 0, 0, 0);
                  Xc[bk] = X; hilo4(X, xh[bk], xl[bk]); }
            }
        }
        __syncthreads();
        if (c + 1 < SEQ / 64) GDN_RAW_STORE();
        { const int col = lane & 15, q4 = lane >> 4, c = 16 * wave + col;
          if (wave < 4) {
#pragma unroll
              for (int g = 0; g < 4; ++g)
#pragma unroll
                  for (int r = 0; r < 4; ++r) ((LAS float*)(gb + G_A))[(16 * g + 4 * q4 + r) * 68 + c] = Xc[g][r];
          } else {
#pragma unroll
              for (int g = 0; g < 4; ++g)
#pragma unroll
                  for (int r = 0; r < 4; ++r) { const int i = 16 * g + 4 * q4 + r; const float x = -Xc[g][r]; const unsigned hb = f2bf(x);
                      *(LAS bf16*)(gb + G_V + i * GP + 2 * (c - 64)) = (bf16)hb;
                      *(LAS bf16*)(gb + G_K + i * GP + 2 * (c - 64)) = (bf16)f2bf(x - __uint_as_float(hb << 16)); }
          } }
        __syncthreads();
        if ((SKIP & 8) && wave < 4) {} else
        if (wave < 4) { const int col = lane & 15, q4 = lane >> 4, e = 16 * wave + col;
          bf16x8 bS0, bS1, bS0l, bS1l; split_acc(Sacc[0], Sacc[1], bS0, bS0l); split_acc(Sacc[2], Sacc[3], bS1, bS1l);
          f32x4 U[4], T1[4];
          const LAS unsigned char* rowa = gb + col * GP + 8 * q4;
#pragma unroll
          for (int it = 0; it < 4; ++it) {
              const LAS float* u0p = (const LAS float*)(gb + G_A) + (16 * it + 4 * q4) * 68 + e;
              U[it] = (f32x4){u0p[0], u0p[68], u0p[136], u0p[204]};
              const LAS unsigned char* ra = rowa + 16 * it * GP;
              const bf16x8 wh0 = ld2x8(ra + G_V), wh1 = ld2x8(ra + G_V + 64), wl0 = ld2x8(ra + G_K), wl1 = ld2x8(ra + G_K + 64), qa0 = ld2x8(ra + G_Q), qa1 = ld2x8(ra + G_Q + 64);
              U[it] = __builtin_amdgcn_mfma_f32_16x16x32_bf16(wl0, bS0, U[it], 0, 0, 0);
              U[it] = __builtin_amdgcn_mfma_f32_16x16x32_bf16(wl1, bS1, U[it], 0, 0, 0);
              U[it] = __builtin_amdgcn_mfma_f32_16x16x32_bf16(wh0, bS0l, U[it], 0, 0, 0);
              U[it] = __builtin_amdgcn_mfma_f32_16x16x32_bf16(wh1, bS1l, U[it], 0, 0, 0);
              U[it] = __builtin_amdgcn_mfma_f32_16x16x32_bf16(wh0, bS0, U[it], 0, 0, 0);
              U[it] = __builtin_amdgcn_mfma_f32_16x16x32_bf16(wh1, bS1, U[it], 0, 0, 0);
              T1[it] = __builtin_amdgcn_mfma_f32_16x16x32_bf16(qa0, bS0l, (f32x4){0.f, 0.f, 0.f, 0.f}, 0, 0, 0);
              T1[it] = __builtin_amdgcn_mfma_f32_16x16x32_bf16(qa1, bS1l, T1[it], 0, 0, 0);
              T1[it] = __builtin_amdgcn_mfma_f32_16x16x32_bf16(qa0, bS0, T1[it], 0, 0, 0);
              T1[it] = __builtin_amdgcn_mfma_f32_16x16x32_bf16(qa1, bS1, T1[it], 0, 0, 0);
              asm volatile("" ::: "memory");
          }
          const f16x8 hU0 = pack_acc_f16(U[0], U[1]), hU1 = pack_acc_f16(U[2], U[3]);
          f32x4 Ud[4];
#pragma unroll
          for (int it = 0; it < 4; ++it) { const f32x4 dc = *(const LAS f32x4*)(sm + 192 + 16 * it + 4 * q4); Ud[it] = U[it] * dc; }
          bf16x8 bD0, bD1, bD0l, bD1l; split_acc(Ud[0], Ud[1], bD0, bD0l); split_acc(Ud[2], Ud[3], bD1, bD1l);
          const float gend = sm[191];
#pragma unroll
          for (int it = 0; it < 4; ++it) {
              const LAS unsigned char* ra = rowa + 16 * it * GP;
              const f32x4 gm = *(const LAS f32x4*)(sm + 128 + 16 * it + 4 * q4);
              const bf16x8 pa0 = ld2x8(ra + G_P), pa1 = ld2x8(ra + G_P + 64), ka0 = ld2x8(ra + G_KT), ka1 = ld2x8(ra + G_KT + 64);
              f32x4 O = T1[it] * gm;
              O = __builtin_amdgcn_mfma_f32_16x16x32_f16(__builtin_bit_cast(f16x8, pa0), hU0, O, 0, 0, 0);
              O = __builtin_amdgcn_mfma_f32_16x16x32_f16(__builtin_bit_cast(f16x8, pa1), hU1, O, 0, 0, 0);
              f32x4 Sn = Sacc[it] * gend;
              Sn = __builtin_amdgcn_mfma_f32_16x16x32_bf16(ka0, bD0l, Sn, 0, 0, 0);
              Sn = __builtin_amdgcn_mfma_f32_16x16x32_bf16(ka1, bD1l, Sn, 0, 0, 0);
              Sn = __builtin_amdgcn_mfma_f32_16x16x32_bf16(ka0, bD0, Sn, 0, 0, 0);
              Sn = __builtin_amdgcn_mfma_f32_16x16x32_bf16(ka1, bD1, Sn, 0, 0, 0);
              Sacc[it] = Sn;
#pragma unroll
              for (int r = 0; r < 4; ++r) ((LAS float*)(gb + G_A))[(16 * it + 4 * q4 + r) * 68 + e] = O[r];
              asm volatile("" ::: "memory");
          } }
        __syncthreads();
    }
    GDN_WRITEOUT(SEQ / 64 - 1);
#undef GDN_WRITEOUT
#undef GDN_RAW_STAGE
#undef GDN_RAW_LOAD
#undef GDN_RAW_STORE
    __syncthreads();
}

constexpr int RC_AT = 0, RC_RT = 9216, RC_BT = 18432, RC_KT = 27648, RC_BH = 36864, RC_KH = 46080, RC_VT = 55296, RC_V = 64512, RC_A = 73728  ,
              RC_AK = 91136, RC_RB = 100352, RC_RK = 109568, RC_T = 118784  , RC_SM = 122880  , RC_R2 = RC_BT  ;
static_assert(RC_SM + 256 <= RING_BYTES && RC_R2 + 17408 <= RC_BH, "chunked RWKV LDS map");
template <int SK> __device__ __forceinline__ void rwkv_unit_c(Frame& F, int unit, gu32* flags) {
    const int bh = unit >> 1, dir = unit & 1, b = bh >> 2, h = bh & 3;
    const int tid = F.tid, lane = F.lane, wave = F.wave;
    const unsigned char* Rs = F.ws + WS_RS;
    const unsigned char* Rd = F.ws + WS_RD + dir * RD_DIR;
    bf16* Yg = (bf16*)(F.ws + WS_Y + (SK ? 8 * MiB : 0)) + (size_t)b * SEQ * 256 + h * 64;
    LAS unsigned char* gb = F.lds + RING_OFF;
    LAS float* gamT = (LAS float*)(gb + RC_SM);
    f32x4 Zacc[4];
#pragma unroll
    for (int i = 0; i < 4; ++i) Zacc[i] = (f32x4){0.f, 0.f, 0.f, 0.f};
    const int ci = tid >> 3, cg = tid & 7;
#define RC_WRITEOUT(cc_) do { const int t_ = dir ? SEQ - 1 - 64 * (cc_) - ci : 64 * (cc_) + ci; bf16* op_ = Yg + (size_t)t_ * 256 + 8 * cg; \
        const LAS f32x4* src_ = (const LAS f32x4*)(gb + RC_A + (ci * 68 + 8 * cg) * 4); f32x4 o0_ = src_[0], o1_ = src_[1]; \
        if ((cc_) >= SEQ / 128) { const v4u p0_ = *(const v4u*)op_; \
            o0_ += (f32x4){__uint_as_float(p0_.x << 16), __uint_as_float(p0_.x & 0xffff0000u), __uint_as_float(p0_.y << 16), __uint_as_float(p0_.y & 0xffff0000u)}; \
            o1_ += (f32x4){__uint_as_float(p0_.z << 16), __uint_as_float(p0_.z & 0xffff0000u), __uint_as_float(p0_.w << 16), __uint_as_float(p0_.w & 0xffff0000u)}; } \
        v4u w0_; w0_.x = pg8::cvt_pk_bf16(o0_[0], o0_[1]); w0_.y = pg8::cvt_pk_bf16(o0_[2], o0_[3]); w0_.z = pg8::cvt_pk_bf16(o1_[0], o1_[1]); w0_.w = pg8::cvt_pk_bf16(o1_[2], o1_[3]); \
        *(v4u*)op_ = w0_; } while (0)
    v4u gkk = {0u, 0u, 0u, 0u}, gv = gkk, gr = gkk, glam = gkk, gbv = gkk, gk = gkk;
#define RC_LOAD(cc_) do { if (!(SK & 1)) { const size_t o_ = rw_rec_off(bh, dir ? SEQ - 1 - 64 * (cc_) - lane : 64 * (cc_) + lane, 0, wave); const unsigned char* rs_ = Rs + o_; const unsigned char* rd_ = Rd + o_; \
        gkk = *(const v4u*)rs_; gv = *(const v4u*)(rs_ + 8192); gr = *(const v4u*)(rs_ + 16384); glam = *(const v4u*)rd_; gbv = *(const v4u*)(rd_ + 8192); gk = *(const v4u*)(rd_ + 16384); } } while (0)
    RC_LOAD(0);
    __syncthreads();
    for (int c = 0; c < SEQ / 64; ++c) {
        if (c > 0) RC_WRITEOUT(c - 1);
        if (c == SEQ / 128) partner_sync(F, flags + 64 * unit, flags + 64 * (unit ^ 1));
        if (!(SK & 32)) { const int t = lane, tok = dir ? SEQ - 1 - 64 * c - t : 64 * c + t, j0 = 8 * wave;
          float lam[8], cum[8];
#pragma unroll
          for (int q = 0; q < 4; ++q) { lam[2 * q] = __half2float(__ushort_as_half((unsigned short)(glam[q] & 0xffffu))); lam[2 * q + 1] = __half2float(__ushort_as_half((unsigned short)(glam[q] >> 16))); }
#pragma unroll
          for (int q = 0; q < 8; ++q) cum[q] = wave_scan(lam[q]);
          v4u wa = {0u, 0u, 0u, 0u}, wr = {0u, 0u, 0u, 0u}, wb = {0u, 0u, 0u, 0u}, wk = {0u, 0u, 0u, 0u}; unsigned short bh_[8], kh_[8];
#pragma unroll
          for (int q = 0; q < 8; ++q) { const float cT = lane63(cum[q]);
              const float e1 = __builtin_amdgcn_exp2f(-LOG2E * (cum[q] - lam[q])), e2 = __builtin_amdgcn_exp2f(-LOG2E * cum[q]), e3 = __builtin_amdgcn_exp2f(LOG2E * cum[q]), e4 = __builtin_amdgcn_exp2f(-LOG2E * (cT - cum[q]));
              const float kkq = __uint_as_float((q & 1) ? (gkk[q >> 1] & 0xffff0000u) : (gkk[q >> 1] << 16)), rq = __uint_as_float((q & 1) ? (gr[q >> 1] & 0xffff0000u) : (gr[q >> 1] << 16));
              const float bq = __uint_as_float((q & 1) ? (gbv[q >> 1] & 0xffff0000u) : (gbv[q >> 1] << 16)), kq = __uint_as_float((q & 1) ? (gk[q >> 1] & 0xffff0000u) : (gk[q >> 1] << 16));
              const unsigned a16 = f2bf(-kkq * e1), r16 = f2bf(rq * e2), b16 = f2bf(bq * e3), k16 = f2bf(kq * e3);
              if (q & 1) { wa[q >> 1] |= a16 << 16; wr[q >> 1] |= r16 << 16; wb[q >> 1] |= b16 << 16; wk[q >> 1] |= k16 << 16; } else { wa[q >> 1] = a16; wr[q >> 1] = r16; wb[q >> 1] = b16; wk[q >> 1] = k16; }
              bh_[q] = (unsigned short)f2bf(bq * e4); kh_[q] = (unsigned short)f2bf(kq * e4);
              if (lane == 63) gamT[j0 + q] = e2; }
          LAS unsigned char* row = gb + t * GP + 2 * j0;
          *(LAS v4u*)(row + RC_AT) = wa; *(LAS v4u*)(row + RC_RT) = wr; *(LAS v4u*)(row + RC_BT) = wb; *(LAS v4u*)(row + RC_KT) = wk; *(LAS v4u*)(row + RC_V) = gv;
#pragma unroll
          for (int q = 0; q < 8; ++q) { LAS unsigned char* tr = gb + (j0 + q) * GP + 2 * t;
              *(LAS bf16*)(tr + RC_BH) = bh_[q]; *(LAS bf16*)(tr + RC_KH) = kh_[q];
              *(LAS bf16*)(tr + RC_VT) = (bf16)((q & 1) ? (gv[q >> 1] >> 16) : (gv[q >> 1] & 0xffffu)); } }
        __syncthreads();
        if (c + 1 < SEQ / 64) RC_LOAD(c + 1);
        if (!(SK & 2)) { const int rb = wave >> 1, r32 = lane & 31, hi = lane >> 5;
          const LAS unsigned char* xr = gb + (rb < 2 ? RC_AT : RC_RT) + (32 * (rb & 1) + r32) * GP + 16 * hi; const int tt = 32 * (rb & 1) + r32;
#pragma unroll
          for (int k2 = 0; k2 < 2; ++k2) { const int cb = 2 * (wave & 1) + k2;
              const LAS unsigned char* yr = gb + (cb < 2 ? RC_BT : RC_KT) + (32 * (cb & 1) + r32) * GP + 16 * hi;
              f32x16 acc = {};
#pragma unroll
              for (int s = 0; s < 4; ++s) acc = __builtin_amdgcn_mfma_f32_32x32x16_bf16(*(const LAS bf16x8*)(yr + 32 * s), *(const LAS bf16x8*)(xr + 32 * s), acc, 0, 0, 0);
              if (rb < 2 && cb < 2) {
#pragma unroll
                  for (int g = 0; g < 4; ++g) { const int s0 = 32 * (cb & 1) + 8 * g + 4 * hi; f32x4 o;
#pragma unroll
                      for (int r = 0; r < 4; ++r) o[r] = (tt > s0 + r) ? -acc[4 * g + r] : 0.f;
                      *(LAS f32x4*)((LAS float*)(gb + RC_A) + tt * 68 + s0) = o; } }
              else { const int incl = rb >= 2 ? 1 : 0; LAS unsigned char* dst = gb + (rb < 2 ? RC_AK : (cb < 2 ? RC_RB : RC_RK)) + tt * GP;
#pragma unroll
                  for (int g = 0; g < 4; ++g) { const int s0 = 32 * (cb & 1) + 8 * g + 4 * hi; f32x4 o;
#pragma unroll
                      for (int r = 0; r < 4; ++r) o[r] = (tt + incl > s0 + r) ? acc[4 * g + r] : 0.f;
                      *(LAS u64_t*)(dst + 2 * s0) = (u64_t)pg8::cvt_pk_bf16(o[0], o[1]) | ((u64_t)pg8::cvt_pk_bf16(o[2], o[3]) << 32); } } } }
        __syncthreads();
        if (!(SK & 4)) { const int col = lane & 15, q4 = lane >> 4, it = wave >> 1;
#pragma unroll
          for (int k2 = 0; k2 < 2; ++k2) { const int ct = 2 * (wave & 1) + k2; f32x4 acc = {0.f, 0.f, 0.f, 0.f};
              const LAS unsigned char* pa = gb + RC_AK + (16 * it + col) * GP + 8 * q4; const LAS unsigned char* pb = gb + RC_VT + (16 * ct + col) * GP + 8 * q4;
              acc = __builtin_amdgcn_mfma_f32_16x16x32_bf16(ld2x8(pa), ld2x8(pb), acc, 0, 0, 0);
              acc = __builtin_amdgcn_mfma_f32_16x16x32_bf16(ld2x8(pa + 64), ld2x8(pb + 64), acc, 0, 0, 0);
#pragma unroll
              for (int r = 0; r < 4; ++r) ((LAS float*)(gb + RC_R2))[(16 * it + 4 * q4 + r) * 68 + 16 * ct + col] = acc[r]; } }
        if (!(SK & 4) && wave == 0) {
            const int bb = lane >> 4, cc = lane & 15; float T[16];
            const LAS float* Ab = (const LAS float*)(gb + RC_A) + (16 * bb) * 68 + 16 * bb;
#pragma unroll
            for (int i = 0; i < 16; ++i) { float a0 = 0.f, a1 = 0.f;
#pragma unroll
                for (int j4 = 0; j4 < (i + 3) / 4; ++j4) { const f32x4 av = *(const LAS f32x4*)(Ab + i * 68 + 4 * j4);
                    a0 += av.x * T[4 * j4] + av.z * T[4 * j4 + 2]; a1 += av.y * T[4 * j4 + 1] + av.w * T[4 * j4 + 3]; }
                T[i] = (i == cc ? 1.f : 0.f) - (a0 + a1);
                if (i < 15 && (i & 3) == 3) asm volatile("" ::: "memory");
                if (i == 0) {
#pragma unroll
                    for (int k = 1; k < 16; ++k) T[k] = 0.f; } }
#pragma unroll
            for (int i = 0; i < 16; ++i) ((LAS float*)(gb + RC_T))[(16 * bb + i) * 16 + cc] = T[i];
        }
        __syncthreads();
        f32x4 Xc[4];
#pragma unroll
        for (int g = 0; g < 4; ++g) Xc[g] = (f32x4){0.f, 0.f, 0.f, 0.f};
        if (!(SK & 8)) { const int col = lane & 15, q4 = lane >> 4, cidx = 16 * wave + col;
          u64_t xh[4], xl[4]; f32x4 Yin[4];
          if (wave < 4) {
#pragma unroll
              for (int bk = 0; bk < 4; ++bk)
#pragma unroll
                  for (int r = 0; r < 4; ++r) Yin[bk][r] = bf2f(*(const LAS bf16*)(gb + RC_AT + (16 * bk + 4 * q4 + r) * GP + 2 * cidx));
          } else {
#pragma unroll
              for (int bk = 0; bk < 4; ++bk)
#pragma unroll
                  for (int r = 0; r < 4; ++r) Yin[bk][r] = ((const LAS float*)(gb + RC_R2))[(16 * bk + 4 * q4 + r) * 68 + (cidx - 64)];
          }
#pragma unroll
          for (int bk = 0; bk < 4; ++bk) {
              f32x4 Y = Yin[bk];
#pragma unroll
              for (int b2 = 0; b2 < bk; b2 += 2) {
                  const LAS float* ar = (const LAS float*)(gb + RC_A) + (16 * bk + col) * 68 + 16 * b2 + 4 * q4;
                  f32x4 a0 = -*(const LAS f32x4*)ar, a1 = (b2 + 1 < bk) ? -*(const LAS f32x4*)(ar + 16) : (f32x4){0.f, 0.f, 0.f, 0.f};
                  u64_t ah0, al0, ah1, al1; hilo4(a0, ah0, al0); hilo4(a1, ah1, al1);
                  const u64_t bh1 = (b2 + 1 < bk) ? xh[b2 + 1] : 0ull, bl1 = (b2 + 1 < bk) ? xl[b2 + 1] : 0ull;
                  const bf16x8 Ah = mk_bf16x8(ah0, ah1), Al = mk_bf16x8(al0, al1), Bh = mk_bf16x8(xh[b2], bh1), Bl = mk_bf16x8(xl[b2], bl1);
                  Y = __builtin_amdgcn_mfma_f32_16x16x32_bf16(Al, Bh, Y, 0, 0, 0);
                  Y = __builtin_amdgcn_mfma_f32_16x16x32_bf16(Ah, Bl, Y, 0, 0, 0);
                  Y = __builtin_amdgcn_mfma_f32_16x16x32_bf16(Ah, Bh, Y, 0, 0, 0); }
              { const f32x4 t0 = *(const LAS f32x4*)((const LAS float*)(gb + RC_T) + (16 * bk + col) * 16 + 4 * q4);
                u64_t th, tl, yh, yl; hilo4(t0, th, tl); hilo4(Y, yh, yl);
                const bf16x8 Ah = mk_bf16x8(th, 0ull), Al = mk_bf16x8(tl, 0ull), Bh = mk_bf16x8(yh, 0ull), Bl = mk_bf16x8(yl, 0ull);
                f32x4 X = {0.f, 0.f, 0.f, 0.f};
                X = __builtin_amdgcn_mfma_f32_16x16x32_bf16(Al, Bh, X, 0, 0, 0);
                X = __builtin_amdgcn_mfma_f32_16x16x32_bf16(Ah, Bl, X, 0, 0, 0);
                X = __builtin_amdgcn_mfma_f32_16x16x32_bf16(Ah, Bh, X, 0, 0, 0);
                Xc[bk] = X; hilo4(X, xh[bk], xl[bk]); }
          } }
        __syncthreads();
        { const int col = lane & 15, q4 = lane >> 4, cidx = 16 * wave + col;
          if (wave < 4) {
#pragma unroll
              for (int g = 0; g < 4; ++g)
#pragma unroll
                  for (int r = 0; r < 4; ++r) { const int i = 16 * g + 4 * q4 + r; const float x = Xc[g][r]; const unsigned hb = f2bf(x);
                      *(LAS bf16*)(gb + RC_AT + i * GP + 2 * cidx) = (bf16)hb; *(LAS bf16*)(gb + RC_AK + i * GP + 2 * cidx) = (bf16)f2bf(x - __uint_as_float(hb << 16)); }
          } else {
#pragma unroll
              for (int g = 0; g < 4; ++g)
#pragma unroll
                  for (int r = 0; r < 4; ++r) ((LAS float*)(gb + RC_A))[(16 * g + 4 * q4 + r) * 68 + (cidx - 64)] = Xc[g][r];
          } }
        __syncthreads();
        if (!(SK & 16) && wave < 4) { const int col = lane & 15, q4 = lane >> 4, e = 16 * wave + col;
          bf16x8 bZ0, bZ1, bZ0l, bZ1l; split_acc(Zacc[0], Zacc[1], bZ0, bZ0l); split_acc(Zacc[2], Zacc[3], bZ1, bZ1l);
          f32x4 U[4], Yo[4], Vc[4];
          const LAS unsigned char* rowa = gb + col * GP + 8 * q4;
#pragma unroll
          for (int it = 0; it < 4; ++it) {
              const LAS float* u0p = (const LAS float*)(gb + RC_A) + (16 * it + 4 * q4) * 68 + e;
              U[it] = (f32x4){u0p[0], u0p[68], u0p[136], u0p[204]};
#pragma unroll
              for (int r = 0; r < 4; ++r) Vc[it][r] = bf2f(*(const LAS bf16*)(gb + RC_V + (16 * it + 4 * q4 + r) * GP + 2 * e));
              const LAS unsigned char* ra = rowa + 16 * it * GP;
              const bf16x8 wh0 = ld2x8(ra + RC_AT), wh1 = ld2x8(ra + RC_AT + 64), wl0 = ld2x8(ra + RC_AK), wl1 = ld2x8(ra + RC_AK + 64), qa0 = ld2x8(ra + RC_RT), qa1 = ld2x8(ra + RC_RT + 64);
              U[it] = __builtin_amdgcn_mfma_f32_16x16x32_bf16(wl0, bZ0, U[it], 0, 0, 0);
              U[it] = __builtin_amdgcn_mfma_f32_16x16x32_bf16(wl1, bZ1, U[it], 0, 0, 0);
              U[it] = __builtin_amdgcn_mfma_f32_16x16x32_bf16(wh0, bZ0l, U[it], 0, 0, 0);
              U[it] = __builtin_amdgcn_mfma_f32_16x16x32_bf16(wh1, bZ1l, U[it], 0, 0, 0);
              U[it] = __builtin_amdgcn_mfma_f32_16x16x32_bf16(wh0, bZ0, U[it], 0, 0, 0);
              U[it] = __builtin_amdgcn_mfma_f32_16x16x32_bf16(wh1, bZ1, U[it], 0, 0, 0);
              Yo[it] = __builtin_amdgcn_mfma_f32_16x16x32_bf16(qa0, bZ0l, (f32x4){0.f, 0.f, 0.f, 0.f}, 0, 0, 0);
              Yo[it] = __builtin_amdgcn_mfma_f32_16x16x32_bf16(qa1, bZ1l, Yo[it], 0, 0, 0);
              Yo[it] = __builtin_amdgcn_mfma_f32_16x16x32_bf16(qa0, bZ0, Yo[it], 0, 0, 0);
              Yo[it] = __builtin_amdgcn_mfma_f32_16x16x32_bf16(qa1, bZ1, Yo[it], 0, 0, 0);
              asm volatile("" ::: "memory");
          }
          bf16x8 bU0, bU1, bU0l, bU1l; split_acc(U[0], U[1], bU0, bU0l); split_acc(U[2], U[3], bU1, bU1l);
          const bf16x8 bV0 = pack_acc(Vc[0], Vc[1]), bV1 = pack_acc(Vc[2], Vc[3]);
#pragma unroll
          for (int it = 0; it < 4; ++it) {
              const LAS unsigned char* ra = rowa + 16 * it * GP;
              const bf16x8 pb0 = ld2x8(ra + RC_RB), pb1 = ld2x8(ra + RC_RB + 64), pk0 = ld2x8(ra + RC_RK), pk1 = ld2x8(ra + RC_RK + 64);
              const bf16x8 hb0 = ld2x8(ra + RC_BH), hb1 = ld2x8(ra + RC_BH + 64), hk0 = ld2x8(ra + RC_KH), hk1 = ld2x8(ra + RC_KH + 64);
              f32x4 O = Yo[it];
              O = __builtin_amdgcn_mfma_f32_16x16x32_bf16(pb0, bU0l, O, 0, 0, 0);
              O = __builtin_amdgcn_mfma_f32_16x16x32_bf16(pb1, bU1l, O, 0, 0, 0);
              O = __builtin_amdgcn_mfma_f32_16x16x32_bf16(pk0, bV0, O, 0, 0, 0);
              O = __builtin_amdgcn_mfma_f32_16x16x32_bf16(pk1, bV1, O, 0, 0, 0);
              O = __builtin_amdgcn_mfma_f32_16x16x32_bf16(pb0, bU0, O, 0, 0, 0);
              O = __builtin_amdgcn_mfma_f32_16x16x32_bf16(pb1, bU1, O, 0, 0, 0);
              const f32x4 gz = *(const LAS f32x4*)(gamT + 16 * it + 4 * q4);
              f32x4 Zn = Zacc[it] * gz;
              Zn = __builtin_amdgcn_mfma_f32_16x16x32_bf16(hb0, bU0l, Zn, 0, 0, 0);
              Zn = __builtin_amdgcn_mfma_f32_16x16x32_bf16(hb1, bU1l, Zn, 0, 0, 0);
              Zn = __builtin_amdgcn_mfma_f32_16x16x32_bf16(hk0, bV0, Zn, 0, 0, 0);
              Zn = __builtin_amdgcn_mfma_f32_16x16x32_bf16(hk1, bV1, Zn, 0, 0, 0);
              Zn = __builtin_amdgcn_mfma_f32_16x16x32_bf16(hb0, bU0, Zn, 0, 0, 0);
              Zn = __builtin_amdgcn_mfma_f32_16x16x32_bf16(hb1, bU1, Zn, 0, 0, 0);
              Zacc[it] = Zn;
#pragma unroll
              for (int r = 0; r < 4; ++r) ((LAS float*)(gb + RC_A))[(16 * it + 4 * q4 + r) * 68 + e] = O[r];
              asm volatile("" ::: "memory");
          } }
        __syncthreads();
    }
    RC_WRITEOUT(SEQ / 64 - 1);
#undef RC_WRITEOUT
#undef RC_LOAD
    __syncthreads();
}
__device__ __forceinline__ int next_unit(Frame& F, gu32* head) {
    __syncthreads();
    if (F.tid == 0) F.MISC[16] = __hip_atomic_fetch_add(head, 1u, RLX_AGENT);
    __syncthreads();
    return (int)F.MISC[16];
}
constexpr int U_GDN = 96, U_RWKV = 64, U_ATT = 384, U_ALL = U_GDN + U_RWKV + U_ATT;
template <int DUMMY> __device__ __forceinline__ void p3_mixers(Frame& F, int l, int rep) {
    gu32* head = F.ctl + CW_QUEUE + 64 * (2 * l + rep);
    for (;;) {
        const int u = next_unit(F, head);
        if (u >= U_ALL) break;
        asm volatile("" : "+v"(F.tid), "+v"(F.lane));
        if (u < U_GDN) {
#ifdef EXP_GDN
            gdn_unit3<EXP_GDN>(F, l, u, F.ctl + CW_FLAG + 64 * 256 * (4 + 2 * l + rep) + 64 * 128); asm volatile("" : "+v"(F.tid), "+v"(F.lane));
#endif
            gdn_unit3<DUMMY ? 128 : 0>(F, l, u, F.ctl + CW_FLAG + 64 * 256 * (2 * l + rep) + 64 * 128); }
        else if (u < U_GDN + U_RWKV) {
#ifdef EXP_RWKV
            rwkv_unit_c<EXP_RWKV>(F, u - U_GDN, F.ctl + CW_FLAG + 64 * 256 * (4 + 2 * l + rep)); asm volatile("" : "+v"(F.tid), "+v"(F.lane));
#endif
            rwkv_unit_c<DUMMY ? 64 : 0>(F, u - U_GDN, F.ctl + CW_FLAG + 64 * 256 * (2 * l + rep)); }
        else {
#ifdef EXP_ATT
            attn_unit(F, u - U_GDN - U_RWKV); asm volatile("" : "+v"(F.tid), "+v"(F.lane));
#endif
            attn_unit(F, u - U_GDN - U_RWKV); }
    }
}
__device__ __forceinline__ f32x4 bf4(u64_t x) { return (f32x4){__uint_as_float(((unsigned)x) << 16), __uint_as_float(((unsigned)x) & 0xffff0000u), __uint_as_float(((unsigned)(x >> 32)) << 16), __uint_as_float(((unsigned)(x >> 32)) & 0xffff0000u)}; }
__device__ __forceinline__ u64_t pk4(const f32x4& v) { return (u64_t)pg8::cvt_pk_bf16(v[0], v[1]) | ((u64_t)pg8::cvt_pk_bf16(v[2], v[3]) << 32); }
__device__ __forceinline__ void p2_mla_unit(Frame& F, int l, int unit) {
    const int lane = F.lane, col = lane & 15, q4 = lane >> 4, m = 16 * unit + col, b = m / SEQ, t = m % SEQ, t0 = (16 * unit) % SEQ;
    const bf16* prow = (const bf16*)(F.ws + WS_PMLA) + (size_t)m * 352;
    const bf16* WuqT = (const bf16*)(F.ws + WS_WSMALL + OFF_WUQ) + (size_t)l * 576 * 192 + (size_t)col * 192 + 8 * q4;
    const bf16* WukvT = (const bf16*)(F.ws + WS_WSMALL + OFF_WUKV) + (size_t)l * 768 * 128 + (size_t)col * 128 + 8 * q4;
    bf16x8 aq[6], akv[4]; float sq = 0.f, skv = 0.f;
#pragma unroll
    for (int s = 0; s < 6; ++s) { aq[s] = *(const bf16x8*)(prow + 32 * s + 8 * q4); const v4u u = __builtin_bit_cast(v4u, aq[s]);
#pragma unroll
        for (int i = 0; i < 4; ++i) { const float a = __uint_as_float(u[i] << 16), c = __uint_as_float(u[i] & 0xffff0000u); sq += a * a + c * c; } }
#pragma unroll
    for (int s = 0; s < 4; ++s) { akv[s] = *(const bf16x8*)(prow + 192 + 32 * s + 8 * q4); const v4u u = __builtin_bit_cast(v4u, akv[s]);
#pragma unroll
        for (int i = 0; i < 4; ++i) { const float a = __uint_as_float(u[i] << 16), c = __uint_as_float(u[i] & 0xffff0000u); skv += a * a + c * c; } }
    sq += __shfl_xor(sq, 16); sq += __shfl_xor(sq, 32); skv += __shfl_xor(skv, 16); skv += __shfl_xor(skv, 32);
    const float rq = rsqrtf(sq * (1.f / 192.f) + NORM_EPS) * (0.10206207261596575f * LOG2E), rkv = rsqrtf(skv * (1.f / 128.f) + NORM_EPS);
    const float pos = (float)((const int*)inptr(F, 1))[m];
    f32x4 cs, sn;
#pragma unroll
    for (int r = 0; r < 4; ++r) { const float inv = exp2f(-(float)(4 * q4 + r) * (13.287712379549449f / 16.f)); float s_, c_; sincosf(pos * inv, &s_, &c_); cs[r] = c_; sn[r] = s_; }
    bf16* Qo = (bf16*)(F.ws + WS_Q) + ((size_t)b * 6 * SEQ + t) * 96 + 4 * q4;
    bf16* Ko = (bf16*)(F.ws + WS_K) + ((size_t)b * 6 * SEQ + t) * 96 + 4 * q4;
    bf16* Vo = (bf16*)(F.ws + WS_VT) + (size_t)b * 6 * 64 * SEQ + (size_t)col * SEQ + t0 + 4 * q4;
    { const u64_t x1 = *(const u64_t*)(prow + 320 + 4 * q4), x2 = *(const u64_t*)(prow + 336 + 4 * q4); const f32x4 a = bf4(x1), c = bf4(x2);
      const u64_t o1 = pk4(a * cs - c * sn), o2 = pk4(c * cs + a * sn);
#pragma unroll
      for (int h = 0; h < 6; ++h) { *(u64_t*)(Ko + (size_t)h * SEQ * 96 + 64) = o1; *(u64_t*)(Ko + (size_t)h * SEQ * 96 + 80) = o2; } }
#pragma unroll 2
    for (int h = 0; h < 6; ++h) {
        f32x4 x1v = {0.f, 0.f, 0.f, 0.f};
#pragma unroll
        for (int nt = 0; nt < 6; ++nt) {
            const bf16* w = WuqT + (size_t)(h * 96 + 16 * nt) * 192; f32x4 acc = {0.f, 0.f, 0.f, 0.f};
#pragma unroll
            for (int s = 0; s < 6; ++s) acc = __builtin_amdgcn_mfma_f32_16x16x32_bf16(*(const bf16x8*)(w + 32 * s), aq[s], acc, 0, 0, 0);
            acc = acc * rq;
            if (nt < 4) *(u64_t*)(Qo + (size_t)h * SEQ * 96 + 16 * nt) = pk4(acc);
            else if (nt == 4) x1v = acc;
            else { *(u64_t*)(Qo + (size_t)h * SEQ * 96 + 64) = pk4(x1v * cs - acc * sn); *(u64_t*)(Qo + (size_t)h * SEQ * 96 + 80) = pk4(acc * cs + x1v * sn); }
        }
#pragma unroll
        for (int nt = 0; nt < 4; ++nt) {
            const bf16* w = WukvT + (size_t)(h * 128 + 16 * nt) * 128; f32x4 acc = {0.f, 0.f, 0.f, 0.f};
#pragma unroll
            for (int s = 0; s < 4; ++s) acc = __builtin_amdgcn_mfma_f32_16x16x32_bf16(*(const bf16x8*)(w + 32 * s), akv[s], acc, 0, 0, 0);
            *(u64_t*)(Ko + (size_t)h * SEQ * 96 + 16 * nt) = pk4(acc * rkv);
        }
        f32x4 rk4;
#pragma unroll
        for (int r = 0; r < 4; ++r) rk4[r] = __shfl(rkv, 4 * q4 + r);
#pragma unroll
        for (int nt = 0; nt < 4; ++nt) {
            const bf16* w = WukvT + (size_t)(h * 128 + 64 + 16 * nt) * 128; f32x4 acc = {0.f, 0.f, 0.f, 0.f};
#pragma unroll
            for (int s = 0; s < 4; ++s) acc = __builtin_amdgcn_mfma_f32_16x16x32_bf16(akv[s], *(const bf16x8*)(w + 32 * s), acc, 0, 0, 0);
            *(u64_t*)(Vo + (size_t)(h * 64 + 16 * nt) * SEQ) = pk4(acc * rk4);
        }
    }
}
__device__ __forceinline__ f32x4 rw_shift4(const bf16* P, size_t m, int c, bool hp, bool hn, const float* mu) {
    const f32x4 x = bf4(*(const u64_t*)(P + m * 896 + c)), xp = hp ? bf4(*(const u64_t*)(P + (m - 1) * 896 + c)) : (f32x4){0.f, 0.f, 0.f, 0.f}, xn = hn ? bf4(*(const u64_t*)(P + (m + 1) * 896 + c)) : (f32x4){0.f, 0.f, 0.f, 0.f};
    const f32x4 m0 = *(const f32x4*)(mu + c), m1 = *(const f32x4*)(mu + 896 + c);
    return x + m0 * (xp - x) + m1 * (xn - x);
}
__device__ __forceinline__ void p2_rwkv_unit(Frame& F, int l, int unit, int h0, int h1) {
    const int lane = F.lane, col = lane & 15, q4 = lane >> 4, b = (16 * unit) / SEQ, t = (16 * unit) % SEQ + col; const size_t m = (size_t)16 * unit + col;
    const bool hp = t > 0, hn = t < SEQ - 1;
    const bf16* Prw = (const bf16*)(F.ws + WS_PRW);
    const float* mu = (const float*)inptr(F, 12) + l * 2 * 896;
    const bf16* W2T = (const bf16*)(F.ws + WS_WSMALL + OFF_W2T) + (size_t)l * 2 * 256 * 64 + (size_t)col * 64 + 8 * q4;
    const bf16* A2T = (const bf16*)(F.ws + WS_WSMALL + OFF_A2T) + (size_t)l * 2 * 256 * 64 + (size_t)col * 64 + 8 * q4;
    bf16x8 awd[2], aad[2];
#pragma unroll
    for (int s = 0; s < 2; ++s) { const int c = 768 + 32 * s + 8 * q4;
        f32x4 lo = rw_shift4(Prw, m, c, hp, hn, mu), hi = rw_shift4(Prw, m, c + 4, hp, hn, mu);
#pragma unroll
        for (int i = 0; i < 4; ++i) { lo[i] = 1.f - 2.f * __builtin_amdgcn_rcpf(1.f + __expf(2.f * lo[i])); hi[i] = 1.f - 2.f * __builtin_amdgcn_rcpf(1.f + __expf(2.f * hi[i])); }
        awd[s] = pack_acc(lo, hi);
        aad[s] = pack_acc(rw_shift4(Prw, m, c + 64, hp, hn, mu), rw_shift4(Prw, m, c + 68, hp, hn, mu)); }
#pragma unroll 1
    for (int h = h0; h < h1; ++h) {
        f32x4 k[4]; float kn = 0.f;
        { const float* k_k = (const float*)inptr(F, 17) + l * 256;
#pragma unroll
          for (int nt = 0; nt < 4; ++nt) { const int c = 64 * h + 16 * nt + 4 * q4; k[nt] = rw_shift4(Prw, m, 256 + c, hp, hn, mu);
              const f32x4 x = k[nt] * *(const f32x4*)(k_k + c); kn += (x[0] * x[0] + x[1] * x[1]) + (x[2] * x[2] + x[3] * x[3]); } }
        kn += __shfl_xor(kn, 16); kn += __shfl_xor(kn, 32);
        const float rkn = rsqrtf(kn + 1e-6f);
        float cbv = 0.f;
        const size_t ro = rw_rec_off(b * 4 + h, t, 0, q4 >> 1) + 8 * (q4 & 1);
        unsigned char* rs = F.ws + WS_RS + ro;
        unsigned char* rd0 = F.ws + WS_RD + ro;
#pragma unroll
        for (int nt = 0; nt < 4; ++nt) { const int c = 64 * h + 16 * nt + 4 * q4;
            const f32x4 r = rw_shift4(Prw, m, c, hp, hn, mu), v = rw_shift4(Prw, m, 512 + c, hp, hn, mu);
            const f32x4 kk = k[nt] * *(const f32x4*)((const float*)inptr(F, 17) + l * 256 + c) * rkn;
            *(u64_t*)(rs + 2048 * nt) = pk4(kk); *(u64_t*)(rs + 8192 + 2048 * nt) = pk4(v); *(u64_t*)(rs + 16384 + 2048 * nt) = pk4(r);
            f32x4 ksum = {0.f, 0.f, 0.f, 0.f};
#pragma unroll
            for (int e = 0; e < 2; ++e) { const bf16* w = W2T + (size_t)(e * 256 + 64 * h + 16 * nt) * 64; const bf16* a = A2T + (size_t)(e * 256 + 64 * h + 16 * nt) * 64;
                f32x4 x = {0.f, 0.f, 0.f, 0.f}, y = {0.f, 0.f, 0.f, 0.f};
#pragma unroll
                for (int s = 0; s < 2; ++s) { x = __builtin_amdgcn_mfma_f32_16x16x32_bf16(*(const bf16x8*)(w + 32 * s), awd[s], x, 0, 0, 0); y = __builtin_amdgcn_mfma_f32_16x16x32_bf16(*(const bf16x8*)(a + 32 * s), aad[s], y, 0, 0, 0); }
                const f32x4 w0v = *(const f32x4*)((const float*)inptr(F, 13) + l * 512 + e * 256 + c), a0v = *(const f32x4*)((const float*)inptr(F, 15) + l * 512 + e * 256 + c), kav = *(const f32x4*)((const float*)inptr(F, 18) + l * 256 + c);
                f32x4 lam, av;
#pragma unroll
                for (int i = 0; i < 4; ++i) { lam[i] = 0.6065306597126334f * sigmoidf_(w0v[i] + x[i]); av[i] = sigmoidf_(a0v[i] + y[i]); }
                const f32x4 km = k[nt] * (1.f + (av - 1.f) * kav), bb = av * kk;
                ksum += km;
                typedef _Float16 h4 __attribute__((ext_vector_type(4)));
                const h4 lh = {(_Float16)lam[0], (_Float16)lam[1], (_Float16)lam[2], (_Float16)lam[3]};
                unsigned char* rd = rd0 + e * RD_DIR;
                *(u64_t*)(rd + 2048 * nt) = __builtin_bit_cast(u64_t, lh); *(u64_t*)(rd + 8192 + 2048 * nt) = pk4(bb); *(u64_t*)(rd + 16384 + 2048 * nt) = pk4(km); }
            const f32x4 rkv = *(const f32x4*)((const float*)inptr(F, 19) + l * 256 + c), xx = r * ksum * rkv; cbv += (xx[0] + xx[1]) + (xx[2] + xx[3]);
        }
        cbv += __shfl_xor(cbv, 16); cbv += __shfl_xor(cbv, 32);
        if (q4 == 0) ((float*)(F.ws + WS_CB))[m * 4 + h] = 0.5f * cbv;
    }
}
constexpr int RW_PITCH = 1808, RW_MU = 66 * RW_PITCH, RW_LDS = RW_MU + 2 * 896 * 4;
static_assert(RW_LDS <= RING_BYTES, "RWKV prep LDS map");
__device__ __forceinline__ f32x4 rw_shift4_l(const LAS unsigned char* row, int c, bool hp, bool hn, const LAS float* mu) {
    const f32x4 x = bf4(*(const LAS u64_t*)(row + 2 * c)), xp = hp ? bf4(*(const LAS u64_t*)(row - RW_PITCH + 2 * c)) : (f32x4){0.f, 0.f, 0.f, 0.f}, xn = hn ? bf4(*(const LAS u64_t*)(row + RW_PITCH + 2 * c)) : (f32x4){0.f, 0.f, 0.f, 0.f};
    const f32x4 m0 = *(const LAS f32x4*)(mu + c), m1 = *(const LAS f32x4*)(mu + 896 + c);
    return x + m0 * (xp - x) + m1 * (xn - x);
}
__device__ __forceinline__ void p2_rwkv_unit_l(Frame& F, int l, int unit, int h0, int h1) {
    const int lane = F.lane, col = lane & 15, q4 = lane >> 4, b = (16 * unit) / SEQ, t = (16 * unit) % SEQ + col; const size_t m = (size_t)16 * unit + col;
    const bool hp = t > 0, hn = t < SEQ - 1;
    const LAS unsigned char* Prw = F.lds + RING_OFF + (16 * (unit & 3) + col + 1) * RW_PITCH;
    const LAS float* mu = (const LAS float*)(F.lds + RING_OFF + RW_MU);
    const bf16* W2T = (const bf16*)(F.ws + WS_WSMALL + OFF_W2T) + (size_t)l * 2 * 256 * 64 + (size_t)col * 64 + 8 * q4;
    const bf16* A2T = (const bf16*)(F.ws + WS_WSMALL + OFF_A2T) + (size_t)l * 2 * 256 * 64 + (size_t)col * 64 + 8 * q4;
    bf16x8 awd[2], aad[2];
#pragma unroll
    for (int s = 0; s < 2; ++s) { const int c = 768 + 32 * s + 8 * q4;
        f32x4 lo = rw_shift4_l(Prw, c, hp, hn, mu), hi = rw_shift4_l(Prw, c + 4, hp, hn, mu);
#pragma unroll
        for (int i = 0; i < 4; ++i) { lo[i] = 1.f - 2.f * __builtin_amdgcn_rcpf(1.f + __expf(2.f * lo[i])); hi[i] = 1.f - 2.f * __builtin_amdgcn_rcpf(1.f + __expf(2.f * hi[i])); }
        awd[s] = pack_acc(lo, hi);
        aad[s] = pack_acc(rw_shift4_l(Prw, c + 64, hp, hn, mu), rw_shift4_l(Prw, c + 68, hp, hn, mu)); }
#pragma unroll 1
    for (int h = h0; h < h1; ++h) {
        f32x4 k[4]; float kn = 0.f;
        { const float* k_k = (const float*)inptr(F, 17) + l * 256;
#pragma unroll
          for (int nt = 0; nt < 4; ++nt) { const int c = 64 * h + 16 * nt + 4 * q4; k[nt] = rw_shift4_l(Prw, 256 + c, hp, hn, mu);
              const f32x4 x = k[nt] * *(const f32x4*)(k_k + c); kn += (x[0] * x[0] + x[1] * x[1]) + (x[2] * x[2] + x[3] * x[3]); } }
        kn += __shfl_xor(kn, 16); kn += __shfl_xor(kn, 32);
        const float rkn = rsqrtf(kn + 1e-6f);
        float cbv = 0.f;
        const size_t ro = rw_rec_off(b * 4 + h, t, 0, q4 >> 1) + 8 * (q4 & 1);
        unsigned char* rs = F.ws + WS_RS + ro;
        unsigned char* rd0 = F.ws + WS_RD + ro;
#pragma unroll
        for (int nt = 0; nt < 4; ++nt) { const int c = 64 * h + 16 * nt + 4 * q4;
            const f32x4 r = rw_shift4_l(Prw, c, hp, hn, mu), v = rw_shift4_l(Prw, 512 + c, hp, hn, mu);
            const f32x4 kk = k[nt] * *(const f32x4*)((const float*)inptr(F, 17) + l * 256 + c) * rkn;
            *(u64_t*)(rs + 2048 * nt) = pk4(kk); *(u64_t*)(rs + 8192 + 2048 * nt) = pk4(v); *(u64_t*)(rs + 16384 + 2048 * nt) = pk4(r);
            f32x4 ksum = {0.f, 0.f, 0.f, 0.f};
#pragma unroll
            for (int e = 0; e < 2; ++e) { const bf16* w = W2T + (size_t)(e * 256 + 64 * h + 16 * nt) * 64; const bf16* a = A2T + (size_t)(e * 256 + 64 * h + 16 * nt) * 64;
                f32x4 x = {0.f, 0.f, 0.f, 0.f}, y = {0.f, 0.f, 0.f, 0.f};
#pragma unroll
                for (int s = 0; s < 2; ++s) { x = __builtin_amdgcn_mfma_f32_16x16x32_bf16(*(const bf16x8*)(w + 32 * s), awd[s], x, 0, 0, 0); y = __builtin_amdgcn_mfma_f32_16x16x32_bf16(*(const bf16x8*)(a + 32 * s), aad[s], y, 0, 0, 0); }
                const f32x4 w0v = *(const f32x4*)((const float*)inptr(F, 13) + l * 512 + e * 256 + c), a0v = *(const f32x4*)((const float*)inptr(F, 15) + l * 512 + e * 256 + c), kav = *(const f32x4*)((const float*)inptr(F, 18) + l * 256 + c);
                f32x4 lam, av;
#pragma unroll
                for (int i = 0; i < 4; ++i) { lam[i] = 0.6065306597126334f * sigmoidf_(w0v[i] + x[i]); av[i] = sigmoidf_(a0v[i] + y[i]); }
                const f32x4 km = k[nt] * (1.f + (av - 1.f) * kav), bb = av * kk;
                ksum += km;
                typedef _Float16 h4 __attribute__((ext_vector_type(4)));
                const h4 lh = {(_Float16)lam[0], (_Float16)lam[1], (_Float16)lam[2], (_Float16)lam[3]};
                unsigned char* rd = rd0 + e * RD_DIR;
                *(u64_t*)(rd + 2048 * nt) = __builtin_bit_cast(u64_t, lh); *(u64_t*)(rd + 8192 + 2048 * nt) = pk4(bb); *(u64_t*)(rd + 16384 + 2048 * nt) = pk4(km); }
            const f32x4 rkv = *(const f32x4*)((const float*)inptr(F, 19) + l * 256 + c), xx = r * ksum * rkv; cbv += (xx[0] + xx[1]) + (xx[2] + xx[3]);
        }
        cbv += __shfl_xor(cbv, 16); cbv += __shfl_xor(cbv, 32);
        if (q4 == 0) ((float*)(F.ws + WS_CB))[m * 4 + h] = 0.5f * cbv;
    }
}
constexpr int ML_QP = 400, ML_KP = 272, ML_KW = 96 * ML_QP, ML_SLAB = ML_KW + 128 * ML_KP;
static_assert(ML_SLAB <= RING_BYTES, "MLA slab");
__device__ __forceinline__ void p2_mla_wg(Frame& F, int l, int tb) {
    const int tid = F.tid, lane = F.lane, wave = F.wave, col = lane & 15, q4 = lane >> 4, tt = wave & 3, half = wave >> 2;
    const int m = 64 * tb + 16 * tt + col, b = m / SEQ, t = m % SEQ, t0 = (64 * tb + 16 * tt) % SEQ;
    const bf16* prow = (const bf16*)(F.ws + WS_PMLA) + (size_t)m * 352;
    const bf16* WuqT = (const bf16*)(F.ws + WS_WSMALL + OFF_WUQ) + (size_t)l * 576 * 192;
    const bf16* WukvT = (const bf16*)(F.ws + WS_WSMALL + OFF_WUKV) + (size_t)l * 768 * 128;
    LAS unsigned char* sl = F.lds + RING_OFF;
    v4u wreg[5];
#define ML_LOADQ(h_) do { _Pragma("unroll") for (int k_ = 0; k_ < 5; ++k_) { const int p_ = tid + 512 * k_; \
        if (p_ < 96 * 24) wreg[k_] = *(const v4u*)(WuqT + (size_t)((h_) * 96 + p_ / 24) * 192 + 8 * (p_ % 24)); } } while (0)
#define ML_STOREQ() do { _Pragma("unroll") for (int k_ = 0; k_ < 5; ++k_) { const int p_ = tid + 512 * k_; \
        if (p_ < 96 * 24) *(LAS v4u*)(sl + (p_ / 24) * ML_QP + 16 * (p_ % 24)) = wreg[k_]; } } while (0)
#define ML_LOADK(h_) do { _Pragma("unroll") for (int k_ = 0; k_ < 4; ++k_) { const int p_ = tid + 512 * k_; \
        wreg[k_] = *(const v4u*)(WukvT + (size_t)((h_) * 128 + (p_ >> 4)) * 128 + 8 * (p_ & 15)); } } while (0)
#define ML_STOREK() do { _Pragma("unroll") for (int k_ = 0; k_ < 4; ++k_) { const int p_ = tid + 512 * k_; \
        *(LAS v4u*)(sl + ML_KW + (p_ >> 4) * ML_KP + 16 * (p_ & 15)) = wreg[k_]; } } while (0)
    ML_LOADQ(0);
    bf16x8 aq[6], akv[4]; float sq = 0.f, skv = 0.f;
#pragma unroll
    for (int s = 0; s < 6; ++s) { aq[s] = *(const bf16x8*)(prow + 32 * s + 8 * q4); const v4u u = __builtin_bit_cast(v4u, aq[s]);
#pragma unroll
        for (int i = 0; i < 4; ++i) { const float a = __uint_as_float(u[i] << 16), c = __uint_as_float(u[i] & 0xffff0000u); sq += a * a + c * c; } }
#pragma unroll
    for (int s = 0; s < 4; ++s) { akv[s] = *(const bf16x8*)(prow + 192 + 32 * s + 8 * q4); const v4u u = __builtin_bit_cast(v4u, akv[s]);
#pragma unroll
        for (int i = 0; i < 4; ++i) { const float a = __uint_as_float(u[i] << 16), c = __uint_as_float(u[i] & 0xffff0000u); skv += a * a + c * c; } }
    sq += __shfl_xor(sq, 16); sq += __shfl_xor(sq, 32); skv += __shfl_xor(skv, 16); skv += __shfl_xor(skv, 32);
    const float rq = rsqrtf(sq * (1.f / 192.f) + NORM_EPS) * (0.10206207261596575f * LOG2E), rkv = rsqrtf(skv * (1.f / 128.f) + NORM_EPS);
    const float pos = (float)((const int*)inptr(F, 1))[m];
    f32x4 cs, sn;
#pragma unroll
    for (int r = 0; r < 4; ++r) { const float inv = exp2f(-(float)(4 * q4 + r) * (13.287712379549449f / 16.f)); float s_, c_; sincosf(pos * inv, &s_, &c_); cs[r] = c_; sn[r] = s_; }
    bf16* Qo = (bf16*)(F.ws + WS_Q) + ((size_t)b * 6 * SEQ + t) * 96 + 4 * q4;
    bf16* Ko = (bf16*)(F.ws + WS_K) + ((size_t)b * 6 * SEQ + t) * 96 + 4 * q4;
    bf16* Vo = (bf16*)(F.ws + WS_VT) + (size_t)b * 6 * 64 * SEQ + (size_t)col * SEQ + t0 + 4 * q4;
    if (half == 0) { const u64_t x1 = *(const u64_t*)(prow + 320 + 4 * q4), x2 = *(const u64_t*)(prow + 336 + 4 * q4); const f32x4 a = bf4(x1), c = bf4(x2);
      const u64_t o1 = pk4(a * cs - c * sn), o2 = pk4(c * cs + a * sn);
#pragma unroll
      for (int h = 0; h < 6; ++h) { *(u64_t*)(Ko + (size_t)h * SEQ * 96 + 64) = o1; *(u64_t*)(Ko + (size_t)h * SEQ * 96 + 80) = o2; } }
    f32x4 rk4;
#pragma unroll
    for (int r = 0; r < 4; ++r) rk4[r] = __shfl(rkv, 4 * q4 + r);
    const LAS unsigned char* wq = sl + col * ML_QP + 16 * q4; const LAS unsigned char* wk = sl + ML_KW + col * ML_KP + 16 * q4;
    ML_STOREQ();
    __syncthreads();
#pragma unroll 1
    for (int h = 0; h < 6; ++h) {
        ML_LOADK(h);
        { f32x4 x1v = {0.f, 0.f, 0.f, 0.f};
#pragma unroll
          for (int n3 = 0; n3 < 3; ++n3) { const int nt = 3 * half + n3; f32x4 acc = {0.f, 0.f, 0.f, 0.f};
#pragma unroll
              for (int s = 0; s < 6; ++s) acc = __builtin_amdgcn_mfma_f32_16x16x32_bf16(*(const LAS bf16x8*)(wq + 16 * nt * ML_QP + 64 * s), aq[s], acc, 0, 0, 0);
              acc = acc * rq;
              if (half == 0 || n3 == 0) *(u64_t*)(Qo + (size_t)h * SEQ * 96 + 16 * nt) = pk4(acc);
              else if (n3 == 1) x1v = acc;
              else { *(u64_t*)(Qo + (size_t)h * SEQ * 96 + 64) = pk4(x1v * cs - acc * sn); *(u64_t*)(Qo + (size_t)h * SEQ * 96 + 80) = pk4(acc * cs + x1v * sn); }
              asm volatile("" ::: "memory"); } }
        ML_STOREK();
        __syncthreads();
        if (h + 1 < 6) ML_LOADQ(h + 1);
        if (half == 0) {
#pragma unroll
            for (int nt = 0; nt < 4; ++nt) { f32x4 acc = {0.f, 0.f, 0.f, 0.f};
#pragma unroll
                for (int s = 0; s < 4; ++s) acc = __builtin_amdgcn_mfma_f32_16x16x32_bf16(*(const LAS bf16x8*)(wk + 16 * nt * ML_KP + 64 * s), akv[s], acc, 0, 0, 0);
                *(u64_t*)(Ko + (size_t)h * SEQ * 96 + 16 * nt) = pk4(acc * rkv); asm volatile("" ::: "memory"); }
        } else {
#pragma unroll
            for (int nt = 0; nt < 4; ++nt) { f32x4 acc = {0.f, 0.f, 0.f, 0.f};
#pragma unroll
                for (int s = 0; s < 4; ++s) acc = __builtin_amdgcn_mfma_f32_16x16x32_bf16(akv[s], *(const LAS bf16x8*)(wk + (64 + 16 * nt) * ML_KP + 64 * s), acc, 0, 0, 0);
                *(u64_t*)(Vo + (size_t)(h * 64 + 16 * nt) * SEQ) = pk4(acc * rk4); asm volatile("" ::: "memory"); }
        }
        if (h + 1 < 6) ML_STOREQ();
        __syncthreads();
    }
#undef ML_LOADQ
#undef ML_STOREQ
#undef ML_LOADK
#undef ML_STOREK
}
__device__ __forceinline__ void p2_prep3(Frame& F, int l) {
    for (int tb = F.vcu; tb < M / 64; tb += F.G) {
        { const int tid = F.tid, t0 = (64 * tb) % SEQ; const bf16* Prw = (const bf16*)(F.ws + WS_PRW) + ((size_t)64 * tb - 1) * 896; LAS unsigned char* sl = F.lds + RING_OFF;
          const float* mu = (const float*)inptr(F, 12) + l * 2 * 896;
          for (int i = tid; i < 2 * 896 / 4; i += 512) *(LAS f32x4*)(sl + RW_MU + 16 * i) = *(const f32x4*)(mu + 4 * i);
#pragma unroll 1
          for (int k0 = 0; k0 < 15; k0 += 5) { v4u rr[5];
#pragma unroll
              for (int k = 0; k < 5; ++k) { const int p = tid + 512 * (k0 + k), row = p / 112, pc = p % 112, tt = t0 - 1 + row; rr[k] = (v4u){0u, 0u, 0u, 0u};
                  if (p < 66 * 112 && tt >= 0 && tt < SEQ) rr[k] = *(const v4u*)(Prw + (size_t)row * 896 + 8 * pc); }
#pragma unroll
              for (int k = 0; k < 5; ++k) { const int p = tid + 512 * (k0 + k), row = p / 112, pc = p % 112; if (p < 66 * 112) *(LAS v4u*)(sl + row * RW_PITCH + 16 * pc) = rr[k]; } } }
        __syncthreads();
        p2_rwkv_unit_l(F, l, 4 * tb + (F.wave & 3), 2 * (F.wave >> 2), 2 * (F.wave >> 2) + 2);
        __syncthreads();
        p2_mla_wg(F, l, tb);
    }
}
template <int MODE> __device__ __forceinline__ void p2_prep2(Frame& F, int l) {
    const int gw = F.vcu * NWAVES + F.wave, NGW = F.G * NWAVES;
    for (int u = gw; u < 2 * (M / 16); u += NGW) { if (u & 1) { if (MODE != 1) p2_rwkv_unit(F, l, u >> 1, 0, 4); } else { if (MODE != 2) p2_mla_unit(F, l, u >> 1); } }
}
__device__ __forceinline__ void ld16(const bf16* p, f32x4 (&o)[4]) { const v4u a = *(const v4u*)p, b = *(const v4u*)(p + 8);
    o[0] = (f32x4){__uint_as_float(a.x << 16), __uint_as_float(a.x & 0xffff0000u), __uint_as_float(a.y << 16), __uint_as_float(a.y & 0xffff0000u)};
    o[1] = (f32x4){__uint_as_float(a.z << 16), __uint_as_float(a.z & 0xffff0000u), __uint_as_float(a.w << 16), __uint_as_float(a.w & 0xffff0000u)};
    o[2] = (f32x4){__uint_as_float(b.x << 16), __uint_as_float(b.x & 0xffff0000u), __uint_as_float(b.y << 16), __uint_as_float(b.y & 0xffff0000u)};
    o[3] = (f32x4){__uint_as_float(b.z << 16), __uint_as_float(b.z & 0xffff0000u), __uint_as_float(b.w << 16), __uint_as_float(b.w & 0xffff0000u)}; }
__device__ __forceinline__ void p4a_mix2(Frame& F, int l) {
    const bf16* Ogdn = (const bf16*)(F.ws + WS_OGDN); const bf16* Omla = (const bf16*)(F.ws + WS_OMLA); const bf16* Y = (const bf16*)(F.ws + WS_Y);
    const bf16* Pgate = (const bf16*)(F.ws + WS_PGATE); const unsigned char* Rs = F.ws + WS_RS; const float* cb = (const float*)(F.ws + WS_CB); bf16* mix = (bf16*)(F.ws + WS_MIX);
    const int gw = F.vcu * NWAVES + F.wave, NGW = F.G * NWAVES, lane = F.lane, g = lane >> 2, c0 = 16 * lane;
    f32x4 pg[4], pb[4];
    if (g < 6) { const float* gg = (const float*)inptr(F, 7) + l * 64 + (c0 & 63);
#pragma unroll
        for (int i = 0; i < 4; ++i) { pg[i] = *(const f32x4*)(gg + 4 * i); pb[i] = (f32x4){0.f, 0.f, 0.f, 0.f}; } }
    else if (g < 12) {
#pragma unroll
        for (int i = 0; i < 4; ++i) { pg[i] = (f32x4){1.f, 1.f, 1.f, 1.f}; pb[i] = (f32x4){0.f, 0.f, 0.f, 0.f}; } }
    else { const float* lg = (const float*)inptr(F, 20) + l * 256 + (c0 - 768); const float* lb = (const float*)inptr(F, 21) + l * 256 + (c0 - 768);
#pragma unroll
        for (int i = 0; i < 4; ++i) { pg[i] = *(const f32x4*)(lg + 4 * i); pb[i] = *(const f32x4*)(lb + 4 * i); } }
#pragma unroll 2
    for (int m = gw; m < M; m += NGW) {
        f32x4 x[4], gt[4];
        ld16(Pgate + (size_t)m * 1024 + c0, gt);
        if (g < 6) { ld16(Ogdn + (size_t)m * 384 + c0, x);
            float ss = 0.f;
#pragma unroll
            for (int i = 0; i < 4; ++i) ss += (x[i][0] * x[i][0] + x[i][1] * x[i][1]) + (x[i][2] * x[i][2] + x[i][3] * x[i][3]);
            ss += dpp_xor1(ss); ss += dpp_xor2(ss);
            const float rs = rsqrtf(ss * (1.f / 64.f) + NORM_EPS);
#pragma unroll
            for (int i = 0; i < 4; ++i) x[i] = x[i] * rs * pg[i]; }
        else if (g < 12) ld16(Omla + (size_t)m * 384 + (c0 - 384), x);
        else { const int cc = c0 - 768, h = g - 12, b = m / SEQ, t = m % SEQ; f32x4 v[4];
            ld16(Y + (size_t)m * 256 + cc, x); { const unsigned char* vp = Rs + rw_rec_off(b * 4 + h, t, 1, (cc & 63) >> 3); const v4u a = *(const v4u*)vp, bq = *(const v4u*)(vp + 1024);
              v[0] = (f32x4){__uint_as_float(a.x << 16), __uint_as_float(a.x & 0xffff0000u), __uint_as_float(a.y << 16), __uint_as_float(a.y & 0xffff0000u)}; v[1] = (f32x4){__uint_as_float(a.z << 16), __uint_as_float(a.z & 0xffff0000u), __uint_as_float(a.w << 16), __uint_as_float(a.w & 0xffff0000u)};
              v[2] = (f32x4){__uint_as_float(bq.x << 16), __uint_as_float(bq.x & 0xffff0000u), __uint_as_float(bq.y << 16), __uint_as_float(bq.y & 0xffff0000u)}; v[3] = (f32x4){__uint_as_float(bq.z << 16), __uint_as_float(bq.z & 0xffff0000u), __uint_as_float(bq.w << 16), __uint_as_float(bq.w & 0xffff0000u)}; }
            const float cbv = cb[(size_t)m * 4 + h];
            float s1 = 0.f;
#pragma unroll
            for (int i = 0; i < 4; ++i) s1 += (x[i][0] + x[i][1]) + (x[i][2] + x[i][3]);
            s1 += dpp_xor1(s1); s1 += dpp_xor2(s1);
            const float mean = s1 * (1.f / 64.f); float s2 = 0.f;
#pragma unroll
            for (int i = 0; i < 4; ++i) { x[i] = x[i] - mean; s2 += (x[i][0] * x[i][0] + x[i][1] * x[i][1]) + (x[i][2] * x[i][2] + x[i][3] * x[i][3]); }
            s2 += dpp_xor1(s2); s2 += dpp_xor2(s2);
            const float rs = rsqrtf(s2 * (1.f / 64.f) + 64e-5f);
#pragma unroll
            for (int i = 0; i < 4; ++i) x[i] = x[i] * rs * pg[i] + pb[i] + cbv * v[i]; }
        v4u o0, o1;
#pragma unroll
        for (int i = 0; i < 4; ++i) {
#pragma unroll
            for (int j = 0; j < 4; ++j) x[i][j] = x[i][j] * siluf(gt[i][j]); }
        o0.x = pg8::cvt_pk_bf16(x[0][0], x[0][1]); o0.y = pg8::cvt_pk_bf16(x[0][2], x[0][3]); o0.z = pg8::cvt_pk_bf16(x[1][0], x[1][1]); o0.w = pg8::cvt_pk_bf16(x[1][2], x[1][3]);
        o1.x = pg8::cvt_pk_bf16(x[2][0], x[2][1]); o1.y = pg8::cvt_pk_bf16(x[2][2], x[2][3]); o1.z = pg8::cvt_pk_bf16(x[3][0], x[3][1]); o1.w = pg8::cvt_pk_bf16(x[3][2], x[3][3]);
        bf16* op = mix + (size_t)m * 1024 + c0; *(v4u*)op = o0; *(v4u*)(op + 8) = o1;
    }
}
constexpr int PT_OUT = 24, PT_WS = 25, PT_N = 26;
__device__ __forceinline__ void build_frame(Frame& F, LAS unsigned char* lds) {
    F.lds = lds; F.MISC = (volatile LAS unsigned*)(lds + MISC_OFF); F.ptab = (volatile LAS const unsigned long long*)(lds + MISC_OFF + 256);
    const int t = pg8::mk_tid(lds);
    F.tid = t; F.lane = t & 63; F.wave = __builtin_amdgcn_readfirstlane(t >> 6);
    F.G = gridDim.x; { const int bx = blockIdx.x; F.vcu = (F.G % 8 == 0) ? (bx % 8) * (F.G / 8) + bx / 8 : bx; }
    F.ws = (unsigned char*)inptr(F, PT_WS); F.out = (float*)inptr(F, PT_OUT); F.ctl = (gu32*)F.ws;
}
__device__ __forceinline__ bool ph_in(LAS unsigned char* lds, int k) { volatile LAS unsigned* mi = (volatile LAS unsigned*)(lds + MISC_OFF); const int lo = __builtin_amdgcn_readfirstlane((int)mi[20]), hi = __builtin_amdgcn_readfirstlane((int)mi[21]); return lo <= k && k < hi; }
__device__ __forceinline__ void seam(LAS unsigned char* lds, int k) {
    if (ph_in(lds, k) && ph_in(lds, k + 1)) { Frame F; build_frame(F, lds);
        XcdBarrier bar; bar.bar = (unsigned*)(F.ctl + CW_BAR); bar.x = xb_xcc_id(); bar.st = F.MISC + 8; xcd_barrier(bar);
#ifdef EXP_BAR
        xcd_barrier(bar); xcd_barrier(bar);
#endif
    }
}
template <int L> __device__ __forceinline__ void layer_phases(LAS unsigned char* lds) {
    constexpr int pb = 1 + 5 * L;
    if (ph_in(lds, pb)) { Frame F; build_frame(F, lds);
        pg8::Gemm g{(const pg8::bf16_t*)(F.ws + WS_XB), (const pg8::bf16_t*)(F.ws + WS_WIN) + (size_t)L * NP * D, M, NP, D};
        pg8::StaticOrder S; S.init(M, NP, F.G, (int)blockIdx.x);
        pg8::EpiRoute E{F.ws};
        pg8::gemm_phase<pg8::EpiRoute, pg8::StaticOrder, true, true>(F.lds + RING_OFF, g, S, E);
#ifdef EXP_REP1
        __syncthreads(); S.init(M, NP, F.G, (int)blockIdx.x); pg8::gemm_phase<pg8::EpiRoute, pg8::StaticOrder, true, true>(F.lds + RING_OFF, g, S, E);
#endif
    }
    seam(lds, pb);
    if (ph_in(lds, pb + 1)) { Frame F; build_frame(F, lds); p2_prep3(F, L);
#ifdef EXP_REP2
        __syncthreads(); p2_prep3(F, L);
#endif
    }
    seam(lds, pb + 1);
    if (ph_in(lds, pb + 2)) { Frame F; build_frame(F, lds);
#ifdef EXP_REP3
        p3_mixers<1>(F, L, 1); __syncthreads();
#endif
        p3_mixers<0>(F, L, 0); }
    seam(lds, pb + 2);
    if (ph_in(lds, pb + 3)) { Frame F; build_frame(F, lds); p4a_mix2(F, L);
#ifdef EXP_REP4A
        __syncthreads(); p4a_mix2(F, L);
#endif
    }
    seam(lds, pb + 3);
    if (ph_in(lds, pb + 4)) { Frame F; build_frame(F, lds);
        pg8::Gemm g{(const pg8::bf16_t*)(F.ws + WS_MIX), (const pg8::bf16_t*)(F.ws + WS_WOUT) + (size_t)L * D * D, M, D, D};
        pg8::StaticOrder S; S.init(M, D, F.G, (int)blockIdx.x);
        pg8::EpiOut<L == 0> E{L == 0 ? (const float*)inptr(F, 0) : (const float*)F.out, F.out, F.ws};
        pg8::gemm_phase<pg8::EpiOut<L == 0>, pg8::StaticOrder, true, true>(F.lds + RING_OFF, g, S, E);
#ifdef EXP_REP4
        if (L == 0) { __syncthreads(); S.init(M, D, F.G, (int)blockIdx.x); pg8::gemm_phase<pg8::EpiOut<L == 0>, pg8::StaticOrder, true, true>(F.lds + RING_OFF, g, S, E); }
#endif
    }
    seam(lds, pb + 4);
}
__global__ void __launch_bounds__(NWAVES * 64, 2) mk_fwd(Args args) {
    extern __shared__ __attribute__((aligned(16))) unsigned char lds_raw[];
    LAS unsigned char* lds = (LAS unsigned char*)lds_raw;
    for (int u = threadIdx.x; u < (LDS_BYTES - LDSCTL_OFF) / 4; u += NWAVES * 64) ((LAS unsigned*)(lds + LDSCTL_OFF))[u] = 0u;
    __syncthreads();
    if (threadIdx.x == 0) { LAS unsigned long long* pt = (LAS unsigned long long*)(lds + MISC_OFF + 256);
#define PT(k) pt[k] = (unsigned long long)args.in[k]
        PT(0); PT(1); PT(2); PT(3); PT(4); PT(5); PT(6); PT(7); PT(8); PT(9); PT(10); PT(11); PT(12); PT(13); PT(14); PT(15); PT(16); PT(17); PT(18); PT(19); PT(20); PT(21); PT(22); PT(23);
#undef PT
        pt[PT_OUT] = (unsigned long long)args.out; pt[PT_WS] = (unsigned long long)args.ws;
        volatile LAS unsigned* mi = (volatile LAS unsigned*)(lds + MISC_OFF); mi[20] = (unsigned)args.ph_lo; mi[21] = (unsigned)args.ph_hi;
        if (args.ph_hi - args.ph_lo > 1) (void)xcd_barrier_post((unsigned*)((gu32*)args.ws + CW_BAR), mi + 8);
    }
    if ((threadIdx.x & 63) == 0) ((volatile LAS unsigned*)(lds + pg8::TIDTAB_OFF))[pg8::hw_slot()] = threadIdx.x >> 6;
    __syncthreads();
    if (ph_in(lds, 0)) { Frame F; build_frame(F, lds); p0_prologue(F);
#ifdef EXP_REP0
        __syncthreads(); p0_prologue(F);
#endif
    }
    seam(lds, 0);
    layer_phases<0>(lds);
    layer_phases<1>(lds);
    if (ph_in(lds, 11)) { Frame F; build_frame(F, lds); p5_final(F); }
}

extern "C" void kernel_launch(void* const* d_in, const int* in_sizes, int n_in, void* d_out, int out_size, void* d_ws, size_t ws_size, hipStream_t stream) {
    static int grid = 0;
    if (grid == 0) {
        if (n_in != 24 || ws_size < WS_END || out_size != M * D) { fprintf(stderr, "kernel_launch: unexpected inputs (%d), out (%d) or workspace (%zu)\n", n_in, out_size, ws_size); grid = -1; return; }
        int dev = 0, cus = 0;
        if (hipGetDevice(&dev) != hipSuccess || hipDeviceGetAttribute(&cus, hipDeviceAttributeMultiprocessorCount, dev) != hipSuccess) { grid = -1; return; }
        if (hipFuncSetAttribute((const void*)mk_fwd, hipFuncAttributeMaxDynamicSharedMemorySize, LDS_BYTES) != hipSuccess) { fprintf(stderr, "kernel_launch: hipFuncSetAttribute failed\n"); grid = -1; return; }
        (void)hipGetLastError();
        grid = cus;
    }
    if (grid < 0) return;
    unsigned char* ws = (unsigned char*)d_ws;
    (void)hipMemsetAsync(ws + WS_CTL, 0, CTL_ZERO_BYTES, stream);
    Args a{};
    for (int i = 0; i < 24; ++i) a.in[i] = d_in[i];
    a.out = (float*)d_out; a.ws = ws; a.ph_lo = 0; a.ph_hi = NPHASE;
    hipLaunchKernelGGL(mk_fwd, dim3(grid), dim3(NWAVES * 64), LDS_BYTES, stream, a);
}
```

```cpp
#include <hip/hip_runtime.h>
#include <cstdio>
#include <cstdint>
#include <hip/hip_fp16.h>
namespace pg8 {
#define PG8_LAS __attribute__((address_space(3)))
typedef unsigned short bf16_t;
typedef short bf16x8 __attribute__((ext_vector_type(8)));
typedef float f32x4 __attribute__((ext_vector_type(4)));
typedef unsigned u32x4 __attribute__((ext_vector_type(4)));
constexpr int BM = 256, BK = 64, HALF = 128, HTB = HALF * BK * 2  , STAGE_BYTES = 8 * HTB, NXCD = 8, WGM = 8;

__host__ __device__ __forceinline__ int lds_byte(int r, int c) { const int st = (r >> 4) * 2 + (c >> 5), rr = r & 15, cc = c & 31, ob = rr * 64 + cc * 2; return st * 1024 + (ob ^ (((ob >> 9) & 1) << 5)); }
__host__ __device__ __forceinline__ void stage_rc(int b, int& R, int& C) { const int st = b / 1024, sb = b % 1024, swz = sb ^ (((sb >> 9) & 1) << 5); R = (st >> 1) * 16 + swz / 64; C = (st & 1) * 32 + (swz % 64) / 2; }
__host__ __device__ __forceinline__ int perm32(int rho) { const int n = rho >> 4, i = rho & 15; return 8 * (i >> 2) + 4 * n + (i & 3); }

struct Unit { int pm, pn; };
struct Gemm { const bf16_t* A; const bf16_t* Bt; int M, N, K; };

struct StaticOrder {
    int nM, nN, nwg, G, c;
    __host__ __device__ void init(int M, int N, int G_, int c_) { nM = M / BM; nN = N / BM; nwg = nM * nN; G = G_; c = c_; }
    __host__ __device__ bool next(int i, Unit& u) const {
        const long L = (long)i * G + c; if (L >= nwg) return false;
        int wgid = (int)L; { const int q = nwg / NXCD, r = nwg % NXCD, xcd = wgid % NXCD, off = wgid / NXCD; wgid = (xcd < r ? xcd * (q + 1) : r * (q + 1) + (xcd - r) * q) + off; }
        const int nig = WGM * nN, gid = wgid / nig, fm = gid * WGM, gsz = (nM - fm) < WGM ? (nM - fm) : WGM;
        u.pm = fm + ((wgid % nig) % gsz); u.pn = (wgid % nig) / gsz; return true;
    }
    __device__ __forceinline__ void a_ready(const Unit&) const {}
    __device__ __forceinline__ void done(const Unit&) const {}
};

__device__ __forceinline__ unsigned cvt_pk_bf16(float lo, float hi) { unsigned r; asm volatile("v_cvt_pk_bf16_f32 %0, %1, %2" : "=v"(r) : "v"(lo), "v"(hi)); return r; }
typedef float f32x2 __attribute__((ext_vector_type(2)));
constexpr int TIDTAB_OFF = 131072 + 320 + 512;
__device__ __forceinline__ unsigned hw_slot() { return (unsigned)__builtin_amdgcn_s_getreg((5 << 11) | 4) & 63u; }
__device__ __forceinline__ int mk_tid(PG8_LAS unsigned char* lds_base) {
    const unsigned lane = __builtin_amdgcn_mbcnt_hi(~0u, __builtin_amdgcn_mbcnt_lo(~0u, 0u));
    const unsigned w = __builtin_amdgcn_readfirstlane(((volatile PG8_LAS unsigned*)(lds_base + TIDTAB_OFF))[hw_slot()]);
    return (int)(w * 64u + lane);
}
struct EpiRoute {
    static constexpr bool PERM = true, AFTER_DRAIN = false;
    unsigned char* ws;
    __device__ __forceinline__ void operator()(const f32x4 (&acc)[2][2][4][2], const Unit& u, int wr, int wc, int fr, int fq) const {
        const int row0 = u.pm * BM + wr * 64 + fr;
        const float* rowss = (const float*)(ws + (1u << 20)); float* Psm = (float*)(ws + (22u << 20));
        unsigned base[2]; int ld[2], cc[2], kind[2];
#pragma unroll
        for (int bj = 0; bj < 2; ++bj) {
            const int cg = u.pn * BM + bj * HALF + wc * 32, col = cg + 8 * fq;
            if (cg < 1024) { base[bj] = 25u << 20; ld[bj] = 1024; cc[bj] = col; kind[bj] = 0; }
            else if (cg < 2176) { base[bj] = 57u << 20; ld[bj] = 1152; cc[bj] = col - 1024; kind[bj] = 0; }
            else if (cg < 2528) { base[bj] = 93u << 20; ld[bj] = 352; cc[bj] = col - 2176; kind[bj] = 0; }
            else if (cg < 3424) { base[bj] = 104u << 20; ld[bj] = 896; cc[bj] = col - 2528; kind[bj] = 0; }
            else if (cg < 3456) { base[bj] = 0u; ld[bj] = 32; cc[bj] = col - 3424; kind[bj] = 1; }
            else { base[bj] = 0u; ld[bj] = 0; cc[bj] = 0; kind[bj] = 2; }
        }
#pragma unroll
        for (int ai = 0; ai < 2; ++ai)
#pragma unroll
            for (int m = 0; m < 4; ++m) {
                const int row = row0 + ai * HALF + m * 16;
                const f32x4* rp = (const f32x4*)(rowss + (size_t)row * 16);
                const f32x4 s0 = rp[0], s1 = rp[1], s2 = rp[2], s3 = rp[3];
                const float ss = ((s0[0] + s0[1]) + (s0[2] + s0[3])) + ((s1[0] + s1[1]) + (s1[2] + s1[3])) + ((s2[0] + s2[1]) + (s2[2] + s2[3])) + ((s3[0] + s3[1]) + (s3[2] + s3[3]));
                const float rstd = __builtin_amdgcn_rsqf(ss * (1.0f / 1024.0f) + 1e-6f);
#pragma unroll
                for (int bj = 0; bj < 2; ++bj) {
                    const f32x4 v0 = acc[ai][bj][m][0] * rstd, v1 = acc[ai][bj][m][1] * rstd;
                    if (kind[bj] == 0) { u32x4 w; w.x = cvt_pk_bf16(v0[0], v0[1]); w.y = cvt_pk_bf16(v0[2], v0[3]); w.z = cvt_pk_bf16(v1[0], v1[1]); w.w = cvt_pk_bf16(v1[2], v1[3]);
                        *(u32x4*)((bf16_t*)(ws + base[bj]) + (size_t)row * ld[bj] + cc[bj]) = w; }
                    else if (kind[bj] == 1) { float* p = Psm + (size_t)row * 32 + cc[bj]; *(f32x4*)p = v0; *(f32x4*)(p + 4) = v1; }
                }
                asm volatile("" ::: "memory");
            }
    }
};
template <bool WRITE_XB> struct EpiOut {
    static constexpr bool PERM = false, AFTER_DRAIN = false;
    const float* xin; float* xout; unsigned char* ws;
    __device__ __forceinline__ void operator()(const f32x4 (&acc)[2][2][4][2], const Unit& u, int wr, int wc, int fr, int fq) const {
        typedef unsigned u32x2v __attribute__((ext_vector_type(2)));
        const int row0 = u.pm * BM + wr * 64 + fr, col0 = u.pn * BM + wc * 32 + 4 * fq;
        float* rowss = (float*)(ws + (1u << 20)); bf16_t* xb = (bf16_t*)(ws + (133u << 20));
#pragma unroll
        for (int ai = 0; ai < 2; ++ai)
#pragma unroll
            for (int m = 0; m < 4; ++m) {
                const int row = row0 + ai * HALF + m * 16; float ss = 0.f;
#pragma unroll
                for (int bj = 0; bj < 2; ++bj)
#pragma unroll
                    for (int n = 0; n < 2; ++n) {
                        const size_t off = (size_t)row * 1024 + col0 + bj * HALF + n * 16;
                        const f32x4 o = *(const f32x4*)(xin + off) + acc[ai][bj][m][n];
                        *(f32x4*)(xout + off) = o;
                        if (WRITE_XB) { u32x2v w; w.x = cvt_pk_bf16(o[0], o[1]); w.y = cvt_pk_bf16(o[2], o[3]); *(u32x2v*)(xb + off) = w; }
                        ss += (o[0] * o[0] + o[1] * o[1]) + (o[2] * o[2] + o[3] * o[3]);
                    }
                ss += __shfl_xor(ss, 16); ss += __shfl_xor(ss, 32);
                if (fq == 0) rowss[(size_t)row * 16 + u.pn * 4 + wc] = ss;
                asm volatile("" ::: "memory");
            }
    }
};
template <class Epi, class Sched, bool ALIGN_EPI = false, bool SP2 = false>
__device__ __forceinline__ void gemm_phase(PG8_LAS unsigned char* lds, const Gemm g, const Sched& S, const Epi& E) {
    const int tid_ = mk_tid(lds);
    const int tid = tid_, wid = __builtin_amdgcn_readfirstlane(tid >> 6), lane = tid & 63, wr = wid >> 2, wc = wid & 3, fr = lane & 15, fq = lane >> 4;
    const int K = g.K, nt = K / BK;
    unsigned voffA[2], voffB[2];
#pragma unroll
    for (int i = 0; i < 2; ++i) { int R, C; stage_rc(tid * 16 + i * 8192, R, C); const int Rb = Epi::PERM ? ((R & ~31) + perm32(R & 31)) : R;
        voffA[i] = (unsigned)(R * K + C) * 2u; voffB[i] = (unsigned)(Rb * K + C) * 2u; }
    const size_t kstep = (size_t)(BK * 2);
    const size_t hstep = (size_t)HALF * K * 2;
    const size_t tstep = 2 * hstep;
    const unsigned ldsw = (unsigned)wid * 1024u;
    const int aoff = lds_byte(wr * 64 + fr, fq * 8), boff = lds_byte(wc * 32 + fr, fq * 8);
#define PG8_SA(b, h) (((b) * 2 + (h)) * HTB)
#define PG8_SB(b, h) ((4 + (b) * 2 + (h)) * HTB)
#define PG8_STAGE(bufoff, gbase, voff) do { _Pragma("unroll") for (int _i = 0; _i < 2; ++_i) \
        __builtin_amdgcn_global_load_lds((const unsigned*)((const char*)(gbase) + (voff)[_i]), (PG8_LAS unsigned*)(lds + (bufoff) + ldsw + _i * 8192), 16, 0, 0); } while (0)
#define PG8_LDA(dst, b, h) do { _Pragma("unroll") for (int m = 0; m < 4; ++m) _Pragma("unroll") for (int k = 0; k < 2; ++k) dst[m][k] = *(const PG8_LAS bf16x8*)(lds + PG8_SA(b, h) + aoff + m * 2048 + k * 1024); } while (0)
#define PG8_LDB(dst, b, h) do { _Pragma("unroll") for (int n = 0; n < 2; ++n) _Pragma("unroll") for (int k = 0; k < 2; ++k) dst[n][k] = *(const PG8_LAS bf16x8*)(lds + PG8_SB(b, h) + boff + n * 2048 + k * 1024); } while (0)
#define PG8_MMA(ai, bj, At, Bt) do { __builtin_amdgcn_s_setprio(1); _Pragma("unroll") for (int m = 0; m < 4; ++m) _Pragma("unroll") for (int n = 0; n < 2; ++n) _Pragma("unroll") for (int k = 0; k < 2; ++k) \
        acc[ai][bj][m][n] = __builtin_amdgcn_mfma_f32_16x16x32_bf16(Bt[n][k], At[m][k], acc[ai][bj][m][n], 0, 0, 0); __builtin_amdgcn_s_setprio(0); } while (0)
#define PG8_WAIT_V(n) asm volatile("s_waitcnt vmcnt(" #n ")" ::: "memory")
#define PG8_WAIT_L(n) asm volatile("s_waitcnt lgkmcnt(" #n ")" ::: "memory")
#define PG8_BAR __builtin_amdgcn_s_barrier()
#define PG8_SCHED __builtin_amdgcn_sched_barrier(0)
    Unit cur, nxt; int ui = 0;
    if (!S.next(0, cur)) return;
    f32x4 acc[2][2][4][2];
#pragma unroll
    for (int a = 0; a < 2; ++a)
#pragma unroll
        for (int b = 0; b < 2; ++b)
#pragma unroll
            for (int m = 0; m < 4; ++m)
#pragma unroll
                for (int n = 0; n < 2; ++n) acc[a][b][m][n] = (f32x4){0.f, 0.f, 0.f, 0.f};
    bf16x8 At[4][2], B0[2][2], B1[2][2];
    const char* cA = (const char*)g.A + (size_t)cur.pm * tstep; const char* cB = (const char*)g.Bt + (size_t)cur.pn * tstep;
    S.a_ready(cur);
    if constexpr (SP2) {
        PG8_STAGE(PG8_SB(0, 0), cB, voffB); PG8_STAGE(PG8_SB(0, 1), cB + hstep, voffB); PG8_STAGE(PG8_SA(0, 0), cA, voffA); PG8_STAGE(PG8_SA(0, 1), cA + hstep, voffA);
        if (wr == 1) PG8_BAR;
        PG8_WAIT_V(2); PG8_BAR;
        PG8_STAGE(PG8_SB(1, 0), cB + kstep, voffB); PG8_STAGE(PG8_SA(1, 0), cA + kstep, voffA); PG8_STAGE(PG8_SB(1, 1), cB + hstep + kstep, voffB);
        PG8_WAIT_V(6); PG8_BAR;
    } else {
        PG8_STAGE(PG8_SB(0, 0), cB, voffB); PG8_STAGE(PG8_SA(0, 0), cA, voffA); PG8_STAGE(PG8_SB(0, 1), cB + hstep, voffB); PG8_STAGE(PG8_SA(0, 1), cA + hstep, voffA);
        if (wr == 1) PG8_BAR;
        PG8_WAIT_V(4); PG8_BAR;
        PG8_STAGE(PG8_SB(1, 0), cB + kstep, voffB); PG8_STAGE(PG8_SA(1, 0), cA + kstep, voffA); PG8_STAGE(PG8_SB(1, 1), cB + hstep + kstep, voffB);
        PG8_WAIT_V(6); PG8_BAR;
    }
    for (;;) {
        const bool has_next = S.next(ui + 1, nxt);
        const char* nA = has_next ? (const char*)g.A + (size_t)nxt.pm * tstep : cA; const char* nB = has_next ? (const char*)g.Bt + (size_t)nxt.pn * tstep : cB;
        for (int t = 0; t < nt; t += 2) {
            const bool last = (t == nt - 2);
            const char* a1 = cA + (size_t)(t + 1) * kstep;
            const char* a2 = last ? nA : cA + (size_t)(t + 2) * kstep; const char* b2 = last ? nB : cB + (size_t)(t + 2) * kstep;
            const char* a3 = a2 + kstep; const char* b3 = b2 + kstep;
            if (last && has_next) S.a_ready(nxt);
            if constexpr (SP2) {
            PG8_LDB(B0, 0, 0); PG8_LDB(B1, 0, 1); PG8_SCHED; PG8_LDA(At, 0, 0); PG8_STAGE(PG8_SA(1, 1), a1 + hstep, voffA);
            PG8_WAIT_V(8); PG8_WAIT_L(0); PG8_BAR; PG8_MMA(0, 0, At, B0); PG8_MMA(0, 1, At, B1); PG8_BAR; PG8_SCHED;
            PG8_LDA(At, 0, 1); PG8_STAGE(PG8_SB(0, 0), b2, voffB); PG8_STAGE(PG8_SB(0, 1), b2 + hstep, voffB); PG8_STAGE(PG8_SA(0, 0), a2, voffA);
            PG8_WAIT_V(8); PG8_WAIT_L(0); PG8_BAR; PG8_MMA(1, 0, At, B0); PG8_MMA(1, 1, At, B1); PG8_BAR; PG8_SCHED;
            PG8_LDB(B0, 1, 0); PG8_LDB(B1, 1, 1); PG8_SCHED; PG8_LDA(At, 1, 0); PG8_STAGE(PG8_SA(0, 1), a2 + hstep, voffA);
            PG8_WAIT_V(8); PG8_WAIT_L(0); PG8_BAR; PG8_MMA(0, 0, At, B0); PG8_MMA(0, 1, At, B1); PG8_BAR; PG8_SCHED;
            PG8_LDA(At, 1, 1); PG8_STAGE(PG8_SB(1, 0), b3, voffB); PG8_STAGE(PG8_SB(1, 1), b3 + hstep, voffB); PG8_STAGE(PG8_SA(1, 0), a3, voffA);
            PG8_WAIT_V(8); PG8_WAIT_L(0); PG8_BAR; PG8_MMA(1, 0, At, B0); PG8_MMA(1, 1, At, B1); PG8_BAR; PG8_SCHED;
            } else {
            PG8_LDB(B0, 0, 0); PG8_SCHED; PG8_LDA(At, 0, 0); PG8_STAGE(PG8_SA(1, 1), a1 + hstep, voffA);
            PG8_WAIT_L(8); PG8_BAR; PG8_WAIT_L(0); PG8_MMA(0, 0, At, B0); PG8_BAR; PG8_SCHED;
            PG8_LDB(B1, 0, 1); PG8_STAGE(PG8_SB(0, 0), b2, voffB);
            PG8_BAR; PG8_WAIT_L(0); PG8_MMA(0, 1, At, B1); PG8_BAR;
            PG8_LDA(At, 0, 1); PG8_STAGE(PG8_SA(0, 0), a2, voffA);
            PG8_BAR; PG8_WAIT_L(0); PG8_MMA(1, 0, At, B0); PG8_BAR; PG8_SCHED;
            PG8_STAGE(PG8_SB(0, 1), b2 + hstep, voffB);
            PG8_WAIT_V(6); PG8_BAR; PG8_MMA(1, 1, At, B1); PG8_BAR;
            PG8_LDB(B0, 1, 0); PG8_SCHED; PG8_LDA(At, 1, 0); PG8_STAGE(PG8_SA(0, 1), a2 + hstep, voffA);
            PG8_WAIT_L(8); PG8_BAR; PG8_WAIT_L(0); PG8_MMA(0, 0, At, B0); PG8_BAR; PG8_SCHED;
            PG8_LDB(B1, 1, 1); PG8_STAGE(PG8_SB(1, 0), b3, voffB);
            PG8_BAR; PG8_WAIT_L(0); PG8_MMA(0, 1, At, B1); PG8_BAR;
            PG8_LDA(At, 1, 1); PG8_STAGE(PG8_SA(1, 0), a3, voffA);
            PG8_BAR; PG8_WAIT_L(0); PG8_MMA(1, 0, At, B0); PG8_BAR; PG8_SCHED;
            PG8_STAGE(PG8_SB(1, 1), b3 + hstep, voffB);
            PG8_WAIT_V(6); PG8_BAR; PG8_MMA(1, 1, At, B1); PG8_BAR;
            }
        }
        if constexpr (ALIGN_EPI) { if (wr == 0) PG8_BAR; }
        if constexpr (!Epi::AFTER_DRAIN) { E(acc, cur, wr, wc, fr, fq); S.done(cur); }
        if (!has_next) break;
#pragma unroll
        for (int a = 0; a < 2; ++a)
#pragma unroll
            for (int b = 0; b < 2; ++b)
#pragma unroll
                for (int m = 0; m < 4; ++m)
#pragma unroll
                    for (int n = 0; n < 2; ++n) acc[a][b][m][n] = (f32x4){0.f, 0.f, 0.f, 0.f};
        cur = nxt; cA = nA; cB = nB; ++ui;
        if constexpr (ALIGN_EPI) { if (wr == 1) PG8_BAR; }
    }
    PG8_WAIT_V(0);
    if constexpr (!ALIGN_EPI) { if (wr == 0) PG8_BAR; }
    PG8_BAR;
    if constexpr (Epi::AFTER_DRAIN) { E.fused(acc, cur, wr, wc, fr, fq, lds, wid, lane); S.done(cur); }
#undef PG8_SA
#undef PG8_SB
#undef PG8_STAGE
#undef PG8_LDA
#undef PG8_LDB
#undef PG8_MMA
#undef PG8_WAIT_V
#undef PG8_WAIT_L
#undef PG8_BAR
#undef PG8_SCHED
}
}
#define GAS __attribute__((address_space(1)))
#define LAS __attribute__((address_space(3)))
typedef unsigned short bf16;
typedef unsigned v4u __attribute__((ext_vector_type(4)));
typedef float f32x4 __attribute__((ext_vector_type(4)));
typedef short bf16x8 __attribute__((ext_vector_type(8)));
typedef GAS unsigned gu32;
typedef GAS unsigned long long gu64;
#define RLX_AGENT __ATOMIC_RELAXED, __HIP_MEMORY_SCOPE_AGENT
#define LDS_WAIT() asm volatile("s_waitcnt lgkmcnt(0)" ::: "memory")
#define VM_WAIT() asm volatile("s_waitcnt vmcnt(0)" ::: "memory")
__device__ __forceinline__ unsigned long long rt() { return __builtin_amdgcn_s_memrealtime(); }
__device__ __forceinline__ unsigned f2bf(float f) { unsigned u = __builtin_bit_cast(unsigned, f); return (u + 0x7fffu + ((u >> 16) & 1u)) >> 16; }
__device__ __forceinline__ unsigned pk2(float lo, float hi) { return f2bf(lo) | (f2bf(hi) << 16); }

#define XB_TMO      128
#define XB_XCNT(j)  (256  + 64 * (j))
#define XB_XSUB(j)  (1280 + 64 * (j))
#define XB_XGEN(j)  (2304 + 64 * (j))
#define XB_TOP      3328
#define XB_TOPGEN   3392
#define XCD_BAR_WORDS 3456
#define XB_SPIN_CAP (1u << 18)

__device__ __forceinline__ unsigned xb_ld(unsigned* p)              { return __hip_atomic_load(p, __ATOMIC_RELAXED, __HIP_MEMORY_SCOPE_AGENT); }
__device__ __forceinline__ unsigned xb_add(unsigned* p, unsigned v) { return __hip_atomic_fetch_add(p, v, __ATOMIC_RELAXED, __HIP_MEMORY_SCOPE_AGENT); }
__device__ __forceinline__ unsigned xb_xcc_id() { return (unsigned)__builtin_amdgcn_s_getreg((3 << 11) | 20) & 0xFu; }
#define XB_SPIN(cond, bar) do { unsigned _sp = 0; while (cond) { __builtin_amdgcn_s_sleep(1); \
    if ((++_sp & 255u) == 0u) { if (xb_ld(&(bar)[XB_TMO])) break; if (_sp > XB_SPIN_CAP) { atomicAdd(&(bar)[XB_TMO], 1u); break; } } } } while (0)

struct XcdBarrier {
    unsigned* bar; unsigned x;
    volatile LAS unsigned* st;
};

__device__ __forceinline__ XcdBarrier xcd_barrier_post(unsigned* bar, volatile LAS unsigned* st) {
    XcdBarrier b; b.bar = bar; b.x = xb_xcc_id(); b.st = st;
    if (threadIdx.x == 0) (void)xb_add(&bar[XB_XCNT(b.x)], 1u);
    return b;
}
__device__ __forceinline__ void xcd_barrier_complete(unsigned* bar, unsigned x, unsigned& nloc, unsigned& nx) {
    const unsigned G = gridDim.x * gridDim.y * gridDim.z;
    unsigned sum, cnt, mine, sp = 0u;
    for (;;) {
        sum = 0u; cnt = 0u; mine = 0u;
#pragma unroll
        for (unsigned j = 0; j < 16; ++j) { const unsigned c = xb_ld(&bar[XB_XCNT(j)]); sum += c; cnt += (c > 0u) ? 1u : 0u; mine = (j == x) ? c : mine; }
        if (sum == G) break;
        __builtin_amdgcn_s_sleep(1);
        if ((++sp & 255u) == 0u) { if (xb_ld(&bar[XB_TMO])) break; if (sp > XB_SPIN_CAP) { atomicAdd(&bar[XB_TMO], 1u); break; } }
    }
    nloc = mine > 0u ? mine : 1u; nx = cnt > 0u ? cnt : 1u;
}

__device__ __forceinline__ void xcd_barrier(const XcdBarrier& b) {
    asm volatile("s_waitcnt vmcnt(0)" ::: "memory");
    __syncthreads();
    if (pg8::mk_tid((LAS unsigned char*)b.st - (131072 + 320 + 32)) == 0) {
        unsigned* bar = b.bar;
        __builtin_amdgcn_s_waitcnt(0);
        unsigned nloc = b.st[0], nx = b.st[1];
        if (nloc == 0u) { xcd_barrier_complete(bar, b.x, nloc, nx); b.st[0] = nloc; b.st[1] = nx; }
        const unsigned old = xb_add(&bar[XB_XSUB(b.x)], 1u);
        const unsigned gen = old / nloc;
        if (old + 1u == (gen + 1u) * nloc) {
            __builtin_amdgcn_fence(__ATOMIC_RELEASE, "agent");
            asm volatile("s_waitcnt vmcnt(0)" ::: "memory");
            const unsigned og = xb_add(&bar[XB_TOP], 1u);
            const unsigned tg = og / nx;
            if (og + 1u == (tg + 1u) * nx) xb_add(&bar[XB_TOPGEN], 1u);
            else XB_SPIN(xb_ld(&bar[XB_TOPGEN]) == tg, bar);
            __builtin_amdgcn_fence(__ATOMIC_ACQUIRE, "agent");
            xb_add(&bar[XB_XGEN(b.x)], 1u);
            asm volatile("s_waitcnt vmcnt(0)" ::: "memory");
        } else {
            XB_SPIN(xb_ld(&bar[XB_XGEN(b.x)]) == gen, bar);
            __builtin_amdgcn_fence(__ATOMIC_ACQUIRE, "agent");
            asm volatile("s_waitcnt vmcnt(0)" ::: "memory");
        }
    }
    __syncthreads();
}
constexpr int BATCH = 8, SEQ = 2048, M = BATCH * SEQ, D = 1024, NIN = 3448, NP = 3584;
constexpr float NORM_EPS = 1e-6f;
constexpr float LOG2E = 1.4426950408889634f;
constexpr size_t MiB = 1u << 20;
constexpr size_t WS_CTL = 0, CTL_ZERO_BYTES = 1 * MiB;
constexpr size_t WS_ROWSS = 1 * MiB;
constexpr size_t WS_WIN = 2 * MiB;
constexpr size_t WS_WOUT = 16 * MiB;
constexpr size_t WS_WSMALL = 20 * MiB;
constexpr size_t OFF_WUQ = 0, OFF_WUKV = 2 * 576 * 192 * 2, OFF_W2T = OFF_WUKV + 2 * 768 * 128 * 2, OFF_A2T = OFF_W2T + 2 * 2 * 256 * 64 * 2;
constexpr size_t WS_PSM = 22 * MiB;
constexpr size_t WS_CB = 24 * MiB;
constexpr size_t WS_PGATE = 25 * MiB;
constexpr size_t WS_PGDN = 57 * MiB;
constexpr size_t WS_PMLA = 93 * MiB;
constexpr size_t WS_PRW = 104 * MiB;
constexpr size_t WS_OGDN = 93 * MiB;
constexpr size_t WS_OMLA = 105 * MiB;
constexpr size_t WS_Y = 117 * MiB;
constexpr size_t WS_RS = 133 * MiB;
constexpr size_t WS_RD = 157 * MiB;
constexpr size_t WS_XB = 133 * MiB;
constexpr size_t WS_Q = 207 * MiB;
constexpr size_t WS_K = 225 * MiB;
constexpr size_t WS_VT = 243 * MiB;
constexpr size_t WS_MIX = 207 * MiB;
constexpr size_t WS_END = 255 * MiB;
constexpr int RS_REC = 384;
constexpr size_t RD_DIR = (size_t)BATCH * 4 * SEQ * RS_REC;
__device__ __forceinline__ size_t rw_rec_off(int bh, int t, int arr, int w) { return ((size_t)(bh * (SEQ / 64) + (t >> 6)) * 3 + arr) * 8192 + w * 1024 + (t & 63) * 16; }
constexpr int CW_BAR = 4096;
constexpr int CW_QUEUE = 16384;

constexpr int NWAVES = 8;
constexpr int RING_OFF = 0, RING_BYTES = 131072, LDSCTL_OFF = RING_BYTES, MISC_OFF = LDSCTL_OFF + 320, LDS_BYTES = 147456;
static_assert(pg8::TIDTAB_OFF == MISC_OFF + 512 && RING_OFF == 0, "LDS map");
constexpr int NPHASE = 12;

__device__ __forceinline__ float bf2f(bf16 v) { return __uint_as_float(((unsigned)v) << 16); }
__device__ __forceinline__ float wave_sum(float v) {
#pragma unroll
    for (int o = 1; o < 64; o <<= 1) v += __shfl_xor(v, o);
    return v;
}
__device__ __forceinline__ float siluf(float x) { return x * __builtin_amdgcn_rcpf(1.f + __expf(-x)); }
__device__ __forceinline__ float sigmoidf_(float x) { return __builtin_amdgcn_rcpf(1.f + __expf(-x)); }
__device__ __forceinline__ float softplusf_(float x) { return x > 20.f ? x : log1pf(__expf(x)); }

typedef float f32x2_t __attribute__((ext_vector_type(2))); typedef __bf16 bf16x2_t __attribute__((ext_vector_type(2)));
__device__ __forceinline__ unsigned cvt2bf(float lo, float hi) { const f32x2_t v = {lo, hi}; const bf16x2_t b = __builtin_convertvector(v, bf16x2_t); return __builtin_bit_cast(unsigned, b); }

struct Args { const void* in[24]; float* out; unsigned char* ws; int ph_lo, ph_hi; };

struct Frame {
    LAS unsigned char* lds;
    volatile LAS unsigned* MISC;
    gu32* ctl;
    int tid, lane, wave, vcu, G;
    unsigned char* ws;
    float* out;
    volatile LAS const unsigned long long* ptab;
};
__device__ __forceinline__ const void* inptr(const Frame& F, int k) {
    const unsigned long long v = F.ptab[k];
    const unsigned lo = __builtin_amdgcn_readfirstlane((unsigned)v), hi = __builtin_amdgcn_readfirstlane((unsigned)(v >> 32));
    return (const void*)(GAS const void*)(((unsigned long long)hi << 32) | lo);
}

__device__ __forceinline__ void tr_item(const float* W, int K, int ldsrc, int scol, int nvalid, bf16* WT, const float* gs, LAS float* scr, int kb, int lane) {
    const int k0 = 64 * kb;
#pragma unroll 8
    for (int i = 0; i < 32; ++i) { const int kk = 2 * i + (lane >> 5), n = lane & 31; float v = 0.f;
        if (n < nvalid) { v = W[(size_t)(k0 + kk) * ldsrc + scol + n]; if (gs) v *= gs[k0 + kk]; }
        scr[kk * 33 + n] = v; }
    LDS_WAIT(); asm volatile("" ::: "memory");
    const int c = lane & 7;
#pragma unroll
    for (int j = 0; j < 4; ++j) { const int n = (lane >> 3) + 8 * j; const LAS float* s = scr + (8 * c) * 33 + n;
        v4u o; o.x = pk2(s[0 * 33], s[1 * 33]); o.y = pk2(s[2 * 33], s[3 * 33]); o.z = pk2(s[4 * 33], s[5 * 33]); o.w = pk2(s[6 * 33], s[7 * 33]);
        *(GAS v4u*)(WT + (size_t)n * K + k0 + 8 * c) = o; }
    LDS_WAIT(); asm volatile("" ::: "memory");
}
__device__ __forceinline__ void p0_prologue(Frame& F) {
    LAS float* scr = (LAS float*)(F.lds + RING_OFF + F.wave * 16384);
    const int gw = F.vcu * NWAVES + F.wave, NGW = F.G * NWAVES;
    constexpr int I_IN = 112 * 16, I_OUT = 32 * 16, I_UQ = 18 * 3, I_UKV = 24 * 2, I_W2 = 16, I_A2 = 16, I_L = I_IN + I_OUT + I_UQ + I_UKV + I_W2 + I_A2;
    for (int it = gw; it < 2 * I_L; it += NGW) {
        const int l = it / I_L; int r = it % I_L;
        if (r < I_IN) { const int nb = r >> 4, kb = r & 15, n0 = 32 * nb; int scol, nv;
            if (n0 < 2176) { scol = n0; nv = 32; } else if (n0 < 3424) { scol = n0 + 24; nv = 32; } else if (n0 == 3424) { scol = 2176; nv = 24; } else { scol = 0; nv = 0; }
            tr_item((const float*)inptr(F, 3) + (size_t)l * D * NIN, D, NIN, scol, nv, (bf16*)(F.ws + WS_WIN) + ((size_t)l * NP + n0) * D, (const float*)inptr(F, 2) + l * D, scr, kb, F.lane); continue; }
        r -= I_IN;
        if (r < I_OUT) { const int nb = r >> 4, kb = r & 15;
            tr_item((const float*)inptr(F, 22) + (size_t)l * D * D, D, D, 32 * nb, 32, (bf16*)(F.ws + WS_WOUT) + ((size_t)l * D + 32 * nb) * D, nullptr, scr, kb, F.lane); continue; }
        r -= I_OUT;
        if (r < I_UQ) { const int nb = r / 3, kb = r % 3;
            tr_item((const float*)inptr(F, 9) + (size_t)l * 192 * 576, 192, 576, 32 * nb, 32, (bf16*)(F.ws + WS_WSMALL + OFF_WUQ) + ((size_t)l * 576 + 32 * nb) * 192, (const float*)inptr(F, 8) + l * 192, scr, kb, F.lane); continue; }
        r -= I_UQ;
        if (r < I_UKV) { const int nb = r >> 1, kb = r & 1;
            tr_item((const float*)inptr(F, 11) + (size_t)l * 128 * 768, 128, 768, 32 * nb, 32, (bf16*)(F.ws + WS_WSMALL + OFF_WUKV) + ((size_t)l * 768 + 32 * nb) * 128, (const float*)inptr(F, 10) + l * 128, scr, kb, F.lane); continue; }
        r -= I_UKV;
        if (r < I_W2) { const int e = r >> 3, nb = r & 7;
            tr_item((const float*)inptr(F, 14) + ((size_t)l * 2 + e) * 64 * 256, 64, 256, 32 * nb, 32, (bf16*)(F.ws + WS_WSMALL + OFF_W2T) + (((size_t)l * 2 + e) * 256 + 32 * nb) * 64, nullptr, scr, 0, F.lane); continue; }
        r -= I_W2;
        { const int e = r >> 3, nb = r & 7;
            tr_item((const float*)inptr(F, 16) + ((size_t)l * 2 + e) * 64 * 256, 64, 256, 32 * nb, 32, (bf16*)(F.ws + WS_WSMALL + OFF_A2T) + (((size_t)l * 2 + e) * 256 + 32 * nb) * 64, nullptr, scr, 0, F.lane); }
    }
    const float* x = (const float*)inptr(F, 0); bf16* xb = (bf16*)(F.ws + WS_XB); float* rowss = (float*)(F.ws + WS_ROWSS);
    for (int m = gw; m < M; m += NGW) {
        const GAS f32x4* xr = (const GAS f32x4*)(x + (size_t)m * D) + F.lane;
        GAS unsigned long long* o8 = (GAS unsigned long long*)(xb + (size_t)m * D) + F.lane; float s = 0.f;
#pragma unroll
        for (int j = 0; j < 4; ++j) { const f32x4 v = xr[64 * j]; s += (v.x * v.x + v.y * v.y) + (v.z * v.z + v.w * v.w);
            o8[64 * j] = (unsigned long long)pk2(v.x, v.y) | ((unsigned long long)pk2(v.z, v.w) << 32); }
        s = wave_sum(s);
        if (F.lane < 16) rowss[(size_t)m * 16 + F.lane] = F.lane == 0 ? s : 0.f;
    }
}
__device__ __forceinline__ void p5_final(Frame& F) {
    const int gw = F.vcu * NWAVES + F.wave, NGW = F.G * NWAVES;
    const float* rowss = (const float*)(F.ws + WS_ROWSS); const float* g = (const float*)inptr(F, 23);
    f32x4 gv[4];
#pragma unroll
    for (int j = 0; j < 4; ++j) gv[j] = ((const f32x4*)g)[F.lane + 64 * j];
    for (int m = gw; m < M; m += NGW) {
        float ss = F.lane < 16 ? rowss[(size_t)m * 16 + F.lane] : 0.f;
        ss = wave_sum(ss);
        const float rstd = rsqrtf(ss * (1.f / D) + NORM_EPS);
        GAS f32x4* xr = (GAS f32x4*)(F.out + (size_t)m * D) + F.lane;
#pragma unroll
        for (int j = 0; j < 4; ++j) { f32x4 v = xr[64 * j]; v = v * rstd * gv[j]; xr[64 * j] = v; }
    }
}
typedef float f32x16 __attribute__((ext_vector_type(16)));
typedef unsigned long long u64_t;
__device__ __forceinline__ f32x4 bf4(u64_t x) { return (f32x4){__uint_as_float(((unsigned)x) << 16), __uint_as_float(((unsigned)x) & 0xffff0000u), __uint_as_float(((unsigned)(x >> 32)) << 16), __uint_as_float(((unsigned)(x >> 32)) & 0xffff0000u)}; }
__device__ __forceinline__ bf16x8 mk_bf16x8(u64_t lo, u64_t hi) { typedef u64_t u64x2 __attribute__((ext_vector_type(2))); u64x2 v = {lo, hi}; return __builtin_bit_cast(bf16x8, v); }

constexpr int AT_KP = 208, AT_VP = 136, AT_KBYTES = 64 * AT_KP, AT_VBYTES = 64 * AT_VP, AT_BUF = AT_KBYTES + AT_VBYTES;
__device__ __forceinline__ float at_max3(float a, float b, float c) { float r; asm("v_max3_f32 %0, %1, %2, %3" : "=v"(r) : "v"(a), "v"(b), "v"(c)); return r; }
__device__ __forceinline__ void attn_unit(Frame& F, int unit) {
    const int bh = unit >> 3, qb = unit & 7, b = bh / 6, h = bh % 6;
    const int tid = F.tid, lane = F.lane, wave = F.wave, r32 = lane & 31, hi = lane >> 5;
    const bf16* Qg = (const bf16*)(F.ws + WS_Q) + ((size_t)bh * SEQ + qb * 256 + wave * 32 + r32) * 96;
    const bf16* Kg = (const bf16*)(F.ws + WS_K) + (size_t)bh * SEQ * 96;
    const bf16* Vg = (const bf16*)(F.ws + WS_VT) + (size_t)bh * 64 * SEQ;
    LAS unsigned char* lds = F.lds + RING_OFF;
    bf16x8 qf[6];
#pragma unroll
    for (int s = 0; s < 6; ++s) qf[s] = *(const bf16x8*)(Qg + 16 * s + 8 * hi);
    const int kr0 = tid / 12, kc0 = tid % 12, kr1 = (512 + tid) / 12, kc1 = (512 + tid) % 12, vd = tid >> 3, vc = tid & 7;
    const bool has1 = tid < 256;
    v4u ka0, ka1 = {0u, 0u, 0u, 0u}, va, kb0, kb1 = {0u, 0u, 0u, 0u}, vb;
#define AT_LOAD(K0, K1, V_, t0) do { K0 = *(const v4u*)(Kg + (size_t)((t0) + kr0) * 96 + kc0 * 8); if (has1) K1 = *(const v4u*)(Kg + (size_t)((t0) + kr1) * 96 + kc1 * 8); \
        V_ = *(const v4u*)(Vg + (size_t)vd * SEQ + (t0) + vc * 8); } while (0)
#define AT_STORE(K0, K1, V_, buf) do { LAS unsigned char* bb_ = lds + (buf) * AT_BUF; *(LAS v4u*)(bb_ + kr0 * AT_KP + kc0 * 16) = K0; if (has1) *(LAS v4u*)(bb_ + kr1 * AT_KP + kc1 * 16) = K1; \
        LAS u64_t* vp_ = (LAS u64_t*)(bb_ + AT_KBYTES + vd * AT_VP + vc * 16); vp_[0] = (u64_t)V_.x | ((u64_t)V_.y << 32); vp_[1] = (u64_t)V_.z | ((u64_t)V_.w << 32); } while (0)
    AT_LOAD(ka0, ka1, va, 0); AT_STORE(ka0, ka1, va, 0);
    AT_LOAD(ka0, ka1, va, 64);
    __syncthreads();
    f32x16 o0 = {}, o1 = {};
    float mrun = -1e30f, lsum = 0.f;
    constexpr int NT = SEQ / 64;
    auto tile = [&](int t) {
        LAS unsigned char* bb = lds + (t % 3) * AT_BUF;
        f32x16 p0 = {}, p1 = {};
        { const LAS unsigned char* kb = bb + r32 * AT_KP + hi * 16;
#pragma unroll
          for (int s = 0; s < 6; ++s) {
              const bf16x8 a0 = *(const LAS bf16x8*)(kb + 32 * s), a1 = *(const LAS bf16x8*)(kb + 32 * AT_KP + 32 * s);
              p0 = __builtin_amdgcn_mfma_f32_32x32x16_bf16(a0, qf[s], p0, 0, 0, 0);
              p1 = __builtin_amdgcn_mfma_f32_32x32x16_bf16(a1, qf[s], p1, 0, 0, 0); } }
        asm volatile("s_nop 15\n\ts_nop 7" : "+v"(p0), "+v"(p1));
        float ma = at_max3(p0[0], p0[1], p1[0]), mb = at_max3(p0[2], p0[3], p1[1]); ma = at_max3(ma, p1[2], p1[3]);
#pragma unroll
        for (int r = 4; r < 16; r += 4) { ma = at_max3(ma, p0[r], p0[r + 1]); mb = at_max3(mb, p0[r + 2], p0[r + 3]); ma = at_max3(ma, p1[r], p1[r + 1]); mb = at_max3(mb, p1[r + 2], p1[r + 3]); }
        float mloc = at_max3(ma, mb, mrun);
        { const auto rr = __builtin_amdgcn_permlane32_swap(__float_as_uint(mloc), __float_as_uint(mloc), false, false); mloc = at_max3(__uint_as_float(rr[0]), __uint_as_float(rr[1]), mloc); }
        const float mnew = mloc, alpha = __builtin_amdgcn_exp2f(mrun - mnew);
        mrun = mnew; lsum *= alpha;
#pragma unroll
        for (int r = 0; r < 16; ++r) { o0[r] *= alpha; o1[r] *= alpha; }
        float ps = 0.f;
#pragma unroll
        for (int r = 0; r < 16; ++r) { p0[r] = __builtin_amdgcn_exp2f(p0[r] - mnew); p1[r] = __builtin_amdgcn_exp2f(p1[r] - mnew); ps += p0[r] + p1[r]; }
        lsum += ps;
        v4u pk[4];
#pragma unroll
        for (int s2 = 0; s2 < 2; ++s2) {
            pk[s2] = (v4u){pg8::cvt_pk_bf16(p0[8 * s2], p0[8 * s2 + 1]), pg8::cvt_pk_bf16(p0[8 * s2 + 2], p0[8 * s2 + 3]), pg8::cvt_pk_bf16(p0[8 * s2 + 4], p0[8 * s2 + 5]), pg8::cvt_pk_bf16(p0[8 * s2 + 6], p0[8 * s2 + 7])};
            pk[2 + s2] = (v4u){pg8::cvt_pk_bf16(p1[8 * s2], p1[8 * s2 + 1]), pg8::cvt_pk_bf16(p1[8 * s2 + 2], p1[8 * s2 + 3]), pg8::cvt_pk_bf16(p1[8 * s2 + 4], p1[8 * s2 + 5]), pg8::cvt_pk_bf16(p1[8 * s2 + 6], p1[8 * s2 + 7])};
        }
        { const LAS unsigned char* vb_ = bb + AT_KBYTES + r32 * AT_VP + hi * 8;
#pragma unroll
          for (int ks = 0; ks < 4; ++ks) {
              const bf16x8 pb = __builtin_bit_cast(bf16x8, pk[ks]);
              const bf16x8 v0 = mk_bf16x8(*(const LAS u64_t*)(vb_ + ks * 32), *(const LAS u64_t*)(vb_ + ks * 32 + 16));
              const bf16x8 v1 = mk_bf16x8(*(const LAS u64_t*)(vb_ + 32 * AT_VP + ks * 32), *(const LAS u64_t*)(vb_ + 32 * AT_VP + ks * 32 + 16));
              o0 = __builtin_amdgcn_mfma_f32_32x32x16_bf16(v0, pb, o0, 0, 0, 0);
              o1 = __builtin_amdgcn_mfma_f32_32x32x16_bf16(v1, pb, o1, 0, 0, 0); } }
    };
    for (int t = 0; t < NT; t += 2) {
        if (t + 2 < NT) AT_LOAD(kb0, kb1, vb, (t + 2) * 64);
        tile(t);
        AT_STORE(ka0, ka1, va, (t + 1) % 3);
        __syncthreads();
        if (t + 3 < NT) AT_LOAD(ka0, ka1, va, (t + 3) * 64);
        tile(t + 1);
        if (t + 2 < NT) AT_STORE(kb0, kb1, vb, (t + 2) % 3);
        __syncthreads();
    }
#undef AT_LOAD
#undef AT_STORE
    lsum += __shfl_xor(lsum, 32);
    const float inv = 1.f / lsum;
    bf16* Og = (bf16*)(F.ws + WS_OMLA) + ((size_t)b * SEQ + qb * 256 + wave * 32 + r32) * 384 + h * 64 + 4 * hi;
#pragma unroll
    for (int rg = 0; rg < 4; ++rg) {
        *(u64_t*)(Og + 8 * rg) = (u64_t)pg8::cvt_pk_bf16(o0[4 * rg] * inv, o0[4 * rg + 1] * inv) | ((u64_t)pg8::cvt_pk_bf16(o0[4 * rg + 2] * inv, o0[4 * rg + 3] * inv) << 32);
        *(u64_t*)(Og + 32 + 8 * rg) = (u64_t)pg8::cvt_pk_bf16(o1[4 * rg] * inv, o1[4 * rg + 1] * inv) | ((u64_t)pg8::cvt_pk_bf16(o1[4 * rg + 2] * inv, o1[4 * rg + 3] * inv) << 32);
    }
}

constexpr int CW_FLAG = 32768;
__device__ __forceinline__ void partner_sync(Frame& F, gu32* mine, gu32* theirs) {
    asm volatile("s_waitcnt vmcnt(0)" ::: "memory");
    __syncthreads();
    if (F.tid == 0) {
        __builtin_amdgcn_fence(__ATOMIC_RELEASE, "agent");
        asm volatile("s_waitcnt vmcnt(0)" ::: "memory");
        __hip_atomic_store(mine, 1u, RLX_AGENT);
        unsigned spins = 0;
        while (__hip_atomic_load(theirs, RLX_AGENT) == 0u) { __builtin_amdgcn_s_sleep(4); if (++spins > (1u << 22)) break; }
        __builtin_amdgcn_fence(__ATOMIC_ACQUIRE, "agent");
        asm volatile("s_waitcnt vmcnt(0)" ::: "memory");
    }
    __syncthreads();
}
constexpr int RW_STEP = 1440, RW_CH = 32, RW_BUF = RW_CH * RW_STEP;
constexpr int RW_Y = 2 * RW_BUF;
static_assert(RW_Y + 2 * 4096 <= RING_BYTES, "RWKV LDS map");
__device__ __forceinline__ float dpp_xor1(float x) { return __builtin_bit_cast(float, __builtin_amdgcn_update_dpp(0, __builtin_bit_cast(int, x), 0xB1, 0xF, 0xF, true)); }
__device__ __forceinline__ float dpp_xor2(float x) { return __builtin_bit_cast(float, __builtin_amdgcn_update_dpp(0, __builtin_bit_cast(int, x), 0x4E, 0xF, 0xF, true)); }
__device__ __forceinline__ float dpp_hmir(float x) { return __builtin_bit_cast(float, __builtin_amdgcn_update_dpp(0, __builtin_bit_cast(int, x), 0x141, 0xF, 0xF, true)); }
__device__ __forceinline__ float dpp_rmir(float x) { return __builtin_bit_cast(float, __builtin_amdgcn_update_dpp(0, __builtin_bit_cast(int, x), 0x140, 0xF, 0xF, true)); }
template <int CTRL, int RM> __device__ __forceinline__ float dpp_sh(float x) { return __builtin_bit_cast(float, __builtin_amdgcn_update_dpp(0, __builtin_bit_cast(int, x), CTRL, RM, 0xF, false)); }
__device__ __forceinline__ float wave_scan(float x) {
    x += dpp_sh<0x111, 0xF>(x); x += dpp_sh<0x112, 0xF>(x); x += dpp_sh<0x114, 0xF>(x); x += dpp_sh<0x118, 0xF>(x);
    x += dpp_sh<0x142, 0xA>(x); x += dpp_sh<0x143, 0xC>(x); return x; }
__device__ __forceinline__ float lane63(float x) { return __builtin_bit_cast(float, __builtin_amdgcn_readlane(__builtin_bit_cast(int, x), 63)); }
constexpr int GP = 144;
constexpr int G_Q = 0, G_K = 9216, G_V = 18432, G_KT = 27648, G_P = 36864, G_A = 46080, G_SM = 63488, G_GROUP = 64512;
constexpr int G_T = 92160;
constexpr int G_RAW = 65536;
constexpr int G_CW = 133120;
static_assert(2 * G_GROUP <= RING_BYTES && G_CW + 3840 <= LDS_BYTES && G_CW >= MISC_OFF + 1024, "GDN LDS map");
__device__ __forceinline__ bf16x8 ld2x8(const LAS unsigned char* p) { return mk_bf16x8(*(const LAS u64_t*)p, *(const LAS u64_t*)(p + 32)); }
__device__ __forceinline__ bf16x8 pack_acc(const f32x4& a, const f32x4& b) {
    v4u w; w.x = pg8::cvt_pk_bf16(a[0], a[1]); w.y = pg8::cvt_pk_bf16(a[2], a[3]); w.z = pg8::cvt_pk_bf16(b[0], b[1]); w.w = pg8::cvt_pk_bf16(b[2], b[3]); return __builtin_bit_cast(bf16x8, w); }
__device__ __forceinline__ void split_acc(const f32x4& a, const f32x4& b, bf16x8& hi, bf16x8& lo) {
    v4u wh; wh.x = cvt2bf(a[0], a[1]); wh.y = cvt2bf(a[2], a[3]); wh.z = cvt2bf(b[0], b[1]); wh.w = cvt2bf(b[2], b[3]);
    f32x4 ra, rb;
    ra[0] = a[0] - __uint_as_float(wh.x << 16); ra[1] = a[1] - __uint_as_float(wh.x & 0xffff0000u); ra[2] = a[2] - __uint_as_float(wh.y << 16); ra[3] = a[3] - __uint_as_float(wh.y & 0xffff0000u);
    rb[0] = b[0] - __uint_as_float(wh.z << 16); rb[1] = b[1] - __uint_as_float(wh.z & 0xffff0000u); rb[2] = b[2] - __uint_as_float(wh.w << 16); rb[3] = b[3] - __uint_as_float(wh.w & 0xffff0000u);
    hi = __builtin_bit_cast(bf16x8, wh); lo = pack_acc(ra, rb);
}
__device__ __forceinline__ void hilo4(const f32x4& a, u64_t& hi, u64_t& lo) {
    const unsigned h0 = cvt2bf(a[0], a[1]), h1 = cvt2bf(a[2], a[3]);
    const float r0 = a[0] - __uint_as_float(h0 << 16), r1 = a[1] - __uint_as_float(h0 & 0xffff0000u), r2 = a[2] - __uint_as_float(h1 << 16), r3 = a[3] - __uint_as_float(h1 & 0xffff0000u);
    hi = (u64_t)h0 | ((u64_t)h1 << 32); lo = (u64_t)cvt2bf(r0, r1) | ((u64_t)cvt2bf(r2, r3) << 32);
}
typedef _Float16 f16x8 __attribute__((ext_vector_type(8)));
typedef _Float16 h4_t __attribute__((ext_vector_type(4)));
__device__ __forceinline__ f16x8 pack_acc_f16(const f32x4& a, const f32x4& b) { return (f16x8){(_Float16)a[0], (_Float16)a[1], (_Float16)a[2], (_Float16)a[3], (_Float16)b[0], (_Float16)b[1], (_Float16)b[2], (_Float16)b[3]}; }
template <int J> __device__ __forceinline__ float dpp_rowbc(float x) { return __builtin_bit_cast(float, __builtin_amdgcn_update_dpp(0, __builtin_bit_cast(int, x), 0x150 + J, 0xF, 0xF, false)); }
template <int I, int J> struct TbbRow { static __device__ __forceinline__ void run(const float (&Mc)[16], const float (&T)[16], float& a0, float& a1) {
    if constexpr (J < I) { if constexpr (J & 1) a1 += dpp_rowbc<J>(Mc[I]) * T[J]; else a0 += dpp_rowbc<J>(Mc[I]) * T[J]; TbbRow<I, J + 1>::run(Mc, T, a0, a1); } } };
template <int I> struct TbbAll { static __device__ __forceinline__ void run(const float (&Mc)[16], float (&T)[16], int cc) {
    if constexpr (I < 16) { float a0 = 0.f, a1 = 0.f; TbbRow<I, 0>::run(Mc, T, a0, a1); T[I] = (I == cc ? 1.f : 0.f) - (a0 + a1); TbbAll<I + 1>::run(Mc, T, cc); } } };
__device__ __forceinline__ void tbb_wave(const LAS float* Mm, LAS float* Tm, int lane) {
    const int bb = lane >> 4, cc = lane & 15; float Mc[16], T[16];
    const LAS float* Mb = Mm + (16 * bb) * 68 + 16 * bb + cc;
#pragma unroll
    for (int i = 0; i < 16; ++i) Mc[i] = Mb[i * 68];
#pragma unroll
    for (int i = 0; i < 16; ++i) T[i] = 0.f;
    TbbAll<0>::run(Mc, T, cc);
#pragma unroll
    for (int i = 0; i < 16; ++i) Tm[(16 * bb + i) * 16 + cc] = T[i];
}
__device__ __forceinline__ void block_solve(const LAS float* Mm, const LAS float* Tm, int col, int q4, const f32x4 (&Yin)[4], f32x4 (&Xc)[4]) {
    u64_t th[4], tl[4], mh[6], ml[6];
#pragma unroll
    for (int bk = 0; bk < 4; ++bk) { const f32x4 tv = *(const LAS f32x4*)(Tm + (16 * bk + col) * 16 + 4 * q4); hilo4(tv, th[bk], tl[bk]); }
    { int n = 0;
#pragma unroll
      for (int bk = 1; bk < 4; ++bk)
#pragma unroll
          for (int b2 = 0; b2 < bk; ++b2) { const f32x4 mv = *(const LAS f32x4*)(Mm + (16 * bk + col) * 68 + 16 * b2 + 4 * q4); const f32x4 mn = -mv; hilo4(mn, mh[n], ml[n]); ++n; } }
    asm volatile("" ::: "memory");
    u64_t xh[4], xl[4];
#pragma unroll
    for (int bk = 0; bk < 4; ++bk) {
        f32x4 Y = Yin[bk];
#pragma unroll
        for (int b2 = 0; b2 < bk; b2 += 2) {
            const int n0 = bk * (bk - 1) / 2 + b2; const bool two = b2 + 1 < bk;
            const bf16x8 Ah = mk_bf16x8(mh[n0], two ? mh[n0 + 1] : 0ull), Al = mk_bf16x8(ml[n0], two ? ml[n0 + 1] : 0ull), Bh = mk_bf16x8(xh[b2], two ? xh[b2 + 1] : 0ull), Bl = mk_bf16x8(xl[b2], two ? xl[b2 + 1] : 0ull);
            Y = __builtin_amdgcn_mfma_f32_16x16x32_bf16(Al, Bh, Y, 0, 0, 0);
            Y = __builtin_amdgcn_mfma_f32_16x16x32_bf16(Ah, Bl, Y, 0, 0, 0);
            Y = __builtin_amdgcn_mfma_f32_16x16x32_bf16(Ah, Bh, Y, 0, 0, 0); }
        u64_t yh, yl; hilo4(Y, yh, yl);
        const bf16x8 Ah = mk_bf16x8(th[bk], 0ull), Al = mk_bf16x8(tl[bk], 0ull), Bh = mk_bf16x8(yh, 0ull), Bl = mk_bf16x8(yl, 0ull);
        f32x4 X = {0.f, 0.f, 0.f, 0.f};
        X = __builtin_amdgcn_mfma_f32_16x16x32_bf16(Al, Bh, X, 0, 0, 0);
        X = __builtin_amdgcn_mfma_f32_16x16x32_bf16(Ah, Bl, X, 0, 0, 0);
        X = __builtin_amdgcn_mfma_f32_16x16x32_bf16(Ah, Bh, X, 0, 0, 0);
        Xc[bk] = X; if (bk < 3) hilo4(X, xh[bk], xl[bk]);
    }
}
template <int SKIP> __device__ __forceinline__ void gdn_unit3(Frame& F, int l, int unit, gu32* flags) {
    const int bh = unit >> 1, dir = unit & 1, b = bh / 6, h = bh % 6;
    const int tid = F.tid, lane = F.lane, wave = F.wave;
    const bf16* Pgdn = (const bf16*)(F.ws + WS_PGDN) + (size_t)b * SEQ * 1152 + h * 64; const float* Psm = (const float*)(F.ws + WS_PSM) + (size_t)b * SEQ * 32;
    bf16* Og = (SKIP & 128) ? (bf16*)(F.ws + WS_Y + 8 * MiB) + (size_t)(b % 5) * SEQ * 384 + h * 64 : (bf16*)(F.ws + WS_OGDN) + (size_t)b * SEQ * 384 + h * 64;
    LAS unsigned char* gb = F.lds + RING_OFF;
    LAS float* cwl = (LAS float*)(F.lds + G_CW);
    LAS float* sm = (LAS float*)(gb + G_SM);
    { const float* conv_w = (const float*)inptr(F, 4) + (size_t)l * 5 * 1152;
      for (int i = tid; i < 960; i += 512) { const int tn = i / 320, tap = (i % 320) / 64, ch = i % 64; cwl[i] = conv_w[tap * 1152 + tn * 384 + h * 64 + ch]; } }
    const float al = -__expf(((const float*)inptr(F, 5))[l * 12 + dir * 6 + h]), dtb = ((const float*)inptr(F, 6))[l * 12 + dir * 6 + h];
    f32x4 Sacc[4];
#pragma unroll
    for (int i = 0; i < 4; ++i) Sacc[i] = (f32x4){0.f, 0.f, 0.f, 0.f};
    const int ci = tid >> 3, cg = tid & 7;
#define GDN_RAW_STAGE(cc_, first_, nthr_) do { const int tlo_ = (dir ? SEQ - 64 * (cc_) - 64 : 64 * (cc_)) - 2; \
        for (int pc_ = (first_); pc_ < 68 * 24; pc_ += (nthr_)) { const int rr_ = pc_ / 24, sg_ = pc_ % 24, tt_ = tlo_ + rr_; v4u x_ = {0u, 0u, 0u, 0u}; \
            if (!(SKIP & 1) && tt_ >= 0 && tt_ < SEQ) x_ = *(const v4u*)(Pgdn + (size_t)tt_ * 1152 + (sg_ >> 3) * 384 + 8 * (sg_ & 7)); \
            *(LAS v4u*)(gb + G_RAW + rr_ * 384 + 16 * sg_) = x_; } } while (0)
#define GDN_WRITEOUT(cc_) do { if (!(SKIP & 4)) { const int t_ = dir ? SEQ - 1 - 64 * (cc_) - ci : 64 * (cc_) + ci; bf16* op_ = Og + (size_t)t_ * 384 + 8 * cg; \
            const LAS f32x4* src_ = (const LAS f32x4*)(gb + G_A + (ci * 68 + 8 * cg) * 4); f32x4 o0_ = src_[0], o1_ = src_[1]; \
            if ((cc_) >= SEQ / 128) { const v4u p0_ = *(const v4u*)op_; \
                o0_ += (f32x4){__uint_as_float(p0_.x << 16), __uint_as_float(p0_.x & 0xffff0000u), __uint_as_float(p0_.y << 16), __uint_as_float(p0_.y & 0xffff0000u)}; \
                o1_ += (f32x4){__uint_as_float(p0_.z << 16), __uint_as_float(p0_.z & 0xffff0000u), __uint_as_float(p0_.w << 16), __uint_as_float(p0_.w & 0xffff0000u)}; } \
            v4u w0_; w0_.x = pg8::cvt_pk_bf16(o0_[0], o0_[1]); w0_.y = pg8::cvt_pk_bf16(o0_[2], o0_[3]); w0_.z = pg8::cvt_pk_bf16(o1_[0], o1_[1]); w0_.w = pg8::cvt_pk_bf16(o1_[2], o1_[3]); \
            *(v4u*)op_ = w0_; } } while (0)
    GDN_RAW_STAGE(0, tid, 512);
#define GDN_RAW_LOAD(cc_) do { const int tlo_ = (dir ? SEQ - 64 * (cc_) - 64 : 64 * (cc_)) - 2; \
        _Pragma("unroll") for (int k_ = 0; k_ < 4; ++k_) { const int pc_ = tid + 512 * k_, rr_ = pc_ / 24, sg_ = pc_ % 24, tt_ = tlo_ + rr_; rawn[k_] = (v4u){0u, 0u, 0u, 0u}; \
            if (!(SKIP & 1) && pc_ < 68 * 24 && tt_ >= 0 && tt_ < SEQ) rawn[k_] = *(const v4u*)(Pgdn + (size_t)tt_ * 1152 + (sg_ >> 3) * 384 + 8 * (sg_ & 7)); } } while (0)
#define GDN_RAW_STORE() do { _Pragma("unroll") for (int k_ = 0; k_ < 4; ++k_) { const int pc_ = tid + 512 * k_, rr_ = pc_ / 24, sg_ = pc_ % 24; \
            if (pc_ < 68 * 24) *(LAS v4u*)(gb + G_RAW + rr_ * 384 + 16 * sg_) = rawn[k_]; } } while (0)
    v4u rawn[4];
    __syncthreads();
    for (int c = 0; c < SEQ / 64; ++c) {
        if (c > 0) GDN_WRITEOUT(c - 1);
        if (c == SEQ / 128) partner_sync(F, flags + 64 * unit, flags + 64 * (unit ^ 1));
        if (!(SKIP & 64) && wave == 0) {
            const int t = dir ? SEQ - 1 - 64 * c - lane : 64 * c + lane;
            const float a = Psm[(size_t)t * 32 + dir * 6 + h], bt = Psm[(size_t)t * 32 + 12 + dir * 6 + h];
            float x = al * softplusf_(a + dtb);
            x = wave_scan(x);
            const float last = lane63(x);
            sm[lane] = x; sm[64 + lane] = sigmoidf_(bt); sm[128 + lane] = __expf(x); sm[192 + lane] = __expf(last - x);
        }
        if (!(SKIP & 16)) { float acc[3][8];
#pragma unroll
          for (int tn = 0; tn < 3; ++tn)
#pragma unroll
              for (int j = 0; j < 8; ++j) acc[tn][j] = 0.f;
          const int rr0 = dir ? 63 - ci : ci;
#pragma unroll
          for (int tap = 0; tap < 5; ++tap) {
#pragma unroll
              for (int tn = 0; tn < 3; ++tn) { const v4u x0 = *(const LAS v4u*)(gb + G_RAW + (rr0 + tap) * 384 + tn * 128 + 16 * cg); const LAS float* w = cwl + tn * 320 + tap * 64 + 8 * cg; const f32x4 w0 = *(const LAS f32x4*)w, w1 = *(const LAS f32x4*)(w + 4);
                  acc[tn][0] += w0[0] * __uint_as_float(x0[0] << 16); acc[tn][1] += w0[1] * __uint_as_float(x0[0] & 0xffff0000u); acc[tn][2] += w0[2] * __uint_as_float(x0[1] << 16); acc[tn][3] += w0[3] * __uint_as_float(x0[1] & 0xffff0000u);
                  acc[tn][4] += w1[0] * __uint_as_float(x0[2] << 16); acc[tn][5] += w1[1] * __uint_as_float(x0[2] & 0xffff0000u); acc[tn][6] += w1[2] * __uint_as_float(x0[3] << 16); acc[tn][7] += w1[3] * __uint_as_float(x0[3] & 0xffff0000u); }
              asm volatile("" ::: "memory"); }
          float sq = 0.f, sk = 0.f;
#pragma unroll
          for (int j = 0; j < 8; ++j) { acc[0][j] = siluf(acc[0][j]); acc[1][j] = siluf(acc[1][j]); acc[2][j] = siluf(acc[2][j]); sq += acc[0][j] * acc[0][j]; sk += acc[1][j] * acc[1][j]; }
          sq += dpp_xor1(sq); sk += dpp_xor1(sk); sq += dpp_xor2(sq); sk += dpp_xor2(sk); sq += dpp_hmir(sq); sk += dpp_hmir(sk);
          const float rq = rsqrtf(sq + 1e-6f) * 0.125f, rk = rsqrtf(sk + 1e-6f);
          v4u wq, wk, wv;
#pragma unroll
          for (int q = 0; q < 4; ++q) { wq[q] = pg8::cvt_pk_bf16(acc[0][2 * q] * rq, acc[0][2 * q + 1] * rq); wk[q] = pg8::cvt_pk_bf16(acc[1][2 * q] * rk, acc[1][2 * q + 1] * rk); wv[q] = pg8::cvt_pk_bf16(acc[2][2 * q], acc[2][2 * q + 1]); }
          LAS unsigned char* row = gb + ci * GP + 16 * cg;
          *(LAS v4u*)(row + G_Q) = wq; *(LAS v4u*)(row + G_K) = wk; *(LAS v4u*)(row + G_V) = wv;
#pragma unroll
          for (int j = 0; j < 8; ++j) *(LAS bf16*)(gb + G_KT + (8 * cg + j) * GP + 2 * ci) = (bf16)((j & 1) ? (wk[j >> 1] >> 16) : (wk[j >> 1] & 0xffffu)); }
        __syncthreads();
        if (c + 1 < SEQ / 64) GDN_RAW_LOAD(c + 1);
        if (!(SKIP & 32)) { const int ti = (wave >> 1) & 1, tj = wave & 1, r32 = lane & 31, hi = lane >> 5;
          f32x16 acc = {};
          const LAS unsigned char* ir = gb + (wave >= 4 ? G_Q : G_K) + (32 * ti + r32) * GP + 16 * hi; const LAS unsigned char* jr = gb + G_K + (32 * tj + r32) * GP + 16 * hi;
#pragma unroll
          for (int s = 0; s < 4; ++s) acc = __builtin_amdgcn_mfma_f32_32x32x16_bf16(*(const LAS bf16x8*)(jr + 32 * s), *(const LAS bf16x8*)(ir + 32 * s), acc, 0, 0, 0);
          const int i = 32 * ti + r32; const float ci = sm[i];
          if (wave < 4) { const float bi = sm[64 + i];
#pragma unroll
              for (int g = 0; g < 4; ++g) { const int j0 = 32 * tj + 8 * g + 4 * hi; const f32x4 cj = *(const LAS f32x4*)(sm + j0); f32x4 o;
#pragma unroll
                  for (int r = 0; r < 4; ++r) o[r] = (i > j0 + r) ? bi * acc[4 * g + r] * __expf(fminf(ci - cj[r], 0.f)) : 0.f;
                  *(LAS f32x4*)((LAS float*)(gb + G_A) + i * 68 + j0) = o; } }
          else {
#pragma unroll
              for (int g = 0; g < 4; ++g) { const int j0 = 32 * tj + 8 * g + 4 * hi; const f32x4 cj = *(const LAS f32x4*)(sm + j0); h4_t o;
#pragma unroll
                  for (int r = 0; r < 4; ++r) o[r] = (_Float16)((i >= j0 + r) ? acc[4 * g + r] * __expf(fminf(ci - cj[r], 0.f)) : 0.f);
                  *(LAS h4_t*)(gb + G_P + i * GP + 2 * j0) = o; } } }
        __syncthreads();
        if (!(SKIP & 2) && wave == 0) tbb_wave((const LAS float*)(gb + G_A), (LAS float*)(gb + G_T), lane);
        __syncthreads();
        f32x4 Xc[4];
#pragma unroll
        for (int g = 0; g < 4; ++g) Xc[g] = (f32x4){0.f, 0.f, 0.f, 0.f};
        if (!(SKIP & 2)) {
            const int col = lane & 15, q4 = lane >> 4, cidx = 16 * wave + col;
            f32x4 Yin[4];
            if (wave < 4) {
#pragma unroll
                for (int bk = 0; bk < 4; ++bk) { const f32x4 be = *(const LAS f32x4*)(sm + 64 + 16 * bk + 4 * q4);
#pragma unroll
                    for (int r = 0; r < 4; ++r) Yin[bk][r] = bf2f(*(const LAS bf16*)(gb + G_V + (16 * bk + 4 * q4 + r) * GP + 2 * cidx)) * be[r]; }
            } else {
#pragma unroll
                for (int bk = 0; bk < 4; ++bk) { const f32x4 be = *(const LAS f32x4*)(sm + 64 + 16 * bk + 4 * q4), ga = *(const LAS f32x4*)(sm + 128 + 16 * bk + 4 * q4);
                    Yin[bk] = bf4(*(const LAS u64_t*)(gb + G_KT + (cidx - 64) * GP + 2 * (16 * bk + 4 * q4))) * be * ga; }
            }
            block_solve((const LAS float*)(gb + G_A), (const LAS float*)(gb + G_T), col, q4, Yin, Xc);
        }
        __syncthreads();
        if (c + 1 < SEQ / 64) GDN_RAW_STORE();
        { const int col = lane & 15, q4 = lane >> 4, c = 16 * wave + col;
          if (wave < 4) {
#pragma unroll
              for (int g = 0; g < 4; ++g)
#pragma unroll
                  for (int r = 0; r < 4; ++r) ((LAS float*)(gb + G_A))[(16 * g + 4 * q4 + r) * 68 + c] = Xc[g][r];
          } else {
#pragma unroll
              for (int g = 0; g < 4; ++g)
#pragma unroll
                  for (int r = 0; r < 4; ++r) { const int i = 16 * g + 4 * q4 + r; const float x = -Xc[g][r]; const unsigned hb = f2bf(x);
                      *(LAS bf16*)(gb + G_V + i * GP + 2 * (c - 64)) = (bf16)hb;
                      *(LAS bf16*)(gb + G_K + i * GP + 2 * (c - 64)) = (bf16)f2bf(x - __uint_as_float(hb << 16)); }
          } }
        __syncthreads();
        if ((SKIP & 8) && wave < 4) {} else
        if (wave < 4) { const int col = lane & 15, q4 = lane >> 4, e = 16 * wave + col;
          bf16x8 bS0, bS1, bS0l, bS1l; split_acc(Sacc[0], Sacc[1], bS0, bS0l); split_acc(Sacc[2], Sacc[3], bS1, bS1l);
          f32x4 U[4], T1[4];
          const LAS unsigned char* rowa = gb + col * GP + 8 * q4;
#pragma unroll
          for (int it = 0; it < 4; ++it) {
              const LAS float* u0p = (const LAS float*)(gb + G_A) + (16 * it + 4 * q4) * 68 + e;
              U[it] = (f32x4){u0p[0], u0p[68], u0p[136], u0p[204]};
              const LAS unsigned char* ra = rowa + 16 * it * GP;
              const bf16x8 wh0 = ld2x8(ra + G_V), wh1 = ld2x8(ra + G_V + 64), wl0 = ld2x8(ra + G_K), wl1 = ld2x8(ra + G_K + 64), qa0 = ld2x8(ra + G_Q), qa1 = ld2x8(ra + G_Q + 64);
              U[it] = __builtin_amdgcn_mfma_f32_16x16x32_bf16(wl0, bS0, U[it], 0, 0, 0);
              U[it] = __builtin_amdgcn_mfma_f32_16x16x32_bf16(wl1, bS1, U[it], 0, 0, 0);
              U[it] = __builtin_amdgcn_mfma_f32_16x16x32_bf16(wh0, bS0l, U[it], 0, 0, 0);
              U[it] = __builtin_amdgcn_mfma_f32_16x16x32_bf16(wh1, bS1l, U[it], 0, 0, 0);
              U[it] = __builtin_amdgcn_mfma_f32_16x16x32_bf16(wh0, bS0, U[it], 0, 0, 0);
              U[it] = __builtin_amdgcn_mfma_f32_16x16x32_bf16(wh1, bS1, U[it], 0, 0, 0);
              T1[it] = __builtin_amdgcn_mfma_f32_16x16x32_bf16(qa0, bS0l, (f32x4){0.f, 0.f, 0.f, 0.f}, 0, 0, 0);
              T1[it] = __builtin_amdgcn_mfma_f32_16x16x32_bf16(qa1, bS1l, T1[it], 0, 0, 0);
              T1[it] = __builtin_amdgcn_mfma_f32_16x16x32_bf16(qa0, bS0, T1[it], 0, 0, 0);
              T1[it] = __builtin_amdgcn_mfma_f32_16x16x32_bf16(qa1, bS1, T1[it], 0, 0, 0);
              asm volatile("" ::: "memory");
          }
          const f16x8 hU0 = pack_acc_f16(U[0], U[1]), hU1 = pack_acc_f16(U[2], U[3]);
          f32x4 Ud[4];
#pragma unroll
          for (int it = 0; it < 4; ++it) { const f32x4 dc = *(const LAS f32x4*)(sm + 192 + 16 * it + 4 * q4); Ud[it] = U[it] * dc; }
          bf16x8 bD0, bD1, bD0l, bD1l; split_acc(Ud[0], Ud[1], bD0, bD0l); split_acc(Ud[2], Ud[3], bD1, bD1l);
          const float gend = sm[191];
#pragma unroll
          for (int it = 0; it < 4; ++it) {
              const LAS unsigned char* ra = rowa + 16 * it * GP;
              const f32x4 gm = *(const LAS f32x4*)(sm + 128 + 16 * it + 4 * q4);
              const bf16x8 pa0 = ld2x8(ra + G_P), pa1 = ld2x8(ra + G_P + 64), ka0 = ld2x8(ra + G_KT), ka1 = ld2x8(ra + G_KT + 64);
              f32x4 O = T1[it] * gm;
              O = __builtin_amdgcn_mfma_f32_16x16x32_f16(__builtin_bit_cast(f16x8, pa0), hU0, O, 0, 0, 0);
              O = __builtin_amdgcn_mfma_f32_16x16x32_f16(__builtin_bit_cast(f16x8, pa1), hU1, O, 0, 0, 0);
              f32x4 Sn = Sacc[it] * gend;
              Sn = __builtin_amdgcn_mfma_f32_16x16x32_bf16(ka0, bD0l, Sn, 0, 0, 0);
              Sn = __builtin_amdgcn_mfma_f32_16x16x32_bf16(ka1, bD1l, Sn, 0, 0, 0);
              Sn = __builtin_amdgcn_mfma_f32_16x16x32_bf16(ka0, bD0, Sn, 0, 0, 0);
              Sn = __builtin_amdgcn_mfma_f32_16x16x32_bf16(ka1, bD1, Sn, 0, 0, 0);
              Sacc[it] = Sn;
#pragma unroll
              for (int r = 0; r < 4; ++r) ((LAS float*)(gb + G_A))[(16 * it + 4 * q4 + r) * 68 + e] = O[r];
              asm volatile("" ::: "memory");
          } }
        __syncthreads();
    }
    GDN_WRITEOUT(SEQ / 64 - 1);
#undef GDN_WRITEOUT
#undef GDN_RAW_STAGE
#undef GDN_RAW_LOAD
#undef GDN_RAW_STORE
    __syncthreads();
}

constexpr int RC_AT = 0, RC_RT = 9216, RC_BT = 18432, RC_KT = 27648, RC_BH = 36864, RC_KH = 46080, RC_VT = 55296, RC_V = 64512, RC_A = 73728  ,
              RC_AK = 91136, RC_RB = 100352, RC_RK = 109568, RC_T = 118784  , RC_SM = 122880  , RC_R2 = RC_BT  ;
static_assert(RC_SM + 256 <= RING_BYTES && RC_R2 + 17408 <= RC_BH, "chunked RWKV LDS map");
template <int SK> __device__ __forceinline__ void rwkv_unit_c(Frame& F, int unit, gu32* flags) {
    const int bh = unit >> 1, dir = unit & 1, b = bh >> 2, h = bh & 3;
    const int tid = F.tid, lane = F.lane, wave = F.wave;
    const unsigned char* Rs = F.ws + WS_RS;
    const unsigned char* Rd = F.ws + WS_RD + dir * RD_DIR;
    bf16* Yg = (bf16*)(F.ws + WS_Y + (SK ? 8 * MiB : 0)) + (size_t)b * SEQ * 256 + h * 64;
    LAS unsigned char* gb = F.lds + RING_OFF;
    LAS float* gamT = (LAS float*)(gb + RC_SM);
    f32x4 Zacc[4];
#pragma unroll
    for (int i = 0; i < 4; ++i) Zacc[i] = (f32x4){0.f, 0.f, 0.f, 0.f};
    const int ci = tid >> 3, cg = tid & 7;
#define RC_WRITEOUT(cc_) do { const int t_ = dir ? SEQ - 1 - 64 * (cc_) - ci : 64 * (cc_) + ci; bf16* op_ = Yg + (size_t)t_ * 256 + 8 * cg; \
        const LAS f32x4* src_ = (const LAS f32x4*)(gb + RC_A + (ci * 68 + 8 * cg) * 4); f32x4 o0_ = src_[0], o1_ = src_[1]; \
        if ((cc_) >= SEQ / 128) { const v4u p0_ = *(const v4u*)op_; \
            o0_ += (f32x4){__uint_as_float(p0_.x << 16), __uint_as_float(p0_.x & 0xffff0000u), __uint_as_float(p0_.y << 16), __uint_as_float(p0_.y & 0xffff0000u)}; \
            o1_ += (f32x4){__uint_as_float(p0_.z << 16), __uint_as_float(p0_.z & 0xffff0000u), __uint_as_float(p0_.w << 16), __uint_as_float(p0_.w & 0xffff0000u)}; } \
        v4u w0_; w0_.x = pg8::cvt_pk_bf16(o0_[0], o0_[1]); w0_.y = pg8::cvt_pk_bf16(o0_[2], o0_[3]); w0_.z = pg8::cvt_pk_bf16(o1_[0], o1_[1]); w0_.w = pg8::cvt_pk_bf16(o1_[2], o1_[3]); \
        *(v4u*)op_ = w0_; } while (0)
    v4u gkk = {0u, 0u, 0u, 0u}, gv = gkk, gr = gkk, glam = gkk, gbv = gkk, gk = gkk;
#define RC_LOAD(cc_) do { if (!(SK & 1)) { const size_t o_ = rw_rec_off(bh, dir ? SEQ - 1 - 64 * (cc_) - lane : 64 * (cc_) + lane, 0, wave); const unsigned char* rs_ = Rs + o_; const unsigned char* rd_ = Rd + o_; \
        gkk = *(const v4u*)rs_; gv = *(const v4u*)(rs_ + 8192); gr = *(const v4u*)(rs_ + 16384); glam = *(const v4u*)rd_; gbv = *(const v4u*)(rd_ + 8192); gk = *(const v4u*)(rd_ + 16384); } } while (0)
    RC_LOAD(0);
    __syncthreads();
    for (int c = 0; c < SEQ / 64; ++c) {
        if (c > 0) RC_WRITEOUT(c - 1);
        if (c == SEQ / 128) partner_sync(F, flags + 64 * unit, flags + 64 * (unit ^ 1));
        if (!(SK & 32)) { const int t = lane, tok = dir ? SEQ - 1 - 64 * c - t : 64 * c + t, j0 = 8 * wave;
          float lam[8], cum[8];
#pragma unroll
          for (int q = 0; q < 4; ++q) { lam[2 * q] = __half2float(__ushort_as_half((unsigned short)(glam[q] & 0xffffu))); lam[2 * q + 1] = __half2float(__ushort_as_half((unsigned short)(glam[q] >> 16))); }
#pragma unroll
          for (int q = 0; q < 8; ++q) cum[q] = wave_scan(lam[q]);
          v4u wa = {0u, 0u, 0u, 0u}, wr = {0u, 0u, 0u, 0u}, wb = {0u, 0u, 0u, 0u}, wk = {0u, 0u, 0u, 0u}; unsigned short bh_[8], kh_[8];
#pragma unroll
          for (int q = 0; q < 8; ++q) { const float cT = lane63(cum[q]);
              const float e1 = __builtin_amdgcn_exp2f(-LOG2E * (cum[q] - lam[q])), e2 = __builtin_amdgcn_exp2f(-LOG2E * cum[q]), e3 = __builtin_amdgcn_exp2f(LOG2E * cum[q]), e4 = __builtin_amdgcn_exp2f(-LOG2E * (cT - cum[q]));
              const float kkq = __uint_as_float((q & 1) ? (gkk[q >> 1] & 0xffff0000u) : (gkk[q >> 1] << 16)), rq = __uint_as_float((q & 1) ? (gr[q >> 1] & 0xffff0000u) : (gr[q >> 1] << 16));
              const float bq = __uint_as_float((q & 1) ? (gbv[q >> 1] & 0xffff0000u) : (gbv[q >> 1] << 16)), kq = __uint_as_float((q & 1) ? (gk[q >> 1] & 0xffff0000u) : (gk[q >> 1] << 16));
              const unsigned a16 = f2bf(-kkq * e1), r16 = f2bf(rq * e2), b16 = f2bf(bq * e3), k16 = f2bf(kq * e3);
              if (q & 1) { wa[q >> 1] |= a16 << 16; wr[q >> 1] |= r16 << 16; wb[q >> 1] |= b16 << 16; wk[q >> 1] |= k16 << 16; } else { wa[q >> 1] = a16; wr[q >> 1] = r16; wb[q >> 1] = b16; wk[q >> 1] = k16; }
              bh_[q] = (unsigned short)f2bf(bq * e4); kh_[q] = (unsigned short)f2bf(kq * e4);
              if (lane == 63) gamT[j0 + q] = e2; }
          LAS unsigned char* row = gb + t * GP + 2 * j0;
          *(LAS v4u*)(row + RC_AT) = wa; *(LAS v4u*)(row + RC_RT) = wr; *(LAS v4u*)(row + RC_BT) = wb; *(LAS v4u*)(row + RC_KT) = wk; *(LAS v4u*)(row + RC_V) = gv;
#pragma unroll
          for (int q = 0; q < 8; ++q) { LAS unsigned char* tr = gb + (j0 + q) * GP + 2 * t;
              *(LAS bf16*)(tr + RC_BH) = bh_[q]; *(LAS bf16*)(tr + RC_KH) = kh_[q];
              *(LAS bf16*)(tr + RC_VT) = (bf16)((q & 1) ? (gv[q >> 1] >> 16) : (gv[q >> 1] & 0xffffu)); } }
        __syncthreads();
        if (c + 1 < SEQ / 64) RC_LOAD(c + 1);
        if (!(SK & 2)) { const int rb = wave >> 1, r32 = lane & 31, hi = lane >> 5;
          const LAS unsigned char* xr = gb + (rb < 2 ? RC_AT : RC_RT) + (32 * (rb & 1) + r32) * GP + 16 * hi; const int tt = 32 * (rb & 1) + r32;
#pragma unroll
          for (int k2 = 0; k2 < 2; ++k2) { const int cb = 2 * (wave & 1) + k2;
              const LAS unsigned char* yr = gb + (cb < 2 ? RC_BT : RC_KT) + (32 * (cb & 1) + r32) * GP + 16 * hi;
              f32x16 acc = {};
#pragma unroll
              for (int s = 0; s < 4; ++s) acc = __builtin_amdgcn_mfma_f32_32x32x16_bf16(*(const LAS bf16x8*)(yr + 32 * s), *(const LAS bf16x8*)(xr + 32 * s), acc, 0, 0, 0);
              if (rb < 2 && cb < 2) {
#pragma unroll
                  for (int g = 0; g < 4; ++g) { const int s0 = 32 * (cb & 1) + 8 * g + 4 * hi; f32x4 o;
#pragma unroll
                      for (int r = 0; r < 4; ++r) o[r] = (tt > s0 + r) ? -acc[4 * g + r] : 0.f;
                      *(LAS f32x4*)((LAS float*)(gb + RC_A) + tt * 68 + s0) = o; } }
              else { const int incl = rb >= 2 ? 1 : 0; LAS unsigned char* dst = gb + (rb < 2 ? RC_AK : (cb < 2 ? RC_RB : RC_RK)) + tt * GP;
#pragma unroll
                  for (int g = 0; g < 4; ++g) { const int s0 = 32 * (cb & 1) + 8 * g + 4 * hi; f32x4 o;
#pragma unroll
                      for (int r = 0; r < 4; ++r) o[r] = (tt + incl > s0 + r) ? acc[4 * g + r] : 0.f;
                      *(LAS u64_t*)(dst + 2 * s0) = (u64_t)pg8::cvt_pk_bf16(o[0], o[1]) | ((u64_t)pg8::cvt_pk_bf16(o[2], o[3]) << 32); } } } }
        __syncthreads();
        if (!(SK & 4)) { const int col = lane & 15, q4 = lane >> 4, it = wave >> 1;
#pragma unroll
          for (int k2 = 0; k2 < 2; ++k2) { const int ct = 2 * (wave & 1) + k2; f32x4 acc = {0.f, 0.f, 0.f, 0.f};
              const LAS unsigned char* pa = gb + RC_AK + (16 * it + col) * GP + 8 * q4; const LAS unsigned char* pb = gb + RC_VT + (16 * ct + col) * GP + 8 * q4;
              acc = __builtin_amdgcn_mfma_f32_16x16x32_bf16(ld2x8(pa), ld2x8(pb), acc, 0, 0, 0);
              acc = __builtin_amdgcn_mfma_f32_16x16x32_bf16(ld2x8(pa + 64), ld2x8(pb + 64), acc, 0, 0, 0);
#pragma unroll
              for (int r = 0; r < 4; ++r) ((LAS float*)(gb + RC_R2))[(16 * it + 4 * q4 + r) * 68 + 16 * ct + col] = acc[r]; } }
        if (!(SK & 4) && wave == 0) tbb_wave((const LAS float*)(gb + RC_A), (LAS float*)(gb + RC_T), lane);
        __syncthreads();
        f32x4 Xc[4];
#pragma unroll
        for (int g = 0; g < 4; ++g) Xc[g] = (f32x4){0.f, 0.f, 0.f, 0.f};
        if (!(SK & 8)) { const int col = lane & 15, q4 = lane >> 4, cidx = 16 * wave + col;
          f32x4 Yin[4];
          if (wave < 4) {
#pragma unroll
              for (int bk = 0; bk < 4; ++bk)
#pragma unroll
                  for (int r = 0; r < 4; ++r) Yin[bk][r] = bf2f(*(const LAS bf16*)(gb + RC_AT + (16 * bk + 4 * q4 + r) * GP + 2 * cidx));
          } else {
#pragma unroll
              for (int bk = 0; bk < 4; ++bk)
#pragma unroll
                  for (int r = 0; r < 4; ++r) Yin[bk][r] = ((const LAS float*)(gb + RC_R2))[(16 * bk + 4 * q4 + r) * 68 + (cidx - 64)];
          }
          block_solve((const LAS float*)(gb + RC_A), (const LAS float*)(gb + RC_T), col, q4, Yin, Xc); }
        __syncthreads();
        { const int col = lane & 15, q4 = lane >> 4, cidx = 16 * wave + col;
          if (wave < 4) {
#pragma unroll
              for (int g = 0; g < 4; ++g)
#pragma unroll
                  for (int r = 0; r < 4; ++r) { const int i = 16 * g + 4 * q4 + r; const float x = Xc[g][r]; const unsigned hb = f2bf(x);
                      *(LAS bf16*)(gb + RC_AT + i * GP + 2 * cidx) = (bf16)hb; *(LAS bf16*)(gb + RC_AK + i * GP + 2 * cidx) = (bf16)f2bf(x - __uint_as_float(hb << 16)); }
          } else {
#pragma unroll
              for (int g = 0; g < 4; ++g)
#pragma unroll
                  for (int r = 0; r < 4; ++r) ((LAS float*)(gb + RC_A))[(16 * g + 4 * q4 + r) * 68 + (cidx - 64)] = Xc[g][r];
          } }
        __syncthreads();
        if (!(SK & 16) && wave < 4) { const int col = lane & 15, q4 = lane >> 4, e = 16 * wave + col;
          bf16x8 bZ0, bZ1, bZ0l, bZ1l; split_acc(Zacc[0], Zacc[1], bZ0, bZ0l); split_acc(Zacc[2], Zacc[3], bZ1, bZ1l);
          f32x4 U[4], Yo[4], Vc[4];
          const LAS unsigned char* rowa = gb + col * GP + 8 * q4;
#pragma unroll
          for (int it = 0; it < 4; ++it) {
              const LAS float* u0p = (const LAS float*)(gb + RC_A) + (16 * it + 4 * q4) * 68 + e;
              U[it] = (f32x4){u0p[0], u0p[68], u0p[136], u0p[204]};
#pragma unroll
              for (int r = 0; r < 4; ++r) Vc[it][r] = bf2f(*(const LAS bf16*)(gb + RC_V + (16 * it + 4 * q4 + r) * GP + 2 * e));
              const LAS unsigned char* ra = rowa + 16 * it * GP;
              const bf16x8 wh0 = ld2x8(ra + RC_AT), wh1 = ld2x8(ra + RC_AT + 64), wl0 = ld2x8(ra + RC_AK), wl1 = ld2x8(ra + RC_AK + 64), qa0 = ld2x8(ra + RC_RT), qa1 = ld2x8(ra + RC_RT + 64);
              U[it] = __builtin_amdgcn_mfma_f32_16x16x32_bf16(wl0, bZ0, U[it], 0, 0, 0);
              U[it] = __builtin_amdgcn_mfma_f32_16x16x32_bf16(wl1, bZ1, U[it], 0, 0, 0);
              U[it] = __builtin_amdgcn_mfma_f32_16x16x32_bf16(wh0, bZ0l, U[it], 0, 0, 0);
              U[it] = __builtin_amdgcn_mfma_f32_16x16x32_bf16(wh1, bZ1l, U[it], 0, 0, 0);
              U[it] = __builtin_amdgcn_mfma_f32_16x16x32_bf16(wh0, bZ0, U[it], 0, 0, 0);
              U[it] = __builtin_amdgcn_mfma_f32_16x16x32_bf16(wh1, bZ1, U[it], 0, 0, 0);
              Yo[it] = __builtin_amdgcn_mfma_f32_16x16x32_bf16(qa0, bZ0l, (f32x4){0.f, 0.f, 0.f, 0.f}, 0, 0, 0);
              Yo[it] = __builtin_amdgcn_mfma_f32_16x16x32_bf16(qa1, bZ1l, Yo[it], 0, 0, 0);
              Yo[it] = __builtin_amdgcn_mfma_f32_16x16x32_bf16(qa0, bZ0, Yo[it], 0, 0, 0);
              Yo[it] = __builtin_amdgcn_mfma_f32_16x16x32_bf16(qa1, bZ1, Yo[it], 0, 0, 0);
              asm volatile("" ::: "memory");
          }
          bf16x8 bU0, bU1, bU0l, bU1l; split_acc(U[0], U[1], bU0, bU0l); split_acc(U[2], U[3], bU1, bU1l);
          const bf16x8 bV0 = pack_acc(Vc[0], Vc[1]), bV1 = pack_acc(Vc[2], Vc[3]);
#pragma unroll
          for (int it = 0; it < 4; ++it) {
              const LAS unsigned char* ra = rowa + 16 * it * GP;
              const bf16x8 pb0 = ld2x8(ra + RC_RB), pb1 = ld2x8(ra + RC_RB + 64), pk0 = ld2x8(ra + RC_RK), pk1 = ld2x8(ra + RC_RK + 64);
              const bf16x8 hb0 = ld2x8(ra + RC_BH), hb1 = ld2x8(ra + RC_BH + 64), hk0 = ld2x8(ra + RC_KH), hk1 = ld2x8(ra + RC_KH + 64);
              f32x4 O = Yo[it];
              O = __builtin_amdgcn_mfma_f32_16x16x32_bf16(pb0, bU0l, O, 0, 0, 0);
              O = __builtin_amdgcn_mfma_f32_16x16x32_bf16(pb1, bU1l, O, 0, 0, 0);
              O = __builtin_amdgcn_mfma_f32_16x16x32_bf16(pk0, bV0, O, 0, 0, 0);
              O = __builtin_amdgcn_mfma_f32_16x16x32_bf16(pk1, bV1, O, 0, 0, 0);
              O = __builtin_amdgcn_mfma_f32_16x16x32_bf16(pb0, bU0, O, 0, 0, 0);
              O = __builtin_amdgcn_mfma_f32_16x16x32_bf16(pb1, bU1, O, 0, 0, 0);
              const f32x4 gz = *(const LAS f32x4*)(gamT + 16 * it + 4 * q4);
              f32x4 Zn = Zacc[it] * gz;
              Zn = __builtin_amdgcn_mfma_f32_16x16x32_bf16(hb0, bU0l, Zn, 0, 0, 0);
              Zn = __builtin_amdgcn_mfma_f32_16x16x32_bf16(hb1, bU1l, Zn, 0, 0, 0);
              Zn = __builtin_amdgcn_mfma_f32_16x16x32_bf16(hk0, bV0, Zn, 0, 0, 0);
              Zn = __builtin_amdgcn_mfma_f32_16x16x32_bf16(hk1, bV1, Zn, 0, 0, 0);
              Zn = __builtin_amdgcn_mfma_f32_16x16x32_bf16(hb0, bU0, Zn, 0, 0, 0);
              Zn = __builtin_amdgcn_mfma_f32_16x16x32_bf16(hb1, bU1, Zn, 0, 0, 0);
              Zacc[it] = Zn;
#pragma unroll
              for (int r = 0; r < 4; ++r) ((LAS float*)(gb + RC_A))[(16 * it + 4 * q4 + r) * 68 + e] = O[r];
              asm volatile("" ::: "memory");
          } }
        __syncthreads();
    }
    RC_WRITEOUT(SEQ / 64 - 1);
#undef RC_WRITEOUT
#undef RC_LOAD
    __syncthreads();
}
__device__ __forceinline__ int next_unit(Frame& F, gu32* head) {
    __syncthreads();
    if (F.tid == 0) F.MISC[16] = __hip_atomic_fetch_add(head, 1u, RLX_AGENT);
    __syncthreads();
    return (int)F.MISC[16];
}
constexpr int U_GDN = 96, U_RWKV = 64, U_ATT = 384, U_ALL = U_GDN + U_RWKV + U_ATT;
template <int DUMMY> __device__ __forceinline__ void p3_mixers(Frame& F, int l, int rep) {
    gu32* head = F.ctl + CW_QUEUE + 64 * (2 * l + rep);
    for (;;) {
        const int u = next_unit(F, head);
        if (u >= U_ALL) break;
        asm volatile("" : "+v"(F.tid), "+v"(F.lane));
        if (u < U_GDN) {
#ifdef EXP_GDN
            gdn_unit3<EXP_GDN>(F, l, u, F.ctl + CW_FLAG + 64 * 256 * (4 + 2 * l + rep) + 64 * 128); asm volatile("" : "+v"(F.tid), "+v"(F.lane));
#endif
            gdn_unit3<DUMMY ? 128 : 0>(F, l, u, F.ctl + CW_FLAG + 64 * 256 * (2 * l + rep) + 64 * 128); }
        else if (u < U_GDN + U_RWKV) {
#ifdef EXP_RWKV
            rwkv_unit_c<EXP_RWKV>(F, u - U_GDN, F.ctl + CW_FLAG + 64 * 256 * (4 + 2 * l + rep)); asm volatile("" : "+v"(F.tid), "+v"(F.lane));
#endif
            rwkv_unit_c<DUMMY ? 64 : 0>(F, u - U_GDN, F.ctl + CW_FLAG + 64 * 256 * (2 * l + rep)); }
        else {
#ifdef EXP_ATT
            attn_unit(F, u - U_GDN - U_RWKV); asm volatile("" : "+v"(F.tid), "+v"(F.lane));
#endif
            attn_unit(F, u - U_GDN - U_RWKV); }
    }
}
__device__ __forceinline__ u64_t pk4(const f32x4& v) { return (u64_t)pg8::cvt_pk_bf16(v[0], v[1]) | ((u64_t)pg8::cvt_pk_bf16(v[2], v[3]) << 32); }
__device__ __forceinline__ void p2_mla_unit(Frame& F, int l, int unit) {
    const int lane = F.lane, col = lane & 15, q4 = lane >> 4, m = 16 * unit + col, b = m / SEQ, t = m % SEQ, t0 = (16 * unit) % SEQ;
    const bf16* prow = (const bf16*)(F.ws + WS_PMLA) + (size_t)m * 352;
    const bf16* WuqT = (const bf16*)(F.ws + WS_WSMALL + OFF_WUQ) + (size_t)l * 576 * 192 + (size_t)col * 192 + 8 * q4;
    const bf16* WukvT = (const bf16*)(F.ws + WS_WSMALL + OFF_WUKV) + (size_t)l * 768 * 128 + (size_t)col * 128 + 8 * q4;
    bf16x8 aq[6], akv[4]; float sq = 0.f, skv = 0.f;
#pragma unroll
    for (int s = 0; s < 6; ++s) { aq[s] = *(const bf16x8*)(prow + 32 * s + 8 * q4); const v4u u = __builtin_bit_cast(v4u, aq[s]);
#pragma unroll
        for (int i = 0; i < 4; ++i) { const float a = __uint_as_float(u[i] << 16), c = __uint_as_float(u[i] & 0xffff0000u); sq += a * a + c * c; } }
#pragma unroll
    for (int s = 0; s < 4; ++s) { akv[s] = *(const bf16x8*)(prow + 192 + 32 * s + 8 * q4); const v4u u = __builtin_bit_cast(v4u, akv[s]);
#pragma unroll
        for (int i = 0; i < 4; ++i) { const float a = __uint_as_float(u[i] << 16), c = __uint_as_float(u[i] & 0xffff0000u); skv += a * a + c * c; } }
    sq += __shfl_xor(sq, 16); sq += __shfl_xor(sq, 32); skv += __shfl_xor(skv, 16); skv += __shfl_xor(skv, 32);
    const float rq = rsqrtf(sq * (1.f / 192.f) + NORM_EPS) * (0.10206207261596575f * LOG2E), rkv = rsqrtf(skv * (1.f / 128.f) + NORM_EPS);
    const float pos = (float)((const int*)inptr(F, 1))[m];
    f32x4 cs, sn;
#pragma unroll
    for (int r = 0; r < 4; ++r) { const float inv = exp2f(-(float)(4 * q4 + r) * (13.287712379549449f / 16.f)); float s_, c_; sincosf(pos * inv, &s_, &c_); cs[r] = c_; sn[r] = s_; }
    bf16* Qo = (bf16*)(F.ws + WS_Q) + ((size_t)b * 6 * SEQ + t) * 96 + 4 * q4;
    bf16* Ko = (bf16*)(F.ws + WS_K) + ((size_t)b * 6 * SEQ + t) * 96 + 4 * q4;
    bf16* Vo = (bf16*)(F.ws + WS_VT) + (size_t)b * 6 * 64 * SEQ + (size_t)col * SEQ + t0 + 4 * q4;
    { const u64_t x1 = *(const u64_t*)(prow + 320 + 4 * q4), x2 = *(const u64_t*)(prow + 336 + 4 * q4); const f32x4 a = bf4(x1), c = bf4(x2);
      const u64_t o1 = pk4(a * cs - c * sn), o2 = pk4(c * cs + a * sn);
#pragma unroll
      for (int h = 0; h < 6; ++h) { *(u64_t*)(Ko + (size_t)h * SEQ * 96 + 64) = o1; *(u64_t*)(Ko + (size_t)h * SEQ * 96 + 80) = o2; } }
#pragma unroll 2
    for (int h = 0; h < 6; ++h) {
        f32x4 x1v = {0.f, 0.f, 0.f, 0.f};
#pragma unroll
        for (int nt = 0; nt < 6; ++nt) {
            const bf16* w = WuqT + (size_t)(h * 96 + 16 * nt) * 192; f32x4 acc = {0.f, 0.f, 0.f, 0.f};
#pragma unroll
            for (int s = 0; s < 6; ++s) acc = __builtin_amdgcn_mfma_f32_16x16x32_bf16(*(const bf16x8*)(w + 32 * s), aq[s], acc, 0, 0, 0);
            acc = acc * rq;
            if (nt < 4) *(u64_t*)(Qo + (size_t)h * SEQ * 96 + 16 * nt) = pk4(acc);
            else if (nt == 4) x1v = acc;
            else { *(u64_t*)(Qo + (size_t)h * SEQ * 96 + 64) = pk4(x1v * cs - acc * sn); *(u64_t*)(Qo + (size_t)h * SEQ * 96 + 80) = pk4(acc * cs + x1v * sn); }
        }
#pragma unroll
        for (int nt = 0; nt < 4; ++nt) {
            const bf16* w = WukvT + (size_t)(h * 128 + 16 * nt) * 128; f32x4 acc = {0.f, 0.f, 0.f, 0.f};
#pragma unroll
            for (int s = 0; s < 4; ++s) acc = __builtin_amdgcn_mfma_f32_16x16x32_bf16(*(const bf16x8*)(w + 32 * s), akv[s], acc, 0, 0, 0);
            *(u64_t*)(Ko + (size_t)h * SEQ * 96 + 16 * nt) = pk4(acc * rkv);
        }
        f32x4 rk4;
#pragma unroll
        for (int r = 0; r < 4; ++r) rk4[r] = __shfl(rkv, 4 * q4 + r);
#pragma unroll
        for (int nt = 0; nt < 4; ++nt) {
            const bf16* w = WukvT + (size_t)(h * 128 + 64 + 16 * nt) * 128; f32x4 acc = {0.f, 0.f, 0.f, 0.f};
#pragma unroll
            for (int s = 0; s < 4; ++s) acc = __builtin_amdgcn_mfma_f32_16x16x32_bf16(akv[s], *(const bf16x8*)(w + 32 * s), acc, 0, 0, 0);
            *(u64_t*)(Vo + (size_t)(h * 64 + 16 * nt) * SEQ) = pk4(acc * rk4);
        }
    }
}
__device__ __forceinline__ f32x4 rw_shift4(const bf16* P, size_t m, int c, bool hp, bool hn, const float* mu) {
    const f32x4 x = bf4(*(const u64_t*)(P + m * 896 + c)), xp = hp ? bf4(*(const u64_t*)(P + (m - 1) * 896 + c)) : (f32x4){0.f, 0.f, 0.f, 0.f}, xn = hn ? bf4(*(const u64_t*)(P + (m + 1) * 896 + c)) : (f32x4){0.f, 0.f, 0.f, 0.f};
    const f32x4 m0 = *(const f32x4*)(mu + c), m1 = *(const f32x4*)(mu + 896 + c);
    return x + m0 * (xp - x) + m1 * (xn - x);
}
__device__ __forceinline__ void p2_rwkv_unit(Frame& F, int l, int unit, int h0, int h1) {
    const int lane = F.lane, col = lane & 15, q4 = lane >> 4, b = (16 * unit) / SEQ, t = (16 * unit) % SEQ + col; const size_t m = (size_t)16 * unit + col;
    const bool hp = t > 0, hn = t < SEQ - 1;
    const bf16* Prw = (const bf16*)(F.ws + WS_PRW);
    const float* mu = (const float*)inptr(F, 12) + l * 2 * 896;
    const bf16* W2T = (const bf16*)(F.ws + WS_WSMALL + OFF_W2T) + (size_t)l * 2 * 256 * 64 + (size_t)col * 64 + 8 * q4;
    const bf16* A2T = (const bf16*)(F.ws + WS_WSMALL + OFF_A2T) + (size_t)l * 2 * 256 * 64 + (size_t)col * 64 + 8 * q4;
    bf16x8 awd[2], aad[2];
#pragma unroll
    for (int s = 0; s < 2; ++s) { const int c = 768 + 32 * s + 8 * q4;
        f32x4 lo = rw_shift4(Prw, m, c, hp, hn, mu), hi = rw_shift4(Prw, m, c + 4, hp, hn, mu);
#pragma unroll
        for (int i = 0; i < 4; ++i) { lo[i] = 1.f - 2.f * __builtin_amdgcn_rcpf(1.f + __expf(2.f * lo[i])); hi[i] = 1.f - 2.f * __builtin_amdgcn_rcpf(1.f + __expf(2.f * hi[i])); }
        awd[s] = pack_acc(lo, hi);
        aad[s] = pack_acc(rw_shift4(Prw, m, c + 64, hp, hn, mu), rw_shift4(Prw, m, c + 68, hp, hn, mu)); }
#pragma unroll 1
    for (int h = h0; h < h1; ++h) {
        f32x4 k[4]; float kn = 0.f;
        { const float* k_k = (const float*)inptr(F, 17) + l * 256;
#pragma unroll
          for (int nt = 0; nt < 4; ++nt) { const int c = 64 * h + 16 * nt + 4 * q4; k[nt] = rw_shift4(Prw, m, 256 + c, hp, hn, mu);
              const f32x4 x = k[nt] * *(const f32x4*)(k_k + c); kn += (x[0] * x[0] + x[1] * x[1]) + (x[2] * x[2] + x[3] * x[3]); } }
        kn += __shfl_xor(kn, 16); kn += __shfl_xor(kn, 32);
        const float rkn = rsqrtf(kn + 1e-6f);
        float cbv = 0.f;
        const size_t ro = rw_rec_off(b * 4 + h, t, 0, q4 >> 1) + 8 * (q4 & 1);
        unsigned char* rs = F.ws + WS_RS + ro;
        unsigned char* rd0 = F.ws + WS_RD + ro;
#pragma unroll
        for (int nt = 0; nt < 4; ++nt) { const int c = 64 * h + 16 * nt + 4 * q4;
            const f32x4 r = rw_shift4(Prw, m, c, hp, hn, mu), v = rw_shift4(Prw, m, 512 + c, hp, hn, mu);
            const f32x4 kk = k[nt] * *(const f32x4*)((const float*)inptr(F, 17) + l * 256 + c) * rkn;
            *(u64_t*)(rs + 2048 * nt) = pk4(kk); *(u64_t*)(rs + 8192 + 2048 * nt) = pk4(v); *(u64_t*)(rs + 16384 + 2048 * nt) = pk4(r);
            f32x4 ksum = {0.f, 0.f, 0.f, 0.f};
#pragma unroll
            for (int e = 0; e < 2; ++e) { const bf16* w = W2T + (size_t)(e * 256 + 64 * h + 16 * nt) * 64; const bf16* a = A2T + (size_t)(e * 256 + 64 * h + 16 * nt) * 64;
                f32x4 x = {0.f, 0.f, 0.f, 0.f}, y = {0.f, 0.f, 0.f, 0.f};
#pragma unroll
                for (int s = 0; s < 2; ++s) { x = __builtin_amdgcn_mfma_f32_16x16x32_bf16(*(const bf16x8*)(w + 32 * s), awd[s], x, 0, 0, 0); y = __builtin_amdgcn_mfma_f32_16x16x32_bf16(*(const bf16x8*)(a + 32 * s), aad[s], y, 0, 0, 0); }
                const f32x4 w0v = *(const f32x4*)((const float*)inptr(F, 13) + l * 512 + e * 256 + c), a0v = *(const f32x4*)((const float*)inptr(F, 15) + l * 512 + e * 256 + c), kav = *(const f32x4*)((const float*)inptr(F, 18) + l * 256 + c);
                f32x4 lam, av;
#pragma unroll
                for (int i = 0; i < 4; ++i) { lam[i] = 0.6065306597126334f * sigmoidf_(w0v[i] + x[i]); av[i] = sigmoidf_(a0v[i] + y[i]); }
                const f32x4 km = k[nt] * (1.f + (av - 1.f) * kav), bb = av * kk;
                ksum += km;
                typedef _Float16 h4 __attribute__((ext_vector_type(4)));
                const h4 lh = {(_Float16)lam[0], (_Float16)lam[1], (_Float16)lam[2], (_Float16)lam[3]};
                unsigned char* rd = rd0 + e * RD_DIR;
                *(u64_t*)(rd + 2048 * nt) = __builtin_bit_cast(u64_t, lh); *(u64_t*)(rd + 8192 + 2048 * nt) = pk4(bb); *(u64_t*)(rd + 16384 + 2048 * nt) = pk4(km); }
            const f32x4 rkv = *(const f32x4*)((const float*)inptr(F, 19) + l * 256 + c), xx = r * ksum * rkv; cbv += (xx[0] + xx[1]) + (xx[2] + xx[3]);
        }
        cbv += __shfl_xor(cbv, 16); cbv += __shfl_xor(cbv, 32);
        if (q4 == 0) ((float*)(F.ws + WS_CB))[m * 4 + h] = 0.5f * cbv;
    }
}
constexpr int RW_PITCH = 1808, RW_MU = 66 * RW_PITCH, RW_LDS = RW_MU + 2 * 896 * 4;
static_assert(RW_LDS <= RING_BYTES, "RWKV prep LDS map");
__device__ __forceinline__ f32x4 rw_shift4_l(const LAS unsigned char* row, int c, bool hp, bool hn, const LAS float* mu) {
    const f32x4 x = bf4(*(const LAS u64_t*)(row + 2 * c)), xp = hp ? bf4(*(const LAS u64_t*)(row - RW_PITCH + 2 * c)) : (f32x4){0.f, 0.f, 0.f, 0.f}, xn = hn ? bf4(*(const LAS u64_t*)(row + RW_PITCH + 2 * c)) : (f32x4){0.f, 0.f, 0.f, 0.f};
    const f32x4 m0 = *(const LAS f32x4*)(mu + c), m1 = *(const LAS f32x4*)(mu + 896 + c);
    return x + m0 * (xp - x) + m1 * (xn - x);
}
__device__ __forceinline__ void p2_rwkv_unit_l(Frame& F, int l, int unit, int h0, int h1) {
    const int lane = F.lane, col = lane & 15, q4 = lane >> 4, b = (16 * unit) / SEQ, t = (16 * unit) % SEQ + col; const size_t m = (size_t)16 * unit + col;
    const bool hp = t > 0, hn = t < SEQ - 1;
    const LAS unsigned char* Prw = F.lds + RING_OFF + (16 * (unit & 3) + col + 1) * RW_PITCH;
    const LAS float* mu = (const LAS float*)(F.lds + RING_OFF + RW_MU);
    const bf16* W2T = (const bf16*)(F.ws + WS_WSMALL + OFF_W2T) + (size_t)l * 2 * 256 * 64 + (size_t)col * 64 + 8 * q4;
    const bf16* A2T = (const bf16*)(F.ws + WS_WSMALL + OFF_A2T) + (size_t)l * 2 * 256 * 64 + (size_t)col * 64 + 8 * q4;
    bf16x8 awd[2], aad[2];
#pragma unroll
    for (int s = 0; s < 2; ++s) { const int c = 768 + 32 * s + 8 * q4;
        f32x4 lo = rw_shift4_l(Prw, c, hp, hn, mu), hi = rw_shift4_l(Prw, c + 4, hp, hn, mu);
#pragma unroll
        for (int i = 0; i < 4; ++i) { lo[i] = 1.f - 2.f * __builtin_amdgcn_rcpf(1.f + __expf(2.f * lo[i])); hi[i] = 1.f - 2.f * __builtin_amdgcn_rcpf(1.f + __expf(2.f * hi[i])); }
        awd[s] = pack_acc(lo, hi);
        aad[s] = pack_acc(rw_shift4_l(Prw, c + 64, hp, hn, mu), rw_shift4_l(Prw, c + 68, hp, hn, mu)); }
#pragma unroll 1
    for (int h = h0; h < h1; ++h) {
        f32x4 k[4]; float kn = 0.f;
        { const float* k_k = (const float*)inptr(F, 17) + l * 256;
#pragma unroll
          for (int nt = 0; nt < 4; ++nt) { const int c = 64 * h + 16 * nt + 4 * q4; k[nt] = rw_shift4_l(Prw, 256 + c, hp, hn, mu);
              const f32x4 x = k[nt] * *(const f32x4*)(k_k + c); kn += (x[0] * x[0] + x[1] * x[1]) + (x[2] * x[2] + x[3] * x[3]); } }
        kn += __shfl_xor(kn, 16); kn += __shfl_xor(kn, 32);
        const float rkn = rsqrtf(kn + 1e-6f);
        float cbv = 0.f;
        const size_t ro = rw_rec_off(b * 4 + h, t, 0, q4 >> 1) + 8 * (q4 & 1);
        unsigned char* rs = F.ws + WS_RS + ro;
        unsigned char* rd0 = F.ws + WS_RD + ro;
#pragma unroll
        for (int nt = 0; nt < 4; ++nt) { const int c = 64 * h + 16 * nt + 4 * q4;
            const f32x4 r = rw_shift4_l(Prw, c, hp, hn, mu), v = rw_shift4_l(Prw, 512 + c, hp, hn, mu);
            const f32x4 kk = k[nt] * *(const f32x4*)((const float*)inptr(F, 17) + l * 256 + c) * rkn;
            *(u64_t*)(rs + 2048 * nt) = pk4(kk); *(u64_t*)(rs + 8192 + 2048 * nt) = pk4(v); *(u64_t*)(rs + 16384 + 2048 * nt) = pk4(r);
            f32x4 ksum = {0.f, 0.f, 0.f, 0.f};
#pragma unroll
            for (int e = 0; e < 2; ++e) { const bf16* w = W2T + (size_t)(e * 256 + 64 * h + 16 * nt) * 64; const bf16* a = A2T + (size_t)(e * 256 + 64 * h + 16 * nt) * 64;
                f32x4 x = {0.f, 0.f, 0.f, 0.f}, y = {0.f, 0.f, 0.f, 0.f};
#pragma unroll
                for (int s = 0; s < 2; ++s) { x = __builtin_amdgcn_mfma_f32_16x16x32_bf16(*(const bf16x8*)(w + 32 * s), awd[s], x, 0, 0, 0); y = __builtin_amdgcn_mfma_f32_16x16x32_bf16(*(const bf16x8*)(a + 32 * s), aad[s], y, 0, 0, 0); }
                const f32x4 w0v = *(const f32x4*)((const float*)inptr(F, 13) + l * 512 + e * 256 + c), a0v = *(const f32x4*)((const float*)inptr(F, 15) + l * 512 + e * 256 + c), kav = *(const f32x4*)((const float*)inptr(F, 18) + l * 256 + c);
                f32x4 lam, av;
#pragma unroll
                for (int i = 0; i < 4; ++i) { lam[i] = 0.6065306597126334f * sigmoidf_(w0v[i] + x[i]); av[i] = sigmoidf_(a0v[i] + y[i]); }
                const f32x4 km = k[nt] * (1.f + (av - 1.f) * kav), bb = av * kk;
                ksum += km;
                typedef _Float16 h4 __attribute__((ext_vector_type(4)));
                const h4 lh = {(_Float16)lam[0], (_Float16)lam[1], (_Float16)lam[2], (_Float16)lam[3]};
                unsigned char* rd = rd0 + e * RD_DIR;
                *(u64_t*)(rd + 2048 * nt) = __builtin_bit_cast(u64_t, lh); *(u64_t*)(rd + 8192 + 2048 * nt) = pk4(bb); *(u64_t*)(rd + 16384 + 2048 * nt) = pk4(km); }
            const f32x4 rkv = *(const f32x4*)((const float*)inptr(F, 19) + l * 256 + c), xx = r * ksum * rkv; cbv += (xx[0] + xx[1]) + (xx[2] + xx[3]);
        }
        cbv += __shfl_xor(cbv, 16); cbv += __shfl_xor(cbv, 32);
        if (q4 == 0) ((float*)(F.ws + WS_CB))[m * 4 + h] = 0.5f * cbv;
    }
}
constexpr int ML_QP = 400, ML_KP = 272, ML_KW = 96 * ML_QP, ML_SLAB = ML_KW + 128 * ML_KP;
static_assert(ML_SLAB <= RING_BYTES, "MLA slab");
__device__ __forceinline__ void p2_mla_wg(Frame& F, int l, int tb) {
    const int tid = F.tid, lane = F.lane, wave = F.wave, col = lane & 15, q4 = lane >> 4, tt = wave & 3, half = wave >> 2;
    const int m = 64 * tb + 16 * tt + col, b = m / SEQ, t = m % SEQ, t0 = (64 * tb + 16 * tt) % SEQ;
    const bf16* prow = (const bf16*)(F.ws + WS_PMLA) + (size_t)m * 352;
    const bf16* WuqT = (const bf16*)(F.ws + WS_WSMALL + OFF_WUQ) + (size_t)l * 576 * 192;
    const bf16* WukvT = (const bf16*)(F.ws + WS_WSMALL + OFF_WUKV) + (size_t)l * 768 * 128;
    LAS unsigned char* sl = F.lds + RING_OFF;
    v4u wreg[5];
#define ML_LOADQ(h_) do { _Pragma("unroll") for (int k_ = 0; k_ < 5; ++k_) { const int p_ = tid + 512 * k_; \
        if (p_ < 96 * 24) wreg[k_] = *(const v4u*)(WuqT + (size_t)((h_) * 96 + p_ / 24) * 192 + 8 * (p_ % 24)); } } while (0)
#define ML_STOREQ() do { _Pragma("unroll") for (int k_ = 0; k_ < 5; ++k_) { const int p_ = tid + 512 * k_; \
        if (p_ < 96 * 24) *(LAS v4u*)(sl + (p_ / 24) * ML_QP + 16 * (p_ % 24)) = wreg[k_]; } } while (0)
#define ML_LOADK(h_) do { _Pragma("unroll") for (int k_ = 0; k_ < 4; ++k_) { const int p_ = tid + 512 * k_; \
        wreg[k_] = *(const v4u*)(WukvT + (size_t)((h_) * 128 + (p_ >> 4)) * 128 + 8 * (p_ & 15)); } } while (0)
#define ML_STOREK() do { _Pragma("unroll") for (int k_ = 0; k_ < 4; ++k_) { const int p_ = tid + 512 * k_; \
        *(LAS v4u*)(sl + ML_KW + (p_ >> 4) * ML_KP + 16 * (p_ & 15)) = wreg[k_]; } } while (0)
    ML_LOADQ(0);
    bf16x8 aq[6], akv[4]; float sq = 0.f, skv = 0.f;
#pragma unroll
    for (int s = 0; s < 6; ++s) { aq[s] = *(const bf16x8*)(prow + 32 * s + 8 * q4); const v4u u = __builtin_bit_cast(v4u, aq[s]);
#pragma unroll
        for (int i = 0; i < 4; ++i) { const float a = __uint_as_float(u[i] << 16), c = __uint_as_float(u[i] & 0xffff0000u); sq += a * a + c * c; } }
#pragma unroll
    for (int s = 0; s < 4; ++s) { akv[s] = *(const bf16x8*)(prow + 192 + 32 * s + 8 * q4); const v4u u = __builtin_bit_cast(v4u, akv[s]);
#pragma unroll
        for (int i = 0; i < 4; ++i) { const float a = __uint_as_float(u[i] << 16), c = __uint_as_float(u[i] & 0xffff0000u); skv += a * a + c * c; } }
    sq += __shfl_xor(sq, 16); sq += __shfl_xor(sq, 32); skv += __shfl_xor(skv, 16); skv += __shfl_xor(skv, 32);
    const float rq = rsqrtf(sq * (1.f / 192.f) + NORM_EPS) * (0.10206207261596575f * LOG2E), rkv = rsqrtf(skv * (1.f / 128.f) + NORM_EPS);
    const float pos = (float)((const int*)inptr(F, 1))[m];
    f32x4 cs, sn;
#pragma unroll
    for (int r = 0; r < 4; ++r) { const float inv = exp2f(-(float)(4 * q4 + r) * (13.287712379549449f / 16.f)); float s_, c_; sincosf(pos * inv, &s_, &c_); cs[r] = c_; sn[r] = s_; }
    bf16* Qo = (bf16*)(F.ws + WS_Q) + ((size_t)b * 6 * SEQ + t) * 96 + 4 * q4;
    bf16* Ko = (bf16*)(F.ws + WS_K) + ((size_t)b * 6 * SEQ + t) * 96 + 4 * q4;
    bf16* Vo = (bf16*)(F.ws + WS_VT) + (size_t)b * 6 * 64 * SEQ + (size_t)col * SEQ + t0 + 4 * q4;
    if (half == 0) { const u64_t x1 = *(const u64_t*)(prow + 320 + 4 * q4), x2 = *(const u64_t*)(prow + 336 + 4 * q4); const f32x4 a = bf4(x1), c = bf4(x2);
      const u64_t o1 = pk4(a * cs - c * sn), o2 = pk4(c * cs + a * sn);
#pragma unroll
      for (int h = 0; h < 6; ++h) { *(u64_t*)(Ko + (size_t)h * SEQ * 96 + 64) = o1; *(u64_t*)(Ko + (size_t)h * SEQ * 96 + 80) = o2; } }
    f32x4 rk4;
#pragma unroll
    for (int r = 0; r < 4; ++r) rk4[r] = __shfl(rkv, 4 * q4 + r);
    const LAS unsigned char* wq = sl + col * ML_QP + 16 * q4; const LAS unsigned char* wk = sl + ML_KW + col * ML_KP + 16 * q4;
    ML_STOREQ();
    __syncthreads();
#pragma unroll 1
    for (int h = 0; h < 6; ++h) {
        ML_LOADK(h);
        { f32x4 x1v = {0.f, 0.f, 0.f, 0.f};
#pragma unroll
          for (int n3 = 0; n3 < 3; ++n3) { const int nt = 3 * half + n3; f32x4 acc = {0.f, 0.f, 0.f, 0.f};
#pragma unroll
              for (int s = 0; s < 6; ++s) acc = __builtin_amdgcn_mfma_f32_16x16x32_bf16(*(const LAS bf16x8*)(wq + 16 * nt * ML_QP + 64 * s), aq[s], acc, 0, 0, 0);
              acc = acc * rq;
              if (half == 0 || n3 == 0) *(u64_t*)(Qo + (size_t)h * SEQ * 96 + 16 * nt) = pk4(acc);
              else if (n3 == 1) x1v = acc;
              else { *(u64_t*)(Qo + (size_t)h * SEQ * 96 + 64) = pk4(x1v * cs - acc * sn); *(u64_t*)(Qo + (size_t)h * SEQ * 96 + 80) = pk4(acc * cs + x1v * sn); }
              asm volatile("" ::: "memory"); } }
        ML_STOREK();
        __syncthreads();
        if (h + 1 < 6) ML_LOADQ(h + 1);
        if (half == 0) {
#pragma unroll
            for (int nt = 0; nt < 4; ++nt) { f32x4 acc = {0.f, 0.f, 0.f, 0.f};
#pragma unroll
                for (int s = 0; s < 4; ++s) acc = __builtin_amdgcn_mfma_f32_16x16x32_bf16(*(const LAS bf16x8*)(wk + 16 * nt * ML_KP + 64 * s), akv[s], acc, 0, 0, 0);
                *(u64_t*)(Ko + (size_t)h * SEQ * 96 + 16 * nt) = pk4(acc * rkv); asm volatile("" ::: "memory"); }
        } else {
#pragma unroll
            for (int nt = 0; nt < 4; ++nt) { f32x4 acc = {0.f, 0.f, 0.f, 0.f};
#pragma unroll
                for (int s = 0; s < 4; ++s) acc = __builtin_amdgcn_mfma_f32_16x16x32_bf16(akv[s], *(const LAS bf16x8*)(wk + (64 + 16 * nt) * ML_KP + 64 * s), acc, 0, 0, 0);
                *(u64_t*)(Vo + (size_t)(h * 64 + 16 * nt) * SEQ) = pk4(acc * rk4); asm volatile("" ::: "memory"); }
        }
        if (h + 1 < 6) ML_STOREQ();
        __syncthreads();
    }
#undef ML_LOADQ
#undef ML_STOREQ
#undef ML_LOADK
#undef ML_STOREK
}
__device__ __forceinline__ void p2_prep3(Frame& F, int l) {
    for (int tb = F.vcu; tb < M / 64; tb += F.G) {
        { const int tid = F.tid, t0 = (64 * tb) % SEQ; const bf16* Prw = (const bf16*)(F.ws + WS_PRW) + ((size_t)64 * tb - 1) * 896; LAS unsigned char* sl = F.lds + RING_OFF;
          const float* mu = (const float*)inptr(F, 12) + l * 2 * 896;
          for (int i = tid; i < 2 * 896 / 4; i += 512) *(LAS f32x4*)(sl + RW_MU + 16 * i) = *(const f32x4*)(mu + 4 * i);
#pragma unroll 1
          for (int k0 = 0; k0 < 15; k0 += 5) { v4u rr[5];
#pragma unroll
              for (int k = 0; k < 5; ++k) { const int p = tid + 512 * (k0 + k), row = p / 112, pc = p % 112, tt = t0 - 1 + row; rr[k] = (v4u){0u, 0u, 0u, 0u};
                  if (p < 66 * 112 && tt >= 0 && tt < SEQ) rr[k] = *(const v4u*)(Prw + (size_t)row * 896 + 8 * pc); }
#pragma unroll
              for (int k = 0; k < 5; ++k) { const int p = tid + 512 * (k0 + k), row = p / 112, pc = p % 112; if (p < 66 * 112) *(LAS v4u*)(sl + row * RW_PITCH + 16 * pc) = rr[k]; } } }
        __syncthreads();
        p2_rwkv_unit_l(F, l, 4 * tb + (F.wave & 3), 2 * (F.wave >> 2), 2 * (F.wave >> 2) + 2);
        __syncthreads();
        p2_mla_wg(F, l, tb);
    }
}
template <int MODE> __device__ __forceinline__ void p2_prep2(Frame& F, int l) {
    const int gw = F.vcu * NWAVES + F.wave, NGW = F.G * NWAVES;
    for (int u = gw; u < 2 * (M / 16); u += NGW) { if (u & 1) { if (MODE != 1) p2_rwkv_unit(F, l, u >> 1, 0, 4); } else { if (MODE != 2) p2_mla_unit(F, l, u >> 1); } }
}
__device__ __forceinline__ void ld16(const bf16* p, f32x4 (&o)[4]) { const v4u a = *(const v4u*)p, b = *(const v4u*)(p + 8);
    o[0] = (f32x4){__uint_as_float(a.x << 16), __uint_as_float(a.x & 0xffff0000u), __uint_as_float(a.y << 16), __uint_as_float(a.y & 0xffff0000u)};
    o[1] = (f32x4){__uint_as_float(a.z << 16), __uint_as_float(a.z & 0xffff0000u), __uint_as_float(a.w << 16), __uint_as_float(a.w & 0xffff0000u)};
    o[2] = (f32x4){__uint_as_float(b.x << 16), __uint_as_float(b.x & 0xffff0000u), __uint_as_float(b.y << 16), __uint_as_float(b.y & 0xffff0000u)};
    o[3] = (f32x4){__uint_as_float(b.z << 16), __uint_as_float(b.z & 0xffff0000u), __uint_as_float(b.w << 16), __uint_as_float(b.w & 0xffff0000u)}; }
__device__ __forceinline__ void p4a_mix2(Frame& F, int l) {
    const bf16* Ogdn = (const bf16*)(F.ws + WS_OGDN); const bf16* Omla = (const bf16*)(F.ws + WS_OMLA); const bf16* Y = (const bf16*)(F.ws + WS_Y);
    const bf16* Pgate = (const bf16*)(F.ws + WS_PGATE); const unsigned char* Rs = F.ws + WS_RS; const float* cb = (const float*)(F.ws + WS_CB); bf16* mix = (bf16*)(F.ws + WS_MIX);
    const int gw = F.vcu * NWAVES + F.wave, NGW = F.G * NWAVES, lane = F.lane, g = lane >> 2, c0 = 16 * lane;
    f32x4 pg[4], pb[4];
    if (g < 6) { const float* gg = (const float*)inptr(F, 7) + l * 64 + (c0 & 63);
#pragma unroll
        for (int i = 0; i < 4; ++i) { pg[i] = *(const f32x4*)(gg + 4 * i); pb[i] = (f32x4){0.f, 0.f, 0.f, 0.f}; } }
    else if (g < 12) {
#pragma unroll
        for (int i = 0; i < 4; ++i) { pg[i] = (f32x4){1.f, 1.f, 1.f, 1.f}; pb[i] = (f32x4){0.f, 0.f, 0.f, 0.f}; } }
    else { const float* lg = (const float*)inptr(F, 20) + l * 256 + (c0 - 768); const float* lb = (const float*)inptr(F, 21) + l * 256 + (c0 - 768);
#pragma unroll
        for (int i = 0; i < 4; ++i) { pg[i] = *(const f32x4*)(lg + 4 * i); pb[i] = *(const f32x4*)(lb + 4 * i); } }
#pragma unroll 2
    for (int m = gw; m < M; m += NGW) {
        f32x4 x[4], gt[4];
        ld16(Pgate + (size_t)m * 1024 + c0, gt);
        if (g < 6) { ld16(Ogdn + (size_t)m * 384 + c0, x);
            float ss = 0.f;
#pragma unroll
            for (int i = 0; i < 4; ++i) ss += (x[i][0] * x[i][0] + x[i][1] * x[i][1]) + (x[i][2] * x[i][2] + x[i][3] * x[i][3]);
            ss += dpp_xor1(ss); ss += dpp_xor2(ss);
            const float rs = rsqrtf(ss * (1.f / 64.f) + NORM_EPS);
#pragma unroll
            for (int i = 0; i < 4; ++i) x[i] = x[i] * rs * pg[i]; }
        else if (g < 12) ld16(Omla + (size_t)m * 384 + (c0 - 384), x);
        else { const int cc = c0 - 768, h = g - 12, b = m / SEQ, t = m % SEQ; f32x4 v[4];
            ld16(Y + (size_t)m * 256 + cc, x); { const unsigned char* vp = Rs + rw_rec_off(b * 4 + h, t, 1, (cc & 63) >> 3); const v4u a = *(const v4u*)vp, bq = *(const v4u*)(vp + 1024);
              v[0] = (f32x4){__uint_as_float(a.x << 16), __uint_as_float(a.x & 0xffff0000u), __uint_as_float(a.y << 16), __uint_as_float(a.y & 0xffff0000u)}; v[1] = (f32x4){__uint_as_float(a.z << 16), __uint_as_float(a.z & 0xffff0000u), __uint_as_float(a.w << 16), __uint_as_float(a.w & 0xffff0000u)};
              v[2] = (f32x4){__uint_as_float(bq.x << 16), __uint_as_float(bq.x & 0xffff0000u), __uint_as_float(bq.y << 16), __uint_as_float(bq.y & 0xffff0000u)}; v[3] = (f32x4){__uint_as_float(bq.z << 16), __uint_as_float(bq.z & 0xffff0000u), __uint_as_float(bq.w << 16), __uint_as_float(bq.w & 0xffff0000u)}; }
            const float cbv = cb[(size_t)m * 4 + h];
            float s1 = 0.f;
#pragma unroll
            for (int i = 0; i < 4; ++i) s1 += (x[i][0] + x[i][1]) + (x[i][2] + x[i][3]);
            s1 += dpp_xor1(s1); s1 += dpp_xor2(s1);
            const float mean = s1 * (1.f / 64.f); float s2 = 0.f;
#pragma unroll
            for (int i = 0; i < 4; ++i) { x[i] = x[i] - mean; s2 += (x[i][0] * x[i][0] + x[i][1] * x[i][1]) + (x[i][2] * x[i][2] + x[i][3] * x[i][3]); }
            s2 += dpp_xor1(s2); s2 += dpp_xor2(s2);
            const float rs = rsqrtf(s2 * (1.f / 64.f) + 64e-5f);
#pragma unroll
            for (int i = 0; i < 4; ++i) x[i] = x[i] * rs * pg[i] + pb[i] + cbv * v[i]; }
        v4u o0, o1;
#pragma unroll
        for (int i = 0; i < 4; ++i) {
#pragma unroll
            for (int j = 0; j < 4; ++j) x[i][j] = x[i][j] * siluf(gt[i][j]); }
        o0.x = pg8::cvt_pk_bf16(x[0][0], x[0][1]); o0.y = pg8::cvt_pk_bf16(x[0][2], x[0][3]); o0.z = pg8::cvt_pk_bf16(x[1][0], x[1][1]); o0.w = pg8::cvt_pk_bf16(x[1][2], x[1][3]);
        o1.x = pg8::cvt_pk_bf16(x[2][0], x[2][1]); o1.y = pg8::cvt_pk_bf16(x[2][2], x[2][3]); o1.z = pg8::cvt_pk_bf16(x[3][0], x[3][1]); o1.w = pg8::cvt_pk_bf16(x[3][2], x[3][3]);
        bf16* op = mix + (size_t)m * 1024 + c0; *(v4u*)op = o0; *(v4u*)(op + 8) = o1;
    }
}
constexpr int PT_OUT = 24, PT_WS = 25, PT_N = 26;
__device__ __forceinline__ void build_frame(Frame& F, LAS unsigned char* lds) {
    F.lds = lds; F.MISC = (volatile LAS unsigned*)(lds + MISC_OFF); F.ptab = (volatile LAS const unsigned long long*)(lds + MISC_OFF + 256);
    const int t = pg8::mk_tid(lds);
    F.tid = t; F.lane = t & 63; F.wave = __builtin_amdgcn_readfirstlane(t >> 6);
    F.G = gridDim.x; { const int bx = blockIdx.x; F.vcu = (F.G % 8 == 0) ? (bx % 8) * (F.G / 8) + bx / 8 : bx; }
    F.ws = (unsigned char*)inptr(F, PT_WS); F.out = (float*)inptr(F, PT_OUT); F.ctl = (gu32*)F.ws;
}
__device__ __forceinline__ bool ph_in(LAS unsigned char* lds, int k) { volatile LAS unsigned* mi = (volatile LAS unsigned*)(lds + MISC_OFF); const int lo = __builtin_amdgcn_readfirstlane((int)mi[20]), hi = __builtin_amdgcn_readfirstlane((int)mi[21]); return lo <= k && k < hi; }
__device__ __forceinline__ void seam(LAS unsigned char* lds, int k) {
    if (ph_in(lds, k) && ph_in(lds, k + 1)) { Frame F; build_frame(F, lds);
        XcdBarrier bar; bar.bar = (unsigned*)(F.ctl + CW_BAR); bar.x = xb_xcc_id(); bar.st = F.MISC + 8; xcd_barrier(bar);
#ifdef EXP_BAR
        xcd_barrier(bar); xcd_barrier(bar);
#endif
    }
}
template <int L> __device__ __forceinline__ void layer_phases(LAS unsigned char* lds) {
    constexpr int pb = 1 + 5 * L;
    if (ph_in(lds, pb)) { Frame F; build_frame(F, lds);
        pg8::Gemm g{(const pg8::bf16_t*)(F.ws + WS_XB), (const pg8::bf16_t*)(F.ws + WS_WIN) + (size_t)L * NP * D, M, NP, D};
        pg8::StaticOrder S; S.init(M, NP, F.G, (int)blockIdx.x);
        pg8::EpiRoute E{F.ws};
        pg8::gemm_phase<pg8::EpiRoute, pg8::StaticOrder, true, true>(F.lds + RING_OFF, g, S, E);
#ifdef EXP_REP1
        __syncthreads(); S.init(M, NP, F.G, (int)blockIdx.x); pg8::gemm_phase<pg8::EpiRoute, pg8::StaticOrder, true, true>(F.lds + RING_OFF, g, S, E);
#endif
    }
    seam(lds, pb);
    if (ph_in(lds, pb + 1)) { Frame F; build_frame(F, lds); p2_prep3(F, L);
#ifdef EXP_REP2
        __syncthreads(); p2_prep3(F, L);
#endif
    }
    seam(lds, pb + 1);
    if (ph_in(lds, pb + 2)) { Frame F; build_frame(F, lds);
#ifdef EXP_REP3
        p3_mixers<1>(F, L, 1); __syncthreads();
#endif
        p3_mixers<0>(F, L, 0); }
    seam(lds, pb + 2);
    if (ph_in(lds, pb + 3)) { Frame F; build_frame(F, lds); p4a_mix2(F, L);
#ifdef EXP_REP4A
        __syncthreads(); p4a_mix2(F, L);
#endif
    }
    seam(lds, pb + 3);
    if (ph_in(lds, pb + 4)) { Frame F; build_frame(F, lds);
        pg8::Gemm g{(const pg8::bf16_t*)(F.ws + WS_MIX), (const pg8::bf16_t*)(F.ws + WS_WOUT) + (size_t)L * D * D, M, D, D};
        pg8::StaticOrder S; S.init(M, D, F.G, (int)blockIdx.x);
        pg8::EpiOut<L == 0> E{L == 0 ? (const float*)inptr(F, 0) : (const float*)F.out, F.out, F.ws};
        pg8::gemm_phase<pg8::EpiOut<L == 0>, pg8::StaticOrder, true, true>(F.lds + RING_OFF, g, S, E);
#ifdef EXP_REP4
        if (L == 0) { __syncthreads(); S.init(M, D, F.G, (int)blockIdx.x); pg8::gemm_phase<pg8::EpiOut<L == 0>, pg8::StaticOrder, true, true>(F.lds + RING_OFF, g, S, E); }
#endif
    }
    seam(lds, pb + 4);
}
__global__ void __launch_bounds__(NWAVES * 64, 2) mk_fwd(Args args) {
    extern __shared__ __attribute__((aligned(16))) unsigned char lds_raw[];
    LAS unsigned char* lds = (LAS unsigned char*)lds_raw;
    for (int u = threadIdx.x; u < (LDS_BYTES - LDSCTL_OFF) / 4; u += NWAVES * 64) ((LAS unsigned*)(lds + LDSCTL_OFF))[u] = 0u;
    __syncthreads();
    if (threadIdx.x == 0) { LAS unsigned long long* pt = (LAS unsigned long long*)(lds + MISC_OFF + 256);
#define PT(k) pt[k] = (unsigned long long)args.in[k]
        PT(0); PT(1); PT(2); PT(3); PT(4); PT(5); PT(6); PT(7); PT(8); PT(9); PT(10); PT(11); PT(12); PT(13); PT(14); PT(15); PT(16); PT(17); PT(18); PT(19); PT(20); PT(21); PT(22); PT(23);
#undef PT
        pt[PT_OUT] = (unsigned long long)args.out; pt[PT_WS] = (unsigned long long)args.ws;
        volatile LAS unsigned* mi = (volatile LAS unsigned*)(lds + MISC_OFF); mi[20] = (unsigned)args.ph_lo; mi[21] = (unsigned)args.ph_hi;
        if (args.ph_hi - args.ph_lo > 1) (void)xcd_barrier_post((unsigned*)((gu32*)args.ws + CW_BAR), mi + 8);
    }
    if ((threadIdx.x & 63) == 0) ((volatile LAS unsigned*)(lds + pg8::TIDTAB_OFF))[pg8::hw_slot()] = threadIdx.x >> 6;
    __syncthreads();
    if (ph_in(lds, 0)) { Frame F; build_frame(F, lds); p0_prologue(F);
#ifdef EXP_REP0
        __syncthreads(); p0_prologue(F);
#endif
    }
    seam(lds, 0);
    layer_phases<0>(lds);
    layer_phases<1>(lds);
    if (ph_in(lds, 11)) { Frame F; build_frame(F, lds); p5_final(F); }
}

extern "C" void kernel_launch(void* const* d_in, const int* in_sizes, int n_in, void* d_out, int out_size, void* d_ws, size_t ws_size, hipStream_t stream) {
    static int grid = 0;
    if (grid == 0) {
        if (n_in != 24 || ws_size < WS_END || out_size != M * D) { fprintf(stderr, "kernel_launch: unexpected inputs (%d), out (%d) or workspace (%zu)\n", n_in, out_size, ws_size); grid = -1; return; }
        int dev = 0, cus = 0;
        if (hipGetDevice(&dev) != hipSuccess || hipDeviceGetAttribute(&cus, hipDeviceAttributeMultiprocessorCount, dev) != hipSuccess) { grid = -1; return; }
        if (hipFuncSetAttribute((const void*)mk_fwd, hipFuncAttributeMaxDynamicSharedMemorySize, LDS_BYTES) != hipSuccess) { fprintf(stderr, "kernel_launch: hipFuncSetAttribute failed\n"); grid = -1; return; }
        (void)hipGetLastError();
        grid = cus;
    }
    if (grid < 0) return;
    unsigned char* ws = (unsigned char*)d_ws;
    (void)hipMemsetAsync(ws + WS_CTL, 0, CTL_ZERO_BYTES, stream);
    Args a{};
    for (int i = 0; i < 24; ++i) a.in[i] = d_in[i];
    a.out = (float*)d_out; a.ws = ws; a.ph_lo = 0; a.ph_hi = NPHASE;
    hipLaunchKernelGGL(mk_fwd, dim3(grid), dim3(NWAVES * 64), LDS_BYTES, stream, a);
}
```

```cpp
#include <hip/hip_runtime.h>
#include <cstdio>
#include <cstdint>
#include <hip/hip_fp16.h>
namespace pg8 {
#define PG8_LAS __attribute__((address_space(3)))
typedef unsigned short bf16_t;
typedef short bf16x8 __attribute__((ext_vector_type(8)));
typedef float f32x4 __attribute__((ext_vector_type(4)));
typedef unsigned u32x4 __attribute__((ext_vector_type(4)));
constexpr int BM = 256, BK = 64, HALF = 128, HTB = HALF * BK * 2  , STAGE_BYTES = 8 * HTB, NXCD = 8, WGM = 8;

__host__ __device__ __forceinline__ int lds_byte(int r, int c) { const int st = (r >> 4) * 2 + (c >> 5), rr = r & 15, cc = c & 31, ob = rr * 64 + cc * 2; return st * 1024 + (ob ^ (((ob >> 9) & 1) << 5)); }
__host__ __device__ __forceinline__ void stage_rc(int b, int& R, int& C) { const int st = b / 1024, sb = b % 1024, swz = sb ^ (((sb >> 9) & 1) << 5); R = (st >> 1) * 16 + swz / 64; C = (st & 1) * 32 + (swz % 64) / 2; }
__host__ __device__ __forceinline__ int perm32(int rho) { const int n = rho >> 4, i = rho & 15; return 8 * (i >> 2) + 4 * n + (i & 3); }

struct Unit { int pm, pn; };
struct Gemm { const bf16_t* A; const bf16_t* Bt; int M, N, K; };

struct StaticOrder {
    int nM, nN, nwg, G, c;
    __host__ __device__ void init(int M, int N, int G_, int c_) { nM = M / BM; nN = N / BM; nwg = nM * nN; G = G_; c = c_; }
    __host__ __device__ bool next(int i, Unit& u) const {
        const long L = (long)i * G + c; if (L >= nwg) return false;
        int wgid = (int)L; { const int q = nwg / NXCD, r = nwg % NXCD, xcd = wgid % NXCD, off = wgid / NXCD; wgid = (xcd < r ? xcd * (q + 1) : r * (q + 1) + (xcd - r) * q) + off; }
        const int nig = WGM * nN, gid = wgid / nig, fm = gid * WGM, gsz = (nM - fm) < WGM ? (nM - fm) : WGM;
        u.pm = fm + ((wgid % nig) % gsz); u.pn = (wgid % nig) / gsz; return true;
    }
    __device__ __forceinline__ void a_ready(const Unit&) const {}
    __device__ __forceinline__ void done(const Unit&) const {}
};

__device__ __forceinline__ unsigned cvt_pk_bf16(float lo, float hi) { unsigned r; asm volatile("v_cvt_pk_bf16_f32 %0, %1, %2" : "=v"(r) : "v"(lo), "v"(hi)); return r; }
typedef float f32x2 __attribute__((ext_vector_type(2)));
constexpr int TIDTAB_OFF = 131072 + 320 + 512;
__device__ __forceinline__ unsigned hw_slot() { return (unsigned)__builtin_amdgcn_s_getreg((5 << 11) | 4) & 63u; }
__device__ __forceinline__ int mk_tid(PG8_LAS unsigned char* lds_base) {
    const unsigned lane = __builtin_amdgcn_mbcnt_hi(~0u, __builtin_amdgcn_mbcnt_lo(~0u, 0u));
    const unsigned w = __builtin_amdgcn_readfirstlane(((volatile PG8_LAS unsigned*)(lds_base + TIDTAB_OFF))[hw_slot()]);
    return (int)(w * 64u + lane);
}
struct EpiRoute {
    static constexpr bool PERM = true, AFTER_DRAIN = false;
    unsigned char* ws;
    __device__ __forceinline__ void operator()(const f32x4 (&acc)[2][2][4][2], const Unit& u, int wr, int wc, int fr, int fq) const {
        const int row0 = u.pm * BM + wr * 64 + fr;
        const float* rowss = (const float*)(ws + (1u << 20)); float* Psm = (float*)(ws + (22u << 20));
        unsigned base[2]; int ld[2], cc[2], kind[2];
#pragma unroll
        for (int bj = 0; bj < 2; ++bj) {
            const int cg = u.pn * BM + bj * HALF + wc * 32, col = cg + 8 * fq;
            if (cg < 1024) { base[bj] = 25u << 20; ld[bj] = 1024; cc[bj] = col; kind[bj] = 0; }
            else if (cg < 2176) { base[bj] = 57u << 20; ld[bj] = 1152; cc[bj] = col - 1024; kind[bj] = 0; }
            else if (cg < 2528) { base[bj] = 93u << 20; ld[bj] = 352; cc[bj] = col - 2176; kind[bj] = 0; }
            else if (cg < 3424) { base[bj] = 104u << 20; ld[bj] = 896; cc[bj] = col - 2528; kind[bj] = 0; }
            else if (cg < 3456) { base[bj] = 0u; ld[bj] = 32; cc[bj] = col - 3424; kind[bj] = 1; }
            else { base[bj] = 0u; ld[bj] = 0; cc[bj] = 0; kind[bj] = 2; }
        }
#pragma unroll
        for (int ai = 0; ai < 2; ++ai)
#pragma unroll
            for (int m = 0; m < 4; ++m) {
                const int row = row0 + ai * HALF + m * 16;
                const f32x4* rp = (const f32x4*)(rowss + (size_t)row * 16);
                const f32x4 s0 = rp[0], s1 = rp[1], s2 = rp[2], s3 = rp[3];
                const float ss = ((s0[0] + s0[1]) + (s0[2] + s0[3])) + ((s1[0] + s1[1]) + (s1[2] + s1[3])) + ((s2[0] + s2[1]) + (s2[2] + s2[3])) + ((s3[0] + s3[1]) + (s3[2] + s3[3]));
                const float rstd = __builtin_amdgcn_rsqf(ss * (1.0f / 1024.0f) + 1e-6f);
#pragma unroll
                for (int bj = 0; bj < 2; ++bj) {
                    const f32x4 v0 = acc[ai][bj][m][0] * rstd, v1 = acc[ai][bj][m][1] * rstd;
                    if (kind[bj] == 0) { u32x4 w; w.x = cvt_pk_bf16(v0[0], v0[1]); w.y = cvt_pk_bf16(v0[2], v0[3]); w.z = cvt_pk_bf16(v1[0], v1[1]); w.w = cvt_pk_bf16(v1[2], v1[3]);
                        *(u32x4*)((bf16_t*)(ws + base[bj]) + (size_t)row * ld[bj] + cc[bj]) = w; }
                    else if (kind[bj] == 1) { float* p = Psm + (size_t)row * 32 + cc[bj]; *(f32x4*)p = v0; *(f32x4*)(p + 4) = v1; }
                }
                asm volatile("" ::: "memory");
            }
    }
};
template <bool WRITE_XB> struct EpiOut {
    static constexpr bool PERM = false, AFTER_DRAIN = false;
    const float* xin; float* xout; unsigned char* ws;
    __device__ __forceinline__ void operator()(const f32x4 (&acc)[2][2][4][2], const Unit& u, int wr, int wc, int fr, int fq) const {
        typedef unsigned u32x2v __attribute__((ext_vector_type(2)));
        const int row0 = u.pm * BM + wr * 64 + fr, col0 = u.pn * BM + wc * 32 + 4 * fq;
        float* rowss = (float*)(ws + (1u << 20)); bf16_t* xb = (bf16_t*)(ws + (133u << 20));
#pragma unroll
        for (int ai = 0; ai < 2; ++ai)
#pragma unroll
            for (int m = 0; m < 4; ++m) {
                const int row = row0 + ai * HALF + m * 16; float ss = 0.f;
#pragma unroll
                for (int bj = 0; bj < 2; ++bj)
#pragma unroll
                    for (int n = 0; n < 2; ++n) {
                        const size_t off = (size_t)row * 1024 + col0 + bj * HALF + n * 16;
                        const f32x4 o = *(const f32x4*)(xin + off) + acc[ai][bj][m][n];
                        *(f32x4*)(xout + off) = o;
                        if (WRITE_XB) { u32x2v w; w.x = cvt_pk_bf16(o[0], o[1]); w.y = cvt_pk_bf16(o[2], o[3]); *(u32x2v*)(xb + off) = w; }
                        ss += (o[0] * o[0] + o[1] * o[1]) + (o[2] * o[2] + o[3] * o[3]);
                    }
                ss += __shfl_xor(ss, 16); ss += __shfl_xor(ss, 32);
                if (fq == 0) rowss[(size_t)row * 16 + u.pn * 4 + wc] = ss;
                asm volatile("" ::: "memory");
            }
    }
};
struct EpiFinal {
    static constexpr bool PERM = false, AFTER_DRAIN = true;
    const float* xin; float* xout; unsigned char* ws; const float* g;
    __device__ __forceinline__ void operator()(const f32x4 (&)[2][2][4][2], const Unit&, int, int, int, int) const {}
    __device__ __forceinline__ void fused(const f32x4 (&acc)[2][2][4][2], const Unit& u, int wr, int wc, int fr, int fq, PG8_LAS unsigned char* lds, int wid, int lane) const {
        const int row0 = u.pm * BM + wr * 64 + fr, col0 = u.pn * BM + wc * 32 + 4 * fq;
        f32x4 (&xa)[2][2][4][2] = const_cast<f32x4 (&)[2][2][4][2]>(acc);
        float* rowss = (float*)(ws + (1u << 20));
        unsigned* cnt = (unsigned*)ws + 20480 + 64 * u.pm;
#pragma unroll
        for (int ai = 0; ai < 2; ++ai)
#pragma unroll
            for (int m = 0; m < 4; ++m) {
                const int row = row0 + ai * HALF + m * 16; float ss = 0.f;
#pragma unroll
                for (int bj = 0; bj < 2; ++bj)
#pragma unroll
                    for (int n = 0; n < 2; ++n) {
                        const f32x4 o = *(const f32x4*)(xin + (size_t)row * 1024 + col0 + bj * HALF + n * 16) + acc[ai][bj][m][n];
                        xa[ai][bj][m][n] = o;
                        ss += (o[0] * o[0] + o[1] * o[1]) + (o[2] * o[2] + o[3] * o[3]);
                    }
                ss += __shfl_xor(ss, 16); ss += __shfl_xor(ss, 32);
                if (fq == 0) rowss[(size_t)row * 16 + u.pn * 4 + wc] = ss;
                asm volatile("" ::: "memory");
            }
        asm volatile("s_waitcnt vmcnt(0)" ::: "memory");
        __syncthreads();
        if (wid == 0 && lane == 0) {
            __builtin_amdgcn_fence(__ATOMIC_RELEASE, "agent");
            asm volatile("s_waitcnt vmcnt(0)" ::: "memory");
            __hip_atomic_fetch_add(cnt, 1u, __ATOMIC_RELAXED, __HIP_MEMORY_SCOPE_AGENT);
            unsigned spins = 0;
            while (__hip_atomic_load(cnt, __ATOMIC_RELAXED, __HIP_MEMORY_SCOPE_AGENT) < 4u) { __builtin_amdgcn_s_sleep(2); if (++spins > (1u << 22)) break; }
            __builtin_amdgcn_fence(__ATOMIC_ACQUIRE, "agent");
            asm volatile("s_waitcnt vmcnt(0)" ::: "memory");
        }
        __syncthreads();
        f32x4 gv[2][2];
#pragma unroll
        for (int bj = 0; bj < 2; ++bj)
#pragma unroll
            for (int n = 0; n < 2; ++n) gv[bj][n] = *(const f32x4*)(g + col0 + bj * HALF + n * 16);
#pragma unroll
        for (int ai = 0; ai < 2; ++ai)
#pragma unroll
            for (int m = 0; m < 4; ++m) {
                const int row = row0 + ai * HALF + m * 16;
                const f32x4* rp = (const f32x4*)(rowss + (size_t)row * 16);
                const f32x4 s0 = rp[0], s1 = rp[1], s2 = rp[2], s3 = rp[3];
                const float ss = ((s0[0] + s0[1]) + (s0[2] + s0[3])) + ((s1[0] + s1[1]) + (s1[2] + s1[3])) + ((s2[0] + s2[1]) + (s2[2] + s2[3])) + ((s3[0] + s3[1]) + (s3[2] + s3[3]));
                const float rstd = __builtin_amdgcn_rsqf(ss * (1.0f / 1024.0f) + 1e-6f);
#pragma unroll
                for (int bj = 0; bj < 2; ++bj)
#pragma unroll
                    for (int n = 0; n < 2; ++n) {
                        const size_t off = (size_t)row * 1024 + col0 + bj * HALF + n * 16;
                        const f32x4 o = xa[ai][bj][m][n] * rstd * gv[bj][n];
                        *(f32x4*)(xout + off) = o;
                    }
                asm volatile("" ::: "memory");
            }
    }
};
template <class Epi, class Sched, bool ALIGN_EPI = false, bool SP2 = false>
__device__ __forceinline__ void gemm_phase(PG8_LAS unsigned char* lds, const Gemm g, const Sched& S, const Epi& E) {
    const int tid_ = mk_tid(lds);
    const int tid = tid_, wid = __builtin_amdgcn_readfirstlane(tid >> 6), lane = tid & 63, wr = wid >> 2, wc = wid & 3, fr = lane & 15, fq = lane >> 4;
    const int K = g.K, nt = K / BK;
    unsigned voffA[2], voffB[2];
#pragma unroll
    for (int i = 0; i < 2; ++i) { int R, C; stage_rc(tid * 16 + i * 8192, R, C); const int Rb = Epi::PERM ? ((R & ~31) + perm32(R & 31)) : R;
        voffA[i] = (unsigned)(R * K + C) * 2u; voffB[i] = (unsigned)(Rb * K + C) * 2u; }
    const size_t kstep = (size_t)(BK * 2);
    const size_t hstep = (size_t)HALF * K * 2;
    const size_t tstep = 2 * hstep;
    const unsigned ldsw = (unsigned)wid * 1024u;
    const int aoff = lds_byte(wr * 64 + fr, fq * 8), boff = lds_byte(wc * 32 + fr, fq * 8);
#define PG8_SA(b, h) (((b) * 2 + (h)) * HTB)
#define PG8_SB(b, h) ((4 + (b) * 2 + (h)) * HTB)
#define PG8_STAGE(bufoff, gbase, voff) do { _Pragma("unroll") for (int _i = 0; _i < 2; ++_i) \
        __builtin_amdgcn_global_load_lds((const unsigned*)((const char*)(gbase) + (voff)[_i]), (PG8_LAS unsigned*)(lds + (bufoff) + ldsw + _i * 8192), 16, 0, 0); } while (0)
#define PG8_LDA(dst, b, h) do { _Pragma("unroll") for (int m = 0; m < 4; ++m) _Pragma("unroll") for (int k = 0; k < 2; ++k) dst[m][k] = *(const PG8_LAS bf16x8*)(lds + PG8_SA(b, h) + aoff + m * 2048 + k * 1024); } while (0)
#define PG8_LDB(dst, b, h) do { _Pragma("unroll") for (int n = 0; n < 2; ++n) _Pragma("unroll") for (int k = 0; k < 2; ++k) dst[n][k] = *(const PG8_LAS bf16x8*)(lds + PG8_SB(b, h) + boff + n * 2048 + k * 1024); } while (0)
#define PG8_MMA(ai, bj, At, Bt) do { __builtin_amdgcn_s_setprio(1); _Pragma("unroll") for (int m = 0; m < 4; ++m) _Pragma("unroll") for (int n = 0; n < 2; ++n) _Pragma("unroll") for (int k = 0; k < 2; ++k) \
        acc[ai][bj][m][n] = __builtin_amdgcn_mfma_f32_16x16x32_bf16(Bt[n][k], At[m][k], acc[ai][bj][m][n], 0, 0, 0); __builtin_amdgcn_s_setprio(0); } while (0)
#define PG8_WAIT_V(n) asm volatile("s_waitcnt vmcnt(" #n ")" ::: "memory")
#define PG8_WAIT_L(n) asm volatile("s_waitcnt lgkmcnt(" #n ")" ::: "memory")
#define PG8_BAR __builtin_amdgcn_s_barrier()
#define PG8_SCHED __builtin_amdgcn_sched_barrier(0)
    Unit cur, nxt; int ui = 0;
    if (!S.next(0, cur)) return;
    f32x4 acc[2][2][4][2];
#pragma unroll
    for (int a = 0; a < 2; ++a)
#pragma unroll
        for (int b = 0; b < 2; ++b)
#pragma unroll
            for (int m = 0; m < 4; ++m)
#pragma unroll
                for (int n = 0; n < 2; ++n) acc[a][b][m][n] = (f32x4){0.f, 0.f, 0.f, 0.f};
    bf16x8 At[4][2], B0[2][2], B1[2][2];
    const char* cA = (const char*)g.A + (size_t)cur.pm * tstep; const char* cB = (const char*)g.Bt + (size_t)cur.pn * tstep;
    S.a_ready(cur);
    if constexpr (SP2) {
        PG8_STAGE(PG8_SB(0, 0), cB, voffB); PG8_STAGE(PG8_SB(0, 1), cB + hstep, voffB); PG8_STAGE(PG8_SA(0, 0), cA, voffA); PG8_STAGE(PG8_SA(0, 1), cA + hstep, voffA);
        if (wr == 1) PG8_BAR;
        PG8_WAIT_V(2); PG8_BAR;
        PG8_STAGE(PG8_SB(1, 0), cB + kstep, voffB); PG8_STAGE(PG8_SA(1, 0), cA + kstep, voffA); PG8_STAGE(PG8_SB(1, 1), cB + hstep + kstep, voffB);
        PG8_WAIT_V(6); PG8_BAR;
    } else {
        PG8_STAGE(PG8_SB(0, 0), cB, voffB); PG8_STAGE(PG8_SA(0, 0), cA, voffA); PG8_STAGE(PG8_SB(0, 1), cB + hstep, voffB); PG8_STAGE(PG8_SA(0, 1), cA + hstep, voffA);
        if (wr == 1) PG8_BAR;
        PG8_WAIT_V(4); PG8_BAR;
        PG8_STAGE(PG8_SB(1, 0), cB + kstep, voffB); PG8_STAGE(PG8_SA(1, 0), cA + kstep, voffA); PG8_STAGE(PG8_SB(1, 1), cB + hstep + kstep, voffB);
        PG8_WAIT_V(6); PG8_BAR;
    }
    for (;;) {
        const bool has_next = S.next(ui + 1, nxt);
        const char* nA = has_next ? (const char*)g.A + (size_t)nxt.pm * tstep : cA; const char* nB = has_next ? (const char*)g.Bt + (size_t)nxt.pn * tstep : cB;
        for (int t = 0; t < nt; t += 2) {
            const bool last = (t == nt - 2);
            const char* a1 = cA + (size_t)(t + 1) * kstep;
            const char* a2 = last ? nA : cA + (size_t)(t + 2) * kstep; const char* b2 = last ? nB : cB + (size_t)(t + 2) * kstep;
            const char* a3 = a2 + kstep; const char* b3 = b2 + kstep;
            if (last && has_next) S.a_ready(nxt);
            if constexpr (SP2) {
            PG8_LDB(B0, 0, 0); PG8_LDB(B1, 0, 1); PG8_SCHED; PG8_LDA(At, 0, 0); PG8_STAGE(PG8_SA(1, 1), a1 + hstep, voffA);
            PG8_WAIT_V(8); PG8_WAIT_L(0); PG8_BAR; PG8_MMA(0, 0, At, B0); PG8_MMA(0, 1, At, B1); PG8_BAR; PG8_SCHED;
            PG8_LDA(At, 0, 1); PG8_STAGE(PG8_SB(0, 0), b2, voffB); PG8_STAGE(PG8_SB(0, 1), b2 + hstep, voffB); PG8_STAGE(PG8_SA(0, 0), a2, voffA);
            PG8_WAIT_V(8); PG8_WAIT_L(0); PG8_BAR; PG8_MMA(1, 0, At, B0); PG8_MMA(1, 1, At, B1); PG8_BAR; PG8_SCHED;
            PG8_LDB(B0, 1, 0); PG8_LDB(B1, 1, 1); PG8_SCHED; PG8_LDA(At, 1, 0); PG8_STAGE(PG8_SA(0, 1), a2 + hstep, voffA);
            PG8_WAIT_V(8); PG8_WAIT_L(0); PG8_BAR; PG8_MMA(0, 0, At, B0); PG8_MMA(0, 1, At, B1); PG8_BAR; PG8_SCHED;
            PG8_LDA(At, 1, 1); PG8_STAGE(PG8_SB(1, 0), b3, voffB); PG8_STAGE(PG8_SB(1, 1), b3 + hstep, voffB); PG8_STAGE(PG8_SA(1, 0), a3, voffA);
            PG8_WAIT_V(8); PG8_WAIT_L(0); PG8_BAR; PG8_MMA(1, 0, At, B0); PG8_MMA(1, 1, At, B1); PG8_BAR; PG8_SCHED;
            } else {
            PG8_LDB(B0, 0, 0); PG8_SCHED; PG8_LDA(At, 0, 0); PG8_STAGE(PG8_SA(1, 1), a1 + hstep, voffA);
            PG8_WAIT_L(8); PG8_BAR; PG8_WAIT_L(0); PG8_MMA(0, 0, At, B0); PG8_BAR; PG8_SCHED;
            PG8_LDB(B1, 0, 1); PG8_STAGE(PG8_SB(0, 0), b2, voffB);
            PG8_BAR; PG8_WAIT_L(0); PG8_MMA(0, 1, At, B1); PG8_BAR;
            PG8_LDA(At, 0, 1); PG8_STAGE(PG8_SA(0, 0), a2, voffA);
            PG8_BAR; PG8_WAIT_L(0); PG8_MMA(1, 0, At, B0); PG8_BAR; PG8_SCHED;
            PG8_STAGE(PG8_SB(0, 1), b2 + hstep, voffB);
            PG8_WAIT_V(6); PG8_BAR; PG8_MMA(1, 1, At, B1); PG8_BAR;
            PG8_LDB(B0, 1, 0); PG8_SCHED; PG8_LDA(At, 1, 0); PG8_STAGE(PG8_SA(0, 1), a2 + hstep, voffA);
            PG8_WAIT_L(8); PG8_BAR; PG8_WAIT_L(0); PG8_MMA(0, 0, At, B0); PG8_BAR; PG8_SCHED;
            PG8_LDB(B1, 1, 1); PG8_STAGE(PG8_SB(1, 0), b3, voffB);
            PG8_BAR; PG8_WAIT_L(0); PG8_MMA(0, 1, At, B1); PG8_BAR;
            PG8_LDA(At, 1, 1); PG8_STAGE(PG8_SA(1, 0), a3, voffA);
            PG8_BAR; PG8_WAIT_L(0); PG8_MMA(1, 0, At, B0); PG8_BAR; PG8_SCHED;
            PG8_STAGE(PG8_SB(1, 1), b3 + hstep, voffB);
            PG8_WAIT_V(6); PG8_BAR; PG8_MMA(1, 1, At, B1); PG8_BAR;
            }
        }
        if constexpr (ALIGN_EPI) { if (wr == 0) PG8_BAR; }
        if constexpr (!Epi::AFTER_DRAIN) { E(acc, cur, wr, wc, fr, fq); S.done(cur); }
        if (!has_next) break;
#pragma unroll
        for (int a = 0; a < 2; ++a)
#pragma unroll
            for (int b = 0; b < 2; ++b)
#pragma unroll
                for (int m = 0; m < 4; ++m)
#pragma unroll
                    for (int n = 0; n < 2; ++n) acc[a][b][m][n] = (f32x4){0.f, 0.f, 0.f, 0.f};
        cur = nxt; cA = nA; cB = nB; ++ui;
        if constexpr (ALIGN_EPI) { if (wr == 1) PG8_BAR; }
    }
    PG8_WAIT_V(0);
    if constexpr (!ALIGN_EPI) { if (wr == 0) PG8_BAR; }
    PG8_BAR;
    if constexpr (Epi::AFTER_DRAIN) { E.fused(acc, cur, wr, wc, fr, fq, lds, wid, lane); S.done(cur); }
#undef PG8_SA
#undef PG8_SB
#undef PG8_STAGE
#undef PG8_LDA
#undef PG8_LDB
#undef PG8_MMA
#undef PG8_WAIT_V
#undef PG8_WAIT_L
#undef PG8_BAR
#undef PG8_SCHED
}
}
#define GAS __attribute__((address_space(1)))
#define LAS __attribute__((address_space(3)))
typedef unsigned short bf16;
typedef unsigned v4u __attribute__((ext_vector_type(4)));
typedef float f32x4 __attribute__((ext_vector_type(4)));
typedef short bf16x8 __attribute__((ext_vector_type(8)));
typedef GAS unsigned gu32;
typedef GAS unsigned long long gu64;
#define RLX_AGENT __ATOMIC_RELAXED, __HIP_MEMORY_SCOPE_AGENT
#define LDS_WAIT() asm volatile("s_waitcnt lgkmcnt(0)" ::: "memory")
#define VM_WAIT() asm volatile("s_waitcnt vmcnt(0)" ::: "memory")
__device__ __forceinline__ unsigned long long rt() { return __builtin_amdgcn_s_memrealtime(); }
__device__ __forceinline__ unsigned f2bf(float f) { unsigned u = __builtin_bit_cast(unsigned, f); return (u + 0x7fffu + ((u >> 16) & 1u)) >> 16; }
__device__ __forceinline__ unsigned pk2(float lo, float hi) { return f2bf(lo) | (f2bf(hi) << 16); }

#define XB_TMO      128
#define XB_XCNT(j)  (256  + 64 * (j))
#define XB_XSUB(j)  (1280 + 64 * (j))
#define XB_XGEN(j)  (2304 + 64 * (j))
#define XB_TOP      3328
#define XB_TOPGEN   3392
#define XCD_BAR_WORDS 3456
#define XB_SPIN_CAP (1u << 18)

__device__ __forceinline__ unsigned xb_ld(unsigned* p)              { return __hip_atomic_load(p, __ATOMIC_RELAXED, __HIP_MEMORY_SCOPE_AGENT); }
__device__ __forceinline__ unsigned xb_add(unsigned* p, unsigned v) { return __hip_atomic_fetch_add(p, v, __ATOMIC_RELAXED, __HIP_MEMORY_SCOPE_AGENT); }
__device__ __forceinline__ unsigned xb_xcc_id() { return (unsigned)__builtin_amdgcn_s_getreg((3 << 11) | 20) & 0xFu; }
#define XB_SPIN(cond, bar) do { unsigned _sp = 0; while (cond) { __builtin_amdgcn_s_sleep(1); \
    if ((++_sp & 255u) == 0u) { if (xb_ld(&(bar)[XB_TMO])) break; if (_sp > XB_SPIN_CAP) { atomicAdd(&(bar)[XB_TMO], 1u); break; } } } } while (0)

struct XcdBarrier {
    unsigned* bar; unsigned x;
    volatile LAS unsigned* st;
};

__device__ __forceinline__ XcdBarrier xcd_barrier_post(unsigned* bar, volatile LAS unsigned* st) {
    XcdBarrier b; b.bar = bar; b.x = xb_xcc_id(); b.st = st;
    if (threadIdx.x == 0) (void)xb_add(&bar[XB_XCNT(b.x)], 1u);
    return b;
}
__device__ __forceinline__ void xcd_barrier_complete(unsigned* bar, unsigned x, unsigned& nloc, unsigned& nx) {
    const unsigned G = gridDim.x * gridDim.y * gridDim.z;
    unsigned sum, cnt, mine, sp = 0u;
    for (;;) {
        sum = 0u; cnt = 0u; mine = 0u;
#pragma unroll
        for (unsigned j = 0; j < 16; ++j) { const unsigned c = xb_ld(&bar[XB_XCNT(j)]); sum += c; cnt += (c > 0u) ? 1u : 0u; mine = (j == x) ? c : mine; }
        if (sum == G) break;
        __builtin_amdgcn_s_sleep(1);
        if ((++sp & 255u) == 0u) { if (xb_ld(&bar[XB_TMO])) break; if (sp > XB_SPIN_CAP) { atomicAdd(&bar[XB_TMO], 1u); break; } }
    }
    nloc = mine > 0u ? mine : 1u; nx = cnt > 0u ? cnt : 1u;
}

__device__ __forceinline__ void xcd_barrier(const XcdBarrier& b) {
    asm volatile("s_waitcnt vmcnt(0)" ::: "memory");
    __syncthreads();
    if (pg8::mk_tid((LAS unsigned char*)b.st - (131072 + 320 + 32)) == 0) {
        unsigned* bar = b.bar;
        __builtin_amdgcn_s_waitcnt(0);
        unsigned nloc = b.st[0], nx = b.st[1];
        if (nloc == 0u) { xcd_barrier_complete(bar, b.x, nloc, nx); b.st[0] = nloc; b.st[1] = nx; }
        const unsigned old = xb_add(&bar[XB_XSUB(b.x)], 1u);
        const unsigned gen = old / nloc;
        if (old + 1u == (gen + 1u) * nloc) {
            __builtin_amdgcn_fence(__ATOMIC_RELEASE, "agent");
            asm volatile("s_waitcnt vmcnt(0)" ::: "memory");
            const unsigned og = xb_add(&bar[XB_TOP], 1u);
            const unsigned tg = og / nx;
            if (og + 1u == (tg + 1u) * nx) xb_add(&bar[XB_TOPGEN], 1u);
            else XB_SPIN(xb_ld(&bar[XB_TOPGEN]) == tg, bar);
            __builtin_amdgcn_fence(__ATOMIC_ACQUIRE, "agent");
            xb_add(&bar[XB_XGEN(b.x)], 1u);
            asm volatile("s_waitcnt vmcnt(0)" ::: "memory");
        } else {
            XB_SPIN(xb_ld(&bar[XB_XGEN(b.x)]) == gen, bar);
            __builtin_amdgcn_fence(__ATOMIC_ACQUIRE, "agent");
            asm volatile("s_waitcnt vmcnt(0)" ::: "memory");
        }
    }
    __syncthreads();
}
constexpr int BATCH = 8, SEQ = 2048, M = BATCH * SEQ, D = 1024, NIN = 3448, NP = 3584;
constexpr float NORM_EPS = 1e-6f;
constexpr float LOG2E = 1.4426950408889634f;
constexpr size_t MiB = 1u << 20;
constexpr size_t WS_CTL = 0, CTL_ZERO_BYTES = 1 * MiB;
constexpr size_t WS_ROWSS = 1 * MiB;
constexpr size_t WS_WIN = 2 * MiB;
constexpr size_t WS_WOUT = 16 * MiB;
constexpr size_t WS_WSMALL = 20 * MiB;
constexpr size_t OFF_WUQ = 0, OFF_WUKV = 2 * 576 * 192 * 2, OFF_W2T = OFF_WUKV + 2 * 768 * 128 * 2, OFF_A2T = OFF_W2T + 2 * 2 * 256 * 64 * 2;
constexpr size_t WS_PSM = 22 * MiB;
constexpr size_t WS_CB = 24 * MiB;
constexpr size_t WS_PGATE = 25 * MiB;
constexpr size_t WS_PGDN = 57 * MiB;
constexpr size_t WS_PMLA = 93 * MiB;
constexpr size_t WS_PRW = 104 * MiB;
constexpr size_t WS_OGDN = 93 * MiB;
constexpr size_t WS_OMLA = 105 * MiB;
constexpr size_t WS_Y = 117 * MiB;
constexpr size_t WS_GSIDE = 125 * MiB;
constexpr size_t WS_RS = 133 * MiB;
constexpr size_t WS_RD = 157 * MiB;
constexpr size_t WS_XB = 133 * MiB;
constexpr size_t WS_Q = 207 * MiB;
constexpr size_t WS_K = 225 * MiB;
constexpr size_t WS_VT = 243 * MiB;
constexpr size_t WS_MIX = 207 * MiB;
constexpr size_t WS_END = 255 * MiB;
constexpr int RS_REC = 384;
constexpr size_t RD_DIR = (size_t)BATCH * 4 * SEQ * RS_REC;
__device__ __forceinline__ size_t rw_rec_off(int bh, int t, int arr, int w) { return ((size_t)(bh * (SEQ / 64) + (t >> 6)) * 3 + arr) * 8192 + w * 1024 + (t & 63) * 16; }
constexpr int CW_BAR = 4096;
constexpr int CW_QUEUE = 16384;

constexpr int NWAVES = 8;
constexpr int RING_OFF = 0, RING_BYTES = 131072, LDSCTL_OFF = RING_BYTES, MISC_OFF = LDSCTL_OFF + 320, LDS_BYTES = 147456;
static_assert(pg8::TIDTAB_OFF == MISC_OFF + 512 && RING_OFF == 0, "LDS map");
constexpr int NPHASE = 12;

__device__ __forceinline__ float bf2f(bf16 v) { return __uint_as_float(((unsigned)v) << 16); }
__device__ __forceinline__ float wave_sum(float v) {
#pragma unroll
    for (int o = 1; o < 64; o <<= 1) v += __shfl_xor(v, o);
    return v;
}
__device__ __forceinline__ float siluf(float x) { return x * __builtin_amdgcn_rcpf(1.f + __expf(-x)); }
__device__ __forceinline__ float sigmoidf_(float x) { return __builtin_amdgcn_rcpf(1.f + __expf(-x)); }
__device__ __forceinline__ float softplusf_(float x) { return x > 20.f ? x : log1pf(__expf(x)); }

typedef float f32x2_t __attribute__((ext_vector_type(2))); typedef __bf16 bf16x2_t __attribute__((ext_vector_type(2)));
__device__ __forceinline__ unsigned cvt2bf(float lo, float hi) { const f32x2_t v = {lo, hi}; const bf16x2_t b = __builtin_convertvector(v, bf16x2_t); return __builtin_bit_cast(unsigned, b); }

struct Args { const void* in[24]; float* out; unsigned char* ws; int ph_lo, ph_hi; };

struct Frame {
    LAS unsigned char* lds;
    volatile LAS unsigned* MISC;
    gu32* ctl;
    int tid, lane, wave, vcu, G;
    unsigned char* ws;
    float* out;
    volatile LAS const unsigned long long* ptab;
};
__device__ __forceinline__ const void* inptr(const Frame& F, int k) {
    const unsigned long long v = F.ptab[k];
    const unsigned lo = __builtin_amdgcn_readfirstlane((unsigned)v), hi = __builtin_amdgcn_readfirstlane((unsigned)(v >> 32));
    return (const void*)(GAS const void*)(((unsigned long long)hi << 32) | lo);
}

__device__ __forceinline__ void tr_item(const float* W, int K, int ldsrc, int scol, int nvalid, bf16* WT, const float* gs, LAS float* scr, int kb, int lane) {
    const int k0 = 64 * kb;
#pragma unroll
    for (int i = 0; i < 32; ++i) { const int kk = 2 * i + (lane >> 5), n = lane & 31; float v = 0.f;
        if (n < nvalid) { v = W[(size_t)(k0 + kk) * ldsrc + scol + n]; if (gs) v *= gs[k0 + kk]; }
        scr[kk * 33 + n] = v; }
    LDS_WAIT(); asm volatile("" ::: "memory");
    const int c = lane & 7;
#pragma unroll
    for (int j = 0; j < 4; ++j) { const int n = (lane >> 3) + 8 * j; const LAS float* s = scr + (8 * c) * 33 + n;
        v4u o; o.x = pg8::cvt_pk_bf16(s[0 * 33], s[1 * 33]); o.y = pg8::cvt_pk_bf16(s[2 * 33], s[3 * 33]); o.z = pg8::cvt_pk_bf16(s[4 * 33], s[5 * 33]); o.w = pg8::cvt_pk_bf16(s[6 * 33], s[7 * 33]);
        *(GAS v4u*)(WT + (size_t)n * K + k0 + 8 * c) = o; }
    LDS_WAIT(); asm volatile("" ::: "memory");
}
constexpr int I_IN = 112 * 16, I_OUT = 32 * 16, I_UQ = 18 * 3, I_UKV = 24 * 2, I_W2 = 16, I_A2 = 16, I_L = I_IN + I_OUT + I_UQ + I_UKV + I_W2 + I_A2;
constexpr int P0_DEFER_G = 256, P0_DEFER_N = 128 * 8;
__device__ __forceinline__ void p0_weights(Frame& F, int it0, int it1, int first, int nw) {
    LAS float* scr = (LAS float*)(F.lds + RING_OFF + F.wave * 16384);
    for (int it = it0 + first; it < it1; it += nw) {
        const int l = it / I_L; int r = it % I_L;
        if (r < I_IN) { const int nb = r >> 4, kb = r & 15, n0 = 32 * nb; int scol, nv;
            if (n0 < 2176) { scol = n0; nv = 32; } else if (n0 < 3424) { scol = n0 + 24; nv = 32; } else if (n0 == 3424) { scol = 2176; nv = 24; } else { scol = 0; nv = 0; }
            tr_item((const float*)inptr(F, 3) + (size_t)l * D * NIN, D, NIN, scol, nv, (bf16*)(F.ws + WS_WIN) + ((size_t)l * NP + n0) * D, (const float*)inptr(F, 2) + l * D, scr, kb, F.lane); continue; }
        r -= I_IN;
        if (r < I_OUT) { const int nb = r >> 4, kb = r & 15;
            tr_item((const float*)inptr(F, 22) + (size_t)l * D * D, D, D, 32 * nb, 32, (bf16*)(F.ws + WS_WOUT) + ((size_t)l * D + 32 * nb) * D, nullptr, scr, kb, F.lane); continue; }
        r -= I_OUT;
        if (r < I_UQ) { const int nb = r / 3, kb = r % 3;
            tr_item((const float*)inptr(F, 9) + (size_t)l * 192 * 576, 192, 576, 32 * nb, 32, (bf16*)(F.ws + WS_WSMALL + OFF_WUQ) + ((size_t)l * 576 + 32 * nb) * 192, (const float*)inptr(F, 8) + l * 192, scr, kb, F.lane); continue; }
        r -= I_UQ;
        if (r < I_UKV) { const int nb = r >> 1, kb = r & 1;
            tr_item((const float*)inptr(F, 11) + (size_t)l * 128 * 768, 128, 768, 32 * nb, 32, (bf16*)(F.ws + WS_WSMALL + OFF_WUKV) + ((size_t)l * 768 + 32 * nb) * 128, (const float*)inptr(F, 10) + l * 128, scr, kb, F.lane); continue; }
        r -= I_UKV;
        if (r < I_W2) { const int e = r >> 3, nb = r & 7;
            tr_item((const float*)inptr(F, 14) + ((size_t)l * 2 + e) * 64 * 256, 64, 256, 32 * nb, 32, (bf16*)(F.ws + WS_WSMALL + OFF_W2T) + (((size_t)l * 2 + e) * 256 + 32 * nb) * 64, nullptr, scr, 0, F.lane); continue; }
        r -= I_W2;
        { const int e = r >> 3, nb = r & 7;
            tr_item((const float*)inptr(F, 16) + ((size_t)l * 2 + e) * 64 * 256, 64, 256, 32 * nb, 32, (bf16*)(F.ws + WS_WSMALL + OFF_A2T) + (((size_t)l * 2 + e) * 256 + 32 * nb) * 64, nullptr, scr, 0, F.lane); }
    }
}
__device__ __forceinline__ void p0_prologue(Frame& F) {
    const int gw = F.vcu * NWAVES + F.wave, NGW = F.G * NWAVES;
    p0_weights(F, 0, F.G == P0_DEFER_G ? 2 * I_L - P0_DEFER_N : 2 * I_L, gw, NGW);
    const float* x = (const float*)inptr(F, 0); bf16* xb = (bf16*)(F.ws + WS_XB); float* rowss = (float*)(F.ws + WS_ROWSS);
    for (int m = gw; m < M; m += NGW) {
        const GAS f32x4* xr = (const GAS f32x4*)(x + (size_t)m * D) + F.lane;
        GAS unsigned long long* o8 = (GAS unsigned long long*)(xb + (size_t)m * D) + F.lane; float s = 0.f;
#pragma unroll
        for (int j = 0; j < 4; ++j) { const f32x4 v = xr[64 * j]; s += (v.x * v.x + v.y * v.y) + (v.z * v.z + v.w * v.w);
            o8[64 * j] = (unsigned long long)pk2(v.x, v.y) | ((unsigned long long)pk2(v.z, v.w) << 32); }
        s = wave_sum(s);
        if (F.lane < 16) rowss[(size_t)m * 16 + F.lane] = F.lane == 0 ? s : 0.f;
    }
}
__device__ __forceinline__ void p5_final(Frame& F) {
    const int gw = F.vcu * NWAVES + F.wave, NGW = F.G * NWAVES;
    const float* rowss = (const float*)(F.ws + WS_ROWSS); const float* g = (const float*)inptr(F, 23);
    f32x4 gv[4];
#pragma unroll
    for (int j = 0; j < 4; ++j) gv[j] = ((const f32x4*)g)[F.lane + 64 * j];
    for (int m = gw; m < M; m += NGW) {
        float ss = F.lane < 16 ? rowss[(size_t)m * 16 + F.lane] : 0.f;
        ss = wave_sum(ss);
        const float rstd = rsqrtf(ss * (1.f / D) + NORM_EPS);
        GAS f32x4* xr = (GAS f32x4*)(F.out + (size_t)m * D) + F.lane;
#pragma unroll
        for (int j = 0; j < 4; ++j) { f32x4 v = xr[64 * j]; v = v * rstd * gv[j]; xr[64 * j] = v; }
    }
}
typedef float f32x16 __attribute__((ext_vector_type(16)));
typedef unsigned long long u64_t;
__device__ __forceinline__ f32x4 bf4(u64_t x) { return (f32x4){__uint_as_float(((unsigned)x) << 16), __uint_as_float(((unsigned)x) & 0xffff0000u), __uint_as_float(((unsigned)(x >> 32)) << 16), __uint_as_float(((unsigned)(x >> 32)) & 0xffff0000u)}; }
__device__ __forceinline__ bf16x8 mk_bf16x8(u64_t lo, u64_t hi) { typedef u64_t u64x2 __attribute__((ext_vector_type(2))); u64x2 v = {lo, hi}; return __builtin_bit_cast(bf16x8, v); }

constexpr float AT_THR = 8.f;
__device__ __forceinline__ float at_max3(float a, float b, float c) { float r; asm("v_max3_f32 %0, %1, %2, %3" : "=v"(r) : "v"(a), "v"(b), "v"(c)); return r; }
__device__ __forceinline__ void at_barrier() { asm volatile("s_waitcnt lgkmcnt(0)\n\ts_barrier" ::: "memory"); }
constexpr int A2_KP = 208, A2_VP = 72, A2_KBYTES = 32 * A2_KP, A2_VBYTES = 64 * A2_VP, A2_BUF = A2_KBYTES + A2_VBYTES;
__device__ __forceinline__ void attn_unit64(Frame& F, int unit) {
    const int bh = unit >> 2, qc = unit & 3, b = bh / 6, h = bh % 6;
    const int tid = F.tid, lane = F.lane, wave = F.wave, r32 = lane & 31, hi = lane >> 5;
    const bf16* Qg = (const bf16*)(F.ws + WS_Q) + ((size_t)bh * SEQ + qc * 512 + wave * 64 + r32) * 96;
    const bf16* Kg = (const bf16*)(F.ws + WS_K) + (size_t)bh * SEQ * 96;
    const bf16* Vg = (const bf16*)(F.ws + WS_VT) + (size_t)bh * 64 * SEQ;
    LAS unsigned char* lds = F.lds + RING_OFF;
    bf16x8 qf[2][6];
#pragma unroll
    for (int qb = 0; qb < 2; ++qb)
#pragma unroll
        for (int s = 0; s < 6; ++s) qf[qb][s] = *(const bf16x8*)(Qg + (size_t)qb * 32 * 96 + 16 * s + 8 * hi);
    const int kr = tid / 12, kc = tid % 12, vd = tid >> 2, vc = tid & 3;
    const bool hask = tid < 384, hasv = tid < 256;
    v4u ka = {0u, 0u, 0u, 0u}, va = ka, kb = ka, vb = ka;
#define A2_LOAD(K_, V_, t0) do { if (hask) K_ = *(const v4u*)(Kg + (size_t)((t0) + kr) * 96 + kc * 8); if (hasv) V_ = *(const v4u*)(Vg + (size_t)vd * SEQ + (t0) + vc * 8); } while (0)
#define A2_STORE(K_, V_, buf) do { LAS unsigned char* bb_ = lds + (buf) * A2_BUF; if (hask) *(LAS v4u*)(bb_ + kr * A2_KP + kc * 16) = K_; \
        if (hasv) { LAS u64_t* vp_ = (LAS u64_t*)(bb_ + A2_KBYTES + vd * A2_VP + vc * 16); vp_[0] = (u64_t)V_.x | ((u64_t)V_.y << 32); vp_[1] = (u64_t)V_.z | ((u64_t)V_.w << 32); } } while (0)
    constexpr int NT = SEQ / 32;
    A2_LOAD(ka, va, 0); A2_LOAD(kb, vb, 32);
    A2_STORE(ka, va, 0); A2_STORE(kb, vb, 1);
    A2_LOAD(ka, va, 64); A2_LOAD(kb, vb, 96);
    __syncthreads();
    f32x16 o[2][2] = {};
    float mrun[2] = {0.f, 0.f}, lsum[2] = {0.f, 0.f};
    auto tile = [&](int t) {
        const LAS unsigned char* bb = lds + (t % 3) * A2_BUF;
        f32x16 p[2] = {};
        { const LAS unsigned char* kp = bb + r32 * A2_KP + hi * 16;
#pragma unroll
          for (int s = 0; s < 6; ++s) { const bf16x8 a0 = *(const LAS bf16x8*)(kp + 32 * s);
              p[0] = __builtin_amdgcn_mfma_f32_32x32x16_bf16(a0, qf[0][s], p[0], 0, 0, 0);
              p[1] = __builtin_amdgcn_mfma_f32_32x32x16_bf16(a0, qf[1][s], p[1], 0, 0, 0); } }
        asm volatile("s_nop 15\n\ts_nop 7" : "+v"(p[0]), "+v"(p[1]));
        v4u pk[2][2];
#pragma unroll
        for (int qb = 0; qb < 2; ++qb) {
            float ma = at_max3(p[qb][0], p[qb][1], p[qb][2]), mb = at_max3(p[qb][3], p[qb][4], p[qb][5]);
            ma = at_max3(ma, p[qb][6], p[qb][7]); mb = at_max3(mb, p[qb][8], p[qb][9]); ma = at_max3(ma, p[qb][10], p[qb][11]); mb = at_max3(mb, p[qb][12], p[qb][13]); ma = at_max3(ma, p[qb][14], p[qb][15]);
            float mx = fmaxf(ma, mb);
            { const auto rr = __builtin_amdgcn_permlane32_swap(__float_as_uint(mx), __float_as_uint(mx), false, false); mx = fmaxf(__uint_as_float(rr[0]), __uint_as_float(rr[1])); }
            if (t == 0 || __builtin_amdgcn_ballot_w64(mx > mrun[qb] + AT_THR) != 0ull) {
                const float newm = (t == 0 || mx > mrun[qb] + AT_THR) ? mx : mrun[qb], alpha = (t == 0) ? 1.f : __builtin_amdgcn_exp2f(mrun[qb] - newm);
                mrun[qb] = newm; lsum[qb] *= alpha;
#pragma unroll
                for (int r = 0; r < 16; ++r) { o[qb][0][r] *= alpha; o[qb][1][r] *= alpha; }
            }
            float ps = 0.f;
#pragma unroll
            for (int r = 0; r < 16; ++r) { p[qb][r] = __builtin_amdgcn_exp2f(p[qb][r] - mrun[qb]); ps += p[qb][r]; }
            lsum[qb] += ps;
#pragma unroll
            for (int s2 = 0; s2 < 2; ++s2)
                pk[qb][s2] = (v4u){pg8::cvt_pk_bf16(p[qb][8 * s2], p[qb][8 * s2 + 1]), pg8::cvt_pk_bf16(p[qb][8 * s2 + 2], p[qb][8 * s2 + 3]), pg8::cvt_pk_bf16(p[qb][8 * s2 + 4], p[qb][8 * s2 + 5]), pg8::cvt_pk_bf16(p[qb][8 * s2 + 6], p[qb][8 * s2 + 7])};
        }
        { const LAS unsigned char* vp = bb + A2_KBYTES + r32 * A2_VP + hi * 8;
#pragma unroll
          for (int ks = 0; ks < 2; ++ks) {
              const bf16x8 v0 = mk_bf16x8(*(const LAS u64_t*)(vp + ks * 32), *(const LAS u64_t*)(vp + ks * 32 + 16));
              const bf16x8 v1 = mk_bf16x8(*(const LAS u64_t*)(vp + 32 * A2_VP + ks * 32), *(const LAS u64_t*)(vp + 32 * A2_VP + ks * 32 + 16));
#pragma unroll
              for (int qb = 0; qb < 2; ++qb) { const bf16x8 pb = __builtin_bit_cast(bf16x8, pk[qb][ks]);
                  o[qb][0] = __builtin_amdgcn_mfma_f32_32x32x16_bf16(v0, pb, o[qb][0], 0, 0, 0);
                  o[qb][1] = __builtin_amdgcn_mfma_f32_32x32x16_bf16(v1, pb, o[qb][1], 0, 0, 0); } } }
    };
#pragma unroll 1
    for (int t = 0; t < NT; t += 2) {
        tile(t);
        if (t + 2 < NT) { A2_STORE(ka, va, (t + 2) % 3); if (t + 4 < NT) A2_LOAD(ka, va, (t + 4) * 32); }
        at_barrier();
        tile(t + 1);
        if (t + 3 < NT) { A2_STORE(kb, vb, (t + 3) % 3); if (t + 5 < NT) A2_LOAD(kb, vb, (t + 5) * 32); }
        at_barrier();
    }
#undef A2_LOAD
#undef A2_STORE
#pragma unroll
    for (int qb = 0; qb < 2; ++qb) {
        float l = lsum[qb]; { const auto rr = __builtin_amdgcn_permlane32_swap(__float_as_uint(l), __float_as_uint(l), false, false); l = __uint_as_float(rr[0]) + __uint_as_float(rr[1]); }
        const float inv = 1.f / l;
        bf16* Og = (bf16*)(F.ws + WS_OMLA) + ((size_t)b * SEQ + qc * 512 + wave * 64 + qb * 32 + r32) * 384 + h * 64 + 4 * hi;
#pragma unroll
        for (int rg = 0; rg < 4; ++rg) {
            *(u64_t*)(Og + 8 * rg) = (u64_t)pg8::cvt_pk_bf16(o[qb][0][4 * rg] * inv, o[qb][0][4 * rg + 1] * inv) | ((u64_t)pg8::cvt_pk_bf16(o[qb][0][4 * rg + 2] * inv, o[qb][0][4 * rg + 3] * inv) << 32);
            *(u64_t*)(Og + 32 + 8 * rg) = (u64_t)pg8::cvt_pk_bf16(o[qb][1][4 * rg] * inv, o[qb][1][4 * rg + 1] * inv) | ((u64_t)pg8::cvt_pk_bf16(o[qb][1][4 * rg + 2] * inv, o[qb][1][4 * rg + 3] * inv) << 32);
        }
    }
    __syncthreads();
}

constexpr int CW_FLAG = 32768;
__device__ __forceinline__ void partner_sync(Frame& F, gu32* mine, gu32* theirs) {
    asm volatile("s_waitcnt vmcnt(0)" ::: "memory");
    __syncthreads();
    if (F.tid == 0) {
        __builtin_amdgcn_fence(__ATOMIC_RELEASE, "agent");
        asm volatile("s_waitcnt vmcnt(0)" ::: "memory");
        __hip_atomic_store(mine, 1u, RLX_AGENT);
        unsigned spins = 0;
        while (__hip_atomic_load(theirs, RLX_AGENT) == 0u) { __builtin_amdgcn_s_sleep(4); if (++spins > (1u << 22)) break; }
        __builtin_amdgcn_fence(__ATOMIC_ACQUIRE, "agent");
        asm volatile("s_waitcnt vmcnt(0)" ::: "memory");
    }
    __syncthreads();
}
__device__ __forceinline__ float dpp_xor1(float x) { return __builtin_bit_cast(float, __builtin_amdgcn_update_dpp(0, __builtin_bit_cast(int, x), 0xB1, 0xF, 0xF, true)); }
__device__ __forceinline__ float dpp_xor2(float x) { return __builtin_bit_cast(float, __builtin_amdgcn_update_dpp(0, __builtin_bit_cast(int, x), 0x4E, 0xF, 0xF, true)); }
__device__ __forceinline__ float dpp_hmir(float x) { return __builtin_bit_cast(float, __builtin_amdgcn_update_dpp(0, __builtin_bit_cast(int, x), 0x141, 0xF, 0xF, true)); }
__device__ __forceinline__ float dpp_rmir(float x) { return __builtin_bit_cast(float, __builtin_amdgcn_update_dpp(0, __builtin_bit_cast(int, x), 0x140, 0xF, 0xF, true)); }
template <int CTRL, int RM> __device__ __forceinline__ float dpp_sh(float x) { return __builtin_bit_cast(float, __builtin_amdgcn_update_dpp(0, __builtin_bit_cast(int, x), CTRL, RM, 0xF, false)); }
__device__ __forceinline__ float wave_scan(float x) {
    x += dpp_sh<0x111, 0xF>(x); x += dpp_sh<0x112, 0xF>(x); x += dpp_sh<0x114, 0xF>(x); x += dpp_sh<0x118, 0xF>(x);
    x += dpp_sh<0x142, 0xA>(x); x += dpp_sh<0x143, 0xC>(x); return x; }
__device__ __forceinline__ float lane63(float x) { return __builtin_bit_cast(float, __builtin_amdgcn_readlane(__builtin_bit_cast(int, x), 63)); }
constexpr int GP = 144;
constexpr int G_Q = 0, G_K = 9216, G_V = 18432, G_KT = 27648, G_P = 36864, G_A = 46080, G_SM = 63488, G_GROUP = 64512;
constexpr int G_T = 136960;
constexpr int G_SET1 = 91648, G_SM2 = 141056;
constexpr int G_RAW = 65536;
constexpr int G_CW = 133120;
static_assert(G_RAW + 68 * 384 <= G_SET1 && G_SET1 + 4 * 9216 <= RING_BYTES && G_CW + 3840 <= G_T && G_T + 4096 <= G_SM2 && G_SM2 + 1024 <= LDS_BYTES && G_CW >= MISC_OFF + 1024, "GDN LDS map");
__device__ __forceinline__ bf16x8 ld2x8(const LAS unsigned char* p) { return mk_bf16x8(*(const LAS u64_t*)p, *(const LAS u64_t*)(p + 32)); }
__device__ __forceinline__ bf16x8 pack_acc(const f32x4& a, const f32x4& b) {
    v4u w; w.x = pg8::cvt_pk_bf16(a[0], a[1]); w.y = pg8::cvt_pk_bf16(a[2], a[3]); w.z = pg8::cvt_pk_bf16(b[0], b[1]); w.w = pg8::cvt_pk_bf16(b[2], b[3]); return __builtin_bit_cast(bf16x8, w); }
__device__ __forceinline__ void split_acc(const f32x4& a, const f32x4& b, bf16x8& hi, bf16x8& lo) {
    v4u wh; wh.x = cvt2bf(a[0], a[1]); wh.y = cvt2bf(a[2], a[3]); wh.z = cvt2bf(b[0], b[1]); wh.w = cvt2bf(b[2], b[3]);
    f32x4 ra, rb;
    ra[0] = a[0] - __uint_as_float(wh.x << 16); ra[1] = a[1] - __uint_as_float(wh.x & 0xffff0000u); ra[2] = a[2] - __uint_as_float(wh.y << 16); ra[3] = a[3] - __uint_as_float(wh.y & 0xffff0000u);
    rb[0] = b[0] - __uint_as_float(wh.z << 16); rb[1] = b[1] - __uint_as_float(wh.z & 0xffff0000u); rb[2] = b[2] - __uint_as_float(wh.w << 16); rb[3] = b[3] - __uint_as_float(wh.w & 0xffff0000u);
    hi = __builtin_bit_cast(bf16x8, wh); lo = pack_acc(ra, rb);
}
__device__ __forceinline__ bf16x8 pack_acc_v(const f32x4& a, const f32x4& b) { v4u w; w.x = cvt2bf(a[0], a[1]); w.y = cvt2bf(a[2], a[3]); w.z = cvt2bf(b[0], b[1]); w.w = cvt2bf(b[2], b[3]); return __builtin_bit_cast(bf16x8, w); }
__device__ __forceinline__ void hilo4(const f32x4& a, u64_t& hi, u64_t& lo) {
    const unsigned h0 = cvt2bf(a[0], a[1]), h1 = cvt2bf(a[2], a[3]);
    const float r0 = a[0] - __uint_as_float(h0 << 16), r1 = a[1] - __uint_as_float(h0 & 0xffff0000u), r2 = a[2] - __uint_as_float(h1 << 16), r3 = a[3] - __uint_as_float(h1 & 0xffff0000u);
    hi = (u64_t)h0 | ((u64_t)h1 << 32); lo = (u64_t)cvt2bf(r0, r1) | ((u64_t)cvt2bf(r2, r3) << 32);
}
typedef _Float16 f16x8 __attribute__((ext_vector_type(8)));
typedef _Float16 h4_t __attribute__((ext_vector_type(4)));
typedef float f32x2 __attribute__((ext_vector_type(2)));
__device__ __forceinline__ f16x8 pack_acc_f16(const f32x4& a, const f32x4& b) { return (f16x8){(_Float16)a[0], (_Float16)a[1], (_Float16)a[2], (_Float16)a[3], (_Float16)b[0], (_Float16)b[1], (_Float16)b[2], (_Float16)b[3]}; }
template <int J> __device__ __forceinline__ void fmac_rowbc(float& acc, float mc, float t) { asm("v_fmac_f32_dpp %0, %1, %2 row_newbcast:%3 row_mask:0xf bank_mask:0xf" : "+v"(acc) : "v"(mc), "v"(t), "n"(J)); }
template <int I, int J> struct TbbRow { static __device__ __forceinline__ void run(const float (&Mc)[16], const float (&T)[16], float& a0, float& a1) {
    if constexpr (J < I) { if constexpr (J & 1) fmac_rowbc<J>(a1, Mc[I], T[J]); else fmac_rowbc<J>(a0, Mc[I], T[J]); TbbRow<I, J + 1>::run(Mc, T, a0, a1); } } };
template <int I> struct TbbAll { static __device__ __forceinline__ void run(const float (&Mc)[16], float (&T)[16], int cc) {
    if constexpr (I < 16) { float a0 = 0.f, a1 = 0.f; TbbRow<I, 0>::run(Mc, T, a0, a1); T[I] = (I == cc ? 1.f : 0.f) - (a0 + a1); TbbAll<I + 1>::run(Mc, T, cc); } } };
__device__ __forceinline__ void tbb_wave(const LAS float* Mm, LAS float* Tm, int lane) {
    const int bb = lane >> 4, cc = lane & 15; float Mc[16], T[16];
    const LAS float* Mb = Mm + (16 * bb) * 68 + 16 * bb + cc;
#pragma unroll
    for (int i = 0; i < 16; ++i) Mc[i] = Mb[i * 68];
#pragma unroll
    for (int i = 0; i < 16; ++i) T[i] = 0.f;
    TbbAll<0>::run(Mc, T, cc);
#pragma unroll
    for (int i = 0; i < 16; ++i) Tm[(16 * bb + i) * 16 + cc] = T[i];
}
__device__ __forceinline__ void tbb_inplace(LAS float* Tm, int lane) {
    const int bb = lane >> 4, cc = lane & 15; float Mc[16], T[16];
#pragma unroll
    for (int i = 0; i < 16; ++i) Mc[i] = Tm[(16 * bb + i) * 16 + cc];
#pragma unroll
    for (int i = 0; i < 16; ++i) T[i] = 0.f;
    TbbAll<0>::run(Mc, T, cc);
#pragma unroll
    for (int i = 0; i < 16; ++i) Tm[(16 * bb + i) * 16 + cc] = T[i];
}
constexpr int MSP = 136;
__device__ __forceinline__ u64_t bf4pack(const f32x4& a) { return (u64_t)cvt2bf(a[0], a[1]) | ((u64_t)cvt2bf(a[2], a[3]) << 32); }
__device__ __forceinline__ void block_solve(const LAS float* Mm, const LAS float* Tm, int col, int q4, const f32x4 (&Yin)[4], f32x4 (&Xc)[4]) {
    u64_t th[4], mh[6];
#pragma unroll
    for (int bk = 0; bk < 4; ++bk) { const f32x4 tv = *(const LAS f32x4*)(Tm + (16 * bk + col) * 16 + 4 * q4); th[bk] = bf4pack(tv); }
    { int n = 0;
#pragma unroll
      for (int bk = 1; bk < 4; ++bk)
#pragma unroll
          for (int b2 = 0; b2 < bk; ++b2) { mh[n] = *(const LAS u64_t*)((const LAS unsigned char*)Mm + (16 * bk + col) * MSP + 2 * (16 * b2 + 4 * q4)); ++n; } }
    asm volatile("" ::: "memory");
    u64_t xh[4];
#pragma unroll
    for (int bk = 0; bk < 4; ++bk) {
        f32x4 Y = Yin[bk];
#pragma unroll
        for (int b2 = 0; b2 < bk; b2 += 2) {
            const int n0 = bk * (bk - 1) / 2 + b2; const bool two = b2 + 1 < bk;
            Y = __builtin_amdgcn_mfma_f32_16x16x32_bf16(mk_bf16x8(mh[n0], two ? mh[n0 + 1] : 0ull), mk_bf16x8(xh[b2], two ? xh[b2 + 1] : 0ull), Y, 0, 0, 0); }
        const f32x4 X = __builtin_amdgcn_mfma_f32_16x16x32_bf16(mk_bf16x8(th[bk], 0ull), mk_bf16x8(bf4pack(Y), 0ull), (f32x4){0.f, 0.f, 0.f, 0.f}, 0, 0, 0);
        Xc[bk] = X; if (bk < 3) xh[bk] = bf4pack(X);
    }
}
template <int SKIP> __device__ __forceinline__ void gdn_unit3(Frame& F, int l, int unit, gu32* flags) {
    const int bh = unit >> 1, dir = unit & 1, b = bh / 6, h = bh % 6;
    const int tid = F.tid, lane = F.lane, wave = F.wave;
    const bf16* Pgdn = (const bf16*)(F.ws + WS_PGDN) + (size_t)b * SEQ * 1152 + h * 64; const float* Psm = (const float*)(F.ws + WS_PSM) + (size_t)b * SEQ * 32;
    bf16* Og = (SKIP & 128) ? (bf16*)(F.ws + WS_Y + 8 * MiB) + (size_t)(b % 5) * SEQ * 384 + h * 64 : (bf16*)(F.ws + WS_OGDN) + (size_t)b * SEQ * 384 + h * 64;
    bf16* Pgw = const_cast<bf16*>(Pgdn);
#define GDN_SIDE(u_) (F.ws + WS_GSIDE + ((size_t)(l * 96 + (u_)) * 2) * 384)
    LAS unsigned char* gb = F.lds + RING_OFF;
    LAS float* cwl = (LAS float*)(F.lds + G_CW);
    { const float* conv_w = (const float*)inptr(F, 4) + (size_t)l * 5 * 1152;
      for (int i = tid; i < 960; i += 512) { const int tn = i / 320, tap = (i % 320) / 64, ch = i % 64; cwl[i] = conv_w[tap * 1152 + tn * 384 + h * 64 + ch]; } }
    const float al = -__expf(((const float*)inptr(F, 5))[l * 12 + dir * 6 + h]), dtb = ((const float*)inptr(F, 6))[l * 12 + dir * 6 + h];
    f32x4 Sacc[4];
#pragma unroll
    for (int i = 0; i < 4; ++i) Sacc[i] = (f32x4){0.f, 0.f, 0.f, 0.f};
#define GDN_RAW_STAGE(cc_, first_, nthr_) do { const int tlo_ = (dir ? SEQ - 64 * (cc_) - 64 : 64 * (cc_)) - 2; \
        for (int pc_ = (first_); pc_ < 68 * 24; pc_ += (nthr_)) { const int rr_ = pc_ / 24, sg_ = pc_ % 24, tt_ = tlo_ + rr_; v4u x_ = {0u, 0u, 0u, 0u}; \
            if (!(SKIP & 1) && tt_ >= 0 && tt_ < SEQ) x_ = *(const v4u*)(Pgdn + (size_t)tt_ * 1152 + (sg_ >> 3) * 384 + 8 * (sg_ & 7)); \
            *(LAS v4u*)(gb + G_RAW + rr_ * 384 + 16 * sg_) = x_; } } while (0)
#define GDN_WRITEOUT(cc_) do { if (!(SKIP & 4)) { const int ci = tid >> 3, cg = tid & 7;        \
            const int t_ = dir ? SEQ - 1 - 64 * (cc_) - ci : 64 * (cc_) + ci; bf16* op_ = Og + (size_t)t_ * 384 + 8 * cg; \
            const LAS f32x4* src_ = (const LAS f32x4*)(gb + G_A + (ci * 68 + 8 * cg) * 4); f32x4 o0_ = src_[0], o1_ = src_[1]; \
            if ((cc_) >= SEQ / 128) { const v4u p0_ = rmw; \
                o0_ += (f32x4){__uint_as_float(p0_.x << 16), __uint_as_float(p0_.x & 0xffff0000u), __uint_as_float(p0_.y << 16), __uint_as_float(p0_.y & 0xffff0000u)}; \
                o1_ += (f32x4){__uint_as_float(p0_.z << 16), __uint_as_float(p0_.z & 0xffff0000u), __uint_as_float(p0_.w << 16), __uint_as_float(p0_.w & 0xffff0000u)}; } \
            v4u w0_; w0_.x = pg8::cvt_pk_bf16(o0_[0], o0_[1]); w0_.y = pg8::cvt_pk_bf16(o0_[2], o0_[3]); w0_.z = pg8::cvt_pk_bf16(o1_[0], o1_[1]); w0_.w = pg8::cvt_pk_bf16(o1_[2], o1_[3]); \
            *(v4u*)op_ = w0_; } } while (0)
    GDN_RAW_STAGE(0, tid, 512);
#define GDN_NEARHALO(rr_) ((cc1_ < SEQ / 128) && (dir ? (rr_) >= 66 : (rr_) < 2))
#define GDN_RAW_LOAD(cc_) do { const int cc1_ = (cc_); const int tlo_ = (dir ? SEQ - 64 * cc1_ - 64 : 64 * cc1_) - 2; \
        _Pragma("unroll") for (int k_ = 0; k_ < 4; ++k_) { const int pc_ = tid + 512 * k_, rr_ = pc_ / 24, sg_ = pc_ % 24, tt_ = tlo_ + rr_; rawn[k_] = (v4u){0u, 0u, 0u, 0u}; \
            if (!(SKIP & 1) && pc_ < 68 * 24 && tt_ >= 0 && tt_ < SEQ && !GDN_NEARHALO(rr_)) rawn[k_] = *(const v4u*)(Pgdn + (size_t)tt_ * 1152 + (sg_ >> 3) * 384 + 8 * (sg_ & 7)); } \
        if (cc1_ < SEQ / 128 && tid < 48) carry = *(const LAS v4u*)(gb + G_RAW + ((dir ? 2 : 64) + tid / 24) * 384 + 16 * (tid % 24)); } while (0)
#define GDN_RAW_STORE(cc_) do { const int cc1_ = (cc_); _Pragma("unroll") for (int k_ = 0; k_ < 4; ++k_) { const int pc_ = tid + 512 * k_, rr_ = pc_ / 24, sg_ = pc_ % 24; \
            if (pc_ < 68 * 24 && !GDN_NEARHALO(rr_)) *(LAS v4u*)(gb + G_RAW + rr_ * 384 + 16 * sg_) = rawn[k_]; } \
        if (cc1_ < SEQ / 128 && tid < 48) *(LAS v4u*)(gb + G_RAW + ((dir ? 66 : 0) + tid / 24) * 384 + 16 * (tid % 24)) = carry; } while (0)
    v4u rawn[4], carry = {0u, 0u, 0u, 0u}, rmw = {0u, 0u, 0u, 0u};
    auto conv_part = [&](int cc, int t2, bool vpart) {
        LAS unsigned char* gs = gb + ((cc & 1) ? G_SET1 : 0); const int cg2 = t2 & 7;
#pragma unroll 1
        for (int hh = 0; hh < 2; ++hh) { const int ci2 = (t2 >> 3) + 32 * hh, rr0 = dir ? 63 - ci2 : ci2;
            LAS unsigned char* row = gs + ci2 * GP + 16 * cg2; const int tok = dir ? SEQ - 1 - 64 * cc - ci2 : 64 * cc + ci2;
#define GDN_TAPS(tn_, a_) do { _Pragma("unroll") for (int j_ = 0; j_ < 4; ++j_) a_[j_] = (f32x2){0.f, 0.f}; \
            _Pragma("unroll") for (int tap_ = 0; tap_ < 5; ++tap_) { const v4u x0 = *(const LAS v4u*)(gb + G_RAW + (rr0 + tap_) * 384 + (tn_) * 128 + 16 * cg2); const LAS float* w = cwl + (tn_) * 320 + tap_ * 64 + 8 * cg2; \
                const f32x4 w0 = *(const LAS f32x4*)w, w1 = *(const LAS f32x4*)(w + 4); \
                a_[0] = __builtin_elementwise_fma((f32x2){w0[0], w0[1]}, (f32x2){__uint_as_float(x0[0] << 16), __uint_as_float(x0[0] & 0xffff0000u)}, a_[0]); \
                a_[1] = __builtin_elementwise_fma((f32x2){w0[2], w0[3]}, (f32x2){__uint_as_float(x0[1] << 16), __uint_as_float(x0[1] & 0xffff0000u)}, a_[1]); \
                a_[2] = __builtin_elementwise_fma((f32x2){w1[0], w1[1]}, (f32x2){__uint_as_float(x0[2] << 16), __uint_as_float(x0[2] & 0xffff0000u)}, a_[2]); \
                a_[3] = __builtin_elementwise_fma((f32x2){w1[2], w1[3]}, (f32x2){__uint_as_float(x0[3] << 16), __uint_as_float(x0[3] & 0xffff0000u)}, a_[3]); } \
            _Pragma("unroll") for (int j_ = 0; j_ < 4; ++j_) { a_[j_][0] = siluf(a_[j_][0]); a_[j_][1] = siluf(a_[j_][1]); } } while (0)
            if (vpart) { f32x2 av[4]; GDN_TAPS(2, av);
                v4u wv;
#pragma unroll
                for (int q = 0; q < 4; ++q) wv[q] = pg8::cvt_pk_bf16(av[q][0], av[q][1]);
                *(LAS v4u*)(row + G_V) = wv;
                if (cc == SEQ / 128 - 1 && ci2 >= 62) *(v4u*)(GDN_SIDE(unit) + (ci2 - 62) * 384 + 256 + 16 * cg2) = wv; else *(v4u*)(Pgw + (size_t)tok * 1152 + 768 + 8 * cg2) = wv; }
            else { f32x2 aq[4], ak[4]; GDN_TAPS(0, aq); asm volatile("" ::: "memory"); GDN_TAPS(1, ak);
                float sq = 0.f, sk = 0.f;
#pragma unroll
                for (int j = 0; j < 4; ++j) { sq += aq[j][0] * aq[j][0] + aq[j][1] * aq[j][1]; sk += ak[j][0] * ak[j][0] + ak[j][1] * ak[j][1]; }
                sq += dpp_xor1(sq); sk += dpp_xor1(sk); sq += dpp_xor2(sq); sk += dpp_xor2(sk); sq += dpp_hmir(sq); sk += dpp_hmir(sk);
                const float rq = rsqrtf(sq + 1e-6f) * 0.125f, rk = rsqrtf(sk + 1e-6f);
                v4u wq, wk;
#pragma unroll
                for (int q = 0; q < 4; ++q) { wq[q] = pg8::cvt_pk_bf16(aq[q][0] * rq, aq[q][1] * rq); wk[q] = pg8::cvt_pk_bf16(ak[q][0] * rk, ak[q][1] * rk); }
                *(LAS v4u*)(row + G_Q) = wq; *(LAS v4u*)(row + G_K) = wk;
#pragma unroll
                for (int j = 0; j < 8; ++j) *(LAS bf16*)(gs + G_KT + (8 * cg2 + j) * GP + 2 * ci2) = (bf16)((j & 1) ? (wk[j >> 1] >> 16) : (wk[j >> 1] & 0xffffu));
                if (cc == SEQ / 128 - 1 && ci2 >= 62) { unsigned char* sd = GDN_SIDE(unit) + (ci2 - 62) * 384 + 16 * cg2; *(v4u*)sd = wq; *(v4u*)(sd + 128) = wk; }
                else { *(v4u*)(Pgw + (size_t)tok * 1152 + 8 * cg2) = wq; *(v4u*)(Pgw + (size_t)tok * 1152 + 384 + 8 * cg2) = wk; } }
            asm volatile("" ::: "memory");
#undef GDN_TAPS
        }
    };
    auto copy_part = [&](int cc, int t2, bool vpart) {
        LAS unsigned char* gs = gb + ((cc & 1) ? G_SET1 : 0); const int cg2 = t2 & 7;
#pragma unroll
        for (int hh = 0; hh < 2; ++hh) { const int ci2 = (t2 >> 3) + 32 * hh; const LAS unsigned char* src = gb + G_RAW + (2 + (dir ? 63 - ci2 : ci2)) * 384 + 16 * cg2;
            LAS unsigned char* row = gs + ci2 * GP + 16 * cg2;
            if (vpart) *(LAS v4u*)(row + G_V) = *(const LAS v4u*)(src + 256);
            else { const v4u wq = *(const LAS v4u*)src, wk = *(const LAS v4u*)(src + 128);
                *(LAS v4u*)(row + G_Q) = wq; *(LAS v4u*)(row + G_K) = wk;
#pragma unroll
                for (int j = 0; j < 8; ++j) *(LAS bf16*)(gs + G_KT + (8 * cg2 + j) * GP + 2 * ci2) = (bf16)((j & 1) ? (wk[j >> 1] >> 16) : (wk[j >> 1] & 0xffffu)); } }
    };
    float pa = 0.f, pb = 0.f;
#define GDN_PSM(cc_) do { if (!(SKIP & 64) && wave == 4) { const int t_ = dir ? SEQ - 1 - 64 * (cc_) - lane : 64 * (cc_) + lane; pa = Psm[(size_t)t_ * 32 + dir * 6 + h]; pb = Psm[(size_t)t_ * 32 + 12 + dir * 6 + h]; } } while (0)
    auto s1_stage = [&](int cc) {
        LAS unsigned char* gs = gb + ((cc & 1) ? G_SET1 : 0); LAS float* sm = (LAS float*)(gb + ((cc & 1) ? G_SM2 : G_SM));
        if (!(SKIP & 64) && wave == 4) {
            float x = al * softplusf_(pa + dtb);
            x = wave_scan(x);
            const float last = lane63(x);
            sm[lane] = x; sm[64 + lane] = sigmoidf_(pb); sm[128 + lane] = __expf(x); sm[192 + lane] = __expf(last - x);
        }
        if (!(SKIP & 16)) { if (cc < SEQ / 128) conv_part(cc, tid - 256, false); else copy_part(cc, tid - 256, false); }
    };
    GDN_PSM(0);
    __syncthreads();
    if (wave >= 4) s1_stage(0); else if (!(SKIP & 16)) conv_part(0, tid, true);
    __syncthreads();
    for (int c = 0; c < SEQ / 64; ++c) {
        LAS unsigned char* gs = gb + ((c & 1) ? G_SET1 : 0); LAS float* sm = (LAS float*)(gb + ((c & 1) ? G_SM2 : G_SM));
        if (c > 0) GDN_WRITEOUT(c - 1);
        if (c == SEQ / 128) {
            partner_sync(F, flags + 64 * unit, flags + 64 * (unit ^ 1));
            GDN_RAW_STAGE(c, tid, 512);
            __syncthreads();
            if (tid < 48) { const int srow = tid / 24, sg = tid % 24, p = 1 - srow;
                *(LAS v4u*)(gb + G_RAW + (2 + (dir ? 63 - p : p)) * 384 + 16 * sg) = *(const v4u*)(GDN_SIDE(unit ^ 1) + srow * 384 + 16 * sg); }
            __syncthreads();
            if (wave >= 4) s1_stage(c); else if (!(SKIP & 16)) copy_part(c, tid, true);
        }
        if (c >= SEQ / 128) rmw = *(const v4u*)(Og + (size_t)(dir ? SEQ - 1 - 64 * c - (tid >> 3) : 64 * c + (tid >> 3)) * 384 + 8 * (tid & 7));
        if (c + 1 < SEQ / 64) GDN_PSM(c + 1);
        __syncthreads();
        if (c + 1 < SEQ / 64 && c + 1 != SEQ / 128) GDN_RAW_LOAD(c + 1);
        if (!(SKIP & 32) && wave == 1) {
            const int col = lane & 15, q4 = lane >> 4;
            LAS float* Tm = (LAS float*)(gb + G_T);
#pragma unroll
            for (int bq = 0; bq < 4; ++bq) { const LAS unsigned char* kr = gs + G_K + (16 * bq + col) * GP + 16 * q4;
                const bf16x8 k0 = *(const LAS bf16x8*)kr, k1 = *(const LAS bf16x8*)(kr + 64);
                f32x4 d = __builtin_amdgcn_mfma_f32_16x16x32_bf16(k0, k0, (f32x4){0.f, 0.f, 0.f, 0.f}, 0, 0, 0);
                d = __builtin_amdgcn_mfma_f32_16x16x32_bf16(k1, k1, d, 0, 0, 0);
                const float ci = sm[16 * bq + col], bi = sm[64 + 16 * bq + col]; const f32x4 cj = *(const LAS f32x4*)(sm + 16 * bq + 4 * q4); f32x4 o;
#pragma unroll
                for (int r = 0; r < 4; ++r) o[r] = (col > 4 * q4 + r) ? bi * d[r] * __expf(fminf(ci - cj[r], 0.f)) : 0.f;
                *(LAS f32x4*)(Tm + (16 * bq + col) * 16 + 4 * q4) = o; }
            if (!(SKIP & 2)) tbb_inplace(Tm, lane);
        }
        else if (!(SKIP & 32)) { const int ti = (wave >> 1) & 1, tj = wave & 1, r32 = lane & 31, hi = lane >> 5;
          f32x16 acc = {};
          const LAS unsigned char* ir = gs + (wave >= 4 ? G_Q : G_K) + (32 * ti + r32) * GP + 16 * hi; const LAS unsigned char* jr = gs + G_K + (32 * tj + r32) * GP + 16 * hi;
#pragma unroll
          for (int s = 0; s < 4; ++s) acc = __builtin_amdgcn_mfma_f32_32x32x16_bf16(*(const LAS bf16x8*)(jr + 32 * s), *(const LAS bf16x8*)(ir + 32 * s), acc, 0, 0, 0);
          const int i = 32 * ti + r32; const float ci = sm[i];
          if (wave < 4) { const float bi = sm[64 + i];
#pragma unroll
              for (int g = 0; g < 4; ++g) { const int j0 = 32 * tj + 8 * g + 4 * hi; const f32x4 cj = *(const LAS f32x4*)(sm + j0); f32x4 o;
#pragma unroll
                  for (int r = 0; r < 4; ++r) o[r] = (i > j0 + r) ? -(bi * acc[4 * g + r] * __expf(fminf(ci - cj[r], 0.f))) : 0.f;
                  *(LAS u64_t*)(gb + G_A + i * MSP + 2 * j0) = bf4pack(o); } }
          else {
#pragma unroll
              for (int g = 0; g < 4; ++g) { const int j0 = 32 * tj + 8 * g + 4 * hi; const f32x4 cj = *(const LAS f32x4*)(sm + j0); h4_t o;
#pragma unroll
                  for (int r = 0; r < 4; ++r) o[r] = (_Float16)((i >= j0 + r) ? acc[4 * g + r] * __expf(fminf(ci - cj[r], 0.f)) : 0.f);
                  *(LAS h4_t*)(gb + G_P + i * GP + 2 * j0) = o; } } }
        __syncthreads();
        f32x4 Xc[4];
#pragma unroll
        for (int g = 0; g < 4; ++g) Xc[g] = (f32x4){0.f, 0.f, 0.f, 0.f};
        if (!(SKIP & 2)) {
            const int col = lane & 15, q4 = lane >> 4, cidx = 16 * wave + col;
            f32x4 Yin[4];
            if (wave < 4) {
#pragma unroll
                for (int bk = 0; bk < 4; ++bk) { const f32x4 be = *(const LAS f32x4*)(sm + 64 + 16 * bk + 4 * q4);
#pragma unroll
                    for (int r = 0; r < 4; ++r) Yin[bk][r] = bf2f(*(const LAS bf16*)(gs + G_V + (16 * bk + 4 * q4 + r) * GP + 2 * cidx)) * be[r]; }
            } else {
#pragma unroll
                for (int bk = 0; bk < 4; ++bk) { const f32x4 be = *(const LAS f32x4*)(sm + 64 + 16 * bk + 4 * q4), ga = *(const LAS f32x4*)(sm + 128 + 16 * bk + 4 * q4);
                    Yin[bk] = bf4(*(const LAS u64_t*)(gs + G_KT + (cidx - 64) * GP + 2 * (16 * bk + 4 * q4))) * be * ga; }
            }
            block_solve((const LAS float*)(gb + G_A), (const LAS float*)(gb + G_T), col, q4, Yin, Xc);
        }
        __syncthreads();
        if (c + 1 < SEQ / 64 && c + 1 != SEQ / 128) GDN_RAW_STORE(c + 1);
        { const int col = lane & 15, q4 = lane >> 4, c = 16 * wave + col;
          if (wave >= 4) {
#pragma unroll
              for (int g = 0; g < 4; ++g) { const f32x4 xn = -Xc[g]; const u64_t hh = (u64_t)cvt2bf(xn[0], xn[1]) | ((u64_t)cvt2bf(xn[2], xn[3]) << 32);
#pragma unroll
                  for (int r = 0; r < 4; ++r) { const int i = 16 * g + 4 * q4 + r;
                      *(LAS bf16*)(gs + G_V + i * GP + 2 * (c - 64)) = (bf16)((unsigned)(hh >> (16 * r)) & 0xffffu); } }
          } }
        __syncthreads();
        if (wave >= 4) { if (c + 1 < SEQ / 64 && c + 1 != SEQ / 128) s1_stage(c + 1); }
        else if (SKIP & 8) {} else
        { const int col = lane & 15, q4 = lane >> 4, e = 16 * wave + col;
          const bf16x8 bS0 = pack_acc_v(Sacc[0], Sacc[1]), bS1 = pack_acc_v(Sacc[2], Sacc[3]);
          f32x4 U[4], T1[4];
          const LAS unsigned char* rowa = gs + col * GP + 8 * q4;
          const LAS unsigned char* rowp = gb + G_P + col * GP + 8 * q4;
#pragma unroll
          for (int it = 0; it < 4; ++it) {
              U[it] = Xc[it];
              const LAS unsigned char* ra = rowa + 16 * it * GP;
              const bf16x8 wh0 = ld2x8(ra + G_V), wh1 = ld2x8(ra + G_V + 64), qa0 = ld2x8(ra + G_Q), qa1 = ld2x8(ra + G_Q + 64);
              U[it] = __builtin_amdgcn_mfma_f32_16x16x32_bf16(wh0, bS0, U[it], 0, 0, 0);
              U[it] = __builtin_amdgcn_mfma_f32_16x16x32_bf16(wh1, bS1, U[it], 0, 0, 0);
              T1[it] = __builtin_amdgcn_mfma_f32_16x16x32_bf16(qa0, bS0, (f32x4){0.f, 0.f, 0.f, 0.f}, 0, 0, 0);
              T1[it] = __builtin_amdgcn_mfma_f32_16x16x32_bf16(qa1, bS1, T1[it], 0, 0, 0);
          }
          const f16x8 hU0 = pack_acc_f16(U[0], U[1]), hU1 = pack_acc_f16(U[2], U[3]);
          f32x4 Ud[4];
#pragma unroll
          for (int it = 0; it < 4; ++it) { const f32x4 dc = *(const LAS f32x4*)(sm + 192 + 16 * it + 4 * q4); Ud[it] = U[it] * dc; }
          const bf16x8 bD0 = pack_acc_v(Ud[0], Ud[1]), bD1 = pack_acc_v(Ud[2], Ud[3]);
          const float gend = sm[191];
#pragma unroll
          for (int it = 0; it < 4; ++it) {
              const LAS unsigned char* ra = rowa + 16 * it * GP;
              const f32x4 gm = *(const LAS f32x4*)(sm + 128 + 16 * it + 4 * q4);
              const LAS unsigned char* rp = rowp + 16 * it * GP;
              const bf16x8 pa0 = ld2x8(rp), pa1 = ld2x8(rp + 64), ka0 = ld2x8(ra + G_KT), ka1 = ld2x8(ra + G_KT + 64);
              f32x4 O = T1[it] * gm;
              O = __builtin_amdgcn_mfma_f32_16x16x32_f16(__builtin_bit_cast(f16x8, pa0), hU0, O, 0, 0, 0);
              O = __builtin_amdgcn_mfma_f32_16x16x32_f16(__builtin_bit_cast(f16x8, pa1), hU1, O, 0, 0, 0);
              f32x4 Sn = Sacc[it] * gend;
              Sn = __builtin_amdgcn_mfma_f32_16x16x32_bf16(ka0, bD0, Sn, 0, 0, 0);
              Sn = __builtin_amdgcn_mfma_f32_16x16x32_bf16(ka1, bD1, Sn, 0, 0, 0);
              Sacc[it] = Sn;
#pragma unroll
              for (int r = 0; r < 4; ++r) ((LAS float*)(gb + G_A))[(16 * it + 4 * q4 + r) * 68 + e] = O[r];
          }
          if (!(SKIP & 16) && c + 1 < SEQ / 64 && c + 1 != SEQ / 128) { if (c + 1 < SEQ / 128) conv_part(c + 1, tid, true); else copy_part(c + 1, tid, true); } }
        __syncthreads();
    }
    GDN_WRITEOUT(SEQ / 64 - 1);
#undef GDN_WRITEOUT
#undef GDN_RAW_STAGE
#undef GDN_PSM
#undef GDN_RAW_LOAD
#undef GDN_NEARHALO
#undef GDN_SIDE
#undef GDN_RAW_STORE
    __syncthreads();
}

constexpr int RC_AT = 0, RC_RT = 9216, RC_BT = 18432, RC_KT = 27648, RC_BH = 36864, RC_KH = 46080, RC_VT = 55296, RC_V = 64512, RC_A = 73728  ,
              RC_AK = 91136, RC_RB = 100352, RC_RK = 109568, RC_T = 118784  , RC_SM = 122880  , RC_R2 = RC_BT  ;
static_assert(RC_SM + 512 <= RING_BYTES && RC_R2 + 17408 <= RC_BH, "chunked RWKV LDS map");
template <int SK> __device__ __forceinline__ void rwkv_unit_c(Frame& F, int unit, gu32* flags) {
    const int bh = unit >> 1, dir = unit & 1, b = bh >> 2, h = bh & 3;
    const int tid = F.tid, lane = F.lane, wave = F.wave;
    const unsigned char* Rs = F.ws + WS_RS;
    const unsigned char* Rd = F.ws + WS_RD + dir * RD_DIR;
    bf16* Yg = (bf16*)(F.ws + WS_Y + (SK ? 8 * MiB : 0)) + (size_t)b * SEQ * 256 + h * 64;
    LAS unsigned char* gb = F.lds + RING_OFF;
    LAS float* gamT = (LAS float*)(gb + RC_SM);
    f32x4 Zacc[4];
#pragma unroll
    for (int i = 0; i < 4; ++i) Zacc[i] = (f32x4){0.f, 0.f, 0.f, 0.f};
#define RC_WRITEOUT(cc_) do { const int ci = tid >> 3, cg = tid & 7;        \
        const int t_ = dir ? SEQ - 1 - 64 * (cc_) - ci : 64 * (cc_) + ci; bf16* op_ = Yg + (size_t)t_ * 256 + 8 * cg; \
        const LAS f32x4* src_ = (const LAS f32x4*)(gb + RC_A + (ci * 68 + 8 * cg) * 4); f32x4 o0_ = src_[0], o1_ = src_[1]; \
        if ((cc_) >= SEQ / 128) { const v4u p0_ = *(const v4u*)op_; \
            o0_ += (f32x4){__uint_as_float(p0_.x << 16), __uint_as_float(p0_.x & 0xffff0000u), __uint_as_float(p0_.y << 16), __uint_as_float(p0_.y & 0xffff0000u)}; \
            o1_ += (f32x4){__uint_as_float(p0_.z << 16), __uint_as_float(p0_.z & 0xffff0000u), __uint_as_float(p0_.w << 16), __uint_as_float(p0_.w & 0xffff0000u)}; } \
        v4u w0_; w0_.x = pg8::cvt_pk_bf16(o0_[0], o0_[1]); w0_.y = pg8::cvt_pk_bf16(o0_[2], o0_[3]); w0_.z = pg8::cvt_pk_bf16(o1_[0], o1_[1]); w0_.w = pg8::cvt_pk_bf16(o1_[2], o1_[3]); \
        *(v4u*)op_ = w0_; } while (0)
    struct S1In { v4u gkk, gv, gr, glam, gbv, gk; }; struct S1Out { v4u wa, wr, bh2, kh2; };
    const v4u z4 = {0u, 0u, 0u, 0u};
    S1In in1 = {z4, z4, z4, z4, z4, z4}, in2 = in1; S1Out o1 = {z4, z4, z4, z4}, o2 = o1;
#define RC_LOAD1(cc_, grp_, in_) do { const size_t o_ = rw_rec_off(bh, dir ? SEQ - 1 - 64 * (cc_) - lane : 64 * (cc_) + lane, 0, (grp_)); const unsigned char* rs_ = Rs + o_; const unsigned char* rd_ = Rd + o_; \
        in_.gkk = *(const v4u*)rs_; in_.gv = *(const v4u*)(rs_ + 8192); in_.gr = *(const v4u*)(rs_ + 16384); in_.glam = *(const v4u*)rd_; in_.gbv = *(const v4u*)(rd_ + 8192); in_.gk = *(const v4u*)(rd_ + 16384); } while (0)
#define RC_LOAD(cc_) do { if (!(SK & 1) && wave >= 4) { RC_LOAD1(cc_, wave, in1); RC_LOAD1(cc_, wave - 4, in2); } } while (0)
    auto s1_compute = [&](int cc, int grp, const S1In& in, S1Out& o) {
        LAS float* gT = gamT + 64 * (cc & 1); const int j0 = 8 * grp;
        float lam[8], cum[8]; v4u wb, wk;
#pragma unroll
        for (int q = 0; q < 4; ++q) { lam[2 * q] = __half2float(__ushort_as_half((unsigned short)(in.glam[q] & 0xffffu))); lam[2 * q + 1] = __half2float(__ushort_as_half((unsigned short)(in.glam[q] >> 16))); }
#pragma unroll
        for (int q = 0; q < 8; ++q) cum[q] = wave_scan(lam[q]);
#pragma unroll
        for (int qq = 0; qq < 4; ++qq) { float e1[2], e2[2], e3[2], e4[2];
#pragma unroll
            for (int u = 0; u < 2; ++u) { const int q = 2 * qq + u; const float cT = lane63(cum[q]);
                e1[u] = __builtin_amdgcn_exp2f(-LOG2E * (cum[q] - lam[q])); e2[u] = __builtin_amdgcn_exp2f(-LOG2E * cum[q]); e3[u] = __builtin_amdgcn_exp2f(LOG2E * cum[q]); e4[u] = __builtin_amdgcn_exp2f(-LOG2E * (cT - cum[q]));
                if (lane == 63) gT[j0 + q] = e2[u]; }
            const float kk0 = __uint_as_float(in.gkk[qq] << 16), kk1 = __uint_as_float(in.gkk[qq] & 0xffff0000u), r0 = __uint_as_float(in.gr[qq] << 16), r1 = __uint_as_float(in.gr[qq] & 0xffff0000u);
            const float b0 = __uint_as_float(in.gbv[qq] << 16), b1 = __uint_as_float(in.gbv[qq] & 0xffff0000u), k0 = __uint_as_float(in.gk[qq] << 16), k1 = __uint_as_float(in.gk[qq] & 0xffff0000u);
            o.wa[qq] = pg8::cvt_pk_bf16(-kk0 * e1[0], -kk1 * e1[1]); o.wr[qq] = pg8::cvt_pk_bf16(r0 * e2[0], r1 * e2[1]); wb[qq] = pg8::cvt_pk_bf16(b0 * e3[0], b1 * e3[1]); wk[qq] = pg8::cvt_pk_bf16(k0 * e3[0], k1 * e3[1]);
            o.bh2[qq] = pg8::cvt_pk_bf16(b0 * e4[0], b1 * e4[1]); o.kh2[qq] = pg8::cvt_pk_bf16(k0 * e4[0], k1 * e4[1]); }
        { LAS unsigned char* row = gb + lane * GP + 2 * j0; *(LAS v4u*)(row + RC_BT) = wb; *(LAS v4u*)(row + RC_KT) = wk;
#pragma unroll
          for (int q = 0; q < 8; ++q) *(LAS bf16*)(gb + (j0 + q) * GP + 2 * lane + RC_VT) = (bf16)((q & 1) ? (in.gv[q >> 1] >> 16) : (in.gv[q >> 1] & 0xffffu)); }
    };
    auto s1_store = [&](int grp, const S1Out& o, const v4u& gv) {
        const int t = lane, j0 = 8 * grp;
        LAS unsigned char* row = gb + t * GP + 2 * j0;
        *(LAS v4u*)(row + RC_AT) = o.wa; *(LAS v4u*)(row + RC_RT) = o.wr; *(LAS v4u*)(row + RC_V) = gv;
#pragma unroll
        for (int q = 0; q < 8; ++q) { LAS unsigned char* tr = gb + (j0 + q) * GP + 2 * t;
            *(LAS bf16*)(tr + RC_BH) = (bf16)((q & 1) ? (o.bh2[q >> 1] >> 16) : (o.bh2[q >> 1] & 0xffffu)); *(LAS bf16*)(tr + RC_KH) = (bf16)((q & 1) ? (o.kh2[q >> 1] >> 16) : (o.kh2[q >> 1] & 0xffffu)); }
    };
    RC_LOAD(0);
    __syncthreads();
    for (int c = 0; c < SEQ / 64; ++c) {
        if (c > 0) RC_WRITEOUT(c - 1);
        if (c == SEQ / 128) partner_sync(F, flags + 64 * unit, flags + 64 * (unit ^ 1));
        if (!(SK & 32) && wave >= 4) { if (c == 0) { s1_compute(0, wave, in1, o1); s1_compute(0, wave - 4, in2, o2); }
            s1_store(wave, o1, in1.gv); s1_store(wave - 4, o2, in2.gv); }
        __syncthreads();
        if (c + 1 < SEQ / 64) RC_LOAD(c + 1);
        if (!(SK & 2)) { const int rb = wave >> 1, r32 = lane & 31, hi = lane >> 5;
          const LAS unsigned char* xr = gb + (rb < 2 ? RC_AT : RC_RT) + (32 * (rb & 1) + r32) * GP + 16 * hi; const int tt = 32 * (rb & 1) + r32;
#pragma unroll
          for (int k2 = 0; k2 < 2; ++k2) { const int cb = 2 * (wave & 1) + k2;
              if (wave == 0 && k2 == 1) {
                  const int col = lane & 15, q4 = lane >> 4; LAS float* Tm = (LAS float*)(gb + RC_T);
#pragma unroll
                  for (int bq = 0; bq < 4; ++bq) { const LAS unsigned char* br_ = gb + RC_BT + (16 * bq + col) * GP + 16 * q4; const LAS unsigned char* ar_ = gb + RC_AT + (16 * bq + col) * GP + 16 * q4;
                      f32x4 d = __builtin_amdgcn_mfma_f32_16x16x32_bf16(*(const LAS bf16x8*)br_, *(const LAS bf16x8*)ar_, (f32x4){0.f, 0.f, 0.f, 0.f}, 0, 0, 0);
                      d = __builtin_amdgcn_mfma_f32_16x16x32_bf16(*(const LAS bf16x8*)(br_ + 64), *(const LAS bf16x8*)(ar_ + 64), d, 0, 0, 0);
                      f32x4 o;
#pragma unroll
                      for (int r = 0; r < 4; ++r) o[r] = (col > 4 * q4 + r) ? -d[r] : 0.f;
                      *(LAS f32x4*)(Tm + (16 * bq + col) * 16 + 4 * q4) = o; }
                  if (!(SK & 4)) tbb_inplace(Tm, lane);
                  continue; }
              const LAS unsigned char* yr = gb + (cb < 2 ? RC_BT : RC_KT) + (32 * (cb & 1) + r32) * GP + 16 * hi;
              f32x16 acc = {};
#pragma unroll
              for (int s = 0; s < 4; ++s) acc = __builtin_amdgcn_mfma_f32_32x32x16_bf16(*(const LAS bf16x8*)(yr + 32 * s), *(const LAS bf16x8*)(xr + 32 * s), acc, 0, 0, 0);
              if (rb < 2 && cb < 2) {
#pragma unroll
                  for (int g = 0; g < 4; ++g) { const int s0 = 32 * (cb & 1) + 8 * g + 4 * hi; f32x4 o;
#pragma unroll
                      for (int r = 0; r < 4; ++r) o[r] = (tt > s0 + r) ? acc[4 * g + r] : 0.f;
                      *(LAS u64_t*)(gb + RC_A + tt * MSP + 2 * s0) = bf4pack(o); } }
              else { const int incl = (tid >> 8) & 1  ; LAS unsigned char* dst = gb + (rb < 2 ? RC_AK : (cb < 2 ? RC_RB : RC_RK)) + tt * GP;
#pragma unroll
                  for (int g = 0; g < 4; ++g) { const int s0 = 32 * (cb & 1) + 8 * g + 4 * hi; f32x4 o;
#pragma unroll
                      for (int r = 0; r < 4; ++r) o[r] = (tt + incl > s0 + r) ? acc[4 * g + r] : 0.f;
                      *(LAS u64_t*)(dst + 2 * s0) = (u64_t)pg8::cvt_pk_bf16(o[0], o[1]) | ((u64_t)pg8::cvt_pk_bf16(o[2], o[3]) << 32); } } } }
        __syncthreads();
        if (!(SK & 4)) { const int col = lane & 15, q4 = lane >> 4, it = wave >> 1;
#pragma unroll
          for (int k2 = 0; k2 < 2; ++k2) { const int ct = 2 * (wave & 1) + k2; f32x4 acc = {0.f, 0.f, 0.f, 0.f};
              const LAS unsigned char* pa = gb + RC_AK + (16 * it + col) * GP + 8 * q4; const LAS unsigned char* pb = gb + RC_VT + (16 * ct + col) * GP + 8 * q4;
              acc = __builtin_amdgcn_mfma_f32_16x16x32_bf16(ld2x8(pa), ld2x8(pb), acc, 0, 0, 0);
              acc = __builtin_amdgcn_mfma_f32_16x16x32_bf16(ld2x8(pa + 64), ld2x8(pb + 64), acc, 0, 0, 0);
#pragma unroll
              for (int r = 0; r < 4; ++r) ((LAS float*)(gb + RC_R2))[(16 * it + 4 * q4 + r) * 68 + 16 * ct + col] = acc[r]; } }
        __syncthreads();
        f32x4 Xc[4];
#pragma unroll
        for (int g = 0; g < 4; ++g) Xc[g] = (f32x4){0.f, 0.f, 0.f, 0.f};
        if (!(SK & 8)) { const int col = lane & 15, q4 = lane >> 4, cidx = 16 * wave + col;
          f32x4 Yin[4];
          if (wave >= 4) {
#pragma unroll
              for (int bk = 0; bk < 4; ++bk)
#pragma unroll
                  for (int r = 0; r < 4; ++r) Yin[bk][r] = bf2f(*(const LAS bf16*)(gb + RC_AT + (16 * bk + 4 * q4 + r) * GP + 2 * (cidx - 64)));
          } else {
#pragma unroll
              for (int bk = 0; bk < 4; ++bk)
#pragma unroll
                  for (int r = 0; r < 4; ++r) Yin[bk][r] = ((const LAS float*)(gb + RC_R2))[(16 * bk + 4 * q4 + r) * 68 + cidx];
          }
          block_solve((const LAS float*)(gb + RC_A), (const LAS float*)(gb + RC_T), col, q4, Yin, Xc); }
        __syncthreads();
        { const int col = lane & 15, q4 = lane >> 4, cidx = 16 * wave + col;
          if (wave >= 4) {
#pragma unroll
              for (int g = 0; g < 4; ++g) { const u64_t hh = (u64_t)cvt2bf(Xc[g][0], Xc[g][1]) | ((u64_t)cvt2bf(Xc[g][2], Xc[g][3]) << 32);
#pragma unroll
                  for (int r = 0; r < 4; ++r) { const int i = 16 * g + 4 * q4 + r;
                      *(LAS bf16*)(gb + RC_AT + i * GP + 2 * (cidx - 64)) = (bf16)((unsigned)(hh >> (16 * r)) & 0xffffu); } }
          } }
        __syncthreads();
        if (wave >= 4) { if (!(SK & 32) && c + 1 < SEQ / 64) { s1_compute(c + 1, wave, in1, o1); s1_compute(c + 1, wave - 4, in2, o2); } }
        else if (!(SK & 16)) { const int col = lane & 15, q4 = lane >> 4, e = 16 * wave + col;
          const bf16x8 bZ0 = pack_acc_v(Zacc[0], Zacc[1]), bZ1 = pack_acc_v(Zacc[2], Zacc[3]);
          f32x4 U[4], Yo[4], Vc[4];
          const LAS unsigned char* rowa = gb + col * GP + 8 * q4;
#pragma unroll
          for (int it = 0; it < 4; ++it) {
              U[it] = Xc[it];
#pragma unroll
              for (int r = 0; r < 4; ++r) Vc[it][r] = bf2f(*(const LAS bf16*)(gb + RC_V + (16 * it + 4 * q4 + r) * GP + 2 * e));
              const LAS unsigned char* ra = rowa + 16 * it * GP;
              const bf16x8 wh0 = ld2x8(ra + RC_AT), wh1 = ld2x8(ra + RC_AT + 64), qa0 = ld2x8(ra + RC_RT), qa1 = ld2x8(ra + RC_RT + 64);
              U[it] = __builtin_amdgcn_mfma_f32_16x16x32_bf16(wh0, bZ0, U[it], 0, 0, 0);
              U[it] = __builtin_amdgcn_mfma_f32_16x16x32_bf16(wh1, bZ1, U[it], 0, 0, 0);
              Yo[it] = __builtin_amdgcn_mfma_f32_16x16x32_bf16(qa0, bZ0, (f32x4){0.f, 0.f, 0.f, 0.f}, 0, 0, 0);
              Yo[it] = __builtin_amdgcn_mfma_f32_16x16x32_bf16(qa1, bZ1, Yo[it], 0, 0, 0);
              asm volatile("" ::: "memory");
          }
          const bf16x8 bU0 = pack_acc_v(U[0], U[1]), bU1 = pack_acc_v(U[2], U[3]);
          const bf16x8 bV0 = pack_acc(Vc[0], Vc[1]), bV1 = pack_acc(Vc[2], Vc[3]);
#pragma unroll
          for (int it = 0; it < 4; ++it) {
              const LAS unsigned char* ra = rowa + 16 * it * GP;
              const bf16x8 pb0 = ld2x8(ra + RC_RB), pb1 = ld2x8(ra + RC_RB + 64), pk0 = ld2x8(ra + RC_RK), pk1 = ld2x8(ra + RC_RK + 64);
              const bf16x8 hb0 = ld2x8(ra + RC_BH), hb1 = ld2x8(ra + RC_BH + 64), hk0 = ld2x8(ra + RC_KH), hk1 = ld2x8(ra + RC_KH + 64);
              f32x4 O = Yo[it];
              O = __builtin_amdgcn_mfma_f32_16x16x32_bf16(pk0, bV0, O, 0, 0, 0);
              O = __builtin_amdgcn_mfma_f32_16x16x32_bf16(pk1, bV1, O, 0, 0, 0);
              O = __builtin_amdgcn_mfma_f32_16x16x32_bf16(pb0, bU0, O, 0, 0, 0);
              O = __builtin_amdgcn_mfma_f32_16x16x32_bf16(pb1, bU1, O, 0, 0, 0);
              const f32x4 gz = *(const LAS f32x4*)(gamT + 64 * (c & 1) + 16 * it + 4 * q4);
              f32x4 Zn = Zacc[it] * gz;
              Zn = __builtin_amdgcn_mfma_f32_16x16x32_bf16(hk0, bV0, Zn, 0, 0, 0);
              Zn = __builtin_amdgcn_mfma_f32_16x16x32_bf16(hk1, bV1, Zn, 0, 0, 0);
              Zn = __builtin_amdgcn_mfma_f32_16x16x32_bf16(hb0, bU0, Zn, 0, 0, 0);
              Zn = __builtin_amdgcn_mfma_f32_16x16x32_bf16(hb1, bU1, Zn, 0, 0, 0);
              Zacc[it] = Zn;
#pragma unroll
              for (int r = 0; r < 4; ++r) ((LAS float*)(gb + RC_A))[(16 * it + 4 * q4 + r) * 68 + e] = O[r];
              asm volatile("" ::: "memory");
          }
          in1 = in2 = (S1In){z4, z4, z4, z4, z4, z4}; o1 = o2 = (S1Out){z4, z4, z4, z4}; }
        __syncthreads();
    }
    RC_WRITEOUT(SEQ / 64 - 1);
#undef RC_WRITEOUT
#undef RC_LOAD
#undef RC_LOAD1
    __syncthreads();
}
__device__ __forceinline__ int next_unit(Frame& F, gu32* head) {
    __syncthreads();
    if (F.tid == 0) F.MISC[16] = __hip_atomic_fetch_add(head, 1u, RLX_AGENT);
    __syncthreads();
    return (int)F.MISC[16];
}
constexpr int U_GDN = 96, U_RWKV = 64, U_ATT = 192, U_ALL = U_GDN + U_RWKV + U_ATT;
template <int DUMMY> __device__ __forceinline__ void p3_mixers(Frame& F, int l, int rep) {
    gu32* head = F.ctl + CW_QUEUE + 64 * (2 * l + rep);
    for (int u = F.vcu; u < U_ALL; u = F.G + next_unit(F, head)) {
        asm volatile("" : "+v"(F.tid), "+v"(F.lane));
        if (u < U_GDN) {
#ifdef EXP_GDN
            gdn_unit3<EXP_GDN>(F, l, u, F.ctl + CW_FLAG + 64 * 256 * (4 + 2 * l + rep) + 64 * 128); asm volatile("" : "+v"(F.tid), "+v"(F.lane));
#endif
            gdn_unit3<DUMMY ? 128 : 0>(F, l, u, F.ctl + CW_FLAG + 64 * 256 * (2 * l + rep) + 64 * 128); }
        else if (u < U_GDN + U_RWKV) {
#ifdef EXP_RWKV
            rwkv_unit_c<EXP_RWKV>(F, u - U_GDN, F.ctl + CW_FLAG + 64 * 256 * (4 + 2 * l + rep)); asm volatile("" : "+v"(F.tid), "+v"(F.lane));
#endif
            rwkv_unit_c<DUMMY ? 64 : 0>(F, u - U_GDN, F.ctl + CW_FLAG + 64 * 256 * (2 * l + rep)); }
        else {
#ifdef EXP_ATT
            attn_unit64(F, u - U_GDN - U_RWKV); asm volatile("" : "+v"(F.tid), "+v"(F.lane));
#endif
            attn_unit64(F, u - U_GDN - U_RWKV); }
    }
}
__device__ __forceinline__ u64_t pk4(const f32x4& v) { return (u64_t)pg8::cvt_pk_bf16(v[0], v[1]) | ((u64_t)pg8::cvt_pk_bf16(v[2], v[3]) << 32); }
constexpr int RW_PITCH = 1808, RW_MU = 66 * RW_PITCH, RW_LDS = RW_MU + 2 * 896 * 4;
static_assert(RW_LDS <= RING_BYTES, "RWKV prep LDS map");
__device__ __forceinline__ f32x4 rw_shift4_l(const LAS unsigned char* row, int c, bool hp, bool hn, const LAS float* mu) {
    const f32x4 x = bf4(*(const LAS u64_t*)(row + 2 * c)), xp = hp ? bf4(*(const LAS u64_t*)(row - RW_PITCH + 2 * c)) : (f32x4){0.f, 0.f, 0.f, 0.f}, xn = hn ? bf4(*(const LAS u64_t*)(row + RW_PITCH + 2 * c)) : (f32x4){0.f, 0.f, 0.f, 0.f};
    const f32x4 m0 = *(const LAS f32x4*)(mu + c), m1 = *(const LAS f32x4*)(mu + 896 + c);
    return x + m0 * (xp - x) + m1 * (xn - x);
}
__device__ __forceinline__ void p2_rwkv_unit_l(Frame& F, int l, int unit, int h0, int h1) {
    const int lane = F.lane, col = lane & 15, q4 = lane >> 4, b = (16 * unit) / SEQ, t = (16 * unit) % SEQ + col; const size_t m = (size_t)16 * unit + col;
    const bool hp = t > 0, hn = t < SEQ - 1;
    const float* kkp = (const float*)inptr(F, 17) + l * 256; const float* w0p = (const float*)inptr(F, 13) + l * 512; const float* a0p = (const float*)inptr(F, 15) + l * 512;
    const float* kap = (const float*)inptr(F, 18) + l * 256; const float* rkp = (const float*)inptr(F, 19) + l * 256;
    const LAS unsigned char* Prw = F.lds + RING_OFF + (16 * (unit & 3) + col + 1) * RW_PITCH;
    const LAS float* mu = (const LAS float*)(F.lds + RING_OFF + RW_MU);
    const bf16* W2T = (const bf16*)(F.ws + WS_WSMALL + OFF_W2T) + (size_t)l * 2 * 256 * 64 + (size_t)col * 64 + 8 * q4;
    const bf16* A2T = (const bf16*)(F.ws + WS_WSMALL + OFF_A2T) + (size_t)l * 2 * 256 * 64 + (size_t)col * 64 + 8 * q4;
    bf16x8 awd[2], aad[2];
#pragma unroll
    for (int s = 0; s < 2; ++s) { const int c = 768 + 32 * s + 8 * q4;
        f32x4 lo = rw_shift4_l(Prw, c, hp, hn, mu), hi = rw_shift4_l(Prw, c + 4, hp, hn, mu);
#pragma unroll
        for (int i = 0; i < 4; ++i) { lo[i] = 1.f - 2.f * __builtin_amdgcn_rcpf(1.f + __expf(2.f * lo[i])); hi[i] = 1.f - 2.f * __builtin_amdgcn_rcpf(1.f + __expf(2.f * hi[i])); }
        awd[s] = pack_acc(lo, hi);
        aad[s] = pack_acc(rw_shift4_l(Prw, c + 64, hp, hn, mu), rw_shift4_l(Prw, c + 68, hp, hn, mu)); }
#pragma unroll 1
    for (int h = h0; h < h1; ++h) {
        f32x4 k[4]; float kn = 0.f;
        { const float* k_k = kkp;
#pragma unroll
          for (int nt = 0; nt < 4; ++nt) { const int c = 64 * h + 16 * nt + 4 * q4; k[nt] = rw_shift4_l(Prw, 256 + c, hp, hn, mu);
              const f32x4 x = k[nt] * *(const f32x4*)(k_k + c); kn += (x[0] * x[0] + x[1] * x[1]) + (x[2] * x[2] + x[3] * x[3]); } }
        kn += __shfl_xor(kn, 16); kn += __shfl_xor(kn, 32);
        const float rkn = rsqrtf(kn + 1e-6f);
        float cbv = 0.f;
        const size_t ro = rw_rec_off(b * 4 + h, t, 0, q4 >> 1) + 8 * (q4 & 1);
        unsigned char* rs = F.ws + WS_RS + ro;
        unsigned char* rd0 = F.ws + WS_RD + ro;
#pragma unroll
        for (int nt = 0; nt < 4; ++nt) { const int c = 64 * h + 16 * nt + 4 * q4;
            const f32x4 r = rw_shift4_l(Prw, c, hp, hn, mu), v = rw_shift4_l(Prw, 512 + c, hp, hn, mu);
            const f32x4 kk = k[nt] * *(const f32x4*)(kkp + c) * rkn;
            *(u64_t*)(rs + 2048 * nt) = pk4(kk); *(u64_t*)(rs + 8192 + 2048 * nt) = pk4(v); *(u64_t*)(rs + 16384 + 2048 * nt) = pk4(r);
            f32x4 ksum = {0.f, 0.f, 0.f, 0.f};
#pragma unroll
            for (int e = 0; e < 2; ++e) { const bf16* w = W2T + (size_t)(e * 256 + 64 * h + 16 * nt) * 64; const bf16* a = A2T + (size_t)(e * 256 + 64 * h + 16 * nt) * 64;
                f32x4 x = {0.f, 0.f, 0.f, 0.f}, y = {0.f, 0.f, 0.f, 0.f};
#pragma unroll
                for (int s = 0; s < 2; ++s) { x = __builtin_amdgcn_mfma_f32_16x16x32_bf16(*(const bf16x8*)(w + 32 * s), awd[s], x, 0, 0, 0); y = __builtin_amdgcn_mfma_f32_16x16x32_bf16(*(const bf16x8*)(a + 32 * s), aad[s], y, 0, 0, 0); }
                const f32x4 w0v = *(const f32x4*)(w0p + e * 256 + c), a0v = *(const f32x4*)(a0p + e * 256 + c), kav = *(const f32x4*)(kap + c);
                f32x4 lam, av;
#pragma unroll
                for (int i = 0; i < 4; ++i) { lam[i] = 0.6065306597126334f * sigmoidf_(w0v[i] + x[i]); av[i] = sigmoidf_(a0v[i] + y[i]); }
                const f32x4 km = k[nt] * (1.f + (av - 1.f) * kav), bb = av * kk;
                ksum += km;
                typedef _Float16 h4 __attribute__((ext_vector_type(4)));
                const h4 lh = {(_Float16)lam[0], (_Float16)lam[1], (_Float16)lam[2], (_Float16)lam[3]};
                unsigned char* rd = rd0 + e * RD_DIR;
                *(u64_t*)(rd + 2048 * nt) = __builtin_bit_cast(u64_t, lh); *(u64_t*)(rd + 8192 + 2048 * nt) = pk4(bb); *(u64_t*)(rd + 16384 + 2048 * nt) = pk4(km); }
            const f32x4 rkv = *(const f32x4*)(rkp + c), xx = r * ksum * rkv; cbv += (xx[0] + xx[1]) + (xx[2] + xx[3]);
        }
        cbv += __shfl_xor(cbv, 16); cbv += __shfl_xor(cbv, 32);
        if (q4 == 0) ((float*)(F.ws + WS_CB))[m * 4 + h] = 0.5f * cbv;
    }
}
constexpr int ML_QP = 400, ML_KP = 272, ML_KW = 96 * ML_QP, ML_SLAB = ML_KW + 128 * ML_KP;
static_assert(ML_SLAB <= RING_BYTES, "MLA slab");
__device__ __forceinline__ void p2_mla_wg(Frame& F, int l, int tb) {
    const int tid = F.tid, lane = F.lane, wave = F.wave, col = lane & 15, q4 = lane >> 4, tt = wave & 3, half = wave >> 2;
    const int m = 64 * tb + 16 * tt + col, b = m / SEQ, t = m % SEQ, t0 = (64 * tb + 16 * tt) % SEQ;
    const bf16* prow = (const bf16*)(F.ws + WS_PMLA) + (size_t)m * 352;
    const bf16* WuqT = (const bf16*)(F.ws + WS_WSMALL + OFF_WUQ) + (size_t)l * 576 * 192;
    const bf16* WukvT = (const bf16*)(F.ws + WS_WSMALL + OFF_WUKV) + (size_t)l * 768 * 128;
    LAS unsigned char* sl = F.lds + RING_OFF;
    v4u wreg[5];
#define ML_LOADQ(h_) do { _Pragma("unroll") for (int k_ = 0; k_ < 5; ++k_) { const int p_ = tid + 512 * k_; \
        if (p_ < 96 * 24) wreg[k_] = *(const v4u*)(WuqT + (size_t)((h_) * 96 + p_ / 24) * 192 + 8 * (p_ % 24)); } } while (0)
#define ML_STOREQ() do { _Pragma("unroll") for (int k_ = 0; k_ < 5; ++k_) { const int p_ = tid + 512 * k_; \
        if (p_ < 96 * 24) *(LAS v4u*)(sl + (p_ / 24) * ML_QP + 16 * (p_ % 24)) = wreg[k_]; } } while (0)
#define ML_LOADK(h_) do { _Pragma("unroll") for (int k_ = 0; k_ < 4; ++k_) { const int p_ = tid + 512 * k_; \
        wreg[k_] = *(const v4u*)(WukvT + (size_t)((h_) * 128 + (p_ >> 4)) * 128 + 8 * (p_ & 15)); } } while (0)
#define ML_STOREK() do { _Pragma("unroll") for (int k_ = 0; k_ < 4; ++k_) { const int p_ = tid + 512 * k_; \
        *(LAS v4u*)(sl + ML_KW + (p_ >> 4) * ML_KP + 16 * (p_ & 15)) = wreg[k_]; } } while (0)
    ML_LOADQ(0);
    bf16x8 aq[6], akv[4]; float sq = 0.f, skv = 0.f;
#pragma unroll
    for (int s = 0; s < 6; ++s) { aq[s] = *(const bf16x8*)(prow + 32 * s + 8 * q4); const v4u u = __builtin_bit_cast(v4u, aq[s]);
#pragma unroll
        for (int i = 0; i < 4; ++i) { const float a = __uint_as_float(u[i] << 16), c = __uint_as_float(u[i] & 0xffff0000u); sq += a * a + c * c; } }
#pragma unroll
    for (int s = 0; s < 4; ++s) { akv[s] = *(const bf16x8*)(prow + 192 + 32 * s + 8 * q4); const v4u u = __builtin_bit_cast(v4u, akv[s]);
#pragma unroll
        for (int i = 0; i < 4; ++i) { const float a = __uint_as_float(u[i] << 16), c = __uint_as_float(u[i] & 0xffff0000u); skv += a * a + c * c; } }
    sq += __shfl_xor(sq, 16); sq += __shfl_xor(sq, 32); skv += __shfl_xor(skv, 16); skv += __shfl_xor(skv, 32);
    const float rq = rsqrtf(sq * (1.f / 192.f) + NORM_EPS) * (0.10206207261596575f * LOG2E), rkv = rsqrtf(skv * (1.f / 128.f) + NORM_EPS);
    const float pos = (float)((const int*)inptr(F, 1))[m];
    f32x4 cs, sn;
#pragma unroll
    for (int r = 0; r < 4; ++r) { const float inv = exp2f(-(float)(4 * q4 + r) * (13.287712379549449f / 16.f)); float s_, c_; sincosf(pos * inv, &s_, &c_); cs[r] = c_; sn[r] = s_; }
    bf16* Qo = (bf16*)(F.ws + WS_Q) + ((size_t)b * 6 * SEQ + t) * 96 + 4 * q4;
    bf16* Ko = (bf16*)(F.ws + WS_K) + ((size_t)b * 6 * SEQ + t) * 96 + 4 * q4;
    bf16* Vo = (bf16*)(F.ws + WS_VT) + (size_t)b * 6 * 64 * SEQ + (size_t)col * SEQ + t0 + 4 * q4;
    if (half == 0) { const u64_t x1 = *(const u64_t*)(prow + 320 + 4 * q4), x2 = *(const u64_t*)(prow + 336 + 4 * q4); const f32x4 a = bf4(x1), c = bf4(x2);
      const u64_t o1 = pk4(a * cs - c * sn), o2 = pk4(c * cs + a * sn);
#pragma unroll
      for (int h = 0; h < 6; ++h) { *(u64_t*)(Ko + (size_t)h * SEQ * 96 + 64) = o1; *(u64_t*)(Ko + (size_t)h * SEQ * 96 + 80) = o2; } }
    f32x4 rk4;
#pragma unroll
    for (int r = 0; r < 4; ++r) rk4[r] = __shfl(rkv, 4 * q4 + r);
    const LAS unsigned char* wq = sl + col * ML_QP + 16 * q4; const LAS unsigned char* wk = sl + ML_KW + col * ML_KP + 16 * q4;
    ML_STOREQ();
    __syncthreads();
#pragma unroll 1
    for (int h = 0; h < 6; ++h) {
        ML_LOADK(h);
        { f32x4 x1v = {0.f, 0.f, 0.f, 0.f};
#pragma unroll
          for (int n3 = 0; n3 < 3; ++n3) { const int nt = 3 * half + n3; f32x4 acc = {0.f, 0.f, 0.f, 0.f};
#pragma unroll
              for (int s = 0; s < 6; ++s) acc = __builtin_amdgcn_mfma_f32_16x16x32_bf16(*(const LAS bf16x8*)(wq + 16 * nt * ML_QP + 64 * s), aq[s], acc, 0, 0, 0);
              acc = acc * rq;
              if (half == 0 || n3 == 0) *(u64_t*)(Qo + (size_t)h * SEQ * 96 + 16 * nt) = pk4(acc);
              else if (n3 == 1) x1v = acc;
              else { *(u64_t*)(Qo + (size_t)h * SEQ * 96 + 64) = pk4(x1v * cs - acc * sn); *(u64_t*)(Qo + (size_t)h * SEQ * 96 + 80) = pk4(acc * cs + x1v * sn); }
              asm volatile("" ::: "memory"); } }
        ML_STOREK();
        __syncthreads();
        if (h + 1 < 6) ML_LOADQ(h + 1);
        if (half == 0) {
#pragma unroll
            for (int nt = 0; nt < 4; ++nt) { f32x4 acc = {0.f, 0.f, 0.f, 0.f};
#pragma unroll
                for (int s = 0; s < 4; ++s) acc = __builtin_amdgcn_mfma_f32_16x16x32_bf16(*(const LAS bf16x8*)(wk + 16 * nt * ML_KP + 64 * s), akv[s], acc, 0, 0, 0);
                *(u64_t*)(Ko + (size_t)h * SEQ * 96 + 16 * nt) = pk4(acc * rkv); asm volatile("" ::: "memory"); }
        } else {
#pragma unroll
            for (int nt = 0; nt < 4; ++nt) { f32x4 acc = {0.f, 0.f, 0.f, 0.f};
#pragma unroll
                for (int s = 0; s < 4; ++s) acc = __builtin_amdgcn_mfma_f32_16x16x32_bf16(akv[s], *(const LAS bf16x8*)(wk + (64 + 16 * nt) * ML_KP + 64 * s), acc, 0, 0, 0);
                *(u64_t*)(Vo + (size_t)(h * 64 + 16 * nt) * SEQ) = pk4(acc * rk4); asm volatile("" ::: "memory"); }
        }
        if (h + 1 < 6) ML_STOREQ();
        __syncthreads();
    }
#undef ML_LOADQ
#undef ML_STOREQ
#undef ML_LOADK
#undef ML_STOREK
}
__device__ __forceinline__ void p2_prep3(Frame& F, int l) {
    for (int tb = F.vcu; tb < M / 64; tb += F.G) {
        { const int tid = F.tid, t0 = (64 * tb) % SEQ; const bf16* Prw = (const bf16*)(F.ws + WS_PRW) + ((size_t)64 * tb - 1) * 896; LAS unsigned char* sl = F.lds + RING_OFF;
          const float* mu = (const float*)inptr(F, 12) + l * 2 * 896;
          for (int i = tid; i < 2 * 896 / 4; i += 512) *(LAS f32x4*)(sl + RW_MU + 16 * i) = *(const f32x4*)(mu + 4 * i);
#pragma unroll 1
          for (int k0 = 0; k0 < 15; k0 += 5) { v4u rr[5];
#pragma unroll
              for (int k = 0; k < 5; ++k) { const int p = tid + 512 * (k0 + k), row = p / 112, pc = p % 112, tt = t0 - 1 + row; rr[k] = (v4u){0u, 0u, 0u, 0u};
                  if (p < 66 * 112 && tt >= 0 && tt < SEQ) rr[k] = *(const v4u*)(Prw + (size_t)row * 896 + 8 * pc); }
#pragma unroll
              for (int k = 0; k < 5; ++k) { const int p = tid + 512 * (k0 + k), row = p / 112, pc = p % 112; if (p < 66 * 112) *(LAS v4u*)(sl + row * RW_PITCH + 16 * pc) = rr[k]; } } }
        __syncthreads();
        p2_rwkv_unit_l(F, l, 4 * tb + (F.wave & 3), 2 * (F.wave >> 2), 2 * (F.wave >> 2) + 2);
        __syncthreads();
        p2_mla_wg(F, l, tb);
    }
}
__device__ __forceinline__ void ld16(const bf16* p, f32x4 (&o)[4]) { const v4u a = *(const v4u*)p, b = *(const v4u*)(p + 8);
    o[0] = (f32x4){__uint_as_float(a.x << 16), __uint_as_float(a.x & 0xffff0000u), __uint_as_float(a.y << 16), __uint_as_float(a.y & 0xffff0000u)};
    o[1] = (f32x4){__uint_as_float(a.z << 16), __uint_as_float(a.z & 0xffff0000u), __uint_as_float(a.w << 16), __uint_as_float(a.w & 0xffff0000u)};
    o[2] = (f32x4){__uint_as_float(b.x << 16), __uint_as_float(b.x & 0xffff0000u), __uint_as_float(b.y << 16), __uint_as_float(b.y & 0xffff0000u)};
    o[3] = (f32x4){__uint_as_float(b.z << 16), __uint_as_float(b.z & 0xffff0000u), __uint_as_float(b.w << 16), __uint_as_float(b.w & 0xffff0000u)}; }
__device__ __forceinline__ void p4a_mix2(Frame& F, int l) {
    const bf16* Ogdn = (const bf16*)(F.ws + WS_OGDN); const bf16* Omla = (const bf16*)(F.ws + WS_OMLA); const bf16* Y = (const bf16*)(F.ws + WS_Y);
    const bf16* Pgate = (const bf16*)(F.ws + WS_PGATE); const unsigned char* Rs = F.ws + WS_RS; const float* cb = (const float*)(F.ws + WS_CB); bf16* mix = (bf16*)(F.ws + WS_MIX);
    const int gw = F.vcu * NWAVES + F.wave, NGW = F.G * NWAVES, lane = F.lane, g = lane >> 2, c0 = 16 * lane;
    f32x4 pg[4], pb[4];
    if (g < 6) { const float* gg = (const float*)inptr(F, 7) + l * 64 + (c0 & 63);
#pragma unroll
        for (int i = 0; i < 4; ++i) { pg[i] = *(const f32x4*)(gg + 4 * i); pb[i] = (f32x4){0.f, 0.f, 0.f, 0.f}; } }
    else if (g < 12) {
#pragma unroll
        for (int i = 0; i < 4; ++i) { pg[i] = (f32x4){1.f, 1.f, 1.f, 1.f}; pb[i] = (f32x4){0.f, 0.f, 0.f, 0.f}; } }
    else { const float* lg = (const float*)inptr(F, 20) + l * 256 + (c0 - 768); const float* lb = (const float*)inptr(F, 21) + l * 256 + (c0 - 768);
#pragma unroll
        for (int i = 0; i < 4; ++i) { pg[i] = *(const f32x4*)(lg + 4 * i); pb[i] = *(const f32x4*)(lb + 4 * i); } }
#pragma unroll 2
    for (int m = gw; m < M; m += NGW) {
        f32x4 x[4], gt[4];
        ld16(Pgate + (size_t)m * 1024 + c0, gt);
        if (g < 6) { ld16(Ogdn + (size_t)m * 384 + c0, x);
            float ss = 0.f;
#pragma unroll
            for (int i = 0; i < 4; ++i) ss += (x[i][0] * x[i][0] + x[i][1] * x[i][1]) + (x[i][2] * x[i][2] + x[i][3] * x[i][3]);
            ss += dpp_xor1(ss); ss += dpp_xor2(ss);
            const float rs = rsqrtf(ss * (1.f / 64.f) + NORM_EPS);
#pragma unroll
            for (int i = 0; i < 4; ++i) x[i] = x[i] * rs * pg[i]; }
        else if (g < 12) ld16(Omla + (size_t)m * 384 + (c0 - 384), x);
        else { const int cc = c0 - 768, h = g - 12, b = m / SEQ, t = m % SEQ; f32x4 v[4];
            ld16(Y + (size_t)m * 256 + cc, x); { const unsigned char* vp = Rs + rw_rec_off(b * 4 + h, t, 1, (cc & 63) >> 3); const v4u a = *(const v4u*)vp, bq = *(const v4u*)(vp + 1024);
              v[0] = (f32x4){__uint_as_float(a.x << 16), __uint_as_float(a.x & 0xffff0000u), __uint_as_float(a.y << 16), __uint_as_float(a.y & 0xffff0000u)}; v[1] = (f32x4){__uint_as_float(a.z << 16), __uint_as_float(a.z & 0xffff0000u), __uint_as_float(a.w << 16), __uint_as_float(a.w & 0xffff0000u)};
              v[2] = (f32x4){__uint_as_float(bq.x << 16), __uint_as_float(bq.x & 0xffff0000u), __uint_as_float(bq.y << 16), __uint_as_float(bq.y & 0xffff0000u)}; v[3] = (f32x4){__uint_as_float(bq.z << 16), __uint_as_float(bq.z & 0xffff0000u), __uint_as_float(bq.w << 16), __uint_as_float(bq.w & 0xffff0000u)}; }
            const float cbv = cb[(size_t)m * 4 + h];
            float s1 = 0.f;
#pragma unroll
            for (int i = 0; i < 4; ++i) s1 += (x[i][0] + x[i][1]) + (x[i][2] + x[i][3]);
            s1 += dpp_xor1(s1); s1 += dpp_xor2(s1);
            const float mean = s1 * (1.f / 64.f); float s2 = 0.f;
#pragma unroll
            for (int i = 0; i < 4; ++i) { x[i] = x[i] - mean; s2 += (x[i][0] * x[i][0] + x[i][1] * x[i][1]) + (x[i][2] * x[i][2] + x[i][3] * x[i][3]); }
            s2 += dpp_xor1(s2); s2 += dpp_xor2(s2);
            const float rs = rsqrtf(s2 * (1.f / 64.f) + 64e-5f);
#pragma unroll
            for (int i = 0; i < 4; ++i) x[i] = x[i] * rs * pg[i] + pb[i] + cbv * v[i]; }
        v4u o0, o1;
#pragma unroll
        for (int i = 0; i < 4; ++i) {
#pragma unroll
            for (int j = 0; j < 4; ++j) x[i][j] = x[i][j] * siluf(gt[i][j]); }
        o0.x = pg8::cvt_pk_bf16(x[0][0], x[0][1]); o0.y = pg8::cvt_pk_bf16(x[0][2], x[0][3]); o0.z = pg8::cvt_pk_bf16(x[1][0], x[1][1]); o0.w = pg8::cvt_pk_bf16(x[1][2], x[1][3]);
        o1.x = pg8::cvt_pk_bf16(x[2][0], x[2][1]); o1.y = pg8::cvt_pk_bf16(x[2][2], x[2][3]); o1.z = pg8::cvt_pk_bf16(x[3][0], x[3][1]); o1.w = pg8::cvt_pk_bf16(x[3][2], x[3][3]);
        bf16* op = mix + (size_t)m * 1024 + c0; *(v4u*)op = o0; *(v4u*)(op + 8) = o1;
    }
}
namespace pg8 {
struct EpiOutB {
    static constexpr bool PERM = false, AFTER_DRAIN = false;
    const float* xin; bf16_t* xb; unsigned char* ws;
    __device__ __forceinline__ void operator()(const f32x4 (&acc)[2][2][4][2], const Unit& u, int wr, int wc, int fr, int fq) const {
        typedef unsigned u32x2v __attribute__((ext_vector_type(2)));
        const int row0 = u.pm * BM + wr * 64 + fr, col0 = u.pn * BM + wc * 32 + 4 * fq;
        float* rowss = (float*)(ws + (1u << 20));
#pragma unroll
        for (int ai = 0; ai < 2; ++ai)
#pragma unroll
            for (int m = 0; m < 4; ++m) {
                const int row = row0 + ai * HALF + m * 16; float ss = 0.f;
#pragma unroll
                for (int bj = 0; bj < 2; ++bj)
#pragma unroll
                    for (int n = 0; n < 2; ++n) {
                        const size_t off = (size_t)row * 1024 + col0 + bj * HALF + n * 16;
                        const f32x4 o = *(const f32x4*)(xin + off) + acc[ai][bj][m][n];
                        u32x2v w; w.x = cvt_pk_bf16(o[0], o[1]); w.y = cvt_pk_bf16(o[2], o[3]); *(u32x2v*)(xb + off) = w;
                        ss += (o[0] * o[0] + o[1] * o[1]) + (o[2] * o[2] + o[3] * o[3]);
                    }
                ss += __shfl_xor(ss, 16); ss += __shfl_xor(ss, 32);
                if (fq == 0) rowss[(size_t)row * 16 + u.pn * 4 + wc] = ss;
                asm volatile("" ::: "memory");
            }
    }
};
struct EpiFinalB {
    static constexpr bool PERM = false, AFTER_DRAIN = true;
    const bf16_t* xinb; float* xout; unsigned char* ws; const float* g; unsigned* bar; volatile PG8_LAS unsigned* st;
    __device__ __forceinline__ void operator()(const f32x4 (&)[2][2][4][2], const Unit&, int, int, int, int) const {}
    __device__ __forceinline__ void fused(const f32x4 (&acc)[2][2][4][2], const Unit& u, int wr, int wc, int fr, int fq, PG8_LAS unsigned char* lds, int wid, int lane) const {
        typedef unsigned u32x2v __attribute__((ext_vector_type(2)));
        const int row0 = u.pm * BM + wr * 64 + fr, col0 = u.pn * BM + wc * 32 + 4 * fq;
        f32x4 (&xa)[2][2][4][2] = const_cast<f32x4 (&)[2][2][4][2]>(acc);
        float* rowss = (float*)(ws + (1u << 20));
#pragma unroll
        for (int ai = 0; ai < 2; ++ai)
#pragma unroll
            for (int m = 0; m < 4; ++m) {
                const int row = row0 + ai * HALF + m * 16; float ss = 0.f;
#pragma unroll
                for (int bj = 0; bj < 2; ++bj)
#pragma unroll
                    for (int n = 0; n < 2; ++n) {
                        const u32x2v w = *(const u32x2v*)(xinb + (size_t)row * 1024 + col0 + bj * HALF + n * 16);
                        const f32x4 o = (f32x4){__uint_as_float(w.x << 16), __uint_as_float(w.x & 0xffff0000u), __uint_as_float(w.y << 16), __uint_as_float(w.y & 0xffff0000u)} + acc[ai][bj][m][n];
                        xa[ai][bj][m][n] = o;
                        ss += (o[0] * o[0] + o[1] * o[1]) + (o[2] * o[2] + o[3] * o[3]);
                    }
                ss += __shfl_xor(ss, 16); ss += __shfl_xor(ss, 32);
                if (fq == 0) rowss[(size_t)row * 16 + u.pn * 4 + wc] = ss;
                asm volatile("" ::: "memory");
            }
        { XcdBarrier b; b.bar = bar; b.x = xb_xcc_id(); b.st = st; xcd_barrier(b); }
        f32x4 gv[2][2];
#pragma unroll
        for (int bj = 0; bj < 2; ++bj)
#pragma unroll
            for (int n = 0; n < 2; ++n) gv[bj][n] = *(const f32x4*)(g + col0 + bj * HALF + n * 16);
#pragma unroll
        for (int ai = 0; ai < 2; ++ai)
#pragma unroll
            for (int m = 0; m < 4; ++m) {
                const int row = row0 + ai * HALF + m * 16;
                const f32x4* rp = (const f32x4*)(rowss + (size_t)row * 16);
                const f32x4 s0 = rp[0], s1 = rp[1], s2 = rp[2], s3 = rp[3];
                const float ss = ((s0[0] + s0[1]) + (s0[2] + s0[3])) + ((s1[0] + s1[1]) + (s1[2] + s1[3])) + ((s2[0] + s2[1]) + (s2[2] + s2[3])) + ((s3[0] + s3[1]) + (s3[2] + s3[3]));
                const float rstd = __builtin_amdgcn_rsqf(ss * (1.0f / 1024.0f) + 1e-6f);
#pragma unroll
                for (int bj = 0; bj < 2; ++bj)
#pragma unroll
                    for (int n = 0; n < 2; ++n) *(f32x4*)(xout + (size_t)row * 1024 + col0 + bj * HALF + n * 16) = xa[ai][bj][m][n] * rstd * gv[bj][n];
                asm volatile("" ::: "memory");
            }
    }
};
}
constexpr int PT_OUT = 24, PT_WS = 25, PT_N = 26;
constexpr int FUSED_FINAL_G = (M / 256) * (D / 256);
__device__ __forceinline__ void build_frame(Frame& F, LAS unsigned char* lds) {
    F.lds = lds; F.MISC = (volatile LAS unsigned*)(lds + MISC_OFF); F.ptab = (volatile LAS const unsigned long long*)(lds + MISC_OFF + 256);
    const int t = pg8::mk_tid(lds);
    F.tid = t; F.lane = t & 63; F.wave = __builtin_amdgcn_readfirstlane(t >> 6);
    F.G = gridDim.x; { const int bx = blockIdx.x; F.vcu = (F.G % 8 == 0) ? (bx % 8) * (F.G / 8) + bx / 8 : bx; }
    F.ws = (unsigned char*)inptr(F, PT_WS); F.out = (float*)inptr(F, PT_OUT); F.ctl = (gu32*)F.ws;
}
__device__ __forceinline__ bool ph_in(LAS unsigned char* lds, int k) { volatile LAS unsigned* mi = (volatile LAS unsigned*)(lds + MISC_OFF); const int lo = __builtin_amdgcn_readfirstlane((int)mi[20]), hi = __builtin_amdgcn_readfirstlane((int)mi[21]); return lo <= k && k < hi; }
__device__ __forceinline__ void seam(LAS unsigned char* lds, int k) {
    if (ph_in(lds, k) && ph_in(lds, k + 1)) { Frame F; build_frame(F, lds);
        XcdBarrier bar; bar.bar = (unsigned*)(F.ctl + CW_BAR); bar.x = xb_xcc_id(); bar.st = F.MISC + 8; xcd_barrier(bar);
#ifdef EXP_BAR
        xcd_barrier(bar); xcd_barrier(bar);
#endif
    }
}
template <int L> __device__ __forceinline__ void layer_phases(LAS unsigned char* lds) {
    constexpr int pb = 1 + 5 * L;
    if (ph_in(lds, pb)) { Frame F; build_frame(F, lds);
        pg8::Gemm g{(L == 1 && F.G == FUSED_FINAL_G) ? (const pg8::bf16_t*)F.out : (const pg8::bf16_t*)(F.ws + WS_XB), (const pg8::bf16_t*)(F.ws + WS_WIN) + (size_t)L * NP * D, M, NP, D};
        pg8::StaticOrder S; S.init(M, NP, F.G, (int)blockIdx.x);
        pg8::EpiRoute E{F.ws};
        pg8::gemm_phase<pg8::EpiRoute, pg8::StaticOrder, true, true>(F.lds + RING_OFF, g, S, E);
        if (L == 0 && F.G == P0_DEFER_G) {
            const int bx = (int)blockIdx.x;
            if (bx >= 128) { __syncthreads(); p0_weights(F, 2 * I_L - P0_DEFER_N, 2 * I_L, (bx - 128) * NWAVES + F.wave, 128 * NWAVES); }
        }
#ifdef EXP_REP1
        __syncthreads(); S.init(M, NP, F.G, (int)blockIdx.x); pg8::gemm_phase<pg8::EpiRoute, pg8::StaticOrder, true, true>(F.lds + RING_OFF, g, S, E);
#endif
    }
    seam(lds, pb);
    if (ph_in(lds, pb + 1)) { Frame F; build_frame(F, lds); p2_prep3(F, L);
#ifdef EXP_REP2
        __syncthreads(); p2_prep3(F, L);
#endif
    }
    seam(lds, pb + 1);
    if (ph_in(lds, pb + 2)) { Frame F; build_frame(F, lds);
#ifdef EXP_REP3
        p3_mixers<1>(F, L, 1); __syncthreads();
        { XcdBarrier bar; bar.bar = (unsigned*)(F.ctl + CW_BAR); bar.x = xb_xcc_id(); bar.st = F.MISC + 8; xcd_barrier(bar); }
#endif
        p3_mixers<0>(F, L, 0); }
    seam(lds, pb + 2);
    if (ph_in(lds, pb + 3)) { Frame F; build_frame(F, lds); p4a_mix2(F, L);
#ifdef EXP_REP4A
        __syncthreads(); p4a_mix2(F, L);
#endif
    }
    seam(lds, pb + 3);
    if (ph_in(lds, pb + 4)) { Frame F; build_frame(F, lds);
        pg8::Gemm g{(const pg8::bf16_t*)(F.ws + WS_MIX), (const pg8::bf16_t*)(F.ws + WS_WOUT) + (size_t)L * D * D, M, D, D};
        pg8::StaticOrder S; S.init(M, D, F.G, (int)blockIdx.x);
        if (L == 1 && F.G == FUSED_FINAL_G) {
            pg8::EpiFinalB E{(const pg8::bf16_t*)F.out, F.out, F.ws, (const float*)inptr(F, 23), (unsigned*)(F.ctl + CW_BAR), F.MISC + 8};
            pg8::gemm_phase<pg8::EpiFinalB, pg8::StaticOrder, true, true>(F.lds + RING_OFF, g, S, E);
        } else if (L == 0 && F.G == FUSED_FINAL_G) {
            pg8::EpiOutB E{(const float*)inptr(F, 0), (pg8::bf16_t*)F.out, F.ws};
            pg8::gemm_phase<pg8::EpiOutB, pg8::StaticOrder, true, true>(F.lds + RING_OFF, g, S, E);
        } else {
            pg8::EpiOut<L == 0> E{L == 0 ? (const float*)inptr(F, 0) : (const float*)F.out, F.out, F.ws};
            pg8::gemm_phase<pg8::EpiOut<L == 0>, pg8::StaticOrder, true, true>(F.lds + RING_OFF, g, S, E);
        }
    }
    if (!(L == 1 && (int)gridDim.x == FUSED_FINAL_G)) seam(lds, pb + 4);
}
__global__ void __launch_bounds__(NWAVES * 64, 2) mk_fwd(Args args) {
    extern __shared__ __attribute__((aligned(16))) unsigned char lds_raw[];
    LAS unsigned char* lds = (LAS unsigned char*)lds_raw;
    for (int u = threadIdx.x; u < (LDS_BYTES - LDSCTL_OFF) / 4; u += NWAVES * 64) ((LAS unsigned*)(lds + LDSCTL_OFF))[u] = 0u;
    __syncthreads();
    if (threadIdx.x == 0) { LAS unsigned long long* pt = (LAS unsigned long long*)(lds + MISC_OFF + 256);
#define PT(k) pt[k] = (unsigned long long)args.in[k]
        PT(0); PT(1); PT(2); PT(3); PT(4); PT(5); PT(6); PT(7); PT(8); PT(9); PT(10); PT(11); PT(12); PT(13); PT(14); PT(15); PT(16); PT(17); PT(18); PT(19); PT(20); PT(21); PT(22); PT(23);
#undef PT
        pt[PT_OUT] = (unsigned long long)args.out; pt[PT_WS] = (unsigned long long)args.ws;
        volatile LAS unsigned* mi = (volatile LAS unsigned*)(lds + MISC_OFF); mi[20] = (unsigned)args.ph_lo; mi[21] = (unsigned)args.ph_hi;
        if (args.ph_hi - args.ph_lo > 1) (void)xcd_barrier_post((unsigned*)((gu32*)args.ws + CW_BAR), mi + 8);
    }
    if ((threadIdx.x & 63) == 0) ((volatile LAS unsigned*)(lds + pg8::TIDTAB_OFF))[pg8::hw_slot()] = threadIdx.x >> 6;
    __syncthreads();
    if (ph_in(lds, 0)) { Frame F; build_frame(F, lds); p0_prologue(F);
#ifdef EXP_REP0
        __syncthreads(); p0_prologue(F);
#endif
    }
    seam(lds, 0);
    layer_phases<0>(lds);
    layer_phases<1>(lds);
    if (ph_in(lds, 11) && (int)gridDim.x != FUSED_FINAL_G) { Frame F; build_frame(F, lds); p5_final(F); }
}

extern "C" void kernel_launch(void* const* d_in, const int* in_sizes, int n_in, void* d_out, int out_size, void* d_ws, size_t ws_size, hipStream_t stream) {
    static int grid = 0;
    if (grid == 0) {
        if (n_in != 24 || ws_size < WS_END || out_size != M * D) { fprintf(stderr, "kernel_launch: unexpected inputs (%d), out (%d) or workspace (%zu)\n", n_in, out_size, ws_size); grid = -1; return; }
        int dev = 0, cus = 0;
        if (hipGetDevice(&dev) != hipSuccess || hipDeviceGetAttribute(&cus, hipDeviceAttributeMultiprocessorCount, dev) != hipSuccess) { grid = -1; return; }
        if (hipFuncSetAttribute((const void*)mk_fwd, hipFuncAttributeMaxDynamicSharedMemorySize, LDS_BYTES) != hipSuccess) { fprintf(stderr, "kernel_launch: hipFuncSetAttribute failed\n"); grid = -1; return; }
        (void)hipGetLastError();
        grid = cus;
    }
    if (grid < 0) return;
    unsigned char* ws = (unsigned char*)d_ws;
    (void)hipMemsetAsync(ws + WS_CTL, 0, CTL_ZERO_BYTES, stream);
    Args a{};
    for (int i = 0; i < 24; ++i) a.in[i] = d_in[i];
    a.out = (float*)d_out; a.ws = ws; a.ph_lo = 0; a.ph_hi = NPHASE;
    hipLaunchKernelGGL(mk_fwd, dim3(grid), dim3(NWAVES * 64), LDS_BYTES, stream, a);
}
```
